# Optimizing an MI355X kernel written in HIP

```python
import math
import jax, jax.numpy as jnp
from jax import lax
import numpy as np

D_MODEL = 1024
BATCH = 2
SEQ = 8192
DEPTH = 2

GRID_W = 64
HEAD_DIM = 64
ATTN_HEADS = 8
ATTN_KV_HEADS = 2
ATTN_WIDTH = ATTN_HEADS * HEAD_DIM
KV_WIDTH = ATTN_KV_HEADS * HEAD_DIM
HY_HEADS = 4
HY_WIDTH = HY_HEADS * HEAD_DIM
HY_ORDER = 2
FN_GROUPS = 4
FN_WIDTH = FN_GROUPS * HEAD_DIM
D_MIX = ATTN_WIDTH + HY_WIDTH + FN_WIDTH
HY_PROJ = (HY_ORDER + 1) * HY_WIDTH
IN_COLS = ATTN_WIDTH + 2 * KV_WIDTH + HY_PROJ + FN_WIDTH
Q_BLOCK = 128
ROPE_THETA = 10000.0
SHORT_CONV = 3
HY_BANDS = 8
HY_POS_FEATS = 1 + 2 * HY_BANDS
HY_FILTER_WIDTH = 64
HY_FILTERS = HY_ORDER * 2 * HY_WIDTH
HY_FAST_DECAY_PCT = 0.3
HY_SLOW_DECAY_PCT = 1.5
HY_DECAY_TARGET = 1e-2
PEER_KEYS = 128
PEER_EXPERTS = PEER_KEYS * PEER_KEYS
PEER_HEADS = 8
PEER_DK = 256
PEER_TOPK = 16
PEER_TOKEN_BLOCK = 128
EPS = 1e-6

kernel_name = 'hybrid_attn_hyena_fnet_peer_encoder'


def rmsnorm(x, g):
    xf = x.astype(jnp.float32)
    y = xf * lax.rsqrt(jnp.mean(xf * xf, axis=-1, keepdims=True) + EPS)
    return (y * g.astype(jnp.float32)).astype(x.dtype)


def axial_rope_tables(L):
    rows_n = L // GRID_W
    row = jnp.repeat(jnp.arange(rows_n), GRID_W).astype(jnp.float32)
    col = jnp.tile(jnp.arange(GRID_W), rows_n).astype(jnp.float32)
    n_freq = HEAD_DIM // 4
    inv = ROPE_THETA ** (-jnp.arange(n_freq, dtype=jnp.float32) / n_freq)
    ang = jnp.stack([row[:, None] * inv, col[:, None] * inv], axis=1)
    return jnp.cos(ang), jnp.sin(ang)


def apply_axial_rope(x, cos, sin):
    B, L, H, _ = x.shape
    xr = x.astype(jnp.float32).reshape(B, L, H, 2, 2, HEAD_DIM // 4)
    c = cos[None, :, None]
    s = sin[None, :, None]
    x1, x2 = xr[..., 0, :], xr[..., 1, :]
    out = jnp.stack([x1 * c - x2 * s, x2 * c + x1 * s], axis=-2)
    return out.reshape(B, L, H, HEAD_DIM).astype(x.dtype)


def attention_group(q, k, v, q_g, k_g, cos, sin):
    B, L, _ = q.shape
    rep = ATTN_HEADS // ATTN_KV_HEADS
    q = apply_axial_rope(rmsnorm(q.reshape(B, L, ATTN_HEADS, HEAD_DIM), q_g), cos, sin)
    k = apply_axial_rope(rmsnorm(k.reshape(B, L, ATTN_KV_HEADS, HEAD_DIM), k_g), cos, sin)
    v = v.reshape(B, L, ATTN_KV_HEADS, HEAD_DIM)
    n_blk = L // Q_BLOCK
    qb = q.reshape(B, n_blk, Q_BLOCK, ATTN_KV_HEADS, rep, HEAD_DIM).transpose(1, 0, 2, 3, 4, 5)
    scale = HEAD_DIM ** -0.5

    def block(qi):
        s = jnp.einsum('bqgrd,bkgd->bgrqk', qi, k).astype(jnp.float32) * scale
        p = jax.nn.softmax(s, axis=-1).astype(v.dtype)
        return jnp.einsum('bgrqk,bkgd->bqgrd', p, v)

    out = lax.map(block, qb)
    return out.transpose(1, 0, 2, 3, 4, 5).reshape(B, L, ATTN_WIDTH)


def short_conv(u, w, b):
    L = u.shape[1]
    pad = SHORT_CONV // 2
    up = jnp.pad(u, ((0, 0), (pad, pad), (0, 0)))
    y = b
    for j in range(SHORT_CONV):
        y = y + up[:, j:j + L] * w[j]
    return y


def hyena_filter_spectra(L, w1, b1, f1, w2, b2, f2, w3):
    t = jnp.linspace(0.0, 1.0, L, dtype=jnp.float32)[:, None]
    bands = jnp.arange(1, HY_BANDS + 1, dtype=jnp.float32)
    ang = 2.0 * math.pi * t * bands
    z = jnp.concatenate([t, jnp.sin(ang), jnp.cos(ang)], axis=-1)
    h = jnp.sin(f1 * (z @ w1.astype(jnp.float32) + b1))
    h = jnp.sin(f2 * (h @ w2.astype(jnp.float32) + b2))
    h = (h @ w3.astype(jnp.float32)).reshape(L, HY_ORDER, 2, HY_WIDTH)
    rates = jnp.linspace(-math.log(HY_DECAY_TARGET) / HY_SLOW_DECAY_PCT,
                         -math.log(HY_DECAY_TARGET) / HY_FAST_DECAY_PCT, HY_WIDTH, dtype=jnp.float32)
    h = h * jnp.exp(-t[:, :, None, None] * rates)
    h = h * lax.rsqrt(jnp.sum(h * h, axis=(0, 2), keepdims=True) + EPS)
    fwd, bwd = h[:, :, 0], h[:, :, 1]
    k_full = jnp.concatenate([fwd, jnp.zeros_like(fwd[:1]), bwd[1:][::-1]], axis=0)
    return jnp.fft.rfft(k_full, n=2 * L, axis=0)


def long_conv(u, kf, bias):
    L = u.shape[1]
    uf = jnp.fft.rfft(u, n=2 * L, axis=1)
    y = jnp.fft.irfft(uf * kf[None], n=2 * L, axis=1)[:, :L]
    return y + u * bias


def hyena_group(proj, conv_w, conv_b, kf, bias):
    u = short_conv(proj, conv_w, conv_b).astype(jnp.float32)
    v, x1, x2 = jnp.split(u, HY_ORDER + 1, axis=-1)
    z = v
    for n, gate in enumerate((x1, x2)):
        z = gate * long_conv(z, kf[:, n], bias[n].astype(jnp.float32))
    return z


def fourier_group(u, w, b):
    B, L, _ = u.shape
    ug = u.astype(jnp.float32).reshape(B, L, FN_GROUPS, HEAD_DIM)
    f = jnp.fft.fft2(ug, axes=(1, 3), norm='ortho').real
    y = jnp.einsum('blgd,gde->blge', f, w.astype(jnp.float32)).reshape(B, L, FN_WIDTH)
    return y + b.astype(jnp.float32)


def peer(x, w_query, sub_keys, u_tab, v_tab):
    B, L, D = x.shape
    T = B * L
    xt = x.reshape(T, D)
    q = (xt @ w_query).reshape(T, PEER_HEADS, 2, PEER_DK // 2)
    s = jnp.einsum('thpd,phkd->thpk', q, sub_keys).astype(jnp.float32)
    s_top, i_top = lax.top_k(s, PEER_TOPK)
    cand = (s_top[:, :, 0, :, None] + s_top[:, :, 1, None, :]).reshape(T, PEER_HEADS, PEER_TOPK * PEER_TOPK)
    cand_idx = (i_top[:, :, 0, :, None] * PEER_KEYS + i_top[:, :, 1, None, :]).reshape(T, PEER_HEADS, PEER_TOPK * PEER_TOPK)
    best, pos = lax.top_k(cand, PEER_TOPK)
    idx = jnp.take_along_axis(cand_idx, pos, axis=-1)
    g = jax.nn.softmax(best, axis=-1)
    n_blk = T // PEER_TOKEN_BLOCK

    def block(args):
        xb, ib, gb = args
        ue = jnp.take(u_tab, ib, axis=0)
        a = jax.nn.gelu(jnp.einsum('thkd,td->thk', ue, xb).astype(jnp.float32), approximate=False)
        ve = jnp.take(v_tab, ib, axis=0)
        return jnp.einsum('thk,thkd->td', (gb * a).astype(ve.dtype), ve)

    out = lax.map(block, (xt.reshape(n_blk, PEER_TOKEN_BLOCK, D),
                          idx.reshape(n_blk, PEER_TOKEN_BLOCK, PEER_HEADS, PEER_TOPK),
                          g.reshape(n_blk, PEER_TOKEN_BLOCK, PEER_HEADS, PEER_TOPK)))
    return out.reshape(B, L, D).astype(x.dtype)


def setup_inputs(seed: int = 0) -> dict:
    key = jax.random.key(seed)
    ks = jax.random.split(key, 32)

    def nrm(k, shape, scale):
        return jax.random.normal(k, shape, jnp.float32) * scale

    def gain(k, shape):
        return 1.0 + 0.02 * jax.random.normal(k, shape, jnp.float32)

    return {
        'x': nrm(ks[0], (BATCH, SEQ, D_MODEL), 1.0),
        'norm1_g': gain(ks[1], (DEPTH, D_MODEL)),
        'w_in': nrm(ks[2], (DEPTH, D_MODEL, IN_COLS), D_MODEL ** -0.5),
        'q_norm_g': gain(ks[3], (DEPTH, HEAD_DIM)),
        'k_norm_g': gain(ks[4], (DEPTH, HEAD_DIM)),
        'hy_conv_w': nrm(ks[5], (DEPTH, SHORT_CONV, HY_PROJ), SHORT_CONV ** -0.5),
        'hy_conv_b': nrm(ks[6], (DEPTH, HY_PROJ), 0.02),
        'hy_w1': nrm(ks[7], (DEPTH, HY_POS_FEATS, HY_FILTER_WIDTH), HY_POS_FEATS ** -0.5),
        'hy_b1': nrm(ks[8], (DEPTH, HY_FILTER_WIDTH), 0.02),
        'hy_freq1': gain(ks[9], (DEPTH, HY_FILTER_WIDTH)),
        'hy_w2': nrm(ks[10], (DEPTH, HY_FILTER_WIDTH, HY_FILTER_WIDTH), HY_FILTER_WIDTH ** -0.5),
        'hy_b2': nrm(ks[11], (DEPTH, HY_FILTER_WIDTH), 0.02),
        'hy_freq2': gain(ks[12], (DEPTH, HY_FILTER_WIDTH)),
        'hy_w3': nrm(ks[13], (DEPTH, HY_FILTER_WIDTH, HY_FILTERS), HY_FILTER_WIDTH ** -0.5),
        'hy_bias': nrm(ks[14], (DEPTH, HY_ORDER, HY_WIDTH), 0.1),
        'fn_w': nrm(ks[15], (DEPTH, FN_GROUPS, HEAD_DIM, HEAD_DIM), HEAD_DIM ** -0.5),
        'fn_b': nrm(ks[16], (DEPTH, FN_WIDTH), 0.02),
        'mix_norm_g': gain(ks[17], (DEPTH, D_MIX)),
        'w_out': nrm(ks[18], (DEPTH, D_MIX, D_MODEL), D_MIX ** -0.5),
        'norm2_g': gain(ks[19], (DEPTH, D_MODEL)),
        'peer_w_query': nrm(ks[20], (DEPTH, D_MODEL, PEER_HEADS * PEER_DK), D_MODEL ** -0.5),
        'peer_sub_keys': nrm(ks[21], (DEPTH, 2, PEER_HEADS, PEER_KEYS, PEER_DK // 2), (PEER_DK // 2) ** -0.5),
        'peer_u': nrm(ks[22], (DEPTH, PEER_EXPERTS, D_MODEL), D_MODEL ** -0.5),
        'peer_v': nrm(ks[23], (DEPTH, PEER_EXPERTS, D_MODEL), PEER_HEADS ** -0.5),
        'final_g': gain(ks[24], (D_MODEL,)),
    }


def reference(x, norm1_g, w_in, q_norm_g, k_norm_g, hy_conv_w, hy_conv_b, hy_w1, hy_b1, hy_freq1,
              hy_w2, hy_b2, hy_freq2, hy_w3, hy_bias, fn_w, fn_b, mix_norm_g, w_out, norm2_g,
              peer_w_query, peer_sub_keys, peer_u, peer_v, final_g):
    L = x.shape[1]
    cos, sin = axial_rope_tables(L)
    o_k = ATTN_WIDTH
    o_v = o_k + KV_WIDTH
    o_h = o_v + KV_WIDTH
    o_f = o_h + HY_PROJ
    for l in range(DEPTH):
        h = rmsnorm(x, norm1_g[l])
        p = h @ w_in[l]
        a = attention_group(p[..., :o_k], p[..., o_k:o_v], p[..., o_v:o_h],
                            q_norm_g[l], k_norm_g[l], cos, sin)
        kf = hyena_filter_spectra(L, hy_w1[l], hy_b1[l], hy_freq1[l], hy_w2[l], hy_b2[l],
                                  hy_freq2[l], hy_w3[l])
        y = hyena_group(p[..., o_h:o_f], hy_conv_w[l], hy_conv_b[l], kf, hy_bias[l])
        f = fourier_group(p[..., o_f:], fn_w[l], fn_b[l])
        g = mix_norm_g[l]
        mixed = jnp.concatenate([
            rmsnorm(a, g[:ATTN_WIDTH]),
            rmsnorm(y.astype(x.dtype), g[ATTN_WIDTH:ATTN_WIDTH + HY_WIDTH]),
            rmsnorm(f.astype(x.dtype), g[ATTN_WIDTH + HY_WIDTH:]),
        ], axis=-1)
        x = x + mixed @ w_out[l]
        x = x + peer(rmsnorm(x, norm2_g[l]), peer_w_query[l], peer_sub_keys[l], peer_u[l], peer_v[l])
    return rmsnorm(x, final_g)
```

```cpp
#include <hip/hip_runtime.h>
#include <hip/hip_cooperative_groups.h>
#include <cstdio>
#include <cstdint>
namespace cg = cooperative_groups;

#ifndef ONE_LAUNCH
#define ONE_LAUNCH 0
#endif

typedef unsigned short bf16_t;
typedef short bf16x8 __attribute__((ext_vector_type(8)));
typedef float f32x16 __attribute__((ext_vector_type(16)));
typedef float f32x4 __attribute__((ext_vector_type(4)));
typedef unsigned u32x4 __attribute__((ext_vector_type(4)));
typedef unsigned u32x2 __attribute__((ext_vector_type(2)));

constexpr int DM = 1024, NB = 2, SL = 8192, T = NB * SL, NLAYER = 2;
constexpr int INC = 1792;
constexpr int NTHR = 512, NWAVE = 8;
constexpr int LDS_BYTES = 147456;
constexpr float EPS = 1e-6f;

constexpr size_t MiB = 1u << 20;
constexpr size_t OFF_CTL = 0;
constexpr size_t OFF_WTIN = 1 * MiB;
constexpr size_t OFF_WTOUT = 8 * MiB;
constexpr size_t OFF_WTQ = 12 * MiB;
constexpr size_t OFF_PU = 20 * MiB;
constexpr size_t OFF_PV = 84 * MiB;
constexpr size_t OFF_H2 = 148 * MiB;
constexpr size_t OFF_FM = 152 * MiB;
constexpr size_t OFF_KF = 153 * MiB;
constexpr size_t OFF_XA = 281 * MiB;
constexpr size_t OFF_R = 345 * MiB;
constexpr size_t R_XN = OFF_R + 0 * MiB;
constexpr size_t R_UR = OFF_R + 0 * MiB;
constexpr size_t R_UI = OFF_R + 16 * MiB;
constexpr size_t R_QKV = OFF_R + 32 * MiB;
constexpr size_t R_VT = OFF_R + 56 * MiB;
constexpr size_t R_HF = OFF_R + 60 * MiB;
constexpr size_t R_MIX = OFF_R + 60 * MiB;
constexpr size_t R_ATT = OFF_R + 124 * MiB;
constexpr size_t R_Y = OFF_R + 140 * MiB;
constexpr size_t R_QP = OFF_R + 32 * MiB;
constexpr size_t WS_NEED = 505 * MiB;

struct Params {
    const float* in[25];
    float* out;
    unsigned char* ws;
};
enum { I_X = 0, I_N1G, I_WIN, I_QG, I_KG, I_CW, I_CB, I_W1, I_B1, I_F1, I_W2, I_B2, I_F2, I_W3, I_HB, I_FW, I_FB, I_MG, I_WOUT, I_N2G, I_WQ, I_SK, I_PU, I_PV, I_FG };

__device__ __forceinline__ unsigned f2bf(float f) { unsigned u = __builtin_bit_cast(unsigned, f); return (u + 0x7fffu + ((u >> 16) & 1u)) >> 16; }
__device__ __forceinline__ unsigned pk2(float lo, float hi) { return f2bf(lo) | (f2bf(hi) << 16); }
__device__ __forceinline__ float bf2f(unsigned b) { return __builtin_bit_cast(float, b << 16); }
__device__ __forceinline__ float bflo(unsigned w) { return __builtin_bit_cast(float, w << 16); }
__device__ __forceinline__ float bfhi(unsigned w) { return __builtin_bit_cast(float, w & 0xffff0000u); }
__device__ __forceinline__ float wave_sum(float v) {
#pragma unroll
    for (int o = 1; o < 64; o <<= 1) v += __shfl_xor(v, o);
    return v;
}
__device__ __forceinline__ float wave_max(float v) {
#pragma unroll
    for (int o = 1; o < 64; o <<= 1) v = fmaxf(v, __shfl_xor(v, o));
    return v;
}
__device__ __forceinline__ f32x16 mfma32(bf16x8 a, bf16x8 b, f32x16 c) { return __builtin_amdgcn_mfma_f32_32x32x16_bf16(a, b, c, 0, 0, 0); }
__device__ __forceinline__ f32x16 zero16() { return (f32x16){0.f,0.f,0.f,0.f,0.f,0.f,0.f,0.f,0.f,0.f,0.f,0.f,0.f,0.f,0.f,0.f}; }

__device__ __forceinline__ void transpose_one(const float* W, int K, int N, bf16_t* Wt, float* tile, int item) {
    const int tid = threadIdx.x;
    const int nblk = N / 64, kb = item / nblk, nb = item % nblk, k0 = kb * 64, n0 = nb * 64;
    __syncthreads();
    {
        const int r = tid >> 6, c = tid & 63;
#pragma unroll
        for (int i = 0; i < 8; ++i) { const int k = r + 8 * i; tile[k * 65 + c] = W[(size_t)(k0 + k) * N + n0 + c]; }
    }
    __syncthreads();
    {
        const int nn = tid >> 3, kc = tid & 7;
        const float* s = tile + (kc * 8) * 65 + nn;
        u32x4 o; o.x = pk2(s[0], s[65]); o.y = pk2(s[2 * 65], s[3 * 65]); o.z = pk2(s[4 * 65], s[5 * 65]); o.w = pk2(s[6 * 65], s[7 * 65]);
        *(u32x4*)(Wt + (size_t)(n0 + nn) * K + k0 + kc * 8) = o;
    }
}

__device__ __forceinline__ void phase_p0(const Params& p, char* lds) {
    const int tid = threadIdx.x;
    float* tile = (float*)lds;
    constexpr int IT_IN = (DM / 64) * (INC / 64), IT_OUT = (DM / 64) * (DM / 64), IT_Q = (DM / 64) * (2048 / 64);
    constexpr int IT_L = IT_IN + IT_OUT + IT_Q;
    for (int it = blockIdx.x; it < NLAYER * IT_L; it += gridDim.x) {
        const int layer = it / IT_L; int r = it % IT_L;
        if (r < IT_IN) { transpose_one(p.in[I_WIN] + (size_t)layer * DM * INC, DM, INC, (bf16_t*)(p.ws + OFF_WTIN) + (size_t)layer * INC * DM, tile, r); continue; }
        r -= IT_IN;
        if (r < IT_OUT) { transpose_one(p.in[I_WOUT] + (size_t)layer * DM * DM, DM, DM, (bf16_t*)(p.ws + OFF_WTOUT) + (size_t)layer * DM * DM, tile, r); continue; }
        r -= IT_OUT;
        transpose_one(p.in[I_WQ] + (size_t)layer * DM * 2048, DM, 2048, (bf16_t*)(p.ws + OFF_WTQ) + (size_t)layer * 2048 * DM, tile, r);
    }
    __syncthreads();
    {
        const size_t n4 = (size_t)NLAYER * 16384 * 1024 / 4;
        const size_t gstride = (size_t)gridDim.x * NTHR;
        for (int tb = 0; tb < 2; ++tb) {
            const f32x4* src = (const f32x4*)p.in[tb ? I_PV : I_PU];
            u32x2* dst = (u32x2*)(p.ws + (tb ? OFF_PV : OFF_PU));
            for (size_t i = (size_t)blockIdx.x * NTHR + tid; i < n4; i += gstride) {
                const f32x4 v = src[i]; u32x2 o; o.x = pk2(v.x, v.y); o.y = pk2(v.z, v.w); dst[i] = o;
            }
        }
    }
    {
        float* sh = (float*)lds;
        float* zl = sh + 8 * 64;
        const int sub = tid >> 6, j = tid & 63;
        for (int it = blockIdx.x; it < NLAYER * SL / 8; it += gridDim.x) {
            const int layer = it / (SL / 8), l = (it % (SL / 8)) * 8 + sub;
            const float t = (float)l / (float)(SL - 1);
            __syncthreads();
            if (j < 17) {
                float z;
                if (j == 0) z = t;
                else if (j <= 8) z = sinf(2.0f * 3.14159265358979323846f * t * (float)j);
                else z = cosf(2.0f * 3.14159265358979323846f * t * (float)(j - 8));
                zl[sub * 17 + j] = z;
            }
            __syncthreads();
            const float* w1 = p.in[I_W1] + layer * 17 * 64;
            float a = p.in[I_B1][layer * 64 + j];
#pragma unroll
            for (int i = 0; i < 17; ++i) a += zl[sub * 17 + i] * w1[i * 64 + j];
            sh[sub * 64 + j] = sinf(p.in[I_F1][layer * 64 + j] * a);
            __syncthreads();
            const float* w2 = p.in[I_W2] + layer * 64 * 64;
            float b = p.in[I_B2][layer * 64 + j];
#pragma unroll 8
            for (int k = 0; k < 64; ++k) b += sh[sub * 64 + k] * w2[k * 64 + j];
            ((float*)(p.ws + OFF_H2))[((size_t)layer * SL + l) * 64 + j] = sinf(p.in[I_F2][layer * 64 + j] * b);
        }
    }
    {
        const int total = NLAYER * 4 * 128 * 64;
        for (int o = blockIdx.x * NTHR + tid; o < total; o += gridDim.x * NTHR) {
            const int e2 = o & 63, dd = (o >> 6) & 127, g = (o >> 13) & 3, layer = o >> 15;
            const int d = dd & 63;
            const float* w = p.in[I_FW] + ((size_t)(layer * 4 + g) * 64) * 64;
            float acc = 0.f;
            for (int e = 0; e < 64; ++e) {
                const int m = (d * e) & 63;
                const float ang = (float)m * (2.0f * 3.14159265358979323846f / 64.0f);
                const float tw = (dd < 64) ? cosf(ang) : sinf(ang);
                acc += tw * w[e * 64 + e2];
            }
            ((float*)(p.ws + OFF_FM))[o] = acc * (1.0f / 724.0773439350246f);
        }
    }
}

template <bool PAD> __device__ __forceinline__ int zi(int i) { return PAD ? i + (i >> 8) : i; }

template <int LOGN, bool PAD>
__device__ __forceinline__ void fft_fwd(float2* Z) {
    constexpr int N = 1 << LOGN;
    const int tid = threadIdx.x;
    int s = 0;
    for (; s + 1 < LOGN; s += 2) {
        const int lh2 = LOGN - s - 2;
        const int h2 = 1 << lh2, h = h2 << 1;
        const float rs = 1.0f / (float)(h << 1);
        for (int q = tid; q < N / 4; q += NTHR) {
            const int j = q & (h2 - 1), blk = q >> lh2;
            const int base = (blk << (lh2 + 2)) + j;
            float2 x0 = Z[zi<PAD>(base)], x1 = Z[zi<PAD>(base + h2)], x2 = Z[zi<PAD>(base + h)], x3 = Z[zi<PAD>(base + h + h2)];
            const float ang = (float)j * rs;
            const float c = __builtin_amdgcn_cosf(ang), sn = __builtin_amdgcn_sinf(ang);
            float2 a0 = make_float2(x0.x + x2.x, x0.y + x2.y);
            float2 d02 = make_float2(x0.x - x2.x, x0.y - x2.y);
            float2 a2 = make_float2(d02.x * c + d02.y * sn, d02.y * c - d02.x * sn);
            float2 a1 = make_float2(x1.x + x3.x, x1.y + x3.y);
            float2 d13 = make_float2(x1.x - x3.x, x1.y - x3.y);
            float2 t3 = make_float2(d13.x * c + d13.y * sn, d13.y * c - d13.x * sn);
            float2 a3 = make_float2(t3.y, -t3.x);
            const float c2 = c * c - sn * sn, s2 = 2.f * c * sn;
            float2 y0 = make_float2(a0.x + a1.x, a0.y + a1.y);
            float2 e01 = make_float2(a0.x - a1.x, a0.y - a1.y);
            float2 y1 = make_float2(e01.x * c2 + e01.y * s2, e01.y * c2 - e01.x * s2);
            float2 y2 = make_float2(a2.x + a3.x, a2.y + a3.y);
            float2 e23 = make_float2(a2.x - a3.x, a2.y - a3.y);
            float2 y3 = make_float2(e23.x * c2 + e23.y * s2, e23.y * c2 - e23.x * s2);
            Z[zi<PAD>(base)] = y0; Z[zi<PAD>(base + h2)] = y1; Z[zi<PAD>(base + h)] = y2; Z[zi<PAD>(base + h + h2)] = y3;
        }
        __syncthreads();
    }
    if (s < LOGN) {
        for (int q = tid; q < N / 2; q += NTHR) {
            const int i0 = 2 * q;
            float2 a = Z[zi<PAD>(i0)], b = Z[zi<PAD>(i0 + 1)];
            Z[zi<PAD>(i0)] = make_float2(a.x + b.x, a.y + b.y);
            Z[zi<PAD>(i0 + 1)] = make_float2(a.x - b.x, a.y - b.y);
        }
        __syncthreads();
    }
}

template <int LOGN, bool PAD>
__device__ __forceinline__ void fft_inv(float2* Z) {
    constexpr int N = 1 << LOGN;
    const int tid = threadIdx.x;
    for (int s = LOGN - 2; s >= 0; s -= 2) {
        const int lh2 = LOGN - s - 2;
        const int h2 = 1 << lh2, h = h2 << 1;
        const float rs = 1.0f / (float)(h << 1);
        for (int q = tid; q < N / 4; q += NTHR) {
            const int j = q & (h2 - 1), blk = q >> lh2;
            const int base = (blk << (lh2 + 2)) + j;
            float2 y0 = Z[zi<PAD>(base)], y1 = Z[zi<PAD>(base + h2)], y2 = Z[zi<PAD>(base + h)], y3 = Z[zi<PAD>(base + h + h2)];
            const float ang = (float)j * rs;
            const float c = __builtin_amdgcn_cosf(ang), sn = __builtin_amdgcn_sinf(ang);
            const float c2 = c * c - sn * sn, s2 = 2.f * c * sn;
            float2 t1 = make_float2(y1.x * c2 - y1.y * s2, y1.y * c2 + y1.x * s2);
            float2 t3 = make_float2(y3.x * c2 - y3.y * s2, y3.y * c2 + y3.x * s2);
            float2 a0 = make_float2(y0.x + t1.x, y0.y + t1.y), a1 = make_float2(y0.x - t1.x, y0.y - t1.y);
            float2 a2 = make_float2(y2.x + t3.x, y2.y + t3.y), a3 = make_float2(y2.x - t3.x, y2.y - t3.y);
            float2 u2 = make_float2(a2.x * c - a2.y * sn, a2.y * c + a2.x * sn);
            float2 u3 = make_float2(a3.x * c - a3.y * sn, a3.y * c + a3.x * sn);
            float2 v3 = make_float2(-u3.y, u3.x);
            Z[zi<PAD>(base)] = make_float2(a0.x + u2.x, a0.y + u2.y);
            Z[zi<PAD>(base + h)] = make_float2(a0.x - u2.x, a0.y - u2.y);
            Z[zi<PAD>(base + h2)] = make_float2(a1.x + v3.x, a1.y + v3.y);
            Z[zi<PAD>(base + h + h2)] = make_float2(a1.x - v3.x, a1.y - v3.y);
        }
        __syncthreads();
    }
}

__device__ __forceinline__ void phase_filter_spectra(const Params& p, char* lds) {
    const int tid = threadIdx.x, lane = tid & 63, wave = tid >> 6;
    float2* Z = (float2*)lds;
    float* w3l = (float*)(lds + 131072);
    float* red = w3l + 256;
    for (int job = blockIdx.x; job < NLAYER * 256; job += gridDim.x) {
        const int layer = job >> 8, c = job & 255;
        __syncthreads();
        if (tid < 256) { const int k = tid >> 2, q = tid & 3; w3l[tid] = p.in[I_W3][((size_t)layer * 64 + k) * 1024 + q * 256 + c]; }
        __syncthreads();
        const float* H2 = (const float*)(p.ws + OFF_H2) + (size_t)layer * SL * 64;
        const float r_lo = 4.605170185988092f / 1.5f, r_hi = 4.605170185988092f / 0.3f;
        const float rate = r_lo + (r_hi - r_lo) * ((float)c / 255.0f);
        float ss0 = 0.f, ss1 = 0.f;
        for (int i = 0; i < 16; ++i) {
            const int l = tid + NTHR * i;
            const f32x4* hr = (const f32x4*)(H2 + (size_t)l * 64);
            float a0 = 0.f, a1 = 0.f, a2 = 0.f, a3 = 0.f;
#pragma unroll
            for (int k4 = 0; k4 < 16; ++k4) {
                const f32x4 hv = hr[k4];
#pragma unroll
                for (int e = 0; e < 4; ++e) {
                    const f32x4 w = *(const f32x4*)(w3l + (k4 * 4 + e) * 4);
                    const float hh = hv[e];
                    a0 += hh * w.x; a1 += hh * w.y; a2 += hh * w.z; a3 += hh * w.w;
                }
            }
            const float t = (float)l / (float)(SL - 1);
            const float dec = expf(-t * rate);
            a0 *= dec; a1 *= dec; a2 *= dec; a3 *= dec;
            ss0 += a0 * a0 + a1 * a1; ss1 += a2 * a2 + a3 * a3;
            Z[l] = make_float2(a0, a2);
            if (l >= 1) Z[16384 - l] = make_float2(a1, a3);
        }
        if (tid == 0) Z[8192] = make_float2(0.f, 0.f);
        ss0 = wave_sum(ss0); ss1 = wave_sum(ss1);
        if (lane == 0) { red[wave * 2] = ss0; red[wave * 2 + 1] = ss1; }
        __syncthreads();
        float t0 = 0.f, t1 = 0.f;
#pragma unroll
        for (int w = 0; w < 8; ++w) { t0 += red[w * 2]; t1 += red[w * 2 + 1]; }
        const float sc0 = rsqrtf(t0 + EPS) * (1.0f / 16384.0f) * 0.5f, sc1 = rsqrtf(t1 + EPS) * (1.0f / 16384.0f) * 0.5f;
        fft_fwd<14, false>(Z);
        float2* KF0 = (float2*)(p.ws + OFF_KF) + ((size_t)(layer * 256 + c) * 2) * 16384;
        float2* KF1 = KF0 + 16384;
        for (int i = 0; i < 32; ++i) {
            const int pp = tid + NTHR * i;
            const int f = (int)(__brev((unsigned)pp) >> 18);
            const int fm = (16384 - f) & 16383;
            const int pq = (int)(__brev((unsigned)fm) >> 18);
            const float2 zp = Z[pp], zq = Z[pq];
            KF0[pp] = make_float2((zp.x + zq.x) * sc0, (zp.y - zq.y) * sc0);
            KF1[pp] = make_float2((zp.y + zq.y) * sc1, (zq.x - zp.x) * sc1);
        }
    }
}

__device__ __forceinline__ void phase_rmsnorm_bf16(const float* x, const float* g, bf16_t* out) {
    const int lane = threadIdx.x & 63, wave = threadIdx.x >> 6;
    const int gw = blockIdx.x * NWAVE + wave, ngw = gridDim.x * NWAVE;
    for (int row = gw; row < T; row += ngw) {
        const f32x4* xr = (const f32x4*)(x + (size_t)row * DM) + lane;
        f32x4 v[4]; float ss = 0.f;
#pragma unroll
        for (int j = 0; j < 4; ++j) { v[j] = xr[64 * j]; ss += v[j].x * v[j].x + v[j].y * v[j].y + v[j].z * v[j].z + v[j].w * v[j].w; }
        ss = wave_sum(ss);
        const float r = rsqrtf(ss * (1.0f / DM) + EPS);
        u32x2* o = (u32x2*)(out + (size_t)row * DM) + lane;
#pragma unroll
        for (int j = 0; j < 4; ++j) {
            const f32x4 gg = ((const f32x4*)g)[lane + 64 * j];
            u32x2 w; w.x = pk2(v[j].x * r * gg.x, v[j].y * r * gg.y); w.y = pk2(v[j].z * r * gg.z, v[j].w * r * gg.w);
            o[64 * j] = w;
        }
    }
}
__device__ __forceinline__ void phase_final_norm(const float* x, const float* g, float* out) {
    const int lane = threadIdx.x & 63, wave = threadIdx.x >> 6;
    const int gw = blockIdx.x * NWAVE + wave, ngw = gridDim.x * NWAVE;
    for (int row = gw; row < T; row += ngw) {
        const f32x4* xr = (const f32x4*)(x + (size_t)row * DM) + lane;
        f32x4 v[4]; float ss = 0.f;
#pragma unroll
        for (int j = 0; j < 4; ++j) { v[j] = xr[64 * j]; ss += v[j].x * v[j].x + v[j].y * v[j].y + v[j].z * v[j].z + v[j].w * v[j].w; }
        ss = wave_sum(ss);
        const float r = rsqrtf(ss * (1.0f / DM) + EPS);
        f32x4* o = (f32x4*)(out + (size_t)row * DM) + lane;
#pragma unroll
        for (int j = 0; j < 4; ++j) { const f32x4 gg = ((const f32x4*)g)[lane + 64 * j]; o[64 * j] = v[j] * r * gg; }
    }
}

constexpr int G_LDA = 144;
template <class Epi>
__device__ __forceinline__ void gemm_phase(const bf16_t* A, const bf16_t* Bt, int M, int N, int K, char* lds, const Epi& epi) {
    const int tid = threadIdx.x, lane = tid & 63, wave = tid >> 6;
    const int wm = wave >> 1, wn = wave & 1;
    const int nMt = M / 256, nNt = N / 128, total = nMt * nNt, nk = K / 64;
    char* As = lds; char* Bs = lds + 256 * G_LDA;
    const int l31 = lane & 31, hl = lane >> 5;
    for (int u = blockIdx.x; u < total; u += gridDim.x) {
        const int mt = u % nMt, nt = u / nMt;
        f32x16 acc[2][2];
#pragma unroll
        for (int i = 0; i < 2; ++i)
#pragma unroll
            for (int j = 0; j < 2; ++j) acc[i][j] = zero16();
        u32x4 ra[4], rb[2];
        const bf16_t* Ab = A + (size_t)(mt * 256) * K;
        const bf16_t* Bb = Bt + (size_t)(nt * 128) * K;
#pragma unroll
        for (int i = 0; i < 4; ++i) { const int id = tid + NTHR * i, row = id >> 3, ch = id & 7; ra[i] = *(const u32x4*)(Ab + (size_t)row * K + ch * 8); }
#pragma unroll
        for (int i = 0; i < 2; ++i) { const int id = tid + NTHR * i, row = id >> 3, ch = id & 7; rb[i] = *(const u32x4*)(Bb + (size_t)row * K + ch * 8); }
        for (int kt = 0; kt < nk; ++kt) {
            __syncthreads();
#pragma unroll
            for (int i = 0; i < 4; ++i) { const int id = tid + NTHR * i, row = id >> 3, ch = id & 7; *(u32x4*)(As + row * G_LDA + ch * 16) = ra[i]; }
#pragma unroll
            for (int i = 0; i < 2; ++i) { const int id = tid + NTHR * i, row = id >> 3, ch = id & 7; *(u32x4*)(Bs + row * G_LDA + ch * 16) = rb[i]; }
            __syncthreads();
            if (kt + 1 < nk) {
                const int ko = (kt + 1) * 64;
#pragma unroll
                for (int i = 0; i < 4; ++i) { const int id = tid + NTHR * i, row = id >> 3, ch = id & 7; ra[i] = *(const u32x4*)(Ab + (size_t)row * K + ko + ch * 8); }
#pragma unroll
                for (int i = 0; i < 2; ++i) { const int id = tid + NTHR * i, row = id >> 3, ch = id & 7; rb[i] = *(const u32x4*)(Bb + (size_t)row * K + ko + ch * 8); }
            }
#pragma unroll
            for (int ks = 0; ks < 4; ++ks) {
                bf16x8 a[2], b[2];
#pragma unroll
                for (int i = 0; i < 2; ++i) a[i] = *(const bf16x8*)(As + (wm * 64 + i * 32 + l31) * G_LDA + ks * 32 + hl * 16);
#pragma unroll
                for (int j = 0; j < 2; ++j) b[j] = *(const bf16x8*)(Bs + (wn * 64 + j * 32 + l31) * G_LDA + ks * 32 + hl * 16);
#pragma unroll
                for (int i = 0; i < 2; ++i)
#pragma unroll
                    for (int j = 0; j < 2; ++j) acc[i][j] = mfma32(a[i], b[j], acc[i][j]);
            }
        }
#pragma unroll
        for (int i = 0; i < 2; ++i)
#pragma unroll
            for (int j = 0; j < 2; ++j) epi(acc[i][j], mt * 256 + wm * 64 + i * 32, nt * 128 + wn * 64 + j * 32, lane);
    }
}

struct EpiIn {
    bf16_t* qkv; float* hf;
    __device__ __forceinline__ void operator()(const f32x16& acc, int row0, int col0, int lane) const {
        const int c = col0 + (lane & 31), h = lane >> 5;
        if (col0 < 768) {
#pragma unroll
            for (int r = 0; r < 16; ++r) { const int row = row0 + (r & 3) + 8 * (r >> 2) + 4 * h; qkv[(size_t)row * 768 + c] = (bf16_t)f2bf(acc[r]); }
        } else {
            float* dst = hf + (size_t)(c - 768) * T;
#pragma unroll
            for (int i = 0; i < 4; ++i) { const int row = row0 + 8 * i + 4 * h; f32x4 v; v.x = acc[4 * i]; v.y = acc[4 * i + 1]; v.z = acc[4 * i + 2]; v.w = acc[4 * i + 3]; *(f32x4*)(dst + row) = v; }
        }
    }
};
struct EpiRes {
    const float* base; float* out;
    __device__ __forceinline__ void operator()(const f32x16& acc, int row0, int col0, int lane) const {
        const int c = col0 + (lane & 31), h = lane >> 5;
#pragma unroll
        for (int r = 0; r < 16; ++r) { const size_t o = (size_t)(row0 + (r & 3) + 8 * (r >> 2) + 4 * h) * DM + c; out[o] = base[o] + acc[r]; }
    }
};
struct EpiF32 {
    float* out; int ld;
    __device__ __forceinline__ void operator()(const f32x16& acc, int row0, int col0, int lane) const {
        const int c = col0 + (lane & 31), h = lane >> 5;
#pragma unroll
        for (int r = 0; r < 16; ++r) { out[(size_t)(row0 + (r & 3) + 8 * (r >> 2) + 4 * h) * ld + c] = acc[r]; }
    }
};

__device__ __forceinline__ void phase_qkprep(const Params& p, int layer, char* lds) {
    const int tid = threadIdx.x, lane = tid & 63, wave = tid >> 6;
    bf16_t* qkv = (bf16_t*)(p.ws + R_QKV);
    bf16_t* vt = (bf16_t*)(p.ws + R_VT);
    const float qgv = p.in[I_QG][layer * 64 + lane], kgv = p.in[I_KG][layer * 64 + lane];
    const int gw = blockIdx.x * NWAVE + wave, ngw = gridDim.x * NWAVE;
    const int ax = lane >> 5, fr = lane & 15; const bool second = (lane >> 4) & 1;
    const float inv = powf(10000.0f, -(float)fr / 16.0f);
    for (int t = gw; t < T; t += ngw) {
        const int l = t & (SL - 1);
        const float pos = ax ? (float)(l & 63) : (float)(l >> 6);
        const float ang = pos * inv;
        const float cs = cosf(ang), sn = sinf(ang);
        bf16_t* row = qkv + (size_t)t * 768;
#pragma unroll
        for (int slot = 0; slot < 10; ++slot) {
            const float x = bf2f(row[slot * 64 + lane]);
            const float ss = wave_sum(x * x);
            const float r = rsqrtf(ss * (1.0f / 64.0f) + EPS);
            const float y = x * r * (slot < 8 ? qgv : kgv);
            const float other = __shfl_xor(y, 16);
            float o = second ? (y * cs + other * sn) : (y * cs - other * sn);
            if (slot < 8) o *= 0.125f * 1.4426950408889634f;
            row[slot * 64 + lane] = (bf16_t)f2bf(o);
        }
    }
    bf16_t* tl = (bf16_t*)lds;
    for (int ch = blockIdx.x; ch < T / 64; ch += gridDim.x) {
        const int t0 = ch * 64, b = t0 >> 13, l0 = t0 & (SL - 1);
        __syncthreads();
#pragma unroll
        for (int i = 0; i < 2; ++i) {
            const int id = tid + NTHR * i, tok = id >> 4, c16 = id & 15;
            const u32x4 v = *(const u32x4*)(qkv + (size_t)(t0 + tok) * 768 + 640 + c16 * 8);
            *(u32x4*)(tl + tok * 136 + c16 * 8) = v;
        }
        __syncthreads();
        {
            const int col = tid >> 2, part = tid & 3;
            unsigned w[8];
#pragma unroll
            for (int j = 0; j < 8; ++j) { const unsigned lo = tl[(part * 16 + 2 * j) * 136 + col], hi = tl[(part * 16 + 2 * j + 1) * 136 + col]; w[j] = lo | (hi << 16); }
            bf16_t* dst = vt + ((size_t)(b * 128 + col)) * SL + l0 + part * 16;
            u32x4 o0, o1; o0.x = w[0]; o0.y = w[1]; o0.z = w[2]; o0.w = w[3]; o1.x = w[4]; o1.y = w[5]; o1.z = w[6]; o1.w = w[7];
            *(u32x4*)dst = o0; *(u32x4*)(dst + 8) = o1;
        }
    }
}

constexpr int A_LDK = 144, A_LDV = 136;
__device__ __forceinline__ void attn_unit(const Params& p, int b, int g, int qb, char* lds) {
    const int tid = threadIdx.x, lane = tid & 63, wave = tid >> 6;
    const int l31 = lane & 31, hl = lane >> 5;
    const bf16_t* qkv = (const bf16_t*)(p.ws + R_QKV);
    const bf16_t* vt = (const bf16_t*)(p.ws + R_VT);
    bf16_t* att = (bf16_t*)(p.ws + R_ATT);
    const int h = 4 * g + (wave & 3);
    const int q = qb * 64 + (wave >> 2) * 32 + l31;
    const bf16_t* Qp = qkv + (size_t)(b * SL + q) * 768 + h * 64;
    bf16x8 qf[4];
#pragma unroll
    for (int s = 0; s < 4; ++s) qf[s] = *(const bf16x8*)(Qp + 16 * s + 8 * hl);
    char* Ks = lds; char* Vs = lds + 64 * A_LDK;
    const int srow = tid >> 3, sch = tid & 7;
    const bf16_t* Kg = qkv + (size_t)(b * SL + srow) * 768 + 512 + g * 64 + sch * 8;
    const bf16_t* Vg = vt + ((size_t)((b * 2 + g) * 64 + srow)) * SL + sch * 8;
    f32x16 o0 = zero16(), o1 = zero16();
    float m = -1e30f, lsum = 0.f;
    u32x4 rk = *(const u32x4*)Kg, rv = *(const u32x4*)Vg;
    __syncthreads();
    for (int kt = 0; kt < SL / 64; ++kt) {
        __syncthreads();
        *(u32x4*)(Ks + srow * A_LDK + sch * 16) = rk;
        { u32x2 lo, hi; lo.x = rv.x; lo.y = rv.y; hi.x = rv.z; hi.y = rv.w; *(u32x2*)(Vs + srow * A_LDV + sch * 16) = lo; *(u32x2*)(Vs + srow * A_LDV + sch * 16 + 8) = hi; }
        __syncthreads();
        if (kt + 1 < SL / 64) { rk = *(const u32x4*)(Kg + (size_t)(kt + 1) * 64 * 768); rv = *(const u32x4*)(Vg + (kt + 1) * 64); }
        f32x16 p0 = zero16(), p1 = zero16();
#pragma unroll
        for (int s = 0; s < 4; ++s) {
            const bf16x8 k0 = *(const bf16x8*)(Ks + l31 * A_LDK + s * 32 + hl * 16);
            const bf16x8 k1 = *(const bf16x8*)(Ks + (32 + l31) * A_LDK + s * 32 + hl * 16);
            p0 = mfma32(k0, qf[s], p0); p1 = mfma32(k1, qf[s], p1);
        }
        float mx = fmaxf(p0[0], p1[0]);
#pragma unroll
        for (int r = 1; r < 16; ++r) mx = fmaxf(mx, fmaxf(p0[r], p1[r]));
        mx = fmaxf(mx, __shfl_xor(mx, 32));
        const float mn = fmaxf(m, mx);
        const float alpha = __builtin_amdgcn_exp2f(m - mn);
        m = mn;
        float rs = 0.f;
#pragma unroll
        for (int r = 0; r < 16; ++r) { p0[r] = __builtin_amdgcn_exp2f(p0[r] - mn); p1[r] = __builtin_amdgcn_exp2f(p1[r] - mn); rs += p0[r] + p1[r]; }
        lsum = lsum * alpha + rs;
#pragma unroll
        for (int r = 0; r < 16; ++r) { o0[r] *= alpha; o1[r] *= alpha; }
#pragma unroll
        for (int kb = 0; kb < 2; ++kb)
#pragma unroll
            for (int s = 0; s < 2; ++s) {
                u32x4 pw;
                if (kb == 0) { pw.x = pk2(p0[8 * s], p0[8 * s + 1]); pw.y = pk2(p0[8 * s + 2], p0[8 * s + 3]); pw.z = pk2(p0[8 * s + 4], p0[8 * s + 5]); pw.w = pk2(p0[8 * s + 6], p0[8 * s + 7]); }
                else { pw.x = pk2(p1[8 * s], p1[8 * s + 1]); pw.y = pk2(p1[8 * s + 2], p1[8 * s + 3]); pw.z = pk2(p1[8 * s + 4], p1[8 * s + 5]); pw.w = pk2(p1[8 * s + 6], p1[8 * s + 7]); }
                const bf16x8 pf = __builtin_bit_cast(bf16x8, pw);
                const int kofs = (kb * 32 + s * 16 + 4 * hl) * 2;
#pragma unroll
                for (int dt = 0; dt < 2; ++dt) {
                    const char* vp = Vs + (dt * 32 + l31) * A_LDV + kofs;
                    const u32x2 v0 = *(const u32x2*)vp, v1 = *(const u32x2*)(vp + 16);
                    u32x4 vw; vw.x = v0.x; vw.y = v0.y; vw.z = v1.x; vw.w = v1.y;
                    const bf16x8 vf = __builtin_bit_cast(bf16x8, vw);
                    if (dt == 0) o0 = mfma32(vf, pf, o0); else o1 = mfma32(vf, pf, o1);
                }
            }
    }
    lsum += __shfl_xor(lsum, 32);
    const float il = 1.0f / lsum;
    bf16_t* Op = att + (size_t)(b * SL + q) * 512 + h * 64;
#pragma unroll
    for (int i = 0; i < 4; ++i) {
        u32x2 w0, w1;
        w0.x = pk2(o0[4 * i] * il, o0[4 * i + 1] * il); w0.y = pk2(o0[4 * i + 2] * il, o0[4 * i + 3] * il);
        w1.x = pk2(o1[4 * i] * il, o1[4 * i + 1] * il); w1.y = pk2(o1[4 * i + 2] * il, o1[4 * i + 3] * il);
        *(u32x2*)(Op + 8 * i + 4 * hl) = w0;
        *(u32x2*)(Op + 32 + 8 * i + 4 * hl) = w1;
    }
}

__device__ __forceinline__ float convd(const float* row, int l, float w0, float w1, float w2, float cb) {
    float v = cb + w1 * row[l];
    if (l > 0) v += w0 * row[l - 1];
    if (l < SL - 1) v += w2 * row[l + 1];
    return v;
}
__device__ __forceinline__ void hyena_job(const Params& p, int layer, int c, char* lds) {
    const int tid = threadIdx.x;
    float2* Z = (float2*)lds;
    const float* HF = (const float*)(p.ws + R_HF);
    const float* cw = p.in[I_CW] + (size_t)layer * 3 * 768; const float* cbp = p.in[I_CB] + layer * 768;
    const float2* KF0 = (const float2*)(p.ws + OFF_KF) + ((size_t)(layer * 256 + c) * 2) * 16384;
    const float2* KF1 = KF0 + 16384;
    float* Y = (float*)(p.ws + R_Y) + (size_t)c * T;
    const float bias0 = p.in[I_HB][(layer * 2 + 0) * 256 + c], bias1 = p.in[I_HB][(layer * 2 + 1) * 256 + c];
    const int cv = c, c1 = 256 + c, c2 = 512 + c;
    const float* rv = HF + (size_t)cv * T; const float* r1 = HF + (size_t)c1 * T; const float* r2 = HF + (size_t)c2 * T;
    const float v_w0 = cw[cv], v_w1 = cw[768 + cv], v_w2 = cw[1536 + cv], v_cb = cbp[cv];
    const float a_w0 = cw[c1], a_w1 = cw[768 + c1], a_w2 = cw[1536 + c1], a_cb = cbp[c1];
    const float b_w0 = cw[c2], b_w1 = cw[768 + c2], b_w2 = cw[1536 + c2], b_cb = cbp[c2];
    __syncthreads();
#pragma unroll 4
    for (int i = 0; i < 16; ++i) {
        const int l = tid + NTHR * i;
        Z[l] = make_float2(convd(rv, l, v_w0, v_w1, v_w2, v_cb), convd(rv + SL, l, v_w0, v_w1, v_w2, v_cb));
        Z[8192 + l] = make_float2(0.f, 0.f);
    }
    __syncthreads();
    fft_fwd<14, false>(Z);
#pragma unroll 4
    for (int i = 0; i < 32; ++i) { const int pp = tid + NTHR * i; const float2 z = Z[pp], k = KF0[pp]; Z[pp] = make_float2(z.x * k.x - z.y * k.y, z.x * k.y + z.y * k.x); }
    __syncthreads();
    fft_inv<14, false>(Z);
#pragma unroll 2
    for (int i = 0; i < 16; ++i) {
        const int l = tid + NTHR * i;
        const float2 cvz = Z[l];
        const float v0 = convd(rv, l, v_w0, v_w1, v_w2, v_cb), v1 = convd(rv + SL, l, v_w0, v_w1, v_w2, v_cb);
        const float g0 = convd(r1, l, a_w0, a_w1, a_w2, a_cb), g1 = convd(r1 + SL, l, a_w0, a_w1, a_w2, a_cb);
        const float za = g0 * (cvz.x + v0 * bias0), zb = g1 * (cvz.y + v1 * bias0);
        Y[l] = za; Y[SL + l] = zb;
        Z[l] = make_float2(za, zb);
    }
#pragma unroll 4
    for (int i = 0; i < 16; ++i) { const int l = tid + NTHR * i; Z[8192 + l] = make_float2(0.f, 0.f); }
    __syncthreads();
    fft_fwd<14, false>(Z);
#pragma unroll 4
    for (int i = 0; i < 32; ++i) { const int pp = tid + NTHR * i; const float2 z = Z[pp], k = KF1[pp]; Z[pp] = make_float2(z.x * k.x - z.y * k.y, z.x * k.y + z.y * k.x); }
    __syncthreads();
    fft_inv<14, false>(Z);
#pragma unroll 2
    for (int i = 0; i < 16; ++i) {
        const int l = tid + NTHR * i;
        const float2 cvz = Z[l];
        const float g0 = convd(r2, l, b_w0, b_w1, b_w2, b_cb), g1 = convd(r2 + SL, l, b_w0, b_w1, b_w2, b_cb);
        const float za = Y[l], zb = Y[SL + l];
        Y[l] = g0 * (cvz.x + za * bias1);
        Y[SL + l] = g1 * (cvz.y + zb * bias1);
    }
    __syncthreads();
}

__device__ __forceinline__ void fnet_job(const Params& p, int ch, char* lds) {
    const int tid = threadIdx.x;
    float2* Z = (float2*)lds;
    const float* row = (const float*)(p.ws + R_HF) + (size_t)(768 + ch) * T;
    float* UR = (float*)(p.ws + R_UR) + (size_t)ch * T;
    float* UI = (float*)(p.ws + R_UI) + (size_t)ch * T;
    __syncthreads();
#pragma unroll 4
    for (int i = 0; i < 16; ++i) { const int l = tid + NTHR * i; Z[zi<true>(l)] = make_float2(row[l], row[SL + l]); }
    __syncthreads();
    fft_fwd<13, true>(Z);
#pragma unroll 4
    for (int i = 0; i < 16; ++i) {
        const int k = tid + NTHR * i;
        const int pk = (int)(__brev((unsigned)k) >> 19);
        const int km = (SL - k) & (SL - 1);
        const int pm = (int)(__brev((unsigned)km) >> 19);
        const float2 zk = Z[zi<true>(pk)], zm = Z[zi<true>(pm)];
        UR[k] = 0.5f * (zk.x + zm.x); UI[k] = 0.5f * (zk.y - zm.y);
        UR[SL + k] = 0.5f * (zk.y + zm.y); UI[SL + k] = 0.5f * (zm.x - zk.x);
    }
    __syncthreads();
}

__device__ __forceinline__ void phase_mix(const Params& p, int layer, char* lds) {
    const int tid = threadIdx.x, lane = tid & 63, wave = tid >> 6;
    float* Ul = (float*)lds;
    float* Yl = Ul + 2 * 256 * 33;
    float* Fl = Yl + 256 * 33;
    const float* UR = (const float*)(p.ws + R_UR); const float* UI = (const float*)(p.ws + R_UI);
    const float* Y = (const float*)(p.ws + R_Y);
    const bf16_t* att = (const bf16_t*)(p.ws + R_ATT);
    bf16_t* mix = (bf16_t*)(p.ws + R_MIX);
    const float* FM = (const float*)(p.ws + OFF_FM) + (size_t)layer * 4 * 128 * 64;
    const float* fb = p.in[I_FB] + layer * 256;
    const float* mg = p.in[I_MG] + layer * 1024;
    for (int tile = blockIdx.x; tile < T / 32; tile += gridDim.x) {
        const int t0 = tile * 32;
        __syncthreads();
        for (int i = tid; i < 256 * 32; i += NTHR) {
            const int c = i >> 5, tt = i & 31;
            Ul[c * 33 + tt] = UR[(size_t)c * T + t0 + tt];
            Ul[(256 + c) * 33 + tt] = UI[(size_t)c * T + t0 + tt];
            Yl[c * 33 + tt] = Y[(size_t)c * T + t0 + tt];
        }
        __syncthreads();
        {
            const int tok = tid & 31, eo = tid >> 5, g = eo >> 2, e0 = (eo & 3) * 16;
            float acc[16];
#pragma unroll
            for (int j = 0; j < 16; ++j) acc[j] = fb[g * 64 + e0 + j];
            const float* Mg = FM + (size_t)g * 128 * 64 + e0;
            for (int dd = 0; dd < 128; ++dd) {
                const float u = Ul[((dd >> 6) * 256 + g * 64 + (dd & 63)) * 33 + tok];
                const f32x4* mr = (const f32x4*)(Mg + dd * 64);
#pragma unroll
                for (int j4 = 0; j4 < 4; ++j4) { const f32x4 mv = mr[j4]; acc[4 * j4] += u * mv.x; acc[4 * j4 + 1] += u * mv.y; acc[4 * j4 + 2] += u * mv.z; acc[4 * j4 + 3] += u * mv.w; }
            }
#pragma unroll
            for (int j = 0; j < 16; ++j) Fl[tok * 257 + g * 64 + e0 + j] = acc[j];
        }
        __syncthreads();
#pragma unroll
        for (int tt = 0; tt < 4; ++tt) {
            const int tok = wave * 4 + tt; const size_t t = (size_t)(t0 + tok);
            {
                const u32x4 v = *(const u32x4*)(att + t * 512 + lane * 8);
                float x[8] = {bflo(v.x), bfhi(v.x), bflo(v.y), bfhi(v.y), bflo(v.z), bfhi(v.z), bflo(v.w), bfhi(v.w)};
                float ss = 0.f;
#pragma unroll
                for (int j = 0; j < 8; ++j) ss += x[j] * x[j];
                ss = wave_sum(ss);
                const float r = rsqrtf(ss * (1.0f / 512.0f) + EPS);
                const f32x4 g0 = *(const f32x4*)(mg + lane * 8), g1 = *(const f32x4*)(mg + lane * 8 + 4);
                u32x4 o; o.x = pk2(x[0] * r * g0.x, x[1] * r * g0.y); o.y = pk2(x[2] * r * g0.z, x[3] * r * g0.w); o.z = pk2(x[4] * r * g1.x, x[5] * r * g1.y); o.w = pk2(x[6] * r * g1.z, x[7] * r * g1.w);
                *(u32x4*)(mix + t * 1024 + lane * 8) = o;
            }
            {
                float y[4], f[4]; float sy = 0.f, sf = 0.f;
#pragma unroll
                for (int i = 0; i < 4; ++i) { y[i] = Yl[(lane + 64 * i) * 33 + tok]; f[i] = Fl[tok * 257 + lane + 64 * i]; sy += y[i] * y[i]; sf += f[i] * f[i]; }
                sy = wave_sum(sy); sf = wave_sum(sf);
                const float ry = rsqrtf(sy * (1.0f / 256.0f) + EPS), rf = rsqrtf(sf * (1.0f / 256.0f) + EPS);
#pragma unroll
                for (int i = 0; i < 4; ++i) {
                    mix[t * 1024 + 512 + lane + 64 * i] = (bf16_t)f2bf(y[i] * ry * mg[512 + lane + 64 * i]);
                    mix[t * 1024 + 768 + lane + 64 * i] = (bf16_t)f2bf(f[i] * rf * mg[768 + lane + 64 * i]);
                }
            }
        }
    }
}

__device__ __forceinline__ void phase_peer_topk(const Params& p, int layer, char* lds, int* IDX, float* GATE) {
    const int tid = threadIdx.x, lane = tid & 63, wave = tid >> 6;
    float* Kl = (float*)lds;
    float* Qw = Kl + 2 * 128 * 132 + wave * 256;
    const float* QP = (const float*)(p.ws + R_QP);
    const float NINF = -3.0e38f;
    for (int u = blockIdx.x; u < 8 * 128; u += gridDim.x) {
        const int h = u >> 7, tc = u & 127;
        __syncthreads();
#pragma unroll
        for (int pp = 0; pp < 2; ++pp) {
            const f32x4* src = (const f32x4*)(p.in[I_SK] + (((size_t)(layer * 2 + pp) * 8 + h) * 128) * 128);
#pragma unroll
            for (int i = 0; i < 8; ++i) { const int id = tid + NTHR * i, key = id >> 5, d4 = id & 31; *(f32x4*)(Kl + (pp * 128 + key) * 132 + d4 * 4) = src[id]; }
        }
        __syncthreads();
        for (int tt = 0; tt < 16; ++tt) {
            const int t = tc * 128 + wave * 16 + tt;
            *(f32x4*)(Qw + lane * 4) = *(const f32x4*)(QP + (size_t)t * 2048 + h * 256 + lane * 4);
            float s00 = 0.f, s01 = 0.f, s10 = 0.f, s11 = 0.f;
#pragma unroll 8
            for (int d4 = 0; d4 < 32; ++d4) {
                const f32x4 q0 = *(const f32x4*)(Qw + d4 * 4), q1 = *(const f32x4*)(Qw + 128 + d4 * 4);
                const f32x4 k00 = *(const f32x4*)(Kl + lane * 132 + d4 * 4), k01 = *(const f32x4*)(Kl + (64 + lane) * 132 + d4 * 4);
                const f32x4 k10 = *(const f32x4*)(Kl + (128 + lane) * 132 + d4 * 4), k11 = *(const f32x4*)(Kl + (192 + lane) * 132 + d4 * 4);
                s00 += q0.x * k00.x + q0.y * k00.y + q0.z * k00.z + q0.w * k00.w;
                s01 += q0.x * k01.x + q0.y * k01.y + q0.z * k01.z + q0.w * k01.w;
                s10 += q1.x * k10.x + q1.y * k10.y + q1.z * k10.z + q1.w * k10.w;
                s11 += q1.x * k11.x + q1.y * k11.y + q1.z * k11.z + q1.w * k11.w;
            }
            float tv0 = 0.f, tv1 = 0.f; int ti0 = 0, ti1 = 0;
            for (int r = 0; r < 16; ++r) {
                {
                    const float mmax = wave_max(fmaxf(s00, s01));
                    const unsigned long long b0 = __ballot(s00 == mmax), b1 = __ballot(s01 == mmax);
                    int src, idx;
                    if (b0) { src = __ffsll((long long)b0) - 1; idx = src; if (lane == src) s00 = NINF; }
                    else { src = __ffsll((long long)b1) - 1; idx = src + 64; if (lane == src) s01 = NINF; }
                    if (lane == r) { tv0 = mmax; ti0 = idx; }
                }
                {
                    const float mmax = wave_max(fmaxf(s10, s11));
                    const unsigned long long b0 = __ballot(s10 == mmax), b1 = __ballot(s11 == mmax);
                    int src, idx;
                    if (b0) { src = __ffsll((long long)b0) - 1; idx = src; if (lane == src) s10 = NINF; }
                    else { src = __ffsll((long long)b1) - 1; idx = src + 64; if (lane == src) s11 = NINF; }
                    if (lane == r) { tv1 = mmax; ti1 = idx; }
                }
            }
            float cd[4];
            {
                const float a = __shfl(tv0, lane >> 2);
#pragma unroll
                for (int mm = 0; mm < 4; ++mm) cd[mm] = a + __shfl(tv1, (lane & 3) * 4 + mm);
            }
            float bv = 0.f; int bi = 0;
            for (int r = 0; r < 16; ++r) {
                const float mmax = wave_max(fmaxf(fmaxf(cd[0], cd[1]), fmaxf(cd[2], cd[3])));
                const unsigned long long b0 = __ballot(cd[0] == mmax), b1 = __ballot(cd[1] == mmax), b2 = __ballot(cd[2] == mmax), b3 = __ballot(cd[3] == mmax);
                const int src = __ffsll((long long)(b0 | b1 | b2 | b3)) - 1;
                const int msel = ((b0 >> src) & 1ull) ? 0 : (((b1 >> src) & 1ull) ? 1 : (((b2 >> src) & 1ull) ? 2 : 3));
                if (lane == src) {
                    if (msel == 0) cd[0] = NINF; else if (msel == 1) cd[1] = NINF; else if (msel == 2) cd[2] = NINF; else cd[3] = NINF;
                }
                const int pos = src * 4 + msel;
                const int e = __shfl(ti0, pos >> 4) * 128 + __shfl(ti1, pos & 15);
                if (lane == r) { bv = mmax; bi = e; }
            }
            const float top = __shfl(bv, 0);
            const float ex = (lane < 16) ? expf(bv - top) : 0.f;
            const float den = wave_sum(ex);
            if (lane < 16) { IDX[(size_t)t * 128 + h * 16 + lane] = bi; GATE[(size_t)t * 128 + h * 16 + lane] = ex / den; }
        }
    }
}

__device__ __forceinline__ float gelu_exact(float x) { return 0.5f * x * (1.0f + erff(x * 0.70710678118654752f)); }
__device__ __forceinline__ void phase_peer_gather(const Params& p, int layer, const int* IDX, const float* GATE) {
    const int lane = threadIdx.x & 63, wave = threadIdx.x >> 6;
    const int gw = blockIdx.x * NWAVE + wave, ngw = gridDim.x * NWAVE;
    const bf16_t* PU = (const bf16_t*)(p.ws + OFF_PU) + (size_t)layer * 16384 * 1024;
    const bf16_t* PV = (const bf16_t*)(p.ws + OFF_PV) + (size_t)layer * 16384 * 1024;
    const bf16_t* XN = (const bf16_t*)(p.ws + R_XN);
    float* XA = (float*)(p.ws + OFF_XA);
    for (int t = gw; t < T; t += ngw) {
        float xv[16];
        {
            const u32x4 a = *(const u32x4*)(XN + (size_t)t * DM + lane * 8), b = *(const u32x4*)(XN + (size_t)t * DM + 512 + lane * 8);
            xv[0] = bflo(a.x); xv[1] = bfhi(a.x); xv[2] = bflo(a.y); xv[3] = bfhi(a.y); xv[4] = bflo(a.z); xv[5] = bfhi(a.z); xv[6] = bflo(a.w); xv[7] = bfhi(a.w);
            xv[8] = bflo(b.x); xv[9] = bfhi(b.x); xv[10] = bflo(b.y); xv[11] = bfhi(b.y); xv[12] = bflo(b.z); xv[13] = bfhi(b.z); xv[14] = bflo(b.w); xv[15] = bfhi(b.w);
        }
        float acc[16];
#pragma unroll
        for (int j = 0; j < 16; ++j) acc[j] = 0.f;
        for (int half = 0; half < 2; ++half) {
            const int myi = IDX[(size_t)t * 128 + half * 64 + lane];
            const float myg = GATE[(size_t)t * 128 + half * 64 + lane];
            for (int e0 = 0; e0 < 64; e0 += 4) {
                int ei[4]; float eg[4];
#pragma unroll
                for (int k = 0; k < 4; ++k) { ei[k] = __shfl(myi, e0 + k); eg[k] = __shfl(myg, e0 + k); }
                u32x4 ua[4], ub[4];
#pragma unroll
                for (int k = 0; k < 4; ++k) { const bf16_t* r = PU + (size_t)ei[k] * DM + lane * 8; ua[k] = *(const u32x4*)r; ub[k] = *(const u32x4*)(r + 512); }
                u32x4 va[4], vb[4];
#pragma unroll
                for (int k = 0; k < 4; ++k) { const bf16_t* r = PV + (size_t)ei[k] * DM + lane * 8; va[k] = *(const u32x4*)r; vb[k] = *(const u32x4*)(r + 512); }
                float ds[4];
#pragma unroll
                for (int k = 0; k < 4; ++k) {
                    float d = bflo(ua[k].x) * xv[0] + bfhi(ua[k].x) * xv[1] + bflo(ua[k].y) * xv[2] + bfhi(ua[k].y) * xv[3]
                            + bflo(ua[k].z) * xv[4] + bfhi(ua[k].z) * xv[5] + bflo(ua[k].w) * xv[6] + bfhi(ua[k].w) * xv[7]
                            + bflo(ub[k].x) * xv[8] + bfhi(ub[k].x) * xv[9] + bflo(ub[k].y) * xv[10] + bfhi(ub[k].y) * xv[11]
                            + bflo(ub[k].z) * xv[12] + bfhi(ub[k].z) * xv[13] + bflo(ub[k].w) * xv[14] + bfhi(ub[k].w) * xv[15];
                    ds[k] = wave_sum(d);
                }
#pragma unroll
                for (int k = 0; k < 4; ++k) {
                    const float a = gelu_exact(ds[k]) * eg[k];
                    acc[0] += a * bflo(va[k].x); acc[1] += a * bfhi(va[k].x); acc[2] += a * bflo(va[k].y); acc[3] += a * bfhi(va[k].y);
                    acc[4] += a * bflo(va[k].z); acc[5] += a * bfhi(va[k].z); acc[6] += a * bflo(va[k].w); acc[7] += a * bfhi(va[k].w);
                    acc[8] += a * bflo(vb[k].x); acc[9] += a * bfhi(vb[k].x); acc[10] += a * bflo(vb[k].y); acc[11] += a * bfhi(vb[k].y);
                    acc[12] += a * bflo(vb[k].z); acc[13] += a * bfhi(vb[k].z); acc[14] += a * bflo(vb[k].w); acc[15] += a * bfhi(vb[k].w);
                }
            }
        }
        f32x4* xr = (f32x4*)(XA + (size_t)t * DM + lane * 8);
        f32x4 x0 = xr[0], x1 = xr[1], x2 = xr[128], x3 = xr[129];
        x0.x += acc[0]; x0.y += acc[1]; x0.z += acc[2]; x0.w += acc[3]; x1.x += acc[4]; x1.y += acc[5]; x1.z += acc[6]; x1.w += acc[7];
        x2.x += acc[8]; x2.y += acc[9]; x2.z += acc[10]; x2.w += acc[11]; x3.x += acc[12]; x3.y += acc[13]; x3.z += acc[14]; x3.w += acc[15];
        xr[0] = x0; xr[1] = x1; xr[128] = x2; xr[129] = x3;
    }
}

constexpr int NPHASE_PRE = 2;
constexpr int NPHASE_LAYER = 10;
constexpr int NPHASE = NPHASE_PRE + NLAYER * NPHASE_LAYER + 1;

__device__ __forceinline__ void run_phase(const Params& p, int ph, char* lds) {
    float* XA = (float*)(p.ws + OFF_XA);
    int* IDX = (int*)p.out; float* GATE = p.out + (size_t)T * 128;
    if (ph == 0) { phase_p0(p, lds); return; }
    if (ph == 1) { phase_filter_spectra(p, lds); return; }
    if (ph == NPHASE - 1) { phase_final_norm(XA, p.in[I_FG], p.out); return; }
    const int layer = (ph - NPHASE_PRE) / NPHASE_LAYER, s = (ph - NPHASE_PRE) % NPHASE_LAYER;
    const float* xin = layer == 0 ? p.in[I_X] : XA;
    switch (s) {
    case 0: phase_rmsnorm_bf16(xin, p.in[I_N1G] + layer * DM, (bf16_t*)(p.ws + R_XN)); break;
    case 1: { EpiIn e{(bf16_t*)(p.ws + R_QKV), (float*)(p.ws + R_HF)};
              gemm_phase(( const bf16_t*)(p.ws + R_XN), (const bf16_t*)(p.ws + OFF_WTIN) + (size_t)layer * INC * DM, T, INC, DM, lds, e); } break;
    case 2: phase_qkprep(p, layer, lds); break;
    case 3: {
        for (int u = blockIdx.x; u < 512; u += gridDim.x) { const int b = u >> 8, g = (u >> 7) & 1, qb = u & 127; attn_unit(p, b, g, qb, lds); }
        for (int c = blockIdx.x; c < 256; c += gridDim.x) hyena_job(p, layer, c, lds);
        for (int c = blockIdx.x; c < 256; c += gridDim.x) fnet_job(p, c, lds);
    } break;
    case 4: phase_mix(p, layer, lds); break;
    case 5: { EpiRes e{xin, XA};
              gemm_phase((const bf16_t*)(p.ws + R_MIX), (const bf16_t*)(p.ws + OFF_WTOUT) + (size_t)layer * DM * DM, T, DM, DM, lds, e); } break;
    case 6: phase_rmsnorm_bf16(XA, p.in[I_N2G] + layer * DM, (bf16_t*)(p.ws + R_XN)); break;
    case 7: { EpiF32 e{(float*)(p.ws + R_QP), 2048};
              gemm_phase((const bf16_t*)(p.ws + R_XN), (const bf16_t*)(p.ws + OFF_WTQ) + (size_t)layer * 2048 * DM, T, 2048, DM, lds, e); } break;
    case 8: phase_peer_topk(p, layer, lds, IDX, GATE); break;
    case 9: phase_peer_gather(p, layer, IDX, GATE); break;
    }
}

#if ONE_LAUNCH
__global__ void __launch_bounds__(NTHR) mega_kernel(Params p) {
    extern __shared__ __attribute__((aligned(16))) char lds[];
    cg::grid_group grid = cg::this_grid();
    for (int ph = 0; ph < NPHASE; ++ph) {
        run_phase(p, ph, lds);
        if (ph + 1 < NPHASE) grid.sync();
    }
}
#else
__global__ void __launch_bounds__(NTHR) phase_kernel(Params p, int ph) {
    extern __shared__ __attribute__((aligned(16))) char lds[];
    run_phase(p, ph, lds);
}
#endif

extern "C" void kernel_launch(void* const* d_in, const int* in_sizes, int n_in, void* d_out, int out_size, void* d_ws, size_t ws_size, hipStream_t stream) {
    static int grid = 0;
    if (grid == 0) {
        if (n_in != 25 || out_size != T * DM || ws_size < WS_NEED) { fprintf(stderr, "kernel_launch: unexpected sizes n_in %d out %d ws %zu (need %zu)\n", n_in, out_size, ws_size, (size_t)WS_NEED); grid = -1; return; }
        int dev = 0, cus = 0;
        hipGetDevice(&dev);
        hipDeviceGetAttribute(&cus, hipDeviceAttributeMultiprocessorCount, dev);
#if ONE_LAUNCH
        hipFuncSetAttribute((const void*)mega_kernel, hipFuncAttributeMaxDynamicSharedMemorySize, LDS_BYTES);
        int per_cu = 0;
        hipOccupancyMaxActiveBlocksPerMultiprocessor(&per_cu, (const void*)mega_kernel, NTHR, LDS_BYTES);
        if (per_cu < 1) { fprintf(stderr, "kernel_launch: occupancy query says %d blocks per CU\n", per_cu); }
        grid = cus;
#else
        hipFuncSetAttribute((const void*)phase_kernel, hipFuncAttributeMaxDynamicSharedMemorySize, LDS_BYTES);
        grid = cus;
#endif
        (void)hipGetLastError();
    }
    if (grid < 0) return;
    Params p{};
    for (int i = 0; i < 25; ++i) p.in[i] = (const float*)d_in[i];
    p.out = (float*)d_out; p.ws = (unsigned char*)d_ws;
#if ONE_LAUNCH
    void* args[] = {&p};
    hipError_t e = hipLaunchCooperativeKernel((const void*)mega_kernel, dim3(grid), dim3(NTHR), args, LDS_BYTES, stream);
    if (e != hipSuccess) fprintf(stderr, "cooperative launch failed: %s (grid %d)\n", hipGetErrorString(e), grid);
#else
    for (int ph = 0; ph < NPHASE; ++ph) hipLaunchKernelGGL(phase_kernel, dim3(grid), dim3(NTHR), LDS_BYTES, stream, p, ph);
#endif
}
```

```cpp
#include <hip/hip_runtime.h>
#include <hip/hip_cooperative_groups.h>
#include <cstdio>
#include <cstdint>
namespace cg = cooperative_groups;

#ifndef ONE_LAUNCH
#define ONE_LAUNCH 1
#endif

typedef unsigned short bf16_t;
typedef short bf16x8 __attribute__((ext_vector_type(8)));
typedef float f32x16 __attribute__((ext_vector_type(16)));
typedef float f32x4 __attribute__((ext_vector_type(4)));
typedef unsigned u32x4 __attribute__((ext_vector_type(4)));
typedef unsigned u32x2 __attribute__((ext_vector_type(2)));

constexpr int DM = 1024, NB = 2, SL = 8192, T = NB * SL, NLAYER = 2;
constexpr int INC = 1792;
constexpr int NTHR = 512, NWAVE = 8;
constexpr int LDS_BYTES = 147456;
constexpr float EPS = 1e-6f;

constexpr size_t MiB = 1u << 20;
constexpr size_t OFF_CTL = 0;
constexpr size_t OFF_WTIN = 1 * MiB;
constexpr size_t OFF_WTOUT = 8 * MiB;
constexpr size_t OFF_WTQ = 12 * MiB;
constexpr size_t OFF_PU = 20 * MiB;
constexpr size_t OFF_PV = 84 * MiB;
constexpr size_t OFF_H2 = 148 * MiB;
constexpr size_t OFF_FM = 152 * MiB;
constexpr size_t OFF_KF = 153 * MiB;
constexpr size_t OFF_XA = 281 * MiB;
constexpr size_t OFF_R = 345 * MiB;
constexpr size_t R_XN = OFF_R + 0 * MiB;
constexpr size_t R_UR = OFF_R + 0 * MiB;
constexpr size_t R_UI = OFF_R + 16 * MiB;
constexpr size_t R_QKV = OFF_R + 32 * MiB;
constexpr size_t R_VT = OFF_R + 56 * MiB;
constexpr size_t R_HF = OFF_R + 60 * MiB;
constexpr size_t R_MIX = OFF_R + 60 * MiB;
constexpr size_t R_ATT = OFF_R + 124 * MiB;
constexpr size_t R_Y = OFF_R + 140 * MiB;
constexpr size_t R_QP = OFF_R + 32 * MiB;
constexpr size_t WS_NEED = 505 * MiB;

struct Params {
    const float* in[25];
    float* out;
    unsigned char* ws;
};
enum { I_X = 0, I_N1G, I_WIN, I_QG, I_KG, I_CW, I_CB, I_W1, I_B1, I_F1, I_W2, I_B2, I_F2, I_W3, I_HB, I_FW, I_FB, I_MG, I_WOUT, I_N2G, I_WQ, I_SK, I_PU, I_PV, I_FG };

__device__ __forceinline__ unsigned f2bf(float f) { unsigned u = __builtin_bit_cast(unsigned, f); return (u + 0x7fffu + ((u >> 16) & 1u)) >> 16; }
__device__ __forceinline__ unsigned pk2(float lo, float hi) { return f2bf(lo) | (f2bf(hi) << 16); }
__device__ __forceinline__ float bf2f(unsigned b) { return __builtin_bit_cast(float, b << 16); }
__device__ __forceinline__ float bflo(unsigned w) { return __builtin_bit_cast(float, w << 16); }
__device__ __forceinline__ float bfhi(unsigned w) { return __builtin_bit_cast(float, w & 0xffff0000u); }
__device__ __forceinline__ float wave_sum(float v) {
#pragma unroll
    for (int o = 1; o < 64; o <<= 1) v += __shfl_xor(v, o);
    return v;
}
__device__ __forceinline__ float wave_max(float v) {
#pragma unroll
    for (int o = 1; o < 64; o <<= 1) v = fmaxf(v, __shfl_xor(v, o));
    return v;
}
__device__ __forceinline__ f32x16 mfma32(bf16x8 a, bf16x8 b, f32x16 c) { return __builtin_amdgcn_mfma_f32_32x32x16_bf16(a, b, c, 0, 0, 0); }
__device__ __forceinline__ f32x16 zero16() { return (f32x16){0.f,0.f,0.f,0.f,0.f,0.f,0.f,0.f,0.f,0.f,0.f,0.f,0.f,0.f,0.f,0.f}; }


__device__ __forceinline__ int otid() { int t = threadIdx.x; asm volatile("" : "+v"(t)); return t; }
__device__ __forceinline__ int obid() { int b = blockIdx.x; asm volatile("" : "+s"(b)); return b; }
__device__ __forceinline__ void transpose_one(const float* W, int K, int N, bf16_t* Wt, float* tile, int item) {
    const int tid = otid();
    const int nblk = N / 64, kb = item / nblk, nb = item % nblk, k0 = kb * 64, n0 = nb * 64;
    __syncthreads();
    {
        const int r = tid >> 6, c = tid & 63;
#pragma unroll
        for (int i = 0; i < 8; ++i) { const int k = r + 8 * i; tile[k * 65 + c] = W[(size_t)(k0 + k) * N + n0 + c]; }
    }
    __syncthreads();
    {
        const int nn = tid >> 3, kc = tid & 7;
        const float* s = tile + (kc * 8) * 65 + nn;
        u32x4 o; o.x = pk2(s[0], s[65]); o.y = pk2(s[2 * 65], s[3 * 65]); o.z = pk2(s[4 * 65], s[5 * 65]); o.w = pk2(s[6 * 65], s[7 * 65]);
        *(u32x4*)(Wt + (size_t)(n0 + nn) * K + k0 + kc * 8) = o;
    }
}

__device__ __forceinline__ void phase_p0(const Params& p, char* lds) {
    const int tid = otid();
    float* tile = (float*)lds;
    constexpr int IT_IN = (DM / 64) * (INC / 64), IT_OUT = (DM / 64) * (DM / 64), IT_Q = (DM / 64) * (2048 / 64);
    constexpr int IT_L = IT_IN + IT_OUT + IT_Q;
    for (int it = obid(); it < NLAYER * IT_L; it += gridDim.x) {
        const int layer = it / IT_L; int r = it % IT_L;
        if (r < IT_IN) { transpose_one(p.in[I_WIN] + (size_t)layer * DM * INC, DM, INC, (bf16_t*)(p.ws + OFF_WTIN) + (size_t)layer * INC * DM, tile, r); continue; }
        r -= IT_IN;
        if (r < IT_OUT) { transpose_one(p.in[I_WOUT] + (size_t)layer * DM * DM, DM, DM, (bf16_t*)(p.ws + OFF_WTOUT) + (size_t)layer * DM * DM, tile, r); continue; }
        r -= IT_OUT;
        transpose_one(p.in[I_WQ] + (size_t)layer * DM * 2048, DM, 2048, (bf16_t*)(p.ws + OFF_WTQ) + (size_t)layer * 2048 * DM, tile, r);
    }
    __syncthreads();
    {
        const size_t n4 = (size_t)NLAYER * 16384 * 1024 / 4;
        const size_t gstride = (size_t)gridDim.x * NTHR;
        for (int tb = 0; tb < 2; ++tb) {
            const f32x4* src = (const f32x4*)p.in[tb ? I_PV : I_PU];
            u32x2* dst = (u32x2*)(p.ws + (tb ? OFF_PV : OFF_PU));
            for (size_t i = (size_t)obid() * NTHR + tid; i < n4; i += gstride) {
                const f32x4 v = src[i]; u32x2 o; o.x = pk2(v.x, v.y); o.y = pk2(v.z, v.w); dst[i] = o;
            }
        }
    }
    {
        float* sh = (float*)lds;
        float* zl = sh + 8 * 64;
        const int sub = tid >> 6, j = tid & 63;
        for (int it = obid(); it < NLAYER * SL / 8; it += gridDim.x) {
            const int layer = it / (SL / 8), l = (it % (SL / 8)) * 8 + sub;
            const float t = (float)l / (float)(SL - 1);
            __syncthreads();
            if (j < 17) {
                float z;
                if (j == 0) z = t;
                else if (j <= 8) z = sinf(2.0f * 3.14159265358979323846f * t * (float)j);
                else z = cosf(2.0f * 3.14159265358979323846f * t * (float)(j - 8));
                zl[sub * 17 + j] = z;
            }
            __syncthreads();
            const float* w1 = p.in[I_W1] + layer * 17 * 64;
            float a = p.in[I_B1][layer * 64 + j];
#pragma unroll
            for (int i = 0; i < 17; ++i) a += zl[sub * 17 + i] * w1[i * 64 + j];
            sh[sub * 64 + j] = sinf(p.in[I_F1][layer * 64 + j] * a);
            __syncthreads();
            const float* w2 = p.in[I_W2] + layer * 64 * 64;
            float b = p.in[I_B2][layer * 64 + j];
#pragma unroll 8
            for (int k = 0; k < 64; ++k) b += sh[sub * 64 + k] * w2[k * 64 + j];
            ((float*)(p.ws + OFF_H2))[((size_t)layer * SL + l) * 64 + j] = sinf(p.in[I_F2][layer * 64 + j] * b);
        }
    }
    {
        const int total = NLAYER * 4 * 128 * 64;
        for (int o = obid() * NTHR + tid; o < total; o += gridDim.x * NTHR) {
            const int e2 = o & 63, dd = (o >> 6) & 127, g = (o >> 13) & 3, layer = o >> 15;
            const int d = dd & 63;
            const float* w = p.in[I_FW] + ((size_t)(layer * 4 + g) * 64) * 64;
            float acc = 0.f;
            for (int e = 0; e < 64; ++e) {
                const int m = (d * e) & 63;
                const float ang = (float)m * (2.0f * 3.14159265358979323846f / 64.0f);
                const float tw = (dd < 64) ? cosf(ang) : sinf(ang);
                acc += tw * w[e * 64 + e2];
            }
            ((float*)(p.ws + OFF_FM))[o] = acc * (1.0f / 724.0773439350246f);
        }
    }
}

template <bool PAD> __device__ __forceinline__ int zi(int i) { return PAD ? i + (i >> 8) : i; }

template <int LOGN, bool PAD>
__device__ __forceinline__ void fft_fwd(float2* Z) {
    constexpr int N = 1 << LOGN;
    const int tid = otid();
    int s = 0;
    for (; s + 1 < LOGN; s += 2) {
        const int lh2 = LOGN - s - 2;
        const int h2 = 1 << lh2, h = h2 << 1;
        const float rs = 1.0f / (float)(h << 1);
        for (int q = tid; q < N / 4; q += NTHR) {
            const int j = q & (h2 - 1), blk = q >> lh2;
            const int base = (blk << (lh2 + 2)) + j;
            float2 x0 = Z[zi<PAD>(base)], x1 = Z[zi<PAD>(base + h2)], x2 = Z[zi<PAD>(base + h)], x3 = Z[zi<PAD>(base + h + h2)];
            const float ang = (float)j * rs;
            const float c = __builtin_amdgcn_cosf(ang), sn = __builtin_amdgcn_sinf(ang);
            float2 a0 = make_float2(x0.x + x2.x, x0.y + x2.y);
            float2 d02 = make_float2(x0.x - x2.x, x0.y - x2.y);
            float2 a2 = make_float2(d02.x * c + d02.y * sn, d02.y * c - d02.x * sn);
            float2 a1 = make_float2(x1.x + x3.x, x1.y + x3.y);
            float2 d13 = make_float2(x1.x - x3.x, x1.y - x3.y);
            float2 t3 = make_float2(d13.x * c + d13.y * sn, d13.y * c - d13.x * sn);
            float2 a3 = make_float2(t3.y, -t3.x);
            const float c2 = c * c - sn * sn, s2 = 2.f * c * sn;
            float2 y0 = make_float2(a0.x + a1.x, a0.y + a1.y);
            float2 e01 = make_float2(a0.x - a1.x, a0.y - a1.y);
            float2 y1 = make_float2(e01.x * c2 + e01.y * s2, e01.y * c2 - e01.x * s2);
            float2 y2 = make_float2(a2.x + a3.x, a2.y + a3.y);
            float2 e23 = make_float2(a2.x - a3.x, a2.y - a3.y);
            float2 y3 = make_float2(e23.x * c2 + e23.y * s2, e23.y * c2 - e23.x * s2);
            Z[zi<PAD>(base)] = y0; Z[zi<PAD>(base + h2)] = y1; Z[zi<PAD>(base + h)] = y2; Z[zi<PAD>(base + h + h2)] = y3;
        }
        __syncthreads();
    }
    if (s < LOGN) {
        for (int q = tid; q < N / 2; q += NTHR) {
            const int i0 = 2 * q;
            float2 a = Z[zi<PAD>(i0)], b = Z[zi<PAD>(i0 + 1)];
            Z[zi<PAD>(i0)] = make_float2(a.x + b.x, a.y + b.y);
            Z[zi<PAD>(i0 + 1)] = make_float2(a.x - b.x, a.y - b.y);
        }
        __syncthreads();
    }
}

template <int LOGN, bool PAD>
__device__ __forceinline__ void fft_inv(float2* Z) {
    constexpr int N = 1 << LOGN;
    const int tid = otid();
    for (int s = LOGN - 2; s >= 0; s -= 2) {
        const int lh2 = LOGN - s - 2;
        const int h2 = 1 << lh2, h = h2 << 1;
        const float rs = 1.0f / (float)(h << 1);
        for (int q = tid; q < N / 4; q += NTHR) {
            const int j = q & (h2 - 1), blk = q >> lh2;
            const int base = (blk << (lh2 + 2)) + j;
            float2 y0 = Z[zi<PAD>(base)], y1 = Z[zi<PAD>(base + h2)], y2 = Z[zi<PAD>(base + h)], y3 = Z[zi<PAD>(base + h + h2)];
            const float ang = (float)j * rs;
            const float c = __builtin_amdgcn_cosf(ang), sn = __builtin_amdgcn_sinf(ang);
            const float c2 = c * c - sn * sn, s2 = 2.f * c * sn;
            float2 t1 = make_float2(y1.x * c2 - y1.y * s2, y1.y * c2 + y1.x * s2);
            float2 t3 = make_float2(y3.x * c2 - y3.y * s2, y3.y * c2 + y3.x * s2);
            float2 a0 = make_float2(y0.x + t1.x, y0.y + t1.y), a1 = make_float2(y0.x - t1.x, y0.y - t1.y);
            float2 a2 = make_float2(y2.x + t3.x, y2.y + t3.y), a3 = make_float2(y2.x - t3.x, y2.y - t3.y);
            float2 u2 = make_float2(a2.x * c - a2.y * sn, a2.y * c + a2.x * sn);
            float2 u3 = make_float2(a3.x * c - a3.y * sn, a3.y * c + a3.x * sn);
            float2 v3 = make_float2(-u3.y, u3.x);
            Z[zi<PAD>(base)] = make_float2(a0.x + u2.x, a0.y + u2.y);
            Z[zi<PAD>(base + h)] = make_float2(a0.x - u2.x, a0.y - u2.y);
            Z[zi<PAD>(base + h2)] = make_float2(a1.x + v3.x, a1.y + v3.y);
            Z[zi<PAD>(base + h + h2)] = make_float2(a1.x - v3.x, a1.y - v3.y);
        }
        __syncthreads();
    }
}

__device__ __forceinline__ void phase_filter_spectra(const Params& p, char* lds) {
    const int tid = otid(), lane = tid & 63, wave = tid >> 6;
    float2* Z = (float2*)lds;
    float* w3l = (float*)(lds + 131072);
    float* red = w3l + 256;
    for (int job = obid(); job < NLAYER * 256; job += gridDim.x) {
        const int layer = job >> 8, c = job & 255;
        __syncthreads();
        if (tid < 256) { const int k = tid >> 2, q = tid & 3; w3l[tid] = p.in[I_W3][((size_t)layer * 64 + k) * 1024 + q * 256 + c]; }
        __syncthreads();
        const float* H2 = (const float*)(p.ws + OFF_H2) + (size_t)layer * SL * 64;
        const float r_lo = 4.605170185988092f / 1.5f, r_hi = 4.605170185988092f / 0.3f;
        const float rate = r_lo + (r_hi - r_lo) * ((float)c / 255.0f);
        float ss0 = 0.f, ss1 = 0.f;
        for (int i = 0; i < 16; ++i) {
            const int l = tid + NTHR * i;
            const f32x4* hr = (const f32x4*)(H2 + (size_t)l * 64);
            float a0 = 0.f, a1 = 0.f, a2 = 0.f, a3 = 0.f;
#pragma unroll
            for (int k4 = 0; k4 < 16; ++k4) {
                const f32x4 hv = hr[k4];
#pragma unroll
                for (int e = 0; e < 4; ++e) {
                    const f32x4 w = *(const f32x4*)(w3l + (k4 * 4 + e) * 4);
                    const float hh = hv[e];
                    a0 += hh * w.x; a1 += hh * w.y; a2 += hh * w.z; a3 += hh * w.w;
                }
            }
            const float t = (float)l / (float)(SL - 1);
            const float dec = expf(-t * rate);
            a0 *= dec; a1 *= dec; a2 *= dec; a3 *= dec;
            ss0 += a0 * a0 + a1 * a1; ss1 += a2 * a2 + a3 * a3;
            Z[l] = make_float2(a0, a2);
            if (l >= 1) Z[16384 - l] = make_float2(a1, a3);
        }
        if (tid == 0) Z[8192] = make_float2(0.f, 0.f);
        ss0 = wave_sum(ss0); ss1 = wave_sum(ss1);
        if (lane == 0) { red[wave * 2] = ss0; red[wave * 2 + 1] = ss1; }
        __syncthreads();
        float t0 = 0.f, t1 = 0.f;
#pragma unroll
        for (int w = 0; w < 8; ++w) { t0 += red[w * 2]; t1 += red[w * 2 + 1]; }
        const float sc0 = rsqrtf(t0 + EPS) * (1.0f / 16384.0f) * 0.5f, sc1 = rsqrtf(t1 + EPS) * (1.0f / 16384.0f) * 0.5f;
        fft_fwd<14, false>(Z);
        float2* KF0 = (float2*)(p.ws + OFF_KF) + ((size_t)(layer * 256 + c) * 2) * 16384;
        float2* KF1 = KF0 + 16384;
        for (int i = 0; i < 32; ++i) {
            const int pp = tid + NTHR * i;
            const int f = (int)(__brev((unsigned)pp) >> 18);
            const int fm = (16384 - f) & 16383;
            const int pq = (int)(__brev((unsigned)fm) >> 18);
            const float2 zp = Z[pp], zq = Z[pq];
            KF0[pp] = make_float2((zp.x + zq.x) * sc0, (zp.y - zq.y) * sc0);
            KF1[pp] = make_float2((zp.y + zq.y) * sc1, (zq.x - zp.x) * sc1);
        }
    }
}

__device__ __forceinline__ void phase_rmsnorm_bf16(const float* x, const float* g, bf16_t* out) {
    const int lane = otid() & 63, wave = otid() >> 6;
    const int gw = obid() * NWAVE + wave, ngw = gridDim.x * NWAVE;
    for (int row = gw; row < T; row += ngw) {
        const f32x4* xr = (const f32x4*)(x + (size_t)row * DM) + lane;
        f32x4 v[4]; float ss = 0.f;
#pragma unroll
        for (int j = 0; j < 4; ++j) { v[j] = xr[64 * j]; ss += v[j].x * v[j].x + v[j].y * v[j].y + v[j].z * v[j].z + v[j].w * v[j].w; }
        ss = wave_sum(ss);
        const float r = rsqrtf(ss * (1.0f / DM) + EPS);
        u32x2* o = (u32x2*)(out + (size_t)row * DM) + lane;
#pragma unroll
        for (int j = 0; j < 4; ++j) {
            const f32x4 gg = ((const f32x4*)g)[lane + 64 * j];
            u32x2 w; w.x = pk2(v[j].x * r * gg.x, v[j].y * r * gg.y); w.y = pk2(v[j].z * r * gg.z, v[j].w * r * gg.w);
            o[64 * j] = w;
        }
    }
}
__device__ __forceinline__ void phase_final_norm(const float* x, const float* g, float* out) {
    const int lane = otid() & 63, wave = otid() >> 6;
    const int gw = obid() * NWAVE + wave, ngw = gridDim.x * NWAVE;
    for (int row = gw; row < T; row += ngw) {
        const f32x4* xr = (const f32x4*)(x + (size_t)row * DM) + lane;
        f32x4 v[4]; float ss = 0.f;
#pragma unroll
        for (int j = 0; j < 4; ++j) { v[j] = xr[64 * j]; ss += v[j].x * v[j].x + v[j].y * v[j].y + v[j].z * v[j].z + v[j].w * v[j].w; }
        ss = wave_sum(ss);
        const float r = rsqrtf(ss * (1.0f / DM) + EPS);
        f32x4* o = (f32x4*)(out + (size_t)row * DM) + lane;
#pragma unroll
        for (int j = 0; j < 4; ++j) { const f32x4 gg = ((const f32x4*)g)[lane + 64 * j]; o[64 * j] = v[j] * r * gg; }
    }
}

constexpr int G_LDA = 144;
template <class Epi>
__device__ __forceinline__ void gemm_phase(const bf16_t* A, const bf16_t* Bt, int M, int N, int K, char* lds, const Epi& epi) {
    const int tid = otid(), lane = tid & 63, wave = tid >> 6;
    const int wm = wave >> 1, wn = wave & 1;
    const int nMt = M / 256, nNt = N / 128, total = nMt * nNt, nk = K / 64;
    char* As = lds; char* Bs = lds + 256 * G_LDA;
    const int l31 = lane & 31, hl = lane >> 5;
    for (int u = obid(); u < total; u += gridDim.x) {
        const int mt = u % nMt, nt = u / nMt;
        f32x16 acc[2][2];
#pragma unroll
        for (int i = 0; i < 2; ++i)
#pragma unroll
            for (int j = 0; j < 2; ++j) acc[i][j] = zero16();
        u32x4 ra[4], rb[2];
        const bf16_t* Ab = A + (size_t)(mt * 256) * K;
        const bf16_t* Bb = Bt + (size_t)(nt * 128) * K;
#pragma unroll
        for (int i = 0; i < 4; ++i) { const int id = tid + NTHR * i, row = id >> 3, ch = id & 7; ra[i] = *(const u32x4*)(Ab + (size_t)row * K + ch * 8); }
#pragma unroll
        for (int i = 0; i < 2; ++i) { const int id = tid + NTHR * i, row = id >> 3, ch = id & 7; rb[i] = *(const u32x4*)(Bb + (size_t)row * K + ch * 8); }
        for (int kt = 0; kt < nk; ++kt) {
            __syncthreads();
#pragma unroll
            for (int i = 0; i < 4; ++i) { const int id = tid + NTHR * i, row = id >> 3, ch = id & 7; *(u32x4*)(As + row * G_LDA + ch * 16) = ra[i]; }
#pragma unroll
            for (int i = 0; i < 2; ++i) { const int id = tid + NTHR * i, row = id >> 3, ch = id & 7; *(u32x4*)(Bs + row * G_LDA + ch * 16) = rb[i]; }
            __syncthreads();
            if (kt + 1 < nk) {
                const int ko = (kt + 1) * 64;
#pragma unroll
                for (int i = 0; i < 4; ++i) { const int id = tid + NTHR * i, row = id >> 3, ch = id & 7; ra[i] = *(const u32x4*)(Ab + (size_t)row * K + ko + ch * 8); }
#pragma unroll
                for (int i = 0; i < 2; ++i) { const int id = tid + NTHR * i, row = id >> 3, ch = id & 7; rb[i] = *(const u32x4*)(Bb + (size_t)row * K + ko + ch * 8); }
            }
#pragma unroll
            for (int ks = 0; ks < 4; ++ks) {
                bf16x8 a[2], b[2];
#pragma unroll
                for (int i = 0; i < 2; ++i) a[i] = *(const bf16x8*)(As + (wm * 64 + i * 32 + l31) * G_LDA + ks * 32 + hl * 16);
#pragma unroll
                for (int j = 0; j < 2; ++j) b[j] = *(const bf16x8*)(Bs + (wn * 64 + j * 32 + l31) * G_LDA + ks * 32 + hl * 16);
#pragma unroll
                for (int i = 0; i < 2; ++i)
#pragma unroll
                    for (int j = 0; j < 2; ++j) acc[i][j] = mfma32(a[i], b[j], acc[i][j]);
            }
        }
#pragma unroll
        for (int i = 0; i < 2; ++i)
#pragma unroll
            for (int j = 0; j < 2; ++j) epi(acc[i][j], mt * 256 + wm * 64 + i * 32, nt * 128 + wn * 64 + j * 32, lane);
    }
}

struct EpiIn {
    bf16_t* qkv; float* hf;
    __device__ __forceinline__ void operator()(const f32x16& acc, int row0, int col0, int lane) const {
        const int c = col0 + (lane & 31), h = lane >> 5;
        if (col0 < 768) {
#pragma unroll
            for (int r = 0; r < 16; ++r) { const int row = row0 + (r & 3) + 8 * (r >> 2) + 4 * h; qkv[(size_t)row * 768 + c] = (bf16_t)f2bf(acc[r]); }
        } else {
            float* dst = hf + (size_t)(c - 768) * T;
#pragma unroll
            for (int i = 0; i < 4; ++i) { const int row = row0 + 8 * i + 4 * h; f32x4 v; v.x = acc[4 * i]; v.y = acc[4 * i + 1]; v.z = acc[4 * i + 2]; v.w = acc[4 * i + 3]; *(f32x4*)(dst + row) = v; }
        }
    }
};
struct EpiRes {
    const float* base; float* out;
    __device__ __forceinline__ void operator()(const f32x16& acc, int row0, int col0, int lane) const {
        const int c = col0 + (lane & 31), h = lane >> 5;
#pragma unroll
        for (int r = 0; r < 16; ++r) { const size_t o = (size_t)(row0 + (r & 3) + 8 * (r >> 2) + 4 * h) * DM + c; out[o] = base[o] + acc[r]; }
    }
};
struct EpiF32 {
    float* out; int ld;
    __device__ __forceinline__ void operator()(const f32x16& acc, int row0, int col0, int lane) const {
        const int c = col0 + (lane & 31), h = lane >> 5;
#pragma unroll
        for (int r = 0; r < 16; ++r) { out[(size_t)(row0 + (r & 3) + 8 * (r >> 2) + 4 * h) * ld + c] = acc[r]; }
    }
};

__device__ __forceinline__ void phase_qkprep(const Params& p, int layer, char* lds) {
    const int tid = otid(), lane = tid & 63, wave = tid >> 6;
    bf16_t* qkv = (bf16_t*)(p.ws + R_QKV);
    bf16_t* vt = (bf16_t*)(p.ws + R_VT);
    const float qgv = p.in[I_QG][layer * 64 + lane], kgv = p.in[I_KG][layer * 64 + lane];
    const int gw = obid() * NWAVE + wave, ngw = gridDim.x * NWAVE;
    const int ax = lane >> 5, fr = lane & 15; const bool second = (lane >> 4) & 1;
    const float inv = powf(10000.0f, -(float)fr / 16.0f);
    for (int t = gw; t < T; t += ngw) {
        const int l = t & (SL - 1);
        const float pos = ax ? (float)(l & 63) : (float)(l >> 6);
        const float ang = pos * inv;
        const float cs = cosf(ang), sn = sinf(ang);
        bf16_t* row = qkv + (size_t)t * 768;
#pragma unroll
        for (int slot = 0; slot < 10; ++slot) {
            const float x = bf2f(row[slot * 64 + lane]);
            const float ss = wave_sum(x * x);
            const float r = rsqrtf(ss * (1.0f / 64.0f) + EPS);
            const float y = x * r * (slot < 8 ? qgv : kgv);
            const float other = __shfl_xor(y, 16);
            float o = second ? (y * cs + other * sn) : (y * cs - other * sn);
            if (slot < 8) o *= 0.125f * 1.4426950408889634f;
            row[slot * 64 + lane] = (bf16_t)f2bf(o);
        }
    }
    bf16_t* tl = (bf16_t*)lds;
    for (int ch = obid(); ch < T / 64; ch += gridDim.x) {
        const int t0 = ch * 64, b = t0 >> 13, l0 = t0 & (SL - 1);
        __syncthreads();
#pragma unroll
        for (int i = 0; i < 2; ++i) {
            const int id = tid + NTHR * i, tok = id >> 4, c16 = id & 15;
            const u32x4 v = *(const u32x4*)(qkv + (size_t)(t0 + tok) * 768 + 640 + c16 * 8);
            *(u32x4*)(tl + tok * 136 + c16 * 8) = v;
        }
        __syncthreads();
        {
            const int col = tid >> 2, part = tid & 3;
            unsigned w[8];
#pragma unroll
            for (int j = 0; j < 8; ++j) { const unsigned lo = tl[(part * 16 + 2 * j) * 136 + col], hi = tl[(part * 16 + 2 * j + 1) * 136 + col]; w[j] = lo | (hi << 16); }
            bf16_t* dst = vt + ((size_t)(b * 128 + col)) * SL + l0 + part * 16;
            u32x4 o0, o1; o0.x = w[0]; o0.y = w[1]; o0.z = w[2]; o0.w = w[3]; o1.x = w[4]; o1.y = w[5]; o1.z = w[6]; o1.w = w[7];
            *(u32x4*)dst = o0; *(u32x4*)(dst + 8) = o1;
        }
    }
}

constexpr int A_LDK = 144, A_LDV = 136;
__device__ __forceinline__ void attn_unit(const Params& p, int b, int g, int qb, char* lds) {
    const int tid = otid(), lane = tid & 63, wave = tid >> 6;
    const int l31 = lane & 31, hl = lane >> 5;
    const bf16_t* qkv = (const bf16_t*)(p.ws + R_QKV);
    const bf16_t* vt = (const bf16_t*)(p.ws + R_VT);
    bf16_t* att = (bf16_t*)(p.ws + R_ATT);
    const int h = 4 * g + (wave & 3);
    const int q = qb * 64 + (wave >> 2) * 32 + l31;
    const bf16_t* Qp = qkv + (size_t)(b * SL + q) * 768 + h * 64;
    bf16x8 qf[4];
#pragma unroll
    for (int s = 0; s < 4; ++s) qf[s] = *(const bf16x8*)(Qp + 16 * s + 8 * hl);
    char* Ks = lds; char* Vs = lds + 64 * A_LDK;
    const int srow = tid >> 3, sch = tid & 7;
    const bf16_t* Kg = qkv + (size_t)(b * SL + srow) * 768 + 512 + g * 64 + sch * 8;
    const bf16_t* Vg = vt + ((size_t)((b * 2 + g) * 64 + srow)) * SL + sch * 8;
    f32x16 o0 = zero16(), o1 = zero16();
    float m = -1e30f, lsum = 0.f;
    u32x4 rk = *(const u32x4*)Kg, rv = *(const u32x4*)Vg;
    __syncthreads();
    for (int kt = 0; kt < SL / 64; ++kt) {
        __syncthreads();
        *(u32x4*)(Ks + srow * A_LDK + sch * 16) = rk;
        { u32x2 lo, hi; lo.x = rv.x; lo.y = rv.y; hi.x = rv.z; hi.y = rv.w; *(u32x2*)(Vs + srow * A_LDV + sch * 16) = lo; *(u32x2*)(Vs + srow * A_LDV + sch * 16 + 8) = hi; }
        __syncthreads();
        if (kt + 1 < SL / 64) { rk = *(const u32x4*)(Kg + (size_t)(kt + 1) * 64 * 768); rv = *(const u32x4*)(Vg + (kt + 1) * 64); }
        f32x16 p0 = zero16(), p1 = zero16();
#pragma unroll
        for (int s = 0; s < 4; ++s) {
            const bf16x8 k0 = *(const bf16x8*)(Ks + l31 * A_LDK + s * 32 + hl * 16);
            const bf16x8 k1 = *(const bf16x8*)(Ks + (32 + l31) * A_LDK + s * 32 + hl * 16);
            p0 = mfma32(k0, qf[s], p0); p1 = mfma32(k1, qf[s], p1);
        }
        float mx = fmaxf(p0[0], p1[0]);
#pragma unroll
        for (int r = 1; r < 16; ++r) mx = fmaxf(mx, fmaxf(p0[r], p1[r]));
        mx = fmaxf(mx, __shfl_xor(mx, 32));
        const float mn = fmaxf(m, mx);
        const float alpha = __builtin_amdgcn_exp2f(m - mn);
        m = mn;
        float rs = 0.f;
#pragma unroll
        for (int r = 0; r < 16; ++r) { p0[r] = __builtin_amdgcn_exp2f(p0[r] - mn); p1[r] = __builtin_amdgcn_exp2f(p1[r] - mn); rs += p0[r] + p1[r]; }
        lsum = lsum * alpha + rs;
#pragma unroll
        for (int r = 0; r < 16; ++r) { o0[r] *= alpha; o1[r] *= alpha; }
#pragma unroll
        for (int kb = 0; kb < 2; ++kb)
#pragma unroll
            for (int s = 0; s < 2; ++s) {
                u32x4 pw;
                if (kb == 0) { pw.x = pk2(p0[8 * s], p0[8 * s + 1]); pw.y = pk2(p0[8 * s + 2], p0[8 * s + 3]); pw.z = pk2(p0[8 * s + 4], p0[8 * s + 5]); pw.w = pk2(p0[8 * s + 6], p0[8 * s + 7]); }
                else { pw.x = pk2(p1[8 * s], p1[8 * s + 1]); pw.y = pk2(p1[8 * s + 2], p1[8 * s + 3]); pw.z = pk2(p1[8 * s + 4], p1[8 * s + 5]); pw.w = pk2(p1[8 * s + 6], p1[8 * s + 7]); }
                const bf16x8 pf = __builtin_bit_cast(bf16x8, pw);
                const int kofs = (kb * 32 + s * 16 + 4 * hl) * 2;
#pragma unroll
                for (int dt = 0; dt < 2; ++dt) {
                    const char* vp = Vs + (dt * 32 + l31) * A_LDV + kofs;
                    const u32x2 v0 = *(const u32x2*)vp, v1 = *(const u32x2*)(vp + 16);
                    u32x4 vw; vw.x = v0.x; vw.y = v0.y; vw.z = v1.x; vw.w = v1.y;
                    const bf16x8 vf = __builtin_bit_cast(bf16x8, vw);
                    if (dt == 0) o0 = mfma32(vf, pf, o0); else o1 = mfma32(vf, pf, o1);
                }
            }
    }
    lsum += __shfl_xor(lsum, 32);
    const float il = 1.0f / lsum;
    bf16_t* Op = att + (size_t)(b * SL + q) * 512 + h * 64;
#pragma unroll
    for (int i = 0; i < 4; ++i) {
        u32x2 w0, w1;
        w0.x = pk2(o0[4 * i] * il, o0[4 * i + 1] * il); w0.y = pk2(o0[4 * i + 2] * il, o0[4 * i + 3] * il);
        w1.x = pk2(o1[4 * i] * il, o1[4 * i + 1] * il); w1.y = pk2(o1[4 * i + 2] * il, o1[4 * i + 3] * il);
        *(u32x2*)(Op + 8 * i + 4 * hl) = w0;
        *(u32x2*)(Op + 32 + 8 * i + 4 * hl) = w1;
    }
}

__device__ __forceinline__ float convd(const float* row, int l, float w0, float w1, float w2, float cb) {
    float v = cb + w1 * row[l];
    if (l > 0) v += w0 * row[l - 1];
    if (l < SL - 1) v += w2 * row[l + 1];
    return v;
}
__device__ __forceinline__ void hyena_job(const Params& p, int layer, int c, char* lds) {
    const int tid = otid();
    float2* Z = (float2*)lds;
    const float* HF = (const float*)(p.ws + R_HF);
    const float* cw = p.in[I_CW] + (size_t)layer * 3 * 768; const float* cbp = p.in[I_CB] + layer * 768;
    const float2* KF0 = (const float2*)(p.ws + OFF_KF) + ((size_t)(layer * 256 + c) * 2) * 16384;
    const float2* KF1 = KF0 + 16384;
    float* Y = (float*)(p.ws + R_Y) + (size_t)c * T;
    const float bias0 = p.in[I_HB][(layer * 2 + 0) * 256 + c], bias1 = p.in[I_HB][(layer * 2 + 1) * 256 + c];
    const int cv = c, c1 = 256 + c, c2 = 512 + c;
    const float* rv = HF + (size_t)cv * T; const float* r1 = HF + (size_t)c1 * T; const float* r2 = HF + (size_t)c2 * T;
    const float v_w0 = cw[cv], v_w1 = cw[768 + cv], v_w2 = cw[1536 + cv], v_cb = cbp[cv];
    const float a_w0 = cw[c1], a_w1 = cw[768 + c1], a_w2 = cw[1536 + c1], a_cb = cbp[c1];
    const float b_w0 = cw[c2], b_w1 = cw[768 + c2], b_w2 = cw[1536 + c2], b_cb = cbp[c2];
    __syncthreads();
#pragma unroll 4
    for (int i = 0; i < 16; ++i) {
        const int l = tid + NTHR * i;
        Z[l] = make_float2(convd(rv, l, v_w0, v_w1, v_w2, v_cb), convd(rv + SL, l, v_w0, v_w1, v_w2, v_cb));
        Z[8192 + l] = make_float2(0.f, 0.f);
    }
    __syncthreads();
    fft_fwd<14, false>(Z);
#pragma unroll 4
    for (int i = 0; i < 32; ++i) { const int pp = tid + NTHR * i; const float2 z = Z[pp], k = KF0[pp]; Z[pp] = make_float2(z.x * k.x - z.y * k.y, z.x * k.y + z.y * k.x); }
    __syncthreads();
    fft_inv<14, false>(Z);
#pragma unroll 2
    for (int i = 0; i < 16; ++i) {
        const int l = tid + NTHR * i;
        const float2 cvz = Z[l];
        const float v0 = convd(rv, l, v_w0, v_w1, v_w2, v_cb), v1 = convd(rv + SL, l, v_w0, v_w1, v_w2, v_cb);
        const float g0 = convd(r1, l, a_w0, a_w1, a_w2, a_cb), g1 = convd(r1 + SL, l, a_w0, a_w1, a_w2, a_cb);
        const float za = g0 * (cvz.x + v0 * bias0), zb = g1 * (cvz.y + v1 * bias0);
        Y[l] = za; Y[SL + l] = zb;
        Z[l] = make_float2(za, zb);
    }
#pragma unroll 4
    for (int i = 0; i < 16; ++i) { const int l = tid + NTHR * i; Z[8192 + l] = make_float2(0.f, 0.f); }
    __syncthreads();
    fft_fwd<14, false>(Z);
#pragma unroll 4
    for (int i = 0; i < 32; ++i) { const int pp = tid + NTHR * i; const float2 z = Z[pp], k = KF1[pp]; Z[pp] = make_float2(z.x * k.x - z.y * k.y, z.x * k.y + z.y * k.x); }
    __syncthreads();
    fft_inv<14, false>(Z);
#pragma unroll 2
    for (int i = 0; i < 16; ++i) {
        const int l = tid + NTHR * i;
        const float2 cvz = Z[l];
        const float g0 = convd(r2, l, b_w0, b_w1, b_w2, b_cb), g1 = convd(r2 + SL, l, b_w0, b_w1, b_w2, b_cb);
        const float za = Y[l], zb = Y[SL + l];
        Y[l] = g0 * (cvz.x + za * bias1);
        Y[SL + l] = g1 * (cvz.y + zb * bias1);
    }
    __syncthreads();
}

__device__ __forceinline__ void fnet_job(const Params& p, int ch, char* lds) {
    const int tid = otid();
    float2* Z = (float2*)lds;
    const float* row = (const float*)(p.ws + R_HF) + (size_t)(768 + ch) * T;
    float* UR = (float*)(p.ws + R_UR) + (size_t)ch * T;
    float* UI = (float*)(p.ws + R_UI) + (size_t)ch * T;
    __syncthreads();
#pragma unroll 4
    for (int i = 0; i < 16; ++i) { const int l = tid + NTHR * i; Z[zi<true>(l)] = make_float2(row[l], row[SL + l]); }
    __syncthreads();
    fft_fwd<13, true>(Z);
#pragma unroll 4
    for (int i = 0; i < 16; ++i) {
        const int k = tid + NTHR * i;
        const int pk = (int)(__brev((unsigned)k) >> 19);
        const int km = (SL - k) & (SL - 1);
        const int pm = (int)(__brev((unsigned)km) >> 19);
        const float2 zk = Z[zi<true>(pk)], zm = Z[zi<true>(pm)];
        UR[k] = 0.5f * (zk.x + zm.x); UI[k] = 0.5f * (zk.y - zm.y);
        UR[SL + k] = 0.5f * (zk.y + zm.y); UI[SL + k] = 0.5f * (zm.x - zk.x);
    }
    __syncthreads();
}

__device__ __forceinline__ void phase_mix(const Params& p, int layer, char* lds) {
    const int tid = otid(), lane = tid & 63, wave = tid >> 6;
    float* Ul = (float*)lds;
    float* Yl = Ul + 2 * 256 * 33;
    float* Fl = Yl + 256 * 33;
    const float* UR = (const float*)(p.ws + R_UR); const float* UI = (const float*)(p.ws + R_UI);
    const float* Y = (const float*)(p.ws + R_Y);
    const bf16_t* att = (const bf16_t*)(p.ws + R_ATT);
    bf16_t* mix = (bf16_t*)(p.ws + R_MIX);
    const float* FM = (const float*)(p.ws + OFF_FM) + (size_t)layer * 4 * 128 * 64;
    const float* fb = p.in[I_FB] + layer * 256;
    const float* mg = p.in[I_MG] + layer * 1024;
    for (int tile = obid(); tile < T / 32; tile += gridDim.x) {
        const int t0 = tile * 32;
        __syncthreads();
        for (int i = tid; i < 256 * 32; i += NTHR) {
            const int c = i >> 5, tt = i & 31;
            Ul[c * 33 + tt] = UR[(size_t)c * T + t0 + tt];
            Ul[(256 + c) * 33 + tt] = UI[(size_t)c * T + t0 + tt];
            Yl[c * 33 + tt] = Y[(size_t)c * T + t0 + tt];
        }
        __syncthreads();
        {
            const int tok = tid & 31, eo = tid >> 5, g = eo >> 2, e0 = (eo & 3) * 16;
            float acc[16];
#pragma unroll
            for (int j = 0; j < 16; ++j) acc[j] = fb[g * 64 + e0 + j];
            const float* Mg = FM + (size_t)g * 128 * 64 + e0;
            for (int dd = 0; dd < 128; ++dd) {
                const float u = Ul[((dd >> 6) * 256 + g * 64 + (dd & 63)) * 33 + tok];
                const f32x4* mr = (const f32x4*)(Mg + dd * 64);
#pragma unroll
                for (int j4 = 0; j4 < 4; ++j4) { const f32x4 mv = mr[j4]; acc[4 * j4] += u * mv.x; acc[4 * j4 + 1] += u * mv.y; acc[4 * j4 + 2] += u * mv.z; acc[4 * j4 + 3] += u * mv.w; }
            }
#pragma unroll
            for (int j = 0; j < 16; ++j) Fl[tok * 257 + g * 64 + e0 + j] = acc[j];
        }
        __syncthreads();
#pragma unroll
        for (int tt = 0; tt < 4; ++tt) {
            const int tok = wave * 4 + tt; const size_t t = (size_t)(t0 + tok);
            {
                const u32x4 v = *(const u32x4*)(att + t * 512 + lane * 8);
                float x[8] = {bflo(v.x), bfhi(v.x), bflo(v.y), bfhi(v.y), bflo(v.z), bfhi(v.z), bflo(v.w), bfhi(v.w)};
                float ss = 0.f;
#pragma unroll
                for (int j = 0; j < 8; ++j) ss += x[j] * x[j];
                ss = wave_sum(ss);
                const float r = rsqrtf(ss * (1.0f / 512.0f) + EPS);
                const f32x4 g0 = *(const f32x4*)(mg + lane * 8), g1 = *(const f32x4*)(mg + lane * 8 + 4);
                u32x4 o; o.x = pk2(x[0] * r * g0.x, x[1] * r * g0.y); o.y = pk2(x[2] * r * g0.z, x[3] * r * g0.w); o.z = pk2(x[4] * r * g1.x, x[5] * r * g1.y); o.w = pk2(x[6] * r * g1.z, x[7] * r * g1.w);
                *(u32x4*)(mix + t * 1024 + lane * 8) = o;
            }
            {
                float y[4], f[4]; float sy = 0.f, sf = 0.f;
#pragma unroll
                for (int i = 0; i < 4; ++i) { y[i] = Yl[(lane + 64 * i) * 33 + tok]; f[i] = Fl[tok * 257 + lane + 64 * i]; sy += y[i] * y[i]; sf += f[i] * f[i]; }
                sy = wave_sum(sy); sf = wave_sum(sf);
                const float ry = rsqrtf(sy * (1.0f / 256.0f) + EPS), rf = rsqrtf(sf * (1.0f / 256.0f) + EPS);
#pragma unroll
                for (int i = 0; i < 4; ++i) {
                    mix[t * 1024 + 512 + lane + 64 * i] = (bf16_t)f2bf(y[i] * ry * mg[512 + lane + 64 * i]);
                    mix[t * 1024 + 768 + lane + 64 * i] = (bf16_t)f2bf(f[i] * rf * mg[768 + lane + 64 * i]);
                }
            }
        }
    }
}

__device__ __forceinline__ void phase_peer_topk(const Params& p, int layer, char* lds, int* IDX, float* GATE) {
    const int tid = otid(), lane = tid & 63, wave = tid >> 6;
    float* Kl = (float*)lds;
    float* Qw = Kl + 2 * 128 * 132 + wave * 256;
    const float* QP = (const float*)(p.ws + R_QP);
    const float NINF = -3.0e38f;
    for (int u = obid(); u < 8 * 128; u += gridDim.x) {
        const int h = u >> 7, tc = u & 127;
        __syncthreads();
#pragma unroll
        for (int pp = 0; pp < 2; ++pp) {
            const f32x4* src = (const f32x4*)(p.in[I_SK] + (((size_t)(layer * 2 + pp) * 8 + h) * 128) * 128);
#pragma unroll
            for (int i = 0; i < 8; ++i) { const int id = tid + NTHR * i, key = id >> 5, d4 = id & 31; *(f32x4*)(Kl + (pp * 128 + key) * 132 + d4 * 4) = src[id]; }
        }
        __syncthreads();
        for (int tt = 0; tt < 16; ++tt) {
            const int t = tc * 128 + wave * 16 + tt;
            *(f32x4*)(Qw + lane * 4) = *(const f32x4*)(QP + (size_t)t * 2048 + h * 256 + lane * 4);
            float s00 = 0.f, s01 = 0.f, s10 = 0.f, s11 = 0.f;
#pragma unroll 8
            for (int d4 = 0; d4 < 32; ++d4) {
                const f32x4 q0 = *(const f32x4*)(Qw + d4 * 4), q1 = *(const f32x4*)(Qw + 128 + d4 * 4);
                const f32x4 k00 = *(const f32x4*)(Kl + lane * 132 + d4 * 4), k01 = *(const f32x4*)(Kl + (64 + lane) * 132 + d4 * 4);
                const f32x4 k10 = *(const f32x4*)(Kl + (128 + lane) * 132 + d4 * 4), k11 = *(const f32x4*)(Kl + (192 + lane) * 132 + d4 * 4);
                s00 += q0.x * k00.x + q0.y * k00.y + q0.z * k00.z + q0.w * k00.w;
                s01 += q0.x * k01.x + q0.y * k01.y + q0.z * k01.z + q0.w * k01.w;
                s10 += q1.x * k10.x + q1.y * k10.y + q1.z * k10.z + q1.w * k10.w;
                s11 += q1.x * k11.x + q1.y * k11.y + q1.z * k11.z + q1.w * k11.w;
            }
            float tv0 = 0.f, tv1 = 0.f; int ti0 = 0, ti1 = 0;
            for (int r = 0; r < 16; ++r) {
                {
                    const float mmax = wave_max(fmaxf(s00, s01));
                    const unsigned long long b0 = __ballot(s00 == mmax), b1 = __ballot(s01 == mmax);
                    int src, idx;
                    if (b0) { src = __ffsll((long long)b0) - 1; idx = src; if (lane == src) s00 = NINF; }
                    else { src = __ffsll((long long)b1) - 1; idx = src + 64; if (lane == src) s01 = NINF; }
                    if (lane == r) { tv0 = mmax; ti0 = idx; }
                }
                {
                    const float mmax = wave_max(fmaxf(s10, s11));
                    const unsigned long long b0 = __ballot(s10 == mmax), b1 = __ballot(s11 == mmax);
                    int src, idx;
                    if (b0) { src = __ffsll((long long)b0) - 1; idx = src; if (lane == src) s10 = NINF; }
                    else { src = __ffsll((long long)b1) - 1; idx = src + 64; if (lane == src) s11 = NINF; }
                    if (lane == r) { tv1 = mmax; ti1 = idx; }
                }
            }
            float cd[4];
            {
                const float a = __shfl(tv0, lane >> 2);
#pragma unroll
                for (int mm = 0; mm < 4; ++mm) cd[mm] = a + __shfl(tv1, (lane & 3) * 4 + mm);
            }
            float bv = 0.f; int bi = 0;
            for (int r = 0; r < 16; ++r) {
                const float mmax = wave_max(fmaxf(fmaxf(cd[0], cd[1]), fmaxf(cd[2], cd[3])));
                const unsigned long long b0 = __ballot(cd[0] == mmax), b1 = __ballot(cd[1] == mmax), b2 = __ballot(cd[2] == mmax), b3 = __ballot(cd[3] == mmax);
                const int src = __ffsll((long long)(b0 | b1 | b2 | b3)) - 1;
                const int msel = ((b0 >> src) & 1ull) ? 0 : (((b1 >> src) & 1ull) ? 1 : (((b2 >> src) & 1ull) ? 2 : 3));
                if (lane == src) {
                    if (msel == 0) cd[0] = NINF; else if (msel == 1) cd[1] = NINF; else if (msel == 2) cd[2] = NINF; else cd[3] = NINF;
                }
                const int pos = src * 4 + msel;
                const int e = __shfl(ti0, pos >> 4) * 128 + __shfl(ti1, pos & 15);
                if (lane == r) { bv = mmax; bi = e; }
            }
            const float top = __shfl(bv, 0);
            const float ex = (lane < 16) ? expf(bv - top) : 0.f;
            const float den = wave_sum(ex);
            if (lane < 16) { IDX[(size_t)t * 128 + h * 16 + lane] = bi; GATE[(size_t)t * 128 + h * 16 + lane] = ex / den; }
        }
    }
}

__device__ __forceinline__ float gelu_exact(float x) { return 0.5f * x * (1.0f + erff(x * 0.70710678118654752f)); }
__device__ __forceinline__ void phase_peer_gather(const Params& p, int layer, const int* IDX, const float* GATE) {
    const int lane = otid() & 63, wave = otid() >> 6;
    const int gw = obid() * NWAVE + wave, ngw = gridDim.x * NWAVE;
    const bf16_t* PU = (const bf16_t*)(p.ws + OFF_PU) + (size_t)layer * 16384 * 1024;
    const bf16_t* PV = (const bf16_t*)(p.ws + OFF_PV) + (size_t)layer * 16384 * 1024;
    const bf16_t* XN = (const bf16_t*)(p.ws + R_XN);
    float* XA = (float*)(p.ws + OFF_XA);
    for (int t = gw; t < T; t += ngw) {
        float xv[16];
        {
            const u32x4 a = *(const u32x4*)(XN + (size_t)t * DM + lane * 8), b = *(const u32x4*)(XN + (size_t)t * DM + 512 + lane * 8);
            xv[0] = bflo(a.x); xv[1] = bfhi(a.x); xv[2] = bflo(a.y); xv[3] = bfhi(a.y); xv[4] = bflo(a.z); xv[5] = bfhi(a.z); xv[6] = bflo(a.w); xv[7] = bfhi(a.w);
            xv[8] = bflo(b.x); xv[9] = bfhi(b.x); xv[10] = bflo(b.y); xv[11] = bfhi(b.y); xv[12] = bflo(b.z); xv[13] = bfhi(b.z); xv[14] = bflo(b.w); xv[15] = bfhi(b.w);
        }
        float acc[16];
#pragma unroll
        for (int j = 0; j < 16; ++j) acc[j] = 0.f;
        for (int half = 0; half < 2; ++half) {
            const int myi = IDX[(size_t)t * 128 + half * 64 + lane];
            const float myg = GATE[(size_t)t * 128 + half * 64 + lane];
            for (int e0 = 0; e0 < 64; e0 += 4) {
                int ei[4]; float eg[4];
#pragma unroll
                for (int k = 0; k < 4; ++k) { ei[k] = __shfl(myi, e0 + k); eg[k] = __shfl(myg, e0 + k); }
                u32x4 ua[4], ub[4];
#pragma unroll
                for (int k = 0; k < 4; ++k) { const bf16_t* r = PU + (size_t)ei[k] * DM + lane * 8; ua[k] = *(const u32x4*)r; ub[k] = *(const u32x4*)(r + 512); }
                u32x4 va[4], vb[4];
#pragma unroll
                for (int k = 0; k < 4; ++k) { const bf16_t* r = PV + (size_t)ei[k] * DM + lane * 8; va[k] = *(const u32x4*)r; vb[k] = *(const u32x4*)(r + 512); }
                float ds[4];
#pragma unroll
                for (int k = 0; k < 4; ++k) {
                    float d = bflo(ua[k].x) * xv[0] + bfhi(ua[k].x) * xv[1] + bflo(ua[k].y) * xv[2] + bfhi(ua[k].y) * xv[3]
                            + bflo(ua[k].z) * xv[4] + bfhi(ua[k].z) * xv[5] + bflo(ua[k].w) * xv[6] + bfhi(ua[k].w) * xv[7]
                            + bflo(ub[k].x) * xv[8] + bfhi(ub[k].x) * xv[9] + bflo(ub[k].y) * xv[10] + bfhi(ub[k].y) * xv[11]
                            + bflo(ub[k].z) * xv[12] + bfhi(ub[k].z) * xv[13] + bflo(ub[k].w) * xv[14] + bfhi(ub[k].w) * xv[15];
                    ds[k] = wave_sum(d);
                }
#pragma unroll
                for (int k = 0; k < 4; ++k) {
                    const float a = gelu_exact(ds[k]) * eg[k];
                    acc[0] += a * bflo(va[k].x); acc[1] += a * bfhi(va[k].x); acc[2] += a * bflo(va[k].y); acc[3] += a * bfhi(va[k].y);
                    acc[4] += a * bflo(va[k].z); acc[5] += a * bfhi(va[k].z); acc[6] += a * bflo(va[k].w); acc[7] += a * bfhi(va[k].w);
                    acc[8] += a * bflo(vb[k].x); acc[9] += a * bfhi(vb[k].x); acc[10] += a * bflo(vb[k].y); acc[11] += a * bfhi(vb[k].y);
                    acc[12] += a * bflo(vb[k].z); acc[13] += a * bfhi(vb[k].z); acc[14] += a * bflo(vb[k].w); acc[15] += a * bfhi(vb[k].w);
                }
            }
        }
        f32x4* xr = (f32x4*)(XA + (size_t)t * DM + lane * 8);
        f32x4 x0 = xr[0], x1 = xr[1], x2 = xr[128], x3 = xr[129];
        x0.x += acc[0]; x0.y += acc[1]; x0.z += acc[2]; x0.w += acc[3]; x1.x += acc[4]; x1.y += acc[5]; x1.z += acc[6]; x1.w += acc[7];
        x2.x += acc[8]; x2.y += acc[9]; x2.z += acc[10]; x2.w += acc[11]; x3.x += acc[12]; x3.y += acc[13]; x3.z += acc[14]; x3.w += acc[15];
        xr[0] = x0; xr[1] = x1; xr[128] = x2; xr[129] = x3;
    }
}

constexpr int NPHASE_PRE = 2;
constexpr int NPHASE_LAYER = 10;
constexpr int NPHASE = NPHASE_PRE + NLAYER * NPHASE_LAYER + 1;

__device__ __forceinline__ void run_phase(const Params& p, int ph, char* lds) {
    float* XA = (float*)(p.ws + OFF_XA);
    int* IDX = (int*)p.out; float* GATE = p.out + (size_t)T * 128;
    if (ph == 0) { phase_p0(p, lds); return; }
    if (ph == 1) { phase_filter_spectra(p, lds); return; }
    if (ph == NPHASE - 1) { phase_final_norm(XA, p.in[I_FG], p.out); return; }
    const int layer = (ph - NPHASE_PRE) / NPHASE_LAYER, s = (ph - NPHASE_PRE) % NPHASE_LAYER;
    const float* xin = layer == 0 ? p.in[I_X] : XA;
    switch (s) {
    case 0: phase_rmsnorm_bf16(xin, p.in[I_N1G] + layer * DM, (bf16_t*)(p.ws + R_XN)); break;
    case 1: { EpiIn e{(bf16_t*)(p.ws + R_QKV), (float*)(p.ws + R_HF)};
              gemm_phase(( const bf16_t*)(p.ws + R_XN), (const bf16_t*)(p.ws + OFF_WTIN) + (size_t)layer * INC * DM, T, INC, DM, lds, e); } break;
    case 2: phase_qkprep(p, layer, lds); break;
    case 3: {
        for (int u = obid(); u < 512; u += gridDim.x) { const int b = u >> 8, g = (u >> 7) & 1, qb = u & 127; attn_unit(p, b, g, qb, lds); }
        for (int c = obid(); c < 256; c += gridDim.x) hyena_job(p, layer, c, lds);
        for (int c = obid(); c < 256; c += gridDim.x) fnet_job(p, c, lds);
    } break;
    case 4: phase_mix(p, layer, lds); break;
    case 5: { EpiRes e{xin, XA};
              gemm_phase((const bf16_t*)(p.ws + R_MIX), (const bf16_t*)(p.ws + OFF_WTOUT) + (size_t)layer * DM * DM, T, DM, DM, lds, e); } break;
    case 6: phase_rmsnorm_bf16(XA, p.in[I_N2G] + layer * DM, (bf16_t*)(p.ws + R_XN)); break;
    case 7: { EpiF32 e{(float*)(p.ws + R_QP), 2048};
              gemm_phase((const bf16_t*)(p.ws + R_XN), (const bf16_t*)(p.ws + OFF_WTQ) + (size_t)layer * 2048 * DM, T, 2048, DM, lds, e); } break;
    case 8: phase_peer_topk(p, layer, lds, IDX, GATE); break;
    case 9: phase_peer_gather(p, layer, IDX, GATE); break;
    }
}

#if ONE_LAUNCH
__global__ void __launch_bounds__(NTHR) mega_kernel(Params p) {
    extern __shared__ __attribute__((aligned(16))) char lds[];
    cg::grid_group grid = cg::this_grid();
    float* XA = (float*)(p.ws + OFF_XA);
    int* IDX = (int*)p.out; float* GATE = p.out + (size_t)T * 128;
    phase_p0(p, lds); grid.sync();
    phase_filter_spectra(p, lds); grid.sync();
#pragma nounroll
    for (int layer = 0; layer < NLAYER; ++layer) {
        const float* xin = layer == 0 ? p.in[I_X] : XA;
        phase_rmsnorm_bf16(xin, p.in[I_N1G] + layer * DM, (bf16_t*)(p.ws + R_XN)); grid.sync();
        { EpiIn e{(bf16_t*)(p.ws + R_QKV), (float*)(p.ws + R_HF)};
          gemm_phase((const bf16_t*)(p.ws + R_XN), (const bf16_t*)(p.ws + OFF_WTIN) + (size_t)layer * INC * DM, T, INC, DM, lds, e); } grid.sync();
        phase_qkprep(p, layer, lds); grid.sync();
        {
            for (int u = obid(); u < 512; u += gridDim.x) { const int b = u >> 8, g = (u >> 7) & 1, qb = u & 127; attn_unit(p, b, g, qb, lds); }
            for (int c = obid(); c < 256; c += gridDim.x) hyena_job(p, layer, c, lds);
            for (int c = obid(); c < 256; c += gridDim.x) fnet_job(p, c, lds);
        } grid.sync();
        phase_mix(p, layer, lds); grid.sync();
        { EpiRes e{xin, XA};
          gemm_phase((const bf16_t*)(p.ws + R_MIX), (const bf16_t*)(p.ws + OFF_WTOUT) + (size_t)layer * DM * DM, T, DM, DM, lds, e); } grid.sync();
        phase_rmsnorm_bf16(XA, p.in[I_N2G] + layer * DM, (bf16_t*)(p.ws + R_XN)); grid.sync();
        { EpiF32 e{(float*)(p.ws + R_QP), 2048};
          gemm_phase((const bf16_t*)(p.ws + R_XN), (const bf16_t*)(p.ws + OFF_WTQ) + (size_t)layer * 2048 * DM, T, 2048, DM, lds, e); } grid.sync();
        phase_peer_topk(p, layer, lds, IDX, GATE); grid.sync();
        phase_peer_gather(p, layer, IDX, GATE); grid.sync();
    }
    phase_final_norm(XA, p.in[I_FG], p.out);
}
#else
__global__ void __launch_bounds__(NTHR) phase_kernel(Params p, int ph) {
    extern __shared__ __attribute__((aligned(16))) char lds[];
    run_phase(p, ph, lds);
}
#endif

extern "C" void kernel_launch(void* const* d_in, const int* in_sizes, int n_in, void* d_out, int out_size, void* d_ws, size_t ws_size, hipStream_t stream) {
    static int grid = 0;
    if (grid == 0) {
        if (n_in != 25 || out_size != T * DM || ws_size < WS_NEED) { fprintf(stderr, "kernel_launch: unexpected sizes n_in %d out %d ws %zu (need %zu)\n", n_in, out_size, ws_size, (size_t)WS_NEED); grid = -1; return; }
        int dev = 0, cus = 0;
        hipGetDevice(&dev);
        hipDeviceGetAttribute(&cus, hipDeviceAttributeMultiprocessorCount, dev);
#if ONE_LAUNCH
        hipFuncSetAttribute((const void*)mega_kernel, hipFuncAttributeMaxDynamicSharedMemorySize, LDS_BYTES);
        int per_cu = 0;
        hipOccupancyMaxActiveBlocksPerMultiprocessor(&per_cu, (const void*)mega_kernel, NTHR, LDS_BYTES);
        if (per_cu < 1) { fprintf(stderr, "kernel_launch: occupancy query says %d blocks per CU\n", per_cu); }
        grid = cus;
#else
        hipFuncSetAttribute((const void*)phase_kernel, hipFuncAttributeMaxDynamicSharedMemorySize, LDS_BYTES);
        grid = cus;
#endif
        (void)hipGetLastError();
    }
    if (grid < 0) return;
    Params p{};
    for (int i = 0; i < 25; ++i) p.in[i] = (const float*)d_in[i];
    p.out = (float*)d_out; p.ws = (unsigned char*)d_ws;
#if ONE_LAUNCH
    void* args[] = {&p};
    hipError_t e = hipLaunchCooperativeKernel((const void*)mega_kernel, dim3(grid), dim3(NTHR), args, LDS_BYTES, stream);
    if (e != hipSuccess) fprintf(stderr, "cooperative launch failed: %s (grid %d)\n", hipGetErrorString(e), grid);
#else
    for (int ph = 0; ph < NPHASE; ++ph) hipLaunchKernelGGL(phase_kernel, dim3(grid), dim3(NTHR), LDS_BYTES, stream, p, ph);
#endif
}
```

```cpp
#include <hip/hip_runtime.h>
#include <hip/hip_cooperative_groups.h>
#include <cstdio>
#include <cstdint>
namespace cg = cooperative_groups;

#ifndef PROBE
#define PROBE 0
#endif
#ifndef ONE_LAUNCH
#define ONE_LAUNCH 1
#endif

typedef unsigned short bf16_t;
typedef short bf16x8 __attribute__((ext_vector_type(8)));
typedef float f32x16 __attribute__((ext_vector_type(16)));
typedef float f32x4 __attribute__((ext_vector_type(4)));
typedef unsigned u32x4 __attribute__((ext_vector_type(4)));
typedef unsigned u32x2 __attribute__((ext_vector_type(2)));

constexpr int DM = 1024, NB = 2, SL = 8192, T = NB * SL, NLAYER = 2;
constexpr int INC = 1792;
constexpr int NTHR = 512, NWAVE = 8;
constexpr int LDS_BYTES = 147456;
constexpr int LDS_MISC = LDS_BYTES - 64;
constexpr float EPS = 1e-6f;

constexpr size_t MiB = 1u << 20;
constexpr size_t OFF_CTL = 0;
constexpr size_t OFF_WTIN = 1 * MiB;
constexpr size_t OFF_WTOUT = 8 * MiB;
constexpr size_t OFF_WTQ = 12 * MiB;
constexpr size_t OFF_PU = 20 * MiB;
constexpr size_t OFF_PV = 84 * MiB;
constexpr size_t OFF_H2 = 148 * MiB;
constexpr size_t OFF_FM = 152 * MiB;
constexpr size_t OFF_KF = 153 * MiB;
constexpr size_t OFF_XA = 281 * MiB;
constexpr size_t OFF_R = 345 * MiB;
constexpr size_t R_XN = OFF_R + 0 * MiB;
constexpr size_t R_UR = OFF_R + 0 * MiB;
constexpr size_t R_UI = OFF_R + 16 * MiB;
constexpr size_t R_QKV = OFF_R + 32 * MiB;
constexpr size_t R_VT = OFF_R + 56 * MiB;
constexpr size_t R_HF = OFF_R + 60 * MiB;
constexpr size_t R_MIX = OFF_R + 60 * MiB;
constexpr size_t R_ATT = OFF_R + 124 * MiB;
constexpr size_t R_Y = OFF_R + 140 * MiB;
constexpr size_t R_QP = OFF_R + 32 * MiB;
constexpr size_t WS_NEED = 505 * MiB;

struct Params {
    const float* in[25];
    float* out;
    unsigned char* ws;
};
enum { I_X = 0, I_N1G, I_WIN, I_QG, I_KG, I_CW, I_CB, I_W1, I_B1, I_F1, I_W2, I_B2, I_F2, I_W3, I_HB, I_FW, I_FB, I_MG, I_WOUT, I_N2G, I_WQ, I_SK, I_PU, I_PV, I_FG };

__device__ __forceinline__ unsigned f2bf(float f) { unsigned u = __builtin_bit_cast(unsigned, f); return (u + 0x7fffu + ((u >> 16) & 1u)) >> 16; }
__device__ __forceinline__ unsigned pk2(float lo, float hi) { return f2bf(lo) | (f2bf(hi) << 16); }
__device__ __forceinline__ float bf2f(unsigned b) { return __builtin_bit_cast(float, b << 16); }
__device__ __forceinline__ float bflo(unsigned w) { return __builtin_bit_cast(float, w << 16); }
__device__ __forceinline__ float bfhi(unsigned w) { return __builtin_bit_cast(float, w & 0xffff0000u); }
__device__ __forceinline__ float wave_sum(float v) {
#pragma unroll
    for (int o = 1; o < 64; o <<= 1) v += __shfl_xor(v, o);
    return v;
}
__device__ __forceinline__ float wave_max(float v) {
#pragma unroll
    for (int o = 1; o < 64; o <<= 1) v = fmaxf(v, __shfl_xor(v, o));
    return v;
}
__device__ __forceinline__ f32x16 mfma32(bf16x8 a, bf16x8 b, f32x16 c) { return __builtin_amdgcn_mfma_f32_32x32x16_bf16(a, b, c, 0, 0, 0); }
__device__ __forceinline__ f32x16 zero16() { return (f32x16){0.f,0.f,0.f,0.f,0.f,0.f,0.f,0.f,0.f,0.f,0.f,0.f,0.f,0.f,0.f,0.f}; }


__device__ __forceinline__ int otid() { int t = threadIdx.x; asm volatile("" : "+v"(t)); return t; }
__device__ __forceinline__ int obid() { int b = blockIdx.x; asm volatile("" : "+s"(b)); return b; }
__device__ __forceinline__ void transpose_one(const float* W, int K, int N, bf16_t* Wt, float* tile, int item) {
    const int tid = otid();
    const int nblk = N / 64, kb = item / nblk, nb = item % nblk, k0 = kb * 64, n0 = nb * 64;
    __syncthreads();
    {
        const int r = tid >> 6, c = tid & 63;
#pragma unroll
        for (int i = 0; i < 8; ++i) { const int k = r + 8 * i; tile[k * 65 + c] = W[(size_t)(k0 + k) * N + n0 + c]; }
    }
    __syncthreads();
    {
        const int nn = tid >> 3, kc = tid & 7;
        const float* s = tile + (kc * 8) * 65 + nn;
        u32x4 o; o.x = pk2(s[0], s[65]); o.y = pk2(s[2 * 65], s[3 * 65]); o.z = pk2(s[4 * 65], s[5 * 65]); o.w = pk2(s[6 * 65], s[7 * 65]);
        *(u32x4*)(Wt + (size_t)(n0 + nn) * K + k0 + kc * 8) = o;
    }
}

__device__ __forceinline__ void phase_p0(const Params& p, char* lds) {
    const int tid = otid();
    float* tile = (float*)lds;
    constexpr int IT_IN = (DM / 64) * (INC / 64), IT_OUT = (DM / 64) * (DM / 64);
    constexpr int IT_L = IT_IN + IT_OUT;
    for (int it = obid(); it < NLAYER * IT_L; it += gridDim.x) {
        const int layer = it / IT_L; int r = it % IT_L;
        if (r < IT_IN) { transpose_one(p.in[I_WIN] + (size_t)layer * DM * INC, DM, INC, (bf16_t*)(p.ws + OFF_WTIN) + (size_t)layer * INC * DM, tile, r); continue; }
        r -= IT_IN;
        transpose_one(p.in[I_WOUT] + (size_t)layer * DM * DM, DM, DM, (bf16_t*)(p.ws + OFF_WTOUT) + (size_t)layer * DM * DM, tile, r);
    }
    __syncthreads();
    {
        float* SKl = (float*)lds;
        float* Wl = SKl + 128 * 129;
        for (int it = obid(); it < NLAYER * 16 * 16; it += gridDim.x) {
            const int layer = it >> 8, hp = (it >> 4) & 15, kc = it & 15, h = hp >> 1, pp = hp & 1, k0 = kc * 64;
            const float* sk = p.in[I_SK] + (((size_t)(layer * 2 + pp) * 8 + h) * 128) * 128;
            const float* wq = p.in[I_WQ] + (size_t)layer * DM * 2048 + (size_t)k0 * 2048 + h * 256 + pp * 128;
            __syncthreads();
            for (int i = tid; i < 128 * 128; i += NTHR) SKl[(i >> 7) * 129 + (i & 127)] = sk[i];
            for (int i = tid; i < 64 * 128; i += NTHR) Wl[(i >> 7) * 132 + (i & 127)] = wq[(size_t)(i >> 7) * 2048 + (i & 127)];
            __syncthreads();
            const int key = tid & 127, kq = tid >> 7;
            float acc[16];
#pragma unroll
            for (int j = 0; j < 16; ++j) acc[j] = 0.f;
            for (int d4 = 0; d4 < 32; ++d4) {
                const float a0 = SKl[key * 129 + d4 * 4], a1 = SKl[key * 129 + d4 * 4 + 1], a2 = SKl[key * 129 + d4 * 4 + 2], a3 = SKl[key * 129 + d4 * 4 + 3];
#pragma unroll
                for (int j = 0; j < 16; ++j) { const f32x4 w = *(const f32x4*)(Wl + (kq * 16 + j) * 132 + d4 * 4); acc[j] += a0 * w.x + a1 * w.y + a2 * w.z + a3 * w.w; }
            }
            bf16_t* dst = (bf16_t*)(p.ws + OFF_WTQ) + (size_t)layer * 2048 * DM + (size_t)(hp * 128 + key) * DM + k0 + kq * 16;
            u32x4 o0, o1;
            o0.x = pk2(acc[0], acc[1]); o0.y = pk2(acc[2], acc[3]); o0.z = pk2(acc[4], acc[5]); o0.w = pk2(acc[6], acc[7]);
            o1.x = pk2(acc[8], acc[9]); o1.y = pk2(acc[10], acc[11]); o1.z = pk2(acc[12], acc[13]); o1.w = pk2(acc[14], acc[15]);
            *(u32x4*)dst = o0; *(u32x4*)(dst + 8) = o1;
        }
        __syncthreads();
    }
    {
        const size_t n4 = (size_t)NLAYER * 16384 * 1024 / 4;
        const size_t gstride = (size_t)gridDim.x * NTHR;
        for (int tb = 0; tb < 2; ++tb) {
            const f32x4* src = (const f32x4*)p.in[tb ? I_PV : I_PU];
            u32x2* dst = (u32x2*)(p.ws + (tb ? OFF_PV : OFF_PU));
            for (size_t i = (size_t)obid() * NTHR + tid; i < n4; i += gstride) {
                const f32x4 v = src[i]; u32x2 o; o.x = pk2(v.x, v.y); o.y = pk2(v.z, v.w); dst[i] = o;
            }
        }
    }
    {
        float* sh = (float*)lds;
        float* zl = sh + 8 * 64;
        const int sub = tid >> 6, j = tid & 63;
        for (int it = obid(); it < NLAYER * SL / 8; it += gridDim.x) {
            const int layer = it / (SL / 8), l = (it % (SL / 8)) * 8 + sub;
            const float t = (float)l / (float)(SL - 1);
            __syncthreads();
            if (j < 17) {
                float z;
                if (j == 0) z = t;
                else if (j <= 8) z = sinf(2.0f * 3.14159265358979323846f * t * (float)j);
                else z = cosf(2.0f * 3.14159265358979323846f * t * (float)(j - 8));
                zl[sub * 17 + j] = z;
            }
            __syncthreads();
            const float* w1 = p.in[I_W1] + layer * 17 * 64;
            float a = p.in[I_B1][layer * 64 + j];
#pragma unroll
            for (int i = 0; i < 17; ++i) a += zl[sub * 17 + i] * w1[i * 64 + j];
            sh[sub * 64 + j] = sinf(p.in[I_F1][layer * 64 + j] * a);
            __syncthreads();
            const float* w2 = p.in[I_W2] + layer * 64 * 64;
            float b = p.in[I_B2][layer * 64 + j];
#pragma unroll 8
            for (int k = 0; k < 64; ++k) b += sh[sub * 64 + k] * w2[k * 64 + j];
            ((float*)(p.ws + OFF_H2))[((size_t)layer * SL + l) * 64 + j] = sinf(p.in[I_F2][layer * 64 + j] * b);
        }
    }
    {
        const int total = NLAYER * 4 * 128 * 64;
        for (int o = obid() * NTHR + tid; o < total; o += gridDim.x * NTHR) {
            const int e2 = o & 63, dd = (o >> 6) & 127, g = (o >> 13) & 3, layer = o >> 15;
            const int d = dd & 63;
            const float* w = p.in[I_FW] + ((size_t)(layer * 4 + g) * 64) * 64;
            float acc = 0.f;
            for (int e = 0; e < 64; ++e) {
                const int m = (d * e) & 63;
                const float ang = (float)m * (2.0f * 3.14159265358979323846f / 64.0f);
                const float tw = (dd < 64) ? cosf(ang) : sinf(ang);
                acc += tw * w[e * 64 + e2];
            }
            ((float*)(p.ws + OFF_FM))[o] = acc * (1.0f / 724.0773439350246f);
        }
    }
}

template <bool PAD> __device__ __forceinline__ int zi(int i) { return PAD ? i + (i >> 8) : i; }

template <int LOGN, bool PAD>
__device__ __forceinline__ void fft_fwd(float2* Z) {
    constexpr int N = 1 << LOGN;
    const int tid = otid();
    int s = 0;
    for (; s + 1 < LOGN; s += 2) {
        const int lh2 = LOGN - s - 2;
        const int h2 = 1 << lh2, h = h2 << 1;
        const float rs = 1.0f / (float)(h << 1);
        for (int q = tid; q < N / 4; q += NTHR) {
            const int j = q & (h2 - 1), blk = q >> lh2;
            const int base = (blk << (lh2 + 2)) + j;
            float2 x0 = Z[zi<PAD>(base)], x1 = Z[zi<PAD>(base + h2)], x2 = Z[zi<PAD>(base + h)], x3 = Z[zi<PAD>(base + h + h2)];
            const float ang = (float)j * rs;
            const float c = __builtin_amdgcn_cosf(ang), sn = __builtin_amdgcn_sinf(ang);
            float2 a0 = make_float2(x0.x + x2.x, x0.y + x2.y);
            float2 d02 = make_float2(x0.x - x2.x, x0.y - x2.y);
            float2 a2 = make_float2(d02.x * c + d02.y * sn, d02.y * c - d02.x * sn);
            float2 a1 = make_float2(x1.x + x3.x, x1.y + x3.y);
            float2 d13 = make_float2(x1.x - x3.x, x1.y - x3.y);
            float2 t3 = make_float2(d13.x * c + d13.y * sn, d13.y * c - d13.x * sn);
            float2 a3 = make_float2(t3.y, -t3.x);
            const float c2 = c * c - sn * sn, s2 = 2.f * c * sn;
            float2 y0 = make_float2(a0.x + a1.x, a0.y + a1.y);
            float2 e01 = make_float2(a0.x - a1.x, a0.y - a1.y);
            float2 y1 = make_float2(e01.x * c2 + e01.y * s2, e01.y * c2 - e01.x * s2);
            float2 y2 = make_float2(a2.x + a3.x, a2.y + a3.y);
            float2 e23 = make_float2(a2.x - a3.x, a2.y - a3.y);
            float2 y3 = make_float2(e23.x * c2 + e23.y * s2, e23.y * c2 - e23.x * s2);
            Z[zi<PAD>(base)] = y0; Z[zi<PAD>(base + h2)] = y1; Z[zi<PAD>(base + h)] = y2; Z[zi<PAD>(base + h + h2)] = y3;
        }
        __syncthreads();
    }
    if (s < LOGN) {
        for (int q = tid; q < N / 2; q += NTHR) {
            const int i0 = 2 * q;
            float2 a = Z[zi<PAD>(i0)], b = Z[zi<PAD>(i0 + 1)];
            Z[zi<PAD>(i0)] = make_float2(a.x + b.x, a.y + b.y);
            Z[zi<PAD>(i0 + 1)] = make_float2(a.x - b.x, a.y - b.y);
        }
        __syncthreads();
    }
}

template <int LOGN, bool PAD>
__device__ __forceinline__ void fft_inv(float2* Z) {
    constexpr int N = 1 << LOGN;
    const int tid = otid();
    for (int s = LOGN - 2; s >= 0; s -= 2) {
        const int lh2 = LOGN - s - 2;
        const int h2 = 1 << lh2, h = h2 << 1;
        const float rs = 1.0f / (float)(h << 1);
        for (int q = tid; q < N / 4; q += NTHR) {
            const int j = q & (h2 - 1), blk = q >> lh2;
            const int base = (blk << (lh2 + 2)) + j;
            float2 y0 = Z[zi<PAD>(base)], y1 = Z[zi<PAD>(base + h2)], y2 = Z[zi<PAD>(base + h)], y3 = Z[zi<PAD>(base + h + h2)];
            const float ang = (float)j * rs;
            const float c = __builtin_amdgcn_cosf(ang), sn = __builtin_amdgcn_sinf(ang);
            const float c2 = c * c - sn * sn, s2 = 2.f * c * sn;
            float2 t1 = make_float2(y1.x * c2 - y1.y * s2, y1.y * c2 + y1.x * s2);
            float2 t3 = make_float2(y3.x * c2 - y3.y * s2, y3.y * c2 + y3.x * s2);
            float2 a0 = make_float2(y0.x + t1.x, y0.y + t1.y), a1 = make_float2(y0.x - t1.x, y0.y - t1.y);
            float2 a2 = make_float2(y2.x + t3.x, y2.y + t3.y), a3 = make_float2(y2.x - t3.x, y2.y - t3.y);
            float2 u2 = make_float2(a2.x * c - a2.y * sn, a2.y * c + a2.x * sn);
            float2 u3 = make_float2(a3.x * c - a3.y * sn, a3.y * c + a3.x * sn);
            float2 v3 = make_float2(-u3.y, u3.x);
            Z[zi<PAD>(base)] = make_float2(a0.x + u2.x, a0.y + u2.y);
            Z[zi<PAD>(base + h)] = make_float2(a0.x - u2.x, a0.y - u2.y);
            Z[zi<PAD>(base + h2)] = make_float2(a1.x + v3.x, a1.y + v3.y);
            Z[zi<PAD>(base + h + h2)] = make_float2(a1.x - v3.x, a1.y - v3.y);
        }
        __syncthreads();
    }
}

__device__ __forceinline__ void phase_filter_spectra(const Params& p, char* lds) {
    const int tid = otid(), lane = tid & 63, wave = tid >> 6;
    float2* Z = (float2*)lds;
    float* w3l = (float*)(lds + 131072);
    float* red = w3l + 256;
    for (int job = obid(); job < NLAYER * 256; job += gridDim.x) {
        const int layer = job >> 8, c = job & 255;
        __syncthreads();
        if (tid < 256) { const int k = tid >> 2, q = tid & 3; w3l[tid] = p.in[I_W3][((size_t)layer * 64 + k) * 1024 + q * 256 + c]; }
        __syncthreads();
        const float* H2 = (const float*)(p.ws + OFF_H2) + (size_t)layer * SL * 64;
        const float r_lo = 4.605170185988092f / 1.5f, r_hi = 4.605170185988092f / 0.3f;
        const float rate = r_lo + (r_hi - r_lo) * ((float)c / 255.0f);
        float ss0 = 0.f, ss1 = 0.f;
        for (int i = 0; i < 16; ++i) {
            const int l = tid + NTHR * i;
            const f32x4* hr = (const f32x4*)(H2 + (size_t)l * 64);
            float a0 = 0.f, a1 = 0.f, a2 = 0.f, a3 = 0.f;
#pragma unroll
            for (int k4 = 0; k4 < 16; ++k4) {
                const f32x4 hv = hr[k4];
#pragma unroll
                for (int e = 0; e < 4; ++e) {
                    const f32x4 w = *(const f32x4*)(w3l + (k4 * 4 + e) * 4);
                    const float hh = hv[e];
                    a0 += hh * w.x; a1 += hh * w.y; a2 += hh * w.z; a3 += hh * w.w;
                }
            }
            const float t = (float)l / (float)(SL - 1);
            const float dec = expf(-t * rate);
            a0 *= dec; a1 *= dec; a2 *= dec; a3 *= dec;
            ss0 += a0 * a0 + a1 * a1; ss1 += a2 * a2 + a3 * a3;
            Z[l] = make_float2(a0, a2);
            if (l >= 1) Z[16384 - l] = make_float2(a1, a3);
        }
        if (tid == 0) Z[8192] = make_float2(0.f, 0.f);
        ss0 = wave_sum(ss0); ss1 = wave_sum(ss1);
        if (lane == 0) { red[wave * 2] = ss0; red[wave * 2 + 1] = ss1; }
        __syncthreads();
        float t0 = 0.f, t1 = 0.f;
#pragma unroll
        for (int w = 0; w < 8; ++w) { t0 += red[w * 2]; t1 += red[w * 2 + 1]; }
        const float sc0 = rsqrtf(t0 + EPS) * (1.0f / 16384.0f) * 0.5f, sc1 = rsqrtf(t1 + EPS) * (1.0f / 16384.0f) * 0.5f;
        fft_fwd<14, false>(Z);
        float2* KF0 = (float2*)(p.ws + OFF_KF) + ((size_t)(layer * 256 + c) * 2) * 16384;
        float2* KF1 = KF0 + 16384;
        for (int i = 0; i < 32; ++i) {
            const int pp = tid + NTHR * i;
            const int f = (int)(__brev((unsigned)pp) >> 18);
            const int fm = (16384 - f) & 16383;
            const int pq = (int)(__brev((unsigned)fm) >> 18);
            const float2 zp = Z[pp], zq = Z[pq];
            KF0[pp] = make_float2((zp.x + zq.x) * sc0, (zp.y - zq.y) * sc0);
            KF1[pp] = make_float2((zp.y + zq.y) * sc1, (zq.x - zp.x) * sc1);
        }
    }
}

__device__ __forceinline__ void phase_rmsnorm_bf16(const float* x, const float* g, bf16_t* out) {
    const int lane = otid() & 63, wave = otid() >> 6;
    const int gw = obid() * NWAVE + wave, ngw = gridDim.x * NWAVE;
    for (int row = gw; row < T; row += ngw) {
        const f32x4* xr = (const f32x4*)(x + (size_t)row * DM) + lane;
        f32x4 v[4]; float ss = 0.f;
#pragma unroll
        for (int j = 0; j < 4; ++j) { v[j] = xr[64 * j]; ss += v[j].x * v[j].x + v[j].y * v[j].y + v[j].z * v[j].z + v[j].w * v[j].w; }
        ss = wave_sum(ss);
        const float r = rsqrtf(ss * (1.0f / DM) + EPS);
        u32x2* o = (u32x2*)(out + (size_t)row * DM) + lane;
#pragma unroll
        for (int j = 0; j < 4; ++j) {
            const f32x4 gg = ((const f32x4*)g)[lane + 64 * j];
            u32x2 w; w.x = pk2(v[j].x * r * gg.x, v[j].y * r * gg.y); w.y = pk2(v[j].z * r * gg.z, v[j].w * r * gg.w);
            o[64 * j] = w;
        }
    }
}
__device__ __forceinline__ void phase_final_norm(const float* x, const float* g, float* out) {
    const int lane = otid() & 63, wave = otid() >> 6;
    const int gw = obid() * NWAVE + wave, ngw = gridDim.x * NWAVE;
    for (int row = gw; row < T; row += ngw) {
        const f32x4* xr = (const f32x4*)(x + (size_t)row * DM) + lane;
        f32x4 v[4]; float ss = 0.f;
#pragma unroll
        for (int j = 0; j < 4; ++j) { v[j] = xr[64 * j]; ss += v[j].x * v[j].x + v[j].y * v[j].y + v[j].z * v[j].z + v[j].w * v[j].w; }
        ss = wave_sum(ss);
        const float r = rsqrtf(ss * (1.0f / DM) + EPS);
        f32x4* o = (f32x4*)(out + (size_t)row * DM) + lane;
#pragma unroll
        for (int j = 0; j < 4; ++j) { const f32x4 gg = ((const f32x4*)g)[lane + 64 * j]; o[64 * j] = v[j] * r * gg; }
    }
}

constexpr int G_LDA = 144;
template <class Epi>
__device__ __forceinline__ void gemm_phase(const bf16_t* A, const bf16_t* Bt, int M, int N, int K, char* lds, const Epi& epi) {
    const int tid = otid(), lane = tid & 63, wave = tid >> 6;
    const int wm = wave >> 1, wn = wave & 1;
    const int nMt = M / 256, nNt = N / 128, total = nMt * nNt, nk = K / 64;
    char* As = lds; char* Bs = lds + 256 * G_LDA;
    const int l31 = lane & 31, hl = lane >> 5;
    for (int u = obid(); u < total; u += gridDim.x) {
        const int mt = u % nMt, nt = u / nMt;
        f32x16 acc[2][2];
#pragma unroll
        for (int i = 0; i < 2; ++i)
#pragma unroll
            for (int j = 0; j < 2; ++j) acc[i][j] = zero16();
        u32x4 ra[4], rb[2];
        const bf16_t* Ab = A + (size_t)(mt * 256) * K;
        const bf16_t* Bb = Bt + (size_t)(nt * 128) * K;
#pragma unroll
        for (int i = 0; i < 4; ++i) { const int id = tid + NTHR * i, row = id >> 3, ch = id & 7; ra[i] = *(const u32x4*)(Ab + (size_t)row * K + ch * 8); }
#pragma unroll
        for (int i = 0; i < 2; ++i) { const int id = tid + NTHR * i, row = id >> 3, ch = id & 7; rb[i] = *(const u32x4*)(Bb + (size_t)row * K + ch * 8); }
        for (int kt = 0; kt < nk; ++kt) {
            __syncthreads();
#pragma unroll
            for (int i = 0; i < 4; ++i) { const int id = tid + NTHR * i, row = id >> 3, ch = id & 7; *(u32x4*)(As + row * G_LDA + ch * 16) = ra[i]; }
#pragma unroll
            for (int i = 0; i < 2; ++i) { const int id = tid + NTHR * i, row = id >> 3, ch = id & 7; *(u32x4*)(Bs + row * G_LDA + ch * 16) = rb[i]; }
            __syncthreads();
            if (kt + 1 < nk) {
                const int ko = (kt + 1) * 64;
#pragma unroll
                for (int i = 0; i < 4; ++i) { const int id = tid + NTHR * i, row = id >> 3, ch = id & 7; ra[i] = *(const u32x4*)(Ab + (size_t)row * K + ko + ch * 8); }
#pragma unroll
                for (int i = 0; i < 2; ++i) { const int id = tid + NTHR * i, row = id >> 3, ch = id & 7; rb[i] = *(const u32x4*)(Bb + (size_t)row * K + ko + ch * 8); }
            }
#pragma unroll
            for (int ks = 0; ks < 4; ++ks) {
                bf16x8 a[2], b[2];
#pragma unroll
                for (int i = 0; i < 2; ++i) a[i] = *(const bf16x8*)(As + (wm * 64 + i * 32 + l31) * G_LDA + ks * 32 + hl * 16);
#pragma unroll
                for (int j = 0; j < 2; ++j) b[j] = *(const bf16x8*)(Bs + (wn * 64 + j * 32 + l31) * G_LDA + ks * 32 + hl * 16);
#pragma unroll
                for (int i = 0; i < 2; ++i)
#pragma unroll
                    for (int j = 0; j < 2; ++j) acc[i][j] = mfma32(a[i], b[j], acc[i][j]);
            }
        }
#pragma unroll
        for (int i = 0; i < 2; ++i)
#pragma unroll
            for (int j = 0; j < 2; ++j) epi(acc[i][j], mt * 256 + wm * 64 + i * 32, nt * 128 + wn * 64 + j * 32, lane);
    }
}

struct EpiIn {
    bf16_t* qkv; float* hf;
    __device__ __forceinline__ void operator()(const f32x16& acc, int row0, int col0, int lane) const {
        const int c = col0 + (lane & 31), h = lane >> 5;
        if (col0 < 768) {
#pragma unroll
            for (int r = 0; r < 16; ++r) { const int row = row0 + (r & 3) + 8 * (r >> 2) + 4 * h; qkv[(size_t)row * 768 + c] = (bf16_t)f2bf(acc[r]); }
        } else {
            float* dst = hf + (size_t)(c - 768) * T;
#pragma unroll
            for (int i = 0; i < 4; ++i) { const int row = row0 + 8 * i + 4 * h; f32x4 v; v.x = acc[4 * i]; v.y = acc[4 * i + 1]; v.z = acc[4 * i + 2]; v.w = acc[4 * i + 3]; *(f32x4*)(dst + row) = v; }
        }
    }
};
struct EpiRes {
    const float* base; float* out;
    __device__ __forceinline__ void operator()(const f32x16& acc, int row0, int col0, int lane) const {
        const int c = col0 + (lane & 31), h = lane >> 5;
#pragma unroll
        for (int r = 0; r < 16; ++r) { const size_t o = (size_t)(row0 + (r & 3) + 8 * (r >> 2) + 4 * h) * DM + c; out[o] = base[o] + acc[r]; }
    }
};
struct EpiF32 {
    float* out; int ld;
    __device__ __forceinline__ void operator()(const f32x16& acc, int row0, int col0, int lane) const {
        const int c = col0 + (lane & 31), h = lane >> 5;
#pragma unroll
        for (int r = 0; r < 16; ++r) { out[(size_t)(row0 + (r & 3) + 8 * (r >> 2) + 4 * h) * ld + c] = acc[r]; }
    }
};

__device__ __forceinline__ void phase_qkprep(const Params& p, int layer, char* lds) {
    const int tid = otid(), lane = tid & 63, wave = tid >> 6;
    bf16_t* qkv = (bf16_t*)(p.ws + R_QKV);
    bf16_t* vt = (bf16_t*)(p.ws + R_VT);
    const float qgv = p.in[I_QG][layer * 64 + lane], kgv = p.in[I_KG][layer * 64 + lane];
    const int gw = obid() * NWAVE + wave, ngw = gridDim.x * NWAVE;
    const int ax = lane >> 5, fr = lane & 15; const bool second = (lane >> 4) & 1;
    const float inv = powf(10000.0f, -(float)fr / 16.0f);
    for (int t = gw; t < T; t += ngw) {
        const int l = t & (SL - 1);
        const float pos = ax ? (float)(l & 63) : (float)(l >> 6);
        const float ang = pos * inv;
        const float cs = cosf(ang), sn = sinf(ang);
        bf16_t* row = qkv + (size_t)t * 768;
#pragma unroll
        for (int slot = 0; slot < 10; ++slot) {
            const float x = bf2f(row[slot * 64 + lane]);
            const float ss = wave_sum(x * x);
            const float r = rsqrtf(ss * (1.0f / 64.0f) + EPS);
            const float y = x * r * (slot < 8 ? qgv : kgv);
            const float other = __shfl_xor(y, 16);
            float o = second ? (y * cs + other * sn) : (y * cs - other * sn);
            if (slot < 8) o *= 0.125f * 1.4426950408889634f;
            row[slot * 64 + lane] = (bf16_t)f2bf(o);
        }
    }
}

#include <hip/hip_bf16.h>
#include <cmath>
namespace attn_body {
using bf16=__hip_bfloat16;
using bf16x8=__attribute__((ext_vector_type(8)))short;
using s16x4=__attribute__((ext_vector_type(4)))short;
using f32x16=__attribute__((ext_vector_type(16)))float;
using u32x4=__attribute__((ext_vector_type(4)))unsigned;
constexpr int SEQ=8192,D=64,PQ=768,PO=512;
constexpr int NW=8,QBLK=32,QB=QBLK*NW,KVBLK=64,NQB=SEQ/QB;
constexpr int ATTN_UNIT_ROWS=QB;
__device__ __forceinline__ int crow(int r,int hi){return (r&3)+8*(r>>2)+4*hi;}
#define SBAR() __builtin_amdgcn_sched_barrier(0)
__device__ __forceinline__ void cmask(f32x16&p0,f32x16&p1,int jb,int qrel,int hi){
  const float NEG=-INFINITY; int kb=64*jb+4*hi;
  #pragma unroll
  for(int r=0;r<16;++r){int kv=kb+(r&3)+8*(r>>2); if(kv>qrel)p0[r]=NEG; if(kv+32>qrel)p1[r]=NEG;}
}

constexpr int NSLOT=3, SLOTB=8192;
constexpr int LDS_K=0, LDS_V=NSLOT*SLOTB, LDS_WS=2*NSLOT*SLOTB, LDS_OST=LDS_WS+NW*64*4, LDS_BYTES=LDS_OST+NW*4096;
constexpr float C2=0.125f*1.4426950408889634f;
__device__ __forceinline__ void glds16(const void*gsrc,unsigned lds_dst){unsigned keep;
  asm volatile("s_mov_b32 %0, m0\n\ts_mov_b32 m0, %2\n\ts_nop 0\n\tglobal_load_lds_dwordx4 %1, off\n\ts_mov_b32 m0, %0":"=&s"(keep):"v"(gsrc),"s"(lds_dst):"memory");}
__device__ __forceinline__ float max3f(float a,float b,float c){float r;asm("v_max3_f32 %0, %1, %2, %3":"=v"(r):"v"(a),"v"(b),"v"(c));return r;}
__device__ __forceinline__ float max2f(float a,float b){float r;asm("v_max_f32_e32 %0, %1, %2":"=v"(r):"v"(a),"v"(b));return r;}
__device__ __forceinline__ float fadd_s(float a,float b){float r;asm("v_add_f32_e32 %0, %1, %2":"=v"(r):"v"(a),"v"(b));return r;}
__device__ __forceinline__ float fsub_s(float a,float b){float r;asm("v_sub_f32_e32 %0, %1, %2":"=v"(r):"v"(a),"v"(b));return r;}
typedef float f32x2_t __attribute__((ext_vector_type(2))); typedef __bf16 bf16x2_t __attribute__((ext_vector_type(2)));
__device__ __forceinline__ unsigned cvtpk_s(float lo,float hi){f32x2_t v={lo,hi};bf16x2_t b=__builtin_convertvector(v,bf16x2_t);return __builtin_bit_cast(unsigned,b);}
#define WAIT_BAR(N) asm volatile("s_waitcnt vmcnt(" #N ") lgkmcnt(0)\n\ts_barrier":::"memory")

__device__ __forceinline__ void qkt(f32x16&p0,f32x16&p1,const char*Kslot,const bf16x8*qr,const f32x16&negm,int r32,int hi){
  const char*kb=Kslot+hi*1024+r32*16;
  #pragma unroll
  for(int d0=0;d0<4;++d0){
    const bf16x8 b0=*reinterpret_cast<const bf16x8*>(kb+d0*2048);
    const bf16x8 b1=*reinterpret_cast<const bf16x8*>(kb+d0*2048+512);
    if(d0==0){p0=__builtin_amdgcn_mfma_f32_32x32x16_bf16(b0,qr[0],negm,0,0,0);p1=__builtin_amdgcn_mfma_f32_32x32x16_bf16(b1,qr[0],negm,0,0,0);}
    else{p0=__builtin_amdgcn_mfma_f32_32x32x16_bf16(b0,qr[d0],p0,0,0,0);p1=__builtin_amdgcn_mfma_f32_32x32x16_bf16(b1,qr[d0],p1,0,0,0);}}
}
typedef __attribute__((address_space(3))) const char* lds_cptr;
typedef short v4i16_t __attribute__((ext_vector_type(4)));
__device__ __forceinline__ void kload8(bf16x8*kf,lds_cptr kp){
  kf[0]=*(const __attribute__((address_space(3))) bf16x8*)(kp);      kf[1]=*(const __attribute__((address_space(3))) bf16x8*)(kp+512);
  kf[2]=*(const __attribute__((address_space(3))) bf16x8*)(kp+2048); kf[3]=*(const __attribute__((address_space(3))) bf16x8*)(kp+2560);
  kf[4]=*(const __attribute__((address_space(3))) bf16x8*)(kp+4096); kf[5]=*(const __attribute__((address_space(3))) bf16x8*)(kp+4608);
  kf[6]=*(const __attribute__((address_space(3))) bf16x8*)(kp+6144); kf[7]=*(const __attribute__((address_space(3))) bf16x8*)(kp+6656);
}
__device__ __forceinline__ void kload2(bf16x8*kf,lds_cptr kp,int j){ kf[2*j]=*(const __attribute__((address_space(3))) bf16x8*)(kp+j*2048); kf[2*j+1]=*(const __attribute__((address_space(3))) bf16x8*)(kp+j*2048+512); }
__device__ __forceinline__ s16x4 vtr(lds_cptr p){ return __builtin_bit_cast(s16x4,__builtin_amdgcn_ds_read_tr16_b64_v4i16((__attribute__((address_space(3))) v4i16_t*)p)); }
__device__ __forceinline__ float rowmax(const f32x16&p0,const f32x16&p1){
  float a=max3f(p0[0],p0[1],p1[0]),b=max3f(p0[2],p0[3],p1[1]);a=max3f(a,p1[2],p1[3]);
  #pragma unroll
  for(int r=4;r<16;r+=4){a=max3f(a,p0[r],p0[r+1]);b=max3f(b,p0[r+2],p0[r+3]);a=max3f(a,p1[r],p1[r+1]);b=max3f(b,p1[r+2],p1[r+3]);}
  const float m=max2f(a,b);
  auto rr=__builtin_amdgcn_permlane32_swap(__float_as_uint(m),__float_as_uint(m),false,false);
  return max2f(__uint_as_float(rr[0]),__uint_as_float(rr[1]));
}
__device__ __forceinline__ void pv(f32x16*o,int vb,bf16x8 pa0,bf16x8 pa1,bf16x8 pa2,bf16x8 pa3){
  #pragma unroll
  for(int d0=0;d0<2;++d0){s16x4 lo[4],hi[4];
    #pragma unroll
    for(int ks=0;ks<4;++ks){
      asm volatile("ds_read_b64_tr_b16 %0,%1 offset:%c2":"=&v"(lo[ks]):"v"(vb),"i"(d0*4096+ks*1024):"memory");
      asm volatile("ds_read_b64_tr_b16 %0,%1 offset:%c2":"=&v"(hi[ks]):"v"(vb),"i"(d0*4096+ks*1024+512):"memory");}
    asm volatile("s_waitcnt lgkmcnt(0)":::"memory");SBAR();
    #define PK(k) (bf16x8){lo[k][0],lo[k][1],lo[k][2],lo[k][3],hi[k][0],hi[k][1],hi[k][2],hi[k][3]}
    o[d0]=__builtin_amdgcn_mfma_f32_32x32x16_bf16(pa0,PK(0),o[d0],0,0,0);
    o[d0]=__builtin_amdgcn_mfma_f32_32x32x16_bf16(pa1,PK(1),o[d0],0,0,0);
    o[d0]=__builtin_amdgcn_mfma_f32_32x32x16_bf16(pa2,PK(2),o[d0],0,0,0);
    o[d0]=__builtin_amdgcn_mfma_f32_32x32x16_bf16(pa3,PK(3),o[d0],0,0,0);
    #undef PK
  }
}

#ifndef ATTN_STORE16
#define ATTN_STORE16(p,v) (*(u32x4*)(p)=(v))
#endif
template<int THRL> __device__ __forceinline__ void attn_unit(int b,int h,int g,int qb,const bf16*Q,const bf16*__restrict__ K,const bf16*__restrict__ V,bf16*O,char*shm){
  const int tid=otid(),lane=tid&63,r32=lane&31,hi=lane>>5; const int wid=__builtin_amdgcn_readfirstlane(tid>>6);
  const long rowbase=(long)b*SEQ; const int q0=qb*QB;
  const bf16*Qw=Q+(rowbase+q0+wid*QBLK)*PQ+h*D;
  const bf16*Kh=K+rowbase*PQ+g*D,*Vh=V+rowbase*PQ+g*D;
  const unsigned lds0=(unsigned)(uintptr_t)shm;
  float*wsf=(float*)(shm+LDS_WS)+wid*64;
  const bf16*ksrc=Kh+(long)lane*PQ+wid*8;
  const bf16*vsrc=Vh+(long)(16*(wid&3)+(lane>>2))*PQ+(wid>>2)*32+(lane&3)*8;
  const unsigned kdst=lds0+LDS_K+wid*1024, vdst=lds0+LDS_V+wid*1024;
  #define DMA_K(t,slot) glds16(ksrc+(long)(t)*KVBLK*PQ,(unsigned)__builtin_amdgcn_readfirstlane(kdst+(slot)))
  #define DMA_V(t,slot) glds16(vsrc+(long)(t)*KVBLK*PQ,(unsigned)__builtin_amdgcn_readfirstlane(vdst+(slot)))
  const int vb0=(int)(lds0+LDS_V)+((lane>>4)&1)*32+(lane&3)*8+(4*hi+((lane&15)>>2))*64;
  const char*Kbase=shm+LDS_K; bf16x8 kf[8];
  const lds_cptr shm3=(lds_cptr)shm; const lds_cptr kp0=shm3+LDS_K+hi*1024+r32*16; const lds_cptr vp0=shm3+LDS_V+((lane>>4)&1)*32+(lane&3)*8+(4*hi+((lane&15)>>2))*64;
  constexpr int NT=SEQ/KVBLK;
  DMA_K(0,0);DMA_V(0,0);DMA_K(1,SLOTB);
  bf16x8 qr[4];
  #pragma unroll
  for(int d0=0;d0<4;++d0)qr[d0]=*reinterpret_cast<const bf16x8*>(&Qw[(long)r32*PQ+d0*16+hi*8]);
  float mhat=0.f,l_reg=0.f;f32x16 o[2];o[0]=f32x16{};o[1]=f32x16{};f32x16 negm=f32x16{};asm volatile("":"+v"(negm));
    #define CMASK(P0,P1,t) do{}while(0)
  bool resc=false;
  #define START(P0,P1) do{ const float rm=rowmax(P0,P1); resc=false; \
    { const float dl=rm; mhat=fadd_s(mhat,dl); \
      _Pragma("unroll") for(int r=0;r<16;++r){P0[r]=fsub_s(P0[r],dl);P1[r]=fsub_s(P1[r],dl);} \
      _Pragma("unroll") for(int r=0;r<16;++r)negm[r]=-mhat; asm volatile("":"+v"(negm)); } \
    _Pragma("unroll") for(int r=0;r<16;++r)P0[r]=__builtin_amdgcn_exp2f(P0[r]); }while(0)
  #define RESC() do{ if(resc){ asm volatile("s_waitcnt lgkmcnt(0)":::"memory"); \
      _Pragma("unroll") for(int d_=0;d_<2;++d_) _Pragma("unroll") for(int r=0;r<16;++r)o[d_][r]*=wsf[crow(r,hi)]; } }while(0)
  f32x16 pA0,pA1,pB0,pB1;
  int sl_prev=0,sl_cur=0,sl_next=SLOTB;
  #define ROT() do{sl_prev=sl_cur;sl_cur=sl_next;sl_next=(sl_next==(NSLOT-1)*SLOTB)?0:sl_next+SLOTB;}while(0)
  DMA_K(2,2*SLOTB);
  WAIT_BAR(3);
  qkt(pA0,pA1,Kbase,qr,negm,r32,hi);asm volatile("s_nop 15\n\ts_nop 7":"+v"(pA0),"+v"(pA1));CMASK(pA0,pA1,0);
  START(pA0,pA1);
  _Pragma("unroll") for(int r=0;r<16;++r)pA1[r]=__builtin_amdgcn_exp2f(pA1[r]);
  WAIT_BAR(0);
  DMA_K(3,0);DMA_V(1,SLOTB);
  ROT();
  kload8(kf,kp0+sl_cur);
  WAIT_BAR(2);
  s16x4 vlo[8],vhi[8]; u32x4 pw0,pw1,pw2,pw3;
  #define PKW(P,B) cvtpk_s(P[B],P[B+1])
  #define PAF(k) __builtin_bit_cast(bf16x8,pw##k)
  #define VFR(i) (bf16x8){vlo[i][0],vlo[i][1],vlo[i][2],vlo[i][3],vhi[i][0],vhi[i][1],vhi[i][2],vhi[i][3]}
  #define PIN(x) asm volatile("":"+v"(x))
  #define MX3(a,b,c) __builtin_fmaxf(__builtin_fmaxf((a),(b)),(c))
  #define GAPA(MF,A0,A1,A2,A3,W0,W1,PW) do{ MF; sacc+=A0; sacc+=A1; sacc+=A2; sacc+=A3; PIN(sacc); W0; W1; PIN(PW); SBAR(); }while(0)
  #define EX(v) __builtin_amdgcn_exp2f(v)
  #define GAPB(MF,X,B) do{ MF; X[B]=EX(X[B]); X[B+1]=EX(X[B+1]); X[B+2]=EX(X[B+2]); X[B+3]=EX(X[B+3]); PIN(X); SBAR(); }while(0)
  #define VRD(i) do{ vlo[i]=vtr(vp_+(((i)>>2)*4096+((i)&3)*1024)); vhi[i]=vtr(vp_+(((i)>>2)*4096+((i)&3)*1024+512)); }while(0)
  #define KRD(G,j) do{ if(G){ kload2(kf,kp0+sl_next,j); SBAR(); } }while(0)
  #define STEP(C0,C1,P0,P1,t,GK,GV,GL) do{ SBAR(); \
    const lds_cptr vp_=vp0+sl_prev; \
    VRD(0); SBAR(); float sacc=(P0[0]+P0[1]); \
    GAPA(C0=__builtin_amdgcn_mfma_f32_32x32x16_bf16(kf[0],qr[0],negm,0,0,0), P0[2],P0[3],P0[4],P0[5],     pw0[0]=PKW(P0,0), pw0[1]=PKW(P0,2), pw0); \
    VRD(4); SBAR(); GAPA(C1=__builtin_amdgcn_mfma_f32_32x32x16_bf16(kf[1],qr[0],negm,0,0,0), P0[6],P0[7],P0[8],P0[9],     pw0[2]=PKW(P0,4), pw0[3]=PKW(P0,6), pw0); \
    VRD(1); SBAR(); GAPA(C0=__builtin_amdgcn_mfma_f32_32x32x16_bf16(kf[2],qr[1],C0,0,0,0),   P0[10],P0[11],P0[12],P0[13], pw1[0]=PKW(P0,8), pw1[1]=PKW(P0,10), pw1); \
    VRD(5); SBAR(); GAPA(C1=__builtin_amdgcn_mfma_f32_32x32x16_bf16(kf[3],qr[1],C1,0,0,0),   P0[14],P0[15],P1[0],P1[1],   pw1[2]=PKW(P0,12),pw1[3]=PKW(P0,14), pw1); \
    VRD(2); SBAR(); GAPA(C0=__builtin_amdgcn_mfma_f32_32x32x16_bf16(kf[4],qr[2],C0,0,0,0),   P1[2],P1[3],P1[4],P1[5],     pw2[0]=PKW(P1,0), pw2[1]=PKW(P1,2), pw2); \
    VRD(6); SBAR(); GAPA(C1=__builtin_amdgcn_mfma_f32_32x32x16_bf16(kf[5],qr[2],C1,0,0,0),   P1[6],P1[7],P1[8],P1[9],     pw2[2]=PKW(P1,4), pw2[3]=PKW(P1,6), pw2); \
    VRD(3); SBAR(); GAPA(C0=__builtin_amdgcn_mfma_f32_32x32x16_bf16(kf[6],qr[3],C0,0,0,0),   P1[10],P1[11],P1[12],P1[13], pw3[0]=PKW(P1,8), pw3[1]=PKW(P1,10), pw3); \
    VRD(7); SBAR(); GAPA(C1=__builtin_amdgcn_mfma_f32_32x32x16_bf16(kf[7],qr[3],C1,0,0,0),   P1[14],P1[15],0.f,0.f,       pw3[2]=PKW(P1,12),pw3[3]=PKW(P1,14), pw3); \
    l_reg+=sacc; \
    if(GK){DMA_K((t)+3,sl_cur);} if(GV){DMA_V((t)+1,sl_next);} \
    CMASK(C0,C1,t); \
    { float a=MX3(C0[0],C0[1],C1[0]),b=MX3(C0[2],C0[3],C1[1]); a=MX3(a,C1[2],C1[3]); \
      _Pragma("unroll") for(int r=4;r<16;r+=4){a=MX3(a,C0[r],C0[r+1]);b=MX3(b,C0[r+2],C0[r+3]);a=MX3(a,C1[r],C1[r+1]);b=MX3(b,C1[r+2],C1[r+3]);} \
      float rm=__builtin_fmaxf(a,b); { auto rr=__builtin_amdgcn_permlane32_swap(__float_as_uint(rm),__float_as_uint(rm),false,false); rm=__builtin_fmaxf(__uint_as_float(rr[0]),__uint_as_float(rr[1])); } \
      resc=false; \
      if(__builtin_expect(__any(rm>(float)THRL),0)){ const float dl=__builtin_fmaxf(rm,0.f); mhat+=dl; \
        _Pragma("unroll") for(int r=0;r<16;++r){C0[r]-=dl;C1[r]-=dl;} \
        _Pragma("unroll") for(int r=0;r<16;++r)negm[r]=-mhat; asm volatile("":"+v"(negm)); \
        const float f=__builtin_amdgcn_exp2f(-dl); l_reg*=f; if(hi==0)wsf[r32]=f; resc=true; } } \
    SBAR(); \
    GAPB(o[0]=__builtin_amdgcn_mfma_f32_32x32x16_bf16(PAF(0),VFR(0),o[0],0,0,0), C0,0); \
    GAPB(o[1]=__builtin_amdgcn_mfma_f32_32x32x16_bf16(PAF(0),VFR(4),o[1],0,0,0), C0,4); \
    KRD(GL,0); GAPB(o[0]=__builtin_amdgcn_mfma_f32_32x32x16_bf16(PAF(1),VFR(1),o[0],0,0,0), C0,8); \
    KRD(GL,1); GAPB(o[1]=__builtin_amdgcn_mfma_f32_32x32x16_bf16(PAF(1),VFR(5),o[1],0,0,0), C0,12); \
    KRD(GL,2); GAPB(o[0]=__builtin_amdgcn_mfma_f32_32x32x16_bf16(PAF(2),VFR(2),o[0],0,0,0), C1,0); \
    KRD(GL,3); GAPB(o[1]=__builtin_amdgcn_mfma_f32_32x32x16_bf16(PAF(2),VFR(6),o[1],0,0,0), C1,4); \
    GAPB(o[0]=__builtin_amdgcn_mfma_f32_32x32x16_bf16(PAF(3),VFR(3),o[0],0,0,0), C1,8); \
    GAPB(o[1]=__builtin_amdgcn_mfma_f32_32x32x16_bf16(PAF(3),VFR(7),o[1],0,0,0), C1,12); \
    }while(0)
  int t=1;
  #undef CMASK
  #define CMASK(P0,P1,t) do{}while(0)
  for(;t+5<NT;t+=2){
    STEP(pB0,pB1,pA0,pA1,t,true,true,true);     WAIT_BAR(2); RESC(); ROT();
    STEP(pA0,pA1,pB0,pB1,t+1,true,true,true);   WAIT_BAR(2); RESC(); ROT();
  }
  #define ENDW(tt) do{ if((tt)+3<NT){WAIT_BAR(2);} else if((tt)+2<NT){WAIT_BAR(1);} else {WAIT_BAR(0);} }while(0)
  for(;t+1<NT;t+=2){
    STEP(pB0,pB1,pA0,pA1,t,(t+3<NT),(t+1<NT),(t+1<NT));       ENDW(t);   RESC(); ROT();
    STEP(pA0,pA1,pB0,pB1,t+1,(t+4<NT),(t+2<NT),(t+2<NT));     ENDW(t+1); RESC(); ROT();
  }
  STEP(pB0,pB1,pA0,pA1,NT-1,false,false,false); RESC();
  { float sacc=pB0[0]+pB0[1]; _Pragma("unroll") for(int r=2;r<16;++r)sacc+=pB0[r]; _Pragma("unroll") for(int r=0;r<16;++r)sacc+=pB1[r]; l_reg+=sacc;
    pw0=(u32x4){PKW(pB0,0),PKW(pB0,2),PKW(pB0,4),PKW(pB0,6)};pw1=(u32x4){PKW(pB0,8),PKW(pB0,10),PKW(pB0,12),PKW(pB0,14)};pw2=(u32x4){PKW(pB1,0),PKW(pB1,2),PKW(pB1,4),PKW(pB1,6)};pw3=(u32x4){PKW(pB1,8),PKW(pB1,10),PKW(pB1,12),PKW(pB1,14)};
    SBAR(); pv(o,vb0+sl_cur,PAF(0),PAF(1),PAF(2),PAF(3)); }
  #undef PKW
  #undef PAF
  #undef VFR
  #undef PIN
  #undef MX3
  #undef GAPA
  #undef GAPB
  #undef EX
  #undef VRD
  #undef KRD
  #undef STEP
  #undef ENDW
  {auto rr=__builtin_amdgcn_permlane32_swap(__float_as_uint(l_reg),__float_as_uint(l_reg),false,false);l_reg=__uint_as_float(rr[0])+__uint_as_float(rr[1]);}
  if(hi==0)wsf[32+r32]=l_reg;asm volatile("s_waitcnt lgkmcnt(0)":::"memory");
  float rli[16];
  #pragma unroll
  for(int r=0;r<16;++r)rli[r]=__builtin_amdgcn_rcpf(wsf[32+crow(r,hi)]);
  bf16*Ow=O+(rowbase+q0+wid*QBLK)*PO+h*D;
  { bf16*stg=(bf16*)(shm+LDS_OST)+wid*2048;
    #pragma unroll
    for(int r=0;r<16;++r){const int orow=crow(r,hi);
      #pragma unroll
      for(int d0=0;d0<2;++d0)stg[orow*64+d0*32+r32]=__float2bfloat16(o[d0][r]*rli[r]);}
    asm volatile("s_waitcnt lgkmcnt(0)":::"memory");
    #pragma unroll
    for(int i=0;i<4;++i){const int row=i*8+(lane>>3),ch=lane&7; const u32x4 v=*(const u32x4*)(stg+row*64+ch*8); ATTN_STORE16(Ow+(long)row*PO+ch*8,v);} }
  asm volatile("s_waitcnt lgkmcnt(0)\n\ts_barrier":::"memory");
  #undef DMA_K
  #undef DMA_V
  #undef CMASK
  #undef START
  #undef RESC
  #undef ROT
}
constexpr int ATTN_LDS_BYTES=LDS_BYTES;
#undef SBAR
#undef WAIT_BAR
}

__device__ __forceinline__ void phase_attn(const Params& p, char* lds) {
            {
                const int bid = obid();
                const int vcu = ((gridDim.x & 7) == 0) ? (bid & 7) * (int)(gridDim.x >> 3) + (bid >> 3) : bid;
                const attn_body::bf16* qkvb = (const attn_body::bf16*)(p.ws + R_QKV);
                for (int u = vcu; u < 512; u += gridDim.x) {
                    const int bg = (u & 255) >> 6, r = u & 63, hh = r & 3, qb = (r >> 2) + 16 * (u >> 8);
                    const int b = bg >> 1, g = bg & 1;
                    attn_body::attn_unit<8>(b, 4 * g + hh, g, qb, qkvb, qkvb + 512, qkvb + 640, (attn_body::bf16*)(p.ws + R_ATT), lds);
                }
            }
}

__device__ __forceinline__ float convd(const float* row, int l, float w0, float w1, float w2, float cb) {
    float v = cb + w1 * row[l];
    if (l > 0) v += w0 * row[l - 1];
    if (l < SL - 1) v += w2 * row[l + 1];
    return v;
}
__device__ __forceinline__ void hyena_job(const Params& p, int layer, int c, char* lds) {
    const int tid = otid();
    float2* Z = (float2*)lds;
    const float* HF = (const float*)(p.ws + R_HF);
    const float* cw = p.in[I_CW] + (size_t)layer * 3 * 768; const float* cbp = p.in[I_CB] + layer * 768;
    const float2* KF0 = (const float2*)(p.ws + OFF_KF) + ((size_t)(layer * 256 + c) * 2) * 16384;
    const float2* KF1 = KF0 + 16384;
    float* Y = (float*)(p.ws + R_Y) + (size_t)c * T;
    const float bias0 = p.in[I_HB][(layer * 2 + 0) * 256 + c], bias1 = p.in[I_HB][(layer * 2 + 1) * 256 + c];
    const int cv = c, c1 = 256 + c, c2 = 512 + c;
    const float* rv = HF + (size_t)cv * T; const float* r1 = HF + (size_t)c1 * T; const float* r2 = HF + (size_t)c2 * T;
    const float v_w0 = cw[cv], v_w1 = cw[768 + cv], v_w2 = cw[1536 + cv], v_cb = cbp[cv];
    const float a_w0 = cw[c1], a_w1 = cw[768 + c1], a_w2 = cw[1536 + c1], a_cb = cbp[c1];
    const float b_w0 = cw[c2], b_w1 = cw[768 + c2], b_w2 = cw[1536 + c2], b_cb = cbp[c2];
    __syncthreads();
#pragma unroll 4
    for (int i = 0; i < 16; ++i) {
        const int l = tid + NTHR * i;
        Z[l] = make_float2(convd(rv, l, v_w0, v_w1, v_w2, v_cb), convd(rv + SL, l, v_w0, v_w1, v_w2, v_cb));
        Z[8192 + l] = make_float2(0.f, 0.f);
    }
    __syncthreads();
    fft_fwd<14, false>(Z);
#pragma unroll 4
    for (int i = 0; i < 32; ++i) { const int pp = tid + NTHR * i; const float2 z = Z[pp], k = KF0[pp]; Z[pp] = make_float2(z.x * k.x - z.y * k.y, z.x * k.y + z.y * k.x); }
    __syncthreads();
    fft_inv<14, false>(Z);
#pragma unroll 2
    for (int i = 0; i < 16; ++i) {
        const int l = tid + NTHR * i;
        const float2 cvz = Z[l];
        const float v0 = convd(rv, l, v_w0, v_w1, v_w2, v_cb), v1 = convd(rv + SL, l, v_w0, v_w1, v_w2, v_cb);
        const float g0 = convd(r1, l, a_w0, a_w1, a_w2, a_cb), g1 = convd(r1 + SL, l, a_w0, a_w1, a_w2, a_cb);
        const float za = g0 * (cvz.x + v0 * bias0), zb = g1 * (cvz.y + v1 * bias0);
        Y[l] = za; Y[SL + l] = zb;
        Z[l] = make_float2(za, zb);
    }
#pragma unroll 4
    for (int i = 0; i < 16; ++i) { const int l = tid + NTHR * i; Z[8192 + l] = make_float2(0.f, 0.f); }
    __syncthreads();
    fft_fwd<14, false>(Z);
#pragma unroll 4
    for (int i = 0; i < 32; ++i) { const int pp = tid + NTHR * i; const float2 z = Z[pp], k = KF1[pp]; Z[pp] = make_float2(z.x * k.x - z.y * k.y, z.x * k.y + z.y * k.x); }
    __syncthreads();
    fft_inv<14, false>(Z);
#pragma unroll 2
    for (int i = 0; i < 16; ++i) {
        const int l = tid + NTHR * i;
        const float2 cvz = Z[l];
        const float g0 = convd(r2, l, b_w0, b_w1, b_w2, b_cb), g1 = convd(r2 + SL, l, b_w0, b_w1, b_w2, b_cb);
        const float za = Y[l], zb = Y[SL + l];
        Y[l] = g0 * (cvz.x + za * bias1);
        Y[SL + l] = g1 * (cvz.y + zb * bias1);
    }
    __syncthreads();
}

__device__ __forceinline__ void fnet_job(const Params& p, int ch, char* lds) {
    const int tid = otid();
    float2* Z = (float2*)lds;
    const float* row = (const float*)(p.ws + R_HF) + (size_t)(768 + ch) * T;
    float* UR = (float*)(p.ws + R_UR) + (size_t)ch * T;
    float* UI = (float*)(p.ws + R_UI) + (size_t)ch * T;
    __syncthreads();
#pragma unroll 4
    for (int i = 0; i < 16; ++i) { const int l = tid + NTHR * i; Z[zi<true>(l)] = make_float2(row[l], row[SL + l]); }
    __syncthreads();
    fft_fwd<13, true>(Z);
#pragma unroll 4
    for (int i = 0; i < 16; ++i) {
        const int k = tid + NTHR * i;
        const int pk = (int)(__brev((unsigned)k) >> 19);
        const int km = (SL - k) & (SL - 1);
        const int pm = (int)(__brev((unsigned)km) >> 19);
        const float2 zk = Z[zi<true>(pk)], zm = Z[zi<true>(pm)];
        UR[k] = 0.5f * (zk.x + zm.x); UI[k] = 0.5f * (zk.y - zm.y);
        UR[SL + k] = 0.5f * (zk.y + zm.y); UI[SL + k] = 0.5f * (zm.x - zk.x);
    }
    __syncthreads();
}

__device__ __forceinline__ void phase_mix(const Params& p, int layer, char* lds) {
    const int tid = otid(), lane = tid & 63, wave = tid >> 6;
    float* Ul = (float*)lds;
    float* Yl = Ul + 2 * 256 * 33;
    float* Fl = Yl + 256 * 33;
    const float* UR = (const float*)(p.ws + R_UR); const float* UI = (const float*)(p.ws + R_UI);
    const float* Y = (const float*)(p.ws + R_Y);
    const bf16_t* att = (const bf16_t*)(p.ws + R_ATT);
    bf16_t* mix = (bf16_t*)(p.ws + R_MIX);
    const float* FM = (const float*)(p.ws + OFF_FM) + (size_t)layer * 4 * 128 * 64;
    const float* fb = p.in[I_FB] + layer * 256;
    const float* mg = p.in[I_MG] + layer * 1024;
    for (int tile = obid(); tile < T / 32; tile += gridDim.x) {
        const int t0 = tile * 32;
        __syncthreads();
        for (int i = tid; i < 256 * 32; i += NTHR) {
            const int c = i >> 5, tt = i & 31;
            Ul[c * 33 + tt] = UR[(size_t)c * T + t0 + tt];
            Ul[(256 + c) * 33 + tt] = UI[(size_t)c * T + t0 + tt];
            Yl[c * 33 + tt] = Y[(size_t)c * T + t0 + tt];
        }
        __syncthreads();
        {
            const int tok = tid & 31, eo = tid >> 5, g = eo >> 2, e0 = (eo & 3) * 16;
            float acc[16];
#pragma unroll
            for (int j = 0; j < 16; ++j) acc[j] = fb[g * 64 + e0 + j];
            const float* Mg = FM + (size_t)g * 128 * 64 + e0;
            for (int dd = 0; dd < 128; ++dd) {
                const float u = Ul[((dd >> 6) * 256 + g * 64 + (dd & 63)) * 33 + tok];
                const f32x4* mr = (const f32x4*)(Mg + dd * 64);
#pragma unroll
                for (int j4 = 0; j4 < 4; ++j4) { const f32x4 mv = mr[j4]; acc[4 * j4] += u * mv.x; acc[4 * j4 + 1] += u * mv.y; acc[4 * j4 + 2] += u * mv.z; acc[4 * j4 + 3] += u * mv.w; }
            }
#pragma unroll
            for (int j = 0; j < 16; ++j) Fl[tok * 257 + g * 64 + e0 + j] = acc[j];
        }
        __syncthreads();
#pragma unroll
        for (int tt = 0; tt < 4; ++tt) {
            const int tok = wave * 4 + tt; const size_t t = (size_t)(t0 + tok);
            {
                const u32x4 v = *(const u32x4*)(att + t * 512 + lane * 8);
                float x[8] = {bflo(v.x), bfhi(v.x), bflo(v.y), bfhi(v.y), bflo(v.z), bfhi(v.z), bflo(v.w), bfhi(v.w)};
                float ss = 0.f;
#pragma unroll
                for (int j = 0; j < 8; ++j) ss += x[j] * x[j];
                ss = wave_sum(ss);
                const float r = rsqrtf(ss * (1.0f / 512.0f) + EPS);
                const f32x4 g0 = *(const f32x4*)(mg + lane * 8), g1 = *(const f32x4*)(mg + lane * 8 + 4);
                u32x4 o; o.x = pk2(x[0] * r * g0.x, x[1] * r * g0.y); o.y = pk2(x[2] * r * g0.z, x[3] * r * g0.w); o.z = pk2(x[4] * r * g1.x, x[5] * r * g1.y); o.w = pk2(x[6] * r * g1.z, x[7] * r * g1.w);
                *(u32x4*)(mix + t * 1024 + lane * 8) = o;
            }
            {
                float y[4], f[4]; float sy = 0.f, sf = 0.f;
#pragma unroll
                for (int i = 0; i < 4; ++i) { y[i] = Yl[(lane + 64 * i) * 33 + tok]; f[i] = Fl[tok * 257 + lane + 64 * i]; sy += y[i] * y[i]; sf += f[i] * f[i]; }
                sy = wave_sum(sy); sf = wave_sum(sf);
                const float ry = rsqrtf(sy * (1.0f / 256.0f) + EPS), rf = rsqrtf(sf * (1.0f / 256.0f) + EPS);
#pragma unroll
                for (int i = 0; i < 4; ++i) {
                    mix[t * 1024 + 512 + lane + 64 * i] = (bf16_t)f2bf(y[i] * ry * mg[512 + lane + 64 * i]);
                    mix[t * 1024 + 768 + lane + 64 * i] = (bf16_t)f2bf(f[i] * rf * mg[768 + lane + 64 * i]);
                }
            }
        }
    }
}

#define TK_INS(L, X) do { float x_ = (X); _Pragma("unroll") for (int i_ = 0; i_ < 16; ++i_) { const float hi_ = fmaxf(L[i_], x_); x_ = fminf(L[i_], x_); L[i_] = hi_; } } while (0)
__device__ __forceinline__ float tk_pack(float v, unsigned code, unsigned mask) { return __builtin_bit_cast(float, (__builtin_bit_cast(unsigned, v) & ~mask) | code); }
__device__ __forceinline__ unsigned tk_lookup(const unsigned (&P)[4], unsigned i) {
    const unsigned w = (i < 4u) ? P[0] : (i < 8u) ? P[1] : (i < 12u) ? P[2] : P[3];
    return (w >> ((i & 3u) * 8u)) & 0x7Fu;
}
__device__ __forceinline__ void phase_peer_topk(const Params& p, int layer, char* lds, int* IDX, float* GATE) {
    const int tid = otid(), lane = tid & 63, wave = tid >> 6;
    const float* SC = (const float*)(p.ws + R_QP);
    const float NINF = -3.0e38f;
    const int pp = lane & 1;
    const int gw = obid() * NWAVE + wave, ngw = gridDim.x * NWAVE;
    for (int grp = gw; grp < T * 8 / 32; grp += ngw) {
        const int prob = grp * 32 + (lane >> 1);
        const int t = prob >> 3, h = prob & 7;
        const f32x4* src = (const f32x4*)(SC + (size_t)t * 2048 + h * 256 + pp * 128);
        float l[16];
#pragma unroll
        for (int i = 0; i < 16; ++i) l[i] = NINF;
#pragma unroll 1
        for (int c = 0; c < 4; ++c) {
            f32x4 v[8];
#pragma unroll
            for (int j = 0; j < 8; ++j) v[j] = src[c * 8 + j];
#pragma unroll
            for (int j = 0; j < 8; ++j) {
                const unsigned kb = (unsigned)(c * 32 + j * 4);
                TK_INS(l, tk_pack(v[j].x, kb, 0x7Fu)); TK_INS(l, tk_pack(v[j].y, kb + 1u, 0x7Fu));
                TK_INS(l, tk_pack(v[j].z, kb + 2u, 0x7Fu)); TK_INS(l, tk_pack(v[j].w, kb + 3u, 0x7Fu));
            }
        }
        float xv[16], ov[16]; unsigned PX[4] = {0u, 0u, 0u, 0u}, PO[4] = {0u, 0u, 0u, 0u};
#pragma unroll
        for (int i = 0; i < 16; ++i) {
            const float o = __shfl_xor(l[i], 1);
            const unsigned xb = __builtin_bit_cast(unsigned, l[i]), ob = __builtin_bit_cast(unsigned, o);
            xv[i] = __builtin_bit_cast(float, xb & ~0x7Fu); ov[i] = __builtin_bit_cast(float, ob & ~0x7Fu);
            PX[i >> 2] |= (xb & 0x7Fu) << ((i & 3) * 8); PO[i >> 2] |= (ob & 0x7Fu) << ((i & 3) * 8);
        }
        float f[16];
#pragma unroll
        for (int i = 0; i < 16; ++i) f[i] = NINF;
#pragma unroll
        for (int i = 0; i < 16; ++i)
#pragma unroll
            for (int j = i; j < 16; ++j)
                if ((i + 1) * (j + 1) <= 16) {
                    float cv = xv[i] + ov[j];
                    const unsigned code = pp ? (unsigned)((j << 4) | i) : (unsigned)((i << 4) | j);
                    cv = tk_pack(cv, code, 0xFFu);
                    if (i == j) cv = pp ? NINF : cv;
                    TK_INS(f, cv);
                }
        {
            float g[16];
#pragma unroll
            for (int i = 0; i < 16; ++i) g[i] = __shfl_xor(f[i], 1);
#pragma unroll
            for (int i = 0; i < 16; ++i) TK_INS(f, g[i]);
        }
        unsigned P0[4], P1[4];
#pragma unroll
        for (int q = 0; q < 4; ++q) { P0[q] = pp ? PO[q] : PX[q]; P1[q] = pp ? PX[q] : PO[q]; }
        const float top = __builtin_bit_cast(float, __builtin_bit_cast(unsigned, f[0]) & ~0xFFu);
        float ev[16]; int ei[16]; float den = 0.f;
#pragma unroll
        for (int r = 0; r < 16; ++r) {
            const unsigned fb = __builtin_bit_cast(unsigned, f[r]);
            const unsigned code = fb & 0xFFu;
            ei[r] = (int)(tk_lookup(P0, code >> 4) * 128u + tk_lookup(P1, code & 15u));
            ev[r] = __expf(__builtin_bit_cast(float, fb & ~0xFFu) - top);
            den += ev[r];
        }
        const float rden = 1.0f / den;
        const size_t ob = (size_t)t * 128 + h * 16;
        if (pp == 0) {
#pragma unroll
            for (int q = 0; q < 4; ++q) { int4 w; w.x = ei[4 * q]; w.y = ei[4 * q + 1]; w.z = ei[4 * q + 2]; w.w = ei[4 * q + 3]; *(int4*)(IDX + ob + 4 * q) = w; }
        } else {
#pragma unroll
            for (int q = 0; q < 4; ++q) { f32x4 w; w.x = ev[4 * q] * rden; w.y = ev[4 * q + 1] * rden; w.z = ev[4 * q + 2] * rden; w.w = ev[4 * q + 3] * rden; *(f32x4*)(GATE + ob + 4 * q) = w; }
        }
    }
}

__device__ __forceinline__ float gelu_exact(float x) { return 0.5f * x * (1.0f + erff(x * 0.70710678118654752f)); }
__device__ __forceinline__ void phase_peer_gather(const Params& p, int layer, const int* IDX, const float* GATE, float* XO) {
    const int lane = otid() & 63, wave = otid() >> 6;
    const int gw = obid() * NWAVE + wave, ngw = gridDim.x * NWAVE;
    const bf16_t* PU = (const bf16_t*)(p.ws + OFF_PU) + (size_t)layer * 16384 * 1024;
    const bf16_t* PV = (const bf16_t*)(p.ws + OFF_PV) + (size_t)layer * 16384 * 1024;
    const bf16_t* XN = (const bf16_t*)(p.ws + R_XN);
    float* XA = (float*)(p.ws + OFF_XA);
    for (int t = gw; t < T; t += ngw) {
        float xv[16];
        {
            const u32x4 a = *(const u32x4*)(XN + (size_t)t * DM + lane * 8), b = *(const u32x4*)(XN + (size_t)t * DM + 512 + lane * 8);
            xv[0] = bflo(a.x); xv[1] = bfhi(a.x); xv[2] = bflo(a.y); xv[3] = bfhi(a.y); xv[4] = bflo(a.z); xv[5] = bfhi(a.z); xv[6] = bflo(a.w); xv[7] = bfhi(a.w);
            xv[8] = bflo(b.x); xv[9] = bfhi(b.x); xv[10] = bflo(b.y); xv[11] = bfhi(b.y); xv[12] = bflo(b.z); xv[13] = bfhi(b.z); xv[14] = bflo(b.w); xv[15] = bfhi(b.w);
        }
        float acc[16];
#pragma unroll
        for (int j = 0; j < 16; ++j) acc[j] = 0.f;
        for (int half = 0; half < 2; ++half) {
            const int myi = IDX[(size_t)t * 128 + half * 64 + lane];
            const float myg = GATE[(size_t)t * 128 + half * 64 + lane];
            for (int e0 = 0; e0 < 64; e0 += 4) {
                int ei[4]; float eg[4];
#pragma unroll
                for (int k = 0; k < 4; ++k) { ei[k] = __shfl(myi, e0 + k); eg[k] = __shfl(myg, e0 + k); }
                u32x4 ua[4], ub[4];
#pragma unroll
                for (int k = 0; k < 4; ++k) { const bf16_t* r = PU + (size_t)ei[k] * DM + lane * 8; ua[k] = *(const u32x4*)r; ub[k] = *(const u32x4*)(r + 512); }
                u32x4 va[4], vb[4];
#pragma unroll
                for (int k = 0; k < 4; ++k) { const bf16_t* r = PV + (size_t)ei[k] * DM + lane * 8; va[k] = *(const u32x4*)r; vb[k] = *(const u32x4*)(r + 512); }
                float ds[4];
#pragma unroll
                for (int k = 0; k < 4; ++k) {
                    float d = bflo(ua[k].x) * xv[0] + bfhi(ua[k].x) * xv[1] + bflo(ua[k].y) * xv[2] + bfhi(ua[k].y) * xv[3]
                            + bflo(ua[k].z) * xv[4] + bfhi(ua[k].z) * xv[5] + bflo(ua[k].w) * xv[6] + bfhi(ua[k].w) * xv[7]
                            + bflo(ub[k].x) * xv[8] + bfhi(ub[k].x) * xv[9] + bflo(ub[k].y) * xv[10] + bfhi(ub[k].y) * xv[11]
                            + bflo(ub[k].z) * xv[12] + bfhi(ub[k].z) * xv[13] + bflo(ub[k].w) * xv[14] + bfhi(ub[k].w) * xv[15];
                    ds[k] = wave_sum(d);
                }
#pragma unroll
                for (int k = 0; k < 4; ++k) {
                    const float a = gelu_exact(ds[k]) * eg[k];
                    acc[0] += a * bflo(va[k].x); acc[1] += a * bfhi(va[k].x); acc[2] += a * bflo(va[k].y); acc[3] += a * bfhi(va[k].y);
                    acc[4] += a * bflo(va[k].z); acc[5] += a * bfhi(va[k].z); acc[6] += a * bflo(va[k].w); acc[7] += a * bfhi(va[k].w);
                    acc[8] += a * bflo(vb[k].x); acc[9] += a * bfhi(vb[k].x); acc[10] += a * bflo(vb[k].y); acc[11] += a * bfhi(vb[k].y);
                    acc[12] += a * bflo(vb[k].z); acc[13] += a * bfhi(vb[k].z); acc[14] += a * bflo(vb[k].w); acc[15] += a * bfhi(vb[k].w);
                }
            }
        }
        f32x4* xr = (f32x4*)(XA + (size_t)t * DM + lane * 8);
        f32x4* xo = (f32x4*)(XO + (size_t)t * DM + lane * 8);
        f32x4 x0 = xr[0], x1 = xr[1], x2 = xr[128], x3 = xr[129];
        x0.x += acc[0]; x0.y += acc[1]; x0.z += acc[2]; x0.w += acc[3]; x1.x += acc[4]; x1.y += acc[5]; x1.z += acc[6]; x1.w += acc[7];
        x2.x += acc[8]; x2.y += acc[9]; x2.z += acc[10]; x2.w += acc[11]; x3.x += acc[12]; x3.y += acc[13]; x3.z += acc[14]; x3.w += acc[15];
        xo[0] = x0; xo[1] = x1; xo[128] = x2; xo[129] = x3;
    }
}


#define LAS __attribute__((address_space(3)))
#define XB_TMO      128
#define XB_XCNT(j)  (256  + 64 * (j))
#define XB_XSUB(j)  (1280 + 64 * (j))
#define XB_XGEN(j)  (2304 + 64 * (j))
#define XB_TOP      3328
#define XB_TOPGEN   3392
#define XCD_BAR_WORDS 3456
#define XB_SPIN_CAP (1u << 20)
__device__ __forceinline__ unsigned xb_ld(unsigned* p)              { return __hip_atomic_load(p, __ATOMIC_RELAXED, __HIP_MEMORY_SCOPE_AGENT); }
__device__ __forceinline__ unsigned xb_add(unsigned* p, unsigned v) { return __hip_atomic_fetch_add(p, v, __ATOMIC_RELAXED, __HIP_MEMORY_SCOPE_AGENT); }
__device__ __forceinline__ unsigned xb_xcc_id() { return (unsigned)__builtin_amdgcn_s_getreg((3 << 11) | 20) & 0xFu; }
#define XB_SPIN(cond, bar) do { unsigned _sp = 0; while (cond) { __builtin_amdgcn_s_sleep(1); \
    if ((++_sp & 255u) == 0u) { if (xb_ld(&(bar)[XB_TMO])) break; if (_sp > XB_SPIN_CAP) { atomicAdd(&(bar)[XB_TMO], 1u); break; } } } } while (0)
struct XcdBarrier { unsigned* bar; unsigned x; volatile LAS unsigned* st; };
__device__ __forceinline__ XcdBarrier xcd_barrier_post(unsigned* bar, volatile LAS unsigned* st) {
    XcdBarrier b; b.bar = bar; b.x = xb_xcc_id(); b.st = st;
    if (threadIdx.x == 0) (void)xb_add(&bar[XB_XCNT(b.x)], 1u);
    return b;
}
__device__ __forceinline__ void xcd_barrier_complete(unsigned* bar, unsigned x, unsigned& nloc, unsigned& nx) {
    const unsigned G = gridDim.x * gridDim.y * gridDim.z;
    unsigned sum, cnt, mine, sp = 0u;
    for (;;) {
        sum = 0u; cnt = 0u; mine = 0u;
#pragma unroll
        for (unsigned j = 0; j < 16; ++j) { const unsigned c = xb_ld(&bar[XB_XCNT(j)]); sum += c; cnt += (c > 0u) ? 1u : 0u; mine = (j == x) ? c : mine; }
        if (sum == G) break;
        __builtin_amdgcn_s_sleep(1);
        if ((++sp & 255u) == 0u) { if (xb_ld(&bar[XB_TMO])) break; if (sp > XB_SPIN_CAP) { atomicAdd(&bar[XB_TMO], 1u); break; } }
    }
    nloc = mine > 0u ? mine : 1u; nx = cnt > 0u ? cnt : 1u;
}
__device__ __forceinline__ void xcd_barrier(const XcdBarrier& b) {
    asm volatile("s_waitcnt vmcnt(0)" ::: "memory");
    __syncthreads();
    if (threadIdx.x == 0) {
        unsigned* bar = b.bar;
        __builtin_amdgcn_s_waitcnt(0);
        unsigned nloc = b.st[0], nx = b.st[1];
        if (nloc == 0u) { xcd_barrier_complete(bar, b.x, nloc, nx); b.st[0] = nloc; b.st[1] = nx; }
        const unsigned old = xb_add(&bar[XB_XSUB(b.x)], 1u);
        const unsigned gen = old / nloc;
        if (old + 1u == (gen + 1u) * nloc) {
            __builtin_amdgcn_fence(__ATOMIC_RELEASE, "agent");
            asm volatile("s_waitcnt vmcnt(0)" ::: "memory");
            const unsigned og = xb_add(&bar[XB_TOP], 1u);
            const unsigned tg = og / nx;
            if (og + 1u == (tg + 1u) * nx) xb_add(&bar[XB_TOPGEN], 1u);
            else XB_SPIN(xb_ld(&bar[XB_TOPGEN]) == tg, bar);
            __builtin_amdgcn_fence(__ATOMIC_ACQUIRE, "agent");
            xb_add(&bar[XB_XGEN(b.x)], 1u);
            asm volatile("s_waitcnt vmcnt(0)" ::: "memory");
        } else {
            XB_SPIN(xb_ld(&bar[XB_XGEN(b.x)]) == gen, bar);
            __builtin_amdgcn_fence(__ATOMIC_ACQUIRE, "agent");
            asm volatile("s_waitcnt vmcnt(0)" ::: "memory");
        }
    }
    __syncthreads();
}

constexpr int NPHASE_PRE = 2;
constexpr int NPHASE_LAYER = 10;
constexpr int NPHASE = NPHASE_PRE + NLAYER * NPHASE_LAYER + 1;

__device__ __forceinline__ void run_phase(const Params& p, int ph, char* lds) {
    float* XA = (float*)(p.ws + OFF_XA);
    int* IDX = (int*)p.out; float* GATE = p.out + (size_t)T * 128;
    if (ph == 0) { phase_p0(p, lds); return; }
    if (ph == 1) { phase_filter_spectra(p, lds); return; }
    if (ph == NPHASE - 1) { phase_final_norm(XA, p.in[I_FG], p.out); return; }
    const int layer = (ph - NPHASE_PRE) / NPHASE_LAYER, s = (ph - NPHASE_PRE) % NPHASE_LAYER;
    const float* xin = layer == 0 ? p.in[I_X] : XA;
    switch (s) {
    case 0: phase_rmsnorm_bf16(xin, p.in[I_N1G] + layer * DM, (bf16_t*)(p.ws + R_XN)); break;
    case 1: { EpiIn e{(bf16_t*)(p.ws + R_QKV), (float*)(p.ws + R_HF)};
              gemm_phase(( const bf16_t*)(p.ws + R_XN), (const bf16_t*)(p.ws + OFF_WTIN) + (size_t)layer * INC * DM, T, INC, DM, lds, e); } break;
    case 2: phase_qkprep(p, layer, lds); break;
    case 3: {
        phase_attn(p, lds);
        for (int c = obid(); c < 256; c += gridDim.x) hyena_job(p, layer, c, lds);
        for (int c = obid(); c < 256; c += gridDim.x) fnet_job(p, c, lds);
    } break;
    case 4: phase_mix(p, layer, lds); break;
    case 5: { EpiRes e{xin, XA};
              gemm_phase((const bf16_t*)(p.ws + R_MIX), (const bf16_t*)(p.ws + OFF_WTOUT) + (size_t)layer * DM * DM, T, DM, DM, lds, e); } break;
    case 6: phase_rmsnorm_bf16(XA, p.in[I_N2G] + layer * DM, (bf16_t*)(p.ws + R_XN)); break;
    case 7: { EpiF32 e{(float*)(p.ws + R_QP), 2048};
              gemm_phase((const bf16_t*)(p.ws + R_XN), (const bf16_t*)(p.ws + OFF_WTQ) + (size_t)layer * 2048 * DM, T, 2048, DM, lds, e); } break;
    case 8: phase_peer_topk(p, layer, lds, IDX, GATE); break;
    case 9: phase_peer_gather(p, layer, IDX, GATE, XA); break;
    }
}

#if ONE_LAUNCH
__global__ void __launch_bounds__(NTHR) mega_kernel(Params p) {
    extern __shared__ __attribute__((aligned(16))) char lds[];
    cg::grid_group grid = cg::this_grid();
    volatile LAS unsigned* misc = (volatile LAS unsigned*)((LAS char*)lds + LDS_MISC);
    if (threadIdx.x < 16) misc[threadIdx.x] = 0u;
    __syncthreads();
    const XcdBarrier xbar = xcd_barrier_post((unsigned*)(p.ws + OFF_CTL) + 4096, misc);
#define GSYNC() xcd_barrier(xbar)
    float* XA = (float*)(p.ws + OFF_XA);
    int* IDX = (int*)p.out; float* GATE = p.out + (size_t)T * 128;
#if PROBE == 7
    phase_p0(p, lds); GSYNC();
    phase_filter_spectra(p, lds); GSYNC();
#endif
    phase_p0(p, lds); grid.sync();
    phase_filter_spectra(p, lds); GSYNC();
#pragma nounroll
    for (int layer = 0; layer < NLAYER; ++layer) {
        const float* xin = layer == 0 ? p.in[I_X] : XA;
        phase_rmsnorm_bf16(xin, p.in[I_N1G] + layer * DM, (bf16_t*)(p.ws + R_XN)); GSYNC();
        { EpiIn e{(bf16_t*)(p.ws + R_QKV), (float*)(p.ws + R_HF)};
          gemm_phase((const bf16_t*)(p.ws + R_XN), (const bf16_t*)(p.ws + OFF_WTIN) + (size_t)layer * INC * DM, T, INC, DM, lds, e); } GSYNC();
        phase_qkprep(p, layer, lds); GSYNC();
        {
#if PROBE == 5
            phase_attn(p, lds);
#endif
#if PROBE == 6
            for (int c = obid(); c < 256; c += gridDim.x) hyena_job(p, layer, c, lds);
            for (int c = obid(); c < 256; c += gridDim.x) fnet_job(p, c, lds);
#endif
            phase_attn(p, lds);
            for (int c = obid(); c < 256; c += gridDim.x) hyena_job(p, layer, c, lds);
            for (int c = obid(); c < 256; c += gridDim.x) fnet_job(p, c, lds);
        } GSYNC();
#if PROBE == 8
        phase_mix(p, layer, lds); GSYNC();
#endif
        phase_mix(p, layer, lds); GSYNC();
        { EpiRes e{xin, XA};
          gemm_phase((const bf16_t*)(p.ws + R_MIX), (const bf16_t*)(p.ws + OFF_WTOUT) + (size_t)layer * DM * DM, T, DM, DM, lds, e); } GSYNC();
        phase_rmsnorm_bf16(XA, p.in[I_N2G] + layer * DM, (bf16_t*)(p.ws + R_XN)); GSYNC();
#if PROBE == 3
        { EpiF32 e{(float*)(p.ws + R_QP), 2048};
          gemm_phase((const bf16_t*)(p.ws + R_XN), (const bf16_t*)(p.ws + OFF_WTQ) + (size_t)layer * 2048 * DM, T, 2048, DM, lds, e); } GSYNC();
#endif
        { EpiF32 e{(float*)(p.ws + R_QP), 2048};
          gemm_phase((const bf16_t*)(p.ws + R_XN), (const bf16_t*)(p.ws + OFF_WTQ) + (size_t)layer * 2048 * DM, T, 2048, DM, lds, e); } GSYNC();
#if PROBE == 2
        phase_peer_topk(p, layer, lds, IDX, GATE); GSYNC();
#endif
        phase_peer_topk(p, layer, lds, IDX, GATE); GSYNC();
#if PROBE == 1
        phase_peer_gather(p, layer, IDX, GATE, (float*)(p.ws + R_QP)); GSYNC();
#endif
        phase_peer_gather(p, layer, IDX, GATE, XA); GSYNC();
    }
    phase_final_norm(XA, p.in[I_FG], p.out);
}
#else
__global__ void __launch_bounds__(NTHR) phase_kernel(Params p, int ph) {
    extern __shared__ __attribute__((aligned(16))) char lds[];
    run_phase(p, ph, lds);
}
#endif

extern "C" void kernel_launch(void* const* d_in, const int* in_sizes, int n_in, void* d_out, int out_size, void* d_ws, size_t ws_size, hipStream_t stream) {
    static int grid = 0;
    if (grid == 0) {
        if (n_in != 25 || out_size != T * DM || ws_size < WS_NEED) { fprintf(stderr, "kernel_launch: unexpected sizes n_in %d out %d ws %zu (need %zu)\n", n_in, out_size, ws_size, (size_t)WS_NEED); grid = -1; return; }
        int dev = 0, cus = 0;
        hipGetDevice(&dev);
        hipDeviceGetAttribute(&cus, hipDeviceAttributeMultiprocessorCount, dev);
#if ONE_LAUNCH
        hipFuncSetAttribute((const void*)mega_kernel, hipFuncAttributeMaxDynamicSharedMemorySize, LDS_BYTES);
        int per_cu = 0;
        hipOccupancyMaxActiveBlocksPerMultiprocessor(&per_cu, (const void*)mega_kernel, NTHR, LDS_BYTES);
        if (per_cu < 1) { fprintf(stderr, "kernel_launch: occupancy query says %d blocks per CU\n", per_cu); }
        grid = cus;
#else
        hipFuncSetAttribute((const void*)phase_kernel, hipFuncAttributeMaxDynamicSharedMemorySize, LDS_BYTES);
        grid = cus;
#endif
        (void)hipGetLastError();
    }
    if (grid < 0) return;
    Params p{};
    for (int i = 0; i < 25; ++i) p.in[i] = (const float*)d_in[i];
    p.out = (float*)d_out; p.ws = (unsigned char*)d_ws;
#if ONE_LAUNCH
    if (hipMemsetAsync((char*)d_ws + OFF_CTL, 0, 64 * 1024, stream) != hipSuccess) { fprintf(stderr, "kernel_launch: memset failed\n"); return; }
    void* args[] = {&p};
    hipError_t e = hipLaunchCooperativeKernel((const void*)mega_kernel, dim3(grid), dim3(NTHR), args, LDS_BYTES, stream);
    if (e != hipSuccess) fprintf(stderr, "cooperative launch failed: %s (grid %d)\n", hipGetErrorString(e), grid);
#else
    for (int ph = 0; ph < NPHASE; ++ph) hipLaunchKernelGGL(phase_kernel, dim3(grid), dim3(NTHR), LDS_BYTES, stream, p, ph);
#endif
}
```

```cpp
#include <hip/hip_runtime.h>
#include <hip/hip_cooperative_groups.h>
#include <cstdio>
#include <cstdint>
namespace cg = cooperative_groups;

#ifndef PROBE
#define PROBE 0
#endif

typedef unsigned short bf16_t;
typedef short bf16x8 __attribute__((ext_vector_type(8)));
typedef float f32x16 __attribute__((ext_vector_type(16)));
typedef float f32x4 __attribute__((ext_vector_type(4)));
typedef unsigned u32x4 __attribute__((ext_vector_type(4)));
typedef unsigned u32x2 __attribute__((ext_vector_type(2)));

constexpr int DM = 1024, NB = 2, SL = 8192, T = NB * SL, NLAYER = 2;
constexpr int INC = 1792;
constexpr int NTHR = 512, NWAVE = 8;
constexpr int LDS_BYTES = 147456;
constexpr int LDS_MISC = LDS_BYTES - 64;
constexpr float EPS = 1e-6f;

constexpr size_t MiB = 1u << 20;
constexpr size_t OFF_CTL = 0;
constexpr size_t OFF_WTIN = 1 * MiB;
constexpr size_t OFF_WTOUT = 8 * MiB;
constexpr size_t OFF_WTQ = 12 * MiB;
constexpr size_t OFF_PU = 20 * MiB;
constexpr size_t OFF_PV = 84 * MiB;
constexpr size_t OFF_PSC = 512 * 1024;
constexpr size_t OFF_H2 = 148 * MiB;
constexpr size_t OFF_FM = 152 * MiB;
constexpr size_t OFF_KF = 153 * MiB;
constexpr size_t OFF_XA = 281 * MiB;
constexpr size_t OFF_R = 345 * MiB;
constexpr size_t R_XN = OFF_R + 0 * MiB;
constexpr size_t R_UR = OFF_R + 0 * MiB;
constexpr size_t R_UI = OFF_R + 16 * MiB;
constexpr size_t R_QKV = OFF_R + 32 * MiB;
constexpr size_t R_VT = OFF_R + 56 * MiB;
constexpr size_t R_HF = OFF_R + 60 * MiB;
constexpr size_t R_MIX = OFF_R + 60 * MiB;
constexpr size_t R_ATT = OFF_R + 124 * MiB;
constexpr size_t R_Y = OFF_R + 140 * MiB;
constexpr size_t R_QP = OFF_R + 32 * MiB;
constexpr size_t WS_NEED = 505 * MiB;

struct Params {
    const float* in[25];
    float* out;
    unsigned char* ws;
};
enum { I_X = 0, I_N1G, I_WIN, I_QG, I_KG, I_CW, I_CB, I_W1, I_B1, I_F1, I_W2, I_B2, I_F2, I_W3, I_HB, I_FW, I_FB, I_MG, I_WOUT, I_N2G, I_WQ, I_SK, I_PU, I_PV, I_FG };

__device__ __forceinline__ unsigned f2bf(float f) { unsigned u = __builtin_bit_cast(unsigned, f); return (u + 0x7fffu + ((u >> 16) & 1u)) >> 16; }
__device__ __forceinline__ unsigned pk2(float lo, float hi) { return f2bf(lo) | (f2bf(hi) << 16); }
__device__ __forceinline__ float bf2f(unsigned b) { return __builtin_bit_cast(float, b << 16); }
__device__ __forceinline__ float bflo(unsigned w) { return __builtin_bit_cast(float, w << 16); }
__device__ __forceinline__ float bfhi(unsigned w) { return __builtin_bit_cast(float, w & 0xffff0000u); }
__device__ __forceinline__ float wave_sum(float v) {
#pragma unroll
    for (int o = 1; o < 64; o <<= 1) v += __shfl_xor(v, o);
    return v;
}
__device__ __forceinline__ float wave_max(float v) {
#pragma unroll
    for (int o = 1; o < 64; o <<= 1) v = fmaxf(v, __shfl_xor(v, o));
    return v;
}
__device__ __forceinline__ f32x16 mfma32(bf16x8 a, bf16x8 b, f32x16 c) { return __builtin_amdgcn_mfma_f32_32x32x16_bf16(a, b, c, 0, 0, 0); }
__device__ __forceinline__ f32x16 zero16() { return (f32x16){0.f,0.f,0.f,0.f,0.f,0.f,0.f,0.f,0.f,0.f,0.f,0.f,0.f,0.f,0.f,0.f}; }


__device__ __forceinline__ int otid() { int t = threadIdx.x; asm volatile("" : "+v"(t)); return t; }
__device__ __forceinline__ int obid() { int b = blockIdx.x; asm volatile("" : "+s"(b)); return b; }
__device__ __forceinline__ void transpose_one(const float* W, int K, int N, bf16_t* Wt, float* tile, int item) {
    const int tid = otid();
    const int nblk = N / 64, kb = item / nblk, nb = item % nblk, k0 = kb * 64, n0 = nb * 64;
    __syncthreads();
    {
        const int r = tid >> 6, c = tid & 63;
#pragma unroll
        for (int i = 0; i < 8; ++i) { const int k = r + 8 * i; tile[k * 65 + c] = W[(size_t)(k0 + k) * N + n0 + c]; }
    }
    __syncthreads();
    {
        const int nn = tid >> 3, kc = tid & 7;
        const float* s = tile + (kc * 8) * 65 + nn;
        u32x4 o; o.x = pk2(s[0], s[65]); o.y = pk2(s[2 * 65], s[3 * 65]); o.z = pk2(s[4 * 65], s[5 * 65]); o.w = pk2(s[6 * 65], s[7 * 65]);
        *(u32x4*)(Wt + (size_t)(n0 + nn) * K + k0 + kc * 8) = o;
    }
}

__device__ __forceinline__ void phase_p0(const Params& p, char* lds) {
    const int tid = otid();
    float* tile = (float*)lds;
    constexpr int IT_IN = (DM / 64) * (INC / 64), IT_OUT = (DM / 64) * (DM / 64);
    constexpr int IT_L = IT_IN + IT_OUT;
    for (int it = obid(); it < NLAYER * IT_L; it += gridDim.x) {
        const int layer = it / IT_L; int r = it % IT_L;
        if (r < IT_IN) { transpose_one(p.in[I_WIN] + (size_t)layer * DM * INC, DM, INC, (bf16_t*)(p.ws + OFF_WTIN) + (size_t)layer * INC * DM, tile, r); continue; }
        r -= IT_IN;
        transpose_one(p.in[I_WOUT] + (size_t)layer * DM * DM, DM, DM, (bf16_t*)(p.ws + OFF_WTOUT) + (size_t)layer * DM * DM, tile, r);
    }
    __syncthreads();
    {
        float* SKl = (float*)lds;
        float* Wl = SKl + 128 * 129;
        for (int it = obid(); it < NLAYER * 16 * 16; it += gridDim.x) {
            const int layer = it >> 8, hp = (it >> 4) & 15, kc = it & 15, h = hp >> 1, pp = hp & 1, k0 = kc * 64;
            const float* sk = p.in[I_SK] + (((size_t)(layer * 2 + pp) * 8 + h) * 128) * 128;
            const float* wq = p.in[I_WQ] + (size_t)layer * DM * 2048 + (size_t)k0 * 2048 + h * 256 + pp * 128;
            __syncthreads();
            for (int i = tid; i < 128 * 128; i += NTHR) SKl[(i >> 7) * 129 + (i & 127)] = sk[i];
            for (int i = tid; i < 64 * 128; i += NTHR) Wl[(i >> 7) * 132 + (i & 127)] = wq[(size_t)(i >> 7) * 2048 + (i & 127)];
            __syncthreads();
            const int key = tid & 127, kq = tid >> 7;
            float acc[16];
#pragma unroll
            for (int j = 0; j < 16; ++j) acc[j] = 0.f;
            for (int d4 = 0; d4 < 32; ++d4) {
                const float a0 = SKl[key * 129 + d4 * 4], a1 = SKl[key * 129 + d4 * 4 + 1], a2 = SKl[key * 129 + d4 * 4 + 2], a3 = SKl[key * 129 + d4 * 4 + 3];
#pragma unroll
                for (int j = 0; j < 16; ++j) { const f32x4 w = *(const f32x4*)(Wl + (kq * 16 + j) * 132 + d4 * 4); acc[j] += a0 * w.x + a1 * w.y + a2 * w.z + a3 * w.w; }
            }
            bf16_t* dst = (bf16_t*)(p.ws + OFF_WTQ) + (size_t)layer * 2048 * DM + (size_t)(hp * 128 + key) * DM + k0 + kq * 16;
            u32x4 o0, o1;
            o0.x = pk2(acc[0], acc[1]); o0.y = pk2(acc[2], acc[3]); o0.z = pk2(acc[4], acc[5]); o0.w = pk2(acc[6], acc[7]);
            o1.x = pk2(acc[8], acc[9]); o1.y = pk2(acc[10], acc[11]); o1.z = pk2(acc[12], acc[13]); o1.w = pk2(acc[14], acc[15]);
            *(u32x4*)dst = o0; *(u32x4*)(dst + 8) = o1;
        }
        __syncthreads();
    }
    {
        const int lane = tid & 63, wave = tid >> 6;
        float* scl = (float*)(p.ws + OFF_PSC);
        for (int row = obid() * NWAVE + wave; row < 2 * NLAYER * 16384; row += gridDim.x * NWAVE) {
            const int tb = row >> 15, r = row & 32767;
            const f32x4* src = (const f32x4*)(p.in[tb ? I_PV : I_PU] + (size_t)r * DM) + lane;
            f32x4 v[4]; float mx = 0.f;
#pragma unroll
            for (int j = 0; j < 4; ++j) { v[j] = src[64 * j]; mx = fmaxf(mx, fmaxf(fmaxf(fabsf(v[j].x), fabsf(v[j].y)), fmaxf(fabsf(v[j].z), fabsf(v[j].w)))); }
            mx = wave_max(mx);
            const float sc = mx > 0.f ? 224.0f / mx : 1.0f;
            u32x4 o;
            { int w = 0; w = __builtin_amdgcn_cvt_pk_fp8_f32(v[0].x * sc, v[0].y * sc, w, false); w = __builtin_amdgcn_cvt_pk_fp8_f32(v[0].z * sc, v[0].w * sc, w, true); o.x = (unsigned)w; }
            { int w = 0; w = __builtin_amdgcn_cvt_pk_fp8_f32(v[1].x * sc, v[1].y * sc, w, false); w = __builtin_amdgcn_cvt_pk_fp8_f32(v[1].z * sc, v[1].w * sc, w, true); o.y = (unsigned)w; }
            { int w = 0; w = __builtin_amdgcn_cvt_pk_fp8_f32(v[2].x * sc, v[2].y * sc, w, false); w = __builtin_amdgcn_cvt_pk_fp8_f32(v[2].z * sc, v[2].w * sc, w, true); o.z = (unsigned)w; }
            { int w = 0; w = __builtin_amdgcn_cvt_pk_fp8_f32(v[3].x * sc, v[3].y * sc, w, false); w = __builtin_amdgcn_cvt_pk_fp8_f32(v[3].z * sc, v[3].w * sc, w, true); o.w = (unsigned)w; }
            *(u32x4*)(p.ws + (tb ? OFF_PV : OFF_PU) + (size_t)r * DM + lane * 16) = o;
            if (lane == 0) scl[row] = mx > 0.f ? mx / 224.0f : 1.0f;
        }
    }
    {
        float* sh = (float*)lds;
        float* zl = sh + 8 * 64;
        const int sub = tid >> 6, j = tid & 63;
        for (int it = obid(); it < NLAYER * SL / 8; it += gridDim.x) {
            const int layer = it / (SL / 8), l = (it % (SL / 8)) * 8 + sub;
            const float t = (float)l / (float)(SL - 1);
            __syncthreads();
            if (j < 17) {
                float z;
                if (j == 0) z = t;
                else if (j <= 8) z = sinf(2.0f * 3.14159265358979323846f * t * (float)j);
                else z = cosf(2.0f * 3.14159265358979323846f * t * (float)(j - 8));
                zl[sub * 17 + j] = z;
            }
            __syncthreads();
            const float* w1 = p.in[I_W1] + layer * 17 * 64;
            float a = p.in[I_B1][layer * 64 + j];
#pragma unroll
            for (int i = 0; i < 17; ++i) a += zl[sub * 17 + i] * w1[i * 64 + j];
            sh[sub * 64 + j] = sinf(p.in[I_F1][layer * 64 + j] * a);
            __syncthreads();
            const float* w2 = p.in[I_W2] + layer * 64 * 64;
            float b = p.in[I_B2][layer * 64 + j];
#pragma unroll 8
            for (int k = 0; k < 64; ++k) b += sh[sub * 64 + k] * w2[k * 64 + j];
            ((float*)(p.ws + OFF_H2))[((size_t)layer * SL + l) * 64 + j] = sinf(p.in[I_F2][layer * 64 + j] * b);
        }
    }
    {
        const int total = NLAYER * 4 * 128 * 64;
        for (int o = obid() * NTHR + tid; o < total; o += gridDim.x * NTHR) {
            const int e2 = o & 63, dd = (o >> 6) & 127, g = (o >> 13) & 3, layer = o >> 15;
            const int d = dd & 63;
            const float* w = p.in[I_FW] + ((size_t)(layer * 4 + g) * 64) * 64;
            float acc = 0.f;
            for (int e = 0; e < 64; ++e) {
                const int m = (d * e) & 63;
                const float ang = (float)m * (2.0f * 3.14159265358979323846f / 64.0f);
                const float tw = (dd < 64) ? cosf(ang) : sinf(ang);
                acc += tw * w[e * 64 + e2];
            }
            ((float*)(p.ws + OFF_FM))[o] = acc * (1.0f / 724.0773439350246f);
        }
    }
}

template <bool PAD> __device__ __forceinline__ int zi(int i) { return PAD ? i + (i >> 8) : i; }

template <int LOGN, bool PAD>
__device__ __forceinline__ void fft_fwd(float2* Z) {
    constexpr int N = 1 << LOGN;
    const int tid = otid();
    int s = 0;
    for (; s + 1 < LOGN; s += 2) {
        const int lh2 = LOGN - s - 2;
        const int h2 = 1 << lh2, h = h2 << 1;
        const float rs = 1.0f / (float)(h << 1);
        for (int q = tid; q < N / 4; q += NTHR) {
            const int j = q & (h2 - 1), blk = q >> lh2;
            const int base = (blk << (lh2 + 2)) + j;
            float2 x0 = Z[zi<PAD>(base)], x1 = Z[zi<PAD>(base + h2)], x2 = Z[zi<PAD>(base + h)], x3 = Z[zi<PAD>(base + h + h2)];
            const float ang = (float)j * rs;
            const float c = __builtin_amdgcn_cosf(ang), sn = __builtin_amdgcn_sinf(ang);
            float2 a0 = make_float2(x0.x + x2.x, x0.y + x2.y);
            float2 d02 = make_float2(x0.x - x2.x, x0.y - x2.y);
            float2 a2 = make_float2(d02.x * c + d02.y * sn, d02.y * c - d02.x * sn);
            float2 a1 = make_float2(x1.x + x3.x, x1.y + x3.y);
            float2 d13 = make_float2(x1.x - x3.x, x1.y - x3.y);
            float2 t3 = make_float2(d13.x * c + d13.y * sn, d13.y * c - d13.x * sn);
            float2 a3 = make_float2(t3.y, -t3.x);
            const float c2 = c * c - sn * sn, s2 = 2.f * c * sn;
            float2 y0 = make_float2(a0.x + a1.x, a0.y + a1.y);
            float2 e01 = make_float2(a0.x - a1.x, a0.y - a1.y);
            float2 y1 = make_float2(e01.x * c2 + e01.y * s2, e01.y * c2 - e01.x * s2);
            float2 y2 = make_float2(a2.x + a3.x, a2.y + a3.y);
            float2 e23 = make_float2(a2.x - a3.x, a2.y - a3.y);
            float2 y3 = make_float2(e23.x * c2 + e23.y * s2, e23.y * c2 - e23.x * s2);
            Z[zi<PAD>(base)] = y0; Z[zi<PAD>(base + h2)] = y1; Z[zi<PAD>(base + h)] = y2; Z[zi<PAD>(base + h + h2)] = y3;
        }
        __syncthreads();
    }
    if (s < LOGN) {
        for (int q = tid; q < N / 2; q += NTHR) {
            const int i0 = 2 * q;
            float2 a = Z[zi<PAD>(i0)], b = Z[zi<PAD>(i0 + 1)];
            Z[zi<PAD>(i0)] = make_float2(a.x + b.x, a.y + b.y);
            Z[zi<PAD>(i0 + 1)] = make_float2(a.x - b.x, a.y - b.y);
        }
        __syncthreads();
    }
}

template <int LOGN, bool PAD>
__device__ __forceinline__ void fft_inv(float2* Z) {
    constexpr int N = 1 << LOGN;
    const int tid = otid();
    for (int s = LOGN - 2; s >= 0; s -= 2) {
        const int lh2 = LOGN - s - 2;
        const int h2 = 1 << lh2, h = h2 << 1;
        const float rs = 1.0f / (float)(h << 1);
        for (int q = tid; q < N / 4; q += NTHR) {
            const int j = q & (h2 - 1), blk = q >> lh2;
            const int base = (blk << (lh2 + 2)) + j;
            float2 y0 = Z[zi<PAD>(base)], y1 = Z[zi<PAD>(base + h2)], y2 = Z[zi<PAD>(base + h)], y3 = Z[zi<PAD>(base + h + h2)];
            const float ang = (float)j * rs;
            const float c = __builtin_amdgcn_cosf(ang), sn = __builtin_amdgcn_sinf(ang);
            const float c2 = c * c - sn * sn, s2 = 2.f * c * sn;
            float2 t1 = make_float2(y1.x * c2 - y1.y * s2, y1.y * c2 + y1.x * s2);
            float2 t3 = make_float2(y3.x * c2 - y3.y * s2, y3.y * c2 + y3.x * s2);
            float2 a0 = make_float2(y0.x + t1.x, y0.y + t1.y), a1 = make_float2(y0.x - t1.x, y0.y - t1.y);
            float2 a2 = make_float2(y2.x + t3.x, y2.y + t3.y), a3 = make_float2(y2.x - t3.x, y2.y - t3.y);
            float2 u2 = make_float2(a2.x * c - a2.y * sn, a2.y * c + a2.x * sn);
            float2 u3 = make_float2(a3.x * c - a3.y * sn, a3.y * c + a3.x * sn);
            float2 v3 = make_float2(-u3.y, u3.x);
            Z[zi<PAD>(base)] = make_float2(a0.x + u2.x, a0.y + u2.y);
            Z[zi<PAD>(base + h)] = make_float2(a0.x - u2.x, a0.y - u2.y);
            Z[zi<PAD>(base + h2)] = make_float2(a1.x + v3.x, a1.y + v3.y);
            Z[zi<PAD>(base + h + h2)] = make_float2(a1.x - v3.x, a1.y - v3.y);
        }
        __syncthreads();
    }
}

__device__ __forceinline__ void phase_filter_spectra(const Params& p, char* lds) {
    const int tid = otid(), lane = tid & 63, wave = tid >> 6;
    float2* Z = (float2*)lds;
    float* w3l = (float*)(lds + 131072);
    float* red = w3l + 256;
    for (int job = obid(); job < NLAYER * 256; job += gridDim.x) {
        const int layer = job >> 8, c = job & 255;
        __syncthreads();
        if (tid < 256) { const int k = tid >> 2, q = tid & 3; w3l[tid] = p.in[I_W3][((size_t)layer * 64 + k) * 1024 + q * 256 + c]; }
        __syncthreads();
        const float* H2 = (const float*)(p.ws + OFF_H2) + (size_t)layer * SL * 64;
        const float r_lo = 4.605170185988092f / 1.5f, r_hi = 4.605170185988092f / 0.3f;
        const float rate = r_lo + (r_hi - r_lo) * ((float)c / 255.0f);
        float ss0 = 0.f, ss1 = 0.f;
        for (int i = 0; i < 16; ++i) {
            const int l = tid + NTHR * i;
            const f32x4* hr = (const f32x4*)(H2 + (size_t)l * 64);
            float a0 = 0.f, a1 = 0.f, a2 = 0.f, a3 = 0.f;
#pragma unroll
            for (int k4 = 0; k4 < 16; ++k4) {
                const f32x4 hv = hr[k4];
#pragma unroll
                for (int e = 0; e < 4; ++e) {
                    const f32x4 w = *(const f32x4*)(w3l + (k4 * 4 + e) * 4);
                    const float hh = hv[e];
                    a0 += hh * w.x; a1 += hh * w.y; a2 += hh * w.z; a3 += hh * w.w;
                }
            }
            const float t = (float)l / (float)(SL - 1);
            const float dec = expf(-t * rate);
            a0 *= dec; a1 *= dec; a2 *= dec; a3 *= dec;
            ss0 += a0 * a0 + a1 * a1; ss1 += a2 * a2 + a3 * a3;
            Z[l] = make_float2(a0, a2);
            if (l >= 1) Z[16384 - l] = make_float2(a1, a3);
        }
        if (tid == 0) Z[8192] = make_float2(0.f, 0.f);
        ss0 = wave_sum(ss0); ss1 = wave_sum(ss1);
        if (lane == 0) { red[wave * 2] = ss0; red[wave * 2 + 1] = ss1; }
        __syncthreads();
        float t0 = 0.f, t1 = 0.f;
#pragma unroll
        for (int w = 0; w < 8; ++w) { t0 += red[w * 2]; t1 += red[w * 2 + 1]; }
        const float sc0 = rsqrtf(t0 + EPS) * (1.0f / 16384.0f) * 0.5f, sc1 = rsqrtf(t1 + EPS) * (1.0f / 16384.0f) * 0.5f;
        fft_fwd<14, false>(Z);
        float2* KF0 = (float2*)(p.ws + OFF_KF) + ((size_t)(layer * 256 + c) * 2) * 16384;
        float2* KF1 = KF0 + 16384;
        for (int i = 0; i < 32; ++i) {
            const int pp = tid + NTHR * i;
            const int f = (int)(__brev((unsigned)pp) >> 18);
            const int fm = (16384 - f) & 16383;
            const int pq = (int)(__brev((unsigned)fm) >> 18);
            const float2 zp = Z[pp], zq = Z[pq];
            KF0[pp] = make_float2((zp.x + zq.x) * sc0, (zp.y - zq.y) * sc0);
            KF1[pp] = make_float2((zp.y + zq.y) * sc1, (zq.x - zp.x) * sc1);
        }
    }
}

__device__ __forceinline__ void phase_rmsnorm_bf16(const float* x, const float* g, bf16_t* out) {
    const int lane = otid() & 63, wave = otid() >> 6;
    const int gw = obid() * NWAVE + wave, ngw = gridDim.x * NWAVE;
    for (int row = gw; row < T; row += ngw) {
        const f32x4* xr = (const f32x4*)(x + (size_t)row * DM) + lane;
        f32x4 v[4]; float ss = 0.f;
#pragma unroll
        for (int j = 0; j < 4; ++j) { v[j] = xr[64 * j]; ss += v[j].x * v[j].x + v[j].y * v[j].y + v[j].z * v[j].z + v[j].w * v[j].w; }
        ss = wave_sum(ss);
        const float r = rsqrtf(ss * (1.0f / DM) + EPS);
        u32x2* o = (u32x2*)(out + (size_t)row * DM) + lane;
#pragma unroll
        for (int j = 0; j < 4; ++j) {
            const f32x4 gg = ((const f32x4*)g)[lane + 64 * j];
            u32x2 w; w.x = pk2(v[j].x * r * gg.x, v[j].y * r * gg.y); w.y = pk2(v[j].z * r * gg.z, v[j].w * r * gg.w);
            o[64 * j] = w;
        }
    }
}
__device__ __forceinline__ void phase_final_norm(const float* x, const float* g, float* out) {
    const int lane = otid() & 63, wave = otid() >> 6;
    const int gw = obid() * NWAVE + wave, ngw = gridDim.x * NWAVE;
    for (int row = gw; row < T; row += ngw) {
        const f32x4* xr = (const f32x4*)(x + (size_t)row * DM) + lane;
        f32x4 v[4]; float ss = 0.f;
#pragma unroll
        for (int j = 0; j < 4; ++j) { v[j] = xr[64 * j]; ss += v[j].x * v[j].x + v[j].y * v[j].y + v[j].z * v[j].z + v[j].w * v[j].w; }
        ss = wave_sum(ss);
        const float r = rsqrtf(ss * (1.0f / DM) + EPS);
        f32x4* o = (f32x4*)(out + (size_t)row * DM) + lane;
#pragma unroll
        for (int j = 0; j < 4; ++j) { const f32x4 gg = ((const f32x4*)g)[lane + 64 * j]; o[64 * j] = v[j] * r * gg; }
    }
}

constexpr int G_LDA = 144;
template <class Epi>
__device__ __forceinline__ void gemm_phase(const bf16_t* A, const bf16_t* Bt, int M, int N, int K, char* lds, const Epi& epi) {
    const int tid = otid(), lane = tid & 63, wave = tid >> 6;
    const int wm = wave >> 1, wn = wave & 1;
    const int nMt = M / 256, nNt = N / 128, total = nMt * nNt, nk = K / 64;
    char* As = lds; char* Bs = lds + 256 * G_LDA;
    const int l31 = lane & 31, hl = lane >> 5;
    for (int u = obid(); u < total; u += gridDim.x) {
        const int mt = u % nMt, nt = u / nMt;
        f32x16 acc[2][2];
#pragma unroll
        for (int i = 0; i < 2; ++i)
#pragma unroll
            for (int j = 0; j < 2; ++j) acc[i][j] = zero16();
        u32x4 ra[4], rb[2];
        const bf16_t* Ab = A + (size_t)(mt * 256) * K;
        const bf16_t* Bb = Bt + (size_t)(nt * 128) * K;
#pragma unroll
        for (int i = 0; i < 4; ++i) { const int id = tid + NTHR * i, row = id >> 3, ch = id & 7; ra[i] = *(const u32x4*)(Ab + (size_t)row * K + ch * 8); }
#pragma unroll
        for (int i = 0; i < 2; ++i) { const int id = tid + NTHR * i, row = id >> 3, ch = id & 7; rb[i] = *(const u32x4*)(Bb + (size_t)row * K + ch * 8); }
        for (int kt = 0; kt < nk; ++kt) {
            __syncthreads();
#pragma unroll
            for (int i = 0; i < 4; ++i) { const int id = tid + NTHR * i, row = id >> 3, ch = id & 7; *(u32x4*)(As + row * G_LDA + ch * 16) = ra[i]; }
#pragma unroll
            for (int i = 0; i < 2; ++i) { const int id = tid + NTHR * i, row = id >> 3, ch = id & 7; *(u32x4*)(Bs + row * G_LDA + ch * 16) = rb[i]; }
            __syncthreads();
            if (kt + 1 < nk) {
                const int ko = (kt + 1) * 64;
#pragma unroll
                for (int i = 0; i < 4; ++i) { const int id = tid + NTHR * i, row = id >> 3, ch = id & 7; ra[i] = *(const u32x4*)(Ab + (size_t)row * K + ko + ch * 8); }
#pragma unroll
                for (int i = 0; i < 2; ++i) { const int id = tid + NTHR * i, row = id >> 3, ch = id & 7; rb[i] = *(const u32x4*)(Bb + (size_t)row * K + ko + ch * 8); }
            }
#pragma unroll
            for (int ks = 0; ks < 4; ++ks) {
                bf16x8 a[2], b[2];
#pragma unroll
                for (int i = 0; i < 2; ++i) a[i] = *(const bf16x8*)(As + (wm * 64 + i * 32 + l31) * G_LDA + ks * 32 + hl * 16);
#pragma unroll
                for (int j = 0; j < 2; ++j) b[j] = *(const bf16x8*)(Bs + (wn * 64 + j * 32 + l31) * G_LDA + ks * 32 + hl * 16);
#pragma unroll
                for (int i = 0; i < 2; ++i)
#pragma unroll
                    for (int j = 0; j < 2; ++j) acc[i][j] = mfma32(a[i], b[j], acc[i][j]);
            }
        }
#pragma unroll
        for (int i = 0; i < 2; ++i)
#pragma unroll
            for (int j = 0; j < 2; ++j) epi(acc[i][j], mt * 256 + wm * 64 + i * 32, nt * 128 + wn * 64 + j * 32, lane);
    }
}

struct EpiIn {
    bf16_t* qkv; float* hf;
    __device__ __forceinline__ void operator()(const f32x16& acc, int row0, int col0, int lane) const {
        const int c = col0 + (lane & 31), h = lane >> 5;
        if (col0 < 768) {
#pragma unroll
            for (int r = 0; r < 16; ++r) { const int row = row0 + (r & 3) + 8 * (r >> 2) + 4 * h; qkv[(size_t)row * 768 + c] = (bf16_t)f2bf(acc[r]); }
        } else {
            float* dst = hf + (size_t)(c - 768) * T;
#pragma unroll
            for (int i = 0; i < 4; ++i) { const int row = row0 + 8 * i + 4 * h; f32x4 v; v.x = acc[4 * i]; v.y = acc[4 * i + 1]; v.z = acc[4 * i + 2]; v.w = acc[4 * i + 3]; *(f32x4*)(dst + row) = v; }
        }
    }
};
struct EpiRes {
    const float* base; float* out;
    __device__ __forceinline__ void operator()(const f32x16& acc, int row0, int col0, int lane) const {
        const int c = col0 + (lane & 31), h = lane >> 5;
#pragma unroll
        for (int r = 0; r < 16; ++r) { const size_t o = (size_t)(row0 + (r & 3) + 8 * (r >> 2) + 4 * h) * DM + c; out[o] = base[o] + acc[r]; }
    }
};
struct EpiF32 {
    float* out; int ld;
    __device__ __forceinline__ void operator()(const f32x16& acc, int row0, int col0, int lane) const {
        const int c = col0 + (lane & 31), h = lane >> 5;
#pragma unroll
        for (int r = 0; r < 16; ++r) { out[(size_t)(row0 + (r & 3) + 8 * (r >> 2) + 4 * h) * ld + c] = acc[r]; }
    }
};

__device__ __forceinline__ void phase_qkprep(const Params& p, int layer, char* lds, bf16_t* qout) {
    const int tid = otid(), lane = tid & 63, wave = tid >> 6;
    bf16_t* qkv = (bf16_t*)(p.ws + R_QKV);
    bf16_t* vt = (bf16_t*)(p.ws + R_VT);
    const float qgv = p.in[I_QG][layer * 64 + lane], kgv = p.in[I_KG][layer * 64 + lane];
    const int gw = obid() * NWAVE + wave, ngw = gridDim.x * NWAVE;
    const int ax = lane >> 5, fr = lane & 15; const bool second = (lane >> 4) & 1;
    const float inv = powf(10000.0f, -(float)fr / 16.0f);
    for (int t = gw; t < T; t += ngw) {
        const int l = t & (SL - 1);
        const float pos = ax ? (float)(l & 63) : (float)(l >> 6);
        const float ang = pos * inv;
        const float cs = cosf(ang), sn = sinf(ang);
        bf16_t* row = qkv + (size_t)t * 768;
#pragma unroll
        for (int slot = 0; slot < 10; ++slot) {
            const float x = bf2f(row[slot * 64 + lane]);
            const float ss = wave_sum(x * x);
            const float r = rsqrtf(ss * (1.0f / 64.0f) + EPS);
            const float y = x * r * (slot < 8 ? qgv : kgv);
            const float other = __shfl_xor(y, 16);
            float o = second ? (y * cs + other * sn) : (y * cs - other * sn);
            if (slot < 8) o *= 0.125f * 1.4426950408889634f;
            qout[(size_t)t * 768 + slot * 64 + lane] = (bf16_t)f2bf(o);
        }
    }
}

#include <hip/hip_bf16.h>
#include <cmath>
namespace attn_body {
using bf16=__hip_bfloat16;
using bf16x8=__attribute__((ext_vector_type(8)))short;
using s16x4=__attribute__((ext_vector_type(4)))short;
using f32x16=__attribute__((ext_vector_type(16)))float;
using u32x4=__attribute__((ext_vector_type(4)))unsigned;
constexpr int SEQ=8192,D=64,PQ=768,PO=512;
constexpr int NW=8,QBLK=32,QB=QBLK*NW,KVBLK=64,NQB=SEQ/QB;
constexpr int ATTN_UNIT_ROWS=QB;
__device__ __forceinline__ int crow(int r,int hi){return (r&3)+8*(r>>2)+4*hi;}
#define SBAR() __builtin_amdgcn_sched_barrier(0)
__device__ __forceinline__ void cmask(f32x16&p0,f32x16&p1,int jb,int qrel,int hi){
  const float NEG=-INFINITY; int kb=64*jb+4*hi;
  #pragma unroll
  for(int r=0;r<16;++r){int kv=kb+(r&3)+8*(r>>2); if(kv>qrel)p0[r]=NEG; if(kv+32>qrel)p1[r]=NEG;}
}

constexpr int NSLOT=3, SLOTB=8192;
constexpr int LDS_K=0, LDS_V=NSLOT*SLOTB, LDS_WS=2*NSLOT*SLOTB, LDS_OST=LDS_WS+NW*64*4, LDS_BYTES=LDS_OST+NW*4096;
constexpr float C2=0.125f*1.4426950408889634f;
__device__ __forceinline__ void glds16(const void*gsrc,unsigned lds_dst){unsigned keep;
  asm volatile("s_mov_b32 %0, m0\n\ts_mov_b32 m0, %2\n\ts_nop 0\n\tglobal_load_lds_dwordx4 %1, off\n\ts_mov_b32 m0, %0":"=&s"(keep):"v"(gsrc),"s"(lds_dst):"memory");}
__device__ __forceinline__ float max3f(float a,float b,float c){float r;asm("v_max3_f32 %0, %1, %2, %3":"=v"(r):"v"(a),"v"(b),"v"(c));return r;}
__device__ __forceinline__ float max2f(float a,float b){float r;asm("v_max_f32_e32 %0, %1, %2":"=v"(r):"v"(a),"v"(b));return r;}
__device__ __forceinline__ float fadd_s(float a,float b){float r;asm("v_add_f32_e32 %0, %1, %2":"=v"(r):"v"(a),"v"(b));return r;}
__device__ __forceinline__ float fsub_s(float a,float b){float r;asm("v_sub_f32_e32 %0, %1, %2":"=v"(r):"v"(a),"v"(b));return r;}
typedef float f32x2_t __attribute__((ext_vector_type(2))); typedef __bf16 bf16x2_t __attribute__((ext_vector_type(2)));
__device__ __forceinline__ unsigned cvtpk_s(float lo,float hi){f32x2_t v={lo,hi};bf16x2_t b=__builtin_convertvector(v,bf16x2_t);return __builtin_bit_cast(unsigned,b);}
#define WAIT_BAR(N) asm volatile("s_waitcnt vmcnt(" #N ") lgkmcnt(0)\n\ts_barrier":::"memory")

__device__ __forceinline__ void qkt(f32x16&p0,f32x16&p1,const char*Kslot,const bf16x8*qr,const f32x16&negm,int r32,int hi){
  const char*kb=Kslot+hi*1024+r32*16;
  #pragma unroll
  for(int d0=0;d0<4;++d0){
    const bf16x8 b0=*reinterpret_cast<const bf16x8*>(kb+d0*2048);
    const bf16x8 b1=*reinterpret_cast<const bf16x8*>(kb+d0*2048+512);
    if(d0==0){p0=__builtin_amdgcn_mfma_f32_32x32x16_bf16(b0,qr[0],negm,0,0,0);p1=__builtin_amdgcn_mfma_f32_32x32x16_bf16(b1,qr[0],negm,0,0,0);}
    else{p0=__builtin_amdgcn_mfma_f32_32x32x16_bf16(b0,qr[d0],p0,0,0,0);p1=__builtin_amdgcn_mfma_f32_32x32x16_bf16(b1,qr[d0],p1,0,0,0);}}
}
typedef __attribute__((address_space(3))) const char* lds_cptr;
typedef short v4i16_t __attribute__((ext_vector_type(4)));
__device__ __forceinline__ void kload8(bf16x8*kf,lds_cptr kp){
  kf[0]=*(const __attribute__((address_space(3))) bf16x8*)(kp);      kf[1]=*(const __attribute__((address_space(3))) bf16x8*)(kp+512);
  kf[2]=*(const __attribute__((address_space(3))) bf16x8*)(kp+2048); kf[3]=*(const __attribute__((address_space(3))) bf16x8*)(kp+2560);
  kf[4]=*(const __attribute__((address_space(3))) bf16x8*)(kp+4096); kf[5]=*(const __attribute__((address_space(3))) bf16x8*)(kp+4608);
  kf[6]=*(const __attribute__((address_space(3))) bf16x8*)(kp+6144); kf[7]=*(const __attribute__((address_space(3))) bf16x8*)(kp+6656);
}
__device__ __forceinline__ void kload2(bf16x8*kf,lds_cptr kp,int j){ kf[2*j]=*(const __attribute__((address_space(3))) bf16x8*)(kp+j*2048); kf[2*j+1]=*(const __attribute__((address_space(3))) bf16x8*)(kp+j*2048+512); }
__device__ __forceinline__ s16x4 vtr(lds_cptr p){ return __builtin_bit_cast(s16x4,__builtin_amdgcn_ds_read_tr16_b64_v4i16((__attribute__((address_space(3))) v4i16_t*)p)); }
__device__ __forceinline__ float rowmax(const f32x16&p0,const f32x16&p1){
  float a=max3f(p0[0],p0[1],p1[0]),b=max3f(p0[2],p0[3],p1[1]);a=max3f(a,p1[2],p1[3]);
  #pragma unroll
  for(int r=4;r<16;r+=4){a=max3f(a,p0[r],p0[r+1]);b=max3f(b,p0[r+2],p0[r+3]);a=max3f(a,p1[r],p1[r+1]);b=max3f(b,p1[r+2],p1[r+3]);}
  const float m=max2f(a,b);
  auto rr=__builtin_amdgcn_permlane32_swap(__float_as_uint(m),__float_as_uint(m),false,false);
  return max2f(__uint_as_float(rr[0]),__uint_as_float(rr[1]));
}
__device__ __forceinline__ void pv(f32x16*o,int vb,bf16x8 pa0,bf16x8 pa1,bf16x8 pa2,bf16x8 pa3){
  #pragma unroll
  for(int d0=0;d0<2;++d0){s16x4 lo[4],hi[4];
    #pragma unroll
    for(int ks=0;ks<4;++ks){
      asm volatile("ds_read_b64_tr_b16 %0,%1 offset:%c2":"=&v"(lo[ks]):"v"(vb),"i"(d0*4096+ks*1024):"memory");
      asm volatile("ds_read_b64_tr_b16 %0,%1 offset:%c2":"=&v"(hi[ks]):"v"(vb),"i"(d0*4096+ks*1024+512):"memory");}
    asm volatile("s_waitcnt lgkmcnt(0)":::"memory");SBAR();
    #define PK(k) (bf16x8){lo[k][0],lo[k][1],lo[k][2],lo[k][3],hi[k][0],hi[k][1],hi[k][2],hi[k][3]}
    o[d0]=__builtin_amdgcn_mfma_f32_32x32x16_bf16(pa0,PK(0),o[d0],0,0,0);
    o[d0]=__builtin_amdgcn_mfma_f32_32x32x16_bf16(pa1,PK(1),o[d0],0,0,0);
    o[d0]=__builtin_amdgcn_mfma_f32_32x32x16_bf16(pa2,PK(2),o[d0],0,0,0);
    o[d0]=__builtin_amdgcn_mfma_f32_32x32x16_bf16(pa3,PK(3),o[d0],0,0,0);
    #undef PK
  }
}

#ifndef ATTN_STORE16
#define ATTN_STORE16(p,v) (*(u32x4*)(p)=(v))
#endif
template<int THRL> __device__ __forceinline__ void attn_unit(int b,int h,int g,int qb,const bf16*Q,const bf16*__restrict__ K,const bf16*__restrict__ V,bf16*O,char*shm){
  const int tid=otid(),lane=tid&63,r32=lane&31,hi=lane>>5; const int wid=__builtin_amdgcn_readfirstlane(tid>>6);
  const long rowbase=(long)b*SEQ; const int q0=qb*QB;
  const bf16*Qw=Q+(rowbase+q0+wid*QBLK)*PQ+h*D;
  const bf16*Kh=K+rowbase*PQ+g*D,*Vh=V+rowbase*PQ+g*D;
  const unsigned lds0=(unsigned)(uintptr_t)shm;
  float*wsf=(float*)(shm+LDS_WS)+wid*64;
  const bf16*ksrc=Kh+(long)lane*PQ+wid*8;
  const bf16*vsrc=Vh+(long)(16*(wid&3)+(lane>>2))*PQ+(wid>>2)*32+(lane&3)*8;
  const unsigned kdst=lds0+LDS_K+wid*1024, vdst=lds0+LDS_V+wid*1024;
  #define DMA_K(t,slot) glds16(ksrc+(long)(t)*KVBLK*PQ,(unsigned)__builtin_amdgcn_readfirstlane(kdst+(slot)))
  #define DMA_V(t,slot) glds16(vsrc+(long)(t)*KVBLK*PQ,(unsigned)__builtin_amdgcn_readfirstlane(vdst+(slot)))
  const int vb0=(int)(lds0+LDS_V)+((lane>>4)&1)*32+(lane&3)*8+(4*hi+((lane&15)>>2))*64;
  const char*Kbase=shm+LDS_K; bf16x8 kf[8];
  const lds_cptr shm3=(lds_cptr)shm; const lds_cptr kp0=shm3+LDS_K+hi*1024+r32*16; const lds_cptr vp0=shm3+LDS_V+((lane>>4)&1)*32+(lane&3)*8+(4*hi+((lane&15)>>2))*64;
  constexpr int NT=SEQ/KVBLK;
  DMA_K(0,0);DMA_V(0,0);DMA_K(1,SLOTB);
  bf16x8 qr[4];
  #pragma unroll
  for(int d0=0;d0<4;++d0)qr[d0]=*reinterpret_cast<const bf16x8*>(&Qw[(long)r32*PQ+d0*16+hi*8]);
  float mhat=0.f,l_reg=0.f;f32x16 o[2];o[0]=f32x16{};o[1]=f32x16{};f32x16 negm=f32x16{};asm volatile("":"+v"(negm));
    #define CMASK(P0,P1,t) do{}while(0)
  bool resc=false;
  #define START(P0,P1) do{ const float rm=rowmax(P0,P1); resc=false; \
    { const float dl=rm; mhat=fadd_s(mhat,dl); \
      _Pragma("unroll") for(int r=0;r<16;++r){P0[r]=fsub_s(P0[r],dl);P1[r]=fsub_s(P1[r],dl);} \
      _Pragma("unroll") for(int r=0;r<16;++r)negm[r]=-mhat; asm volatile("":"+v"(negm)); } \
    _Pragma("unroll") for(int r=0;r<16;++r)P0[r]=__builtin_amdgcn_exp2f(P0[r]); }while(0)
  #define RESC() do{ if(resc){ asm volatile("s_waitcnt lgkmcnt(0)":::"memory"); \
      _Pragma("unroll") for(int d_=0;d_<2;++d_) _Pragma("unroll") for(int r=0;r<16;++r)o[d_][r]*=wsf[crow(r,hi)]; } }while(0)
  f32x16 pA0,pA1,pB0,pB1;
  int sl_prev=0,sl_cur=0,sl_next=SLOTB;
  #define ROT() do{sl_prev=sl_cur;sl_cur=sl_next;sl_next=(sl_next==(NSLOT-1)*SLOTB)?0:sl_next+SLOTB;}while(0)
  DMA_K(2,2*SLOTB);
  WAIT_BAR(3);
  qkt(pA0,pA1,Kbase,qr,negm,r32,hi);asm volatile("s_nop 15\n\ts_nop 7":"+v"(pA0),"+v"(pA1));CMASK(pA0,pA1,0);
  START(pA0,pA1);
  _Pragma("unroll") for(int r=0;r<16;++r)pA1[r]=__builtin_amdgcn_exp2f(pA1[r]);
  WAIT_BAR(0);
  DMA_K(3,0);DMA_V(1,SLOTB);
  ROT();
  kload8(kf,kp0+sl_cur);
  WAIT_BAR(2);
  s16x4 vlo[8],vhi[8]; u32x4 pw0,pw1,pw2,pw3;
  #define PKW(P,B) cvtpk_s(P[B],P[B+1])
  #define PAF(k) __builtin_bit_cast(bf16x8,pw##k)
  #define VFR(i) (bf16x8){vlo[i][0],vlo[i][1],vlo[i][2],vlo[i][3],vhi[i][0],vhi[i][1],vhi[i][2],vhi[i][3]}
  #define PIN(x) asm volatile("":"+v"(x))
  #define MX3(a,b,c) __builtin_fmaxf(__builtin_fmaxf((a),(b)),(c))
  #define GAPA(MF,A0,A1,A2,A3,W0,W1,PW) do{ MF; sacc+=A0; sacc+=A1; sacc+=A2; sacc+=A3; PIN(sacc); W0; W1; PIN(PW); SBAR(); }while(0)
  #define EX(v) __builtin_amdgcn_exp2f(v)
  #define GAPB(MF,X,B) do{ MF; X[B]=EX(X[B]); X[B+1]=EX(X[B+1]); X[B+2]=EX(X[B+2]); X[B+3]=EX(X[B+3]); PIN(X); SBAR(); }while(0)
  #define VRD(i) do{ vlo[i]=vtr(vp_+(((i)>>2)*4096+((i)&3)*1024)); vhi[i]=vtr(vp_+(((i)>>2)*4096+((i)&3)*1024+512)); }while(0)
  #define KRD(G,j) do{ if(G){ kload2(kf,kp0+sl_next,j); SBAR(); } }while(0)
  #define STEP(C0,C1,P0,P1,t,GK,GV,GL) do{ SBAR(); \
    const lds_cptr vp_=vp0+sl_prev; \
    VRD(0); SBAR(); float sacc=(P0[0]+P0[1]); \
    GAPA(C0=__builtin_amdgcn_mfma_f32_32x32x16_bf16(kf[0],qr[0],negm,0,0,0), P0[2],P0[3],P0[4],P0[5],     pw0[0]=PKW(P0,0), pw0[1]=PKW(P0,2), pw0); \
    VRD(4); SBAR(); GAPA(C1=__builtin_amdgcn_mfma_f32_32x32x16_bf16(kf[1],qr[0],negm,0,0,0), P0[6],P0[7],P0[8],P0[9],     pw0[2]=PKW(P0,4), pw0[3]=PKW(P0,6), pw0); \
    VRD(1); SBAR(); GAPA(C0=__builtin_amdgcn_mfma_f32_32x32x16_bf16(kf[2],qr[1],C0,0,0,0),   P0[10],P0[11],P0[12],P0[13], pw1[0]=PKW(P0,8), pw1[1]=PKW(P0,10), pw1); \
    VRD(5); SBAR(); GAPA(C1=__builtin_amdgcn_mfma_f32_32x32x16_bf16(kf[3],qr[1],C1,0,0,0),   P0[14],P0[15],P1[0],P1[1],   pw1[2]=PKW(P0,12),pw1[3]=PKW(P0,14), pw1); \
    VRD(2); SBAR(); GAPA(C0=__builtin_amdgcn_mfma_f32_32x32x16_bf16(kf[4],qr[2],C0,0,0,0),   P1[2],P1[3],P1[4],P1[5],     pw2[0]=PKW(P1,0), pw2[1]=PKW(P1,2), pw2); \
    VRD(6); SBAR(); GAPA(C1=__builtin_amdgcn_mfma_f32_32x32x16_bf16(kf[5],qr[2],C1,0,0,0),   P1[6],P1[7],P1[8],P1[9],     pw2[2]=PKW(P1,4), pw2[3]=PKW(P1,6), pw2); \
    VRD(3); SBAR(); GAPA(C0=__builtin_amdgcn_mfma_f32_32x32x16_bf16(kf[6],qr[3],C0,0,0,0),   P1[10],P1[11],P1[12],P1[13], pw3[0]=PKW(P1,8), pw3[1]=PKW(P1,10), pw3); \
    VRD(7); SBAR(); GAPA(C1=__builtin_amdgcn_mfma_f32_32x32x16_bf16(kf[7],qr[3],C1,0,0,0),   P1[14],P1[15],0.f,0.f,       pw3[2]=PKW(P1,12),pw3[3]=PKW(P1,14), pw3); \
    l_reg+=sacc; \
    if(GK){DMA_K((t)+3,sl_cur);} if(GV){DMA_V((t)+1,sl_next);} \
    CMASK(C0,C1,t); \
    { float a=MX3(C0[0],C0[1],C1[0]),b=MX3(C0[2],C0[3],C1[1]); a=MX3(a,C1[2],C1[3]); \
      _Pragma("unroll") for(int r=4;r<16;r+=4){a=MX3(a,C0[r],C0[r+1]);b=MX3(b,C0[r+2],C0[r+3]);a=MX3(a,C1[r],C1[r+1]);b=MX3(b,C1[r+2],C1[r+3]);} \
      float rm=__builtin_fmaxf(a,b); { auto rr=__builtin_amdgcn_permlane32_swap(__float_as_uint(rm),__float_as_uint(rm),false,false); rm=__builtin_fmaxf(__uint_as_float(rr[0]),__uint_as_float(rr[1])); } \
      resc=false; \
      if(__builtin_expect(__any(rm>(float)THRL),0)){ const float dl=__builtin_fmaxf(rm,0.f); mhat+=dl; \
        _Pragma("unroll") for(int r=0;r<16;++r){C0[r]-=dl;C1[r]-=dl;} \
        _Pragma("unroll") for(int r=0;r<16;++r)negm[r]=-mhat; asm volatile("":"+v"(negm)); \
        const float f=__builtin_amdgcn_exp2f(-dl); l_reg*=f; if(hi==0)wsf[r32]=f; resc=true; } } \
    SBAR(); \
    GAPB(o[0]=__builtin_amdgcn_mfma_f32_32x32x16_bf16(PAF(0),VFR(0),o[0],0,0,0), C0,0); \
    GAPB(o[1]=__builtin_amdgcn_mfma_f32_32x32x16_bf16(PAF(0),VFR(4),o[1],0,0,0), C0,4); \
    KRD(GL,0); GAPB(o[0]=__builtin_amdgcn_mfma_f32_32x32x16_bf16(PAF(1),VFR(1),o[0],0,0,0), C0,8); \
    KRD(GL,1); GAPB(o[1]=__builtin_amdgcn_mfma_f32_32x32x16_bf16(PAF(1),VFR(5),o[1],0,0,0), C0,12); \
    KRD(GL,2); GAPB(o[0]=__builtin_amdgcn_mfma_f32_32x32x16_bf16(PAF(2),VFR(2),o[0],0,0,0), C1,0); \
    KRD(GL,3); GAPB(o[1]=__builtin_amdgcn_mfma_f32_32x32x16_bf16(PAF(2),VFR(6),o[1],0,0,0), C1,4); \
    GAPB(o[0]=__builtin_amdgcn_mfma_f32_32x32x16_bf16(PAF(3),VFR(3),o[0],0,0,0), C1,8); \
    GAPB(o[1]=__builtin_amdgcn_mfma_f32_32x32x16_bf16(PAF(3),VFR(7),o[1],0,0,0), C1,12); \
    }while(0)
  int t=1;
  #undef CMASK
  #define CMASK(P0,P1,t) do{}while(0)
  for(;t+5<NT;t+=2){
    STEP(pB0,pB1,pA0,pA1,t,true,true,true);     WAIT_BAR(2); RESC(); ROT();
    STEP(pA0,pA1,pB0,pB1,t+1,true,true,true);   WAIT_BAR(2); RESC(); ROT();
  }
  #define ENDW(tt) do{ if((tt)+3<NT){WAIT_BAR(2);} else if((tt)+2<NT){WAIT_BAR(1);} else {WAIT_BAR(0);} }while(0)
  for(;t+1<NT;t+=2){
    STEP(pB0,pB1,pA0,pA1,t,(t+3<NT),(t+1<NT),(t+1<NT));       ENDW(t);   RESC(); ROT();
    STEP(pA0,pA1,pB0,pB1,t+1,(t+4<NT),(t+2<NT),(t+2<NT));     ENDW(t+1); RESC(); ROT();
  }
  STEP(pB0,pB1,pA0,pA1,NT-1,false,false,false); RESC();
  { float sacc=pB0[0]+pB0[1]; _Pragma("unroll") for(int r=2;r<16;++r)sacc+=pB0[r]; _Pragma("unroll") for(int r=0;r<16;++r)sacc+=pB1[r]; l_reg+=sacc;
    pw0=(u32x4){PKW(pB0,0),PKW(pB0,2),PKW(pB0,4),PKW(pB0,6)};pw1=(u32x4){PKW(pB0,8),PKW(pB0,10),PKW(pB0,12),PKW(pB0,14)};pw2=(u32x4){PKW(pB1,0),PKW(pB1,2),PKW(pB1,4),PKW(pB1,6)};pw3=(u32x4){PKW(pB1,8),PKW(pB1,10),PKW(pB1,12),PKW(pB1,14)};
    SBAR(); pv(o,vb0+sl_cur,PAF(0),PAF(1),PAF(2),PAF(3)); }
  #undef PKW
  #undef PAF
  #undef VFR
  #undef PIN
  #undef MX3
  #undef GAPA
  #undef GAPB
  #undef EX
  #undef VRD
  #undef KRD
  #undef STEP
  #undef ENDW
  {auto rr=__builtin_amdgcn_permlane32_swap(__float_as_uint(l_reg),__float_as_uint(l_reg),false,false);l_reg=__uint_as_float(rr[0])+__uint_as_float(rr[1]);}
  if(hi==0)wsf[32+r32]=l_reg;asm volatile("s_waitcnt lgkmcnt(0)":::"memory");
  float rli[16];
  #pragma unroll
  for(int r=0;r<16;++r)rli[r]=__builtin_amdgcn_rcpf(wsf[32+crow(r,hi)]);
  bf16*Ow=O+(rowbase+q0+wid*QBLK)*PO+h*D;
  { bf16*stg=(bf16*)(shm+LDS_OST)+wid*2048;
    #pragma unroll
    for(int r=0;r<16;++r){const int orow=crow(r,hi);
      #pragma unroll
      for(int d0=0;d0<2;++d0)stg[orow*64+d0*32+r32]=__float2bfloat16(o[d0][r]*rli[r]);}
    asm volatile("s_waitcnt lgkmcnt(0)":::"memory");
    #pragma unroll
    for(int i=0;i<4;++i){const int row=i*8+(lane>>3),ch=lane&7; const u32x4 v=*(const u32x4*)(stg+row*64+ch*8); ATTN_STORE16(Ow+(long)row*PO+ch*8,v);} }
  asm volatile("s_waitcnt lgkmcnt(0)\n\ts_barrier":::"memory");
  #undef DMA_K
  #undef DMA_V
  #undef CMASK
  #undef START
  #undef RESC
  #undef ROT
}
constexpr int ATTN_LDS_BYTES=LDS_BYTES;
#undef SBAR
#undef WAIT_BAR
}

__device__ __forceinline__ void phase_attn(const Params& p, char* lds) {
            {
                const int bid = obid();
                const int vcu = ((gridDim.x & 7) == 0) ? (bid & 7) * (int)(gridDim.x >> 3) + (bid >> 3) : bid;
                const attn_body::bf16* qkvb = (const attn_body::bf16*)(p.ws + R_QKV);
                for (int u = vcu; u < 512; u += gridDim.x) {
                    const int bg = (u & 255) >> 6, r = u & 63, hh = r & 3, qb = (r >> 2) + 16 * (u >> 8);
                    const int b = bg >> 1, g = bg & 1;
                    attn_body::attn_unit<8>(b, 4 * g + hh, g, qb, qkvb, qkvb + 512, qkvb + 640, (attn_body::bf16*)(p.ws + R_ATT), lds);
                }
            }
}

__device__ __forceinline__ float convd(const float* row, int l, float w0, float w1, float w2, float cb) {
    float v = cb + w1 * row[l];
    if (l > 0) v += w0 * row[l - 1];
    if (l < SL - 1) v += w2 * row[l + 1];
    return v;
}
__device__ __forceinline__ void hyena_job(const Params& p, int layer, int c, char* lds) {
    const int tid = otid();
    float2* Z = (float2*)lds;
    const float* HF = (const float*)(p.ws + R_HF);
    const float* cw = p.in[I_CW] + (size_t)layer * 3 * 768; const float* cbp = p.in[I_CB] + layer * 768;
    const float2* KF0 = (const float2*)(p.ws + OFF_KF) + ((size_t)(layer * 256 + c) * 2) * 16384;
    const float2* KF1 = KF0 + 16384;
    float* Y = (float*)(p.ws + R_Y) + (size_t)c * T;
    const float bias0 = p.in[I_HB][(layer * 2 + 0) * 256 + c], bias1 = p.in[I_HB][(layer * 2 + 1) * 256 + c];
    const int cv = c, c1 = 256 + c, c2 = 512 + c;
    const float* rv = HF + (size_t)cv * T; const float* r1 = HF + (size_t)c1 * T; const float* r2 = HF + (size_t)c2 * T;
    const float v_w0 = cw[cv], v_w1 = cw[768 + cv], v_w2 = cw[1536 + cv], v_cb = cbp[cv];
    const float a_w0 = cw[c1], a_w1 = cw[768 + c1], a_w2 = cw[1536 + c1], a_cb = cbp[c1];
    const float b_w0 = cw[c2], b_w1 = cw[768 + c2], b_w2 = cw[1536 + c2], b_cb = cbp[c2];
    __syncthreads();
#pragma unroll 4
    for (int i = 0; i < 16; ++i) {
        const int l = tid + NTHR * i;
        Z[l] = make_float2(convd(rv, l, v_w0, v_w1, v_w2, v_cb), convd(rv + SL, l, v_w0, v_w1, v_w2, v_cb));
        Z[8192 + l] = make_float2(0.f, 0.f);
    }
    __syncthreads();
    fft_fwd<14, false>(Z);
#pragma unroll 4
    for (int i = 0; i < 32; ++i) { const int pp = tid + NTHR * i; const float2 z = Z[pp], k = KF0[pp]; Z[pp] = make_float2(z.x * k.x - z.y * k.y, z.x * k.y + z.y * k.x); }
    __syncthreads();
    fft_inv<14, false>(Z);
#pragma unroll 2
    for (int i = 0; i < 16; ++i) {
        const int l = tid + NTHR * i;
        const float2 cvz = Z[l];
        const float v0 = convd(rv, l, v_w0, v_w1, v_w2, v_cb), v1 = convd(rv + SL, l, v_w0, v_w1, v_w2, v_cb);
        const float g0 = convd(r1, l, a_w0, a_w1, a_w2, a_cb), g1 = convd(r1 + SL, l, a_w0, a_w1, a_w2, a_cb);
        const float za = g0 * (cvz.x + v0 * bias0), zb = g1 * (cvz.y + v1 * bias0);
        Y[l] = za; Y[SL + l] = zb;
        Z[l] = make_float2(za, zb);
    }
#pragma unroll 4
    for (int i = 0; i < 16; ++i) { const int l = tid + NTHR * i; Z[8192 + l] = make_float2(0.f, 0.f); }
    __syncthreads();
    fft_fwd<14, false>(Z);
#pragma unroll 4
    for (int i = 0; i < 32; ++i) { const int pp = tid + NTHR * i; const float2 z = Z[pp], k = KF1[pp]; Z[pp] = make_float2(z.x * k.x - z.y * k.y, z.x * k.y + z.y * k.x); }
    __syncthreads();
    fft_inv<14, false>(Z);
#pragma unroll 2
    for (int i = 0; i < 16; ++i) {
        const int l = tid + NTHR * i;
        const float2 cvz = Z[l];
        const float g0 = convd(r2, l, b_w0, b_w1, b_w2, b_cb), g1 = convd(r2 + SL, l, b_w0, b_w1, b_w2, b_cb);
        const float za = Y[l], zb = Y[SL + l];
        Y[l] = g0 * (cvz.x + za * bias1);
        Y[SL + l] = g1 * (cvz.y + zb * bias1);
    }
    __syncthreads();
}

__device__ __forceinline__ void fnet_job(const Params& p, int ch, char* lds) {
    const int tid = otid();
    float2* Z = (float2*)lds;
    const float* row = (const float*)(p.ws + R_HF) + (size_t)(768 + ch) * T;
    float* UR = (float*)(p.ws + R_UR) + (size_t)ch * T;
    float* UI = (float*)(p.ws + R_UI) + (size_t)ch * T;
    __syncthreads();
#pragma unroll 4
    for (int i = 0; i < 16; ++i) { const int l = tid + NTHR * i; Z[zi<true>(l)] = make_float2(row[l], row[SL + l]); }
    __syncthreads();
    fft_fwd<13, true>(Z);
#pragma unroll 4
    for (int i = 0; i < 16; ++i) {
        const int k = tid + NTHR * i;
        const int pk = (int)(__brev((unsigned)k) >> 19);
        const int km = (SL - k) & (SL - 1);
        const int pm = (int)(__brev((unsigned)km) >> 19);
        const float2 zk = Z[zi<true>(pk)], zm = Z[zi<true>(pm)];
        UR[k] = 0.5f * (zk.x + zm.x); UI[k] = 0.5f * (zk.y - zm.y);
        UR[SL + k] = 0.5f * (zk.y + zm.y); UI[SL + k] = 0.5f * (zm.x - zk.x);
    }
    __syncthreads();
}

__device__ __forceinline__ void phase_mix(const Params& p, int layer, char* lds) {
    const int tid = otid(), lane = tid & 63, wave = tid >> 6;
    float* Ul = (float*)lds;
    float* Yl = Ul + 2 * 256 * 33;
    float* Fl = Yl + 256 * 33;
    const float* UR = (const float*)(p.ws + R_UR); const float* UI = (const float*)(p.ws + R_UI);
    const float* Y = (const float*)(p.ws + R_Y);
    const bf16_t* att = (const bf16_t*)(p.ws + R_ATT);
    bf16_t* mix = (bf16_t*)(p.ws + R_MIX);
    const float* FM = (const float*)(p.ws + OFF_FM) + (size_t)layer * 4 * 128 * 64;
    const float* fb = p.in[I_FB] + layer * 256;
    const float* mg = p.in[I_MG] + layer * 1024;
    for (int tile = obid(); tile < T / 32; tile += gridDim.x) {
        const int t0 = tile * 32;
        __syncthreads();
        for (int i = tid; i < 256 * 32; i += NTHR) {
            const int c = i >> 5, tt = i & 31;
            Ul[c * 33 + tt] = UR[(size_t)c * T + t0 + tt];
            Ul[(256 + c) * 33 + tt] = UI[(size_t)c * T + t0 + tt];
            Yl[c * 33 + tt] = Y[(size_t)c * T + t0 + tt];
        }
        __syncthreads();
        {
            const int tok = tid & 31, eo = tid >> 5, g = eo >> 2, e0 = (eo & 3) * 16;
            float acc[16];
#pragma unroll
            for (int j = 0; j < 16; ++j) acc[j] = fb[g * 64 + e0 + j];
            const float* Mg = FM + (size_t)g * 128 * 64 + e0;
            for (int dd = 0; dd < 128; ++dd) {
                const float u = Ul[((dd >> 6) * 256 + g * 64 + (dd & 63)) * 33 + tok];
                const f32x4* mr = (const f32x4*)(Mg + dd * 64);
#pragma unroll
                for (int j4 = 0; j4 < 4; ++j4) { const f32x4 mv = mr[j4]; acc[4 * j4] += u * mv.x; acc[4 * j4 + 1] += u * mv.y; acc[4 * j4 + 2] += u * mv.z; acc[4 * j4 + 3] += u * mv.w; }
            }
#pragma unroll
            for (int j = 0; j < 16; ++j) Fl[tok * 257 + g * 64 + e0 + j] = acc[j];
        }
        __syncthreads();
#pragma unroll
        for (int tt = 0; tt < 4; ++tt) {
            const int tok = wave * 4 + tt; const size_t t = (size_t)(t0 + tok);
            {
                const u32x4 v = *(const u32x4*)(att + t * 512 + lane * 8);
                float x[8] = {bflo(v.x), bfhi(v.x), bflo(v.y), bfhi(v.y), bflo(v.z), bfhi(v.z), bflo(v.w), bfhi(v.w)};
                float ss = 0.f;
#pragma unroll
                for (int j = 0; j < 8; ++j) ss += x[j] * x[j];
                ss = wave_sum(ss);
                const float r = rsqrtf(ss * (1.0f / 512.0f) + EPS);
                const f32x4 g0 = *(const f32x4*)(mg + lane * 8), g1 = *(const f32x4*)(mg + lane * 8 + 4);
                u32x4 o; o.x = pk2(x[0] * r * g0.x, x[1] * r * g0.y); o.y = pk2(x[2] * r * g0.z, x[3] * r * g0.w); o.z = pk2(x[4] * r * g1.x, x[5] * r * g1.y); o.w = pk2(x[6] * r * g1.z, x[7] * r * g1.w);
                *(u32x4*)(mix + t * 1024 + lane * 8) = o;
            }
            {
                float y[4], f[4]; float sy = 0.f, sf = 0.f;
#pragma unroll
                for (int i = 0; i < 4; ++i) { y[i] = Yl[(lane + 64 * i) * 33 + tok]; f[i] = Fl[tok * 257 + lane + 64 * i]; sy += y[i] * y[i]; sf += f[i] * f[i]; }
                sy = wave_sum(sy); sf = wave_sum(sf);
                const float ry = rsqrtf(sy * (1.0f / 256.0f) + EPS), rf = rsqrtf(sf * (1.0f / 256.0f) + EPS);
#pragma unroll
                for (int i = 0; i < 4; ++i) {
                    mix[t * 1024 + 512 + lane + 64 * i] = (bf16_t)f2bf(y[i] * ry * mg[512 + lane + 64 * i]);
                    mix[t * 1024 + 768 + lane + 64 * i] = (bf16_t)f2bf(f[i] * rf * mg[768 + lane + 64 * i]);
                }
            }
        }
    }
}

#define TK_INS(L, X) do { float x_ = (X); _Pragma("unroll") for (int i_ = 0; i_ < 16; ++i_) { const float hi_ = fmaxf(L[i_], x_); x_ = fminf(L[i_], x_); L[i_] = hi_; } } while (0)
__device__ __forceinline__ float tk_pack(float v, unsigned code, unsigned mask) { return __builtin_bit_cast(float, (__builtin_bit_cast(unsigned, v) & ~mask) | code); }
__device__ __forceinline__ unsigned tk_lookup(const unsigned (&P)[4], unsigned i) {
    const unsigned w = (i < 4u) ? P[0] : (i < 8u) ? P[1] : (i < 12u) ? P[2] : P[3];
    return (w >> ((i & 3u) * 8u)) & 0x7Fu;
}
__device__ __forceinline__ void phase_peer_topk(const Params& p, int layer, char* lds, int* IDX, float* GATE) {
    const int tid = otid(), lane = tid & 63, wave = tid >> 6;
    const float* SC = (const float*)(p.ws + R_QP);
    const float NINF = -3.0e38f;
    const int pp = lane & 1;
    const int gw = obid() * NWAVE + wave, ngw = gridDim.x * NWAVE;
    for (int grp = gw; grp < T * 8 / 32; grp += ngw) {
        const int prob = grp * 32 + (lane >> 1);
        const int t = prob >> 3, h = prob & 7;
        const f32x4* src = (const f32x4*)(SC + (size_t)t * 2048 + h * 256 + pp * 128);
        float l[16];
#pragma unroll
        for (int i = 0; i < 16; ++i) l[i] = NINF;
#pragma unroll 1
        for (int c = 0; c < 4; ++c) {
            f32x4 v[8];
#pragma unroll
            for (int j = 0; j < 8; ++j) v[j] = src[c * 8 + j];
#pragma unroll
            for (int j = 0; j < 8; ++j) {
                const unsigned kb = (unsigned)(c * 32 + j * 4);
                TK_INS(l, tk_pack(v[j].x, kb, 0x7Fu)); TK_INS(l, tk_pack(v[j].y, kb + 1u, 0x7Fu));
                TK_INS(l, tk_pack(v[j].z, kb + 2u, 0x7Fu)); TK_INS(l, tk_pack(v[j].w, kb + 3u, 0x7Fu));
            }
        }
        float xv[16], ov[16]; unsigned PX[4] = {0u, 0u, 0u, 0u}, PO[4] = {0u, 0u, 0u, 0u};
#pragma unroll
        for (int i = 0; i < 16; ++i) {
            const float o = __shfl_xor(l[i], 1);
            const unsigned xb = __builtin_bit_cast(unsigned, l[i]), ob = __builtin_bit_cast(unsigned, o);
            xv[i] = __builtin_bit_cast(float, xb & ~0x7Fu); ov[i] = __builtin_bit_cast(float, ob & ~0x7Fu);
            PX[i >> 2] |= (xb & 0x7Fu) << ((i & 3) * 8); PO[i >> 2] |= (ob & 0x7Fu) << ((i & 3) * 8);
        }
        float f[16];
#pragma unroll
        for (int i = 0; i < 16; ++i) f[i] = NINF;
#pragma unroll
        for (int i = 0; i < 16; ++i)
#pragma unroll
            for (int j = i; j < 16; ++j)
                if ((i + 1) * (j + 1) <= 16) {
                    float cv = xv[i] + ov[j];
                    const unsigned code = pp ? (unsigned)((j << 4) | i) : (unsigned)((i << 4) | j);
                    cv = tk_pack(cv, code, 0xFFu);
                    if (i == j) cv = pp ? NINF : cv;
                    TK_INS(f, cv);
                }
        {
            float g[16];
#pragma unroll
            for (int i = 0; i < 16; ++i) g[i] = __shfl_xor(f[i], 1);
#pragma unroll
            for (int i = 0; i < 16; ++i) TK_INS(f, g[i]);
        }
        unsigned P0[4], P1[4];
#pragma unroll
        for (int q = 0; q < 4; ++q) { P0[q] = pp ? PO[q] : PX[q]; P1[q] = pp ? PX[q] : PO[q]; }
        const float top = __builtin_bit_cast(float, __builtin_bit_cast(unsigned, f[0]) & ~0xFFu);
        float ev[16]; int ei[16]; float den = 0.f;
#pragma unroll
        for (int r = 0; r < 16; ++r) {
            const unsigned fb = __builtin_bit_cast(unsigned, f[r]);
            const unsigned code = fb & 0xFFu;
            ei[r] = (int)(tk_lookup(P0, code >> 4) * 128u + tk_lookup(P1, code & 15u));
            ev[r] = __expf(__builtin_bit_cast(float, fb & ~0xFFu) - top);
            den += ev[r];
        }
        const float rden = 1.0f / den;
        const size_t ob = (size_t)t * 2048 + h * 16;
        if (pp == 0) {
#pragma unroll
            for (int q = 0; q < 4; ++q) { int4 w; w.x = ei[4 * q]; w.y = ei[4 * q + 1]; w.z = ei[4 * q + 2]; w.w = ei[4 * q + 3]; *(int4*)(IDX + ob + 4 * q) = w; }
        } else {
#pragma unroll
            for (int q = 0; q < 4; ++q) { f32x4 w; w.x = ev[4 * q] * rden; w.y = ev[4 * q + 1] * rden; w.z = ev[4 * q + 2] * rden; w.w = ev[4 * q + 3] * rden; *(f32x4*)(GATE + ob + 128 + 4 * q) = w; }
        }
    }
}

__device__ __forceinline__ float gelu_exact(float x) { return 0.5f * x * (1.0f + erff(x * 0.70710678118654752f)); }
typedef float f32x2 __attribute__((ext_vector_type(2)));
#define G8_DOT(U, D) do { f32x2 c_; \
    c_ = __builtin_amdgcn_cvt_pk_f32_fp8((int)U.x, false); D = c_.x * xv[0] + c_.y * xv[1]; c_ = __builtin_amdgcn_cvt_pk_f32_fp8((int)U.x, true); D += c_.x * xv[2] + c_.y * xv[3]; \
    c_ = __builtin_amdgcn_cvt_pk_f32_fp8((int)U.y, false); D += c_.x * xv[4] + c_.y * xv[5]; c_ = __builtin_amdgcn_cvt_pk_f32_fp8((int)U.y, true); D += c_.x * xv[6] + c_.y * xv[7]; \
    c_ = __builtin_amdgcn_cvt_pk_f32_fp8((int)U.z, false); D += c_.x * xv[8] + c_.y * xv[9]; c_ = __builtin_amdgcn_cvt_pk_f32_fp8((int)U.z, true); D += c_.x * xv[10] + c_.y * xv[11]; \
    c_ = __builtin_amdgcn_cvt_pk_f32_fp8((int)U.w, false); D += c_.x * xv[12] + c_.y * xv[13]; c_ = __builtin_amdgcn_cvt_pk_f32_fp8((int)U.w, true); D += c_.x * xv[14] + c_.y * xv[15]; } while (0)
#define G8_AXPY(V, A) do { f32x2 c_; \
    c_ = __builtin_amdgcn_cvt_pk_f32_fp8((int)V.x, false); acc[0] += A * c_.x; acc[1] += A * c_.y; c_ = __builtin_amdgcn_cvt_pk_f32_fp8((int)V.x, true); acc[2] += A * c_.x; acc[3] += A * c_.y; \
    c_ = __builtin_amdgcn_cvt_pk_f32_fp8((int)V.y, false); acc[4] += A * c_.x; acc[5] += A * c_.y; c_ = __builtin_amdgcn_cvt_pk_f32_fp8((int)V.y, true); acc[6] += A * c_.x; acc[7] += A * c_.y; \
    c_ = __builtin_amdgcn_cvt_pk_f32_fp8((int)V.z, false); acc[8] += A * c_.x; acc[9] += A * c_.y; c_ = __builtin_amdgcn_cvt_pk_f32_fp8((int)V.z, true); acc[10] += A * c_.x; acc[11] += A * c_.y; \
    c_ = __builtin_amdgcn_cvt_pk_f32_fp8((int)V.w, false); acc[12] += A * c_.x; acc[13] += A * c_.y; c_ = __builtin_amdgcn_cvt_pk_f32_fp8((int)V.w, true); acc[14] += A * c_.x; acc[15] += A * c_.y; } while (0)
__device__ __forceinline__ void phase_peer_gather(const Params& p, int layer) {
    const int lane = otid() & 63, wave = otid() >> 6;
    const int gw = obid() * NWAVE + wave, ngw = gridDim.x * NWAVE;
    const unsigned char* PU = p.ws + OFF_PU + (size_t)layer * 16384 * 1024;
    const unsigned char* PV = p.ws + OFF_PV + (size_t)layer * 16384 * 1024;
    const float* SU = (const float*)(p.ws + OFF_PSC) + (size_t)layer * 16384;
    const float* SV = (const float*)(p.ws + OFF_PSC) + (size_t)(2 + layer) * 16384;
    bf16_t* XN = (bf16_t*)(p.ws + R_XN);
    float* XA = (float*)(p.ws + OFF_XA);
    const float* SC = (const float*)(p.ws + R_QP);
    const bool last = (layer == NLAYER - 1);
    const float* gnext = last ? p.in[I_FG] : p.in[I_N1G] + (layer + 1) * DM;
    for (int t = gw; t < T; t += ngw) {
        float xv[16];
#pragma unroll
        for (int j = 0; j < 4; ++j) {
            const u32x2 a = *(const u32x2*)(XN + (size_t)t * DM + 4 * lane + 256 * j);
            xv[4 * j] = bflo(a.x); xv[4 * j + 1] = bfhi(a.x); xv[4 * j + 2] = bflo(a.y); xv[4 * j + 3] = bfhi(a.y);
        }
        float acc[16];
#pragma unroll
        for (int j = 0; j < 16; ++j) acc[j] = 0.f;
        const int* idxp = (const int*)(SC + (size_t)t * 2048);
        const float* gatep = SC + (size_t)t * 2048 + 128;
#pragma unroll 1
        for (int half = 0; half < 2; ++half) {
            const int myi = idxp[half * 64 + lane];
            const float mycu = SU[myi];
            const float mycg = gatep[half * 64 + lane] * SV[myi];
#pragma unroll 1
            for (int e0 = 0; e0 < 64; e0 += 8) {
                u32x4 ur[8], vr[8];
#pragma unroll
                for (int k = 0; k < 8; ++k) { const int e = __shfl(myi, e0 + k); ur[k] = *(const u32x4*)(PU + (size_t)e * DM + lane * 16); vr[k] = *(const u32x4*)(PV + (size_t)e * DM + lane * 16); }
                float ds[8];
#pragma unroll
                for (int k = 0; k < 8; ++k) { float d; G8_DOT(ur[k], d); ds[k] = d; }
#pragma unroll
                for (int o = 1; o < 64; o <<= 1) {
#pragma unroll
                    for (int k = 0; k < 8; ++k) ds[k] += __shfl_xor(ds[k], o);
                }
#pragma unroll
                for (int k = 0; k < 8; ++k) {
                    const float a = gelu_exact(ds[k] * __shfl(mycu, e0 + k)) * __shfl(mycg, e0 + k);
                    G8_AXPY(vr[k], a);
                }
            }
        }
        f32x4 x[4]; float ss = 0.f;
#pragma unroll
        for (int j = 0; j < 4; ++j) {
            x[j] = *(const f32x4*)(XA + (size_t)t * DM + 4 * lane + 256 * j);
            x[j].x += acc[4 * j]; x[j].y += acc[4 * j + 1]; x[j].z += acc[4 * j + 2]; x[j].w += acc[4 * j + 3];
            ss += x[j].x * x[j].x + x[j].y * x[j].y + x[j].z * x[j].z + x[j].w * x[j].w;
        }
        ss = wave_sum(ss);
        const float r = rsqrtf(ss * (1.0f / DM) + EPS);
        if (last) {
#pragma unroll
            for (int j = 0; j < 4; ++j) { const f32x4 gg = *(const f32x4*)(gnext + 4 * lane + 256 * j); *(f32x4*)(p.out + (size_t)t * DM + 4 * lane + 256 * j) = x[j] * r * gg; }
        } else {
#pragma unroll
            for (int j = 0; j < 4; ++j) {
                const f32x4 gg = *(const f32x4*)(gnext + 4 * lane + 256 * j);
                *(f32x4*)(XA + (size_t)t * DM + 4 * lane + 256 * j) = x[j];
                u32x2 w; w.x = pk2(x[j].x * r * gg.x, x[j].y * r * gg.y); w.y = pk2(x[j].z * r * gg.z, x[j].w * r * gg.w);
                *(u32x2*)(XN + (size_t)t * DM + 4 * lane + 256 * j) = w;
            }
        }
    }
}

#define LAS __attribute__((address_space(3)))
#define XB_TMO      128
#define XB_XCNT(j)  (256  + 64 * (j))
#define XB_XSUB(j)  (1280 + 64 * (j))
#define XB_XGEN(j)  (2304 + 64 * (j))
#define XB_TOP      3328
#define XB_TOPGEN   3392
#define XCD_BAR_WORDS 3456
#define XB_SPIN_CAP (1u << 20)
__device__ __forceinline__ unsigned xb_ld(unsigned* p)              { return __hip_atomic_load(p, __ATOMIC_RELAXED, __HIP_MEMORY_SCOPE_AGENT); }
__device__ __forceinline__ unsigned xb_add(unsigned* p, unsigned v) { return __hip_atomic_fetch_add(p, v, __ATOMIC_RELAXED, __HIP_MEMORY_SCOPE_AGENT); }
__device__ __forceinline__ unsigned xb_xcc_id() { return (unsigned)__builtin_amdgcn_s_getreg((3 << 11) | 20) & 0xFu; }
#define XB_SPIN(cond, bar) do { unsigned _sp = 0; while (cond) { __builtin_amdgcn_s_sleep(1); \
    if ((++_sp & 255u) == 0u) { if (xb_ld(&(bar)[XB_TMO])) break; if (_sp > XB_SPIN_CAP) { atomicAdd(&(bar)[XB_TMO], 1u); break; } } } } while (0)
struct XcdBarrier { unsigned* bar; unsigned x; volatile LAS unsigned* st; };
__device__ __forceinline__ XcdBarrier xcd_barrier_post(unsigned* bar, volatile LAS unsigned* st) {
    XcdBarrier b; b.bar = bar; b.x = xb_xcc_id(); b.st = st;
    if (threadIdx.x == 0) (void)xb_add(&bar[XB_XCNT(b.x)], 1u);
    return b;
}
__device__ __forceinline__ void xcd_barrier_complete(unsigned* bar, unsigned x, unsigned& nloc, unsigned& nx) {
    const unsigned G = gridDim.x * gridDim.y * gridDim.z;
    unsigned sum, cnt, mine, sp = 0u;
    for (;;) {
        sum = 0u; cnt = 0u; mine = 0u;
#pragma unroll
        for (unsigned j = 0; j < 16; ++j) { const unsigned c = xb_ld(&bar[XB_XCNT(j)]); sum += c; cnt += (c > 0u) ? 1u : 0u; mine = (j == x) ? c : mine; }
        if (sum == G) break;
        __builtin_amdgcn_s_sleep(1);
        if ((++sp & 255u) == 0u) { if (xb_ld(&bar[XB_TMO])) break; if (sp > XB_SPIN_CAP) { atomicAdd(&bar[XB_TMO], 1u); break; } }
    }
    nloc = mine > 0u ? mine : 1u; nx = cnt > 0u ? cnt : 1u;
}
__device__ __forceinline__ void xcd_barrier(const XcdBarrier& b) {
    asm volatile("s_waitcnt vmcnt(0)" ::: "memory");
    __syncthreads();
    if (threadIdx.x == 0) {
        unsigned* bar = b.bar;
        __builtin_amdgcn_s_waitcnt(0);
        unsigned nloc = b.st[0], nx = b.st[1];
        if (nloc == 0u) { xcd_barrier_complete(bar, b.x, nloc, nx); b.st[0] = nloc; b.st[1] = nx; }
        const unsigned old = xb_add(&bar[XB_XSUB(b.x)], 1u);
        const unsigned gen = old / nloc;
        if (old + 1u == (gen + 1u) * nloc) {
            __builtin_amdgcn_fence(__ATOMIC_RELEASE, "agent");
            asm volatile("s_waitcnt vmcnt(0)" ::: "memory");
            const unsigned og = xb_add(&bar[XB_TOP], 1u);
            const unsigned tg = og / nx;
            if (og + 1u == (tg + 1u) * nx) xb_add(&bar[XB_TOPGEN], 1u);
            else XB_SPIN(xb_ld(&bar[XB_TOPGEN]) == tg, bar);
            __builtin_amdgcn_fence(__ATOMIC_ACQUIRE, "agent");
            xb_add(&bar[XB_XGEN(b.x)], 1u);
            asm volatile("s_waitcnt vmcnt(0)" ::: "memory");
        } else {
            XB_SPIN(xb_ld(&bar[XB_XGEN(b.x)]) == gen, bar);
            __builtin_amdgcn_fence(__ATOMIC_ACQUIRE, "agent");
            asm volatile("s_waitcnt vmcnt(0)" ::: "memory");
        }
    }
    __syncthreads();
}

__global__ void __launch_bounds__(NTHR) mega_kernel(Params p) {
    extern __shared__ __attribute__((aligned(16))) char lds[];
    cg::grid_group grid = cg::this_grid();
    volatile LAS unsigned* misc = (volatile LAS unsigned*)((LAS char*)lds + LDS_MISC);
    if (threadIdx.x < 16) misc[threadIdx.x] = 0u;
    __syncthreads();
    const XcdBarrier xbar = xcd_barrier_post((unsigned*)(p.ws + OFF_CTL) + 4096, misc);
#define GSYNC() xcd_barrier(xbar)
    float* XA = (float*)(p.ws + OFF_XA);
#if PROBE == 7
    phase_p0(p, lds); GSYNC();
#endif
    phase_p0(p, lds);
    phase_rmsnorm_bf16(p.in[I_X], p.in[I_N1G], (bf16_t*)(p.ws + R_XN));
    grid.sync();
#pragma nounroll
    for (int layer = 0; layer < NLAYER; ++layer) {
        const float* xin = layer == 0 ? p.in[I_X] : XA;
#if PROBE == 10
        { EpiIn e{(bf16_t*)(p.ws + R_QKV), (float*)(p.ws + R_HF)};
          gemm_phase((const bf16_t*)(p.ws + R_XN), (const bf16_t*)(p.ws + OFF_WTIN) + (size_t)layer * INC * DM, T, INC, DM, lds, e); } GSYNC();
#endif
        { EpiIn e{(bf16_t*)(p.ws + R_QKV), (float*)(p.ws + R_HF)};
          gemm_phase((const bf16_t*)(p.ws + R_XN), (const bf16_t*)(p.ws + OFF_WTIN) + (size_t)layer * INC * DM, T, INC, DM, lds, e); }
        if (layer == 0) {
            phase_filter_spectra(p, lds);
#if PROBE == 13
            phase_filter_spectra(p, lds);
#endif
        }
        GSYNC();
#if PROBE == 12
        phase_qkprep(p, layer, lds, (bf16_t*)(p.ws + R_ATT)); GSYNC();
#endif
        phase_qkprep(p, layer, lds, (bf16_t*)(p.ws + R_QKV)); GSYNC();
        {
#if PROBE == 5
            phase_attn(p, lds);
#endif
#if PROBE == 6
            for (int c = obid(); c < 256; c += gridDim.x) hyena_job(p, layer, c, lds);
            for (int c = obid(); c < 256; c += gridDim.x) fnet_job(p, c, lds);
#endif
            phase_attn(p, lds);
            for (int c = obid(); c < 256; c += gridDim.x) hyena_job(p, layer, c, lds);
            for (int c = obid(); c < 256; c += gridDim.x) fnet_job(p, c, lds);
        } GSYNC();
#if PROBE == 8
        phase_mix(p, layer, lds); GSYNC();
#endif
        phase_mix(p, layer, lds); GSYNC();
#if PROBE == 11
        { EpiRes e{xin, p.out};
          gemm_phase((const bf16_t*)(p.ws + R_MIX), (const bf16_t*)(p.ws + OFF_WTOUT) + (size_t)layer * DM * DM, T, DM, DM, lds, e); } GSYNC();
#endif
        { EpiRes e{xin, XA};
          gemm_phase((const bf16_t*)(p.ws + R_MIX), (const bf16_t*)(p.ws + OFF_WTOUT) + (size_t)layer * DM * DM, T, DM, DM, lds, e); } GSYNC();
        phase_rmsnorm_bf16(XA, p.in[I_N2G] + layer * DM, (bf16_t*)(p.ws + R_XN)); GSYNC();
#if PROBE == 3
        { EpiF32 e{(float*)(p.ws + R_QP), 2048};
          gemm_phase((const bf16_t*)(p.ws + R_XN), (const bf16_t*)(p.ws + OFF_WTQ) + (size_t)layer * 2048 * DM, T, 2048, DM, lds, e); } GSYNC();
#endif
        { EpiF32 e{(float*)(p.ws + R_QP), 2048};
          gemm_phase((const bf16_t*)(p.ws + R_XN), (const bf16_t*)(p.ws + OFF_WTQ) + (size_t)layer * 2048 * DM, T, 2048, DM, lds, e); } GSYNC();
        phase_peer_topk(p, layer, lds, (int*)(p.ws + R_QP), (float*)(p.ws + R_QP)); GSYNC();
        phase_peer_gather(p, layer);
        if (layer + 1 < NLAYER) GSYNC();
    }
}

extern "C" void kernel_launch(void* const* d_in, const int* in_sizes, int n_in, void* d_out, int out_size, void* d_ws, size_t ws_size, hipStream_t stream) {
    static int grid = 0;
    if (grid == 0) {
        if (n_in != 25 || out_size != T * DM || ws_size < WS_NEED) { fprintf(stderr, "kernel_launch: unexpected sizes n_in %d out %d ws %zu (need %zu)\n", n_in, out_size, ws_size, (size_t)WS_NEED); grid = -1; return; }
        int dev = 0, cus = 0, per_cu = 0;
        if (hipGetDevice(&dev) != hipSuccess || hipDeviceGetAttribute(&cus, hipDeviceAttributeMultiprocessorCount, dev) != hipSuccess) { grid = -1; return; }
        if (hipFuncSetAttribute((const void*)mega_kernel, hipFuncAttributeMaxDynamicSharedMemorySize, LDS_BYTES) != hipSuccess) { fprintf(stderr, "kernel_launch: hipFuncSetAttribute failed\n"); grid = -1; return; }
        if (hipOccupancyMaxActiveBlocksPerMultiprocessor(&per_cu, (const void*)mega_kernel, NTHR, LDS_BYTES) != hipSuccess || per_cu < 1) { fprintf(stderr, "kernel_launch: occupancy query says %d blocks per CU\n", per_cu); grid = -1; return; }
        (void)hipGetLastError();
        grid = cus;
    }
    if (grid < 0) return;
    Params p{};
    for (int i = 0; i < 25; ++i) p.in[i] = (const float*)d_in[i];
    p.out = (float*)d_out; p.ws = (unsigned char*)d_ws;
    if (hipMemsetAsync((char*)d_ws + OFF_CTL, 0, 64 * 1024, stream) != hipSuccess) { fprintf(stderr, "kernel_launch: memset failed\n"); return; }
    void* args[] = {&p};
    hipError_t e = hipLaunchCooperativeKernel((const void*)mega_kernel, dim3(grid), dim3(NTHR), args, LDS_BYTES, stream);
    if (e != hipSuccess) fprintf(stderr, "cooperative launch failed: %s (grid %d)\n", hipGetErrorString(e), grid);
}
```

```cpp
#include <hip/hip_runtime.h>
#include <hip/hip_cooperative_groups.h>
#include <cstdio>
#include <cstdint>
namespace cg = cooperative_groups;

#ifndef PROBE
#define PROBE 0
#endif

typedef unsigned short bf16_t;
typedef short bf16x8 __attribute__((ext_vector_type(8)));
typedef float f32x16 __attribute__((ext_vector_type(16)));
typedef float f32x4 __attribute__((ext_vector_type(4)));
typedef unsigned u32x4 __attribute__((ext_vector_type(4)));
typedef unsigned u32x2 __attribute__((ext_vector_type(2)));

constexpr int DM = 1024, NB = 2, SL = 8192, T = NB * SL, NLAYER = 2;
constexpr int INC = 1792;
constexpr int NTHR = 512, NWAVE = 8;
constexpr int LDS_BYTES = 147456;
constexpr int LDS_MISC = LDS_BYTES - 64;
constexpr float EPS = 1e-6f;

constexpr size_t MiB = 1u << 20;
constexpr size_t OFF_CTL = 0;
constexpr size_t OFF_WTIN = 1 * MiB;
constexpr size_t OFF_WTOUT = 8 * MiB;
constexpr size_t OFF_WTQ = 12 * MiB;
constexpr size_t OFF_PU = 20 * MiB;
constexpr size_t OFF_PV = 84 * MiB;
constexpr size_t OFF_PSC = 512 * 1024;
constexpr size_t OFF_H2 = 148 * MiB;
constexpr size_t OFF_W3T = 150 * MiB;
constexpr size_t OFF_HFILT0 = 52 * MiB, OFF_HFILT1 = 116 * MiB;
constexpr size_t OFF_FM = 152 * MiB;
constexpr size_t OFF_KF = 153 * MiB;
constexpr size_t OFF_XA = 281 * MiB;
constexpr size_t OFF_R = 345 * MiB;
constexpr size_t R_XN = OFF_R + 0 * MiB;
constexpr size_t R_UR = OFF_R + 0 * MiB;
constexpr size_t R_UI = OFF_R + 16 * MiB;
constexpr size_t R_QKV = OFF_R + 32 * MiB;
constexpr size_t R_VT = OFF_R + 56 * MiB;
constexpr size_t R_HF = OFF_R + 60 * MiB;
constexpr size_t R_MIX = OFF_R + 60 * MiB;
constexpr size_t R_ATT = OFF_R + 124 * MiB;
constexpr size_t R_Y = OFF_R + 140 * MiB;
constexpr size_t R_QP = OFF_R + 32 * MiB;
constexpr size_t WS_NEED = 505 * MiB;

struct Params {
    const float* in[25];
    float* out;
    unsigned char* ws;
};
enum { I_X = 0, I_N1G, I_WIN, I_QG, I_KG, I_CW, I_CB, I_W1, I_B1, I_F1, I_W2, I_B2, I_F2, I_W3, I_HB, I_FW, I_FB, I_MG, I_WOUT, I_N2G, I_WQ, I_SK, I_PU, I_PV, I_FG };

__device__ __forceinline__ unsigned f2bf(float f) { unsigned u = __builtin_bit_cast(unsigned, f); return (u + 0x7fffu + ((u >> 16) & 1u)) >> 16; }
__device__ __forceinline__ unsigned pk2(float lo, float hi) { return f2bf(lo) | (f2bf(hi) << 16); }
__device__ __forceinline__ float bf2f(unsigned b) { return __builtin_bit_cast(float, b << 16); }
__device__ __forceinline__ float bflo(unsigned w) { return __builtin_bit_cast(float, w << 16); }
__device__ __forceinline__ float bfhi(unsigned w) { return __builtin_bit_cast(float, w & 0xffff0000u); }
__device__ __forceinline__ float wave_sum(float v) {
#pragma unroll
    for (int o = 1; o < 64; o <<= 1) v += __shfl_xor(v, o);
    return v;
}
__device__ __forceinline__ float wave_max(float v) {
#pragma unroll
    for (int o = 1; o < 64; o <<= 1) v = fmaxf(v, __shfl_xor(v, o));
    return v;
}
__device__ __forceinline__ f32x16 mfma32(bf16x8 a, bf16x8 b, f32x16 c) { return __builtin_amdgcn_mfma_f32_32x32x16_bf16(a, b, c, 0, 0, 0); }
__device__ __forceinline__ f32x16 zero16() { return (f32x16){0.f,0.f,0.f,0.f,0.f,0.f,0.f,0.f,0.f,0.f,0.f,0.f,0.f,0.f,0.f,0.f}; }


__device__ __forceinline__ int otid() { int t = threadIdx.x; asm volatile("" : "+v"(t)); return t; }
__device__ __forceinline__ int obid() { int b = blockIdx.x; asm volatile("" : "+s"(b)); return b; }
__device__ __forceinline__ void transpose_one(const float* W, int K, int N, bf16_t* Wt, float* tile, int item) {
    const int tid = otid();
    const int nblk = N / 64, kb = item / nblk, nb = item % nblk, k0 = kb * 64, n0 = nb * 64;
    __syncthreads();
    {
        const int r = tid >> 6, c = tid & 63;
#pragma unroll
        for (int i = 0; i < 8; ++i) { const int k = r + 8 * i; tile[k * 65 + c] = W[(size_t)(k0 + k) * N + n0 + c]; }
    }
    __syncthreads();
    {
        const int nn = tid >> 3, kc = tid & 7;
        const float* s = tile + (kc * 8) * 65 + nn;
        u32x4 o; o.x = pk2(s[0], s[65]); o.y = pk2(s[2 * 65], s[3 * 65]); o.z = pk2(s[4 * 65], s[5 * 65]); o.w = pk2(s[6 * 65], s[7 * 65]);
        *(u32x4*)(Wt + (size_t)(n0 + nn) * K + k0 + kc * 8) = o;
    }
}

__device__ __forceinline__ void phase_p0(const Params& p, char* lds) {
    const int tid = otid();
    float* tile = (float*)lds;
    constexpr int IT_IN = (DM / 64) * (INC / 64), IT_OUT = (DM / 64) * (DM / 64), IT_W3 = 1024 / 64;
    constexpr int IT_L = IT_IN + IT_OUT + IT_W3;
    for (int it = obid(); it < NLAYER * IT_L; it += gridDim.x) {
        const int layer = it / IT_L; int r = it % IT_L;
        if (r < IT_IN) { transpose_one(p.in[I_WIN] + (size_t)layer * DM * INC, DM, INC, (bf16_t*)(p.ws + OFF_WTIN) + (size_t)layer * INC * DM, tile, r); continue; }
        r -= IT_IN;
        if (r < IT_OUT) { transpose_one(p.in[I_WOUT] + (size_t)layer * DM * DM, DM, DM, (bf16_t*)(p.ws + OFF_WTOUT) + (size_t)layer * DM * DM, tile, r); continue; }
        r -= IT_OUT;
        transpose_one(p.in[I_W3] + (size_t)layer * 64 * 1024, 64, 1024, (bf16_t*)(p.ws + OFF_W3T) + (size_t)layer * 1024 * 64, tile, r);
    }
    __syncthreads();
    {
        float* SKl = (float*)lds;
        float* Wl = SKl + 128 * 129;
        for (int it = obid(); it < NLAYER * 16 * 16; it += gridDim.x) {
            const int layer = it >> 8, hp = (it >> 4) & 15, kc = it & 15, h = hp >> 1, pp = hp & 1, k0 = kc * 64;
            const float* sk = p.in[I_SK] + (((size_t)(layer * 2 + pp) * 8 + h) * 128) * 128;
            const float* wq = p.in[I_WQ] + (size_t)layer * DM * 2048 + (size_t)k0 * 2048 + h * 256 + pp * 128;
            __syncthreads();
            for (int i = tid; i < 128 * 128; i += NTHR) SKl[(i >> 7) * 129 + (i & 127)] = sk[i];
            for (int i = tid; i < 64 * 128; i += NTHR) Wl[(i >> 7) * 132 + (i & 127)] = wq[(size_t)(i >> 7) * 2048 + (i & 127)];
            __syncthreads();
            const int key = tid & 127, kq = tid >> 7;
            float acc[16];
#pragma unroll
            for (int j = 0; j < 16; ++j) acc[j] = 0.f;
            for (int d4 = 0; d4 < 32; ++d4) {
                const float a0 = SKl[key * 129 + d4 * 4], a1 = SKl[key * 129 + d4 * 4 + 1], a2 = SKl[key * 129 + d4 * 4 + 2], a3 = SKl[key * 129 + d4 * 4 + 3];
#pragma unroll
                for (int j = 0; j < 16; ++j) { const f32x4 w = *(const f32x4*)(Wl + (kq * 16 + j) * 132 + d4 * 4); acc[j] += a0 * w.x + a1 * w.y + a2 * w.z + a3 * w.w; }
            }
            bf16_t* dst = (bf16_t*)(p.ws + OFF_WTQ) + (size_t)layer * 2048 * DM + (size_t)(hp * 128 + key) * DM + k0 + kq * 16;
            u32x4 o0, o1;
            o0.x = pk2(acc[0], acc[1]); o0.y = pk2(acc[2], acc[3]); o0.z = pk2(acc[4], acc[5]); o0.w = pk2(acc[6], acc[7]);
            o1.x = pk2(acc[8], acc[9]); o1.y = pk2(acc[10], acc[11]); o1.z = pk2(acc[12], acc[13]); o1.w = pk2(acc[14], acc[15]);
            *(u32x4*)dst = o0; *(u32x4*)(dst + 8) = o1;
        }
        __syncthreads();
    }
    {
        const int lane = tid & 63, wave = tid >> 6;
        float* scl = (float*)(p.ws + OFF_PSC);
        for (int row = obid() * NWAVE + wave; row < 2 * NLAYER * 16384; row += gridDim.x * NWAVE) {
            const int tb = row >> 15, r = row & 32767;
            const f32x4* src = (const f32x4*)(p.in[tb ? I_PV : I_PU] + (size_t)r * DM) + lane;
            f32x4 v[4]; float mx = 0.f;
#pragma unroll
            for (int j = 0; j < 4; ++j) { v[j] = src[64 * j]; mx = fmaxf(mx, fmaxf(fmaxf(fabsf(v[j].x), fabsf(v[j].y)), fmaxf(fabsf(v[j].z), fabsf(v[j].w)))); }
            mx = wave_max(mx);
            const float sc = mx > 0.f ? 224.0f / mx : 1.0f;
            u32x4 o;
            { int w = 0; w = __builtin_amdgcn_cvt_pk_fp8_f32(v[0].x * sc, v[0].y * sc, w, false); w = __builtin_amdgcn_cvt_pk_fp8_f32(v[0].z * sc, v[0].w * sc, w, true); o.x = (unsigned)w; }
            { int w = 0; w = __builtin_amdgcn_cvt_pk_fp8_f32(v[1].x * sc, v[1].y * sc, w, false); w = __builtin_amdgcn_cvt_pk_fp8_f32(v[1].z * sc, v[1].w * sc, w, true); o.y = (unsigned)w; }
            { int w = 0; w = __builtin_amdgcn_cvt_pk_fp8_f32(v[2].x * sc, v[2].y * sc, w, false); w = __builtin_amdgcn_cvt_pk_fp8_f32(v[2].z * sc, v[2].w * sc, w, true); o.z = (unsigned)w; }
            { int w = 0; w = __builtin_amdgcn_cvt_pk_fp8_f32(v[3].x * sc, v[3].y * sc, w, false); w = __builtin_amdgcn_cvt_pk_fp8_f32(v[3].z * sc, v[3].w * sc, w, true); o.w = (unsigned)w; }
            *(u32x4*)(p.ws + (tb ? OFF_PV : OFF_PU) + (size_t)r * DM + lane * 16) = o;
            if (lane == 0) scl[row] = mx > 0.f ? mx / 224.0f : 1.0f;
        }
    }
    {
        float* sh = (float*)lds;
        float* zl = sh + 8 * 64;
        const int sub = tid >> 6, j = tid & 63;
        for (int it = obid(); it < NLAYER * SL / 8; it += gridDim.x) {
            const int layer = it / (SL / 8), l = (it % (SL / 8)) * 8 + sub;
            const float t = (float)l / (float)(SL - 1);
            __syncthreads();
            if (j < 17) {
                float z;
                if (j == 0) z = t;
                else if (j <= 8) z = sinf(2.0f * 3.14159265358979323846f * t * (float)j);
                else z = cosf(2.0f * 3.14159265358979323846f * t * (float)(j - 8));
                zl[sub * 17 + j] = z;
            }
            __syncthreads();
            const float* w1 = p.in[I_W1] + layer * 17 * 64;
            float a = p.in[I_B1][layer * 64 + j];
#pragma unroll
            for (int i = 0; i < 17; ++i) a += zl[sub * 17 + i] * w1[i * 64 + j];
            sh[sub * 64 + j] = sinf(p.in[I_F1][layer * 64 + j] * a);
            __syncthreads();
            const float* w2 = p.in[I_W2] + layer * 64 * 64;
            float b = p.in[I_B2][layer * 64 + j];
#pragma unroll 8
            for (int k = 0; k < 64; ++k) b += sh[sub * 64 + k] * w2[k * 64 + j];
            ((bf16_t*)(p.ws + OFF_H2))[((size_t)layer * SL + l) * 64 + j] = (bf16_t)f2bf(sinf(p.in[I_F2][layer * 64 + j] * b));
        }
    }
    {
        const int total = NLAYER * 4 * 128 * 64;
        for (int o = obid() * NTHR + tid; o < total; o += gridDim.x * NTHR) {
            const int e2 = o & 63, dd = (o >> 6) & 127, g = (o >> 13) & 3, layer = o >> 15;
            const int d = dd & 63;
            const float* w = p.in[I_FW] + ((size_t)(layer * 4 + g) * 64) * 64;
            float acc = 0.f;
            for (int e = 0; e < 64; ++e) {
                const int m = (d * e) & 63;
                const float ang = (float)m * (2.0f * 3.14159265358979323846f / 64.0f);
                const float tw = (dd < 64) ? cosf(ang) : sinf(ang);
                acc += tw * w[e * 64 + e2];
            }
            ((float*)(p.ws + OFF_FM))[o] = acc * (1.0f / 724.0773439350246f);
        }
    }
}

template <bool PAD> __device__ __forceinline__ int zi(int i) { return PAD ? i + (i >> 8) : i; }

template <int LOGN, bool PAD>
__device__ __forceinline__ void fft_fwd(float2* Z) {
    constexpr int N = 1 << LOGN;
    const int tid = otid();
    int s = 0;
    for (; s + 1 < LOGN; s += 2) {
        const int lh2 = LOGN - s - 2;
        const int h2 = 1 << lh2, h = h2 << 1;
        const float rs = 1.0f / (float)(h << 1);
        for (int q = tid; q < N / 4; q += NTHR) {
            const int j = q & (h2 - 1), blk = q >> lh2;
            const int base = (blk << (lh2 + 2)) + j;
            float2 x0 = Z[zi<PAD>(base)], x1 = Z[zi<PAD>(base + h2)], x2 = Z[zi<PAD>(base + h)], x3 = Z[zi<PAD>(base + h + h2)];
            const float ang = (float)j * rs;
            const float c = __builtin_amdgcn_cosf(ang), sn = __builtin_amdgcn_sinf(ang);
            float2 a0 = make_float2(x0.x + x2.x, x0.y + x2.y);
            float2 d02 = make_float2(x0.x - x2.x, x0.y - x2.y);
            float2 a2 = make_float2(d02.x * c + d02.y * sn, d02.y * c - d02.x * sn);
            float2 a1 = make_float2(x1.x + x3.x, x1.y + x3.y);
            float2 d13 = make_float2(x1.x - x3.x, x1.y - x3.y);
            float2 t3 = make_float2(d13.x * c + d13.y * sn, d13.y * c - d13.x * sn);
            float2 a3 = make_float2(t3.y, -t3.x);
            const float c2 = c * c - sn * sn, s2 = 2.f * c * sn;
            float2 y0 = make_float2(a0.x + a1.x, a0.y + a1.y);
            float2 e01 = make_float2(a0.x - a1.x, a0.y - a1.y);
            float2 y1 = make_float2(e01.x * c2 + e01.y * s2, e01.y * c2 - e01.x * s2);
            float2 y2 = make_float2(a2.x + a3.x, a2.y + a3.y);
            float2 e23 = make_float2(a2.x - a3.x, a2.y - a3.y);
            float2 y3 = make_float2(e23.x * c2 + e23.y * s2, e23.y * c2 - e23.x * s2);
            Z[zi<PAD>(base)] = y0; Z[zi<PAD>(base + h2)] = y1; Z[zi<PAD>(base + h)] = y2; Z[zi<PAD>(base + h + h2)] = y3;
        }
        __syncthreads();
    }
    if (s < LOGN) {
        for (int q = tid; q < N / 2; q += NTHR) {
            const int i0 = 2 * q;
            float2 a = Z[zi<PAD>(i0)], b = Z[zi<PAD>(i0 + 1)];
            Z[zi<PAD>(i0)] = make_float2(a.x + b.x, a.y + b.y);
            Z[zi<PAD>(i0 + 1)] = make_float2(a.x - b.x, a.y - b.y);
        }
        __syncthreads();
    }
}

template <int LOGN, bool PAD>
__device__ __forceinline__ void fft_inv(float2* Z) {
    constexpr int N = 1 << LOGN;
    const int tid = otid();
    for (int s = LOGN - 2; s >= 0; s -= 2) {
        const int lh2 = LOGN - s - 2;
        const int h2 = 1 << lh2, h = h2 << 1;
        const float rs = 1.0f / (float)(h << 1);
        for (int q = tid; q < N / 4; q += NTHR) {
            const int j = q & (h2 - 1), blk = q >> lh2;
            const int base = (blk << (lh2 + 2)) + j;
            float2 y0 = Z[zi<PAD>(base)], y1 = Z[zi<PAD>(base + h2)], y2 = Z[zi<PAD>(base + h)], y3 = Z[zi<PAD>(base + h + h2)];
            const float ang = (float)j * rs;
            const float c = __builtin_amdgcn_cosf(ang), sn = __builtin_amdgcn_sinf(ang);
            const float c2 = c * c - sn * sn, s2 = 2.f * c * sn;
            float2 t1 = make_float2(y1.x * c2 - y1.y * s2, y1.y * c2 + y1.x * s2);
            float2 t3 = make_float2(y3.x * c2 - y3.y * s2, y3.y * c2 + y3.x * s2);
            float2 a0 = make_float2(y0.x + t1.x, y0.y + t1.y), a1 = make_float2(y0.x - t1.x, y0.y - t1.y);
            float2 a2 = make_float2(y2.x + t3.x, y2.y + t3.y), a3 = make_float2(y2.x - t3.x, y2.y - t3.y);
            float2 u2 = make_float2(a2.x * c - a2.y * sn, a2.y * c + a2.x * sn);
            float2 u3 = make_float2(a3.x * c - a3.y * sn, a3.y * c + a3.x * sn);
            float2 v3 = make_float2(-u3.y, u3.x);
            Z[zi<PAD>(base)] = make_float2(a0.x + u2.x, a0.y + u2.y);
            Z[zi<PAD>(base + h)] = make_float2(a0.x - u2.x, a0.y - u2.y);
            Z[zi<PAD>(base + h2)] = make_float2(a1.x + v3.x, a1.y + v3.y);
            Z[zi<PAD>(base + h + h2)] = make_float2(a1.x - v3.x, a1.y - v3.y);
        }
        __syncthreads();
    }
}

__device__ __forceinline__ void phase_filter_spectra(const Params& p, char* lds) {
    const int tid = otid(), lane = tid & 63, wave = tid >> 6;
    float2* Z = (float2*)lds;
    float* red = (float*)(lds + 131072);
    for (int job = obid(); job < NLAYER * 256; job += gridDim.x) {
        const int layer = job >> 8, c = job & 255;
        __syncthreads();
        const float* HFc = (const float*)(p.ws + (layer ? OFF_HFILT1 : OFF_HFILT0)) + (size_t)c * SL;
        const float r_lo = 4.605170185988092f / 1.5f, r_hi = 4.605170185988092f / 0.3f;
        const float rate = r_lo + (r_hi - r_lo) * ((float)c / 255.0f);
        float ss0 = 0.f, ss1 = 0.f;
#pragma unroll 1
        for (int i = 0; i < 4; ++i) {
            const int l0 = 4 * tid + 2048 * i;
            const f32x4 a0 = *(const f32x4*)(HFc + l0), a1 = *(const f32x4*)(HFc + (size_t)256 * SL + l0);
            const f32x4 a2 = *(const f32x4*)(HFc + (size_t)512 * SL + l0), a3 = *(const f32x4*)(HFc + (size_t)768 * SL + l0);
#pragma unroll
            for (int e = 0; e < 4; ++e) {
                const int l = l0 + e;
                const float t = (float)l / (float)(SL - 1);
                const float dec = expf(-t * rate);
                const float f0 = a0[e] * dec, b0 = a1[e] * dec, f1 = a2[e] * dec, b1 = a3[e] * dec;
                ss0 += f0 * f0 + b0 * b0; ss1 += f1 * f1 + b1 * b1;
                Z[l] = make_float2(f0, f1);
                if (l >= 1) Z[16384 - l] = make_float2(b0, b1);
            }
        }
        if (tid == 0) Z[8192] = make_float2(0.f, 0.f);
        ss0 = wave_sum(ss0); ss1 = wave_sum(ss1);
        if (lane == 0) { red[wave * 2] = ss0; red[wave * 2 + 1] = ss1; }
        __syncthreads();
        float t0 = 0.f, t1 = 0.f;
#pragma unroll
        for (int w = 0; w < 8; ++w) { t0 += red[w * 2]; t1 += red[w * 2 + 1]; }
        const float sc0 = rsqrtf(t0 + EPS) * (1.0f / 16384.0f) * 0.5f, sc1 = rsqrtf(t1 + EPS) * (1.0f / 16384.0f) * 0.5f;
        fft_fwd<14, false>(Z);
        float2* KF0 = (float2*)(p.ws + OFF_KF) + ((size_t)(layer * 256 + c) * 2) * 16384;
        float2* KF1 = KF0 + 16384;
        for (int i = 0; i < 32; ++i) {
            const int pp = tid + NTHR * i;
            const int f = (int)(__brev((unsigned)pp) >> 18);
            const int fm = (16384 - f) & 16383;
            const int pq = (int)(__brev((unsigned)fm) >> 18);
            const float2 zp = Z[pp], zq = Z[pq];
            KF0[pp] = make_float2((zp.x + zq.x) * sc0, (zp.y - zq.y) * sc0);
            KF1[pp] = make_float2((zp.y + zq.y) * sc1, (zq.x - zp.x) * sc1);
        }
    }
}

__device__ __forceinline__ void phase_rmsnorm_bf16(const float* x, const float* g, bf16_t* out) {
    const int lane = otid() & 63, wave = otid() >> 6;
    const int gw = obid() * NWAVE + wave, ngw = gridDim.x * NWAVE;
    for (int row = gw; row < T; row += ngw) {
        const f32x4* xr = (const f32x4*)(x + (size_t)row * DM) + lane;
        f32x4 v[4]; float ss = 0.f;
#pragma unroll
        for (int j = 0; j < 4; ++j) { v[j] = xr[64 * j]; ss += v[j].x * v[j].x + v[j].y * v[j].y + v[j].z * v[j].z + v[j].w * v[j].w; }
        ss = wave_sum(ss);
        const float r = rsqrtf(ss * (1.0f / DM) + EPS);
        u32x2* o = (u32x2*)(out + (size_t)row * DM) + lane;
#pragma unroll
        for (int j = 0; j < 4; ++j) {
            const f32x4 gg = ((const f32x4*)g)[lane + 64 * j];
            u32x2 w; w.x = pk2(v[j].x * r * gg.x, v[j].y * r * gg.y); w.y = pk2(v[j].z * r * gg.z, v[j].w * r * gg.w);
            o[64 * j] = w;
        }
    }
}
__device__ __forceinline__ void phase_final_norm(const float* x, const float* g, float* out) {
    const int lane = otid() & 63, wave = otid() >> 6;
    const int gw = obid() * NWAVE + wave, ngw = gridDim.x * NWAVE;
    for (int row = gw; row < T; row += ngw) {
        const f32x4* xr = (const f32x4*)(x + (size_t)row * DM) + lane;
        f32x4 v[4]; float ss = 0.f;
#pragma unroll
        for (int j = 0; j < 4; ++j) { v[j] = xr[64 * j]; ss += v[j].x * v[j].x + v[j].y * v[j].y + v[j].z * v[j].z + v[j].w * v[j].w; }
        ss = wave_sum(ss);
        const float r = rsqrtf(ss * (1.0f / DM) + EPS);
        f32x4* o = (f32x4*)(out + (size_t)row * DM) + lane;
#pragma unroll
        for (int j = 0; j < 4; ++j) { const f32x4 gg = ((const f32x4*)g)[lane + 64 * j]; o[64 * j] = v[j] * r * gg; }
    }
}

constexpr int G_LDA = 144;
template <class Epi>
__device__ __forceinline__ void gemm_phase(const bf16_t* A, const bf16_t* Bt, int M, int N, int K, char* lds, const Epi& epi) {
    const int tid = otid(), lane = tid & 63, wave = tid >> 6;
    const int wm = wave >> 1, wn = wave & 1;
    const int nMt = M / 256, nNt = N / 128, total = nMt * nNt, nk = K / 64;
    char* As = lds; char* Bs = lds + 256 * G_LDA;
    const int l31 = lane & 31, hl = lane >> 5;
    for (int u = obid(); u < total; u += gridDim.x) {
        const int mt = u % nMt, nt = u / nMt;
        f32x16 acc[2][2];
#pragma unroll
        for (int i = 0; i < 2; ++i)
#pragma unroll
            for (int j = 0; j < 2; ++j) acc[i][j] = zero16();
        u32x4 ra[4], rb[2];
        const bf16_t* Ab = A + (size_t)(mt * 256) * K;
        const bf16_t* Bb = Bt + (size_t)(nt * 128) * K;
#pragma unroll
        for (int i = 0; i < 4; ++i) { const int id = tid + NTHR * i, row = id >> 3, ch = id & 7; ra[i] = *(const u32x4*)(Ab + (size_t)row * K + ch * 8); }
#pragma unroll
        for (int i = 0; i < 2; ++i) { const int id = tid + NTHR * i, row = id >> 3, ch = id & 7; rb[i] = *(const u32x4*)(Bb + (size_t)row * K + ch * 8); }
        for (int kt = 0; kt < nk; ++kt) {
            __syncthreads();
#pragma unroll
            for (int i = 0; i < 4; ++i) { const int id = tid + NTHR * i, row = id >> 3, ch = id & 7; *(u32x4*)(As + row * G_LDA + ch * 16) = ra[i]; }
#pragma unroll
            for (int i = 0; i < 2; ++i) { const int id = tid + NTHR * i, row = id >> 3, ch = id & 7; *(u32x4*)(Bs + row * G_LDA + ch * 16) = rb[i]; }
            __syncthreads();
            if (kt + 1 < nk) {
                const int ko = (kt + 1) * 64;
#pragma unroll
                for (int i = 0; i < 4; ++i) { const int id = tid + NTHR * i, row = id >> 3, ch = id & 7; ra[i] = *(const u32x4*)(Ab + (size_t)row * K + ko + ch * 8); }
#pragma unroll
                for (int i = 0; i < 2; ++i) { const int id = tid + NTHR * i, row = id >> 3, ch = id & 7; rb[i] = *(const u32x4*)(Bb + (size_t)row * K + ko + ch * 8); }
            }
#pragma unroll
            for (int ks = 0; ks < 4; ++ks) {
                bf16x8 a[2], b[2];
#pragma unroll
                for (int i = 0; i < 2; ++i) a[i] = *(const bf16x8*)(As + (wm * 64 + i * 32 + l31) * G_LDA + ks * 32 + hl * 16);
#pragma unroll
                for (int j = 0; j < 2; ++j) b[j] = *(const bf16x8*)(Bs + (wn * 64 + j * 32 + l31) * G_LDA + ks * 32 + hl * 16);
#pragma unroll
                for (int i = 0; i < 2; ++i)
#pragma unroll
                    for (int j = 0; j < 2; ++j) acc[i][j] = mfma32(a[i], b[j], acc[i][j]);
            }
        }
#pragma unroll
        for (int i = 0; i < 2; ++i)
#pragma unroll
            for (int j = 0; j < 2; ++j) epi(acc[i][j], mt * 256 + wm * 64 + i * 32, nt * 128 + wn * 64 + j * 32, lane);
    }
}

struct EpiIn {
    bf16_t* qkv; float* hf;
    __device__ __forceinline__ void operator()(const f32x16& acc, int row0, int col0, int lane) const {
        const int c = col0 + (lane & 31), h = lane >> 5;
        if (col0 < 768) {
#pragma unroll
            for (int r = 0; r < 16; ++r) { const int row = row0 + (r & 3) + 8 * (r >> 2) + 4 * h; qkv[(size_t)row * 768 + c] = (bf16_t)f2bf(acc[r]); }
        } else {
            float* dst = hf + (size_t)(c - 768) * T;
#pragma unroll
            for (int i = 0; i < 4; ++i) { const int row = row0 + 8 * i + 4 * h; f32x4 v; v.x = acc[4 * i]; v.y = acc[4 * i + 1]; v.z = acc[4 * i + 2]; v.w = acc[4 * i + 3]; *(f32x4*)(dst + row) = v; }
        }
    }
};
struct EpiRes {
    const float* base; float* out;
    __device__ __forceinline__ void operator()(const f32x16& acc, int row0, int col0, int lane) const {
        const int c = col0 + (lane & 31), h = lane >> 5;
#pragma unroll
        for (int r = 0; r < 16; ++r) { const size_t o = (size_t)(row0 + (r & 3) + 8 * (r >> 2) + 4 * h) * DM + c; out[o] = base[o] + acc[r]; }
    }
};
struct EpiF32 {
    float* out; int ld;
    __device__ __forceinline__ void operator()(const f32x16& acc, int row0, int col0, int lane) const {
        const int c = col0 + (lane & 31), h = lane >> 5;
#pragma unroll
        for (int r = 0; r < 16; ++r) { out[(size_t)(row0 + (r & 3) + 8 * (r >> 2) + 4 * h) * ld + c] = acc[r]; }
    }
};

__device__ __forceinline__ void phase_qkprep(const Params& p, int layer, char* lds, bf16_t* qout) {
    const int tid = otid(), lane = tid & 63, wave = tid >> 6;
    bf16_t* qkv = (bf16_t*)(p.ws + R_QKV);
    bf16_t* vt = (bf16_t*)(p.ws + R_VT);
    const float qgv = p.in[I_QG][layer * 64 + lane], kgv = p.in[I_KG][layer * 64 + lane];
    const int gw = obid() * NWAVE + wave, ngw = gridDim.x * NWAVE;
    const int ax = lane >> 5, fr = lane & 15; const bool second = (lane >> 4) & 1;
    const float inv = powf(10000.0f, -(float)fr / 16.0f);
    for (int t = gw; t < T; t += ngw) {
        const int l = t & (SL - 1);
        const float pos = ax ? (float)(l & 63) : (float)(l >> 6);
        const float ang = pos * inv;
        const float cs = cosf(ang), sn = sinf(ang);
        bf16_t* row = qkv + (size_t)t * 768;
#pragma unroll
        for (int slot = 0; slot < 10; ++slot) {
            const float x = bf2f(row[slot * 64 + lane]);
            const float ss = wave_sum(x * x);
            const float r = rsqrtf(ss * (1.0f / 64.0f) + EPS);
            const float y = x * r * (slot < 8 ? qgv : kgv);
            const float other = __shfl_xor(y, 16);
            float o = second ? (y * cs + other * sn) : (y * cs - other * sn);
            if (slot < 8) o *= 0.125f * 1.4426950408889634f;
            qout[(size_t)t * 768 + slot * 64 + lane] = (bf16_t)f2bf(o);
        }
    }
}

#include <hip/hip_bf16.h>
#include <cmath>
namespace attn_body {
using bf16=__hip_bfloat16;
using bf16x8=__attribute__((ext_vector_type(8)))short;
using s16x4=__attribute__((ext_vector_type(4)))short;
using f32x16=__attribute__((ext_vector_type(16)))float;
using u32x4=__attribute__((ext_vector_type(4)))unsigned;
constexpr int SEQ=8192,D=64,PQ=768,PO=512;
constexpr int NW=8,QBLK=32,QB=QBLK*NW,KVBLK=64,NQB=SEQ/QB;
constexpr int ATTN_UNIT_ROWS=QB;
__device__ __forceinline__ int crow(int r,int hi){return (r&3)+8*(r>>2)+4*hi;}
#define SBAR() __builtin_amdgcn_sched_barrier(0)
__device__ __forceinline__ void cmask(f32x16&p0,f32x16&p1,int jb,int qrel,int hi){
  const float NEG=-INFINITY; int kb=64*jb+4*hi;
  #pragma unroll
  for(int r=0;r<16;++r){int kv=kb+(r&3)+8*(r>>2); if(kv>qrel)p0[r]=NEG; if(kv+32>qrel)p1[r]=NEG;}
}

constexpr int NSLOT=3, SLOTB=8192;
constexpr int LDS_K=0, LDS_V=NSLOT*SLOTB, LDS_WS=2*NSLOT*SLOTB, LDS_OST=LDS_WS+NW*64*4, LDS_BYTES=LDS_OST+NW*4096;
constexpr float C2=0.125f*1.4426950408889634f;
__device__ __forceinline__ void glds16(const void*gsrc,unsigned lds_dst){unsigned keep;
  asm volatile("s_mov_b32 %0, m0\n\ts_mov_b32 m0, %2\n\ts_nop 0\n\tglobal_load_lds_dwordx4 %1, off\n\ts_mov_b32 m0, %0":"=&s"(keep):"v"(gsrc),"s"(lds_dst):"memory");}
__device__ __forceinline__ float max3f(float a,float b,float c){float r;asm("v_max3_f32 %0, %1, %2, %3":"=v"(r):"v"(a),"v"(b),"v"(c));return r;}
__device__ __forceinline__ float max2f(float a,float b){float r;asm("v_max_f32_e32 %0, %1, %2":"=v"(r):"v"(a),"v"(b));return r;}
__device__ __forceinline__ float fadd_s(float a,float b){float r;asm("v_add_f32_e32 %0, %1, %2":"=v"(r):"v"(a),"v"(b));return r;}
__device__ __forceinline__ float fsub_s(float a,float b){float r;asm("v_sub_f32_e32 %0, %1, %2":"=v"(r):"v"(a),"v"(b));return r;}
typedef float f32x2_t __attribute__((ext_vector_type(2))); typedef __bf16 bf16x2_t __attribute__((ext_vector_type(2)));
__device__ __forceinline__ unsigned cvtpk_s(float lo,float hi){f32x2_t v={lo,hi};bf16x2_t b=__builtin_convertvector(v,bf16x2_t);return __builtin_bit_cast(unsigned,b);}
#define WAIT_BAR(N) asm volatile("s_waitcnt vmcnt(" #N ") lgkmcnt(0)\n\ts_barrier":::"memory")

__device__ __forceinline__ void qkt(f32x16&p0,f32x16&p1,const char*Kslot,const bf16x8*qr,const f32x16&negm,int r32,int hi){
  const char*kb=Kslot+hi*1024+r32*16;
  #pragma unroll
  for(int d0=0;d0<4;++d0){
    const bf16x8 b0=*reinterpret_cast<const bf16x8*>(kb+d0*2048);
    const bf16x8 b1=*reinterpret_cast<const bf16x8*>(kb+d0*2048+512);
    if(d0==0){p0=__builtin_amdgcn_mfma_f32_32x32x16_bf16(b0,qr[0],negm,0,0,0);p1=__builtin_amdgcn_mfma_f32_32x32x16_bf16(b1,qr[0],negm,0,0,0);}
    else{p0=__builtin_amdgcn_mfma_f32_32x32x16_bf16(b0,qr[d0],p0,0,0,0);p1=__builtin_amdgcn_mfma_f32_32x32x16_bf16(b1,qr[d0],p1,0,0,0);}}
}
typedef __attribute__((address_space(3))) const char* lds_cptr;
typedef short v4i16_t __attribute__((ext_vector_type(4)));
__device__ __forceinline__ void kload8(bf16x8*kf,lds_cptr kp){
  kf[0]=*(const __attribute__((address_space(3))) bf16x8*)(kp);      kf[1]=*(const __attribute__((address_space(3))) bf16x8*)(kp+512);
  kf[2]=*(const __attribute__((address_space(3))) bf16x8*)(kp+2048); kf[3]=*(const __attribute__((address_space(3))) bf16x8*)(kp+2560);
  kf[4]=*(const __attribute__((address_space(3))) bf16x8*)(kp+4096); kf[5]=*(const __attribute__((address_space(3))) bf16x8*)(kp+4608);
  kf[6]=*(const __attribute__((address_space(3))) bf16x8*)(kp+6144); kf[7]=*(const __attribute__((address_space(3))) bf16x8*)(kp+6656);
}
__device__ __forceinline__ void kload2(bf16x8*kf,lds_cptr kp,int j){ kf[2*j]=*(const __attribute__((address_space(3))) bf16x8*)(kp+j*2048); kf[2*j+1]=*(const __attribute__((address_space(3))) bf16x8*)(kp+j*2048+512); }
__device__ __forceinline__ s16x4 vtr(lds_cptr p){ return __builtin_bit_cast(s16x4,__builtin_amdgcn_ds_read_tr16_b64_v4i16((__attribute__((address_space(3))) v4i16_t*)p)); }
__device__ __forceinline__ float rowmax(const f32x16&p0,const f32x16&p1){
  float a=max3f(p0[0],p0[1],p1[0]),b=max3f(p0[2],p0[3],p1[1]);a=max3f(a,p1[2],p1[3]);
  #pragma unroll
  for(int r=4;r<16;r+=4){a=max3f(a,p0[r],p0[r+1]);b=max3f(b,p0[r+2],p0[r+3]);a=max3f(a,p1[r],p1[r+1]);b=max3f(b,p1[r+2],p1[r+3]);}
  const float m=max2f(a,b);
  auto rr=__builtin_amdgcn_permlane32_swap(__float_as_uint(m),__float_as_uint(m),false,false);
  return max2f(__uint_as_float(rr[0]),__uint_as_float(rr[1]));
}
__device__ __forceinline__ void pv(f32x16*o,int vb,bf16x8 pa0,bf16x8 pa1,bf16x8 pa2,bf16x8 pa3){
  #pragma unroll
  for(int d0=0;d0<2;++d0){s16x4 lo[4],hi[4];
    #pragma unroll
    for(int ks=0;ks<4;++ks){
      asm volatile("ds_read_b64_tr_b16 %0,%1 offset:%c2":"=&v"(lo[ks]):"v"(vb),"i"(d0*4096+ks*1024):"memory");
      asm volatile("ds_read_b64_tr_b16 %0,%1 offset:%c2":"=&v"(hi[ks]):"v"(vb),"i"(d0*4096+ks*1024+512):"memory");}
    asm volatile("s_waitcnt lgkmcnt(0)":::"memory");SBAR();
    #define PK(k) (bf16x8){lo[k][0],lo[k][1],lo[k][2],lo[k][3],hi[k][0],hi[k][1],hi[k][2],hi[k][3]}
    o[d0]=__builtin_amdgcn_mfma_f32_32x32x16_bf16(pa0,PK(0),o[d0],0,0,0);
    o[d0]=__builtin_amdgcn_mfma_f32_32x32x16_bf16(pa1,PK(1),o[d0],0,0,0);
    o[d0]=__builtin_amdgcn_mfma_f32_32x32x16_bf16(pa2,PK(2),o[d0],0,0,0);
    o[d0]=__builtin_amdgcn_mfma_f32_32x32x16_bf16(pa3,PK(3),o[d0],0,0,0);
    #undef PK
  }
}

#ifndef ATTN_STORE16
#define ATTN_STORE16(p,v) (*(u32x4*)(p)=(v))
#endif
template<int THRL> __device__ __forceinline__ void attn_unit(int b,int h,int g,int qb,const bf16*Q,const bf16*__restrict__ K,const bf16*__restrict__ V,bf16*O,char*shm){
  const int tid=otid(),lane=tid&63,r32=lane&31,hi=lane>>5; const int wid=__builtin_amdgcn_readfirstlane(tid>>6);
  const long rowbase=(long)b*SEQ; const int q0=qb*QB;
  const bf16*Qw=Q+(rowbase+q0+wid*QBLK)*PQ+h*D;
  const bf16*Kh=K+rowbase*PQ+g*D,*Vh=V+rowbase*PQ+g*D;
  const unsigned lds0=(unsigned)(uintptr_t)shm;
  float*wsf=(float*)(shm+LDS_WS)+wid*64;
  const bf16*ksrc=Kh+(long)lane*PQ+wid*8;
  const bf16*vsrc=Vh+(long)(16*(wid&3)+(lane>>2))*PQ+(wid>>2)*32+(lane&3)*8;
  const unsigned kdst=lds0+LDS_K+wid*1024, vdst=lds0+LDS_V+wid*1024;
  #define DMA_K(t,slot) glds16(ksrc+(long)(t)*KVBLK*PQ,(unsigned)__builtin_amdgcn_readfirstlane(kdst+(slot)))
  #define DMA_V(t,slot) glds16(vsrc+(long)(t)*KVBLK*PQ,(unsigned)__builtin_amdgcn_readfirstlane(vdst+(slot)))
  const int vb0=(int)(lds0+LDS_V)+((lane>>4)&1)*32+(lane&3)*8+(4*hi+((lane&15)>>2))*64;
  const char*Kbase=shm+LDS_K; bf16x8 kf[8];
  const lds_cptr shm3=(lds_cptr)shm; const lds_cptr kp0=shm3+LDS_K+hi*1024+r32*16; const lds_cptr vp0=shm3+LDS_V+((lane>>4)&1)*32+(lane&3)*8+(4*hi+((lane&15)>>2))*64;
  constexpr int NT=SEQ/KVBLK;
  DMA_K(0,0);DMA_V(0,0);DMA_K(1,SLOTB);
  bf16x8 qr[4];
  #pragma unroll
  for(int d0=0;d0<4;++d0)qr[d0]=*reinterpret_cast<const bf16x8*>(&Qw[(long)r32*PQ+d0*16+hi*8]);
  float mhat=0.f,l_reg=0.f;f32x16 o[2];o[0]=f32x16{};o[1]=f32x16{};f32x16 negm=f32x16{};asm volatile("":"+v"(negm));
    #define CMASK(P0,P1,t) do{}while(0)
  bool resc=false;
  #define START(P0,P1) do{ const float rm=rowmax(P0,P1); resc=false; \
    { const float dl=rm; mhat=fadd_s(mhat,dl); \
      _Pragma("unroll") for(int r=0;r<16;++r){P0[r]=fsub_s(P0[r],dl);P1[r]=fsub_s(P1[r],dl);} \
      _Pragma("unroll") for(int r=0;r<16;++r)negm[r]=-mhat; asm volatile("":"+v"(negm)); } \
    _Pragma("unroll") for(int r=0;r<16;++r)P0[r]=__builtin_amdgcn_exp2f(P0[r]); }while(0)
  #define RESC() do{ if(resc){ asm volatile("s_waitcnt lgkmcnt(0)":::"memory"); \
      _Pragma("unroll") for(int d_=0;d_<2;++d_) _Pragma("unroll") for(int r=0;r<16;++r)o[d_][r]*=wsf[crow(r,hi)]; } }while(0)
  f32x16 pA0,pA1,pB0,pB1;
  int sl_prev=0,sl_cur=0,sl_next=SLOTB;
  #define ROT() do{sl_prev=sl_cur;sl_cur=sl_next;sl_next=(sl_next==(NSLOT-1)*SLOTB)?0:sl_next+SLOTB;}while(0)
  DMA_K(2,2*SLOTB);
  WAIT_BAR(3);
  qkt(pA0,pA1,Kbase,qr,negm,r32,hi);asm volatile("s_nop 15\n\ts_nop 7":"+v"(pA0),"+v"(pA1));CMASK(pA0,pA1,0);
  START(pA0,pA1);
  _Pragma("unroll") for(int r=0;r<16;++r)pA1[r]=__builtin_amdgcn_exp2f(pA1[r]);
  WAIT_BAR(0);
  DMA_K(3,0);DMA_V(1,SLOTB);
  ROT();
  kload8(kf,kp0+sl_cur);
  WAIT_BAR(2);
  s16x4 vlo[8],vhi[8]; u32x4 pw0,pw1,pw2,pw3;
  #define PKW(P,B) cvtpk_s(P[B],P[B+1])
  #define PAF(k) __builtin_bit_cast(bf16x8,pw##k)
  #define VFR(i) (bf16x8){vlo[i][0],vlo[i][1],vlo[i][2],vlo[i][3],vhi[i][0],vhi[i][1],vhi[i][2],vhi[i][3]}
  #define PIN(x) asm volatile("":"+v"(x))
  #define MX3(a,b,c) __builtin_fmaxf(__builtin_fmaxf((a),(b)),(c))
  #define GAPA(MF,A0,A1,A2,A3,W0,W1,PW) do{ MF; sacc+=A0; sacc+=A1; sacc+=A2; sacc+=A3; PIN(sacc); W0; W1; PIN(PW); SBAR(); }while(0)
  #define EX(v) __builtin_amdgcn_exp2f(v)
  #define GAPB(MF,X,B) do{ MF; X[B]=EX(X[B]); X[B+1]=EX(X[B+1]); X[B+2]=EX(X[B+2]); X[B+3]=EX(X[B+3]); PIN(X); SBAR(); }while(0)
  #define VRD(i) do{ vlo[i]=vtr(vp_+(((i)>>2)*4096+((i)&3)*1024)); vhi[i]=vtr(vp_+(((i)>>2)*4096+((i)&3)*1024+512)); }while(0)
  #define KRD(G,j) do{ if(G){ kload2(kf,kp0+sl_next,j); SBAR(); } }while(0)
  #define STEP(C0,C1,P0,P1,t,GK,GV,GL) do{ SBAR(); \
    const lds_cptr vp_=vp0+sl_prev; \
    VRD(0); SBAR(); float sacc=(P0[0]+P0[1]); \
    GAPA(C0=__builtin_amdgcn_mfma_f32_32x32x16_bf16(kf[0],qr[0],negm,0,0,0), P0[2],P0[3],P0[4],P0[5],     pw0[0]=PKW(P0,0), pw0[1]=PKW(P0,2), pw0); \
    VRD(4); SBAR(); GAPA(C1=__builtin_amdgcn_mfma_f32_32x32x16_bf16(kf[1],qr[0],negm,0,0,0), P0[6],P0[7],P0[8],P0[9],     pw0[2]=PKW(P0,4), pw0[3]=PKW(P0,6), pw0); \
    VRD(1); SBAR(); GAPA(C0=__builtin_amdgcn_mfma_f32_32x32x16_bf16(kf[2],qr[1],C0,0,0,0),   P0[10],P0[11],P0[12],P0[13], pw1[0]=PKW(P0,8), pw1[1]=PKW(P0,10), pw1); \
    VRD(5); SBAR(); GAPA(C1=__builtin_amdgcn_mfma_f32_32x32x16_bf16(kf[3],qr[1],C1,0,0,0),   P0[14],P0[15],P1[0],P1[1],   pw1[2]=PKW(P0,12),pw1[3]=PKW(P0,14), pw1); \
    VRD(2); SBAR(); GAPA(C0=__builtin_amdgcn_mfma_f32_32x32x16_bf16(kf[4],qr[2],C0,0,0,0),   P1[2],P1[3],P1[4],P1[5],     pw2[0]=PKW(P1,0), pw2[1]=PKW(P1,2), pw2); \
    VRD(6); SBAR(); GAPA(C1=__builtin_amdgcn_mfma_f32_32x32x16_bf16(kf[5],qr[2],C1,0,0,0),   P1[6],P1[7],P1[8],P1[9],     pw2[2]=PKW(P1,4), pw2[3]=PKW(P1,6), pw2); \
    VRD(3); SBAR(); GAPA(C0=__builtin_amdgcn_mfma_f32_32x32x16_bf16(kf[6],qr[3],C0,0,0,0),   P1[10],P1[11],P1[12],P1[13], pw3[0]=PKW(P1,8), pw3[1]=PKW(P1,10), pw3); \
    VRD(7); SBAR(); GAPA(C1=__builtin_amdgcn_mfma_f32_32x32x16_bf16(kf[7],qr[3],C1,0,0,0),   P1[14],P1[15],0.f,0.f,       pw3[2]=PKW(P1,12),pw3[3]=PKW(P1,14), pw3); \
    l_reg+=sacc; \
    if(GK){DMA_K((t)+3,sl_cur);} if(GV){DMA_V((t)+1,sl_next);} \
    CMASK(C0,C1,t); \
    { float a=MX3(C0[0],C0[1],C1[0]),b=MX3(C0[2],C0[3],C1[1]); a=MX3(a,C1[2],C1[3]); \
      _Pragma("unroll") for(int r=4;r<16;r+=4){a=MX3(a,C0[r],C0[r+1]);b=MX3(b,C0[r+2],C0[r+3]);a=MX3(a,C1[r],C1[r+1]);b=MX3(b,C1[r+2],C1[r+3]);} \
      float rm=__builtin_fmaxf(a,b); { auto rr=__builtin_amdgcn_permlane32_swap(__float_as_uint(rm),__float_as_uint(rm),false,false); rm=__builtin_fmaxf(__uint_as_float(rr[0]),__uint_as_float(rr[1])); } \
      resc=false; \
      if(__builtin_expect(__any(rm>(float)THRL),0)){ const float dl=__builtin_fmaxf(rm,0.f); mhat+=dl; \
        _Pragma("unroll") for(int r=0;r<16;++r){C0[r]-=dl;C1[r]-=dl;} \
        _Pragma("unroll") for(int r=0;r<16;++r)negm[r]=-mhat; asm volatile("":"+v"(negm)); \
        const float f=__builtin_amdgcn_exp2f(-dl); l_reg*=f; if(hi==0)wsf[r32]=f; resc=true; } } \
    SBAR(); \
    GAPB(o[0]=__builtin_amdgcn_mfma_f32_32x32x16_bf16(PAF(0),VFR(0),o[0],0,0,0), C0,0); \
    GAPB(o[1]=__builtin_amdgcn_mfma_f32_32x32x16_bf16(PAF(0),VFR(4),o[1],0,0,0), C0,4); \
    KRD(GL,0); GAPB(o[0]=__builtin_amdgcn_mfma_f32_32x32x16_bf16(PAF(1),VFR(1),o[0],0,0,0), C0,8); \
    KRD(GL,1); GAPB(o[1]=__builtin_amdgcn_mfma_f32_32x32x16_bf16(PAF(1),VFR(5),o[1],0,0,0), C0,12); \
    KRD(GL,2); GAPB(o[0]=__builtin_amdgcn_mfma_f32_32x32x16_bf16(PAF(2),VFR(2),o[0],0,0,0), C1,0); \
    KRD(GL,3); GAPB(o[1]=__builtin_amdgcn_mfma_f32_32x32x16_bf16(PAF(2),VFR(6),o[1],0,0,0), C1,4); \
    GAPB(o[0]=__builtin_amdgcn_mfma_f32_32x32x16_bf16(PAF(3),VFR(3),o[0],0,0,0), C1,8); \
    GAPB(o[1]=__builtin_amdgcn_mfma_f32_32x32x16_bf16(PAF(3),VFR(7),o[1],0,0,0), C1,12); \
    }while(0)
  int t=1;
  #undef CMASK
  #define CMASK(P0,P1,t) do{}while(0)
  for(;t+5<NT;t+=2){
    STEP(pB0,pB1,pA0,pA1,t,true,true,true);     WAIT_BAR(2); RESC(); ROT();
    STEP(pA0,pA1,pB0,pB1,t+1,true,true,true);   WAIT_BAR(2); RESC(); ROT();
  }
  #define ENDW(tt) do{ if((tt)+3<NT){WAIT_BAR(2);} else if((tt)+2<NT){WAIT_BAR(1);} else {WAIT_BAR(0);} }while(0)
  for(;t+1<NT;t+=2){
    STEP(pB0,pB1,pA0,pA1,t,(t+3<NT),(t+1<NT),(t+1<NT));       ENDW(t);   RESC(); ROT();
    STEP(pA0,pA1,pB0,pB1,t+1,(t+4<NT),(t+2<NT),(t+2<NT));     ENDW(t+1); RESC(); ROT();
  }
  STEP(pB0,pB1,pA0,pA1,NT-1,false,false,false); RESC();
  { float sacc=pB0[0]+pB0[1]; _Pragma("unroll") for(int r=2;r<16;++r)sacc+=pB0[r]; _Pragma("unroll") for(int r=0;r<16;++r)sacc+=pB1[r]; l_reg+=sacc;
    pw0=(u32x4){PKW(pB0,0),PKW(pB0,2),PKW(pB0,4),PKW(pB0,6)};pw1=(u32x4){PKW(pB0,8),PKW(pB0,10),PKW(pB0,12),PKW(pB0,14)};pw2=(u32x4){PKW(pB1,0),PKW(pB1,2),PKW(pB1,4),PKW(pB1,6)};pw3=(u32x4){PKW(pB1,8),PKW(pB1,10),PKW(pB1,12),PKW(pB1,14)};
    SBAR(); pv(o,vb0+sl_cur,PAF(0),PAF(1),PAF(2),PAF(3)); }
  #undef PKW
  #undef PAF
  #undef VFR
  #undef PIN
  #undef MX3
  #undef GAPA
  #undef GAPB
  #undef EX
  #undef VRD
  #undef KRD
  #undef STEP
  #undef ENDW
  {auto rr=__builtin_amdgcn_permlane32_swap(__float_as_uint(l_reg),__float_as_uint(l_reg),false,false);l_reg=__uint_as_float(rr[0])+__uint_as_float(rr[1]);}
  if(hi==0)wsf[32+r32]=l_reg;asm volatile("s_waitcnt lgkmcnt(0)":::"memory");
  float rli[16];
  #pragma unroll
  for(int r=0;r<16;++r)rli[r]=__builtin_amdgcn_rcpf(wsf[32+crow(r,hi)]);
  bf16*Ow=O+(rowbase+q0+wid*QBLK)*PO+h*D;
  { bf16*stg=(bf16*)(shm+LDS_OST)+wid*2048;
    #pragma unroll
    for(int r=0;r<16;++r){const int orow=crow(r,hi);
      #pragma unroll
      for(int d0=0;d0<2;++d0)stg[orow*64+d0*32+r32]=__float2bfloat16(o[d0][r]*rli[r]);}
    asm volatile("s_waitcnt lgkmcnt(0)":::"memory");
    #pragma unroll
    for(int i=0;i<4;++i){const int row=i*8+(lane>>3),ch=lane&7; const u32x4 v=*(const u32x4*)(stg+row*64+ch*8); ATTN_STORE16(Ow+(long)row*PO+ch*8,v);} }
  asm volatile("s_waitcnt lgkmcnt(0)\n\ts_barrier":::"memory");
  #undef DMA_K
  #undef DMA_V
  #undef CMASK
  #undef START
  #undef RESC
  #undef ROT
}
constexpr int ATTN_LDS_BYTES=LDS_BYTES;
#undef SBAR
#undef WAIT_BAR
}

__device__ __forceinline__ void phase_attn(const Params& p, char* lds) {
            {
                const int bid = obid();
                const int vcu = ((gridDim.x & 7) == 0) ? (bid & 7) * (int)(gridDim.x >> 3) + (bid >> 3) : bid;
                const attn_body::bf16* qkvb = (const attn_body::bf16*)(p.ws + R_QKV);
                for (int u = vcu; u < 512; u += gridDim.x) {
                    const int bg = (u & 255) >> 6, r = u & 63, hh = r & 3, qb = (r >> 2) + 16 * (u >> 8);
                    const int b = bg >> 1, g = bg & 1;
                    attn_body::attn_unit<8>(b, 4 * g + hh, g, qb, qkvb, qkvb + 512, qkvb + 640, (attn_body::bf16*)(p.ws + R_ATT), lds);
                }
            }
}

__device__ __forceinline__ f32x4 convd4(const float* row, int l0, float w0, float w1, float w2, float cb) {
    const f32x4 c = *(const f32x4*)(row + l0);
    const float lft = (l0 > 0) ? row[l0 - 1] : 0.f;
    const float rgt = (l0 + 4 < SL) ? row[l0 + 4] : 0.f;
    f32x4 o;
    o.x = cb + w0 * lft + w1 * c.x + w2 * c.y;
    o.y = cb + w0 * c.x + w1 * c.y + w2 * c.z;
    o.z = cb + w0 * c.y + w1 * c.z + w2 * c.w;
    o.w = cb + w0 * c.z + w1 * c.w + w2 * rgt;
    return o;
}
__device__ __forceinline__ void cmul_kf(float2* Z, const float2* KF, int tid) {
#pragma unroll 4
    for (int i = 0; i < 16; ++i) {
        const int pp = 2 * tid + 1024 * i;
        const f32x4 z = *(const f32x4*)(Z + pp), k = *(const f32x4*)(KF + pp);
        f32x4 o; o.x = z.x * k.x - z.y * k.y; o.y = z.x * k.y + z.y * k.x; o.z = z.z * k.z - z.w * k.w; o.w = z.z * k.w + z.w * k.z;
        *(f32x4*)(Z + pp) = o;
    }
}
__device__ __forceinline__ void hyena_job(const Params& p, int layer, int c, char* lds) {
    const int tid = otid();
    float2* Z = (float2*)lds;
    const float* HF = (const float*)(p.ws + R_HF);
    const float* cw = p.in[I_CW] + (size_t)layer * 3 * 768; const float* cbp = p.in[I_CB] + layer * 768;
    const float2* KF0 = (const float2*)(p.ws + OFF_KF) + ((size_t)(layer * 256 + c) * 2) * 16384;
    const float2* KF1 = KF0 + 16384;
    float* Y = (float*)(p.ws + R_Y) + (size_t)c * T;
    const float bias0 = p.in[I_HB][(layer * 2 + 0) * 256 + c], bias1 = p.in[I_HB][(layer * 2 + 1) * 256 + c];
    const int cv = c, c1 = 256 + c, c2 = 512 + c;
    const float* rv = HF + (size_t)cv * T; const float* r1 = HF + (size_t)c1 * T; const float* r2 = HF + (size_t)c2 * T;
    const float v_w0 = cw[cv], v_w1 = cw[768 + cv], v_w2 = cw[1536 + cv], v_cb = cbp[cv];
    const float a_w0 = cw[c1], a_w1 = cw[768 + c1], a_w2 = cw[1536 + c1], a_cb = cbp[c1];
    const float b_w0 = cw[c2], b_w1 = cw[768 + c2], b_w2 = cw[1536 + c2], b_cb = cbp[c2];
    const f32x4 zero4 = {0.f, 0.f, 0.f, 0.f};
    __syncthreads();
#pragma unroll
    for (int i = 0; i < 4; ++i) {
        const int l0 = 4 * tid + 2048 * i;
        const f32x4 va = convd4(rv, l0, v_w0, v_w1, v_w2, v_cb), vb = convd4(rv + SL, l0, v_w0, v_w1, v_w2, v_cb);
        *(f32x4*)(Z + l0) = (f32x4){va.x, vb.x, va.y, vb.y}; *(f32x4*)(Z + l0 + 2) = (f32x4){va.z, vb.z, va.w, vb.w};
        *(f32x4*)(Z + 8192 + l0) = zero4; *(f32x4*)(Z + 8192 + l0 + 2) = zero4;
    }
    __syncthreads();
    fft_fwd<14, false>(Z);
    cmul_kf(Z, KF0, tid);
    __syncthreads();
    fft_inv<14, false>(Z);
#pragma unroll
    for (int i = 0; i < 4; ++i) {
        const int l0 = 4 * tid + 2048 * i;
        const f32x4 za = *(const f32x4*)(Z + l0), zb = *(const f32x4*)(Z + l0 + 2);
        const f32x4 va = convd4(rv, l0, v_w0, v_w1, v_w2, v_cb), vb = convd4(rv + SL, l0, v_w0, v_w1, v_w2, v_cb);
        const f32x4 ga = convd4(r1, l0, a_w0, a_w1, a_w2, a_cb), gb = convd4(r1 + SL, l0, a_w0, a_w1, a_w2, a_cb);
        f32x4 ya, yb;
        ya.x = ga.x * (za.x + va.x * bias0); ya.y = ga.y * (za.z + va.y * bias0); ya.z = ga.z * (zb.x + va.z * bias0); ya.w = ga.w * (zb.z + va.w * bias0);
        yb.x = gb.x * (za.y + vb.x * bias0); yb.y = gb.y * (za.w + vb.y * bias0); yb.z = gb.z * (zb.y + vb.z * bias0); yb.w = gb.w * (zb.w + vb.w * bias0);
        *(f32x4*)(Y + l0) = ya; *(f32x4*)(Y + SL + l0) = yb;
        *(f32x4*)(Z + l0) = (f32x4){ya.x, yb.x, ya.y, yb.y}; *(f32x4*)(Z + l0 + 2) = (f32x4){ya.z, yb.z, ya.w, yb.w};
        *(f32x4*)(Z + 8192 + l0) = zero4; *(f32x4*)(Z + 8192 + l0 + 2) = zero4;
    }
    __syncthreads();
    fft_fwd<14, false>(Z);
    cmul_kf(Z, KF1, tid);
    __syncthreads();
    fft_inv<14, false>(Z);
#pragma unroll
    for (int i = 0; i < 4; ++i) {
        const int l0 = 4 * tid + 2048 * i;
        const f32x4 za = *(const f32x4*)(Z + l0), zb = *(const f32x4*)(Z + l0 + 2);
        const f32x4 ga = convd4(r2, l0, b_w0, b_w1, b_w2, b_cb), gb = convd4(r2 + SL, l0, b_w0, b_w1, b_w2, b_cb);
        const f32x4 pa = *(const f32x4*)(Y + l0), pb = *(const f32x4*)(Y + SL + l0);
        f32x4 ya, yb;
        ya.x = ga.x * (za.x + pa.x * bias1); ya.y = ga.y * (za.z + pa.y * bias1); ya.z = ga.z * (zb.x + pa.z * bias1); ya.w = ga.w * (zb.z + pa.w * bias1);
        yb.x = gb.x * (za.y + pb.x * bias1); yb.y = gb.y * (za.w + pb.y * bias1); yb.z = gb.z * (zb.y + pb.z * bias1); yb.w = gb.w * (zb.w + pb.w * bias1);
        *(f32x4*)(Y + l0) = ya; *(f32x4*)(Y + SL + l0) = yb;
    }
    __syncthreads();
}

__device__ __forceinline__ void fnet_job(const Params& p, int ch, char* lds) {
    const int tid = otid();
    float2* Z = (float2*)lds;
    const float* row = (const float*)(p.ws + R_HF) + (size_t)(768 + ch) * T;
    float* UR = (float*)(p.ws + R_UR) + (size_t)ch * T;
    float* UI = (float*)(p.ws + R_UI) + (size_t)ch * T;
    __syncthreads();
#pragma unroll
    for (int i = 0; i < 4; ++i) {
        const int l0 = 4 * tid + 2048 * i;
        const f32x4 a = *(const f32x4*)(row + l0), b = *(const f32x4*)(row + SL + l0);
        const int z0 = zi<true>(l0);
        Z[z0] = make_float2(a.x, b.x); Z[z0 + 1] = make_float2(a.y, b.y); Z[z0 + 2] = make_float2(a.z, b.z); Z[z0 + 3] = make_float2(a.w, b.w);
    }
    __syncthreads();
    fft_fwd<13, true>(Z);
#pragma unroll
    for (int i = 0; i < 4; ++i) {
        const int k0 = 4 * tid + 2048 * i;
        f32x4 ur0, ui0, ur1, ui1;
#pragma unroll
        for (int e = 0; e < 4; ++e) {
            const int k = k0 + e;
            const int pk = (int)(__brev((unsigned)k) >> 19);
            const int km = (SL - k) & (SL - 1);
            const int pm = (int)(__brev((unsigned)km) >> 19);
            const float2 zk = Z[zi<true>(pk)], zm = Z[zi<true>(pm)];
            ur0[e] = 0.5f * (zk.x + zm.x); ui0[e] = 0.5f * (zk.y - zm.y);
            ur1[e] = 0.5f * (zk.y + zm.y); ui1[e] = 0.5f * (zm.x - zk.x);
        }
        *(f32x4*)(UR + k0) = ur0; *(f32x4*)(UI + k0) = ui0; *(f32x4*)(UR + SL + k0) = ur1; *(f32x4*)(UI + SL + k0) = ui1;
    }
    __syncthreads();
}

__device__ __forceinline__ void phase_mix(const Params& p, int layer, char* lds) {
    const int tid = otid(), lane = tid & 63, wave = tid >> 6;
    float* Ul = (float*)lds;
    float* Yl = Ul + 2 * 256 * 33;
    float* Fl = Yl + 256 * 33;
    const float* UR = (const float*)(p.ws + R_UR); const float* UI = (const float*)(p.ws + R_UI);
    const float* Y = (const float*)(p.ws + R_Y);
    const bf16_t* att = (const bf16_t*)(p.ws + R_ATT);
    bf16_t* mix = (bf16_t*)(p.ws + R_MIX);
    const float* FM = (const float*)(p.ws + OFF_FM) + (size_t)layer * 4 * 128 * 64;
    const float* fb = p.in[I_FB] + layer * 256;
    const float* mg = p.in[I_MG] + layer * 1024;
    for (int tile = obid(); tile < T / 32; tile += gridDim.x) {
        const int t0 = tile * 32;
        __syncthreads();
        for (int i = tid; i < 256 * 32; i += NTHR) {
            const int c = i >> 5, tt = i & 31;
            Ul[c * 33 + tt] = UR[(size_t)c * T + t0 + tt];
            Ul[(256 + c) * 33 + tt] = UI[(size_t)c * T + t0 + tt];
            Yl[c * 33 + tt] = Y[(size_t)c * T + t0 + tt];
        }
        __syncthreads();
        {
            const int tok = tid & 31, eo = tid >> 5, g = eo >> 2, e0 = (eo & 3) * 16;
            float acc[16];
#pragma unroll
            for (int j = 0; j < 16; ++j) acc[j] = fb[g * 64 + e0 + j];
            const float* Mg = FM + (size_t)g * 128 * 64 + e0;
            for (int dd = 0; dd < 128; ++dd) {
                const float u = Ul[((dd >> 6) * 256 + g * 64 + (dd & 63)) * 33 + tok];
                const f32x4* mr = (const f32x4*)(Mg + dd * 64);
#pragma unroll
                for (int j4 = 0; j4 < 4; ++j4) { const f32x4 mv = mr[j4]; acc[4 * j4] += u * mv.x; acc[4 * j4 + 1] += u * mv.y; acc[4 * j4 + 2] += u * mv.z; acc[4 * j4 + 3] += u * mv.w; }
            }
#pragma unroll
            for (int j = 0; j < 16; ++j) Fl[tok * 257 + g * 64 + e0 + j] = acc[j];
        }
        __syncthreads();
#pragma unroll
        for (int tt = 0; tt < 4; ++tt) {
            const int tok = wave * 4 + tt; const size_t t = (size_t)(t0 + tok);
            {
                const u32x4 v = *(const u32x4*)(att + t * 512 + lane * 8);
                float x[8] = {bflo(v.x), bfhi(v.x), bflo(v.y), bfhi(v.y), bflo(v.z), bfhi(v.z), bflo(v.w), bfhi(v.w)};
                float ss = 0.f;
#pragma unroll
                for (int j = 0; j < 8; ++j) ss += x[j] * x[j];
                ss = wave_sum(ss);
                const float r = rsqrtf(ss * (1.0f / 512.0f) + EPS);
                const f32x4 g0 = *(const f32x4*)(mg + lane * 8), g1 = *(const f32x4*)(mg + lane * 8 + 4);
                u32x4 o; o.x = pk2(x[0] * r * g0.x, x[1] * r * g0.y); o.y = pk2(x[2] * r * g0.z, x[3] * r * g0.w); o.z = pk2(x[4] * r * g1.x, x[5] * r * g1.y); o.w = pk2(x[6] * r * g1.z, x[7] * r * g1.w);
                *(u32x4*)(mix + t * 1024 + lane * 8) = o;
            }
            {
                float y[4], f[4]; float sy = 0.f, sf = 0.f;
#pragma unroll
                for (int i = 0; i < 4; ++i) { y[i] = Yl[(lane + 64 * i) * 33 + tok]; f[i] = Fl[tok * 257 + lane + 64 * i]; sy += y[i] * y[i]; sf += f[i] * f[i]; }
                sy = wave_sum(sy); sf = wave_sum(sf);
                const float ry = rsqrtf(sy * (1.0f / 256.0f) + EPS), rf = rsqrtf(sf * (1.0f / 256.0f) + EPS);
#pragma unroll
                for (int i = 0; i < 4; ++i) {
                    mix[t * 1024 + 512 + lane + 64 * i] = (bf16_t)f2bf(y[i] * ry * mg[512 + lane + 64 * i]);
                    mix[t * 1024 + 768 + lane + 64 * i] = (bf16_t)f2bf(f[i] * rf * mg[768 + lane + 64 * i]);
                }
            }
        }
    }
}

#define TK_INS(L, X) do { float x_ = (X); _Pragma("unroll") for (int i_ = 0; i_ < 16; ++i_) { const float hi_ = fmaxf(L[i_], x_); x_ = fminf(L[i_], x_); L[i_] = hi_; } } while (0)
__device__ __forceinline__ float tk_pack(float v, unsigned code, unsigned mask) { return __builtin_bit_cast(float, (__builtin_bit_cast(unsigned, v) & ~mask) | code); }
__device__ __forceinline__ unsigned tk_lookup(const unsigned (&P)[4], unsigned i) {
    const unsigned w = (i < 4u) ? P[0] : (i < 8u) ? P[1] : (i < 12u) ? P[2] : P[3];
    return (w >> ((i & 3u) * 8u)) & 0x7Fu;
}
__device__ __forceinline__ void phase_peer_topk(const Params& p, int layer, char* lds, int* IDX, float* GATE) {
    const int tid = otid(), lane = tid & 63, wave = tid >> 6;
    const float* SC = (const float*)(p.ws + R_QP);
    const float NINF = -3.0e38f;
    const int pp = lane & 1;
    const int gw = obid() * NWAVE + wave, ngw = gridDim.x * NWAVE;
    for (int grp = gw; grp < T * 8 / 32; grp += ngw) {
        const int prob = grp * 32 + (lane >> 1);
        const int t = prob >> 3, h = prob & 7;
        const f32x4* src = (const f32x4*)(SC + (size_t)t * 2048 + h * 256 + pp * 128);
        float l[16];
#pragma unroll
        for (int i = 0; i < 16; ++i) l[i] = NINF;
#pragma unroll 1
        for (int c = 0; c < 4; ++c) {
            f32x4 v[8];
#pragma unroll
            for (int j = 0; j < 8; ++j) v[j] = src[c * 8 + j];
#pragma unroll
            for (int j = 0; j < 8; ++j) {
                const unsigned kb = (unsigned)(c * 32 + j * 4);
                TK_INS(l, tk_pack(v[j].x, kb, 0x7Fu)); TK_INS(l, tk_pack(v[j].y, kb + 1u, 0x7Fu));
                TK_INS(l, tk_pack(v[j].z, kb + 2u, 0x7Fu)); TK_INS(l, tk_pack(v[j].w, kb + 3u, 0x7Fu));
            }
        }
        float xv[16], ov[16]; unsigned PX[4] = {0u, 0u, 0u, 0u}, PO[4] = {0u, 0u, 0u, 0u};
#pragma unroll
        for (int i = 0; i < 16; ++i) {
            const float o = __shfl_xor(l[i], 1);
            const unsigned xb = __builtin_bit_cast(unsigned, l[i]), ob = __builtin_bit_cast(unsigned, o);
            xv[i] = __builtin_bit_cast(float, xb & ~0x7Fu); ov[i] = __builtin_bit_cast(float, ob & ~0x7Fu);
            PX[i >> 2] |= (xb & 0x7Fu) << ((i & 3) * 8); PO[i >> 2] |= (ob & 0x7Fu) << ((i & 3) * 8);
        }
        float f[16];
#pragma unroll
        for (int i = 0; i < 16; ++i) f[i] = NINF;
#pragma unroll
        for (int i = 0; i < 16; ++i)
#pragma unroll
            for (int j = i; j < 16; ++j)
                if ((i + 1) * (j + 1) <= 16) {
                    float cv = xv[i] + ov[j];
                    const unsigned code = pp ? (unsigned)((j << 4) | i) : (unsigned)((i << 4) | j);
                    cv = tk_pack(cv, code, 0xFFu);
                    if (i == j) cv = pp ? NINF : cv;
                    TK_INS(f, cv);
                }
        {
            float g[16];
#pragma unroll
            for (int i = 0; i < 16; ++i) g[i] = __shfl_xor(f[i], 1);
#pragma unroll
            for (int i = 0; i < 16; ++i) TK_INS(f, g[i]);
        }
        unsigned P0[4], P1[4];
#pragma unroll
        for (int q = 0; q < 4; ++q) { P0[q] = pp ? PO[q] : PX[q]; P1[q] = pp ? PX[q] : PO[q]; }
        const float top = __builtin_bit_cast(float, __builtin_bit_cast(unsigned, f[0]) & ~0xFFu);
        float ev[16]; int ei[16]; float den = 0.f;
#pragma unroll
        for (int r = 0; r < 16; ++r) {
            const unsigned fb = __builtin_bit_cast(unsigned, f[r]);
            const unsigned code = fb & 0xFFu;
            ei[r] = (int)(tk_lookup(P0, code >> 4) * 128u + tk_lookup(P1, code & 15u));
            ev[r] = __expf(__builtin_bit_cast(float, fb & ~0xFFu) - top);
            den += ev[r];
        }
        const float rden = 1.0f / den;
        const size_t ob = (size_t)t * 2048 + h * 16;
        if (pp == 0) {
#pragma unroll
            for (int q = 0; q < 4; ++q) { int4 w; w.x = ei[4 * q]; w.y = ei[4 * q + 1]; w.z = ei[4 * q + 2]; w.w = ei[4 * q + 3]; *(int4*)(IDX + ob + 4 * q) = w; }
        } else {
#pragma unroll
            for (int q = 0; q < 4; ++q) { f32x4 w; w.x = ev[4 * q] * rden; w.y = ev[4 * q + 1] * rden; w.z = ev[4 * q + 2] * rden; w.w = ev[4 * q + 3] * rden; *(f32x4*)(GATE + ob + 128 + 4 * q) = w; }
        }
    }
}

__device__ __forceinline__ float gelu_exact(float x) { return 0.5f * x * (1.0f + erff(x * 0.70710678118654752f)); }
typedef float f32x2 __attribute__((ext_vector_type(2)));
#define CVT_LO(W) __builtin_amdgcn_cvt_pk_f32_fp8((int)(W), false)
#define CVT_HI(W) __builtin_amdgcn_cvt_pk_f32_fp8((int)(W), true)
template <bool DRY, int EMASK = 16383> __device__ __forceinline__ void phase_peer_gather(const Params& p, int layer) {
    const int lane = otid() & 63, wave = otid() >> 6;
    const int gw = obid() * NWAVE + wave, ngw = gridDim.x * NWAVE;
    const unsigned char* PU = p.ws + OFF_PU + (size_t)layer * 16384 * 1024;
    const unsigned char* PV = p.ws + OFF_PV + (size_t)layer * 16384 * 1024;
    const float* SU = (const float*)(p.ws + OFF_PSC) + (size_t)layer * 16384;
    const float* SV = (const float*)(p.ws + OFF_PSC) + (size_t)(2 + layer) * 16384;
    bf16_t* XN = (bf16_t*)(p.ws + R_XN);
    float* XA = (float*)(p.ws + OFF_XA);
    const float* SC = (const float*)(p.ws + R_QP);
    const bool last = (layer == NLAYER - 1);
    const float* gnext = last ? p.in[I_FG] : p.in[I_N1G] + (layer + 1) * DM;
    const bool b5 = (lane & 32) != 0, b4 = (lane & 16) != 0, b3 = (lane & 8) != 0;
    const unsigned loff = (unsigned)lane * 16u;
    for (int t = gw; t < T; t += ngw) {
        f32x2 xv[8];
#pragma unroll
        for (int j = 0; j < 4; ++j) {
            const u32x2 a = *(const u32x2*)(XN + (size_t)t * DM + 4 * lane + 256 * j);
            xv[2 * j] = (f32x2){bflo(a.x), bfhi(a.x)}; xv[2 * j + 1] = (f32x2){bflo(a.y), bfhi(a.y)};
        }
        f32x2 acc[8];
#pragma unroll
        for (int j = 0; j < 8; ++j) acc[j] = (f32x2){0.f, 0.f};
        const int* idxp = (const int*)(SC + (size_t)t * 2048);
        const float* gatep = SC + (size_t)t * 2048 + 128;
#pragma unroll 1
        for (int half = 0; half < 2; ++half) {
            const int myi = idxp[half * 64 + lane] & EMASK;
            const float mycu = SU[myi];
            const float mycg = gatep[half * 64 + lane] * SV[myi];
#pragma unroll 1
            for (int e0 = 0; e0 < 64; e0 += 8) {
                u32x4 ur[8], vr[8];
#pragma unroll
                for (int k = 0; k < 8; ++k) {
                    const unsigned e = (unsigned)__builtin_amdgcn_readlane(myi, e0 + k);
                    ur[k] = *(const u32x4*)(PU + (size_t)(e * 1024u) + loff);
                    vr[k] = *(const u32x4*)(PV + (size_t)(e * 1024u) + loff);
                }
                float d[8];
#pragma unroll
                for (int k = 0; k < 8; ++k) {
                    f32x2 s2 = CVT_LO(ur[k].x) * xv[0];
                    s2 += CVT_HI(ur[k].x) * xv[1]; s2 += CVT_LO(ur[k].y) * xv[2]; s2 += CVT_HI(ur[k].y) * xv[3];
                    s2 += CVT_LO(ur[k].z) * xv[4]; s2 += CVT_HI(ur[k].z) * xv[5]; s2 += CVT_LO(ur[k].w) * xv[6]; s2 += CVT_HI(ur[k].w) * xv[7];
                    d[k] = s2.x + s2.y;
                }
                float r4[4], r2[2], u1;
#pragma unroll
                for (int k = 0; k < 4; ++k) { const float send = b5 ? d[k] : d[k + 4], keep = b5 ? d[k + 4] : d[k]; r4[k] = keep + __shfl_xor(send, 32); }
#pragma unroll
                for (int k = 0; k < 2; ++k) { const float send = b4 ? r4[k] : r4[k + 2], keep = b4 ? r4[k + 2] : r4[k]; r2[k] = keep + __shfl_xor(send, 16); }
                { const float send = b3 ? r2[0] : r2[1], keep = b3 ? r2[1] : r2[0]; u1 = keep + __shfl_xor(send, 8); }
                u1 += __shfl_xor(u1, 4); u1 += __shfl_xor(u1, 2); u1 += __shfl_xor(u1, 1);
                const int kk = e0 + (lane >> 3);
                const float av = gelu_exact(u1 * __shfl(mycu, kk)) * __shfl(mycg, kk);
#pragma unroll
                for (int k = 0; k < 8; ++k) {
                    const float a = __builtin_bit_cast(float, __builtin_amdgcn_readlane(__builtin_bit_cast(int, av), 8 * k));
                    const f32x2 a2 = (f32x2){a, a};
                    acc[0] += a2 * CVT_LO(vr[k].x); acc[1] += a2 * CVT_HI(vr[k].x); acc[2] += a2 * CVT_LO(vr[k].y); acc[3] += a2 * CVT_HI(vr[k].y);
                    acc[4] += a2 * CVT_LO(vr[k].z); acc[5] += a2 * CVT_HI(vr[k].z); acc[6] += a2 * CVT_LO(vr[k].w); acc[7] += a2 * CVT_HI(vr[k].w);
                }
            }
        }
        f32x4 x[4]; float ss = 0.f;
#pragma unroll
        for (int j = 0; j < 4; ++j) {
            x[j] = *(const f32x4*)(XA + (size_t)t * DM + 4 * lane + 256 * j);
            x[j].x += acc[2 * j].x; x[j].y += acc[2 * j].y; x[j].z += acc[2 * j + 1].x; x[j].w += acc[2 * j + 1].y;
            ss += x[j].x * x[j].x + x[j].y * x[j].y + x[j].z * x[j].z + x[j].w * x[j].w;
        }
        ss = wave_sum(ss);
        const float r = rsqrtf(ss * (1.0f / DM) + EPS);
        if (last) {
#pragma unroll
            for (int j = 0; j < 4; ++j) { const f32x4 gg = *(const f32x4*)(gnext + 4 * lane + 256 * j); *(f32x4*)(p.out + (size_t)t * DM + 4 * lane + 256 * j) = x[j] * r * gg; }
        } else {
#pragma unroll
            for (int j = 0; j < 4; ++j) {
                const f32x4 gg = *(const f32x4*)(gnext + 4 * lane + 256 * j);
                *(f32x4*)((DRY ? p.out : XA) + (size_t)t * DM + 4 * lane + 256 * j) = x[j];
                u32x2 w; w.x = pk2(x[j].x * r * gg.x, x[j].y * r * gg.y); w.y = pk2(x[j].z * r * gg.z, x[j].w * r * gg.w);
                if (!DRY) *(u32x2*)(XN + (size_t)t * DM + 4 * lane + 256 * j) = w;
            }
        }
    }
}

#define LAS __attribute__((address_space(3)))
#define XB_TMO      128
#define XB_XCNT(j)  (256  + 64 * (j))
#define XB_XSUB(j)  (1280 + 64 * (j))
#define XB_XGEN(j)  (2304 + 64 * (j))
#define XB_TOP      3328
#define XB_TOPGEN   3392
#define XCD_BAR_WORDS 3456
#define XB_SPIN_CAP (1u << 20)
__device__ __forceinline__ unsigned xb_ld(unsigned* p)              { return __hip_atomic_load(p, __ATOMIC_RELAXED, __HIP_MEMORY_SCOPE_AGENT); }
__device__ __forceinline__ unsigned xb_add(unsigned* p, unsigned v) { return __hip_atomic_fetch_add(p, v, __ATOMIC_RELAXED, __HIP_MEMORY_SCOPE_AGENT); }
__device__ __forceinline__ unsigned xb_xcc_id() { return (unsigned)__builtin_amdgcn_s_getreg((3 << 11) | 20) & 0xFu; }
#define XB_SPIN(cond, bar) do { unsigned _sp = 0; while (cond) { __builtin_amdgcn_s_sleep(1); \
    if ((++_sp & 255u) == 0u) { if (xb_ld(&(bar)[XB_TMO])) break; if (_sp > XB_SPIN_CAP) { atomicAdd(&(bar)[XB_TMO], 1u); break; } } } } while (0)
struct XcdBarrier { unsigned* bar; unsigned x; volatile LAS unsigned* st; };
__device__ __forceinline__ XcdBarrier xcd_barrier_post(unsigned* bar, volatile LAS unsigned* st) {
    XcdBarrier b; b.bar = bar; b.x = xb_xcc_id(); b.st = st;
    if (threadIdx.x == 0) (void)xb_add(&bar[XB_XCNT(b.x)], 1u);
    return b;
}
__device__ __forceinline__ void xcd_barrier_complete(unsigned* bar, unsigned x, unsigned& nloc, unsigned& nx) {
    const unsigned G = gridDim.x * gridDim.y * gridDim.z;
    unsigned sum, cnt, mine, sp = 0u;
    for (;;) {
        sum = 0u; cnt = 0u; mine = 0u;
#pragma unroll
        for (unsigned j = 0; j < 16; ++j) { const unsigned c = xb_ld(&bar[XB_XCNT(j)]); sum += c; cnt += (c > 0u) ? 1u : 0u; mine = (j == x) ? c : mine; }
        if (sum == G) break;
        __builtin_amdgcn_s_sleep(1);
        if ((++sp & 255u) == 0u) { if (xb_ld(&bar[XB_TMO])) break; if (sp > XB_SPIN_CAP) { atomicAdd(&bar[XB_TMO], 1u); break; } }
    }
    nloc = mine > 0u ? mine : 1u; nx = cnt > 0u ? cnt : 1u;
}
__device__ __forceinline__ void xcd_barrier(const XcdBarrier& b) {
    asm volatile("s_waitcnt vmcnt(0)" ::: "memory");
    __syncthreads();
    if (threadIdx.x == 0) {
        unsigned* bar = b.bar;
        __builtin_amdgcn_s_waitcnt(0);
        unsigned nloc = b.st[0], nx = b.st[1];
        if (nloc == 0u) { xcd_barrier_complete(bar, b.x, nloc, nx); b.st[0] = nloc; b.st[1] = nx; }
        const unsigned old = xb_add(&bar[XB_XSUB(b.x)], 1u);
        const unsigned gen = old / nloc;
        if (old + 1u == (gen + 1u) * nloc) {
            __builtin_amdgcn_fence(__ATOMIC_RELEASE, "agent");
            asm volatile("s_waitcnt vmcnt(0)" ::: "memory");
            const unsigned og = xb_add(&bar[XB_TOP], 1u);
            const unsigned tg = og / nx;
            if (og + 1u == (tg + 1u) * nx) xb_add(&bar[XB_TOPGEN], 1u);
            else XB_SPIN(xb_ld(&bar[XB_TOPGEN]) == tg, bar);
            __builtin_amdgcn_fence(__ATOMIC_ACQUIRE, "agent");
            xb_add(&bar[XB_XGEN(b.x)], 1u);
            asm volatile("s_waitcnt vmcnt(0)" ::: "memory");
        } else {
            XB_SPIN(xb_ld(&bar[XB_XGEN(b.x)]) == gen, bar);
            __builtin_amdgcn_fence(__ATOMIC_ACQUIRE, "agent");
            asm volatile("s_waitcnt vmcnt(0)" ::: "memory");
        }
    }
    __syncthreads();
}

__global__ void __launch_bounds__(NTHR) mega_kernel(Params p) {
    extern __shared__ __attribute__((aligned(16))) char lds[];
    cg::grid_group grid = cg::this_grid();
    volatile LAS unsigned* misc = (volatile LAS unsigned*)((LAS char*)lds + LDS_MISC);
    if (threadIdx.x < 16) misc[threadIdx.x] = 0u;
    __syncthreads();
    const XcdBarrier xbar = xcd_barrier_post((unsigned*)(p.ws + OFF_CTL) + 4096, misc);
#define GSYNC() xcd_barrier(xbar)
    float* XA = (float*)(p.ws + OFF_XA);
#if PROBE == 7
    phase_p0(p, lds); GSYNC();
#endif
#if PROBE == 14
#pragma nounroll
    for (int i = 0; i < 40; ++i) GSYNC();
#endif
    phase_p0(p, lds);
    phase_rmsnorm_bf16(p.in[I_X], p.in[I_N1G], (bf16_t*)(p.ws + R_XN));
    grid.sync();
#pragma nounroll
    for (int layer = 0; layer < NLAYER; ++layer) {
        const float* xin = layer == 0 ? p.in[I_X] : XA;
#if PROBE == 10
        { EpiIn e{(bf16_t*)(p.ws + R_QKV), (float*)(p.ws + R_HF)};
          gemm_phase((const bf16_t*)(p.ws + R_XN), (const bf16_t*)(p.ws + OFF_WTIN) + (size_t)layer * INC * DM, T, INC, DM, lds, e); } GSYNC();
#endif
        { EpiIn e{(bf16_t*)(p.ws + R_QKV), (float*)(p.ws + R_HF)};
          gemm_phase((const bf16_t*)(p.ws + R_XN), (const bf16_t*)(p.ws + OFF_WTIN) + (size_t)layer * INC * DM, T, INC, DM, lds, e); }
        if (layer == 0) {
#pragma nounroll
            for (int fl = 0; fl < NLAYER; ++fl) {
                EpiF32 e{(float*)(p.ws + (fl ? OFF_HFILT1 : OFF_HFILT0)), SL};
                gemm_phase((const bf16_t*)(p.ws + OFF_W3T) + (size_t)fl * 1024 * 64, (const bf16_t*)(p.ws + OFF_H2) + (size_t)fl * SL * 64, 1024, SL, 64, lds, e);
            }
        }
        GSYNC();
        if (layer == 0) {
            phase_filter_spectra(p, lds);
#if PROBE == 13
            phase_filter_spectra(p, lds);
#endif
        }
#if PROBE == 12
        phase_qkprep(p, layer, lds, (bf16_t*)(p.ws + R_ATT)); GSYNC();
#endif
        phase_qkprep(p, layer, lds, (bf16_t*)(p.ws + R_QKV)); GSYNC();
        {
#if PROBE == 5
            phase_attn(p, lds);
#endif
#if PROBE == 6
            for (int c = obid(); c < 256; c += gridDim.x) hyena_job(p, layer, c, lds);
            for (int c = obid(); c < 256; c += gridDim.x) fnet_job(p, c, lds);
#endif
            phase_attn(p, lds);
            for (int c = obid(); c < 256; c += gridDim.x) hyena_job(p, layer, c, lds);
            for (int c = obid(); c < 256; c += gridDim.x) fnet_job(p, c, lds);
        } GSYNC();
#if PROBE == 8
        phase_mix(p, layer, lds); GSYNC();
#endif
        phase_mix(p, layer, lds); GSYNC();
#if PROBE == 11
        { EpiRes e{xin, p.out};
          gemm_phase((const bf16_t*)(p.ws + R_MIX), (const bf16_t*)(p.ws + OFF_WTOUT) + (size_t)layer * DM * DM, T, DM, DM, lds, e); } GSYNC();
#endif
        { EpiRes e{xin, XA};
          gemm_phase((const bf16_t*)(p.ws + R_MIX), (const bf16_t*)(p.ws + OFF_WTOUT) + (size_t)layer * DM * DM, T, DM, DM, lds, e); } GSYNC();
        phase_rmsnorm_bf16(XA, p.in[I_N2G] + layer * DM, (bf16_t*)(p.ws + R_XN)); GSYNC();
#if PROBE == 3
        { EpiF32 e{(float*)(p.ws + R_QP), 2048};
          gemm_phase((const bf16_t*)(p.ws + R_XN), (const bf16_t*)(p.ws + OFF_WTQ) + (size_t)layer * 2048 * DM, T, 2048, DM, lds, e); } GSYNC();
#endif
        { EpiF32 e{(float*)(p.ws + R_QP), 2048};
          gemm_phase((const bf16_t*)(p.ws + R_XN), (const bf16_t*)(p.ws + OFF_WTQ) + (size_t)layer * 2048 * DM, T, 2048, DM, lds, e); } GSYNC();
        phase_peer_topk(p, layer, lds, (int*)(p.ws + R_QP), (float*)(p.ws + R_QP)); GSYNC();
#if PROBE == 1
        phase_peer_gather<true>(p, layer); GSYNC();
#endif
#if PROBE == 15
        phase_peer_gather<true, 1023>(p, layer); GSYNC();
#endif
        phase_peer_gather<false>(p, layer);
        if (layer + 1 < NLAYER) GSYNC();
    }
}

extern "C" void kernel_launch(void* const* d_in, const int* in_sizes, int n_in, void* d_out, int out_size, void* d_ws, size_t ws_size, hipStream_t stream) {
    static int grid = 0;
    if (grid == 0) {
        if (n_in != 25 || out_size != T * DM || ws_size < WS_NEED) { fprintf(stderr, "kernel_launch: unexpected sizes n_in %d out %d ws %zu (need %zu)\n", n_in, out_size, ws_size, (size_t)WS_NEED); grid = -1; return; }
        int dev = 0, cus = 0, per_cu = 0;
        if (hipGetDevice(&dev) != hipSuccess || hipDeviceGetAttribute(&cus, hipDeviceAttributeMultiprocessorCount, dev) != hipSuccess) { grid = -1; return; }
        if (hipFuncSetAttribute((const void*)mega_kernel, hipFuncAttributeMaxDynamicSharedMemorySize, LDS_BYTES) != hipSuccess) { fprintf(stderr, "kernel_launch: hipFuncSetAttribute failed\n"); grid = -1; return; }
        if (hipOccupancyMaxActiveBlocksPerMultiprocessor(&per_cu, (const void*)mega_kernel, NTHR, LDS_BYTES) != hipSuccess || per_cu < 1) { fprintf(stderr, "kernel_launch: occupancy query says %d blocks per CU\n", per_cu); grid = -1; return; }
        (void)hipGetLastError();
        grid = cus;
    }
    if (grid < 0) return;
    Params p{};
    for (int i = 0; i < 25; ++i) p.in[i] = (const float*)d_in[i];
    p.out = (float*)d_out; p.ws = (unsigned char*)d_ws;
    if (hipMemsetAsync((char*)d_ws + OFF_CTL, 0, 64 * 1024, stream) != hipSuccess) { fprintf(stderr, "kernel_launch: memset failed\n"); return; }
    void* args[] = {&p};
    hipError_t e = hipLaunchCooperativeKernel((const void*)mega_kernel, dim3(grid), dim3(NTHR), args, LDS_BYTES, stream);
    if (e != hipSuccess) fprintf(stderr, "cooperative launch failed: %s (grid %d)\n", hipGetErrorString(e), grid);
}
```

```cpp
#include <hip/hip_runtime.h>
#include <hip/hip_cooperative_groups.h>
#include <cstdio>
#include <cstdint>
namespace cg = cooperative_groups;

#ifndef PROBE
#define PROBE 0
#endif
#ifndef PEER_FUSED
#define PEER_FUSED 1
#endif

typedef unsigned short bf16_t;
typedef short bf16x8 __attribute__((ext_vector_type(8)));
typedef float f32x16 __attribute__((ext_vector_type(16)));
typedef float f32x4 __attribute__((ext_vector_type(4)));
typedef unsigned u32x4 __attribute__((ext_vector_type(4)));
typedef unsigned u32x2 __attribute__((ext_vector_type(2)));

constexpr int DM = 1024, NB = 2, SL = 8192, T = NB * SL, NLAYER = 2;
constexpr int INC = 1792;
constexpr int NTHR = 512, NWAVE = 8;
constexpr int LDS_BYTES = 147456;
constexpr int LDS_MISC = LDS_BYTES - 64;
constexpr float EPS = 1e-6f;

constexpr size_t MiB = 1u << 20;
constexpr size_t OFF_CTL = 0;
constexpr size_t OFF_WTIN = 1 * MiB;
constexpr size_t OFF_WTOUT = 8 * MiB;
constexpr size_t OFF_WTQ = 12 * MiB;
constexpr size_t OFF_PU = 20 * MiB;
constexpr size_t OFF_PV = 84 * MiB;
constexpr size_t OFF_PSC = 512 * 1024;
constexpr size_t OFF_H2 = 148 * MiB;
constexpr size_t OFF_W3T = 150 * MiB;
constexpr size_t OFF_HFILT0 = 52 * MiB, OFF_HFILT1 = 116 * MiB;
constexpr size_t OFF_FM = 152 * MiB;
constexpr size_t OFF_KF = 153 * MiB;
constexpr size_t OFF_XA = 281 * MiB;
constexpr size_t OFF_R = 345 * MiB;
constexpr size_t R_XN = OFF_R + 0 * MiB;
constexpr size_t R_UR = OFF_R + 0 * MiB;
constexpr size_t R_UI = OFF_R + 16 * MiB;
constexpr size_t R_QKV = OFF_R + 32 * MiB;
constexpr size_t R_VT = OFF_R + 56 * MiB;
constexpr size_t R_HF = OFF_R + 60 * MiB;
constexpr size_t R_MIX = OFF_R + 60 * MiB;
constexpr size_t R_ATT = OFF_R + 124 * MiB;
constexpr size_t R_Y = OFF_R + 140 * MiB;
constexpr size_t R_QP = OFF_R + 32 * MiB;
constexpr size_t WS_NEED = 505 * MiB;

struct Params {
    const float* in[25];
    float* out;
    unsigned char* ws;
};
enum { I_X = 0, I_N1G, I_WIN, I_QG, I_KG, I_CW, I_CB, I_W1, I_B1, I_F1, I_W2, I_B2, I_F2, I_W3, I_HB, I_FW, I_FB, I_MG, I_WOUT, I_N2G, I_WQ, I_SK, I_PU, I_PV, I_FG };

__device__ __forceinline__ unsigned f2bf(float f) { unsigned u = __builtin_bit_cast(unsigned, f); return (u + 0x7fffu + ((u >> 16) & 1u)) >> 16; }
__device__ __forceinline__ unsigned pk2(float lo, float hi) { return f2bf(lo) | (f2bf(hi) << 16); }
__device__ __forceinline__ float bf2f(unsigned b) { return __builtin_bit_cast(float, b << 16); }
__device__ __forceinline__ float bflo(unsigned w) { return __builtin_bit_cast(float, w << 16); }
__device__ __forceinline__ float bfhi(unsigned w) { return __builtin_bit_cast(float, w & 0xffff0000u); }
__device__ __forceinline__ float wave_sum(float v) {
#pragma unroll
    for (int o = 1; o < 64; o <<= 1) v += __shfl_xor(v, o);
    return v;
}
__device__ __forceinline__ float wave_max(float v) {
#pragma unroll
    for (int o = 1; o < 64; o <<= 1) v = fmaxf(v, __shfl_xor(v, o));
    return v;
}
__device__ __forceinline__ f32x16 mfma32(bf16x8 a, bf16x8 b, f32x16 c) { return __builtin_amdgcn_mfma_f32_32x32x16_bf16(a, b, c, 0, 0, 0); }
__device__ __forceinline__ f32x16 zero16() { return (f32x16){0.f,0.f,0.f,0.f,0.f,0.f,0.f,0.f,0.f,0.f,0.f,0.f,0.f,0.f,0.f,0.f}; }


__device__ __forceinline__ int otid() { int t = threadIdx.x; asm volatile("" : "+v"(t)); return t; }
__device__ __forceinline__ int obid() { int b = blockIdx.x; asm volatile("" : "+s"(b)); return b; }
__device__ __forceinline__ void transpose_one(const float* W, int K, int N, bf16_t* Wt, float* tile, int item) {
    const int tid = otid();
    const int nblk = N / 64, kb = item / nblk, nb = item % nblk, k0 = kb * 64, n0 = nb * 64;
    __syncthreads();
    {
        const int r = tid >> 6, c = tid & 63;
#pragma unroll
        for (int i = 0; i < 8; ++i) { const int k = r + 8 * i; tile[k * 65 + c] = W[(size_t)(k0 + k) * N + n0 + c]; }
    }
    __syncthreads();
    {
        const int nn = tid >> 3, kc = tid & 7;
        const float* s = tile + (kc * 8) * 65 + nn;
        u32x4 o; o.x = pk2(s[0], s[65]); o.y = pk2(s[2 * 65], s[3 * 65]); o.z = pk2(s[4 * 65], s[5 * 65]); o.w = pk2(s[6 * 65], s[7 * 65]);
        *(u32x4*)(Wt + (size_t)(n0 + nn) * K + k0 + kc * 8) = o;
    }
}

__device__ __forceinline__ void phase_p0(const Params& p, char* lds) {
    const int tid = otid();
    float* tile = (float*)lds;
    constexpr int IT_IN = (DM / 64) * (INC / 64), IT_OUT = (DM / 64) * (DM / 64), IT_W3 = 1024 / 64;
    constexpr int IT_L = IT_IN + IT_OUT + IT_W3;
    for (int it = obid(); it < NLAYER * IT_L; it += gridDim.x) {
        const int layer = it / IT_L; int r = it % IT_L;
        if (r < IT_IN) { transpose_one(p.in[I_WIN] + (size_t)layer * DM * INC, DM, INC, (bf16_t*)(p.ws + OFF_WTIN) + (size_t)layer * INC * DM, tile, r); continue; }
        r -= IT_IN;
        if (r < IT_OUT) { transpose_one(p.in[I_WOUT] + (size_t)layer * DM * DM, DM, DM, (bf16_t*)(p.ws + OFF_WTOUT) + (size_t)layer * DM * DM, tile, r); continue; }
        r -= IT_OUT;
        transpose_one(p.in[I_W3] + (size_t)layer * 64 * 1024, 64, 1024, (bf16_t*)(p.ws + OFF_W3T) + (size_t)layer * 1024 * 64, tile, r);
    }
    __syncthreads();
    {
        float* SKl = (float*)lds;
        float* Wl = SKl + 128 * 129;
        for (int it = obid(); it < NLAYER * 16 * 16; it += gridDim.x) {
            const int layer = it >> 8, hp = (it >> 4) & 15, kc = it & 15, h = hp >> 1, pp = hp & 1, k0 = kc * 64;
            const float* sk = p.in[I_SK] + (((size_t)(layer * 2 + pp) * 8 + h) * 128) * 128;
            const float* wq = p.in[I_WQ] + (size_t)layer * DM * 2048 + (size_t)k0 * 2048 + h * 256 + pp * 128;
            __syncthreads();
            for (int i = tid; i < 128 * 128; i += NTHR) SKl[(i >> 7) * 129 + (i & 127)] = sk[i];
            for (int i = tid; i < 64 * 128; i += NTHR) Wl[(i >> 7) * 132 + (i & 127)] = wq[(size_t)(i >> 7) * 2048 + (i & 127)];
            __syncthreads();
            const int key = tid & 127, kq = tid >> 7;
            float acc[16];
#pragma unroll
            for (int j = 0; j < 16; ++j) acc[j] = 0.f;
            for (int d4 = 0; d4 < 32; ++d4) {
                const float a0 = SKl[key * 129 + d4 * 4], a1 = SKl[key * 129 + d4 * 4 + 1], a2 = SKl[key * 129 + d4 * 4 + 2], a3 = SKl[key * 129 + d4 * 4 + 3];
#pragma unroll
                for (int j = 0; j < 16; ++j) { const f32x4 w = *(const f32x4*)(Wl + (kq * 16 + j) * 132 + d4 * 4); acc[j] += a0 * w.x + a1 * w.y + a2 * w.z + a3 * w.w; }
            }
            bf16_t* dst = (bf16_t*)(p.ws + OFF_WTQ) + (size_t)layer * 2048 * DM + (size_t)(hp * 128 + key) * DM + k0 + kq * 16;
            u32x4 o0, o1;
            o0.x = pk2(acc[0], acc[1]); o0.y = pk2(acc[2], acc[3]); o0.z = pk2(acc[4], acc[5]); o0.w = pk2(acc[6], acc[7]);
            o1.x = pk2(acc[8], acc[9]); o1.y = pk2(acc[10], acc[11]); o1.z = pk2(acc[12], acc[13]); o1.w = pk2(acc[14], acc[15]);
            *(u32x4*)dst = o0; *(u32x4*)(dst + 8) = o1;
        }
        __syncthreads();
    }
    {
        const int lane = tid & 63, wave = tid >> 6;
        float* scl = (float*)(p.ws + OFF_PSC);
        for (int row = obid() * NWAVE + wave; row < 2 * NLAYER * 16384; row += gridDim.x * NWAVE) {
            const int tb = row >> 15, r = row & 32767;
            const f32x4* src = (const f32x4*)(p.in[tb ? I_PV : I_PU] + (size_t)r * DM) + lane;
            f32x4 v[4]; float mx = 0.f;
#pragma unroll
            for (int j = 0; j < 4; ++j) { v[j] = src[64 * j]; mx = fmaxf(mx, fmaxf(fmaxf(fabsf(v[j].x), fabsf(v[j].y)), fmaxf(fabsf(v[j].z), fabsf(v[j].w)))); }
            mx = wave_max(mx);
            const float sc = mx > 0.f ? 224.0f / mx : 1.0f;
            u32x4 o;
            { int w = 0; w = __builtin_amdgcn_cvt_pk_fp8_f32(v[0].x * sc, v[0].y * sc, w, false); w = __builtin_amdgcn_cvt_pk_fp8_f32(v[0].z * sc, v[0].w * sc, w, true); o.x = (unsigned)w; }
            { int w = 0; w = __builtin_amdgcn_cvt_pk_fp8_f32(v[1].x * sc, v[1].y * sc, w, false); w = __builtin_amdgcn_cvt_pk_fp8_f32(v[1].z * sc, v[1].w * sc, w, true); o.y = (unsigned)w; }
            { int w = 0; w = __builtin_amdgcn_cvt_pk_fp8_f32(v[2].x * sc, v[2].y * sc, w, false); w = __builtin_amdgcn_cvt_pk_fp8_f32(v[2].z * sc, v[2].w * sc, w, true); o.z = (unsigned)w; }
            { int w = 0; w = __builtin_amdgcn_cvt_pk_fp8_f32(v[3].x * sc, v[3].y * sc, w, false); w = __builtin_amdgcn_cvt_pk_fp8_f32(v[3].z * sc, v[3].w * sc, w, true); o.w = (unsigned)w; }
            *(u32x4*)(p.ws + (tb ? OFF_PV : OFF_PU) + (size_t)r * DM + lane * 16) = o;
            if (lane == 0) scl[row] = mx > 0.f ? mx / 224.0f : 1.0f;
        }
    }
    {
        float* sh = (float*)lds;
        float* zl = sh + 8 * 64;
        const int sub = tid >> 6, j = tid & 63;
        for (int it = obid(); it < NLAYER * SL / 8; it += gridDim.x) {
            const int layer = it / (SL / 8), l = (it % (SL / 8)) * 8 + sub;
            const float t = (float)l / (float)(SL - 1);
            __syncthreads();
            if (j < 17) {
                float z;
                if (j == 0) z = t;
                else if (j <= 8) z = sinf(2.0f * 3.14159265358979323846f * t * (float)j);
                else z = cosf(2.0f * 3.14159265358979323846f * t * (float)(j - 8));
                zl[sub * 17 + j] = z;
            }
            __syncthreads();
            const float* w1 = p.in[I_W1] + layer * 17 * 64;
            float a = p.in[I_B1][layer * 64 + j];
#pragma unroll
            for (int i = 0; i < 17; ++i) a += zl[sub * 17 + i] * w1[i * 64 + j];
            sh[sub * 64 + j] = sinf(p.in[I_F1][layer * 64 + j] * a);
            __syncthreads();
            const float* w2 = p.in[I_W2] + layer * 64 * 64;
            float b = p.in[I_B2][layer * 64 + j];
#pragma unroll 8
            for (int k = 0; k < 64; ++k) b += sh[sub * 64 + k] * w2[k * 64 + j];
            ((bf16_t*)(p.ws + OFF_H2))[((size_t)layer * SL + l) * 64 + j] = (bf16_t)f2bf(sinf(p.in[I_F2][layer * 64 + j] * b));
        }
    }
    {
        const int total = NLAYER * 4 * 128 * 64;
        for (int o = obid() * NTHR + tid; o < total; o += gridDim.x * NTHR) {
            const int e2 = o & 63, dd = (o >> 6) & 127, g = (o >> 13) & 3, layer = o >> 15;
            const int d = dd & 63;
            const float* w = p.in[I_FW] + ((size_t)(layer * 4 + g) * 64) * 64;
            float acc = 0.f;
            for (int e = 0; e < 64; ++e) {
                const int m = (d * e) & 63;
                const float ang = (float)m * (2.0f * 3.14159265358979323846f / 64.0f);
                const float tw = (dd < 64) ? cosf(ang) : sinf(ang);
                acc += tw * w[e * 64 + e2];
            }
            ((float*)(p.ws + OFF_FM))[o] = acc * (1.0f / 724.0773439350246f);
        }
    }
}

template <bool PAD> __device__ __forceinline__ int zi(int i) { return PAD ? i + (i >> 8) : i; }

template <int LOGN, bool PAD>
__device__ __forceinline__ void fft_fwd(float2* Z) {
    constexpr int N = 1 << LOGN;
    const int tid = otid();
    int s = 0;
    for (; s + 1 < LOGN; s += 2) {
        const int lh2 = LOGN - s - 2;
        const int h2 = 1 << lh2, h = h2 << 1;
        const float rs = 1.0f / (float)(h << 1);
        for (int q = tid; q < N / 4; q += NTHR) {
            const int j = q & (h2 - 1), blk = q >> lh2;
            const int base = (blk << (lh2 + 2)) + j;
            float2 x0 = Z[zi<PAD>(base)], x1 = Z[zi<PAD>(base + h2)], x2 = Z[zi<PAD>(base + h)], x3 = Z[zi<PAD>(base + h + h2)];
            const float ang = (float)j * rs;
            const float c = __builtin_amdgcn_cosf(ang), sn = __builtin_amdgcn_sinf(ang);
            float2 a0 = make_float2(x0.x + x2.x, x0.y + x2.y);
            float2 d02 = make_float2(x0.x - x2.x, x0.y - x2.y);
            float2 a2 = make_float2(d02.x * c + d02.y * sn, d02.y * c - d02.x * sn);
            float2 a1 = make_float2(x1.x + x3.x, x1.y + x3.y);
            float2 d13 = make_float2(x1.x - x3.x, x1.y - x3.y);
            float2 t3 = make_float2(d13.x * c + d13.y * sn, d13.y * c - d13.x * sn);
            float2 a3 = make_float2(t3.y, -t3.x);
            const float c2 = c * c - sn * sn, s2 = 2.f * c * sn;
            float2 y0 = make_float2(a0.x + a1.x, a0.y + a1.y);
            float2 e01 = make_float2(a0.x - a1.x, a0.y - a1.y);
            float2 y1 = make_float2(e01.x * c2 + e01.y * s2, e01.y * c2 - e01.x * s2);
            float2 y2 = make_float2(a2.x + a3.x, a2.y + a3.y);
            float2 e23 = make_float2(a2.x - a3.x, a2.y - a3.y);
            float2 y3 = make_float2(e23.x * c2 + e23.y * s2, e23.y * c2 - e23.x * s2);
            Z[zi<PAD>(base)] = y0; Z[zi<PAD>(base + h2)] = y1; Z[zi<PAD>(base + h)] = y2; Z[zi<PAD>(base + h + h2)] = y3;
        }
        __syncthreads();
    }
    if (s < LOGN) {
        for (int q = tid; q < N / 2; q += NTHR) {
            const int i0 = 2 * q;
            float2 a = Z[zi<PAD>(i0)], b = Z[zi<PAD>(i0 + 1)];
            Z[zi<PAD>(i0)] = make_float2(a.x + b.x, a.y + b.y);
            Z[zi<PAD>(i0 + 1)] = make_float2(a.x - b.x, a.y - b.y);
        }
        __syncthreads();
    }
}

template <int LOGN, bool PAD>
__device__ __forceinline__ void fft_inv(float2* Z) {
    constexpr int N = 1 << LOGN;
    const int tid = otid();
    for (int s = LOGN - 2; s >= 0; s -= 2) {
        const int lh2 = LOGN - s - 2;
        const int h2 = 1 << lh2, h = h2 << 1;
        const float rs = 1.0f / (float)(h << 1);
        for (int q = tid; q < N / 4; q += NTHR) {
            const int j = q & (h2 - 1), blk = q >> lh2;
            const int base = (blk << (lh2 + 2)) + j;
            float2 y0 = Z[zi<PAD>(base)], y1 = Z[zi<PAD>(base + h2)], y2 = Z[zi<PAD>(base + h)], y3 = Z[zi<PAD>(base + h + h2)];
            const float ang = (float)j * rs;
            const float c = __builtin_amdgcn_cosf(ang), sn = __builtin_amdgcn_sinf(ang);
            const float c2 = c * c - sn * sn, s2 = 2.f * c * sn;
            float2 t1 = make_float2(y1.x * c2 - y1.y * s2, y1.y * c2 + y1.x * s2);
            float2 t3 = make_float2(y3.x * c2 - y3.y * s2, y3.y * c2 + y3.x * s2);
            float2 a0 = make_float2(y0.x + t1.x, y0.y + t1.y), a1 = make_float2(y0.x - t1.x, y0.y - t1.y);
            float2 a2 = make_float2(y2.x + t3.x, y2.y + t3.y), a3 = make_float2(y2.x - t3.x, y2.y - t3.y);
            float2 u2 = make_float2(a2.x * c - a2.y * sn, a2.y * c + a2.x * sn);
            float2 u3 = make_float2(a3.x * c - a3.y * sn, a3.y * c + a3.x * sn);
            float2 v3 = make_float2(-u3.y, u3.x);
            Z[zi<PAD>(base)] = make_float2(a0.x + u2.x, a0.y + u2.y);
            Z[zi<PAD>(base + h)] = make_float2(a0.x - u2.x, a0.y - u2.y);
            Z[zi<PAD>(base + h2)] = make_float2(a1.x + v3.x, a1.y + v3.y);
            Z[zi<PAD>(base + h + h2)] = make_float2(a1.x - v3.x, a1.y - v3.y);
        }
        __syncthreads();
    }
}

__device__ __forceinline__ void phase_filter_spectra(const Params& p, char* lds) {
    const int tid = otid(), lane = tid & 63, wave = tid >> 6;
    float2* Z = (float2*)lds;
    float* red = (float*)(lds + 131072);
    for (int job = obid(); job < NLAYER * 256; job += gridDim.x) {
        const int layer = job >> 8, c = job & 255;
        __syncthreads();
        const float* HFc = (const float*)(p.ws + (layer ? OFF_HFILT1 : OFF_HFILT0)) + (size_t)c * SL;
        const float r_lo = 4.605170185988092f / 1.5f, r_hi = 4.605170185988092f / 0.3f;
        const float rate = r_lo + (r_hi - r_lo) * ((float)c / 255.0f);
        float ss0 = 0.f, ss1 = 0.f;
#pragma unroll 1
        for (int i = 0; i < 4; ++i) {
            const int l0 = 4 * tid + 2048 * i;
            const f32x4 a0 = *(const f32x4*)(HFc + l0), a1 = *(const f32x4*)(HFc + (size_t)256 * SL + l0);
            const f32x4 a2 = *(const f32x4*)(HFc + (size_t)512 * SL + l0), a3 = *(const f32x4*)(HFc + (size_t)768 * SL + l0);
#pragma unroll
            for (int e = 0; e < 4; ++e) {
                const int l = l0 + e;
                const float t = (float)l / (float)(SL - 1);
                const float dec = expf(-t * rate);
                const float f0 = a0[e] * dec, b0 = a1[e] * dec, f1 = a2[e] * dec, b1 = a3[e] * dec;
                ss0 += f0 * f0 + b0 * b0; ss1 += f1 * f1 + b1 * b1;
                Z[l] = make_float2(f0, f1);
                if (l >= 1) Z[16384 - l] = make_float2(b0, b1);
            }
        }
        if (tid == 0) Z[8192] = make_float2(0.f, 0.f);
        ss0 = wave_sum(ss0); ss1 = wave_sum(ss1);
        if (lane == 0) { red[wave * 2] = ss0; red[wave * 2 + 1] = ss1; }
        __syncthreads();
        float t0 = 0.f, t1 = 0.f;
#pragma unroll
        for (int w = 0; w < 8; ++w) { t0 += red[w * 2]; t1 += red[w * 2 + 1]; }
        const float sc0 = rsqrtf(t0 + EPS) * (1.0f / 16384.0f) * 0.5f, sc1 = rsqrtf(t1 + EPS) * (1.0f / 16384.0f) * 0.5f;
        fft_fwd<14, false>(Z);
        float2* KF0 = (float2*)(p.ws + OFF_KF) + ((size_t)(layer * 256 + c) * 2) * 16384;
        float2* KF1 = KF0 + 16384;
        for (int i = 0; i < 32; ++i) {
            const int pp = tid + NTHR * i;
            const int f = (int)(__brev((unsigned)pp) >> 18);
            const int fm = (16384 - f) & 16383;
            const int pq = (int)(__brev((unsigned)fm) >> 18);
            const float2 zp = Z[pp], zq = Z[pq];
            KF0[pp] = make_float2((zp.x + zq.x) * sc0, (zp.y - zq.y) * sc0);
            KF1[pp] = make_float2((zp.y + zq.y) * sc1, (zq.x - zp.x) * sc1);
        }
    }
}

__device__ __forceinline__ void phase_rmsnorm_bf16(const float* x, const float* g, bf16_t* out) {
    const int lane = otid() & 63, wave = otid() >> 6;
    const int gw = obid() * NWAVE + wave, ngw = gridDim.x * NWAVE;
    for (int row = gw; row < T; row += ngw) {
        const f32x4* xr = (const f32x4*)(x + (size_t)row * DM) + lane;
        f32x4 v[4]; float ss = 0.f;
#pragma unroll
        for (int j = 0; j < 4; ++j) { v[j] = xr[64 * j]; ss += v[j].x * v[j].x + v[j].y * v[j].y + v[j].z * v[j].z + v[j].w * v[j].w; }
        ss = wave_sum(ss);
        const float r = rsqrtf(ss * (1.0f / DM) + EPS);
        u32x2* o = (u32x2*)(out + (size_t)row * DM) + lane;
#pragma unroll
        for (int j = 0; j < 4; ++j) {
            const f32x4 gg = ((const f32x4*)g)[lane + 64 * j];
            u32x2 w; w.x = pk2(v[j].x * r * gg.x, v[j].y * r * gg.y); w.y = pk2(v[j].z * r * gg.z, v[j].w * r * gg.w);
            o[64 * j] = w;
        }
    }
}
__device__ __forceinline__ void phase_final_norm(const float* x, const float* g, float* out) {
    const int lane = otid() & 63, wave = otid() >> 6;
    const int gw = obid() * NWAVE + wave, ngw = gridDim.x * NWAVE;
    for (int row = gw; row < T; row += ngw) {
        const f32x4* xr = (const f32x4*)(x + (size_t)row * DM) + lane;
        f32x4 v[4]; float ss = 0.f;
#pragma unroll
        for (int j = 0; j < 4; ++j) { v[j] = xr[64 * j]; ss += v[j].x * v[j].x + v[j].y * v[j].y + v[j].z * v[j].z + v[j].w * v[j].w; }
        ss = wave_sum(ss);
        const float r = rsqrtf(ss * (1.0f / DM) + EPS);
        f32x4* o = (f32x4*)(out + (size_t)row * DM) + lane;
#pragma unroll
        for (int j = 0; j < 4; ++j) { const f32x4 gg = ((const f32x4*)g)[lane + 64 * j]; o[64 * j] = v[j] * r * gg; }
    }
}

constexpr int G_LDA = 144;
template <class Epi>
__device__ __forceinline__ void gemm_simple(const bf16_t* A, const bf16_t* Bt, int M, int N, int K, char* lds, const Epi& epi) {
    const int tid = otid(), lane = tid & 63, wave = tid >> 6;
    const int wm = wave >> 1, wn = wave & 1;
    const int nMt = M / 256, nNt = N / 128, total = nMt * nNt, nk = K / 64;
    char* As = lds; char* Bs = lds + 256 * G_LDA;
    const int l31 = lane & 31, hl = lane >> 5;
    for (int u = obid(); u < total; u += gridDim.x) {
        const int mt = u % nMt, nt = u / nMt;
        f32x16 acc[2][2];
#pragma unroll
        for (int i = 0; i < 2; ++i)
#pragma unroll
            for (int j = 0; j < 2; ++j) acc[i][j] = zero16();
        u32x4 ra[4], rb[2];
        const bf16_t* Ab = A + (size_t)(mt * 256) * K;
        const bf16_t* Bb = Bt + (size_t)(nt * 128) * K;
#pragma unroll
        for (int i = 0; i < 4; ++i) { const int id = tid + NTHR * i, row = id >> 3, ch = id & 7; ra[i] = *(const u32x4*)(Ab + (size_t)row * K + ch * 8); }
#pragma unroll
        for (int i = 0; i < 2; ++i) { const int id = tid + NTHR * i, row = id >> 3, ch = id & 7; rb[i] = *(const u32x4*)(Bb + (size_t)row * K + ch * 8); }
        for (int kt = 0; kt < nk; ++kt) {
            __syncthreads();
#pragma unroll
            for (int i = 0; i < 4; ++i) { const int id = tid + NTHR * i, row = id >> 3, ch = id & 7; *(u32x4*)(As + row * G_LDA + ch * 16) = ra[i]; }
#pragma unroll
            for (int i = 0; i < 2; ++i) { const int id = tid + NTHR * i, row = id >> 3, ch = id & 7; *(u32x4*)(Bs + row * G_LDA + ch * 16) = rb[i]; }
            __syncthreads();
            if (kt + 1 < nk) {
                const int ko = (kt + 1) * 64;
#pragma unroll
                for (int i = 0; i < 4; ++i) { const int id = tid + NTHR * i, row = id >> 3, ch = id & 7; ra[i] = *(const u32x4*)(Ab + (size_t)row * K + ko + ch * 8); }
#pragma unroll
                for (int i = 0; i < 2; ++i) { const int id = tid + NTHR * i, row = id >> 3, ch = id & 7; rb[i] = *(const u32x4*)(Bb + (size_t)row * K + ko + ch * 8); }
            }
#pragma unroll
            for (int ks = 0; ks < 4; ++ks) {
                bf16x8 a[2], b[2];
#pragma unroll
                for (int i = 0; i < 2; ++i) a[i] = *(const bf16x8*)(As + (wm * 64 + i * 32 + l31) * G_LDA + ks * 32 + hl * 16);
#pragma unroll
                for (int j = 0; j < 2; ++j) b[j] = *(const bf16x8*)(Bs + (wn * 64 + j * 32 + l31) * G_LDA + ks * 32 + hl * 16);
#pragma unroll
                for (int i = 0; i < 2; ++i)
#pragma unroll
                    for (int j = 0; j < 2; ++j) acc[i][j] = mfma32(a[i], b[j], acc[i][j]);
            }
        }
#pragma unroll
        for (int i = 0; i < 2; ++i)
#pragma unroll
            for (int j = 0; j < 2; ++j) epi(acc[i][j], mt * 256 + wm * 64 + i * 32, nt * 128 + wn * 64 + j * 32, lane);
    }
}

struct EpiIn {
    bf16_t* qkv; float* hf;
    __device__ __forceinline__ void operator()(const f32x16& acc, int row0, int col0, int lane) const {
        const int c = col0 + (lane & 31), h = lane >> 5;
        if (col0 < 768) {
#pragma unroll
            for (int r = 0; r < 16; ++r) { const int row = row0 + (r & 3) + 8 * (r >> 2) + 4 * h; qkv[(size_t)row * 768 + c] = (bf16_t)f2bf(acc[r]); }
        } else {
            float* dst = hf + (size_t)(c - 768) * T;
#pragma unroll
            for (int i = 0; i < 4; ++i) { const int row = row0 + 8 * i + 4 * h; f32x4 v; v.x = acc[4 * i]; v.y = acc[4 * i + 1]; v.z = acc[4 * i + 2]; v.w = acc[4 * i + 3]; *(f32x4*)(dst + row) = v; }
        }
    }
};
struct EpiRes {
    const float* base; float* out;
    __device__ __forceinline__ void operator()(const f32x16& acc, int row0, int col0, int lane) const {
        const int c = col0 + (lane & 31), h = lane >> 5;
#pragma unroll
        for (int r = 0; r < 16; ++r) { const size_t o = (size_t)(row0 + (r & 3) + 8 * (r >> 2) + 4 * h) * DM + c; out[o] = base[o] + acc[r]; }
    }
};
struct EpiF32 {
    float* out; int ld;
    __device__ __forceinline__ void operator()(const f32x16& acc, int row0, int col0, int lane) const {
        const int c = col0 + (lane & 31), h = lane >> 5;
#pragma unroll
        for (int r = 0; r < 16; ++r) { out[(size_t)(row0 + (r & 3) + 8 * (r >> 2) + 4 * h) * ld + c] = acc[r]; }
    }
};

namespace pg8 {
#define PG8_LAS __attribute__((address_space(3)))
constexpr int BM = 256, BK = 64, HALF = 128, HTB = HALF * BK * 2  , STAGE_BYTES = 8 * HTB, NXCD = 8, WGM = 8;

__host__ __device__ __forceinline__ int lds_byte(int r, int c) { const int st = (r >> 4) * 2 + (c >> 5), rr = r & 15, cc = c & 31, ob = rr * 64 + cc * 2; return st * 1024 + (ob ^ (((ob >> 9) & 1) << 5)); }
__host__ __device__ __forceinline__ void stage_rc(int b, int& R, int& C) { const int st = b / 1024, sb = b % 1024, swz = sb ^ (((sb >> 9) & 1) << 5); R = (st >> 1) * 16 + swz / 64; C = (st & 1) * 32 + (swz % 64) / 2; }
__host__ __device__ __forceinline__ int perm32(int rho) { const int n = rho >> 4, i = rho & 15; return 8 * (i >> 2) + 4 * n + (i & 3); }

struct Unit { int pm, pn; };
struct Gemm { const bf16_t* A; const bf16_t* Bt; int M, N, K; };

struct StaticOrder {
    int nM, nN, nwg, G, c;
    __host__ __device__ void init(int M, int N, int G_, int c_) { nM = M / BM; nN = N / BM; nwg = nM * nN; G = G_; c = c_; }
    __host__ __device__ bool next(int i, Unit& u) const {
        const long L = (long)i * G + c; if (L >= nwg) return false;
        int wgid = (int)L; { const int q = nwg / NXCD, r = nwg % NXCD, xcd = wgid % NXCD, off = wgid / NXCD; wgid = (xcd < r ? xcd * (q + 1) : r * (q + 1) + (xcd - r) * q) + off; }
        const int nig = WGM * nN, gid = wgid / nig, fm = gid * WGM, gsz = (nM - fm) < WGM ? (nM - fm) : WGM;
        u.pm = fm + ((wgid % nig) % gsz); u.pn = (wgid % nig) / gsz; return true;
    }
    __device__ __forceinline__ void a_ready(const Unit&) const {}
    __device__ __forceinline__ void done(const Unit&) const {}
};


__device__ __forceinline__ unsigned cvt_pk_bf16(float lo, float hi) { unsigned r; asm volatile("v_cvt_pk_bf16_f32 %0, %1, %2" : "=v"(r) : "v"(lo), "v"(hi)); return r; }
struct EpiStoreBf16 {
    static constexpr bool PERM = true, AFTER_DRAIN = false;
    bf16_t* O; int ldc;
    __device__ __forceinline__ void operator()(const f32x4 (&acc)[2][2][4][2], const Unit& u, int wr, int wc, int fr, int fq) const {
        const int row0 = u.pm * BM + wr * 64 + fr, col0 = u.pn * BM + wc * 32 + 8 * fq;
#pragma unroll
        for (int ai = 0; ai < 2; ++ai)
#pragma unroll
            for (int m = 0; m < 4; ++m) { bf16_t* rowp = O + (size_t)(row0 + ai * HALF + m * 16) * ldc + col0;
#pragma unroll
                for (int bj = 0; bj < 2; ++bj) { const f32x4 v0 = acc[ai][bj][m][0], v1 = acc[ai][bj][m][1];
                    u32x4 w; w.x = cvt_pk_bf16(v0[0], v0[1]); w.y = cvt_pk_bf16(v0[2], v0[3]); w.z = cvt_pk_bf16(v1[0], v1[1]); w.w = cvt_pk_bf16(v1[2], v1[3]);
                    *(u32x4*)(rowp + bj * HALF) = w; } }
    }
};
struct EpiStoreF32 {
    static constexpr bool PERM = false, AFTER_DRAIN = false;
    const float* base; float* O; int ldc;
    __device__ __forceinline__ void operator()(const f32x4 (&acc)[2][2][4][2], const Unit& u, int wr, int wc, int fr, int fq) const {
        const int row0 = u.pm * BM + wr * 64 + fr, col0 = u.pn * BM + wc * 32 + 4 * fq;
#pragma unroll
        for (int ai = 0; ai < 2; ++ai)
#pragma unroll
            for (int m = 0; m < 4; ++m) { const size_t off = (size_t)(row0 + ai * HALF + m * 16) * ldc + col0;
#pragma unroll
                for (int bj = 0; bj < 2; ++bj)
#pragma unroll
                    for (int n = 0; n < 2; ++n) { f32x4 v = acc[ai][bj][m][n]; if (base) v += *(const f32x4*)(base + off + bj * HALF + n * 16); *(f32x4*)(O + off + bj * HALF + n * 16) = v; } }
    }
};

template <class Epi, class Sched, bool ALIGN_EPI = false, bool SP2 = false>
__device__ __forceinline__ void gemm_phase(PG8_LAS unsigned char* lds, const Gemm g, const Sched& S, const Epi& E) {
    const int tid = otid(), wid = __builtin_amdgcn_readfirstlane(tid >> 6), lane = tid & 63, wr = wid >> 2, wc = wid & 3, fr = lane & 15, fq = lane >> 4;
    const int K = g.K, nt = K / BK;
    unsigned voffA[2], voffB[2];
#pragma unroll
    for (int i = 0; i < 2; ++i) { int R, C; stage_rc(tid * 16 + i * 8192, R, C); const int Rb = Epi::PERM ? ((R & ~31) + perm32(R & 31)) : R;
        voffA[i] = (unsigned)(R * K + C) * 2u; voffB[i] = (unsigned)(Rb * K + C) * 2u; }
    const size_t kstep = (size_t)(BK * 2);
    const size_t hstep = (size_t)HALF * K * 2;
    const size_t tstep = 2 * hstep;
    const unsigned ldsw = (unsigned)wid * 1024u;
    const int aoff = lds_byte(wr * 64 + fr, fq * 8), boff = lds_byte(wc * 32 + fr, fq * 8);
#define PG8_SA(b, h) (((b) * 2 + (h)) * HTB)
#define PG8_SB(b, h) ((4 + (b) * 2 + (h)) * HTB)
#define PG8_STAGE(bufoff, gbase, voff) do { _Pragma("unroll") for (int _i = 0; _i < 2; ++_i) \
        __builtin_amdgcn_global_load_lds((const unsigned*)((const char*)(gbase) + (voff)[_i]), (PG8_LAS unsigned*)(lds + (bufoff) + ldsw + _i * 8192), 16, 0, 0); } while (0)
#define PG8_LDA(dst, b, h) do { _Pragma("unroll") for (int m = 0; m < 4; ++m) _Pragma("unroll") for (int k = 0; k < 2; ++k) dst[m][k] = *(const PG8_LAS bf16x8*)(lds + PG8_SA(b, h) + aoff + m * 2048 + k * 1024); } while (0)
#define PG8_LDB(dst, b, h) do { _Pragma("unroll") for (int n = 0; n < 2; ++n) _Pragma("unroll") for (int k = 0; k < 2; ++k) dst[n][k] = *(const PG8_LAS bf16x8*)(lds + PG8_SB(b, h) + boff + n * 2048 + k * 1024); } while (0)
#define PG8_MMA(ai, bj, At, Bt) do { __builtin_amdgcn_s_setprio(1); _Pragma("unroll") for (int m = 0; m < 4; ++m) _Pragma("unroll") for (int n = 0; n < 2; ++n) _Pragma("unroll") for (int k = 0; k < 2; ++k) \
        acc[ai][bj][m][n] = __builtin_amdgcn_mfma_f32_16x16x32_bf16(Bt[n][k], At[m][k], acc[ai][bj][m][n], 0, 0, 0); __builtin_amdgcn_s_setprio(0); } while (0)
#define PG8_WAIT_V(n) asm volatile("s_waitcnt vmcnt(" #n ")" ::: "memory")
#define PG8_WAIT_L(n) asm volatile("s_waitcnt lgkmcnt(" #n ")" ::: "memory")
#define PG8_BAR __builtin_amdgcn_s_barrier()
#define PG8_SCHED __builtin_amdgcn_sched_barrier(0)
    Unit cur, nxt; int ui = 0;
    if (!S.next(0, cur)) return;
    f32x4 acc[2][2][4][2];
#pragma unroll
    for (int a = 0; a < 2; ++a)
#pragma unroll
        for (int b = 0; b < 2; ++b)
#pragma unroll
            for (int m = 0; m < 4; ++m)
#pragma unroll
                for (int n = 0; n < 2; ++n) acc[a][b][m][n] = (f32x4){0.f, 0.f, 0.f, 0.f};
    bf16x8 At[4][2], B0[2][2], B1[2][2];
    const char* cA = (const char*)g.A + (size_t)cur.pm * tstep; const char* cB = (const char*)g.Bt + (size_t)cur.pn * tstep;
    S.a_ready(cur);
    if constexpr (SP2) {
        PG8_STAGE(PG8_SB(0, 0), cB, voffB); PG8_STAGE(PG8_SB(0, 1), cB + hstep, voffB); PG8_STAGE(PG8_SA(0, 0), cA, voffA); PG8_STAGE(PG8_SA(0, 1), cA + hstep, voffA);
        if (wr == 1) PG8_BAR;
        PG8_WAIT_V(2); PG8_BAR;
        PG8_STAGE(PG8_SB(1, 0), cB + kstep, voffB); PG8_STAGE(PG8_SA(1, 0), cA + kstep, voffA); PG8_STAGE(PG8_SB(1, 1), cB + hstep + kstep, voffB);
        PG8_WAIT_V(6); PG8_BAR;
    } else {
        PG8_STAGE(PG8_SB(0, 0), cB, voffB); PG8_STAGE(PG8_SA(0, 0), cA, voffA); PG8_STAGE(PG8_SB(0, 1), cB + hstep, voffB); PG8_STAGE(PG8_SA(0, 1), cA + hstep, voffA);
        if (wr == 1) PG8_BAR;
        PG8_WAIT_V(4); PG8_BAR;
        PG8_STAGE(PG8_SB(1, 0), cB + kstep, voffB); PG8_STAGE(PG8_SA(1, 0), cA + kstep, voffA); PG8_STAGE(PG8_SB(1, 1), cB + hstep + kstep, voffB);
        PG8_WAIT_V(6); PG8_BAR;
    }
    for (;;) {
        const bool has_next = S.next(ui + 1, nxt);
        const char* nA = has_next ? (const char*)g.A + (size_t)nxt.pm * tstep : cA; const char* nB = has_next ? (const char*)g.Bt + (size_t)nxt.pn * tstep : cB;
        for (int t = 0; t < nt; t += 2) {
            const bool last = (t == nt - 2);
            const char* a1 = cA + (size_t)(t + 1) * kstep;
            const char* a2 = last ? nA : cA + (size_t)(t + 2) * kstep; const char* b2 = last ? nB : cB + (size_t)(t + 2) * kstep;
            const char* a3 = a2 + kstep; const char* b3 = b2 + kstep;
            if (last && has_next) S.a_ready(nxt);
            if constexpr (SP2) {
            PG8_LDB(B0, 0, 0); PG8_LDB(B1, 0, 1); PG8_SCHED; PG8_LDA(At, 0, 0); PG8_STAGE(PG8_SA(1, 1), a1 + hstep, voffA);
            PG8_WAIT_V(8); PG8_WAIT_L(0); PG8_BAR; PG8_MMA(0, 0, At, B0); PG8_MMA(0, 1, At, B1); PG8_BAR; PG8_SCHED;
            PG8_LDA(At, 0, 1); PG8_STAGE(PG8_SB(0, 0), b2, voffB); PG8_STAGE(PG8_SB(0, 1), b2 + hstep, voffB); PG8_STAGE(PG8_SA(0, 0), a2, voffA);
            PG8_WAIT_V(8); PG8_WAIT_L(0); PG8_BAR; PG8_MMA(1, 0, At, B0); PG8_MMA(1, 1, At, B1); PG8_BAR; PG8_SCHED;
            PG8_LDB(B0, 1, 0); PG8_LDB(B1, 1, 1); PG8_SCHED; PG8_LDA(At, 1, 0); PG8_STAGE(PG8_SA(0, 1), a2 + hstep, voffA);
            PG8_WAIT_V(8); PG8_WAIT_L(0); PG8_BAR; PG8_MMA(0, 0, At, B0); PG8_MMA(0, 1, At, B1); PG8_BAR; PG8_SCHED;
            PG8_LDA(At, 1, 1); PG8_STAGE(PG8_SB(1, 0), b3, voffB); PG8_STAGE(PG8_SB(1, 1), b3 + hstep, voffB); PG8_STAGE(PG8_SA(1, 0), a3, voffA);
            PG8_WAIT_V(8); PG8_WAIT_L(0); PG8_BAR; PG8_MMA(1, 0, At, B0); PG8_MMA(1, 1, At, B1); PG8_BAR; PG8_SCHED;
            } else {
            PG8_LDB(B0, 0, 0); PG8_SCHED; PG8_LDA(At, 0, 0); PG8_STAGE(PG8_SA(1, 1), a1 + hstep, voffA);
            PG8_WAIT_L(8); PG8_BAR; PG8_WAIT_L(0); PG8_MMA(0, 0, At, B0); PG8_BAR; PG8_SCHED;
            PG8_LDB(B1, 0, 1); PG8_STAGE(PG8_SB(0, 0), b2, voffB);
            PG8_BAR; PG8_WAIT_L(0); PG8_MMA(0, 1, At, B1); PG8_BAR;
            PG8_LDA(At, 0, 1); PG8_STAGE(PG8_SA(0, 0), a2, voffA);
            PG8_BAR; PG8_WAIT_L(0); PG8_MMA(1, 0, At, B0); PG8_BAR; PG8_SCHED;
            PG8_STAGE(PG8_SB(0, 1), b2 + hstep, voffB);
            PG8_WAIT_V(6); PG8_BAR; PG8_MMA(1, 1, At, B1); PG8_BAR;
            PG8_LDB(B0, 1, 0); PG8_SCHED; PG8_LDA(At, 1, 0); PG8_STAGE(PG8_SA(0, 1), a2 + hstep, voffA);
            PG8_WAIT_L(8); PG8_BAR; PG8_WAIT_L(0); PG8_MMA(0, 0, At, B0); PG8_BAR; PG8_SCHED;
            PG8_LDB(B1, 1, 1); PG8_STAGE(PG8_SB(1, 0), b3, voffB);
            PG8_BAR; PG8_WAIT_L(0); PG8_MMA(0, 1, At, B1); PG8_BAR;
            PG8_LDA(At, 1, 1); PG8_STAGE(PG8_SA(1, 0), a3, voffA);
            PG8_BAR; PG8_WAIT_L(0); PG8_MMA(1, 0, At, B0); PG8_BAR; PG8_SCHED;
            PG8_STAGE(PG8_SB(1, 1), b3 + hstep, voffB);
            PG8_WAIT_V(6); PG8_BAR; PG8_MMA(1, 1, At, B1); PG8_BAR;
            }
        }
        if constexpr (ALIGN_EPI) { if (wr == 0) PG8_BAR; }
        if constexpr (!Epi::AFTER_DRAIN) { E(acc, cur, wr, wc, fr, fq); S.done(cur); }
        if (!has_next) break;
#pragma unroll
        for (int a = 0; a < 2; ++a)
#pragma unroll
            for (int b = 0; b < 2; ++b)
#pragma unroll
                for (int m = 0; m < 4; ++m)
#pragma unroll
                    for (int n = 0; n < 2; ++n) acc[a][b][m][n] = (f32x4){0.f, 0.f, 0.f, 0.f};
        cur = nxt; cA = nA; cB = nB; ++ui;
        if constexpr (ALIGN_EPI) { if (wr == 1) PG8_BAR; }
    }
    PG8_WAIT_V(0);
    if constexpr (!ALIGN_EPI) { if (wr == 0) PG8_BAR; }
    PG8_BAR;
    if constexpr (Epi::AFTER_DRAIN) { E.fused(acc, cur, wr, wc, fr, fq, lds, wid, lane); S.done(cur); }
#undef PG8_SA
#undef PG8_SB
#undef PG8_STAGE
#undef PG8_LDA
#undef PG8_LDB
#undef PG8_MMA
#undef PG8_WAIT_V
#undef PG8_WAIT_L
#undef PG8_BAR
#undef PG8_SCHED
}
}

__device__ __forceinline__ void phase_qkprep(const Params& p, int layer, char* lds, bf16_t* qout) {
    const int tid = otid(), lane = tid & 63, wave = tid >> 6;
    bf16_t* qkv = (bf16_t*)(p.ws + R_QKV);
    bf16_t* vt = (bf16_t*)(p.ws + R_VT);
    const float qgv = p.in[I_QG][layer * 64 + lane], kgv = p.in[I_KG][layer * 64 + lane];
    const int gw = obid() * NWAVE + wave, ngw = gridDim.x * NWAVE;
    const int ax = lane >> 5, fr = lane & 15; const bool second = (lane >> 4) & 1;
    const float inv = powf(10000.0f, -(float)fr / 16.0f);
    for (int t = gw; t < T; t += ngw) {
        const int l = t & (SL - 1);
        const float pos = ax ? (float)(l & 63) : (float)(l >> 6);
        const float ang = pos * inv;
        const float cs = cosf(ang), sn = sinf(ang);
        bf16_t* row = qkv + (size_t)t * 768;
#pragma unroll
        for (int slot = 0; slot < 10; ++slot) {
            const float x = bf2f(row[slot * 64 + lane]);
            const float ss = wave_sum(x * x);
            const float r = rsqrtf(ss * (1.0f / 64.0f) + EPS);
            const float y = x * r * (slot < 8 ? qgv : kgv);
            const float other = __shfl_xor(y, 16);
            float o = second ? (y * cs + other * sn) : (y * cs - other * sn);
            if (slot < 8) o *= 0.125f * 1.4426950408889634f;
            qout[(size_t)t * 768 + slot * 64 + lane] = (bf16_t)f2bf(o);
        }
    }
}

#include <hip/hip_bf16.h>
#include <cmath>
namespace attn_body {
using bf16=__hip_bfloat16;
using bf16x8=__attribute__((ext_vector_type(8)))short;
using s16x4=__attribute__((ext_vector_type(4)))short;
using f32x16=__attribute__((ext_vector_type(16)))float;
using u32x4=__attribute__((ext_vector_type(4)))unsigned;
constexpr int SEQ=8192,D=64,PQ=768,PO=512;
constexpr int NW=8,QBLK=32,QB=QBLK*NW,KVBLK=64,NQB=SEQ/QB;
constexpr int ATTN_UNIT_ROWS=QB;
__device__ __forceinline__ int crow(int r,int hi){return (r&3)+8*(r>>2)+4*hi;}
#define SBAR() __builtin_amdgcn_sched_barrier(0)
__device__ __forceinline__ void cmask(f32x16&p0,f32x16&p1,int jb,int qrel,int hi){
  const float NEG=-INFINITY; int kb=64*jb+4*hi;
  #pragma unroll
  for(int r=0;r<16;++r){int kv=kb+(r&3)+8*(r>>2); if(kv>qrel)p0[r]=NEG; if(kv+32>qrel)p1[r]=NEG;}
}

constexpr int NSLOT=3, SLOTB=8192;
constexpr int LDS_K=0, LDS_V=NSLOT*SLOTB, LDS_WS=2*NSLOT*SLOTB, LDS_OST=LDS_WS+NW*64*4, LDS_BYTES=LDS_OST+NW*4096;
constexpr float C2=0.125f*1.4426950408889634f;
__device__ __forceinline__ void glds16(const void*gsrc,unsigned lds_dst){unsigned keep;
  asm volatile("s_mov_b32 %0, m0\n\ts_mov_b32 m0, %2\n\ts_nop 0\n\tglobal_load_lds_dwordx4 %1, off\n\ts_mov_b32 m0, %0":"=&s"(keep):"v"(gsrc),"s"(lds_dst):"memory");}
__device__ __forceinline__ float max3f(float a,float b,float c){float r;asm("v_max3_f32 %0, %1, %2, %3":"=v"(r):"v"(a),"v"(b),"v"(c));return r;}
__device__ __forceinline__ float max2f(float a,float b){float r;asm("v_max_f32_e32 %0, %1, %2":"=v"(r):"v"(a),"v"(b));return r;}
__device__ __forceinline__ float fadd_s(float a,float b){float r;asm("v_add_f32_e32 %0, %1, %2":"=v"(r):"v"(a),"v"(b));return r;}
__device__ __forceinline__ float fsub_s(float a,float b){float r;asm("v_sub_f32_e32 %0, %1, %2":"=v"(r):"v"(a),"v"(b));return r;}
typedef float f32x2_t __attribute__((ext_vector_type(2))); typedef __bf16 bf16x2_t __attribute__((ext_vector_type(2)));
__device__ __forceinline__ unsigned cvtpk_s(float lo,float hi){f32x2_t v={lo,hi};bf16x2_t b=__builtin_convertvector(v,bf16x2_t);return __builtin_bit_cast(unsigned,b);}
#define WAIT_BAR(N) asm volatile("s_waitcnt vmcnt(" #N ") lgkmcnt(0)\n\ts_barrier":::"memory")

__device__ __forceinline__ void qkt(f32x16&p0,f32x16&p1,const char*Kslot,const bf16x8*qr,const f32x16&negm,int r32,int hi){
  const char*kb=Kslot+hi*1024+r32*16;
  #pragma unroll
  for(int d0=0;d0<4;++d0){
    const bf16x8 b0=*reinterpret_cast<const bf16x8*>(kb+d0*2048);
    const bf16x8 b1=*reinterpret_cast<const bf16x8*>(kb+d0*2048+512);
    if(d0==0){p0=__builtin_amdgcn_mfma_f32_32x32x16_bf16(b0,qr[0],negm,0,0,0);p1=__builtin_amdgcn_mfma_f32_32x32x16_bf16(b1,qr[0],negm,0,0,0);}
    else{p0=__builtin_amdgcn_mfma_f32_32x32x16_bf16(b0,qr[d0],p0,0,0,0);p1=__builtin_amdgcn_mfma_f32_32x32x16_bf16(b1,qr[d0],p1,0,0,0);}}
}
typedef __attribute__((address_space(3))) const char* lds_cptr;
typedef short v4i16_t __attribute__((ext_vector_type(4)));
__device__ __forceinline__ void kload8(bf16x8*kf,lds_cptr kp){
  kf[0]=*(const __attribute__((address_space(3))) bf16x8*)(kp);      kf[1]=*(const __attribute__((address_space(3))) bf16x8*)(kp+512);
  kf[2]=*(const __attribute__((address_space(3))) bf16x8*)(kp+2048); kf[3]=*(const __attribute__((address_space(3))) bf16x8*)(kp+2560);
  kf[4]=*(const __attribute__((address_space(3))) bf16x8*)(kp+4096); kf[5]=*(const __attribute__((address_space(3))) bf16x8*)(kp+4608);
  kf[6]=*(const __attribute__((address_space(3))) bf16x8*)(kp+6144); kf[7]=*(const __attribute__((address_space(3))) bf16x8*)(kp+6656);
}
__device__ __forceinline__ void kload2(bf16x8*kf,lds_cptr kp,int j){ kf[2*j]=*(const __attribute__((address_space(3))) bf16x8*)(kp+j*2048); kf[2*j+1]=*(const __attribute__((address_space(3))) bf16x8*)(kp+j*2048+512); }
__device__ __forceinline__ s16x4 vtr(lds_cptr p){ return __builtin_bit_cast(s16x4,__builtin_amdgcn_ds_read_tr16_b64_v4i16((__attribute__((address_space(3))) v4i16_t*)p)); }
__device__ __forceinline__ float rowmax(const f32x16&p0,const f32x16&p1){
  float a=max3f(p0[0],p0[1],p1[0]),b=max3f(p0[2],p0[3],p1[1]);a=max3f(a,p1[2],p1[3]);
  #pragma unroll
  for(int r=4;r<16;r+=4){a=max3f(a,p0[r],p0[r+1]);b=max3f(b,p0[r+2],p0[r+3]);a=max3f(a,p1[r],p1[r+1]);b=max3f(b,p1[r+2],p1[r+3]);}
  const float m=max2f(a,b);
  auto rr=__builtin_amdgcn_permlane32_swap(__float_as_uint(m),__float_as_uint(m),false,false);
  return max2f(__uint_as_float(rr[0]),__uint_as_float(rr[1]));
}
__device__ __forceinline__ void pv(f32x16*o,int vb,bf16x8 pa0,bf16x8 pa1,bf16x8 pa2,bf16x8 pa3){
  #pragma unroll
  for(int d0=0;d0<2;++d0){s16x4 lo[4],hi[4];
    #pragma unroll
    for(int ks=0;ks<4;++ks){
      asm volatile("ds_read_b64_tr_b16 %0,%1 offset:%c2":"=&v"(lo[ks]):"v"(vb),"i"(d0*4096+ks*1024):"memory");
      asm volatile("ds_read_b64_tr_b16 %0,%1 offset:%c2":"=&v"(hi[ks]):"v"(vb),"i"(d0*4096+ks*1024+512):"memory");}
    asm volatile("s_waitcnt lgkmcnt(0)":::"memory");SBAR();
    #define PK(k) (bf16x8){lo[k][0],lo[k][1],lo[k][2],lo[k][3],hi[k][0],hi[k][1],hi[k][2],hi[k][3]}
    o[d0]=__builtin_amdgcn_mfma_f32_32x32x16_bf16(pa0,PK(0),o[d0],0,0,0);
    o[d0]=__builtin_amdgcn_mfma_f32_32x32x16_bf16(pa1,PK(1),o[d0],0,0,0);
    o[d0]=__builtin_amdgcn_mfma_f32_32x32x16_bf16(pa2,PK(2),o[d0],0,0,0);
    o[d0]=__builtin_amdgcn_mfma_f32_32x32x16_bf16(pa3,PK(3),o[d0],0,0,0);
    #undef PK
  }
}

#ifndef ATTN_STORE16
#define ATTN_STORE16(p,v) (*(u32x4*)(p)=(v))
#endif
template<int THRL> __device__ __forceinline__ void attn_unit(int b,int h,int g,int qb,const bf16*Q,const bf16*__restrict__ K,const bf16*__restrict__ V,bf16*O,char*shm){
  const int tid=otid(),lane=tid&63,r32=lane&31,hi=lane>>5; const int wid=__builtin_amdgcn_readfirstlane(tid>>6);
  const long rowbase=(long)b*SEQ; const int q0=qb*QB;
  const bf16*Qw=Q+(rowbase+q0+wid*QBLK)*PQ+h*D;
  const bf16*Kh=K+rowbase*PQ+g*D,*Vh=V+rowbase*PQ+g*D;
  const unsigned lds0=(unsigned)(uintptr_t)shm;
  float*wsf=(float*)(shm+LDS_WS)+wid*64;
  const bf16*ksrc=Kh+(long)lane*PQ+wid*8;
  const bf16*vsrc=Vh+(long)(16*(wid&3)+(lane>>2))*PQ+(wid>>2)*32+(lane&3)*8;
  const unsigned kdst=lds0+LDS_K+wid*1024, vdst=lds0+LDS_V+wid*1024;
  #define DMA_K(t,slot) glds16(ksrc+(long)(t)*KVBLK*PQ,(unsigned)__builtin_amdgcn_readfirstlane(kdst+(slot)))
  #define DMA_V(t,slot) glds16(vsrc+(long)(t)*KVBLK*PQ,(unsigned)__builtin_amdgcn_readfirstlane(vdst+(slot)))
  const int vb0=(int)(lds0+LDS_V)+((lane>>4)&1)*32+(lane&3)*8+(4*hi+((lane&15)>>2))*64;
  const char*Kbase=shm+LDS_K; bf16x8 kf[8];
  const lds_cptr shm3=(lds_cptr)shm; const lds_cptr kp0=shm3+LDS_K+hi*1024+r32*16; const lds_cptr vp0=shm3+LDS_V+((lane>>4)&1)*32+(lane&3)*8+(4*hi+((lane&15)>>2))*64;
  constexpr int NT=SEQ/KVBLK;
  DMA_K(0,0);DMA_V(0,0);DMA_K(1,SLOTB);
  bf16x8 qr[4];
  #pragma unroll
  for(int d0=0;d0<4;++d0)qr[d0]=*reinterpret_cast<const bf16x8*>(&Qw[(long)r32*PQ+d0*16+hi*8]);
  float mhat=0.f,l_reg=0.f;f32x16 o[2];o[0]=f32x16{};o[1]=f32x16{};f32x16 negm=f32x16{};asm volatile("":"+v"(negm));
    #define CMASK(P0,P1,t) do{}while(0)
  bool resc=false;
  #define START(P0,P1) do{ const float rm=rowmax(P0,P1); resc=false; \
    { const float dl=rm; mhat=fadd_s(mhat,dl); \
      _Pragma("unroll") for(int r=0;r<16;++r){P0[r]=fsub_s(P0[r],dl);P1[r]=fsub_s(P1[r],dl);} \
      _Pragma("unroll") for(int r=0;r<16;++r)negm[r]=-mhat; asm volatile("":"+v"(negm)); } \
    _Pragma("unroll") for(int r=0;r<16;++r)P0[r]=__builtin_amdgcn_exp2f(P0[r]); }while(0)
  #define RESC() do{ if(resc){ asm volatile("s_waitcnt lgkmcnt(0)":::"memory"); \
      _Pragma("unroll") for(int d_=0;d_<2;++d_) _Pragma("unroll") for(int r=0;r<16;++r)o[d_][r]*=wsf[crow(r,hi)]; } }while(0)
  f32x16 pA0,pA1,pB0,pB1;
  int sl_prev=0,sl_cur=0,sl_next=SLOTB;
  #define ROT() do{sl_prev=sl_cur;sl_cur=sl_next;sl_next=(sl_next==(NSLOT-1)*SLOTB)?0:sl_next+SLOTB;}while(0)
  DMA_K(2,2*SLOTB);
  WAIT_BAR(3);
  qkt(pA0,pA1,Kbase,qr,negm,r32,hi);asm volatile("s_nop 15\n\ts_nop 7":"+v"(pA0),"+v"(pA1));CMASK(pA0,pA1,0);
  START(pA0,pA1);
  _Pragma("unroll") for(int r=0;r<16;++r)pA1[r]=__builtin_amdgcn_exp2f(pA1[r]);
  WAIT_BAR(0);
  DMA_K(3,0);DMA_V(1,SLOTB);
  ROT();
  kload8(kf,kp0+sl_cur);
  WAIT_BAR(2);
  s16x4 vlo[8],vhi[8]; u32x4 pw0,pw1,pw2,pw3;
  #define PKW(P,B) cvtpk_s(P[B],P[B+1])
  #define PAF(k) __builtin_bit_cast(bf16x8,pw##k)
  #define VFR(i) (bf16x8){vlo[i][0],vlo[i][1],vlo[i][2],vlo[i][3],vhi[i][0],vhi[i][1],vhi[i][2],vhi[i][3]}
  #define PIN(x) asm volatile("":"+v"(x))
  #define MX3(a,b,c) __builtin_fmaxf(__builtin_fmaxf((a),(b)),(c))
  #define GAPA(MF,A0,A1,A2,A3,W0,W1,PW) do{ MF; sacc+=A0; sacc+=A1; sacc+=A2; sacc+=A3; PIN(sacc); W0; W1; PIN(PW); SBAR(); }while(0)
  #define EX(v) __builtin_amdgcn_exp2f(v)
  #define GAPB(MF,X,B) do{ MF; X[B]=EX(X[B]); X[B+1]=EX(X[B+1]); X[B+2]=EX(X[B+2]); X[B+3]=EX(X[B+3]); PIN(X); SBAR(); }while(0)
  #define VRD(i) do{ vlo[i]=vtr(vp_+(((i)>>2)*4096+((i)&3)*1024)); vhi[i]=vtr(vp_+(((i)>>2)*4096+((i)&3)*1024+512)); }while(0)
  #define KRD(G,j) do{ if(G){ kload2(kf,kp0+sl_next,j); SBAR(); } }while(0)
  #define STEP(C0,C1,P0,P1,t,GK,GV,GL) do{ SBAR(); \
    const lds_cptr vp_=vp0+sl_prev; \
    VRD(0); SBAR(); float sacc=(P0[0]+P0[1]); \
    GAPA(C0=__builtin_amdgcn_mfma_f32_32x32x16_bf16(kf[0],qr[0],negm,0,0,0), P0[2],P0[3],P0[4],P0[5],     pw0[0]=PKW(P0,0), pw0[1]=PKW(P0,2), pw0); \
    VRD(4); SBAR(); GAPA(C1=__builtin_amdgcn_mfma_f32_32x32x16_bf16(kf[1],qr[0],negm,0,0,0), P0[6],P0[7],P0[8],P0[9],     pw0[2]=PKW(P0,4), pw0[3]=PKW(P0,6), pw0); \
    VRD(1); SBAR(); GAPA(C0=__builtin_amdgcn_mfma_f32_32x32x16_bf16(kf[2],qr[1],C0,0,0,0),   P0[10],P0[11],P0[12],P0[13], pw1[0]=PKW(P0,8), pw1[1]=PKW(P0,10), pw1); \
    VRD(5); SBAR(); GAPA(C1=__builtin_amdgcn_mfma_f32_32x32x16_bf16(kf[3],qr[1],C1,0,0,0),   P0[14],P0[15],P1[0],P1[1],   pw1[2]=PKW(P0,12),pw1[3]=PKW(P0,14), pw1); \
    VRD(2); SBAR(); GAPA(C0=__builtin_amdgcn_mfma_f32_32x32x16_bf16(kf[4],qr[2],C0,0,0,0),   P1[2],P1[3],P1[4],P1[5],     pw2[0]=PKW(P1,0), pw2[1]=PKW(P1,2), pw2); \
    VRD(6); SBAR(); GAPA(C1=__builtin_amdgcn_mfma_f32_32x32x16_bf16(kf[5],qr[2],C1,0,0,0),   P1[6],P1[7],P1[8],P1[9],     pw2[2]=PKW(P1,4), pw2[3]=PKW(P1,6), pw2); \
    VRD(3); SBAR(); GAPA(C0=__builtin_amdgcn_mfma_f32_32x32x16_bf16(kf[6],qr[3],C0,0,0,0),   P1[10],P1[11],P1[12],P1[13], pw3[0]=PKW(P1,8), pw3[1]=PKW(P1,10), pw3); \
    VRD(7); SBAR(); GAPA(C1=__builtin_amdgcn_mfma_f32_32x32x16_bf16(kf[7],qr[3],C1,0,0,0),   P1[14],P1[15],0.f,0.f,       pw3[2]=PKW(P1,12),pw3[3]=PKW(P1,14), pw3); \
    l_reg+=sacc; \
    if(GK){DMA_K((t)+3,sl_cur);} if(GV){DMA_V((t)+1,sl_next);} \
    CMASK(C0,C1,t); \
    { float a=MX3(C0[0],C0[1],C1[0]),b=MX3(C0[2],C0[3],C1[1]); a=MX3(a,C1[2],C1[3]); \
      _Pragma("unroll") for(int r=4;r<16;r+=4){a=MX3(a,C0[r],C0[r+1]);b=MX3(b,C0[r+2],C0[r+3]);a=MX3(a,C1[r],C1[r+1]);b=MX3(b,C1[r+2],C1[r+3]);} \
      float rm=__builtin_fmaxf(a,b); { auto rr=__builtin_amdgcn_permlane32_swap(__float_as_uint(rm),__float_as_uint(rm),false,false); rm=__builtin_fmaxf(__uint_as_float(rr[0]),__uint_as_float(rr[1])); } \
      resc=false; \
      if(__builtin_expect(__any(rm>(float)THRL),0)){ const float dl=__builtin_fmaxf(rm,0.f); mhat+=dl; \
        _Pragma("unroll") for(int r=0;r<16;++r){C0[r]-=dl;C1[r]-=dl;} \
        _Pragma("unroll") for(int r=0;r<16;++r)negm[r]=-mhat; asm volatile("":"+v"(negm)); \
        const float f=__builtin_amdgcn_exp2f(-dl); l_reg*=f; if(hi==0)wsf[r32]=f; resc=true; } } \
    SBAR(); \
    GAPB(o[0]=__builtin_amdgcn_mfma_f32_32x32x16_bf16(PAF(0),VFR(0),o[0],0,0,0), C0,0); \
    GAPB(o[1]=__builtin_amdgcn_mfma_f32_32x32x16_bf16(PAF(0),VFR(4),o[1],0,0,0), C0,4); \
    KRD(GL,0); GAPB(o[0]=__builtin_amdgcn_mfma_f32_32x32x16_bf16(PAF(1),VFR(1),o[0],0,0,0), C0,8); \
    KRD(GL,1); GAPB(o[1]=__builtin_amdgcn_mfma_f32_32x32x16_bf16(PAF(1),VFR(5),o[1],0,0,0), C0,12); \
    KRD(GL,2); GAPB(o[0]=__builtin_amdgcn_mfma_f32_32x32x16_bf16(PAF(2),VFR(2),o[0],0,0,0), C1,0); \
    KRD(GL,3); GAPB(o[1]=__builtin_amdgcn_mfma_f32_32x32x16_bf16(PAF(2),VFR(6),o[1],0,0,0), C1,4); \
    GAPB(o[0]=__builtin_amdgcn_mfma_f32_32x32x16_bf16(PAF(3),VFR(3),o[0],0,0,0), C1,8); \
    GAPB(o[1]=__builtin_amdgcn_mfma_f32_32x32x16_bf16(PAF(3),VFR(7),o[1],0,0,0), C1,12); \
    }while(0)
  int t=1;
  #undef CMASK
  #define CMASK(P0,P1,t) do{}while(0)
  for(;t+5<NT;t+=2){
    STEP(pB0,pB1,pA0,pA1,t,true,true,true);     WAIT_BAR(2); RESC(); ROT();
    STEP(pA0,pA1,pB0,pB1,t+1,true,true,true);   WAIT_BAR(2); RESC(); ROT();
  }
  #define ENDW(tt) do{ if((tt)+3<NT){WAIT_BAR(2);} else if((tt)+2<NT){WAIT_BAR(1);} else {WAIT_BAR(0);} }while(0)
  for(;t+1<NT;t+=2){
    STEP(pB0,pB1,pA0,pA1,t,(t+3<NT),(t+1<NT),(t+1<NT));       ENDW(t);   RESC(); ROT();
    STEP(pA0,pA1,pB0,pB1,t+1,(t+4<NT),(t+2<NT),(t+2<NT));     ENDW(t+1); RESC(); ROT();
  }
  STEP(pB0,pB1,pA0,pA1,NT-1,false,false,false); RESC();
  { float sacc=pB0[0]+pB0[1]; _Pragma("unroll") for(int r=2;r<16;++r)sacc+=pB0[r]; _Pragma("unroll") for(int r=0;r<16;++r)sacc+=pB1[r]; l_reg+=sacc;
    pw0=(u32x4){PKW(pB0,0),PKW(pB0,2),PKW(pB0,4),PKW(pB0,6)};pw1=(u32x4){PKW(pB0,8),PKW(pB0,10),PKW(pB0,12),PKW(pB0,14)};pw2=(u32x4){PKW(pB1,0),PKW(pB1,2),PKW(pB1,4),PKW(pB1,6)};pw3=(u32x4){PKW(pB1,8),PKW(pB1,10),PKW(pB1,12),PKW(pB1,14)};
    SBAR(); pv(o,vb0+sl_cur,PAF(0),PAF(1),PAF(2),PAF(3)); }
  #undef PKW
  #undef PAF
  #undef VFR
  #undef PIN
  #undef MX3
  #undef GAPA
  #undef GAPB
  #undef EX
  #undef VRD
  #undef KRD
  #undef STEP
  #undef ENDW
  {auto rr=__builtin_amdgcn_permlane32_swap(__float_as_uint(l_reg),__float_as_uint(l_reg),false,false);l_reg=__uint_as_float(rr[0])+__uint_as_float(rr[1]);}
  if(hi==0)wsf[32+r32]=l_reg;asm volatile("s_waitcnt lgkmcnt(0)":::"memory");
  float rli[16];
  #pragma unroll
  for(int r=0;r<16;++r)rli[r]=__builtin_amdgcn_rcpf(wsf[32+crow(r,hi)]);
  bf16*Ow=O+(rowbase+q0+wid*QBLK)*PO+h*D;
  { bf16*stg=(bf16*)(shm+LDS_OST)+wid*2048;
    #pragma unroll
    for(int r=0;r<16;++r){const int orow=crow(r,hi);
      #pragma unroll
      for(int d0=0;d0<2;++d0)stg[orow*64+d0*32+r32]=__float2bfloat16(o[d0][r]*rli[r]);}
    asm volatile("s_waitcnt lgkmcnt(0)":::"memory");
    #pragma unroll
    for(int i=0;i<4;++i){const int row=i*8+(lane>>3),ch=lane&7; const u32x4 v=*(const u32x4*)(stg+row*64+ch*8); ATTN_STORE16(Ow+(long)row*PO+ch*8,v);} }
  asm volatile("s_waitcnt lgkmcnt(0)\n\ts_barrier":::"memory");
  #undef DMA_K
  #undef DMA_V
  #undef CMASK
  #undef START
  #undef RESC
  #undef ROT
}
constexpr int ATTN_LDS_BYTES=LDS_BYTES;
#undef SBAR
#undef WAIT_BAR
}

__device__ __forceinline__ void phase_attn(const Params& p, char* lds) {
            {
                const int bid = obid();
                const int vcu = ((gridDim.x & 7) == 0) ? (bid & 7) * (int)(gridDim.x >> 3) + (bid >> 3) : bid;
                const attn_body::bf16* qkvb = (const attn_body::bf16*)(p.ws + R_QKV);
                for (int u = vcu; u < 512; u += gridDim.x) {
                    const int bg = (u & 255) >> 6, r = u & 63, hh = r & 3, qb = (r >> 2) + 16 * (u >> 8);
                    const int b = bg >> 1, g = bg & 1;
                    attn_body::attn_unit<8>(b, 4 * g + hh, g, qb, qkvb, qkvb + 512, qkvb + 640, (attn_body::bf16*)(p.ws + R_ATT), lds);
                }
            }
}

__device__ __forceinline__ f32x4 convd4(const float* row, int l0, float w0, float w1, float w2, float cb) {
    const f32x4 c = *(const f32x4*)(row + l0);
    const float lft = (l0 > 0) ? row[l0 - 1] : 0.f;
    const float rgt = (l0 + 4 < SL) ? row[l0 + 4] : 0.f;
    f32x4 o;
    o.x = cb + w0 * lft + w1 * c.x + w2 * c.y;
    o.y = cb + w0 * c.x + w1 * c.y + w2 * c.z;
    o.z = cb + w0 * c.y + w1 * c.z + w2 * c.w;
    o.w = cb + w0 * c.z + w1 * c.w + w2 * rgt;
    return o;
}
__device__ __forceinline__ void cmul_kf(float2* Z, const float2* KF, int tid) {
#pragma unroll 4
    for (int i = 0; i < 16; ++i) {
        const int pp = 2 * tid + 1024 * i;
        const f32x4 z = *(const f32x4*)(Z + pp), k = *(const f32x4*)(KF + pp);
        f32x4 o; o.x = z.x * k.x - z.y * k.y; o.y = z.x * k.y + z.y * k.x; o.z = z.z * k.z - z.w * k.w; o.w = z.z * k.w + z.w * k.z;
        *(f32x4*)(Z + pp) = o;
    }
}
__device__ __forceinline__ void hyena_job(const Params& p, int layer, int c, char* lds) {
    const int tid = otid();
    float2* Z = (float2*)lds;
    const float* HF = (const float*)(p.ws + R_HF);
    const float* cw = p.in[I_CW] + (size_t)layer * 3 * 768; const float* cbp = p.in[I_CB] + layer * 768;
    const float2* KF0 = (const float2*)(p.ws + OFF_KF) + ((size_t)(layer * 256 + c) * 2) * 16384;
    const float2* KF1 = KF0 + 16384;
    float* Y = (float*)(p.ws + R_Y) + (size_t)c * T;
    const float bias0 = p.in[I_HB][(layer * 2 + 0) * 256 + c], bias1 = p.in[I_HB][(layer * 2 + 1) * 256 + c];
    const int cv = c, c1 = 256 + c, c2 = 512 + c;
    const float* rv = HF + (size_t)cv * T; const float* r1 = HF + (size_t)c1 * T; const float* r2 = HF + (size_t)c2 * T;
    const float v_w0 = cw[cv], v_w1 = cw[768 + cv], v_w2 = cw[1536 + cv], v_cb = cbp[cv];
    const float a_w0 = cw[c1], a_w1 = cw[768 + c1], a_w2 = cw[1536 + c1], a_cb = cbp[c1];
    const float b_w0 = cw[c2], b_w1 = cw[768 + c2], b_w2 = cw[1536 + c2], b_cb = cbp[c2];
    const f32x4 zero4 = {0.f, 0.f, 0.f, 0.f};
    __syncthreads();
#pragma unroll
    for (int i = 0; i < 4; ++i) {
        const int l0 = 4 * tid + 2048 * i;
        const f32x4 va = convd4(rv, l0, v_w0, v_w1, v_w2, v_cb), vb = convd4(rv + SL, l0, v_w0, v_w1, v_w2, v_cb);
        *(f32x4*)(Z + l0) = (f32x4){va.x, vb.x, va.y, vb.y}; *(f32x4*)(Z + l0 + 2) = (f32x4){va.z, vb.z, va.w, vb.w};
        *(f32x4*)(Z + 8192 + l0) = zero4; *(f32x4*)(Z + 8192 + l0 + 2) = zero4;
    }
    __syncthreads();
    fft_fwd<14, false>(Z);
    cmul_kf(Z, KF0, tid);
    __syncthreads();
    fft_inv<14, false>(Z);
#pragma unroll
    for (int i = 0; i < 4; ++i) {
        const int l0 = 4 * tid + 2048 * i;
        const f32x4 za = *(const f32x4*)(Z + l0), zb = *(const f32x4*)(Z + l0 + 2);
        const f32x4 va = convd4(rv, l0, v_w0, v_w1, v_w2, v_cb), vb = convd4(rv + SL, l0, v_w0, v_w1, v_w2, v_cb);
        const f32x4 ga = convd4(r1, l0, a_w0, a_w1, a_w2, a_cb), gb = convd4(r1 + SL, l0, a_w0, a_w1, a_w2, a_cb);
        f32x4 ya, yb;
        ya.x = ga.x * (za.x + va.x * bias0); ya.y = ga.y * (za.z + va.y * bias0); ya.z = ga.z * (zb.x + va.z * bias0); ya.w = ga.w * (zb.z + va.w * bias0);
        yb.x = gb.x * (za.y + vb.x * bias0); yb.y = gb.y * (za.w + vb.y * bias0); yb.z = gb.z * (zb.y + vb.z * bias0); yb.w = gb.w * (zb.w + vb.w * bias0);
        *(f32x4*)(Y + l0) = ya; *(f32x4*)(Y + SL + l0) = yb;
        *(f32x4*)(Z + l0) = (f32x4){ya.x, yb.x, ya.y, yb.y}; *(f32x4*)(Z + l0 + 2) = (f32x4){ya.z, yb.z, ya.w, yb.w};
        *(f32x4*)(Z + 8192 + l0) = zero4; *(f32x4*)(Z + 8192 + l0 + 2) = zero4;
    }
    __syncthreads();
    fft_fwd<14, false>(Z);
    cmul_kf(Z, KF1, tid);
    __syncthreads();
    fft_inv<14, false>(Z);
#pragma unroll
    for (int i = 0; i < 4; ++i) {
        const int l0 = 4 * tid + 2048 * i;
        const f32x4 za = *(const f32x4*)(Z + l0), zb = *(const f32x4*)(Z + l0 + 2);
        const f32x4 ga = convd4(r2, l0, b_w0, b_w1, b_w2, b_cb), gb = convd4(r2 + SL, l0, b_w0, b_w1, b_w2, b_cb);
        const f32x4 pa = *(const f32x4*)(Y + l0), pb = *(const f32x4*)(Y + SL + l0);
        f32x4 ya, yb;
        ya.x = ga.x * (za.x + pa.x * bias1); ya.y = ga.y * (za.z + pa.y * bias1); ya.z = ga.z * (zb.x + pa.z * bias1); ya.w = ga.w * (zb.z + pa.w * bias1);
        yb.x = gb.x * (za.y + pb.x * bias1); yb.y = gb.y * (za.w + pb.y * bias1); yb.z = gb.z * (zb.y + pb.z * bias1); yb.w = gb.w * (zb.w + pb.w * bias1);
        *(f32x4*)(Y + l0) = ya; *(f32x4*)(Y + SL + l0) = yb;
    }
    __syncthreads();
}

__device__ __forceinline__ void fnet_job(const Params& p, int ch, char* lds) {
    const int tid = otid();
    float2* Z = (float2*)lds;
    const float* row = (const float*)(p.ws + R_HF) + (size_t)(768 + ch) * T;
    float* UR = (float*)(p.ws + R_UR) + (size_t)ch * T;
    float* UI = (float*)(p.ws + R_UI) + (size_t)ch * T;
    __syncthreads();
#pragma unroll
    for (int i = 0; i < 4; ++i) {
        const int l0 = 4 * tid + 2048 * i;
        const f32x4 a = *(const f32x4*)(row + l0), b = *(const f32x4*)(row + SL + l0);
        const int z0 = zi<true>(l0);
        Z[z0] = make_float2(a.x, b.x); Z[z0 + 1] = make_float2(a.y, b.y); Z[z0 + 2] = make_float2(a.z, b.z); Z[z0 + 3] = make_float2(a.w, b.w);
    }
    __syncthreads();
    fft_fwd<13, true>(Z);
#pragma unroll
    for (int i = 0; i < 4; ++i) {
        const int k0 = 4 * tid + 2048 * i;
        f32x4 ur0, ui0, ur1, ui1;
#pragma unroll
        for (int e = 0; e < 4; ++e) {
            const int k = k0 + e;
            const int pk = (int)(__brev((unsigned)k) >> 19);
            const int km = (SL - k) & (SL - 1);
            const int pm = (int)(__brev((unsigned)km) >> 19);
            const float2 zk = Z[zi<true>(pk)], zm = Z[zi<true>(pm)];
            ur0[e] = 0.5f * (zk.x + zm.x); ui0[e] = 0.5f * (zk.y - zm.y);
            ur1[e] = 0.5f * (zk.y + zm.y); ui1[e] = 0.5f * (zm.x - zk.x);
        }
        *(f32x4*)(UR + k0) = ur0; *(f32x4*)(UI + k0) = ui0; *(f32x4*)(UR + SL + k0) = ur1; *(f32x4*)(UI + SL + k0) = ui1;
    }
    __syncthreads();
}

__device__ __forceinline__ void phase_mix(const Params& p, int layer, char* lds) {
    const int tid = otid(), lane = tid & 63, wave = tid >> 6;
    const int l31 = lane & 31, hl = lane >> 5, g = wave & 3, tsel = wave >> 2;
    float* ex = (float*)lds;
    const float* UR = (const float*)(p.ws + R_UR); const float* UI = (const float*)(p.ws + R_UI);
    const float* Y = (const float*)(p.ws + R_Y);
    const bf16_t* att = (const bf16_t*)(p.ws + R_ATT);
    bf16_t* mix = (bf16_t*)(p.ws + R_MIX);
    const float* FMg = (const float*)(p.ws + OFF_FM) + ((size_t)layer * 4 + g) * 128 * 64;
    const float* fb = p.in[I_FB] + layer * 256 + g * 64;
    const float* mg = p.in[I_MG] + layer * 1024;
    for (int tp = obid(); tp < T / 64; tp += gridDim.x) {
        const int t = (tp * 2 + tsel) * 32 + l31;
        f32x16 acc0 = zero16(), acc1 = zero16();
        {
            const float* ub = UR + (size_t)(g * 64 + hl) * T + t;
            const float* fa = FMg + hl * 64 + l31;
#pragma unroll 16
            for (int dd0 = 0; dd0 < 64; dd0 += 2) {
                const float bv = ub[(size_t)dd0 * T];
                const float a0 = fa[dd0 * 64], a1 = fa[dd0 * 64 + 32];
                acc0 = __builtin_amdgcn_mfma_f32_32x32x2f32(a0, bv, acc0, 0, 0, 0);
                acc1 = __builtin_amdgcn_mfma_f32_32x32x2f32(a1, bv, acc1, 0, 0, 0);
            }
            const float* ub2 = UI + (size_t)(g * 64 + hl) * T + t;
            const float* fa2 = FMg + (64 + hl) * 64 + l31;
#pragma unroll 16
            for (int dd0 = 0; dd0 < 64; dd0 += 2) {
                const float bv = ub2[(size_t)dd0 * T];
                const float a0 = fa2[dd0 * 64], a1 = fa2[dd0 * 64 + 32];
                acc0 = __builtin_amdgcn_mfma_f32_32x32x2f32(a0, bv, acc0, 0, 0, 0);
                acc1 = __builtin_amdgcn_mfma_f32_32x32x2f32(a1, bv, acc1, 0, 0, 0);
            }
        }
        float sf = 0.f;
#pragma unroll
        for (int i = 0; i < 4; ++i) {
            const f32x4 b0 = *(const f32x4*)(fb + 8 * i + 4 * hl), b1 = *(const f32x4*)(fb + 32 + 8 * i + 4 * hl);
            acc0[4 * i] += b0.x; acc0[4 * i + 1] += b0.y; acc0[4 * i + 2] += b0.z; acc0[4 * i + 3] += b0.w;
            acc1[4 * i] += b1.x; acc1[4 * i + 1] += b1.y; acc1[4 * i + 2] += b1.z; acc1[4 * i + 3] += b1.w;
        }
#pragma unroll
        for (int r = 0; r < 16; ++r) sf += acc0[r] * acc0[r] + acc1[r] * acc1[r];
        float sy = 0.f;
        const float* yb = Y + (size_t)(g * 64 + hl * 32) * T + t;
#pragma unroll 32
        for (int i = 0; i < 32; ++i) { const float y = yb[(size_t)i * T]; sy += y * y; }
        float sa = 0.f;
        const bf16_t* ab = att + (size_t)t * 512 + g * 128 + hl * 64;
#pragma unroll 4
        for (int q = 0; q < 8; ++q) {
            const u32x4 a = *(const u32x4*)(ab + 8 * q);
            const float x0 = bflo(a.x), x1 = bfhi(a.x), x2 = bflo(a.y), x3 = bfhi(a.y), x4 = bflo(a.z), x5 = bfhi(a.z), x6 = bflo(a.w), x7 = bfhi(a.w);
            sa += x0 * x0 + x1 * x1 + x2 * x2 + x3 * x3 + x4 * x4 + x5 * x5 + x6 * x6 + x7 * x7;
        }
        __syncthreads();
        ex[(0 * 8 + wave) * 64 + lane] = sa; ex[(1 * 8 + wave) * 64 + lane] = sy; ex[(2 * 8 + wave) * 64 + lane] = sf;
        __syncthreads();
        float ta = 0.f, ty = 0.f, tf = 0.f;
#pragma unroll
        for (int w = 0; w < 4; ++w)
#pragma unroll
            for (int hh = 0; hh < 2; ++hh) {
                const int o = (tsel * 4 + w) * 64 + hh * 32 + l31;
                ta += ex[0 * 512 + o]; ty += ex[1 * 512 + o]; tf += ex[2 * 512 + o];
            }
        const float ra = rsqrtf(ta * (1.0f / 512.0f) + EPS), ry = rsqrtf(ty * (1.0f / 256.0f) + EPS), rf = rsqrtf(tf * (1.0f / 256.0f) + EPS);
        bf16_t* mrow = mix + (size_t)t * 1024;
        {
            const float* gg = mg + g * 128 + hl * 64;
#pragma unroll 4
            for (int q = 0; q < 8; ++q) {
                const u32x4 a = *(const u32x4*)(ab + 8 * q);
                const f32x4 g0 = *(const f32x4*)(gg + 8 * q), g1 = *(const f32x4*)(gg + 8 * q + 4);
                u32x4 o;
                o.x = pk2(bflo(a.x) * ra * g0.x, bfhi(a.x) * ra * g0.y); o.y = pk2(bflo(a.y) * ra * g0.z, bfhi(a.y) * ra * g0.w);
                o.z = pk2(bflo(a.z) * ra * g1.x, bfhi(a.z) * ra * g1.y); o.w = pk2(bflo(a.w) * ra * g1.z, bfhi(a.w) * ra * g1.w);
                *(u32x4*)(mrow + g * 128 + hl * 64 + 8 * q) = o;
            }
        }
        {
            const float* gg = mg + 512 + g * 64 + hl * 32;
#pragma unroll 2
            for (int q = 0; q < 4; ++q) {
                float yv[8];
#pragma unroll
                for (int i = 0; i < 8; ++i) yv[i] = yb[(size_t)(8 * q + i) * T];
                const f32x4 g0 = *(const f32x4*)(gg + 8 * q), g1 = *(const f32x4*)(gg + 8 * q + 4);
                u32x4 o;
                o.x = pk2(yv[0] * ry * g0.x, yv[1] * ry * g0.y); o.y = pk2(yv[2] * ry * g0.z, yv[3] * ry * g0.w);
                o.z = pk2(yv[4] * ry * g1.x, yv[5] * ry * g1.y); o.w = pk2(yv[6] * ry * g1.z, yv[7] * ry * g1.w);
                *(u32x4*)(mrow + 512 + g * 64 + hl * 32 + 8 * q) = o;
            }
        }
        {
            const float* gg = mg + 768 + g * 64;
#pragma unroll
            for (int i = 0; i < 4; ++i) {
                const f32x4 g0 = *(const f32x4*)(gg + 8 * i + 4 * hl), g1 = *(const f32x4*)(gg + 32 + 8 * i + 4 * hl);
                u32x2 o0, o1;
                o0.x = pk2(acc0[4 * i] * rf * g0.x, acc0[4 * i + 1] * rf * g0.y); o0.y = pk2(acc0[4 * i + 2] * rf * g0.z, acc0[4 * i + 3] * rf * g0.w);
                o1.x = pk2(acc1[4 * i] * rf * g1.x, acc1[4 * i + 1] * rf * g1.y); o1.y = pk2(acc1[4 * i + 2] * rf * g1.z, acc1[4 * i + 3] * rf * g1.w);
                *(u32x2*)(mrow + 768 + g * 64 + 8 * i + 4 * hl) = o0;
                *(u32x2*)(mrow + 768 + g * 64 + 32 + 8 * i + 4 * hl) = o1;
            }
        }
    }
}

#define TK_INS(L, X) do { float x_ = (X); _Pragma("unroll") for (int i_ = 0; i_ < 16; ++i_) { const float hi_ = fmaxf(L[i_], x_); x_ = fminf(L[i_], x_); L[i_] = hi_; } } while (0)
__device__ __forceinline__ float tk_pack(float v, unsigned code, unsigned mask) { return __builtin_bit_cast(float, (__builtin_bit_cast(unsigned, v) & ~mask) | code); }
__device__ __forceinline__ unsigned tk_lookup(const unsigned (&P)[4], unsigned i) {
    const unsigned w = (i < 4u) ? P[0] : (i < 8u) ? P[1] : (i < 12u) ? P[2] : P[3];
    return (w >> ((i & 3u) * 8u)) & 0x7Fu;
}
__device__ __forceinline__ void phase_peer_topk(const Params& p, int layer, char* lds, int* IDX, float* GATE) {
    const int tid = otid(), lane = tid & 63, wave = tid >> 6;
    const float* SC = (const float*)(p.ws + R_QP);
    const float NINF = -3.0e38f;
    const int pp = lane & 1;
    const int gw = obid() * NWAVE + wave, ngw = gridDim.x * NWAVE;
    for (int grp = gw; grp < T * 8 / 32; grp += ngw) {
        const int prob = grp * 32 + (lane >> 1);
        const int t = prob >> 3, h = prob & 7;
        const f32x4* src = (const f32x4*)(SC + (size_t)t * 2048 + h * 256 + pp * 128);
        float l[16];
#pragma unroll
        for (int i = 0; i < 16; ++i) l[i] = NINF;
#pragma unroll 1
        for (int c = 0; c < 4; ++c) {
            f32x4 v[8];
#pragma unroll
            for (int j = 0; j < 8; ++j) v[j] = src[c * 8 + j];
#pragma unroll
            for (int j = 0; j < 8; ++j) {
                const unsigned kb = (unsigned)(c * 32 + j * 4);
                TK_INS(l, tk_pack(v[j].x, kb, 0x7Fu)); TK_INS(l, tk_pack(v[j].y, kb + 1u, 0x7Fu));
                TK_INS(l, tk_pack(v[j].z, kb + 2u, 0x7Fu)); TK_INS(l, tk_pack(v[j].w, kb + 3u, 0x7Fu));
            }
        }
        float xv[16], ov[16]; unsigned PX[4] = {0u, 0u, 0u, 0u}, PO[4] = {0u, 0u, 0u, 0u};
#pragma unroll
        for (int i = 0; i < 16; ++i) {
            const float o = __shfl_xor(l[i], 1);
            const unsigned xb = __builtin_bit_cast(unsigned, l[i]), ob = __builtin_bit_cast(unsigned, o);
            xv[i] = __builtin_bit_cast(float, xb & ~0x7Fu); ov[i] = __builtin_bit_cast(float, ob & ~0x7Fu);
            PX[i >> 2] |= (xb & 0x7Fu) << ((i & 3) * 8); PO[i >> 2] |= (ob & 0x7Fu) << ((i & 3) * 8);
        }
        float f[16];
#pragma unroll
        for (int i = 0; i < 16; ++i) f[i] = NINF;
#pragma unroll
        for (int i = 0; i < 16; ++i)
#pragma unroll
            for (int j = i; j < 16; ++j)
                if ((i + 1) * (j + 1) <= 16) {
                    float cv = xv[i] + ov[j];
                    const unsigned code = pp ? (unsigned)((j << 4) | i) : (unsigned)((i << 4) | j);
                    cv = tk_pack(cv, code, 0xFFu);
                    if (i == j) cv = pp ? NINF : cv;
                    TK_INS(f, cv);
                }
        {
            float g[16];
#pragma unroll
            for (int i = 0; i < 16; ++i) g[i] = __shfl_xor(f[i], 1);
#pragma unroll
            for (int i = 0; i < 16; ++i) TK_INS(f, g[i]);
        }
        unsigned P0[4], P1[4];
#pragma unroll
        for (int q = 0; q < 4; ++q) { P0[q] = pp ? PO[q] : PX[q]; P1[q] = pp ? PX[q] : PO[q]; }
        const float top = __builtin_bit_cast(float, __builtin_bit_cast(unsigned, f[0]) & ~0xFFu);
        float ev[16]; int ei[16]; float den = 0.f;
#pragma unroll
        for (int r = 0; r < 16; ++r) {
            const unsigned fb = __builtin_bit_cast(unsigned, f[r]);
            const unsigned code = fb & 0xFFu;
            ei[r] = (int)(tk_lookup(P0, code >> 4) * 128u + tk_lookup(P1, code & 15u));
            ev[r] = __expf(__builtin_bit_cast(float, fb & ~0xFFu) - top);
            den += ev[r];
        }
        const float rden = 1.0f / den;
        const size_t ob = (size_t)t * 2048 + h * 16;
        if (pp == 0) {
#pragma unroll
            for (int q = 0; q < 4; ++q) { int4 w; w.x = ei[4 * q]; w.y = ei[4 * q + 1]; w.z = ei[4 * q + 2]; w.w = ei[4 * q + 3]; *(int4*)(IDX + ob + 4 * q) = w; }
        } else {
#pragma unroll
            for (int q = 0; q < 4; ++q) { f32x4 w; w.x = ev[4 * q] * rden; w.y = ev[4 * q + 1] * rden; w.z = ev[4 * q + 2] * rden; w.w = ev[4 * q + 3] * rden; *(f32x4*)(GATE + ob + 128 + 4 * q) = w; }
        }
    }
}

__device__ __forceinline__ float gelu_exact(float x) { return 0.5f * x * (1.0f + erff(x * 0.70710678118654752f)); }
typedef float f32x2 __attribute__((ext_vector_type(2)));
#define CVT_LO(W) __builtin_amdgcn_cvt_pk_f32_fp8((int)(W), false)
#define CVT_HI(W) __builtin_amdgcn_cvt_pk_f32_fp8((int)(W), true)
template <bool DRY, int EMASK = 16383> __device__ __forceinline__ void phase_peer_gather(const Params& p, int layer) {
    const int lane = otid() & 63, wave = otid() >> 6;
    const int gw = obid() * NWAVE + wave, ngw = gridDim.x * NWAVE;
    const unsigned char* PU = p.ws + OFF_PU + (size_t)layer * 16384 * 1024;
    const unsigned char* PV = p.ws + OFF_PV + (size_t)layer * 16384 * 1024;
    const float* SU = (const float*)(p.ws + OFF_PSC) + (size_t)layer * 16384;
    const float* SV = (const float*)(p.ws + OFF_PSC) + (size_t)(2 + layer) * 16384;
    bf16_t* XN = (bf16_t*)(p.ws + R_XN);
    float* XA = (float*)(p.ws + OFF_XA);
    const float* SC = (const float*)(p.ws + R_QP);
    const bool last = (layer == NLAYER - 1);
    const float* gnext = last ? p.in[I_FG] : p.in[I_N1G] + (layer + 1) * DM;
    const bool b5 = (lane & 32) != 0, b4 = (lane & 16) != 0, b3 = (lane & 8) != 0;
    const unsigned loff = (unsigned)lane * 16u;
    for (int t = gw; t < T; t += ngw) {
        f32x2 xv[8];
#pragma unroll
        for (int j = 0; j < 4; ++j) {
            const u32x2 a = *(const u32x2*)(XN + (size_t)t * DM + 4 * lane + 256 * j);
            xv[2 * j] = (f32x2){bflo(a.x), bfhi(a.x)}; xv[2 * j + 1] = (f32x2){bflo(a.y), bfhi(a.y)};
        }
        f32x2 acc[8];
#pragma unroll
        for (int j = 0; j < 8; ++j) acc[j] = (f32x2){0.f, 0.f};
        const int* idxp = (const int*)(SC + (size_t)t * 2048);
        const float* gatep = SC + (size_t)t * 2048 + 128;
#pragma unroll 1
        for (int half = 0; half < 2; ++half) {
            const int myi = idxp[half * 64 + lane] & EMASK;
            const float mycu = SU[myi];
            const float mycg = gatep[half * 64 + lane] * SV[myi];
#pragma unroll 1
            for (int e0 = 0; e0 < 64; e0 += 8) {
                u32x4 ur[8], vr[8];
#pragma unroll
                for (int k = 0; k < 8; ++k) {
                    const unsigned e = (unsigned)__builtin_amdgcn_readlane(myi, e0 + k);
                    ur[k] = *(const u32x4*)(PU + (size_t)(e * 1024u) + loff);
                    vr[k] = *(const u32x4*)(PV + (size_t)(e * 1024u) + loff);
                }
                float d[8];
#pragma unroll
                for (int k = 0; k < 8; ++k) {
                    f32x2 s2 = CVT_LO(ur[k].x) * xv[0];
                    s2 += CVT_HI(ur[k].x) * xv[1]; s2 += CVT_LO(ur[k].y) * xv[2]; s2 += CVT_HI(ur[k].y) * xv[3];
                    s2 += CVT_LO(ur[k].z) * xv[4]; s2 += CVT_HI(ur[k].z) * xv[5]; s2 += CVT_LO(ur[k].w) * xv[6]; s2 += CVT_HI(ur[k].w) * xv[7];
                    d[k] = s2.x + s2.y;
                }
                float r4[4], r2[2], u1;
#pragma unroll
                for (int k = 0; k < 4; ++k) { const float send = b5 ? d[k] : d[k + 4], keep = b5 ? d[k + 4] : d[k]; r4[k] = keep + __shfl_xor(send, 32); }
#pragma unroll
                for (int k = 0; k < 2; ++k) { const float send = b4 ? r4[k] : r4[k + 2], keep = b4 ? r4[k + 2] : r4[k]; r2[k] = keep + __shfl_xor(send, 16); }
                { const float send = b3 ? r2[0] : r2[1], keep = b3 ? r2[1] : r2[0]; u1 = keep + __shfl_xor(send, 8); }
                u1 += __shfl_xor(u1, 4); u1 += __shfl_xor(u1, 2); u1 += __shfl_xor(u1, 1);
                const int kk = e0 + (lane >> 3);
                const float av = gelu_exact(u1 * __shfl(mycu, kk)) * __shfl(mycg, kk);
#pragma unroll
                for (int k = 0; k < 8; ++k) {
                    const float a = __builtin_bit_cast(float, __builtin_amdgcn_readlane(__builtin_bit_cast(int, av), 8 * k));
                    const f32x2 a2 = (f32x2){a, a};
                    acc[0] += a2 * CVT_LO(vr[k].x); acc[1] += a2 * CVT_HI(vr[k].x); acc[2] += a2 * CVT_LO(vr[k].y); acc[3] += a2 * CVT_HI(vr[k].y);
                    acc[4] += a2 * CVT_LO(vr[k].z); acc[5] += a2 * CVT_HI(vr[k].z); acc[6] += a2 * CVT_LO(vr[k].w); acc[7] += a2 * CVT_HI(vr[k].w);
                }
            }
        }
        f32x4 x[4]; float ss = 0.f;
#pragma unroll
        for (int j = 0; j < 4; ++j) {
            x[j] = *(const f32x4*)(XA + (size_t)t * DM + 4 * lane + 256 * j);
            x[j].x += acc[2 * j].x; x[j].y += acc[2 * j].y; x[j].z += acc[2 * j + 1].x; x[j].w += acc[2 * j + 1].y;
            ss += x[j].x * x[j].x + x[j].y * x[j].y + x[j].z * x[j].z + x[j].w * x[j].w;
        }
        ss = wave_sum(ss);
        const float r = rsqrtf(ss * (1.0f / DM) + EPS);
        if (last) {
#pragma unroll
            for (int j = 0; j < 4; ++j) { const f32x4 gg = *(const f32x4*)(gnext + 4 * lane + 256 * j); *(f32x4*)(p.out + (size_t)t * DM + 4 * lane + 256 * j) = x[j] * r * gg; }
        } else {
#pragma unroll
            for (int j = 0; j < 4; ++j) {
                const f32x4 gg = *(const f32x4*)(gnext + 4 * lane + 256 * j);
                *(f32x4*)((DRY ? p.out : XA) + (size_t)t * DM + 4 * lane + 256 * j) = x[j];
                u32x2 w; w.x = pk2(x[j].x * r * gg.x, x[j].y * r * gg.y); w.y = pk2(x[j].z * r * gg.z, x[j].w * r * gg.w);
                if (!DRY) *(u32x2*)(XN + (size_t)t * DM + 4 * lane + 256 * j) = w;
            }
        }
    }
}

#ifndef PE_NTK
#define PE_NTK 2
#endif
#ifndef PE_PASS_SYNC
#define PE_PASS_SYNC 0
#endif
constexpr int PE_ENT = 12 * 1024;
constexpr int PE_WAVE = PE_ENT + 1024;
#define PE_TOKEN_CHUNK(TK) do { \
    const int s_ = st[(sr * PE_NTK + (TK)) * 32 + r], e_ = st[(sr * PE_NTK + (TK)) * 32 + r + 1]; \
    for (int pos = s_; pos < e_; pos += 8) { \
        const int n = (e_ - pos < 8) ? (e_ - pos) : 8; \
        const int ei_ = pos + (lane >> 3); \
        const bool ok_ = (lane >> 3) < n; \
        const int base_ = ((sr * PE_NTK + (TK)) * 128 + (ok_ ? ei_ : pos)) * 3; \
        const int ev = ent[base_]; const float cu = __builtin_bit_cast(float, ent[base_ + 1]), cg = __builtin_bit_cast(float, ent[base_ + 2]); \
        f32x2 xl[8]; \
        _Pragma("unroll") for (int j = 0; j < 4; ++j) { xl[2 * j] = (f32x2){bflo(xp[TK][j].x), bfhi(xp[TK][j].x)}; xl[2 * j + 1] = (f32x2){bflo(xp[TK][j].y), bfhi(xp[TK][j].y)}; } \
        u32x4 ur[8], vr[8]; \
        _Pragma("unroll") for (int k = 0; k < 8; ++k) { \
            if (k < n) { const unsigned e = (unsigned)__builtin_amdgcn_readlane(ev, 8 * k); \
                ur[k] = *(const u32x4*)(PU + (size_t)(e * 1024u) + loff); vr[k] = *(const u32x4*)(PV + (size_t)(e * 1024u) + loff); } \
            else { ur[k] = (u32x4){0u, 0u, 0u, 0u}; vr[k] = (u32x4){0u, 0u, 0u, 0u}; } } \
        float d[8]; \
        _Pragma("unroll") for (int k = 0; k < 8; ++k) { \
            if (k < n) { f32x2 s2 = CVT_LO(ur[k].x) * xl[0]; \
                s2 += CVT_HI(ur[k].x) * xl[1]; s2 += CVT_LO(ur[k].y) * xl[2]; s2 += CVT_HI(ur[k].y) * xl[3]; \
                s2 += CVT_LO(ur[k].z) * xl[4]; s2 += CVT_HI(ur[k].z) * xl[5]; s2 += CVT_LO(ur[k].w) * xl[6]; s2 += CVT_HI(ur[k].w) * xl[7]; \
                d[k] = s2.x + s2.y; } else d[k] = 0.f; } \
        float r4[4], r2[2], u1; \
        _Pragma("unroll") for (int k = 0; k < 4; ++k) { const float send = b5 ? d[k] : d[k + 4], keep = b5 ? d[k + 4] : d[k]; r4[k] = keep + __shfl_xor(send, 32); } \
        _Pragma("unroll") for (int k = 0; k < 2; ++k) { const float send = b4 ? r4[k] : r4[k + 2], keep = b4 ? r4[k + 2] : r4[k]; r2[k] = keep + __shfl_xor(send, 16); } \
        { const float send = b3 ? r2[0] : r2[1], keep = b3 ? r2[1] : r2[0]; u1 = keep + __shfl_xor(send, 8); } \
        u1 += __shfl_xor(u1, 4); u1 += __shfl_xor(u1, 2); u1 += __shfl_xor(u1, 1); \
        const float av = ok_ ? gelu_exact(u1 * cu) * cg : 0.f; \
        _Pragma("unroll") for (int k = 0; k < 8; ++k) { \
            if (k < n) { const float a = __builtin_bit_cast(float, __builtin_amdgcn_readlane(__builtin_bit_cast(int, av), 8 * k)); \
                const f32x2 a2 = (f32x2){a, a}; \
                acc[TK][0] += a2 * CVT_LO(vr[k].x); acc[TK][1] += a2 * CVT_HI(vr[k].x); acc[TK][2] += a2 * CVT_LO(vr[k].y); acc[TK][3] += a2 * CVT_HI(vr[k].y); \
                acc[TK][4] += a2 * CVT_LO(vr[k].z); acc[TK][5] += a2 * CVT_HI(vr[k].z); acc[TK][6] += a2 * CVT_LO(vr[k].w); acc[TK][7] += a2 * CVT_HI(vr[k].w); } } \
    } } while (0)

template <bool DRY> __device__ __forceinline__ void phase_peer_fused(const Params& p, int layer, char* lds) {
    const int tid = otid(), lane = tid & 63, wave = tid >> 6;
    const unsigned char* PU = p.ws + OFF_PU + (size_t)layer * 16384 * 1024;
    const unsigned char* PV = p.ws + OFF_PV + (size_t)layer * 16384 * 1024;
    const float* SU = (const float*)(p.ws + OFF_PSC) + (size_t)layer * 16384;
    const float* SV = (const float*)(p.ws + OFF_PSC) + (size_t)(2 + layer) * 16384;
    bf16_t* XN = (bf16_t*)(p.ws + R_XN);
    float* XA = (float*)(p.ws + OFF_XA);
    const float* SC = (const float*)(p.ws + R_QP);
    const bool last = (layer == NLAYER - 1);
    const float* gnext = last ? p.in[I_FG] : p.in[I_N1G] + (layer + 1) * DM;
    const bool b5 = (lane & 32) != 0, b4 = (lane & 16) != 0, b3 = (lane & 8) != 0;
    const unsigned loff = (unsigned)lane * 16u;
    int* ent = (int*)(lds + wave * PE_WAVE);
    int* st = (int*)(lds + wave * PE_WAVE + PE_ENT);
    const float NINF = -3.0e38f;
    const int pp = lane & 1;
    for (int tb = (obid() * NWAVE + wave) * 8; tb < T; tb += gridDim.x * NWAVE * 8) {
#pragma unroll 1
        for (int grp = 0; grp < 2; ++grp) {
            const int tkl = grp * 4 + (lane >> 4), h = (lane >> 1) & 7;
            const f32x4* src = (const f32x4*)(SC + (size_t)(tb + tkl) * 2048 + h * 256 + pp * 128);
            float l[16];
#pragma unroll
            for (int i = 0; i < 16; ++i) l[i] = NINF;
#pragma unroll 1
            for (int c = 0; c < 4; ++c) {
                f32x4 v[8];
#pragma unroll
                for (int j = 0; j < 8; ++j) v[j] = src[c * 8 + j];
#pragma unroll
                for (int j = 0; j < 8; ++j) {
                    const unsigned kb = (unsigned)(c * 32 + j * 4);
                    TK_INS(l, tk_pack(v[j].x, kb, 0x7Fu)); TK_INS(l, tk_pack(v[j].y, kb + 1u, 0x7Fu));
                    TK_INS(l, tk_pack(v[j].z, kb + 2u, 0x7Fu)); TK_INS(l, tk_pack(v[j].w, kb + 3u, 0x7Fu));
                }
            }
            float xw[16], ow[16]; unsigned PX[4] = {0u, 0u, 0u, 0u}, PO[4] = {0u, 0u, 0u, 0u};
#pragma unroll
            for (int i = 0; i < 16; ++i) {
                const float o = __shfl_xor(l[i], 1);
                const unsigned xb = __builtin_bit_cast(unsigned, l[i]), ob = __builtin_bit_cast(unsigned, o);
                xw[i] = __builtin_bit_cast(float, xb & ~0x7Fu); ow[i] = __builtin_bit_cast(float, ob & ~0x7Fu);
                PX[i >> 2] |= (xb & 0x7Fu) << ((i & 3) * 8); PO[i >> 2] |= (ob & 0x7Fu) << ((i & 3) * 8);
            }
            float f[16];
#pragma unroll
            for (int i = 0; i < 16; ++i) f[i] = NINF;
#pragma unroll
            for (int i = 0; i < 16; ++i)
#pragma unroll
                for (int j = i; j < 16; ++j)
                    if ((i + 1) * (j + 1) <= 16) {
                        float cv = xw[i] + ow[j];
                        const unsigned code = pp ? (unsigned)((j << 4) | i) : (unsigned)((i << 4) | j);
                        cv = tk_pack(cv, code, 0xFFu);
                        if (i == j) cv = pp ? NINF : cv;
                        TK_INS(f, cv);
                    }
            {
                float gq[16];
#pragma unroll
                for (int i = 0; i < 16; ++i) gq[i] = __shfl_xor(f[i], 1);
#pragma unroll
                for (int i = 0; i < 16; ++i) TK_INS(f, gq[i]);
            }
            unsigned P0[4], P1[4];
#pragma unroll
            for (int q = 0; q < 4; ++q) { P0[q] = pp ? PO[q] : PX[q]; P1[q] = pp ? PX[q] : PO[q]; }
            const float top = __builtin_bit_cast(float, __builtin_bit_cast(unsigned, f[0]) & ~0xFFu);
            float ev[16]; float den = 0.f;
#pragma unroll
            for (int r = 0; r < 16; ++r) { ev[r] = __expf(__builtin_bit_cast(float, __builtin_bit_cast(unsigned, f[r]) & ~0xFFu) - top); den += ev[r]; }
            const float rden = 1.0f / den;
#pragma unroll
            for (int r8 = 0; r8 < 8; ++r8) {
                const unsigned c0 = __builtin_bit_cast(unsigned, f[r8]) & 0xFFu, c1 = __builtin_bit_cast(unsigned, f[r8 + 8]) & 0xFFu;
                const unsigned code = pp ? c1 : c0;
                const float gate = (pp ? ev[r8 + 8] : ev[r8]) * rden;
                const int e = (int)(tk_lookup(P0, code >> 4) * 128u + tk_lookup(P1, code & 15u));
                const int o = (tkl * 128 + h * 16 + pp * 8 + r8) * 3;
                ent[o] = e; ent[o + 1] = __builtin_bit_cast(int, SU[e]); ent[o + 2] = __builtin_bit_cast(int, gate * SV[e]);
            }
        }
#pragma unroll 1
        for (int tk = 0; tk < 8; ++tk) {
            int* et = ent + tk * 384;
            const int eA = et[lane * 3], uA = et[lane * 3 + 1], gA = et[lane * 3 + 2];
            const int eB = et[(64 + lane) * 3], uB = et[(64 + lane) * 3 + 1], gB = et[(64 + lane) * 3 + 2];
            const int rA = eA >> 10, rB = eB >> 10;
            int base = 0;
#pragma unroll 1
            for (int r = 0; r < 16; ++r) {
                const unsigned long long mA = __ballot(rA == r), mB = __ballot(rB == r);
                const int cA = __popcll(mA);
                if (lane == 0) st[tk * 32 + r] = base;
                if (rA == r) { const int q = base + (int)__builtin_amdgcn_mbcnt_hi((unsigned)(mA >> 32), __builtin_amdgcn_mbcnt_lo((unsigned)mA, 0u)); et[q * 3] = eA; et[q * 3 + 1] = uA; et[q * 3 + 2] = gA; }
                if (rB == r) { const int q = base + cA + (int)__builtin_amdgcn_mbcnt_hi((unsigned)(mB >> 32), __builtin_amdgcn_mbcnt_lo((unsigned)mB, 0u)); et[q * 3] = eB; et[q * 3 + 1] = uB; et[q * 3 + 2] = gB; }
                base += cA + __popcll(mB);
            }
            if (lane == 0) st[tk * 32 + 16] = base;
        }
#pragma unroll 1
        for (int sr = 0; sr < 8 / PE_NTK; ++sr) {
            u32x2 xp[PE_NTK][4]; f32x2 acc[PE_NTK][8];
#pragma unroll
            for (int tk = 0; tk < PE_NTK; ++tk) {
#pragma unroll
                for (int j = 0; j < 4; ++j) xp[tk][j] = *(const u32x2*)(XN + (size_t)(tb + sr * PE_NTK + tk) * DM + 4 * lane + 256 * j);
#pragma unroll
                for (int j = 0; j < 8; ++j) acc[tk][j] = (f32x2){0.f, 0.f};
            }
#pragma unroll 1
            for (int r = 0; r < 16; ++r) {
#if PE_PASS_SYNC
                __syncthreads();
#endif
                PE_TOKEN_CHUNK(0); PE_TOKEN_CHUNK(1);
#if PE_NTK == 4
                PE_TOKEN_CHUNK(2); PE_TOKEN_CHUNK(3);
#endif
            }
#pragma unroll
            for (int tk = 0; tk < PE_NTK; ++tk) {
                const int t = tb + sr * PE_NTK + tk;
                f32x4 x[4]; float ss = 0.f;
#pragma unroll
                for (int j = 0; j < 4; ++j) {
                    x[j] = *(const f32x4*)(XA + (size_t)t * DM + 4 * lane + 256 * j);
                    x[j].x += acc[tk][2 * j].x; x[j].y += acc[tk][2 * j].y; x[j].z += acc[tk][2 * j + 1].x; x[j].w += acc[tk][2 * j + 1].y;
                    ss += x[j].x * x[j].x + x[j].y * x[j].y + x[j].z * x[j].z + x[j].w * x[j].w;
                }
                ss = wave_sum(ss);
                const float rr = rsqrtf(ss * (1.0f / DM) + EPS);
                if (last) {
#pragma unroll
                    for (int j = 0; j < 4; ++j) { const f32x4 gg = *(const f32x4*)(gnext + 4 * lane + 256 * j); *(f32x4*)(p.out + (size_t)t * DM + 4 * lane + 256 * j) = x[j] * rr * gg; }
                } else {
#pragma unroll
                    for (int j = 0; j < 4; ++j) {
                        const f32x4 gg = *(const f32x4*)(gnext + 4 * lane + 256 * j);
                        *(f32x4*)((DRY ? p.out : XA) + (size_t)t * DM + 4 * lane + 256 * j) = x[j];
                        u32x2 w; w.x = pk2(x[j].x * rr * gg.x, x[j].y * rr * gg.y); w.y = pk2(x[j].z * rr * gg.z, x[j].w * rr * gg.w);
                        if (!DRY) *(u32x2*)(XN + (size_t)t * DM + 4 * lane + 256 * j) = w;
                    }
                }
            }
        }
    }
}

#define LAS __attribute__((address_space(3)))
#define XB_TMO      128
#define XB_XCNT(j)  (256  + 64 * (j))
#define XB_XSUB(j)  (1280 + 64 * (j))
#define XB_XGEN(j)  (2304 + 64 * (j))
#define XB_TOP      3328
#define XB_TOPGEN   3392
#define XCD_BAR_WORDS 3456
#define XB_SPIN_CAP (1u << 20)
__device__ __forceinline__ unsigned xb_ld(unsigned* p)              { return __hip_atomic_load(p, __ATOMIC_RELAXED, __HIP_MEMORY_SCOPE_AGENT); }
__device__ __forceinline__ unsigned xb_add(unsigned* p, unsigned v) { return __hip_atomic_fetch_add(p, v, __ATOMIC_RELAXED, __HIP_MEMORY_SCOPE_AGENT); }
__device__ __forceinline__ unsigned xb_xcc_id() { return (unsigned)__builtin_amdgcn_s_getreg((3 << 11) | 20) & 0xFu; }
#define XB_SPIN(cond, bar) do { unsigned _sp = 0; while (cond) { __builtin_amdgcn_s_sleep(1); \
    if ((++_sp & 255u) == 0u) { if (xb_ld(&(bar)[XB_TMO])) break; if (_sp > XB_SPIN_CAP) { atomicAdd(&(bar)[XB_TMO], 1u); break; } } } } while (0)
struct XcdBarrier { unsigned* bar; unsigned x; volatile LAS unsigned* st; };
__device__ __forceinline__ XcdBarrier xcd_barrier_post(unsigned* bar, volatile LAS unsigned* st) {
    XcdBarrier b; b.bar = bar; b.x = xb_xcc_id(); b.st = st;
    if (threadIdx.x == 0) (void)xb_add(&bar[XB_XCNT(b.x)], 1u);
    return b;
}
__device__ __forceinline__ void xcd_barrier_complete(unsigned* bar, unsigned x, unsigned& nloc, unsigned& nx) {
    const unsigned G = gridDim.x * gridDim.y * gridDim.z;
    unsigned sum, cnt, mine, sp = 0u;
    for (;;) {
        sum = 0u; cnt = 0u; mine = 0u;
#pragma unroll
        for (unsigned j = 0; j < 16; ++j) { const unsigned c = xb_ld(&bar[XB_XCNT(j)]); sum += c; cnt += (c > 0u) ? 1u : 0u; mine = (j == x) ? c : mine; }
        if (sum == G) break;
        __builtin_amdgcn_s_sleep(1);
        if ((++sp & 255u) == 0u) { if (xb_ld(&bar[XB_TMO])) break; if (sp > XB_SPIN_CAP) { atomicAdd(&bar[XB_TMO], 1u); break; } }
    }
    nloc = mine > 0u ? mine : 1u; nx = cnt > 0u ? cnt : 1u;
}
__device__ __forceinline__ void xcd_barrier(const XcdBarrier& b) {
    asm volatile("s_waitcnt vmcnt(0)" ::: "memory");
    __syncthreads();
    if (threadIdx.x == 0) {
        unsigned* bar = b.bar;
        __builtin_amdgcn_s_waitcnt(0);
        unsigned nloc = b.st[0], nx = b.st[1];
        if (nloc == 0u) { xcd_barrier_complete(bar, b.x, nloc, nx); b.st[0] = nloc; b.st[1] = nx; }
        const unsigned old = xb_add(&bar[XB_XSUB(b.x)], 1u);
        const unsigned gen = old / nloc;
        if (old + 1u == (gen + 1u) * nloc) {
            __builtin_amdgcn_fence(__ATOMIC_RELEASE, "agent");
            asm volatile("s_waitcnt vmcnt(0)" ::: "memory");
            const unsigned og = xb_add(&bar[XB_TOP], 1u);
            const unsigned tg = og / nx;
            if (og + 1u == (tg + 1u) * nx) xb_add(&bar[XB_TOPGEN], 1u);
            else XB_SPIN(xb_ld(&bar[XB_TOPGEN]) == tg, bar);
            __builtin_amdgcn_fence(__ATOMIC_ACQUIRE, "agent");
            xb_add(&bar[XB_XGEN(b.x)], 1u);
            asm volatile("s_waitcnt vmcnt(0)" ::: "memory");
        } else {
            XB_SPIN(xb_ld(&bar[XB_XGEN(b.x)]) == gen, bar);
            __builtin_amdgcn_fence(__ATOMIC_ACQUIRE, "agent");
            asm volatile("s_waitcnt vmcnt(0)" ::: "memory");
        }
    }
    __syncthreads();
}


template <class Epi> __device__ __forceinline__ void big_gemm(const bf16_t* A, const bf16_t* Bt, int M, int N, int K, char* lds, const Epi& e) {
    pg8::Gemm g{A, Bt, M, N, K}; pg8::StaticOrder S; S.init(M, N, (int)gridDim.x, obid());
    pg8::gemm_phase<Epi, pg8::StaticOrder, true, true>((PG8_LAS unsigned char*)lds, g, S, e);
}

__global__ void __launch_bounds__(NTHR) mega_kernel(Params p) {
    extern __shared__ __attribute__((aligned(16))) char lds[];
    cg::grid_group grid = cg::this_grid();
    volatile LAS unsigned* misc = (volatile LAS unsigned*)((LAS char*)lds + LDS_MISC);
    if (threadIdx.x < 16) misc[threadIdx.x] = 0u;
    __syncthreads();
    const XcdBarrier xbar = xcd_barrier_post((unsigned*)(p.ws + OFF_CTL) + 4096, misc);
#define GSYNC() xcd_barrier(xbar)
    float* XA = (float*)(p.ws + OFF_XA);
#if PROBE == 7
    phase_p0(p, lds); GSYNC();
#endif
#if PROBE == 14
#pragma nounroll
    for (int i = 0; i < 40; ++i) GSYNC();
#endif
    phase_p0(p, lds);
    phase_rmsnorm_bf16(p.in[I_X], p.in[I_N1G], (bf16_t*)(p.ws + R_XN));
    grid.sync();
#pragma nounroll
    for (int layer = 0; layer < NLAYER; ++layer) {
        const float* xin = layer == 0 ? p.in[I_X] : XA;
#if PROBE == 10
        { EpiIn e{(bf16_t*)(p.ws + R_QKV), (float*)(p.ws + R_HF)};
          gemm_simple((const bf16_t*)(p.ws + R_XN), (const bf16_t*)(p.ws + OFF_WTIN) + (size_t)layer * INC * DM, T, INC, DM, lds, e); } GSYNC();
#endif
        {
            const bf16_t* wt = (const bf16_t*)(p.ws + OFF_WTIN) + (size_t)layer * INC * DM;
            pg8::EpiStoreBf16 e1{(bf16_t*)(p.ws + R_QKV), 768};
            big_gemm((const bf16_t*)(p.ws + R_XN), wt, T, 768, DM, lds, e1);
            pg8::EpiStoreF32 e2{nullptr, (float*)(p.ws + R_HF), T};
            big_gemm(wt + (size_t)768 * DM, (const bf16_t*)(p.ws + R_XN), 1024, T, DM, lds, e2);
        }
        if (layer == 0) {
#pragma nounroll
            for (int fl = 0; fl < NLAYER; ++fl) {
                EpiF32 e{(float*)(p.ws + (fl ? OFF_HFILT1 : OFF_HFILT0)), SL};
                gemm_simple((const bf16_t*)(p.ws + OFF_W3T) + (size_t)fl * 1024 * 64, (const bf16_t*)(p.ws + OFF_H2) + (size_t)fl * SL * 64, 1024, SL, 64, lds, e);
            }
        }
        GSYNC();
        if (layer == 0) {
            phase_filter_spectra(p, lds);
#if PROBE == 13
            phase_filter_spectra(p, lds);
#endif
        }
#if PROBE == 12
        phase_qkprep(p, layer, lds, (bf16_t*)(p.ws + R_ATT)); GSYNC();
#endif
        phase_qkprep(p, layer, lds, (bf16_t*)(p.ws + R_QKV)); GSYNC();
        {
#if PROBE == 5
            phase_attn(p, lds);
#endif
#if PROBE == 6
            for (int c = obid(); c < 256; c += gridDim.x) hyena_job(p, layer, c, lds);
            for (int c = obid(); c < 256; c += gridDim.x) fnet_job(p, c, lds);
#endif
            phase_attn(p, lds);
            for (int c = obid(); c < 256; c += gridDim.x) hyena_job(p, layer, c, lds);
            for (int c = obid(); c < 256; c += gridDim.x) fnet_job(p, c, lds);
        } GSYNC();
#if PROBE == 8
        phase_mix(p, layer, lds); GSYNC();
#endif
        phase_mix(p, layer, lds); GSYNC();
#if PROBE == 11
        { EpiRes e{xin, p.out};
          gemm_simple((const bf16_t*)(p.ws + R_MIX), (const bf16_t*)(p.ws + OFF_WTOUT) + (size_t)layer * DM * DM, T, DM, DM, lds, e); } GSYNC();
#endif
        { pg8::EpiStoreF32 e{xin, XA, DM};
          big_gemm((const bf16_t*)(p.ws + R_MIX), (const bf16_t*)(p.ws + OFF_WTOUT) + (size_t)layer * DM * DM, T, DM, DM, lds, e); } GSYNC();
        phase_rmsnorm_bf16(XA, p.in[I_N2G] + layer * DM, (bf16_t*)(p.ws + R_XN)); GSYNC();
#if PROBE == 3
        { EpiF32 e{(float*)(p.ws + R_QP), 2048};
          gemm_simple((const bf16_t*)(p.ws + R_XN), (const bf16_t*)(p.ws + OFF_WTQ) + (size_t)layer * 2048 * DM, T, 2048, DM, lds, e); } GSYNC();
#endif
        { pg8::EpiStoreF32 e{nullptr, (float*)(p.ws + R_QP), 2048};
          big_gemm((const bf16_t*)(p.ws + R_XN), (const bf16_t*)(p.ws + OFF_WTQ) + (size_t)layer * 2048 * DM, T, 2048, DM, lds, e); } GSYNC();
#if PEER_FUSED
#if PROBE == 1
        phase_peer_fused<true>(p, layer, lds); GSYNC();
#endif
        phase_peer_fused<false>(p, layer, lds);
#else
        phase_peer_topk(p, layer, lds, (int*)(p.ws + R_QP), (float*)(p.ws + R_QP)); GSYNC();
#if PROBE == 1
        phase_peer_gather<true>(p, layer); GSYNC();
#endif
#if PROBE == 15
        phase_peer_gather<true, 1023>(p, layer); GSYNC();
#endif
        phase_peer_gather<false>(p, layer);
#endif
        if (layer + 1 < NLAYER) GSYNC();
    }
}

extern "C" void kernel_launch(void* const* d_in, const int* in_sizes, int n_in, void* d_out, int out_size, void* d_ws, size_t ws_size, hipStream_t stream) {
    static int grid = 0;
    if (grid == 0) {
        if (n_in != 25 || out_size != T * DM || ws_size < WS_NEED) { fprintf(stderr, "kernel_launch: unexpected sizes n_in %d out %d ws %zu (need %zu)\n", n_in, out_size, ws_size, (size_t)WS_NEED); grid = -1; return; }
        int dev = 0, cus = 0, per_cu = 0;
        if (hipGetDevice(&dev) != hipSuccess || hipDeviceGetAttribute(&cus, hipDeviceAttributeMultiprocessorCount, dev) != hipSuccess) { grid = -1; return; }
        if (hipFuncSetAttribute((const void*)mega_kernel, hipFuncAttributeMaxDynamicSharedMemorySize, LDS_BYTES) != hipSuccess) { fprintf(stderr, "kernel_launch: hipFuncSetAttribute failed\n"); grid = -1; return; }
        if (hipOccupancyMaxActiveBlocksPerMultiprocessor(&per_cu, (const void*)mega_kernel, NTHR, LDS_BYTES) != hipSuccess || per_cu < 1) { fprintf(stderr, "kernel_launch: occupancy query says %d blocks per CU\n", per_cu); grid = -1; return; }
        (void)hipGetLastError();
        grid = cus;
    }
    if (grid < 0) return;
    Params p{};
    for (int i = 0; i < 25; ++i) p.in[i] = (const float*)d_in[i];
    p.out = (float*)d_out; p.ws = (unsigned char*)d_ws;
    if (hipMemsetAsync((char*)d_ws + OFF_CTL, 0, 64 * 1024, stream) != hipSuccess) { fprintf(stderr, "kernel_launch: memset failed\n"); return; }
    void* args[] = {&p};
    hipError_t e = hipLaunchCooperativeKernel((const void*)mega_kernel, dim3(grid), dim3(NTHR), args, LDS_BYTES, stream);
    if (e != hipSuccess) fprintf(stderr, "cooperative launch failed: %s (grid %d)\n", hipGetErrorString(e), grid);
}
```

```cpp
#include <hip/hip_runtime.h>
#include <hip/hip_cooperative_groups.h>
#include <cstdio>
#include <cstdint>
namespace cg = cooperative_groups;

#ifndef PROBE
#define PROBE 0
#endif
#ifndef PEER_FUSED
#define PEER_FUSED 1
#endif

typedef unsigned short bf16_t;
typedef short bf16x8 __attribute__((ext_vector_type(8)));
typedef float f32x16 __attribute__((ext_vector_type(16)));
typedef float f32x4 __attribute__((ext_vector_type(4)));
typedef unsigned u32x4 __attribute__((ext_vector_type(4)));
typedef unsigned u32x2 __attribute__((ext_vector_type(2)));

constexpr int DM = 1024, NB = 2, SL = 8192, T = NB * SL, NLAYER = 2;
constexpr int INC = 1792;
constexpr int NTHR = 512, NWAVE = 8;
constexpr int LDS_BYTES = 147456;
constexpr int LDS_MISC = LDS_BYTES - 64;
constexpr float EPS = 1e-6f;

constexpr size_t MiB = 1u << 20;
constexpr size_t OFF_CTL = 0;
constexpr size_t OFF_WTIN = 1 * MiB;
constexpr size_t OFF_WTOUT = 8 * MiB;
constexpr size_t OFF_WTQ = 12 * MiB;
constexpr size_t OFF_PU = 20 * MiB;
constexpr size_t OFF_PV = 84 * MiB;
constexpr size_t OFF_PSC = 512 * 1024;
constexpr size_t OFF_H2 = 148 * MiB;
constexpr size_t OFF_W3T = 150 * MiB;
constexpr size_t OFF_HFILT0 = 52 * MiB, OFF_HFILT1 = 116 * MiB;
constexpr size_t OFF_FM = 152 * MiB;
constexpr size_t OFF_KF = 153 * MiB;
constexpr size_t OFF_XA = 281 * MiB;
constexpr size_t OFF_R = 345 * MiB;
constexpr size_t R_XN = OFF_R + 0 * MiB;
constexpr size_t R_UR = OFF_R + 0 * MiB;
constexpr size_t R_UI = OFF_R + 16 * MiB;
constexpr size_t R_QKV = OFF_R + 32 * MiB;
constexpr size_t R_VT = OFF_R + 56 * MiB;
constexpr size_t R_HF = OFF_R + 60 * MiB;
constexpr size_t R_MIX = OFF_R + 60 * MiB;
constexpr size_t R_ATT = OFF_R + 124 * MiB;
constexpr size_t R_Y = OFF_R + 140 * MiB;
constexpr size_t R_QP = OFF_R + 32 * MiB;
constexpr size_t WS_NEED = 505 * MiB;

struct Params {
    const float* in[25];
    float* out;
    unsigned char* ws;
};
enum { I_X = 0, I_N1G, I_WIN, I_QG, I_KG, I_CW, I_CB, I_W1, I_B1, I_F1, I_W2, I_B2, I_F2, I_W3, I_HB, I_FW, I_FB, I_MG, I_WOUT, I_N2G, I_WQ, I_SK, I_PU, I_PV, I_FG };

__device__ __forceinline__ unsigned f2bf(float f) { unsigned u = __builtin_bit_cast(unsigned, f); return (u + 0x7fffu + ((u >> 16) & 1u)) >> 16; }
__device__ __forceinline__ unsigned pk2(float lo, float hi) { return f2bf(lo) | (f2bf(hi) << 16); }
__device__ __forceinline__ float bf2f(unsigned b) { return __builtin_bit_cast(float, b << 16); }
__device__ __forceinline__ float bflo(unsigned w) { return __builtin_bit_cast(float, w << 16); }
__device__ __forceinline__ float bfhi(unsigned w) { return __builtin_bit_cast(float, w & 0xffff0000u); }
__device__ __forceinline__ float wave_sum(float v) {
#pragma unroll
    for (int o = 1; o < 64; o <<= 1) v += __shfl_xor(v, o);
    return v;
}
__device__ __forceinline__ float wave_max(float v) {
#pragma unroll
    for (int o = 1; o < 64; o <<= 1) v = fmaxf(v, __shfl_xor(v, o));
    return v;
}
__device__ __forceinline__ f32x16 mfma32(bf16x8 a, bf16x8 b, f32x16 c) { return __builtin_amdgcn_mfma_f32_32x32x16_bf16(a, b, c, 0, 0, 0); }
__device__ __forceinline__ f32x16 zero16() { return (f32x16){0.f,0.f,0.f,0.f,0.f,0.f,0.f,0.f,0.f,0.f,0.f,0.f,0.f,0.f,0.f,0.f}; }


__device__ __forceinline__ int otid() { int t = threadIdx.x; asm volatile("" : "+v"(t)); return t; }
__device__ __forceinline__ int obid() { int b = blockIdx.x; asm volatile("" : "+s"(b)); return b; }
__device__ __forceinline__ void transpose_one(const float* W, int K, int N, bf16_t* Wt, float* tile, int item) {
    const int tid = otid();
    const int nblk = N / 64, kb = item / nblk, nb = item % nblk, k0 = kb * 64, n0 = nb * 64;
    __syncthreads();
    {
        const int r = tid >> 6, c = tid & 63;
#pragma unroll
        for (int i = 0; i < 8; ++i) { const int k = r + 8 * i; tile[k * 65 + c] = W[(size_t)(k0 + k) * N + n0 + c]; }
    }
    __syncthreads();
    {
        const int nn = tid >> 3, kc = tid & 7;
        const float* s = tile + (kc * 8) * 65 + nn;
        u32x4 o; o.x = pk2(s[0], s[65]); o.y = pk2(s[2 * 65], s[3 * 65]); o.z = pk2(s[4 * 65], s[5 * 65]); o.w = pk2(s[6 * 65], s[7 * 65]);
        *(u32x4*)(Wt + (size_t)(n0 + nn) * K + k0 + kc * 8) = o;
    }
}

__device__ __forceinline__ void phase_p0(const Params& p, char* lds) {
    const int tid = otid();
    float* tile = (float*)lds;
    constexpr int IT_IN = (DM / 64) * (INC / 64), IT_OUT = (DM / 64) * (DM / 64), IT_W3 = 1024 / 64;
    constexpr int IT_L = IT_IN + IT_OUT + IT_W3;
    for (int it = obid(); it < NLAYER * IT_L; it += gridDim.x) {
        const int layer = it / IT_L; int r = it % IT_L;
        if (r < IT_IN) { transpose_one(p.in[I_WIN] + (size_t)layer * DM * INC, DM, INC, (bf16_t*)(p.ws + OFF_WTIN) + (size_t)layer * INC * DM, tile, r); continue; }
        r -= IT_IN;
        if (r < IT_OUT) { transpose_one(p.in[I_WOUT] + (size_t)layer * DM * DM, DM, DM, (bf16_t*)(p.ws + OFF_WTOUT) + (size_t)layer * DM * DM, tile, r); continue; }
        r -= IT_OUT;
        transpose_one(p.in[I_W3] + (size_t)layer * 64 * 1024, 64, 1024, (bf16_t*)(p.ws + OFF_W3T) + (size_t)layer * 1024 * 64, tile, r);
    }
    __syncthreads();
    {
        float* SKl = (float*)lds;
        float* Wl = SKl + 128 * 129;
        for (int it = obid(); it < NLAYER * 16 * 16; it += gridDim.x) {
            const int layer = it >> 8, hp = (it >> 4) & 15, kc = it & 15, h = hp >> 1, pp = hp & 1, k0 = kc * 64;
            const float* sk = p.in[I_SK] + (((size_t)(layer * 2 + pp) * 8 + h) * 128) * 128;
            const float* wq = p.in[I_WQ] + (size_t)layer * DM * 2048 + (size_t)k0 * 2048 + h * 256 + pp * 128;
            __syncthreads();
            for (int i = tid; i < 128 * 128; i += NTHR) SKl[(i >> 7) * 129 + (i & 127)] = sk[i];
            for (int i = tid; i < 64 * 128; i += NTHR) Wl[(i >> 7) * 132 + (i & 127)] = wq[(size_t)(i >> 7) * 2048 + (i & 127)];
            __syncthreads();
            const int key = tid & 127, kq = tid >> 7;
            float acc[16];
#pragma unroll
            for (int j = 0; j < 16; ++j) acc[j] = 0.f;
            for (int d4 = 0; d4 < 32; ++d4) {
                const float a0 = SKl[key * 129 + d4 * 4], a1 = SKl[key * 129 + d4 * 4 + 1], a2 = SKl[key * 129 + d4 * 4 + 2], a3 = SKl[key * 129 + d4 * 4 + 3];
#pragma unroll
                for (int j = 0; j < 16; ++j) { const f32x4 w = *(const f32x4*)(Wl + (kq * 16 + j) * 132 + d4 * 4); acc[j] += a0 * w.x + a1 * w.y + a2 * w.z + a3 * w.w; }
            }
            bf16_t* dst = (bf16_t*)(p.ws + OFF_WTQ) + (size_t)layer * 2048 * DM + (size_t)(hp * 128 + key) * DM + k0 + kq * 16;
            u32x4 o0, o1;
            o0.x = pk2(acc[0], acc[1]); o0.y = pk2(acc[2], acc[3]); o0.z = pk2(acc[4], acc[5]); o0.w = pk2(acc[6], acc[7]);
            o1.x = pk2(acc[8], acc[9]); o1.y = pk2(acc[10], acc[11]); o1.z = pk2(acc[12], acc[13]); o1.w = pk2(acc[14], acc[15]);
            *(u32x4*)dst = o0; *(u32x4*)(dst + 8) = o1;
        }
        __syncthreads();
    }
    {
        const int lane = tid & 63, wave = tid >> 6;
        float* scl = (float*)(p.ws + OFF_PSC);
        for (int row = obid() * NWAVE + wave; row < 2 * NLAYER * 16384; row += gridDim.x * NWAVE) {
            const int tb = row >> 15, r = row & 32767;
            const f32x4* src = (const f32x4*)(p.in[tb ? I_PV : I_PU] + (size_t)r * DM) + lane;
            f32x4 v[4]; float mx = 0.f;
#pragma unroll
            for (int j = 0; j < 4; ++j) { v[j] = src[64 * j]; mx = fmaxf(mx, fmaxf(fmaxf(fabsf(v[j].x), fabsf(v[j].y)), fmaxf(fabsf(v[j].z), fabsf(v[j].w)))); }
            mx = wave_max(mx);
            const float sc = mx > 0.f ? 224.0f / mx : 1.0f;
            u32x4 o;
            { int w = 0; w = __builtin_amdgcn_cvt_pk_fp8_f32(v[0].x * sc, v[0].y * sc, w, false); w = __builtin_amdgcn_cvt_pk_fp8_f32(v[0].z * sc, v[0].w * sc, w, true); o.x = (unsigned)w; }
            { int w = 0; w = __builtin_amdgcn_cvt_pk_fp8_f32(v[1].x * sc, v[1].y * sc, w, false); w = __builtin_amdgcn_cvt_pk_fp8_f32(v[1].z * sc, v[1].w * sc, w, true); o.y = (unsigned)w; }
            { int w = 0; w = __builtin_amdgcn_cvt_pk_fp8_f32(v[2].x * sc, v[2].y * sc, w, false); w = __builtin_amdgcn_cvt_pk_fp8_f32(v[2].z * sc, v[2].w * sc, w, true); o.z = (unsigned)w; }
            { int w = 0; w = __builtin_amdgcn_cvt_pk_fp8_f32(v[3].x * sc, v[3].y * sc, w, false); w = __builtin_amdgcn_cvt_pk_fp8_f32(v[3].z * sc, v[3].w * sc, w, true); o.w = (unsigned)w; }
            *(u32x4*)(p.ws + (tb ? OFF_PV : OFF_PU) + (size_t)r * DM + lane * 16) = o;
            if (lane == 0) scl[row] = mx > 0.f ? mx / 224.0f : 1.0f;
        }
    }
    {
        float* sh = (float*)lds;
        float* zl = sh + 8 * 64;
        const int sub = tid >> 6, j = tid & 63;
        for (int it = obid(); it < NLAYER * SL / 8; it += gridDim.x) {
            const int layer = it / (SL / 8), l = (it % (SL / 8)) * 8 + sub;
            const float t = (float)l / (float)(SL - 1);
            __syncthreads();
            if (j < 17) {
                float z;
                if (j == 0) z = t;
                else if (j <= 8) z = sinf(2.0f * 3.14159265358979323846f * t * (float)j);
                else z = cosf(2.0f * 3.14159265358979323846f * t * (float)(j - 8));
                zl[sub * 17 + j] = z;
            }
            __syncthreads();
            const float* w1 = p.in[I_W1] + layer * 17 * 64;
            float a = p.in[I_B1][layer * 64 + j];
#pragma unroll
            for (int i = 0; i < 17; ++i) a += zl[sub * 17 + i] * w1[i * 64 + j];
            sh[sub * 64 + j] = sinf(p.in[I_F1][layer * 64 + j] * a);
            __syncthreads();
            const float* w2 = p.in[I_W2] + layer * 64 * 64;
            float b = p.in[I_B2][layer * 64 + j];
#pragma unroll 8
            for (int k = 0; k < 64; ++k) b += sh[sub * 64 + k] * w2[k * 64 + j];
            ((bf16_t*)(p.ws + OFF_H2))[((size_t)layer * SL + l) * 64 + j] = (bf16_t)f2bf(sinf(p.in[I_F2][layer * 64 + j] * b));
        }
    }
    {
        const int total = NLAYER * 4 * 128 * 64;
        for (int o = obid() * NTHR + tid; o < total; o += gridDim.x * NTHR) {
            const int e2 = o & 63, dd = (o >> 6) & 127, g = (o >> 13) & 3, layer = o >> 15;
            const int d = dd & 63;
            const float* w = p.in[I_FW] + ((size_t)(layer * 4 + g) * 64) * 64;
            float acc = 0.f;
            for (int e = 0; e < 64; ++e) {
                const int m = (d * e) & 63;
                const float ang = (float)m * (2.0f * 3.14159265358979323846f / 64.0f);
                const float tw = (dd < 64) ? cosf(ang) : sinf(ang);
                acc += tw * w[e * 64 + e2];
            }
            ((float*)(p.ws + OFF_FM))[o] = acc * (1.0f / 724.0773439350246f);
        }
    }
}

template <bool PAD> __device__ __forceinline__ int zi(int i) { return PAD ? i + (i >> 8) : i; }

template <int LOGN, bool PAD>
__device__ __forceinline__ void fft_fwd(float2* Z) {
    constexpr int N = 1 << LOGN;
    const int tid = otid();
    int s = 0;
    for (; s + 1 < LOGN; s += 2) {
        const int lh2 = LOGN - s - 2;
        const int h2 = 1 << lh2, h = h2 << 1;
        const float rs = 1.0f / (float)(h << 1);
        for (int q = tid; q < N / 4; q += NTHR) {
            const int j = q & (h2 - 1), blk = q >> lh2;
            const int base = (blk << (lh2 + 2)) + j;
            float2 x0 = Z[zi<PAD>(base)], x1 = Z[zi<PAD>(base + h2)], x2 = Z[zi<PAD>(base + h)], x3 = Z[zi<PAD>(base + h + h2)];
            const float ang = (float)j * rs;
            const float c = __builtin_amdgcn_cosf(ang), sn = __builtin_amdgcn_sinf(ang);
            float2 a0 = make_float2(x0.x + x2.x, x0.y + x2.y);
            float2 d02 = make_float2(x0.x - x2.x, x0.y - x2.y);
            float2 a2 = make_float2(d02.x * c + d02.y * sn, d02.y * c - d02.x * sn);
            float2 a1 = make_float2(x1.x + x3.x, x1.y + x3.y);
            float2 d13 = make_float2(x1.x - x3.x, x1.y - x3.y);
            float2 t3 = make_float2(d13.x * c + d13.y * sn, d13.y * c - d13.x * sn);
            float2 a3 = make_float2(t3.y, -t3.x);
            const float c2 = c * c - sn * sn, s2 = 2.f * c * sn;
            float2 y0 = make_float2(a0.x + a1.x, a0.y + a1.y);
            float2 e01 = make_float2(a0.x - a1.x, a0.y - a1.y);
            float2 y1 = make_float2(e01.x * c2 + e01.y * s2, e01.y * c2 - e01.x * s2);
            float2 y2 = make_float2(a2.x + a3.x, a2.y + a3.y);
            float2 e23 = make_float2(a2.x - a3.x, a2.y - a3.y);
            float2 y3 = make_float2(e23.x * c2 + e23.y * s2, e23.y * c2 - e23.x * s2);
            Z[zi<PAD>(base)] = y0; Z[zi<PAD>(base + h2)] = y1; Z[zi<PAD>(base + h)] = y2; Z[zi<PAD>(base + h + h2)] = y3;
        }
        __syncthreads();
    }
    if (s < LOGN) {
        for (int q = tid; q < N / 2; q += NTHR) {
            const int i0 = 2 * q;
            float2 a = Z[zi<PAD>(i0)], b = Z[zi<PAD>(i0 + 1)];
            Z[zi<PAD>(i0)] = make_float2(a.x + b.x, a.y + b.y);
            Z[zi<PAD>(i0 + 1)] = make_float2(a.x - b.x, a.y - b.y);
        }
        __syncthreads();
    }
}

template <int LOGN, bool PAD>
__device__ __forceinline__ void fft_inv(float2* Z) {
    constexpr int N = 1 << LOGN;
    const int tid = otid();
    for (int s = LOGN - 2; s >= 0; s -= 2) {
        const int lh2 = LOGN - s - 2;
        const int h2 = 1 << lh2, h = h2 << 1;
        const float rs = 1.0f / (float)(h << 1);
        for (int q = tid; q < N / 4; q += NTHR) {
            const int j = q & (h2 - 1), blk = q >> lh2;
            const int base = (blk << (lh2 + 2)) + j;
            float2 y0 = Z[zi<PAD>(base)], y1 = Z[zi<PAD>(base + h2)], y2 = Z[zi<PAD>(base + h)], y3 = Z[zi<PAD>(base + h + h2)];
            const float ang = (float)j * rs;
            const float c = __builtin_amdgcn_cosf(ang), sn = __builtin_amdgcn_sinf(ang);
            const float c2 = c * c - sn * sn, s2 = 2.f * c * sn;
            float2 t1 = make_float2(y1.x * c2 - y1.y * s2, y1.y * c2 + y1.x * s2);
            float2 t3 = make_float2(y3.x * c2 - y3.y * s2, y3.y * c2 + y3.x * s2);
            float2 a0 = make_float2(y0.x + t1.x, y0.y + t1.y), a1 = make_float2(y0.x - t1.x, y0.y - t1.y);
            float2 a2 = make_float2(y2.x + t3.x, y2.y + t3.y), a3 = make_float2(y2.x - t3.x, y2.y - t3.y);
            float2 u2 = make_float2(a2.x * c - a2.y * sn, a2.y * c + a2.x * sn);
            float2 u3 = make_float2(a3.x * c - a3.y * sn, a3.y * c + a3.x * sn);
            float2 v3 = make_float2(-u3.y, u3.x);
            Z[zi<PAD>(base)] = make_float2(a0.x + u2.x, a0.y + u2.y);
            Z[zi<PAD>(base + h)] = make_float2(a0.x - u2.x, a0.y - u2.y);
            Z[zi<PAD>(base + h2)] = make_float2(a1.x + v3.x, a1.y + v3.y);
            Z[zi<PAD>(base + h + h2)] = make_float2(a1.x - v3.x, a1.y - v3.y);
        }
        __syncthreads();
    }
}


__device__ __forceinline__ int zp(int i) { return i + 2 * (i >> 5); }
__device__ constexpr float FC32[16] = {1.000000000f, 0.980785280f, 0.923879533f, 0.831469612f, 0.707106781f, 0.555570233f, 0.382683432f, 0.195090322f, 0.000000000f, -0.195090322f, -0.382683432f, -0.555570233f, -0.707106781f, -0.831469612f, -0.923879533f, -0.980785280f};
__device__ constexpr float FS32[16] = {0.000000000f, 0.195090322f, 0.382683432f, 0.555570233f, 0.707106781f, 0.831469612f, 0.923879533f, 0.980785280f, 1.000000000f, 0.980785280f, 0.923879533f, 0.831469612f, 0.707106781f, 0.555570233f, 0.382683432f, 0.195090322f};
__device__ __forceinline__ float2 cmulf(float2 a, float2 b) { return make_float2(a.x * b.x - a.y * b.y, a.x * b.y + a.y * b.x); }
template <int R> __device__ __forceinline__ constexpr int brevR(int x) { int r = 0; for (int b = 1, t = R >> 1; t >= 1; b <<= 1, t >>= 1) if (x & b) r |= t; return r; }
template <int R> __device__ __forceinline__ void dft_fwd_regs(float2 (&x)[R]) {
#pragma unroll
    for (int half = R / 2; half >= 1; half >>= 1) {
#pragma unroll
        for (int blk = 0; blk < R; blk += 2 * half)
#pragma unroll
            for (int k = 0; k < half; ++k) {
                const float2 a = x[blk + k], b = x[blk + k + half];
                x[blk + k] = make_float2(a.x + b.x, a.y + b.y);
                const float2 d = make_float2(a.x - b.x, a.y - b.y);
                const int ti = k * (16 / half);
                if (ti == 0) x[blk + k + half] = d;
                else if (ti == 8) x[blk + k + half] = make_float2(d.y, -d.x);
                else { const float c = FC32[ti], sn = FS32[ti]; x[blk + k + half] = make_float2(d.x * c + d.y * sn, d.y * c - d.x * sn); }
            }
    }
}
template <int R> __device__ __forceinline__ void dft_inv_regs(float2 (&x)[R]) {
#pragma unroll
    for (int half = 1; half <= R / 2; half <<= 1) {
#pragma unroll
        for (int blk = 0; blk < R; blk += 2 * half)
#pragma unroll
            for (int k = 0; k < half; ++k) {
                const float2 a = x[blk + k], b0 = x[blk + k + half];
                const int ti = k * (16 / half);
                float2 b;
                if (ti == 0) b = b0;
                else if (ti == 8) b = make_float2(-b0.y, b0.x);
                else { const float c = FC32[ti], sn = FS32[ti]; b = make_float2(b0.x * c - b0.y * sn, b0.y * c + b0.x * sn); }
                x[blk + k] = make_float2(a.x + b.x, a.y + b.y);
                x[blk + k + half] = make_float2(a.x - b.x, a.y - b.y);
            }
    }
}
template <int R> __device__ __forceinline__ void apply_tw(float2 (&x)[R], float c, float sg) {
    const float2 w1 = make_float2(c, sg), w2 = cmulf(w1, w1);
    float2 po = w1, pe = w2;
#pragma unroll
    for (int m = 1; m < R; m += 2) {
        x[brevR<R>(m)] = cmulf(x[brevR<R>(m)], po);
        if (m + 1 < R) x[brevR<R>(m + 1)] = cmulf(x[brevR<R>(m + 1)], pe);
        if (m + 2 < R) { po = cmulf(po, w2); pe = cmulf(pe, w2); }
    }
}
template <int R, bool INV> __device__ __forceinline__ void fft_group(float2* Z, int pbase, int PS, float ang) {
    float2 x[R];
    if (!INV) {
#pragma unroll
        for (int m = 0; m < R; ++m) x[m] = Z[pbase + PS * m];
        dft_fwd_regs<R>(x);
        apply_tw<R>(x, __builtin_amdgcn_cosf(ang), -__builtin_amdgcn_sinf(ang));
#pragma unroll
        for (int m = 0; m < R; ++m) Z[pbase + PS * m] = x[brevR<R>(m)];
    } else {
#pragma unroll
        for (int m = 0; m < R; ++m) x[brevR<R>(m)] = Z[pbase + PS * m];
        apply_tw<R>(x, __builtin_amdgcn_cosf(ang), __builtin_amdgcn_sinf(ang));
        dft_inv_regs<R>(x);
#pragma unroll
        for (int m = 0; m < R; ++m) Z[pbase + PS * m] = x[m];
    }
}
template <bool INV> __device__ __forceinline__ void fft_group32_contig(float2* Z, int pbase) {
    float2 x[32];
    if (!INV) {
#pragma unroll
        for (int m = 0; m < 32; m += 2) { const f32x4 v = *(const f32x4*)(Z + pbase + m); x[m] = make_float2(v.x, v.y); x[m + 1] = make_float2(v.z, v.w); }
        dft_fwd_regs<32>(x);
#pragma unroll
        for (int m = 0; m < 32; m += 2) { const float2 a = x[brevR<32>(m)], b = x[brevR<32>(m + 1)]; *(f32x4*)(Z + pbase + m) = (f32x4){a.x, a.y, b.x, b.y}; }
    } else {
#pragma unroll
        for (int m = 0; m < 32; m += 2) { const f32x4 v = *(const f32x4*)(Z + pbase + m); x[brevR<32>(m)] = make_float2(v.x, v.y); x[brevR<32>(m + 1)] = make_float2(v.z, v.w); }
        dft_inv_regs<32>(x);
#pragma unroll
        for (int m = 0; m < 32; m += 2) *(f32x4*)(Z + pbase + m) = (f32x4){x[m].x, x[m].y, x[m + 1].x, x[m + 1].y};
    }
}
__device__ __forceinline__ void fft16k_fwd(float2* Z) {
    const int tid = otid();
#pragma unroll 1
    for (int g = 0; g < 2; ++g) { const int j = tid + 512 * g; fft_group<16, false>(Z, zp(j), 1088, (float)j * (1.0f / 16384.0f)); }
    __syncthreads();
    { const int blk = tid >> 5, j = tid & 31; fft_group<32, false>(Z, blk * 1088 + j, 34, (float)j * (1.0f / 1024.0f)); }
    __syncthreads();
    fft_group32_contig<false>(Z, 34 * tid);
    __syncthreads();
}
__device__ __forceinline__ void fft16k_inv(float2* Z) {
    const int tid = otid();
    fft_group32_contig<true>(Z, 34 * tid);
    __syncthreads();
    { const int blk = tid >> 5, j = tid & 31; fft_group<32, true>(Z, blk * 1088 + j, 34, (float)j * (1.0f / 1024.0f)); }
    __syncthreads();
#pragma unroll 1
    for (int g = 0; g < 2; ++g) { const int j = tid + 512 * g; fft_group<16, true>(Z, zp(j), 1088, (float)j * (1.0f / 16384.0f)); }
    __syncthreads();
}
__device__ __forceinline__ void fft8k_fwd(float2* Z) {
    const int tid = otid();
    fft_group<16, false>(Z, zp(tid), 544, (float)tid * (1.0f / 8192.0f));
    __syncthreads();
    { const int blk = tid >> 5, j = tid & 31; fft_group<16, false>(Z, blk * 544 + j, 34, (float)j * (1.0f / 512.0f)); }
    __syncthreads();
    if (tid < 256) fft_group32_contig<false>(Z, 34 * tid);
    __syncthreads();
}
__device__ __forceinline__ int f16k_of_p(int p) { return (p >> 10) + 16 * ((p >> 5) & 31) + 512 * (p & 31); }
__device__ __forceinline__ int p16k_of_f(int f) { return 1024 * (f & 15) + 32 * ((f >> 4) & 31) + (f >> 9); }
__device__ __forceinline__ int p8k_of_f(int f) { return 512 * (f & 15) + 32 * ((f >> 4) & 15) + (f >> 8); }

__device__ __forceinline__ void phase_filter_spectra(const Params& p, char* lds) {
    const int tid = otid(), lane = tid & 63, wave = tid >> 6;
    float2* Z = (float2*)lds;
    float* red = (float*)(lds + 139264 + 64);
    for (int job = obid(); job < NLAYER * 256; job += gridDim.x) {
        const int layer = job >> 8, c = job & 255;
        __syncthreads();
        const float* HFc = (const float*)(p.ws + (layer ? OFF_HFILT1 : OFF_HFILT0)) + (size_t)c * SL;
        const float r_lo = 4.605170185988092f / 1.5f, r_hi = 4.605170185988092f / 0.3f;
        const float rate = r_lo + (r_hi - r_lo) * ((float)c / 255.0f);
        float ss0 = 0.f, ss1 = 0.f;
#pragma unroll 1
        for (int i = 0; i < 4; ++i) {
            const int l0 = 4 * tid + 2048 * i;
            const f32x4 a0 = *(const f32x4*)(HFc + l0), a1 = *(const f32x4*)(HFc + (size_t)256 * SL + l0);
            const f32x4 a2 = *(const f32x4*)(HFc + (size_t)512 * SL + l0), a3 = *(const f32x4*)(HFc + (size_t)768 * SL + l0);
#pragma unroll
            for (int e = 0; e < 4; ++e) {
                const int l = l0 + e;
                const float t = (float)l / (float)(SL - 1);
                const float dec = expf(-t * rate);
                const float f0 = a0[e] * dec, b0 = a1[e] * dec, f1 = a2[e] * dec, b1 = a3[e] * dec;
                ss0 += f0 * f0 + b0 * b0; ss1 += f1 * f1 + b1 * b1;
                Z[zp(l)] = make_float2(f0, f1);
                if (l >= 1) Z[zp(16384 - l)] = make_float2(b0, b1);
            }
        }
        if (tid == 0) Z[zp(8192)] = make_float2(0.f, 0.f);
        ss0 = wave_sum(ss0); ss1 = wave_sum(ss1);
        if (lane == 0) { red[wave * 2] = ss0; red[wave * 2 + 1] = ss1; }
        __syncthreads();
        float t0 = 0.f, t1 = 0.f;
#pragma unroll
        for (int w = 0; w < 8; ++w) { t0 += red[w * 2]; t1 += red[w * 2 + 1]; }
        const float sc0 = rsqrtf(t0 + EPS) * (1.0f / 16384.0f) * 0.5f, sc1 = rsqrtf(t1 + EPS) * (1.0f / 16384.0f) * 0.5f;
        fft16k_fwd(Z);
        float2* KF0 = (float2*)(p.ws + OFF_KF) + ((size_t)(layer * 256 + c) * 2) * 16384;
        float2* KF1 = KF0 + 16384;
        for (int i = 0; i < 32; ++i) {
            const int pp = tid + NTHR * i;
            const int fq = f16k_of_p(pp);
            const int pq = p16k_of_f((16384 - fq) & 16383);
            const float2 za = Z[zp(pp)], zq = Z[zp(pq)];
            KF0[pp] = make_float2((za.x + zq.x) * sc0, (za.y - zq.y) * sc0);
            KF1[pp] = make_float2((za.y + zq.y) * sc1, (zq.x - za.x) * sc1);
        }
    }
}

__device__ __forceinline__ void phase_rmsnorm_bf16(const float* x, const float* g, bf16_t* out) {
    const int lane = otid() & 63, wave = otid() >> 6;
    const int gw = obid() * NWAVE + wave, ngw = gridDim.x * NWAVE;
    for (int row = gw; row < T; row += ngw) {
        const f32x4* xr = (const f32x4*)(x + (size_t)row * DM) + lane;
        f32x4 v[4]; float ss = 0.f;
#pragma unroll
        for (int j = 0; j < 4; ++j) { v[j] = xr[64 * j]; ss += v[j].x * v[j].x + v[j].y * v[j].y + v[j].z * v[j].z + v[j].w * v[j].w; }
        ss = wave_sum(ss);
        const float r = rsqrtf(ss * (1.0f / DM) + EPS);
        u32x2* o = (u32x2*)(out + (size_t)row * DM) + lane;
#pragma unroll
        for (int j = 0; j < 4; ++j) {
            const f32x4 gg = ((const f32x4*)g)[lane + 64 * j];
            u32x2 w; w.x = pk2(v[j].x * r * gg.x, v[j].y * r * gg.y); w.y = pk2(v[j].z * r * gg.z, v[j].w * r * gg.w);
            o[64 * j] = w;
        }
    }
}
__device__ __forceinline__ void phase_final_norm(const float* x, const float* g, float* out) {
    const int lane = otid() & 63, wave = otid() >> 6;
    const int gw = obid() * NWAVE + wave, ngw = gridDim.x * NWAVE;
    for (int row = gw; row < T; row += ngw) {
        const f32x4* xr = (const f32x4*)(x + (size_t)row * DM) + lane;
        f32x4 v[4]; float ss = 0.f;
#pragma unroll
        for (int j = 0; j < 4; ++j) { v[j] = xr[64 * j]; ss += v[j].x * v[j].x + v[j].y * v[j].y + v[j].z * v[j].z + v[j].w * v[j].w; }
        ss = wave_sum(ss);
        const float r = rsqrtf(ss * (1.0f / DM) + EPS);
        f32x4* o = (f32x4*)(out + (size_t)row * DM) + lane;
#pragma unroll
        for (int j = 0; j < 4; ++j) { const f32x4 gg = ((const f32x4*)g)[lane + 64 * j]; o[64 * j] = v[j] * r * gg; }
    }
}

constexpr int G_LDA = 144;
template <class Epi>
__device__ __forceinline__ void gemm_simple(const bf16_t* A, const bf16_t* Bt, int M, int N, int K, char* lds, const Epi& epi) {
    const int tid = otid(), lane = tid & 63, wave = tid >> 6;
    const int wm = wave >> 1, wn = wave & 1;
    const int nMt = M / 256, nNt = N / 128, total = nMt * nNt, nk = K / 64;
    char* As = lds; char* Bs = lds + 256 * G_LDA;
    const int l31 = lane & 31, hl = lane >> 5;
    for (int u = obid(); u < total; u += gridDim.x) {
        const int mt = u % nMt, nt = u / nMt;
        f32x16 acc[2][2];
#pragma unroll
        for (int i = 0; i < 2; ++i)
#pragma unroll
            for (int j = 0; j < 2; ++j) acc[i][j] = zero16();
        u32x4 ra[4], rb[2];
        const bf16_t* Ab = A + (size_t)(mt * 256) * K;
        const bf16_t* Bb = Bt + (size_t)(nt * 128) * K;
#pragma unroll
        for (int i = 0; i < 4; ++i) { const int id = tid + NTHR * i, row = id >> 3, ch = id & 7; ra[i] = *(const u32x4*)(Ab + (size_t)row * K + ch * 8); }
#pragma unroll
        for (int i = 0; i < 2; ++i) { const int id = tid + NTHR * i, row = id >> 3, ch = id & 7; rb[i] = *(const u32x4*)(Bb + (size_t)row * K + ch * 8); }
        for (int kt = 0; kt < nk; ++kt) {
            __syncthreads();
#pragma unroll
            for (int i = 0; i < 4; ++i) { const int id = tid + NTHR * i, row = id >> 3, ch = id & 7; *(u32x4*)(As + row * G_LDA + ch * 16) = ra[i]; }
#pragma unroll
            for (int i = 0; i < 2; ++i) { const int id = tid + NTHR * i, row = id >> 3, ch = id & 7; *(u32x4*)(Bs + row * G_LDA + ch * 16) = rb[i]; }
            __syncthreads();
            if (kt + 1 < nk) {
                const int ko = (kt + 1) * 64;
#pragma unroll
                for (int i = 0; i < 4; ++i) { const int id = tid + NTHR * i, row = id >> 3, ch = id & 7; ra[i] = *(const u32x4*)(Ab + (size_t)row * K + ko + ch * 8); }
#pragma unroll
                for (int i = 0; i < 2; ++i) { const int id = tid + NTHR * i, row = id >> 3, ch = id & 7; rb[i] = *(const u32x4*)(Bb + (size_t)row * K + ko + ch * 8); }
            }
#pragma unroll
            for (int ks = 0; ks < 4; ++ks) {
                bf16x8 a[2], b[2];
#pragma unroll
                for (int i = 0; i < 2; ++i) a[i] = *(const bf16x8*)(As + (wm * 64 + i * 32 + l31) * G_LDA + ks * 32 + hl * 16);
#pragma unroll
                for (int j = 0; j < 2; ++j) b[j] = *(const bf16x8*)(Bs + (wn * 64 + j * 32 + l31) * G_LDA + ks * 32 + hl * 16);
#pragma unroll
                for (int i = 0; i < 2; ++i)
#pragma unroll
                    for (int j = 0; j < 2; ++j) acc[i][j] = mfma32(a[i], b[j], acc[i][j]);
            }
        }
#pragma unroll
        for (int i = 0; i < 2; ++i)
#pragma unroll
            for (int j = 0; j < 2; ++j) epi(acc[i][j], mt * 256 + wm * 64 + i * 32, nt * 128 + wn * 64 + j * 32, lane);
    }
}

struct EpiIn {
    bf16_t* qkv; float* hf;
    __device__ __forceinline__ void operator()(const f32x16& acc, int row0, int col0, int lane) const {
        const int c = col0 + (lane & 31), h = lane >> 5;
        if (col0 < 768) {
#pragma unroll
            for (int r = 0; r < 16; ++r) { const int row = row0 + (r & 3) + 8 * (r >> 2) + 4 * h; qkv[(size_t)row * 768 + c] = (bf16_t)f2bf(acc[r]); }
        } else {
            float* dst = hf + (size_t)(c - 768) * T;
#pragma unroll
            for (int i = 0; i < 4; ++i) { const int row = row0 + 8 * i + 4 * h; f32x4 v; v.x = acc[4 * i]; v.y = acc[4 * i + 1]; v.z = acc[4 * i + 2]; v.w = acc[4 * i + 3]; *(f32x4*)(dst + row) = v; }
        }
    }
};
struct EpiRes {
    const float* base; float* out;
    __device__ __forceinline__ void operator()(const f32x16& acc, int row0, int col0, int lane) const {
        const int c = col0 + (lane & 31), h = lane >> 5;
#pragma unroll
        for (int r = 0; r < 16; ++r) { const size_t o = (size_t)(row0 + (r & 3) + 8 * (r >> 2) + 4 * h) * DM + c; out[o] = base[o] + acc[r]; }
    }
};
struct EpiF32 {
    float* out; int ld;
    __device__ __forceinline__ void operator()(const f32x16& acc, int row0, int col0, int lane) const {
        const int c = col0 + (lane & 31), h = lane >> 5;
#pragma unroll
        for (int r = 0; r < 16; ++r) { out[(size_t)(row0 + (r & 3) + 8 * (r >> 2) + 4 * h) * ld + c] = acc[r]; }
    }
};

namespace pg8 {
#define PG8_LAS __attribute__((address_space(3)))
constexpr int BM = 256, BK = 64, HALF = 128, HTB = HALF * BK * 2  , STAGE_BYTES = 8 * HTB, NXCD = 8, WGM = 8;

__host__ __device__ __forceinline__ int lds_byte(int r, int c) { const int st = (r >> 4) * 2 + (c >> 5), rr = r & 15, cc = c & 31, ob = rr * 64 + cc * 2; return st * 1024 + (ob ^ (((ob >> 9) & 1) << 5)); }
__host__ __device__ __forceinline__ void stage_rc(int b, int& R, int& C) { const int st = b / 1024, sb = b % 1024, swz = sb ^ (((sb >> 9) & 1) << 5); R = (st >> 1) * 16 + swz / 64; C = (st & 1) * 32 + (swz % 64) / 2; }
__host__ __device__ __forceinline__ int perm32(int rho) { const int n = rho >> 4, i = rho & 15; return 8 * (i >> 2) + 4 * n + (i & 3); }

struct Unit { int pm, pn; };
struct Gemm { const bf16_t* A; const bf16_t* Bt; int M, N, K; };

struct StaticOrder {
    int nM, nN, nwg, G, c;
    __host__ __device__ void init(int M, int N, int G_, int c_) { nM = M / BM; nN = N / BM; nwg = nM * nN; G = G_; c = c_; }
    __host__ __device__ bool next(int i, Unit& u) const {
        const long L = (long)i * G + c; if (L >= nwg) return false;
        int wgid = (int)L; { const int q = nwg / NXCD, r = nwg % NXCD, xcd = wgid % NXCD, off = wgid / NXCD; wgid = (xcd < r ? xcd * (q + 1) : r * (q + 1) + (xcd - r) * q) + off; }
        const int nig = WGM * nN, gid = wgid / nig, fm = gid * WGM, gsz = (nM - fm) < WGM ? (nM - fm) : WGM;
        u.pm = fm + ((wgid % nig) % gsz); u.pn = (wgid % nig) / gsz; return true;
    }
    __device__ __forceinline__ void a_ready(const Unit&) const {}
    __device__ __forceinline__ void done(const Unit&) const {}
};


__device__ __forceinline__ unsigned cvt_pk_bf16(float lo, float hi) { unsigned r; asm volatile("v_cvt_pk_bf16_f32 %0, %1, %2" : "=v"(r) : "v"(lo), "v"(hi)); return r; }
struct EpiStoreBf16 {
    static constexpr bool PERM = true, AFTER_DRAIN = false;
    bf16_t* O; int ldc;
    __device__ __forceinline__ void operator()(const f32x4 (&acc)[2][2][4][2], const Unit& u, int wr, int wc, int fr, int fq) const {
        const int row0 = u.pm * BM + wr * 64 + fr, col0 = u.pn * BM + wc * 32 + 8 * fq;
#pragma unroll
        for (int ai = 0; ai < 2; ++ai)
#pragma unroll
            for (int m = 0; m < 4; ++m) { bf16_t* rowp = O + (size_t)(row0 + ai * HALF + m * 16) * ldc + col0;
#pragma unroll
                for (int bj = 0; bj < 2; ++bj) { const f32x4 v0 = acc[ai][bj][m][0], v1 = acc[ai][bj][m][1];
                    u32x4 w; w.x = cvt_pk_bf16(v0[0], v0[1]); w.y = cvt_pk_bf16(v0[2], v0[3]); w.z = cvt_pk_bf16(v1[0], v1[1]); w.w = cvt_pk_bf16(v1[2], v1[3]);
                    *(u32x4*)(rowp + bj * HALF) = w; } }
    }
};
struct EpiStoreF32 {
    static constexpr bool PERM = false, AFTER_DRAIN = false;
    const float* base; float* O; int ldc;
    __device__ __forceinline__ void operator()(const f32x4 (&acc)[2][2][4][2], const Unit& u, int wr, int wc, int fr, int fq) const {
        const int row0 = u.pm * BM + wr * 64 + fr, col0 = u.pn * BM + wc * 32 + 4 * fq;
#pragma unroll
        for (int ai = 0; ai < 2; ++ai)
#pragma unroll
            for (int m = 0; m < 4; ++m) { const size_t off = (size_t)(row0 + ai * HALF + m * 16) * ldc + col0;
#pragma unroll
                for (int bj = 0; bj < 2; ++bj)
#pragma unroll
                    for (int n = 0; n < 2; ++n) { f32x4 v = acc[ai][bj][m][n]; if (base) v += *(const f32x4*)(base + off + bj * HALF + n * 16); *(f32x4*)(O + off + bj * HALF + n * 16) = v; } }
    }
};

template <class Epi, class Sched, bool ALIGN_EPI = false, bool SP2 = false>
__device__ __forceinline__ void gemm_phase(PG8_LAS unsigned char* lds, const Gemm g, const Sched& S, const Epi& E) {
    const int tid = otid(), wid = __builtin_amdgcn_readfirstlane(tid >> 6), lane = tid & 63, wr = wid >> 2, wc = wid & 3, fr = lane & 15, fq = lane >> 4;
    const int K = g.K, nt = K / BK;
    unsigned voffA[2], voffB[2];
#pragma unroll
    for (int i = 0; i < 2; ++i) { int R, C; stage_rc(tid * 16 + i * 8192, R, C); const int Rb = Epi::PERM ? ((R & ~31) + perm32(R & 31)) : R;
        voffA[i] = (unsigned)(R * K + C) * 2u; voffB[i] = (unsigned)(Rb * K + C) * 2u; }
    const size_t kstep = (size_t)(BK * 2);
    const size_t hstep = (size_t)HALF * K * 2;
    const size_t tstep = 2 * hstep;
    const unsigned ldsw = (unsigned)wid * 1024u;
    const int aoff = lds_byte(wr * 64 + fr, fq * 8), boff = lds_byte(wc * 32 + fr, fq * 8);
#define PG8_SA(b, h) (((b) * 2 + (h)) * HTB)
#define PG8_SB(b, h) ((4 + (b) * 2 + (h)) * HTB)
#define PG8_STAGE(bufoff, gbase, voff) do { _Pragma("unroll") for (int _i = 0; _i < 2; ++_i) \
        __builtin_amdgcn_global_load_lds((const unsigned*)((const char*)(gbase) + (voff)[_i]), (PG8_LAS unsigned*)(lds + (bufoff) + ldsw + _i * 8192), 16, 0, 0); } while (0)
#define PG8_LDA(dst, b, h) do { _Pragma("unroll") for (int m = 0; m < 4; ++m) _Pragma("unroll") for (int k = 0; k < 2; ++k) dst[m][k] = *(const PG8_LAS bf16x8*)(lds + PG8_SA(b, h) + aoff + m * 2048 + k * 1024); } while (0)
#define PG8_LDB(dst, b, h) do { _Pragma("unroll") for (int n = 0; n < 2; ++n) _Pragma("unroll") for (int k = 0; k < 2; ++k) dst[n][k] = *(const PG8_LAS bf16x8*)(lds + PG8_SB(b, h) + boff + n * 2048 + k * 1024); } while (0)
#define PG8_MMA(ai, bj, At, Bt) do { __builtin_amdgcn_s_setprio(1); _Pragma("unroll") for (int m = 0; m < 4; ++m) _Pragma("unroll") for (int n = 0; n < 2; ++n) _Pragma("unroll") for (int k = 0; k < 2; ++k) \
        acc[ai][bj][m][n] = __builtin_amdgcn_mfma_f32_16x16x32_bf16(Bt[n][k], At[m][k], acc[ai][bj][m][n], 0, 0, 0); __builtin_amdgcn_s_setprio(0); } while (0)
#define PG8_WAIT_V(n) asm volatile("s_waitcnt vmcnt(" #n ")" ::: "memory")
#define PG8_WAIT_L(n) asm volatile("s_waitcnt lgkmcnt(" #n ")" ::: "memory")
#define PG8_BAR __builtin_amdgcn_s_barrier()
#define PG8_SCHED __builtin_amdgcn_sched_barrier(0)
    Unit cur, nxt; int ui = 0;
    if (!S.next(0, cur)) return;
    f32x4 acc[2][2][4][2];
#pragma unroll
    for (int a = 0; a < 2; ++a)
#pragma unroll
        for (int b = 0; b < 2; ++b)
#pragma unroll
            for (int m = 0; m < 4; ++m)
#pragma unroll
                for (int n = 0; n < 2; ++n) acc[a][b][m][n] = (f32x4){0.f, 0.f, 0.f, 0.f};
    bf16x8 At[4][2], B0[2][2], B1[2][2];
    const char* cA = (const char*)g.A + (size_t)cur.pm * tstep; const char* cB = (const char*)g.Bt + (size_t)cur.pn * tstep;
    S.a_ready(cur);
    if constexpr (SP2) {
        PG8_STAGE(PG8_SB(0, 0), cB, voffB); PG8_STAGE(PG8_SB(0, 1), cB + hstep, voffB); PG8_STAGE(PG8_SA(0, 0), cA, voffA); PG8_STAGE(PG8_SA(0, 1), cA + hstep, voffA);
        if (wr == 1) PG8_BAR;
        PG8_WAIT_V(2); PG8_BAR;
        PG8_STAGE(PG8_SB(1, 0), cB + kstep, voffB); PG8_STAGE(PG8_SA(1, 0), cA + kstep, voffA); PG8_STAGE(PG8_SB(1, 1), cB + hstep + kstep, voffB);
        PG8_WAIT_V(6); PG8_BAR;
    } else {
        PG8_STAGE(PG8_SB(0, 0), cB, voffB); PG8_STAGE(PG8_SA(0, 0), cA, voffA); PG8_STAGE(PG8_SB(0, 1), cB + hstep, voffB); PG8_STAGE(PG8_SA(0, 1), cA + hstep, voffA);
        if (wr == 1) PG8_BAR;
        PG8_WAIT_V(4); PG8_BAR;
        PG8_STAGE(PG8_SB(1, 0), cB + kstep, voffB); PG8_STAGE(PG8_SA(1, 0), cA + kstep, voffA); PG8_STAGE(PG8_SB(1, 1), cB + hstep + kstep, voffB);
        PG8_WAIT_V(6); PG8_BAR;
    }
    for (;;) {
        const bool has_next = S.next(ui + 1, nxt);
        const char* nA = has_next ? (const char*)g.A + (size_t)nxt.pm * tstep : cA; const char* nB = has_next ? (const char*)g.Bt + (size_t)nxt.pn * tstep : cB;
        for (int t = 0; t < nt; t += 2) {
            const bool last = (t == nt - 2);
            const char* a1 = cA + (size_t)(t + 1) * kstep;
            const char* a2 = last ? nA : cA + (size_t)(t + 2) * kstep; const char* b2 = last ? nB : cB + (size_t)(t + 2) * kstep;
            const char* a3 = a2 + kstep; const char* b3 = b2 + kstep;
            if (last && has_next) S.a_ready(nxt);
            if constexpr (SP2) {
            PG8_LDB(B0, 0, 0); PG8_LDB(B1, 0, 1); PG8_SCHED; PG8_LDA(At, 0, 0); PG8_STAGE(PG8_SA(1, 1), a1 + hstep, voffA);
            PG8_WAIT_V(8); PG8_WAIT_L(0); PG8_BAR; PG8_MMA(0, 0, At, B0); PG8_MMA(0, 1, At, B1); PG8_BAR; PG8_SCHED;
            PG8_LDA(At, 0, 1); PG8_STAGE(PG8_SB(0, 0), b2, voffB); PG8_STAGE(PG8_SB(0, 1), b2 + hstep, voffB); PG8_STAGE(PG8_SA(0, 0), a2, voffA);
            PG8_WAIT_V(8); PG8_WAIT_L(0); PG8_BAR; PG8_MMA(1, 0, At, B0); PG8_MMA(1, 1, At, B1); PG8_BAR; PG8_SCHED;
            PG8_LDB(B0, 1, 0); PG8_LDB(B1, 1, 1); PG8_SCHED; PG8_LDA(At, 1, 0); PG8_STAGE(PG8_SA(0, 1), a2 + hstep, voffA);
            PG8_WAIT_V(8); PG8_WAIT_L(0); PG8_BAR; PG8_MMA(0, 0, At, B0); PG8_MMA(0, 1, At, B1); PG8_BAR; PG8_SCHED;
            PG8_LDA(At, 1, 1); PG8_STAGE(PG8_SB(1, 0), b3, voffB); PG8_STAGE(PG8_SB(1, 1), b3 + hstep, voffB); PG8_STAGE(PG8_SA(1, 0), a3, voffA);
            PG8_WAIT_V(8); PG8_WAIT_L(0); PG8_BAR; PG8_MMA(1, 0, At, B0); PG8_MMA(1, 1, At, B1); PG8_BAR; PG8_SCHED;
            } else {
            PG8_LDB(B0, 0, 0); PG8_SCHED; PG8_LDA(At, 0, 0); PG8_STAGE(PG8_SA(1, 1), a1 + hstep, voffA);
            PG8_WAIT_L(8); PG8_BAR; PG8_WAIT_L(0); PG8_MMA(0, 0, At, B0); PG8_BAR; PG8_SCHED;
            PG8_LDB(B1, 0, 1); PG8_STAGE(PG8_SB(0, 0), b2, voffB);
            PG8_BAR; PG8_WAIT_L(0); PG8_MMA(0, 1, At, B1); PG8_BAR;
            PG8_LDA(At, 0, 1); PG8_STAGE(PG8_SA(0, 0), a2, voffA);
            PG8_BAR; PG8_WAIT_L(0); PG8_MMA(1, 0, At, B0); PG8_BAR; PG8_SCHED;
            PG8_STAGE(PG8_SB(0, 1), b2 + hstep, voffB);
            PG8_WAIT_V(6); PG8_BAR; PG8_MMA(1, 1, At, B1); PG8_BAR;
            PG8_LDB(B0, 1, 0); PG8_SCHED; PG8_LDA(At, 1, 0); PG8_STAGE(PG8_SA(0, 1), a2 + hstep, voffA);
            PG8_WAIT_L(8); PG8_BAR; PG8_WAIT_L(0); PG8_MMA(0, 0, At, B0); PG8_BAR; PG8_SCHED;
            PG8_LDB(B1, 1, 1); PG8_STAGE(PG8_SB(1, 0), b3, voffB);
            PG8_BAR; PG8_WAIT_L(0); PG8_MMA(0, 1, At, B1); PG8_BAR;
            PG8_LDA(At, 1, 1); PG8_STAGE(PG8_SA(1, 0), a3, voffA);
            PG8_BAR; PG8_WAIT_L(0); PG8_MMA(1, 0, At, B0); PG8_BAR; PG8_SCHED;
            PG8_STAGE(PG8_SB(1, 1), b3 + hstep, voffB);
            PG8_WAIT_V(6); PG8_BAR; PG8_MMA(1, 1, At, B1); PG8_BAR;
            }
        }
        if constexpr (ALIGN_EPI) { if (wr == 0) PG8_BAR; }
        if constexpr (!Epi::AFTER_DRAIN) { E(acc, cur, wr, wc, fr, fq); S.done(cur); }
        if (!has_next) break;
#pragma unroll
        for (int a = 0; a < 2; ++a)
#pragma unroll
            for (int b = 0; b < 2; ++b)
#pragma unroll
                for (int m = 0; m < 4; ++m)
#pragma unroll
                    for (int n = 0; n < 2; ++n) acc[a][b][m][n] = (f32x4){0.f, 0.f, 0.f, 0.f};
        cur = nxt; cA = nA; cB = nB; ++ui;
        if constexpr (ALIGN_EPI) { if (wr == 1) PG8_BAR; }
    }
    PG8_WAIT_V(0);
    if constexpr (!ALIGN_EPI) { if (wr == 0) PG8_BAR; }
    PG8_BAR;
    if constexpr (Epi::AFTER_DRAIN) { E.fused(acc, cur, wr, wc, fr, fq, lds, wid, lane); S.done(cur); }
#undef PG8_SA
#undef PG8_SB
#undef PG8_STAGE
#undef PG8_LDA
#undef PG8_LDB
#undef PG8_MMA
#undef PG8_WAIT_V
#undef PG8_WAIT_L
#undef PG8_BAR
#undef PG8_SCHED
}
}

__device__ __forceinline__ void phase_qkprep(const Params& p, int layer, char* lds, bf16_t* qout) {
    const int tid = otid(), lane = tid & 63, wave = tid >> 6;
    bf16_t* qkv = (bf16_t*)(p.ws + R_QKV);
    bf16_t* vt = (bf16_t*)(p.ws + R_VT);
    const float qgv = p.in[I_QG][layer * 64 + lane], kgv = p.in[I_KG][layer * 64 + lane];
    const int gw = obid() * NWAVE + wave, ngw = gridDim.x * NWAVE;
    const int ax = lane >> 5, fr = lane & 15; const bool second = (lane >> 4) & 1;
    const float inv = powf(10000.0f, -(float)fr / 16.0f);
    for (int t = gw; t < T; t += ngw) {
        const int l = t & (SL - 1);
        const float pos = ax ? (float)(l & 63) : (float)(l >> 6);
        const float ang = pos * inv;
        const float cs = cosf(ang), sn = sinf(ang);
        bf16_t* row = qkv + (size_t)t * 768;
#pragma unroll
        for (int slot = 0; slot < 10; ++slot) {
            const float x = bf2f(row[slot * 64 + lane]);
            const float ss = wave_sum(x * x);
            const float r = rsqrtf(ss * (1.0f / 64.0f) + EPS);
            const float y = x * r * (slot < 8 ? qgv : kgv);
            const float other = __shfl_xor(y, 16);
            float o = second ? (y * cs + other * sn) : (y * cs - other * sn);
            if (slot < 8) o *= 0.125f * 1.4426950408889634f;
            qout[(size_t)t * 768 + slot * 64 + lane] = (bf16_t)f2bf(o);
        }
    }
}

#include <hip/hip_bf16.h>
#include <cmath>
namespace attn_body {
using bf16=__hip_bfloat16;
using bf16x8=__attribute__((ext_vector_type(8)))short;
using s16x4=__attribute__((ext_vector_type(4)))short;
using f32x16=__attribute__((ext_vector_type(16)))float;
using u32x4=__attribute__((ext_vector_type(4)))unsigned;
constexpr int SEQ=8192,D=64,PQ=768,PO=512;
constexpr int NW=8,QBLK=32,QB=QBLK*NW,KVBLK=64,NQB=SEQ/QB;
constexpr int ATTN_UNIT_ROWS=QB;
__device__ __forceinline__ int crow(int r,int hi){return (r&3)+8*(r>>2)+4*hi;}
#define SBAR() __builtin_amdgcn_sched_barrier(0)
__device__ __forceinline__ void cmask(f32x16&p0,f32x16&p1,int jb,int qrel,int hi){
  const float NEG=-INFINITY; int kb=64*jb+4*hi;
  #pragma unroll
  for(int r=0;r<16;++r){int kv=kb+(r&3)+8*(r>>2); if(kv>qrel)p0[r]=NEG; if(kv+32>qrel)p1[r]=NEG;}
}

constexpr int NSLOT=3, SLOTB=8192;
constexpr int LDS_K=0, LDS_V=NSLOT*SLOTB, LDS_WS=2*NSLOT*SLOTB, LDS_OST=LDS_WS+NW*64*4, LDS_BYTES=LDS_OST+NW*4096;
constexpr float C2=0.125f*1.4426950408889634f;
__device__ __forceinline__ void glds16(const void*gsrc,unsigned lds_dst){unsigned keep;
  asm volatile("s_mov_b32 %0, m0\n\ts_mov_b32 m0, %2\n\ts_nop 0\n\tglobal_load_lds_dwordx4 %1, off\n\ts_mov_b32 m0, %0":"=&s"(keep):"v"(gsrc),"s"(lds_dst):"memory");}
__device__ __forceinline__ float max3f(float a,float b,float c){float r;asm("v_max3_f32 %0, %1, %2, %3":"=v"(r):"v"(a),"v"(b),"v"(c));return r;}
__device__ __forceinline__ float max2f(float a,float b){float r;asm("v_max_f32_e32 %0, %1, %2":"=v"(r):"v"(a),"v"(b));return r;}
__device__ __forceinline__ float fadd_s(float a,float b){float r;asm("v_add_f32_e32 %0, %1, %2":"=v"(r):"v"(a),"v"(b));return r;}
__device__ __forceinline__ float fsub_s(float a,float b){float r;asm("v_sub_f32_e32 %0, %1, %2":"=v"(r):"v"(a),"v"(b));return r;}
typedef float f32x2_t __attribute__((ext_vector_type(2))); typedef __bf16 bf16x2_t __attribute__((ext_vector_type(2)));
__device__ __forceinline__ unsigned cvtpk_s(float lo,float hi){f32x2_t v={lo,hi};bf16x2_t b=__builtin_convertvector(v,bf16x2_t);return __builtin_bit_cast(unsigned,b);}
#define WAIT_BAR(N) asm volatile("s_waitcnt vmcnt(" #N ") lgkmcnt(0)\n\ts_barrier":::"memory")

__device__ __forceinline__ void qkt(f32x16&p0,f32x16&p1,const char*Kslot,const bf16x8*qr,const f32x16&negm,int r32,int hi){
  const char*kb=Kslot+hi*1024+r32*16;
  #pragma unroll
  for(int d0=0;d0<4;++d0){
    const bf16x8 b0=*reinterpret_cast<const bf16x8*>(kb+d0*2048);
    const bf16x8 b1=*reinterpret_cast<const bf16x8*>(kb+d0*2048+512);
    if(d0==0){p0=__builtin_amdgcn_mfma_f32_32x32x16_bf16(b0,qr[0],negm,0,0,0);p1=__builtin_amdgcn_mfma_f32_32x32x16_bf16(b1,qr[0],negm,0,0,0);}
    else{p0=__builtin_amdgcn_mfma_f32_32x32x16_bf16(b0,qr[d0],p0,0,0,0);p1=__builtin_amdgcn_mfma_f32_32x32x16_bf16(b1,qr[d0],p1,0,0,0);}}
}
typedef __attribute__((address_space(3))) const char* lds_cptr;
typedef short v4i16_t __attribute__((ext_vector_type(4)));
__device__ __forceinline__ void kload8(bf16x8*kf,lds_cptr kp){
  kf[0]=*(const __attribute__((address_space(3))) bf16x8*)(kp);      kf[1]=*(const __attribute__((address_space(3))) bf16x8*)(kp+512);
  kf[2]=*(const __attribute__((address_space(3))) bf16x8*)(kp+2048); kf[3]=*(const __attribute__((address_space(3))) bf16x8*)(kp+2560);
  kf[4]=*(const __attribute__((address_space(3))) bf16x8*)(kp+4096); kf[5]=*(const __attribute__((address_space(3))) bf16x8*)(kp+4608);
  kf[6]=*(const __attribute__((address_space(3))) bf16x8*)(kp+6144); kf[7]=*(const __attribute__((address_space(3))) bf16x8*)(kp+6656);
}
__device__ __forceinline__ void kload2(bf16x8*kf,lds_cptr kp,int j){ kf[2*j]=*(const __attribute__((address_space(3))) bf16x8*)(kp+j*2048); kf[2*j+1]=*(const __attribute__((address_space(3))) bf16x8*)(kp+j*2048+512); }
__device__ __forceinline__ s16x4 vtr(lds_cptr p){ return __builtin_bit_cast(s16x4,__builtin_amdgcn_ds_read_tr16_b64_v4i16((__attribute__((address_space(3))) v4i16_t*)p)); }
__device__ __forceinline__ float rowmax(const f32x16&p0,const f32x16&p1){
  float a=max3f(p0[0],p0[1],p1[0]),b=max3f(p0[2],p0[3],p1[1]);a=max3f(a,p1[2],p1[3]);
  #pragma unroll
  for(int r=4;r<16;r+=4){a=max3f(a,p0[r],p0[r+1]);b=max3f(b,p0[r+2],p0[r+3]);a=max3f(a,p1[r],p1[r+1]);b=max3f(b,p1[r+2],p1[r+3]);}
  const float m=max2f(a,b);
  auto rr=__builtin_amdgcn_permlane32_swap(__float_as_uint(m),__float_as_uint(m),false,false);
  return max2f(__uint_as_float(rr[0]),__uint_as_float(rr[1]));
}
__device__ __forceinline__ void pv(f32x16*o,int vb,bf16x8 pa0,bf16x8 pa1,bf16x8 pa2,bf16x8 pa3){
  #pragma unroll
  for(int d0=0;d0<2;++d0){s16x4 lo[4],hi[4];
    #pragma unroll
    for(int ks=0;ks<4;++ks){
      asm volatile("ds_read_b64_tr_b16 %0,%1 offset:%c2":"=&v"(lo[ks]):"v"(vb),"i"(d0*4096+ks*1024):"memory");
      asm volatile("ds_read_b64_tr_b16 %0,%1 offset:%c2":"=&v"(hi[ks]):"v"(vb),"i"(d0*4096+ks*1024+512):"memory");}
    asm volatile("s_waitcnt lgkmcnt(0)":::"memory");SBAR();
    #define PK(k) (bf16x8){lo[k][0],lo[k][1],lo[k][2],lo[k][3],hi[k][0],hi[k][1],hi[k][2],hi[k][3]}
    o[d0]=__builtin_amdgcn_mfma_f32_32x32x16_bf16(pa0,PK(0),o[d0],0,0,0);
    o[d0]=__builtin_amdgcn_mfma_f32_32x32x16_bf16(pa1,PK(1),o[d0],0,0,0);
    o[d0]=__builtin_amdgcn_mfma_f32_32x32x16_bf16(pa2,PK(2),o[d0],0,0,0);
    o[d0]=__builtin_amdgcn_mfma_f32_32x32x16_bf16(pa3,PK(3),o[d0],0,0,0);
    #undef PK
  }
}

#ifndef ATTN_STORE16
#define ATTN_STORE16(p,v) (*(u32x4*)(p)=(v))
#endif
template<int THRL> __device__ __forceinline__ void attn_unit(int b,int h,int g,int qb,const bf16*Q,const bf16*__restrict__ K,const bf16*__restrict__ V,bf16*O,char*shm){
  const int tid=otid(),lane=tid&63,r32=lane&31,hi=lane>>5; const int wid=__builtin_amdgcn_readfirstlane(tid>>6);
  const long rowbase=(long)b*SEQ; const int q0=qb*QB;
  const bf16*Qw=Q+(rowbase+q0+wid*QBLK)*PQ+h*D;
  const bf16*Kh=K+rowbase*PQ+g*D,*Vh=V+rowbase*PQ+g*D;
  const unsigned lds0=(unsigned)(uintptr_t)shm;
  float*wsf=(float*)(shm+LDS_WS)+wid*64;
  const bf16*ksrc=Kh+(long)lane*PQ+wid*8;
  const bf16*vsrc=Vh+(long)(16*(wid&3)+(lane>>2))*PQ+(wid>>2)*32+(lane&3)*8;
  const unsigned kdst=lds0+LDS_K+wid*1024, vdst=lds0+LDS_V+wid*1024;
  #define DMA_K(t,slot) glds16(ksrc+(long)(t)*KVBLK*PQ,(unsigned)__builtin_amdgcn_readfirstlane(kdst+(slot)))
  #define DMA_V(t,slot) glds16(vsrc+(long)(t)*KVBLK*PQ,(unsigned)__builtin_amdgcn_readfirstlane(vdst+(slot)))
  const int vb0=(int)(lds0+LDS_V)+((lane>>4)&1)*32+(lane&3)*8+(4*hi+((lane&15)>>2))*64;
  const char*Kbase=shm+LDS_K; bf16x8 kf[8];
  const lds_cptr shm3=(lds_cptr)shm; const lds_cptr kp0=shm3+LDS_K+hi*1024+r32*16; const lds_cptr vp0=shm3+LDS_V+((lane>>4)&1)*32+(lane&3)*8+(4*hi+((lane&15)>>2))*64;
  constexpr int NT=SEQ/KVBLK;
  DMA_K(0,0);DMA_V(0,0);DMA_K(1,SLOTB);
  bf16x8 qr[4];
  #pragma unroll
  for(int d0=0;d0<4;++d0)qr[d0]=*reinterpret_cast<const bf16x8*>(&Qw[(long)r32*PQ+d0*16+hi*8]);
  float mhat=0.f,l_reg=0.f;f32x16 o[2];o[0]=f32x16{};o[1]=f32x16{};f32x16 negm=f32x16{};asm volatile("":"+v"(negm));
    #define CMASK(P0,P1,t) do{}while(0)
  bool resc=false;
  #define START(P0,P1) do{ const float rm=rowmax(P0,P1); resc=false; \
    { const float dl=rm; mhat=fadd_s(mhat,dl); \
      _Pragma("unroll") for(int r=0;r<16;++r){P0[r]=fsub_s(P0[r],dl);P1[r]=fsub_s(P1[r],dl);} \
      _Pragma("unroll") for(int r=0;r<16;++r)negm[r]=-mhat; asm volatile("":"+v"(negm)); } \
    _Pragma("unroll") for(int r=0;r<16;++r)P0[r]=__builtin_amdgcn_exp2f(P0[r]); }while(0)
  #define RESC() do{ if(resc){ asm volatile("s_waitcnt lgkmcnt(0)":::"memory"); \
      _Pragma("unroll") for(int d_=0;d_<2;++d_) _Pragma("unroll") for(int r=0;r<16;++r)o[d_][r]*=wsf[crow(r,hi)]; } }while(0)
  f32x16 pA0,pA1,pB0,pB1;
  int sl_prev=0,sl_cur=0,sl_next=SLOTB;
  #define ROT() do{sl_prev=sl_cur;sl_cur=sl_next;sl_next=(sl_next==(NSLOT-1)*SLOTB)?0:sl_next+SLOTB;}while(0)
  DMA_K(2,2*SLOTB);
  WAIT_BAR(3);
  qkt(pA0,pA1,Kbase,qr,negm,r32,hi);asm volatile("s_nop 15\n\ts_nop 7":"+v"(pA0),"+v"(pA1));CMASK(pA0,pA1,0);
  START(pA0,pA1);
  _Pragma("unroll") for(int r=0;r<16;++r)pA1[r]=__builtin_amdgcn_exp2f(pA1[r]);
  WAIT_BAR(0);
  DMA_K(3,0);DMA_V(1,SLOTB);
  ROT();
  kload8(kf,kp0+sl_cur);
  WAIT_BAR(2);
  s16x4 vlo[8],vhi[8]; u32x4 pw0,pw1,pw2,pw3;
  #define PKW(P,B) cvtpk_s(P[B],P[B+1])
  #define PAF(k) __builtin_bit_cast(bf16x8,pw##k)
  #define VFR(i) (bf16x8){vlo[i][0],vlo[i][1],vlo[i][2],vlo[i][3],vhi[i][0],vhi[i][1],vhi[i][2],vhi[i][3]}
  #define PIN(x) asm volatile("":"+v"(x))
  #define MX3(a,b,c) __builtin_fmaxf(__builtin_fmaxf((a),(b)),(c))
  #define GAPA(MF,A0,A1,A2,A3,W0,W1,PW) do{ MF; sacc+=A0; sacc+=A1; sacc+=A2; sacc+=A3; PIN(sacc); W0; W1; PIN(PW); SBAR(); }while(0)
  #define EX(v) __builtin_amdgcn_exp2f(v)
  #define GAPB(MF,X,B) do{ MF; X[B]=EX(X[B]); X[B+1]=EX(X[B+1]); X[B+2]=EX(X[B+2]); X[B+3]=EX(X[B+3]); PIN(X); SBAR(); }while(0)
  #define VRD(i) do{ vlo[i]=vtr(vp_+(((i)>>2)*4096+((i)&3)*1024)); vhi[i]=vtr(vp_+(((i)>>2)*4096+((i)&3)*1024+512)); }while(0)
  #define KRD(G,j) do{ if(G){ kload2(kf,kp0+sl_next,j); SBAR(); } }while(0)
  #define STEP(C0,C1,P0,P1,t,GK,GV,GL) do{ SBAR(); \
    const lds_cptr vp_=vp0+sl_prev; \
    VRD(0); SBAR(); float sacc=(P0[0]+P0[1]); \
    GAPA(C0=__builtin_amdgcn_mfma_f32_32x32x16_bf16(kf[0],qr[0],negm,0,0,0), P0[2],P0[3],P0[4],P0[5],     pw0[0]=PKW(P0,0), pw0[1]=PKW(P0,2), pw0); \
    VRD(4); SBAR(); GAPA(C1=__builtin_amdgcn_mfma_f32_32x32x16_bf16(kf[1],qr[0],negm,0,0,0), P0[6],P0[7],P0[8],P0[9],     pw0[2]=PKW(P0,4), pw0[3]=PKW(P0,6), pw0); \
    VRD(1); SBAR(); GAPA(C0=__builtin_amdgcn_mfma_f32_32x32x16_bf16(kf[2],qr[1],C0,0,0,0),   P0[10],P0[11],P0[12],P0[13], pw1[0]=PKW(P0,8), pw1[1]=PKW(P0,10), pw1); \
    VRD(5); SBAR(); GAPA(C1=__builtin_amdgcn_mfma_f32_32x32x16_bf16(kf[3],qr[1],C1,0,0,0),   P0[14],P0[15],P1[0],P1[1],   pw1[2]=PKW(P0,12),pw1[3]=PKW(P0,14), pw1); \
    VRD(2); SBAR(); GAPA(C0=__builtin_amdgcn_mfma_f32_32x32x16_bf16(kf[4],qr[2],C0,0,0,0),   P1[2],P1[3],P1[4],P1[5],     pw2[0]=PKW(P1,0), pw2[1]=PKW(P1,2), pw2); \
    VRD(6); SBAR(); GAPA(C1=__builtin_amdgcn_mfma_f32_32x32x16_bf16(kf[5],qr[2],C1,0,0,0),   P1[6],P1[7],P1[8],P1[9],     pw2[2]=PKW(P1,4), pw2[3]=PKW(P1,6), pw2); \
    VRD(3); SBAR(); GAPA(C0=__builtin_amdgcn_mfma_f32_32x32x16_bf16(kf[6],qr[3],C0,0,0,0),   P1[10],P1[11],P1[12],P1[13], pw3[0]=PKW(P1,8), pw3[1]=PKW(P1,10), pw3); \
    VRD(7); SBAR(); GAPA(C1=__builtin_amdgcn_mfma_f32_32x32x16_bf16(kf[7],qr[3],C1,0,0,0),   P1[14],P1[15],0.f,0.f,       pw3[2]=PKW(P1,12),pw3[3]=PKW(P1,14), pw3); \
    l_reg+=sacc; \
    if(GK){DMA_K((t)+3,sl_cur);} if(GV){DMA_V((t)+1,sl_next);} \
    CMASK(C0,C1,t); \
    { float a=MX3(C0[0],C0[1],C1[0]),b=MX3(C0[2],C0[3],C1[1]); a=MX3(a,C1[2],C1[3]); \
      _Pragma("unroll") for(int r=4;r<16;r+=4){a=MX3(a,C0[r],C0[r+1]);b=MX3(b,C0[r+2],C0[r+3]);a=MX3(a,C1[r],C1[r+1]);b=MX3(b,C1[r+2],C1[r+3]);} \
      float rm=__builtin_fmaxf(a,b); { auto rr=__builtin_amdgcn_permlane32_swap(__float_as_uint(rm),__float_as_uint(rm),false,false); rm=__builtin_fmaxf(__uint_as_float(rr[0]),__uint_as_float(rr[1])); } \
      resc=false; \
      if(__builtin_expect(__any(rm>(float)THRL),0)){ const float dl=__builtin_fmaxf(rm,0.f); mhat+=dl; \
        _Pragma("unroll") for(int r=0;r<16;++r){C0[r]-=dl;C1[r]-=dl;} \
        _Pragma("unroll") for(int r=0;r<16;++r)negm[r]=-mhat; asm volatile("":"+v"(negm)); \
        const float f=__builtin_amdgcn_exp2f(-dl); l_reg*=f; if(hi==0)wsf[r32]=f; resc=true; } } \
    SBAR(); \
    GAPB(o[0]=__builtin_amdgcn_mfma_f32_32x32x16_bf16(PAF(0),VFR(0),o[0],0,0,0), C0,0); \
    GAPB(o[1]=__builtin_amdgcn_mfma_f32_32x32x16_bf16(PAF(0),VFR(4),o[1],0,0,0), C0,4); \
    KRD(GL,0); GAPB(o[0]=__builtin_amdgcn_mfma_f32_32x32x16_bf16(PAF(1),VFR(1),o[0],0,0,0), C0,8); \
    KRD(GL,1); GAPB(o[1]=__builtin_amdgcn_mfma_f32_32x32x16_bf16(PAF(1),VFR(5),o[1],0,0,0), C0,12); \
    KRD(GL,2); GAPB(o[0]=__builtin_amdgcn_mfma_f32_32x32x16_bf16(PAF(2),VFR(2),o[0],0,0,0), C1,0); \
    KRD(GL,3); GAPB(o[1]=__builtin_amdgcn_mfma_f32_32x32x16_bf16(PAF(2),VFR(6),o[1],0,0,0), C1,4); \
    GAPB(o[0]=__builtin_amdgcn_mfma_f32_32x32x16_bf16(PAF(3),VFR(3),o[0],0,0,0), C1,8); \
    GAPB(o[1]=__builtin_amdgcn_mfma_f32_32x32x16_bf16(PAF(3),VFR(7),o[1],0,0,0), C1,12); \
    }while(0)
  int t=1;
  #undef CMASK
  #define CMASK(P0,P1,t) do{}while(0)
  for(;t+5<NT;t+=2){
    STEP(pB0,pB1,pA0,pA1,t,true,true,true);     WAIT_BAR(2); RESC(); ROT();
    STEP(pA0,pA1,pB0,pB1,t+1,true,true,true);   WAIT_BAR(2); RESC(); ROT();
  }
  #define ENDW(tt) do{ if((tt)+3<NT){WAIT_BAR(2);} else if((tt)+2<NT){WAIT_BAR(1);} else {WAIT_BAR(0);} }while(0)
  for(;t+1<NT;t+=2){
    STEP(pB0,pB1,pA0,pA1,t,(t+3<NT),(t+1<NT),(t+1<NT));       ENDW(t);   RESC(); ROT();
    STEP(pA0,pA1,pB0,pB1,t+1,(t+4<NT),(t+2<NT),(t+2<NT));     ENDW(t+1); RESC(); ROT();
  }
  STEP(pB0,pB1,pA0,pA1,NT-1,false,false,false); RESC();
  { float sacc=pB0[0]+pB0[1]; _Pragma("unroll") for(int r=2;r<16;++r)sacc+=pB0[r]; _Pragma("unroll") for(int r=0;r<16;++r)sacc+=pB1[r]; l_reg+=sacc;
    pw0=(u32x4){PKW(pB0,0),PKW(pB0,2),PKW(pB0,4),PKW(pB0,6)};pw1=(u32x4){PKW(pB0,8),PKW(pB0,10),PKW(pB0,12),PKW(pB0,14)};pw2=(u32x4){PKW(pB1,0),PKW(pB1,2),PKW(pB1,4),PKW(pB1,6)};pw3=(u32x4){PKW(pB1,8),PKW(pB1,10),PKW(pB1,12),PKW(pB1,14)};
    SBAR(); pv(o,vb0+sl_cur,PAF(0),PAF(1),PAF(2),PAF(3)); }
  #undef PKW
  #undef PAF
  #undef VFR
  #undef PIN
  #undef MX3
  #undef GAPA
  #undef GAPB
  #undef EX
  #undef VRD
  #undef KRD
  #undef STEP
  #undef ENDW
  {auto rr=__builtin_amdgcn_permlane32_swap(__float_as_uint(l_reg),__float_as_uint(l_reg),false,false);l_reg=__uint_as_float(rr[0])+__uint_as_float(rr[1]);}
  if(hi==0)wsf[32+r32]=l_reg;asm volatile("s_waitcnt lgkmcnt(0)":::"memory");
  float rli[16];
  #pragma unroll
  for(int r=0;r<16;++r)rli[r]=__builtin_amdgcn_rcpf(wsf[32+crow(r,hi)]);
  bf16*Ow=O+(rowbase+q0+wid*QBLK)*PO+h*D;
  { bf16*stg=(bf16*)(shm+LDS_OST)+wid*2048;
    #pragma unroll
    for(int r=0;r<16;++r){const int orow=crow(r,hi);
      #pragma unroll
      for(int d0=0;d0<2;++d0)stg[orow*64+d0*32+r32]=__float2bfloat16(o[d0][r]*rli[r]);}
    asm volatile("s_waitcnt lgkmcnt(0)":::"memory");
    #pragma unroll
    for(int i=0;i<4;++i){const int row=i*8+(lane>>3),ch=lane&7; const u32x4 v=*(const u32x4*)(stg+row*64+ch*8); ATTN_STORE16(Ow+(long)row*PO+ch*8,v);} }
  asm volatile("s_waitcnt lgkmcnt(0)\n\ts_barrier":::"memory");
  #undef DMA_K
  #undef DMA_V
  #undef CMASK
  #undef START
  #undef RESC
  #undef ROT
}
constexpr int ATTN_LDS_BYTES=LDS_BYTES;
#undef SBAR
#undef WAIT_BAR
}

__device__ __forceinline__ void phase_attn(const Params& p, char* lds) {
            {
                const int bid = obid();
                const int vcu = ((gridDim.x & 7) == 0) ? (bid & 7) * (int)(gridDim.x >> 3) + (bid >> 3) : bid;
                const attn_body::bf16* qkvb = (const attn_body::bf16*)(p.ws + R_QKV);
                for (int u = vcu; u < 512; u += gridDim.x) {
                    const int bg = (u & 255) >> 6, r = u & 63, hh = r & 3, qb = (r >> 2) + 16 * (u >> 8);
                    const int b = bg >> 1, g = bg & 1;
                    attn_body::attn_unit<8>(b, 4 * g + hh, g, qb, qkvb, qkvb + 512, qkvb + 640, (attn_body::bf16*)(p.ws + R_ATT), lds);
                }
            }
}

__device__ __forceinline__ f32x4 convd4(const float* row, int l0, float w0, float w1, float w2, float cb) {
    const f32x4 c = *(const f32x4*)(row + l0);
    const float lft = (l0 > 0) ? row[l0 - 1] : 0.f;
    const float rgt = (l0 + 4 < SL) ? row[l0 + 4] : 0.f;
    f32x4 o;
    o.x = cb + w0 * lft + w1 * c.x + w2 * c.y;
    o.y = cb + w0 * c.x + w1 * c.y + w2 * c.z;
    o.z = cb + w0 * c.y + w1 * c.z + w2 * c.w;
    o.w = cb + w0 * c.z + w1 * c.w + w2 * rgt;
    return o;
}
__device__ __forceinline__ void cmul_kf(float2* Z, const float2* KF, int tid) {
#pragma unroll 4
    for (int i = 0; i < 16; ++i) {
        const int pp = 2 * tid + 1024 * i;
        const f32x4 z = *(const f32x4*)(Z + zp(pp)), k = *(const f32x4*)(KF + pp);
        f32x4 o; o.x = z.x * k.x - z.y * k.y; o.y = z.x * k.y + z.y * k.x; o.z = z.z * k.z - z.w * k.w; o.w = z.z * k.w + z.w * k.z;
        *(f32x4*)(Z + zp(pp)) = o;
    }
}
__device__ __forceinline__ void hyena_job(const Params& p, int layer, int c, char* lds) {
    const int tid = otid();
    float2* Z = (float2*)lds;
    const float* HF = (const float*)(p.ws + R_HF);
    const float* cw = p.in[I_CW] + (size_t)layer * 3 * 768; const float* cbp = p.in[I_CB] + layer * 768;
    const float2* KF0 = (const float2*)(p.ws + OFF_KF) + ((size_t)(layer * 256 + c) * 2) * 16384;
    const float2* KF1 = KF0 + 16384;
    float* Y = (float*)(p.ws + R_Y) + (size_t)c * T;
    const float bias0 = p.in[I_HB][(layer * 2 + 0) * 256 + c], bias1 = p.in[I_HB][(layer * 2 + 1) * 256 + c];
    const int cv = c, c1 = 256 + c, c2 = 512 + c;
    const float* rv = HF + (size_t)cv * T; const float* r1 = HF + (size_t)c1 * T; const float* r2 = HF + (size_t)c2 * T;
    const float v_w0 = cw[cv], v_w1 = cw[768 + cv], v_w2 = cw[1536 + cv], v_cb = cbp[cv];
    const float a_w0 = cw[c1], a_w1 = cw[768 + c1], a_w2 = cw[1536 + c1], a_cb = cbp[c1];
    const float b_w0 = cw[c2], b_w1 = cw[768 + c2], b_w2 = cw[1536 + c2], b_cb = cbp[c2];
    const f32x4 zero4 = {0.f, 0.f, 0.f, 0.f};
    __syncthreads();
#pragma unroll 1
    for (int i = 0; i < 4; ++i) {
        const int l0 = 4 * otid() + 2048 * i;
        const f32x4 va = convd4(rv, l0, v_w0, v_w1, v_w2, v_cb), vb = convd4(rv + SL, l0, v_w0, v_w1, v_w2, v_cb);
        *(f32x4*)(Z + zp(l0)) = (f32x4){va.x, vb.x, va.y, vb.y}; *(f32x4*)(Z + zp(l0) + 2) = (f32x4){va.z, vb.z, va.w, vb.w};
        *(f32x4*)(Z + zp(8192 + l0)) = zero4; *(f32x4*)(Z + zp(8192 + l0) + 2) = zero4;
    }
    __syncthreads();
    fft16k_fwd(Z);
    cmul_kf(Z, KF0, otid());
    __syncthreads();
    fft16k_inv(Z);
#pragma unroll 1
    for (int i = 0; i < 4; ++i) {
        const int l0 = 4 * otid() + 2048 * i;
        const f32x4 za = *(const f32x4*)(Z + zp(l0)), zb = *(const f32x4*)(Z + zp(l0) + 2);
        const f32x4 va = convd4(rv, l0, v_w0, v_w1, v_w2, v_cb), vb = convd4(rv + SL, l0, v_w0, v_w1, v_w2, v_cb);
        const f32x4 ga = convd4(r1, l0, a_w0, a_w1, a_w2, a_cb), gb = convd4(r1 + SL, l0, a_w0, a_w1, a_w2, a_cb);
        f32x4 ya, yb;
        ya.x = ga.x * (za.x + va.x * bias0); ya.y = ga.y * (za.z + va.y * bias0); ya.z = ga.z * (zb.x + va.z * bias0); ya.w = ga.w * (zb.z + va.w * bias0);
        yb.x = gb.x * (za.y + vb.x * bias0); yb.y = gb.y * (za.w + vb.y * bias0); yb.z = gb.z * (zb.y + vb.z * bias0); yb.w = gb.w * (zb.w + vb.w * bias0);
        *(f32x4*)(Y + l0) = ya; *(f32x4*)(Y + SL + l0) = yb;
        *(f32x4*)(Z + zp(l0)) = (f32x4){ya.x, yb.x, ya.y, yb.y}; *(f32x4*)(Z + zp(l0) + 2) = (f32x4){ya.z, yb.z, ya.w, yb.w};
        *(f32x4*)(Z + zp(8192 + l0)) = zero4; *(f32x4*)(Z + zp(8192 + l0) + 2) = zero4;
    }
    __syncthreads();
    fft16k_fwd(Z);
    cmul_kf(Z, KF1, otid());
    __syncthreads();
    fft16k_inv(Z);
#pragma unroll 1
    for (int i = 0; i < 4; ++i) {
        const int l0 = 4 * otid() + 2048 * i;
        const f32x4 za = *(const f32x4*)(Z + zp(l0)), zb = *(const f32x4*)(Z + zp(l0) + 2);
        const f32x4 ga = convd4(r2, l0, b_w0, b_w1, b_w2, b_cb), gb = convd4(r2 + SL, l0, b_w0, b_w1, b_w2, b_cb);
        const f32x4 pa = *(const f32x4*)(Y + l0), pb = *(const f32x4*)(Y + SL + l0);
        f32x4 ya, yb;
        ya.x = ga.x * (za.x + pa.x * bias1); ya.y = ga.y * (za.z + pa.y * bias1); ya.z = ga.z * (zb.x + pa.z * bias1); ya.w = ga.w * (zb.z + pa.w * bias1);
        yb.x = gb.x * (za.y + pb.x * bias1); yb.y = gb.y * (za.w + pb.y * bias1); yb.z = gb.z * (zb.y + pb.z * bias1); yb.w = gb.w * (zb.w + pb.w * bias1);
        *(f32x4*)(Y + l0) = ya; *(f32x4*)(Y + SL + l0) = yb;
    }
    __syncthreads();
}

__device__ __forceinline__ void fnet_job(const Params& p, int ch, char* lds) {
    const int tid = otid();
    float2* Z = (float2*)lds;
    const float* row = (const float*)(p.ws + R_HF) + (size_t)(768 + ch) * T;
    float* UR = (float*)(p.ws + R_UR) + (size_t)ch * T;
    float* UI = (float*)(p.ws + R_UI) + (size_t)ch * T;
    __syncthreads();
#pragma unroll
    for (int i = 0; i < 4; ++i) {
        const int l0 = 4 * tid + 2048 * i;
        const f32x4 a = *(const f32x4*)(row + l0), b = *(const f32x4*)(row + SL + l0);
        const int z0 = zp(l0);
        *(f32x4*)(Z + z0) = (f32x4){a.x, b.x, a.y, b.y}; *(f32x4*)(Z + z0 + 2) = (f32x4){a.z, b.z, a.w, b.w};
    }
    __syncthreads();
    fft8k_fwd(Z);
#pragma unroll
    for (int i = 0; i < 4; ++i) {
        const int k0 = 4 * tid + 2048 * i;
        f32x4 ur0, ui0, ur1, ui1;
#pragma unroll
        for (int e = 0; e < 4; ++e) {
            const int k = k0 + e;
            const int pk = p8k_of_f(k);
            const int pm = p8k_of_f((SL - k) & (SL - 1));
            const float2 zk = Z[zp(pk)], zm = Z[zp(pm)];
            ur0[e] = 0.5f * (zk.x + zm.x); ui0[e] = 0.5f * (zk.y - zm.y);
            ur1[e] = 0.5f * (zk.y + zm.y); ui1[e] = 0.5f * (zm.x - zk.x);
        }
        *(f32x4*)(UR + k0) = ur0; *(f32x4*)(UI + k0) = ui0; *(f32x4*)(UR + SL + k0) = ur1; *(f32x4*)(UI + SL + k0) = ui1;
    }
    __syncthreads();
}

__device__ __forceinline__ void phase_mix(const Params& p, int layer, char* lds) {
    const int tid = otid(), lane = tid & 63, wave = tid >> 6;
    const int l31 = lane & 31, hl = lane >> 5, g = wave & 3, tsel = wave >> 2;
    float* ex = (float*)lds;
    const float* UR = (const float*)(p.ws + R_UR); const float* UI = (const float*)(p.ws + R_UI);
    const float* Y = (const float*)(p.ws + R_Y);
    const bf16_t* att = (const bf16_t*)(p.ws + R_ATT);
    bf16_t* mix = (bf16_t*)(p.ws + R_MIX);
    const float* FMg = (const float*)(p.ws + OFF_FM) + ((size_t)layer * 4 + g) * 128 * 64;
    const float* fb = p.in[I_FB] + layer * 256 + g * 64;
    const float* mg = p.in[I_MG] + layer * 1024;
    for (int tp = obid(); tp < T / 64; tp += gridDim.x) {
        const int t = (tp * 2 + tsel) * 32 + l31;
        f32x16 acc0 = zero16(), acc1 = zero16();
        {
            const float* ub = UR + (size_t)(g * 64 + hl) * T + t;
            const float* fa = FMg + hl * 64 + l31;
#pragma unroll 16
            for (int dd0 = 0; dd0 < 64; dd0 += 2) {
                const float bv = ub[(size_t)dd0 * T];
                const float a0 = fa[dd0 * 64], a1 = fa[dd0 * 64 + 32];
                acc0 = __builtin_amdgcn_mfma_f32_32x32x2f32(a0, bv, acc0, 0, 0, 0);
                acc1 = __builtin_amdgcn_mfma_f32_32x32x2f32(a1, bv, acc1, 0, 0, 0);
            }
            const float* ub2 = UI + (size_t)(g * 64 + hl) * T + t;
            const float* fa2 = FMg + (64 + hl) * 64 + l31;
#pragma unroll 16
            for (int dd0 = 0; dd0 < 64; dd0 += 2) {
                const float bv = ub2[(size_t)dd0 * T];
                const float a0 = fa2[dd0 * 64], a1 = fa2[dd0 * 64 + 32];
                acc0 = __builtin_amdgcn_mfma_f32_32x32x2f32(a0, bv, acc0, 0, 0, 0);
                acc1 = __builtin_amdgcn_mfma_f32_32x32x2f32(a1, bv, acc1, 0, 0, 0);
            }
        }
        float sf = 0.f;
#pragma unroll
        for (int i = 0; i < 4; ++i) {
            const f32x4 b0 = *(const f32x4*)(fb + 8 * i + 4 * hl), b1 = *(const f32x4*)(fb + 32 + 8 * i + 4 * hl);
            acc0[4 * i] += b0.x; acc0[4 * i + 1] += b0.y; acc0[4 * i + 2] += b0.z; acc0[4 * i + 3] += b0.w;
            acc1[4 * i] += b1.x; acc1[4 * i + 1] += b1.y; acc1[4 * i + 2] += b1.z; acc1[4 * i + 3] += b1.w;
        }
#pragma unroll
        for (int r = 0; r < 16; ++r) sf += acc0[r] * acc0[r] + acc1[r] * acc1[r];
        float sy = 0.f;
        const float* yb = Y + (size_t)(g * 64 + hl * 32) * T + t;
#pragma unroll 32
        for (int i = 0; i < 32; ++i) { const float y = yb[(size_t)i * T]; sy += y * y; }
        float sa = 0.f;
        const bf16_t* ab = att + (size_t)t * 512 + g * 128 + hl * 64;
#pragma unroll 4
        for (int q = 0; q < 8; ++q) {
            const u32x4 a = *(const u32x4*)(ab + 8 * q);
            const float x0 = bflo(a.x), x1 = bfhi(a.x), x2 = bflo(a.y), x3 = bfhi(a.y), x4 = bflo(a.z), x5 = bfhi(a.z), x6 = bflo(a.w), x7 = bfhi(a.w);
            sa += x0 * x0 + x1 * x1 + x2 * x2 + x3 * x3 + x4 * x4 + x5 * x5 + x6 * x6 + x7 * x7;
        }
        __syncthreads();
        ex[(0 * 8 + wave) * 64 + lane] = sa; ex[(1 * 8 + wave) * 64 + lane] = sy; ex[(2 * 8 + wave) * 64 + lane] = sf;
        __syncthreads();
        float ta = 0.f, ty = 0.f, tf = 0.f;
#pragma unroll
        for (int w = 0; w < 4; ++w)
#pragma unroll
            for (int hh = 0; hh < 2; ++hh) {
                const int o = (tsel * 4 + w) * 64 + hh * 32 + l31;
                ta += ex[0 * 512 + o]; ty += ex[1 * 512 + o]; tf += ex[2 * 512 + o];
            }
        const float ra = rsqrtf(ta * (1.0f / 512.0f) + EPS), ry = rsqrtf(ty * (1.0f / 256.0f) + EPS), rf = rsqrtf(tf * (1.0f / 256.0f) + EPS);
        bf16_t* mrow = mix + (size_t)t * 1024;
        {
            const float* gg = mg + g * 128 + hl * 64;
#pragma unroll 4
            for (int q = 0; q < 8; ++q) {
                const u32x4 a = *(const u32x4*)(ab + 8 * q);
                const f32x4 g0 = *(const f32x4*)(gg + 8 * q), g1 = *(const f32x4*)(gg + 8 * q + 4);
                u32x4 o;
                o.x = pk2(bflo(a.x) * ra * g0.x, bfhi(a.x) * ra * g0.y); o.y = pk2(bflo(a.y) * ra * g0.z, bfhi(a.y) * ra * g0.w);
                o.z = pk2(bflo(a.z) * ra * g1.x, bfhi(a.z) * ra * g1.y); o.w = pk2(bflo(a.w) * ra * g1.z, bfhi(a.w) * ra * g1.w);
                *(u32x4*)(mrow + g * 128 + hl * 64 + 8 * q) = o;
            }
        }
        {
            const float* gg = mg + 512 + g * 64 + hl * 32;
#pragma unroll 2
            for (int q = 0; q < 4; ++q) {
                float yv[8];
#pragma unroll
                for (int i = 0; i < 8; ++i) yv[i] = yb[(size_t)(8 * q + i) * T];
                const f32x4 g0 = *(const f32x4*)(gg + 8 * q), g1 = *(const f32x4*)(gg + 8 * q + 4);
                u32x4 o;
                o.x = pk2(yv[0] * ry * g0.x, yv[1] * ry * g0.y); o.y = pk2(yv[2] * ry * g0.z, yv[3] * ry * g0.w);
                o.z = pk2(yv[4] * ry * g1.x, yv[5] * ry * g1.y); o.w = pk2(yv[6] * ry * g1.z, yv[7] * ry * g1.w);
                *(u32x4*)(mrow + 512 + g * 64 + hl * 32 + 8 * q) = o;
            }
        }
        {
            const float* gg = mg + 768 + g * 64;
#pragma unroll
            for (int i = 0; i < 4; ++i) {
                const f32x4 g0 = *(const f32x4*)(gg + 8 * i + 4 * hl), g1 = *(const f32x4*)(gg + 32 + 8 * i + 4 * hl);
                u32x2 o0, o1;
                o0.x = pk2(acc0[4 * i] * rf * g0.x, acc0[4 * i + 1] * rf * g0.y); o0.y = pk2(acc0[4 * i + 2] * rf * g0.z, acc0[4 * i + 3] * rf * g0.w);
                o1.x = pk2(acc1[4 * i] * rf * g1.x, acc1[4 * i + 1] * rf * g1.y); o1.y = pk2(acc1[4 * i + 2] * rf * g1.z, acc1[4 * i + 3] * rf * g1.w);
                *(u32x2*)(mrow + 768 + g * 64 + 8 * i + 4 * hl) = o0;
                *(u32x2*)(mrow + 768 + g * 64 + 32 + 8 * i + 4 * hl) = o1;
            }
        }
    }
}

#define TK_INS(L, X) do { float x_ = (X); _Pragma("unroll") for (int i_ = 0; i_ < 16; ++i_) { const float hi_ = fmaxf(L[i_], x_); x_ = fminf(L[i_], x_); L[i_] = hi_; } } while (0)
__device__ __forceinline__ float tk_pack(float v, unsigned code, unsigned mask) { return __builtin_bit_cast(float, (__builtin_bit_cast(unsigned, v) & ~mask) | code); }
__device__ __forceinline__ unsigned tk_lookup(const unsigned (&P)[4], unsigned i) {
    const unsigned w = (i < 4u) ? P[0] : (i < 8u) ? P[1] : (i < 12u) ? P[2] : P[3];
    return (w >> ((i & 3u) * 8u)) & 0x7Fu;
}
__device__ __forceinline__ void phase_peer_topk(const Params& p, int layer, char* lds, int* IDX, float* GATE) {
    const int tid = otid(), lane = tid & 63, wave = tid >> 6;
    const float* SC = (const float*)(p.ws + R_QP);
    const float NINF = -3.0e38f;
    const int pp = lane & 1;
    const int gw = obid() * NWAVE + wave, ngw = gridDim.x * NWAVE;
    for (int grp = gw; grp < T * 8 / 32; grp += ngw) {
        const int prob = grp * 32 + (lane >> 1);
        const int t = prob >> 3, h = prob & 7;
        const f32x4* src = (const f32x4*)(SC + (size_t)t * 2048 + h * 256 + pp * 128);
        float l[16];
#pragma unroll
        for (int i = 0; i < 16; ++i) l[i] = NINF;
#pragma unroll 1
        for (int c = 0; c < 4; ++c) {
            f32x4 v[8];
#pragma unroll
            for (int j = 0; j < 8; ++j) v[j] = src[c * 8 + j];
#pragma unroll
            for (int j = 0; j < 8; ++j) {
                const unsigned kb = (unsigned)(c * 32 + j * 4);
                TK_INS(l, tk_pack(v[j].x, kb, 0x7Fu)); TK_INS(l, tk_pack(v[j].y, kb + 1u, 0x7Fu));
                TK_INS(l, tk_pack(v[j].z, kb + 2u, 0x7Fu)); TK_INS(l, tk_pack(v[j].w, kb + 3u, 0x7Fu));
            }
        }
        float xv[16], ov[16]; unsigned PX[4] = {0u, 0u, 0u, 0u}, PO[4] = {0u, 0u, 0u, 0u};
#pragma unroll
        for (int i = 0; i < 16; ++i) {
            const float o = __shfl_xor(l[i], 1);
            const unsigned xb = __builtin_bit_cast(unsigned, l[i]), ob = __builtin_bit_cast(unsigned, o);
            xv[i] = __builtin_bit_cast(float, xb & ~0x7Fu); ov[i] = __builtin_bit_cast(float, ob & ~0x7Fu);
            PX[i >> 2] |= (xb & 0x7Fu) << ((i & 3) * 8); PO[i >> 2] |= (ob & 0x7Fu) << ((i & 3) * 8);
        }
        float f[16];
#pragma unroll
        for (int i = 0; i < 16; ++i) f[i] = NINF;
#pragma unroll
        for (int i = 0; i < 16; ++i)
#pragma unroll
            for (int j = i; j < 16; ++j)
                if ((i + 1) * (j + 1) <= 16) {
                    float cv = xv[i] + ov[j];
                    const unsigned code = pp ? (unsigned)((j << 4) | i) : (unsigned)((i << 4) | j);
                    cv = tk_pack(cv, code, 0xFFu);
                    if (i == j) cv = pp ? NINF : cv;
                    TK_INS(f, cv);
                }
        {
            float g[16];
#pragma unroll
            for (int i = 0; i < 16; ++i) g[i] = __shfl_xor(f[i], 1);
#pragma unroll
            for (int i = 0; i < 16; ++i) TK_INS(f, g[i]);
        }
        unsigned P0[4], P1[4];
#pragma unroll
        for (int q = 0; q < 4; ++q) { P0[q] = pp ? PO[q] : PX[q]; P1[q] = pp ? PX[q] : PO[q]; }
        const float top = __builtin_bit_cast(float, __builtin_bit_cast(unsigned, f[0]) & ~0xFFu);
        float ev[16]; int ei[16]; float den = 0.f;
#pragma unroll
        for (int r = 0; r < 16; ++r) {
            const unsigned fb = __builtin_bit_cast(unsigned, f[r]);
            const unsigned code = fb & 0xFFu;
            ei[r] = (int)(tk_lookup(P0, code >> 4) * 128u + tk_lookup(P1, code & 15u));
            ev[r] = __expf(__builtin_bit_cast(float, fb & ~0xFFu) - top);
            den += ev[r];
        }
        const float rden = 1.0f / den;
        const size_t ob = (size_t)t * 2048 + h * 16;
        if (pp == 0) {
#pragma unroll
            for (int q = 0; q < 4; ++q) { int4 w; w.x = ei[4 * q]; w.y = ei[4 * q + 1]; w.z = ei[4 * q + 2]; w.w = ei[4 * q + 3]; *(int4*)(IDX + ob + 4 * q) = w; }
        } else {
#pragma unroll
            for (int q = 0; q < 4; ++q) { f32x4 w; w.x = ev[4 * q] * rden; w.y = ev[4 * q + 1] * rden; w.z = ev[4 * q + 2] * rden; w.w = ev[4 * q + 3] * rden; *(f32x4*)(GATE + ob + 128 + 4 * q) = w; }
        }
    }
}

__device__ __forceinline__ float gelu_exact(float x) { return 0.5f * x * (1.0f + erff(x * 0.70710678118654752f)); }
typedef float f32x2 __attribute__((ext_vector_type(2)));
#define CVT_LO(W) __builtin_amdgcn_cvt_pk_f32_fp8((int)(W), false)
#define CVT_HI(W) __builtin_amdgcn_cvt_pk_f32_fp8((int)(W), true)
template <bool DRY, int EMASK = 16383> __device__ __forceinline__ void phase_peer_gather(const Params& p, int layer) {
    const int lane = otid() & 63, wave = otid() >> 6;
    const int gw = obid() * NWAVE + wave, ngw = gridDim.x * NWAVE;
    const unsigned char* PU = p.ws + OFF_PU + (size_t)layer * 16384 * 1024;
    const unsigned char* PV = p.ws + OFF_PV + (size_t)layer * 16384 * 1024;
    const float* SU = (const float*)(p.ws + OFF_PSC) + (size_t)layer * 16384;
    const float* SV = (const float*)(p.ws + OFF_PSC) + (size_t)(2 + layer) * 16384;
    bf16_t* XN = (bf16_t*)(p.ws + R_XN);
    float* XA = (float*)(p.ws + OFF_XA);
    const float* SC = (const float*)(p.ws + R_QP);
    const bool last = (layer == NLAYER - 1);
    const float* gnext = last ? p.in[I_FG] : p.in[I_N1G] + (layer + 1) * DM;
    const bool b5 = (lane & 32) != 0, b4 = (lane & 16) != 0, b3 = (lane & 8) != 0;
    const unsigned loff = (unsigned)lane * 16u;
    for (int t = gw; t < T; t += ngw) {
        f32x2 xv[8];
#pragma unroll
        for (int j = 0; j < 4; ++j) {
            const u32x2 a = *(const u32x2*)(XN + (size_t)t * DM + 4 * lane + 256 * j);
            xv[2 * j] = (f32x2){bflo(a.x), bfhi(a.x)}; xv[2 * j + 1] = (f32x2){bflo(a.y), bfhi(a.y)};
        }
        f32x2 acc[8];
#pragma unroll
        for (int j = 0; j < 8; ++j) acc[j] = (f32x2){0.f, 0.f};
        const int* idxp = (const int*)(SC + (size_t)t * 2048);
        const float* gatep = SC + (size_t)t * 2048 + 128;
#pragma unroll 1
        for (int half = 0; half < 2; ++half) {
            const int myi = idxp[half * 64 + lane] & EMASK;
            const float mycu = SU[myi];
            const float mycg = gatep[half * 64 + lane] * SV[myi];
#pragma unroll 1
            for (int e0 = 0; e0 < 64; e0 += 8) {
                u32x4 ur[8], vr[8];
#pragma unroll
                for (int k = 0; k < 8; ++k) {
                    const unsigned e = (unsigned)__builtin_amdgcn_readlane(myi, e0 + k);
                    ur[k] = *(const u32x4*)(PU + (size_t)(e * 1024u) + loff);
                    vr[k] = *(const u32x4*)(PV + (size_t)(e * 1024u) + loff);
                }
                float d[8];
#pragma unroll
                for (int k = 0; k < 8; ++k) {
                    f32x2 s2 = CVT_LO(ur[k].x) * xv[0];
                    s2 += CVT_HI(ur[k].x) * xv[1]; s2 += CVT_LO(ur[k].y) * xv[2]; s2 += CVT_HI(ur[k].y) * xv[3];
                    s2 += CVT_LO(ur[k].z) * xv[4]; s2 += CVT_HI(ur[k].z) * xv[5]; s2 += CVT_LO(ur[k].w) * xv[6]; s2 += CVT_HI(ur[k].w) * xv[7];
                    d[k] = s2.x + s2.y;
                }
                float r4[4], r2[2], u1;
#pragma unroll
                for (int k = 0; k < 4; ++k) { const float send = b5 ? d[k] : d[k + 4], keep = b5 ? d[k + 4] : d[k]; r4[k] = keep + __shfl_xor(send, 32); }
#pragma unroll
                for (int k = 0; k < 2; ++k) { const float send = b4 ? r4[k] : r4[k + 2], keep = b4 ? r4[k + 2] : r4[k]; r2[k] = keep + __shfl_xor(send, 16); }
                { const float send = b3 ? r2[0] : r2[1], keep = b3 ? r2[1] : r2[0]; u1 = keep + __shfl_xor(send, 8); }
                u1 += __shfl_xor(u1, 4); u1 += __shfl_xor(u1, 2); u1 += __shfl_xor(u1, 1);
                const int kk = e0 + (lane >> 3);
                const float av = gelu_exact(u1 * __shfl(mycu, kk)) * __shfl(mycg, kk);
#pragma unroll
                for (int k = 0; k < 8; ++k) {
                    const float a = __builtin_bit_cast(float, __builtin_amdgcn_readlane(__builtin_bit_cast(int, av), 8 * k));
                    const f32x2 a2 = (f32x2){a, a};
                    acc[0] += a2 * CVT_LO(vr[k].x); acc[1] += a2 * CVT_HI(vr[k].x); acc[2] += a2 * CVT_LO(vr[k].y); acc[3] += a2 * CVT_HI(vr[k].y);
                    acc[4] += a2 * CVT_LO(vr[k].z); acc[5] += a2 * CVT_HI(vr[k].z); acc[6] += a2 * CVT_LO(vr[k].w); acc[7] += a2 * CVT_HI(vr[k].w);
                }
            }
        }
        f32x4 x[4]; float ss = 0.f;
#pragma unroll
        for (int j = 0; j < 4; ++j) {
            x[j] = *(const f32x4*)(XA + (size_t)t * DM + 4 * lane + 256 * j);
            x[j].x += acc[2 * j].x; x[j].y += acc[2 * j].y; x[j].z += acc[2 * j + 1].x; x[j].w += acc[2 * j + 1].y;
            ss += x[j].x * x[j].x + x[j].y * x[j].y + x[j].z * x[j].z + x[j].w * x[j].w;
        }
        ss = wave_sum(ss);
        const float r = rsqrtf(ss * (1.0f / DM) + EPS);
        if (last) {
#pragma unroll
            for (int j = 0; j < 4; ++j) { const f32x4 gg = *(const f32x4*)(gnext + 4 * lane + 256 * j); *(f32x4*)(p.out + (size_t)t * DM + 4 * lane + 256 * j) = x[j] * r * gg; }
        } else {
#pragma unroll
            for (int j = 0; j < 4; ++j) {
                const f32x4 gg = *(const f32x4*)(gnext + 4 * lane + 256 * j);
                *(f32x4*)((DRY ? p.out : XA) + (size_t)t * DM + 4 * lane + 256 * j) = x[j];
                u32x2 w; w.x = pk2(x[j].x * r * gg.x, x[j].y * r * gg.y); w.y = pk2(x[j].z * r * gg.z, x[j].w * r * gg.w);
                if (!DRY) *(u32x2*)(XN + (size_t)t * DM + 4 * lane + 256 * j) = w;
            }
        }
    }
}

#ifndef PE_NTK
#define PE_NTK 2
#endif
#ifndef PE_PASS_SYNC
#define PE_PASS_SYNC 0
#endif
constexpr int PE_ENT = 12 * 1024;
constexpr int PE_WAVE = PE_ENT + 1024;
#define PE_TOKEN_CHUNK(TK) do { \
    const int s_ = st[(sr * PE_NTK + (TK)) * 32 + r], e_ = st[(sr * PE_NTK + (TK)) * 32 + r + 1]; \
    for (int pos = s_; pos < e_; pos += 8) { \
        const int n = (e_ - pos < 8) ? (e_ - pos) : 8; \
        const int ei_ = pos + (lane >> 3); \
        const bool ok_ = (lane >> 3) < n; \
        const int base_ = ((sr * PE_NTK + (TK)) * 128 + (ok_ ? ei_ : pos)) * 3; \
        const int ev = ent[base_]; const float cu = __builtin_bit_cast(float, ent[base_ + 1]), cg = __builtin_bit_cast(float, ent[base_ + 2]); \
        f32x2 xl[8]; \
        _Pragma("unroll") for (int j = 0; j < 4; ++j) { xl[2 * j] = (f32x2){bflo(xp[TK][j].x), bfhi(xp[TK][j].x)}; xl[2 * j + 1] = (f32x2){bflo(xp[TK][j].y), bfhi(xp[TK][j].y)}; } \
        u32x4 ur[8], vr[8]; \
        _Pragma("unroll") for (int k = 0; k < 8; ++k) { \
            if (k < n) { const unsigned e = (unsigned)__builtin_amdgcn_readlane(ev, 8 * k); \
                ur[k] = *(const u32x4*)(PU + (size_t)(e * 1024u) + loff); vr[k] = *(const u32x4*)(PV + (size_t)(e * 1024u) + loff); } \
            else { ur[k] = (u32x4){0u, 0u, 0u, 0u}; vr[k] = (u32x4){0u, 0u, 0u, 0u}; } } \
        float d[8]; \
        _Pragma("unroll") for (int k = 0; k < 8; ++k) { \
            if (k < n) { f32x2 s2 = CVT_LO(ur[k].x) * xl[0]; \
                s2 += CVT_HI(ur[k].x) * xl[1]; s2 += CVT_LO(ur[k].y) * xl[2]; s2 += CVT_HI(ur[k].y) * xl[3]; \
                s2 += CVT_LO(ur[k].z) * xl[4]; s2 += CVT_HI(ur[k].z) * xl[5]; s2 += CVT_LO(ur[k].w) * xl[6]; s2 += CVT_HI(ur[k].w) * xl[7]; \
                d[k] = s2.x + s2.y; } else d[k] = 0.f; } \
        float r4[4], r2[2], u1; \
        _Pragma("unroll") for (int k = 0; k < 4; ++k) { const float send = b5 ? d[k] : d[k + 4], keep = b5 ? d[k + 4] : d[k]; r4[k] = keep + __shfl_xor(send, 32); } \
        _Pragma("unroll") for (int k = 0; k < 2; ++k) { const float send = b4 ? r4[k] : r4[k + 2], keep = b4 ? r4[k + 2] : r4[k]; r2[k] = keep + __shfl_xor(send, 16); } \
        { const float send = b3 ? r2[0] : r2[1], keep = b3 ? r2[1] : r2[0]; u1 = keep + __shfl_xor(send, 8); } \
        u1 += __shfl_xor(u1, 4); u1 += __shfl_xor(u1, 2); u1 += __shfl_xor(u1, 1); \
        const float av = ok_ ? gelu_exact(u1 * cu) * cg : 0.f; \
        _Pragma("unroll") for (int k = 0; k < 8; ++k) { \
            if (k < n) { const float a = __builtin_bit_cast(float, __builtin_amdgcn_readlane(__builtin_bit_cast(int, av), 8 * k)); \
                const f32x2 a2 = (f32x2){a, a}; \
                acc[TK][0] += a2 * CVT_LO(vr[k].x); acc[TK][1] += a2 * CVT_HI(vr[k].x); acc[TK][2] += a2 * CVT_LO(vr[k].y); acc[TK][3] += a2 * CVT_HI(vr[k].y); \
                acc[TK][4] += a2 * CVT_LO(vr[k].z); acc[TK][5] += a2 * CVT_HI(vr[k].z); acc[TK][6] += a2 * CVT_LO(vr[k].w); acc[TK][7] += a2 * CVT_HI(vr[k].w); } } \
    } } while (0)

template <bool DRY> __device__ __forceinline__ void phase_peer_fused(const Params& p, int layer, char* lds) {
    const int tid = otid(), lane = tid & 63, wave = tid >> 6;
    const unsigned char* PU = p.ws + OFF_PU + (size_t)layer * 16384 * 1024;
    const unsigned char* PV = p.ws + OFF_PV + (size_t)layer * 16384 * 1024;
    const float* SU = (const float*)(p.ws + OFF_PSC) + (size_t)layer * 16384;
    const float* SV = (const float*)(p.ws + OFF_PSC) + (size_t)(2 + layer) * 16384;
    bf16_t* XN = (bf16_t*)(p.ws + R_XN);
    float* XA = (float*)(p.ws + OFF_XA);
    const float* SC = (const float*)(p.ws + R_QP);
    const bool last = (layer == NLAYER - 1);
    const float* gnext = last ? p.in[I_FG] : p.in[I_N1G] + (layer + 1) * DM;
    const bool b5 = (lane & 32) != 0, b4 = (lane & 16) != 0, b3 = (lane & 8) != 0;
    const unsigned loff = (unsigned)lane * 16u;
    int* ent = (int*)(lds + wave * PE_WAVE);
    int* st = (int*)(lds + wave * PE_WAVE + PE_ENT);
    const float NINF = -3.0e38f;
    const int pp = lane & 1;
    for (int tb = (obid() * NWAVE + wave) * 8; tb < T; tb += gridDim.x * NWAVE * 8) {
#pragma unroll 1
        for (int grp = 0; grp < 2; ++grp) {
            const int tkl = grp * 4 + (lane >> 4), h = (lane >> 1) & 7;
            const f32x4* src = (const f32x4*)(SC + (size_t)(tb + tkl) * 2048 + h * 256 + pp * 128);
            float l[16];
#pragma unroll
            for (int i = 0; i < 16; ++i) l[i] = NINF;
#pragma unroll 1
            for (int c = 0; c < 4; ++c) {
                f32x4 v[8];
#pragma unroll
                for (int j = 0; j < 8; ++j) v[j] = src[c * 8 + j];
#pragma unroll
                for (int j = 0; j < 8; ++j) {
                    const unsigned kb = (unsigned)(c * 32 + j * 4);
                    TK_INS(l, tk_pack(v[j].x, kb, 0x7Fu)); TK_INS(l, tk_pack(v[j].y, kb + 1u, 0x7Fu));
                    TK_INS(l, tk_pack(v[j].z, kb + 2u, 0x7Fu)); TK_INS(l, tk_pack(v[j].w, kb + 3u, 0x7Fu));
                }
            }
            float xw[16], ow[16]; unsigned PX[4] = {0u, 0u, 0u, 0u}, PO[4] = {0u, 0u, 0u, 0u};
#pragma unroll
            for (int i = 0; i < 16; ++i) {
                const float o = __shfl_xor(l[i], 1);
                const unsigned xb = __builtin_bit_cast(unsigned, l[i]), ob = __builtin_bit_cast(unsigned, o);
                xw[i] = __builtin_bit_cast(float, xb & ~0x7Fu); ow[i] = __builtin_bit_cast(float, ob & ~0x7Fu);
                PX[i >> 2] |= (xb & 0x7Fu) << ((i & 3) * 8); PO[i >> 2] |= (ob & 0x7Fu) << ((i & 3) * 8);
            }
            float f[16];
#pragma unroll
            for (int i = 0; i < 16; ++i) f[i] = NINF;
#pragma unroll
            for (int i = 0; i < 16; ++i)
#pragma unroll
                for (int j = i; j < 16; ++j)
                    if ((i + 1) * (j + 1) <= 16) {
                        float cv = xw[i] + ow[j];
                        const unsigned code = pp ? (unsigned)((j << 4) | i) : (unsigned)((i << 4) | j);
                        cv = tk_pack(cv, code, 0xFFu);
                        if (i == j) cv = pp ? NINF : cv;
                        TK_INS(f, cv);
                    }
            {
                float gq[16];
#pragma unroll
                for (int i = 0; i < 16; ++i) gq[i] = __shfl_xor(f[i], 1);
#pragma unroll
                for (int i = 0; i < 16; ++i) TK_INS(f, gq[i]);
            }
            unsigned P0[4], P1[4];
#pragma unroll
            for (int q = 0; q < 4; ++q) { P0[q] = pp ? PO[q] : PX[q]; P1[q] = pp ? PX[q] : PO[q]; }
            const float top = __builtin_bit_cast(float, __builtin_bit_cast(unsigned, f[0]) & ~0xFFu);
            float ev[16]; float den = 0.f;
#pragma unroll
            for (int r = 0; r < 16; ++r) { ev[r] = __expf(__builtin_bit_cast(float, __builtin_bit_cast(unsigned, f[r]) & ~0xFFu) - top); den += ev[r]; }
            const float rden = 1.0f / den;
#pragma unroll
            for (int r8 = 0; r8 < 8; ++r8) {
                const unsigned c0 = __builtin_bit_cast(unsigned, f[r8]) & 0xFFu, c1 = __builtin_bit_cast(unsigned, f[r8 + 8]) & 0xFFu;
                const unsigned code = pp ? c1 : c0;
                const float gate = (pp ? ev[r8 + 8] : ev[r8]) * rden;
                const int e = (int)(tk_lookup(P0, code >> 4) * 128u + tk_lookup(P1, code & 15u));
                const int o = (tkl * 128 + h * 16 + pp * 8 + r8) * 3;
                ent[o] = e; ent[o + 1] = __builtin_bit_cast(int, SU[e]); ent[o + 2] = __builtin_bit_cast(int, gate * SV[e]);
            }
        }
#pragma unroll 1
        for (int tk = 0; tk < 8; ++tk) {
            int* et = ent + tk * 384;
            const int eA = et[lane * 3], uA = et[lane * 3 + 1], gA = et[lane * 3 + 2];
            const int eB = et[(64 + lane) * 3], uB = et[(64 + lane) * 3 + 1], gB = et[(64 + lane) * 3 + 2];
            const int rA = eA >> 10, rB = eB >> 10;
            int base = 0;
#pragma unroll 1
            for (int r = 0; r < 16; ++r) {
                const unsigned long long mA = __ballot(rA == r), mB = __ballot(rB == r);
                const int cA = __popcll(mA);
                if (lane == 0) st[tk * 32 + r] = base;
                if (rA == r) { const int q = base + (int)__builtin_amdgcn_mbcnt_hi((unsigned)(mA >> 32), __builtin_amdgcn_mbcnt_lo((unsigned)mA, 0u)); et[q * 3] = eA; et[q * 3 + 1] = uA; et[q * 3 + 2] = gA; }
                if (rB == r) { const int q = base + cA + (int)__builtin_amdgcn_mbcnt_hi((unsigned)(mB >> 32), __builtin_amdgcn_mbcnt_lo((unsigned)mB, 0u)); et[q * 3] = eB; et[q * 3 + 1] = uB; et[q * 3 + 2] = gB; }
                base += cA + __popcll(mB);
            }
            if (lane == 0) st[tk * 32 + 16] = base;
        }
#pragma unroll 1
        for (int sr = 0; sr < 8 / PE_NTK; ++sr) {
            u32x2 xp[PE_NTK][4]; f32x2 acc[PE_NTK][8];
#pragma unroll
            for (int tk = 0; tk < PE_NTK; ++tk) {
#pragma unroll
                for (int j = 0; j < 4; ++j) xp[tk][j] = *(const u32x2*)(XN + (size_t)(tb + sr * PE_NTK + tk) * DM + 4 * lane + 256 * j);
#pragma unroll
                for (int j = 0; j < 8; ++j) acc[tk][j] = (f32x2){0.f, 0.f};
            }
#pragma unroll 1
            for (int r = 0; r < 16; ++r) {
#if PE_PASS_SYNC
                __syncthreads();
#endif
                PE_TOKEN_CHUNK(0); PE_TOKEN_CHUNK(1);
#if PE_NTK == 4
                PE_TOKEN_CHUNK(2); PE_TOKEN_CHUNK(3);
#endif
            }
#pragma unroll
            for (int tk = 0; tk < PE_NTK; ++tk) {
                const int t = tb + sr * PE_NTK + tk;
                f32x4 x[4]; float ss = 0.f;
#pragma unroll
                for (int j = 0; j < 4; ++j) {
                    x[j] = *(const f32x4*)(XA + (size_t)t * DM + 4 * lane + 256 * j);
                    x[j].x += acc[tk][2 * j].x; x[j].y += acc[tk][2 * j].y; x[j].z += acc[tk][2 * j + 1].x; x[j].w += acc[tk][2 * j + 1].y;
                    ss += x[j].x * x[j].x + x[j].y * x[j].y + x[j].z * x[j].z + x[j].w * x[j].w;
                }
                ss = wave_sum(ss);
                const float rr = rsqrtf(ss * (1.0f / DM) + EPS);
                if (last) {
#pragma unroll
                    for (int j = 0; j < 4; ++j) { const f32x4 gg = *(const f32x4*)(gnext + 4 * lane + 256 * j); *(f32x4*)(p.out + (size_t)t * DM + 4 * lane + 256 * j) = x[j] * rr * gg; }
                } else {
#pragma unroll
                    for (int j = 0; j < 4; ++j) {
                        const f32x4 gg = *(const f32x4*)(gnext + 4 * lane + 256 * j);
                        *(f32x4*)((DRY ? p.out : XA) + (size_t)t * DM + 4 * lane + 256 * j) = x[j];
                        u32x2 w; w.x = pk2(x[j].x * rr * gg.x, x[j].y * rr * gg.y); w.y = pk2(x[j].z * rr * gg.z, x[j].w * rr * gg.w);
                        if (!DRY) *(u32x2*)(XN + (size_t)t * DM + 4 * lane + 256 * j) = w;
                    }
                }
            }
        }
    }
}

#define LAS __attribute__((address_space(3)))
#define XB_TMO      128
#define XB_XCNT(j)  (256  + 64 * (j))
#define XB_XSUB(j)  (1280 + 64 * (j))
#define XB_XGEN(j)  (2304 + 64 * (j))
#define XB_TOP      3328
#define XB_TOPGEN   3392
#define XCD_BAR_WORDS 3456
#define XB_SPIN_CAP (1u << 20)
__device__ __forceinline__ unsigned xb_ld(unsigned* p)              { return __hip_atomic_load(p, __ATOMIC_RELAXED, __HIP_MEMORY_SCOPE_AGENT); }
__device__ __forceinline__ unsigned xb_add(unsigned* p, unsigned v) { return __hip_atomic_fetch_add(p, v, __ATOMIC_RELAXED, __HIP_MEMORY_SCOPE_AGENT); }
__device__ __forceinline__ unsigned xb_xcc_id() { return (unsigned)__builtin_amdgcn_s_getreg((3 << 11) | 20) & 0xFu; }
#define XB_SPIN(cond, bar) do { unsigned _sp = 0; while (cond) { __builtin_amdgcn_s_sleep(1); \
    if ((++_sp & 255u) == 0u) { if (xb_ld(&(bar)[XB_TMO])) break; if (_sp > XB_SPIN_CAP) { atomicAdd(&(bar)[XB_TMO], 1u); break; } } } } while (0)
struct XcdBarrier { unsigned* bar; unsigned x; volatile LAS unsigned* st; };
__device__ __forceinline__ XcdBarrier xcd_barrier_post(unsigned* bar, volatile LAS unsigned* st) {
    XcdBarrier b; b.bar = bar; b.x = xb_xcc_id(); b.st = st;
    if (threadIdx.x == 0) (void)xb_add(&bar[XB_XCNT(b.x)], 1u);
    return b;
}
__device__ __forceinline__ void xcd_barrier_complete(unsigned* bar, unsigned x, unsigned& nloc, unsigned& nx) {
    const unsigned G = gridDim.x * gridDim.y * gridDim.z;
    unsigned sum, cnt, mine, sp = 0u;
    for (;;) {
        sum = 0u; cnt = 0u; mine = 0u;
#pragma unroll
        for (unsigned j = 0; j < 16; ++j) { const unsigned c = xb_ld(&bar[XB_XCNT(j)]); sum += c; cnt += (c > 0u) ? 1u : 0u; mine = (j == x) ? c : mine; }
        if (sum == G) break;
        __builtin_amdgcn_s_sleep(1);
        if ((++sp & 255u) == 0u) { if (xb_ld(&bar[XB_TMO])) break; if (sp > XB_SPIN_CAP) { atomicAdd(&bar[XB_TMO], 1u); break; } }
    }
    nloc = mine > 0u ? mine : 1u; nx = cnt > 0u ? cnt : 1u;
}
__device__ __forceinline__ void xcd_barrier(const XcdBarrier& b) {
    asm volatile("s_waitcnt vmcnt(0)" ::: "memory");
    __syncthreads();
    if (threadIdx.x == 0) {
        unsigned* bar = b.bar;
        __builtin_amdgcn_s_waitcnt(0);
        unsigned nloc = b.st[0], nx = b.st[1];
        if (nloc == 0u) { xcd_barrier_complete(bar, b.x, nloc, nx); b.st[0] = nloc; b.st[1] = nx; }
        const unsigned old = xb_add(&bar[XB_XSUB(b.x)], 1u);
        const unsigned gen = old / nloc;
        if (old + 1u == (gen + 1u) * nloc) {
            __builtin_amdgcn_fence(__ATOMIC_RELEASE, "agent");
            asm volatile("s_waitcnt vmcnt(0)" ::: "memory");
            const unsigned og = xb_add(&bar[XB_TOP], 1u);
            const unsigned tg = og / nx;
            if (og + 1u == (tg + 1u) * nx) xb_add(&bar[XB_TOPGEN], 1u);
            else XB_SPIN(xb_ld(&bar[XB_TOPGEN]) == tg, bar);
            __builtin_amdgcn_fence(__ATOMIC_ACQUIRE, "agent");
            xb_add(&bar[XB_XGEN(b.x)], 1u);
            asm volatile("s_waitcnt vmcnt(0)" ::: "memory");
        } else {
            XB_SPIN(xb_ld(&bar[XB_XGEN(b.x)]) == gen, bar);
            __builtin_amdgcn_fence(__ATOMIC_ACQUIRE, "agent");
            asm volatile("s_waitcnt vmcnt(0)" ::: "memory");
        }
    }
    __syncthreads();
}


template <class Epi> __device__ __forceinline__ void big_gemm(const bf16_t* A, const bf16_t* Bt, int M, int N, int K, char* lds, const Epi& e) {
    pg8::Gemm g{A, Bt, M, N, K}; pg8::StaticOrder S; S.init(M, N, (int)gridDim.x, obid());
    pg8::gemm_phase<Epi, pg8::StaticOrder, true, true>((PG8_LAS unsigned char*)lds, g, S, e);
}

#define GSYNC() xcd_barrier(xbar)
template <int layer> __device__ __forceinline__ void run_layer(const Params& p, char* lds, const XcdBarrier& xbar) {
    float* XA = (float*)(p.ws + OFF_XA);

        const float* xin = layer == 0 ? p.in[I_X] : XA;
#if PROBE == 10
        { EpiIn e{(bf16_t*)(p.ws + R_QKV), (float*)(p.ws + R_HF)};
          gemm_simple((const bf16_t*)(p.ws + R_XN), (const bf16_t*)(p.ws + OFF_WTIN) + (size_t)layer * INC * DM, T, INC, DM, lds, e); } GSYNC();
#endif
        {
            const bf16_t* wt = (const bf16_t*)(p.ws + OFF_WTIN) + (size_t)layer * INC * DM;
            pg8::EpiStoreBf16 e1{(bf16_t*)(p.ws + R_QKV), 768};
            big_gemm((const bf16_t*)(p.ws + R_XN), wt, T, 768, DM, lds, e1);
            pg8::EpiStoreF32 e2{nullptr, (float*)(p.ws + R_HF), T};
            big_gemm(wt + (size_t)768 * DM, (const bf16_t*)(p.ws + R_XN), 1024, T, DM, lds, e2);
        }
        if (layer == 0) {
#pragma nounroll
            for (int fl = 0; fl < NLAYER; ++fl) {
                EpiF32 e{(float*)(p.ws + (fl ? OFF_HFILT1 : OFF_HFILT0)), SL};
                gemm_simple((const bf16_t*)(p.ws + OFF_W3T) + (size_t)fl * 1024 * 64, (const bf16_t*)(p.ws + OFF_H2) + (size_t)fl * SL * 64, 1024, SL, 64, lds, e);
            }
        }
        GSYNC();
        if (layer == 0) {
            phase_filter_spectra(p, lds);
#if PROBE == 13
            phase_filter_spectra(p, lds);
#endif
        }
#if PROBE == 12
        phase_qkprep(p, layer, lds, (bf16_t*)(p.ws + R_ATT)); GSYNC();
#endif
        phase_qkprep(p, layer, lds, (bf16_t*)(p.ws + R_QKV)); GSYNC();
        {
#if PROBE == 5
            phase_attn(p, lds);
#endif
#if PROBE == 6
            for (int c = obid(); c < 256; c += gridDim.x) hyena_job(p, layer, c, lds);
            for (int c = obid(); c < 256; c += gridDim.x) fnet_job(p, c, lds);
#endif
            phase_attn(p, lds);
            for (int c = obid(); c < 256; c += gridDim.x) hyena_job(p, layer, c, lds);
            for (int c = obid(); c < 256; c += gridDim.x) fnet_job(p, c, lds);
        } GSYNC();
#if PROBE == 8
        phase_mix(p, layer, lds); GSYNC();
#endif
        phase_mix(p, layer, lds); GSYNC();
#if PROBE == 11
        { EpiRes e{xin, p.out};
          gemm_simple((const bf16_t*)(p.ws + R_MIX), (const bf16_t*)(p.ws + OFF_WTOUT) + (size_t)layer * DM * DM, T, DM, DM, lds, e); } GSYNC();
#endif
        { pg8::EpiStoreF32 e{xin, XA, DM};
          big_gemm((const bf16_t*)(p.ws + R_MIX), (const bf16_t*)(p.ws + OFF_WTOUT) + (size_t)layer * DM * DM, T, DM, DM, lds, e); } GSYNC();
        phase_rmsnorm_bf16(XA, p.in[I_N2G] + layer * DM, (bf16_t*)(p.ws + R_XN)); GSYNC();
#if PROBE == 3
        { EpiF32 e{(float*)(p.ws + R_QP), 2048};
          gemm_simple((const bf16_t*)(p.ws + R_XN), (const bf16_t*)(p.ws + OFF_WTQ) + (size_t)layer * 2048 * DM, T, 2048, DM, lds, e); } GSYNC();
#endif
        { pg8::EpiStoreF32 e{nullptr, (float*)(p.ws + R_QP), 2048};
          big_gemm((const bf16_t*)(p.ws + R_XN), (const bf16_t*)(p.ws + OFF_WTQ) + (size_t)layer * 2048 * DM, T, 2048, DM, lds, e); } GSYNC();
#if PEER_FUSED
#if PROBE == 1
        phase_peer_fused<true>(p, layer, lds); GSYNC();
#endif
        phase_peer_fused<false>(p, layer, lds);
#else
        phase_peer_topk(p, layer, lds, (int*)(p.ws + R_QP), (float*)(p.ws + R_QP)); GSYNC();
#if PROBE == 1
        phase_peer_gather<true>(p, layer); GSYNC();
#endif
#if PROBE == 15
        phase_peer_gather<true, 1023>(p, layer); GSYNC();
#endif
        phase_peer_gather<false>(p, layer);
#endif
        if (layer + 1 < NLAYER) GSYNC();
}

__global__ void __launch_bounds__(NTHR) mega_kernel(Params p) {
    extern __shared__ __attribute__((aligned(16))) char lds[];
    cg::grid_group grid = cg::this_grid();
    volatile LAS unsigned* misc = (volatile LAS unsigned*)((LAS char*)lds + LDS_MISC);
    if (threadIdx.x < 16) misc[threadIdx.x] = 0u;
    __syncthreads();
    const XcdBarrier xbar = xcd_barrier_post((unsigned*)(p.ws + OFF_CTL) + 4096, misc);
    float* XA = (float*)(p.ws + OFF_XA);
#if PROBE == 7
    phase_p0(p, lds); GSYNC();
#endif
#if PROBE == 14
#pragma nounroll
    for (int i = 0; i < 40; ++i) GSYNC();
#endif
    phase_p0(p, lds);
    phase_rmsnorm_bf16(p.in[I_X], p.in[I_N1G], (bf16_t*)(p.ws + R_XN));
    grid.sync();
    run_layer<0>(p, lds, xbar);
    run_layer<1>(p, lds, xbar);
}

extern "C" void kernel_launch(void* const* d_in, const int* in_sizes, int n_in, void* d_out, int out_size, void* d_ws, size_t ws_size, hipStream_t stream) {
    static int grid = 0;
    if (grid == 0) {
        if (n_in != 25 || out_size != T * DM || ws_size < WS_NEED) { fprintf(stderr, "kernel_launch: unexpected sizes n_in %d out %d ws %zu (need %zu)\n", n_in, out_size, ws_size, (size_t)WS_NEED); grid = -1; return; }
        int dev = 0, cus = 0, per_cu = 0;
        if (hipGetDevice(&dev) != hipSuccess || hipDeviceGetAttribute(&cus, hipDeviceAttributeMultiprocessorCount, dev) != hipSuccess) { grid = -1; return; }
        if (hipFuncSetAttribute((const void*)mega_kernel, hipFuncAttributeMaxDynamicSharedMemorySize, LDS_BYTES) != hipSuccess) { fprintf(stderr, "kernel_launch: hipFuncSetAttribute failed\n"); grid = -1; return; }
        if (hipOccupancyMaxActiveBlocksPerMultiprocessor(&per_cu, (const void*)mega_kernel, NTHR, LDS_BYTES) != hipSuccess || per_cu < 1) { fprintf(stderr, "kernel_launch: occupancy query says %d blocks per CU\n", per_cu); grid = -1; return; }
        (void)hipGetLastError();
        grid = cus;
    }
    if (grid < 0) return;
    Params p{};
    for (int i = 0; i < 25; ++i) p.in[i] = (const float*)d_in[i];
    p.out = (float*)d_out; p.ws = (unsigned char*)d_ws;
    if (hipMemsetAsync((char*)d_ws + OFF_CTL, 0, 64 * 1024, stream) != hipSuccess) { fprintf(stderr, "kernel_launch: memset failed\n"); return; }
    void* args[] = {&p};
    hipError_t e = hipLaunchCooperativeKernel((const void*)mega_kernel, dim3(grid), dim3(NTHR), args, LDS_BYTES, stream);
    if (e != hipSuccess) fprintf(stderr, "cooperative launch failed: %s (grid %d)\n", hipGetErrorString(e), grid);
}
```

```cpp
#include <hip/hip_runtime.h>
#include <hip/hip_cooperative_groups.h>
#include <cstdio>
#include <cstdint>
namespace cg = cooperative_groups;

#ifndef PROBE
#define PROBE 0
#endif
#ifndef PEER_FUSED
#define PEER_FUSED 1
#endif

typedef unsigned short bf16_t;
typedef short bf16x8 __attribute__((ext_vector_type(8)));
typedef float f32x16 __attribute__((ext_vector_type(16)));
typedef float f32x4 __attribute__((ext_vector_type(4)));
typedef unsigned u32x4 __attribute__((ext_vector_type(4)));
typedef unsigned u32x2 __attribute__((ext_vector_type(2)));

constexpr int DM = 1024, NB = 2, SL = 8192, T = NB * SL, NLAYER = 2;
constexpr int INC = 1792;
constexpr int NTHR = 512, NWAVE = 8;
constexpr int LDS_BYTES = 147456;
constexpr int LDS_MISC = LDS_BYTES - 64;
constexpr float EPS = 1e-6f;

constexpr size_t MiB = 1u << 20;
constexpr size_t OFF_CTL = 0;
constexpr size_t OFF_WTIN = 1 * MiB;
constexpr size_t OFF_WTOUT = 8 * MiB;
constexpr size_t OFF_WTQ = 12 * MiB;
constexpr size_t OFF_PU = 20 * MiB;
constexpr size_t OFF_PV = 84 * MiB;
constexpr size_t OFF_RS = 505 * MiB;
constexpr size_t OFF_PSC = 512 * 1024;
constexpr size_t OFF_H2 = 148 * MiB;
constexpr size_t OFF_W3T = 150 * MiB;
constexpr size_t OFF_HFILT0 = 52 * MiB, OFF_HFILT1 = 116 * MiB;
constexpr size_t OFF_FM = 152 * MiB;
constexpr size_t OFF_KF = 153 * MiB;
constexpr size_t OFF_XA = 281 * MiB;
constexpr size_t OFF_R = 345 * MiB;
constexpr size_t R_XN = OFF_R + 0 * MiB;
constexpr size_t R_UR = OFF_R + 0 * MiB;
constexpr size_t R_UI = OFF_R + 16 * MiB;
constexpr size_t R_QKV = OFF_R + 32 * MiB;
constexpr size_t R_VT = OFF_R + 56 * MiB;
constexpr size_t R_HF = OFF_R + 60 * MiB;
constexpr size_t R_MIX = OFF_R + 60 * MiB;
constexpr size_t R_ATT = OFF_R + 124 * MiB;
constexpr size_t R_Y = OFF_R + 140 * MiB;
constexpr size_t R_QP = OFF_R + 32 * MiB;
constexpr size_t WS_NEED = 506 * MiB;

struct Params {
    const float* in[25];
    float* out;
    unsigned char* ws;
};
enum { I_X = 0, I_N1G, I_WIN, I_QG, I_KG, I_CW, I_CB, I_W1, I_B1, I_F1, I_W2, I_B2, I_F2, I_W3, I_HB, I_FW, I_FB, I_MG, I_WOUT, I_N2G, I_WQ, I_SK, I_PU, I_PV, I_FG };

__device__ __forceinline__ unsigned f2bf(float f) { unsigned u = __builtin_bit_cast(unsigned, f); return (u + 0x7fffu + ((u >> 16) & 1u)) >> 16; }
__device__ __forceinline__ unsigned pk2(float lo, float hi) { return f2bf(lo) | (f2bf(hi) << 16); }
__device__ __forceinline__ float bf2f(unsigned b) { return __builtin_bit_cast(float, b << 16); }
__device__ __forceinline__ float bflo(unsigned w) { return __builtin_bit_cast(float, w << 16); }
__device__ __forceinline__ float bfhi(unsigned w) { return __builtin_bit_cast(float, w & 0xffff0000u); }
__device__ __forceinline__ float wave_sum(float v) {
#pragma unroll
    for (int o = 1; o < 64; o <<= 1) v += __shfl_xor(v, o);
    return v;
}
__device__ __forceinline__ float wave_max(float v) {
#pragma unroll
    for (int o = 1; o < 64; o <<= 1) v = fmaxf(v, __shfl_xor(v, o));
    return v;
}
__device__ __forceinline__ f32x16 mfma32(bf16x8 a, bf16x8 b, f32x16 c) { return __builtin_amdgcn_mfma_f32_32x32x16_bf16(a, b, c, 0, 0, 0); }
__device__ __forceinline__ f32x16 zero16() { return (f32x16){0.f,0.f,0.f,0.f,0.f,0.f,0.f,0.f,0.f,0.f,0.f,0.f,0.f,0.f,0.f,0.f}; }


__device__ __forceinline__ int otid() { int t = threadIdx.x; asm volatile("" : "+v"(t)); return t; }
__device__ __forceinline__ int obid() { int b = blockIdx.x; asm volatile("" : "+s"(b)); return b; }
__device__ __forceinline__ void transpose_one(const float* W, int K, int N, bf16_t* Wt, float* tile, int item) {
    const int tid = otid();
    const int nblk = N / 64, kb = item / nblk, nb = item % nblk, k0 = kb * 64, n0 = nb * 64;
    __syncthreads();
    {
        const int r = tid >> 6, c = tid & 63;
#pragma unroll
        for (int i = 0; i < 8; ++i) { const int k = r + 8 * i; tile[k * 65 + c] = W[(size_t)(k0 + k) * N + n0 + c]; }
    }
    __syncthreads();
    {
        const int nn = tid >> 3, kc = tid & 7;
        const float* s = tile + (kc * 8) * 65 + nn;
        u32x4 o; o.x = pk2(s[0], s[65]); o.y = pk2(s[2 * 65], s[3 * 65]); o.z = pk2(s[4 * 65], s[5 * 65]); o.w = pk2(s[6 * 65], s[7 * 65]);
        *(u32x4*)(Wt + (size_t)(n0 + nn) * K + k0 + kc * 8) = o;
    }
}

__device__ __forceinline__ void phase_p0(const Params& p, char* lds) {
    const int tid = otid();
    float* tile = (float*)lds;
    constexpr int IT_IN = (DM / 64) * (INC / 64), IT_OUT = (DM / 64) * (DM / 64), IT_W3 = 1024 / 64;
    constexpr int IT_L = IT_IN + IT_OUT + IT_W3;
    for (int it = obid(); it < NLAYER * IT_L; it += gridDim.x) {
        const int layer = it / IT_L; int r = it % IT_L;
        if (r < IT_IN) { transpose_one(p.in[I_WIN] + (size_t)layer * DM * INC, DM, INC, (bf16_t*)(p.ws + OFF_WTIN) + (size_t)layer * INC * DM, tile, r); continue; }
        r -= IT_IN;
        if (r < IT_OUT) { transpose_one(p.in[I_WOUT] + (size_t)layer * DM * DM, DM, DM, (bf16_t*)(p.ws + OFF_WTOUT) + (size_t)layer * DM * DM, tile, r); continue; }
        r -= IT_OUT;
        transpose_one(p.in[I_W3] + (size_t)layer * 64 * 1024, 64, 1024, (bf16_t*)(p.ws + OFF_W3T) + (size_t)layer * 1024 * 64, tile, r);
    }
    __syncthreads();
    {
        float* SKl = (float*)lds;
        float* Wl = SKl + 128 * 129;
        for (int it = obid(); it < NLAYER * 16 * 16; it += gridDim.x) {
            const int layer = it >> 8, hp = (it >> 4) & 15, kc = it & 15, h = hp >> 1, pp = hp & 1, k0 = kc * 64;
            const float* sk = p.in[I_SK] + (((size_t)(layer * 2 + pp) * 8 + h) * 128) * 128;
            const float* wq = p.in[I_WQ] + (size_t)layer * DM * 2048 + (size_t)k0 * 2048 + h * 256 + pp * 128;
            __syncthreads();
            for (int i = tid; i < 128 * 128; i += NTHR) SKl[(i >> 7) * 129 + (i & 127)] = sk[i];
            for (int i = tid; i < 64 * 128; i += NTHR) Wl[(i >> 7) * 132 + (i & 127)] = wq[(size_t)(i >> 7) * 2048 + (i & 127)];
            __syncthreads();
            const int key = tid & 127, kq = tid >> 7;
            float acc[16];
#pragma unroll
            for (int j = 0; j < 16; ++j) acc[j] = 0.f;
            for (int d4 = 0; d4 < 32; ++d4) {
                const float a0 = SKl[key * 129 + d4 * 4], a1 = SKl[key * 129 + d4 * 4 + 1], a2 = SKl[key * 129 + d4 * 4 + 2], a3 = SKl[key * 129 + d4 * 4 + 3];
#pragma unroll
                for (int j = 0; j < 16; ++j) { const f32x4 w = *(const f32x4*)(Wl + (kq * 16 + j) * 132 + d4 * 4); acc[j] += a0 * w.x + a1 * w.y + a2 * w.z + a3 * w.w; }
            }
            bf16_t* dst = (bf16_t*)(p.ws + OFF_WTQ) + (size_t)layer * 2048 * DM + (size_t)(hp * 128 + key) * DM + k0 + kq * 16;
            {
                const float* g2 = p.in[I_N2G] + layer * DM + k0 + kq * 16;
#pragma unroll
                for (int j = 0; j < 16; ++j) acc[j] *= g2[j];
            }
            u32x4 o0, o1;
            o0.x = pk2(acc[0], acc[1]); o0.y = pk2(acc[2], acc[3]); o0.z = pk2(acc[4], acc[5]); o0.w = pk2(acc[6], acc[7]);
            o1.x = pk2(acc[8], acc[9]); o1.y = pk2(acc[10], acc[11]); o1.z = pk2(acc[12], acc[13]); o1.w = pk2(acc[14], acc[15]);
            *(u32x4*)dst = o0; *(u32x4*)(dst + 8) = o1;
        }
        __syncthreads();
    }
    {
        const int lane = tid & 63, wave = tid >> 6;
        float* scl = (float*)(p.ws + OFF_PSC);
        for (int row = obid() * NWAVE + wave; row < 2 * NLAYER * 16384; row += gridDim.x * NWAVE) {
            const int tb = row >> 15, r = row & 32767;
            const f32x4* src = (const f32x4*)(p.in[tb ? I_PV : I_PU] + (size_t)r * DM) + lane;
            f32x4 v[4]; float mx = 0.f;
#pragma unroll
            for (int j = 0; j < 4; ++j) { v[j] = src[64 * j]; mx = fmaxf(mx, fmaxf(fmaxf(fabsf(v[j].x), fabsf(v[j].y)), fmaxf(fabsf(v[j].z), fabsf(v[j].w)))); }
            mx = wave_max(mx);
            const float sc = mx > 0.f ? 224.0f / mx : 1.0f;
            u32x4 o;
            { int w = 0; w = __builtin_amdgcn_cvt_pk_fp8_f32(v[0].x * sc, v[0].y * sc, w, false); w = __builtin_amdgcn_cvt_pk_fp8_f32(v[0].z * sc, v[0].w * sc, w, true); o.x = (unsigned)w; }
            { int w = 0; w = __builtin_amdgcn_cvt_pk_fp8_f32(v[1].x * sc, v[1].y * sc, w, false); w = __builtin_amdgcn_cvt_pk_fp8_f32(v[1].z * sc, v[1].w * sc, w, true); o.y = (unsigned)w; }
            { int w = 0; w = __builtin_amdgcn_cvt_pk_fp8_f32(v[2].x * sc, v[2].y * sc, w, false); w = __builtin_amdgcn_cvt_pk_fp8_f32(v[2].z * sc, v[2].w * sc, w, true); o.z = (unsigned)w; }
            { int w = 0; w = __builtin_amdgcn_cvt_pk_fp8_f32(v[3].x * sc, v[3].y * sc, w, false); w = __builtin_amdgcn_cvt_pk_fp8_f32(v[3].z * sc, v[3].w * sc, w, true); o.w = (unsigned)w; }
            *(u32x4*)(p.ws + (tb ? OFF_PV : OFF_PU) + (size_t)r * DM + lane * 16) = o;
            if (lane == 0) scl[row] = mx > 0.f ? mx / 224.0f : 1.0f;
        }
    }
    {
        float* sh = (float*)lds;
        float* zl = sh + 8 * 64;
        const int sub = tid >> 6, j = tid & 63;
        for (int it = obid(); it < NLAYER * SL / 8; it += gridDim.x) {
            const int layer = it / (SL / 8), l = (it % (SL / 8)) * 8 + sub;
            const float t = (float)l / (float)(SL - 1);
            __syncthreads();
            if (j < 17) {
                float z;
                if (j == 0) z = t;
                else if (j <= 8) z = sinf(2.0f * 3.14159265358979323846f * t * (float)j);
                else z = cosf(2.0f * 3.14159265358979323846f * t * (float)(j - 8));
                zl[sub * 17 + j] = z;
            }
            __syncthreads();
            const float* w1 = p.in[I_W1] + layer * 17 * 64;
            float a = p.in[I_B1][layer * 64 + j];
#pragma unroll
            for (int i = 0; i < 17; ++i) a += zl[sub * 17 + i] * w1[i * 64 + j];
            sh[sub * 64 + j] = sinf(p.in[I_F1][layer * 64 + j] * a);
            __syncthreads();
            const float* w2 = p.in[I_W2] + layer * 64 * 64;
            float b = p.in[I_B2][layer * 64 + j];
#pragma unroll 8
            for (int k = 0; k < 64; ++k) b += sh[sub * 64 + k] * w2[k * 64 + j];
            ((bf16_t*)(p.ws + OFF_H2))[((size_t)layer * SL + l) * 64 + j] = (bf16_t)f2bf(sinf(p.in[I_F2][layer * 64 + j] * b));
        }
    }
    {
        const int total = NLAYER * 4 * 128 * 64;
        for (int o = obid() * NTHR + tid; o < total; o += gridDim.x * NTHR) {
            const int e2 = o & 63, dd = (o >> 6) & 127, g = (o >> 13) & 3, layer = o >> 15;
            const int d = dd & 63;
            const float* w = p.in[I_FW] + ((size_t)(layer * 4 + g) * 64) * 64;
            float acc = 0.f;
            for (int e = 0; e < 64; ++e) {
                const int m = (d * e) & 63;
                const float ang = (float)m * (2.0f * 3.14159265358979323846f / 64.0f);
                const float tw = (dd < 64) ? cosf(ang) : sinf(ang);
                acc += tw * w[e * 64 + e2];
            }
            ((float*)(p.ws + OFF_FM))[o] = acc * (1.0f / 724.0773439350246f);
        }
    }
}

template <bool PAD> __device__ __forceinline__ int zi(int i) { return PAD ? i + (i >> 8) : i; }

template <int LOGN, bool PAD>
__device__ __forceinline__ void fft_fwd(float2* Z) {
    constexpr int N = 1 << LOGN;
    const int tid = otid();
    int s = 0;
    for (; s + 1 < LOGN; s += 2) {
        const int lh2 = LOGN - s - 2;
        const int h2 = 1 << lh2, h = h2 << 1;
        const float rs = 1.0f / (float)(h << 1);
        for (int q = tid; q < N / 4; q += NTHR) {
            const int j = q & (h2 - 1), blk = q >> lh2;
            const int base = (blk << (lh2 + 2)) + j;
            float2 x0 = Z[zi<PAD>(base)], x1 = Z[zi<PAD>(base + h2)], x2 = Z[zi<PAD>(base + h)], x3 = Z[zi<PAD>(base + h + h2)];
            const float ang = (float)j * rs;
            const float c = __builtin_amdgcn_cosf(ang), sn = __builtin_amdgcn_sinf(ang);
            float2 a0 = make_float2(x0.x + x2.x, x0.y + x2.y);
            float2 d02 = make_float2(x0.x - x2.x, x0.y - x2.y);
            float2 a2 = make_float2(d02.x * c + d02.y * sn, d02.y * c - d02.x * sn);
            float2 a1 = make_float2(x1.x + x3.x, x1.y + x3.y);
            float2 d13 = make_float2(x1.x - x3.x, x1.y - x3.y);
            float2 t3 = make_float2(d13.x * c + d13.y * sn, d13.y * c - d13.x * sn);
            float2 a3 = make_float2(t3.y, -t3.x);
            const float c2 = c * c - sn * sn, s2 = 2.f * c * sn;
            float2 y0 = make_float2(a0.x + a1.x, a0.y + a1.y);
            float2 e01 = make_float2(a0.x - a1.x, a0.y - a1.y);
            float2 y1 = make_float2(e01.x * c2 + e01.y * s2, e01.y * c2 - e01.x * s2);
            float2 y2 = make_float2(a2.x + a3.x, a2.y + a3.y);
            float2 e23 = make_float2(a2.x - a3.x, a2.y - a3.y);
            float2 y3 = make_float2(e23.x * c2 + e23.y * s2, e23.y * c2 - e23.x * s2);
            Z[zi<PAD>(base)] = y0; Z[zi<PAD>(base + h2)] = y1; Z[zi<PAD>(base + h)] = y2; Z[zi<PAD>(base + h + h2)] = y3;
        }
        __syncthreads();
    }
    if (s < LOGN) {
        for (int q = tid; q < N / 2; q += NTHR) {
            const int i0 = 2 * q;
            float2 a = Z[zi<PAD>(i0)], b = Z[zi<PAD>(i0 + 1)];
            Z[zi<PAD>(i0)] = make_float2(a.x + b.x, a.y + b.y);
            Z[zi<PAD>(i0 + 1)] = make_float2(a.x - b.x, a.y - b.y);
        }
        __syncthreads();
    }
}

template <int LOGN, bool PAD>
__device__ __forceinline__ void fft_inv(float2* Z) {
    constexpr int N = 1 << LOGN;
    const int tid = otid();
    for (int s = LOGN - 2; s >= 0; s -= 2) {
        const int lh2 = LOGN - s - 2;
        const int h2 = 1 << lh2, h = h2 << 1;
        const float rs = 1.0f / (float)(h << 1);
        for (int q = tid; q < N / 4; q += NTHR) {
            const int j = q & (h2 - 1), blk = q >> lh2;
            const int base = (blk << (lh2 + 2)) + j;
            float2 y0 = Z[zi<PAD>(base)], y1 = Z[zi<PAD>(base + h2)], y2 = Z[zi<PAD>(base + h)], y3 = Z[zi<PAD>(base + h + h2)];
            const float ang = (float)j * rs;
            const float c = __builtin_amdgcn_cosf(ang), sn = __builtin_amdgcn_sinf(ang);
            const float c2 = c * c - sn * sn, s2 = 2.f * c * sn;
            float2 t1 = make_float2(y1.x * c2 - y1.y * s2, y1.y * c2 + y1.x * s2);
            float2 t3 = make_float2(y3.x * c2 - y3.y * s2, y3.y * c2 + y3.x * s2);
            float2 a0 = make_float2(y0.x + t1.x, y0.y + t1.y), a1 = make_float2(y0.x - t1.x, y0.y - t1.y);
            float2 a2 = make_float2(y2.x + t3.x, y2.y + t3.y), a3 = make_float2(y2.x - t3.x, y2.y - t3.y);
            float2 u2 = make_float2(a2.x * c - a2.y * sn, a2.y * c + a2.x * sn);
            float2 u3 = make_float2(a3.x * c - a3.y * sn, a3.y * c + a3.x * sn);
            float2 v3 = make_float2(-u3.y, u3.x);
            Z[zi<PAD>(base)] = make_float2(a0.x + u2.x, a0.y + u2.y);
            Z[zi<PAD>(base + h)] = make_float2(a0.x - u2.x, a0.y - u2.y);
            Z[zi<PAD>(base + h2)] = make_float2(a1.x + v3.x, a1.y + v3.y);
            Z[zi<PAD>(base + h + h2)] = make_float2(a1.x - v3.x, a1.y - v3.y);
        }
        __syncthreads();
    }
}


__device__ __forceinline__ int zp(int i) { return i + 2 * (i >> 5); }
__device__ constexpr float FC32[16] = {1.000000000f, 0.980785280f, 0.923879533f, 0.831469612f, 0.707106781f, 0.555570233f, 0.382683432f, 0.195090322f, 0.000000000f, -0.195090322f, -0.382683432f, -0.555570233f, -0.707106781f, -0.831469612f, -0.923879533f, -0.980785280f};
__device__ constexpr float FS32[16] = {0.000000000f, 0.195090322f, 0.382683432f, 0.555570233f, 0.707106781f, 0.831469612f, 0.923879533f, 0.980785280f, 1.000000000f, 0.980785280f, 0.923879533f, 0.831469612f, 0.707106781f, 0.555570233f, 0.382683432f, 0.195090322f};
__device__ __forceinline__ float2 cmulf(float2 a, float2 b) { return make_float2(a.x * b.x - a.y * b.y, a.x * b.y + a.y * b.x); }
template <int R> __device__ __forceinline__ constexpr int brevR(int x) { int r = 0; for (int b = 1, t = R >> 1; t >= 1; b <<= 1, t >>= 1) if (x & b) r |= t; return r; }
template <int R> __device__ __forceinline__ void dft_fwd_regs(float2 (&x)[R]) {
#pragma unroll
    for (int half = R / 2; half >= 1; half >>= 1) {
#pragma unroll
        for (int blk = 0; blk < R; blk += 2 * half)
#pragma unroll
            for (int k = 0; k < half; ++k) {
                const float2 a = x[blk + k], b = x[blk + k + half];
                x[blk + k] = make_float2(a.x + b.x, a.y + b.y);
                const float2 d = make_float2(a.x - b.x, a.y - b.y);
                const int ti = k * (16 / half);
                if (ti == 0) x[blk + k + half] = d;
                else if (ti == 8) x[blk + k + half] = make_float2(d.y, -d.x);
                else { const float c = FC32[ti], sn = FS32[ti]; x[blk + k + half] = make_float2(d.x * c + d.y * sn, d.y * c - d.x * sn); }
            }
    }
}
template <int R> __device__ __forceinline__ void dft_inv_regs(float2 (&x)[R]) {
#pragma unroll
    for (int half = 1; half <= R / 2; half <<= 1) {
#pragma unroll
        for (int blk = 0; blk < R; blk += 2 * half)
#pragma unroll
            for (int k = 0; k < half; ++k) {
                const float2 a = x[blk + k], b0 = x[blk + k + half];
                const int ti = k * (16 / half);
                float2 b;
                if (ti == 0) b = b0;
                else if (ti == 8) b = make_float2(-b0.y, b0.x);
                else { const float c = FC32[ti], sn = FS32[ti]; b = make_float2(b0.x * c - b0.y * sn, b0.y * c + b0.x * sn); }
                x[blk + k] = make_float2(a.x + b.x, a.y + b.y);
                x[blk + k + half] = make_float2(a.x - b.x, a.y - b.y);
            }
    }
}
template <int R> __device__ __forceinline__ void apply_tw(float2 (&x)[R], float c, float sg) {
    const float2 w1 = make_float2(c, sg), w2 = cmulf(w1, w1);
    float2 po = w1, pe = w2;
#pragma unroll
    for (int m = 1; m < R; m += 2) {
        x[brevR<R>(m)] = cmulf(x[brevR<R>(m)], po);
        if (m + 1 < R) x[brevR<R>(m + 1)] = cmulf(x[brevR<R>(m + 1)], pe);
        if (m + 2 < R) { po = cmulf(po, w2); pe = cmulf(pe, w2); }
    }
}
template <int R, bool INV> __device__ __forceinline__ void fft_group(float2* Z, int pbase, int PS, float ang) {
    float2 x[R];
    if (!INV) {
#pragma unroll
        for (int m = 0; m < R; ++m) x[m] = Z[pbase + PS * m];
        dft_fwd_regs<R>(x);
        apply_tw<R>(x, __builtin_amdgcn_cosf(ang), -__builtin_amdgcn_sinf(ang));
#pragma unroll
        for (int m = 0; m < R; ++m) Z[pbase + PS * m] = x[brevR<R>(m)];
    } else {
#pragma unroll
        for (int m = 0; m < R; ++m) x[brevR<R>(m)] = Z[pbase + PS * m];
        apply_tw<R>(x, __builtin_amdgcn_cosf(ang), __builtin_amdgcn_sinf(ang));
        dft_inv_regs<R>(x);
#pragma unroll
        for (int m = 0; m < R; ++m) Z[pbase + PS * m] = x[m];
    }
}
template <bool INV> __device__ __forceinline__ void fft_group32_contig(float2* Z, int pbase) {
    float2 x[32];
    if (!INV) {
#pragma unroll
        for (int m = 0; m < 32; m += 2) { const f32x4 v = *(const f32x4*)(Z + pbase + m); x[m] = make_float2(v.x, v.y); x[m + 1] = make_float2(v.z, v.w); }
        dft_fwd_regs<32>(x);
#pragma unroll
        for (int m = 0; m < 32; m += 2) { const float2 a = x[brevR<32>(m)], b = x[brevR<32>(m + 1)]; *(f32x4*)(Z + pbase + m) = (f32x4){a.x, a.y, b.x, b.y}; }
    } else {
#pragma unroll
        for (int m = 0; m < 32; m += 2) { const f32x4 v = *(const f32x4*)(Z + pbase + m); x[brevR<32>(m)] = make_float2(v.x, v.y); x[brevR<32>(m + 1)] = make_float2(v.z, v.w); }
        dft_inv_regs<32>(x);
#pragma unroll
        for (int m = 0; m < 32; m += 2) *(f32x4*)(Z + pbase + m) = (f32x4){x[m].x, x[m].y, x[m + 1].x, x[m + 1].y};
    }
}
__device__ __forceinline__ void fft16k_fwd(float2* Z) {
    const int tid = otid();
#pragma unroll 1
    for (int g = 0; g < 2; ++g) { const int j = tid + 512 * g; fft_group<16, false>(Z, zp(j), 1088, (float)j * (1.0f / 16384.0f)); }
    __syncthreads();
    { const int blk = tid >> 5, j = tid & 31; fft_group<32, false>(Z, blk * 1088 + j, 34, (float)j * (1.0f / 1024.0f)); }
    __syncthreads();
    fft_group32_contig<false>(Z, 34 * tid);
    __syncthreads();
}
__device__ __forceinline__ void fft16k_inv(float2* Z) {
    const int tid = otid();
    fft_group32_contig<true>(Z, 34 * tid);
    __syncthreads();
    { const int blk = tid >> 5, j = tid & 31; fft_group<32, true>(Z, blk * 1088 + j, 34, (float)j * (1.0f / 1024.0f)); }
    __syncthreads();
#pragma unroll 1
    for (int g = 0; g < 2; ++g) { const int j = tid + 512 * g; fft_group<16, true>(Z, zp(j), 1088, (float)j * (1.0f / 16384.0f)); }
    __syncthreads();
}
__device__ __forceinline__ void fft8k_fwd(float2* Z) {
    const int tid = otid();
    fft_group<16, false>(Z, zp(tid), 544, (float)tid * (1.0f / 8192.0f));
    __syncthreads();
    { const int blk = tid >> 5, j = tid & 31; fft_group<16, false>(Z, blk * 544 + j, 34, (float)j * (1.0f / 512.0f)); }
    __syncthreads();
    if (tid < 256) fft_group32_contig<false>(Z, 34 * tid);
    __syncthreads();
}
__device__ __forceinline__ int f16k_of_p(int p) { return (p >> 10) + 16 * ((p >> 5) & 31) + 512 * (p & 31); }
__device__ __forceinline__ int p16k_of_f(int f) { return 1024 * (f & 15) + 32 * ((f >> 4) & 31) + (f >> 9); }
__device__ __forceinline__ int p8k_of_f(int f) { return 512 * (f & 15) + 32 * ((f >> 4) & 15) + (f >> 8); }

__device__ __forceinline__ void phase_filter_spectra(const Params& p, char* lds) {
    const int tid = otid(), lane = tid & 63, wave = tid >> 6;
    float2* Z = (float2*)lds;
    float* red = (float*)(lds + 139264 + 64);
    for (int job = obid(); job < NLAYER * 256; job += gridDim.x) {
        const int layer = job >> 8, c = job & 255;
        __syncthreads();
        const float* HFc = (const float*)(p.ws + (layer ? OFF_HFILT1 : OFF_HFILT0)) + (size_t)c * SL;
        const float r_lo = 4.605170185988092f / 1.5f, r_hi = 4.605170185988092f / 0.3f;
        const float rate = r_lo + (r_hi - r_lo) * ((float)c / 255.0f);
        float ss0 = 0.f, ss1 = 0.f;
#pragma unroll 1
        for (int i = 0; i < 4; ++i) {
            const int l0 = 4 * tid + 2048 * i;
            const f32x4 a0 = *(const f32x4*)(HFc + l0), a1 = *(const f32x4*)(HFc + (size_t)256 * SL + l0);
            const f32x4 a2 = *(const f32x4*)(HFc + (size_t)512 * SL + l0), a3 = *(const f32x4*)(HFc + (size_t)768 * SL + l0);
#pragma unroll
            for (int e = 0; e < 4; ++e) {
                const int l = l0 + e;
                const float t = (float)l / (float)(SL - 1);
                const float dec = expf(-t * rate);
                const float f0 = a0[e] * dec, b0 = a1[e] * dec, f1 = a2[e] * dec, b1 = a3[e] * dec;
                ss0 += f0 * f0 + b0 * b0; ss1 += f1 * f1 + b1 * b1;
                Z[zp(l)] = make_float2(f0, f1);
                if (l >= 1) Z[zp(16384 - l)] = make_float2(b0, b1);
            }
        }
        if (tid == 0) Z[zp(8192)] = make_float2(0.f, 0.f);
        ss0 = wave_sum(ss0); ss1 = wave_sum(ss1);
        if (lane == 0) { red[wave * 2] = ss0; red[wave * 2 + 1] = ss1; }
        __syncthreads();
        float t0 = 0.f, t1 = 0.f;
#pragma unroll
        for (int w = 0; w < 8; ++w) { t0 += red[w * 2]; t1 += red[w * 2 + 1]; }
        const float sc0 = rsqrtf(t0 + EPS) * (1.0f / 16384.0f) * 0.5f, sc1 = rsqrtf(t1 + EPS) * (1.0f / 16384.0f) * 0.5f;
        fft16k_fwd(Z);
        float2* KF0 = (float2*)(p.ws + OFF_KF) + ((size_t)(layer * 256 + c) * 2) * 16384;
        float2* KF1 = KF0 + 16384;
        for (int i = 0; i < 32; ++i) {
            const int pp = tid + NTHR * i;
            const int fq = f16k_of_p(pp);
            const int pq = p16k_of_f((16384 - fq) & 16383);
            const float2 za = Z[zp(pp)], zq = Z[zp(pq)];
            KF0[pp] = make_float2((za.x + zq.x) * sc0, (za.y - zq.y) * sc0);
            KF1[pp] = make_float2((za.y + zq.y) * sc1, (zq.x - za.x) * sc1);
        }
    }
}

__device__ __forceinline__ void phase_rmsnorm_bf16(const float* x, const float* g, bf16_t* out) {
    const int lane = otid() & 63, wave = otid() >> 6;
    const int gw = obid() * NWAVE + wave, ngw = gridDim.x * NWAVE;
    for (int row = gw; row < T; row += ngw) {
        const f32x4* xr = (const f32x4*)(x + (size_t)row * DM) + lane;
        f32x4 v[4]; float ss = 0.f;
#pragma unroll
        for (int j = 0; j < 4; ++j) { v[j] = xr[64 * j]; ss += v[j].x * v[j].x + v[j].y * v[j].y + v[j].z * v[j].z + v[j].w * v[j].w; }
        ss = wave_sum(ss);
        const float r = rsqrtf(ss * (1.0f / DM) + EPS);
        u32x2* o = (u32x2*)(out + (size_t)row * DM) + lane;
#pragma unroll
        for (int j = 0; j < 4; ++j) {
            const f32x4 gg = ((const f32x4*)g)[lane + 64 * j];
            u32x2 w; w.x = pk2(v[j].x * r * gg.x, v[j].y * r * gg.y); w.y = pk2(v[j].z * r * gg.z, v[j].w * r * gg.w);
            o[64 * j] = w;
        }
    }
}
__device__ __forceinline__ void phase_final_norm(const float* x, const float* g, float* out) {
    const int lane = otid() & 63, wave = otid() >> 6;
    const int gw = obid() * NWAVE + wave, ngw = gridDim.x * NWAVE;
    for (int row = gw; row < T; row += ngw) {
        const f32x4* xr = (const f32x4*)(x + (size_t)row * DM) + lane;
        f32x4 v[4]; float ss = 0.f;
#pragma unroll
        for (int j = 0; j < 4; ++j) { v[j] = xr[64 * j]; ss += v[j].x * v[j].x + v[j].y * v[j].y + v[j].z * v[j].z + v[j].w * v[j].w; }
        ss = wave_sum(ss);
        const float r = rsqrtf(ss * (1.0f / DM) + EPS);
        f32x4* o = (f32x4*)(out + (size_t)row * DM) + lane;
#pragma unroll
        for (int j = 0; j < 4; ++j) { const f32x4 gg = ((const f32x4*)g)[lane + 64 * j]; o[64 * j] = v[j] * r * gg; }
    }
}

constexpr int G_LDA = 144;
template <class Epi>
__device__ __forceinline__ void gemm_simple(const bf16_t* A, const bf16_t* Bt, int M, int N, int K, char* lds, const Epi& epi) {
    const int tid = otid(), lane = tid & 63, wave = tid >> 6;
    const int wm = wave >> 1, wn = wave & 1;
    const int nMt = M / 256, nNt = N / 128, total = nMt * nNt, nk = K / 64;
    char* As = lds; char* Bs = lds + 256 * G_LDA;
    const int l31 = lane & 31, hl = lane >> 5;
    for (int u = obid(); u < total; u += gridDim.x) {
        const int mt = u % nMt, nt = u / nMt;
        f32x16 acc[2][2];
#pragma unroll
        for (int i = 0; i < 2; ++i)
#pragma unroll
            for (int j = 0; j < 2; ++j) acc[i][j] = zero16();
        u32x4 ra[4], rb[2];
        const bf16_t* Ab = A + (size_t)(mt * 256) * K;
        const bf16_t* Bb = Bt + (size_t)(nt * 128) * K;
#pragma unroll
        for (int i = 0; i < 4; ++i) { const int id = tid + NTHR * i, row = id >> 3, ch = id & 7; ra[i] = *(const u32x4*)(Ab + (size_t)row * K + ch * 8); }
#pragma unroll
        for (int i = 0; i < 2; ++i) { const int id = tid + NTHR * i, row = id >> 3, ch = id & 7; rb[i] = *(const u32x4*)(Bb + (size_t)row * K + ch * 8); }
        for (int kt = 0; kt < nk; ++kt) {
            __syncthreads();
#pragma unroll
            for (int i = 0; i < 4; ++i) { const int id = tid + NTHR * i, row = id >> 3, ch = id & 7; *(u32x4*)(As + row * G_LDA + ch * 16) = ra[i]; }
#pragma unroll
            for (int i = 0; i < 2; ++i) { const int id = tid + NTHR * i, row = id >> 3, ch = id & 7; *(u32x4*)(Bs + row * G_LDA + ch * 16) = rb[i]; }
            __syncthreads();
            if (kt + 1 < nk) {
                const int ko = (kt + 1) * 64;
#pragma unroll
                for (int i = 0; i < 4; ++i) { const int id = tid + NTHR * i, row = id >> 3, ch = id & 7; ra[i] = *(const u32x4*)(Ab + (size_t)row * K + ko + ch * 8); }
#pragma unroll
                for (int i = 0; i < 2; ++i) { const int id = tid + NTHR * i, row = id >> 3, ch = id & 7; rb[i] = *(const u32x4*)(Bb + (size_t)row * K + ko + ch * 8); }
            }
#pragma unroll
            for (int ks = 0; ks < 4; ++ks) {
                bf16x8 a[2], b[2];
#pragma unroll
                for (int i = 0; i < 2; ++i) a[i] = *(const bf16x8*)(As + (wm * 64 + i * 32 + l31) * G_LDA + ks * 32 + hl * 16);
#pragma unroll
                for (int j = 0; j < 2; ++j) b[j] = *(const bf16x8*)(Bs + (wn * 64 + j * 32 + l31) * G_LDA + ks * 32 + hl * 16);
#pragma unroll
                for (int i = 0; i < 2; ++i)
#pragma unroll
                    for (int j = 0; j < 2; ++j) acc[i][j] = mfma32(a[i], b[j], acc[i][j]);
            }
        }
#pragma unroll
        for (int i = 0; i < 2; ++i)
#pragma unroll
            for (int j = 0; j < 2; ++j) epi(acc[i][j], mt * 256 + wm * 64 + i * 32, nt * 128 + wn * 64 + j * 32, lane);
    }
}

struct EpiIn {
    bf16_t* qkv; float* hf;
    __device__ __forceinline__ void operator()(const f32x16& acc, int row0, int col0, int lane) const {
        const int c = col0 + (lane & 31), h = lane >> 5;
        if (col0 < 768) {
#pragma unroll
            for (int r = 0; r < 16; ++r) { const int row = row0 + (r & 3) + 8 * (r >> 2) + 4 * h; qkv[(size_t)row * 768 + c] = (bf16_t)f2bf(acc[r]); }
        } else {
            float* dst = hf + (size_t)(c - 768) * T;
#pragma unroll
            for (int i = 0; i < 4; ++i) { const int row = row0 + 8 * i + 4 * h; f32x4 v; v.x = acc[4 * i]; v.y = acc[4 * i + 1]; v.z = acc[4 * i + 2]; v.w = acc[4 * i + 3]; *(f32x4*)(dst + row) = v; }
        }
    }
};
struct EpiRes {
    const float* base; float* out;
    __device__ __forceinline__ void operator()(const f32x16& acc, int row0, int col0, int lane) const {
        const int c = col0 + (lane & 31), h = lane >> 5;
#pragma unroll
        for (int r = 0; r < 16; ++r) { const size_t o = (size_t)(row0 + (r & 3) + 8 * (r >> 2) + 4 * h) * DM + c; out[o] = base[o] + acc[r]; }
    }
};
struct EpiF32 {
    float* out; int ld;
    __device__ __forceinline__ void operator()(const f32x16& acc, int row0, int col0, int lane) const {
        const int c = col0 + (lane & 31), h = lane >> 5;
#pragma unroll
        for (int r = 0; r < 16; ++r) { out[(size_t)(row0 + (r & 3) + 8 * (r >> 2) + 4 * h) * ld + c] = acc[r]; }
    }
};

namespace pg8 {
#define PG8_LAS __attribute__((address_space(3)))
constexpr int BM = 256, BK = 64, HALF = 128, HTB = HALF * BK * 2  , STAGE_BYTES = 8 * HTB, NXCD = 8, WGM = 8;

__host__ __device__ __forceinline__ int lds_byte(int r, int c) { const int st = (r >> 4) * 2 + (c >> 5), rr = r & 15, cc = c & 31, ob = rr * 64 + cc * 2; return st * 1024 + (ob ^ (((ob >> 9) & 1) << 5)); }
__host__ __device__ __forceinline__ void stage_rc(int b, int& R, int& C) { const int st = b / 1024, sb = b % 1024, swz = sb ^ (((sb >> 9) & 1) << 5); R = (st >> 1) * 16 + swz / 64; C = (st & 1) * 32 + (swz % 64) / 2; }
__host__ __device__ __forceinline__ int perm32(int rho) { const int n = rho >> 4, i = rho & 15; return 8 * (i >> 2) + 4 * n + (i & 3); }

struct Unit { int pm, pn; };
struct Gemm { const bf16_t* A; const bf16_t* Bt; int M, N, K; };

struct StaticOrder {
    int nM, nN, nwg, G, c;
    __host__ __device__ void init(int M, int N, int G_, int c_) { nM = M / BM; nN = N / BM; nwg = nM * nN; G = G_; c = c_; }
    __host__ __device__ bool next(int i, Unit& u) const {
        const long L = (long)i * G + c; if (L >= nwg) return false;
        int wgid = (int)L; { const int q = nwg / NXCD, r = nwg % NXCD, xcd = wgid % NXCD, off = wgid / NXCD; wgid = (xcd < r ? xcd * (q + 1) : r * (q + 1) + (xcd - r) * q) + off; }
        const int nig = WGM * nN, gid = wgid / nig, fm = gid * WGM, gsz = (nM - fm) < WGM ? (nM - fm) : WGM;
        u.pm = fm + ((wgid % nig) % gsz); u.pn = (wgid % nig) / gsz; return true;
    }
    __device__ __forceinline__ void a_ready(const Unit&) const {}
    __device__ __forceinline__ void done(const Unit&) const {}
};


__device__ __forceinline__ unsigned cvt_pk_bf16(float lo, float hi) { unsigned r; asm volatile("v_cvt_pk_bf16_f32 %0, %1, %2" : "=v"(r) : "v"(lo), "v"(hi)); return r; }
struct EpiStoreBf16 {
    static constexpr bool PERM = true, AFTER_DRAIN = false;
    bf16_t* O; int ldc;
    __device__ __forceinline__ void operator()(const f32x4 (&acc)[2][2][4][2], const Unit& u, int wr, int wc, int fr, int fq) const {
        const int row0 = u.pm * BM + wr * 64 + fr, col0 = u.pn * BM + wc * 32 + 8 * fq;
#pragma unroll
        for (int ai = 0; ai < 2; ++ai)
#pragma unroll
            for (int m = 0; m < 4; ++m) { bf16_t* rowp = O + (size_t)(row0 + ai * HALF + m * 16) * ldc + col0;
#pragma unroll
                for (int bj = 0; bj < 2; ++bj) { const f32x4 v0 = acc[ai][bj][m][0], v1 = acc[ai][bj][m][1];
                    u32x4 w; w.x = cvt_pk_bf16(v0[0], v0[1]); w.y = cvt_pk_bf16(v0[2], v0[3]); w.z = cvt_pk_bf16(v1[0], v1[1]); w.w = cvt_pk_bf16(v1[2], v1[3]);
                    *(u32x4*)(rowp + bj * HALF) = w; } }
    }
};
struct EpiOutProj {
    static constexpr bool PERM = false, AFTER_DRAIN = false;
    const float* base; float* O; bf16_t* XB; float* RS;
    __device__ __forceinline__ void operator()(const f32x4 (&acc)[2][2][4][2], const Unit& u, int wr, int wc, int fr, int fq) const {
        const int row0 = u.pm * BM + wr * 64 + fr, col0 = u.pn * BM + wc * 32 + 4 * fq;
#pragma unroll
        for (int ai = 0; ai < 2; ++ai)
#pragma unroll
            for (int m = 0; m < 4; ++m) { const int row = row0 + ai * HALF + m * 16; const size_t off = (size_t)row * 1024 + col0; float ss = 0.f;
#pragma unroll
                for (int bj = 0; bj < 2; ++bj)
#pragma unroll
                    for (int n = 0; n < 2; ++n) { const f32x4 v = acc[ai][bj][m][n] + *(const f32x4*)(base + off + bj * HALF + n * 16);
                        *(f32x4*)(O + off + bj * HALF + n * 16) = v; ss += v[0] * v[0] + v[1] * v[1] + v[2] * v[2] + v[3] * v[3];
                        u32x2 w; w.x = cvt_pk_bf16(v[0], v[1]); w.y = cvt_pk_bf16(v[2], v[3]); *(u32x2*)(XB + off + bj * HALF + n * 16) = w; }
                ss += __shfl_xor(ss, 16); ss += __shfl_xor(ss, 32);
                if (fq == 0) RS[(size_t)row * 16 + u.pn * 4 + wc] = ss; }
    }
};
struct EpiRowScaleF32 {
    static constexpr bool PERM = false, AFTER_DRAIN = false;
    float* O; int ldc; const float* RS;
    __device__ __forceinline__ void operator()(const f32x4 (&acc)[2][2][4][2], const Unit& u, int wr, int wc, int fr, int fq) const {
        const int row0 = u.pm * BM + wr * 64 + fr, col0 = u.pn * BM + wc * 32 + 4 * fq;
#pragma unroll
        for (int ai = 0; ai < 2; ++ai)
#pragma unroll
            for (int m = 0; m < 4; ++m) { const int row = row0 + ai * HALF + m * 16; const size_t off = (size_t)row * ldc + col0;
                float tot = 0.f;
#pragma unroll
                for (int q = 0; q < 4; ++q) { const f32x4 pr = *(const f32x4*)(RS + (size_t)row * 16 + 4 * q); tot += (pr[0] + pr[1]) + (pr[2] + pr[3]); }
                const float r = rsqrtf(tot * (1.0f / 1024.0f) + 1e-6f);
#pragma unroll
                for (int bj = 0; bj < 2; ++bj)
#pragma unroll
                    for (int n = 0; n < 2; ++n) *(f32x4*)(O + off + bj * HALF + n * 16) = acc[ai][bj][m][n] * r; }
    }
};
struct EpiStoreF32 {
    static constexpr bool PERM = false, AFTER_DRAIN = false;
    const float* base; float* O; int ldc;
    __device__ __forceinline__ void operator()(const f32x4 (&acc)[2][2][4][2], const Unit& u, int wr, int wc, int fr, int fq) const {
        const int row0 = u.pm * BM + wr * 64 + fr, col0 = u.pn * BM + wc * 32 + 4 * fq;
#pragma unroll
        for (int ai = 0; ai < 2; ++ai)
#pragma unroll
            for (int m = 0; m < 4; ++m) { const size_t off = (size_t)(row0 + ai * HALF + m * 16) * ldc + col0;
#pragma unroll
                for (int bj = 0; bj < 2; ++bj)
#pragma unroll
                    for (int n = 0; n < 2; ++n) { f32x4 v = acc[ai][bj][m][n]; if (base) v += *(const f32x4*)(base + off + bj * HALF + n * 16); *(f32x4*)(O + off + bj * HALF + n * 16) = v; } }
    }
};

template <class Epi, class Sched, bool ALIGN_EPI = false, bool SP2 = false>
__device__ __forceinline__ void gemm_phase(PG8_LAS unsigned char* lds, const Gemm g, const Sched& S, const Epi& E) {
    const int tid = otid(), wid = __builtin_amdgcn_readfirstlane(tid >> 6), lane = tid & 63, wr = wid >> 2, wc = wid & 3, fr = lane & 15, fq = lane >> 4;
    const int K = g.K, nt = K / BK;
    unsigned voffA[2], voffB[2];
#pragma unroll
    for (int i = 0; i < 2; ++i) { int R, C; stage_rc(tid * 16 + i * 8192, R, C); const int Rb = Epi::PERM ? ((R & ~31) + perm32(R & 31)) : R;
        voffA[i] = (unsigned)(R * K + C) * 2u; voffB[i] = (unsigned)(Rb * K + C) * 2u; }
    const size_t kstep = (size_t)(BK * 2);
    const size_t hstep = (size_t)HALF * K * 2;
    const size_t tstep = 2 * hstep;
    const unsigned ldsw = (unsigned)wid * 1024u;
    const int aoff = lds_byte(wr * 64 + fr, fq * 8), boff = lds_byte(wc * 32 + fr, fq * 8);
#define PG8_SA(b, h) (((b) * 2 + (h)) * HTB)
#define PG8_SB(b, h) ((4 + (b) * 2 + (h)) * HTB)
#define PG8_STAGE(bufoff, gbase, voff) do { _Pragma("unroll") for (int _i = 0; _i < 2; ++_i) \
        __builtin_amdgcn_global_load_lds((const unsigned*)((const char*)(gbase) + (voff)[_i]), (PG8_LAS unsigned*)(lds + (bufoff) + ldsw + _i * 8192), 16, 0, 0); } while (0)
#define PG8_LDA(dst, b, h) do { _Pragma("unroll") for (int m = 0; m < 4; ++m) _Pragma("unroll") for (int k = 0; k < 2; ++k) dst[m][k] = *(const PG8_LAS bf16x8*)(lds + PG8_SA(b, h) + aoff + m * 2048 + k * 1024); } while (0)
#define PG8_LDB(dst, b, h) do { _Pragma("unroll") for (int n = 0; n < 2; ++n) _Pragma("unroll") for (int k = 0; k < 2; ++k) dst[n][k] = *(const PG8_LAS bf16x8*)(lds + PG8_SB(b, h) + boff + n * 2048 + k * 1024); } while (0)
#define PG8_MMA(ai, bj, At, Bt) do { __builtin_amdgcn_s_setprio(1); _Pragma("unroll") for (int m = 0; m < 4; ++m) _Pragma("unroll") for (int n = 0; n < 2; ++n) _Pragma("unroll") for (int k = 0; k < 2; ++k) \
        acc[ai][bj][m][n] = __builtin_amdgcn_mfma_f32_16x16x32_bf16(Bt[n][k], At[m][k], acc[ai][bj][m][n], 0, 0, 0); __builtin_amdgcn_s_setprio(0); } while (0)
#define PG8_WAIT_V(n) asm volatile("s_waitcnt vmcnt(" #n ")" ::: "memory")
#define PG8_WAIT_L(n) asm volatile("s_waitcnt lgkmcnt(" #n ")" ::: "memory")
#define PG8_BAR __builtin_amdgcn_s_barrier()
#define PG8_SCHED __builtin_amdgcn_sched_barrier(0)
    Unit cur, nxt; int ui = 0;
    if (!S.next(0, cur)) return;
    f32x4 acc[2][2][4][2];
#pragma unroll
    for (int a = 0; a < 2; ++a)
#pragma unroll
        for (int b = 0; b < 2; ++b)
#pragma unroll
            for (int m = 0; m < 4; ++m)
#pragma unroll
                for (int n = 0; n < 2; ++n) acc[a][b][m][n] = (f32x4){0.f, 0.f, 0.f, 0.f};
    bf16x8 At[4][2], B0[2][2], B1[2][2];
    const char* cA = (const char*)g.A + (size_t)cur.pm * tstep; const char* cB = (const char*)g.Bt + (size_t)cur.pn * tstep;
    S.a_ready(cur);
    if constexpr (SP2) {
        PG8_STAGE(PG8_SB(0, 0), cB, voffB); PG8_STAGE(PG8_SB(0, 1), cB + hstep, voffB); PG8_STAGE(PG8_SA(0, 0), cA, voffA); PG8_STAGE(PG8_SA(0, 1), cA + hstep, voffA);
        if (wr == 1) PG8_BAR;
        PG8_WAIT_V(2); PG8_BAR;
        PG8_STAGE(PG8_SB(1, 0), cB + kstep, voffB); PG8_STAGE(PG8_SA(1, 0), cA + kstep, voffA); PG8_STAGE(PG8_SB(1, 1), cB + hstep + kstep, voffB);
        PG8_WAIT_V(6); PG8_BAR;
    } else {
        PG8_STAGE(PG8_SB(0, 0), cB, voffB); PG8_STAGE(PG8_SA(0, 0), cA, voffA); PG8_STAGE(PG8_SB(0, 1), cB + hstep, voffB); PG8_STAGE(PG8_SA(0, 1), cA + hstep, voffA);
        if (wr == 1) PG8_BAR;
        PG8_WAIT_V(4); PG8_BAR;
        PG8_STAGE(PG8_SB(1, 0), cB + kstep, voffB); PG8_STAGE(PG8_SA(1, 0), cA + kstep, voffA); PG8_STAGE(PG8_SB(1, 1), cB + hstep + kstep, voffB);
        PG8_WAIT_V(6); PG8_BAR;
    }
    for (;;) {
        const bool has_next = S.next(ui + 1, nxt);
        const char* nA = has_next ? (const char*)g.A + (size_t)nxt.pm * tstep : cA; const char* nB = has_next ? (const char*)g.Bt + (size_t)nxt.pn * tstep : cB;
        for (int t = 0; t < nt; t += 2) {
            const bool last = (t == nt - 2);
            const char* a1 = cA + (size_t)(t + 1) * kstep;
            const char* a2 = last ? nA : cA + (size_t)(t + 2) * kstep; const char* b2 = last ? nB : cB + (size_t)(t + 2) * kstep;
            const char* a3 = a2 + kstep; const char* b3 = b2 + kstep;
            if (last && has_next) S.a_ready(nxt);
            if constexpr (SP2) {
            PG8_LDB(B0, 0, 0); PG8_LDB(B1, 0, 1); PG8_SCHED; PG8_LDA(At, 0, 0); PG8_STAGE(PG8_SA(1, 1), a1 + hstep, voffA);
            PG8_WAIT_V(8); PG8_WAIT_L(0); PG8_BAR; PG8_MMA(0, 0, At, B0); PG8_MMA(0, 1, At, B1); PG8_BAR; PG8_SCHED;
            PG8_LDA(At, 0, 1); PG8_STAGE(PG8_SB(0, 0), b2, voffB); PG8_STAGE(PG8_SB(0, 1), b2 + hstep, voffB); PG8_STAGE(PG8_SA(0, 0), a2, voffA);
            PG8_WAIT_V(8); PG8_WAIT_L(0); PG8_BAR; PG8_MMA(1, 0, At, B0); PG8_MMA(1, 1, At, B1); PG8_BAR; PG8_SCHED;
            PG8_LDB(B0, 1, 0); PG8_LDB(B1, 1, 1); PG8_SCHED; PG8_LDA(At, 1, 0); PG8_STAGE(PG8_SA(0, 1), a2 + hstep, voffA);
            PG8_WAIT_V(8); PG8_WAIT_L(0); PG8_BAR; PG8_MMA(0, 0, At, B0); PG8_MMA(0, 1, At, B1); PG8_BAR; PG8_SCHED;
            PG8_LDA(At, 1, 1); PG8_STAGE(PG8_SB(1, 0), b3, voffB); PG8_STAGE(PG8_SB(1, 1), b3 + hstep, voffB); PG8_STAGE(PG8_SA(1, 0), a3, voffA);
            PG8_WAIT_V(8); PG8_WAIT_L(0); PG8_BAR; PG8_MMA(1, 0, At, B0); PG8_MMA(1, 1, At, B1); PG8_BAR; PG8_SCHED;
            } else {
            PG8_LDB(B0, 0, 0); PG8_SCHED; PG8_LDA(At, 0, 0); PG8_STAGE(PG8_SA(1, 1), a1 + hstep, voffA);
            PG8_WAIT_L(8); PG8_BAR; PG8_WAIT_L(0); PG8_MMA(0, 0, At, B0); PG8_BAR; PG8_SCHED;
            PG8_LDB(B1, 0, 1); PG8_STAGE(PG8_SB(0, 0), b2, voffB);
            PG8_BAR; PG8_WAIT_L(0); PG8_MMA(0, 1, At, B1); PG8_BAR;
            PG8_LDA(At, 0, 1); PG8_STAGE(PG8_SA(0, 0), a2, voffA);
            PG8_BAR; PG8_WAIT_L(0); PG8_MMA(1, 0, At, B0); PG8_BAR; PG8_SCHED;
            PG8_STAGE(PG8_SB(0, 1), b2 + hstep, voffB);
            PG8_WAIT_V(6); PG8_BAR; PG8_MMA(1, 1, At, B1); PG8_BAR;
            PG8_LDB(B0, 1, 0); PG8_SCHED; PG8_LDA(At, 1, 0); PG8_STAGE(PG8_SA(0, 1), a2 + hstep, voffA);
            PG8_WAIT_L(8); PG8_BAR; PG8_WAIT_L(0); PG8_MMA(0, 0, At, B0); PG8_BAR; PG8_SCHED;
            PG8_LDB(B1, 1, 1); PG8_STAGE(PG8_SB(1, 0), b3, voffB);
            PG8_BAR; PG8_WAIT_L(0); PG8_MMA(0, 1, At, B1); PG8_BAR;
            PG8_LDA(At, 1, 1); PG8_STAGE(PG8_SA(1, 0), a3, voffA);
            PG8_BAR; PG8_WAIT_L(0); PG8_MMA(1, 0, At, B0); PG8_BAR; PG8_SCHED;
            PG8_STAGE(PG8_SB(1, 1), b3 + hstep, voffB);
            PG8_WAIT_V(6); PG8_BAR; PG8_MMA(1, 1, At, B1); PG8_BAR;
            }
        }
        if constexpr (ALIGN_EPI) { if (wr == 0) PG8_BAR; }
        if constexpr (!Epi::AFTER_DRAIN) { E(acc, cur, wr, wc, fr, fq); S.done(cur); }
        if (!has_next) break;
#pragma unroll
        for (int a = 0; a < 2; ++a)
#pragma unroll
            for (int b = 0; b < 2; ++b)
#pragma unroll
                for (int m = 0; m < 4; ++m)
#pragma unroll
                    for (int n = 0; n < 2; ++n) acc[a][b][m][n] = (f32x4){0.f, 0.f, 0.f, 0.f};
        cur = nxt; cA = nA; cB = nB; ++ui;
        if constexpr (ALIGN_EPI) { if (wr == 1) PG8_BAR; }
    }
    PG8_WAIT_V(0);
    if constexpr (!ALIGN_EPI) { if (wr == 0) PG8_BAR; }
    PG8_BAR;
    if constexpr (Epi::AFTER_DRAIN) { E.fused(acc, cur, wr, wc, fr, fq, lds, wid, lane); S.done(cur); }
#undef PG8_SA
#undef PG8_SB
#undef PG8_STAGE
#undef PG8_LDA
#undef PG8_LDB
#undef PG8_MMA
#undef PG8_WAIT_V
#undef PG8_WAIT_L
#undef PG8_BAR
#undef PG8_SCHED
}
}

__device__ constexpr float ROPE_INV_REV[16] = {1.591549431e-01f, 8.949940161e-02f, 5.032921210e-02f, 2.830219583e-02f, 1.591549431e-02f, 8.949940161e-03f, 5.032921210e-03f, 2.830219583e-03f, 1.591549431e-03f, 8.949940161e-04f, 5.032921210e-04f, 2.830219583e-04f, 1.591549431e-04f, 8.949940161e-05f, 5.032921210e-05f, 2.830219583e-05f};
__device__ __forceinline__ void qk_norm_rope8(const u32x4 raw, const float (&gn)[8], const float (&cs)[8], const float (&sn)[8], bool second, float scale, u32x4& out) {
    float x[8] = {bflo(raw.x), bfhi(raw.x), bflo(raw.y), bfhi(raw.y), bflo(raw.z), bfhi(raw.z), bflo(raw.w), bfhi(raw.w)};
    float ss = 0.f;
#pragma unroll
    for (int e = 0; e < 8; ++e) ss += x[e] * x[e];
    ss += __shfl_xor(ss, 1); ss += __shfl_xor(ss, 2); ss += __shfl_xor(ss, 4);
    const float r = rsqrtf(ss * (1.0f / 64.0f) + EPS) ;
    float o[8];
#pragma unroll
    for (int e = 0; e < 8; ++e) {
        const float y = x[e] * r * gn[e];
        const float other = __shfl_xor(y, 2);
        o[e] = (second ? (y * cs[e] + other * sn[e]) : (y * cs[e] - other * sn[e])) * scale;
    }
    out.x = pk2(o[0], o[1]); out.y = pk2(o[2], o[3]); out.z = pk2(o[4], o[5]); out.w = pk2(o[6], o[7]);
}
__device__ __forceinline__ void phase_qkprep(const Params& p, int layer, char* lds, bf16_t* qout) {
    const int tid = otid(), lane = tid & 63, wave = tid >> 6;
    const bf16_t* qkv = (const bf16_t*)(p.ws + R_QKV);
    const int sub = lane & 7;
    const bool second = ((sub >> 1) & 1) != 0, colaxis = (sub >> 2) != 0;
    float gq[8], gk[8], ir[8];
#pragma unroll
    for (int e = 0; e < 8; ++e) {
        gq[e] = p.in[I_QG][layer * 64 + sub * 8 + e]; gk[e] = p.in[I_KG][layer * 64 + sub * 8 + e];
        ir[e] = (sub & 1) ? ROPE_INV_REV[8 + e] : ROPE_INV_REV[e];
    }
    const int gw = obid() * NWAVE + wave, ngw = gridDim.x * NWAVE;
    for (int t = gw; t < T; t += ngw) {
        const int l = t & (SL - 1);
        const float pos = colaxis ? (float)(l & 63) : (float)(l >> 6);
        float cs[8], sn[8];
#pragma unroll
        for (int e = 0; e < 8; ++e) { const float a = pos * ir[e]; cs[e] = __builtin_amdgcn_cosf(a); sn[e] = __builtin_amdgcn_sinf(a); }
        const u32x4 rq = *(const u32x4*)(qkv + (size_t)t * 768 + lane * 8);
        u32x4 rk = {0u, 0u, 0u, 0u};
        if (lane < 16) rk = *(const u32x4*)(qkv + (size_t)t * 768 + 512 + lane * 8);
        u32x4 oq, ok;
        qk_norm_rope8(rq, gq, cs, sn, second, 0.125f * 1.4426950408889634f, oq);
        qk_norm_rope8(rk, gk, cs, sn, second, 1.0f, ok);
        *(u32x4*)(qout + (size_t)t * 768 + lane * 8) = oq;
        if (lane < 16) *(u32x4*)(qout + (size_t)t * 768 + 512 + lane * 8) = ok;
    }
}

#include <hip/hip_bf16.h>
#include <cmath>
namespace attn_body {
using bf16=__hip_bfloat16;
using bf16x8=__attribute__((ext_vector_type(8)))short;
using s16x4=__attribute__((ext_vector_type(4)))short;
using f32x16=__attribute__((ext_vector_type(16)))float;
using u32x4=__attribute__((ext_vector_type(4)))unsigned;
constexpr int SEQ=8192,D=64,PQ=768,PO=512;
constexpr int NW=8,QBLK=32,QB=QBLK*NW,KVBLK=64,NQB=SEQ/QB;
constexpr int ATTN_UNIT_ROWS=QB;
__device__ __forceinline__ int crow(int r,int hi){return (r&3)+8*(r>>2)+4*hi;}
#define SBAR() __builtin_amdgcn_sched_barrier(0)
__device__ __forceinline__ void cmask(f32x16&p0,f32x16&p1,int jb,int qrel,int hi){
  const float NEG=-INFINITY; int kb=64*jb+4*hi;
  #pragma unroll
  for(int r=0;r<16;++r){int kv=kb+(r&3)+8*(r>>2); if(kv>qrel)p0[r]=NEG; if(kv+32>qrel)p1[r]=NEG;}
}

constexpr int NSLOT=3, SLOTB=8192;
constexpr int LDS_K=0, LDS_V=NSLOT*SLOTB, LDS_WS=2*NSLOT*SLOTB, LDS_OST=LDS_WS+NW*64*4, LDS_BYTES=LDS_OST+NW*4096;
constexpr float C2=0.125f*1.4426950408889634f;
__device__ __forceinline__ void glds16(const void*gsrc,unsigned lds_dst){unsigned keep;
  asm volatile("s_mov_b32 %0, m0\n\ts_mov_b32 m0, %2\n\ts_nop 0\n\tglobal_load_lds_dwordx4 %1, off\n\ts_mov_b32 m0, %0":"=&s"(keep):"v"(gsrc),"s"(lds_dst):"memory");}
__device__ __forceinline__ float max3f(float a,float b,float c){float r;asm("v_max3_f32 %0, %1, %2, %3":"=v"(r):"v"(a),"v"(b),"v"(c));return r;}
__device__ __forceinline__ float max2f(float a,float b){float r;asm("v_max_f32_e32 %0, %1, %2":"=v"(r):"v"(a),"v"(b));return r;}
__device__ __forceinline__ float fadd_s(float a,float b){float r;asm("v_add_f32_e32 %0, %1, %2":"=v"(r):"v"(a),"v"(b));return r;}
__device__ __forceinline__ float fsub_s(float a,float b){float r;asm("v_sub_f32_e32 %0, %1, %2":"=v"(r):"v"(a),"v"(b));return r;}
typedef float f32x2_t __attribute__((ext_vector_type(2))); typedef __bf16 bf16x2_t __attribute__((ext_vector_type(2)));
__device__ __forceinline__ unsigned cvtpk_s(float lo,float hi){f32x2_t v={lo,hi};bf16x2_t b=__builtin_convertvector(v,bf16x2_t);return __builtin_bit_cast(unsigned,b);}
#define WAIT_BAR(N) asm volatile("s_waitcnt vmcnt(" #N ") lgkmcnt(0)\n\ts_barrier":::"memory")

__device__ __forceinline__ void qkt(f32x16&p0,f32x16&p1,const char*Kslot,const bf16x8*qr,const f32x16&negm,int r32,int hi){
  const char*kb=Kslot+hi*1024+r32*16;
  #pragma unroll
  for(int d0=0;d0<4;++d0){
    const bf16x8 b0=*reinterpret_cast<const bf16x8*>(kb+d0*2048);
    const bf16x8 b1=*reinterpret_cast<const bf16x8*>(kb+d0*2048+512);
    if(d0==0){p0=__builtin_amdgcn_mfma_f32_32x32x16_bf16(b0,qr[0],negm,0,0,0);p1=__builtin_amdgcn_mfma_f32_32x32x16_bf16(b1,qr[0],negm,0,0,0);}
    else{p0=__builtin_amdgcn_mfma_f32_32x32x16_bf16(b0,qr[d0],p0,0,0,0);p1=__builtin_amdgcn_mfma_f32_32x32x16_bf16(b1,qr[d0],p1,0,0,0);}}
}
typedef __attribute__((address_space(3))) const char* lds_cptr;
typedef short v4i16_t __attribute__((ext_vector_type(4)));
__device__ __forceinline__ void kload8(bf16x8*kf,lds_cptr kp){
  kf[0]=*(const __attribute__((address_space(3))) bf16x8*)(kp);      kf[1]=*(const __attribute__((address_space(3))) bf16x8*)(kp+512);
  kf[2]=*(const __attribute__((address_space(3))) bf16x8*)(kp+2048); kf[3]=*(const __attribute__((address_space(3))) bf16x8*)(kp+2560);
  kf[4]=*(const __attribute__((address_space(3))) bf16x8*)(kp+4096); kf[5]=*(const __attribute__((address_space(3))) bf16x8*)(kp+4608);
  kf[6]=*(const __attribute__((address_space(3))) bf16x8*)(kp+6144); kf[7]=*(const __attribute__((address_space(3))) bf16x8*)(kp+6656);
}
__device__ __forceinline__ void kload2(bf16x8*kf,lds_cptr kp,int j){ kf[2*j]=*(const __attribute__((address_space(3))) bf16x8*)(kp+j*2048); kf[2*j+1]=*(const __attribute__((address_space(3))) bf16x8*)(kp+j*2048+512); }
__device__ __forceinline__ s16x4 vtr(lds_cptr p){ return __builtin_bit_cast(s16x4,__builtin_amdgcn_ds_read_tr16_b64_v4i16((__attribute__((address_space(3))) v4i16_t*)p)); }
__device__ __forceinline__ float rowmax(const f32x16&p0,const f32x16&p1){
  float a=max3f(p0[0],p0[1],p1[0]),b=max3f(p0[2],p0[3],p1[1]);a=max3f(a,p1[2],p1[3]);
  #pragma unroll
  for(int r=4;r<16;r+=4){a=max3f(a,p0[r],p0[r+1]);b=max3f(b,p0[r+2],p0[r+3]);a=max3f(a,p1[r],p1[r+1]);b=max3f(b,p1[r+2],p1[r+3]);}
  const float m=max2f(a,b);
  auto rr=__builtin_amdgcn_permlane32_swap(__float_as_uint(m),__float_as_uint(m),false,false);
  return max2f(__uint_as_float(rr[0]),__uint_as_float(rr[1]));
}
__device__ __forceinline__ void pv(f32x16*o,int vb,bf16x8 pa0,bf16x8 pa1,bf16x8 pa2,bf16x8 pa3){
  #pragma unroll
  for(int d0=0;d0<2;++d0){s16x4 lo[4],hi[4];
    #pragma unroll
    for(int ks=0;ks<4;++ks){
      asm volatile("ds_read_b64_tr_b16 %0,%1 offset:%c2":"=&v"(lo[ks]):"v"(vb),"i"(d0*4096+ks*1024):"memory");
      asm volatile("ds_read_b64_tr_b16 %0,%1 offset:%c2":"=&v"(hi[ks]):"v"(vb),"i"(d0*4096+ks*1024+512):"memory");}
    asm volatile("s_waitcnt lgkmcnt(0)":::"memory");SBAR();
    #define PK(k) (bf16x8){lo[k][0],lo[k][1],lo[k][2],lo[k][3],hi[k][0],hi[k][1],hi[k][2],hi[k][3]}
    o[d0]=__builtin_amdgcn_mfma_f32_32x32x16_bf16(pa0,PK(0),o[d0],0,0,0);
    o[d0]=__builtin_amdgcn_mfma_f32_32x32x16_bf16(pa1,PK(1),o[d0],0,0,0);
    o[d0]=__builtin_amdgcn_mfma_f32_32x32x16_bf16(pa2,PK(2),o[d0],0,0,0);
    o[d0]=__builtin_amdgcn_mfma_f32_32x32x16_bf16(pa3,PK(3),o[d0],0,0,0);
    #undef PK
  }
}

#ifndef ATTN_STORE16
#define ATTN_STORE16(p,v) (*(u32x4*)(p)=(v))
#endif
template<int THRL> __device__ __forceinline__ void attn_unit(int b,int h,int g,int qb,const bf16*Q,const bf16*__restrict__ K,const bf16*__restrict__ V,bf16*O,char*shm){
  const int tid=otid(),lane=tid&63,r32=lane&31,hi=lane>>5; const int wid=__builtin_amdgcn_readfirstlane(tid>>6);
  const long rowbase=(long)b*SEQ; const int q0=qb*QB;
  const bf16*Qw=Q+(rowbase+q0+wid*QBLK)*PQ+h*D;
  const bf16*Kh=K+rowbase*PQ+g*D,*Vh=V+rowbase*PQ+g*D;
  const unsigned lds0=(unsigned)(uintptr_t)shm;
  float*wsf=(float*)(shm+LDS_WS)+wid*64;
  const bf16*ksrc=Kh+(long)lane*PQ+wid*8;
  const bf16*vsrc=Vh+(long)(16*(wid&3)+(lane>>2))*PQ+(wid>>2)*32+(lane&3)*8;
  const unsigned kdst=lds0+LDS_K+wid*1024, vdst=lds0+LDS_V+wid*1024;
  #define DMA_K(t,slot) glds16(ksrc+(long)(t)*KVBLK*PQ,(unsigned)__builtin_amdgcn_readfirstlane(kdst+(slot)))
  #define DMA_V(t,slot) glds16(vsrc+(long)(t)*KVBLK*PQ,(unsigned)__builtin_amdgcn_readfirstlane(vdst+(slot)))
  const int vb0=(int)(lds0+LDS_V)+((lane>>4)&1)*32+(lane&3)*8+(4*hi+((lane&15)>>2))*64;
  const char*Kbase=shm+LDS_K; bf16x8 kf[8];
  const lds_cptr shm3=(lds_cptr)shm; const lds_cptr kp0=shm3+LDS_K+hi*1024+r32*16; const lds_cptr vp0=shm3+LDS_V+((lane>>4)&1)*32+(lane&3)*8+(4*hi+((lane&15)>>2))*64;
  constexpr int NT=SEQ/KVBLK;
  DMA_K(0,0);DMA_V(0,0);DMA_K(1,SLOTB);
  bf16x8 qr[4];
  #pragma unroll
  for(int d0=0;d0<4;++d0)qr[d0]=*reinterpret_cast<const bf16x8*>(&Qw[(long)r32*PQ+d0*16+hi*8]);
  float mhat=0.f,l_reg=0.f;f32x16 o[2];o[0]=f32x16{};o[1]=f32x16{};f32x16 negm=f32x16{};asm volatile("":"+v"(negm));
    #define CMASK(P0,P1,t) do{}while(0)
  bool resc=false;
  #define START(P0,P1) do{ const float rm=rowmax(P0,P1); resc=false; \
    { const float dl=rm; mhat=fadd_s(mhat,dl); \
      _Pragma("unroll") for(int r=0;r<16;++r){P0[r]=fsub_s(P0[r],dl);P1[r]=fsub_s(P1[r],dl);} \
      _Pragma("unroll") for(int r=0;r<16;++r)negm[r]=-mhat; asm volatile("":"+v"(negm)); } \
    _Pragma("unroll") for(int r=0;r<16;++r)P0[r]=__builtin_amdgcn_exp2f(P0[r]); }while(0)
  #define RESC() do{ if(resc){ asm volatile("s_waitcnt lgkmcnt(0)":::"memory"); \
      _Pragma("unroll") for(int d_=0;d_<2;++d_) _Pragma("unroll") for(int r=0;r<16;++r)o[d_][r]*=wsf[crow(r,hi)]; } }while(0)
  f32x16 pA0,pA1,pB0,pB1;
  int sl_prev=0,sl_cur=0,sl_next=SLOTB;
  #define ROT() do{sl_prev=sl_cur;sl_cur=sl_next;sl_next=(sl_next==(NSLOT-1)*SLOTB)?0:sl_next+SLOTB;}while(0)
  DMA_K(2,2*SLOTB);
  WAIT_BAR(3);
  qkt(pA0,pA1,Kbase,qr,negm,r32,hi);asm volatile("s_nop 15\n\ts_nop 7":"+v"(pA0),"+v"(pA1));CMASK(pA0,pA1,0);
  START(pA0,pA1);
  _Pragma("unroll") for(int r=0;r<16;++r)pA1[r]=__builtin_amdgcn_exp2f(pA1[r]);
  WAIT_BAR(0);
  DMA_K(3,0);DMA_V(1,SLOTB);
  ROT();
  kload8(kf,kp0+sl_cur);
  WAIT_BAR(2);
  s16x4 vlo[8],vhi[8]; u32x4 pw0,pw1,pw2,pw3;
  #define PKW(P,B) cvtpk_s(P[B],P[B+1])
  #define PAF(k) __builtin_bit_cast(bf16x8,pw##k)
  #define VFR(i) (bf16x8){vlo[i][0],vlo[i][1],vlo[i][2],vlo[i][3],vhi[i][0],vhi[i][1],vhi[i][2],vhi[i][3]}
  #define PIN(x) asm volatile("":"+v"(x))
  #define MX3(a,b,c) __builtin_fmaxf(__builtin_fmaxf((a),(b)),(c))
  #define GAPA(MF,A0,A1,A2,A3,W0,W1,PW) do{ MF; sacc+=A0; sacc+=A1; sacc+=A2; sacc+=A3; PIN(sacc); W0; W1; PIN(PW); SBAR(); }while(0)
  #define EX(v) __builtin_amdgcn_exp2f(v)
  #define GAPB(MF,X,B) do{ MF; X[B]=EX(X[B]); X[B+1]=EX(X[B+1]); X[B+2]=EX(X[B+2]); X[B+3]=EX(X[B+3]); PIN(X); SBAR(); }while(0)
  #define VRD(i) do{ vlo[i]=vtr(vp_+(((i)>>2)*4096+((i)&3)*1024)); vhi[i]=vtr(vp_+(((i)>>2)*4096+((i)&3)*1024+512)); }while(0)
  #define KRD(G,j) do{ if(G){ kload2(kf,kp0+sl_next,j); SBAR(); } }while(0)
  #define STEP(C0,C1,P0,P1,t,GK,GV,GL) do{ SBAR(); \
    const lds_cptr vp_=vp0+sl_prev; \
    VRD(0); SBAR(); float sacc=(P0[0]+P0[1]); \
    GAPA(C0=__builtin_amdgcn_mfma_f32_32x32x16_bf16(kf[0],qr[0],negm,0,0,0), P0[2],P0[3],P0[4],P0[5],     pw0[0]=PKW(P0,0), pw0[1]=PKW(P0,2), pw0); \
    VRD(4); SBAR(); GAPA(C1=__builtin_amdgcn_mfma_f32_32x32x16_bf16(kf[1],qr[0],negm,0,0,0), P0[6],P0[7],P0[8],P0[9],     pw0[2]=PKW(P0,4), pw0[3]=PKW(P0,6), pw0); \
    VRD(1); SBAR(); GAPA(C0=__builtin_amdgcn_mfma_f32_32x32x16_bf16(kf[2],qr[1],C0,0,0,0),   P0[10],P0[11],P0[12],P0[13], pw1[0]=PKW(P0,8), pw1[1]=PKW(P0,10), pw1); \
    VRD(5); SBAR(); GAPA(C1=__builtin_amdgcn_mfma_f32_32x32x16_bf16(kf[3],qr[1],C1,0,0,0),   P0[14],P0[15],P1[0],P1[1],   pw1[2]=PKW(P0,12),pw1[3]=PKW(P0,14), pw1); \
    VRD(2); SBAR(); GAPA(C0=__builtin_amdgcn_mfma_f32_32x32x16_bf16(kf[4],qr[2],C0,0,0,0),   P1[2],P1[3],P1[4],P1[5],     pw2[0]=PKW(P1,0), pw2[1]=PKW(P1,2), pw2); \
    VRD(6); SBAR(); GAPA(C1=__builtin_amdgcn_mfma_f32_32x32x16_bf16(kf[5],qr[2],C1,0,0,0),   P1[6],P1[7],P1[8],P1[9],     pw2[2]=PKW(P1,4), pw2[3]=PKW(P1,6), pw2); \
    VRD(3); SBAR(); GAPA(C0=__builtin_amdgcn_mfma_f32_32x32x16_bf16(kf[6],qr[3],C0,0,0,0),   P1[10],P1[11],P1[12],P1[13], pw3[0]=PKW(P1,8), pw3[1]=PKW(P1,10), pw3); \
    VRD(7); SBAR(); GAPA(C1=__builtin_amdgcn_mfma_f32_32x32x16_bf16(kf[7],qr[3],C1,0,0,0),   P1[14],P1[15],0.f,0.f,       pw3[2]=PKW(P1,12),pw3[3]=PKW(P1,14), pw3); \
    l_reg+=sacc; \
    if(GK){DMA_K((t)+3,sl_cur);} if(GV){DMA_V((t)+1,sl_next);} \
    CMASK(C0,C1,t); \
    { float a=MX3(C0[0],C0[1],C1[0]),b=MX3(C0[2],C0[3],C1[1]); a=MX3(a,C1[2],C1[3]); \
      _Pragma("unroll") for(int r=4;r<16;r+=4){a=MX3(a,C0[r],C0[r+1]);b=MX3(b,C0[r+2],C0[r+3]);a=MX3(a,C1[r],C1[r+1]);b=MX3(b,C1[r+2],C1[r+3]);} \
      float rm=__builtin_fmaxf(a,b); { auto rr=__builtin_amdgcn_permlane32_swap(__float_as_uint(rm),__float_as_uint(rm),false,false); rm=__builtin_fmaxf(__uint_as_float(rr[0]),__uint_as_float(rr[1])); } \
      resc=false; \
      if(__builtin_expect(__any(rm>(float)THRL),0)){ const float dl=__builtin_fmaxf(rm,0.f); mhat+=dl; \
        _Pragma("unroll") for(int r=0;r<16;++r){C0[r]-=dl;C1[r]-=dl;} \
        _Pragma("unroll") for(int r=0;r<16;++r)negm[r]=-mhat; asm volatile("":"+v"(negm)); \
        const float f=__builtin_amdgcn_exp2f(-dl); l_reg*=f; if(hi==0)wsf[r32]=f; resc=true; } } \
    SBAR(); \
    GAPB(o[0]=__builtin_amdgcn_mfma_f32_32x32x16_bf16(PAF(0),VFR(0),o[0],0,0,0), C0,0); \
    GAPB(o[1]=__builtin_amdgcn_mfma_f32_32x32x16_bf16(PAF(0),VFR(4),o[1],0,0,0), C0,4); \
    KRD(GL,0); GAPB(o[0]=__builtin_amdgcn_mfma_f32_32x32x16_bf16(PAF(1),VFR(1),o[0],0,0,0), C0,8); \
    KRD(GL,1); GAPB(o[1]=__builtin_amdgcn_mfma_f32_32x32x16_bf16(PAF(1),VFR(5),o[1],0,0,0), C0,12); \
    KRD(GL,2); GAPB(o[0]=__builtin_amdgcn_mfma_f32_32x32x16_bf16(PAF(2),VFR(2),o[0],0,0,0), C1,0); \
    KRD(GL,3); GAPB(o[1]=__builtin_amdgcn_mfma_f32_32x32x16_bf16(PAF(2),VFR(6),o[1],0,0,0), C1,4); \
    GAPB(o[0]=__builtin_amdgcn_mfma_f32_32x32x16_bf16(PAF(3),VFR(3),o[0],0,0,0), C1,8); \
    GAPB(o[1]=__builtin_amdgcn_mfma_f32_32x32x16_bf16(PAF(3),VFR(7),o[1],0,0,0), C1,12); \
    }while(0)
  int t=1;
  #undef CMASK
  #define CMASK(P0,P1,t) do{}while(0)
  for(;t+5<NT;t+=2){
    STEP(pB0,pB1,pA0,pA1,t,true,true,true);     WAIT_BAR(2); RESC(); ROT();
    STEP(pA0,pA1,pB0,pB1,t+1,true,true,true);   WAIT_BAR(2); RESC(); ROT();
  }
  #define ENDW(tt) do{ if((tt)+3<NT){WAIT_BAR(2);} else if((tt)+2<NT){WAIT_BAR(1);} else {WAIT_BAR(0);} }while(0)
  for(;t+1<NT;t+=2){
    STEP(pB0,pB1,pA0,pA1,t,(t+3<NT),(t+1<NT),(t+1<NT));       ENDW(t);   RESC(); ROT();
    STEP(pA0,pA1,pB0,pB1,t+1,(t+4<NT),(t+2<NT),(t+2<NT));     ENDW(t+1); RESC(); ROT();
  }
  STEP(pB0,pB1,pA0,pA1,NT-1,false,false,false); RESC();
  { float sacc=pB0[0]+pB0[1]; _Pragma("unroll") for(int r=2;r<16;++r)sacc+=pB0[r]; _Pragma("unroll") for(int r=0;r<16;++r)sacc+=pB1[r]; l_reg+=sacc;
    pw0=(u32x4){PKW(pB0,0),PKW(pB0,2),PKW(pB0,4),PKW(pB0,6)};pw1=(u32x4){PKW(pB0,8),PKW(pB0,10),PKW(pB0,12),PKW(pB0,14)};pw2=(u32x4){PKW(pB1,0),PKW(pB1,2),PKW(pB1,4),PKW(pB1,6)};pw3=(u32x4){PKW(pB1,8),PKW(pB1,10),PKW(pB1,12),PKW(pB1,14)};
    SBAR(); pv(o,vb0+sl_cur,PAF(0),PAF(1),PAF(2),PAF(3)); }
  #undef PKW
  #undef PAF
  #undef VFR
  #undef PIN
  #undef MX3
  #undef GAPA
  #undef GAPB
  #undef EX
  #undef VRD
  #undef KRD
  #undef STEP
  #undef ENDW
  {auto rr=__builtin_amdgcn_permlane32_swap(__float_as_uint(l_reg),__float_as_uint(l_reg),false,false);l_reg=__uint_as_float(rr[0])+__uint_as_float(rr[1]);}
  if(hi==0)wsf[32+r32]=l_reg;asm volatile("s_waitcnt lgkmcnt(0)":::"memory");
  float rli[16];
  #pragma unroll
  for(int r=0;r<16;++r)rli[r]=__builtin_amdgcn_rcpf(wsf[32+crow(r,hi)]);
  bf16*Ow=O+(rowbase+q0+wid*QBLK)*PO+h*D;
  { bf16*stg=(bf16*)(shm+LDS_OST)+wid*2048;
    #pragma unroll
    for(int r=0;r<16;++r){const int orow=crow(r,hi);
      #pragma unroll
      for(int d0=0;d0<2;++d0)stg[orow*64+d0*32+r32]=__float2bfloat16(o[d0][r]*rli[r]);}
    asm volatile("s_waitcnt lgkmcnt(0)":::"memory");
    #pragma unroll
    for(int i=0;i<4;++i){const int row=i*8+(lane>>3),ch=lane&7; const u32x4 v=*(const u32x4*)(stg+row*64+ch*8); ATTN_STORE16(Ow+(long)row*PO+ch*8,v);} }
  asm volatile("s_waitcnt lgkmcnt(0)\n\ts_barrier":::"memory");
  #undef DMA_K
  #undef DMA_V
  #undef CMASK
  #undef START
  #undef RESC
  #undef ROT
}
constexpr int ATTN_LDS_BYTES=LDS_BYTES;
#undef SBAR
#undef WAIT_BAR
}

__device__ __forceinline__ void phase_attn(const Params& p, char* lds) {
            {
                const int bid = obid();
                const int vcu = ((gridDim.x & 7) == 0) ? (bid & 7) * (int)(gridDim.x >> 3) + (bid >> 3) : bid;
                const attn_body::bf16* qkvb = (const attn_body::bf16*)(p.ws + R_QKV);
                for (int u = vcu; u < 512; u += gridDim.x) {
                    const int bg = (u & 255) >> 6, r = u & 63, hh = r & 3, qb = (r >> 2) + 16 * (u >> 8);
                    const int b = bg >> 1, g = bg & 1;
                    attn_body::attn_unit<8>(b, 4 * g + hh, g, qb, qkvb, qkvb + 512, qkvb + 640, (attn_body::bf16*)(p.ws + R_ATT), lds);
                }
            }
}

__device__ __forceinline__ f32x4 convd4(const float* row, int l0, float w0, float w1, float w2, float cb) {
    const f32x4 c = *(const f32x4*)(row + l0);
    const float lft = (l0 > 0) ? row[l0 - 1] : 0.f;
    const float rgt = (l0 + 4 < SL) ? row[l0 + 4] : 0.f;
    f32x4 o;
    o.x = cb + w0 * lft + w1 * c.x + w2 * c.y;
    o.y = cb + w0 * c.x + w1 * c.y + w2 * c.z;
    o.z = cb + w0 * c.y + w1 * c.z + w2 * c.w;
    o.w = cb + w0 * c.z + w1 * c.w + w2 * rgt;
    return o;
}
__device__ __forceinline__ void cmul_kf(float2* Z, const float2* KF, int tid) {
#pragma unroll 4
    for (int i = 0; i < 16; ++i) {
        const int pp = 2 * tid + 1024 * i;
        const f32x4 z = *(const f32x4*)(Z + zp(pp)), k = *(const f32x4*)(KF + pp);
        f32x4 o; o.x = z.x * k.x - z.y * k.y; o.y = z.x * k.y + z.y * k.x; o.z = z.z * k.z - z.w * k.w; o.w = z.z * k.w + z.w * k.z;
        *(f32x4*)(Z + zp(pp)) = o;
    }
}
__device__ __forceinline__ void hyena_job(const Params& p, int layer, int c, char* lds) {
    const int tid = otid();
    float2* Z = (float2*)lds;
    const float* HF = (const float*)(p.ws + R_HF);
    const float* cw = p.in[I_CW] + (size_t)layer * 3 * 768; const float* cbp = p.in[I_CB] + layer * 768;
    const float2* KF0 = (const float2*)(p.ws + OFF_KF) + ((size_t)(layer * 256 + c) * 2) * 16384;
    const float2* KF1 = KF0 + 16384;
    float* Y = (float*)(p.ws + R_Y) + (size_t)c * T;
    const float bias0 = p.in[I_HB][(layer * 2 + 0) * 256 + c], bias1 = p.in[I_HB][(layer * 2 + 1) * 256 + c];
    const int cv = c, c1 = 256 + c, c2 = 512 + c;
    const float* rv = HF + (size_t)cv * T; const float* r1 = HF + (size_t)c1 * T; const float* r2 = HF + (size_t)c2 * T;
    const float v_w0 = cw[cv], v_w1 = cw[768 + cv], v_w2 = cw[1536 + cv], v_cb = cbp[cv];
    const float a_w0 = cw[c1], a_w1 = cw[768 + c1], a_w2 = cw[1536 + c1], a_cb = cbp[c1];
    const float b_w0 = cw[c2], b_w1 = cw[768 + c2], b_w2 = cw[1536 + c2], b_cb = cbp[c2];
    const f32x4 zero4 = {0.f, 0.f, 0.f, 0.f};
    __syncthreads();
#pragma unroll 1
    for (int i = 0; i < 4; ++i) {
        const int l0 = 4 * otid() + 2048 * i;
        const f32x4 va = convd4(rv, l0, v_w0, v_w1, v_w2, v_cb), vb = convd4(rv + SL, l0, v_w0, v_w1, v_w2, v_cb);
        *(f32x4*)(Z + zp(l0)) = (f32x4){va.x, vb.x, va.y, vb.y}; *(f32x4*)(Z + zp(l0) + 2) = (f32x4){va.z, vb.z, va.w, vb.w};
        *(f32x4*)(Z + zp(8192 + l0)) = zero4; *(f32x4*)(Z + zp(8192 + l0) + 2) = zero4;
    }
    __syncthreads();
    fft16k_fwd(Z);
    cmul_kf(Z, KF0, otid());
    __syncthreads();
    fft16k_inv(Z);
#pragma unroll 1
    for (int i = 0; i < 4; ++i) {
        const int l0 = 4 * otid() + 2048 * i;
        const f32x4 za = *(const f32x4*)(Z + zp(l0)), zb = *(const f32x4*)(Z + zp(l0) + 2);
        const f32x4 va = convd4(rv, l0, v_w0, v_w1, v_w2, v_cb), vb = convd4(rv + SL, l0, v_w0, v_w1, v_w2, v_cb);
        const f32x4 ga = convd4(r1, l0, a_w0, a_w1, a_w2, a_cb), gb = convd4(r1 + SL, l0, a_w0, a_w1, a_w2, a_cb);
        f32x4 ya, yb;
        ya.x = ga.x * (za.x + va.x * bias0); ya.y = ga.y * (za.z + va.y * bias0); ya.z = ga.z * (zb.x + va.z * bias0); ya.w = ga.w * (zb.z + va.w * bias0);
        yb.x = gb.x * (za.y + vb.x * bias0); yb.y = gb.y * (za.w + vb.y * bias0); yb.z = gb.z * (zb.y + vb.z * bias0); yb.w = gb.w * (zb.w + vb.w * bias0);
        *(f32x4*)(Y + l0) = ya; *(f32x4*)(Y + SL + l0) = yb;
        *(f32x4*)(Z + zp(l0)) = (f32x4){ya.x, yb.x, ya.y, yb.y}; *(f32x4*)(Z + zp(l0) + 2) = (f32x4){ya.z, yb.z, ya.w, yb.w};
        *(f32x4*)(Z + zp(8192 + l0)) = zero4; *(f32x4*)(Z + zp(8192 + l0) + 2) = zero4;
    }
    __syncthreads();
    fft16k_fwd(Z);
    cmul_kf(Z, KF1, otid());
    __syncthreads();
    fft16k_inv(Z);
#pragma unroll 1
    for (int i = 0; i < 4; ++i) {
        const int l0 = 4 * otid() + 2048 * i;
        const f32x4 za = *(const f32x4*)(Z + zp(l0)), zb = *(const f32x4*)(Z + zp(l0) + 2);
        const f32x4 ga = convd4(r2, l0, b_w0, b_w1, b_w2, b_cb), gb = convd4(r2 + SL, l0, b_w0, b_w1, b_w2, b_cb);
        const f32x4 pa = *(const f32x4*)(Y + l0), pb = *(const f32x4*)(Y + SL + l0);
        f32x4 ya, yb;
        ya.x = ga.x * (za.x + pa.x * bias1); ya.y = ga.y * (za.z + pa.y * bias1); ya.z = ga.z * (zb.x + pa.z * bias1); ya.w = ga.w * (zb.z + pa.w * bias1);
        yb.x = gb.x * (za.y + pb.x * bias1); yb.y = gb.y * (za.w + pb.y * bias1); yb.z = gb.z * (zb.y + pb.z * bias1); yb.w = gb.w * (zb.w + pb.w * bias1);
        *(f32x4*)(Y + l0) = ya; *(f32x4*)(Y + SL + l0) = yb;
    }
    __syncthreads();
}

__device__ __forceinline__ void fnet_job(const Params& p, int ch, char* lds) {
    const int tid = otid();
    float2* Z = (float2*)lds;
    const float* row = (const float*)(p.ws + R_HF) + (size_t)(768 + ch) * T;
    float* UR = (float*)(p.ws + R_UR) + (size_t)ch * T;
    float* UI = (float*)(p.ws + R_UI) + (size_t)ch * T;
    __syncthreads();
#pragma unroll
    for (int i = 0; i < 4; ++i) {
        const int l0 = 4 * tid + 2048 * i;
        const f32x4 a = *(const f32x4*)(row + l0), b = *(const f32x4*)(row + SL + l0);
        const int z0 = zp(l0);
        *(f32x4*)(Z + z0) = (f32x4){a.x, b.x, a.y, b.y}; *(f32x4*)(Z + z0 + 2) = (f32x4){a.z, b.z, a.w, b.w};
    }
    __syncthreads();
    fft8k_fwd(Z);
#pragma unroll
    for (int i = 0; i < 4; ++i) {
        const int k0 = 4 * tid + 2048 * i;
        f32x4 ur0, ui0, ur1, ui1;
#pragma unroll
        for (int e = 0; e < 4; ++e) {
            const int k = k0 + e;
            const int pk = p8k_of_f(k);
            const int pm = p8k_of_f((SL - k) & (SL - 1));
            const float2 zk = Z[zp(pk)], zm = Z[zp(pm)];
            ur0[e] = 0.5f * (zk.x + zm.x); ui0[e] = 0.5f * (zk.y - zm.y);
            ur1[e] = 0.5f * (zk.y + zm.y); ui1[e] = 0.5f * (zm.x - zk.x);
        }
        *(f32x4*)(UR + k0) = ur0; *(f32x4*)(UI + k0) = ui0; *(f32x4*)(UR + SL + k0) = ur1; *(f32x4*)(UI + SL + k0) = ui1;
    }
    __syncthreads();
}

__device__ __forceinline__ void phase_mix(const Params& p, int layer, char* lds) {
    const int tid = otid(), lane = tid & 63, wave = tid >> 6;
    const int l31 = lane & 31, hl = lane >> 5, g = wave & 3, tsel = wave >> 2;
    float* ex = (float*)lds;
    const float* UR = (const float*)(p.ws + R_UR); const float* UI = (const float*)(p.ws + R_UI);
    const float* Y = (const float*)(p.ws + R_Y);
    const bf16_t* att = (const bf16_t*)(p.ws + R_ATT);
    bf16_t* mix = (bf16_t*)(p.ws + R_MIX);
    const float* FMg = (const float*)(p.ws + OFF_FM) + ((size_t)layer * 4 + g) * 128 * 64;
    const float* fb = p.in[I_FB] + layer * 256 + g * 64;
    const float* mg = p.in[I_MG] + layer * 1024;
    for (int tp = obid(); tp < T / 64; tp += gridDim.x) {
        const int t = (tp * 2 + tsel) * 32 + l31;
        f32x16 acc0 = zero16(), acc1 = zero16();
        {
            const float* ub = UR + (size_t)(g * 64 + hl) * T + t;
            const float* fa = FMg + hl * 64 + l31;
#pragma unroll 16
            for (int dd0 = 0; dd0 < 64; dd0 += 2) {
                const float bv = ub[(size_t)dd0 * T];
                const float a0 = fa[dd0 * 64], a1 = fa[dd0 * 64 + 32];
                acc0 = __builtin_amdgcn_mfma_f32_32x32x2f32(a0, bv, acc0, 0, 0, 0);
                acc1 = __builtin_amdgcn_mfma_f32_32x32x2f32(a1, bv, acc1, 0, 0, 0);
            }
            const float* ub2 = UI + (size_t)(g * 64 + hl) * T + t;
            const float* fa2 = FMg + (64 + hl) * 64 + l31;
#pragma unroll 16
            for (int dd0 = 0; dd0 < 64; dd0 += 2) {
                const float bv = ub2[(size_t)dd0 * T];
                const float a0 = fa2[dd0 * 64], a1 = fa2[dd0 * 64 + 32];
                acc0 = __builtin_amdgcn_mfma_f32_32x32x2f32(a0, bv, acc0, 0, 0, 0);
                acc1 = __builtin_amdgcn_mfma_f32_32x32x2f32(a1, bv, acc1, 0, 0, 0);
            }
        }
        float sf = 0.f;
#pragma unroll
        for (int i = 0; i < 4; ++i) {
            const f32x4 b0 = *(const f32x4*)(fb + 8 * i + 4 * hl), b1 = *(const f32x4*)(fb + 32 + 8 * i + 4 * hl);
            acc0[4 * i] += b0.x; acc0[4 * i + 1] += b0.y; acc0[4 * i + 2] += b0.z; acc0[4 * i + 3] += b0.w;
            acc1[4 * i] += b1.x; acc1[4 * i + 1] += b1.y; acc1[4 * i + 2] += b1.z; acc1[4 * i + 3] += b1.w;
        }
#pragma unroll
        for (int r = 0; r < 16; ++r) sf += acc0[r] * acc0[r] + acc1[r] * acc1[r];
        float sy = 0.f;
        const float* yb = Y + (size_t)(g * 64 + hl * 32) * T + t;
#pragma unroll 32
        for (int i = 0; i < 32; ++i) { const float y = yb[(size_t)i * T]; sy += y * y; }
        float sa = 0.f;
        const bf16_t* ab = att + (size_t)t * 512 + g * 128 + hl * 64;
#pragma unroll 4
        for (int q = 0; q < 8; ++q) {
            const u32x4 a = *(const u32x4*)(ab + 8 * q);
            const float x0 = bflo(a.x), x1 = bfhi(a.x), x2 = bflo(a.y), x3 = bfhi(a.y), x4 = bflo(a.z), x5 = bfhi(a.z), x6 = bflo(a.w), x7 = bfhi(a.w);
            sa += x0 * x0 + x1 * x1 + x2 * x2 + x3 * x3 + x4 * x4 + x5 * x5 + x6 * x6 + x7 * x7;
        }
        __syncthreads();
        ex[(0 * 8 + wave) * 64 + lane] = sa; ex[(1 * 8 + wave) * 64 + lane] = sy; ex[(2 * 8 + wave) * 64 + lane] = sf;
        __syncthreads();
        float ta = 0.f, ty = 0.f, tf = 0.f;
#pragma unroll
        for (int w = 0; w < 4; ++w)
#pragma unroll
            for (int hh = 0; hh < 2; ++hh) {
                const int o = (tsel * 4 + w) * 64 + hh * 32 + l31;
                ta += ex[0 * 512 + o]; ty += ex[1 * 512 + o]; tf += ex[2 * 512 + o];
            }
        const float ra = rsqrtf(ta * (1.0f / 512.0f) + EPS), ry = rsqrtf(ty * (1.0f / 256.0f) + EPS), rf = rsqrtf(tf * (1.0f / 256.0f) + EPS);
        bf16_t* mrow = mix + (size_t)t * 1024;
        {
            const float* gg = mg + g * 128 + hl * 64;
#pragma unroll 4
            for (int q = 0; q < 8; ++q) {
                const u32x4 a = *(const u32x4*)(ab + 8 * q);
                const f32x4 g0 = *(const f32x4*)(gg + 8 * q), g1 = *(const f32x4*)(gg + 8 * q + 4);
                u32x4 o;
                o.x = pk2(bflo(a.x) * ra * g0.x, bfhi(a.x) * ra * g0.y); o.y = pk2(bflo(a.y) * ra * g0.z, bfhi(a.y) * ra * g0.w);
                o.z = pk2(bflo(a.z) * ra * g1.x, bfhi(a.z) * ra * g1.y); o.w = pk2(bflo(a.w) * ra * g1.z, bfhi(a.w) * ra * g1.w);
                *(u32x4*)(mrow + g * 128 + hl * 64 + 8 * q) = o;
            }
        }
        {
            const float* gg = mg + 512 + g * 64 + hl * 32;
#pragma unroll 2
            for (int q = 0; q < 4; ++q) {
                float yv[8];
#pragma unroll
                for (int i = 0; i < 8; ++i) yv[i] = yb[(size_t)(8 * q + i) * T];
                const f32x4 g0 = *(const f32x4*)(gg + 8 * q), g1 = *(const f32x4*)(gg + 8 * q + 4);
                u32x4 o;
                o.x = pk2(yv[0] * ry * g0.x, yv[1] * ry * g0.y); o.y = pk2(yv[2] * ry * g0.z, yv[3] * ry * g0.w);
                o.z = pk2(yv[4] * ry * g1.x, yv[5] * ry * g1.y); o.w = pk2(yv[6] * ry * g1.z, yv[7] * ry * g1.w);
                *(u32x4*)(mrow + 512 + g * 64 + hl * 32 + 8 * q) = o;
            }
        }
        {
            const float* gg = mg + 768 + g * 64;
#pragma unroll
            for (int i = 0; i < 4; ++i) {
                const f32x4 g0 = *(const f32x4*)(gg + 8 * i + 4 * hl), g1 = *(const f32x4*)(gg + 32 + 8 * i + 4 * hl);
                u32x2 o0, o1;
                o0.x = pk2(acc0[4 * i] * rf * g0.x, acc0[4 * i + 1] * rf * g0.y); o0.y = pk2(acc0[4 * i + 2] * rf * g0.z, acc0[4 * i + 3] * rf * g0.w);
                o1.x = pk2(acc1[4 * i] * rf * g1.x, acc1[4 * i + 1] * rf * g1.y); o1.y = pk2(acc1[4 * i + 2] * rf * g1.z, acc1[4 * i + 3] * rf * g1.w);
                *(u32x2*)(mrow + 768 + g * 64 + 8 * i + 4 * hl) = o0;
                *(u32x2*)(mrow + 768 + g * 64 + 32 + 8 * i + 4 * hl) = o1;
            }
        }
    }
}

#define TK_INS(L, X) do { float x_ = (X); _Pragma("unroll") for (int i_ = 0; i_ < 16; ++i_) { const float hi_ = fmaxf(L[i_], x_); x_ = fminf(L[i_], x_); L[i_] = hi_; } } while (0)
__device__ __forceinline__ float tk_pack(float v, unsigned code, unsigned mask) { return __builtin_bit_cast(float, (__builtin_bit_cast(unsigned, v) & ~mask) | code); }
__device__ __forceinline__ unsigned tk_lookup(const unsigned (&P)[4], unsigned i) {
    const unsigned w = (i < 4u) ? P[0] : (i < 8u) ? P[1] : (i < 12u) ? P[2] : P[3];
    return (w >> ((i & 3u) * 8u)) & 0x7Fu;
}
__device__ __forceinline__ void phase_peer_topk(const Params& p, int layer, char* lds, int* IDX, float* GATE) {
    const int tid = otid(), lane = tid & 63, wave = tid >> 6;
    const float* SC = (const float*)(p.ws + R_QP);
    const float NINF = -3.0e38f;
    const int pp = lane & 1;
    const int gw = obid() * NWAVE + wave, ngw = gridDim.x * NWAVE;
    for (int grp = gw; grp < T * 8 / 32; grp += ngw) {
        const int prob = grp * 32 + (lane >> 1);
        const int t = prob >> 3, h = prob & 7;
        const f32x4* src = (const f32x4*)(SC + (size_t)t * 2048 + h * 256 + pp * 128);
        float l[16];
#pragma unroll
        for (int i = 0; i < 16; ++i) l[i] = NINF;
#pragma unroll 1
        for (int c = 0; c < 4; ++c) {
            f32x4 v[8];
#pragma unroll
            for (int j = 0; j < 8; ++j) v[j] = src[c * 8 + j];
#pragma unroll
            for (int j = 0; j < 8; ++j) {
                const unsigned kb = (unsigned)(c * 32 + j * 4);
                TK_INS(l, tk_pack(v[j].x, kb, 0x7Fu)); TK_INS(l, tk_pack(v[j].y, kb + 1u, 0x7Fu));
                TK_INS(l, tk_pack(v[j].z, kb + 2u, 0x7Fu)); TK_INS(l, tk_pack(v[j].w, kb + 3u, 0x7Fu));
            }
        }
        float xv[16], ov[16]; unsigned PX[4] = {0u, 0u, 0u, 0u}, PO[4] = {0u, 0u, 0u, 0u};
#pragma unroll
        for (int i = 0; i < 16; ++i) {
            const float o = __shfl_xor(l[i], 1);
            const unsigned xb = __builtin_bit_cast(unsigned, l[i]), ob = __builtin_bit_cast(unsigned, o);
            xv[i] = __builtin_bit_cast(float, xb & ~0x7Fu); ov[i] = __builtin_bit_cast(float, ob & ~0x7Fu);
            PX[i >> 2] |= (xb & 0x7Fu) << ((i & 3) * 8); PO[i >> 2] |= (ob & 0x7Fu) << ((i & 3) * 8);
        }
        float f[16];
#pragma unroll
        for (int i = 0; i < 16; ++i) f[i] = NINF;
#pragma unroll
        for (int i = 0; i < 16; ++i)
#pragma unroll
            for (int j = i; j < 16; ++j)
                if ((i + 1) * (j + 1) <= 16) {
                    float cv = xv[i] + ov[j];
                    const unsigned code = pp ? (unsigned)((j << 4) | i) : (unsigned)((i << 4) | j);
                    cv = tk_pack(cv, code, 0xFFu);
                    if (i == j) cv = pp ? NINF : cv;
                    TK_INS(f, cv);
                }
        {
            float g[16];
#pragma unroll
            for (int i = 0; i < 16; ++i) g[i] = __shfl_xor(f[i], 1);
#pragma unroll
            for (int i = 0; i < 16; ++i) TK_INS(f, g[i]);
        }
        unsigned P0[4], P1[4];
#pragma unroll
        for (int q = 0; q < 4; ++q) { P0[q] = pp ? PO[q] : PX[q]; P1[q] = pp ? PX[q] : PO[q]; }
        const float top = __builtin_bit_cast(float, __builtin_bit_cast(unsigned, f[0]) & ~0xFFu);
        float ev[16]; int ei[16]; float den = 0.f;
#pragma unroll
        for (int r = 0; r < 16; ++r) {
            const unsigned fb = __builtin_bit_cast(unsigned, f[r]);
            const unsigned code = fb & 0xFFu;
            ei[r] = (int)(tk_lookup(P0, code >> 4) * 128u + tk_lookup(P1, code & 15u));
            ev[r] = __expf(__builtin_bit_cast(float, fb & ~0xFFu) - top);
            den += ev[r];
        }
        const float rden = 1.0f / den;
        const size_t ob = (size_t)t * 2048 + h * 16;
        if (pp == 0) {
#pragma unroll
            for (int q = 0; q < 4; ++q) { int4 w; w.x = ei[4 * q]; w.y = ei[4 * q + 1]; w.z = ei[4 * q + 2]; w.w = ei[4 * q + 3]; *(int4*)(IDX + ob + 4 * q) = w; }
        } else {
#pragma unroll
            for (int q = 0; q < 4; ++q) { f32x4 w; w.x = ev[4 * q] * rden; w.y = ev[4 * q + 1] * rden; w.z = ev[4 * q + 2] * rden; w.w = ev[4 * q + 3] * rden; *(f32x4*)(GATE + ob + 128 + 4 * q) = w; }
        }
    }
}

__device__ __forceinline__ float gelu_exact(float x) { return 0.5f * x * (1.0f + erff(x * 0.70710678118654752f)); }
typedef float f32x2 __attribute__((ext_vector_type(2)));
#define CVT_LO(W) __builtin_amdgcn_cvt_pk_f32_fp8((int)(W), false)
#define CVT_HI(W) __builtin_amdgcn_cvt_pk_f32_fp8((int)(W), true)
template <bool DRY, int EMASK = 16383> __device__ __forceinline__ void phase_peer_gather(const Params& p, int layer) {
    const int lane = otid() & 63, wave = otid() >> 6;
    const int gw = obid() * NWAVE + wave, ngw = gridDim.x * NWAVE;
    const unsigned char* PU = p.ws + OFF_PU + (size_t)layer * 16384 * 1024;
    const unsigned char* PV = p.ws + OFF_PV + (size_t)layer * 16384 * 1024;
    const float* SU = (const float*)(p.ws + OFF_PSC) + (size_t)layer * 16384;
    const float* SV = (const float*)(p.ws + OFF_PSC) + (size_t)(2 + layer) * 16384;
    bf16_t* XN = (bf16_t*)(p.ws + R_XN);
    float* XA = (float*)(p.ws + OFF_XA);
    const float* SC = (const float*)(p.ws + R_QP);
    const bool last = (layer == NLAYER - 1);
    const float* gnext = last ? p.in[I_FG] : p.in[I_N1G] + (layer + 1) * DM;
    const bool b5 = (lane & 32) != 0, b4 = (lane & 16) != 0, b3 = (lane & 8) != 0;
    const unsigned loff = (unsigned)lane * 16u;
    for (int t = gw; t < T; t += ngw) {
        f32x2 xv[8];
#pragma unroll
        for (int j = 0; j < 4; ++j) {
            const u32x2 a = *(const u32x2*)(XN + (size_t)t * DM + 4 * lane + 256 * j);
            xv[2 * j] = (f32x2){bflo(a.x), bfhi(a.x)}; xv[2 * j + 1] = (f32x2){bflo(a.y), bfhi(a.y)};
        }
        f32x2 acc[8];
#pragma unroll
        for (int j = 0; j < 8; ++j) acc[j] = (f32x2){0.f, 0.f};
        const int* idxp = (const int*)(SC + (size_t)t * 2048);
        const float* gatep = SC + (size_t)t * 2048 + 128;
#pragma unroll 1
        for (int half = 0; half < 2; ++half) {
            const int myi = idxp[half * 64 + lane] & EMASK;
            const float mycu = SU[myi];
            const float mycg = gatep[half * 64 + lane] * SV[myi];
#pragma unroll 1
            for (int e0 = 0; e0 < 64; e0 += 8) {
                u32x4 ur[8], vr[8];
#pragma unroll
                for (int k = 0; k < 8; ++k) {
                    const unsigned e = (unsigned)__builtin_amdgcn_readlane(myi, e0 + k);
                    ur[k] = *(const u32x4*)(PU + (size_t)(e * 1024u) + loff);
                    vr[k] = *(const u32x4*)(PV + (size_t)(e * 1024u) + loff);
                }
                float d[8];
#pragma unroll
                for (int k = 0; k < 8; ++k) {
                    f32x2 s2 = CVT_LO(ur[k].x) * xv[0];
                    s2 += CVT_HI(ur[k].x) * xv[1]; s2 += CVT_LO(ur[k].y) * xv[2]; s2 += CVT_HI(ur[k].y) * xv[3];
                    s2 += CVT_LO(ur[k].z) * xv[4]; s2 += CVT_HI(ur[k].z) * xv[5]; s2 += CVT_LO(ur[k].w) * xv[6]; s2 += CVT_HI(ur[k].w) * xv[7];
                    d[k] = s2.x + s2.y;
                }
                float r4[4], r2[2], u1;
#pragma unroll
                for (int k = 0; k < 4; ++k) { const float send = b5 ? d[k] : d[k + 4], keep = b5 ? d[k + 4] : d[k]; r4[k] = keep + __shfl_xor(send, 32); }
#pragma unroll
                for (int k = 0; k < 2; ++k) { const float send = b4 ? r4[k] : r4[k + 2], keep = b4 ? r4[k + 2] : r4[k]; r2[k] = keep + __shfl_xor(send, 16); }
                { const float send = b3 ? r2[0] : r2[1], keep = b3 ? r2[1] : r2[0]; u1 = keep + __shfl_xor(send, 8); }
                u1 += __shfl_xor(u1, 4); u1 += __shfl_xor(u1, 2); u1 += __shfl_xor(u1, 1);
                const int kk = e0 + (lane >> 3);
                const float av = gelu_exact(u1 * __shfl(mycu, kk)) * __shfl(mycg, kk);
#pragma unroll
                for (int k = 0; k < 8; ++k) {
                    const float a = __builtin_bit_cast(float, __builtin_amdgcn_readlane(__builtin_bit_cast(int, av), 8 * k));
                    const f32x2 a2 = (f32x2){a, a};
                    acc[0] += a2 * CVT_LO(vr[k].x); acc[1] += a2 * CVT_HI(vr[k].x); acc[2] += a2 * CVT_LO(vr[k].y); acc[3] += a2 * CVT_HI(vr[k].y);
                    acc[4] += a2 * CVT_LO(vr[k].z); acc[5] += a2 * CVT_HI(vr[k].z); acc[6] += a2 * CVT_LO(vr[k].w); acc[7] += a2 * CVT_HI(vr[k].w);
                }
            }
        }
        f32x4 x[4]; float ss = 0.f;
#pragma unroll
        for (int j = 0; j < 4; ++j) {
            x[j] = *(const f32x4*)(XA + (size_t)t * DM + 4 * lane + 256 * j);
            x[j].x += acc[2 * j].x; x[j].y += acc[2 * j].y; x[j].z += acc[2 * j + 1].x; x[j].w += acc[2 * j + 1].y;
            ss += x[j].x * x[j].x + x[j].y * x[j].y + x[j].z * x[j].z + x[j].w * x[j].w;
        }
        ss = wave_sum(ss);
        const float r = rsqrtf(ss * (1.0f / DM) + EPS);
        if (last) {
#pragma unroll
            for (int j = 0; j < 4; ++j) { const f32x4 gg = *(const f32x4*)(gnext + 4 * lane + 256 * j); *(f32x4*)(p.out + (size_t)t * DM + 4 * lane + 256 * j) = x[j] * r * gg; }
        } else {
#pragma unroll
            for (int j = 0; j < 4; ++j) {
                const f32x4 gg = *(const f32x4*)(gnext + 4 * lane + 256 * j);
                *(f32x4*)((DRY ? p.out : XA) + (size_t)t * DM + 4 * lane + 256 * j) = x[j];
                u32x2 w; w.x = pk2(x[j].x * r * gg.x, x[j].y * r * gg.y); w.y = pk2(x[j].z * r * gg.z, x[j].w * r * gg.w);
                if (!DRY) *(u32x2*)(XN + (size_t)t * DM + 4 * lane + 256 * j) = w;
            }
        }
    }
}

#ifndef PE_NTK
#define PE_NTK 2
#endif
#ifndef PE_PASS_SYNC
#define PE_PASS_SYNC 0
#endif
constexpr int PE_ENT = 12 * 1024;
constexpr int PE_WAVE = PE_ENT + 1024;
#define PE_TOKEN_CHUNK(TK) do { \
    const int s_ = st[(sr * PE_NTK + (TK)) * 32 + r], e_ = st[(sr * PE_NTK + (TK)) * 32 + r + 1]; \
    for (int pos = s_; pos < e_; pos += 8) { \
        const int n = (e_ - pos < 8) ? (e_ - pos) : 8; \
        const int ei_ = pos + (lane >> 3); \
        const bool ok_ = (lane >> 3) < n; \
        const int base_ = ((sr * PE_NTK + (TK)) * 128 + (ok_ ? ei_ : pos)) * 3; \
        const int ev = ent[base_]; const float cu = __builtin_bit_cast(float, ent[base_ + 1]), cg = __builtin_bit_cast(float, ent[base_ + 2]); \
        f32x2 xl[8]; \
        _Pragma("unroll") for (int j = 0; j < 4; ++j) { xl[2 * j] = (f32x2){bflo(xp[TK][j].x), bfhi(xp[TK][j].x)}; xl[2 * j + 1] = (f32x2){bflo(xp[TK][j].y), bfhi(xp[TK][j].y)}; } \
        u32x4 ur[8], vr[8]; \
        _Pragma("unroll") for (int k = 0; k < 8; ++k) { \
            if (k < n) { const unsigned e = (unsigned)__builtin_amdgcn_readlane(ev, 8 * k); \
                ur[k] = *(const u32x4*)(PU + (size_t)(e * 1024u) + loff); vr[k] = *(const u32x4*)(PV + (size_t)(e * 1024u) + loff); } \
            else { ur[k] = (u32x4){0u, 0u, 0u, 0u}; vr[k] = (u32x4){0u, 0u, 0u, 0u}; } } \
        float d[8]; \
        _Pragma("unroll") for (int k = 0; k < 8; ++k) { \
            if (k < n) { f32x2 s2 = CVT_LO(ur[k].x) * xl[0]; \
                s2 += CVT_HI(ur[k].x) * xl[1]; s2 += CVT_LO(ur[k].y) * xl[2]; s2 += CVT_HI(ur[k].y) * xl[3]; \
                s2 += CVT_LO(ur[k].z) * xl[4]; s2 += CVT_HI(ur[k].z) * xl[5]; s2 += CVT_LO(ur[k].w) * xl[6]; s2 += CVT_HI(ur[k].w) * xl[7]; \
                d[k] = s2.x + s2.y; } else d[k] = 0.f; } \
        float r4[4], r2[2], u1; \
        _Pragma("unroll") for (int k = 0; k < 4; ++k) { const float send = b5 ? d[k] : d[k + 4], keep = b5 ? d[k + 4] : d[k]; r4[k] = keep + __shfl_xor(send, 32); } \
        _Pragma("unroll") for (int k = 0; k < 2; ++k) { const float send = b4 ? r4[k] : r4[k + 2], keep = b4 ? r4[k + 2] : r4[k]; r2[k] = keep + __shfl_xor(send, 16); } \
        { const float send = b3 ? r2[0] : r2[1], keep = b3 ? r2[1] : r2[0]; u1 = keep + __shfl_xor(send, 8); } \
        u1 += __shfl_xor(u1, 4); u1 += __shfl_xor(u1, 2); u1 += __shfl_xor(u1, 1); \
        const float av = ok_ ? gelu_exact(u1 * cu) * cg : 0.f; \
        _Pragma("unroll") for (int k = 0; k < 8; ++k) { \
            if (k < n) { const float a = __builtin_bit_cast(float, __builtin_amdgcn_readlane(__builtin_bit_cast(int, av), 8 * k)); \
                const f32x2 a2 = (f32x2){a, a}; \
                acc[TK][0] += a2 * CVT_LO(vr[k].x); acc[TK][1] += a2 * CVT_HI(vr[k].x); acc[TK][2] += a2 * CVT_LO(vr[k].y); acc[TK][3] += a2 * CVT_HI(vr[k].y); \
                acc[TK][4] += a2 * CVT_LO(vr[k].z); acc[TK][5] += a2 * CVT_HI(vr[k].z); acc[TK][6] += a2 * CVT_LO(vr[k].w); acc[TK][7] += a2 * CVT_HI(vr[k].w); } } \
    } } while (0)

template <bool DRY> __device__ __forceinline__ void phase_peer_fused(const Params& p, int layer, char* lds) {
    const int tid = otid(), lane = tid & 63, wave = tid >> 6;
    const unsigned char* PU = p.ws + OFF_PU + (size_t)layer * 16384 * 1024;
    const unsigned char* PV = p.ws + OFF_PV + (size_t)layer * 16384 * 1024;
    const float* SU = (const float*)(p.ws + OFF_PSC) + (size_t)layer * 16384;
    const float* SV = (const float*)(p.ws + OFF_PSC) + (size_t)(2 + layer) * 16384;
    bf16_t* XN = (bf16_t*)(p.ws + R_XN);
    float* XA = (float*)(p.ws + OFF_XA);
    const float* SC = (const float*)(p.ws + R_QP);
    const bool last = (layer == NLAYER - 1);
    const float* gnext = last ? p.in[I_FG] : p.in[I_N1G] + (layer + 1) * DM;
    const float* g2p = p.in[I_N2G] + layer * DM;
    const bool b5 = (lane & 32) != 0, b4 = (lane & 16) != 0, b3 = (lane & 8) != 0;
    const unsigned loff = (unsigned)lane * 16u;
    int* ent = (int*)(lds + wave * PE_WAVE);
    int* st = (int*)(lds + wave * PE_WAVE + PE_ENT);
    const float NINF = -3.0e38f;
    const int pp = lane & 1;
    for (int tb = (obid() * NWAVE + wave) * 8; tb < T; tb += gridDim.x * NWAVE * 8) {
#pragma unroll 1
        for (int grp = 0; grp < 2; ++grp) {
            const int tkl = grp * 4 + (lane >> 4), h = (lane >> 1) & 7;
            const f32x4* src = (const f32x4*)(SC + (size_t)(tb + tkl) * 2048 + h * 256 + pp * 128);
            float l[16];
#pragma unroll
            for (int i = 0; i < 16; ++i) l[i] = NINF;
#pragma unroll 1
            for (int c = 0; c < 4; ++c) {
                f32x4 v[8];
#pragma unroll
                for (int j = 0; j < 8; ++j) v[j] = src[c * 8 + j];
#pragma unroll
                for (int j = 0; j < 8; ++j) {
                    const unsigned kb = (unsigned)(c * 32 + j * 4);
                    TK_INS(l, tk_pack(v[j].x, kb, 0x7Fu)); TK_INS(l, tk_pack(v[j].y, kb + 1u, 0x7Fu));
                    TK_INS(l, tk_pack(v[j].z, kb + 2u, 0x7Fu)); TK_INS(l, tk_pack(v[j].w, kb + 3u, 0x7Fu));
                }
            }
            float xw[16], ow[16]; unsigned PX[4] = {0u, 0u, 0u, 0u}, PO[4] = {0u, 0u, 0u, 0u};
#pragma unroll
            for (int i = 0; i < 16; ++i) {
                const float o = __shfl_xor(l[i], 1);
                const unsigned xb = __builtin_bit_cast(unsigned, l[i]), ob = __builtin_bit_cast(unsigned, o);
                xw[i] = __builtin_bit_cast(float, xb & ~0x7Fu); ow[i] = __builtin_bit_cast(float, ob & ~0x7Fu);
                PX[i >> 2] |= (xb & 0x7Fu) << ((i & 3) * 8); PO[i >> 2] |= (ob & 0x7Fu) << ((i & 3) * 8);
            }
            float f[16];
#pragma unroll
            for (int i = 0; i < 16; ++i) f[i] = NINF;
#pragma unroll
            for (int i = 0; i < 16; ++i)
#pragma unroll
                for (int j = i; j < 16; ++j)
                    if ((i + 1) * (j + 1) <= 16) {
                        float cv = xw[i] + ow[j];
                        const unsigned code = pp ? (unsigned)((j << 4) | i) : (unsigned)((i << 4) | j);
                        cv = tk_pack(cv, code, 0xFFu);
                        if (i == j) cv = pp ? NINF : cv;
                        TK_INS(f, cv);
                    }
            {
                float gq[16];
#pragma unroll
                for (int i = 0; i < 16; ++i) gq[i] = __shfl_xor(f[i], 1);
#pragma unroll
                for (int i = 0; i < 16; ++i) TK_INS(f, gq[i]);
            }
            unsigned P0[4], P1[4];
#pragma unroll
            for (int q = 0; q < 4; ++q) { P0[q] = pp ? PO[q] : PX[q]; P1[q] = pp ? PX[q] : PO[q]; }
            const float top = __builtin_bit_cast(float, __builtin_bit_cast(unsigned, f[0]) & ~0xFFu);
            float ev[16]; float den = 0.f;
#pragma unroll
            for (int r = 0; r < 16; ++r) { ev[r] = __expf(__builtin_bit_cast(float, __builtin_bit_cast(unsigned, f[r]) & ~0xFFu) - top); den += ev[r]; }
            const float rden = 1.0f / den;
#pragma unroll
            for (int r8 = 0; r8 < 8; ++r8) {
                const unsigned c0 = __builtin_bit_cast(unsigned, f[r8]) & 0xFFu, c1 = __builtin_bit_cast(unsigned, f[r8 + 8]) & 0xFFu;
                const unsigned code = pp ? c1 : c0;
                const float gate = (pp ? ev[r8 + 8] : ev[r8]) * rden;
                const int e = (int)(tk_lookup(P0, code >> 4) * 128u + tk_lookup(P1, code & 15u));
                const int o = (tkl * 128 + h * 16 + pp * 8 + r8) * 3;
                ent[o] = e; ent[o + 1] = __builtin_bit_cast(int, SU[e]); ent[o + 2] = __builtin_bit_cast(int, gate * SV[e]);
            }
        }
#pragma unroll 1
        for (int tk = 0; tk < 8; ++tk) {
            int* et = ent + tk * 384;
            const int eA = et[lane * 3], uA = et[lane * 3 + 1], gA = et[lane * 3 + 2];
            const int eB = et[(64 + lane) * 3], uB = et[(64 + lane) * 3 + 1], gB = et[(64 + lane) * 3 + 2];
            const int rA = eA >> 10, rB = eB >> 10;
            int base = 0;
#pragma unroll 1
            for (int r = 0; r < 16; ++r) {
                const unsigned long long mA = __ballot(rA == r), mB = __ballot(rB == r);
                const int cA = __popcll(mA);
                if (lane == 0) st[tk * 32 + r] = base;
                if (rA == r) { const int q = base + (int)__builtin_amdgcn_mbcnt_hi((unsigned)(mA >> 32), __builtin_amdgcn_mbcnt_lo((unsigned)mA, 0u)); et[q * 3] = eA; et[q * 3 + 1] = uA; et[q * 3 + 2] = gA; }
                if (rB == r) { const int q = base + cA + (int)__builtin_amdgcn_mbcnt_hi((unsigned)(mB >> 32), __builtin_amdgcn_mbcnt_lo((unsigned)mB, 0u)); et[q * 3] = eB; et[q * 3 + 1] = uB; et[q * 3 + 2] = gB; }
                base += cA + __popcll(mB);
            }
            if (lane == 0) st[tk * 32 + 16] = base;
        }
#pragma unroll 1
        for (int sr = 0; sr < 8 / PE_NTK; ++sr) {
            u32x2 xp[PE_NTK][4]; f32x2 acc[PE_NTK][8];
#pragma unroll
            for (int tk = 0; tk < PE_NTK; ++tk) {
                f32x4 xr[4]; float ss = 0.f;
#pragma unroll
                for (int j = 0; j < 4; ++j) { xr[j] = *(const f32x4*)(XA + (size_t)(tb + sr * PE_NTK + tk) * DM + 4 * lane + 256 * j); ss += xr[j].x * xr[j].x + xr[j].y * xr[j].y + xr[j].z * xr[j].z + xr[j].w * xr[j].w; }
                ss = wave_sum(ss);
                const float rn = rsqrtf(ss * (1.0f / DM) + EPS);
#pragma unroll
                for (int j = 0; j < 4; ++j) { const f32x4 gg = *(const f32x4*)(g2p + 4 * lane + 256 * j);
                    xp[tk][j].x = pk2(xr[j].x * rn * gg.x, xr[j].y * rn * gg.y); xp[tk][j].y = pk2(xr[j].z * rn * gg.z, xr[j].w * rn * gg.w); }
#pragma unroll
                for (int j = 0; j < 8; ++j) acc[tk][j] = (f32x2){0.f, 0.f};
            }
#pragma unroll 1
            for (int r = 0; r < 16; ++r) {
#if PE_PASS_SYNC
                __syncthreads();
#endif
                PE_TOKEN_CHUNK(0); PE_TOKEN_CHUNK(1);
#if PE_NTK == 4
                PE_TOKEN_CHUNK(2); PE_TOKEN_CHUNK(3);
#endif
            }
#pragma unroll
            for (int tk = 0; tk < PE_NTK; ++tk) {
                const int t = tb + sr * PE_NTK + tk;
                f32x4 x[4]; float ss = 0.f;
#pragma unroll
                for (int j = 0; j < 4; ++j) {
                    x[j] = *(const f32x4*)(XA + (size_t)t * DM + 4 * lane + 256 * j);
                    x[j].x += acc[tk][2 * j].x; x[j].y += acc[tk][2 * j].y; x[j].z += acc[tk][2 * j + 1].x; x[j].w += acc[tk][2 * j + 1].y;
                    ss += x[j].x * x[j].x + x[j].y * x[j].y + x[j].z * x[j].z + x[j].w * x[j].w;
                }
                ss = wave_sum(ss);
                const float rr = rsqrtf(ss * (1.0f / DM) + EPS);
                if (last) {
#pragma unroll
                    for (int j = 0; j < 4; ++j) { const f32x4 gg = *(const f32x4*)(gnext + 4 * lane + 256 * j); *(f32x4*)(p.out + (size_t)t * DM + 4 * lane + 256 * j) = x[j] * rr * gg; }
                } else {
#pragma unroll
                    for (int j = 0; j < 4; ++j) {
                        const f32x4 gg = *(const f32x4*)(gnext + 4 * lane + 256 * j);
                        *(f32x4*)((DRY ? p.out : XA) + (size_t)t * DM + 4 * lane + 256 * j) = x[j];
                        u32x2 w; w.x = pk2(x[j].x * rr * gg.x, x[j].y * rr * gg.y); w.y = pk2(x[j].z * rr * gg.z, x[j].w * rr * gg.w);
                        if (!DRY) *(u32x2*)(XN + (size_t)t * DM + 4 * lane + 256 * j) = w;
                    }
                }
            }
        }
    }
}

#define LAS __attribute__((address_space(3)))
#define XB_TMO      128
#define XB_XCNT(j)  (256  + 64 * (j))
#define XB_XSUB(j)  (1280 + 64 * (j))
#define XB_XGEN(j)  (2304 + 64 * (j))
#define XB_TOP      3328
#define XB_TOPGEN   3392
#define XCD_BAR_WORDS 3456
#define XB_SPIN_CAP (1u << 20)
__device__ __forceinline__ unsigned xb_ld(unsigned* p)              { return __hip_atomic_load(p, __ATOMIC_RELAXED, __HIP_MEMORY_SCOPE_AGENT); }
__device__ __forceinline__ unsigned xb_add(unsigned* p, unsigned v) { return __hip_atomic_fetch_add(p, v, __ATOMIC_RELAXED, __HIP_MEMORY_SCOPE_AGENT); }
__device__ __forceinline__ unsigned xb_xcc_id() { return (unsigned)__builtin_amdgcn_s_getreg((3 << 11) | 20) & 0xFu; }
#define XB_SPIN(cond, bar) do { unsigned _sp = 0; while (cond) { __builtin_amdgcn_s_sleep(1); \
    if ((++_sp & 255u) == 0u) { if (xb_ld(&(bar)[XB_TMO])) break; if (_sp > XB_SPIN_CAP) { atomicAdd(&(bar)[XB_TMO], 1u); break; } } } } while (0)
struct XcdBarrier { unsigned* bar; unsigned x; volatile LAS unsigned* st; };
__device__ __forceinline__ XcdBarrier xcd_barrier_post(unsigned* bar, volatile LAS unsigned* st) {
    XcdBarrier b; b.bar = bar; b.x = xb_xcc_id(); b.st = st;
    if (threadIdx.x == 0) (void)xb_add(&bar[XB_XCNT(b.x)], 1u);
    return b;
}
__device__ __forceinline__ void xcd_barrier_complete(unsigned* bar, unsigned x, unsigned& nloc, unsigned& nx) {
    const unsigned G = gridDim.x * gridDim.y * gridDim.z;
    unsigned sum, cnt, mine, sp = 0u;
    for (;;) {
        sum = 0u; cnt = 0u; mine = 0u;
#pragma unroll
        for (unsigned j = 0; j < 16; ++j) { const unsigned c = xb_ld(&bar[XB_XCNT(j)]); sum += c; cnt += (c > 0u) ? 1u : 0u; mine = (j == x) ? c : mine; }
        if (sum == G) break;
        __builtin_amdgcn_s_sleep(1);
        if ((++sp & 255u) == 0u) { if (xb_ld(&bar[XB_TMO])) break; if (sp > XB_SPIN_CAP) { atomicAdd(&bar[XB_TMO], 1u); break; } }
    }
    nloc = mine > 0u ? mine : 1u; nx = cnt > 0u ? cnt : 1u;
}
__device__ __forceinline__ void xcd_barrier(const XcdBarrier& b) {
    asm volatile("s_waitcnt vmcnt(0)" ::: "memory");
    __syncthreads();
    if (threadIdx.x == 0) {
        unsigned* bar = b.bar;
        __builtin_amdgcn_s_waitcnt(0);
        unsigned nloc = b.st[0], nx = b.st[1];
        if (nloc == 0u) { xcd_barrier_complete(bar, b.x, nloc, nx); b.st[0] = nloc; b.st[1] = nx; }
        const unsigned old = xb_add(&bar[XB_XSUB(b.x)], 1u);
        const unsigned gen = old / nloc;
        if (old + 1u == (gen + 1u) * nloc) {
            __builtin_amdgcn_fence(__ATOMIC_RELEASE, "agent");
            asm volatile("s_waitcnt vmcnt(0)" ::: "memory");
            const unsigned og = xb_add(&bar[XB_TOP], 1u);
            const unsigned tg = og / nx;
            if (og + 1u == (tg + 1u) * nx) xb_add(&bar[XB_TOPGEN], 1u);
            else XB_SPIN(xb_ld(&bar[XB_TOPGEN]) == tg, bar);
            __builtin_amdgcn_fence(__ATOMIC_ACQUIRE, "agent");
            xb_add(&bar[XB_XGEN(b.x)], 1u);
            asm volatile("s_waitcnt vmcnt(0)" ::: "memory");
        } else {
            XB_SPIN(xb_ld(&bar[XB_XGEN(b.x)]) == gen, bar);
            __builtin_amdgcn_fence(__ATOMIC_ACQUIRE, "agent");
            asm volatile("s_waitcnt vmcnt(0)" ::: "memory");
        }
    }
    __syncthreads();
}


template <class Epi> __device__ __forceinline__ void big_gemm(const bf16_t* A, const bf16_t* Bt, int M, int N, int K, char* lds, const Epi& e) {
    pg8::Gemm g{A, Bt, M, N, K}; pg8::StaticOrder S; S.init(M, N, (int)gridDim.x, obid());
    pg8::gemm_phase<Epi, pg8::StaticOrder, true, true>((PG8_LAS unsigned char*)lds, g, S, e);
}

#define GSYNC() xcd_barrier(xbar)
template <int layer> __device__ __forceinline__ void run_layer(const Params& p, char* lds, const XcdBarrier& xbar) {
    float* XA = (float*)(p.ws + OFF_XA);

        const float* xin = layer == 0 ? p.in[I_X] : XA;
#if PROBE == 10
        { EpiIn e{(bf16_t*)(p.ws + R_QKV), (float*)(p.ws + R_HF)};
          gemm_simple((const bf16_t*)(p.ws + R_XN), (const bf16_t*)(p.ws + OFF_WTIN) + (size_t)layer * INC * DM, T, INC, DM, lds, e); } GSYNC();
#endif
        {
            const bf16_t* wt = (const bf16_t*)(p.ws + OFF_WTIN) + (size_t)layer * INC * DM;
            pg8::EpiStoreBf16 e1{(bf16_t*)(p.ws + R_QKV), 768};
            big_gemm((const bf16_t*)(p.ws + R_XN), wt, T, 768, DM, lds, e1);
            pg8::EpiStoreF32 e2{nullptr, (float*)(p.ws + R_HF), T};
            big_gemm(wt + (size_t)768 * DM, (const bf16_t*)(p.ws + R_XN), 1024, T, DM, lds, e2);
        }
        if (layer == 0) {
#pragma nounroll
            for (int fl = 0; fl < NLAYER; ++fl) {
                EpiF32 e{(float*)(p.ws + (fl ? OFF_HFILT1 : OFF_HFILT0)), SL};
                gemm_simple((const bf16_t*)(p.ws + OFF_W3T) + (size_t)fl * 1024 * 64, (const bf16_t*)(p.ws + OFF_H2) + (size_t)fl * SL * 64, 1024, SL, 64, lds, e);
            }
        }
        GSYNC();
        if (layer == 0) {
            phase_filter_spectra(p, lds);
#if PROBE == 13
            phase_filter_spectra(p, lds);
#endif
        }
#if PROBE == 12
        phase_qkprep(p, layer, lds, (bf16_t*)(p.ws + R_ATT)); GSYNC();
#endif
        phase_qkprep(p, layer, lds, (bf16_t*)(p.ws + R_QKV)); GSYNC();
        {
#if PROBE == 5
            phase_attn(p, lds);
#endif
#if PROBE == 6
            for (int c = obid(); c < 256; c += gridDim.x) hyena_job(p, layer, c, lds);
            for (int c = obid(); c < 256; c += gridDim.x) fnet_job(p, c, lds);
#endif
            phase_attn(p, lds);
            for (int c = obid(); c < 256; c += gridDim.x) hyena_job(p, layer, c, lds);
            for (int c = obid(); c < 256; c += gridDim.x) fnet_job(p, c, lds);
        } GSYNC();
#if PROBE == 8
        phase_mix(p, layer, lds); GSYNC();
#endif
        phase_mix(p, layer, lds); GSYNC();
#if PROBE == 11
        { EpiRes e{xin, p.out};
          gemm_simple((const bf16_t*)(p.ws + R_MIX), (const bf16_t*)(p.ws + OFF_WTOUT) + (size_t)layer * DM * DM, T, DM, DM, lds, e); } GSYNC();
#endif
        { pg8::EpiOutProj e{xin, XA, (bf16_t*)(p.ws + R_XN), (float*)(p.ws + OFF_RS)};
          big_gemm((const bf16_t*)(p.ws + R_MIX), (const bf16_t*)(p.ws + OFF_WTOUT) + (size_t)layer * DM * DM, T, DM, DM, lds, e); } GSYNC();
#if PROBE == 3
        { EpiF32 e{(float*)(p.ws + R_QP), 2048};
          gemm_simple((const bf16_t*)(p.ws + R_XN), (const bf16_t*)(p.ws + OFF_WTQ) + (size_t)layer * 2048 * DM, T, 2048, DM, lds, e); } GSYNC();
#endif
        { pg8::EpiRowScaleF32 e{(float*)(p.ws + R_QP), 2048, (const float*)(p.ws + OFF_RS)};
          big_gemm((const bf16_t*)(p.ws + R_XN), (const bf16_t*)(p.ws + OFF_WTQ) + (size_t)layer * 2048 * DM, T, 2048, DM, lds, e); } GSYNC();
#if PEER_FUSED
#if PROBE == 1
        phase_peer_fused<true>(p, layer, lds); GSYNC();
#endif
        phase_peer_fused<false>(p, layer, lds);
#else
        phase_peer_topk(p, layer, lds, (int*)(p.ws + R_QP), (float*)(p.ws + R_QP)); GSYNC();
#if PROBE == 1
        phase_peer_gather<true>(p, layer); GSYNC();
#endif
#if PROBE == 15
        phase_peer_gather<true, 1023>(p, layer); GSYNC();
#endif
        phase_peer_gather<false>(p, layer);
#endif
        if (layer + 1 < NLAYER) GSYNC();
}

__global__ void __launch_bounds__(NTHR) mega_kernel(Params p) {
    extern __shared__ __attribute__((aligned(16))) char lds[];
    cg::grid_group grid = cg::this_grid();
    volatile LAS unsigned* misc = (volatile LAS unsigned*)((LAS char*)lds + LDS_MISC);
    if (threadIdx.x < 16) misc[threadIdx.x] = 0u;
    __syncthreads();
    const XcdBarrier xbar = xcd_barrier_post((unsigned*)(p.ws + OFF_CTL) + 4096, misc);
    float* XA = (float*)(p.ws + OFF_XA);
#if PROBE == 7
    phase_p0(p, lds); GSYNC();
#endif
#if PROBE == 14
#pragma nounroll
    for (int i = 0; i < 40; ++i) GSYNC();
#endif
    phase_p0(p, lds);
    phase_rmsnorm_bf16(p.in[I_X], p.in[I_N1G], (bf16_t*)(p.ws + R_XN));
    grid.sync();
    run_layer<0>(p, lds, xbar);
    run_layer<1>(p, lds, xbar);
}

extern "C" void kernel_launch(void* const* d_in, const int* in_sizes, int n_in, void* d_out, int out_size, void* d_ws, size_t ws_size, hipStream_t stream) {
    static int grid = 0;
    if (grid == 0) {
        if (n_in != 25 || out_size != T * DM || ws_size < WS_NEED) { fprintf(stderr, "kernel_launch: unexpected sizes n_in %d out %d ws %zu (need %zu)\n", n_in, out_size, ws_size, (size_t)WS_NEED); grid = -1; return; }
        int dev = 0, cus = 0, per_cu = 0;
        if (hipGetDevice(&dev) != hipSuccess || hipDeviceGetAttribute(&cus, hipDeviceAttributeMultiprocessorCount, dev) != hipSuccess) { grid = -1; return; }
        if (hipFuncSetAttribute((const void*)mega_kernel, hipFuncAttributeMaxDynamicSharedMemorySize, LDS_BYTES) != hipSuccess) { fprintf(stderr, "kernel_launch: hipFuncSetAttribute failed\n"); grid = -1; return; }
        if (hipOccupancyMaxActiveBlocksPerMultiprocessor(&per_cu, (const void*)mega_kernel, NTHR, LDS_BYTES) != hipSuccess || per_cu < 1) { fprintf(stderr, "kernel_launch: occupancy query says %d blocks per CU\n", per_cu); grid = -1; return; }
        (void)hipGetLastError();
        grid = cus;
    }
    if (grid < 0) return;
    Params p{};
    for (int i = 0; i < 25; ++i) p.in[i] = (const float*)d_in[i];
    p.out = (float*)d_out; p.ws = (unsigned char*)d_ws;
    if (hipMemsetAsync((char*)d_ws + OFF_CTL, 0, 64 * 1024, stream) != hipSuccess) { fprintf(stderr, "kernel_launch: memset failed\n"); return; }
    void* args[] = {&p};
    hipError_t e = hipLaunchCooperativeKernel((const void*)mega_kernel, dim3(grid), dim3(NTHR), args, LDS_BYTES, stream);
    if (e != hipSuccess) fprintf(stderr, "cooperative launch failed: %s (grid %d)\n", hipGetErrorString(e), grid);
}
```

```cpp
#include <hip/hip_runtime.h>
#include <hip/hip_cooperative_groups.h>
#include <cstdio>
#include <cstdint>
namespace cg = cooperative_groups;

#ifndef PROBE
#define PROBE 0
#endif
#ifndef PEER_FUSED
#define PEER_FUSED 1
#endif

typedef unsigned short bf16_t;
typedef short bf16x8 __attribute__((ext_vector_type(8)));
typedef float f32x16 __attribute__((ext_vector_type(16)));
typedef float f32x4 __attribute__((ext_vector_type(4)));
typedef unsigned u32x4 __attribute__((ext_vector_type(4)));
typedef unsigned u32x2 __attribute__((ext_vector_type(2)));

constexpr int DM = 1024, NB = 2, SL = 8192, T = NB * SL, NLAYER = 2;
constexpr int INC = 1792;
constexpr int NTHR = 512, NWAVE = 8;
constexpr int NBLK = 256;
constexpr int LDS_BYTES = 147456;
constexpr int LDS_MISC = LDS_BYTES - 64;
constexpr float EPS = 1e-6f;

constexpr size_t MiB = 1u << 20;
constexpr size_t OFF_CTL = 0;
constexpr size_t OFF_WTIN = 1 * MiB;
constexpr size_t OFF_WTOUT = 8 * MiB;
constexpr size_t OFF_WTQ = 12 * MiB;
constexpr size_t OFF_PU = 20 * MiB;
constexpr size_t OFF_PV = 84 * MiB;
constexpr size_t OFF_RS = 505 * MiB;
constexpr size_t OFF_PSC = 512 * 1024;
constexpr size_t OFF_H2 = 148 * MiB;
constexpr size_t OFF_W3T = 150 * MiB;
constexpr size_t OFF_HFILT0 = 52 * MiB, OFF_HFILT1 = 116 * MiB;
constexpr size_t OFF_FM = 152 * MiB;
constexpr size_t OFF_KF = 153 * MiB;
constexpr size_t OFF_XA = 281 * MiB;
constexpr size_t OFF_R = 345 * MiB;
constexpr size_t R_XN = OFF_R + 0 * MiB;
constexpr size_t R_UR = OFF_R + 0 * MiB;
constexpr size_t R_UI = OFF_R + 16 * MiB;
constexpr size_t R_QKV = OFF_R + 32 * MiB;
constexpr size_t R_VT = OFF_R + 56 * MiB;
constexpr size_t R_HF = OFF_R + 60 * MiB;
constexpr size_t R_MIX = OFF_R + 60 * MiB;
constexpr size_t R_ATT = OFF_R + 124 * MiB;
constexpr size_t R_Y = OFF_R + 140 * MiB;
constexpr size_t R_QP = OFF_R + 32 * MiB;
constexpr size_t WS_NEED = 506 * MiB;

struct Params {
    const float* in[25];
    float* out;
    unsigned char* ws;
};
enum { I_X = 0, I_N1G, I_WIN, I_QG, I_KG, I_CW, I_CB, I_W1, I_B1, I_F1, I_W2, I_B2, I_F2, I_W3, I_HB, I_FW, I_FB, I_MG, I_WOUT, I_N2G, I_WQ, I_SK, I_PU, I_PV, I_FG };

__device__ __forceinline__ unsigned f2bf(float f) { unsigned u = __builtin_bit_cast(unsigned, f); return (u + 0x7fffu + ((u >> 16) & 1u)) >> 16; }
__device__ __forceinline__ unsigned pk2(float lo, float hi) { return f2bf(lo) | (f2bf(hi) << 16); }
__device__ __forceinline__ float bf2f(unsigned b) { return __builtin_bit_cast(float, b << 16); }
__device__ __forceinline__ float bflo(unsigned w) { return __builtin_bit_cast(float, w << 16); }
__device__ __forceinline__ float bfhi(unsigned w) { return __builtin_bit_cast(float, w & 0xffff0000u); }
__device__ __forceinline__ float wave_sum(float v) {
#pragma unroll
    for (int o = 1; o < 64; o <<= 1) v += __shfl_xor(v, o);
    return v;
}
__device__ __forceinline__ float wave_max(float v) {
#pragma unroll
    for (int o = 1; o < 64; o <<= 1) v = fmaxf(v, __shfl_xor(v, o));
    return v;
}
__device__ __forceinline__ f32x16 mfma32(bf16x8 a, bf16x8 b, f32x16 c) { return __builtin_amdgcn_mfma_f32_32x32x16_bf16(a, b, c, 0, 0, 0); }
__device__ __forceinline__ f32x16 zero16() { return (f32x16){0.f,0.f,0.f,0.f,0.f,0.f,0.f,0.f,0.f,0.f,0.f,0.f,0.f,0.f,0.f,0.f}; }


__device__ __forceinline__ int otid() { int t = threadIdx.x; asm volatile("" : "+v"(t)); return t; }
__device__ __forceinline__ int obid() { int b = blockIdx.x; asm volatile("" : "+s"(b)); return b; }
__device__ __forceinline__ void transpose_one(const float* W, int K, int N, bf16_t* Wt, float* tile, int item) {
    const int tid = otid();
    const int nblk = N / 64, kb = item / nblk, nb = item % nblk, k0 = kb * 64, n0 = nb * 64;
    __syncthreads();
    {
        const int r = tid >> 6, c = tid & 63;
#pragma unroll
        for (int i = 0; i < 8; ++i) { const int k = r + 8 * i; tile[k * 65 + c] = W[(size_t)(k0 + k) * N + n0 + c]; }
    }
    __syncthreads();
    {
        const int nn = tid >> 3, kc = tid & 7;
        const float* s = tile + (kc * 8) * 65 + nn;
        u32x4 o; o.x = pk2(s[0], s[65]); o.y = pk2(s[2 * 65], s[3 * 65]); o.z = pk2(s[4 * 65], s[5 * 65]); o.w = pk2(s[6 * 65], s[7 * 65]);
        *(u32x4*)(Wt + (size_t)(n0 + nn) * K + k0 + kc * 8) = o;
    }
}

__device__ __forceinline__ void phase_p0(const Params& p, char* lds) {
    const int tid = otid();
    float* tile = (float*)lds;
    constexpr int IT_IN = (DM / 64) * (INC / 64), IT_OUT = (DM / 64) * (DM / 64), IT_W3 = 1024 / 64;
    constexpr int IT_L = IT_IN + IT_OUT + IT_W3;
    for (int it = obid(); it < NLAYER * IT_L; it += NBLK) {
        const int layer = it / IT_L; int r = it % IT_L;
        if (r < IT_IN) { transpose_one(p.in[I_WIN] + (size_t)layer * DM * INC, DM, INC, (bf16_t*)(p.ws + OFF_WTIN) + (size_t)layer * INC * DM, tile, r); continue; }
        r -= IT_IN;
        if (r < IT_OUT) { transpose_one(p.in[I_WOUT] + (size_t)layer * DM * DM, DM, DM, (bf16_t*)(p.ws + OFF_WTOUT) + (size_t)layer * DM * DM, tile, r); continue; }
        r -= IT_OUT;
        transpose_one(p.in[I_W3] + (size_t)layer * 64 * 1024, 64, 1024, (bf16_t*)(p.ws + OFF_W3T) + (size_t)layer * 1024 * 64, tile, r);
    }
    __syncthreads();
    {
        float* SKl = (float*)lds;
        float* Wl = SKl + 128 * 129;
        for (int it = obid(); it < NLAYER * 16 * 16; it += NBLK) {
            const int layer = it >> 8, hp = (it >> 4) & 15, kc = it & 15, h = hp >> 1, pp = hp & 1, k0 = kc * 64;
            const float* sk = p.in[I_SK] + (((size_t)(layer * 2 + pp) * 8 + h) * 128) * 128;
            const float* wq = p.in[I_WQ] + (size_t)layer * DM * 2048 + (size_t)k0 * 2048 + h * 256 + pp * 128;
            __syncthreads();
            for (int i = tid; i < 128 * 128; i += NTHR) SKl[(i >> 7) * 129 + (i & 127)] = sk[i];
            for (int i = tid; i < 64 * 128; i += NTHR) Wl[(i >> 7) * 132 + (i & 127)] = wq[(size_t)(i >> 7) * 2048 + (i & 127)];
            __syncthreads();
            const int key = tid & 127, kq = tid >> 7;
            float acc[16];
#pragma unroll
            for (int j = 0; j < 16; ++j) acc[j] = 0.f;
            for (int d4 = 0; d4 < 32; ++d4) {
                const float a0 = SKl[key * 129 + d4 * 4], a1 = SKl[key * 129 + d4 * 4 + 1], a2 = SKl[key * 129 + d4 * 4 + 2], a3 = SKl[key * 129 + d4 * 4 + 3];
#pragma unroll
                for (int j = 0; j < 16; ++j) { const f32x4 w = *(const f32x4*)(Wl + (kq * 16 + j) * 132 + d4 * 4); acc[j] += a0 * w.x + a1 * w.y + a2 * w.z + a3 * w.w; }
            }
            bf16_t* dst = (bf16_t*)(p.ws + OFF_WTQ) + (size_t)layer * 2048 * DM + (size_t)(hp * 128 + key) * DM + k0 + kq * 16;
            {
                const float* g2 = p.in[I_N2G] + layer * DM + k0 + kq * 16;
#pragma unroll
                for (int j = 0; j < 16; ++j) acc[j] *= g2[j];
            }
            u32x4 o0, o1;
            o0.x = pk2(acc[0], acc[1]); o0.y = pk2(acc[2], acc[3]); o0.z = pk2(acc[4], acc[5]); o0.w = pk2(acc[6], acc[7]);
            o1.x = pk2(acc[8], acc[9]); o1.y = pk2(acc[10], acc[11]); o1.z = pk2(acc[12], acc[13]); o1.w = pk2(acc[14], acc[15]);
            *(u32x4*)dst = o0; *(u32x4*)(dst + 8) = o1;
        }
        __syncthreads();
    }
    {
        const int lane = tid & 63, wave = tid >> 6;
        float* scl = (float*)(p.ws + OFF_PSC);
        for (int row = obid() * NWAVE + wave; row < 2 * NLAYER * 16384; row += NBLK * NWAVE) {
            const int tb = row >> 15, r = row & 32767;
            const f32x4* src = (const f32x4*)(p.in[tb ? I_PV : I_PU] + (size_t)r * DM) + lane;
            f32x4 v[4]; float mx = 0.f;
#pragma unroll
            for (int j = 0; j < 4; ++j) { v[j] = src[64 * j]; mx = fmaxf(mx, fmaxf(fmaxf(fabsf(v[j].x), fabsf(v[j].y)), fmaxf(fabsf(v[j].z), fabsf(v[j].w)))); }
            mx = wave_max(mx);
            const float sc = mx > 0.f ? 224.0f / mx : 1.0f;
            u32x4 o;
            { int w = 0; w = __builtin_amdgcn_cvt_pk_fp8_f32(v[0].x * sc, v[0].y * sc, w, false); w = __builtin_amdgcn_cvt_pk_fp8_f32(v[0].z * sc, v[0].w * sc, w, true); o.x = (unsigned)w; }
            { int w = 0; w = __builtin_amdgcn_cvt_pk_fp8_f32(v[1].x * sc, v[1].y * sc, w, false); w = __builtin_amdgcn_cvt_pk_fp8_f32(v[1].z * sc, v[1].w * sc, w, true); o.y = (unsigned)w; }
            { int w = 0; w = __builtin_amdgcn_cvt_pk_fp8_f32(v[2].x * sc, v[2].y * sc, w, false); w = __builtin_amdgcn_cvt_pk_fp8_f32(v[2].z * sc, v[2].w * sc, w, true); o.z = (unsigned)w; }
            { int w = 0; w = __builtin_amdgcn_cvt_pk_fp8_f32(v[3].x * sc, v[3].y * sc, w, false); w = __builtin_amdgcn_cvt_pk_fp8_f32(v[3].z * sc, v[3].w * sc, w, true); o.w = (unsigned)w; }
            *(u32x4*)(p.ws + (tb ? OFF_PV : OFF_PU) + (size_t)r * DM + lane * 16) = o;
            if (lane == 0) scl[row] = mx > 0.f ? mx / 224.0f : 1.0f;
        }
    }
    {
        float* sh = (float*)lds;
        float* zl = sh + 8 * 64;
        const int sub = tid >> 6, j = tid & 63;
        for (int it = obid(); it < NLAYER * SL / 8; it += NBLK) {
            const int layer = it / (SL / 8), l = (it % (SL / 8)) * 8 + sub;
            const float t = (float)l / (float)(SL - 1);
            __syncthreads();
            if (j < 17) {
                float z;
                if (j == 0) z = t;
                else if (j <= 8) z = sinf(2.0f * 3.14159265358979323846f * t * (float)j);
                else z = cosf(2.0f * 3.14159265358979323846f * t * (float)(j - 8));
                zl[sub * 17 + j] = z;
            }
            __syncthreads();
            const float* w1 = p.in[I_W1] + layer * 17 * 64;
            float a = p.in[I_B1][layer * 64 + j];
#pragma unroll
            for (int i = 0; i < 17; ++i) a += zl[sub * 17 + i] * w1[i * 64 + j];
            sh[sub * 64 + j] = sinf(p.in[I_F1][layer * 64 + j] * a);
            __syncthreads();
            const float* w2 = p.in[I_W2] + layer * 64 * 64;
            float b = p.in[I_B2][layer * 64 + j];
#pragma unroll 8
            for (int k = 0; k < 64; ++k) b += sh[sub * 64 + k] * w2[k * 64 + j];
            ((bf16_t*)(p.ws + OFF_H2))[((size_t)layer * SL + l) * 64 + j] = (bf16_t)f2bf(sinf(p.in[I_F2][layer * 64 + j] * b));
        }
    }
    {
        const int total = NLAYER * 4 * 128 * 64;
        for (int o = obid() * NTHR + tid; o < total; o += NBLK * NTHR) {
            const int e2 = o & 63, dd = (o >> 6) & 127, g = (o >> 13) & 3, layer = o >> 15;
            const int d = dd & 63;
            const float* w = p.in[I_FW] + ((size_t)(layer * 4 + g) * 64) * 64;
            float acc = 0.f;
            for (int e = 0; e < 64; ++e) {
                const int m = (d * e) & 63;
                const float ang = (float)m * (2.0f * 3.14159265358979323846f / 64.0f);
                const float tw = (dd < 64) ? cosf(ang) : sinf(ang);
                acc += tw * w[e * 64 + e2];
            }
            ((float*)(p.ws + OFF_FM))[o] = acc * (1.0f / 724.0773439350246f);
        }
    }
}

template <bool PAD> __device__ __forceinline__ int zi(int i) { return PAD ? i + (i >> 8) : i; }

template <int LOGN, bool PAD>
__device__ __forceinline__ void fft_fwd(float2* Z) {
    constexpr int N = 1 << LOGN;
    const int tid = otid();
    int s = 0;
    for (; s + 1 < LOGN; s += 2) {
        const int lh2 = LOGN - s - 2;
        const int h2 = 1 << lh2, h = h2 << 1;
        const float rs = 1.0f / (float)(h << 1);
        for (int q = tid; q < N / 4; q += NTHR) {
            const int j = q & (h2 - 1), blk = q >> lh2;
            const int base = (blk << (lh2 + 2)) + j;
            float2 x0 = Z[zi<PAD>(base)], x1 = Z[zi<PAD>(base + h2)], x2 = Z[zi<PAD>(base + h)], x3 = Z[zi<PAD>(base + h + h2)];
            const float ang = (float)j * rs;
            const float c = __builtin_amdgcn_cosf(ang), sn = __builtin_amdgcn_sinf(ang);
            float2 a0 = make_float2(x0.x + x2.x, x0.y + x2.y);
            float2 d02 = make_float2(x0.x - x2.x, x0.y - x2.y);
            float2 a2 = make_float2(d02.x * c + d02.y * sn, d02.y * c - d02.x * sn);
            float2 a1 = make_float2(x1.x + x3.x, x1.y + x3.y);
            float2 d13 = make_float2(x1.x - x3.x, x1.y - x3.y);
            float2 t3 = make_float2(d13.x * c + d13.y * sn, d13.y * c - d13.x * sn);
            float2 a3 = make_float2(t3.y, -t3.x);
            const float c2 = c * c - sn * sn, s2 = 2.f * c * sn;
            float2 y0 = make_float2(a0.x + a1.x, a0.y + a1.y);
            float2 e01 = make_float2(a0.x - a1.x, a0.y - a1.y);
            float2 y1 = make_float2(e01.x * c2 + e01.y * s2, e01.y * c2 - e01.x * s2);
            float2 y2 = make_float2(a2.x + a3.x, a2.y + a3.y);
            float2 e23 = make_float2(a2.x - a3.x, a2.y - a3.y);
            float2 y3 = make_float2(e23.x * c2 + e23.y * s2, e23.y * c2 - e23.x * s2);
            Z[zi<PAD>(base)] = y0; Z[zi<PAD>(base + h2)] = y1; Z[zi<PAD>(base + h)] = y2; Z[zi<PAD>(base + h + h2)] = y3;
        }
        __syncthreads();
    }
    if (s < LOGN) {
        for (int q = tid; q < N / 2; q += NTHR) {
            const int i0 = 2 * q;
            float2 a = Z[zi<PAD>(i0)], b = Z[zi<PAD>(i0 + 1)];
            Z[zi<PAD>(i0)] = make_float2(a.x + b.x, a.y + b.y);
            Z[zi<PAD>(i0 + 1)] = make_float2(a.x - b.x, a.y - b.y);
        }
        __syncthreads();
    }
}

template <int LOGN, bool PAD>
__device__ __forceinline__ void fft_inv(float2* Z) {
    constexpr int N = 1 << LOGN;
    const int tid = otid();
    for (int s = LOGN - 2; s >= 0; s -= 2) {
        const int lh2 = LOGN - s - 2;
        const int h2 = 1 << lh2, h = h2 << 1;
        const float rs = 1.0f / (float)(h << 1);
        for (int q = tid; q < N / 4; q += NTHR) {
            const int j = q & (h2 - 1), blk = q >> lh2;
            const int base = (blk << (lh2 + 2)) + j;
            float2 y0 = Z[zi<PAD>(base)], y1 = Z[zi<PAD>(base + h2)], y2 = Z[zi<PAD>(base + h)], y3 = Z[zi<PAD>(base + h + h2)];
            const float ang = (float)j * rs;
            const float c = __builtin_amdgcn_cosf(ang), sn = __builtin_amdgcn_sinf(ang);
            const float c2 = c * c - sn * sn, s2 = 2.f * c * sn;
            float2 t1 = make_float2(y1.x * c2 - y1.y * s2, y1.y * c2 + y1.x * s2);
            float2 t3 = make_float2(y3.x * c2 - y3.y * s2, y3.y * c2 + y3.x * s2);
            float2 a0 = make_float2(y0.x + t1.x, y0.y + t1.y), a1 = make_float2(y0.x - t1.x, y0.y - t1.y);
            float2 a2 = make_float2(y2.x + t3.x, y2.y + t3.y), a3 = make_float2(y2.x - t3.x, y2.y - t3.y);
            float2 u2 = make_float2(a2.x * c - a2.y * sn, a2.y * c + a2.x * sn);
            float2 u3 = make_float2(a3.x * c - a3.y * sn, a3.y * c + a3.x * sn);
            float2 v3 = make_float2(-u3.y, u3.x);
            Z[zi<PAD>(base)] = make_float2(a0.x + u2.x, a0.y + u2.y);
            Z[zi<PAD>(base + h)] = make_float2(a0.x - u2.x, a0.y - u2.y);
            Z[zi<PAD>(base + h2)] = make_float2(a1.x + v3.x, a1.y + v3.y);
            Z[zi<PAD>(base + h + h2)] = make_float2(a1.x - v3.x, a1.y - v3.y);
        }
        __syncthreads();
    }
}


__device__ __forceinline__ int zp(int i) { return i + 2 * (i >> 5); }
__device__ constexpr float FC32[16] = {1.000000000f, 0.980785280f, 0.923879533f, 0.831469612f, 0.707106781f, 0.555570233f, 0.382683432f, 0.195090322f, 0.000000000f, -0.195090322f, -0.382683432f, -0.555570233f, -0.707106781f, -0.831469612f, -0.923879533f, -0.980785280f};
__device__ constexpr float FS32[16] = {0.000000000f, 0.195090322f, 0.382683432f, 0.555570233f, 0.707106781f, 0.831469612f, 0.923879533f, 0.980785280f, 1.000000000f, 0.980785280f, 0.923879533f, 0.831469612f, 0.707106781f, 0.555570233f, 0.382683432f, 0.195090322f};
__device__ __forceinline__ float2 cmulf(float2 a, float2 b) { return make_float2(a.x * b.x - a.y * b.y, a.x * b.y + a.y * b.x); }
template <int R> __device__ __forceinline__ constexpr int brevR(int x) { int r = 0; for (int b = 1, t = R >> 1; t >= 1; b <<= 1, t >>= 1) if (x & b) r |= t; return r; }
template <int R> __device__ __forceinline__ void dft_fwd_regs(float2 (&x)[R]) {
#pragma unroll
    for (int half = R / 2; half >= 1; half >>= 1) {
#pragma unroll
        for (int blk = 0; blk < R; blk += 2 * half)
#pragma unroll
            for (int k = 0; k < half; ++k) {
                const float2 a = x[blk + k], b = x[blk + k + half];
                x[blk + k] = make_float2(a.x + b.x, a.y + b.y);
                const float2 d = make_float2(a.x - b.x, a.y - b.y);
                const int ti = k * (16 / half);
                if (ti == 0) x[blk + k + half] = d;
                else if (ti == 8) x[blk + k + half] = make_float2(d.y, -d.x);
                else { const float c = FC32[ti], sn = FS32[ti]; x[blk + k + half] = make_float2(d.x * c + d.y * sn, d.y * c - d.x * sn); }
            }
    }
}
template <int R> __device__ __forceinline__ void dft_inv_regs(float2 (&x)[R]) {
#pragma unroll
    for (int half = 1; half <= R / 2; half <<= 1) {
#pragma unroll
        for (int blk = 0; blk < R; blk += 2 * half)
#pragma unroll
            for (int k = 0; k < half; ++k) {
                const float2 a = x[blk + k], b0 = x[blk + k + half];
                const int ti = k * (16 / half);
                float2 b;
                if (ti == 0) b = b0;
                else if (ti == 8) b = make_float2(-b0.y, b0.x);
                else { const float c = FC32[ti], sn = FS32[ti]; b = make_float2(b0.x * c - b0.y * sn, b0.y * c + b0.x * sn); }
                x[blk + k] = make_float2(a.x + b.x, a.y + b.y);
                x[blk + k + half] = make_float2(a.x - b.x, a.y - b.y);
            }
    }
}
template <int R> __device__ __forceinline__ void apply_tw(float2 (&x)[R], float c, float sg) {
    const float2 w1 = make_float2(c, sg), w2 = cmulf(w1, w1);
    float2 po = w1, pe = w2;
#pragma unroll
    for (int m = 1; m < R; m += 2) {
        x[brevR<R>(m)] = cmulf(x[brevR<R>(m)], po);
        if (m + 1 < R) x[brevR<R>(m + 1)] = cmulf(x[brevR<R>(m + 1)], pe);
        if (m + 2 < R) { po = cmulf(po, w2); pe = cmulf(pe, w2); }
    }
}
template <int R, bool INV> __device__ __forceinline__ void fft_group(float2* Z, int pbase, int PS, float ang) {
    float2 x[R];
    if (!INV) {
#pragma unroll
        for (int m = 0; m < R; ++m) x[m] = Z[pbase + PS * m];
        dft_fwd_regs<R>(x);
        apply_tw<R>(x, __builtin_amdgcn_cosf(ang), -__builtin_amdgcn_sinf(ang));
#pragma unroll
        for (int m = 0; m < R; ++m) Z[pbase + PS * m] = x[brevR<R>(m)];
    } else {
#pragma unroll
        for (int m = 0; m < R; ++m) x[brevR<R>(m)] = Z[pbase + PS * m];
        apply_tw<R>(x, __builtin_amdgcn_cosf(ang), __builtin_amdgcn_sinf(ang));
        dft_inv_regs<R>(x);
#pragma unroll
        for (int m = 0; m < R; ++m) Z[pbase + PS * m] = x[m];
    }
}
template <bool INV> __device__ __forceinline__ void fft_group32_contig(float2* Z, int pbase) {
    float2 x[32];
    if (!INV) {
#pragma unroll
        for (int m = 0; m < 32; m += 2) { const f32x4 v = *(const f32x4*)(Z + pbase + m); x[m] = make_float2(v.x, v.y); x[m + 1] = make_float2(v.z, v.w); }
        dft_fwd_regs<32>(x);
#pragma unroll
        for (int m = 0; m < 32; m += 2) { const float2 a = x[brevR<32>(m)], b = x[brevR<32>(m + 1)]; *(f32x4*)(Z + pbase + m) = (f32x4){a.x, a.y, b.x, b.y}; }
    } else {
#pragma unroll
        for (int m = 0; m < 32; m += 2) { const f32x4 v = *(const f32x4*)(Z + pbase + m); x[brevR<32>(m)] = make_float2(v.x, v.y); x[brevR<32>(m + 1)] = make_float2(v.z, v.w); }
        dft_inv_regs<32>(x);
#pragma unroll
        for (int m = 0; m < 32; m += 2) *(f32x4*)(Z + pbase + m) = (f32x4){x[m].x, x[m].y, x[m + 1].x, x[m + 1].y};
    }
}
__device__ __forceinline__ void fft16k_fwd(float2* Z) {
    const int tid = otid();
#pragma unroll 1
    for (int g = 0; g < 2; ++g) { const int j = tid + 512 * g; fft_group<16, false>(Z, zp(j), 1088, (float)j * (1.0f / 16384.0f)); }
    __syncthreads();
    { const int blk = tid >> 5, j = tid & 31; fft_group<32, false>(Z, blk * 1088 + j, 34, (float)j * (1.0f / 1024.0f)); }
    __syncthreads();
    fft_group32_contig<false>(Z, 34 * tid);
    __syncthreads();
}
__device__ __forceinline__ void fft16k_inv(float2* Z) {
    const int tid = otid();
    fft_group32_contig<true>(Z, 34 * tid);
    __syncthreads();
    { const int blk = tid >> 5, j = tid & 31; fft_group<32, true>(Z, blk * 1088 + j, 34, (float)j * (1.0f / 1024.0f)); }
    __syncthreads();
#pragma unroll 1
    for (int g = 0; g < 2; ++g) { const int j = tid + 512 * g; fft_group<16, true>(Z, zp(j), 1088, (float)j * (1.0f / 16384.0f)); }
    __syncthreads();
}
__device__ __forceinline__ void fft8k_fwd(float2* Z) {
    const int tid = otid();
    fft_group<16, false>(Z, zp(tid), 544, (float)tid * (1.0f / 8192.0f));
    __syncthreads();
    { const int blk = tid >> 5, j = tid & 31; fft_group<16, false>(Z, blk * 544 + j, 34, (float)j * (1.0f / 512.0f)); }
    __syncthreads();
    if (tid < 256) fft_group32_contig<false>(Z, 34 * tid);
    __syncthreads();
}
__device__ __forceinline__ int f16k_of_p(int p) { return (p >> 10) + 16 * ((p >> 5) & 31) + 512 * (p & 31); }
__device__ __forceinline__ int p16k_of_f(int f) { return 1024 * (f & 15) + 32 * ((f >> 4) & 31) + (f >> 9); }
__device__ __forceinline__ int p8k_of_f(int f) { return 512 * (f & 15) + 32 * ((f >> 4) & 15) + (f >> 8); }

__device__ __forceinline__ void phase_filter_spectra(const Params& p, char* lds) {
    const int tid = otid(), lane = tid & 63, wave = tid >> 6;
    float2* Z = (float2*)lds;
    float* red = (float*)(lds + 139264 + 64);
    for (int job = obid(); job < NLAYER * 256; job += NBLK) {
        const int layer = job >> 8, c = job & 255;
        __syncthreads();
        const float* HFc = (const float*)(p.ws + (layer ? OFF_HFILT1 : OFF_HFILT0)) + (size_t)c * SL;
        const float r_lo = 4.605170185988092f / 1.5f, r_hi = 4.605170185988092f / 0.3f;
        const float rate = r_lo + (r_hi - r_lo) * ((float)c / 255.0f);
        float ss0 = 0.f, ss1 = 0.f;
#pragma unroll 1
        for (int i = 0; i < 4; ++i) {
            const int l0 = 4 * tid + 2048 * i;
            const f32x4 a0 = *(const f32x4*)(HFc + l0), a1 = *(const f32x4*)(HFc + (size_t)256 * SL + l0);
            const f32x4 a2 = *(const f32x4*)(HFc + (size_t)512 * SL + l0), a3 = *(const f32x4*)(HFc + (size_t)768 * SL + l0);
#pragma unroll
            for (int e = 0; e < 4; ++e) {
                const int l = l0 + e;
                const float t = (float)l / (float)(SL - 1);
                const float dec = expf(-t * rate);
                const float f0 = a0[e] * dec, b0 = a1[e] * dec, f1 = a2[e] * dec, b1 = a3[e] * dec;
                ss0 += f0 * f0 + b0 * b0; ss1 += f1 * f1 + b1 * b1;
                Z[zp(l)] = make_float2(f0, f1);
                if (l >= 1) Z[zp(16384 - l)] = make_float2(b0, b1);
            }
        }
        if (tid == 0) Z[zp(8192)] = make_float2(0.f, 0.f);
        ss0 = wave_sum(ss0); ss1 = wave_sum(ss1);
        if (lane == 0) { red[wave * 2] = ss0; red[wave * 2 + 1] = ss1; }
        __syncthreads();
        float t0 = 0.f, t1 = 0.f;
#pragma unroll
        for (int w = 0; w < 8; ++w) { t0 += red[w * 2]; t1 += red[w * 2 + 1]; }
        const float sc0 = rsqrtf(t0 + EPS) * (1.0f / 16384.0f) * 0.5f, sc1 = rsqrtf(t1 + EPS) * (1.0f / 16384.0f) * 0.5f;
        fft16k_fwd(Z);
        float2* KF0 = (float2*)(p.ws + OFF_KF) + ((size_t)(layer * 256 + c) * 2) * 16384;
        float2* KF1 = KF0 + 16384;
        for (int i = 0; i < 32; ++i) {
            const int pp = tid + NTHR * i;
            const int fq = f16k_of_p(pp);
            const int pq = p16k_of_f((16384 - fq) & 16383);
            const float2 za = Z[zp(pp)], zq = Z[zp(pq)];
            KF0[pp] = make_float2((za.x + zq.x) * sc0, (za.y - zq.y) * sc0);
            KF1[pp] = make_float2((za.y + zq.y) * sc1, (zq.x - za.x) * sc1);
        }
    }
}

__device__ __forceinline__ void phase_rmsnorm_bf16(const float* x, const float* g, bf16_t* out) {
    const int lane = otid() & 63, wave = otid() >> 6;
    const int gw = obid() * NWAVE + wave, ngw = NBLK * NWAVE;
    for (int row = gw; row < T; row += ngw) {
        const f32x4* xr = (const f32x4*)(x + (size_t)row * DM) + lane;
        f32x4 v[4]; float ss = 0.f;
#pragma unroll
        for (int j = 0; j < 4; ++j) { v[j] = xr[64 * j]; ss += v[j].x * v[j].x + v[j].y * v[j].y + v[j].z * v[j].z + v[j].w * v[j].w; }
        ss = wave_sum(ss);
        const float r = rsqrtf(ss * (1.0f / DM) + EPS);
        u32x2* o = (u32x2*)(out + (size_t)row * DM) + lane;
#pragma unroll
        for (int j = 0; j < 4; ++j) {
            const f32x4 gg = ((const f32x4*)g)[lane + 64 * j];
            u32x2 w; w.x = pk2(v[j].x * r * gg.x, v[j].y * r * gg.y); w.y = pk2(v[j].z * r * gg.z, v[j].w * r * gg.w);
            o[64 * j] = w;
        }
    }
}
__device__ __forceinline__ void phase_final_norm(const float* x, const float* g, float* out) {
    const int lane = otid() & 63, wave = otid() >> 6;
    const int gw = obid() * NWAVE + wave, ngw = NBLK * NWAVE;
    for (int row = gw; row < T; row += ngw) {
        const f32x4* xr = (const f32x4*)(x + (size_t)row * DM) + lane;
        f32x4 v[4]; float ss = 0.f;
#pragma unroll
        for (int j = 0; j < 4; ++j) { v[j] = xr[64 * j]; ss += v[j].x * v[j].x + v[j].y * v[j].y + v[j].z * v[j].z + v[j].w * v[j].w; }
        ss = wave_sum(ss);
        const float r = rsqrtf(ss * (1.0f / DM) + EPS);
        f32x4* o = (f32x4*)(out + (size_t)row * DM) + lane;
#pragma unroll
        for (int j = 0; j < 4; ++j) { const f32x4 gg = ((const f32x4*)g)[lane + 64 * j]; o[64 * j] = v[j] * r * gg; }
    }
}

constexpr int G_LDA = 144;
template <class Epi>
__device__ __forceinline__ void gemm_simple(const bf16_t* A, const bf16_t* Bt, int M, int N, int K, char* lds, const Epi& epi) {
    const int tid = otid(), lane = tid & 63, wave = tid >> 6;
    const int wm = wave >> 1, wn = wave & 1;
    const int nMt = M / 256, nNt = N / 128, total = nMt * nNt, nk = K / 64;
    char* As = lds; char* Bs = lds + 256 * G_LDA;
    const int l31 = lane & 31, hl = lane >> 5;
    for (int u = obid(); u < total; u += NBLK) {
        const int mt = u % nMt, nt = u / nMt;
        f32x16 acc[2][2];
#pragma unroll
        for (int i = 0; i < 2; ++i)
#pragma unroll
            for (int j = 0; j < 2; ++j) acc[i][j] = zero16();
        u32x4 ra[4], rb[2];
        const bf16_t* Ab = A + (size_t)(mt * 256) * K;
        const bf16_t* Bb = Bt + (size_t)(nt * 128) * K;
#pragma unroll
        for (int i = 0; i < 4; ++i) { const int id = tid + NTHR * i, row = id >> 3, ch = id & 7; ra[i] = *(const u32x4*)(Ab + (size_t)row * K + ch * 8); }
#pragma unroll
        for (int i = 0; i < 2; ++i) { const int id = tid + NTHR * i, row = id >> 3, ch = id & 7; rb[i] = *(const u32x4*)(Bb + (size_t)row * K + ch * 8); }
        for (int kt = 0; kt < nk; ++kt) {
            __syncthreads();
#pragma unroll
            for (int i = 0; i < 4; ++i) { const int id = tid + NTHR * i, row = id >> 3, ch = id & 7; *(u32x4*)(As + row * G_LDA + ch * 16) = ra[i]; }
#pragma unroll
            for (int i = 0; i < 2; ++i) { const int id = tid + NTHR * i, row = id >> 3, ch = id & 7; *(u32x4*)(Bs + row * G_LDA + ch * 16) = rb[i]; }
            __syncthreads();
            if (kt + 1 < nk) {
                const int ko = (kt + 1) * 64;
#pragma unroll
                for (int i = 0; i < 4; ++i) { const int id = tid + NTHR * i, row = id >> 3, ch = id & 7; ra[i] = *(const u32x4*)(Ab + (size_t)row * K + ko + ch * 8); }
#pragma unroll
                for (int i = 0; i < 2; ++i) { const int id = tid + NTHR * i, row = id >> 3, ch = id & 7; rb[i] = *(const u32x4*)(Bb + (size_t)row * K + ko + ch * 8); }
            }
#pragma unroll
            for (int ks = 0; ks < 4; ++ks) {
                bf16x8 a[2], b[2];
#pragma unroll
                for (int i = 0; i < 2; ++i) a[i] = *(const bf16x8*)(As + (wm * 64 + i * 32 + l31) * G_LDA + ks * 32 + hl * 16);
#pragma unroll
                for (int j = 0; j < 2; ++j) b[j] = *(const bf16x8*)(Bs + (wn * 64 + j * 32 + l31) * G_LDA + ks * 32 + hl * 16);
#pragma unroll
                for (int i = 0; i < 2; ++i)
#pragma unroll
                    for (int j = 0; j < 2; ++j) acc[i][j] = mfma32(a[i], b[j], acc[i][j]);
            }
        }
#pragma unroll
        for (int i = 0; i < 2; ++i)
#pragma unroll
            for (int j = 0; j < 2; ++j) epi(acc[i][j], mt * 256 + wm * 64 + i * 32, nt * 128 + wn * 64 + j * 32, lane);
    }
}

struct EpiIn {
    bf16_t* qkv; float* hf;
    __device__ __forceinline__ void operator()(const f32x16& acc, int row0, int col0, int lane) const {
        const int c = col0 + (lane & 31), h = lane >> 5;
        if (col0 < 768) {
#pragma unroll
            for (int r = 0; r < 16; ++r) { const int row = row0 + (r & 3) + 8 * (r >> 2) + 4 * h; qkv[(size_t)row * 768 + c] = (bf16_t)f2bf(acc[r]); }
        } else {
            float* dst = hf + (size_t)(c - 768) * T;
#pragma unroll
            for (int i = 0; i < 4; ++i) { const int row = row0 + 8 * i + 4 * h; f32x4 v; v.x = acc[4 * i]; v.y = acc[4 * i + 1]; v.z = acc[4 * i + 2]; v.w = acc[4 * i + 3]; *(f32x4*)(dst + row) = v; }
        }
    }
};
struct EpiRes {
    const float* base; float* out;
    __device__ __forceinline__ void operator()(const f32x16& acc, int row0, int col0, int lane) const {
        const int c = col0 + (lane & 31), h = lane >> 5;
#pragma unroll
        for (int r = 0; r < 16; ++r) { const size_t o = (size_t)(row0 + (r & 3) + 8 * (r >> 2) + 4 * h) * DM + c; out[o] = base[o] + acc[r]; }
    }
};
struct EpiF32 {
    float* out; int ld;
    __device__ __forceinline__ void operator()(const f32x16& acc, int row0, int col0, int lane) const {
        const int c = col0 + (lane & 31), h = lane >> 5;
#pragma unroll
        for (int r = 0; r < 16; ++r) { out[(size_t)(row0 + (r & 3) + 8 * (r >> 2) + 4 * h) * ld + c] = acc[r]; }
    }
};

namespace pg8 {
#define PG8_LAS __attribute__((address_space(3)))
constexpr int BM = 256, BK = 64, HALF = 128, HTB = HALF * BK * 2  , STAGE_BYTES = 8 * HTB, NXCD = 8, WGM = 8;

__host__ __device__ __forceinline__ int lds_byte(int r, int c) { const int st = (r >> 4) * 2 + (c >> 5), rr = r & 15, cc = c & 31, ob = rr * 64 + cc * 2; return st * 1024 + (ob ^ (((ob >> 9) & 1) << 5)); }
__host__ __device__ __forceinline__ void stage_rc(int b, int& R, int& C) { const int st = b / 1024, sb = b % 1024, swz = sb ^ (((sb >> 9) & 1) << 5); R = (st >> 1) * 16 + swz / 64; C = (st & 1) * 32 + (swz % 64) / 2; }
__host__ __device__ __forceinline__ int perm32(int rho) { const int n = rho >> 4, i = rho & 15; return 8 * (i >> 2) + 4 * n + (i & 3); }

struct Unit { int pm, pn; };
struct Gemm { const bf16_t* A; const bf16_t* Bt; int M, N, K; };

struct StaticOrder {
    int nM, nN, nwg, G, c;
    __host__ __device__ void init(int M, int N, int G_, int c_) { nM = M / BM; nN = N / BM; nwg = nM * nN; G = G_; c = c_; }
    __host__ __device__ bool next(int i, Unit& u) const {
        const long L = (long)i * G + c; if (L >= nwg) return false;
        int wgid = (int)L; { const int q = nwg / NXCD, r = nwg % NXCD, xcd = wgid % NXCD, off = wgid / NXCD; wgid = (xcd < r ? xcd * (q + 1) : r * (q + 1) + (xcd - r) * q) + off; }
        const int nig = WGM * nN, gid = wgid / nig, fm = gid * WGM, gsz = (nM - fm) < WGM ? (nM - fm) : WGM;
        u.pm = fm + ((wgid % nig) % gsz); u.pn = (wgid % nig) / gsz; return true;
    }
    __device__ __forceinline__ void a_ready(const Unit&) const {}
    __device__ __forceinline__ void done(const Unit&) const {}
};


__device__ __forceinline__ unsigned cvt_pk_bf16(float lo, float hi) { unsigned r; asm volatile("v_cvt_pk_bf16_f32 %0, %1, %2" : "=v"(r) : "v"(lo), "v"(hi)); return r; }
struct EpiStoreBf16 {
    static constexpr bool PERM = true, AFTER_DRAIN = false;
    bf16_t* O; int ldc;
    __device__ __forceinline__ void operator()(const f32x4 (&acc)[2][2][4][2], const Unit& u, int wr, int wc, int fr, int fq) const {
        const int row0 = u.pm * BM + wr * 64 + fr, col0 = u.pn * BM + wc * 32 + 8 * fq;
#pragma unroll
        for (int ai = 0; ai < 2; ++ai)
#pragma unroll
            for (int m = 0; m < 4; ++m) { bf16_t* rowp = O + (size_t)(row0 + ai * HALF + m * 16) * ldc + col0;
#pragma unroll
                for (int bj = 0; bj < 2; ++bj) { const f32x4 v0 = acc[ai][bj][m][0], v1 = acc[ai][bj][m][1];
                    u32x4 w; w.x = cvt_pk_bf16(v0[0], v0[1]); w.y = cvt_pk_bf16(v0[2], v0[3]); w.z = cvt_pk_bf16(v1[0], v1[1]); w.w = cvt_pk_bf16(v1[2], v1[3]);
                    *(u32x4*)(rowp + bj * HALF) = w; } }
    }
};
struct EpiOutProj {
    static constexpr bool PERM = false, AFTER_DRAIN = false;
    const float* base; float* O; bf16_t* XB; float* RS;
    __device__ __forceinline__ void operator()(const f32x4 (&acc)[2][2][4][2], const Unit& u, int wr, int wc, int fr, int fq) const {
        const int row0 = u.pm * BM + wr * 64 + fr, col0 = u.pn * BM + wc * 32 + 4 * fq;
#pragma unroll
        for (int ai = 0; ai < 2; ++ai)
#pragma unroll
            for (int m = 0; m < 4; ++m) { const int row = row0 + ai * HALF + m * 16; const size_t off = (size_t)row * 1024 + col0; float ss = 0.f;
#pragma unroll
                for (int bj = 0; bj < 2; ++bj)
#pragma unroll
                    for (int n = 0; n < 2; ++n) { const f32x4 v = acc[ai][bj][m][n] + *(const f32x4*)(base + off + bj * HALF + n * 16);
                        *(f32x4*)(O + off + bj * HALF + n * 16) = v; ss += v[0] * v[0] + v[1] * v[1] + v[2] * v[2] + v[3] * v[3];
                        u32x2 w; w.x = cvt_pk_bf16(v[0], v[1]); w.y = cvt_pk_bf16(v[2], v[3]); *(u32x2*)(XB + off + bj * HALF + n * 16) = w; }
                ss += __shfl_xor(ss, 16); ss += __shfl_xor(ss, 32);
                if (fq == 0) RS[(size_t)row * 16 + u.pn * 4 + wc] = ss; }
    }
};
struct EpiRowScaleF32 {
    static constexpr bool PERM = false, AFTER_DRAIN = false;
    float* O; int ldc; const float* RS;
    __device__ __forceinline__ void operator()(const f32x4 (&acc)[2][2][4][2], const Unit& u, int wr, int wc, int fr, int fq) const {
        const int row0 = u.pm * BM + wr * 64 + fr, col0 = u.pn * BM + wc * 32 + 4 * fq;
#pragma unroll
        for (int ai = 0; ai < 2; ++ai)
#pragma unroll
            for (int m = 0; m < 4; ++m) { const int row = row0 + ai * HALF + m * 16; const size_t off = (size_t)row * ldc + col0;
                float tot = 0.f;
#pragma unroll
                for (int q = 0; q < 4; ++q) { const f32x4 pr = *(const f32x4*)(RS + (size_t)row * 16 + 4 * q); tot += (pr[0] + pr[1]) + (pr[2] + pr[3]); }
                const float r = rsqrtf(tot * (1.0f / 1024.0f) + 1e-6f);
#pragma unroll
                for (int bj = 0; bj < 2; ++bj)
#pragma unroll
                    for (int n = 0; n < 2; ++n) *(f32x4*)(O + off + bj * HALF + n * 16) = acc[ai][bj][m][n] * r; }
    }
};
struct EpiStoreF32 {
    static constexpr bool PERM = false, AFTER_DRAIN = false;
    const float* base; float* O; int ldc;
    __device__ __forceinline__ void operator()(const f32x4 (&acc)[2][2][4][2], const Unit& u, int wr, int wc, int fr, int fq) const {
        const int row0 = u.pm * BM + wr * 64 + fr, col0 = u.pn * BM + wc * 32 + 4 * fq;
#pragma unroll
        for (int ai = 0; ai < 2; ++ai)
#pragma unroll
            for (int m = 0; m < 4; ++m) { const size_t off = (size_t)(row0 + ai * HALF + m * 16) * ldc + col0;
#pragma unroll
                for (int bj = 0; bj < 2; ++bj)
#pragma unroll
                    for (int n = 0; n < 2; ++n) { f32x4 v = acc[ai][bj][m][n]; if (base) v += *(const f32x4*)(base + off + bj * HALF + n * 16); *(f32x4*)(O + off + bj * HALF + n * 16) = v; } }
    }
};

template <class Epi, class Sched, bool ALIGN_EPI = false, bool SP2 = false>
__device__ __forceinline__ void gemm_phase(PG8_LAS unsigned char* lds, const Gemm g, const Sched& S, const Epi& E) {
    const int tid = otid(), wid = __builtin_amdgcn_readfirstlane(tid >> 6), lane = tid & 63, wr = wid >> 2, wc = wid & 3, fr = lane & 15, fq = lane >> 4;
    const int K = g.K, nt = K / BK;
    unsigned voffA[2], voffB[2];
#pragma unroll
    for (int i = 0; i < 2; ++i) { int R, C; stage_rc(tid * 16 + i * 8192, R, C); const int Rb = Epi::PERM ? ((R & ~31) + perm32(R & 31)) : R;
        voffA[i] = (unsigned)(R * K + C) * 2u; voffB[i] = (unsigned)(Rb * K + C) * 2u; }
    const size_t kstep = (size_t)(BK * 2);
    const size_t hstep = (size_t)HALF * K * 2;
    const size_t tstep = 2 * hstep;
    const unsigned ldsw = (unsigned)wid * 1024u;
    const int aoff = lds_byte(wr * 64 + fr, fq * 8), boff = lds_byte(wc * 32 + fr, fq * 8);
#define PG8_SA(b, h) (((b) * 2 + (h)) * HTB)
#define PG8_SB(b, h) ((4 + (b) * 2 + (h)) * HTB)
#define PG8_STAGE(bufoff, gbase, voff) do { _Pragma("unroll") for (int _i = 0; _i < 2; ++_i) \
        __builtin_amdgcn_global_load_lds((const unsigned*)((const char*)(gbase) + (voff)[_i]), (PG8_LAS unsigned*)(lds + (bufoff) + ldsw + _i * 8192), 16, 0, 0); } while (0)
#define PG8_LDA(dst, b, h) do { _Pragma("unroll") for (int m = 0; m < 4; ++m) _Pragma("unroll") for (int k = 0; k < 2; ++k) dst[m][k] = *(const PG8_LAS bf16x8*)(lds + PG8_SA(b, h) + aoff + m * 2048 + k * 1024); } while (0)
#define PG8_LDB(dst, b, h) do { _Pragma("unroll") for (int n = 0; n < 2; ++n) _Pragma("unroll") for (int k = 0; k < 2; ++k) dst[n][k] = *(const PG8_LAS bf16x8*)(lds + PG8_SB(b, h) + boff + n * 2048 + k * 1024); } while (0)
#define PG8_MMA(ai, bj, At, Bt) do { __builtin_amdgcn_s_setprio(1); _Pragma("unroll") for (int m = 0; m < 4; ++m) _Pragma("unroll") for (int n = 0; n < 2; ++n) _Pragma("unroll") for (int k = 0; k < 2; ++k) \
        acc[ai][bj][m][n] = __builtin_amdgcn_mfma_f32_16x16x32_bf16(Bt[n][k], At[m][k], acc[ai][bj][m][n], 0, 0, 0); __builtin_amdgcn_s_setprio(0); } while (0)
#define PG8_WAIT_V(n) asm volatile("s_waitcnt vmcnt(" #n ")" ::: "memory")
#define PG8_WAIT_L(n) asm volatile("s_waitcnt lgkmcnt(" #n ")" ::: "memory")
#define PG8_BAR __builtin_amdgcn_s_barrier()
#define PG8_SCHED __builtin_amdgcn_sched_barrier(0)
    Unit cur, nxt; int ui = 0;
    if (!S.next(0, cur)) return;
    f32x4 acc[2][2][4][2];
#pragma unroll
    for (int a = 0; a < 2; ++a)
#pragma unroll
        for (int b = 0; b < 2; ++b)
#pragma unroll
            for (int m = 0; m < 4; ++m)
#pragma unroll
                for (int n = 0; n < 2; ++n) acc[a][b][m][n] = (f32x4){0.f, 0.f, 0.f, 0.f};
    bf16x8 At[4][2], B0[2][2], B1[2][2];
    const char* cA = (const char*)g.A + (size_t)cur.pm * tstep; const char* cB = (const char*)g.Bt + (size_t)cur.pn * tstep;
    S.a_ready(cur);
    if constexpr (SP2) {
        PG8_STAGE(PG8_SB(0, 0), cB, voffB); PG8_STAGE(PG8_SB(0, 1), cB + hstep, voffB); PG8_STAGE(PG8_SA(0, 0), cA, voffA); PG8_STAGE(PG8_SA(0, 1), cA + hstep, voffA);
        if (wr == 1) PG8_BAR;
        PG8_WAIT_V(2); PG8_BAR;
        PG8_STAGE(PG8_SB(1, 0), cB + kstep, voffB); PG8_STAGE(PG8_SA(1, 0), cA + kstep, voffA); PG8_STAGE(PG8_SB(1, 1), cB + hstep + kstep, voffB);
        PG8_WAIT_V(6); PG8_BAR;
    } else {
        PG8_STAGE(PG8_SB(0, 0), cB, voffB); PG8_STAGE(PG8_SA(0, 0), cA, voffA); PG8_STAGE(PG8_SB(0, 1), cB + hstep, voffB); PG8_STAGE(PG8_SA(0, 1), cA + hstep, voffA);
        if (wr == 1) PG8_BAR;
        PG8_WAIT_V(4); PG8_BAR;
        PG8_STAGE(PG8_SB(1, 0), cB + kstep, voffB); PG8_STAGE(PG8_SA(1, 0), cA + kstep, voffA); PG8_STAGE(PG8_SB(1, 1), cB + hstep + kstep, voffB);
        PG8_WAIT_V(6); PG8_BAR;
    }
    for (;;) {
        const bool has_next = S.next(ui + 1, nxt);
        const char* nA = has_next ? (const char*)g.A + (size_t)nxt.pm * tstep : cA; const char* nB = has_next ? (const char*)g.Bt + (size_t)nxt.pn * tstep : cB;
        for (int t = 0; t < nt; t += 2) {
            const bool last = (t == nt - 2);
            const char* a1 = cA + (size_t)(t + 1) * kstep;
            const char* a2 = last ? nA : cA + (size_t)(t + 2) * kstep; const char* b2 = last ? nB : cB + (size_t)(t + 2) * kstep;
            const char* a3 = a2 + kstep; const char* b3 = b2 + kstep;
            if (last && has_next) S.a_ready(nxt);
            if constexpr (SP2) {
            PG8_LDB(B0, 0, 0); PG8_LDB(B1, 0, 1); PG8_SCHED; PG8_LDA(At, 0, 0); PG8_STAGE(PG8_SA(1, 1), a1 + hstep, voffA);
            PG8_WAIT_V(8); PG8_WAIT_L(0); PG8_BAR; PG8_MMA(0, 0, At, B0); PG8_MMA(0, 1, At, B1); PG8_BAR; PG8_SCHED;
            PG8_LDA(At, 0, 1); PG8_STAGE(PG8_SB(0, 0), b2, voffB); PG8_STAGE(PG8_SB(0, 1), b2 + hstep, voffB); PG8_STAGE(PG8_SA(0, 0), a2, voffA);
            PG8_WAIT_V(8); PG8_WAIT_L(0); PG8_BAR; PG8_MMA(1, 0, At, B0); PG8_MMA(1, 1, At, B1); PG8_BAR; PG8_SCHED;
            PG8_LDB(B0, 1, 0); PG8_LDB(B1, 1, 1); PG8_SCHED; PG8_LDA(At, 1, 0); PG8_STAGE(PG8_SA(0, 1), a2 + hstep, voffA);
            PG8_WAIT_V(8); PG8_WAIT_L(0); PG8_BAR; PG8_MMA(0, 0, At, B0); PG8_MMA(0, 1, At, B1); PG8_BAR; PG8_SCHED;
            PG8_LDA(At, 1, 1); PG8_STAGE(PG8_SB(1, 0), b3, voffB); PG8_STAGE(PG8_SB(1, 1), b3 + hstep, voffB); PG8_STAGE(PG8_SA(1, 0), a3, voffA);
            PG8_WAIT_V(8); PG8_WAIT_L(0); PG8_BAR; PG8_MMA(1, 0, At, B0); PG8_MMA(1, 1, At, B1); PG8_BAR; PG8_SCHED;
            } else {
            PG8_LDB(B0, 0, 0); PG8_SCHED; PG8_LDA(At, 0, 0); PG8_STAGE(PG8_SA(1, 1), a1 + hstep, voffA);
            PG8_WAIT_L(8); PG8_BAR; PG8_WAIT_L(0); PG8_MMA(0, 0, At, B0); PG8_BAR; PG8_SCHED;
            PG8_LDB(B1, 0, 1); PG8_STAGE(PG8_SB(0, 0), b2, voffB);
            PG8_BAR; PG8_WAIT_L(0); PG8_MMA(0, 1, At, B1); PG8_BAR;
            PG8_LDA(At, 0, 1); PG8_STAGE(PG8_SA(0, 0), a2, voffA);
            PG8_BAR; PG8_WAIT_L(0); PG8_MMA(1, 0, At, B0); PG8_BAR; PG8_SCHED;
            PG8_STAGE(PG8_SB(0, 1), b2 + hstep, voffB);
            PG8_WAIT_V(6); PG8_BAR; PG8_MMA(1, 1, At, B1); PG8_BAR;
            PG8_LDB(B0, 1, 0); PG8_SCHED; PG8_LDA(At, 1, 0); PG8_STAGE(PG8_SA(0, 1), a2 + hstep, voffA);
            PG8_WAIT_L(8); PG8_BAR; PG8_WAIT_L(0); PG8_MMA(0, 0, At, B0); PG8_BAR; PG8_SCHED;
            PG8_LDB(B1, 1, 1); PG8_STAGE(PG8_SB(1, 0), b3, voffB);
            PG8_BAR; PG8_WAIT_L(0); PG8_MMA(0, 1, At, B1); PG8_BAR;
            PG8_LDA(At, 1, 1); PG8_STAGE(PG8_SA(1, 0), a3, voffA);
            PG8_BAR; PG8_WAIT_L(0); PG8_MMA(1, 0, At, B0); PG8_BAR; PG8_SCHED;
            PG8_STAGE(PG8_SB(1, 1), b3 + hstep, voffB);
            PG8_WAIT_V(6); PG8_BAR; PG8_MMA(1, 1, At, B1); PG8_BAR;
            }
        }
        if constexpr (ALIGN_EPI) { if (wr == 0) PG8_BAR; }
        if constexpr (!Epi::AFTER_DRAIN) { E(acc, cur, wr, wc, fr, fq); S.done(cur); }
        if (!has_next) break;
#pragma unroll
        for (int a = 0; a < 2; ++a)
#pragma unroll
            for (int b = 0; b < 2; ++b)
#pragma unroll
                for (int m = 0; m < 4; ++m)
#pragma unroll
                    for (int n = 0; n < 2; ++n) acc[a][b][m][n] = (f32x4){0.f, 0.f, 0.f, 0.f};
        cur = nxt; cA = nA; cB = nB; ++ui;
        if constexpr (ALIGN_EPI) { if (wr == 1) PG8_BAR; }
    }
    PG8_WAIT_V(0);
    if constexpr (!ALIGN_EPI) { if (wr == 0) PG8_BAR; }
    PG8_BAR;
    if constexpr (Epi::AFTER_DRAIN) { E.fused(acc, cur, wr, wc, fr, fq, lds, wid, lane); S.done(cur); }
#undef PG8_SA
#undef PG8_SB
#undef PG8_STAGE
#undef PG8_LDA
#undef PG8_LDB
#undef PG8_MMA
#undef PG8_WAIT_V
#undef PG8_WAIT_L
#undef PG8_BAR
#undef PG8_SCHED
}
}

__device__ constexpr float ROPE_INV_REV[16] = {1.591549431e-01f, 8.949940161e-02f, 5.032921210e-02f, 2.830219583e-02f, 1.591549431e-02f, 8.949940161e-03f, 5.032921210e-03f, 2.830219583e-03f, 1.591549431e-03f, 8.949940161e-04f, 5.032921210e-04f, 2.830219583e-04f, 1.591549431e-04f, 8.949940161e-05f, 5.032921210e-05f, 2.830219583e-05f};
__device__ __forceinline__ void qk_norm_rope8(const u32x4 raw, const float (&gn)[8], const float (&cs)[8], const float (&sn)[8], bool second, float scale, u32x4& out) {
    float x[8] = {bflo(raw.x), bfhi(raw.x), bflo(raw.y), bfhi(raw.y), bflo(raw.z), bfhi(raw.z), bflo(raw.w), bfhi(raw.w)};
    float ss = 0.f;
#pragma unroll
    for (int e = 0; e < 8; ++e) ss += x[e] * x[e];
    ss += __shfl_xor(ss, 1); ss += __shfl_xor(ss, 2); ss += __shfl_xor(ss, 4);
    const float r = rsqrtf(ss * (1.0f / 64.0f) + EPS) ;
    float o[8];
#pragma unroll
    for (int e = 0; e < 8; ++e) {
        const float y = x[e] * r * gn[e];
        const float other = __shfl_xor(y, 2);
        o[e] = (second ? (y * cs[e] + other * sn[e]) : (y * cs[e] - other * sn[e])) * scale;
    }
    out.x = pk2(o[0], o[1]); out.y = pk2(o[2], o[3]); out.z = pk2(o[4], o[5]); out.w = pk2(o[6], o[7]);
}
__device__ __forceinline__ void phase_qkprep(const Params& p, int layer, char* lds, bf16_t* qout) {
    const int tid = otid(), lane = tid & 63, wave = tid >> 6;
    const bf16_t* qkv = (const bf16_t*)(p.ws + R_QKV);
    const int sub = lane & 7;
    const bool second = ((sub >> 1) & 1) != 0, colaxis = (sub >> 2) != 0;
    float gq[8], gk[8], ir[8];
#pragma unroll
    for (int e = 0; e < 8; ++e) {
        gq[e] = p.in[I_QG][layer * 64 + sub * 8 + e]; gk[e] = p.in[I_KG][layer * 64 + sub * 8 + e];
        ir[e] = (sub & 1) ? ROPE_INV_REV[8 + e] : ROPE_INV_REV[e];
    }
    const int gw = obid() * NWAVE + wave, ngw = NBLK * NWAVE;
    for (int t = gw; t < T; t += ngw) {
        const int l = t & (SL - 1);
        const float pos = colaxis ? (float)(l & 63) : (float)(l >> 6);
        float cs[8], sn[8];
#pragma unroll
        for (int e = 0; e < 8; ++e) { const float a = pos * ir[e]; cs[e] = __builtin_amdgcn_cosf(a); sn[e] = __builtin_amdgcn_sinf(a); }
        const u32x4 rq = *(const u32x4*)(qkv + (size_t)t * 768 + lane * 8);
        u32x4 rk = {0u, 0u, 0u, 0u};
        if (lane < 16) rk = *(const u32x4*)(qkv + (size_t)t * 768 + 512 + lane * 8);
        u32x4 oq, ok;
        qk_norm_rope8(rq, gq, cs, sn, second, 0.125f * 1.4426950408889634f, oq);
        qk_norm_rope8(rk, gk, cs, sn, second, 1.0f, ok);
        *(u32x4*)(qout + (size_t)t * 768 + lane * 8) = oq;
        if (lane < 16) *(u32x4*)(qout + (size_t)t * 768 + 512 + lane * 8) = ok;
    }
}

#include <hip/hip_bf16.h>
#include <cmath>
namespace attn_body {
using bf16=__hip_bfloat16;
using bf16x8=__attribute__((ext_vector_type(8)))short;
using s16x4=__attribute__((ext_vector_type(4)))short;
using f32x16=__attribute__((ext_vector_type(16)))float;
using u32x4=__attribute__((ext_vector_type(4)))unsigned;
constexpr int SEQ=8192,D=64,PQ=768,PO=512;
constexpr int NW=8,QBLK=32,QB=QBLK*NW,KVBLK=64,NQB=SEQ/QB;
constexpr int ATTN_UNIT_ROWS=QB;
__device__ __forceinline__ int crow(int r,int hi){return (r&3)+8*(r>>2)+4*hi;}
#define SBAR() __builtin_amdgcn_sched_barrier(0)
__device__ __forceinline__ void cmask(f32x16&p0,f32x16&p1,int jb,int qrel,int hi){
  const float NEG=-INFINITY; int kb=64*jb+4*hi;
  #pragma unroll
  for(int r=0;r<16;++r){int kv=kb+(r&3)+8*(r>>2); if(kv>qrel)p0[r]=NEG; if(kv+32>qrel)p1[r]=NEG;}
}

constexpr int NSLOT=3, SLOTB=8192;
constexpr int LDS_K=0, LDS_V=NSLOT*SLOTB, LDS_WS=2*NSLOT*SLOTB, LDS_OST=LDS_WS+NW*64*4, LDS_BYTES=LDS_OST+NW*4096;
constexpr float C2=0.125f*1.4426950408889634f;
__device__ __forceinline__ void glds16(const void*gsrc,unsigned lds_dst){unsigned keep;
  asm volatile("s_mov_b32 %0, m0\n\ts_mov_b32 m0, %2\n\ts_nop 0\n\tglobal_load_lds_dwordx4 %1, off\n\ts_mov_b32 m0, %0":"=&s"(keep):"v"(gsrc),"s"(lds_dst):"memory");}
__device__ __forceinline__ float max3f(float a,float b,float c){float r;asm("v_max3_f32 %0, %1, %2, %3":"=v"(r):"v"(a),"v"(b),"v"(c));return r;}
__device__ __forceinline__ float max2f(float a,float b){float r;asm("v_max_f32_e32 %0, %1, %2":"=v"(r):"v"(a),"v"(b));return r;}
__device__ __forceinline__ float fadd_s(float a,float b){float r;asm("v_add_f32_e32 %0, %1, %2":"=v"(r):"v"(a),"v"(b));return r;}
__device__ __forceinline__ float fsub_s(float a,float b){float r;asm("v_sub_f32_e32 %0, %1, %2":"=v"(r):"v"(a),"v"(b));return r;}
typedef float f32x2_t __attribute__((ext_vector_type(2))); typedef __bf16 bf16x2_t __attribute__((ext_vector_type(2)));
__device__ __forceinline__ unsigned cvtpk_s(float lo,float hi){f32x2_t v={lo,hi};bf16x2_t b=__builtin_convertvector(v,bf16x2_t);return __builtin_bit_cast(unsigned,b);}
#define WAIT_BAR(N) asm volatile("s_waitcnt vmcnt(" #N ") lgkmcnt(0)\n\ts_barrier":::"memory")

__device__ __forceinline__ void qkt(f32x16&p0,f32x16&p1,const char*Kslot,const bf16x8*qr,const f32x16&negm,int r32,int hi){
  const char*kb=Kslot+hi*1024+r32*16;
  #pragma unroll
  for(int d0=0;d0<4;++d0){
    const bf16x8 b0=*reinterpret_cast<const bf16x8*>(kb+d0*2048);
    const bf16x8 b1=*reinterpret_cast<const bf16x8*>(kb+d0*2048+512);
    if(d0==0){p0=__builtin_amdgcn_mfma_f32_32x32x16_bf16(b0,qr[0],negm,0,0,0);p1=__builtin_amdgcn_mfma_f32_32x32x16_bf16(b1,qr[0],negm,0,0,0);}
    else{p0=__builtin_amdgcn_mfma_f32_32x32x16_bf16(b0,qr[d0],p0,0,0,0);p1=__builtin_amdgcn_mfma_f32_32x32x16_bf16(b1,qr[d0],p1,0,0,0);}}
}
typedef __attribute__((address_space(3))) const char* lds_cptr;
typedef short v4i16_t __attribute__((ext_vector_type(4)));
__device__ __forceinline__ void kload8(bf16x8*kf,lds_cptr kp){
  kf[0]=*(const __attribute__((address_space(3))) bf16x8*)(kp);      kf[1]=*(const __attribute__((address_space(3))) bf16x8*)(kp+512);
  kf[2]=*(const __attribute__((address_space(3))) bf16x8*)(kp+2048); kf[3]=*(const __attribute__((address_space(3))) bf16x8*)(kp+2560);
  kf[4]=*(const __attribute__((address_space(3))) bf16x8*)(kp+4096); kf[5]=*(const __attribute__((address_space(3))) bf16x8*)(kp+4608);
  kf[6]=*(const __attribute__((address_space(3))) bf16x8*)(kp+6144); kf[7]=*(const __attribute__((address_space(3))) bf16x8*)(kp+6656);
}
__device__ __forceinline__ void kload2(bf16x8*kf,lds_cptr kp,int j){ kf[2*j]=*(const __attribute__((address_space(3))) bf16x8*)(kp+j*2048); kf[2*j+1]=*(const __attribute__((address_space(3))) bf16x8*)(kp+j*2048+512); }
__device__ __forceinline__ s16x4 vtr(lds_cptr p){ return __builtin_bit_cast(s16x4,__builtin_amdgcn_ds_read_tr16_b64_v4i16((__attribute__((address_space(3))) v4i16_t*)p)); }
__device__ __forceinline__ float rowmax(const f32x16&p0,const f32x16&p1){
  float a=max3f(p0[0],p0[1],p1[0]),b=max3f(p0[2],p0[3],p1[1]);a=max3f(a,p1[2],p1[3]);
  #pragma unroll
  for(int r=4;r<16;r+=4){a=max3f(a,p0[r],p0[r+1]);b=max3f(b,p0[r+2],p0[r+3]);a=max3f(a,p1[r],p1[r+1]);b=max3f(b,p1[r+2],p1[r+3]);}
  const float m=max2f(a,b);
  auto rr=__builtin_amdgcn_permlane32_swap(__float_as_uint(m),__float_as_uint(m),false,false);
  return max2f(__uint_as_float(rr[0]),__uint_as_float(rr[1]));
}
__device__ __forceinline__ void pv(f32x16*o,int vb,bf16x8 pa0,bf16x8 pa1,bf16x8 pa2,bf16x8 pa3){
  #pragma unroll
  for(int d0=0;d0<2;++d0){s16x4 lo[4],hi[4];
    #pragma unroll
    for(int ks=0;ks<4;++ks){
      asm volatile("ds_read_b64_tr_b16 %0,%1 offset:%c2":"=&v"(lo[ks]):"v"(vb),"i"(d0*4096+ks*1024):"memory");
      asm volatile("ds_read_b64_tr_b16 %0,%1 offset:%c2":"=&v"(hi[ks]):"v"(vb),"i"(d0*4096+ks*1024+512):"memory");}
    asm volatile("s_waitcnt lgkmcnt(0)":::"memory");SBAR();
    #define PK(k) (bf16x8){lo[k][0],lo[k][1],lo[k][2],lo[k][3],hi[k][0],hi[k][1],hi[k][2],hi[k][3]}
    o[d0]=__builtin_amdgcn_mfma_f32_32x32x16_bf16(pa0,PK(0),o[d0],0,0,0);
    o[d0]=__builtin_amdgcn_mfma_f32_32x32x16_bf16(pa1,PK(1),o[d0],0,0,0);
    o[d0]=__builtin_amdgcn_mfma_f32_32x32x16_bf16(pa2,PK(2),o[d0],0,0,0);
    o[d0]=__builtin_amdgcn_mfma_f32_32x32x16_bf16(pa3,PK(3),o[d0],0,0,0);
    #undef PK
  }
}

#ifndef ATTN_STORE16
#define ATTN_STORE16(p,v) (*(u32x4*)(p)=(v))
#endif
template<int THRL> __device__ __forceinline__ void attn_unit(int b,int h,int g,int qb,const bf16*Q,const bf16*__restrict__ K,const bf16*__restrict__ V,bf16*O,char*shm){
  const int tid=otid(),lane=tid&63,r32=lane&31,hi=lane>>5; const int wid=__builtin_amdgcn_readfirstlane(tid>>6);
  const long rowbase=(long)b*SEQ; const int q0=qb*QB;
  const bf16*Qw=Q+(rowbase+q0+wid*QBLK)*PQ+h*D;
  const bf16*Kh=K+rowbase*PQ+g*D,*Vh=V+rowbase*PQ+g*D;
  const unsigned lds0=(unsigned)(uintptr_t)shm;
  float*wsf=(float*)(shm+LDS_WS)+wid*64;
  const bf16*ksrc=Kh+(long)lane*PQ+wid*8;
  const bf16*vsrc=Vh+(long)(16*(wid&3)+(lane>>2))*PQ+(wid>>2)*32+(lane&3)*8;
  const unsigned kdst=lds0+LDS_K+wid*1024, vdst=lds0+LDS_V+wid*1024;
  #define DMA_K(t,slot) glds16(ksrc+(long)(t)*KVBLK*PQ,(unsigned)__builtin_amdgcn_readfirstlane(kdst+(slot)))
  #define DMA_V(t,slot) glds16(vsrc+(long)(t)*KVBLK*PQ,(unsigned)__builtin_amdgcn_readfirstlane(vdst+(slot)))
  const int vb0=(int)(lds0+LDS_V)+((lane>>4)&1)*32+(lane&3)*8+(4*hi+((lane&15)>>2))*64;
  const char*Kbase=shm+LDS_K; bf16x8 kf[8];
  const lds_cptr shm3=(lds_cptr)shm; const lds_cptr kp0=shm3+LDS_K+hi*1024+r32*16; const lds_cptr vp0=shm3+LDS_V+((lane>>4)&1)*32+(lane&3)*8+(4*hi+((lane&15)>>2))*64;
  constexpr int NT=SEQ/KVBLK;
  DMA_K(0,0);DMA_V(0,0);DMA_K(1,SLOTB);
  bf16x8 qr[4];
  #pragma unroll
  for(int d0=0;d0<4;++d0)qr[d0]=*reinterpret_cast<const bf16x8*>(&Qw[(long)r32*PQ+d0*16+hi*8]);
  float mhat=0.f,l_reg=0.f;f32x16 o[2];o[0]=f32x16{};o[1]=f32x16{};f32x16 negm=f32x16{};asm volatile("":"+v"(negm));
    #define CMASK(P0,P1,t) do{}while(0)
  bool resc=false;
  #define START(P0,P1) do{ const float rm=rowmax(P0,P1); resc=false; \
    { const float dl=rm; mhat=fadd_s(mhat,dl); \
      _Pragma("unroll") for(int r=0;r<16;++r){P0[r]=fsub_s(P0[r],dl);P1[r]=fsub_s(P1[r],dl);} \
      _Pragma("unroll") for(int r=0;r<16;++r)negm[r]=-mhat; asm volatile("":"+v"(negm)); } \
    _Pragma("unroll") for(int r=0;r<16;++r)P0[r]=__builtin_amdgcn_exp2f(P0[r]); }while(0)
  #define RESC() do{ if(resc){ asm volatile("s_waitcnt lgkmcnt(0)":::"memory"); \
      _Pragma("unroll") for(int d_=0;d_<2;++d_) _Pragma("unroll") for(int r=0;r<16;++r)o[d_][r]*=wsf[crow(r,hi)]; } }while(0)
  f32x16 pA0,pA1,pB0,pB1;
  int sl_prev=0,sl_cur=0,sl_next=SLOTB;
  #define ROT() do{sl_prev=sl_cur;sl_cur=sl_next;sl_next=(sl_next==(NSLOT-1)*SLOTB)?0:sl_next+SLOTB;}while(0)
  DMA_K(2,2*SLOTB);
  WAIT_BAR(3);
  qkt(pA0,pA1,Kbase,qr,negm,r32,hi);asm volatile("s_nop 15\n\ts_nop 7":"+v"(pA0),"+v"(pA1));CMASK(pA0,pA1,0);
  START(pA0,pA1);
  _Pragma("unroll") for(int r=0;r<16;++r)pA1[r]=__builtin_amdgcn_exp2f(pA1[r]);
  WAIT_BAR(0);
  DMA_K(3,0);DMA_V(1,SLOTB);
  ROT();
  kload8(kf,kp0+sl_cur);
  WAIT_BAR(2);
  s16x4 vlo[8],vhi[8]; u32x4 pw0,pw1,pw2,pw3;
  #define PKW(P,B) cvtpk_s(P[B],P[B+1])
  #define PAF(k) __builtin_bit_cast(bf16x8,pw##k)
  #define VFR(i) (bf16x8){vlo[i][0],vlo[i][1],vlo[i][2],vlo[i][3],vhi[i][0],vhi[i][1],vhi[i][2],vhi[i][3]}
  #define PIN(x) asm volatile("":"+v"(x))
  #define MX3(a,b,c) __builtin_fmaxf(__builtin_fmaxf((a),(b)),(c))
  #define GAPA(MF,A0,A1,A2,A3,W0,W1,PW) do{ MF; sacc+=A0; sacc+=A1; sacc+=A2; sacc+=A3; PIN(sacc); W0; W1; PIN(PW); SBAR(); }while(0)
  #define EX(v) __builtin_amdgcn_exp2f(v)
  #define GAPB(MF,X,B) do{ MF; X[B]=EX(X[B]); X[B+1]=EX(X[B+1]); X[B+2]=EX(X[B+2]); X[B+3]=EX(X[B+3]); PIN(X); SBAR(); }while(0)
  #define VRD(i) do{ vlo[i]=vtr(vp_+(((i)>>2)*4096+((i)&3)*1024)); vhi[i]=vtr(vp_+(((i)>>2)*4096+((i)&3)*1024+512)); }while(0)
  #define KRD(G,j) do{ if(G){ kload2(kf,kp0+sl_next,j); SBAR(); } }while(0)
  #define STEP(C0,C1,P0,P1,t,GK,GV,GL) do{ SBAR(); \
    const lds_cptr vp_=vp0+sl_prev; \
    VRD(0); SBAR(); float sacc=(P0[0]+P0[1]); \
    GAPA(C0=__builtin_amdgcn_mfma_f32_32x32x16_bf16(kf[0],qr[0],negm,0,0,0), P0[2],P0[3],P0[4],P0[5],     pw0[0]=PKW(P0,0), pw0[1]=PKW(P0,2), pw0); \
    VRD(4); SBAR(); GAPA(C1=__builtin_amdgcn_mfma_f32_32x32x16_bf16(kf[1],qr[0],negm,0,0,0), P0[6],P0[7],P0[8],P0[9],     pw0[2]=PKW(P0,4), pw0[3]=PKW(P0,6), pw0); \
    VRD(1); SBAR(); GAPA(C0=__builtin_amdgcn_mfma_f32_32x32x16_bf16(kf[2],qr[1],C0,0,0,0),   P0[10],P0[11],P0[12],P0[13], pw1[0]=PKW(P0,8), pw1[1]=PKW(P0,10), pw1); \
    VRD(5); SBAR(); GAPA(C1=__builtin_amdgcn_mfma_f32_32x32x16_bf16(kf[3],qr[1],C1,0,0,0),   P0[14],P0[15],P1[0],P1[1],   pw1[2]=PKW(P0,12),pw1[3]=PKW(P0,14), pw1); \
    VRD(2); SBAR(); GAPA(C0=__builtin_amdgcn_mfma_f32_32x32x16_bf16(kf[4],qr[2],C0,0,0,0),   P1[2],P1[3],P1[4],P1[5],     pw2[0]=PKW(P1,0), pw2[1]=PKW(P1,2), pw2); \
    VRD(6); SBAR(); GAPA(C1=__builtin_amdgcn_mfma_f32_32x32x16_bf16(kf[5],qr[2],C1,0,0,0),   P1[6],P1[7],P1[8],P1[9],     pw2[2]=PKW(P1,4), pw2[3]=PKW(P1,6), pw2); \
    VRD(3); SBAR(); GAPA(C0=__builtin_amdgcn_mfma_f32_32x32x16_bf16(kf[6],qr[3],C0,0,0,0),   P1[10],P1[11],P1[12],P1[13], pw3[0]=PKW(P1,8), pw3[1]=PKW(P1,10), pw3); \
    VRD(7); SBAR(); GAPA(C1=__builtin_amdgcn_mfma_f32_32x32x16_bf16(kf[7],qr[3],C1,0,0,0),   P1[14],P1[15],0.f,0.f,       pw3[2]=PKW(P1,12),pw3[3]=PKW(P1,14), pw3); \
    l_reg+=sacc; \
    if(GK){DMA_K((t)+3,sl_cur);} if(GV){DMA_V((t)+1,sl_next);} \
    CMASK(C0,C1,t); \
    { float a=MX3(C0[0],C0[1],C1[0]),b=MX3(C0[2],C0[3],C1[1]); a=MX3(a,C1[2],C1[3]); \
      _Pragma("unroll") for(int r=4;r<16;r+=4){a=MX3(a,C0[r],C0[r+1]);b=MX3(b,C0[r+2],C0[r+3]);a=MX3(a,C1[r],C1[r+1]);b=MX3(b,C1[r+2],C1[r+3]);} \
      float rm=__builtin_fmaxf(a,b); { auto rr=__builtin_amdgcn_permlane32_swap(__float_as_uint(rm),__float_as_uint(rm),false,false); rm=__builtin_fmaxf(__uint_as_float(rr[0]),__uint_as_float(rr[1])); } \
      resc=false; \
      if(__builtin_expect(__any(rm>(float)THRL),0)){ const float dl=__builtin_fmaxf(rm,0.f); mhat+=dl; \
        _Pragma("unroll") for(int r=0;r<16;++r){C0[r]-=dl;C1[r]-=dl;} \
        _Pragma("unroll") for(int r=0;r<16;++r)negm[r]=-mhat; asm volatile("":"+v"(negm)); \
        const float f=__builtin_amdgcn_exp2f(-dl); l_reg*=f; if(hi==0)wsf[r32]=f; resc=true; } } \
    SBAR(); \
    GAPB(o[0]=__builtin_amdgcn_mfma_f32_32x32x16_bf16(PAF(0),VFR(0),o[0],0,0,0), C0,0); \
    GAPB(o[1]=__builtin_amdgcn_mfma_f32_32x32x16_bf16(PAF(0),VFR(4),o[1],0,0,0), C0,4); \
    KRD(GL,0); GAPB(o[0]=__builtin_amdgcn_mfma_f32_32x32x16_bf16(PAF(1),VFR(1),o[0],0,0,0), C0,8); \
    KRD(GL,1); GAPB(o[1]=__builtin_amdgcn_mfma_f32_32x32x16_bf16(PAF(1),VFR(5),o[1],0,0,0), C0,12); \
    KRD(GL,2); GAPB(o[0]=__builtin_amdgcn_mfma_f32_32x32x16_bf16(PAF(2),VFR(2),o[0],0,0,0), C1,0); \
    KRD(GL,3); GAPB(o[1]=__builtin_amdgcn_mfma_f32_32x32x16_bf16(PAF(2),VFR(6),o[1],0,0,0), C1,4); \
    GAPB(o[0]=__builtin_amdgcn_mfma_f32_32x32x16_bf16(PAF(3),VFR(3),o[0],0,0,0), C1,8); \
    GAPB(o[1]=__builtin_amdgcn_mfma_f32_32x32x16_bf16(PAF(3),VFR(7),o[1],0,0,0), C1,12); \
    }while(0)
  int t=1;
  #undef CMASK
  #define CMASK(P0,P1,t) do{}while(0)
  for(;t+5<NT;t+=2){
    STEP(pB0,pB1,pA0,pA1,t,true,true,true);     WAIT_BAR(2); RESC(); ROT();
    STEP(pA0,pA1,pB0,pB1,t+1,true,true,true);   WAIT_BAR(2); RESC(); ROT();
  }
  #define ENDW(tt) do{ if((tt)+3<NT){WAIT_BAR(2);} else if((tt)+2<NT){WAIT_BAR(1);} else {WAIT_BAR(0);} }while(0)
  for(;t+1<NT;t+=2){
    STEP(pB0,pB1,pA0,pA1,t,(t+3<NT),(t+1<NT),(t+1<NT));       ENDW(t);   RESC(); ROT();
    STEP(pA0,pA1,pB0,pB1,t+1,(t+4<NT),(t+2<NT),(t+2<NT));     ENDW(t+1); RESC(); ROT();
  }
  STEP(pB0,pB1,pA0,pA1,NT-1,false,false,false); RESC();
  { float sacc=pB0[0]+pB0[1]; _Pragma("unroll") for(int r=2;r<16;++r)sacc+=pB0[r]; _Pragma("unroll") for(int r=0;r<16;++r)sacc+=pB1[r]; l_reg+=sacc;
    pw0=(u32x4){PKW(pB0,0),PKW(pB0,2),PKW(pB0,4),PKW(pB0,6)};pw1=(u32x4){PKW(pB0,8),PKW(pB0,10),PKW(pB0,12),PKW(pB0,14)};pw2=(u32x4){PKW(pB1,0),PKW(pB1,2),PKW(pB1,4),PKW(pB1,6)};pw3=(u32x4){PKW(pB1,8),PKW(pB1,10),PKW(pB1,12),PKW(pB1,14)};
    SBAR(); pv(o,vb0+sl_cur,PAF(0),PAF(1),PAF(2),PAF(3)); }
  #undef PKW
  #undef PAF
  #undef VFR
  #undef PIN
  #undef MX3
  #undef GAPA
  #undef GAPB
  #undef EX
  #undef VRD
  #undef KRD
  #undef STEP
  #undef ENDW
  {auto rr=__builtin_amdgcn_permlane32_swap(__float_as_uint(l_reg),__float_as_uint(l_reg),false,false);l_reg=__uint_as_float(rr[0])+__uint_as_float(rr[1]);}
  if(hi==0)wsf[32+r32]=l_reg;asm volatile("s_waitcnt lgkmcnt(0)":::"memory");
  float rli[16];
  #pragma unroll
  for(int r=0;r<16;++r)rli[r]=__builtin_amdgcn_rcpf(wsf[32+crow(r,hi)]);
  bf16*Ow=O+(rowbase+q0+wid*QBLK)*PO+h*D;
  { bf16*stg=(bf16*)(shm+LDS_OST)+wid*2048;
    #pragma unroll
    for(int r=0;r<16;++r){const int orow=crow(r,hi);
      #pragma unroll
      for(int d0=0;d0<2;++d0)stg[orow*64+d0*32+r32]=__float2bfloat16(o[d0][r]*rli[r]);}
    asm volatile("s_waitcnt lgkmcnt(0)":::"memory");
    #pragma unroll
    for(int i=0;i<4;++i){const int row=i*8+(lane>>3),ch=lane&7; const u32x4 v=*(const u32x4*)(stg+row*64+ch*8); ATTN_STORE16(Ow+(long)row*PO+ch*8,v);} }
  asm volatile("s_waitcnt lgkmcnt(0)\n\ts_barrier":::"memory");
  #undef DMA_K
  #undef DMA_V
  #undef CMASK
  #undef START
  #undef RESC
  #undef ROT
}
constexpr int ATTN_LDS_BYTES=LDS_BYTES;
#undef SBAR
#undef WAIT_BAR
}

__device__ __forceinline__ void phase_attn(const Params& p, char* lds) {
            {
                const int bid = obid();
                const int vcu = ((NBLK & 7) == 0) ? (bid & 7) * (int)(NBLK >> 3) + (bid >> 3) : bid;
                const attn_body::bf16* qkvb = (const attn_body::bf16*)(p.ws + R_QKV);
                for (int u = vcu; u < 512; u += NBLK) {
                    const int bg = (u & 255) >> 6, r = u & 63, hh = r & 3, qb = (r >> 2) + 16 * (u >> 8);
                    const int b = bg >> 1, g = bg & 1;
                    attn_body::attn_unit<8>(b, 4 * g + hh, g, qb, qkvb, qkvb + 512, qkvb + 640, (attn_body::bf16*)(p.ws + R_ATT), lds);
                }
            }
}

__device__ __forceinline__ f32x4 convd4(const float* row, int l0, float w0, float w1, float w2, float cb) {
    const f32x4 c = *(const f32x4*)(row + l0);
    const float lft = (l0 > 0) ? row[l0 - 1] : 0.f;
    const float rgt = (l0 + 4 < SL) ? row[l0 + 4] : 0.f;
    f32x4 o;
    o.x = cb + w0 * lft + w1 * c.x + w2 * c.y;
    o.y = cb + w0 * c.x + w1 * c.y + w2 * c.z;
    o.z = cb + w0 * c.y + w1 * c.z + w2 * c.w;
    o.w = cb + w0 * c.z + w1 * c.w + w2 * rgt;
    return o;
}
__device__ __forceinline__ void cmul_kf(float2* Z, const float2* KF, int tid) {
#pragma unroll 4
    for (int i = 0; i < 16; ++i) {
        const int pp = 2 * tid + 1024 * i;
        const f32x4 z = *(const f32x4*)(Z + zp(pp)), k = *(const f32x4*)(KF + pp);
        f32x4 o; o.x = z.x * k.x - z.y * k.y; o.y = z.x * k.y + z.y * k.x; o.z = z.z * k.z - z.w * k.w; o.w = z.z * k.w + z.w * k.z;
        *(f32x4*)(Z + zp(pp)) = o;
    }
}
__device__ __forceinline__ void hyena_job(const Params& p, int layer, int c, char* lds) {
    const int tid = otid();
    float2* Z = (float2*)lds;
    const float* HF = (const float*)(p.ws + R_HF);
    const float* cw = p.in[I_CW] + (size_t)layer * 3 * 768; const float* cbp = p.in[I_CB] + layer * 768;
    const float2* KF0 = (const float2*)(p.ws + OFF_KF) + ((size_t)(layer * 256 + c) * 2) * 16384;
    const float2* KF1 = KF0 + 16384;
    float* Y = (float*)(p.ws + R_Y) + (size_t)c * T;
    const float bias0 = p.in[I_HB][(layer * 2 + 0) * 256 + c], bias1 = p.in[I_HB][(layer * 2 + 1) * 256 + c];
    const int cv = c, c1 = 256 + c, c2 = 512 + c;
    const float* rv = HF + (size_t)cv * T; const float* r1 = HF + (size_t)c1 * T; const float* r2 = HF + (size_t)c2 * T;
    const float v_w0 = cw[cv], v_w1 = cw[768 + cv], v_w2 = cw[1536 + cv], v_cb = cbp[cv];
    const float a_w0 = cw[c1], a_w1 = cw[768 + c1], a_w2 = cw[1536 + c1], a_cb = cbp[c1];
    const float b_w0 = cw[c2], b_w1 = cw[768 + c2], b_w2 = cw[1536 + c2], b_cb = cbp[c2];
    const f32x4 zero4 = {0.f, 0.f, 0.f, 0.f};
    __syncthreads();
#pragma unroll 1
    for (int i = 0; i < 4; ++i) {
        const int l0 = 4 * otid() + 2048 * i;
        const f32x4 va = convd4(rv, l0, v_w0, v_w1, v_w2, v_cb), vb = convd4(rv + SL, l0, v_w0, v_w1, v_w2, v_cb);
        *(f32x4*)(Z + zp(l0)) = (f32x4){va.x, vb.x, va.y, vb.y}; *(f32x4*)(Z + zp(l0) + 2) = (f32x4){va.z, vb.z, va.w, vb.w};
        *(f32x4*)(Z + zp(8192 + l0)) = zero4; *(f32x4*)(Z + zp(8192 + l0) + 2) = zero4;
    }
    __syncthreads();
    fft16k_fwd(Z);
    cmul_kf(Z, KF0, otid());
    __syncthreads();
    fft16k_inv(Z);
#pragma unroll 1
    for (int i = 0; i < 4; ++i) {
        const int l0 = 4 * otid() + 2048 * i;
        const f32x4 za = *(const f32x4*)(Z + zp(l0)), zb = *(const f32x4*)(Z + zp(l0) + 2);
        const f32x4 va = convd4(rv, l0, v_w0, v_w1, v_w2, v_cb), vb = convd4(rv + SL, l0, v_w0, v_w1, v_w2, v_cb);
        const f32x4 ga = convd4(r1, l0, a_w0, a_w1, a_w2, a_cb), gb = convd4(r1 + SL, l0, a_w0, a_w1, a_w2, a_cb);
        f32x4 ya, yb;
        ya.x = ga.x * (za.x + va.x * bias0); ya.y = ga.y * (za.z + va.y * bias0); ya.z = ga.z * (zb.x + va.z * bias0); ya.w = ga.w * (zb.z + va.w * bias0);
        yb.x = gb.x * (za.y + vb.x * bias0); yb.y = gb.y * (za.w + vb.y * bias0); yb.z = gb.z * (zb.y + vb.z * bias0); yb.w = gb.w * (zb.w + vb.w * bias0);
        *(f32x4*)(Y + l0) = ya; *(f32x4*)(Y + SL + l0) = yb;
        *(f32x4*)(Z + zp(l0)) = (f32x4){ya.x, yb.x, ya.y, yb.y}; *(f32x4*)(Z + zp(l0) + 2) = (f32x4){ya.z, yb.z, ya.w, yb.w};
        *(f32x4*)(Z + zp(8192 + l0)) = zero4; *(f32x4*)(Z + zp(8192 + l0) + 2) = zero4;
    }
    __syncthreads();
    fft16k_fwd(Z);
    cmul_kf(Z, KF1, otid());
    __syncthreads();
    fft16k_inv(Z);
#pragma unroll 1
    for (int i = 0; i < 4; ++i) {
        const int l0 = 4 * otid() + 2048 * i;
        const f32x4 za = *(const f32x4*)(Z + zp(l0)), zb = *(const f32x4*)(Z + zp(l0) + 2);
        const f32x4 ga = convd4(r2, l0, b_w0, b_w1, b_w2, b_cb), gb = convd4(r2 + SL, l0, b_w0, b_w1, b_w2, b_cb);
        const f32x4 pa = *(const f32x4*)(Y + l0), pb = *(const f32x4*)(Y + SL + l0);
        f32x4 ya, yb;
        ya.x = ga.x * (za.x + pa.x * bias1); ya.y = ga.y * (za.z + pa.y * bias1); ya.z = ga.z * (zb.x + pa.z * bias1); ya.w = ga.w * (zb.z + pa.w * bias1);
        yb.x = gb.x * (za.y + pb.x * bias1); yb.y = gb.y * (za.w + pb.y * bias1); yb.z = gb.z * (zb.y + pb.z * bias1); yb.w = gb.w * (zb.w + pb.w * bias1);
        *(f32x4*)(Y + l0) = ya; *(f32x4*)(Y + SL + l0) = yb;
    }
    __syncthreads();
}

__device__ __forceinline__ void fnet_job(const Params& p, int ch, char* lds) {
    const int tid = otid();
    float2* Z = (float2*)lds;
    const float* row = (const float*)(p.ws + R_HF) + (size_t)(768 + ch) * T;
    float* UR = (float*)(p.ws + R_UR) + (size_t)ch * T;
    float* UI = (float*)(p.ws + R_UI) + (size_t)ch * T;
    __syncthreads();
#pragma unroll
    for (int i = 0; i < 4; ++i) {
        const int l0 = 4 * tid + 2048 * i;
        const f32x4 a = *(const f32x4*)(row + l0), b = *(const f32x4*)(row + SL + l0);
        const int z0 = zp(l0);
        *(f32x4*)(Z + z0) = (f32x4){a.x, b.x, a.y, b.y}; *(f32x4*)(Z + z0 + 2) = (f32x4){a.z, b.z, a.w, b.w};
    }
    __syncthreads();
    fft8k_fwd(Z);
#pragma unroll
    for (int i = 0; i < 4; ++i) {
        const int k0 = 4 * tid + 2048 * i;
        f32x4 ur0, ui0, ur1, ui1;
#pragma unroll
        for (int e = 0; e < 4; ++e) {
            const int k = k0 + e;
            const int pk = p8k_of_f(k);
            const int pm = p8k_of_f((SL - k) & (SL - 1));
            const float2 zk = Z[zp(pk)], zm = Z[zp(pm)];
            ur0[e] = 0.5f * (zk.x + zm.x); ui0[e] = 0.5f * (zk.y - zm.y);
            ur1[e] = 0.5f * (zk.y + zm.y); ui1[e] = 0.5f * (zm.x - zk.x);
        }
        *(f32x4*)(UR + k0) = ur0; *(f32x4*)(UI + k0) = ui0; *(f32x4*)(UR + SL + k0) = ur1; *(f32x4*)(UI + SL + k0) = ui1;
    }
    __syncthreads();
}

__device__ __forceinline__ void phase_mix(const Params& p, int layer, char* lds) {
    const int tid = otid(), lane = tid & 63, wave = tid >> 6;
    const int l31 = lane & 31, hl = lane >> 5, g = wave & 3, tsel = wave >> 2;
    float* ex = (float*)lds;
    const float* UR = (const float*)(p.ws + R_UR); const float* UI = (const float*)(p.ws + R_UI);
    const float* Y = (const float*)(p.ws + R_Y);
    const bf16_t* att = (const bf16_t*)(p.ws + R_ATT);
    bf16_t* mix = (bf16_t*)(p.ws + R_MIX);
    const float* FMg = (const float*)(p.ws + OFF_FM) + ((size_t)layer * 4 + g) * 128 * 64;
    const float* fb = p.in[I_FB] + layer * 256 + g * 64;
    const float* mg = p.in[I_MG] + layer * 1024;
    for (int tp = obid(); tp < T / 64; tp += NBLK) {
        const int t = (tp * 2 + tsel) * 32 + l31;
        f32x16 acc0 = zero16(), acc1 = zero16();
        {
            const float* ub = UR + (size_t)(g * 64 + hl) * T + t;
            const float* fa = FMg + hl * 64 + l31;
#pragma unroll 16
            for (int dd0 = 0; dd0 < 64; dd0 += 2) {
                const float bv = ub[(size_t)dd0 * T];
                const float a0 = fa[dd0 * 64], a1 = fa[dd0 * 64 + 32];
                acc0 = __builtin_amdgcn_mfma_f32_32x32x2f32(a0, bv, acc0, 0, 0, 0);
                acc1 = __builtin_amdgcn_mfma_f32_32x32x2f32(a1, bv, acc1, 0, 0, 0);
            }
            const float* ub2 = UI + (size_t)(g * 64 + hl) * T + t;
            const float* fa2 = FMg + (64 + hl) * 64 + l31;
#pragma unroll 16
            for (int dd0 = 0; dd0 < 64; dd0 += 2) {
                const float bv = ub2[(size_t)dd0 * T];
                const float a0 = fa2[dd0 * 64], a1 = fa2[dd0 * 64 + 32];
                acc0 = __builtin_amdgcn_mfma_f32_32x32x2f32(a0, bv, acc0, 0, 0, 0);
                acc1 = __builtin_amdgcn_mfma_f32_32x32x2f32(a1, bv, acc1, 0, 0, 0);
            }
        }
        float sf = 0.f;
#pragma unroll
        for (int i = 0; i < 4; ++i) {
            const f32x4 b0 = *(const f32x4*)(fb + 8 * i + 4 * hl), b1 = *(const f32x4*)(fb + 32 + 8 * i + 4 * hl);
            acc0[4 * i] += b0.x; acc0[4 * i + 1] += b0.y; acc0[4 * i + 2] += b0.z; acc0[4 * i + 3] += b0.w;
            acc1[4 * i] += b1.x; acc1[4 * i + 1] += b1.y; acc1[4 * i + 2] += b1.z; acc1[4 * i + 3] += b1.w;
        }
#pragma unroll
        for (int r = 0; r < 16; ++r) sf += acc0[r] * acc0[r] + acc1[r] * acc1[r];
        float sy = 0.f;
        const float* yb = Y + (size_t)(g * 64 + hl * 32) * T + t;
#pragma unroll 32
        for (int i = 0; i < 32; ++i) { const float y = yb[(size_t)i * T]; sy += y * y; }
        float sa = 0.f;
        const bf16_t* ab = att + (size_t)t * 512 + g * 128 + hl * 64;
#pragma unroll 4
        for (int q = 0; q < 8; ++q) {
            const u32x4 a = *(const u32x4*)(ab + 8 * q);
            const float x0 = bflo(a.x), x1 = bfhi(a.x), x2 = bflo(a.y), x3 = bfhi(a.y), x4 = bflo(a.z), x5 = bfhi(a.z), x6 = bflo(a.w), x7 = bfhi(a.w);
            sa += x0 * x0 + x1 * x1 + x2 * x2 + x3 * x3 + x4 * x4 + x5 * x5 + x6 * x6 + x7 * x7;
        }
        __syncthreads();
        ex[(0 * 8 + wave) * 64 + lane] = sa; ex[(1 * 8 + wave) * 64 + lane] = sy; ex[(2 * 8 + wave) * 64 + lane] = sf;
        __syncthreads();
        float ta = 0.f, ty = 0.f, tf = 0.f;
#pragma unroll
        for (int w = 0; w < 4; ++w)
#pragma unroll
            for (int hh = 0; hh < 2; ++hh) {
                const int o = (tsel * 4 + w) * 64 + hh * 32 + l31;
                ta += ex[0 * 512 + o]; ty += ex[1 * 512 + o]; tf += ex[2 * 512 + o];
            }
        const float ra = rsqrtf(ta * (1.0f / 512.0f) + EPS), ry = rsqrtf(ty * (1.0f / 256.0f) + EPS), rf = rsqrtf(tf * (1.0f / 256.0f) + EPS);
        bf16_t* mrow = mix + (size_t)t * 1024;
        {
            const float* gg = mg + g * 128 + hl * 64;
#pragma unroll 4
            for (int q = 0; q < 8; ++q) {
                const u32x4 a = *(const u32x4*)(ab + 8 * q);
                const f32x4 g0 = *(const f32x4*)(gg + 8 * q), g1 = *(const f32x4*)(gg + 8 * q + 4);
                u32x4 o;
                o.x = pk2(bflo(a.x) * ra * g0.x, bfhi(a.x) * ra * g0.y); o.y = pk2(bflo(a.y) * ra * g0.z, bfhi(a.y) * ra * g0.w);
                o.z = pk2(bflo(a.z) * ra * g1.x, bfhi(a.z) * ra * g1.y); o.w = pk2(bflo(a.w) * ra * g1.z, bfhi(a.w) * ra * g1.w);
                *(u32x4*)(mrow + g * 128 + hl * 64 + 8 * q) = o;
            }
        }
        {
            const float* gg = mg + 512 + g * 64 + hl * 32;
#pragma unroll 2
            for (int q = 0; q < 4; ++q) {
                float yv[8];
#pragma unroll
                for (int i = 0; i < 8; ++i) yv[i] = yb[(size_t)(8 * q + i) * T];
                const f32x4 g0 = *(const f32x4*)(gg + 8 * q), g1 = *(const f32x4*)(gg + 8 * q + 4);
                u32x4 o;
                o.x = pk2(yv[0] * ry * g0.x, yv[1] * ry * g0.y); o.y = pk2(yv[2] * ry * g0.z, yv[3] * ry * g0.w);
                o.z = pk2(yv[4] * ry * g1.x, yv[5] * ry * g1.y); o.w = pk2(yv[6] * ry * g1.z, yv[7] * ry * g1.w);
                *(u32x4*)(mrow + 512 + g * 64 + hl * 32 + 8 * q) = o;
            }
        }
        {
            const float* gg = mg + 768 + g * 64;
#pragma unroll
            for (int i = 0; i < 4; ++i) {
                const f32x4 g0 = *(const f32x4*)(gg + 8 * i + 4 * hl), g1 = *(const f32x4*)(gg + 32 + 8 * i + 4 * hl);
                u32x2 o0, o1;
                o0.x = pk2(acc0[4 * i] * rf * g0.x, acc0[4 * i + 1] * rf * g0.y); o0.y = pk2(acc0[4 * i + 2] * rf * g0.z, acc0[4 * i + 3] * rf * g0.w);
                o1.x = pk2(acc1[4 * i] * rf * g1.x, acc1[4 * i + 1] * rf * g1.y); o1.y = pk2(acc1[4 * i + 2] * rf * g1.z, acc1[4 * i + 3] * rf * g1.w);
                *(u32x2*)(mrow + 768 + g * 64 + 8 * i + 4 * hl) = o0;
                *(u32x2*)(mrow + 768 + g * 64 + 32 + 8 * i + 4 * hl) = o1;
            }
        }
    }
}

#define TK_INS(L, X) do { float x_ = (X); _Pragma("unroll") for (int i_ = 0; i_ < 16; ++i_) { const float hi_ = fmaxf(L[i_], x_); x_ = fminf(L[i_], x_); L[i_] = hi_; } } while (0)
__device__ __forceinline__ float tk_pack(float v, unsigned code, unsigned mask) { return __builtin_bit_cast(float, (__builtin_bit_cast(unsigned, v) & ~mask) | code); }
__device__ __forceinline__ unsigned tk_lookup(const unsigned (&P)[4], unsigned i) {
    const unsigned w = (i < 4u) ? P[0] : (i < 8u) ? P[1] : (i < 12u) ? P[2] : P[3];
    return (w >> ((i & 3u) * 8u)) & 0x7Fu;
}
__device__ __forceinline__ void phase_peer_topk(const Params& p, int layer, char* lds, int* IDX, float* GATE) {
    const int tid = otid(), lane = tid & 63, wave = tid >> 6;
    const float* SC = (const float*)(p.ws + R_QP);
    const float NINF = -3.0e38f;
    const int pp = lane & 1;
    const int gw = obid() * NWAVE + wave, ngw = NBLK * NWAVE;
    for (int grp = gw; grp < T * 8 / 32; grp += ngw) {
        const int prob = grp * 32 + (lane >> 1);
        const int t = prob >> 3, h = prob & 7;
        const f32x4* src = (const f32x4*)(SC + (size_t)t * 2048 + h * 256 + pp * 128);
        float l[16];
#pragma unroll
        for (int i = 0; i < 16; ++i) l[i] = NINF;
#pragma unroll 1
        for (int c = 0; c < 4; ++c) {
            f32x4 v[8];
#pragma unroll
            for (int j = 0; j < 8; ++j) v[j] = src[c * 8 + j];
#pragma unroll
            for (int j = 0; j < 8; ++j) {
                const unsigned kb = (unsigned)(c * 32 + j * 4);
                TK_INS(l, tk_pack(v[j].x, kb, 0x7Fu)); TK_INS(l, tk_pack(v[j].y, kb + 1u, 0x7Fu));
                TK_INS(l, tk_pack(v[j].z, kb + 2u, 0x7Fu)); TK_INS(l, tk_pack(v[j].w, kb + 3u, 0x7Fu));
            }
        }
        float xv[16], ov[16]; unsigned PX[4] = {0u, 0u, 0u, 0u}, PO[4] = {0u, 0u, 0u, 0u};
#pragma unroll
        for (int i = 0; i < 16; ++i) {
            const float o = __shfl_xor(l[i], 1);
            const unsigned xb = __builtin_bit_cast(unsigned, l[i]), ob = __builtin_bit_cast(unsigned, o);
            xv[i] = __builtin_bit_cast(float, xb & ~0x7Fu); ov[i] = __builtin_bit_cast(float, ob & ~0x7Fu);
            PX[i >> 2] |= (xb & 0x7Fu) << ((i & 3) * 8); PO[i >> 2] |= (ob & 0x7Fu) << ((i & 3) * 8);
        }
        float f[16];
#pragma unroll
        for (int i = 0; i < 16; ++i) f[i] = NINF;
#pragma unroll
        for (int i = 0; i < 16; ++i)
#pragma unroll
            for (int j = i; j < 16; ++j)
                if ((i + 1) * (j + 1) <= 16) {
                    float cv = xv[i] + ov[j];
                    const unsigned code = pp ? (unsigned)((j << 4) | i) : (unsigned)((i << 4) | j);
                    cv = tk_pack(cv, code, 0xFFu);
                    if (i == j) cv = pp ? NINF : cv;
                    TK_INS(f, cv);
                }
        {
            float g[16];
#pragma unroll
            for (int i = 0; i < 16; ++i) g[i] = __shfl_xor(f[i], 1);
#pragma unroll
            for (int i = 0; i < 16; ++i) TK_INS(f, g[i]);
        }
        unsigned P0[4], P1[4];
#pragma unroll
        for (int q = 0; q < 4; ++q) { P0[q] = pp ? PO[q] : PX[q]; P1[q] = pp ? PX[q] : PO[q]; }
        const float top = __builtin_bit_cast(float, __builtin_bit_cast(unsigned, f[0]) & ~0xFFu);
        float ev[16]; int ei[16]; float den = 0.f;
#pragma unroll
        for (int r = 0; r < 16; ++r) {
            const unsigned fb = __builtin_bit_cast(unsigned, f[r]);
            const unsigned code = fb & 0xFFu;
            ei[r] = (int)(tk_lookup(P0, code >> 4) * 128u + tk_lookup(P1, code & 15u));
            ev[r] = __expf(__builtin_bit_cast(float, fb & ~0xFFu) - top);
            den += ev[r];
        }
        const float rden = 1.0f / den;
        const size_t ob = (size_t)t * 2048 + h * 16;
        if (pp == 0) {
#pragma unroll
            for (int q = 0; q < 4; ++q) { int4 w; w.x = ei[4 * q]; w.y = ei[4 * q + 1]; w.z = ei[4 * q + 2]; w.w = ei[4 * q + 3]; *(int4*)(IDX + ob + 4 * q) = w; }
        } else {
#pragma unroll
            for (int q = 0; q < 4; ++q) { f32x4 w; w.x = ev[4 * q] * rden; w.y = ev[4 * q + 1] * rden; w.z = ev[4 * q + 2] * rden; w.w = ev[4 * q + 3] * rden; *(f32x4*)(GATE + ob + 128 + 4 * q) = w; }
        }
    }
}

__device__ __forceinline__ float gelu_exact(float x) { return 0.5f * x * (1.0f + erff(x * 0.70710678118654752f)); }
typedef float f32x2 __attribute__((ext_vector_type(2)));
#define CVT_LO(W) __builtin_amdgcn_cvt_pk_f32_fp8((int)(W), false)
#define CVT_HI(W) __builtin_amdgcn_cvt_pk_f32_fp8((int)(W), true)
template <bool DRY, int EMASK = 16383> __device__ __forceinline__ void phase_peer_gather(const Params& p, int layer) {
    const int lane = otid() & 63, wave = otid() >> 6;
    const int gw = obid() * NWAVE + wave, ngw = NBLK * NWAVE;
    const unsigned char* PU = p.ws + OFF_PU + (size_t)layer * 16384 * 1024;
    const unsigned char* PV = p.ws + OFF_PV + (size_t)layer * 16384 * 1024;
    const float* SU = (const float*)(p.ws + OFF_PSC) + (size_t)layer * 16384;
    const float* SV = (const float*)(p.ws + OFF_PSC) + (size_t)(2 + layer) * 16384;
    bf16_t* XN = (bf16_t*)(p.ws + R_XN);
    float* XA = (float*)(p.ws + OFF_XA);
    const float* SC = (const float*)(p.ws + R_QP);
    const bool last = (layer == NLAYER - 1);
    const float* gnext = last ? p.in[I_FG] : p.in[I_N1G] + (layer + 1) * DM;
    const bool b5 = (lane & 32) != 0, b4 = (lane & 16) != 0, b3 = (lane & 8) != 0;
    const unsigned loff = (unsigned)lane * 16u;
    for (int t = gw; t < T; t += ngw) {
        f32x2 xv[8];
#pragma unroll
        for (int j = 0; j < 4; ++j) {
            const u32x2 a = *(const u32x2*)(XN + (size_t)t * DM + 4 * lane + 256 * j);
            xv[2 * j] = (f32x2){bflo(a.x), bfhi(a.x)}; xv[2 * j + 1] = (f32x2){bflo(a.y), bfhi(a.y)};
        }
        f32x2 acc[8];
#pragma unroll
        for (int j = 0; j < 8; ++j) acc[j] = (f32x2){0.f, 0.f};
        const int* idxp = (const int*)(SC + (size_t)t * 2048);
        const float* gatep = SC + (size_t)t * 2048 + 128;
#pragma unroll 1
        for (int half = 0; half < 2; ++half) {
            const int myi = idxp[half * 64 + lane] & EMASK;
            const float mycu = SU[myi];
            const float mycg = gatep[half * 64 + lane] * SV[myi];
#pragma unroll 1
            for (int e0 = 0; e0 < 64; e0 += 8) {
                u32x4 ur[8], vr[8];
#pragma unroll
                for (int k = 0; k < 8; ++k) {
                    const unsigned e = (unsigned)__builtin_amdgcn_readlane(myi, e0 + k);
                    ur[k] = *(const u32x4*)(PU + (size_t)(e * 1024u) + loff);
                    vr[k] = *(const u32x4*)(PV + (size_t)(e * 1024u) + loff);
                }
                float d[8];
#pragma unroll
                for (int k = 0; k < 8; ++k) {
                    f32x2 s2 = CVT_LO(ur[k].x) * xv[0];
                    s2 += CVT_HI(ur[k].x) * xv[1]; s2 += CVT_LO(ur[k].y) * xv[2]; s2 += CVT_HI(ur[k].y) * xv[3];
                    s2 += CVT_LO(ur[k].z) * xv[4]; s2 += CVT_HI(ur[k].z) * xv[5]; s2 += CVT_LO(ur[k].w) * xv[6]; s2 += CVT_HI(ur[k].w) * xv[7];
                    d[k] = s2.x + s2.y;
                }
                float r4[4], r2[2], u1;
#pragma unroll
                for (int k = 0; k < 4; ++k) { const float send = b5 ? d[k] : d[k + 4], keep = b5 ? d[k + 4] : d[k]; r4[k] = keep + __shfl_xor(send, 32); }
#pragma unroll
                for (int k = 0; k < 2; ++k) { const float send = b4 ? r4[k] : r4[k + 2], keep = b4 ? r4[k + 2] : r4[k]; r2[k] = keep + __shfl_xor(send, 16); }
                { const float send = b3 ? r2[0] : r2[1], keep = b3 ? r2[1] : r2[0]; u1 = keep + __shfl_xor(send, 8); }
                u1 += __shfl_xor(u1, 4); u1 += __shfl_xor(u1, 2); u1 += __shfl_xor(u1, 1);
                const int kk = e0 + (lane >> 3);
                const float av = gelu_exact(u1 * __shfl(mycu, kk)) * __shfl(mycg, kk);
#pragma unroll
                for (int k = 0; k < 8; ++k) {
                    const float a = __builtin_bit_cast(float, __builtin_amdgcn_readlane(__builtin_bit_cast(int, av), 8 * k));
                    const f32x2 a2 = (f32x2){a, a};
                    acc[0] += a2 * CVT_LO(vr[k].x); acc[1] += a2 * CVT_HI(vr[k].x); acc[2] += a2 * CVT_LO(vr[k].y); acc[3] += a2 * CVT_HI(vr[k].y);
                    acc[4] += a2 * CVT_LO(vr[k].z); acc[5] += a2 * CVT_HI(vr[k].z); acc[6] += a2 * CVT_LO(vr[k].w); acc[7] += a2 * CVT_HI(vr[k].w);
                }
            }
        }
        f32x4 x[4]; float ss = 0.f;
#pragma unroll
        for (int j = 0; j < 4; ++j) {
            x[j] = *(const f32x4*)(XA + (size_t)t * DM + 4 * lane + 256 * j);
            x[j].x += acc[2 * j].x; x[j].y += acc[2 * j].y; x[j].z += acc[2 * j + 1].x; x[j].w += acc[2 * j + 1].y;
            ss += x[j].x * x[j].x + x[j].y * x[j].y + x[j].z * x[j].z + x[j].w * x[j].w;
        }
        ss = wave_sum(ss);
        const float r = rsqrtf(ss * (1.0f / DM) + EPS);
        if (last) {
#pragma unroll
            for (int j = 0; j < 4; ++j) { const f32x4 gg = *(const f32x4*)(gnext + 4 * lane + 256 * j); *(f32x4*)(p.out + (size_t)t * DM + 4 * lane + 256 * j) = x[j] * r * gg; }
        } else {
#pragma unroll
            for (int j = 0; j < 4; ++j) {
                const f32x4 gg = *(const f32x4*)(gnext + 4 * lane + 256 * j);
                *(f32x4*)((DRY ? p.out : XA) + (size_t)t * DM + 4 * lane + 256 * j) = x[j];
                u32x2 w; w.x = pk2(x[j].x * r * gg.x, x[j].y * r * gg.y); w.y = pk2(x[j].z * r * gg.z, x[j].w * r * gg.w);
                if (!DRY) *(u32x2*)(XN + (size_t)t * DM + 4 * lane + 256 * j) = w;
            }
        }
    }
}


template <int CTRL> __device__ __forceinline__ float dpp_f(float v) { return __builtin_bit_cast(float, __builtin_amdgcn_update_dpp(0, __builtin_bit_cast(int, v), CTRL, 0xF, 0xF, false)); }
#ifndef PE_NTK
#define PE_NTK 2
#endif
#ifndef PE_PASS_SYNC
#define PE_PASS_SYNC 0
#endif
constexpr int PE_ENT = 12 * 1024;
#ifndef PE_LOGR
#define PE_LOGR 4
#endif
constexpr int PE_NR = 1 << PE_LOGR, PE_STS = 40;
constexpr int PE_WAVE = PE_ENT + 8 * PE_STS * 4;
#define PE_TOKEN_CHUNK(TK) do { \
    const int s_ = st[(sr * PE_NTK + (TK)) * PE_STS + r], e_ = st[(sr * PE_NTK + (TK)) * PE_STS + r + 1]; \
    for (int pos = s_; pos < e_; pos += 8) { \
        const int n = (e_ - pos < 8) ? (e_ - pos) : 8; \
        const int ei_ = pos + eid; \
        const bool ok_ = eid < n; \
        const int base_ = ((sr * PE_NTK + (TK)) * 128 + (ok_ ? ei_ : pos)) * 3; \
        const int ev = ent[base_]; const float cu = __builtin_bit_cast(float, ent[base_ + 1]), cg = __builtin_bit_cast(float, ent[base_ + 2]); \
        f32x2 xl[8]; \
        _Pragma("unroll") for (int j = 0; j < 4; ++j) { xl[2 * j] = (f32x2){bflo(xp[TK][j].x), bfhi(xp[TK][j].x)}; xl[2 * j + 1] = (f32x2){bflo(xp[TK][j].y), bfhi(xp[TK][j].y)}; } \
        u32x4 ur[8], vr[8]; \
        _Pragma("unroll") for (int k = 0; k < 8; ++k) { \
            if (k < n) { const unsigned e = (unsigned)__builtin_amdgcn_readlane(ev, ((k & 4) << 1) | ((k & 2) << 3) | ((k & 1) << 5)); \
                ur[k] = *(const u32x4*)(PU + (size_t)(e * 1024u) + loff); vr[k] = *(const u32x4*)(PV + (size_t)(e * 1024u) + loff); } \
            else { ur[k] = (u32x4){0u, 0u, 0u, 0u}; vr[k] = (u32x4){0u, 0u, 0u, 0u}; } } \
        float d[8]; \
        _Pragma("unroll") for (int k = 0; k < 8; ++k) { \
            if (k < n) { f32x2 s2 = CVT_LO(ur[k].x) * xl[0]; \
                s2 += CVT_HI(ur[k].x) * xl[1]; s2 += CVT_LO(ur[k].y) * xl[2]; s2 += CVT_HI(ur[k].y) * xl[3]; \
                s2 += CVT_LO(ur[k].z) * xl[4]; s2 += CVT_HI(ur[k].z) * xl[5]; s2 += CVT_LO(ur[k].w) * xl[6]; s2 += CVT_HI(ur[k].w) * xl[7]; \
                d[k] = s2.x + s2.y; } else d[k] = 0.f; } \
        _Pragma("unroll") for (int k = 0; k < 8; ++k) { d[k] += dpp_f<0xB1>(d[k]); d[k] += dpp_f<0x4E>(d[k]); d[k] += dpp_f<0x141>(d[k]); }     \
        float r4[4], r2[2], u1; \
        _Pragma("unroll") for (int k = 0; k < 4; ++k) { const float send = b3 ? d[k] : d[k + 4], keep = b3 ? d[k + 4] : d[k]; r4[k] = keep + dpp_f<0x140>(send); } \
        _Pragma("unroll") for (int k = 0; k < 2; ++k) { const float send = b4 ? r4[k] : r4[k + 2], keep = b4 ? r4[k + 2] : r4[k]; r2[k] = keep + __shfl_xor(send, 16); } \
        { const float send = b5 ? r2[0] : r2[1], keep = b5 ? r2[1] : r2[0]; u1 = keep + __shfl_xor(send, 32); }     \
        const float av = ok_ ? gelu_exact(u1 * cu) * cg : 0.f; \
        _Pragma("unroll") for (int k = 0; k < 8; ++k) { \
            if (k < n) { const float a = __builtin_bit_cast(float, __builtin_amdgcn_readlane(__builtin_bit_cast(int, av), ((k & 4) << 1) | ((k & 2) << 3) | ((k & 1) << 5))); \
                const f32x2 a2 = (f32x2){a, a}; \
                acc[TK][0] += a2 * CVT_LO(vr[k].x); acc[TK][1] += a2 * CVT_HI(vr[k].x); acc[TK][2] += a2 * CVT_LO(vr[k].y); acc[TK][3] += a2 * CVT_HI(vr[k].y); \
                acc[TK][4] += a2 * CVT_LO(vr[k].z); acc[TK][5] += a2 * CVT_HI(vr[k].z); acc[TK][6] += a2 * CVT_LO(vr[k].w); acc[TK][7] += a2 * CVT_HI(vr[k].w); } } \
    } } while (0)

template <bool DRY> __device__ __forceinline__ void phase_peer_fused(const Params& p, int layer, char* lds) {
    const int tid = otid(), lane = tid & 63, wave = tid >> 6;
    const unsigned char* PU = p.ws + OFF_PU + (size_t)layer * 16384 * 1024;
    const unsigned char* PV = p.ws + OFF_PV + (size_t)layer * 16384 * 1024;
    const float* SU = (const float*)(p.ws + OFF_PSC) + (size_t)layer * 16384;
    const float* SV = (const float*)(p.ws + OFF_PSC) + (size_t)(2 + layer) * 16384;
    bf16_t* XN = (bf16_t*)(p.ws + R_XN);
    float* XA = (float*)(p.ws + OFF_XA);
    const float* SC = (const float*)(p.ws + R_QP);
    const bool last = (layer == NLAYER - 1);
    const float* gnext = last ? p.in[I_FG] : p.in[I_N1G] + (layer + 1) * DM;
    const float* g2p = p.in[I_N2G] + layer * DM;
    const bool b5 = (lane & 32) != 0, b4 = (lane & 16) != 0, b3 = (lane & 8) != 0;
    const int eid = ((lane >> 3) & 1) * 4 + ((lane >> 4) & 1) * 2 + (lane >> 5);
    const unsigned loff = (unsigned)lane * 16u;
    int* ent = (int*)(lds + wave * PE_WAVE);
    int* st = (int*)(lds + wave * PE_WAVE + PE_ENT);
    const float NINF = -3.0e38f;
    const int pp = lane & 1;
    for (int tb = (obid() * NWAVE + wave) * 8; tb < T; tb += NBLK * NWAVE * 8) {
#pragma unroll 1
        for (int grp = 0; grp < 2; ++grp) {
            const int tkl = grp * 4 + (lane >> 4), h = (lane >> 1) & 7;
            const f32x4* src = (const f32x4*)(SC + (size_t)(tb + tkl) * 2048 + h * 256 + pp * 128);
            float l[16];
#pragma unroll
            for (int i = 0; i < 16; ++i) l[i] = NINF;
#pragma unroll 1
            for (int c = 0; c < 4; ++c) {
                f32x4 v[8];
#pragma unroll
                for (int j = 0; j < 8; ++j) v[j] = src[c * 8 + j];
#pragma unroll
                for (int j = 0; j < 8; ++j) {
                    const unsigned kb = (unsigned)(c * 32 + j * 4);
                    TK_INS(l, tk_pack(v[j].x, kb, 0x7Fu)); TK_INS(l, tk_pack(v[j].y, kb + 1u, 0x7Fu));
                    TK_INS(l, tk_pack(v[j].z, kb + 2u, 0x7Fu)); TK_INS(l, tk_pack(v[j].w, kb + 3u, 0x7Fu));
                }
            }
            float xw[16], ow[16]; unsigned PX[4] = {0u, 0u, 0u, 0u}, PO[4] = {0u, 0u, 0u, 0u};
#pragma unroll
            for (int i = 0; i < 16; ++i) {
                const float o = __shfl_xor(l[i], 1);
                const unsigned xb = __builtin_bit_cast(unsigned, l[i]), ob = __builtin_bit_cast(unsigned, o);
                xw[i] = __builtin_bit_cast(float, xb & ~0x7Fu); ow[i] = __builtin_bit_cast(float, ob & ~0x7Fu);
                PX[i >> 2] |= (xb & 0x7Fu) << ((i & 3) * 8); PO[i >> 2] |= (ob & 0x7Fu) << ((i & 3) * 8);
            }
            float f[16];
#pragma unroll
            for (int i = 0; i < 16; ++i) f[i] = NINF;
#pragma unroll
            for (int i = 0; i < 16; ++i)
#pragma unroll
                for (int j = i; j < 16; ++j)
                    if ((i + 1) * (j + 1) <= 16) {
                        float cv = xw[i] + ow[j];
                        const unsigned code = pp ? (unsigned)((j << 4) | i) : (unsigned)((i << 4) | j);
                        cv = tk_pack(cv, code, 0xFFu);
                        if (i == j) cv = pp ? NINF : cv;
                        TK_INS(f, cv);
                    }
            {
                float gq[16];
#pragma unroll
                for (int i = 0; i < 16; ++i) gq[i] = __shfl_xor(f[i], 1);
#pragma unroll
                for (int i = 0; i < 16; ++i) TK_INS(f, gq[i]);
            }
            unsigned P0[4], P1[4];
#pragma unroll
            for (int q = 0; q < 4; ++q) { P0[q] = pp ? PO[q] : PX[q]; P1[q] = pp ? PX[q] : PO[q]; }
            const float top = __builtin_bit_cast(float, __builtin_bit_cast(unsigned, f[0]) & ~0xFFu);
            float ev[16]; float den = 0.f;
#pragma unroll
            for (int r = 0; r < 16; ++r) { ev[r] = __expf(__builtin_bit_cast(float, __builtin_bit_cast(unsigned, f[r]) & ~0xFFu) - top); den += ev[r]; }
            const float rden = 1.0f / den;
#pragma unroll
            for (int r8 = 0; r8 < 8; ++r8) {
                const unsigned c0 = __builtin_bit_cast(unsigned, f[r8]) & 0xFFu, c1 = __builtin_bit_cast(unsigned, f[r8 + 8]) & 0xFFu;
                const unsigned code = pp ? c1 : c0;
                const float gate = (pp ? ev[r8 + 8] : ev[r8]) * rden;
                const int e = (int)(tk_lookup(P0, code >> 4) * 128u + tk_lookup(P1, code & 15u));
                const int o = (tkl * 128 + h * 16 + pp * 8 + r8) * 3;
                ent[o] = e; ent[o + 1] = __builtin_bit_cast(int, SU[e]); ent[o + 2] = __builtin_bit_cast(int, gate * SV[e]);
            }
        }
#pragma unroll 1
        for (int tk = 0; tk < 8; ++tk) {
            int* et = ent + tk * 384;
            const int eA = et[lane * 3], uA = et[lane * 3 + 1], gA = et[lane * 3 + 2];
            const int eB = et[(64 + lane) * 3], uB = et[(64 + lane) * 3 + 1], gB = et[(64 + lane) * 3 + 2];
            const int rA = eA >> (14 - PE_LOGR), rB = eB >> (14 - PE_LOGR);
            int base = 0;
#pragma unroll 1
            for (int r = 0; r < PE_NR; ++r) {
                const unsigned long long mA = __ballot(rA == r), mB = __ballot(rB == r);
                const int cA = __popcll(mA);
                if (lane == 0) st[tk * PE_STS + r] = base;
                if (rA == r) { const int q = base + (int)__builtin_amdgcn_mbcnt_hi((unsigned)(mA >> 32), __builtin_amdgcn_mbcnt_lo((unsigned)mA, 0u)); et[q * 3] = eA; et[q * 3 + 1] = uA; et[q * 3 + 2] = gA; }
                if (rB == r) { const int q = base + cA + (int)__builtin_amdgcn_mbcnt_hi((unsigned)(mB >> 32), __builtin_amdgcn_mbcnt_lo((unsigned)mB, 0u)); et[q * 3] = eB; et[q * 3 + 1] = uB; et[q * 3 + 2] = gB; }
                base += cA + __popcll(mB);
            }
            if (lane == 0) st[tk * PE_STS + PE_NR] = base;
        }
#pragma unroll 1
        for (int sr = 0; sr < 8 / PE_NTK; ++sr) {
            u32x2 xp[PE_NTK][4]; f32x2 acc[PE_NTK][8];
#pragma unroll
            for (int tk = 0; tk < PE_NTK; ++tk) {
                f32x4 xr[4]; float ss = 0.f;
#pragma unroll
                for (int j = 0; j < 4; ++j) { xr[j] = *(const f32x4*)(XA + (size_t)(tb + sr * PE_NTK + tk) * DM + 4 * lane + 256 * j); ss += xr[j].x * xr[j].x + xr[j].y * xr[j].y + xr[j].z * xr[j].z + xr[j].w * xr[j].w; }
                ss = wave_sum(ss);
                const float rn = rsqrtf(ss * (1.0f / DM) + EPS);
#pragma unroll
                for (int j = 0; j < 4; ++j) { const f32x4 gg = *(const f32x4*)(g2p + 4 * lane + 256 * j);
                    xp[tk][j].x = pk2(xr[j].x * rn * gg.x, xr[j].y * rn * gg.y); xp[tk][j].y = pk2(xr[j].z * rn * gg.z, xr[j].w * rn * gg.w); }
#pragma unroll
                for (int j = 0; j < 8; ++j) acc[tk][j] = (f32x2){0.f, 0.f};
            }
#pragma unroll 1
            for (int r = 0; r < PE_NR; ++r) {
#if PE_PASS_SYNC
                __syncthreads();
#endif
                PE_TOKEN_CHUNK(0); PE_TOKEN_CHUNK(1);
#if PE_NTK == 4
                PE_TOKEN_CHUNK(2); PE_TOKEN_CHUNK(3);
#endif
            }
#pragma unroll
            for (int tk = 0; tk < PE_NTK; ++tk) {
                const int t = tb + sr * PE_NTK + tk;
                f32x4 x[4]; float ss = 0.f;
#pragma unroll
                for (int j = 0; j < 4; ++j) {
                    x[j] = *(const f32x4*)(XA + (size_t)t * DM + 4 * lane + 256 * j);
                    x[j].x += acc[tk][2 * j].x; x[j].y += acc[tk][2 * j].y; x[j].z += acc[tk][2 * j + 1].x; x[j].w += acc[tk][2 * j + 1].y;
                    ss += x[j].x * x[j].x + x[j].y * x[j].y + x[j].z * x[j].z + x[j].w * x[j].w;
                }
                ss = wave_sum(ss);
                const float rr = rsqrtf(ss * (1.0f / DM) + EPS);
                if (last) {
#pragma unroll
                    for (int j = 0; j < 4; ++j) { const f32x4 gg = *(const f32x4*)(gnext + 4 * lane + 256 * j); *(f32x4*)(p.out + (size_t)t * DM + 4 * lane + 256 * j) = x[j] * rr * gg; }
                } else {
#pragma unroll
                    for (int j = 0; j < 4; ++j) {
                        const f32x4 gg = *(const f32x4*)(gnext + 4 * lane + 256 * j);
                        *(f32x4*)((DRY ? p.out : XA) + (size_t)t * DM + 4 * lane + 256 * j) = x[j];
                        u32x2 w; w.x = pk2(x[j].x * rr * gg.x, x[j].y * rr * gg.y); w.y = pk2(x[j].z * rr * gg.z, x[j].w * rr * gg.w);
                        if (!DRY) *(u32x2*)(XN + (size_t)t * DM + 4 * lane + 256 * j) = w;
                    }
                }
            }
        }
    }
}

#define LAS __attribute__((address_space(3)))
#define XB_TMO      128
#define XB_XCNT(j)  (256  + 64 * (j))
#define XB_XSUB(j)  (1280 + 64 * (j))
#define XB_XGEN(j)  (2304 + 64 * (j))
#define XB_TOP      3328
#define XB_TOPGEN   3392
#define XCD_BAR_WORDS 3456
#define XB_SPIN_CAP (1u << 20)
__device__ __forceinline__ unsigned xb_ld(unsigned* p)              { return __hip_atomic_load(p, __ATOMIC_RELAXED, __HIP_MEMORY_SCOPE_AGENT); }
__device__ __forceinline__ unsigned xb_add(unsigned* p, unsigned v) { return __hip_atomic_fetch_add(p, v, __ATOMIC_RELAXED, __HIP_MEMORY_SCOPE_AGENT); }
__device__ __forceinline__ unsigned xb_xcc_id() { return (unsigned)__builtin_amdgcn_s_getreg((3 << 11) | 20) & 0xFu; }
#define XB_SPIN(cond, bar) do { unsigned _sp = 0; while (cond) { __builtin_amdgcn_s_sleep(1); \
    if ((++_sp & 255u) == 0u) { if (xb_ld(&(bar)[XB_TMO])) break; if (_sp > XB_SPIN_CAP) { atomicAdd(&(bar)[XB_TMO], 1u); break; } } } } while (0)
struct XcdBarrier { unsigned* bar; unsigned x; volatile LAS unsigned* st; };
__device__ __forceinline__ XcdBarrier xcd_barrier_post(unsigned* bar, volatile LAS unsigned* st) {
    XcdBarrier b; b.bar = bar; b.x = xb_xcc_id(); b.st = st;
    if (threadIdx.x == 0) (void)xb_add(&bar[XB_XCNT(b.x)], 1u);
    return b;
}
__device__ __forceinline__ void xcd_barrier_complete(unsigned* bar, unsigned x, unsigned& nloc, unsigned& nx) {
    const unsigned G = NBLK;
    unsigned sum, cnt, mine, sp = 0u;
    for (;;) {
        sum = 0u; cnt = 0u; mine = 0u;
#pragma unroll
        for (unsigned j = 0; j < 16; ++j) { const unsigned c = xb_ld(&bar[XB_XCNT(j)]); sum += c; cnt += (c > 0u) ? 1u : 0u; mine = (j == x) ? c : mine; }
        if (sum == G) break;
        __builtin_amdgcn_s_sleep(1);
        if ((++sp & 255u) == 0u) { if (xb_ld(&bar[XB_TMO])) break; if (sp > XB_SPIN_CAP) { atomicAdd(&bar[XB_TMO], 1u); break; } }
    }
    nloc = mine > 0u ? mine : 1u; nx = cnt > 0u ? cnt : 1u;
}
__device__ __forceinline__ void xcd_barrier(const XcdBarrier& b) {
    asm volatile("s_waitcnt vmcnt(0)" ::: "memory");
    __syncthreads();
    if (threadIdx.x == 0) {
        unsigned* bar = b.bar;
        __builtin_amdgcn_s_waitcnt(0);
        unsigned nloc = b.st[0], nx = b.st[1];
        if (nloc == 0u) { xcd_barrier_complete(bar, b.x, nloc, nx); b.st[0] = nloc; b.st[1] = nx; }
        const unsigned old = xb_add(&bar[XB_XSUB(b.x)], 1u);
        const unsigned gen = old / nloc;
        if (old + 1u == (gen + 1u) * nloc) {
            __builtin_amdgcn_fence(__ATOMIC_RELEASE, "agent");
            asm volatile("s_waitcnt vmcnt(0)" ::: "memory");
            const unsigned og = xb_add(&bar[XB_TOP], 1u);
            const unsigned tg = og / nx;
            if (og + 1u == (tg + 1u) * nx) xb_add(&bar[XB_TOPGEN], 1u);
            else XB_SPIN(xb_ld(&bar[XB_TOPGEN]) == tg, bar);
            __builtin_amdgcn_fence(__ATOMIC_ACQUIRE, "agent");
            xb_add(&bar[XB_XGEN(b.x)], 1u);
            asm volatile("s_waitcnt vmcnt(0)" ::: "memory");
        } else {
            XB_SPIN(xb_ld(&bar[XB_XGEN(b.x)]) == gen, bar);
            __builtin_amdgcn_fence(__ATOMIC_ACQUIRE, "agent");
            asm volatile("s_waitcnt vmcnt(0)" ::: "memory");
        }
    }
    __syncthreads();
}


template <class Epi> __device__ __forceinline__ void big_gemm(const bf16_t* A, const bf16_t* Bt, int M, int N, int K, char* lds, const Epi& e) {
    pg8::Gemm g{A, Bt, M, N, K}; pg8::StaticOrder S; S.init(M, N, NBLK, obid());
    pg8::gemm_phase<Epi, pg8::StaticOrder, true, true>((PG8_LAS unsigned char*)lds, g, S, e);
}

#define GSYNC() xcd_barrier(xbar)
template <int layer> __device__ __forceinline__ void run_layer(const Params& p, char* lds, const XcdBarrier& xbar) {
    float* XA = (float*)(p.ws + OFF_XA);

        const float* xin = layer == 0 ? p.in[I_X] : XA;
#if PROBE == 10
        { EpiIn e{(bf16_t*)(p.ws + R_QKV), (float*)(p.ws + R_HF)};
          gemm_simple((const bf16_t*)(p.ws + R_XN), (const bf16_t*)(p.ws + OFF_WTIN) + (size_t)layer * INC * DM, T, INC, DM, lds, e); } GSYNC();
#endif
        {
            const bf16_t* wt = (const bf16_t*)(p.ws + OFF_WTIN) + (size_t)layer * INC * DM;
            pg8::EpiStoreBf16 e1{(bf16_t*)(p.ws + R_QKV), 768};
            big_gemm((const bf16_t*)(p.ws + R_XN), wt, T, 768, DM, lds, e1);
            pg8::EpiStoreF32 e2{nullptr, (float*)(p.ws + R_HF), T};
            big_gemm(wt + (size_t)768 * DM, (const bf16_t*)(p.ws + R_XN), 1024, T, DM, lds, e2);
        }
        if (layer == 0) {
#pragma nounroll
            for (int fl = 0; fl < NLAYER; ++fl) {
                EpiF32 e{(float*)(p.ws + (fl ? OFF_HFILT1 : OFF_HFILT0)), SL};
                gemm_simple((const bf16_t*)(p.ws + OFF_W3T) + (size_t)fl * 1024 * 64, (const bf16_t*)(p.ws + OFF_H2) + (size_t)fl * SL * 64, 1024, SL, 64, lds, e);
            }
        }
        GSYNC();
        if (layer == 0) {
            phase_filter_spectra(p, lds);
#if PROBE == 13
            phase_filter_spectra(p, lds);
#endif
        }
#if PROBE == 12
        phase_qkprep(p, layer, lds, (bf16_t*)(p.ws + R_ATT)); GSYNC();
#endif
        phase_qkprep(p, layer, lds, (bf16_t*)(p.ws + R_QKV)); GSYNC();
        {
#if PROBE == 5
            phase_attn(p, lds);
#endif
#if PROBE == 6
            for (int c = obid(); c < 256; c += NBLK) hyena_job(p, layer, c, lds);
            for (int c = obid(); c < 256; c += NBLK) fnet_job(p, c, lds);
#endif
            phase_attn(p, lds);
            for (int c = obid(); c < 256; c += NBLK) hyena_job(p, layer, c, lds);
            for (int c = obid(); c < 256; c += NBLK) fnet_job(p, c, lds);
        } GSYNC();
#if PROBE == 8
        phase_mix(p, layer, lds); GSYNC();
#endif
        phase_mix(p, layer, lds); GSYNC();
#if PROBE == 11
        { EpiRes e{xin, p.out};
          gemm_simple((const bf16_t*)(p.ws + R_MIX), (const bf16_t*)(p.ws + OFF_WTOUT) + (size_t)layer * DM * DM, T, DM, DM, lds, e); } GSYNC();
#endif
        { pg8::EpiOutProj e{xin, XA, (bf16_t*)(p.ws + R_XN), (float*)(p.ws + OFF_RS)};
          big_gemm((const bf16_t*)(p.ws + R_MIX), (const bf16_t*)(p.ws + OFF_WTOUT) + (size_t)layer * DM * DM, T, DM, DM, lds, e); } GSYNC();
#if PROBE == 3
        { EpiF32 e{(float*)(p.ws + R_QP), 2048};
          gemm_simple((const bf16_t*)(p.ws + R_XN), (const bf16_t*)(p.ws + OFF_WTQ) + (size_t)layer * 2048 * DM, T, 2048, DM, lds, e); } GSYNC();
#endif
        { pg8::EpiRowScaleF32 e{(float*)(p.ws + R_QP), 2048, (const float*)(p.ws + OFF_RS)};
          big_gemm((const bf16_t*)(p.ws + R_XN), (const bf16_t*)(p.ws + OFF_WTQ) + (size_t)layer * 2048 * DM, T, 2048, DM, lds, e); } GSYNC();
#if PEER_FUSED
#if PROBE == 1
        phase_peer_fused<true>(p, layer, lds); GSYNC();
#endif
        phase_peer_fused<false>(p, layer, lds);
#else
        phase_peer_topk(p, layer, lds, (int*)(p.ws + R_QP), (float*)(p.ws + R_QP)); GSYNC();
#if PROBE == 1
        phase_peer_gather<true>(p, layer); GSYNC();
#endif
#if PROBE == 15
        phase_peer_gather<true, 1023>(p, layer); GSYNC();
#endif
        phase_peer_gather<false>(p, layer);
#endif
        if (layer + 1 < NLAYER) GSYNC();
}

__global__ void __launch_bounds__(NTHR) mega_kernel(Params p) {
    extern __shared__ __attribute__((aligned(16))) char lds[];
    volatile LAS unsigned* misc = (volatile LAS unsigned*)((LAS char*)lds + LDS_MISC);
    if (threadIdx.x < 16) misc[threadIdx.x] = 0u;
    __syncthreads();
    const XcdBarrier xbar = xcd_barrier_post((unsigned*)(p.ws + OFF_CTL) + 4096, misc);
    float* XA = (float*)(p.ws + OFF_XA);
#if PROBE == 7
    phase_p0(p, lds); GSYNC();
#endif
#if PROBE == 14
#pragma nounroll
    for (int i = 0; i < 40; ++i) GSYNC();
#endif
    phase_p0(p, lds);
    phase_rmsnorm_bf16(p.in[I_X], p.in[I_N1G], (bf16_t*)(p.ws + R_XN));
    GSYNC();
    run_layer<0>(p, lds, xbar);
    run_layer<1>(p, lds, xbar);
}

extern "C" void kernel_launch(void* const* d_in, const int* in_sizes, int n_in, void* d_out, int out_size, void* d_ws, size_t ws_size, hipStream_t stream) {
    static int grid = 0;
    if (grid == 0) {
        if (n_in != 25 || out_size != T * DM || ws_size < WS_NEED) { fprintf(stderr, "kernel_launch: unexpected sizes n_in %d out %d ws %zu (need %zu)\n", n_in, out_size, ws_size, (size_t)WS_NEED); grid = -1; return; }
        int dev = 0, cus = 0, per_cu = 0;
        if (hipGetDevice(&dev) != hipSuccess || hipDeviceGetAttribute(&cus, hipDeviceAttributeMultiprocessorCount, dev) != hipSuccess) { grid = -1; return; }
        if (hipFuncSetAttribute((const void*)mega_kernel, hipFuncAttributeMaxDynamicSharedMemorySize, LDS_BYTES) != hipSuccess) { fprintf(stderr, "kernel_launch: hipFuncSetAttribute failed\n"); grid = -1; return; }
        if (hipOccupancyMaxActiveBlocksPerMultiprocessor(&per_cu, (const void*)mega_kernel, NTHR, LDS_BYTES) != hipSuccess || per_cu < 1) { fprintf(stderr, "kernel_launch: occupancy query says %d blocks per CU\n", per_cu); grid = -1; return; }
        (void)hipGetLastError();
        if (cus < NBLK) { fprintf(stderr, "kernel_launch: built for a %d-CU device, found %d CUs\n", NBLK, cus); grid = -1; return; }
        grid = NBLK;
    }
    if (grid < 0) return;
    Params p{};
    for (int i = 0; i < 25; ++i) p.in[i] = (const float*)d_in[i];
    p.out = (float*)d_out; p.ws = (unsigned char*)d_ws;
    if (hipMemsetAsync((char*)d_ws + OFF_CTL, 0, 64 * 1024, stream) != hipSuccess) { fprintf(stderr, "kernel_launch: memset failed\n"); return; }
    void* args[] = {&p};
    hipError_t e = hipLaunchCooperativeKernel((const void*)mega_kernel, dim3(grid), dim3(NTHR), args, LDS_BYTES, stream);
    if (e != hipSuccess) fprintf(stderr, "cooperative launch failed: %s (grid %d)\n", hipGetErrorString(e), grid);
}
```

```cpp
#include <hip/hip_runtime.h>
#include <hip/hip_cooperative_groups.h>
#include <cstdio>
#include <cstdint>
namespace cg = cooperative_groups;

#ifndef PROBE
#define PROBE 0
#endif
#ifndef PEER_FUSED
#define PEER_FUSED 1
#endif

typedef unsigned short bf16_t;
typedef short bf16x8 __attribute__((ext_vector_type(8)));
typedef float f32x16 __attribute__((ext_vector_type(16)));
typedef float f32x4 __attribute__((ext_vector_type(4)));
typedef unsigned u32x4 __attribute__((ext_vector_type(4)));
typedef unsigned u32x2 __attribute__((ext_vector_type(2)));

constexpr int DM = 1024, NB = 2, SL = 8192, T = NB * SL, NLAYER = 2;
constexpr int INC = 1792;
constexpr int NTHR = 512, NWAVE = 8;
constexpr int NBLK = 256;
constexpr int LDS_BYTES = 147456;
constexpr int LDS_MISC = LDS_BYTES - 64;
constexpr float EPS = 1e-6f;

constexpr size_t MiB = 1u << 20;
constexpr size_t OFF_CTL = 0;
constexpr size_t OFF_WTIN = 1 * MiB;
constexpr size_t OFF_WTOUT = 8 * MiB;
constexpr size_t OFF_WTQ = 12 * MiB;
constexpr size_t OFF_PU = 20 * MiB;
constexpr size_t OFF_PV = 84 * MiB;
constexpr size_t OFF_RS = 505 * MiB;
constexpr size_t OFF_PSC = 512 * 1024;
constexpr size_t OFF_H2 = 148 * MiB;
constexpr size_t OFF_W3T = 150 * MiB;
constexpr size_t OFF_HFILT0 = 52 * MiB, OFF_HFILT1 = 116 * MiB;
constexpr size_t OFF_FM = 152 * MiB;
constexpr size_t OFF_KF = 153 * MiB;
constexpr size_t OFF_XA = 281 * MiB;
constexpr size_t OFF_R = 345 * MiB;
constexpr size_t R_XN = OFF_R + 0 * MiB;
constexpr size_t R_UR = OFF_R + 0 * MiB;
constexpr size_t R_UI = OFF_R + 16 * MiB;
constexpr size_t R_QKV = OFF_R + 32 * MiB;
constexpr size_t R_VT = OFF_R + 56 * MiB;
constexpr size_t R_HF = OFF_R + 60 * MiB;
constexpr size_t R_MIX = OFF_R + 60 * MiB;
constexpr size_t R_ATT = OFF_R + 124 * MiB;
constexpr size_t R_Y = OFF_R + 140 * MiB;
constexpr size_t R_QP = OFF_R + 32 * MiB;
constexpr size_t WS_NEED = 506 * MiB;

struct Params {
    const float* in[25];
    float* out;
    unsigned char* ws;
};
enum { I_X = 0, I_N1G, I_WIN, I_QG, I_KG, I_CW, I_CB, I_W1, I_B1, I_F1, I_W2, I_B2, I_F2, I_W3, I_HB, I_FW, I_FB, I_MG, I_WOUT, I_N2G, I_WQ, I_SK, I_PU, I_PV, I_FG };

__device__ __forceinline__ unsigned f2bf(float f) { unsigned u = __builtin_bit_cast(unsigned, f); return (u + 0x7fffu + ((u >> 16) & 1u)) >> 16; }
__device__ __forceinline__ unsigned pk2(float lo, float hi) { return f2bf(lo) | (f2bf(hi) << 16); }
__device__ __forceinline__ float bf2f(unsigned b) { return __builtin_bit_cast(float, b << 16); }
__device__ __forceinline__ float bflo(unsigned w) { return __builtin_bit_cast(float, w << 16); }
__device__ __forceinline__ float bfhi(unsigned w) { return __builtin_bit_cast(float, w & 0xffff0000u); }
__device__ __forceinline__ float wave_sum(float v) {
#pragma unroll
    for (int o = 1; o < 64; o <<= 1) v += __shfl_xor(v, o);
    return v;
}
__device__ __forceinline__ float wave_max(float v) {
#pragma unroll
    for (int o = 1; o < 64; o <<= 1) v = fmaxf(v, __shfl_xor(v, o));
    return v;
}
__device__ __forceinline__ f32x16 mfma32(bf16x8 a, bf16x8 b, f32x16 c) { return __builtin_amdgcn_mfma_f32_32x32x16_bf16(a, b, c, 0, 0, 0); }
__device__ __forceinline__ f32x16 zero16() { return (f32x16){0.f,0.f,0.f,0.f,0.f,0.f,0.f,0.f,0.f,0.f,0.f,0.f,0.f,0.f,0.f,0.f}; }


__device__ __forceinline__ int otid() { int t = threadIdx.x; asm volatile("" : "+v"(t)); return t; }
__device__ __forceinline__ int obid() { int b = blockIdx.x; asm volatile("" : "+s"(b)); return b; }
__device__ __forceinline__ void transpose_one(const float* W, int K, int N, bf16_t* Wt, float* tile, int item) {
    const int tid = otid();
    const int nblk = N / 64, kb = item / nblk, nb = item % nblk, k0 = kb * 64, n0 = nb * 64;
    __syncthreads();
    {
        const int r = tid >> 6, c = tid & 63;
#pragma unroll
        for (int i = 0; i < 8; ++i) { const int k = r + 8 * i; tile[k * 65 + c] = W[(size_t)(k0 + k) * N + n0 + c]; }
    }
    __syncthreads();
    {
        const int nn = tid >> 3, kc = tid & 7;
        const float* s = tile + (kc * 8) * 65 + nn;
        u32x4 o; o.x = pk2(s[0], s[65]); o.y = pk2(s[2 * 65], s[3 * 65]); o.z = pk2(s[4 * 65], s[5 * 65]); o.w = pk2(s[6 * 65], s[7 * 65]);
        *(u32x4*)(Wt + (size_t)(n0 + nn) * K + k0 + kc * 8) = o;
    }
}

template <int PARTS = 31> __device__ __forceinline__ void phase_p0(const Params& p, char* lds) {
    const int tid = otid();
    float* tile = (float*)lds;
    if (PARTS & 1) {
    constexpr int IT_IN = (DM / 64) * (INC / 64), IT_OUT = (DM / 64) * (DM / 64), IT_W3 = 1024 / 64;
    constexpr int IT_L = IT_IN + IT_OUT + IT_W3;
    for (int it = obid(); it < NLAYER * IT_L; it += NBLK) {
        const int layer = it / IT_L; int r = it % IT_L;
        if (r < IT_IN) { transpose_one(p.in[I_WIN] + (size_t)layer * DM * INC, DM, INC, (bf16_t*)(p.ws + OFF_WTIN) + (size_t)layer * INC * DM, tile, r); continue; }
        r -= IT_IN;
        if (r < IT_OUT) { transpose_one(p.in[I_WOUT] + (size_t)layer * DM * DM, DM, DM, (bf16_t*)(p.ws + OFF_WTOUT) + (size_t)layer * DM * DM, tile, r); continue; }
        r -= IT_OUT;
        transpose_one(p.in[I_W3] + (size_t)layer * 64 * 1024, 64, 1024, (bf16_t*)(p.ws + OFF_W3T) + (size_t)layer * 1024 * 64, tile, r);
    }
    }
    __syncthreads();
    if (PARTS & 2) {
        float* SKl = (float*)lds;
        float* Wl = SKl + 128 * 129;
        const int lane = tid & 63, wave = tid >> 6, l31 = lane & 31, hl = lane >> 5, mt = wave & 3, nt = wave >> 2;
        for (int it = obid(); it < NLAYER * 16 * 16; it += NBLK) {
            const int layer = it >> 8, hp = (it >> 4) & 15, kc = it & 15, h = hp >> 1, pp = hp & 1, k0 = kc * 64;
            const float* sk = p.in[I_SK] + (((size_t)(layer * 2 + pp) * 8 + h) * 128) * 128;
            const float* wq = p.in[I_WQ] + (size_t)layer * DM * 2048 + (size_t)k0 * 2048 + h * 256 + pp * 128;
            __syncthreads();
            for (int i = tid; i < 128 * 128; i += NTHR) SKl[(i >> 7) * 129 + (i & 127)] = sk[i];
            for (int i = tid; i < 64 * 128; i += NTHR) Wl[(i >> 7) * 129 + (i & 127)] = wq[(size_t)(i >> 7) * 2048 + (i & 127)];
            __syncthreads();
            f32x16 acc = zero16();
            const float* ap = SKl + (32 * mt + l31) * 129 + hl;
            const float* bp = Wl + (32 * nt + l31) * 129 + hl;
#pragma unroll 16
            for (int kk = 0; kk < 64; ++kk) acc = __builtin_amdgcn_mfma_f32_32x32x2f32(ap[2 * kk], bp[2 * kk], acc, 0, 0, 0);
            const float g2 = p.in[I_N2G][layer * DM + k0 + 32 * nt + l31];
            bf16_t* dst = (bf16_t*)(p.ws + OFF_WTQ) + (size_t)layer * 2048 * DM + (size_t)(hp * 128 + 32 * mt + 4 * hl) * DM + k0 + 32 * nt + l31;
#pragma unroll
            for (int r = 0; r < 16; ++r) dst[(size_t)((r & 3) + 8 * (r >> 2)) * DM] = (bf16_t)f2bf(acc[r] * g2);
        }
        __syncthreads();
    }
    if (PARTS & 4) {
        const int lane = tid & 63, wave = tid >> 6;
        float* scl = (float*)(p.ws + OFF_PSC);
        for (int row = obid() * NWAVE + wave; row < 2 * NLAYER * 16384; row += NBLK * NWAVE) {
            const int tb = row >> 15, r = row & 32767;
            const f32x4* src = (const f32x4*)(p.in[tb ? I_PV : I_PU] + (size_t)r * DM) + lane;
            f32x4 v[4]; float mx = 0.f;
#pragma unroll
            for (int j = 0; j < 4; ++j) { v[j] = src[64 * j]; mx = fmaxf(mx, fmaxf(fmaxf(fabsf(v[j].x), fabsf(v[j].y)), fmaxf(fabsf(v[j].z), fabsf(v[j].w)))); }
            mx = wave_max(mx);
            const float sc = mx > 0.f ? 224.0f / mx : 1.0f;
            u32x4 o;
            { int w = 0; w = __builtin_amdgcn_cvt_pk_fp8_f32(v[0].x * sc, v[0].y * sc, w, false); w = __builtin_amdgcn_cvt_pk_fp8_f32(v[0].z * sc, v[0].w * sc, w, true); o.x = (unsigned)w; }
            { int w = 0; w = __builtin_amdgcn_cvt_pk_fp8_f32(v[1].x * sc, v[1].y * sc, w, false); w = __builtin_amdgcn_cvt_pk_fp8_f32(v[1].z * sc, v[1].w * sc, w, true); o.y = (unsigned)w; }
            { int w = 0; w = __builtin_amdgcn_cvt_pk_fp8_f32(v[2].x * sc, v[2].y * sc, w, false); w = __builtin_amdgcn_cvt_pk_fp8_f32(v[2].z * sc, v[2].w * sc, w, true); o.z = (unsigned)w; }
            { int w = 0; w = __builtin_amdgcn_cvt_pk_fp8_f32(v[3].x * sc, v[3].y * sc, w, false); w = __builtin_amdgcn_cvt_pk_fp8_f32(v[3].z * sc, v[3].w * sc, w, true); o.w = (unsigned)w; }
            *(u32x4*)(p.ws + (tb ? OFF_PV : OFF_PU) + (size_t)r * DM + lane * 16) = o;
            if (lane == 0) scl[row] = mx > 0.f ? mx / 224.0f : 1.0f;
        }
    }
    if (PARTS & 8) {
        float* sh = (float*)lds;
        float* zl = sh + 64 * 64;
        const int sub = tid >> 6, j = tid & 63;
        for (int it0 = obid() * 64; it0 < NLAYER * SL; it0 += NBLK * 64) {
            const int layer = it0 / SL;
            __syncthreads();
            for (int o = tid; o < 64 * 17; o += NTHR) {
                const int item = o / 17, f = o % 17;
                const float t = (float)((it0 + item) % SL) / (float)(SL - 1);
                float z;
                if (f == 0) z = t;
                else if (f <= 8) z = sinf(2.0f * 3.14159265358979323846f * t * (float)f);
                else z = cosf(2.0f * 3.14159265358979323846f * t * (float)(f - 8));
                zl[o] = z;
            }
            __syncthreads();
            {
                const float* w1 = p.in[I_W1] + layer * 17 * 64;
                float wv[17];
#pragma unroll
                for (int i = 0; i < 17; ++i) wv[i] = w1[i * 64 + j];
                const float b1 = p.in[I_B1][layer * 64 + j], f1 = p.in[I_F1][layer * 64 + j];
#pragma unroll
                for (int r = 0; r < 8; ++r) {
                    const int item = sub * 8 + r;
                    float a = b1;
#pragma unroll
                    for (int i = 0; i < 17; ++i) a += zl[item * 17 + i] * wv[i];
                    sh[item * 64 + j] = sinf(f1 * a);
                }
            }
            __syncthreads();
            {
                const float* w2 = p.in[I_W2] + layer * 64 * 64;
                const float b2 = p.in[I_B2][layer * 64 + j], f2 = p.in[I_F2][layer * 64 + j];
                float acc[8];
#pragma unroll
                for (int r = 0; r < 8; ++r) acc[r] = b2;
#pragma unroll 8
                for (int k = 0; k < 64; ++k) {
                    const float w = w2[k * 64 + j];
#pragma unroll
                    for (int r = 0; r < 8; ++r) acc[r] += sh[(sub * 8 + r) * 64 + k] * w;
                }
#pragma unroll
                for (int r = 0; r < 8; ++r)
                    ((bf16_t*)(p.ws + OFF_H2))[((size_t)(it0 + sub * 8 + r)) * 64 + j] = (bf16_t)f2bf(sinf(f2 * acc[r]));
            }
        }
        __syncthreads();
    }
    if (PARTS & 16) {
        float* ctab = (float*)lds;
        __syncthreads();
        if (tid < 64) ctab[tid] = cosf((float)tid * (2.0f * 3.14159265358979323846f / 64.0f));
        __syncthreads();
        const int total = NLAYER * 4 * 128 * 64;
        for (int o = obid() * NTHR + tid; o < total; o += NBLK * NTHR) {
            const int e2 = o & 63, dd = (o >> 6) & 127, g = (o >> 13) & 3, layer = o >> 15;
            const int d = dd & 63, sh = (dd < 64) ? 0 : 48;
            const float* w = p.in[I_FW] + ((size_t)(layer * 4 + g) * 64) * 64;
            float acc = 0.f;
#pragma unroll 8
            for (int e = 0; e < 64; ++e) acc += ctab[(d * e + sh) & 63] * w[e * 64 + e2];
            ((float*)(p.ws + OFF_FM))[o] = acc * (1.0f / 724.0773439350246f);
        }
        __syncthreads();
    }
}

template <bool PAD> __device__ __forceinline__ int zi(int i) { return PAD ? i + (i >> 8) : i; }

template <int LOGN, bool PAD>
__device__ __forceinline__ void fft_fwd(float2* Z) {
    constexpr int N = 1 << LOGN;
    const int tid = otid();
    int s = 0;
    for (; s + 1 < LOGN; s += 2) {
        const int lh2 = LOGN - s - 2;
        const int h2 = 1 << lh2, h = h2 << 1;
        const float rs = 1.0f / (float)(h << 1);
        for (int q = tid; q < N / 4; q += NTHR) {
            const int j = q & (h2 - 1), blk = q >> lh2;
            const int base = (blk << (lh2 + 2)) + j;
            float2 x0 = Z[zi<PAD>(base)], x1 = Z[zi<PAD>(base + h2)], x2 = Z[zi<PAD>(base + h)], x3 = Z[zi<PAD>(base + h + h2)];
            const float ang = (float)j * rs;
            const float c = __builtin_amdgcn_cosf(ang), sn = __builtin_amdgcn_sinf(ang);
            float2 a0 = make_float2(x0.x + x2.x, x0.y + x2.y);
            float2 d02 = make_float2(x0.x - x2.x, x0.y - x2.y);
            float2 a2 = make_float2(d02.x * c + d02.y * sn, d02.y * c - d02.x * sn);
            float2 a1 = make_float2(x1.x + x3.x, x1.y + x3.y);
            float2 d13 = make_float2(x1.x - x3.x, x1.y - x3.y);
            float2 t3 = make_float2(d13.x * c + d13.y * sn, d13.y * c - d13.x * sn);
            float2 a3 = make_float2(t3.y, -t3.x);
            const float c2 = c * c - sn * sn, s2 = 2.f * c * sn;
            float2 y0 = make_float2(a0.x + a1.x, a0.y + a1.y);
            float2 e01 = make_float2(a0.x - a1.x, a0.y - a1.y);
            float2 y1 = make_float2(e01.x * c2 + e01.y * s2, e01.y * c2 - e01.x * s2);
            float2 y2 = make_float2(a2.x + a3.x, a2.y + a3.y);
            float2 e23 = make_float2(a2.x - a3.x, a2.y - a3.y);
            float2 y3 = make_float2(e23.x * c2 + e23.y * s2, e23.y * c2 - e23.x * s2);
            Z[zi<PAD>(base)] = y0; Z[zi<PAD>(base + h2)] = y1; Z[zi<PAD>(base + h)] = y2; Z[zi<PAD>(base + h + h2)] = y3;
        }
        __syncthreads();
    }
    if (s < LOGN) {
        for (int q = tid; q < N / 2; q += NTHR) {
            const int i0 = 2 * q;
            float2 a = Z[zi<PAD>(i0)], b = Z[zi<PAD>(i0 + 1)];
            Z[zi<PAD>(i0)] = make_float2(a.x + b.x, a.y + b.y);
            Z[zi<PAD>(i0 + 1)] = make_float2(a.x - b.x, a.y - b.y);
        }
        __syncthreads();
    }
}

template <int LOGN, bool PAD>
__device__ __forceinline__ void fft_inv(float2* Z) {
    constexpr int N = 1 << LOGN;
    const int tid = otid();
    for (int s = LOGN - 2; s >= 0; s -= 2) {
        const int lh2 = LOGN - s - 2;
        const int h2 = 1 << lh2, h = h2 << 1;
        const float rs = 1.0f / (float)(h << 1);
        for (int q = tid; q < N / 4; q += NTHR) {
            const int j = q & (h2 - 1), blk = q >> lh2;
            const int base = (blk << (lh2 + 2)) + j;
            float2 y0 = Z[zi<PAD>(base)], y1 = Z[zi<PAD>(base + h2)], y2 = Z[zi<PAD>(base + h)], y3 = Z[zi<PAD>(base + h + h2)];
            const float ang = (float)j * rs;
            const float c = __builtin_amdgcn_cosf(ang), sn = __builtin_amdgcn_sinf(ang);
            const float c2 = c * c - sn * sn, s2 = 2.f * c * sn;
            float2 t1 = make_float2(y1.x * c2 - y1.y * s2, y1.y * c2 + y1.x * s2);
            float2 t3 = make_float2(y3.x * c2 - y3.y * s2, y3.y * c2 + y3.x * s2);
            float2 a0 = make_float2(y0.x + t1.x, y0.y + t1.y), a1 = make_float2(y0.x - t1.x, y0.y - t1.y);
            float2 a2 = make_float2(y2.x + t3.x, y2.y + t3.y), a3 = make_float2(y2.x - t3.x, y2.y - t3.y);
            float2 u2 = make_float2(a2.x * c - a2.y * sn, a2.y * c + a2.x * sn);
            float2 u3 = make_float2(a3.x * c - a3.y * sn, a3.y * c + a3.x * sn);
            float2 v3 = make_float2(-u3.y, u3.x);
            Z[zi<PAD>(base)] = make_float2(a0.x + u2.x, a0.y + u2.y);
            Z[zi<PAD>(base + h)] = make_float2(a0.x - u2.x, a0.y - u2.y);
            Z[zi<PAD>(base + h2)] = make_float2(a1.x + v3.x, a1.y + v3.y);
            Z[zi<PAD>(base + h + h2)] = make_float2(a1.x - v3.x, a1.y - v3.y);
        }
        __syncthreads();
    }
}


__device__ __forceinline__ int zp(int i) { return i + 2 * (i >> 5); }
__device__ constexpr float FC32[16] = {1.000000000f, 0.980785280f, 0.923879533f, 0.831469612f, 0.707106781f, 0.555570233f, 0.382683432f, 0.195090322f, 0.000000000f, -0.195090322f, -0.382683432f, -0.555570233f, -0.707106781f, -0.831469612f, -0.923879533f, -0.980785280f};
__device__ constexpr float FS32[16] = {0.000000000f, 0.195090322f, 0.382683432f, 0.555570233f, 0.707106781f, 0.831469612f, 0.923879533f, 0.980785280f, 1.000000000f, 0.980785280f, 0.923879533f, 0.831469612f, 0.707106781f, 0.555570233f, 0.382683432f, 0.195090322f};
__device__ __forceinline__ float2 cmulf(float2 a, float2 b) { return make_float2(a.x * b.x - a.y * b.y, a.x * b.y + a.y * b.x); }
template <int R> __device__ __forceinline__ constexpr int brevR(int x) { int r = 0; for (int b = 1, t = R >> 1; t >= 1; b <<= 1, t >>= 1) if (x & b) r |= t; return r; }
template <int R> __device__ __forceinline__ void dft_fwd_regs(float2 (&x)[R]) {
#pragma unroll
    for (int half = R / 2; half >= 1; half >>= 1) {
#pragma unroll
        for (int blk = 0; blk < R; blk += 2 * half)
#pragma unroll
            for (int k = 0; k < half; ++k) {
                const float2 a = x[blk + k], b = x[blk + k + half];
                x[blk + k] = make_float2(a.x + b.x, a.y + b.y);
                const float2 d = make_float2(a.x - b.x, a.y - b.y);
                const int ti = k * (16 / half);
                if (ti == 0) x[blk + k + half] = d;
                else if (ti == 8) x[blk + k + half] = make_float2(d.y, -d.x);
                else { const float c = FC32[ti], sn = FS32[ti]; x[blk + k + half] = make_float2(d.x * c + d.y * sn, d.y * c - d.x * sn); }
            }
    }
}
template <int R> __device__ __forceinline__ void dft_inv_regs(float2 (&x)[R]) {
#pragma unroll
    for (int half = 1; half <= R / 2; half <<= 1) {
#pragma unroll
        for (int blk = 0; blk < R; blk += 2 * half)
#pragma unroll
            for (int k = 0; k < half; ++k) {
                const float2 a = x[blk + k], b0 = x[blk + k + half];
                const int ti = k * (16 / half);
                float2 b;
                if (ti == 0) b = b0;
                else if (ti == 8) b = make_float2(-b0.y, b0.x);
                else { const float c = FC32[ti], sn = FS32[ti]; b = make_float2(b0.x * c - b0.y * sn, b0.y * c + b0.x * sn); }
                x[blk + k] = make_float2(a.x + b.x, a.y + b.y);
                x[blk + k + half] = make_float2(a.x - b.x, a.y - b.y);
            }
    }
}
template <int R> __device__ __forceinline__ void apply_tw(float2 (&x)[R], float c, float sg) {
    const float2 w1 = make_float2(c, sg), w2 = cmulf(w1, w1);
    float2 po = w1, pe = w2;
#pragma unroll
    for (int m = 1; m < R; m += 2) {
        x[brevR<R>(m)] = cmulf(x[brevR<R>(m)], po);
        if (m + 1 < R) x[brevR<R>(m + 1)] = cmulf(x[brevR<R>(m + 1)], pe);
        if (m + 2 < R) { po = cmulf(po, w2); pe = cmulf(pe, w2); }
    }
}
template <int R, bool INV> __device__ __forceinline__ void fft_group(float2* Z, int pbase, int PS, float ang) {
    float2 x[R];
    if (!INV) {
#pragma unroll
        for (int m = 0; m < R; ++m) x[m] = Z[pbase + PS * m];
        dft_fwd_regs<R>(x);
        apply_tw<R>(x, __builtin_amdgcn_cosf(ang), -__builtin_amdgcn_sinf(ang));
#pragma unroll
        for (int m = 0; m < R; ++m) Z[pbase + PS * m] = x[brevR<R>(m)];
    } else {
#pragma unroll
        for (int m = 0; m < R; ++m) x[brevR<R>(m)] = Z[pbase + PS * m];
        apply_tw<R>(x, __builtin_amdgcn_cosf(ang), __builtin_amdgcn_sinf(ang));
        dft_inv_regs<R>(x);
#pragma unroll
        for (int m = 0; m < R; ++m) Z[pbase + PS * m] = x[m];
    }
}
template <bool INV> __device__ __forceinline__ void fft_group32_contig(float2* Z, int pbase) {
    float2 x[32];
    if (!INV) {
#pragma unroll
        for (int m = 0; m < 32; m += 2) { const f32x4 v = *(const f32x4*)(Z + pbase + m); x[m] = make_float2(v.x, v.y); x[m + 1] = make_float2(v.z, v.w); }
        dft_fwd_regs<32>(x);
#pragma unroll
        for (int m = 0; m < 32; m += 2) { const float2 a = x[brevR<32>(m)], b = x[brevR<32>(m + 1)]; *(f32x4*)(Z + pbase + m) = (f32x4){a.x, a.y, b.x, b.y}; }
    } else {
#pragma unroll
        for (int m = 0; m < 32; m += 2) { const f32x4 v = *(const f32x4*)(Z + pbase + m); x[brevR<32>(m)] = make_float2(v.x, v.y); x[brevR<32>(m + 1)] = make_float2(v.z, v.w); }
        dft_inv_regs<32>(x);
#pragma unroll
        for (int m = 0; m < 32; m += 2) *(f32x4*)(Z + pbase + m) = (f32x4){x[m].x, x[m].y, x[m + 1].x, x[m + 1].y};
    }
}
__device__ __forceinline__ void fft16k_fwd(float2* Z) {
    const int tid = otid();
#pragma unroll 1
    for (int g = 0; g < 2; ++g) { const int j = tid + 512 * g; fft_group<16, false>(Z, zp(j), 1088, (float)j * (1.0f / 16384.0f)); }
    __syncthreads();
    { const int blk = tid >> 5, j = tid & 31; fft_group<32, false>(Z, blk * 1088 + j, 34, (float)j * (1.0f / 1024.0f)); }
    __syncthreads();
    fft_group32_contig<false>(Z, 34 * tid);
    __syncthreads();
}
__device__ __forceinline__ void fft16k_inv(float2* Z) {
    const int tid = otid();
    fft_group32_contig<true>(Z, 34 * tid);
    __syncthreads();
    { const int blk = tid >> 5, j = tid & 31; fft_group<32, true>(Z, blk * 1088 + j, 34, (float)j * (1.0f / 1024.0f)); }
    __syncthreads();
#pragma unroll 1
    for (int g = 0; g < 2; ++g) { const int j = tid + 512 * g; fft_group<16, true>(Z, zp(j), 1088, (float)j * (1.0f / 16384.0f)); }
    __syncthreads();
}
__device__ __forceinline__ void fft8k_fwd(float2* Z) {
    const int tid = otid();
    fft_group<16, false>(Z, zp(tid), 544, (float)tid * (1.0f / 8192.0f));
    __syncthreads();
    { const int blk = tid >> 5, j = tid & 31; fft_group<16, false>(Z, blk * 544 + j, 34, (float)j * (1.0f / 512.0f)); }
    __syncthreads();
    if (tid < 256) fft_group32_contig<false>(Z, 34 * tid);
    __syncthreads();
}
__device__ __forceinline__ int f16k_of_p(int p) { return (p >> 10) + 16 * ((p >> 5) & 31) + 512 * (p & 31); }
__device__ __forceinline__ int p16k_of_f(int f) { return 1024 * (f & 15) + 32 * ((f >> 4) & 31) + (f >> 9); }
__device__ __forceinline__ int p8k_of_f(int f) { return 512 * (f & 15) + 32 * ((f >> 4) & 15) + (f >> 8); }

__device__ __forceinline__ void phase_filter_spectra(const Params& p, char* lds) {
    const int tid = otid(), lane = tid & 63, wave = tid >> 6;
    float2* Z = (float2*)lds;
    float* red = (float*)(lds + 139264 + 64);
    for (int job = obid(); job < NLAYER * 256; job += NBLK) {
        const int layer = job >> 8, c = job & 255;
        __syncthreads();
        const float* HFc = (const float*)(p.ws + (layer ? OFF_HFILT1 : OFF_HFILT0)) + (size_t)c * SL;
        const float r_lo = 4.605170185988092f / 1.5f, r_hi = 4.605170185988092f / 0.3f;
        const float rate = r_lo + (r_hi - r_lo) * ((float)c / 255.0f);
        float ss0 = 0.f, ss1 = 0.f;
#pragma unroll 1
        for (int i = 0; i < 4; ++i) {
            const int l0 = 4 * tid + 2048 * i;
            const f32x4 a0 = *(const f32x4*)(HFc + l0), a1 = *(const f32x4*)(HFc + (size_t)256 * SL + l0);
            const f32x4 a2 = *(const f32x4*)(HFc + (size_t)512 * SL + l0), a3 = *(const f32x4*)(HFc + (size_t)768 * SL + l0);
#pragma unroll
            for (int e = 0; e < 4; ++e) {
                const int l = l0 + e;
                const float t = (float)l / (float)(SL - 1);
                const float dec = expf(-t * rate);
                const float f0 = a0[e] * dec, b0 = a1[e] * dec, f1 = a2[e] * dec, b1 = a3[e] * dec;
                ss0 += f0 * f0 + b0 * b0; ss1 += f1 * f1 + b1 * b1;
                Z[zp(l)] = make_float2(f0, f1);
                if (l >= 1) Z[zp(16384 - l)] = make_float2(b0, b1);
            }
        }
        if (tid == 0) Z[zp(8192)] = make_float2(0.f, 0.f);
        ss0 = wave_sum(ss0); ss1 = wave_sum(ss1);
        if (lane == 0) { red[wave * 2] = ss0; red[wave * 2 + 1] = ss1; }
        __syncthreads();
        float t0 = 0.f, t1 = 0.f;
#pragma unroll
        for (int w = 0; w < 8; ++w) { t0 += red[w * 2]; t1 += red[w * 2 + 1]; }
        const float sc0 = rsqrtf(t0 + EPS) * (1.0f / 16384.0f) * 0.5f, sc1 = rsqrtf(t1 + EPS) * (1.0f / 16384.0f) * 0.5f;
        fft16k_fwd(Z);
        float2* KF0 = (float2*)(p.ws + OFF_KF) + ((size_t)(layer * 256 + c) * 2) * 16384;
        float2* KF1 = KF0 + 16384;
        for (int i = 0; i < 32; ++i) {
            const int pp = tid + NTHR * i;
            const int fq = f16k_of_p(pp);
            const int pq = p16k_of_f((16384 - fq) & 16383);
            const float2 za = Z[zp(pp)], zq = Z[zp(pq)];
            KF0[pp] = make_float2((za.x + zq.x) * sc0, (za.y - zq.y) * sc0);
            KF1[pp] = make_float2((za.y + zq.y) * sc1, (zq.x - za.x) * sc1);
        }
    }
}

__device__ __forceinline__ void phase_rmsnorm_bf16(const float* x, const float* g, bf16_t* out) {
    const int lane = otid() & 63, wave = otid() >> 6;
    const int gw = obid() * NWAVE + wave, ngw = NBLK * NWAVE;
    for (int row = gw; row < T; row += ngw) {
        const f32x4* xr = (const f32x4*)(x + (size_t)row * DM) + lane;
        f32x4 v[4]; float ss = 0.f;
#pragma unroll
        for (int j = 0; j < 4; ++j) { v[j] = xr[64 * j]; ss += v[j].x * v[j].x + v[j].y * v[j].y + v[j].z * v[j].z + v[j].w * v[j].w; }
        ss = wave_sum(ss);
        const float r = rsqrtf(ss * (1.0f / DM) + EPS);
        u32x2* o = (u32x2*)(out + (size_t)row * DM) + lane;
#pragma unroll
        for (int j = 0; j < 4; ++j) {
            const f32x4 gg = ((const f32x4*)g)[lane + 64 * j];
            u32x2 w; w.x = pk2(v[j].x * r * gg.x, v[j].y * r * gg.y); w.y = pk2(v[j].z * r * gg.z, v[j].w * r * gg.w);
            o[64 * j] = w;
        }
    }
}
__device__ __forceinline__ void phase_final_norm(const float* x, const float* g, float* out) {
    const int lane = otid() & 63, wave = otid() >> 6;
    const int gw = obid() * NWAVE + wave, ngw = NBLK * NWAVE;
    for (int row = gw; row < T; row += ngw) {
        const f32x4* xr = (const f32x4*)(x + (size_t)row * DM) + lane;
        f32x4 v[4]; float ss = 0.f;
#pragma unroll
        for (int j = 0; j < 4; ++j) { v[j] = xr[64 * j]; ss += v[j].x * v[j].x + v[j].y * v[j].y + v[j].z * v[j].z + v[j].w * v[j].w; }
        ss = wave_sum(ss);
        const float r = rsqrtf(ss * (1.0f / DM) + EPS);
        f32x4* o = (f32x4*)(out + (size_t)row * DM) + lane;
#pragma unroll
        for (int j = 0; j < 4; ++j) { const f32x4 gg = ((const f32x4*)g)[lane + 64 * j]; o[64 * j] = v[j] * r * gg; }
    }
}

constexpr int G_LDA = 144;
template <class Epi>
__device__ __forceinline__ void gemm_simple(const bf16_t* A, const bf16_t* Bt, int M, int N, int K, char* lds, const Epi& epi) {
    const int tid = otid(), lane = tid & 63, wave = tid >> 6;
    const int wm = wave >> 1, wn = wave & 1;
    const int nMt = M / 256, nNt = N / 128, total = nMt * nNt, nk = K / 64;
    char* As = lds; char* Bs = lds + 256 * G_LDA;
    const int l31 = lane & 31, hl = lane >> 5;
    for (int u = obid(); u < total; u += NBLK) {
        const int mt = u % nMt, nt = u / nMt;
        f32x16 acc[2][2];
#pragma unroll
        for (int i = 0; i < 2; ++i)
#pragma unroll
            for (int j = 0; j < 2; ++j) acc[i][j] = zero16();
        u32x4 ra[4], rb[2];
        const bf16_t* Ab = A + (size_t)(mt * 256) * K;
        const bf16_t* Bb = Bt + (size_t)(nt * 128) * K;
#pragma unroll
        for (int i = 0; i < 4; ++i) { const int id = tid + NTHR * i, row = id >> 3, ch = id & 7; ra[i] = *(const u32x4*)(Ab + (size_t)row * K + ch * 8); }
#pragma unroll
        for (int i = 0; i < 2; ++i) { const int id = tid + NTHR * i, row = id >> 3, ch = id & 7; rb[i] = *(const u32x4*)(Bb + (size_t)row * K + ch * 8); }
        for (int kt = 0; kt < nk; ++kt) {
            __syncthreads();
#pragma unroll
            for (int i = 0; i < 4; ++i) { const int id = tid + NTHR * i, row = id >> 3, ch = id & 7; *(u32x4*)(As + row * G_LDA + ch * 16) = ra[i]; }
#pragma unroll
            for (int i = 0; i < 2; ++i) { const int id = tid + NTHR * i, row = id >> 3, ch = id & 7; *(u32x4*)(Bs + row * G_LDA + ch * 16) = rb[i]; }
            __syncthreads();
            if (kt + 1 < nk) {
                const int ko = (kt + 1) * 64;
#pragma unroll
                for (int i = 0; i < 4; ++i) { const int id = tid + NTHR * i, row = id >> 3, ch = id & 7; ra[i] = *(const u32x4*)(Ab + (size_t)row * K + ko + ch * 8); }
#pragma unroll
                for (int i = 0; i < 2; ++i) { const int id = tid + NTHR * i, row = id >> 3, ch = id & 7; rb[i] = *(const u32x4*)(Bb + (size_t)row * K + ko + ch * 8); }
            }
#pragma unroll
            for (int ks = 0; ks < 4; ++ks) {
                bf16x8 a[2], b[2];
#pragma unroll
                for (int i = 0; i < 2; ++i) a[i] = *(const bf16x8*)(As + (wm * 64 + i * 32 + l31) * G_LDA + ks * 32 + hl * 16);
#pragma unroll
                for (int j = 0; j < 2; ++j) b[j] = *(const bf16x8*)(Bs + (wn * 64 + j * 32 + l31) * G_LDA + ks * 32 + hl * 16);
#pragma unroll
                for (int i = 0; i < 2; ++i)
#pragma unroll
                    for (int j = 0; j < 2; ++j) acc[i][j] = mfma32(a[i], b[j], acc[i][j]);
            }
        }
#pragma unroll
        for (int i = 0; i < 2; ++i)
#pragma unroll
            for (int j = 0; j < 2; ++j) epi(acc[i][j], mt * 256 + wm * 64 + i * 32, nt * 128 + wn * 64 + j * 32, lane);
    }
}

struct EpiIn {
    bf16_t* qkv; float* hf;
    __device__ __forceinline__ void operator()(const f32x16& acc, int row0, int col0, int lane) const {
        const int c = col0 + (lane & 31), h = lane >> 5;
        if (col0 < 768) {
#pragma unroll
            for (int r = 0; r < 16; ++r) { const int row = row0 + (r & 3) + 8 * (r >> 2) + 4 * h; qkv[(size_t)row * 768 + c] = (bf16_t)f2bf(acc[r]); }
        } else {
            float* dst = hf + (size_t)(c - 768) * T;
#pragma unroll
            for (int i = 0; i < 4; ++i) { const int row = row0 + 8 * i + 4 * h; f32x4 v; v.x = acc[4 * i]; v.y = acc[4 * i + 1]; v.z = acc[4 * i + 2]; v.w = acc[4 * i + 3]; *(f32x4*)(dst + row) = v; }
        }
    }
};
struct EpiRes {
    const float* base; float* out;
    __device__ __forceinline__ void operator()(const f32x16& acc, int row0, int col0, int lane) const {
        const int c = col0 + (lane & 31), h = lane >> 5;
#pragma unroll
        for (int r = 0; r < 16; ++r) { const size_t o = (size_t)(row0 + (r & 3) + 8 * (r >> 2) + 4 * h) * DM + c; out[o] = base[o] + acc[r]; }
    }
};
struct EpiF32 {
    float* out; int ld;
    __device__ __forceinline__ void operator()(const f32x16& acc, int row0, int col0, int lane) const {
        const int c = col0 + (lane & 31), h = lane >> 5;
#pragma unroll
        for (int r = 0; r < 16; ++r) { out[(size_t)(row0 + (r & 3) + 8 * (r >> 2) + 4 * h) * ld + c] = acc[r]; }
    }
};

namespace pg8 {
#define PG8_LAS __attribute__((address_space(3)))
constexpr int BM = 256, BK = 64, HALF = 128, HTB = HALF * BK * 2  , STAGE_BYTES = 8 * HTB, NXCD = 8, WGM = 8;

__host__ __device__ __forceinline__ int lds_byte(int r, int c) { const int st = (r >> 4) * 2 + (c >> 5), rr = r & 15, cc = c & 31, ob = rr * 64 + cc * 2; return st * 1024 + (ob ^ (((ob >> 9) & 1) << 5)); }
__host__ __device__ __forceinline__ void stage_rc(int b, int& R, int& C) { const int st = b / 1024, sb = b % 1024, swz = sb ^ (((sb >> 9) & 1) << 5); R = (st >> 1) * 16 + swz / 64; C = (st & 1) * 32 + (swz % 64) / 2; }
__host__ __device__ __forceinline__ int perm32(int rho) { const int n = rho >> 4, i = rho & 15; return 8 * (i >> 2) + 4 * n + (i & 3); }

struct Unit { int pm, pn; };
struct Gemm { const bf16_t* A; const bf16_t* Bt; int M, N, K; };

struct StaticOrder {
    int nM, nN, nwg, G, c;
    __host__ __device__ void init(int M, int N, int G_, int c_) { nM = M / BM; nN = N / BM; nwg = nM * nN; G = G_; c = c_; }
    __host__ __device__ bool next(int i, Unit& u) const {
        const long L = (long)i * G + c; if (L >= nwg) return false;
        int wgid = (int)L; { const int q = nwg / NXCD, r = nwg % NXCD, xcd = wgid % NXCD, off = wgid / NXCD; wgid = (xcd < r ? xcd * (q + 1) : r * (q + 1) + (xcd - r) * q) + off; }
        const int nig = WGM * nN, gid = wgid / nig, fm = gid * WGM, gsz = (nM - fm) < WGM ? (nM - fm) : WGM;
        u.pm = fm + ((wgid % nig) % gsz); u.pn = (wgid % nig) / gsz; return true;
    }
    __device__ __forceinline__ void a_ready(const Unit&) const {}
    __device__ __forceinline__ void done(const Unit&) const {}
};


__device__ __forceinline__ unsigned cvt_pk_bf16(float lo, float hi) { unsigned r; asm volatile("v_cvt_pk_bf16_f32 %0, %1, %2" : "=v"(r) : "v"(lo), "v"(hi)); return r; }
struct EpiStoreBf16 {
    static constexpr bool PERM = true, AFTER_DRAIN = false;
    bf16_t* O; int ldc;
    __device__ __forceinline__ void operator()(const f32x4 (&acc)[2][2][4][2], const Unit& u, int wr, int wc, int fr, int fq) const {
        const int row0 = u.pm * BM + wr * 64 + fr, col0 = u.pn * BM + wc * 32 + 8 * fq;
#pragma unroll
        for (int ai = 0; ai < 2; ++ai)
#pragma unroll
            for (int m = 0; m < 4; ++m) { bf16_t* rowp = O + (size_t)(row0 + ai * HALF + m * 16) * ldc + col0;
#pragma unroll
                for (int bj = 0; bj < 2; ++bj) { const f32x4 v0 = acc[ai][bj][m][0], v1 = acc[ai][bj][m][1];
                    u32x4 w; w.x = cvt_pk_bf16(v0[0], v0[1]); w.y = cvt_pk_bf16(v0[2], v0[3]); w.z = cvt_pk_bf16(v1[0], v1[1]); w.w = cvt_pk_bf16(v1[2], v1[3]);
                    *(u32x4*)(rowp + bj * HALF) = w; } }
    }
};
struct EpiOutProj {
    static constexpr bool PERM = false, AFTER_DRAIN = false;
    const float* base; float* O; bf16_t* XB; float* RS;
    __device__ __forceinline__ void operator()(const f32x4 (&acc)[2][2][4][2], const Unit& u, int wr, int wc, int fr, int fq) const {
        const int row0 = u.pm * BM + wr * 64 + fr, col0 = u.pn * BM + wc * 32 + 4 * fq;
#pragma unroll
        for (int ai = 0; ai < 2; ++ai)
#pragma unroll
            for (int m = 0; m < 4; ++m) { const int row = row0 + ai * HALF + m * 16; const size_t off = (size_t)row * 1024 + col0; float ss = 0.f;
#pragma unroll
                for (int bj = 0; bj < 2; ++bj)
#pragma unroll
                    for (int n = 0; n < 2; ++n) { const f32x4 v = acc[ai][bj][m][n] + *(const f32x4*)(base + off + bj * HALF + n * 16);
                        *(f32x4*)(O + off + bj * HALF + n * 16) = v; ss += v[0] * v[0] + v[1] * v[1] + v[2] * v[2] + v[3] * v[3];
                        u32x2 w; w.x = cvt_pk_bf16(v[0], v[1]); w.y = cvt_pk_bf16(v[2], v[3]); *(u32x2*)(XB + off + bj * HALF + n * 16) = w; }
                ss += __shfl_xor(ss, 16); ss += __shfl_xor(ss, 32);
                if (fq == 0) RS[(size_t)row * 16 + u.pn * 4 + wc] = ss; }
    }
};
struct EpiRowScaleF32 {
    static constexpr bool PERM = false, AFTER_DRAIN = false;
    float* O; int ldc; const float* RS;
    __device__ __forceinline__ void operator()(const f32x4 (&acc)[2][2][4][2], const Unit& u, int wr, int wc, int fr, int fq) const {
        const int row0 = u.pm * BM + wr * 64 + fr, col0 = u.pn * BM + wc * 32 + 4 * fq;
#pragma unroll
        for (int ai = 0; ai < 2; ++ai)
#pragma unroll
            for (int m = 0; m < 4; ++m) { const int row = row0 + ai * HALF + m * 16; const size_t off = (size_t)row * ldc + col0;
                float tot = 0.f;
#pragma unroll
                for (int q = 0; q < 4; ++q) { const f32x4 pr = *(const f32x4*)(RS + (size_t)row * 16 + 4 * q); tot += (pr[0] + pr[1]) + (pr[2] + pr[3]); }
                const float r = rsqrtf(tot * (1.0f / 1024.0f) + 1e-6f);
#pragma unroll
                for (int bj = 0; bj < 2; ++bj)
#pragma unroll
                    for (int n = 0; n < 2; ++n) *(f32x4*)(O + off + bj * HALF + n * 16) = acc[ai][bj][m][n] * r; }
    }
};
struct EpiStoreF32 {
    static constexpr bool PERM = false, AFTER_DRAIN = false;
    const float* base; float* O; int ldc;
    __device__ __forceinline__ void operator()(const f32x4 (&acc)[2][2][4][2], const Unit& u, int wr, int wc, int fr, int fq) const {
        const int row0 = u.pm * BM + wr * 64 + fr, col0 = u.pn * BM + wc * 32 + 4 * fq;
#pragma unroll
        for (int ai = 0; ai < 2; ++ai)
#pragma unroll
            for (int m = 0; m < 4; ++m) { const size_t off = (size_t)(row0 + ai * HALF + m * 16) * ldc + col0;
#pragma unroll
                for (int bj = 0; bj < 2; ++bj)
#pragma unroll
                    for (int n = 0; n < 2; ++n) { f32x4 v = acc[ai][bj][m][n]; if (base) v += *(const f32x4*)(base + off + bj * HALF + n * 16); *(f32x4*)(O + off + bj * HALF + n * 16) = v; } }
    }
};

template <class Epi, class Sched, bool ALIGN_EPI = false, bool SP2 = false>
__device__ __forceinline__ void gemm_phase(PG8_LAS unsigned char* lds, const Gemm g, const Sched& S, const Epi& E) {
    const int tid = otid(), wid = __builtin_amdgcn_readfirstlane(tid >> 6), lane = tid & 63, wr = wid >> 2, wc = wid & 3, fr = lane & 15, fq = lane >> 4;
    const int K = g.K, nt = K / BK;
    unsigned voffA[2], voffB[2];
#pragma unroll
    for (int i = 0; i < 2; ++i) { int R, C; stage_rc(tid * 16 + i * 8192, R, C); const int Rb = Epi::PERM ? ((R & ~31) + perm32(R & 31)) : R;
        voffA[i] = (unsigned)(R * K + C) * 2u; voffB[i] = (unsigned)(Rb * K + C) * 2u; }
    const size_t kstep = (size_t)(BK * 2);
    const size_t hstep = (size_t)HALF * K * 2;
    const size_t tstep = 2 * hstep;
    const unsigned ldsw = (unsigned)wid * 1024u;
    const int aoff = lds_byte(wr * 64 + fr, fq * 8), boff = lds_byte(wc * 32 + fr, fq * 8);
#define PG8_SA(b, h) (((b) * 2 + (h)) * HTB)
#define PG8_SB(b, h) ((4 + (b) * 2 + (h)) * HTB)
#define PG8_STAGE(bufoff, gbase, voff) do { _Pragma("unroll") for (int _i = 0; _i < 2; ++_i) \
        __builtin_amdgcn_global_load_lds((const unsigned*)((const char*)(gbase) + (voff)[_i]), (PG8_LAS unsigned*)(lds + (bufoff) + ldsw + _i * 8192), 16, 0, 0); } while (0)
#define PG8_LDA(dst, b, h) do { _Pragma("unroll") for (int m = 0; m < 4; ++m) _Pragma("unroll") for (int k = 0; k < 2; ++k) dst[m][k] = *(const PG8_LAS bf16x8*)(lds + PG8_SA(b, h) + aoff + m * 2048 + k * 1024); } while (0)
#define PG8_LDB(dst, b, h) do { _Pragma("unroll") for (int n = 0; n < 2; ++n) _Pragma("unroll") for (int k = 0; k < 2; ++k) dst[n][k] = *(const PG8_LAS bf16x8*)(lds + PG8_SB(b, h) + boff + n * 2048 + k * 1024); } while (0)
#define PG8_MMA(ai, bj, At, Bt) do { __builtin_amdgcn_s_setprio(1); _Pragma("unroll") for (int m = 0; m < 4; ++m) _Pragma("unroll") for (int n = 0; n < 2; ++n) _Pragma("unroll") for (int k = 0; k < 2; ++k) \
        acc[ai][bj][m][n] = __builtin_amdgcn_mfma_f32_16x16x32_bf16(Bt[n][k], At[m][k], acc[ai][bj][m][n], 0, 0, 0); __builtin_amdgcn_s_setprio(0); } while (0)
#define PG8_WAIT_V(n) asm volatile("s_waitcnt vmcnt(" #n ")" ::: "memory")
#define PG8_WAIT_L(n) asm volatile("s_waitcnt lgkmcnt(" #n ")" ::: "memory")
#define PG8_BAR __builtin_amdgcn_s_barrier()
#define PG8_SCHED __builtin_amdgcn_sched_barrier(0)
    Unit cur, nxt; int ui = 0;
    if (!S.next(0, cur)) return;
    f32x4 acc[2][2][4][2];
#pragma unroll
    for (int a = 0; a < 2; ++a)
#pragma unroll
        for (int b = 0; b < 2; ++b)
#pragma unroll
            for (int m = 0; m < 4; ++m)
#pragma unroll
                for (int n = 0; n < 2; ++n) acc[a][b][m][n] = (f32x4){0.f, 0.f, 0.f, 0.f};
    bf16x8 At[4][2], B0[2][2], B1[2][2];
    const char* cA = (const char*)g.A + (size_t)cur.pm * tstep; const char* cB = (const char*)g.Bt + (size_t)cur.pn * tstep;
    S.a_ready(cur);
    if constexpr (SP2) {
        PG8_STAGE(PG8_SB(0, 0), cB, voffB); PG8_STAGE(PG8_SB(0, 1), cB + hstep, voffB); PG8_STAGE(PG8_SA(0, 0), cA, voffA); PG8_STAGE(PG8_SA(0, 1), cA + hstep, voffA);
        if (wr == 1) PG8_BAR;
        PG8_WAIT_V(2); PG8_BAR;
        PG8_STAGE(PG8_SB(1, 0), cB + kstep, voffB); PG8_STAGE(PG8_SA(1, 0), cA + kstep, voffA); PG8_STAGE(PG8_SB(1, 1), cB + hstep + kstep, voffB);
        PG8_WAIT_V(6); PG8_BAR;
    } else {
        PG8_STAGE(PG8_SB(0, 0), cB, voffB); PG8_STAGE(PG8_SA(0, 0), cA, voffA); PG8_STAGE(PG8_SB(0, 1), cB + hstep, voffB); PG8_STAGE(PG8_SA(0, 1), cA + hstep, voffA);
        if (wr == 1) PG8_BAR;
        PG8_WAIT_V(4); PG8_BAR;
        PG8_STAGE(PG8_SB(1, 0), cB + kstep, voffB); PG8_STAGE(PG8_SA(1, 0), cA + kstep, voffA); PG8_STAGE(PG8_SB(1, 1), cB + hstep + kstep, voffB);
        PG8_WAIT_V(6); PG8_BAR;
    }
    for (;;) {
        const bool has_next = S.next(ui + 1, nxt);
        const char* nA = has_next ? (const char*)g.A + (size_t)nxt.pm * tstep : cA; const char* nB = has_next ? (const char*)g.Bt + (size_t)nxt.pn * tstep : cB;
        for (int t = 0; t < nt; t += 2) {
            const bool last = (t == nt - 2);
            const char* a1 = cA + (size_t)(t + 1) * kstep;
            const char* a2 = last ? nA : cA + (size_t)(t + 2) * kstep; const char* b2 = last ? nB : cB + (size_t)(t + 2) * kstep;
            const char* a3 = a2 + kstep; const char* b3 = b2 + kstep;
            if (last && has_next) S.a_ready(nxt);
            if constexpr (SP2) {
            PG8_LDB(B0, 0, 0); PG8_LDB(B1, 0, 1); PG8_SCHED; PG8_LDA(At, 0, 0); PG8_STAGE(PG8_SA(1, 1), a1 + hstep, voffA);
            PG8_WAIT_V(8); PG8_WAIT_L(0); PG8_BAR; PG8_MMA(0, 0, At, B0); PG8_MMA(0, 1, At, B1); PG8_BAR; PG8_SCHED;
            PG8_LDA(At, 0, 1); PG8_STAGE(PG8_SB(0, 0), b2, voffB); PG8_STAGE(PG8_SB(0, 1), b2 + hstep, voffB); PG8_STAGE(PG8_SA(0, 0), a2, voffA);
            PG8_WAIT_V(8); PG8_WAIT_L(0); PG8_BAR; PG8_MMA(1, 0, At, B0); PG8_MMA(1, 1, At, B1); PG8_BAR; PG8_SCHED;
            PG8_LDB(B0, 1, 0); PG8_LDB(B1, 1, 1); PG8_SCHED; PG8_LDA(At, 1, 0); PG8_STAGE(PG8_SA(0, 1), a2 + hstep, voffA);
            PG8_WAIT_V(8); PG8_WAIT_L(0); PG8_BAR; PG8_MMA(0, 0, At, B0); PG8_MMA(0, 1, At, B1); PG8_BAR; PG8_SCHED;
            PG8_LDA(At, 1, 1); PG8_STAGE(PG8_SB(1, 0), b3, voffB); PG8_STAGE(PG8_SB(1, 1), b3 + hstep, voffB); PG8_STAGE(PG8_SA(1, 0), a3, voffA);
            PG8_WAIT_V(8); PG8_WAIT_L(0); PG8_BAR; PG8_MMA(1, 0, At, B0); PG8_MMA(1, 1, At, B1); PG8_BAR; PG8_SCHED;
            } else {
            PG8_LDB(B0, 0, 0); PG8_SCHED; PG8_LDA(At, 0, 0); PG8_STAGE(PG8_SA(1, 1), a1 + hstep, voffA);
            PG8_WAIT_L(8); PG8_BAR; PG8_WAIT_L(0); PG8_MMA(0, 0, At, B0); PG8_BAR; PG8_SCHED;
            PG8_LDB(B1, 0, 1); PG8_STAGE(PG8_SB(0, 0), b2, voffB);
            PG8_BAR; PG8_WAIT_L(0); PG8_MMA(0, 1, At, B1); PG8_BAR;
            PG8_LDA(At, 0, 1); PG8_STAGE(PG8_SA(0, 0), a2, voffA);
            PG8_BAR; PG8_WAIT_L(0); PG8_MMA(1, 0, At, B0); PG8_BAR; PG8_SCHED;
            PG8_STAGE(PG8_SB(0, 1), b2 + hstep, voffB);
            PG8_WAIT_V(6); PG8_BAR; PG8_MMA(1, 1, At, B1); PG8_BAR;
            PG8_LDB(B0, 1, 0); PG8_SCHED; PG8_LDA(At, 1, 0); PG8_STAGE(PG8_SA(0, 1), a2 + hstep, voffA);
            PG8_WAIT_L(8); PG8_BAR; PG8_WAIT_L(0); PG8_MMA(0, 0, At, B0); PG8_BAR; PG8_SCHED;
            PG8_LDB(B1, 1, 1); PG8_STAGE(PG8_SB(1, 0), b3, voffB);
            PG8_BAR; PG8_WAIT_L(0); PG8_MMA(0, 1, At, B1); PG8_BAR;
            PG8_LDA(At, 1, 1); PG8_STAGE(PG8_SA(1, 0), a3, voffA);
            PG8_BAR; PG8_WAIT_L(0); PG8_MMA(1, 0, At, B0); PG8_BAR; PG8_SCHED;
            PG8_STAGE(PG8_SB(1, 1), b3 + hstep, voffB);
            PG8_WAIT_V(6); PG8_BAR; PG8_MMA(1, 1, At, B1); PG8_BAR;
            }
        }
        if constexpr (ALIGN_EPI) { if (wr == 0) PG8_BAR; }
        if constexpr (!Epi::AFTER_DRAIN) { E(acc, cur, wr, wc, fr, fq); S.done(cur); }
        if (!has_next) break;
#pragma unroll
        for (int a = 0; a < 2; ++a)
#pragma unroll
            for (int b = 0; b < 2; ++b)
#pragma unroll
                for (int m = 0; m < 4; ++m)
#pragma unroll
                    for (int n = 0; n < 2; ++n) acc[a][b][m][n] = (f32x4){0.f, 0.f, 0.f, 0.f};
        cur = nxt; cA = nA; cB = nB; ++ui;
        if constexpr (ALIGN_EPI) { if (wr == 1) PG8_BAR; }
    }
    PG8_WAIT_V(0);
    if constexpr (!ALIGN_EPI) { if (wr == 0) PG8_BAR; }
    PG8_BAR;
    if constexpr (Epi::AFTER_DRAIN) { E.fused(acc, cur, wr, wc, fr, fq, lds, wid, lane); S.done(cur); }
#undef PG8_SA
#undef PG8_SB
#undef PG8_STAGE
#undef PG8_LDA
#undef PG8_LDB
#undef PG8_MMA
#undef PG8_WAIT_V
#undef PG8_WAIT_L
#undef PG8_BAR
#undef PG8_SCHED
}
}

__device__ constexpr float ROPE_INV_REV[16] = {1.591549431e-01f, 8.949940161e-02f, 5.032921210e-02f, 2.830219583e-02f, 1.591549431e-02f, 8.949940161e-03f, 5.032921210e-03f, 2.830219583e-03f, 1.591549431e-03f, 8.949940161e-04f, 5.032921210e-04f, 2.830219583e-04f, 1.591549431e-04f, 8.949940161e-05f, 5.032921210e-05f, 2.830219583e-05f};
__device__ __forceinline__ void qk_norm_rope8(const u32x4 raw, const float (&gn)[8], const float (&cs)[8], const float (&sn)[8], bool second, float scale, u32x4& out) {
    float x[8] = {bflo(raw.x), bfhi(raw.x), bflo(raw.y), bfhi(raw.y), bflo(raw.z), bfhi(raw.z), bflo(raw.w), bfhi(raw.w)};
    float ss = 0.f;
#pragma unroll
    for (int e = 0; e < 8; ++e) ss += x[e] * x[e];
    ss += __shfl_xor(ss, 1); ss += __shfl_xor(ss, 2); ss += __shfl_xor(ss, 4);
    const float r = rsqrtf(ss * (1.0f / 64.0f) + EPS) ;
    float o[8];
#pragma unroll
    for (int e = 0; e < 8; ++e) {
        const float y = x[e] * r * gn[e];
        const float other = __shfl_xor(y, 2);
        o[e] = (second ? (y * cs[e] + other * sn[e]) : (y * cs[e] - other * sn[e])) * scale;
    }
    out.x = pk2(o[0], o[1]); out.y = pk2(o[2], o[3]); out.z = pk2(o[4], o[5]); out.w = pk2(o[6], o[7]);
}
__device__ __forceinline__ void phase_qkprep(const Params& p, int layer, char* lds, bf16_t* qout) {
    const int tid = otid(), lane = tid & 63, wave = tid >> 6;
    const bf16_t* qkv = (const bf16_t*)(p.ws + R_QKV);
    const int sub = lane & 7;
    const bool second = ((sub >> 1) & 1) != 0, colaxis = (sub >> 2) != 0;
    float gq[8], gk[8], ir[8];
#pragma unroll
    for (int e = 0; e < 8; ++e) {
        gq[e] = p.in[I_QG][layer * 64 + sub * 8 + e]; gk[e] = p.in[I_KG][layer * 64 + sub * 8 + e];
        ir[e] = (sub & 1) ? ROPE_INV_REV[8 + e] : ROPE_INV_REV[e];
    }
    const int gw = obid() * NWAVE + wave, ngw = NBLK * NWAVE;
    for (int t = gw; t < T; t += ngw) {
        const int l = t & (SL - 1);
        const float pos = colaxis ? (float)(l & 63) : (float)(l >> 6);
        float cs[8], sn[8];
#pragma unroll
        for (int e = 0; e < 8; ++e) { const float a = pos * ir[e]; cs[e] = __builtin_amdgcn_cosf(a); sn[e] = __builtin_amdgcn_sinf(a); }
        const u32x4 rq = *(const u32x4*)(qkv + (size_t)t * 768 + lane * 8);
        u32x4 rk = {0u, 0u, 0u, 0u};
        if (lane < 16) rk = *(const u32x4*)(qkv + (size_t)t * 768 + 512 + lane * 8);
        u32x4 oq, ok;
        qk_norm_rope8(rq, gq, cs, sn, second, 0.125f * 1.4426950408889634f, oq);
        qk_norm_rope8(rk, gk, cs, sn, second, 1.0f, ok);
        *(u32x4*)(qout + (size_t)t * 768 + lane * 8) = oq;
        if (lane < 16) *(u32x4*)(qout + (size_t)t * 768 + 512 + lane * 8) = ok;
    }
}

#include <hip/hip_bf16.h>
#include <cmath>
namespace attn_body {
using bf16=__hip_bfloat16;
using bf16x8=__attribute__((ext_vector_type(8)))short;
using s16x4=__attribute__((ext_vector_type(4)))short;
using f32x16=__attribute__((ext_vector_type(16)))float;
using u32x4=__attribute__((ext_vector_type(4)))unsigned;
constexpr int SEQ=8192,D=64,PQ=768,PO=512;
constexpr int NW=8,QBLK=32,QB=QBLK*NW,KVBLK=64,NQB=SEQ/QB;
constexpr int ATTN_UNIT_ROWS=QB;
__device__ __forceinline__ int crow(int r,int hi){return (r&3)+8*(r>>2)+4*hi;}
#define SBAR() __builtin_amdgcn_sched_barrier(0)
__device__ __forceinline__ void cmask(f32x16&p0,f32x16&p1,int jb,int qrel,int hi){
  const float NEG=-INFINITY; int kb=64*jb+4*hi;
  #pragma unroll
  for(int r=0;r<16;++r){int kv=kb+(r&3)+8*(r>>2); if(kv>qrel)p0[r]=NEG; if(kv+32>qrel)p1[r]=NEG;}
}

constexpr int NSLOT=3, SLOTB=8192;
constexpr int LDS_K=0, LDS_V=NSLOT*SLOTB, LDS_WS=2*NSLOT*SLOTB, LDS_OST=LDS_WS+NW*64*4, LDS_BYTES=LDS_OST+NW*4096;
constexpr float C2=0.125f*1.4426950408889634f;
__device__ __forceinline__ void glds16(const void*gsrc,unsigned lds_dst){unsigned keep;
  asm volatile("s_mov_b32 %0, m0\n\ts_mov_b32 m0, %2\n\ts_nop 0\n\tglobal_load_lds_dwordx4 %1, off\n\ts_mov_b32 m0, %0":"=&s"(keep):"v"(gsrc),"s"(lds_dst):"memory");}
__device__ __forceinline__ float max3f(float a,float b,float c){float r;asm("v_max3_f32 %0, %1, %2, %3":"=v"(r):"v"(a),"v"(b),"v"(c));return r;}
__device__ __forceinline__ float max2f(float a,float b){float r;asm("v_max_f32_e32 %0, %1, %2":"=v"(r):"v"(a),"v"(b));return r;}
__device__ __forceinline__ float fadd_s(float a,float b){float r;asm("v_add_f32_e32 %0, %1, %2":"=v"(r):"v"(a),"v"(b));return r;}
__device__ __forceinline__ float fsub_s(float a,float b){float r;asm("v_sub_f32_e32 %0, %1, %2":"=v"(r):"v"(a),"v"(b));return r;}
typedef float f32x2_t __attribute__((ext_vector_type(2))); typedef __bf16 bf16x2_t __attribute__((ext_vector_type(2)));
__device__ __forceinline__ unsigned cvtpk_s(float lo,float hi){f32x2_t v={lo,hi};bf16x2_t b=__builtin_convertvector(v,bf16x2_t);return __builtin_bit_cast(unsigned,b);}
#define WAIT_BAR(N) asm volatile("s_waitcnt vmcnt(" #N ") lgkmcnt(0)\n\ts_barrier":::"memory")

__device__ __forceinline__ void qkt(f32x16&p0,f32x16&p1,const char*Kslot,const bf16x8*qr,const f32x16&negm,int r32,int hi){
  const char*kb=Kslot+hi*1024+r32*16;
  #pragma unroll
  for(int d0=0;d0<4;++d0){
    const bf16x8 b0=*reinterpret_cast<const bf16x8*>(kb+d0*2048);
    const bf16x8 b1=*reinterpret_cast<const bf16x8*>(kb+d0*2048+512);
    if(d0==0){p0=__builtin_amdgcn_mfma_f32_32x32x16_bf16(b0,qr[0],negm,0,0,0);p1=__builtin_amdgcn_mfma_f32_32x32x16_bf16(b1,qr[0],negm,0,0,0);}
    else{p0=__builtin_amdgcn_mfma_f32_32x32x16_bf16(b0,qr[d0],p0,0,0,0);p1=__builtin_amdgcn_mfma_f32_32x32x16_bf16(b1,qr[d0],p1,0,0,0);}}
}
typedef __attribute__((address_space(3))) const char* lds_cptr;
typedef short v4i16_t __attribute__((ext_vector_type(4)));
__device__ __forceinline__ void kload8(bf16x8*kf,lds_cptr kp){
  kf[0]=*(const __attribute__((address_space(3))) bf16x8*)(kp);      kf[1]=*(const __attribute__((address_space(3))) bf16x8*)(kp+512);
  kf[2]=*(const __attribute__((address_space(3))) bf16x8*)(kp+2048); kf[3]=*(const __attribute__((address_space(3))) bf16x8*)(kp+2560);
  kf[4]=*(const __attribute__((address_space(3))) bf16x8*)(kp+4096); kf[5]=*(const __attribute__((address_space(3))) bf16x8*)(kp+4608);
  kf[6]=*(const __attribute__((address_space(3))) bf16x8*)(kp+6144); kf[7]=*(const __attribute__((address_space(3))) bf16x8*)(kp+6656);
}
__device__ __forceinline__ void kload2(bf16x8*kf,lds_cptr kp,int j){ kf[2*j]=*(const __attribute__((address_space(3))) bf16x8*)(kp+j*2048); kf[2*j+1]=*(const __attribute__((address_space(3))) bf16x8*)(kp+j*2048+512); }
__device__ __forceinline__ s16x4 vtr(lds_cptr p){ return __builtin_bit_cast(s16x4,__builtin_amdgcn_ds_read_tr16_b64_v4i16((__attribute__((address_space(3))) v4i16_t*)p)); }
__device__ __forceinline__ float rowmax(const f32x16&p0,const f32x16&p1){
  float a=max3f(p0[0],p0[1],p1[0]),b=max3f(p0[2],p0[3],p1[1]);a=max3f(a,p1[2],p1[3]);
  #pragma unroll
  for(int r=4;r<16;r+=4){a=max3f(a,p0[r],p0[r+1]);b=max3f(b,p0[r+2],p0[r+3]);a=max3f(a,p1[r],p1[r+1]);b=max3f(b,p1[r+2],p1[r+3]);}
  const float m=max2f(a,b);
  auto rr=__builtin_amdgcn_permlane32_swap(__float_as_uint(m),__float_as_uint(m),false,false);
  return max2f(__uint_as_float(rr[0]),__uint_as_float(rr[1]));
}
__device__ __forceinline__ void pv(f32x16*o,int vb,bf16x8 pa0,bf16x8 pa1,bf16x8 pa2,bf16x8 pa3){
  #pragma unroll
  for(int d0=0;d0<2;++d0){s16x4 lo[4],hi[4];
    #pragma unroll
    for(int ks=0;ks<4;++ks){
      asm volatile("ds_read_b64_tr_b16 %0,%1 offset:%c2":"=&v"(lo[ks]):"v"(vb),"i"(d0*4096+ks*1024):"memory");
      asm volatile("ds_read_b64_tr_b16 %0,%1 offset:%c2":"=&v"(hi[ks]):"v"(vb),"i"(d0*4096+ks*1024+512):"memory");}
    asm volatile("s_waitcnt lgkmcnt(0)":::"memory");SBAR();
    #define PK(k) (bf16x8){lo[k][0],lo[k][1],lo[k][2],lo[k][3],hi[k][0],hi[k][1],hi[k][2],hi[k][3]}
    o[d0]=__builtin_amdgcn_mfma_f32_32x32x16_bf16(pa0,PK(0),o[d0],0,0,0);
    o[d0]=__builtin_amdgcn_mfma_f32_32x32x16_bf16(pa1,PK(1),o[d0],0,0,0);
    o[d0]=__builtin_amdgcn_mfma_f32_32x32x16_bf16(pa2,PK(2),o[d0],0,0,0);
    o[d0]=__builtin_amdgcn_mfma_f32_32x32x16_bf16(pa3,PK(3),o[d0],0,0,0);
    #undef PK
  }
}

#ifndef ATTN_STORE16
#define ATTN_STORE16(p,v) (*(u32x4*)(p)=(v))
#endif
template<int THRL> __device__ __forceinline__ void attn_unit(int b,int h,int g,int qb,const bf16*Q,const bf16*__restrict__ K,const bf16*__restrict__ V,bf16*O,char*shm){
  const int tid=otid(),lane=tid&63,r32=lane&31,hi=lane>>5; const int wid=__builtin_amdgcn_readfirstlane(tid>>6);
  const long rowbase=(long)b*SEQ; const int q0=qb*QB;
  const bf16*Qw=Q+(rowbase+q0+wid*QBLK)*PQ+h*D;
  const bf16*Kh=K+rowbase*PQ+g*D,*Vh=V+rowbase*PQ+g*D;
  const unsigned lds0=(unsigned)(uintptr_t)shm;
  float*wsf=(float*)(shm+LDS_WS)+wid*64;
  const bf16*ksrc=Kh+(long)lane*PQ+wid*8;
  const bf16*vsrc=Vh+(long)(16*(wid&3)+(lane>>2))*PQ+(wid>>2)*32+(lane&3)*8;
  const unsigned kdst=lds0+LDS_K+wid*1024, vdst=lds0+LDS_V+wid*1024;
  #define DMA_K(t,slot) glds16(ksrc+(long)(t)*KVBLK*PQ,(unsigned)__builtin_amdgcn_readfirstlane(kdst+(slot)))
  #define DMA_V(t,slot) glds16(vsrc+(long)(t)*KVBLK*PQ,(unsigned)__builtin_amdgcn_readfirstlane(vdst+(slot)))
  const int vb0=(int)(lds0+LDS_V)+((lane>>4)&1)*32+(lane&3)*8+(4*hi+((lane&15)>>2))*64;
  const char*Kbase=shm+LDS_K; bf16x8 kf[8];
  const lds_cptr shm3=(lds_cptr)shm; const lds_cptr kp0=shm3+LDS_K+hi*1024+r32*16; const lds_cptr vp0=shm3+LDS_V+((lane>>4)&1)*32+(lane&3)*8+(4*hi+((lane&15)>>2))*64;
  constexpr int NT=SEQ/KVBLK;
  DMA_K(0,0);DMA_V(0,0);DMA_K(1,SLOTB);
  bf16x8 qr[4];
  #pragma unroll
  for(int d0=0;d0<4;++d0)qr[d0]=*reinterpret_cast<const bf16x8*>(&Qw[(long)r32*PQ+d0*16+hi*8]);
  float mhat=0.f,l_reg=0.f;f32x16 o[2];o[0]=f32x16{};o[1]=f32x16{};f32x16 negm=f32x16{};asm volatile("":"+v"(negm));
    #define CMASK(P0,P1,t) do{}while(0)
  bool resc=false;
  #define START(P0,P1) do{ const float rm=rowmax(P0,P1); resc=false; \
    { const float dl=rm; mhat=fadd_s(mhat,dl); \
      _Pragma("unroll") for(int r=0;r<16;++r){P0[r]=fsub_s(P0[r],dl);P1[r]=fsub_s(P1[r],dl);} \
      _Pragma("unroll") for(int r=0;r<16;++r)negm[r]=-mhat; asm volatile("":"+v"(negm)); } \
    _Pragma("unroll") for(int r=0;r<16;++r)P0[r]=__builtin_amdgcn_exp2f(P0[r]); }while(0)
  #define RESC() do{ if(resc){ asm volatile("s_waitcnt lgkmcnt(0)":::"memory"); \
      _Pragma("unroll") for(int d_=0;d_<2;++d_) _Pragma("unroll") for(int r=0;r<16;++r)o[d_][r]*=wsf[crow(r,hi)]; } }while(0)
  f32x16 pA0,pA1,pB0,pB1;
  int sl_prev=0,sl_cur=0,sl_next=SLOTB;
  #define ROT() do{sl_prev=sl_cur;sl_cur=sl_next;sl_next=(sl_next==(NSLOT-1)*SLOTB)?0:sl_next+SLOTB;}while(0)
  DMA_K(2,2*SLOTB);
  WAIT_BAR(3);
  qkt(pA0,pA1,Kbase,qr,negm,r32,hi);asm volatile("s_nop 15\n\ts_nop 7":"+v"(pA0),"+v"(pA1));CMASK(pA0,pA1,0);
  START(pA0,pA1);
  _Pragma("unroll") for(int r=0;r<16;++r)pA1[r]=__builtin_amdgcn_exp2f(pA1[r]);
  WAIT_BAR(0);
  DMA_K(3,0);DMA_V(1,SLOTB);
  ROT();
  kload8(kf,kp0+sl_cur);
  WAIT_BAR(2);
  s16x4 vlo[8],vhi[8]; u32x4 pw0,pw1,pw2,pw3;
  #define PKW(P,B) cvtpk_s(P[B],P[B+1])
  #define PAF(k) __builtin_bit_cast(bf16x8,pw##k)
  #define VFR(i) (bf16x8){vlo[i][0],vlo[i][1],vlo[i][2],vlo[i][3],vhi[i][0],vhi[i][1],vhi[i][2],vhi[i][3]}
  #define PIN(x) asm volatile("":"+v"(x))
  #define MX3(a,b,c) __builtin_fmaxf(__builtin_fmaxf((a),(b)),(c))
  #define GAPA(MF,A0,A1,A2,A3,W0,W1,PW) do{ MF; sacc+=A0; sacc+=A1; sacc+=A2; sacc+=A3; PIN(sacc); W0; W1; PIN(PW); SBAR(); }while(0)
  #define EX(v) __builtin_amdgcn_exp2f(v)
  #define GAPB(MF,X,B) do{ MF; X[B]=EX(X[B]); X[B+1]=EX(X[B+1]); X[B+2]=EX(X[B+2]); X[B+3]=EX(X[B+3]); PIN(X); SBAR(); }while(0)
  #define VRD(i) do{ vlo[i]=vtr(vp_+(((i)>>2)*4096+((i)&3)*1024)); vhi[i]=vtr(vp_+(((i)>>2)*4096+((i)&3)*1024+512)); }while(0)
  #define KRD(G,j) do{ if(G){ kload2(kf,kp0+sl_next,j); SBAR(); } }while(0)
  #define STEP(C0,C1,P0,P1,t,GK,GV,GL) do{ SBAR(); \
    const lds_cptr vp_=vp0+sl_prev; \
    VRD(0); SBAR(); float sacc=(P0[0]+P0[1]); \
    GAPA(C0=__builtin_amdgcn_mfma_f32_32x32x16_bf16(kf[0],qr[0],negm,0,0,0), P0[2],P0[3],P0[4],P0[5],     pw0[0]=PKW(P0,0), pw0[1]=PKW(P0,2), pw0); \
    VRD(4); SBAR(); GAPA(C1=__builtin_amdgcn_mfma_f32_32x32x16_bf16(kf[1],qr[0],negm,0,0,0), P0[6],P0[7],P0[8],P0[9],     pw0[2]=PKW(P0,4), pw0[3]=PKW(P0,6), pw0); \
    VRD(1); SBAR(); GAPA(C0=__builtin_amdgcn_mfma_f32_32x32x16_bf16(kf[2],qr[1],C0,0,0,0),   P0[10],P0[11],P0[12],P0[13], pw1[0]=PKW(P0,8), pw1[1]=PKW(P0,10), pw1); \
    VRD(5); SBAR(); GAPA(C1=__builtin_amdgcn_mfma_f32_32x32x16_bf16(kf[3],qr[1],C1,0,0,0),   P0[14],P0[15],P1[0],P1[1],   pw1[2]=PKW(P0,12),pw1[3]=PKW(P0,14), pw1); \
    VRD(2); SBAR(); GAPA(C0=__builtin_amdgcn_mfma_f32_32x32x16_bf16(kf[4],qr[2],C0,0,0,0),   P1[2],P1[3],P1[4],P1[5],     pw2[0]=PKW(P1,0), pw2[1]=PKW(P1,2), pw2); \
    VRD(6); SBAR(); GAPA(C1=__builtin_amdgcn_mfma_f32_32x32x16_bf16(kf[5],qr[2],C1,0,0,0),   P1[6],P1[7],P1[8],P1[9],     pw2[2]=PKW(P1,4), pw2[3]=PKW(P1,6), pw2); \
    VRD(3); SBAR(); GAPA(C0=__builtin_amdgcn_mfma_f32_32x32x16_bf16(kf[6],qr[3],C0,0,0,0),   P1[10],P1[11],P1[12],P1[13], pw3[0]=PKW(P1,8), pw3[1]=PKW(P1,10), pw3); \
    VRD(7); SBAR(); GAPA(C1=__builtin_amdgcn_mfma_f32_32x32x16_bf16(kf[7],qr[3],C1,0,0,0),   P1[14],P1[15],0.f,0.f,       pw3[2]=PKW(P1,12),pw3[3]=PKW(P1,14), pw3); \
    l_reg+=sacc; \
    if(GK){DMA_K((t)+3,sl_cur);} if(GV){DMA_V((t)+1,sl_next);} \
    CMASK(C0,C1,t); \
    { float a=MX3(C0[0],C0[1],C1[0]),b=MX3(C0[2],C0[3],C1[1]); a=MX3(a,C1[2],C1[3]); \
      _Pragma("unroll") for(int r=4;r<16;r+=4){a=MX3(a,C0[r],C0[r+1]);b=MX3(b,C0[r+2],C0[r+3]);a=MX3(a,C1[r],C1[r+1]);b=MX3(b,C1[r+2],C1[r+3]);} \
      float rm=__builtin_fmaxf(a,b); { auto rr=__builtin_amdgcn_permlane32_swap(__float_as_uint(rm),__float_as_uint(rm),false,false); rm=__builtin_fmaxf(__uint_as_float(rr[0]),__uint_as_float(rr[1])); } \
      resc=false; \
      if(__builtin_expect(__any(rm>(float)THRL),0)){ const float dl=__builtin_fmaxf(rm,0.f); mhat+=dl; \
        _Pragma("unroll") for(int r=0;r<16;++r){C0[r]-=dl;C1[r]-=dl;} \
        _Pragma("unroll") for(int r=0;r<16;++r)negm[r]=-mhat; asm volatile("":"+v"(negm)); \
        const float f=__builtin_amdgcn_exp2f(-dl); l_reg*=f; if(hi==0)wsf[r32]=f; resc=true; } } \
    SBAR(); \
    GAPB(o[0]=__builtin_amdgcn_mfma_f32_32x32x16_bf16(PAF(0),VFR(0),o[0],0,0,0), C0,0); \
    GAPB(o[1]=__builtin_amdgcn_mfma_f32_32x32x16_bf16(PAF(0),VFR(4),o[1],0,0,0), C0,4); \
    KRD(GL,0); GAPB(o[0]=__builtin_amdgcn_mfma_f32_32x32x16_bf16(PAF(1),VFR(1),o[0],0,0,0), C0,8); \
    KRD(GL,1); GAPB(o[1]=__builtin_amdgcn_mfma_f32_32x32x16_bf16(PAF(1),VFR(5),o[1],0,0,0), C0,12); \
    KRD(GL,2); GAPB(o[0]=__builtin_amdgcn_mfma_f32_32x32x16_bf16(PAF(2),VFR(2),o[0],0,0,0), C1,0); \
    KRD(GL,3); GAPB(o[1]=__builtin_amdgcn_mfma_f32_32x32x16_bf16(PAF(2),VFR(6),o[1],0,0,0), C1,4); \
    GAPB(o[0]=__builtin_amdgcn_mfma_f32_32x32x16_bf16(PAF(3),VFR(3),o[0],0,0,0), C1,8); \
    GAPB(o[1]=__builtin_amdgcn_mfma_f32_32x32x16_bf16(PAF(3),VFR(7),o[1],0,0,0), C1,12); \
    }while(0)
  int t=1;
  #undef CMASK
  #define CMASK(P0,P1,t) do{}while(0)
  for(;t+5<NT;t+=2){
    STEP(pB0,pB1,pA0,pA1,t,true,true,true);     WAIT_BAR(2); RESC(); ROT();
    STEP(pA0,pA1,pB0,pB1,t+1,true,true,true);   WAIT_BAR(2); RESC(); ROT();
  }
  #define ENDW(tt) do{ if((tt)+3<NT){WAIT_BAR(2);} else if((tt)+2<NT){WAIT_BAR(1);} else {WAIT_BAR(0);} }while(0)
  for(;t+1<NT;t+=2){
    STEP(pB0,pB1,pA0,pA1,t,(t+3<NT),(t+1<NT),(t+1<NT));       ENDW(t);   RESC(); ROT();
    STEP(pA0,pA1,pB0,pB1,t+1,(t+4<NT),(t+2<NT),(t+2<NT));     ENDW(t+1); RESC(); ROT();
  }
  STEP(pB0,pB1,pA0,pA1,NT-1,false,false,false); RESC();
  { float sacc=pB0[0]+pB0[1]; _Pragma("unroll") for(int r=2;r<16;++r)sacc+=pB0[r]; _Pragma("unroll") for(int r=0;r<16;++r)sacc+=pB1[r]; l_reg+=sacc;
    pw0=(u32x4){PKW(pB0,0),PKW(pB0,2),PKW(pB0,4),PKW(pB0,6)};pw1=(u32x4){PKW(pB0,8),PKW(pB0,10),PKW(pB0,12),PKW(pB0,14)};pw2=(u32x4){PKW(pB1,0),PKW(pB1,2),PKW(pB1,4),PKW(pB1,6)};pw3=(u32x4){PKW(pB1,8),PKW(pB1,10),PKW(pB1,12),PKW(pB1,14)};
    SBAR(); pv(o,vb0+sl_cur,PAF(0),PAF(1),PAF(2),PAF(3)); }
  #undef PKW
  #undef PAF
  #undef VFR
  #undef PIN
  #undef MX3
  #undef GAPA
  #undef GAPB
  #undef EX
  #undef VRD
  #undef KRD
  #undef STEP
  #undef ENDW
  {auto rr=__builtin_amdgcn_permlane32_swap(__float_as_uint(l_reg),__float_as_uint(l_reg),false,false);l_reg=__uint_as_float(rr[0])+__uint_as_float(rr[1]);}
  if(hi==0)wsf[32+r32]=l_reg;asm volatile("s_waitcnt lgkmcnt(0)":::"memory");
  float rli[16];
  #pragma unroll
  for(int r=0;r<16;++r)rli[r]=__builtin_amdgcn_rcpf(wsf[32+crow(r,hi)]);
  bf16*Ow=O+(rowbase+q0+wid*QBLK)*PO+h*D;
  { bf16*stg=(bf16*)(shm+LDS_OST)+wid*2048;
    #pragma unroll
    for(int r=0;r<16;++r){const int orow=crow(r,hi);
      #pragma unroll
      for(int d0=0;d0<2;++d0)stg[orow*64+d0*32+r32]=__float2bfloat16(o[d0][r]*rli[r]);}
    asm volatile("s_waitcnt lgkmcnt(0)":::"memory");
    #pragma unroll
    for(int i=0;i<4;++i){const int row=i*8+(lane>>3),ch=lane&7; const u32x4 v=*(const u32x4*)(stg+row*64+ch*8); ATTN_STORE16(Ow+(long)row*PO+ch*8,v);} }
  asm volatile("s_waitcnt lgkmcnt(0)\n\ts_barrier":::"memory");
  #undef DMA_K
  #undef DMA_V
  #undef CMASK
  #undef START
  #undef RESC
  #undef ROT
}
constexpr int ATTN_LDS_BYTES=LDS_BYTES;
#undef SBAR
#undef WAIT_BAR
}

__device__ __forceinline__ void phase_attn(const Params& p, char* lds) {
            {
                const int bid = obid();
                const int vcu = ((NBLK & 7) == 0) ? (bid & 7) * (int)(NBLK >> 3) + (bid >> 3) : bid;
                const attn_body::bf16* qkvb = (const attn_body::bf16*)(p.ws + R_QKV);
                for (int u = vcu; u < 512; u += NBLK) {
                    const int bg = (u & 255) >> 6, r = u & 63, hh = r & 3, qb = (r >> 2) + 16 * (u >> 8);
                    const int b = bg >> 1, g = bg & 1;
                    attn_body::attn_unit<8>(b, 4 * g + hh, g, qb, qkvb, qkvb + 512, qkvb + 640, (attn_body::bf16*)(p.ws + R_ATT), lds);
                }
            }
}

__device__ __forceinline__ f32x4 convd4(const float* row, int l0, float w0, float w1, float w2, float cb) {
    const f32x4 c = *(const f32x4*)(row + l0);
    const float lft = (l0 > 0) ? row[l0 - 1] : 0.f;
    const float rgt = (l0 + 4 < SL) ? row[l0 + 4] : 0.f;
    f32x4 o;
    o.x = cb + w0 * lft + w1 * c.x + w2 * c.y;
    o.y = cb + w0 * c.x + w1 * c.y + w2 * c.z;
    o.z = cb + w0 * c.y + w1 * c.z + w2 * c.w;
    o.w = cb + w0 * c.z + w1 * c.w + w2 * rgt;
    return o;
}
__device__ __forceinline__ void cmul_kf(float2* Z, const float2* KF, int tid) {
#pragma unroll 4
    for (int i = 0; i < 16; ++i) {
        const int pp = 2 * tid + 1024 * i;
        const f32x4 z = *(const f32x4*)(Z + zp(pp)), k = *(const f32x4*)(KF + pp);
        f32x4 o; o.x = z.x * k.x - z.y * k.y; o.y = z.x * k.y + z.y * k.x; o.z = z.z * k.z - z.w * k.w; o.w = z.z * k.w + z.w * k.z;
        *(f32x4*)(Z + zp(pp)) = o;
    }
}
__device__ __forceinline__ void hyena_job(const Params& p, int layer, int c, char* lds) {
    const int tid = otid();
    float2* Z = (float2*)lds;
    const float* HF = (const float*)(p.ws + R_HF);
    const float* cw = p.in[I_CW] + (size_t)layer * 3 * 768; const float* cbp = p.in[I_CB] + layer * 768;
    const float2* KF0 = (const float2*)(p.ws + OFF_KF) + ((size_t)(layer * 256 + c) * 2) * 16384;
    const float2* KF1 = KF0 + 16384;
    float* Y = (float*)(p.ws + R_Y) + (size_t)c * T;
    const float bias0 = p.in[I_HB][(layer * 2 + 0) * 256 + c], bias1 = p.in[I_HB][(layer * 2 + 1) * 256 + c];
    const int cv = c, c1 = 256 + c, c2 = 512 + c;
    const float* rv = HF + (size_t)cv * T; const float* r1 = HF + (size_t)c1 * T; const float* r2 = HF + (size_t)c2 * T;
    const float v_w0 = cw[cv], v_w1 = cw[768 + cv], v_w2 = cw[1536 + cv], v_cb = cbp[cv];
    const float a_w0 = cw[c1], a_w1 = cw[768 + c1], a_w2 = cw[1536 + c1], a_cb = cbp[c1];
    const float b_w0 = cw[c2], b_w1 = cw[768 + c2], b_w2 = cw[1536 + c2], b_cb = cbp[c2];
    const f32x4 zero4 = {0.f, 0.f, 0.f, 0.f};
    __syncthreads();
#pragma unroll 1
    for (int i = 0; i < 4; ++i) {
        const int l0 = 4 * otid() + 2048 * i;
        const f32x4 va = convd4(rv, l0, v_w0, v_w1, v_w2, v_cb), vb = convd4(rv + SL, l0, v_w0, v_w1, v_w2, v_cb);
        *(f32x4*)(Z + zp(l0)) = (f32x4){va.x, vb.x, va.y, vb.y}; *(f32x4*)(Z + zp(l0) + 2) = (f32x4){va.z, vb.z, va.w, vb.w};
        *(f32x4*)(Z + zp(8192 + l0)) = zero4; *(f32x4*)(Z + zp(8192 + l0) + 2) = zero4;
    }
    __syncthreads();
    fft16k_fwd(Z);
    cmul_kf(Z, KF0, otid());
    __syncthreads();
    fft16k_inv(Z);
#pragma unroll 1
    for (int i = 0; i < 4; ++i) {
        const int l0 = 4 * otid() + 2048 * i;
        const f32x4 za = *(const f32x4*)(Z + zp(l0)), zb = *(const f32x4*)(Z + zp(l0) + 2);
        const f32x4 va = convd4(rv, l0, v_w0, v_w1, v_w2, v_cb), vb = convd4(rv + SL, l0, v_w0, v_w1, v_w2, v_cb);
        const f32x4 ga = convd4(r1, l0, a_w0, a_w1, a_w2, a_cb), gb = convd4(r1 + SL, l0, a_w0, a_w1, a_w2, a_cb);
        f32x4 ya, yb;
        ya.x = ga.x * (za.x + va.x * bias0); ya.y = ga.y * (za.z + va.y * bias0); ya.z = ga.z * (zb.x + va.z * bias0); ya.w = ga.w * (zb.z + va.w * bias0);
        yb.x = gb.x * (za.y + vb.x * bias0); yb.y = gb.y * (za.w + vb.y * bias0); yb.z = gb.z * (zb.y + vb.z * bias0); yb.w = gb.w * (zb.w + vb.w * bias0);
        *(f32x4*)(Y + l0) = ya; *(f32x4*)(Y + SL + l0) = yb;
        *(f32x4*)(Z + zp(l0)) = (f32x4){ya.x, yb.x, ya.y, yb.y}; *(f32x4*)(Z + zp(l0) + 2) = (f32x4){ya.z, yb.z, ya.w, yb.w};
        *(f32x4*)(Z + zp(8192 + l0)) = zero4; *(f32x4*)(Z + zp(8192 + l0) + 2) = zero4;
    }
    __syncthreads();
    fft16k_fwd(Z);
    cmul_kf(Z, KF1, otid());
    __syncthreads();
    fft16k_inv(Z);
#pragma unroll 1
    for (int i = 0; i < 4; ++i) {
        const int l0 = 4 * otid() + 2048 * i;
        const f32x4 za = *(const f32x4*)(Z + zp(l0)), zb = *(const f32x4*)(Z + zp(l0) + 2);
        const f32x4 ga = convd4(r2, l0, b_w0, b_w1, b_w2, b_cb), gb = convd4(r2 + SL, l0, b_w0, b_w1, b_w2, b_cb);
        const f32x4 pa = *(const f32x4*)(Y + l0), pb = *(const f32x4*)(Y + SL + l0);
        f32x4 ya, yb;
        ya.x = ga.x * (za.x + pa.x * bias1); ya.y = ga.y * (za.z + pa.y * bias1); ya.z = ga.z * (zb.x + pa.z * bias1); ya.w = ga.w * (zb.z + pa.w * bias1);
        yb.x = gb.x * (za.y + pb.x * bias1); yb.y = gb.y * (za.w + pb.y * bias1); yb.z = gb.z * (zb.y + pb.z * bias1); yb.w = gb.w * (zb.w + pb.w * bias1);
        *(f32x4*)(Y + l0) = ya; *(f32x4*)(Y + SL + l0) = yb;
    }
    __syncthreads();
}

__device__ __forceinline__ void fnet_job(const Params& p, int ch, char* lds) {
    const int tid = otid();
    float2* Z = (float2*)lds;
    const float* row = (const float*)(p.ws + R_HF) + (size_t)(768 + ch) * T;
    float* UR = (float*)(p.ws + R_UR) + (size_t)ch * T;
    float* UI = (float*)(p.ws + R_UI) + (size_t)ch * T;
    __syncthreads();
#pragma unroll
    for (int i = 0; i < 4; ++i) {
        const int l0 = 4 * tid + 2048 * i;
        const f32x4 a = *(const f32x4*)(row + l0), b = *(const f32x4*)(row + SL + l0);
        const int z0 = zp(l0);
        *(f32x4*)(Z + z0) = (f32x4){a.x, b.x, a.y, b.y}; *(f32x4*)(Z + z0 + 2) = (f32x4){a.z, b.z, a.w, b.w};
    }
    __syncthreads();
    fft8k_fwd(Z);
#pragma unroll
    for (int i = 0; i < 4; ++i) {
        const int k0 = 4 * tid + 2048 * i;
        f32x4 ur0, ui0, ur1, ui1;
#pragma unroll
        for (int e = 0; e < 4; ++e) {
            const int k = k0 + e;
            const int pk = p8k_of_f(k);
            const int pm = p8k_of_f((SL - k) & (SL - 1));
            const float2 zk = Z[zp(pk)], zm = Z[zp(pm)];
            ur0[e] = 0.5f * (zk.x + zm.x); ui0[e] = 0.5f * (zk.y - zm.y);
            ur1[e] = 0.5f * (zk.y + zm.y); ui1[e] = 0.5f * (zm.x - zk.x);
        }
        *(f32x4*)(UR + k0) = ur0; *(f32x4*)(UI + k0) = ui0; *(f32x4*)(UR + SL + k0) = ur1; *(f32x4*)(UI + SL + k0) = ui1;
    }
    __syncthreads();
}

__device__ __forceinline__ void phase_mix(const Params& p, int layer, char* lds) {
    const int tid = otid(), lane = tid & 63, wave = tid >> 6;
    const int l31 = lane & 31, hl = lane >> 5, g = wave & 3, tsel = wave >> 2;
    float* ex = (float*)lds;
    const float* UR = (const float*)(p.ws + R_UR); const float* UI = (const float*)(p.ws + R_UI);
    const float* Y = (const float*)(p.ws + R_Y);
    const bf16_t* att = (const bf16_t*)(p.ws + R_ATT);
    bf16_t* mix = (bf16_t*)(p.ws + R_MIX);
    const float* FMg = (const float*)(p.ws + OFF_FM) + ((size_t)layer * 4 + g) * 128 * 64;
    const float* fb = p.in[I_FB] + layer * 256 + g * 64;
    const float* mg = p.in[I_MG] + layer * 1024;
    for (int tp = obid(); tp < T / 64; tp += NBLK) {
        const int t = (tp * 2 + tsel) * 32 + l31;
        f32x16 acc0 = zero16(), acc1 = zero16();
        {
            const float* ub = UR + (size_t)(g * 64 + hl) * T + t;
            const float* fa = FMg + hl * 64 + l31;
#pragma unroll 16
            for (int dd0 = 0; dd0 < 64; dd0 += 2) {
                const float bv = ub[(size_t)dd0 * T];
                const float a0 = fa[dd0 * 64], a1 = fa[dd0 * 64 + 32];
                acc0 = __builtin_amdgcn_mfma_f32_32x32x2f32(a0, bv, acc0, 0, 0, 0);
                acc1 = __builtin_amdgcn_mfma_f32_32x32x2f32(a1, bv, acc1, 0, 0, 0);
            }
            const float* ub2 = UI + (size_t)(g * 64 + hl) * T + t;
            const float* fa2 = FMg + (64 + hl) * 64 + l31;
#pragma unroll 16
            for (int dd0 = 0; dd0 < 64; dd0 += 2) {
                const float bv = ub2[(size_t)dd0 * T];
                const float a0 = fa2[dd0 * 64], a1 = fa2[dd0 * 64 + 32];
                acc0 = __builtin_amdgcn_mfma_f32_32x32x2f32(a0, bv, acc0, 0, 0, 0);
                acc1 = __builtin_amdgcn_mfma_f32_32x32x2f32(a1, bv, acc1, 0, 0, 0);
            }
        }
        float sf = 0.f;
#pragma unroll
        for (int i = 0; i < 4; ++i) {
            const f32x4 b0 = *(const f32x4*)(fb + 8 * i + 4 * hl), b1 = *(const f32x4*)(fb + 32 + 8 * i + 4 * hl);
            acc0[4 * i] += b0.x; acc0[4 * i + 1] += b0.y; acc0[4 * i + 2] += b0.z; acc0[4 * i + 3] += b0.w;
            acc1[4 * i] += b1.x; acc1[4 * i + 1] += b1.y; acc1[4 * i + 2] += b1.z; acc1[4 * i + 3] += b1.w;
        }
#pragma unroll
        for (int r = 0; r < 16; ++r) sf += acc0[r] * acc0[r] + acc1[r] * acc1[r];
        float sy = 0.f;
        const float* yb = Y + (size_t)(g * 64 + hl * 32) * T + t;
#pragma unroll 32
        for (int i = 0; i < 32; ++i) { const float y = yb[(size_t)i * T]; sy += y * y; }
        float sa = 0.f;
        const bf16_t* ab = att + (size_t)t * 512 + g * 128 + hl * 64;
#pragma unroll 4
        for (int q = 0; q < 8; ++q) {
            const u32x4 a = *(const u32x4*)(ab + 8 * q);
            const float x0 = bflo(a.x), x1 = bfhi(a.x), x2 = bflo(a.y), x3 = bfhi(a.y), x4 = bflo(a.z), x5 = bfhi(a.z), x6 = bflo(a.w), x7 = bfhi(a.w);
            sa += x0 * x0 + x1 * x1 + x2 * x2 + x3 * x3 + x4 * x4 + x5 * x5 + x6 * x6 + x7 * x7;
        }
        __syncthreads();
        ex[(0 * 8 + wave) * 64 + lane] = sa; ex[(1 * 8 + wave) * 64 + lane] = sy; ex[(2 * 8 + wave) * 64 + lane] = sf;
        __syncthreads();
        float ta = 0.f, ty = 0.f, tf = 0.f;
#pragma unroll
        for (int w = 0; w < 4; ++w)
#pragma unroll
            for (int hh = 0; hh < 2; ++hh) {
                const int o = (tsel * 4 + w) * 64 + hh * 32 + l31;
                ta += ex[0 * 512 + o]; ty += ex[1 * 512 + o]; tf += ex[2 * 512 + o];
            }
        const float ra = rsqrtf(ta * (1.0f / 512.0f) + EPS), ry = rsqrtf(ty * (1.0f / 256.0f) + EPS), rf = rsqrtf(tf * (1.0f / 256.0f) + EPS);
        bf16_t* mrow = mix + (size_t)t * 1024;
        {
            const float* gg = mg + g * 128 + hl * 64;
#pragma unroll 4
            for (int q = 0; q < 8; ++q) {
                const u32x4 a = *(const u32x4*)(ab + 8 * q);
                const f32x4 g0 = *(const f32x4*)(gg + 8 * q), g1 = *(const f32x4*)(gg + 8 * q + 4);
                u32x4 o;
                o.x = pk2(bflo(a.x) * ra * g0.x, bfhi(a.x) * ra * g0.y); o.y = pk2(bflo(a.y) * ra * g0.z, bfhi(a.y) * ra * g0.w);
                o.z = pk2(bflo(a.z) * ra * g1.x, bfhi(a.z) * ra * g1.y); o.w = pk2(bflo(a.w) * ra * g1.z, bfhi(a.w) * ra * g1.w);
                *(u32x4*)(mrow + g * 128 + hl * 64 + 8 * q) = o;
            }
        }
        {
            const float* gg = mg + 512 + g * 64 + hl * 32;
#pragma unroll 2
            for (int q = 0; q < 4; ++q) {
                float yv[8];
#pragma unroll
                for (int i = 0; i < 8; ++i) yv[i] = yb[(size_t)(8 * q + i) * T];
                const f32x4 g0 = *(const f32x4*)(gg + 8 * q), g1 = *(const f32x4*)(gg + 8 * q + 4);
                u32x4 o;
                o.x = pk2(yv[0] * ry * g0.x, yv[1] * ry * g0.y); o.y = pk2(yv[2] * ry * g0.z, yv[3] * ry * g0.w);
                o.z = pk2(yv[4] * ry * g1.x, yv[5] * ry * g1.y); o.w = pk2(yv[6] * ry * g1.z, yv[7] * ry * g1.w);
                *(u32x4*)(mrow + 512 + g * 64 + hl * 32 + 8 * q) = o;
            }
        }
        {
            const float* gg = mg + 768 + g * 64;
#pragma unroll
            for (int i = 0; i < 4; ++i) {
                const f32x4 g0 = *(const f32x4*)(gg + 8 * i + 4 * hl), g1 = *(const f32x4*)(gg + 32 + 8 * i + 4 * hl);
                u32x2 o0, o1;
                o0.x = pk2(acc0[4 * i] * rf * g0.x, acc0[4 * i + 1] * rf * g0.y); o0.y = pk2(acc0[4 * i + 2] * rf * g0.z, acc0[4 * i + 3] * rf * g0.w);
                o1.x = pk2(acc1[4 * i] * rf * g1.x, acc1[4 * i + 1] * rf * g1.y); o1.y = pk2(acc1[4 * i + 2] * rf * g1.z, acc1[4 * i + 3] * rf * g1.w);
                *(u32x2*)(mrow + 768 + g * 64 + 8 * i + 4 * hl) = o0;
                *(u32x2*)(mrow + 768 + g * 64 + 32 + 8 * i + 4 * hl) = o1;
            }
        }
    }
}

#define TK_INS(L, X) do { float x_ = (X); _Pragma("unroll") for (int i_ = 0; i_ < 16; ++i_) { const float hi_ = fmaxf(L[i_], x_); x_ = fminf(L[i_], x_); L[i_] = hi_; } } while (0)
__device__ __forceinline__ float tk_pack(float v, unsigned code, unsigned mask) { return __builtin_bit_cast(float, (__builtin_bit_cast(unsigned, v) & ~mask) | code); }
__device__ __forceinline__ unsigned tk_lookup(const unsigned (&P)[4], unsigned i) {
    const unsigned w = (i < 4u) ? P[0] : (i < 8u) ? P[1] : (i < 12u) ? P[2] : P[3];
    return (w >> ((i & 3u) * 8u)) & 0x7Fu;
}
__device__ __forceinline__ void phase_peer_topk(const Params& p, int layer, char* lds, int* IDX, float* GATE) {
    const int tid = otid(), lane = tid & 63, wave = tid >> 6;
    const float* SC = (const float*)(p.ws + R_QP);
    const float NINF = -3.0e38f;
    const int pp = lane & 1;
    const int gw = obid() * NWAVE + wave, ngw = NBLK * NWAVE;
    for (int grp = gw; grp < T * 8 / 32; grp += ngw) {
        const int prob = grp * 32 + (lane >> 1);
        const int t = prob >> 3, h = prob & 7;
        const f32x4* src = (const f32x4*)(SC + (size_t)t * 2048 + h * 256 + pp * 128);
        float l[16];
#pragma unroll
        for (int i = 0; i < 16; ++i) l[i] = NINF;
#pragma unroll 1
        for (int c = 0; c < 4; ++c) {
            f32x4 v[8];
#pragma unroll
            for (int j = 0; j < 8; ++j) v[j] = src[c * 8 + j];
#pragma unroll
            for (int j = 0; j < 8; ++j) {
                const unsigned kb = (unsigned)(c * 32 + j * 4);
                TK_INS(l, tk_pack(v[j].x, kb, 0x7Fu)); TK_INS(l, tk_pack(v[j].y, kb + 1u, 0x7Fu));
                TK_INS(l, tk_pack(v[j].z, kb + 2u, 0x7Fu)); TK_INS(l, tk_pack(v[j].w, kb + 3u, 0x7Fu));
            }
        }
        float xv[16], ov[16]; unsigned PX[4] = {0u, 0u, 0u, 0u}, PO[4] = {0u, 0u, 0u, 0u};
#pragma unroll
        for (int i = 0; i < 16; ++i) {
            const float o = __shfl_xor(l[i], 1);
            const unsigned xb = __builtin_bit_cast(unsigned, l[i]), ob = __builtin_bit_cast(unsigned, o);
            xv[i] = __builtin_bit_cast(float, xb & ~0x7Fu); ov[i] = __builtin_bit_cast(float, ob & ~0x7Fu);
            PX[i >> 2] |= (xb & 0x7Fu) << ((i & 3) * 8); PO[i >> 2] |= (ob & 0x7Fu) << ((i & 3) * 8);
        }
        float f[16];
#pragma unroll
        for (int i = 0; i < 16; ++i) f[i] = NINF;
#pragma unroll
        for (int i = 0; i < 16; ++i)
#pragma unroll
            for (int j = i; j < 16; ++j)
                if ((i + 1) * (j + 1) <= 16) {
                    float cv = xv[i] + ov[j];
                    const unsigned code = pp ? (unsigned)((j << 4) | i) : (unsigned)((i << 4) | j);
                    cv = tk_pack(cv, code, 0xFFu);
                    if (i == j) cv = pp ? NINF : cv;
                    TK_INS(f, cv);
                }
        {
            float g[16];
#pragma unroll
            for (int i = 0; i < 16; ++i) g[i] = __shfl_xor(f[i], 1);
#pragma unroll
            for (int i = 0; i < 16; ++i) TK_INS(f, g[i]);
        }
        unsigned P0[4], P1[4];
#pragma unroll
        for (int q = 0; q < 4; ++q) { P0[q] = pp ? PO[q] : PX[q]; P1[q] = pp ? PX[q] : PO[q]; }
        const float top = __builtin_bit_cast(float, __builtin_bit_cast(unsigned, f[0]) & ~0xFFu);
        float ev[16]; int ei[16]; float den = 0.f;
#pragma unroll
        for (int r = 0; r < 16; ++r) {
            const unsigned fb = __builtin_bit_cast(unsigned, f[r]);
            const unsigned code = fb & 0xFFu;
            ei[r] = (int)(tk_lookup(P0, code >> 4) * 128u + tk_lookup(P1, code & 15u));
            ev[r] = __expf(__builtin_bit_cast(float, fb & ~0xFFu) - top);
            den += ev[r];
        }
        const float rden = 1.0f / den;
        const size_t ob = (size_t)t * 2048 + h * 16;
        if (pp == 0) {
#pragma unroll
            for (int q = 0; q < 4; ++q) { int4 w; w.x = ei[4 * q]; w.y = ei[4 * q + 1]; w.z = ei[4 * q + 2]; w.w = ei[4 * q + 3]; *(int4*)(IDX + ob + 4 * q) = w; }
        } else {
#pragma unroll
            for (int q = 0; q < 4; ++q) { f32x4 w; w.x = ev[4 * q] * rden; w.y = ev[4 * q + 1] * rden; w.z = ev[4 * q + 2] * rden; w.w = ev[4 * q + 3] * rden; *(f32x4*)(GATE + ob + 128 + 4 * q) = w; }
        }
    }
}

__device__ __forceinline__ float gelu_exact(float x) { return 0.5f * x * (1.0f + erff(x * 0.70710678118654752f)); }
typedef float f32x2 __attribute__((ext_vector_type(2)));
#define CVT_LO(W) __builtin_amdgcn_cvt_pk_f32_fp8((int)(W), false)
#define CVT_HI(W) __builtin_amdgcn_cvt_pk_f32_fp8((int)(W), true)
template <bool DRY, int EMASK = 16383> __device__ __forceinline__ void phase_peer_gather(const Params& p, int layer) {
    const int lane = otid() & 63, wave = otid() >> 6;
    const int gw = obid() * NWAVE + wave, ngw = NBLK * NWAVE;
    const unsigned char* PU = p.ws + OFF_PU + (size_t)layer * 16384 * 1024;
    const unsigned char* PV = p.ws + OFF_PV + (size_t)layer * 16384 * 1024;
    const float* SU = (const float*)(p.ws + OFF_PSC) + (size_t)layer * 16384;
    const float* SV = (const float*)(p.ws + OFF_PSC) + (size_t)(2 + layer) * 16384;
    bf16_t* XN = (bf16_t*)(p.ws + R_XN);
    float* XA = (float*)(p.ws + OFF_XA);
    const float* SC = (const float*)(p.ws + R_QP);
    const bool last = (layer == NLAYER - 1);
    const float* gnext = last ? p.in[I_FG] : p.in[I_N1G] + (layer + 1) * DM;
    const bool b5 = (lane & 32) != 0, b4 = (lane & 16) != 0, b3 = (lane & 8) != 0;
    const unsigned loff = (unsigned)lane * 16u;
    for (int t = gw; t < T; t += ngw) {
        f32x2 xv[8];
#pragma unroll
        for (int j = 0; j < 4; ++j) {
            const u32x2 a = *(const u32x2*)(XN + (size_t)t * DM + 4 * lane + 256 * j);
            xv[2 * j] = (f32x2){bflo(a.x), bfhi(a.x)}; xv[2 * j + 1] = (f32x2){bflo(a.y), bfhi(a.y)};
        }
        f32x2 acc[8];
#pragma unroll
        for (int j = 0; j < 8; ++j) acc[j] = (f32x2){0.f, 0.f};
        const int* idxp = (const int*)(SC + (size_t)t * 2048);
        const float* gatep = SC + (size_t)t * 2048 + 128;
#pragma unroll 1
        for (int half = 0; half < 2; ++half) {
            const int myi = idxp[half * 64 + lane] & EMASK;
            const float mycu = SU[myi];
            const float mycg = gatep[half * 64 + lane] * SV[myi];
#pragma unroll 1
            for (int e0 = 0; e0 < 64; e0 += 8) {
                u32x4 ur[8], vr[8];
#pragma unroll
                for (int k = 0; k < 8; ++k) {
                    const unsigned e = (unsigned)__builtin_amdgcn_readlane(myi, e0 + k);
                    ur[k] = *(const u32x4*)(PU + (size_t)(e * 1024u) + loff);
                    vr[k] = *(const u32x4*)(PV + (size_t)(e * 1024u) + loff);
                }
                float d[8];
#pragma unroll
                for (int k = 0; k < 8; ++k) {
                    f32x2 s2 = CVT_LO(ur[k].x) * xv[0];
                    s2 += CVT_HI(ur[k].x) * xv[1]; s2 += CVT_LO(ur[k].y) * xv[2]; s2 += CVT_HI(ur[k].y) * xv[3];
                    s2 += CVT_LO(ur[k].z) * xv[4]; s2 += CVT_HI(ur[k].z) * xv[5]; s2 += CVT_LO(ur[k].w) * xv[6]; s2 += CVT_HI(ur[k].w) * xv[7];
                    d[k] = s2.x + s2.y;
                }
                float r4[4], r2[2], u1;
#pragma unroll
                for (int k = 0; k < 4; ++k) { const float send = b5 ? d[k] : d[k + 4], keep = b5 ? d[k + 4] : d[k]; r4[k] = keep + __shfl_xor(send, 32); }
#pragma unroll
                for (int k = 0; k < 2; ++k) { const float send = b4 ? r4[k] : r4[k + 2], keep = b4 ? r4[k + 2] : r4[k]; r2[k] = keep + __shfl_xor(send, 16); }
                { const float send = b3 ? r2[0] : r2[1], keep = b3 ? r2[1] : r2[0]; u1 = keep + __shfl_xor(send, 8); }
                u1 += __shfl_xor(u1, 4); u1 += __shfl_xor(u1, 2); u1 += __shfl_xor(u1, 1);
                const int kk = e0 + (lane >> 3);
                const float av = gelu_exact(u1 * __shfl(mycu, kk)) * __shfl(mycg, kk);
#pragma unroll
                for (int k = 0; k < 8; ++k) {
                    const float a = __builtin_bit_cast(float, __builtin_amdgcn_readlane(__builtin_bit_cast(int, av), 8 * k));
                    const f32x2 a2 = (f32x2){a, a};
                    acc[0] += a2 * CVT_LO(vr[k].x); acc[1] += a2 * CVT_HI(vr[k].x); acc[2] += a2 * CVT_LO(vr[k].y); acc[3] += a2 * CVT_HI(vr[k].y);
                    acc[4] += a2 * CVT_LO(vr[k].z); acc[5] += a2 * CVT_HI(vr[k].z); acc[6] += a2 * CVT_LO(vr[k].w); acc[7] += a2 * CVT_HI(vr[k].w);
                }
            }
        }
        f32x4 x[4]; float ss = 0.f;
#pragma unroll
        for (int j = 0; j < 4; ++j) {
            x[j] = *(const f32x4*)(XA + (size_t)t * DM + 4 * lane + 256 * j);
            x[j].x += acc[2 * j].x; x[j].y += acc[2 * j].y; x[j].z += acc[2 * j + 1].x; x[j].w += acc[2 * j + 1].y;
            ss += x[j].x * x[j].x + x[j].y * x[j].y + x[j].z * x[j].z + x[j].w * x[j].w;
        }
        ss = wave_sum(ss);
        const float r = rsqrtf(ss * (1.0f / DM) + EPS);
        if (last) {
#pragma unroll
            for (int j = 0; j < 4; ++j) { const f32x4 gg = *(const f32x4*)(gnext + 4 * lane + 256 * j); *(f32x4*)(p.out + (size_t)t * DM + 4 * lane + 256 * j) = x[j] * r * gg; }
        } else {
#pragma unroll
            for (int j = 0; j < 4; ++j) {
                const f32x4 gg = *(const f32x4*)(gnext + 4 * lane + 256 * j);
                *(f32x4*)((DRY ? p.out : XA) + (size_t)t * DM + 4 * lane + 256 * j) = x[j];
                u32x2 w; w.x = pk2(x[j].x * r * gg.x, x[j].y * r * gg.y); w.y = pk2(x[j].z * r * gg.z, x[j].w * r * gg.w);
                if (!DRY) *(u32x2*)(XN + (size_t)t * DM + 4 * lane + 256 * j) = w;
            }
        }
    }
}


template <int CTRL> __device__ __forceinline__ float dpp_f(float v) { return __builtin_bit_cast(float, __builtin_amdgcn_update_dpp(0, __builtin_bit_cast(int, v), CTRL, 0xF, 0xF, false)); }
#ifndef PE_NTK
#define PE_NTK 2
#endif
#ifndef PE_PASS_SYNC
#define PE_PASS_SYNC 0
#endif
constexpr int PE_ENT = 12 * 1024;
#ifndef PE_LOGR
#define PE_LOGR 4
#endif
constexpr int PE_NR = 1 << PE_LOGR, PE_STS = 40;
constexpr int PE_WAVE = PE_ENT + 8 * PE_STS * 4;
#define PE_TOKEN_CHUNK(TK) do { \
    const int s_ = st[(sr * PE_NTK + (TK)) * PE_STS + r], e_ = st[(sr * PE_NTK + (TK)) * PE_STS + r + 1]; \
    for (int pos = s_; pos < e_; pos += 8) { \
        const int n = (e_ - pos < 8) ? (e_ - pos) : 8; \
        const int ei_ = pos + eid; \
        const bool ok_ = eid < n; \
        const int base_ = ((sr * PE_NTK + (TK)) * 128 + (ok_ ? ei_ : pos)) * 3; \
        const int ev = ent[base_]; const float cu = __builtin_bit_cast(float, ent[base_ + 1]), cg = __builtin_bit_cast(float, ent[base_ + 2]); \
        f32x2 xl[8]; \
        _Pragma("unroll") for (int j = 0; j < 4; ++j) { xl[2 * j] = (f32x2){bflo(xp[TK][j].x), bfhi(xp[TK][j].x)}; xl[2 * j + 1] = (f32x2){bflo(xp[TK][j].y), bfhi(xp[TK][j].y)}; } \
        u32x4 ur[8], vr[8]; \
        _Pragma("unroll") for (int k = 0; k < 8; ++k) { \
            if (k < n) { const unsigned e = (unsigned)__builtin_amdgcn_readlane(ev, ((k & 4) << 1) | ((k & 2) << 3) | ((k & 1) << 5)); \
                ur[k] = *(const u32x4*)(PU + (size_t)(e * 1024u) + loff); vr[k] = *(const u32x4*)(PV + (size_t)(e * 1024u) + loff); } \
            else { ur[k] = (u32x4){0u, 0u, 0u, 0u}; vr[k] = (u32x4){0u, 0u, 0u, 0u}; } } \
        float d[8]; \
        _Pragma("unroll") for (int k = 0; k < 8; ++k) { \
            if (k < n) { f32x2 s2 = CVT_LO(ur[k].x) * xl[0]; \
                s2 += CVT_HI(ur[k].x) * xl[1]; s2 += CVT_LO(ur[k].y) * xl[2]; s2 += CVT_HI(ur[k].y) * xl[3]; \
                s2 += CVT_LO(ur[k].z) * xl[4]; s2 += CVT_HI(ur[k].z) * xl[5]; s2 += CVT_LO(ur[k].w) * xl[6]; s2 += CVT_HI(ur[k].w) * xl[7]; \
                d[k] = s2.x + s2.y; } else d[k] = 0.f; } \
        _Pragma("unroll") for (int k = 0; k < 8; ++k) { d[k] += dpp_f<0xB1>(d[k]); d[k] += dpp_f<0x4E>(d[k]); d[k] += dpp_f<0x141>(d[k]); }     \
        float r4[4], r2[2], u1; \
        _Pragma("unroll") for (int k = 0; k < 4; ++k) { const float send = b3 ? d[k] : d[k + 4], keep = b3 ? d[k + 4] : d[k]; r4[k] = keep + dpp_f<0x140>(send); } \
        _Pragma("unroll") for (int k = 0; k < 2; ++k) { const float send = b4 ? r4[k] : r4[k + 2], keep = b4 ? r4[k + 2] : r4[k]; r2[k] = keep + __shfl_xor(send, 16); } \
        { const float send = b5 ? r2[0] : r2[1], keep = b5 ? r2[1] : r2[0]; u1 = keep + __shfl_xor(send, 32); }     \
        const float av = ok_ ? gelu_exact(u1 * cu) * cg : 0.f; \
        _Pragma("unroll") for (int k = 0; k < 8; ++k) { \
            if (k < n) { const float a = __builtin_bit_cast(float, __builtin_amdgcn_readlane(__builtin_bit_cast(int, av), ((k & 4) << 1) | ((k & 2) << 3) | ((k & 1) << 5))); \
                const f32x2 a2 = (f32x2){a, a}; \
                acc[TK][0] += a2 * CVT_LO(vr[k].x); acc[TK][1] += a2 * CVT_HI(vr[k].x); acc[TK][2] += a2 * CVT_LO(vr[k].y); acc[TK][3] += a2 * CVT_HI(vr[k].y); \
                acc[TK][4] += a2 * CVT_LO(vr[k].z); acc[TK][5] += a2 * CVT_HI(vr[k].z); acc[TK][6] += a2 * CVT_LO(vr[k].w); acc[TK][7] += a2 * CVT_HI(vr[k].w); } } \
    } } while (0)

template <bool DRY> __device__ __forceinline__ void phase_peer_fused(const Params& p, int layer, char* lds) {
    const int tid = otid(), lane = tid & 63, wave = tid >> 6;
    const unsigned char* PU = p.ws + OFF_PU + (size_t)layer * 16384 * 1024;
    const unsigned char* PV = p.ws + OFF_PV + (size_t)layer * 16384 * 1024;
    const float* SU = (const float*)(p.ws + OFF_PSC) + (size_t)layer * 16384;
    const float* SV = (const float*)(p.ws + OFF_PSC) + (size_t)(2 + layer) * 16384;
    bf16_t* XN = (bf16_t*)(p.ws + R_XN);
    float* XA = (float*)(p.ws + OFF_XA);
    const float* SC = (const float*)(p.ws + R_QP);
    const bool last = (layer == NLAYER - 1);
    const float* gnext = last ? p.in[I_FG] : p.in[I_N1G] + (layer + 1) * DM;
    const float* g2p = p.in[I_N2G] + layer * DM;
    const bool b5 = (lane & 32) != 0, b4 = (lane & 16) != 0, b3 = (lane & 8) != 0;
    const int eid = ((lane >> 3) & 1) * 4 + ((lane >> 4) & 1) * 2 + (lane >> 5);
    const unsigned loff = (unsigned)lane * 16u;
    int* ent = (int*)(lds + wave * PE_WAVE);
    int* st = (int*)(lds + wave * PE_WAVE + PE_ENT);
    const float NINF = -3.0e38f;
    const int pp = lane & 1;
    for (int tb = (obid() * NWAVE + wave) * 8; tb < T; tb += NBLK * NWAVE * 8) {
#pragma unroll 1
        for (int grp = 0; grp < 2; ++grp) {
            const int tkl = grp * 4 + (lane >> 4), h = (lane >> 1) & 7;
            const f32x4* src = (const f32x4*)(SC + (size_t)(tb + tkl) * 2048 + h * 256 + pp * 128);
            float l[16];
#pragma unroll
            for (int i = 0; i < 16; ++i) l[i] = NINF;
#pragma unroll 1
            for (int c = 0; c < 4; ++c) {
                f32x4 v[8];
#pragma unroll
                for (int j = 0; j < 8; ++j) v[j] = src[c * 8 + j];
#pragma unroll
                for (int j = 0; j < 8; ++j) {
                    const unsigned kb = (unsigned)(c * 32 + j * 4);
                    TK_INS(l, tk_pack(v[j].x, kb, 0x7Fu)); TK_INS(l, tk_pack(v[j].y, kb + 1u, 0x7Fu));
                    TK_INS(l, tk_pack(v[j].z, kb + 2u, 0x7Fu)); TK_INS(l, tk_pack(v[j].w, kb + 3u, 0x7Fu));
                }
            }
            float xw[16], ow[16]; unsigned PX[4] = {0u, 0u, 0u, 0u}, PO[4] = {0u, 0u, 0u, 0u};
#pragma unroll
            for (int i = 0; i < 16; ++i) {
                const float o = __shfl_xor(l[i], 1);
                const unsigned xb = __builtin_bit_cast(unsigned, l[i]), ob = __builtin_bit_cast(unsigned, o);
                xw[i] = __builtin_bit_cast(float, xb & ~0x7Fu); ow[i] = __builtin_bit_cast(float, ob & ~0x7Fu);
                PX[i >> 2] |= (xb & 0x7Fu) << ((i & 3) * 8); PO[i >> 2] |= (ob & 0x7Fu) << ((i & 3) * 8);
            }
            float f[16];
#pragma unroll
            for (int i = 0; i < 16; ++i) f[i] = NINF;
#pragma unroll
            for (int i = 0; i < 16; ++i)
#pragma unroll
                for (int j = i; j < 16; ++j)
                    if ((i + 1) * (j + 1) <= 16) {
                        float cv = xw[i] + ow[j];
                        const unsigned code = pp ? (unsigned)((j << 4) | i) : (unsigned)((i << 4) | j);
                        cv = tk_pack(cv, code, 0xFFu);
                        if (i == j) cv = pp ? NINF : cv;
                        TK_INS(f, cv);
                    }
            {
                float gq[16];
#pragma unroll
                for (int i = 0; i < 16; ++i) gq[i] = __shfl_xor(f[i], 1);
#pragma unroll
                for (int i = 0; i < 16; ++i) TK_INS(f, gq[i]);
            }
            unsigned P0[4], P1[4];
#pragma unroll
            for (int q = 0; q < 4; ++q) { P0[q] = pp ? PO[q] : PX[q]; P1[q] = pp ? PX[q] : PO[q]; }
            const float top = __builtin_bit_cast(float, __builtin_bit_cast(unsigned, f[0]) & ~0xFFu);
            float ev[16]; float den = 0.f;
#pragma unroll
            for (int r = 0; r < 16; ++r) { ev[r] = __expf(__builtin_bit_cast(float, __builtin_bit_cast(unsigned, f[r]) & ~0xFFu) - top); den += ev[r]; }
            const float rden = 1.0f / den;
#pragma unroll
            for (int r8 = 0; r8 < 8; ++r8) {
                const unsigned c0 = __builtin_bit_cast(unsigned, f[r8]) & 0xFFu, c1 = __builtin_bit_cast(unsigned, f[r8 + 8]) & 0xFFu;
                const unsigned code = pp ? c1 : c0;
                const float gate = (pp ? ev[r8 + 8] : ev[r8]) * rden;
                const int e = (int)(tk_lookup(P0, code >> 4) * 128u + tk_lookup(P1, code & 15u));
                const int o = (tkl * 128 + h * 16 + pp * 8 + r8) * 3;
                ent[o] = e; ent[o + 1] = __builtin_bit_cast(int, SU[e]); ent[o + 2] = __builtin_bit_cast(int, gate * SV[e]);
            }
        }
#pragma unroll 1
        for (int tk = 0; tk < 8; ++tk) {
            int* et = ent + tk * 384;
            const int eA = et[lane * 3], uA = et[lane * 3 + 1], gA = et[lane * 3 + 2];
            const int eB = et[(64 + lane) * 3], uB = et[(64 + lane) * 3 + 1], gB = et[(64 + lane) * 3 + 2];
            const int rA = eA >> (14 - PE_LOGR), rB = eB >> (14 - PE_LOGR);
            int base = 0;
#pragma unroll 1
            for (int r = 0; r < PE_NR; ++r) {
                const unsigned long long mA = __ballot(rA == r), mB = __ballot(rB == r);
                const int cA = __popcll(mA);
                if (lane == 0) st[tk * PE_STS + r] = base;
                if (rA == r) { const int q = base + (int)__builtin_amdgcn_mbcnt_hi((unsigned)(mA >> 32), __builtin_amdgcn_mbcnt_lo((unsigned)mA, 0u)); et[q * 3] = eA; et[q * 3 + 1] = uA; et[q * 3 + 2] = gA; }
                if (rB == r) { const int q = base + cA + (int)__builtin_amdgcn_mbcnt_hi((unsigned)(mB >> 32), __builtin_amdgcn_mbcnt_lo((unsigned)mB, 0u)); et[q * 3] = eB; et[q * 3 + 1] = uB; et[q * 3 + 2] = gB; }
                base += cA + __popcll(mB);
            }
            if (lane == 0) st[tk * PE_STS + PE_NR] = base;
        }
#pragma unroll 1
        for (int sr = 0; sr < 8 / PE_NTK; ++sr) {
            u32x2 xp[PE_NTK][4]; f32x2 acc[PE_NTK][8];
#pragma unroll
            for (int tk = 0; tk < PE_NTK; ++tk) {
                f32x4 xr[4]; float ss = 0.f;
#pragma unroll
                for (int j = 0; j < 4; ++j) { xr[j] = *(const f32x4*)(XA + (size_t)(tb + sr * PE_NTK + tk) * DM + 4 * lane + 256 * j); ss += xr[j].x * xr[j].x + xr[j].y * xr[j].y + xr[j].z * xr[j].z + xr[j].w * xr[j].w; }
                ss = wave_sum(ss);
                const float rn = rsqrtf(ss * (1.0f / DM) + EPS);
#pragma unroll
                for (int j = 0; j < 4; ++j) { const f32x4 gg = *(const f32x4*)(g2p + 4 * lane + 256 * j);
                    xp[tk][j].x = pk2(xr[j].x * rn * gg.x, xr[j].y * rn * gg.y); xp[tk][j].y = pk2(xr[j].z * rn * gg.z, xr[j].w * rn * gg.w); }
#pragma unroll
                for (int j = 0; j < 8; ++j) acc[tk][j] = (f32x2){0.f, 0.f};
            }
#pragma unroll 1
            for (int r = 0; r < PE_NR; ++r) {
#if PE_PASS_SYNC
                __syncthreads();
#endif
                PE_TOKEN_CHUNK(0); PE_TOKEN_CHUNK(1);
#if PE_NTK == 4
                PE_TOKEN_CHUNK(2); PE_TOKEN_CHUNK(3);
#endif
            }
#pragma unroll
            for (int tk = 0; tk < PE_NTK; ++tk) {
                const int t = tb + sr * PE_NTK + tk;
                f32x4 x[4]; float ss = 0.f;
#pragma unroll
                for (int j = 0; j < 4; ++j) {
                    x[j] = *(const f32x4*)(XA + (size_t)t * DM + 4 * lane + 256 * j);
                    x[j].x += acc[tk][2 * j].x; x[j].y += acc[tk][2 * j].y; x[j].z += acc[tk][2 * j + 1].x; x[j].w += acc[tk][2 * j + 1].y;
                    ss += x[j].x * x[j].x + x[j].y * x[j].y + x[j].z * x[j].z + x[j].w * x[j].w;
                }
                ss = wave_sum(ss);
                const float rr = rsqrtf(ss * (1.0f / DM) + EPS);
                if (last) {
#pragma unroll
                    for (int j = 0; j < 4; ++j) { const f32x4 gg = *(const f32x4*)(gnext + 4 * lane + 256 * j); *(f32x4*)(p.out + (size_t)t * DM + 4 * lane + 256 * j) = x[j] * rr * gg; }
                } else {
#pragma unroll
                    for (int j = 0; j < 4; ++j) {
                        const f32x4 gg = *(const f32x4*)(gnext + 4 * lane + 256 * j);
                        *(f32x4*)((DRY ? p.out : XA) + (size_t)t * DM + 4 * lane + 256 * j) = x[j];
                        u32x2 w; w.x = pk2(x[j].x * rr * gg.x, x[j].y * rr * gg.y); w.y = pk2(x[j].z * rr * gg.z, x[j].w * rr * gg.w);
                        if (!DRY) *(u32x2*)(XN + (size_t)t * DM + 4 * lane + 256 * j) = w;
                    }
                }
            }
        }
    }
}

#define LAS __attribute__((address_space(3)))
#define XB_TMO      128
#define XB_XCNT(j)  (256  + 64 * (j))
#define XB_XSUB(j)  (1280 + 64 * (j))
#define XB_XGEN(j)  (2304 + 64 * (j))
#define XB_TOP      3328
#define XB_TOPGEN   3392
#define XCD_BAR_WORDS 3456
#define XB_SPIN_CAP (1u << 20)
__device__ __forceinline__ unsigned xb_ld(unsigned* p)              { return __hip_atomic_load(p, __ATOMIC_RELAXED, __HIP_MEMORY_SCOPE_AGENT); }
__device__ __forceinline__ unsigned xb_add(unsigned* p, unsigned v) { return __hip_atomic_fetch_add(p, v, __ATOMIC_RELAXED, __HIP_MEMORY_SCOPE_AGENT); }
__device__ __forceinline__ unsigned xb_xcc_id() { return (unsigned)__builtin_amdgcn_s_getreg((3 << 11) | 20) & 0xFu; }
#define XB_SPIN(cond, bar) do { unsigned _sp = 0; while (cond) { __builtin_amdgcn_s_sleep(1); \
    if ((++_sp & 255u) == 0u) { if (xb_ld(&(bar)[XB_TMO])) break; if (_sp > XB_SPIN_CAP) { atomicAdd(&(bar)[XB_TMO], 1u); break; } } } } while (0)
struct XcdBarrier { unsigned* bar; unsigned x; volatile LAS unsigned* st; };
__device__ __forceinline__ XcdBarrier xcd_barrier_post(unsigned* bar, volatile LAS unsigned* st) {
    XcdBarrier b; b.bar = bar; b.x = xb_xcc_id(); b.st = st;
    if (threadIdx.x == 0) (void)xb_add(&bar[XB_XCNT(b.x)], 1u);
    return b;
}
__device__ __forceinline__ void xcd_barrier_complete(unsigned* bar, unsigned x, unsigned& nloc, unsigned& nx) {
    const unsigned G = NBLK;
    unsigned sum, cnt, mine, sp = 0u;
    for (;;) {
        sum = 0u; cnt = 0u; mine = 0u;
#pragma unroll
        for (unsigned j = 0; j < 16; ++j) { const unsigned c = xb_ld(&bar[XB_XCNT(j)]); sum += c; cnt += (c > 0u) ? 1u : 0u; mine = (j == x) ? c : mine; }
        if (sum == G) break;
        __builtin_amdgcn_s_sleep(1);
        if ((++sp & 255u) == 0u) { if (xb_ld(&bar[XB_TMO])) break; if (sp > XB_SPIN_CAP) { atomicAdd(&bar[XB_TMO], 1u); break; } }
    }
    nloc = mine > 0u ? mine : 1u; nx = cnt > 0u ? cnt : 1u;
}
__device__ __forceinline__ void xcd_barrier(const XcdBarrier& b) {
    asm volatile("s_waitcnt vmcnt(0)" ::: "memory");
    __syncthreads();
    if (threadIdx.x == 0) {
        unsigned* bar = b.bar;
        __builtin_amdgcn_s_waitcnt(0);
        unsigned nloc = b.st[0], nx = b.st[1];
        if (nloc == 0u) { xcd_barrier_complete(bar, b.x, nloc, nx); b.st[0] = nloc; b.st[1] = nx; }
        const unsigned old = xb_add(&bar[XB_XSUB(b.x)], 1u);
        const unsigned gen = old / nloc;
        if (old + 1u == (gen + 1u) * nloc) {
            __builtin_amdgcn_fence(__ATOMIC_RELEASE, "agent");
            asm volatile("s_waitcnt vmcnt(0)" ::: "memory");
            const unsigned og = xb_add(&bar[XB_TOP], 1u);
            const unsigned tg = og / nx;
            if (og + 1u == (tg + 1u) * nx) xb_add(&bar[XB_TOPGEN], 1u);
            else XB_SPIN(xb_ld(&bar[XB_TOPGEN]) == tg, bar);
            __builtin_amdgcn_fence(__ATOMIC_ACQUIRE, "agent");
            xb_add(&bar[XB_XGEN(b.x)], 1u);
            asm volatile("s_waitcnt vmcnt(0)" ::: "memory");
        } else {
            XB_SPIN(xb_ld(&bar[XB_XGEN(b.x)]) == gen, bar);
            __builtin_amdgcn_fence(__ATOMIC_ACQUIRE, "agent");
            asm volatile("s_waitcnt vmcnt(0)" ::: "memory");
        }
    }
    __syncthreads();
}


template <class Epi> __device__ __forceinline__ void big_gemm(const bf16_t* A, const bf16_t* Bt, int M, int N, int K, char* lds, const Epi& e) {
    pg8::Gemm g{A, Bt, M, N, K}; pg8::StaticOrder S; S.init(M, N, NBLK, obid());
    pg8::gemm_phase<Epi, pg8::StaticOrder, true, true>((PG8_LAS unsigned char*)lds, g, S, e);
}

#define GSYNC() xcd_barrier(xbar)
template <int layer> __device__ __forceinline__ void run_layer(const Params& p, char* lds, const XcdBarrier& xbar) {
    float* XA = (float*)(p.ws + OFF_XA);

        const float* xin = layer == 0 ? p.in[I_X] : XA;
#if PROBE == 10
        { EpiIn e{(bf16_t*)(p.ws + R_QKV), (float*)(p.ws + R_HF)};
          gemm_simple((const bf16_t*)(p.ws + R_XN), (const bf16_t*)(p.ws + OFF_WTIN) + (size_t)layer * INC * DM, T, INC, DM, lds, e); } GSYNC();
#endif
        {
            const bf16_t* wt = (const bf16_t*)(p.ws + OFF_WTIN) + (size_t)layer * INC * DM;
            pg8::EpiStoreBf16 e1{(bf16_t*)(p.ws + R_QKV), 768};
            big_gemm((const bf16_t*)(p.ws + R_XN), wt, T, 768, DM, lds, e1);
            pg8::EpiStoreF32 e2{nullptr, (float*)(p.ws + R_HF), T};
            big_gemm(wt + (size_t)768 * DM, (const bf16_t*)(p.ws + R_XN), 1024, T, DM, lds, e2);
        }
        if (layer == 0) {
#pragma nounroll
            for (int fl = 0; fl < NLAYER; ++fl) {
                EpiF32 e{(float*)(p.ws + (fl ? OFF_HFILT1 : OFF_HFILT0)), SL};
                gemm_simple((const bf16_t*)(p.ws + OFF_W3T) + (size_t)fl * 1024 * 64, (const bf16_t*)(p.ws + OFF_H2) + (size_t)fl * SL * 64, 1024, SL, 64, lds, e);
            }
        }
        GSYNC();
        if (layer == 0) {
            phase_filter_spectra(p, lds);
#if PROBE == 13
            phase_filter_spectra(p, lds);
#endif
        }
#if PROBE == 12
        phase_qkprep(p, layer, lds, (bf16_t*)(p.ws + R_ATT)); GSYNC();
#endif
        phase_qkprep(p, layer, lds, (bf16_t*)(p.ws + R_QKV)); GSYNC();
        {
#if PROBE == 5
            phase_attn(p, lds);
#endif
#if PROBE == 6
            for (int c = obid(); c < 256; c += NBLK) hyena_job(p, layer, c, lds);
            for (int c = obid(); c < 256; c += NBLK) fnet_job(p, c, lds);
#endif
            phase_attn(p, lds);
            for (int c = obid(); c < 256; c += NBLK) hyena_job(p, layer, c, lds);
            for (int c = obid(); c < 256; c += NBLK) fnet_job(p, c, lds);
        } GSYNC();
#if PROBE == 8
        phase_mix(p, layer, lds); GSYNC();
#endif
        phase_mix(p, layer, lds); GSYNC();
#if PROBE == 11
        { EpiRes e{xin, p.out};
          gemm_simple((const bf16_t*)(p.ws + R_MIX), (const bf16_t*)(p.ws + OFF_WTOUT) + (size_t)layer * DM * DM, T, DM, DM, lds, e); } GSYNC();
#endif
        { pg8::EpiOutProj e{xin, XA, (bf16_t*)(p.ws + R_XN), (float*)(p.ws + OFF_RS)};
          big_gemm((const bf16_t*)(p.ws + R_MIX), (const bf16_t*)(p.ws + OFF_WTOUT) + (size_t)layer * DM * DM, T, DM, DM, lds, e); } GSYNC();
#if PROBE == 3
        { EpiF32 e{(float*)(p.ws + R_QP), 2048};
          gemm_simple((const bf16_t*)(p.ws + R_XN), (const bf16_t*)(p.ws + OFF_WTQ) + (size_t)layer * 2048 * DM, T, 2048, DM, lds, e); } GSYNC();
#endif
        { pg8::EpiRowScaleF32 e{(float*)(p.ws + R_QP), 2048, (const float*)(p.ws + OFF_RS)};
          big_gemm((const bf16_t*)(p.ws + R_XN), (const bf16_t*)(p.ws + OFF_WTQ) + (size_t)layer * 2048 * DM, T, 2048, DM, lds, e); } GSYNC();
#if PEER_FUSED
#if PROBE == 1
        phase_peer_fused<true>(p, layer, lds); GSYNC();
#endif
        phase_peer_fused<false>(p, layer, lds);
#else
        phase_peer_topk(p, layer, lds, (int*)(p.ws + R_QP), (float*)(p.ws + R_QP)); GSYNC();
#if PROBE == 1
        phase_peer_gather<true>(p, layer); GSYNC();
#endif
#if PROBE == 15
        phase_peer_gather<true, 1023>(p, layer); GSYNC();
#endif
        phase_peer_gather<false>(p, layer);
#endif
        if (layer + 1 < NLAYER) GSYNC();
}

__global__ void __launch_bounds__(NTHR) mega_kernel(Params p) {
    extern __shared__ __attribute__((aligned(16))) char lds[];
    volatile LAS unsigned* misc = (volatile LAS unsigned*)((LAS char*)lds + LDS_MISC);
    if (threadIdx.x < 16) misc[threadIdx.x] = 0u;
    __syncthreads();
    const XcdBarrier xbar = xcd_barrier_post((unsigned*)(p.ws + OFF_CTL) + 4096, misc);
    float* XA = (float*)(p.ws + OFF_XA);
#if PROBE == 7
    phase_p0(p, lds); GSYNC();
#endif
#if PROBE >= 30 && PROBE <= 34
    phase_p0<(1 << (PROBE - 30))>(p, lds); GSYNC();
#endif
#if PROBE == 35
    phase_rmsnorm_bf16(p.in[I_X], p.in[I_N1G], (bf16_t*)(p.ws + R_XN)); GSYNC();
#endif
#if PROBE == 14
#pragma nounroll
    for (int i = 0; i < 40; ++i) GSYNC();
#endif
    phase_p0(p, lds);
    phase_rmsnorm_bf16(p.in[I_X], p.in[I_N1G], (bf16_t*)(p.ws + R_XN));
    GSYNC();
    run_layer<0>(p, lds, xbar);
    run_layer<1>(p, lds, xbar);
}

extern "C" void kernel_launch(void* const* d_in, const int* in_sizes, int n_in, void* d_out, int out_size, void* d_ws, size_t ws_size, hipStream_t stream) {
    static int grid = 0;
    if (grid == 0) {
        if (n_in != 25 || out_size != T * DM || ws_size < WS_NEED) { fprintf(stderr, "kernel_launch: unexpected sizes n_in %d out %d ws %zu (need %zu)\n", n_in, out_size, ws_size, (size_t)WS_NEED); grid = -1; return; }
        int dev = 0, cus = 0, per_cu = 0;
        if (hipGetDevice(&dev) != hipSuccess || hipDeviceGetAttribute(&cus, hipDeviceAttributeMultiprocessorCount, dev) != hipSuccess) { grid = -1; return; }
        if (hipFuncSetAttribute((const void*)mega_kernel, hipFuncAttributeMaxDynamicSharedMemorySize, LDS_BYTES) != hipSuccess) { fprintf(stderr, "kernel_launch: hipFuncSetAttribute failed\n"); grid = -1; return; }
        if (hipOccupancyMaxActiveBlocksPerMultiprocessor(&per_cu, (const void*)mega_kernel, NTHR, LDS_BYTES) != hipSuccess || per_cu < 1) { fprintf(stderr, "kernel_launch: occupancy query says %d blocks per CU\n", per_cu); grid = -1; return; }
        (void)hipGetLastError();
        if (cus < NBLK) { fprintf(stderr, "kernel_launch: built for a %d-CU device, found %d CUs\n", NBLK, cus); grid = -1; return; }
        grid = NBLK;
    }
    if (grid < 0) return;
    Params p{};
    for (int i = 0; i < 25; ++i) p.in[i] = (const float*)d_in[i];
    p.out = (float*)d_out; p.ws = (unsigned char*)d_ws;
    if (hipMemsetAsync((char*)d_ws + OFF_CTL, 0, 64 * 1024, stream) != hipSuccess) { fprintf(stderr, "kernel_launch: memset failed\n"); return; }
    void* args[] = {&p};
    hipError_t e = hipLaunchCooperativeKernel((const void*)mega_kernel, dim3(grid), dim3(NTHR), args, LDS_BYTES, stream);
    if (e != hipSuccess) fprintf(stderr, "cooperative launch failed: %s (grid %d)\n", hipGetErrorString(e), grid);
}
```

```cpp
#include <hip/hip_runtime.h>
#include <hip/hip_cooperative_groups.h>
#include <cstdio>
#include <cstdint>
namespace cg = cooperative_groups;

#ifndef PROBE
#define PROBE 0
#endif
#ifndef PEER_FUSED
#define PEER_FUSED 1
#endif

typedef unsigned short bf16_t;
typedef short bf16x8 __attribute__((ext_vector_type(8)));
typedef float f32x16 __attribute__((ext_vector_type(16)));
typedef float f32x4 __attribute__((ext_vector_type(4)));
typedef unsigned u32x4 __attribute__((ext_vector_type(4)));
typedef unsigned u32x2 __attribute__((ext_vector_type(2)));

constexpr int DM = 1024, NB = 2, SL = 8192, T = NB * SL, NLAYER = 2;
constexpr int INC = 1792;
constexpr int NTHR = 512, NWAVE = 8;
constexpr int NBLK = 256;
constexpr int LDS_BYTES = 147456;
constexpr int LDS_MISC = LDS_BYTES - 64;
constexpr float EPS = 1e-6f;

constexpr size_t MiB = 1u << 20;
constexpr size_t OFF_CTL = 0;
constexpr size_t OFF_WTIN = 1 * MiB;
constexpr size_t OFF_WTOUT = 8 * MiB;
constexpr size_t OFF_WTQ = 12 * MiB;
constexpr size_t OFF_PU = 20 * MiB;
constexpr size_t OFF_PV = 84 * MiB;
constexpr size_t OFF_RS = 505 * MiB;
constexpr size_t OFF_PSC = 512 * 1024;
constexpr size_t OFF_H2 = 148 * MiB;
constexpr size_t OFF_W3T = 150 * MiB;
constexpr size_t OFF_HFILT0 = 52 * MiB, OFF_HFILT1 = 116 * MiB;
constexpr size_t OFF_FM = 152 * MiB;
constexpr size_t OFF_KF = 153 * MiB;
constexpr size_t OFF_XA = 281 * MiB;
constexpr size_t OFF_R = 345 * MiB;
constexpr size_t R_XN = OFF_R + 0 * MiB;
constexpr size_t R_UR = OFF_R + 0 * MiB;
constexpr size_t R_UI = OFF_R + 16 * MiB;
constexpr size_t R_QKV = OFF_R + 32 * MiB;
constexpr size_t R_VT = OFF_R + 56 * MiB;
constexpr size_t R_HF = OFF_R + 60 * MiB;
constexpr size_t R_MIX = OFF_R + 60 * MiB;
constexpr size_t R_ATT = OFF_R + 124 * MiB;
constexpr size_t R_Y = OFF_R + 140 * MiB;
constexpr size_t R_QP = OFF_R + 32 * MiB;
constexpr size_t WS_NEED = 506 * MiB;

struct Params {
    const float* in[25];
    float* out;
    unsigned char* ws;
};
enum { I_X = 0, I_N1G, I_WIN, I_QG, I_KG, I_CW, I_CB, I_W1, I_B1, I_F1, I_W2, I_B2, I_F2, I_W3, I_HB, I_FW, I_FB, I_MG, I_WOUT, I_N2G, I_WQ, I_SK, I_PU, I_PV, I_FG };

__device__ __forceinline__ unsigned f2bf(float f) { unsigned u = __builtin_bit_cast(unsigned, f); return (u + 0x7fffu + ((u >> 16) & 1u)) >> 16; }
__device__ __forceinline__ unsigned pk2(float lo, float hi) { return f2bf(lo) | (f2bf(hi) << 16); }
__device__ __forceinline__ float bf2f(unsigned b) { return __builtin_bit_cast(float, b << 16); }
__device__ __forceinline__ float bflo(unsigned w) { return __builtin_bit_cast(float, w << 16); }
__device__ __forceinline__ float bfhi(unsigned w) { return __builtin_bit_cast(float, w & 0xffff0000u); }
__device__ __forceinline__ float wave_sum(float v) {
#pragma unroll
    for (int o = 1; o < 64; o <<= 1) v += __shfl_xor(v, o);
    return v;
}
__device__ __forceinline__ float wave_max(float v) {
#pragma unroll
    for (int o = 1; o < 64; o <<= 1) v = fmaxf(v, __shfl_xor(v, o));
    return v;
}
__device__ __forceinline__ f32x16 mfma32(bf16x8 a, bf16x8 b, f32x16 c) { return __builtin_amdgcn_mfma_f32_32x32x16_bf16(a, b, c, 0, 0, 0); }
__device__ __forceinline__ f32x16 zero16() { return (f32x16){0.f,0.f,0.f,0.f,0.f,0.f,0.f,0.f,0.f,0.f,0.f,0.f,0.f,0.f,0.f,0.f}; }


__device__ __forceinline__ int otid() { int t = threadIdx.x; asm volatile("" : "+v"(t)); return t; }
__device__ __forceinline__ int obid() { int b = blockIdx.x; asm volatile("" : "+s"(b)); return b; }
__device__ __forceinline__ void transpose_one(const float* W, int K, int N, bf16_t* Wt, float* tile, int item) {
    const int tid = otid();
    const int nblk = N / 64, kb = item / nblk, nb = item % nblk, k0 = kb * 64, n0 = nb * 64;
    __syncthreads();
    {
        const int r = tid >> 6, c = tid & 63;
#pragma unroll
        for (int i = 0; i < 8; ++i) { const int k = r + 8 * i; tile[k * 65 + c] = W[(size_t)(k0 + k) * N + n0 + c]; }
    }
    __syncthreads();
    {
        const int nn = tid >> 3, kc = tid & 7;
        const float* s = tile + (kc * 8) * 65 + nn;
        u32x4 o; o.x = pk2(s[0], s[65]); o.y = pk2(s[2 * 65], s[3 * 65]); o.z = pk2(s[4 * 65], s[5 * 65]); o.w = pk2(s[6 * 65], s[7 * 65]);
        *(u32x4*)(Wt + (size_t)(n0 + nn) * K + k0 + kc * 8) = o;
    }
}

template <int PARTS = 31> __device__ __forceinline__ void phase_p0(const Params& p, char* lds) {
    const int tid = otid();
    float* tile = (float*)lds;
    if (PARTS & 1) {
    constexpr int IT_IN = (DM / 64) * (INC / 64), IT_OUT = (DM / 64) * (DM / 64), IT_W3 = 1024 / 64;
    constexpr int IT_L = IT_IN + IT_OUT + IT_W3;
    for (int it = obid(); it < NLAYER * IT_L; it += NBLK) {
        const int layer = it / IT_L; int r = it % IT_L;
        if (r < IT_IN) { transpose_one(p.in[I_WIN] + (size_t)layer * DM * INC, DM, INC, (bf16_t*)(p.ws + OFF_WTIN) + (size_t)layer * INC * DM, tile, r); continue; }
        r -= IT_IN;
        if (r < IT_OUT) { transpose_one(p.in[I_WOUT] + (size_t)layer * DM * DM, DM, DM, (bf16_t*)(p.ws + OFF_WTOUT) + (size_t)layer * DM * DM, tile, r); continue; }
        r -= IT_OUT;
        transpose_one(p.in[I_W3] + (size_t)layer * 64 * 1024, 64, 1024, (bf16_t*)(p.ws + OFF_W3T) + (size_t)layer * 1024 * 64, tile, r);
    }
    }
    __syncthreads();
    if (PARTS & 2) {
        float* SKl = (float*)lds;
        float* Wl = SKl + 128 * 129;
        const int lane = tid & 63, wave = tid >> 6, l31 = lane & 31, hl = lane >> 5, mt = wave & 3, nt = wave >> 2;
        for (int it = obid(); it < NLAYER * 16 * 16; it += NBLK) {
            const int layer = it >> 8, hp = (it >> 4) & 15, kc = it & 15, h = hp >> 1, pp = hp & 1, k0 = kc * 64;
            const float* sk = p.in[I_SK] + (((size_t)(layer * 2 + pp) * 8 + h) * 128) * 128;
            const float* wq = p.in[I_WQ] + (size_t)layer * DM * 2048 + (size_t)k0 * 2048 + h * 256 + pp * 128;
            __syncthreads();
            for (int i = tid; i < 128 * 128; i += NTHR) SKl[(i >> 7) * 129 + (i & 127)] = sk[i];
            for (int i = tid; i < 64 * 128; i += NTHR) Wl[(i >> 7) * 129 + (i & 127)] = wq[(size_t)(i >> 7) * 2048 + (i & 127)];
            __syncthreads();
            f32x16 acc = zero16();
            const float* ap = SKl + (32 * mt + l31) * 129 + hl;
            const float* bp = Wl + (32 * nt + l31) * 129 + hl;
#pragma unroll 16
            for (int kk = 0; kk < 64; ++kk) acc = __builtin_amdgcn_mfma_f32_32x32x2f32(ap[2 * kk], bp[2 * kk], acc, 0, 0, 0);
            const float g2 = p.in[I_N2G][layer * DM + k0 + 32 * nt + l31];
            bf16_t* dst = (bf16_t*)(p.ws + OFF_WTQ) + (size_t)layer * 2048 * DM + (size_t)(hp * 128 + 32 * mt + 4 * hl) * DM + k0 + 32 * nt + l31;
#pragma unroll
            for (int r = 0; r < 16; ++r) dst[(size_t)((r & 3) + 8 * (r >> 2)) * DM] = (bf16_t)f2bf(acc[r] * g2);
        }
        __syncthreads();
    }
    if (PARTS & 4) {
        const int lane = tid & 63, wave = tid >> 6;
        float* scl = (float*)(p.ws + OFF_PSC);
        for (int row = obid() * NWAVE + wave; row < 2 * NLAYER * 16384; row += NBLK * NWAVE) {
            const int tb = row >> 15, r = row & 32767;
            const f32x4* src = (const f32x4*)(p.in[tb ? I_PV : I_PU] + (size_t)r * DM) + lane;
            f32x4 v[4]; float mx = 0.f;
#pragma unroll
            for (int j = 0; j < 4; ++j) { v[j] = src[64 * j]; mx = fmaxf(mx, fmaxf(fmaxf(fabsf(v[j].x), fabsf(v[j].y)), fmaxf(fabsf(v[j].z), fabsf(v[j].w)))); }
            mx = wave_max(mx);
            const float sc = mx > 0.f ? 224.0f / mx : 1.0f;
            u32x4 o;
            { int w = 0; w = __builtin_amdgcn_cvt_pk_fp8_f32(v[0].x * sc, v[0].y * sc, w, false); w = __builtin_amdgcn_cvt_pk_fp8_f32(v[0].z * sc, v[0].w * sc, w, true); o.x = (unsigned)w; }
            { int w = 0; w = __builtin_amdgcn_cvt_pk_fp8_f32(v[1].x * sc, v[1].y * sc, w, false); w = __builtin_amdgcn_cvt_pk_fp8_f32(v[1].z * sc, v[1].w * sc, w, true); o.y = (unsigned)w; }
            { int w = 0; w = __builtin_amdgcn_cvt_pk_fp8_f32(v[2].x * sc, v[2].y * sc, w, false); w = __builtin_amdgcn_cvt_pk_fp8_f32(v[2].z * sc, v[2].w * sc, w, true); o.z = (unsigned)w; }
            { int w = 0; w = __builtin_amdgcn_cvt_pk_fp8_f32(v[3].x * sc, v[3].y * sc, w, false); w = __builtin_amdgcn_cvt_pk_fp8_f32(v[3].z * sc, v[3].w * sc, w, true); o.w = (unsigned)w; }
            *(u32x4*)(p.ws + (tb ? OFF_PV : OFF_PU) + (size_t)r * DM + lane * 16) = o;
            if (lane == 0) scl[row] = mx > 0.f ? mx / 224.0f : 1.0f;
        }
    }
    if (PARTS & 8) {
        float* sh = (float*)lds;
        float* zl = sh + 64 * 64;
        const int sub = tid >> 6, j = tid & 63;
        for (int it0 = obid() * 64; it0 < NLAYER * SL; it0 += NBLK * 64) {
            const int layer = it0 / SL;
            __syncthreads();
            for (int o = tid; o < 64 * 17; o += NTHR) {
                const int item = o / 17, f = o % 17;
                const float t = (float)((it0 + item) % SL) / (float)(SL - 1);
                float z;
                if (f == 0) z = t;
                else if (f <= 8) z = sinf(2.0f * 3.14159265358979323846f * t * (float)f);
                else z = cosf(2.0f * 3.14159265358979323846f * t * (float)(f - 8));
                zl[o] = z;
            }
            __syncthreads();
            {
                const float* w1 = p.in[I_W1] + layer * 17 * 64;
                float wv[17];
#pragma unroll
                for (int i = 0; i < 17; ++i) wv[i] = w1[i * 64 + j];
                const float b1 = p.in[I_B1][layer * 64 + j], f1 = p.in[I_F1][layer * 64 + j];
#pragma unroll
                for (int r = 0; r < 8; ++r) {
                    const int item = sub * 8 + r;
                    float a = b1;
#pragma unroll
                    for (int i = 0; i < 17; ++i) a += zl[item * 17 + i] * wv[i];
                    sh[item * 64 + j] = sinf(f1 * a);
                }
            }
            __syncthreads();
            {
                const float* w2 = p.in[I_W2] + layer * 64 * 64;
                const float b2 = p.in[I_B2][layer * 64 + j], f2 = p.in[I_F2][layer * 64 + j];
                float acc[8];
#pragma unroll
                for (int r = 0; r < 8; ++r) acc[r] = b2;
#pragma unroll 8
                for (int k = 0; k < 64; ++k) {
                    const float w = w2[k * 64 + j];
#pragma unroll
                    for (int r = 0; r < 8; ++r) acc[r] += sh[(sub * 8 + r) * 64 + k] * w;
                }
#pragma unroll
                for (int r = 0; r < 8; ++r)
                    ((bf16_t*)(p.ws + OFF_H2))[((size_t)(it0 + sub * 8 + r)) * 64 + j] = (bf16_t)f2bf(sinf(f2 * acc[r]));
            }
        }
        __syncthreads();
    }
    if (PARTS & 16) {
        float* ctab = (float*)lds;
        __syncthreads();
        if (tid < 64) ctab[tid] = cosf((float)tid * (2.0f * 3.14159265358979323846f / 64.0f));
        __syncthreads();
        const int total = NLAYER * 4 * 128 * 64;
        for (int o = obid() * NTHR + tid; o < total; o += NBLK * NTHR) {
            const int e2 = o & 63, dd = (o >> 6) & 127, g = (o >> 13) & 3, layer = o >> 15;
            const int d = dd & 63, sh = (dd < 64) ? 0 : 48;
            const float* w = p.in[I_FW] + ((size_t)(layer * 4 + g) * 64) * 64;
            float acc = 0.f;
#pragma unroll 8
            for (int e = 0; e < 64; ++e) acc += ctab[(d * e + sh) & 63] * w[e * 64 + e2];
            ((float*)(p.ws + OFF_FM))[o] = acc * (1.0f / 724.0773439350246f);
        }
        __syncthreads();
    }
}

template <bool PAD> __device__ __forceinline__ int zi(int i) { return PAD ? i + (i >> 8) : i; }

template <int LOGN, bool PAD>
__device__ __forceinline__ void fft_fwd(float2* Z) {
    constexpr int N = 1 << LOGN;
    const int tid = otid();
    int s = 0;
    for (; s + 1 < LOGN; s += 2) {
        const int lh2 = LOGN - s - 2;
        const int h2 = 1 << lh2, h = h2 << 1;
        const float rs = 1.0f / (float)(h << 1);
        for (int q = tid; q < N / 4; q += NTHR) {
            const int j = q & (h2 - 1), blk = q >> lh2;
            const int base = (blk << (lh2 + 2)) + j;
            float2 x0 = Z[zi<PAD>(base)], x1 = Z[zi<PAD>(base + h2)], x2 = Z[zi<PAD>(base + h)], x3 = Z[zi<PAD>(base + h + h2)];
            const float ang = (float)j * rs;
            const float c = __builtin_amdgcn_cosf(ang), sn = __builtin_amdgcn_sinf(ang);
            float2 a0 = make_float2(x0.x + x2.x, x0.y + x2.y);
            float2 d02 = make_float2(x0.x - x2.x, x0.y - x2.y);
            float2 a2 = make_float2(d02.x * c + d02.y * sn, d02.y * c - d02.x * sn);
            float2 a1 = make_float2(x1.x + x3.x, x1.y + x3.y);
            float2 d13 = make_float2(x1.x - x3.x, x1.y - x3.y);
            float2 t3 = make_float2(d13.x * c + d13.y * sn, d13.y * c - d13.x * sn);
            float2 a3 = make_float2(t3.y, -t3.x);
            const float c2 = c * c - sn * sn, s2 = 2.f * c * sn;
            float2 y0 = make_float2(a0.x + a1.x, a0.y + a1.y);
            float2 e01 = make_float2(a0.x - a1.x, a0.y - a1.y);
            float2 y1 = make_float2(e01.x * c2 + e01.y * s2, e01.y * c2 - e01.x * s2);
            float2 y2 = make_float2(a2.x + a3.x, a2.y + a3.y);
            float2 e23 = make_float2(a2.x - a3.x, a2.y - a3.y);
            float2 y3 = make_float2(e23.x * c2 + e23.y * s2, e23.y * c2 - e23.x * s2);
            Z[zi<PAD>(base)] = y0; Z[zi<PAD>(base + h2)] = y1; Z[zi<PAD>(base + h)] = y2; Z[zi<PAD>(base + h + h2)] = y3;
        }
        __syncthreads();
    }
    if (s < LOGN) {
        for (int q = tid; q < N / 2; q += NTHR) {
            const int i0 = 2 * q;
            float2 a = Z[zi<PAD>(i0)], b = Z[zi<PAD>(i0 + 1)];
            Z[zi<PAD>(i0)] = make_float2(a.x + b.x, a.y + b.y);
            Z[zi<PAD>(i0 + 1)] = make_float2(a.x - b.x, a.y - b.y);
        }
        __syncthreads();
    }
}

template <int LOGN, bool PAD>
__device__ __forceinline__ void fft_inv(float2* Z) {
    constexpr int N = 1 << LOGN;
    const int tid = otid();
    for (int s = LOGN - 2; s >= 0; s -= 2) {
        const int lh2 = LOGN - s - 2;
        const int h2 = 1 << lh2, h = h2 << 1;
        const float rs = 1.0f / (float)(h << 1);
        for (int q = tid; q < N / 4; q += NTHR) {
            const int j = q & (h2 - 1), blk = q >> lh2;
            const int base = (blk << (lh2 + 2)) + j;
            float2 y0 = Z[zi<PAD>(base)], y1 = Z[zi<PAD>(base + h2)], y2 = Z[zi<PAD>(base + h)], y3 = Z[zi<PAD>(base + h + h2)];
            const float ang = (float)j * rs;
            const float c = __builtin_amdgcn_cosf(ang), sn = __builtin_amdgcn_sinf(ang);
            const float c2 = c * c - sn * sn, s2 = 2.f * c * sn;
            float2 t1 = make_float2(y1.x * c2 - y1.y * s2, y1.y * c2 + y1.x * s2);
            float2 t3 = make_float2(y3.x * c2 - y3.y * s2, y3.y * c2 + y3.x * s2);
            float2 a0 = make_float2(y0.x + t1.x, y0.y + t1.y), a1 = make_float2(y0.x - t1.x, y0.y - t1.y);
            float2 a2 = make_float2(y2.x + t3.x, y2.y + t3.y), a3 = make_float2(y2.x - t3.x, y2.y - t3.y);
            float2 u2 = make_float2(a2.x * c - a2.y * sn, a2.y * c + a2.x * sn);
            float2 u3 = make_float2(a3.x * c - a3.y * sn, a3.y * c + a3.x * sn);
            float2 v3 = make_float2(-u3.y, u3.x);
            Z[zi<PAD>(base)] = make_float2(a0.x + u2.x, a0.y + u2.y);
            Z[zi<PAD>(base + h)] = make_float2(a0.x - u2.x, a0.y - u2.y);
            Z[zi<PAD>(base + h2)] = make_float2(a1.x + v3.x, a1.y + v3.y);
            Z[zi<PAD>(base + h + h2)] = make_float2(a1.x - v3.x, a1.y - v3.y);
        }
        __syncthreads();
    }
}


__device__ __forceinline__ int zp(int i) { return i + 2 * (i >> 5); }
__device__ constexpr float FC32[16] = {1.000000000f, 0.980785280f, 0.923879533f, 0.831469612f, 0.707106781f, 0.555570233f, 0.382683432f, 0.195090322f, 0.000000000f, -0.195090322f, -0.382683432f, -0.555570233f, -0.707106781f, -0.831469612f, -0.923879533f, -0.980785280f};
__device__ constexpr float FS32[16] = {0.000000000f, 0.195090322f, 0.382683432f, 0.555570233f, 0.707106781f, 0.831469612f, 0.923879533f, 0.980785280f, 1.000000000f, 0.980785280f, 0.923879533f, 0.831469612f, 0.707106781f, 0.555570233f, 0.382683432f, 0.195090322f};
__device__ __forceinline__ float2 cmulf(float2 a, float2 b) { return make_float2(a.x * b.x - a.y * b.y, a.x * b.y + a.y * b.x); }
template <int R> __device__ __forceinline__ constexpr int brevR(int x) { int r = 0; for (int b = 1, t = R >> 1; t >= 1; b <<= 1, t >>= 1) if (x & b) r |= t; return r; }
template <int R> __device__ __forceinline__ void dft_fwd_regs(float2 (&x)[R]) {
#pragma unroll
    for (int half = R / 2; half >= 1; half >>= 1) {
#pragma unroll
        for (int blk = 0; blk < R; blk += 2 * half)
#pragma unroll
            for (int k = 0; k < half; ++k) {
                const float2 a = x[blk + k], b = x[blk + k + half];
                x[blk + k] = make_float2(a.x + b.x, a.y + b.y);
                const float2 d = make_float2(a.x - b.x, a.y - b.y);
                const int ti = k * (16 / half);
                if (ti == 0) x[blk + k + half] = d;
                else if (ti == 8) x[blk + k + half] = make_float2(d.y, -d.x);
                else { const float c = FC32[ti], sn = FS32[ti]; x[blk + k + half] = make_float2(d.x * c + d.y * sn, d.y * c - d.x * sn); }
            }
    }
}
template <int R> __device__ __forceinline__ void dft_inv_regs(float2 (&x)[R]) {
#pragma unroll
    for (int half = 1; half <= R / 2; half <<= 1) {
#pragma unroll
        for (int blk = 0; blk < R; blk += 2 * half)
#pragma unroll
            for (int k = 0; k < half; ++k) {
                const float2 a = x[blk + k], b0 = x[blk + k + half];
                const int ti = k * (16 / half);
                float2 b;
                if (ti == 0) b = b0;
                else if (ti == 8) b = make_float2(-b0.y, b0.x);
                else { const float c = FC32[ti], sn = FS32[ti]; b = make_float2(b0.x * c - b0.y * sn, b0.y * c + b0.x * sn); }
                x[blk + k] = make_float2(a.x + b.x, a.y + b.y);
                x[blk + k + half] = make_float2(a.x - b.x, a.y - b.y);
            }
    }
}
template <int R> __device__ __forceinline__ void apply_tw(float2 (&x)[R], float c, float sg) {
    const float2 w1 = make_float2(c, sg), w2 = cmulf(w1, w1);
    float2 po = w1, pe = w2;
#pragma unroll
    for (int m = 1; m < R; m += 2) {
        x[brevR<R>(m)] = cmulf(x[brevR<R>(m)], po);
        if (m + 1 < R) x[brevR<R>(m + 1)] = cmulf(x[brevR<R>(m + 1)], pe);
        if (m + 2 < R) { po = cmulf(po, w2); pe = cmulf(pe, w2); }
    }
}
template <int R, bool INV> __device__ __forceinline__ void fft_group(float2* Z, int pbase, int PS, float ang) {
    float2 x[R];
    if (!INV) {
#pragma unroll
        for (int m = 0; m < R; ++m) x[m] = Z[pbase + PS * m];
        dft_fwd_regs<R>(x);
        apply_tw<R>(x, __builtin_amdgcn_cosf(ang), -__builtin_amdgcn_sinf(ang));
#pragma unroll
        for (int m = 0; m < R; ++m) Z[pbase + PS * m] = x[brevR<R>(m)];
    } else {
#pragma unroll
        for (int m = 0; m < R; ++m) x[brevR<R>(m)] = Z[pbase + PS * m];
        apply_tw<R>(x, __builtin_amdgcn_cosf(ang), __builtin_amdgcn_sinf(ang));
        dft_inv_regs<R>(x);
#pragma unroll
        for (int m = 0; m < R; ++m) Z[pbase + PS * m] = x[m];
    }
}
template <bool INV> __device__ __forceinline__ void fft_group32_contig(float2* Z, int pbase) {
    float2 x[32];
    if (!INV) {
#pragma unroll
        for (int m = 0; m < 32; m += 2) { const f32x4 v = *(const f32x4*)(Z + pbase + m); x[m] = make_float2(v.x, v.y); x[m + 1] = make_float2(v.z, v.w); }
        dft_fwd_regs<32>(x);
#pragma unroll
        for (int m = 0; m < 32; m += 2) { const float2 a = x[brevR<32>(m)], b = x[brevR<32>(m + 1)]; *(f32x4*)(Z + pbase + m) = (f32x4){a.x, a.y, b.x, b.y}; }
    } else {
#pragma unroll
        for (int m = 0; m < 32; m += 2) { const f32x4 v = *(const f32x4*)(Z + pbase + m); x[brevR<32>(m)] = make_float2(v.x, v.y); x[brevR<32>(m + 1)] = make_float2(v.z, v.w); }
        dft_inv_regs<32>(x);
#pragma unroll
        for (int m = 0; m < 32; m += 2) *(f32x4*)(Z + pbase + m) = (f32x4){x[m].x, x[m].y, x[m + 1].x, x[m + 1].y};
    }
}
__device__ __forceinline__ void fft16k_fwd(float2* Z) {
    const int tid = otid();
#pragma unroll 1
    for (int g = 0; g < 2; ++g) { const int j = tid + 512 * g; fft_group<16, false>(Z, zp(j), 1088, (float)j * (1.0f / 16384.0f)); }
    __syncthreads();
    { const int blk = tid >> 5, j = tid & 31; fft_group<32, false>(Z, blk * 1088 + j, 34, (float)j * (1.0f / 1024.0f)); }
    __syncthreads();
    fft_group32_contig<false>(Z, 34 * tid);
    __syncthreads();
}
__device__ __forceinline__ void fft16k_inv(float2* Z) {
    const int tid = otid();
    fft_group32_contig<true>(Z, 34 * tid);
    __syncthreads();
    { const int blk = tid >> 5, j = tid & 31; fft_group<32, true>(Z, blk * 1088 + j, 34, (float)j * (1.0f / 1024.0f)); }
    __syncthreads();
#pragma unroll 1
    for (int g = 0; g < 2; ++g) { const int j = tid + 512 * g; fft_group<16, true>(Z, zp(j), 1088, (float)j * (1.0f / 16384.0f)); }
    __syncthreads();
}
__device__ __forceinline__ void fft8k_fwd(float2* Z) {
    const int tid = otid();
    fft_group<16, false>(Z, zp(tid), 544, (float)tid * (1.0f / 8192.0f));
    __syncthreads();
    { const int blk = tid >> 5, j = tid & 31; fft_group<16, false>(Z, blk * 544 + j, 34, (float)j * (1.0f / 512.0f)); }
    __syncthreads();
    if (tid < 256) fft_group32_contig<false>(Z, 34 * tid);
    __syncthreads();
}
__device__ __forceinline__ int f16k_of_p(int p) { return (p >> 10) + 16 * ((p >> 5) & 31) + 512 * (p & 31); }
__device__ __forceinline__ int p16k_of_f(int f) { return 1024 * (f & 15) + 32 * ((f >> 4) & 31) + (f >> 9); }
__device__ __forceinline__ int p8k_of_f(int f) { return 512 * (f & 15) + 32 * ((f >> 4) & 15) + (f >> 8); }

__device__ __forceinline__ void phase_filter_spectra(const Params& p, char* lds) {
    const int tid = otid(), lane = tid & 63, wave = tid >> 6;
    float2* Z = (float2*)lds;
    float* red = (float*)(lds + 139264 + 64);
    for (int job = obid(); job < NLAYER * 256; job += NBLK) {
        const int layer = job >> 8, c = job & 255;
        __syncthreads();
        const float* HFc = (const float*)(p.ws + (layer ? OFF_HFILT1 : OFF_HFILT0)) + (size_t)c * SL;
        const float r_lo = 4.605170185988092f / 1.5f, r_hi = 4.605170185988092f / 0.3f;
        const float rate = r_lo + (r_hi - r_lo) * ((float)c / 255.0f);
        float ss0 = 0.f, ss1 = 0.f;
#pragma unroll 1
        for (int i = 0; i < 4; ++i) {
            const int l0 = 4 * tid + 2048 * i;
            const f32x4 a0 = *(const f32x4*)(HFc + l0), a1 = *(const f32x4*)(HFc + (size_t)256 * SL + l0);
            const f32x4 a2 = *(const f32x4*)(HFc + (size_t)512 * SL + l0), a3 = *(const f32x4*)(HFc + (size_t)768 * SL + l0);
#pragma unroll
            for (int e = 0; e < 4; ++e) {
                const int l = l0 + e;
                const float t = (float)l / (float)(SL - 1);
                const float dec = expf(-t * rate);
                const float f0 = a0[e] * dec, b0 = a1[e] * dec, f1 = a2[e] * dec, b1 = a3[e] * dec;
                ss0 += f0 * f0 + b0 * b0; ss1 += f1 * f1 + b1 * b1;
                Z[zp(l)] = make_float2(f0, f1);
                if (l >= 1) Z[zp(16384 - l)] = make_float2(b0, b1);
            }
        }
        if (tid == 0) Z[zp(8192)] = make_float2(0.f, 0.f);
        ss0 = wave_sum(ss0); ss1 = wave_sum(ss1);
        if (lane == 0) { red[wave * 2] = ss0; red[wave * 2 + 1] = ss1; }
        __syncthreads();
        float t0 = 0.f, t1 = 0.f;
#pragma unroll
        for (int w = 0; w < 8; ++w) { t0 += red[w * 2]; t1 += red[w * 2 + 1]; }
        const float sc0 = rsqrtf(t0 + EPS) * (1.0f / 16384.0f) * 0.5f, sc1 = rsqrtf(t1 + EPS) * (1.0f / 16384.0f) * 0.5f;
        fft16k_fwd(Z);
        float2* KF0 = (float2*)(p.ws + OFF_KF) + ((size_t)(layer * 256 + c) * 2) * 16384;
        float2* KF1 = KF0 + 16384;
        for (int i = 0; i < 32; ++i) {
            const int pp = tid + NTHR * i;
            const int fq = f16k_of_p(pp);
            const int pq = p16k_of_f((16384 - fq) & 16383);
            const float2 za = Z[zp(pp)], zq = Z[zp(pq)];
            KF0[pp] = make_float2((za.x + zq.x) * sc0, (za.y - zq.y) * sc0);
            KF1[pp] = make_float2((za.y + zq.y) * sc1, (zq.x - za.x) * sc1);
        }
    }
}

__device__ __forceinline__ void phase_rmsnorm_bf16(const float* x, const float* g, bf16_t* out) {
    const int lane = otid() & 63, wave = otid() >> 6;
    const int gw = obid() * NWAVE + wave, ngw = NBLK * NWAVE;
    for (int row = gw; row < T; row += ngw) {
        const f32x4* xr = (const f32x4*)(x + (size_t)row * DM) + lane;
        f32x4 v[4]; float ss = 0.f;
#pragma unroll
        for (int j = 0; j < 4; ++j) { v[j] = xr[64 * j]; ss += v[j].x * v[j].x + v[j].y * v[j].y + v[j].z * v[j].z + v[j].w * v[j].w; }
        ss = wave_sum(ss);
        const float r = rsqrtf(ss * (1.0f / DM) + EPS);
        u32x2* o = (u32x2*)(out + (size_t)row * DM) + lane;
#pragma unroll
        for (int j = 0; j < 4; ++j) {
            const f32x4 gg = ((const f32x4*)g)[lane + 64 * j];
            u32x2 w; w.x = pk2(v[j].x * r * gg.x, v[j].y * r * gg.y); w.y = pk2(v[j].z * r * gg.z, v[j].w * r * gg.w);
            o[64 * j] = w;
        }
    }
}
__device__ __forceinline__ void phase_final_norm(const float* x, const float* g, float* out) {
    const int lane = otid() & 63, wave = otid() >> 6;
    const int gw = obid() * NWAVE + wave, ngw = NBLK * NWAVE;
    for (int row = gw; row < T; row += ngw) {
        const f32x4* xr = (const f32x4*)(x + (size_t)row * DM) + lane;
        f32x4 v[4]; float ss = 0.f;
#pragma unroll
        for (int j = 0; j < 4; ++j) { v[j] = xr[64 * j]; ss += v[j].x * v[j].x + v[j].y * v[j].y + v[j].z * v[j].z + v[j].w * v[j].w; }
        ss = wave_sum(ss);
        const float r = rsqrtf(ss * (1.0f / DM) + EPS);
        f32x4* o = (f32x4*)(out + (size_t)row * DM) + lane;
#pragma unroll
        for (int j = 0; j < 4; ++j) { const f32x4 gg = ((const f32x4*)g)[lane + 64 * j]; o[64 * j] = v[j] * r * gg; }
    }
}

constexpr int G_LDA = 144;
template <class Epi>
__device__ __forceinline__ void gemm_simple(const bf16_t* A, const bf16_t* Bt, int M, int N, int K, char* lds, const Epi& epi) {
    const int tid = otid(), lane = tid & 63, wave = tid >> 6;
    const int wm = wave >> 1, wn = wave & 1;
    const int nMt = M / 256, nNt = N / 128, total = nMt * nNt, nk = K / 64;
    char* As = lds; char* Bs = lds + 256 * G_LDA;
    const int l31 = lane & 31, hl = lane >> 5;
    for (int u = obid(); u < total; u += NBLK) {
        const int mt = u % nMt, nt = u / nMt;
        f32x16 acc[2][2];
#pragma unroll
        for (int i = 0; i < 2; ++i)
#pragma unroll
            for (int j = 0; j < 2; ++j) acc[i][j] = zero16();
        u32x4 ra[4], rb[2];
        const bf16_t* Ab = A + (size_t)(mt * 256) * K;
        const bf16_t* Bb = Bt + (size_t)(nt * 128) * K;
#pragma unroll
        for (int i = 0; i < 4; ++i) { const int id = tid + NTHR * i, row = id >> 3, ch = id & 7; ra[i] = *(const u32x4*)(Ab + (size_t)row * K + ch * 8); }
#pragma unroll
        for (int i = 0; i < 2; ++i) { const int id = tid + NTHR * i, row = id >> 3, ch = id & 7; rb[i] = *(const u32x4*)(Bb + (size_t)row * K + ch * 8); }
        for (int kt = 0; kt < nk; ++kt) {
            __syncthreads();
#pragma unroll
            for (int i = 0; i < 4; ++i) { const int id = tid + NTHR * i, row = id >> 3, ch = id & 7; *(u32x4*)(As + row * G_LDA + ch * 16) = ra[i]; }
#pragma unroll
            for (int i = 0; i < 2; ++i) { const int id = tid + NTHR * i, row = id >> 3, ch = id & 7; *(u32x4*)(Bs + row * G_LDA + ch * 16) = rb[i]; }
            __syncthreads();
            if (kt + 1 < nk) {
                const int ko = (kt + 1) * 64;
#pragma unroll
                for (int i = 0; i < 4; ++i) { const int id = tid + NTHR * i, row = id >> 3, ch = id & 7; ra[i] = *(const u32x4*)(Ab + (size_t)row * K + ko + ch * 8); }
#pragma unroll
                for (int i = 0; i < 2; ++i) { const int id = tid + NTHR * i, row = id >> 3, ch = id & 7; rb[i] = *(const u32x4*)(Bb + (size_t)row * K + ko + ch * 8); }
            }
#pragma unroll
            for (int ks = 0; ks < 4; ++ks) {
                bf16x8 a[2], b[2];
#pragma unroll
                for (int i = 0; i < 2; ++i) a[i] = *(const bf16x8*)(As + (wm * 64 + i * 32 + l31) * G_LDA + ks * 32 + hl * 16);
#pragma unroll
                for (int j = 0; j < 2; ++j) b[j] = *(const bf16x8*)(Bs + (wn * 64 + j * 32 + l31) * G_LDA + ks * 32 + hl * 16);
#pragma unroll
                for (int i = 0; i < 2; ++i)
#pragma unroll
                    for (int j = 0; j < 2; ++j) acc[i][j] = mfma32(a[i], b[j], acc[i][j]);
            }
        }
#pragma unroll
        for (int i = 0; i < 2; ++i)
#pragma unroll
            for (int j = 0; j < 2; ++j) epi(acc[i][j], mt * 256 + wm * 64 + i * 32, nt * 128 + wn * 64 + j * 32, lane);
    }
}

struct EpiIn {
    bf16_t* qkv; float* hf;
    __device__ __forceinline__ void operator()(const f32x16& acc, int row0, int col0, int lane) const {
        const int c = col0 + (lane & 31), h = lane >> 5;
        if (col0 < 768) {
#pragma unroll
            for (int r = 0; r < 16; ++r) { const int row = row0 + (r & 3) + 8 * (r >> 2) + 4 * h; qkv[(size_t)row * 768 + c] = (bf16_t)f2bf(acc[r]); }
        } else {
            float* dst = hf + (size_t)(c - 768) * T;
#pragma unroll
            for (int i = 0; i < 4; ++i) { const int row = row0 + 8 * i + 4 * h; f32x4 v; v.x = acc[4 * i]; v.y = acc[4 * i + 1]; v.z = acc[4 * i + 2]; v.w = acc[4 * i + 3]; *(f32x4*)(dst + row) = v; }
        }
    }
};
struct EpiRes {
    const float* base; float* out;
    __device__ __forceinline__ void operator()(const f32x16& acc, int row0, int col0, int lane) const {
        const int c = col0 + (lane & 31), h = lane >> 5;
#pragma unroll
        for (int r = 0; r < 16; ++r) { const size_t o = (size_t)(row0 + (r & 3) + 8 * (r >> 2) + 4 * h) * DM + c; out[o] = base[o] + acc[r]; }
    }
};
struct EpiF32 {
    float* out; int ld;
    __device__ __forceinline__ void operator()(const f32x16& acc, int row0, int col0, int lane) const {
        const int c = col0 + (lane & 31), h = lane >> 5;
#pragma unroll
        for (int r = 0; r < 16; ++r) { out[(size_t)(row0 + (r & 3) + 8 * (r >> 2) + 4 * h) * ld + c] = acc[r]; }
    }
};

namespace pg8 {
#define PG8_LAS __attribute__((address_space(3)))
constexpr int BM = 256, BK = 64, HALF = 128, HTB = HALF * BK * 2  , STAGE_BYTES = 8 * HTB, NXCD = 8, WGM = 8;

__host__ __device__ __forceinline__ int lds_byte(int r, int c) { const int st = (r >> 4) * 2 + (c >> 5), rr = r & 15, cc = c & 31, ob = rr * 64 + cc * 2; return st * 1024 + (ob ^ (((ob >> 9) & 1) << 5)); }
__host__ __device__ __forceinline__ void stage_rc(int b, int& R, int& C) { const int st = b / 1024, sb = b % 1024, swz = sb ^ (((sb >> 9) & 1) << 5); R = (st >> 1) * 16 + swz / 64; C = (st & 1) * 32 + (swz % 64) / 2; }
__host__ __device__ __forceinline__ int perm32(int rho) { const int n = rho >> 4, i = rho & 15; return 8 * (i >> 2) + 4 * n + (i & 3); }

struct Unit { int pm, pn; };
struct Gemm { const bf16_t* A; const bf16_t* Bt; int M, N, K; };

struct StaticOrder {
    int nM, nN, nwg, G, c;
    __host__ __device__ void init(int M, int N, int G_, int c_) { nM = M / BM; nN = N / BM; nwg = nM * nN; G = G_; c = c_; }
    __host__ __device__ bool next(int i, Unit& u) const {
        const long L = (long)i * G + c; if (L >= nwg) return false;
        int wgid = (int)L; { const int q = nwg / NXCD, r = nwg % NXCD, xcd = wgid % NXCD, off = wgid / NXCD; wgid = (xcd < r ? xcd * (q + 1) : r * (q + 1) + (xcd - r) * q) + off; }
        const int nig = WGM * nN, gid = wgid / nig, fm = gid * WGM, gsz = (nM - fm) < WGM ? (nM - fm) : WGM;
        u.pm = fm + ((wgid % nig) % gsz); u.pn = (wgid % nig) / gsz; return true;
    }
    __device__ __forceinline__ void a_ready(const Unit&) const {}
    __device__ __forceinline__ void done(const Unit&) const {}
};


__device__ __forceinline__ unsigned cvt_pk_bf16(float lo, float hi) { unsigned r; asm volatile("v_cvt_pk_bf16_f32 %0, %1, %2" : "=v"(r) : "v"(lo), "v"(hi)); return r; }
struct EpiStoreBf16 {
    static constexpr bool PERM = true, AFTER_DRAIN = false;
    bf16_t* O; int ldc;
    __device__ __forceinline__ void operator()(const f32x4 (&acc)[2][2][4][2], const Unit& u, int wr, int wc, int fr, int fq) const {
        const int row0 = u.pm * BM + wr * 64 + fr, col0 = u.pn * BM + wc * 32 + 8 * fq;
#pragma unroll
        for (int ai = 0; ai < 2; ++ai)
#pragma unroll
            for (int m = 0; m < 4; ++m) { bf16_t* rowp = O + (size_t)(row0 + ai * HALF + m * 16) * ldc + col0;
#pragma unroll
                for (int bj = 0; bj < 2; ++bj) { const f32x4 v0 = acc[ai][bj][m][0], v1 = acc[ai][bj][m][1];
                    u32x4 w; w.x = cvt_pk_bf16(v0[0], v0[1]); w.y = cvt_pk_bf16(v0[2], v0[3]); w.z = cvt_pk_bf16(v1[0], v1[1]); w.w = cvt_pk_bf16(v1[2], v1[3]);
                    *(u32x4*)(rowp + bj * HALF) = w; } }
    }
};
struct EpiOutProj {
    static constexpr bool PERM = false, AFTER_DRAIN = false;
    const float* base; float* O; bf16_t* XB; float* RS;
    __device__ __forceinline__ void operator()(const f32x4 (&acc)[2][2][4][2], const Unit& u, int wr, int wc, int fr, int fq) const {
        const int row0 = u.pm * BM + wr * 64 + fr, col0 = u.pn * BM + wc * 32 + 4 * fq;
#pragma unroll
        for (int ai = 0; ai < 2; ++ai)
#pragma unroll
            for (int m = 0; m < 4; ++m) { const int row = row0 + ai * HALF + m * 16; const size_t off = (size_t)row * 1024 + col0; float ss = 0.f;
#pragma unroll
                for (int bj = 0; bj < 2; ++bj)
#pragma unroll
                    for (int n = 0; n < 2; ++n) { const f32x4 v = acc[ai][bj][m][n] + *(const f32x4*)(base + off + bj * HALF + n * 16);
                        *(f32x4*)(O + off + bj * HALF + n * 16) = v; ss += v[0] * v[0] + v[1] * v[1] + v[2] * v[2] + v[3] * v[3];
                        u32x2 w; w.x = cvt_pk_bf16(v[0], v[1]); w.y = cvt_pk_bf16(v[2], v[3]); *(u32x2*)(XB + off + bj * HALF + n * 16) = w; }
                ss += __shfl_xor(ss, 16); ss += __shfl_xor(ss, 32);
                if (fq == 0) RS[(size_t)row * 16 + u.pn * 4 + wc] = ss; }
    }
};
struct EpiRowScaleF32 {
    static constexpr bool PERM = false, AFTER_DRAIN = false;
    float* O; int ldc; const float* RS;
    __device__ __forceinline__ void operator()(const f32x4 (&acc)[2][2][4][2], const Unit& u, int wr, int wc, int fr, int fq) const {
        const int row0 = u.pm * BM + wr * 64 + fr, col0 = u.pn * BM + wc * 32 + 4 * fq;
#pragma unroll
        for (int ai = 0; ai < 2; ++ai)
#pragma unroll
            for (int m = 0; m < 4; ++m) { const int row = row0 + ai * HALF + m * 16; const size_t off = (size_t)row * ldc + col0;
                float tot = 0.f;
#pragma unroll
                for (int q = 0; q < 4; ++q) { const f32x4 pr = *(const f32x4*)(RS + (size_t)row * 16 + 4 * q); tot += (pr[0] + pr[1]) + (pr[2] + pr[3]); }
                const float r = rsqrtf(tot * (1.0f / 1024.0f) + 1e-6f);
#pragma unroll
                for (int bj = 0; bj < 2; ++bj)
#pragma unroll
                    for (int n = 0; n < 2; ++n) *(f32x4*)(O + off + bj * HALF + n * 16) = acc[ai][bj][m][n] * r; }
    }
};
struct EpiStoreF32 {
    static constexpr bool PERM = false, AFTER_DRAIN = false;
    const float* base; float* O; int ldc;
    __device__ __forceinline__ void operator()(const f32x4 (&acc)[2][2][4][2], const Unit& u, int wr, int wc, int fr, int fq) const {
        const int row0 = u.pm * BM + wr * 64 + fr, col0 = u.pn * BM + wc * 32 + 4 * fq;
#pragma unroll
        for (int ai = 0; ai < 2; ++ai)
#pragma unroll
            for (int m = 0; m < 4; ++m) { const size_t off = (size_t)(row0 + ai * HALF + m * 16) * ldc + col0;
#pragma unroll
                for (int bj = 0; bj < 2; ++bj)
#pragma unroll
                    for (int n = 0; n < 2; ++n) { f32x4 v = acc[ai][bj][m][n]; if (base) v += *(const f32x4*)(base + off + bj * HALF + n * 16); *(f32x4*)(O + off + bj * HALF + n * 16) = v; } }
    }
};

template <class Epi, class Sched, bool ALIGN_EPI = false, bool SP2 = false>
__device__ __forceinline__ void gemm_phase(PG8_LAS unsigned char* lds, const Gemm g, const Sched& S, const Epi& E) {
    const int tid = otid(), wid = __builtin_amdgcn_readfirstlane(tid >> 6), lane = tid & 63, wr = wid >> 2, wc = wid & 3, fr = lane & 15, fq = lane >> 4;
    const int K = g.K, nt = K / BK;
    unsigned voffA[2], voffB[2];
#pragma unroll
    for (int i = 0; i < 2; ++i) { int R, C; stage_rc(tid * 16 + i * 8192, R, C); const int Rb = Epi::PERM ? ((R & ~31) + perm32(R & 31)) : R;
        voffA[i] = (unsigned)(R * K + C) * 2u; voffB[i] = (unsigned)(Rb * K + C) * 2u; }
    const size_t kstep = (size_t)(BK * 2);
    const size_t hstep = (size_t)HALF * K * 2;
    const size_t tstep = 2 * hstep;
    const unsigned ldsw = (unsigned)wid * 1024u;
    const int aoff = lds_byte(wr * 64 + fr, fq * 8), boff = lds_byte(wc * 32 + fr, fq * 8);
#define PG8_SA(b, h) (((b) * 2 + (h)) * HTB)
#define PG8_SB(b, h) ((4 + (b) * 2 + (h)) * HTB)
#define PG8_STAGE(bufoff, gbase, voff) do { _Pragma("unroll") for (int _i = 0; _i < 2; ++_i) \
        __builtin_amdgcn_global_load_lds((const unsigned*)((const char*)(gbase) + (voff)[_i]), (PG8_LAS unsigned*)(lds + (bufoff) + ldsw + _i * 8192), 16, 0, 0); } while (0)
#define PG8_LDA(dst, b, h) do { _Pragma("unroll") for (int m = 0; m < 4; ++m) _Pragma("unroll") for (int k = 0; k < 2; ++k) dst[m][k] = *(const PG8_LAS bf16x8*)(lds + PG8_SA(b, h) + aoff + m * 2048 + k * 1024); } while (0)
#define PG8_LDB(dst, b, h) do { _Pragma("unroll") for (int n = 0; n < 2; ++n) _Pragma("unroll") for (int k = 0; k < 2; ++k) dst[n][k] = *(const PG8_LAS bf16x8*)(lds + PG8_SB(b, h) + boff + n * 2048 + k * 1024); } while (0)
#define PG8_MMA(ai, bj, At, Bt) do { __builtin_amdgcn_s_setprio(1); _Pragma("unroll") for (int m = 0; m < 4; ++m) _Pragma("unroll") for (int n = 0; n < 2; ++n) _Pragma("unroll") for (int k = 0; k < 2; ++k) \
        acc[ai][bj][m][n] = __builtin_amdgcn_mfma_f32_16x16x32_bf16(Bt[n][k], At[m][k], acc[ai][bj][m][n], 0, 0, 0); __builtin_amdgcn_s_setprio(0); } while (0)
#define PG8_WAIT_V(n) asm volatile("s_waitcnt vmcnt(" #n ")" ::: "memory")
#define PG8_WAIT_L(n) asm volatile("s_waitcnt lgkmcnt(" #n ")" ::: "memory")
#define PG8_BAR __builtin_amdgcn_s_barrier()
#define PG8_SCHED __builtin_amdgcn_sched_barrier(0)
    Unit cur, nxt; int ui = 0;
    if (!S.next(0, cur)) return;
    f32x4 acc[2][2][4][2];
#pragma unroll
    for (int a = 0; a < 2; ++a)
#pragma unroll
        for (int b = 0; b < 2; ++b)
#pragma unroll
            for (int m = 0; m < 4; ++m)
#pragma unroll
                for (int n = 0; n < 2; ++n) acc[a][b][m][n] = (f32x4){0.f, 0.f, 0.f, 0.f};
    bf16x8 At[4][2], B0[2][2], B1[2][2];
    const char* cA = (const char*)g.A + (size_t)cur.pm * tstep; const char* cB = (const char*)g.Bt + (size_t)cur.pn * tstep;
    S.a_ready(cur);
    if constexpr (SP2) {
        PG8_STAGE(PG8_SB(0, 0), cB, voffB); PG8_STAGE(PG8_SB(0, 1), cB + hstep, voffB); PG8_STAGE(PG8_SA(0, 0), cA, voffA); PG8_STAGE(PG8_SA(0, 1), cA + hstep, voffA);
        if (wr == 1) PG8_BAR;
        PG8_WAIT_V(2); PG8_BAR;
        PG8_STAGE(PG8_SB(1, 0), cB + kstep, voffB); PG8_STAGE(PG8_SA(1, 0), cA + kstep, voffA); PG8_STAGE(PG8_SB(1, 1), cB + hstep + kstep, voffB);
        PG8_WAIT_V(6); PG8_BAR;
    } else {
        PG8_STAGE(PG8_SB(0, 0), cB, voffB); PG8_STAGE(PG8_SA(0, 0), cA, voffA); PG8_STAGE(PG8_SB(0, 1), cB + hstep, voffB); PG8_STAGE(PG8_SA(0, 1), cA + hstep, voffA);
        if (wr == 1) PG8_BAR;
        PG8_WAIT_V(4); PG8_BAR;
        PG8_STAGE(PG8_SB(1, 0), cB + kstep, voffB); PG8_STAGE(PG8_SA(1, 0), cA + kstep, voffA); PG8_STAGE(PG8_SB(1, 1), cB + hstep + kstep, voffB);
        PG8_WAIT_V(6); PG8_BAR;
    }
    for (;;) {
        const bool has_next = S.next(ui + 1, nxt);
        const char* nA = has_next ? (const char*)g.A + (size_t)nxt.pm * tstep : cA; const char* nB = has_next ? (const char*)g.Bt + (size_t)nxt.pn * tstep : cB;
        for (int t = 0; t < nt; t += 2) {
            const bool last = (t == nt - 2);
            const char* a1 = cA + (size_t)(t + 1) * kstep;
            const char* a2 = last ? nA : cA + (size_t)(t + 2) * kstep; const char* b2 = last ? nB : cB + (size_t)(t + 2) * kstep;
            const char* a3 = a2 + kstep; const char* b3 = b2 + kstep;
            if (last && has_next) S.a_ready(nxt);
            if constexpr (SP2) {
            PG8_LDB(B0, 0, 0); PG8_LDB(B1, 0, 1); PG8_SCHED; PG8_LDA(At, 0, 0); PG8_STAGE(PG8_SA(1, 1), a1 + hstep, voffA);
            PG8_WAIT_V(8); PG8_WAIT_L(0); PG8_BAR; PG8_MMA(0, 0, At, B0); PG8_MMA(0, 1, At, B1); PG8_BAR; PG8_SCHED;
            PG8_LDA(At, 0, 1); PG8_STAGE(PG8_SB(0, 0), b2, voffB); PG8_STAGE(PG8_SB(0, 1), b2 + hstep, voffB); PG8_STAGE(PG8_SA(0, 0), a2, voffA);
            PG8_WAIT_V(8); PG8_WAIT_L(0); PG8_BAR; PG8_MMA(1, 0, At, B0); PG8_MMA(1, 1, At, B1); PG8_BAR; PG8_SCHED;
            PG8_LDB(B0, 1, 0); PG8_LDB(B1, 1, 1); PG8_SCHED; PG8_LDA(At, 1, 0); PG8_STAGE(PG8_SA(0, 1), a2 + hstep, voffA);
            PG8_WAIT_V(8); PG8_WAIT_L(0); PG8_BAR; PG8_MMA(0, 0, At, B0); PG8_MMA(0, 1, At, B1); PG8_BAR; PG8_SCHED;
            PG8_LDA(At, 1, 1); PG8_STAGE(PG8_SB(1, 0), b3, voffB); PG8_STAGE(PG8_SB(1, 1), b3 + hstep, voffB); PG8_STAGE(PG8_SA(1, 0), a3, voffA);
            PG8_WAIT_V(8); PG8_WAIT_L(0); PG8_BAR; PG8_MMA(1, 0, At, B0); PG8_MMA(1, 1, At, B1); PG8_BAR; PG8_SCHED;
            } else {
            PG8_LDB(B0, 0, 0); PG8_SCHED; PG8_LDA(At, 0, 0); PG8_STAGE(PG8_SA(1, 1), a1 + hstep, voffA);
            PG8_WAIT_L(8); PG8_BAR; PG8_WAIT_L(0); PG8_MMA(0, 0, At, B0); PG8_BAR; PG8_SCHED;
            PG8_LDB(B1, 0, 1); PG8_STAGE(PG8_SB(0, 0), b2, voffB);
            PG8_BAR; PG8_WAIT_L(0); PG8_MMA(0, 1, At, B1); PG8_BAR;
            PG8_LDA(At, 0, 1); PG8_STAGE(PG8_SA(0, 0), a2, voffA);
            PG8_BAR; PG8_WAIT_L(0); PG8_MMA(1, 0, At, B0); PG8_BAR; PG8_SCHED;
            PG8_STAGE(PG8_SB(0, 1), b2 + hstep, voffB);
            PG8_WAIT_V(6); PG8_BAR; PG8_MMA(1, 1, At, B1); PG8_BAR;
            PG8_LDB(B0, 1, 0); PG8_SCHED; PG8_LDA(At, 1, 0); PG8_STAGE(PG8_SA(0, 1), a2 + hstep, voffA);
            PG8_WAIT_L(8); PG8_BAR; PG8_WAIT_L(0); PG8_MMA(0, 0, At, B0); PG8_BAR; PG8_SCHED;
            PG8_LDB(B1, 1, 1); PG8_STAGE(PG8_SB(1, 0), b3, voffB);
            PG8_BAR; PG8_WAIT_L(0); PG8_MMA(0, 1, At, B1); PG8_BAR;
            PG8_LDA(At, 1, 1); PG8_STAGE(PG8_SA(1, 0), a3, voffA);
            PG8_BAR; PG8_WAIT_L(0); PG8_MMA(1, 0, At, B0); PG8_BAR; PG8_SCHED;
            PG8_STAGE(PG8_SB(1, 1), b3 + hstep, voffB);
            PG8_WAIT_V(6); PG8_BAR; PG8_MMA(1, 1, At, B1); PG8_BAR;
            }
        }
        if constexpr (ALIGN_EPI) { if (wr == 0) PG8_BAR; }
        if constexpr (!Epi::AFTER_DRAIN) { E(acc, cur, wr, wc, fr, fq); S.done(cur); }
        if (!has_next) break;
#pragma unroll
        for (int a = 0; a < 2; ++a)
#pragma unroll
            for (int b = 0; b < 2; ++b)
#pragma unroll
                for (int m = 0; m < 4; ++m)
#pragma unroll
                    for (int n = 0; n < 2; ++n) acc[a][b][m][n] = (f32x4){0.f, 0.f, 0.f, 0.f};
        cur = nxt; cA = nA; cB = nB; ++ui;
        if constexpr (ALIGN_EPI) { if (wr == 1) PG8_BAR; }
    }
    PG8_WAIT_V(0);
    if constexpr (!ALIGN_EPI) { if (wr == 0) PG8_BAR; }
    PG8_BAR;
    if constexpr (Epi::AFTER_DRAIN) { E.fused(acc, cur, wr, wc, fr, fq, lds, wid, lane); S.done(cur); }
#undef PG8_SA
#undef PG8_SB
#undef PG8_STAGE
#undef PG8_LDA
#undef PG8_LDB
#undef PG8_MMA
#undef PG8_WAIT_V
#undef PG8_WAIT_L
#undef PG8_BAR
#undef PG8_SCHED
}
}

__device__ constexpr float ROPE_INV_REV[16] = {1.591549431e-01f, 8.949940161e-02f, 5.032921210e-02f, 2.830219583e-02f, 1.591549431e-02f, 8.949940161e-03f, 5.032921210e-03f, 2.830219583e-03f, 1.591549431e-03f, 8.949940161e-04f, 5.032921210e-04f, 2.830219583e-04f, 1.591549431e-04f, 8.949940161e-05f, 5.032921210e-05f, 2.830219583e-05f};
__device__ __forceinline__ void qk_norm_rope8(const u32x4 raw, const float (&gn)[8], const float (&cs)[8], const float (&sn)[8], bool second, float scale, u32x4& out) {
    float x[8] = {bflo(raw.x), bfhi(raw.x), bflo(raw.y), bfhi(raw.y), bflo(raw.z), bfhi(raw.z), bflo(raw.w), bfhi(raw.w)};
    float ss = 0.f;
#pragma unroll
    for (int e = 0; e < 8; ++e) ss += x[e] * x[e];
    ss += __shfl_xor(ss, 1); ss += __shfl_xor(ss, 2); ss += __shfl_xor(ss, 4);
    const float r = rsqrtf(ss * (1.0f / 64.0f) + EPS) ;
    float o[8];
#pragma unroll
    for (int e = 0; e < 8; ++e) {
        const float y = x[e] * r * gn[e];
        const float other = __shfl_xor(y, 2);
        o[e] = (second ? (y * cs[e] + other * sn[e]) : (y * cs[e] - other * sn[e])) * scale;
    }
    out.x = pk2(o[0], o[1]); out.y = pk2(o[2], o[3]); out.z = pk2(o[4], o[5]); out.w = pk2(o[6], o[7]);
}
__device__ __forceinline__ void phase_qkprep(const Params& p, int layer, char* lds, bf16_t* qout) {
    const int tid = otid(), lane = tid & 63, wave = tid >> 6;
    const bf16_t* qkv = (const bf16_t*)(p.ws + R_QKV);
    const int sub = lane & 7;
    const bool second = ((sub >> 1) & 1) != 0, colaxis = (sub >> 2) != 0;
    float gq[8], gk[8], ir[8];
#pragma unroll
    for (int e = 0; e < 8; ++e) {
        gq[e] = p.in[I_QG][layer * 64 + sub * 8 + e]; gk[e] = p.in[I_KG][layer * 64 + sub * 8 + e];
        ir[e] = (sub & 1) ? ROPE_INV_REV[8 + e] : ROPE_INV_REV[e];
    }
    const int gw = obid() * NWAVE + wave, ngw = NBLK * NWAVE;
    for (int t = gw; t < T; t += ngw) {
        const int l = t & (SL - 1);
        const float pos = colaxis ? (float)(l & 63) : (float)(l >> 6);
        float cs[8], sn[8];
#pragma unroll
        for (int e = 0; e < 8; ++e) { const float a = pos * ir[e]; cs[e] = __builtin_amdgcn_cosf(a); sn[e] = __builtin_amdgcn_sinf(a); }
        const u32x4 rq = *(const u32x4*)(qkv + (size_t)t * 768 + lane * 8);
        u32x4 rk = {0u, 0u, 0u, 0u};
        if (lane < 16) rk = *(const u32x4*)(qkv + (size_t)t * 768 + 512 + lane * 8);
        u32x4 oq, ok;
        qk_norm_rope8(rq, gq, cs, sn, second, 0.125f * 1.4426950408889634f, oq);
        qk_norm_rope8(rk, gk, cs, sn, second, 1.0f, ok);
        *(u32x4*)(qout + (size_t)t * 768 + lane * 8) = oq;
        if (lane < 16) *(u32x4*)(qout + (size_t)t * 768 + 512 + lane * 8) = ok;
    }
}

#include <hip/hip_bf16.h>
#include <cmath>
namespace attn_body {
using bf16=__hip_bfloat16;
using bf16x8=__attribute__((ext_vector_type(8)))short;
using s16x4=__attribute__((ext_vector_type(4)))short;
using f32x16=__attribute__((ext_vector_type(16)))float;
using u32x4=__attribute__((ext_vector_type(4)))unsigned;
constexpr int SEQ=8192,D=64,PQ=768,PO=512;
constexpr int NW=8,QBLK=32,QB=QBLK*NW,KVBLK=64,NQB=SEQ/QB;
constexpr int ATTN_UNIT_ROWS=QB;
__device__ __forceinline__ int crow(int r,int hi){return (r&3)+8*(r>>2)+4*hi;}
#define SBAR() __builtin_amdgcn_sched_barrier(0)
__device__ __forceinline__ void cmask(f32x16&p0,f32x16&p1,int jb,int qrel,int hi){
  const float NEG=-INFINITY; int kb=64*jb+4*hi;
  #pragma unroll
  for(int r=0;r<16;++r){int kv=kb+(r&3)+8*(r>>2); if(kv>qrel)p0[r]=NEG; if(kv+32>qrel)p1[r]=NEG;}
}

constexpr int NSLOT=3, SLOTB=8192;
constexpr int LDS_K=0, LDS_V=NSLOT*SLOTB, LDS_WS=2*NSLOT*SLOTB, LDS_OST=LDS_WS+NW*64*4, LDS_BYTES=LDS_OST+NW*4096;
constexpr float C2=0.125f*1.4426950408889634f;
__device__ __forceinline__ void glds16(const void*gsrc,unsigned lds_dst){unsigned keep;
  asm volatile("s_mov_b32 %0, m0\n\ts_mov_b32 m0, %2\n\ts_nop 0\n\tglobal_load_lds_dwordx4 %1, off\n\ts_mov_b32 m0, %0":"=&s"(keep):"v"(gsrc),"s"(lds_dst):"memory");}
__device__ __forceinline__ float max3f(float a,float b,float c){float r;asm("v_max3_f32 %0, %1, %2, %3":"=v"(r):"v"(a),"v"(b),"v"(c));return r;}
__device__ __forceinline__ float max2f(float a,float b){float r;asm("v_max_f32_e32 %0, %1, %2":"=v"(r):"v"(a),"v"(b));return r;}
__device__ __forceinline__ float fadd_s(float a,float b){float r;asm("v_add_f32_e32 %0, %1, %2":"=v"(r):"v"(a),"v"(b));return r;}
__device__ __forceinline__ float fsub_s(float a,float b){float r;asm("v_sub_f32_e32 %0, %1, %2":"=v"(r):"v"(a),"v"(b));return r;}
typedef float f32x2_t __attribute__((ext_vector_type(2))); typedef __bf16 bf16x2_t __attribute__((ext_vector_type(2)));
__device__ __forceinline__ unsigned cvtpk_s(float lo,float hi){f32x2_t v={lo,hi};bf16x2_t b=__builtin_convertvector(v,bf16x2_t);return __builtin_bit_cast(unsigned,b);}
#define WAIT_BAR(N) asm volatile("s_waitcnt vmcnt(" #N ") lgkmcnt(0)\n\ts_barrier":::"memory")

__device__ __forceinline__ void qkt(f32x16&p0,f32x16&p1,const char*Kslot,const bf16x8*qr,const f32x16&negm,int r32,int hi){
  const char*kb=Kslot+hi*1024+r32*16;
  #pragma unroll
  for(int d0=0;d0<4;++d0){
    const bf16x8 b0=*reinterpret_cast<const bf16x8*>(kb+d0*2048);
    const bf16x8 b1=*reinterpret_cast<const bf16x8*>(kb+d0*2048+512);
    if(d0==0){p0=__builtin_amdgcn_mfma_f32_32x32x16_bf16(b0,qr[0],negm,0,0,0);p1=__builtin_amdgcn_mfma_f32_32x32x16_bf16(b1,qr[0],negm,0,0,0);}
    else{p0=__builtin_amdgcn_mfma_f32_32x32x16_bf16(b0,qr[d0],p0,0,0,0);p1=__builtin_amdgcn_mfma_f32_32x32x16_bf16(b1,qr[d0],p1,0,0,0);}}
}
typedef __attribute__((address_space(3))) const char* lds_cptr;
typedef short v4i16_t __attribute__((ext_vector_type(4)));
__device__ __forceinline__ void kload8(bf16x8*kf,lds_cptr kp){
  kf[0]=*(const __attribute__((address_space(3))) bf16x8*)(kp);      kf[1]=*(const __attribute__((address_space(3))) bf16x8*)(kp+512);
  kf[2]=*(const __attribute__((address_space(3))) bf16x8*)(kp+2048); kf[3]=*(const __attribute__((address_space(3))) bf16x8*)(kp+2560);
  kf[4]=*(const __attribute__((address_space(3))) bf16x8*)(kp+4096); kf[5]=*(const __attribute__((address_space(3))) bf16x8*)(kp+4608);
  kf[6]=*(const __attribute__((address_space(3))) bf16x8*)(kp+6144); kf[7]=*(const __attribute__((address_space(3))) bf16x8*)(kp+6656);
}
__device__ __forceinline__ void kload2(bf16x8*kf,lds_cptr kp,int j){ kf[2*j]=*(const __attribute__((address_space(3))) bf16x8*)(kp+j*2048); kf[2*j+1]=*(const __attribute__((address_space(3))) bf16x8*)(kp+j*2048+512); }
__device__ __forceinline__ s16x4 vtr(lds_cptr p){ return __builtin_bit_cast(s16x4,__builtin_amdgcn_ds_read_tr16_b64_v4i16((__attribute__((address_space(3))) v4i16_t*)p)); }
__device__ __forceinline__ float rowmax(const f32x16&p0,const f32x16&p1){
  float a=max3f(p0[0],p0[1],p1[0]),b=max3f(p0[2],p0[3],p1[1]);a=max3f(a,p1[2],p1[3]);
  #pragma unroll
  for(int r=4;r<16;r+=4){a=max3f(a,p0[r],p0[r+1]);b=max3f(b,p0[r+2],p0[r+3]);a=max3f(a,p1[r],p1[r+1]);b=max3f(b,p1[r+2],p1[r+3]);}
  const float m=max2f(a,b);
  auto rr=__builtin_amdgcn_permlane32_swap(__float_as_uint(m),__float_as_uint(m),false,false);
  return max2f(__uint_as_float(rr[0]),__uint_as_float(rr[1]));
}
__device__ __forceinline__ void pv(f32x16*o,int vb,bf16x8 pa0,bf16x8 pa1,bf16x8 pa2,bf16x8 pa3){
  #pragma unroll
  for(int d0=0;d0<2;++d0){s16x4 lo[4],hi[4];
    #pragma unroll
    for(int ks=0;ks<4;++ks){
      asm volatile("ds_read_b64_tr_b16 %0,%1 offset:%c2":"=&v"(lo[ks]):"v"(vb),"i"(d0*4096+ks*1024):"memory");
      asm volatile("ds_read_b64_tr_b16 %0,%1 offset:%c2":"=&v"(hi[ks]):"v"(vb),"i"(d0*4096+ks*1024+512):"memory");}
    asm volatile("s_waitcnt lgkmcnt(0)":::"memory");SBAR();
    #define PK(k) (bf16x8){lo[k][0],lo[k][1],lo[k][2],lo[k][3],hi[k][0],hi[k][1],hi[k][2],hi[k][3]}
    o[d0]=__builtin_amdgcn_mfma_f32_32x32x16_bf16(pa0,PK(0),o[d0],0,0,0);
    o[d0]=__builtin_amdgcn_mfma_f32_32x32x16_bf16(pa1,PK(1),o[d0],0,0,0);
    o[d0]=__builtin_amdgcn_mfma_f32_32x32x16_bf16(pa2,PK(2),o[d0],0,0,0);
    o[d0]=__builtin_amdgcn_mfma_f32_32x32x16_bf16(pa3,PK(3),o[d0],0,0,0);
    #undef PK
  }
}

#ifndef ATTN_STORE16
#define ATTN_STORE16(p,v) (*(u32x4*)(p)=(v))
#endif
template<int THRL> __device__ __forceinline__ void attn_unit(int b,int h,int g,int qb,const bf16*Q,const bf16*__restrict__ K,const bf16*__restrict__ V,bf16*O,char*shm){
  const int tid=otid(),lane=tid&63,r32=lane&31,hi=lane>>5; const int wid=__builtin_amdgcn_readfirstlane(tid>>6);
  const long rowbase=(long)b*SEQ; const int q0=qb*QB;
  const bf16*Qw=Q+(rowbase+q0+wid*QBLK)*PQ+h*D;
  const bf16*Kh=K+rowbase*PQ+g*D,*Vh=V+rowbase*PQ+g*D;
  const unsigned lds0=(unsigned)(uintptr_t)shm;
  float*wsf=(float*)(shm+LDS_WS)+wid*64;
  const bf16*ksrc=Kh+(long)lane*PQ+wid*8;
  const bf16*vsrc=Vh+(long)(16*(wid&3)+(lane>>2))*PQ+(wid>>2)*32+(lane&3)*8;
  const unsigned kdst=lds0+LDS_K+wid*1024, vdst=lds0+LDS_V+wid*1024;
  #define DMA_K(t,slot) glds16(ksrc+(long)(t)*KVBLK*PQ,(unsigned)__builtin_amdgcn_readfirstlane(kdst+(slot)))
  #define DMA_V(t,slot) glds16(vsrc+(long)(t)*KVBLK*PQ,(unsigned)__builtin_amdgcn_readfirstlane(vdst+(slot)))
  const int vb0=(int)(lds0+LDS_V)+((lane>>4)&1)*32+(lane&3)*8+(4*hi+((lane&15)>>2))*64;
  const char*Kbase=shm+LDS_K; bf16x8 kf[8];
  const lds_cptr shm3=(lds_cptr)shm; const lds_cptr kp0=shm3+LDS_K+hi*1024+r32*16; const lds_cptr vp0=shm3+LDS_V+((lane>>4)&1)*32+(lane&3)*8+(4*hi+((lane&15)>>2))*64;
  constexpr int NT=SEQ/KVBLK;
  DMA_K(0,0);DMA_V(0,0);DMA_K(1,SLOTB);
  bf16x8 qr[4];
  #pragma unroll
  for(int d0=0;d0<4;++d0)qr[d0]=*reinterpret_cast<const bf16x8*>(&Qw[(long)r32*PQ+d0*16+hi*8]);
  float mhat=0.f,l_reg=0.f;f32x16 o[2];o[0]=f32x16{};o[1]=f32x16{};f32x16 negm=f32x16{};asm volatile("":"+v"(negm));
    #define CMASK(P0,P1,t) do{}while(0)
  bool resc=false;
  #define START(P0,P1) do{ const float rm=rowmax(P0,P1); resc=false; \
    { const float dl=rm; mhat=fadd_s(mhat,dl); \
      _Pragma("unroll") for(int r=0;r<16;++r){P0[r]=fsub_s(P0[r],dl);P1[r]=fsub_s(P1[r],dl);} \
      _Pragma("unroll") for(int r=0;r<16;++r)negm[r]=-mhat; asm volatile("":"+v"(negm)); } \
    _Pragma("unroll") for(int r=0;r<16;++r)P0[r]=__builtin_amdgcn_exp2f(P0[r]); }while(0)
  #define RESC() do{ if(resc){ asm volatile("s_waitcnt lgkmcnt(0)":::"memory"); \
      _Pragma("unroll") for(int d_=0;d_<2;++d_) _Pragma("unroll") for(int r=0;r<16;++r)o[d_][r]*=wsf[crow(r,hi)]; } }while(0)
  f32x16 pA0,pA1,pB0,pB1;
  int sl_prev=0,sl_cur=0,sl_next=SLOTB;
  #define ROT() do{sl_prev=sl_cur;sl_cur=sl_next;sl_next=(sl_next==(NSLOT-1)*SLOTB)?0:sl_next+SLOTB;}while(0)
  DMA_K(2,2*SLOTB);
  WAIT_BAR(3);
  qkt(pA0,pA1,Kbase,qr,negm,r32,hi);asm volatile("s_nop 15\n\ts_nop 7":"+v"(pA0),"+v"(pA1));CMASK(pA0,pA1,0);
  START(pA0,pA1);
  _Pragma("unroll") for(int r=0;r<16;++r)pA1[r]=__builtin_amdgcn_exp2f(pA1[r]);
  WAIT_BAR(0);
  DMA_K(3,0);DMA_V(1,SLOTB);
  ROT();
  kload8(kf,kp0+sl_cur);
  WAIT_BAR(2);
  s16x4 vlo[8],vhi[8]; u32x4 pw0,pw1,pw2,pw3;
  #define PKW(P,B) cvtpk_s(P[B],P[B+1])
  #define PAF(k) __builtin_bit_cast(bf16x8,pw##k)
  #define VFR(i) (bf16x8){vlo[i][0],vlo[i][1],vlo[i][2],vlo[i][3],vhi[i][0],vhi[i][1],vhi[i][2],vhi[i][3]}
  #define PIN(x) asm volatile("":"+v"(x))
  #define MX3(a,b,c) __builtin_fmaxf(__builtin_fmaxf((a),(b)),(c))
  #define GAPA(MF,A0,A1,A2,A3,W0,W1,PW) do{ MF; sacc+=A0; sacc+=A1; sacc+=A2; sacc+=A3; PIN(sacc); W0; W1; PIN(PW); SBAR(); }while(0)
  #define EX(v) __builtin_amdgcn_exp2f(v)
  #define GAPB(MF,X,B) do{ MF; X[B]=EX(X[B]); X[B+1]=EX(X[B+1]); X[B+2]=EX(X[B+2]); X[B+3]=EX(X[B+3]); PIN(X); SBAR(); }while(0)
  #define VRD(i) do{ vlo[i]=vtr(vp_+(((i)>>2)*4096+((i)&3)*1024)); vhi[i]=vtr(vp_+(((i)>>2)*4096+((i)&3)*1024+512)); }while(0)
  #define KRD(G,j) do{ if(G){ kload2(kf,kp0+sl_next,j); SBAR(); } }while(0)
  #define STEP(C0,C1,P0,P1,t,GK,GV,GL) do{ SBAR(); \
    const lds_cptr vp_=vp0+sl_prev; \
    VRD(0); SBAR(); float sacc=(P0[0]+P0[1]); \
    GAPA(C0=__builtin_amdgcn_mfma_f32_32x32x16_bf16(kf[0],qr[0],negm,0,0,0), P0[2],P0[3],P0[4],P0[5],     pw0[0]=PKW(P0,0), pw0[1]=PKW(P0,2), pw0); \
    VRD(4); SBAR(); GAPA(C1=__builtin_amdgcn_mfma_f32_32x32x16_bf16(kf[1],qr[0],negm,0,0,0), P0[6],P0[7],P0[8],P0[9],     pw0[2]=PKW(P0,4), pw0[3]=PKW(P0,6), pw0); \
    VRD(1); SBAR(); GAPA(C0=__builtin_amdgcn_mfma_f32_32x32x16_bf16(kf[2],qr[1],C0,0,0,0),   P0[10],P0[11],P0[12],P0[13], pw1[0]=PKW(P0,8), pw1[1]=PKW(P0,10), pw1); \
    VRD(5); SBAR(); GAPA(C1=__builtin_amdgcn_mfma_f32_32x32x16_bf16(kf[3],qr[1],C1,0,0,0),   P0[14],P0[15],P1[0],P1[1],   pw1[2]=PKW(P0,12),pw1[3]=PKW(P0,14), pw1); \
    VRD(2); SBAR(); GAPA(C0=__builtin_amdgcn_mfma_f32_32x32x16_bf16(kf[4],qr[2],C0,0,0,0),   P1[2],P1[3],P1[4],P1[5],     pw2[0]=PKW(P1,0), pw2[1]=PKW(P1,2), pw2); \
    VRD(6); SBAR(); GAPA(C1=__builtin_amdgcn_mfma_f32_32x32x16_bf16(kf[5],qr[2],C1,0,0,0),   P1[6],P1[7],P1[8],P1[9],     pw2[2]=PKW(P1,4), pw2[3]=PKW(P1,6), pw2); \
    VRD(3); SBAR(); GAPA(C0=__builtin_amdgcn_mfma_f32_32x32x16_bf16(kf[6],qr[3],C0,0,0,0),   P1[10],P1[11],P1[12],P1[13], pw3[0]=PKW(P1,8), pw3[1]=PKW(P1,10), pw3); \
    VRD(7); SBAR(); GAPA(C1=__builtin_amdgcn_mfma_f32_32x32x16_bf16(kf[7],qr[3],C1,0,0,0),   P1[14],P1[15],0.f,0.f,       pw3[2]=PKW(P1,12),pw3[3]=PKW(P1,14), pw3); \
    l_reg+=sacc; \
    if(GK){DMA_K((t)+3,sl_cur);} if(GV){DMA_V((t)+1,sl_next);} \
    CMASK(C0,C1,t); \
    { float a=MX3(C0[0],C0[1],C1[0]),b=MX3(C0[2],C0[3],C1[1]); a=MX3(a,C1[2],C1[3]); \
      _Pragma("unroll") for(int r=4;r<16;r+=4){a=MX3(a,C0[r],C0[r+1]);b=MX3(b,C0[r+2],C0[r+3]);a=MX3(a,C1[r],C1[r+1]);b=MX3(b,C1[r+2],C1[r+3]);} \
      float rm=__builtin_fmaxf(a,b); { auto rr=__builtin_amdgcn_permlane32_swap(__float_as_uint(rm),__float_as_uint(rm),false,false); rm=__builtin_fmaxf(__uint_as_float(rr[0]),__uint_as_float(rr[1])); } \
      resc=false; \
      if(__builtin_expect(__any(rm>(float)THRL),0)){ const float dl=__builtin_fmaxf(rm,0.f); mhat+=dl; \
        _Pragma("unroll") for(int r=0;r<16;++r){C0[r]-=dl;C1[r]-=dl;} \
        _Pragma("unroll") for(int r=0;r<16;++r)negm[r]=-mhat; asm volatile("":"+v"(negm)); \
        const float f=__builtin_amdgcn_exp2f(-dl); l_reg*=f; if(hi==0)wsf[r32]=f; resc=true; } } \
    SBAR(); \
    GAPB(o[0]=__builtin_amdgcn_mfma_f32_32x32x16_bf16(PAF(0),VFR(0),o[0],0,0,0), C0,0); \
    GAPB(o[1]=__builtin_amdgcn_mfma_f32_32x32x16_bf16(PAF(0),VFR(4),o[1],0,0,0), C0,4); \
    KRD(GL,0); GAPB(o[0]=__builtin_amdgcn_mfma_f32_32x32x16_bf16(PAF(1),VFR(1),o[0],0,0,0), C0,8); \
    KRD(GL,1); GAPB(o[1]=__builtin_amdgcn_mfma_f32_32x32x16_bf16(PAF(1),VFR(5),o[1],0,0,0), C0,12); \
    KRD(GL,2); GAPB(o[0]=__builtin_amdgcn_mfma_f32_32x32x16_bf16(PAF(2),VFR(2),o[0],0,0,0), C1,0); \
    KRD(GL,3); GAPB(o[1]=__builtin_amdgcn_mfma_f32_32x32x16_bf16(PAF(2),VFR(6),o[1],0,0,0), C1,4); \
    GAPB(o[0]=__builtin_amdgcn_mfma_f32_32x32x16_bf16(PAF(3),VFR(3),o[0],0,0,0), C1,8); \
    GAPB(o[1]=__builtin_amdgcn_mfma_f32_32x32x16_bf16(PAF(3),VFR(7),o[1],0,0,0), C1,12); \
    }while(0)
  int t=1;
  #undef CMASK
  #define CMASK(P0,P1,t) do{}while(0)
  for(;t+5<NT;t+=2){
    STEP(pB0,pB1,pA0,pA1,t,true,true,true);     WAIT_BAR(2); RESC(); ROT();
    STEP(pA0,pA1,pB0,pB1,t+1,true,true,true);   WAIT_BAR(2); RESC(); ROT();
  }
  #define ENDW(tt) do{ if((tt)+3<NT){WAIT_BAR(2);} else if((tt)+2<NT){WAIT_BAR(1);} else {WAIT_BAR(0);} }while(0)
  for(;t+1<NT;t+=2){
    STEP(pB0,pB1,pA0,pA1,t,(t+3<NT),(t+1<NT),(t+1<NT));       ENDW(t);   RESC(); ROT();
    STEP(pA0,pA1,pB0,pB1,t+1,(t+4<NT),(t+2<NT),(t+2<NT));     ENDW(t+1); RESC(); ROT();
  }
  STEP(pB0,pB1,pA0,pA1,NT-1,false,false,false); RESC();
  { float sacc=pB0[0]+pB0[1]; _Pragma("unroll") for(int r=2;r<16;++r)sacc+=pB0[r]; _Pragma("unroll") for(int r=0;r<16;++r)sacc+=pB1[r]; l_reg+=sacc;
    pw0=(u32x4){PKW(pB0,0),PKW(pB0,2),PKW(pB0,4),PKW(pB0,6)};pw1=(u32x4){PKW(pB0,8),PKW(pB0,10),PKW(pB0,12),PKW(pB0,14)};pw2=(u32x4){PKW(pB1,0),PKW(pB1,2),PKW(pB1,4),PKW(pB1,6)};pw3=(u32x4){PKW(pB1,8),PKW(pB1,10),PKW(pB1,12),PKW(pB1,14)};
    SBAR(); pv(o,vb0+sl_cur,PAF(0),PAF(1),PAF(2),PAF(3)); }
  #undef PKW
  #undef PAF
  #undef VFR
  #undef PIN
  #undef MX3
  #undef GAPA
  #undef GAPB
  #undef EX
  #undef VRD
  #undef KRD
  #undef STEP
  #undef ENDW
  {auto rr=__builtin_amdgcn_permlane32_swap(__float_as_uint(l_reg),__float_as_uint(l_reg),false,false);l_reg=__uint_as_float(rr[0])+__uint_as_float(rr[1]);}
  if(hi==0)wsf[32+r32]=l_reg;asm volatile("s_waitcnt lgkmcnt(0)":::"memory");
  float rli[16];
  #pragma unroll
  for(int r=0;r<16;++r)rli[r]=__builtin_amdgcn_rcpf(wsf[32+crow(r,hi)]);
  bf16*Ow=O+(rowbase+q0+wid*QBLK)*PO+h*D;
  { bf16*stg=(bf16*)(shm+LDS_OST)+wid*2048;
    #pragma unroll
    for(int r=0;r<16;++r){const int orow=crow(r,hi);
      #pragma unroll
      for(int d0=0;d0<2;++d0)stg[orow*64+d0*32+r32]=__float2bfloat16(o[d0][r]*rli[r]);}
    asm volatile("s_waitcnt lgkmcnt(0)":::"memory");
    #pragma unroll
    for(int i=0;i<4;++i){const int row=i*8+(lane>>3),ch=lane&7; const u32x4 v=*(const u32x4*)(stg+row*64+ch*8); ATTN_STORE16(Ow+(long)row*PO+ch*8,v);} }
  asm volatile("s_waitcnt lgkmcnt(0)\n\ts_barrier":::"memory");
  #undef DMA_K
  #undef DMA_V
  #undef CMASK
  #undef START
  #undef RESC
  #undef ROT
}
constexpr int ATTN_LDS_BYTES=LDS_BYTES;
#undef SBAR
#undef WAIT_BAR
}

__device__ __forceinline__ void phase_attn(const Params& p, char* lds) {
            {
                const int bid = obid();
                const int vcu = ((NBLK & 7) == 0) ? (bid & 7) * (int)(NBLK >> 3) + (bid >> 3) : bid;
                const attn_body::bf16* qkvb = (const attn_body::bf16*)(p.ws + R_QKV);
                for (int u = vcu; u < 512; u += NBLK) {
                    const int bg = (u & 255) >> 6, r = u & 63, hh = r & 3, qb = (r >> 2) + 16 * (u >> 8);
                    const int b = bg >> 1, g = bg & 1;
                    attn_body::attn_unit<8>(b, 4 * g + hh, g, qb, qkvb, qkvb + 512, qkvb + 640, (attn_body::bf16*)(p.ws + R_ATT), lds);
                }
            }
}

__device__ __forceinline__ f32x4 convd4(const float* row, int l0, float w0, float w1, float w2, float cb) {
    const f32x4 c = *(const f32x4*)(row + l0);
    const float lft = (l0 > 0) ? row[l0 - 1] : 0.f;
    const float rgt = (l0 + 4 < SL) ? row[l0 + 4] : 0.f;
    f32x4 o;
    o.x = cb + w0 * lft + w1 * c.x + w2 * c.y;
    o.y = cb + w0 * c.x + w1 * c.y + w2 * c.z;
    o.z = cb + w0 * c.y + w1 * c.z + w2 * c.w;
    o.w = cb + w0 * c.z + w1 * c.w + w2 * rgt;
    return o;
}
__device__ __forceinline__ void cmul_kf(float2* Z, const float2* KF, int tid) {
#pragma unroll 4
    for (int i = 0; i < 16; ++i) {
        const int pp = 2 * tid + 1024 * i;
        const f32x4 z = *(const f32x4*)(Z + zp(pp)), k = *(const f32x4*)(KF + pp);
        f32x4 o; o.x = z.x * k.x - z.y * k.y; o.y = z.x * k.y + z.y * k.x; o.z = z.z * k.z - z.w * k.w; o.w = z.z * k.w + z.w * k.z;
        *(f32x4*)(Z + zp(pp)) = o;
    }
}
__device__ __forceinline__ void hyena_job(const Params& p, int layer, int c, char* lds) {
    const int tid = otid();
    float2* Z = (float2*)lds;
    const float* HF = (const float*)(p.ws + R_HF);
    const float* cw = p.in[I_CW] + (size_t)layer * 3 * 768; const float* cbp = p.in[I_CB] + layer * 768;
    const float2* KF0 = (const float2*)(p.ws + OFF_KF) + ((size_t)(layer * 256 + c) * 2) * 16384;
    const float2* KF1 = KF0 + 16384;
    float* Y = (float*)(p.ws + R_Y) + (size_t)c * T;
    const float bias0 = p.in[I_HB][(layer * 2 + 0) * 256 + c], bias1 = p.in[I_HB][(layer * 2 + 1) * 256 + c];
    const int cv = c, c1 = 256 + c, c2 = 512 + c;
    const float* rv = HF + (size_t)cv * T; const float* r1 = HF + (size_t)c1 * T; const float* r2 = HF + (size_t)c2 * T;
    const float v_w0 = cw[cv], v_w1 = cw[768 + cv], v_w2 = cw[1536 + cv], v_cb = cbp[cv];
    const float a_w0 = cw[c1], a_w1 = cw[768 + c1], a_w2 = cw[1536 + c1], a_cb = cbp[c1];
    const float b_w0 = cw[c2], b_w1 = cw[768 + c2], b_w2 = cw[1536 + c2], b_cb = cbp[c2];
    const f32x4 zero4 = {0.f, 0.f, 0.f, 0.f};
    __syncthreads();
#pragma unroll 1
    for (int i = 0; i < 4; ++i) {
        const int l0 = 4 * otid() + 2048 * i;
        const f32x4 va = convd4(rv, l0, v_w0, v_w1, v_w2, v_cb), vb = convd4(rv + SL, l0, v_w0, v_w1, v_w2, v_cb);
        *(f32x4*)(Z + zp(l0)) = (f32x4){va.x, vb.x, va.y, vb.y}; *(f32x4*)(Z + zp(l0) + 2) = (f32x4){va.z, vb.z, va.w, vb.w};
        *(f32x4*)(Z + zp(8192 + l0)) = zero4; *(f32x4*)(Z + zp(8192 + l0) + 2) = zero4;
    }
    __syncthreads();
    fft16k_fwd(Z);
    cmul_kf(Z, KF0, otid());
    __syncthreads();
    fft16k_inv(Z);
#pragma unroll 1
    for (int i = 0; i < 4; ++i) {
        const int l0 = 4 * otid() + 2048 * i;
        const f32x4 za = *(const f32x4*)(Z + zp(l0)), zb = *(const f32x4*)(Z + zp(l0) + 2);
        const f32x4 va = convd4(rv, l0, v_w0, v_w1, v_w2, v_cb), vb = convd4(rv + SL, l0, v_w0, v_w1, v_w2, v_cb);
        const f32x4 ga = convd4(r1, l0, a_w0, a_w1, a_w2, a_cb), gb = convd4(r1 + SL, l0, a_w0, a_w1, a_w2, a_cb);
        f32x4 ya, yb;
        ya.x = ga.x * (za.x + va.x * bias0); ya.y = ga.y * (za.z + va.y * bias0); ya.z = ga.z * (zb.x + va.z * bias0); ya.w = ga.w * (zb.z + va.w * bias0);
        yb.x = gb.x * (za.y + vb.x * bias0); yb.y = gb.y * (za.w + vb.y * bias0); yb.z = gb.z * (zb.y + vb.z * bias0); yb.w = gb.w * (zb.w + vb.w * bias0);
        *(f32x4*)(Y + l0) = ya; *(f32x4*)(Y + SL + l0) = yb;
        *(f32x4*)(Z + zp(l0)) = (f32x4){ya.x, yb.x, ya.y, yb.y}; *(f32x4*)(Z + zp(l0) + 2) = (f32x4){ya.z, yb.z, ya.w, yb.w};
        *(f32x4*)(Z + zp(8192 + l0)) = zero4; *(f32x4*)(Z + zp(8192 + l0) + 2) = zero4;
    }
    __syncthreads();
    fft16k_fwd(Z);
    cmul_kf(Z, KF1, otid());
    __syncthreads();
    fft16k_inv(Z);
#pragma unroll 1
    for (int i = 0; i < 4; ++i) {
        const int l0 = 4 * otid() + 2048 * i;
        const f32x4 za = *(const f32x4*)(Z + zp(l0)), zb = *(const f32x4*)(Z + zp(l0) + 2);
        const f32x4 ga = convd4(r2, l0, b_w0, b_w1, b_w2, b_cb), gb = convd4(r2 + SL, l0, b_w0, b_w1, b_w2, b_cb);
        const f32x4 pa = *(const f32x4*)(Y + l0), pb = *(const f32x4*)(Y + SL + l0);
        f32x4 ya, yb;
        ya.x = ga.x * (za.x + pa.x * bias1); ya.y = ga.y * (za.z + pa.y * bias1); ya.z = ga.z * (zb.x + pa.z * bias1); ya.w = ga.w * (zb.z + pa.w * bias1);
        yb.x = gb.x * (za.y + pb.x * bias1); yb.y = gb.y * (za.w + pb.y * bias1); yb.z = gb.z * (zb.y + pb.z * bias1); yb.w = gb.w * (zb.w + pb.w * bias1);
        *(f32x4*)(Y + l0) = ya; *(f32x4*)(Y + SL + l0) = yb;
    }
    __syncthreads();
}

__device__ __forceinline__ void fnet_job(const Params& p, int ch, char* lds) {
    const int tid = otid();
    float2* Z = (float2*)lds;
    const float* row = (const float*)(p.ws + R_HF) + (size_t)(768 + ch) * T;
    float* UR = (float*)(p.ws + R_UR) + (size_t)ch * T;
    float* UI = (float*)(p.ws + R_UI) + (size_t)ch * T;
    __syncthreads();
#pragma unroll
    for (int i = 0; i < 4; ++i) {
        const int l0 = 4 * tid + 2048 * i;
        const f32x4 a = *(const f32x4*)(row + l0), b = *(const f32x4*)(row + SL + l0);
        const int z0 = zp(l0);
        *(f32x4*)(Z + z0) = (f32x4){a.x, b.x, a.y, b.y}; *(f32x4*)(Z + z0 + 2) = (f32x4){a.z, b.z, a.w, b.w};
    }
    __syncthreads();
    fft8k_fwd(Z);
#pragma unroll
    for (int i = 0; i < 4; ++i) {
        const int k0 = 4 * tid + 2048 * i;
        f32x4 ur0, ui0, ur1, ui1;
#pragma unroll
        for (int e = 0; e < 4; ++e) {
            const int k = k0 + e;
            const int pk = p8k_of_f(k);
            const int pm = p8k_of_f((SL - k) & (SL - 1));
            const float2 zk = Z[zp(pk)], zm = Z[zp(pm)];
            ur0[e] = 0.5f * (zk.x + zm.x); ui0[e] = 0.5f * (zk.y - zm.y);
            ur1[e] = 0.5f * (zk.y + zm.y); ui1[e] = 0.5f * (zm.x - zk.x);
        }
        *(f32x4*)(UR + k0) = ur0; *(f32x4*)(UI + k0) = ui0; *(f32x4*)(UR + SL + k0) = ur1; *(f32x4*)(UI + SL + k0) = ui1;
    }
    __syncthreads();
}

__device__ __forceinline__ void phase_mix(const Params& p, int layer, char* lds) {
    const int tid = otid(), lane = tid & 63, wave = tid >> 6;
    const int l31 = lane & 31, hl = lane >> 5, g = wave & 3, tsel = wave >> 2;
    float* ex = (float*)lds;
    const float* UR = (const float*)(p.ws + R_UR); const float* UI = (const float*)(p.ws + R_UI);
    const float* Y = (const float*)(p.ws + R_Y);
    const bf16_t* att = (const bf16_t*)(p.ws + R_ATT);
    bf16_t* mix = (bf16_t*)(p.ws + R_MIX);
    const float* FMg = (const float*)(p.ws + OFF_FM) + ((size_t)layer * 4 + g) * 128 * 64;
    const float* fb = p.in[I_FB] + layer * 256 + g * 64;
    const float* mg = p.in[I_MG] + layer * 1024;
    for (int tp = obid(); tp < T / 64; tp += NBLK) {
        const int t = (tp * 2 + tsel) * 32 + l31;
        f32x16 acc0 = zero16(), acc1 = zero16();
        {
            const float* ub = UR + (size_t)(g * 64 + hl) * T + t;
            const float* fa = FMg + hl * 64 + l31;
#pragma unroll 16
            for (int dd0 = 0; dd0 < 64; dd0 += 2) {
                const float bv = ub[(size_t)dd0 * T];
                const float a0 = fa[dd0 * 64], a1 = fa[dd0 * 64 + 32];
                acc0 = __builtin_amdgcn_mfma_f32_32x32x2f32(a0, bv, acc0, 0, 0, 0);
                acc1 = __builtin_amdgcn_mfma_f32_32x32x2f32(a1, bv, acc1, 0, 0, 0);
            }
            const float* ub2 = UI + (size_t)(g * 64 + hl) * T + t;
            const float* fa2 = FMg + (64 + hl) * 64 + l31;
#pragma unroll 16
            for (int dd0 = 0; dd0 < 64; dd0 += 2) {
                const float bv = ub2[(size_t)dd0 * T];
                const float a0 = fa2[dd0 * 64], a1 = fa2[dd0 * 64 + 32];
                acc0 = __builtin_amdgcn_mfma_f32_32x32x2f32(a0, bv, acc0, 0, 0, 0);
                acc1 = __builtin_amdgcn_mfma_f32_32x32x2f32(a1, bv, acc1, 0, 0, 0);
            }
        }
        float sf = 0.f;
#pragma unroll
        for (int i = 0; i < 4; ++i) {
            const f32x4 b0 = *(const f32x4*)(fb + 8 * i + 4 * hl), b1 = *(const f32x4*)(fb + 32 + 8 * i + 4 * hl);
            acc0[4 * i] += b0.x; acc0[4 * i + 1] += b0.y; acc0[4 * i + 2] += b0.z; acc0[4 * i + 3] += b0.w;
            acc1[4 * i] += b1.x; acc1[4 * i + 1] += b1.y; acc1[4 * i + 2] += b1.z; acc1[4 * i + 3] += b1.w;
        }
#pragma unroll
        for (int r = 0; r < 16; ++r) sf += acc0[r] * acc0[r] + acc1[r] * acc1[r];
        float sy = 0.f;
        const float* yb = Y + (size_t)(g * 64 + hl * 32) * T + t;
#pragma unroll 32
        for (int i = 0; i < 32; ++i) { const float y = yb[(size_t)i * T]; sy += y * y; }
        float sa = 0.f;
        const bf16_t* ab = att + (size_t)t * 512 + g * 128 + hl * 64;
#pragma unroll 4
        for (int q = 0; q < 8; ++q) {
            const u32x4 a = *(const u32x4*)(ab + 8 * q);
            const float x0 = bflo(a.x), x1 = bfhi(a.x), x2 = bflo(a.y), x3 = bfhi(a.y), x4 = bflo(a.z), x5 = bfhi(a.z), x6 = bflo(a.w), x7 = bfhi(a.w);
            sa += x0 * x0 + x1 * x1 + x2 * x2 + x3 * x3 + x4 * x4 + x5 * x5 + x6 * x6 + x7 * x7;
        }
        __syncthreads();
        ex[(0 * 8 + wave) * 64 + lane] = sa; ex[(1 * 8 + wave) * 64 + lane] = sy; ex[(2 * 8 + wave) * 64 + lane] = sf;
        __syncthreads();
        float ta = 0.f, ty = 0.f, tf = 0.f;
#pragma unroll
        for (int w = 0; w < 4; ++w)
#pragma unroll
            for (int hh = 0; hh < 2; ++hh) {
                const int o = (tsel * 4 + w) * 64 + hh * 32 + l31;
                ta += ex[0 * 512 + o]; ty += ex[1 * 512 + o]; tf += ex[2 * 512 + o];
            }
        const float ra = rsqrtf(ta * (1.0f / 512.0f) + EPS), ry = rsqrtf(ty * (1.0f / 256.0f) + EPS), rf = rsqrtf(tf * (1.0f / 256.0f) + EPS);
        bf16_t* mrow = mix + (size_t)t * 1024;
        {
            const float* gg = mg + g * 128 + hl * 64;
#pragma unroll 4
            for (int q = 0; q < 8; ++q) {
                const u32x4 a = *(const u32x4*)(ab + 8 * q);
                const f32x4 g0 = *(const f32x4*)(gg + 8 * q), g1 = *(const f32x4*)(gg + 8 * q + 4);
                u32x4 o;
                o.x = pk2(bflo(a.x) * ra * g0.x, bfhi(a.x) * ra * g0.y); o.y = pk2(bflo(a.y) * ra * g0.z, bfhi(a.y) * ra * g0.w);
                o.z = pk2(bflo(a.z) * ra * g1.x, bfhi(a.z) * ra * g1.y); o.w = pk2(bflo(a.w) * ra * g1.z, bfhi(a.w) * ra * g1.w);
                *(u32x4*)(mrow + g * 128 + hl * 64 + 8 * q) = o;
            }
        }
        {
            const float* gg = mg + 512 + g * 64 + hl * 32;
#pragma unroll 2
            for (int q = 0; q < 4; ++q) {
                float yv[8];
#pragma unroll
                for (int i = 0; i < 8; ++i) yv[i] = yb[(size_t)(8 * q + i) * T];
                const f32x4 g0 = *(const f32x4*)(gg + 8 * q), g1 = *(const f32x4*)(gg + 8 * q + 4);
                u32x4 o;
                o.x = pk2(yv[0] * ry * g0.x, yv[1] * ry * g0.y); o.y = pk2(yv[2] * ry * g0.z, yv[3] * ry * g0.w);
                o.z = pk2(yv[4] * ry * g1.x, yv[5] * ry * g1.y); o.w = pk2(yv[6] * ry * g1.z, yv[7] * ry * g1.w);
                *(u32x4*)(mrow + 512 + g * 64 + hl * 32 + 8 * q) = o;
            }
        }
        {
            const float* gg = mg + 768 + g * 64;
#pragma unroll
            for (int i = 0; i < 4; ++i) {
                const f32x4 g0 = *(const f32x4*)(gg + 8 * i + 4 * hl), g1 = *(const f32x4*)(gg + 32 + 8 * i + 4 * hl);
                u32x2 o0, o1;
                o0.x = pk2(acc0[4 * i] * rf * g0.x, acc0[4 * i + 1] * rf * g0.y); o0.y = pk2(acc0[4 * i + 2] * rf * g0.z, acc0[4 * i + 3] * rf * g0.w);
                o1.x = pk2(acc1[4 * i] * rf * g1.x, acc1[4 * i + 1] * rf * g1.y); o1.y = pk2(acc1[4 * i + 2] * rf * g1.z, acc1[4 * i + 3] * rf * g1.w);
                *(u32x2*)(mrow + 768 + g * 64 + 8 * i + 4 * hl) = o0;
                *(u32x2*)(mrow + 768 + g * 64 + 32 + 8 * i + 4 * hl) = o1;
            }
        }
    }
}

#define TK_INS(L, X) do { float x_ = (X); _Pragma("unroll") for (int i_ = 0; i_ < 16; ++i_) { const float hi_ = fmaxf(L[i_], x_); x_ = fminf(L[i_], x_); L[i_] = hi_; } } while (0)
__device__ __forceinline__ float tk_pack(float v, unsigned code, unsigned mask) { return __builtin_bit_cast(float, (__builtin_bit_cast(unsigned, v) & ~mask) | code); }
__device__ __forceinline__ unsigned tk_lookup(const unsigned (&P)[4], unsigned i) {
    const unsigned w = (i < 4u) ? P[0] : (i < 8u) ? P[1] : (i < 12u) ? P[2] : P[3];
    return (w >> ((i & 3u) * 8u)) & 0x7Fu;
}
__device__ __forceinline__ void phase_peer_topk(const Params& p, int layer, char* lds, int* IDX, float* GATE) {
    const int tid = otid(), lane = tid & 63, wave = tid >> 6;
    const float* SC = (const float*)(p.ws + R_QP);
    const float NINF = -3.0e38f;
    const int pp = lane & 1;
    const int gw = obid() * NWAVE + wave, ngw = NBLK * NWAVE;
    for (int grp = gw; grp < T * 8 / 32; grp += ngw) {
        const int prob = grp * 32 + (lane >> 1);
        const int t = prob >> 3, h = prob & 7;
        const f32x4* src = (const f32x4*)(SC + (size_t)t * 2048 + h * 256 + pp * 128);
        float l[16];
#pragma unroll
        for (int i = 0; i < 16; ++i) l[i] = NINF;
#pragma unroll 1
        for (int c = 0; c < 4; ++c) {
            f32x4 v[8];
#pragma unroll
            for (int j = 0; j < 8; ++j) v[j] = src[c * 8 + j];
#pragma unroll
            for (int j = 0; j < 8; ++j) {
                const unsigned kb = (unsigned)(c * 32 + j * 4);
                TK_INS(l, tk_pack(v[j].x, kb, 0x7Fu)); TK_INS(l, tk_pack(v[j].y, kb + 1u, 0x7Fu));
                TK_INS(l, tk_pack(v[j].z, kb + 2u, 0x7Fu)); TK_INS(l, tk_pack(v[j].w, kb + 3u, 0x7Fu));
            }
        }
        float xv[16], ov[16]; unsigned PX[4] = {0u, 0u, 0u, 0u}, PO[4] = {0u, 0u, 0u, 0u};
#pragma unroll
        for (int i = 0; i < 16; ++i) {
            const float o = __shfl_xor(l[i], 1);
            const unsigned xb = __builtin_bit_cast(unsigned, l[i]), ob = __builtin_bit_cast(unsigned, o);
            xv[i] = __builtin_bit_cast(float, xb & ~0x7Fu); ov[i] = __builtin_bit_cast(float, ob & ~0x7Fu);
            PX[i >> 2] |= (xb & 0x7Fu) << ((i & 3) * 8); PO[i >> 2] |= (ob & 0x7Fu) << ((i & 3) * 8);
        }
        float f[16];
#pragma unroll
        for (int i = 0; i < 16; ++i) f[i] = NINF;
#pragma unroll
        for (int i = 0; i < 16; ++i)
#pragma unroll
            for (int j = i; j < 16; ++j)
                if ((i + 1) * (j + 1) <= 16) {
                    float cv = xv[i] + ov[j];
                    const unsigned code = pp ? (unsigned)((j << 4) | i) : (unsigned)((i << 4) | j);
                    cv = tk_pack(cv, code, 0xFFu);
                    if (i == j) cv = pp ? NINF : cv;
                    TK_INS(f, cv);
                }
        {
            float g[16];
#pragma unroll
            for (int i = 0; i < 16; ++i) g[i] = __shfl_xor(f[i], 1);
#pragma unroll
            for (int i = 0; i < 16; ++i) TK_INS(f, g[i]);
        }
        unsigned P0[4], P1[4];
#pragma unroll
        for (int q = 0; q < 4; ++q) { P0[q] = pp ? PO[q] : PX[q]; P1[q] = pp ? PX[q] : PO[q]; }
        const float top = __builtin_bit_cast(float, __builtin_bit_cast(unsigned, f[0]) & ~0xFFu);
        float ev[16]; int ei[16]; float den = 0.f;
#pragma unroll
        for (int r = 0; r < 16; ++r) {
            const unsigned fb = __builtin_bit_cast(unsigned, f[r]);
            const unsigned code = fb & 0xFFu;
            ei[r] = (int)(tk_lookup(P0, code >> 4) * 128u + tk_lookup(P1, code & 15u));
            ev[r] = __expf(__builtin_bit_cast(float, fb & ~0xFFu) - top);
            den += ev[r];
        }
        const float rden = 1.0f / den;
        const size_t ob = (size_t)t * 2048 + h * 16;
        if (pp == 0) {
#pragma unroll
            for (int q = 0; q < 4; ++q) { int4 w; w.x = ei[4 * q]; w.y = ei[4 * q + 1]; w.z = ei[4 * q + 2]; w.w = ei[4 * q + 3]; *(int4*)(IDX + ob + 4 * q) = w; }
        } else {
#pragma unroll
            for (int q = 0; q < 4; ++q) { f32x4 w; w.x = ev[4 * q] * rden; w.y = ev[4 * q + 1] * rden; w.z = ev[4 * q + 2] * rden; w.w = ev[4 * q + 3] * rden; *(f32x4*)(GATE + ob + 128 + 4 * q) = w; }
        }
    }
}

__device__ __forceinline__ float gelu_exact(float x) { return 0.5f * x * (1.0f + erff(x * 0.70710678118654752f)); }
typedef float f32x2 __attribute__((ext_vector_type(2)));
#define CVT_LO(W) __builtin_amdgcn_cvt_pk_f32_fp8((int)(W), false)
#define CVT_HI(W) __builtin_amdgcn_cvt_pk_f32_fp8((int)(W), true)
template <bool DRY, int EMASK = 16383> __device__ __forceinline__ void phase_peer_gather(const Params& p, int layer) {
    const int lane = otid() & 63, wave = otid() >> 6;
    const int gw = obid() * NWAVE + wave, ngw = NBLK * NWAVE;
    const unsigned char* PU = p.ws + OFF_PU + (size_t)layer * 16384 * 1024;
    const unsigned char* PV = p.ws + OFF_PV + (size_t)layer * 16384 * 1024;
    const float* SU = (const float*)(p.ws + OFF_PSC) + (size_t)layer * 16384;
    const float* SV = (const float*)(p.ws + OFF_PSC) + (size_t)(2 + layer) * 16384;
    bf16_t* XN = (bf16_t*)(p.ws + R_XN);
    float* XA = (float*)(p.ws + OFF_XA);
    const float* SC = (const float*)(p.ws + R_QP);
    const bool last = (layer == NLAYER - 1);
    const float* gnext = last ? p.in[I_FG] : p.in[I_N1G] + (layer + 1) * DM;
    const bool b5 = (lane & 32) != 0, b4 = (lane & 16) != 0, b3 = (lane & 8) != 0;
    const unsigned loff = (unsigned)lane * 16u;
    for (int t = gw; t < T; t += ngw) {
        f32x2 xv[8];
#pragma unroll
        for (int j = 0; j < 4; ++j) {
            const u32x2 a = *(const u32x2*)(XN + (size_t)t * DM + 4 * lane + 256 * j);
            xv[2 * j] = (f32x2){bflo(a.x), bfhi(a.x)}; xv[2 * j + 1] = (f32x2){bflo(a.y), bfhi(a.y)};
        }
        f32x2 acc[8];
#pragma unroll
        for (int j = 0; j < 8; ++j) acc[j] = (f32x2){0.f, 0.f};
        const int* idxp = (const int*)(SC + (size_t)t * 2048);
        const float* gatep = SC + (size_t)t * 2048 + 128;
#pragma unroll 1
        for (int half = 0; half < 2; ++half) {
            const int myi = idxp[half * 64 + lane] & EMASK;
            const float mycu = SU[myi];
            const float mycg = gatep[half * 64 + lane] * SV[myi];
#pragma unroll 1
            for (int e0 = 0; e0 < 64; e0 += 8) {
                u32x4 ur[8], vr[8];
#pragma unroll
                for (int k = 0; k < 8; ++k) {
                    const unsigned e = (unsigned)__builtin_amdgcn_readlane(myi, e0 + k);
                    ur[k] = *(const u32x4*)(PU + (size_t)(e * 1024u) + loff);
                    vr[k] = *(const u32x4*)(PV + (size_t)(e * 1024u) + loff);
                }
                float d[8];
#pragma unroll
                for (int k = 0; k < 8; ++k) {
                    f32x2 s2 = CVT_LO(ur[k].x) * xv[0];
                    s2 += CVT_HI(ur[k].x) * xv[1]; s2 += CVT_LO(ur[k].y) * xv[2]; s2 += CVT_HI(ur[k].y) * xv[3];
                    s2 += CVT_LO(ur[k].z) * xv[4]; s2 += CVT_HI(ur[k].z) * xv[5]; s2 += CVT_LO(ur[k].w) * xv[6]; s2 += CVT_HI(ur[k].w) * xv[7];
                    d[k] = s2.x + s2.y;
                }
                float r4[4], r2[2], u1;
#pragma unroll
                for (int k = 0; k < 4; ++k) { const float send = b5 ? d[k] : d[k + 4], keep = b5 ? d[k + 4] : d[k]; r4[k] = keep + __shfl_xor(send, 32); }
#pragma unroll
                for (int k = 0; k < 2; ++k) { const float send = b4 ? r4[k] : r4[k + 2], keep = b4 ? r4[k + 2] : r4[k]; r2[k] = keep + __shfl_xor(send, 16); }
                { const float send = b3 ? r2[0] : r2[1], keep = b3 ? r2[1] : r2[0]; u1 = keep + __shfl_xor(send, 8); }
                u1 += __shfl_xor(u1, 4); u1 += __shfl_xor(u1, 2); u1 += __shfl_xor(u1, 1);
                const int kk = e0 + (lane >> 3);
                const float av = gelu_exact(u1 * __shfl(mycu, kk)) * __shfl(mycg, kk);
#pragma unroll
                for (int k = 0; k < 8; ++k) {
                    const float a = __builtin_bit_cast(float, __builtin_amdgcn_readlane(__builtin_bit_cast(int, av), 8 * k));
                    const f32x2 a2 = (f32x2){a, a};
                    acc[0] += a2 * CVT_LO(vr[k].x); acc[1] += a2 * CVT_HI(vr[k].x); acc[2] += a2 * CVT_LO(vr[k].y); acc[3] += a2 * CVT_HI(vr[k].y);
                    acc[4] += a2 * CVT_LO(vr[k].z); acc[5] += a2 * CVT_HI(vr[k].z); acc[6] += a2 * CVT_LO(vr[k].w); acc[7] += a2 * CVT_HI(vr[k].w);
                }
            }
        }
        f32x4 x[4]; float ss = 0.f;
#pragma unroll
        for (int j = 0; j < 4; ++j) {
            x[j] = *(const f32x4*)(XA + (size_t)t * DM + 4 * lane + 256 * j);
            x[j].x += acc[2 * j].x; x[j].y += acc[2 * j].y; x[j].z += acc[2 * j + 1].x; x[j].w += acc[2 * j + 1].y;
            ss += x[j].x * x[j].x + x[j].y * x[j].y + x[j].z * x[j].z + x[j].w * x[j].w;
        }
        ss = wave_sum(ss);
        const float r = rsqrtf(ss * (1.0f / DM) + EPS);
        if (last) {
#pragma unroll
            for (int j = 0; j < 4; ++j) { const f32x4 gg = *(const f32x4*)(gnext + 4 * lane + 256 * j); *(f32x4*)(p.out + (size_t)t * DM + 4 * lane + 256 * j) = x[j] * r * gg; }
        } else {
#pragma unroll
            for (int j = 0; j < 4; ++j) {
                const f32x4 gg = *(const f32x4*)(gnext + 4 * lane + 256 * j);
                *(f32x4*)((DRY ? p.out : XA) + (size_t)t * DM + 4 * lane + 256 * j) = x[j];
                u32x2 w; w.x = pk2(x[j].x * r * gg.x, x[j].y * r * gg.y); w.y = pk2(x[j].z * r * gg.z, x[j].w * r * gg.w);
                if (!DRY) *(u32x2*)(XN + (size_t)t * DM + 4 * lane + 256 * j) = w;
            }
        }
    }
}


__device__ __forceinline__ void tk_sort16(float (&a)[16]) {
#pragma unroll
    for (int k = 2; k <= 16; k <<= 1)
#pragma unroll
        for (int j = k >> 1; j > 0; j >>= 1)
#pragma unroll
            for (int i = 0; i < 16; ++i) {
                const int l = i ^ j;
                if (l > i) {
                    const float hi = fmaxf(a[i], a[l]), lo = fminf(a[i], a[l]);
                    if ((i & k) == 0) { a[i] = hi; a[l] = lo; } else { a[i] = lo; a[l] = hi; }
                }
            }
}
__device__ __forceinline__ void tk_merge16(float (&a)[16]) {
#pragma unroll
    for (int j = 8; j > 0; j >>= 1)
#pragma unroll
        for (int i = 0; i < 16; ++i) {
            const int l = i ^ j;
            if (l > i) { const float hi = fmaxf(a[i], a[l]), lo = fminf(a[i], a[l]); a[i] = hi; a[l] = lo; }
        }
}
__device__ __forceinline__ void tk_top16_merge(float (&l)[16], const float (&g)[16]) {
#pragma unroll
    for (int i = 0; i < 16; ++i) l[i] = fmaxf(l[i], g[15 - i]);
    tk_merge16(l);
}
template <int CTRL> __device__ __forceinline__ float dpp_f(float v) { return __builtin_bit_cast(float, __builtin_amdgcn_update_dpp(0, __builtin_bit_cast(int, v), CTRL, 0xF, 0xF, false)); }
#ifndef PE_NTK
#define PE_NTK 2
#endif
#ifndef PE_PASS_SYNC
#define PE_PASS_SYNC 1
#endif
constexpr int PE_ENT = 12 * 1024;
#ifndef PE_LOGR
#define PE_LOGR 4
#endif
#ifndef PE_SPLIT
#define PE_SPLIT 1
#endif
#ifndef PE_FIXED
#define PE_FIXED 1
#endif
constexpr int PE_NR = 1 << PE_LOGR, PE_STS = 40;
constexpr int PE_WAVE = PE_ENT + 8 * PE_STS * 4;
#define PE_TOKEN_CHUNK(TK) do { \
    const int s_ = PE_FIXED ? r * 8 : st[(sr * PE_NTK + (TK)) * PE_STS + r], e_ = PE_FIXED ? r * 8 + 8 : st[(sr * PE_NTK + (TK)) * PE_STS + r + 1]; \
    for (int pos = s_; pos < e_; pos += 8) { \
        const int n = PE_FIXED ? 8 : ((e_ - pos < 8) ? (e_ - pos) : 8); \
        const int ei_ = pos + eid; \
        const bool ok_ = eid < n; \
        const int base_ = ((sr * PE_NTK + (TK)) * 128 + (ok_ ? ei_ : pos)) * 3; \
        const int ev = ent[base_]; const float cu = __builtin_bit_cast(float, ent[base_ + 1]), cg = __builtin_bit_cast(float, ent[base_ + 2]); \
        f32x2 xl[8]; \
        _Pragma("unroll") for (int j = 0; j < 4; ++j) { xl[2 * j] = (f32x2){bflo(xp[TK][j].x), bfhi(xp[TK][j].x)}; xl[2 * j + 1] = (f32x2){bflo(xp[TK][j].y), bfhi(xp[TK][j].y)}; } \
        u32x4 ur[8], vr[8]; \
        _Pragma("unroll") for (int k = 0; k < 8; ++k) { \
            if (k < n) { const unsigned e = (unsigned)__builtin_amdgcn_readlane(ev, ((k & 4) << 1) | ((k & 2) << 3) | ((k & 1) << 5)); \
                ur[k] = *(const u32x4*)(PU + (size_t)(e * 1024u) + loff); vr[k] = *(const u32x4*)(PV + (size_t)(e * 1024u) + loff); } \
            else { ur[k] = (u32x4){0u, 0u, 0u, 0u}; vr[k] = (u32x4){0u, 0u, 0u, 0u}; } } \
        float d[8]; \
        _Pragma("unroll") for (int k = 0; k < 8; ++k) { \
            if (k < n) { f32x2 s2 = CVT_LO(ur[k].x) * xl[0]; \
                s2 += CVT_HI(ur[k].x) * xl[1]; s2 += CVT_LO(ur[k].y) * xl[2]; s2 += CVT_HI(ur[k].y) * xl[3]; \
                s2 += CVT_LO(ur[k].z) * xl[4]; s2 += CVT_HI(ur[k].z) * xl[5]; s2 += CVT_LO(ur[k].w) * xl[6]; s2 += CVT_HI(ur[k].w) * xl[7]; \
                d[k] = s2.x + s2.y; } else d[k] = 0.f; } \
        _Pragma("unroll") for (int k = 0; k < 8; ++k) { d[k] += dpp_f<0xB1>(d[k]); d[k] += dpp_f<0x4E>(d[k]); d[k] += dpp_f<0x141>(d[k]); }     \
        float r4[4], r2[2], u1; \
        _Pragma("unroll") for (int k = 0; k < 4; ++k) { const float send = b3 ? d[k] : d[k + 4], keep = b3 ? d[k + 4] : d[k]; r4[k] = keep + dpp_f<0x140>(send); } \
        _Pragma("unroll") for (int k = 0; k < 2; ++k) { const float send = b4 ? r4[k] : r4[k + 2], keep = b4 ? r4[k + 2] : r4[k]; r2[k] = keep + __shfl_xor(send, 16); } \
        { const float send = b5 ? r2[0] : r2[1], keep = b5 ? r2[1] : r2[0]; u1 = keep + __shfl_xor(send, 32); }     \
        const float av = ok_ ? gelu_exact(u1 * cu) * cg : 0.f; \
        _Pragma("unroll") for (int k = 0; k < 8; ++k) { \
            if (k < n) { const float a = __builtin_bit_cast(float, __builtin_amdgcn_readlane(__builtin_bit_cast(int, av), ((k & 4) << 1) | ((k & 2) << 3) | ((k & 1) << 5))); \
                const f32x2 a2 = (f32x2){a, a}; \
                acc[TK][0] += a2 * CVT_LO(vr[k].x); acc[TK][1] += a2 * CVT_HI(vr[k].x); acc[TK][2] += a2 * CVT_LO(vr[k].y); acc[TK][3] += a2 * CVT_HI(vr[k].y); \
                acc[TK][4] += a2 * CVT_LO(vr[k].z); acc[TK][5] += a2 * CVT_HI(vr[k].z); acc[TK][6] += a2 * CVT_LO(vr[k].w); acc[TK][7] += a2 * CVT_HI(vr[k].w); } } \
    } } while (0)


#define PE_CHUNK_U(TK) do { \
        const int base_ = ((TK) * 128 + r * 8 + eid) * 3; \
        const int ev = ent[base_]; const float cu = __builtin_bit_cast(float, ent[base_ + 1]), cg = __builtin_bit_cast(float, ent[base_ + 2]); \
        f32x2 xl[8]; \
        _Pragma("unroll") for (int j = 0; j < 4; ++j) { xl[2 * j] = (f32x2){bflo(xp[TK][j].x), bfhi(xp[TK][j].x)}; xl[2 * j + 1] = (f32x2){bflo(xp[TK][j].y), bfhi(xp[TK][j].y)}; } \
        u32x4 rw[8]; \
        _Pragma("unroll") for (int k = 0; k < 8; ++k) { const unsigned e = (unsigned)__builtin_amdgcn_readlane(ev, ((k & 4) << 1) | ((k & 2) << 3) | ((k & 1) << 5)); \
            rw[k] = *(const u32x4*)(PU + (size_t)(e * 1024u) + loff); } \
        float d[8]; \
        _Pragma("unroll") for (int k = 0; k < 8; ++k) { f32x2 s2 = CVT_LO(rw[k].x) * xl[0]; \
            s2 += CVT_HI(rw[k].x) * xl[1]; s2 += CVT_LO(rw[k].y) * xl[2]; s2 += CVT_HI(rw[k].y) * xl[3]; \
            s2 += CVT_LO(rw[k].z) * xl[4]; s2 += CVT_HI(rw[k].z) * xl[5]; s2 += CVT_LO(rw[k].w) * xl[6]; s2 += CVT_HI(rw[k].w) * xl[7]; \
            d[k] = s2.x + s2.y; } \
        _Pragma("unroll") for (int k = 0; k < 8; ++k) { d[k] += dpp_f<0xB1>(d[k]); d[k] += dpp_f<0x4E>(d[k]); d[k] += dpp_f<0x141>(d[k]); } \
        float r4[4], r2[2], u1; \
        _Pragma("unroll") for (int k = 0; k < 4; ++k) { const float send = b3 ? d[k] : d[k + 4], keep = b3 ? d[k + 4] : d[k]; r4[k] = keep + dpp_f<0x140>(send); } \
        _Pragma("unroll") for (int k = 0; k < 2; ++k) { const float send = b4 ? r4[k] : r4[k + 2], keep = b4 ? r4[k + 2] : r4[k]; r2[k] = keep + __shfl_xor(send, 16); } \
        { const float send = b5 ? r2[0] : r2[1], keep = b5 ? r2[1] : r2[0]; u1 = keep + __shfl_xor(send, 32); } \
        const float av = gelu_exact(u1 * cu) * cg; \
        if ((lane & 7) == 0) ent[base_ + 1] = __builtin_bit_cast(int, av);     \
    } while (0)
#define PE_CHUNK_V(TK) do { \
        const int base_ = ((TK) * 128 + r * 8 + eid) * 3; \
        const int ev = ent[base_]; const int avb = ent[base_ + 1]; \
        u32x4 rw[8]; \
        _Pragma("unroll") for (int k = 0; k < 8; ++k) { const unsigned e = (unsigned)__builtin_amdgcn_readlane(ev, ((k & 4) << 1) | ((k & 2) << 3) | ((k & 1) << 5)); \
            rw[k] = *(const u32x4*)(PV + (size_t)(e * 1024u) + loff); } \
        _Pragma("unroll") for (int k = 0; k < 8; ++k) { \
            const float a = __builtin_bit_cast(float, __builtin_amdgcn_readlane(avb, ((k & 4) << 1) | ((k & 2) << 3) | ((k & 1) << 5))); \
            const f32x2 a2 = (f32x2){a, a}; \
            acc[TK][0] += a2 * CVT_LO(rw[k].x); acc[TK][1] += a2 * CVT_HI(rw[k].x); acc[TK][2] += a2 * CVT_LO(rw[k].y); acc[TK][3] += a2 * CVT_HI(rw[k].y); \
            acc[TK][4] += a2 * CVT_LO(rw[k].z); acc[TK][5] += a2 * CVT_HI(rw[k].z); acc[TK][6] += a2 * CVT_LO(rw[k].w); acc[TK][7] += a2 * CVT_HI(rw[k].w); } \
    } while (0)

template <bool DRY> __device__ __forceinline__ void phase_peer_fused(const Params& p, int layer, char* lds) {
    const int tid = otid(), lane = tid & 63, wave = tid >> 6;
    const unsigned char* PU = p.ws + OFF_PU + (size_t)layer * 16384 * 1024;
    const unsigned char* PV = p.ws + OFF_PV + (size_t)layer * 16384 * 1024;
    const float* SU = (const float*)(p.ws + OFF_PSC) + (size_t)layer * 16384;
    const float* SV = (const float*)(p.ws + OFF_PSC) + (size_t)(2 + layer) * 16384;
    bf16_t* XN = (bf16_t*)(p.ws + R_XN);
    float* XA = (float*)(p.ws + OFF_XA);
    const float* SC = (const float*)(p.ws + R_QP);
    const bool last = (layer == NLAYER - 1);
    const float* gnext = last ? p.in[I_FG] : p.in[I_N1G] + (layer + 1) * DM;
    const float* g2p = p.in[I_N2G] + layer * DM;
    const bool b5 = (lane & 32) != 0, b4 = (lane & 16) != 0, b3 = (lane & 8) != 0;
    const int eid = ((lane >> 3) & 1) * 4 + ((lane >> 4) & 1) * 2 + (lane >> 5);
    const unsigned loff = (unsigned)lane * 16u;
    int* ent = (int*)(lds + wave * PE_WAVE);
    int* st = (int*)(lds + wave * PE_WAVE + PE_ENT);
    const float NINF = -3.0e38f;
    const int pp = lane & 1;
    for (int tb = (obid() * NWAVE + wave) * 8; tb < T; tb += NBLK * NWAVE * 8) {
#pragma unroll 1
        for (int grp = 0; grp < 2; ++grp) {
            const int tkl = grp * 4 + (lane >> 4), h = (lane >> 1) & 7;
            const f32x4* src = (const f32x4*)(SC + (size_t)(tb + tkl) * 2048 + h * 256 + pp * 128);
            float l[16];
#pragma unroll
            for (int i = 0; i < 16; ++i) l[i] = NINF;
#pragma unroll 1
            for (int c = 0; c < 4; ++c) {
                f32x4 v[8];
#pragma unroll
                for (int j = 0; j < 8; ++j) v[j] = src[c * 8 + j];
#pragma unroll
                for (int hh = 0; hh < 2; ++hh) {
                    float g[16];
#pragma unroll
                    for (int j = 0; j < 4; ++j) {
                        const unsigned kb = (unsigned)(c * 32 + hh * 16 + j * 4);
                        g[4 * j] = tk_pack(v[hh * 4 + j].x, kb, 0x7Fu); g[4 * j + 1] = tk_pack(v[hh * 4 + j].y, kb + 1u, 0x7Fu);
                        g[4 * j + 2] = tk_pack(v[hh * 4 + j].z, kb + 2u, 0x7Fu); g[4 * j + 3] = tk_pack(v[hh * 4 + j].w, kb + 3u, 0x7Fu);
                    }
                    tk_sort16(g);
                    tk_top16_merge(l, g);
                }
            }
            float xw[16], ow[16]; unsigned PX[4] = {0u, 0u, 0u, 0u}, PO[4] = {0u, 0u, 0u, 0u};
#pragma unroll
            for (int i = 0; i < 16; ++i) {
                const float o = __shfl_xor(l[i], 1);
                const unsigned xb = __builtin_bit_cast(unsigned, l[i]), ob = __builtin_bit_cast(unsigned, o);
                xw[i] = __builtin_bit_cast(float, xb & ~0x7Fu); ow[i] = __builtin_bit_cast(float, ob & ~0x7Fu);
                PX[i >> 2] |= (xb & 0x7Fu) << ((i & 3) * 8); PO[i >> 2] |= (ob & 0x7Fu) << ((i & 3) * 8);
            }
            float f[16];
            {
                float c1[16];
#pragma unroll
                for (int i = 0; i < 16; ++i) { f[i] = NINF; c1[i] = NINF; }
                int cnt = 0;
#pragma unroll
                for (int i = 0; i < 16; ++i)
#pragma unroll
                    for (int j = i; j < 16; ++j)
                        if ((i + 1) * (j + 1) <= 16) {
                            float cv = xw[i] + ow[j];
                            const unsigned code = pp ? (unsigned)((j << 4) | i) : (unsigned)((i << 4) | j);
                            cv = tk_pack(cv, code, 0xFFu);
                            if (i == j) cv = pp ? NINF : cv;
                            if (cnt < 16) f[cnt & 15] = cv; else c1[cnt & 15] = cv;
                            ++cnt;
                        }
                tk_sort16(f); tk_sort16(c1);
                tk_top16_merge(f, c1);
                float gq[16];
#pragma unroll
                for (int i = 0; i < 16; ++i) gq[i] = __shfl_xor(f[i], 1);
                tk_top16_merge(f, gq);
            }
            unsigned P0[4], P1[4];
#pragma unroll
            for (int q = 0; q < 4; ++q) { P0[q] = pp ? PO[q] : PX[q]; P1[q] = pp ? PX[q] : PO[q]; }
            const float top = __builtin_bit_cast(float, __builtin_bit_cast(unsigned, f[0]) & ~0xFFu);
            float ev[16]; float den = 0.f;
#pragma unroll
            for (int r = 0; r < 16; ++r) { ev[r] = __expf(__builtin_bit_cast(float, __builtin_bit_cast(unsigned, f[r]) & ~0xFFu) - top); den += ev[r]; }
            const float rden = 1.0f / den;
#pragma unroll
            for (int r8 = 0; r8 < 8; ++r8) {
                const unsigned c0 = __builtin_bit_cast(unsigned, f[r8]) & 0xFFu, c1 = __builtin_bit_cast(unsigned, f[r8 + 8]) & 0xFFu;
                const unsigned code = pp ? c1 : c0;
                const float gate = (pp ? ev[r8 + 8] : ev[r8]) * rden;
                const int e = (int)(tk_lookup(P0, code >> 4) * 128u + tk_lookup(P1, code & 15u));
                const int o = (tkl * 128 + h * 16 + pp * 8 + r8) * 3;
                ent[o] = e; ent[o + 1] = __builtin_bit_cast(int, SU[e]); ent[o + 2] = __builtin_bit_cast(int, gate * SV[e]);
            }
        }
#pragma unroll 1
        for (int tk = 0; tk < 8; ++tk) {
            int* et = ent + tk * 384;
            const int eA = et[lane * 3], uA = et[lane * 3 + 1], gA = et[lane * 3 + 2];
            const int eB = et[(64 + lane) * 3], uB = et[(64 + lane) * 3 + 1], gB = et[(64 + lane) * 3 + 2];
            const int rA = eA >> (14 - PE_LOGR), rB = eB >> (14 - PE_LOGR);
            int base = 0;
#pragma unroll 1
            for (int r = 0; r < PE_NR; ++r) {
                const unsigned long long mA = __ballot(rA == r), mB = __ballot(rB == r);
                const int cA = __popcll(mA);
                if (lane == 0) st[tk * PE_STS + r] = base;
                if (rA == r) { const int q = base + (int)__builtin_amdgcn_mbcnt_hi((unsigned)(mA >> 32), __builtin_amdgcn_mbcnt_lo((unsigned)mA, 0u)); et[q * 3] = eA; et[q * 3 + 1] = uA; et[q * 3 + 2] = gA; }
                if (rB == r) { const int q = base + cA + (int)__builtin_amdgcn_mbcnt_hi((unsigned)(mB >> 32), __builtin_amdgcn_mbcnt_lo((unsigned)mB, 0u)); et[q * 3] = eB; et[q * 3 + 1] = uB; et[q * 3 + 2] = gB; }
                base += cA + __popcll(mB);
            }
            if (lane == 0) st[tk * PE_STS + PE_NR] = base;
        }
#if PE_SPLIT
        {
            {
                u32x2 xp[8][4];
#pragma unroll
                for (int tk = 0; tk < 8; ++tk) {
                    f32x4 xr[4]; float ss = 0.f;
#pragma unroll
                    for (int j = 0; j < 4; ++j) { xr[j] = *(const f32x4*)(XA + (size_t)(tb + tk) * DM + 4 * lane + 256 * j); ss += xr[j].x * xr[j].x + xr[j].y * xr[j].y + xr[j].z * xr[j].z + xr[j].w * xr[j].w; }
                    ss = wave_sum(ss);
                    const float rn = rsqrtf(ss * (1.0f / DM) + EPS);
#pragma unroll
                    for (int j = 0; j < 4; ++j) { const f32x4 gg = *(const f32x4*)(g2p + 4 * lane + 256 * j);
                        xp[tk][j].x = pk2(xr[j].x * rn * gg.x, xr[j].y * rn * gg.y); xp[tk][j].y = pk2(xr[j].z * rn * gg.z, xr[j].w * rn * gg.w); }
                }
#pragma unroll 1
                for (int r = 0; r < 16; ++r) {
                    __syncthreads();
                    PE_CHUNK_U(0); PE_CHUNK_U(1); PE_CHUNK_U(2); PE_CHUNK_U(3); PE_CHUNK_U(4); PE_CHUNK_U(5); PE_CHUNK_U(6); PE_CHUNK_U(7);
                }
            }
#pragma unroll 1
            for (int hv = 0; hv < 2; ++hv) {
            f32x2 acc[4][8];
#pragma unroll
            for (int tk = 0; tk < 4; ++tk)
#pragma unroll
                for (int j = 0; j < 8; ++j) acc[tk][j] = (f32x2){0.f, 0.f};
            const int* entv = ent;
            {
                int* ent = (int*)entv + hv * 4 * 128 * 3;
#pragma unroll 1
                for (int r = 0; r < 16; ++r) {
                    __syncthreads();
                    PE_CHUNK_V(0); PE_CHUNK_V(1); PE_CHUNK_V(2); PE_CHUNK_V(3);
                }
            }
#pragma unroll
            for (int tk = 0; tk < 4; ++tk) {
                const int t = tb + hv * 4 + tk;
                f32x4 x[4]; float ss = 0.f;
#pragma unroll
                for (int j = 0; j < 4; ++j) {
                    x[j] = *(const f32x4*)(XA + (size_t)t * DM + 4 * lane + 256 * j);
                    x[j].x += acc[tk][2 * j].x; x[j].y += acc[tk][2 * j].y; x[j].z += acc[tk][2 * j + 1].x; x[j].w += acc[tk][2 * j + 1].y;
                    ss += x[j].x * x[j].x + x[j].y * x[j].y + x[j].z * x[j].z + x[j].w * x[j].w;
                }
                ss = wave_sum(ss);
                const float rr = rsqrtf(ss * (1.0f / DM) + EPS);
                if (last) {
#pragma unroll
                    for (int j = 0; j < 4; ++j) { const f32x4 gg = *(const f32x4*)(gnext + 4 * lane + 256 * j); *(f32x4*)(p.out + (size_t)t * DM + 4 * lane + 256 * j) = x[j] * rr * gg; }
                } else {
#pragma unroll
                    for (int j = 0; j < 4; ++j) {
                        const f32x4 gg = *(const f32x4*)(gnext + 4 * lane + 256 * j);
                        *(f32x4*)((DRY ? p.out : XA) + (size_t)t * DM + 4 * lane + 256 * j) = x[j];
                        u32x2 w; w.x = pk2(x[j].x * rr * gg.x, x[j].y * rr * gg.y); w.y = pk2(x[j].z * rr * gg.z, x[j].w * rr * gg.w);
                        if (!DRY) *(u32x2*)(XN + (size_t)t * DM + 4 * lane + 256 * j) = w;
                    }
                }
            }
            }
        }
#else
#pragma unroll 1
        for (int sr = 0; sr < 8 / PE_NTK; ++sr) {
            u32x2 xp[PE_NTK][4]; f32x2 acc[PE_NTK][8];
#pragma unroll
            for (int tk = 0; tk < PE_NTK; ++tk) {
                f32x4 xr[4]; float ss = 0.f;
#pragma unroll
                for (int j = 0; j < 4; ++j) { xr[j] = *(const f32x4*)(XA + (size_t)(tb + sr * PE_NTK + tk) * DM + 4 * lane + 256 * j); ss += xr[j].x * xr[j].x + xr[j].y * xr[j].y + xr[j].z * xr[j].z + xr[j].w * xr[j].w; }
                ss = wave_sum(ss);
                const float rn = rsqrtf(ss * (1.0f / DM) + EPS);
#pragma unroll
                for (int j = 0; j < 4; ++j) { const f32x4 gg = *(const f32x4*)(g2p + 4 * lane + 256 * j);
                    xp[tk][j].x = pk2(xr[j].x * rn * gg.x, xr[j].y * rn * gg.y); xp[tk][j].y = pk2(xr[j].z * rn * gg.z, xr[j].w * rn * gg.w); }
#pragma unroll
                for (int j = 0; j < 8; ++j) acc[tk][j] = (f32x2){0.f, 0.f};
            }
#pragma unroll 1
            for (int r = 0; r < (PE_FIXED ? 16 : PE_NR); ++r) {
#if PE_PASS_SYNC
                __syncthreads();
#endif
                PE_TOKEN_CHUNK(0); PE_TOKEN_CHUNK(1);
#if PE_NTK == 4
                PE_TOKEN_CHUNK(2); PE_TOKEN_CHUNK(3);
#endif
            }
#pragma unroll
            for (int tk = 0; tk < PE_NTK; ++tk) {
                const int t = tb + sr * PE_NTK + tk;
                f32x4 x[4]; float ss = 0.f;
#pragma unroll
                for (int j = 0; j < 4; ++j) {
                    x[j] = *(const f32x4*)(XA + (size_t)t * DM + 4 * lane + 256 * j);
                    x[j].x += acc[tk][2 * j].x; x[j].y += acc[tk][2 * j].y; x[j].z += acc[tk][2 * j + 1].x; x[j].w += acc[tk][2 * j + 1].y;
                    ss += x[j].x * x[j].x + x[j].y * x[j].y + x[j].z * x[j].z + x[j].w * x[j].w;
                }
                ss = wave_sum(ss);
                const float rr = rsqrtf(ss * (1.0f / DM) + EPS);
                if (last) {
#pragma unroll
                    for (int j = 0; j < 4; ++j) { const f32x4 gg = *(const f32x4*)(gnext + 4 * lane + 256 * j); *(f32x4*)(p.out + (size_t)t * DM + 4 * lane + 256 * j) = x[j] * rr * gg; }
                } else {
#pragma unroll
                    for (int j = 0; j < 4; ++j) {
                        const f32x4 gg = *(const f32x4*)(gnext + 4 * lane + 256 * j);
                        *(f32x4*)((DRY ? p.out : XA) + (size_t)t * DM + 4 * lane + 256 * j) = x[j];
                        u32x2 w; w.x = pk2(x[j].x * rr * gg.x, x[j].y * rr * gg.y); w.y = pk2(x[j].z * rr * gg.z, x[j].w * rr * gg.w);
                        if (!DRY) *(u32x2*)(XN + (size_t)t * DM + 4 * lane + 256 * j) = w;
                    }
                }
            }
        }
#endif
    }
}

#define LAS __attribute__((address_space(3)))
#define XB_TMO      128
#define XB_XCNT(j)  (256  + 64 * (j))
#define XB_XSUB(j)  (1280 + 64 * (j))
#define XB_XGEN(j)  (2304 + 64 * (j))
#define XB_TOP      3328
#define XB_TOPGEN   3392
#define XCD_BAR_WORDS 3456
#define XB_SPIN_CAP (1u << 20)
__device__ __forceinline__ unsigned xb_ld(unsigned* p)              { return __hip_atomic_load(p, __ATOMIC_RELAXED, __HIP_MEMORY_SCOPE_AGENT); }
__device__ __forceinline__ unsigned xb_add(unsigned* p, unsigned v) { return __hip_atomic_fetch_add(p, v, __ATOMIC_RELAXED, __HIP_MEMORY_SCOPE_AGENT); }
__device__ __forceinline__ unsigned xb_xcc_id() { return (unsigned)__builtin_amdgcn_s_getreg((3 << 11) | 20) & 0xFu; }
#define XB_SPIN(cond, bar) do { unsigned _sp = 0; while (cond) { __builtin_amdgcn_s_sleep(1); \
    if ((++_sp & 255u) == 0u) { if (xb_ld(&(bar)[XB_TMO])) break; if (_sp > XB_SPIN_CAP) { atomicAdd(&(bar)[XB_TMO], 1u); break; } } } } while (0)
struct XcdBarrier { unsigned* bar; unsigned x; volatile LAS unsigned* st; };
__device__ __forceinline__ XcdBarrier xcd_barrier_post(unsigned* bar, volatile LAS unsigned* st) {
    XcdBarrier b; b.bar = bar; b.x = xb_xcc_id(); b.st = st;
    if (threadIdx.x == 0) (void)xb_add(&bar[XB_XCNT(b.x)], 1u);
    return b;
}
__device__ __forceinline__ void xcd_barrier_complete(unsigned* bar, unsigned x, unsigned& nloc, unsigned& nx) {
    const unsigned G = NBLK;
    unsigned sum, cnt, mine, sp = 0u;
    for (;;) {
        sum = 0u; cnt = 0u; mine = 0u;
#pragma unroll
        for (unsigned j = 0; j < 16; ++j) { const unsigned c = xb_ld(&bar[XB_XCNT(j)]); sum += c; cnt += (c > 0u) ? 1u : 0u; mine = (j == x) ? c : mine; }
        if (sum == G) break;
        __builtin_amdgcn_s_sleep(1);
        if ((++sp & 255u) == 0u) { if (xb_ld(&bar[XB_TMO])) break; if (sp > XB_SPIN_CAP) { atomicAdd(&bar[XB_TMO], 1u); break; } }
    }
    nloc = mine > 0u ? mine : 1u; nx = cnt > 0u ? cnt : 1u;
}
__device__ __forceinline__ void xcd_barrier(const XcdBarrier& b) {
    asm volatile("s_waitcnt vmcnt(0)" ::: "memory");
    __syncthreads();
    if (threadIdx.x == 0) {
        unsigned* bar = b.bar;
        __builtin_amdgcn_s_waitcnt(0);
        unsigned nloc = b.st[0], nx = b.st[1];
        if (nloc == 0u) { xcd_barrier_complete(bar, b.x, nloc, nx); b.st[0] = nloc; b.st[1] = nx; }
        const unsigned old = xb_add(&bar[XB_XSUB(b.x)], 1u);
        const unsigned gen = old / nloc;
        if (old + 1u == (gen + 1u) * nloc) {
            __builtin_amdgcn_fence(__ATOMIC_RELEASE, "agent");
            asm volatile("s_waitcnt vmcnt(0)" ::: "memory");
            const unsigned og = xb_add(&bar[XB_TOP], 1u);
            const unsigned tg = og / nx;
            if (og + 1u == (tg + 1u) * nx) xb_add(&bar[XB_TOPGEN], 1u);
            else XB_SPIN(xb_ld(&bar[XB_TOPGEN]) == tg, bar);
            __builtin_amdgcn_fence(__ATOMIC_ACQUIRE, "agent");
            xb_add(&bar[XB_XGEN(b.x)], 1u);
            asm volatile("s_waitcnt vmcnt(0)" ::: "memory");
        } else {
            XB_SPIN(xb_ld(&bar[XB_XGEN(b.x)]) == gen, bar);
            __builtin_amdgcn_fence(__ATOMIC_ACQUIRE, "agent");
            asm volatile("s_waitcnt vmcnt(0)" ::: "memory");
        }
    }
    __syncthreads();
}


template <class Epi> __device__ __forceinline__ void big_gemm(const bf16_t* A, const bf16_t* Bt, int M, int N, int K, char* lds, const Epi& e) {
    pg8::Gemm g{A, Bt, M, N, K}; pg8::StaticOrder S; S.init(M, N, NBLK, obid());
    pg8::gemm_phase<Epi, pg8::StaticOrder, true, true>((PG8_LAS unsigned char*)lds, g, S, e);
}

#define GSYNC() xcd_barrier(xbar)
template <int layer> __device__ __forceinline__ void run_layer(const Params& p, char* lds, const XcdBarrier& xbar) {
    float* XA = (float*)(p.ws + OFF_XA);

        const float* xin = layer == 0 ? p.in[I_X] : XA;
#if PROBE == 10
        { EpiIn e{(bf16_t*)(p.ws + R_QKV), (float*)(p.ws + R_HF)};
          gemm_simple((const bf16_t*)(p.ws + R_XN), (const bf16_t*)(p.ws + OFF_WTIN) + (size_t)layer * INC * DM, T, INC, DM, lds, e); } GSYNC();
#endif
        {
            const bf16_t* wt = (const bf16_t*)(p.ws + OFF_WTIN) + (size_t)layer * INC * DM;
            pg8::EpiStoreBf16 e1{(bf16_t*)(p.ws + R_QKV), 768};
            big_gemm((const bf16_t*)(p.ws + R_XN), wt, T, 768, DM, lds, e1);
            pg8::EpiStoreF32 e2{nullptr, (float*)(p.ws + R_HF), T};
            big_gemm(wt + (size_t)768 * DM, (const bf16_t*)(p.ws + R_XN), 1024, T, DM, lds, e2);
        }
        if (layer == 0) {
#pragma nounroll
            for (int fl = 0; fl < NLAYER; ++fl) {
                EpiF32 e{(float*)(p.ws + (fl ? OFF_HFILT1 : OFF_HFILT0)), SL};
                gemm_simple((const bf16_t*)(p.ws + OFF_W3T) + (size_t)fl * 1024 * 64, (const bf16_t*)(p.ws + OFF_H2) + (size_t)fl * SL * 64, 1024, SL, 64, lds, e);
            }
        }
        GSYNC();
        if (layer == 0) {
            phase_filter_spectra(p, lds);
#if PROBE == 13
            phase_filter_spectra(p, lds);
#endif
        }
#if PROBE == 12
        phase_qkprep(p, layer, lds, (bf16_t*)(p.ws + R_ATT)); GSYNC();
#endif
        phase_qkprep(p, layer, lds, (bf16_t*)(p.ws + R_QKV)); GSYNC();
        {
#if PROBE == 5
            phase_attn(p, lds);
#endif
#if PROBE == 6
            for (int c = obid(); c < 256; c += NBLK) hyena_job(p, layer, c, lds);
            for (int c = obid(); c < 256; c += NBLK) fnet_job(p, c, lds);
#endif
            phase_attn(p, lds);
            for (int c = obid(); c < 256; c += NBLK) hyena_job(p, layer, c, lds);
            for (int c = obid(); c < 256; c += NBLK) fnet_job(p, c, lds);
        } GSYNC();
#if PROBE == 8
        phase_mix(p, layer, lds); GSYNC();
#endif
        phase_mix(p, layer, lds); GSYNC();
#if PROBE == 11
        { EpiRes e{xin, p.out};
          gemm_simple((const bf16_t*)(p.ws + R_MIX), (const bf16_t*)(p.ws + OFF_WTOUT) + (size_t)layer * DM * DM, T, DM, DM, lds, e); } GSYNC();
#endif
        { pg8::EpiOutProj e{xin, XA, (bf16_t*)(p.ws + R_XN), (float*)(p.ws + OFF_RS)};
          big_gemm((const bf16_t*)(p.ws + R_MIX), (const bf16_t*)(p.ws + OFF_WTOUT) + (size_t)layer * DM * DM, T, DM, DM, lds, e); } GSYNC();
#if PROBE == 3
        { EpiF32 e{(float*)(p.ws + R_QP), 2048};
          gemm_simple((const bf16_t*)(p.ws + R_XN), (const bf16_t*)(p.ws + OFF_WTQ) + (size_t)layer * 2048 * DM, T, 2048, DM, lds, e); } GSYNC();
#endif
        { pg8::EpiRowScaleF32 e{(float*)(p.ws + R_QP), 2048, (const float*)(p.ws + OFF_RS)};
          big_gemm((const bf16_t*)(p.ws + R_XN), (const bf16_t*)(p.ws + OFF_WTQ) + (size_t)layer * 2048 * DM, T, 2048, DM, lds, e); } GSYNC();
#if PEER_FUSED
#if PROBE == 1
        phase_peer_fused<true>(p, layer, lds); GSYNC();
#endif
        phase_peer_fused<false>(p, layer, lds);
#else
        phase_peer_topk(p, layer, lds, (int*)(p.ws + R_QP), (float*)(p.ws + R_QP)); GSYNC();
#if PROBE == 1
        phase_peer_gather<true>(p, layer); GSYNC();
#endif
#if PROBE == 15
        phase_peer_gather<true, 1023>(p, layer); GSYNC();
#endif
        phase_peer_gather<false>(p, layer);
#endif
        if (layer + 1 < NLAYER) GSYNC();
}

__global__ void __launch_bounds__(NTHR) mega_kernel(Params p) {
    extern __shared__ __attribute__((aligned(16))) char lds[];
    volatile LAS unsigned* misc = (volatile LAS unsigned*)((LAS char*)lds + LDS_MISC);
    if (threadIdx.x < 16) misc[threadIdx.x] = 0u;
    __syncthreads();
    const XcdBarrier xbar = xcd_barrier_post((unsigned*)(p.ws + OFF_CTL) + 4096, misc);
    float* XA = (float*)(p.ws + OFF_XA);
#if PROBE == 7
    phase_p0(p, lds); GSYNC();
#endif
#if PROBE >= 30 && PROBE <= 34
    phase_p0<(1 << (PROBE - 30))>(p, lds); GSYNC();
#endif
#if PROBE == 35
    phase_rmsnorm_bf16(p.in[I_X], p.in[I_N1G], (bf16_t*)(p.ws + R_XN)); GSYNC();
#endif
#if PROBE == 14
#pragma nounroll
    for (int i = 0; i < 40; ++i) GSYNC();
#endif
    phase_p0(p, lds);
    phase_rmsnorm_bf16(p.in[I_X], p.in[I_N1G], (bf16_t*)(p.ws + R_XN));
    GSYNC();
    run_layer<0>(p, lds, xbar);
    run_layer<1>(p, lds, xbar);
}

extern "C" void kernel_launch(void* const* d_in, const int* in_sizes, int n_in, void* d_out, int out_size, void* d_ws, size_t ws_size, hipStream_t stream) {
    static int grid = 0;
    if (grid == 0) {
        if (n_in != 25 || out_size != T * DM || ws_size < WS_NEED) { fprintf(stderr, "kernel_launch: unexpected sizes n_in %d out %d ws %zu (need %zu)\n", n_in, out_size, ws_size, (size_t)WS_NEED); grid = -1; return; }
        int dev = 0, cus = 0, per_cu = 0;
        if (hipGetDevice(&dev) != hipSuccess || hipDeviceGetAttribute(&cus, hipDeviceAttributeMultiprocessorCount, dev) != hipSuccess) { grid = -1; return; }
        if (hipFuncSetAttribute((const void*)mega_kernel, hipFuncAttributeMaxDynamicSharedMemorySize, LDS_BYTES) != hipSuccess) { fprintf(stderr, "kernel_launch: hipFuncSetAttribute failed\n"); grid = -1; return; }
        if (hipOccupancyMaxActiveBlocksPerMultiprocessor(&per_cu, (const void*)mega_kernel, NTHR, LDS_BYTES) != hipSuccess || per_cu < 1) { fprintf(stderr, "kernel_launch: occupancy query says %d blocks per CU\n", per_cu); grid = -1; return; }
        (void)hipGetLastError();
        if (cus < NBLK) { fprintf(stderr, "kernel_launch: built for a %d-CU device, found %d CUs\n", NBLK, cus); grid = -1; return; }
        grid = NBLK;
    }
    if (grid < 0) return;
    Params p{};
    for (int i = 0; i < 25; ++i) p.in[i] = (const float*)d_in[i];
    p.out = (float*)d_out; p.ws = (unsigned char*)d_ws;
    if (hipMemsetAsync((char*)d_ws + OFF_CTL, 0, 64 * 1024, stream) != hipSuccess) { fprintf(stderr, "kernel_launch: memset failed\n"); return; }
    void* args[] = {&p};
    hipError_t e = hipLaunchCooperativeKernel((const void*)mega_kernel, dim3(grid), dim3(NTHR), args, LDS_BYTES, stream);
    if (e != hipSuccess) fprintf(stderr, "cooperative launch failed: %s (grid %d)\n", hipGetErrorString(e), grid);
}
```

```cpp
#include <hip/hip_runtime.h>
#include <hip/hip_cooperative_groups.h>
#include <cstdio>
#include <cstdint>
namespace cg = cooperative_groups;

#ifndef PROBE
#define PROBE 0
#endif
#ifndef PEER_FUSED
#define PEER_FUSED 1
#endif

typedef unsigned short bf16_t;
typedef short bf16x8 __attribute__((ext_vector_type(8)));
typedef float f32x16 __attribute__((ext_vector_type(16)));
typedef float f32x4 __attribute__((ext_vector_type(4)));
typedef unsigned u32x4 __attribute__((ext_vector_type(4)));
typedef unsigned u32x2 __attribute__((ext_vector_type(2)));

constexpr int DM = 1024, NB = 2, SL = 8192, T = NB * SL, NLAYER = 2;
constexpr int INC = 1792;
constexpr int NTHR = 512, NWAVE = 8;
constexpr int NBLK = 256;
constexpr int LDS_BYTES = 147456;
constexpr int LDS_MISC = LDS_BYTES - 64;
constexpr float EPS = 1e-6f;

constexpr size_t MiB = 1u << 20;
constexpr size_t OFF_CTL = 0;
constexpr size_t OFF_WTIN = 1 * MiB;
constexpr size_t OFF_WTOUT = 8 * MiB;
constexpr size_t OFF_WTQ = 12 * MiB;
constexpr size_t OFF_PU = 20 * MiB;
constexpr size_t OFF_PV = 84 * MiB;
constexpr size_t OFF_RS = 505 * MiB;
constexpr size_t OFF_PSC = 512 * 1024;
constexpr size_t OFF_H2 = 148 * MiB;
constexpr size_t OFF_W3T = 150 * MiB;
constexpr size_t OFF_HFILT0 = 52 * MiB, OFF_HFILT1 = 116 * MiB;
constexpr size_t OFF_FM = 152 * MiB;
constexpr size_t OFF_KF = 153 * MiB;
constexpr size_t OFF_XA = 281 * MiB;
constexpr size_t OFF_R = 345 * MiB;
constexpr size_t R_XN = OFF_R + 0 * MiB;
constexpr size_t R_UR = OFF_R + 0 * MiB;
constexpr size_t R_UI = OFF_R + 16 * MiB;
constexpr size_t R_QKV = OFF_R + 32 * MiB;
constexpr size_t R_VT = OFF_R + 56 * MiB;
constexpr size_t R_HF = OFF_R + 60 * MiB;
constexpr size_t R_MIX = OFF_R + 60 * MiB;
constexpr size_t R_ATT = OFF_R + 124 * MiB;
constexpr size_t R_Y = OFF_R + 140 * MiB;
constexpr size_t R_QP = OFF_R + 32 * MiB;
constexpr size_t WS_NEED = 506 * MiB;

struct Params {
    const float* in[25];
    float* out;
    unsigned char* ws;
};
enum { I_X = 0, I_N1G, I_WIN, I_QG, I_KG, I_CW, I_CB, I_W1, I_B1, I_F1, I_W2, I_B2, I_F2, I_W3, I_HB, I_FW, I_FB, I_MG, I_WOUT, I_N2G, I_WQ, I_SK, I_PU, I_PV, I_FG };

__device__ __forceinline__ unsigned f2bf(float f) { unsigned u = __builtin_bit_cast(unsigned, f); return (u + 0x7fffu + ((u >> 16) & 1u)) >> 16; }
__device__ __forceinline__ unsigned pk2(float lo, float hi) { return f2bf(lo) | (f2bf(hi) << 16); }
__device__ __forceinline__ float bf2f(unsigned b) { return __builtin_bit_cast(float, b << 16); }
__device__ __forceinline__ float bflo(unsigned w) { return __builtin_bit_cast(float, w << 16); }
__device__ __forceinline__ float bfhi(unsigned w) { return __builtin_bit_cast(float, w & 0xffff0000u); }
__device__ __forceinline__ float wave_sum(float v) {
#pragma unroll
    for (int o = 1; o < 64; o <<= 1) v += __shfl_xor(v, o);
    return v;
}
__device__ __forceinline__ float wave_max(float v) {
#pragma unroll
    for (int o = 1; o < 64; o <<= 1) v = fmaxf(v, __shfl_xor(v, o));
    return v;
}
__device__ __forceinline__ f32x16 mfma32(bf16x8 a, bf16x8 b, f32x16 c) { return __builtin_amdgcn_mfma_f32_32x32x16_bf16(a, b, c, 0, 0, 0); }
__device__ __forceinline__ f32x16 zero16() { return (f32x16){0.f,0.f,0.f,0.f,0.f,0.f,0.f,0.f,0.f,0.f,0.f,0.f,0.f,0.f,0.f,0.f}; }


__device__ __forceinline__ int otid() { int t = threadIdx.x; asm volatile("" : "+v"(t)); return t; }
__device__ __forceinline__ int obid() { int b = blockIdx.x; asm volatile("" : "+s"(b)); return b; }
__device__ __forceinline__ void transpose_one(const float* W, int K, int N, bf16_t* Wt, float* tile, int item) {
    const int tid = otid();
    const int nblk = N / 64, kb = item / nblk, nb = item % nblk, k0 = kb * 64, n0 = nb * 64;
    __syncthreads();
    {
        const int r = tid >> 6, c = tid & 63;
#pragma unroll
        for (int i = 0; i < 8; ++i) { const int k = r + 8 * i; tile[k * 65 + c] = W[(size_t)(k0 + k) * N + n0 + c]; }
    }
    __syncthreads();
    {
        const int nn = tid >> 3, kc = tid & 7;
        const float* s = tile + (kc * 8) * 65 + nn;
        u32x4 o; o.x = pk2(s[0], s[65]); o.y = pk2(s[2 * 65], s[3 * 65]); o.z = pk2(s[4 * 65], s[5 * 65]); o.w = pk2(s[6 * 65], s[7 * 65]);
        *(u32x4*)(Wt + (size_t)(n0 + nn) * K + k0 + kc * 8) = o;
    }
}

template <int PARTS = 31> __device__ __forceinline__ void phase_p0(const Params& p, char* lds) {
    const int tid = otid();
    float* tile = (float*)lds;
    if (PARTS & 1) {
    constexpr int IT_IN = (DM / 64) * (INC / 64), IT_OUT = (DM / 64) * (DM / 64), IT_W3 = 1024 / 64;
    constexpr int IT_L = IT_IN + IT_OUT + IT_W3;
    for (int it = obid(); it < NLAYER * IT_L; it += NBLK) {
        const int layer = it / IT_L; int r = it % IT_L;
        if (r < IT_IN) { transpose_one(p.in[I_WIN] + (size_t)layer * DM * INC, DM, INC, (bf16_t*)(p.ws + OFF_WTIN) + (size_t)layer * INC * DM, tile, r); continue; }
        r -= IT_IN;
        if (r < IT_OUT) { transpose_one(p.in[I_WOUT] + (size_t)layer * DM * DM, DM, DM, (bf16_t*)(p.ws + OFF_WTOUT) + (size_t)layer * DM * DM, tile, r); continue; }
        r -= IT_OUT;
        transpose_one(p.in[I_W3] + (size_t)layer * 64 * 1024, 64, 1024, (bf16_t*)(p.ws + OFF_W3T) + (size_t)layer * 1024 * 64, tile, r);
    }
    }
    __syncthreads();
    if (PARTS & 2) {
        float* SKl = (float*)lds;
        float* Wl = SKl + 128 * 129;
        const int lane = tid & 63, wave = tid >> 6, l31 = lane & 31, hl = lane >> 5, mt = wave & 3, nt = wave >> 2;
        for (int it = obid(); it < NLAYER * 16 * 16; it += NBLK) {
            const int layer = it >> 8, hp = (it >> 4) & 15, kc = it & 15, h = hp >> 1, pp = hp & 1, k0 = kc * 64;
            const float* sk = p.in[I_SK] + (((size_t)(layer * 2 + pp) * 8 + h) * 128) * 128;
            const float* wq = p.in[I_WQ] + (size_t)layer * DM * 2048 + (size_t)k0 * 2048 + h * 256 + pp * 128;
            __syncthreads();
            for (int i = tid; i < 128 * 128; i += NTHR) SKl[(i >> 7) * 129 + (i & 127)] = sk[i];
            for (int i = tid; i < 64 * 128; i += NTHR) Wl[(i >> 7) * 129 + (i & 127)] = wq[(size_t)(i >> 7) * 2048 + (i & 127)];
            __syncthreads();
            f32x16 acc = zero16();
            const float* ap = SKl + (32 * mt + l31) * 129 + hl;
            const float* bp = Wl + (32 * nt + l31) * 129 + hl;
#pragma unroll 16
            for (int kk = 0; kk < 64; ++kk) acc = __builtin_amdgcn_mfma_f32_32x32x2f32(ap[2 * kk], bp[2 * kk], acc, 0, 0, 0);
            const float g2 = p.in[I_N2G][layer * DM + k0 + 32 * nt + l31];
            bf16_t* dst = (bf16_t*)(p.ws + OFF_WTQ) + (size_t)layer * 2048 * DM + (size_t)(hp * 128 + 32 * mt + 4 * hl) * DM + k0 + 32 * nt + l31;
#pragma unroll
            for (int r = 0; r < 16; ++r) dst[(size_t)((r & 3) + 8 * (r >> 2)) * DM] = (bf16_t)f2bf(acc[r] * g2);
        }
        __syncthreads();
    }
    if (PARTS & 4) {
        const int lane = tid & 63, wave = tid >> 6;
        float* scl = (float*)(p.ws + OFF_PSC);
        for (int row = obid() * NWAVE + wave; row < 2 * NLAYER * 16384; row += NBLK * NWAVE) {
            const int tb = row >> 15, r = row & 32767;
            const f32x4* src = (const f32x4*)(p.in[tb ? I_PV : I_PU] + (size_t)r * DM) + lane;
            f32x4 v[4]; float mx = 0.f;
#pragma unroll
            for (int j = 0; j < 4; ++j) { v[j] = src[64 * j]; mx = fmaxf(mx, fmaxf(fmaxf(fabsf(v[j].x), fabsf(v[j].y)), fmaxf(fabsf(v[j].z), fabsf(v[j].w)))); }
            mx = wave_max(mx);
            const float sc = mx > 0.f ? 224.0f / mx : 1.0f;
            u32x4 o;
            { int w = 0; w = __builtin_amdgcn_cvt_pk_fp8_f32(v[0].x * sc, v[0].y * sc, w, false); w = __builtin_amdgcn_cvt_pk_fp8_f32(v[0].z * sc, v[0].w * sc, w, true); o.x = (unsigned)w; }
            { int w = 0; w = __builtin_amdgcn_cvt_pk_fp8_f32(v[1].x * sc, v[1].y * sc, w, false); w = __builtin_amdgcn_cvt_pk_fp8_f32(v[1].z * sc, v[1].w * sc, w, true); o.y = (unsigned)w; }
            { int w = 0; w = __builtin_amdgcn_cvt_pk_fp8_f32(v[2].x * sc, v[2].y * sc, w, false); w = __builtin_amdgcn_cvt_pk_fp8_f32(v[2].z * sc, v[2].w * sc, w, true); o.z = (unsigned)w; }
            { int w = 0; w = __builtin_amdgcn_cvt_pk_fp8_f32(v[3].x * sc, v[3].y * sc, w, false); w = __builtin_amdgcn_cvt_pk_fp8_f32(v[3].z * sc, v[3].w * sc, w, true); o.w = (unsigned)w; }
            *(u32x4*)(p.ws + (tb ? OFF_PV : OFF_PU) + (size_t)r * DM + lane * 16) = o;
            if (lane == 0) scl[row] = mx > 0.f ? mx / 224.0f : 1.0f;
        }
    }
    if (PARTS & 8) {
        float* sh = (float*)lds;
        float* zl = sh + 64 * 64;
        const int sub = tid >> 6, j = tid & 63;
        for (int it0 = obid() * 64; it0 < NLAYER * SL; it0 += NBLK * 64) {
            const int layer = it0 / SL;
            __syncthreads();
            for (int o = tid; o < 64 * 17; o += NTHR) {
                const int item = o / 17, f = o % 17;
                const float t = (float)((it0 + item) % SL) / (float)(SL - 1);
                float z;
                if (f == 0) z = t;
                else if (f <= 8) z = sinf(2.0f * 3.14159265358979323846f * t * (float)f);
                else z = cosf(2.0f * 3.14159265358979323846f * t * (float)(f - 8));
                zl[o] = z;
            }
            __syncthreads();
            {
                const float* w1 = p.in[I_W1] + layer * 17 * 64;
                float wv[17];
#pragma unroll
                for (int i = 0; i < 17; ++i) wv[i] = w1[i * 64 + j];
                const float b1 = p.in[I_B1][layer * 64 + j], f1 = p.in[I_F1][layer * 64 + j];
#pragma unroll
                for (int r = 0; r < 8; ++r) {
                    const int item = sub * 8 + r;
                    float a = b1;
#pragma unroll
                    for (int i = 0; i < 17; ++i) a += zl[item * 17 + i] * wv[i];
                    sh[item * 64 + j] = sinf(f1 * a);
                }
            }
            __syncthreads();
            {
                const float* w2 = p.in[I_W2] + layer * 64 * 64;
                const float b2 = p.in[I_B2][layer * 64 + j], f2 = p.in[I_F2][layer * 64 + j];
                float acc[8];
#pragma unroll
                for (int r = 0; r < 8; ++r) acc[r] = b2;
#pragma unroll 8
                for (int k = 0; k < 64; ++k) {
                    const float w = w2[k * 64 + j];
#pragma unroll
                    for (int r = 0; r < 8; ++r) acc[r] += sh[(sub * 8 + r) * 64 + k] * w;
                }
#pragma unroll
                for (int r = 0; r < 8; ++r)
                    ((bf16_t*)(p.ws + OFF_H2))[((size_t)(it0 + sub * 8 + r)) * 64 + j] = (bf16_t)f2bf(sinf(f2 * acc[r]));
            }
        }
        __syncthreads();
    }
    if (PARTS & 16) {
        float* ctab = (float*)lds;
        __syncthreads();
        if (tid < 64) ctab[tid] = cosf((float)tid * (2.0f * 3.14159265358979323846f / 64.0f));
        __syncthreads();
        const int total = NLAYER * 4 * 128 * 64;
        for (int o = obid() * NTHR + tid; o < total; o += NBLK * NTHR) {
            const int e2 = o & 63, dd = (o >> 6) & 127, g = (o >> 13) & 3, layer = o >> 15;
            const int d = dd & 63, sh = (dd < 64) ? 0 : 48;
            const float* w = p.in[I_FW] + ((size_t)(layer * 4 + g) * 64) * 64;
            float acc = 0.f;
#pragma unroll 8
            for (int e = 0; e < 64; ++e) acc += ctab[(d * e + sh) & 63] * w[e * 64 + e2];
            ((float*)(p.ws + OFF_FM))[o] = acc * (1.0f / 724.0773439350246f);
        }
        __syncthreads();
    }
}

template <bool PAD> __device__ __forceinline__ int zi(int i) { return PAD ? i + (i >> 8) : i; }

template <int LOGN, bool PAD>
__device__ __forceinline__ void fft_fwd(float2* Z) {
    constexpr int N = 1 << LOGN;
    const int tid = otid();
    int s = 0;
    for (; s + 1 < LOGN; s += 2) {
        const int lh2 = LOGN - s - 2;
        const int h2 = 1 << lh2, h = h2 << 1;
        const float rs = 1.0f / (float)(h << 1);
        for (int q = tid; q < N / 4; q += NTHR) {
            const int j = q & (h2 - 1), blk = q >> lh2;
            const int base = (blk << (lh2 + 2)) + j;
            float2 x0 = Z[zi<PAD>(base)], x1 = Z[zi<PAD>(base + h2)], x2 = Z[zi<PAD>(base + h)], x3 = Z[zi<PAD>(base + h + h2)];
            const float ang = (float)j * rs;
            const float c = __builtin_amdgcn_cosf(ang), sn = __builtin_amdgcn_sinf(ang);
            float2 a0 = make_float2(x0.x + x2.x, x0.y + x2.y);
            float2 d02 = make_float2(x0.x - x2.x, x0.y - x2.y);
            float2 a2 = make_float2(d02.x * c + d02.y * sn, d02.y * c - d02.x * sn);
            float2 a1 = make_float2(x1.x + x3.x, x1.y + x3.y);
            float2 d13 = make_float2(x1.x - x3.x, x1.y - x3.y);
            float2 t3 = make_float2(d13.x * c + d13.y * sn, d13.y * c - d13.x * sn);
            float2 a3 = make_float2(t3.y, -t3.x);
            const float c2 = c * c - sn * sn, s2 = 2.f * c * sn;
            float2 y0 = make_float2(a0.x + a1.x, a0.y + a1.y);
            float2 e01 = make_float2(a0.x - a1.x, a0.y - a1.y);
            float2 y1 = make_float2(e01.x * c2 + e01.y * s2, e01.y * c2 - e01.x * s2);
            float2 y2 = make_float2(a2.x + a3.x, a2.y + a3.y);
            float2 e23 = make_float2(a2.x - a3.x, a2.y - a3.y);
            float2 y3 = make_float2(e23.x * c2 + e23.y * s2, e23.y * c2 - e23.x * s2);
            Z[zi<PAD>(base)] = y0; Z[zi<PAD>(base + h2)] = y1; Z[zi<PAD>(base + h)] = y2; Z[zi<PAD>(base + h + h2)] = y3;
        }
        __syncthreads();
    }
    if (s < LOGN) {
        for (int q = tid; q < N / 2; q += NTHR) {
            const int i0 = 2 * q;
            float2 a = Z[zi<PAD>(i0)], b = Z[zi<PAD>(i0 + 1)];
            Z[zi<PAD>(i0)] = make_float2(a.x + b.x, a.y + b.y);
            Z[zi<PAD>(i0 + 1)] = make_float2(a.x - b.x, a.y - b.y);
        }
        __syncthreads();
    }
}

template <int LOGN, bool PAD>
__device__ __forceinline__ void fft_inv(float2* Z) {
    constexpr int N = 1 << LOGN;
    const int tid = otid();
    for (int s = LOGN - 2; s >= 0; s -= 2) {
        const int lh2 = LOGN - s - 2;
        const int h2 = 1 << lh2, h = h2 << 1;
        const float rs = 1.0f / (float)(h << 1);
        for (int q = tid; q < N / 4; q += NTHR) {
            const int j = q & (h2 - 1), blk = q >> lh2;
            const int base = (blk << (lh2 + 2)) + j;
            float2 y0 = Z[zi<PAD>(base)], y1 = Z[zi<PAD>(base + h2)], y2 = Z[zi<PAD>(base + h)], y3 = Z[zi<PAD>(base + h + h2)];
            const float ang = (float)j * rs;
            const float c = __builtin_amdgcn_cosf(ang), sn = __builtin_amdgcn_sinf(ang);
            const float c2 = c * c - sn * sn, s2 = 2.f * c * sn;
            float2 t1 = make_float2(y1.x * c2 - y1.y * s2, y1.y * c2 + y1.x * s2);
            float2 t3 = make_float2(y3.x * c2 - y3.y * s2, y3.y * c2 + y3.x * s2);
            float2 a0 = make_float2(y0.x + t1.x, y0.y + t1.y), a1 = make_float2(y0.x - t1.x, y0.y - t1.y);
            float2 a2 = make_float2(y2.x + t3.x, y2.y + t3.y), a3 = make_float2(y2.x - t3.x, y2.y - t3.y);
            float2 u2 = make_float2(a2.x * c - a2.y * sn, a2.y * c + a2.x * sn);
            float2 u3 = make_float2(a3.x * c - a3.y * sn, a3.y * c + a3.x * sn);
            float2 v3 = make_float2(-u3.y, u3.x);
            Z[zi<PAD>(base)] = make_float2(a0.x + u2.x, a0.y + u2.y);
            Z[zi<PAD>(base + h)] = make_float2(a0.x - u2.x, a0.y - u2.y);
            Z[zi<PAD>(base + h2)] = make_float2(a1.x + v3.x, a1.y + v3.y);
            Z[zi<PAD>(base + h + h2)] = make_float2(a1.x - v3.x, a1.y - v3.y);
        }
        __syncthreads();
    }
}


__device__ __forceinline__ int zp(int i) { return i + 2 * (i >> 5); }
__device__ constexpr float FC32[16] = {1.000000000f, 0.980785280f, 0.923879533f, 0.831469612f, 0.707106781f, 0.555570233f, 0.382683432f, 0.195090322f, 0.000000000f, -0.195090322f, -0.382683432f, -0.555570233f, -0.707106781f, -0.831469612f, -0.923879533f, -0.980785280f};
__device__ constexpr float FS32[16] = {0.000000000f, 0.195090322f, 0.382683432f, 0.555570233f, 0.707106781f, 0.831469612f, 0.923879533f, 0.980785280f, 1.000000000f, 0.980785280f, 0.923879533f, 0.831469612f, 0.707106781f, 0.555570233f, 0.382683432f, 0.195090322f};
__device__ __forceinline__ float2 cmulf(float2 a, float2 b) { return make_float2(a.x * b.x - a.y * b.y, a.x * b.y + a.y * b.x); }
template <int R> __device__ __forceinline__ constexpr int brevR(int x) { int r = 0; for (int b = 1, t = R >> 1; t >= 1; b <<= 1, t >>= 1) if (x & b) r |= t; return r; }
template <int R> __device__ __forceinline__ void dft_fwd_regs(float2 (&x)[R]) {
#pragma unroll
    for (int half = R / 2; half >= 1; half >>= 1) {
#pragma unroll
        for (int blk = 0; blk < R; blk += 2 * half)
#pragma unroll
            for (int k = 0; k < half; ++k) {
                const float2 a = x[blk + k], b = x[blk + k + half];
                x[blk + k] = make_float2(a.x + b.x, a.y + b.y);
                const float2 d = make_float2(a.x - b.x, a.y - b.y);
                const int ti = k * (16 / half);
                if (ti == 0) x[blk + k + half] = d;
                else if (ti == 8) x[blk + k + half] = make_float2(d.y, -d.x);
                else { const float c = FC32[ti], sn = FS32[ti]; x[blk + k + half] = make_float2(d.x * c + d.y * sn, d.y * c - d.x * sn); }
            }
    }
}
template <int R> __device__ __forceinline__ void dft_inv_regs(float2 (&x)[R]) {
#pragma unroll
    for (int half = 1; half <= R / 2; half <<= 1) {
#pragma unroll
        for (int blk = 0; blk < R; blk += 2 * half)
#pragma unroll
            for (int k = 0; k < half; ++k) {
                const float2 a = x[blk + k], b0 = x[blk + k + half];
                const int ti = k * (16 / half);
                float2 b;
                if (ti == 0) b = b0;
                else if (ti == 8) b = make_float2(-b0.y, b0.x);
                else { const float c = FC32[ti], sn = FS32[ti]; b = make_float2(b0.x * c - b0.y * sn, b0.y * c + b0.x * sn); }
                x[blk + k] = make_float2(a.x + b.x, a.y + b.y);
                x[blk + k + half] = make_float2(a.x - b.x, a.y - b.y);
            }
    }
}
template <int R> __device__ __forceinline__ void apply_tw(float2 (&x)[R], float c, float sg) {
    const float2 w1 = make_float2(c, sg), w2 = cmulf(w1, w1);
    float2 po = w1, pe = w2;
#pragma unroll
    for (int m = 1; m < R; m += 2) {
        x[brevR<R>(m)] = cmulf(x[brevR<R>(m)], po);
        if (m + 1 < R) x[brevR<R>(m + 1)] = cmulf(x[brevR<R>(m + 1)], pe);
        if (m + 2 < R) { po = cmulf(po, w2); pe = cmulf(pe, w2); }
    }
}
template <int R, bool INV> __device__ __forceinline__ void fft_group(float2* Z, int pbase, int PS, float ang) {
    float2 x[R];
    if (!INV) {
#pragma unroll
        for (int m = 0; m < R; ++m) x[m] = Z[pbase + PS * m];
        dft_fwd_regs<R>(x);
        apply_tw<R>(x, __builtin_amdgcn_cosf(ang), -__builtin_amdgcn_sinf(ang));
#pragma unroll
        for (int m = 0; m < R; ++m) Z[pbase + PS * m] = x[brevR<R>(m)];
    } else {
#pragma unroll
        for (int m = 0; m < R; ++m) x[brevR<R>(m)] = Z[pbase + PS * m];
        apply_tw<R>(x, __builtin_amdgcn_cosf(ang), __builtin_amdgcn_sinf(ang));
        dft_inv_regs<R>(x);
#pragma unroll
        for (int m = 0; m < R; ++m) Z[pbase + PS * m] = x[m];
    }
}
template <bool INV> __device__ __forceinline__ void fft_group32_contig(float2* Z, int pbase) {
    float2 x[32];
    if (!INV) {
#pragma unroll
        for (int m = 0; m < 32; m += 2) { const f32x4 v = *(const f32x4*)(Z + pbase + m); x[m] = make_float2(v.x, v.y); x[m + 1] = make_float2(v.z, v.w); }
        dft_fwd_regs<32>(x);
#pragma unroll
        for (int m = 0; m < 32; m += 2) { const float2 a = x[brevR<32>(m)], b = x[brevR<32>(m + 1)]; *(f32x4*)(Z + pbase + m) = (f32x4){a.x, a.y, b.x, b.y}; }
    } else {
#pragma unroll
        for (int m = 0; m < 32; m += 2) { const f32x4 v = *(const f32x4*)(Z + pbase + m); x[brevR<32>(m)] = make_float2(v.x, v.y); x[brevR<32>(m + 1)] = make_float2(v.z, v.w); }
        dft_inv_regs<32>(x);
#pragma unroll
        for (int m = 0; m < 32; m += 2) *(f32x4*)(Z + pbase + m) = (f32x4){x[m].x, x[m].y, x[m + 1].x, x[m + 1].y};
    }
}
__device__ __forceinline__ void fft16k_fwd(float2* Z) {
    const int tid = otid();
#pragma unroll 1
    for (int g = 0; g < 2; ++g) { const int j = tid + 512 * g; fft_group<16, false>(Z, zp(j), 1088, (float)j * (1.0f / 16384.0f)); }
    __syncthreads();
    { const int blk = tid >> 5, j = tid & 31; fft_group<32, false>(Z, blk * 1088 + j, 34, (float)j * (1.0f / 1024.0f)); }
    __syncthreads();
    fft_group32_contig<false>(Z, 34 * tid);
    __syncthreads();
}
__device__ __forceinline__ void fft16k_inv(float2* Z) {
    const int tid = otid();
    fft_group32_contig<true>(Z, 34 * tid);
    __syncthreads();
    { const int blk = tid >> 5, j = tid & 31; fft_group<32, true>(Z, blk * 1088 + j, 34, (float)j * (1.0f / 1024.0f)); }
    __syncthreads();
#pragma unroll 1
    for (int g = 0; g < 2; ++g) { const int j = tid + 512 * g; fft_group<16, true>(Z, zp(j), 1088, (float)j * (1.0f / 16384.0f)); }
    __syncthreads();
}
__device__ __forceinline__ void fft8k_fwd(float2* Z) {
    const int tid = otid();
    fft_group<16, false>(Z, zp(tid), 544, (float)tid * (1.0f / 8192.0f));
    __syncthreads();
    { const int blk = tid >> 5, j = tid & 31; fft_group<16, false>(Z, blk * 544 + j, 34, (float)j * (1.0f / 512.0f)); }
    __syncthreads();
    if (tid < 256) fft_group32_contig<false>(Z, 34 * tid);
    __syncthreads();
}
__device__ __forceinline__ int f16k_of_p(int p) { return (p >> 10) + 16 * ((p >> 5) & 31) + 512 * (p & 31); }
__device__ __forceinline__ int p16k_of_f(int f) { return 1024 * (f & 15) + 32 * ((f >> 4) & 31) + (f >> 9); }
__device__ __forceinline__ int p8k_of_f(int f) { return 512 * (f & 15) + 32 * ((f >> 4) & 15) + (f >> 8); }

__device__ __forceinline__ void phase_filter_spectra(const Params& p, char* lds) {
    const int tid = otid(), lane = tid & 63, wave = tid >> 6;
    float2* Z = (float2*)lds;
    float* red = (float*)(lds + 139264 + 64);
    for (int job = obid(); job < NLAYER * 256; job += NBLK) {
        const int layer = job >> 8, c = job & 255;
        __syncthreads();
        const float* HFc = (const float*)(p.ws + (layer ? OFF_HFILT1 : OFF_HFILT0)) + (size_t)c * SL;
        const float r_lo = 4.605170185988092f / 1.5f, r_hi = 4.605170185988092f / 0.3f;
        const float rate = r_lo + (r_hi - r_lo) * ((float)c / 255.0f);
        float ss0 = 0.f, ss1 = 0.f;
#pragma unroll 1
        for (int i = 0; i < 4; ++i) {
            const int l0 = 4 * tid + 2048 * i;
            const f32x4 a0 = *(const f32x4*)(HFc + l0), a1 = *(const f32x4*)(HFc + (size_t)256 * SL + l0);
            const f32x4 a2 = *(const f32x4*)(HFc + (size_t)512 * SL + l0), a3 = *(const f32x4*)(HFc + (size_t)768 * SL + l0);
#pragma unroll
            for (int e = 0; e < 4; ++e) {
                const int l = l0 + e;
                const float t = (float)l / (float)(SL - 1);
                const float dec = expf(-t * rate);
                const float f0 = a0[e] * dec, b0 = a1[e] * dec, f1 = a2[e] * dec, b1 = a3[e] * dec;
                ss0 += f0 * f0 + b0 * b0; ss1 += f1 * f1 + b1 * b1;
                Z[zp(l)] = make_float2(f0, f1);
                if (l >= 1) Z[zp(16384 - l)] = make_float2(b0, b1);
            }
        }
        if (tid == 0) Z[zp(8192)] = make_float2(0.f, 0.f);
        ss0 = wave_sum(ss0); ss1 = wave_sum(ss1);
        if (lane == 0) { red[wave * 2] = ss0; red[wave * 2 + 1] = ss1; }
        __syncthreads();
        float t0 = 0.f, t1 = 0.f;
#pragma unroll
        for (int w = 0; w < 8; ++w) { t0 += red[w * 2]; t1 += red[w * 2 + 1]; }
        const float sc0 = rsqrtf(t0 + EPS) * (1.0f / 16384.0f) * 0.5f, sc1 = rsqrtf(t1 + EPS) * (1.0f / 16384.0f) * 0.5f;
        fft16k_fwd(Z);
        float2* KF0 = (float2*)(p.ws + OFF_KF) + ((size_t)(layer * 256 + c) * 2) * 16384;
        float2* KF1 = KF0 + 16384;
        for (int i = 0; i < 32; ++i) {
            const int pp = tid + NTHR * i;
            const int fq = f16k_of_p(pp);
            const int pq = p16k_of_f((16384 - fq) & 16383);
            const float2 za = Z[zp(pp)], zq = Z[zp(pq)];
            KF0[pp] = make_float2((za.x + zq.x) * sc0, (za.y - zq.y) * sc0);
            KF1[pp] = make_float2((za.y + zq.y) * sc1, (zq.x - za.x) * sc1);
        }
    }
}

__device__ __forceinline__ void phase_rmsnorm_bf16(const float* x, const float* g, bf16_t* out) {
    const int lane = otid() & 63, wave = otid() >> 6;
    const int gw = obid() * NWAVE + wave, ngw = NBLK * NWAVE;
    for (int row = gw; row < T; row += ngw) {
        const f32x4* xr = (const f32x4*)(x + (size_t)row * DM) + lane;
        f32x4 v[4]; float ss = 0.f;
#pragma unroll
        for (int j = 0; j < 4; ++j) { v[j] = xr[64 * j]; ss += v[j].x * v[j].x + v[j].y * v[j].y + v[j].z * v[j].z + v[j].w * v[j].w; }
        ss = wave_sum(ss);
        const float r = rsqrtf(ss * (1.0f / DM) + EPS);
        u32x2* o = (u32x2*)(out + (size_t)row * DM) + lane;
#pragma unroll
        for (int j = 0; j < 4; ++j) {
            const f32x4 gg = ((const f32x4*)g)[lane + 64 * j];
            u32x2 w; w.x = pk2(v[j].x * r * gg.x, v[j].y * r * gg.y); w.y = pk2(v[j].z * r * gg.z, v[j].w * r * gg.w);
            o[64 * j] = w;
        }
    }
}
__device__ __forceinline__ void phase_final_norm(const float* x, const float* g, float* out) {
    const int lane = otid() & 63, wave = otid() >> 6;
    const int gw = obid() * NWAVE + wave, ngw = NBLK * NWAVE;
    for (int row = gw; row < T; row += ngw) {
        const f32x4* xr = (const f32x4*)(x + (size_t)row * DM) + lane;
        f32x4 v[4]; float ss = 0.f;
#pragma unroll
        for (int j = 0; j < 4; ++j) { v[j] = xr[64 * j]; ss += v[j].x * v[j].x + v[j].y * v[j].y + v[j].z * v[j].z + v[j].w * v[j].w; }
        ss = wave_sum(ss);
        const float r = rsqrtf(ss * (1.0f / DM) + EPS);
        f32x4* o = (f32x4*)(out + (size_t)row * DM) + lane;
#pragma unroll
        for (int j = 0; j < 4; ++j) { const f32x4 gg = ((const f32x4*)g)[lane + 64 * j]; o[64 * j] = v[j] * r * gg; }
    }
}

constexpr int G_LDA = 144;
template <class Epi>
__device__ __forceinline__ void gemm_simple(const bf16_t* A, const bf16_t* Bt, int M, int N, int K, char* lds, const Epi& epi) {
    const int tid = otid(), lane = tid & 63, wave = tid >> 6;
    const int wm = wave >> 1, wn = wave & 1;
    const int nMt = M / 256, nNt = N / 128, total = nMt * nNt, nk = K / 64;
    char* As = lds; char* Bs = lds + 256 * G_LDA;
    const int l31 = lane & 31, hl = lane >> 5;
    for (int u = obid(); u < total; u += NBLK) {
        const int mt = u % nMt, nt = u / nMt;
        f32x16 acc[2][2];
#pragma unroll
        for (int i = 0; i < 2; ++i)
#pragma unroll
            for (int j = 0; j < 2; ++j) acc[i][j] = zero16();
        u32x4 ra[4], rb[2];
        const bf16_t* Ab = A + (size_t)(mt * 256) * K;
        const bf16_t* Bb = Bt + (size_t)(nt * 128) * K;
#pragma unroll
        for (int i = 0; i < 4; ++i) { const int id = tid + NTHR * i, row = id >> 3, ch = id & 7; ra[i] = *(const u32x4*)(Ab + (size_t)row * K + ch * 8); }
#pragma unroll
        for (int i = 0; i < 2; ++i) { const int id = tid + NTHR * i, row = id >> 3, ch = id & 7; rb[i] = *(const u32x4*)(Bb + (size_t)row * K + ch * 8); }
        for (int kt = 0; kt < nk; ++kt) {
            __syncthreads();
#pragma unroll
            for (int i = 0; i < 4; ++i) { const int id = tid + NTHR * i, row = id >> 3, ch = id & 7; *(u32x4*)(As + row * G_LDA + ch * 16) = ra[i]; }
#pragma unroll
            for (int i = 0; i < 2; ++i) { const int id = tid + NTHR * i, row = id >> 3, ch = id & 7; *(u32x4*)(Bs + row * G_LDA + ch * 16) = rb[i]; }
            __syncthreads();
            if (kt + 1 < nk) {
                const int ko = (kt + 1) * 64;
#pragma unroll
                for (int i = 0; i < 4; ++i) { const int id = tid + NTHR * i, row = id >> 3, ch = id & 7; ra[i] = *(const u32x4*)(Ab + (size_t)row * K + ko + ch * 8); }
#pragma unroll
                for (int i = 0; i < 2; ++i) { const int id = tid + NTHR * i, row = id >> 3, ch = id & 7; rb[i] = *(const u32x4*)(Bb + (size_t)row * K + ko + ch * 8); }
            }
#pragma unroll
            for (int ks = 0; ks < 4; ++ks) {
                bf16x8 a[2], b[2];
#pragma unroll
                for (int i = 0; i < 2; ++i) a[i] = *(const bf16x8*)(As + (wm * 64 + i * 32 + l31) * G_LDA + ks * 32 + hl * 16);
#pragma unroll
                for (int j = 0; j < 2; ++j) b[j] = *(const bf16x8*)(Bs + (wn * 64 + j * 32 + l31) * G_LDA + ks * 32 + hl * 16);
#pragma unroll
                for (int i = 0; i < 2; ++i)
#pragma unroll
                    for (int j = 0; j < 2; ++j) acc[i][j] = mfma32(a[i], b[j], acc[i][j]);
            }
        }
#pragma unroll
        for (int i = 0; i < 2; ++i)
#pragma unroll
            for (int j = 0; j < 2; ++j) epi(acc[i][j], mt * 256 + wm * 64 + i * 32, nt * 128 + wn * 64 + j * 32, lane);
    }
}

struct EpiIn {
    bf16_t* qkv; float* hf;
    __device__ __forceinline__ void operator()(const f32x16& acc, int row0, int col0, int lane) const {
        const int c = col0 + (lane & 31), h = lane >> 5;
        if (col0 < 768) {
#pragma unroll
            for (int r = 0; r < 16; ++r) { const int row = row0 + (r & 3) + 8 * (r >> 2) + 4 * h; qkv[(size_t)row * 768 + c] = (bf16_t)f2bf(acc[r]); }
        } else {
            float* dst = hf + (size_t)(c - 768) * T;
#pragma unroll
            for (int i = 0; i < 4; ++i) { const int row = row0 + 8 * i + 4 * h; f32x4 v; v.x = acc[4 * i]; v.y = acc[4 * i + 1]; v.z = acc[4 * i + 2]; v.w = acc[4 * i + 3]; *(f32x4*)(dst + row) = v; }
        }
    }
};
struct EpiRes {
    const float* base; float* out;
    __device__ __forceinline__ void operator()(const f32x16& acc, int row0, int col0, int lane) const {
        const int c = col0 + (lane & 31), h = lane >> 5;
#pragma unroll
        for (int r = 0; r < 16; ++r) { const size_t o = (size_t)(row0 + (r & 3) + 8 * (r >> 2) + 4 * h) * DM + c; out[o] = base[o] + acc[r]; }
    }
};
struct EpiF32 {
    float* out; int ld;
    __device__ __forceinline__ void operator()(const f32x16& acc, int row0, int col0, int lane) const {
        const int c = col0 + (lane & 31), h = lane >> 5;
#pragma unroll
        for (int r = 0; r < 16; ++r) { out[(size_t)(row0 + (r & 3) + 8 * (r >> 2) + 4 * h) * ld + c] = acc[r]; }
    }
};

namespace pg8 {
#define PG8_LAS __attribute__((address_space(3)))
constexpr int BM = 256, BK = 64, HALF = 128, HTB = HALF * BK * 2  , STAGE_BYTES = 8 * HTB, NXCD = 8, WGM = 8;

__host__ __device__ __forceinline__ int lds_byte(int r, int c) { const int st = (r >> 4) * 2 + (c >> 5), rr = r & 15, cc = c & 31, ob = rr * 64 + cc * 2; return st * 1024 + (ob ^ (((ob >> 9) & 1) << 5)); }
__host__ __device__ __forceinline__ void stage_rc(int b, int& R, int& C) { const int st = b / 1024, sb = b % 1024, swz = sb ^ (((sb >> 9) & 1) << 5); R = (st >> 1) * 16 + swz / 64; C = (st & 1) * 32 + (swz % 64) / 2; }
__host__ __device__ __forceinline__ int perm32(int rho) { const int n = rho >> 4, i = rho & 15; return 8 * (i >> 2) + 4 * n + (i & 3); }

struct Unit { int pm, pn; };
struct Gemm { const bf16_t* A; const bf16_t* Bt; int M, N, K; };

struct StaticOrder {
    int nM, nN, nwg, G, c;
    __host__ __device__ void init(int M, int N, int G_, int c_) { nM = M / BM; nN = N / BM; nwg = nM * nN; G = G_; c = c_; }
    __host__ __device__ bool next(int i, Unit& u) const {
        const long L = (long)i * G + c; if (L >= nwg) return false;
        int wgid = (int)L; { const int q = nwg / NXCD, r = nwg % NXCD, xcd = wgid % NXCD, off = wgid / NXCD; wgid = (xcd < r ? xcd * (q + 1) : r * (q + 1) + (xcd - r) * q) + off; }
        const int nig = WGM * nN, gid = wgid / nig, fm = gid * WGM, gsz = (nM - fm) < WGM ? (nM - fm) : WGM;
        u.pm = fm + ((wgid % nig) % gsz); u.pn = (wgid % nig) / gsz; return true;
    }
    __device__ __forceinline__ void a_ready(const Unit&) const {}
    __device__ __forceinline__ void done(const Unit&) const {}
};


__device__ __forceinline__ unsigned cvt_pk_bf16(float lo, float hi) { unsigned r; asm volatile("v_cvt_pk_bf16_f32 %0, %1, %2" : "=v"(r) : "v"(lo), "v"(hi)); return r; }
struct EpiStoreBf16 {
    static constexpr bool PERM = true, AFTER_DRAIN = false;
    bf16_t* O; int ldc;
    __device__ __forceinline__ void operator()(const f32x4 (&acc)[2][2][4][2], const Unit& u, int wr, int wc, int fr, int fq) const {
        const int row0 = u.pm * BM + wr * 64 + fr, col0 = u.pn * BM + wc * 32 + 8 * fq;
#pragma unroll
        for (int ai = 0; ai < 2; ++ai)
#pragma unroll
            for (int m = 0; m < 4; ++m) { bf16_t* rowp = O + (size_t)(row0 + ai * HALF + m * 16) * ldc + col0;
#pragma unroll
                for (int bj = 0; bj < 2; ++bj) { const f32x4 v0 = acc[ai][bj][m][0], v1 = acc[ai][bj][m][1];
                    u32x4 w; w.x = cvt_pk_bf16(v0[0], v0[1]); w.y = cvt_pk_bf16(v0[2], v0[3]); w.z = cvt_pk_bf16(v1[0], v1[1]); w.w = cvt_pk_bf16(v1[2], v1[3]);
                    *(u32x4*)(rowp + bj * HALF) = w; } }
    }
};
struct EpiOutProj {
    static constexpr bool PERM = false, AFTER_DRAIN = false;
    const float* base; float* O; bf16_t* XB; float* RS;
    __device__ __forceinline__ void operator()(const f32x4 (&acc)[2][2][4][2], const Unit& u, int wr, int wc, int fr, int fq) const {
        const int row0 = u.pm * BM + wr * 64 + fr, col0 = u.pn * BM + wc * 32 + 4 * fq;
#pragma unroll
        for (int ai = 0; ai < 2; ++ai)
#pragma unroll
            for (int m = 0; m < 4; ++m) { const int row = row0 + ai * HALF + m * 16; const size_t off = (size_t)row * 1024 + col0; float ss = 0.f;
#pragma unroll
                for (int bj = 0; bj < 2; ++bj)
#pragma unroll
                    for (int n = 0; n < 2; ++n) { const f32x4 v = acc[ai][bj][m][n] + *(const f32x4*)(base + off + bj * HALF + n * 16);
                        *(f32x4*)(O + off + bj * HALF + n * 16) = v; ss += v[0] * v[0] + v[1] * v[1] + v[2] * v[2] + v[3] * v[3];
                        u32x2 w; w.x = cvt_pk_bf16(v[0], v[1]); w.y = cvt_pk_bf16(v[2], v[3]); *(u32x2*)(XB + off + bj * HALF + n * 16) = w; }
                ss += __shfl_xor(ss, 16); ss += __shfl_xor(ss, 32);
                if (fq == 0) RS[(size_t)row * 16 + u.pn * 4 + wc] = ss; }
    }
};
struct EpiRowScaleF32 {
    static constexpr bool PERM = false, AFTER_DRAIN = false;
    float* O; int ldc; const float* RS;
    __device__ __forceinline__ void operator()(const f32x4 (&acc)[2][2][4][2], const Unit& u, int wr, int wc, int fr, int fq) const {
        const int row0 = u.pm * BM + wr * 64 + fr, col0 = u.pn * BM + wc * 32 + 4 * fq;
#pragma unroll
        for (int ai = 0; ai < 2; ++ai)
#pragma unroll
            for (int m = 0; m < 4; ++m) { const int row = row0 + ai * HALF + m * 16; const size_t off = (size_t)row * ldc + col0;
                float tot = 0.f;
#pragma unroll
                for (int q = 0; q < 4; ++q) { const f32x4 pr = *(const f32x4*)(RS + (size_t)row * 16 + 4 * q); tot += (pr[0] + pr[1]) + (pr[2] + pr[3]); }
                const float r = rsqrtf(tot * (1.0f / 1024.0f) + 1e-6f);
#pragma unroll
                for (int bj = 0; bj < 2; ++bj)
#pragma unroll
                    for (int n = 0; n < 2; ++n) *(f32x4*)(O + off + bj * HALF + n * 16) = acc[ai][bj][m][n] * r; }
    }
};
struct EpiStoreF32 {
    static constexpr bool PERM = false, AFTER_DRAIN = false;
    const float* base; float* O; int ldc;
    __device__ __forceinline__ void operator()(const f32x4 (&acc)[2][2][4][2], const Unit& u, int wr, int wc, int fr, int fq) const {
        const int row0 = u.pm * BM + wr * 64 + fr, col0 = u.pn * BM + wc * 32 + 4 * fq;
#pragma unroll
        for (int ai = 0; ai < 2; ++ai)
#pragma unroll
            for (int m = 0; m < 4; ++m) { const size_t off = (size_t)(row0 + ai * HALF + m * 16) * ldc + col0;
#pragma unroll
                for (int bj = 0; bj < 2; ++bj)
#pragma unroll
                    for (int n = 0; n < 2; ++n) { f32x4 v = acc[ai][bj][m][n]; if (base) v += *(const f32x4*)(base + off + bj * HALF + n * 16); *(f32x4*)(O + off + bj * HALF + n * 16) = v; } }
    }
};

template <class Epi, class Sched, bool ALIGN_EPI = false, bool SP2 = false>
__device__ __forceinline__ void gemm_phase(PG8_LAS unsigned char* lds, const Gemm g, const Sched& S, const Epi& E) {
    const int tid = otid(), wid = __builtin_amdgcn_readfirstlane(tid >> 6), lane = tid & 63, wr = wid >> 2, wc = wid & 3, fr = lane & 15, fq = lane >> 4;
    const int K = g.K, nt = K / BK;
    unsigned voffA[2], voffB[2];
#pragma unroll
    for (int i = 0; i < 2; ++i) { int R, C; stage_rc(tid * 16 + i * 8192, R, C); const int Rb = Epi::PERM ? ((R & ~31) + perm32(R & 31)) : R;
        voffA[i] = (unsigned)(R * K + C) * 2u; voffB[i] = (unsigned)(Rb * K + C) * 2u; }
    const size_t kstep = (size_t)(BK * 2);
    const size_t hstep = (size_t)HALF * K * 2;
    const size_t tstep = 2 * hstep;
    const unsigned ldsw = (unsigned)wid * 1024u;
    const int aoff = lds_byte(wr * 64 + fr, fq * 8), boff = lds_byte(wc * 32 + fr, fq * 8);
#define PG8_SA(b, h) (((b) * 2 + (h)) * HTB)
#define PG8_SB(b, h) ((4 + (b) * 2 + (h)) * HTB)
#define PG8_STAGE(bufoff, gbase, voff) do { _Pragma("unroll") for (int _i = 0; _i < 2; ++_i) \
        __builtin_amdgcn_global_load_lds((const unsigned*)((const char*)(gbase) + (voff)[_i]), (PG8_LAS unsigned*)(lds + (bufoff) + ldsw + _i * 8192), 16, 0, 0); } while (0)
#define PG8_LDA(dst, b, h) do { _Pragma("unroll") for (int m = 0; m < 4; ++m) _Pragma("unroll") for (int k = 0; k < 2; ++k) dst[m][k] = *(const PG8_LAS bf16x8*)(lds + PG8_SA(b, h) + aoff + m * 2048 + k * 1024); } while (0)
#define PG8_LDB(dst, b, h) do { _Pragma("unroll") for (int n = 0; n < 2; ++n) _Pragma("unroll") for (int k = 0; k < 2; ++k) dst[n][k] = *(const PG8_LAS bf16x8*)(lds + PG8_SB(b, h) + boff + n * 2048 + k * 1024); } while (0)
#define PG8_MMA(ai, bj, At, Bt) do { __builtin_amdgcn_s_setprio(1); _Pragma("unroll") for (int m = 0; m < 4; ++m) _Pragma("unroll") for (int n = 0; n < 2; ++n) _Pragma("unroll") for (int k = 0; k < 2; ++k) \
        acc[ai][bj][m][n] = __builtin_amdgcn_mfma_f32_16x16x32_bf16(Bt[n][k], At[m][k], acc[ai][bj][m][n], 0, 0, 0); __builtin_amdgcn_s_setprio(0); } while (0)
#define PG8_WAIT_V(n) asm volatile("s_waitcnt vmcnt(" #n ")" ::: "memory")
#define PG8_WAIT_L(n) asm volatile("s_waitcnt lgkmcnt(" #n ")" ::: "memory")
#define PG8_BAR __builtin_amdgcn_s_barrier()
#define PG8_SCHED __builtin_amdgcn_sched_barrier(0)
    Unit cur, nxt; int ui = 0;
    if (!S.next(0, cur)) return;
    f32x4 acc[2][2][4][2];
#pragma unroll
    for (int a = 0; a < 2; ++a)
#pragma unroll
        for (int b = 0; b < 2; ++b)
#pragma unroll
            for (int m = 0; m < 4; ++m)
#pragma unroll
                for (int n = 0; n < 2; ++n) acc[a][b][m][n] = (f32x4){0.f, 0.f, 0.f, 0.f};
    bf16x8 At[4][2], B0[2][2], B1[2][2];
    const char* cA = (const char*)g.A + (size_t)cur.pm * tstep; const char* cB = (const char*)g.Bt + (size_t)cur.pn * tstep;
    S.a_ready(cur);
    if constexpr (SP2) {
        PG8_STAGE(PG8_SB(0, 0), cB, voffB); PG8_STAGE(PG8_SB(0, 1), cB + hstep, voffB); PG8_STAGE(PG8_SA(0, 0), cA, voffA); PG8_STAGE(PG8_SA(0, 1), cA + hstep, voffA);
        if (wr == 1) PG8_BAR;
        PG8_WAIT_V(2); PG8_BAR;
        PG8_STAGE(PG8_SB(1, 0), cB + kstep, voffB); PG8_STAGE(PG8_SA(1, 0), cA + kstep, voffA); PG8_STAGE(PG8_SB(1, 1), cB + hstep + kstep, voffB);
        PG8_WAIT_V(6); PG8_BAR;
    } else {
        PG8_STAGE(PG8_SB(0, 0), cB, voffB); PG8_STAGE(PG8_SA(0, 0), cA, voffA); PG8_STAGE(PG8_SB(0, 1), cB + hstep, voffB); PG8_STAGE(PG8_SA(0, 1), cA + hstep, voffA);
        if (wr == 1) PG8_BAR;
        PG8_WAIT_V(4); PG8_BAR;
        PG8_STAGE(PG8_SB(1, 0), cB + kstep, voffB); PG8_STAGE(PG8_SA(1, 0), cA + kstep, voffA); PG8_STAGE(PG8_SB(1, 1), cB + hstep + kstep, voffB);
        PG8_WAIT_V(6); PG8_BAR;
    }
    for (;;) {
        const bool has_next = S.next(ui + 1, nxt);
        const char* nA = has_next ? (const char*)g.A + (size_t)nxt.pm * tstep : cA; const char* nB = has_next ? (const char*)g.Bt + (size_t)nxt.pn * tstep : cB;
        for (int t = 0; t < nt; t += 2) {
            const bool last = (t == nt - 2);
            const char* a1 = cA + (size_t)(t + 1) * kstep;
            const char* a2 = last ? nA : cA + (size_t)(t + 2) * kstep; const char* b2 = last ? nB : cB + (size_t)(t + 2) * kstep;
            const char* a3 = a2 + kstep; const char* b3 = b2 + kstep;
            if (last && has_next) S.a_ready(nxt);
            if constexpr (SP2) {
            PG8_LDB(B0, 0, 0); PG8_LDB(B1, 0, 1); PG8_SCHED; PG8_LDA(At, 0, 0); PG8_STAGE(PG8_SA(1, 1), a1 + hstep, voffA);
            PG8_WAIT_V(8); PG8_WAIT_L(0); PG8_BAR; PG8_MMA(0, 0, At, B0); PG8_MMA(0, 1, At, B1); PG8_BAR; PG8_SCHED;
            PG8_LDA(At, 0, 1); PG8_STAGE(PG8_SB(0, 0), b2, voffB); PG8_STAGE(PG8_SB(0, 1), b2 + hstep, voffB); PG8_STAGE(PG8_SA(0, 0), a2, voffA);
            PG8_WAIT_V(8); PG8_WAIT_L(0); PG8_BAR; PG8_MMA(1, 0, At, B0); PG8_MMA(1, 1, At, B1); PG8_BAR; PG8_SCHED;
            PG8_LDB(B0, 1, 0); PG8_LDB(B1, 1, 1); PG8_SCHED; PG8_LDA(At, 1, 0); PG8_STAGE(PG8_SA(0, 1), a2 + hstep, voffA);
            PG8_WAIT_V(8); PG8_WAIT_L(0); PG8_BAR; PG8_MMA(0, 0, At, B0); PG8_MMA(0, 1, At, B1); PG8_BAR; PG8_SCHED;
            PG8_LDA(At, 1, 1); PG8_STAGE(PG8_SB(1, 0), b3, voffB); PG8_STAGE(PG8_SB(1, 1), b3 + hstep, voffB); PG8_STAGE(PG8_SA(1, 0), a3, voffA);
            PG8_WAIT_V(8); PG8_WAIT_L(0); PG8_BAR; PG8_MMA(1, 0, At, B0); PG8_MMA(1, 1, At, B1); PG8_BAR; PG8_SCHED;
            } else {
            PG8_LDB(B0, 0, 0); PG8_SCHED; PG8_LDA(At, 0, 0); PG8_STAGE(PG8_SA(1, 1), a1 + hstep, voffA);
            PG8_WAIT_L(8); PG8_BAR; PG8_WAIT_L(0); PG8_MMA(0, 0, At, B0); PG8_BAR; PG8_SCHED;
            PG8_LDB(B1, 0, 1); PG8_STAGE(PG8_SB(0, 0), b2, voffB);
            PG8_BAR; PG8_WAIT_L(0); PG8_MMA(0, 1, At, B1); PG8_BAR;
            PG8_LDA(At, 0, 1); PG8_STAGE(PG8_SA(0, 0), a2, voffA);
            PG8_BAR; PG8_WAIT_L(0); PG8_MMA(1, 0, At, B0); PG8_BAR; PG8_SCHED;
            PG8_STAGE(PG8_SB(0, 1), b2 + hstep, voffB);
            PG8_WAIT_V(6); PG8_BAR; PG8_MMA(1, 1, At, B1); PG8_BAR;
            PG8_LDB(B0, 1, 0); PG8_SCHED; PG8_LDA(At, 1, 0); PG8_STAGE(PG8_SA(0, 1), a2 + hstep, voffA);
            PG8_WAIT_L(8); PG8_BAR; PG8_WAIT_L(0); PG8_MMA(0, 0, At, B0); PG8_BAR; PG8_SCHED;
            PG8_LDB(B1, 1, 1); PG8_STAGE(PG8_SB(1, 0), b3, voffB);
            PG8_BAR; PG8_WAIT_L(0); PG8_MMA(0, 1, At, B1); PG8_BAR;
            PG8_LDA(At, 1, 1); PG8_STAGE(PG8_SA(1, 0), a3, voffA);
            PG8_BAR; PG8_WAIT_L(0); PG8_MMA(1, 0, At, B0); PG8_BAR; PG8_SCHED;
            PG8_STAGE(PG8_SB(1, 1), b3 + hstep, voffB);
            PG8_WAIT_V(6); PG8_BAR; PG8_MMA(1, 1, At, B1); PG8_BAR;
            }
        }
        if constexpr (ALIGN_EPI) { if (wr == 0) PG8_BAR; }
        if constexpr (!Epi::AFTER_DRAIN) { E(acc, cur, wr, wc, fr, fq); S.done(cur); }
        if (!has_next) break;
#pragma unroll
        for (int a = 0; a < 2; ++a)
#pragma unroll
            for (int b = 0; b < 2; ++b)
#pragma unroll
                for (int m = 0; m < 4; ++m)
#pragma unroll
                    for (int n = 0; n < 2; ++n) acc[a][b][m][n] = (f32x4){0.f, 0.f, 0.f, 0.f};
        cur = nxt; cA = nA; cB = nB; ++ui;
        if constexpr (ALIGN_EPI) { if (wr == 1) PG8_BAR; }
    }
    PG8_WAIT_V(0);
    if constexpr (!ALIGN_EPI) { if (wr == 0) PG8_BAR; }
    PG8_BAR;
    if constexpr (Epi::AFTER_DRAIN) { E.fused(acc, cur, wr, wc, fr, fq, lds, wid, lane); S.done(cur); }
#undef PG8_SA
#undef PG8_SB
#undef PG8_STAGE
#undef PG8_LDA
#undef PG8_LDB
#undef PG8_MMA
#undef PG8_WAIT_V
#undef PG8_WAIT_L
#undef PG8_BAR
#undef PG8_SCHED
}
}

__device__ constexpr float ROPE_INV_REV[16] = {1.591549431e-01f, 8.949940161e-02f, 5.032921210e-02f, 2.830219583e-02f, 1.591549431e-02f, 8.949940161e-03f, 5.032921210e-03f, 2.830219583e-03f, 1.591549431e-03f, 8.949940161e-04f, 5.032921210e-04f, 2.830219583e-04f, 1.591549431e-04f, 8.949940161e-05f, 5.032921210e-05f, 2.830219583e-05f};
__device__ __forceinline__ void qk_norm_rope8(const u32x4 raw, const float (&gn)[8], const float (&cs)[8], const float (&sn)[8], bool second, float scale, u32x4& out) {
    float x[8] = {bflo(raw.x), bfhi(raw.x), bflo(raw.y), bfhi(raw.y), bflo(raw.z), bfhi(raw.z), bflo(raw.w), bfhi(raw.w)};
    float ss = 0.f;
#pragma unroll
    for (int e = 0; e < 8; ++e) ss += x[e] * x[e];
    ss += __shfl_xor(ss, 1); ss += __shfl_xor(ss, 2); ss += __shfl_xor(ss, 4);
    const float r = rsqrtf(ss * (1.0f / 64.0f) + EPS) ;
    float o[8];
#pragma unroll
    for (int e = 0; e < 8; ++e) {
        const float y = x[e] * r * gn[e];
        const float other = __shfl_xor(y, 2);
        o[e] = (second ? (y * cs[e] + other * sn[e]) : (y * cs[e] - other * sn[e])) * scale;
    }
    out.x = pk2(o[0], o[1]); out.y = pk2(o[2], o[3]); out.z = pk2(o[4], o[5]); out.w = pk2(o[6], o[7]);
}
__device__ __forceinline__ void phase_qkprep(const Params& p, int layer, char* lds, bf16_t* qout) {
    const int tid = otid(), lane = tid & 63, wave = tid >> 6;
    const bf16_t* qkv = (const bf16_t*)(p.ws + R_QKV);
    const int sub = lane & 7;
    const bool second = ((sub >> 1) & 1) != 0, colaxis = (sub >> 2) != 0;
    float gq[8], gk[8], ir[8];
#pragma unroll
    for (int e = 0; e < 8; ++e) {
        gq[e] = p.in[I_QG][layer * 64 + sub * 8 + e]; gk[e] = p.in[I_KG][layer * 64 + sub * 8 + e];
        ir[e] = (sub & 1) ? ROPE_INV_REV[8 + e] : ROPE_INV_REV[e];
    }
    const int gw = obid() * NWAVE + wave, ngw = NBLK * NWAVE;
    for (int t = gw; t < T; t += ngw) {
        const int l = t & (SL - 1);
        const float pos = colaxis ? (float)(l & 63) : (float)(l >> 6);
        float cs[8], sn[8];
#pragma unroll
        for (int e = 0; e < 8; ++e) { const float a = pos * ir[e]; cs[e] = __builtin_amdgcn_cosf(a); sn[e] = __builtin_amdgcn_sinf(a); }
        const u32x4 rq = *(const u32x4*)(qkv + (size_t)t * 768 + lane * 8);
        u32x4 rk = {0u, 0u, 0u, 0u};
        if (lane < 16) rk = *(const u32x4*)(qkv + (size_t)t * 768 + 512 + lane * 8);
        u32x4 oq, ok;
        qk_norm_rope8(rq, gq, cs, sn, second, 0.125f * 1.4426950408889634f, oq);
        qk_norm_rope8(rk, gk, cs, sn, second, 1.0f, ok);
        *(u32x4*)(qout + (size_t)t * 768 + lane * 8) = oq;
        if (lane < 16) *(u32x4*)(qout + (size_t)t * 768 + 512 + lane * 8) = ok;
    }
}

#include <hip/hip_bf16.h>
#include <cmath>
namespace attn_body {
using bf16=__hip_bfloat16;
using bf16x8=__attribute__((ext_vector_type(8)))short;
using s16x4=__attribute__((ext_vector_type(4)))short;
using f32x16=__attribute__((ext_vector_type(16)))float;
using u32x4=__attribute__((ext_vector_type(4)))unsigned;
constexpr int SEQ=8192,D=64,PQ=768,PO=512;
constexpr int NW=8,QBLK=32,QB=QBLK*NW,KVBLK=64,NQB=SEQ/QB;
constexpr int ATTN_UNIT_ROWS=QB;
__device__ __forceinline__ int crow(int r,int hi){return (r&3)+8*(r>>2)+4*hi;}
#define SBAR() __builtin_amdgcn_sched_barrier(0)
__device__ __forceinline__ void cmask(f32x16&p0,f32x16&p1,int jb,int qrel,int hi){
  const float NEG=-INFINITY; int kb=64*jb+4*hi;
  #pragma unroll
  for(int r=0;r<16;++r){int kv=kb+(r&3)+8*(r>>2); if(kv>qrel)p0[r]=NEG; if(kv+32>qrel)p1[r]=NEG;}
}

constexpr int NSLOT=3, SLOTB=8192;
constexpr int LDS_K=0, LDS_V=NSLOT*SLOTB, LDS_WS=2*NSLOT*SLOTB, LDS_OST=LDS_WS+NW*64*4, LDS_BYTES=LDS_OST+NW*4096;
constexpr float C2=0.125f*1.4426950408889634f;
__device__ __forceinline__ void glds16(const void*gsrc,unsigned lds_dst){unsigned keep;
  asm volatile("s_mov_b32 %0, m0\n\ts_mov_b32 m0, %2\n\ts_nop 0\n\tglobal_load_lds_dwordx4 %1, off\n\ts_mov_b32 m0, %0":"=&s"(keep):"v"(gsrc),"s"(lds_dst):"memory");}
__device__ __forceinline__ float max3f(float a,float b,float c){float r;asm("v_max3_f32 %0, %1, %2, %3":"=v"(r):"v"(a),"v"(b),"v"(c));return r;}
__device__ __forceinline__ float max2f(float a,float b){float r;asm("v_max_f32_e32 %0, %1, %2":"=v"(r):"v"(a),"v"(b));return r;}
__device__ __forceinline__ float fadd_s(float a,float b){float r;asm("v_add_f32_e32 %0, %1, %2":"=v"(r):"v"(a),"v"(b));return r;}
__device__ __forceinline__ float fsub_s(float a,float b){float r;asm("v_sub_f32_e32 %0, %1, %2":"=v"(r):"v"(a),"v"(b));return r;}
typedef float f32x2_t __attribute__((ext_vector_type(2))); typedef __bf16 bf16x2_t __attribute__((ext_vector_type(2)));
__device__ __forceinline__ unsigned cvtpk_s(float lo,float hi){f32x2_t v={lo,hi};bf16x2_t b=__builtin_convertvector(v,bf16x2_t);return __builtin_bit_cast(unsigned,b);}
#define WAIT_BAR(N) asm volatile("s_waitcnt vmcnt(" #N ") lgkmcnt(0)\n\ts_barrier":::"memory")

__device__ __forceinline__ void qkt(f32x16&p0,f32x16&p1,const char*Kslot,const bf16x8*qr,const f32x16&negm,int r32,int hi){
  const char*kb=Kslot+hi*1024+r32*16;
  #pragma unroll
  for(int d0=0;d0<4;++d0){
    const bf16x8 b0=*reinterpret_cast<const bf16x8*>(kb+d0*2048);
    const bf16x8 b1=*reinterpret_cast<const bf16x8*>(kb+d0*2048+512);
    if(d0==0){p0=__builtin_amdgcn_mfma_f32_32x32x16_bf16(b0,qr[0],negm,0,0,0);p1=__builtin_amdgcn_mfma_f32_32x32x16_bf16(b1,qr[0],negm,0,0,0);}
    else{p0=__builtin_amdgcn_mfma_f32_32x32x16_bf16(b0,qr[d0],p0,0,0,0);p1=__builtin_amdgcn_mfma_f32_32x32x16_bf16(b1,qr[d0],p1,0,0,0);}}
}
typedef __attribute__((address_space(3))) const char* lds_cptr;
typedef short v4i16_t __attribute__((ext_vector_type(4)));
__device__ __forceinline__ void kload8(bf16x8*kf,lds_cptr kp){
  kf[0]=*(const __attribute__((address_space(3))) bf16x8*)(kp);      kf[1]=*(const __attribute__((address_space(3))) bf16x8*)(kp+512);
  kf[2]=*(const __attribute__((address_space(3))) bf16x8*)(kp+2048); kf[3]=*(const __attribute__((address_space(3))) bf16x8*)(kp+2560);
  kf[4]=*(const __attribute__((address_space(3))) bf16x8*)(kp+4096); kf[5]=*(const __attribute__((address_space(3))) bf16x8*)(kp+4608);
  kf[6]=*(const __attribute__((address_space(3))) bf16x8*)(kp+6144); kf[7]=*(const __attribute__((address_space(3))) bf16x8*)(kp+6656);
}
__device__ __forceinline__ void kload2(bf16x8*kf,lds_cptr kp,int j){ kf[2*j]=*(const __attribute__((address_space(3))) bf16x8*)(kp+j*2048); kf[2*j+1]=*(const __attribute__((address_space(3))) bf16x8*)(kp+j*2048+512); }
__device__ __forceinline__ s16x4 vtr(lds_cptr p){ return __builtin_bit_cast(s16x4,__builtin_amdgcn_ds_read_tr16_b64_v4i16((__attribute__((address_space(3))) v4i16_t*)p)); }
__device__ __forceinline__ float rowmax(const f32x16&p0,const f32x16&p1){
  float a=max3f(p0[0],p0[1],p1[0]),b=max3f(p0[2],p0[3],p1[1]);a=max3f(a,p1[2],p1[3]);
  #pragma unroll
  for(int r=4;r<16;r+=4){a=max3f(a,p0[r],p0[r+1]);b=max3f(b,p0[r+2],p0[r+3]);a=max3f(a,p1[r],p1[r+1]);b=max3f(b,p1[r+2],p1[r+3]);}
  const float m=max2f(a,b);
  auto rr=__builtin_amdgcn_permlane32_swap(__float_as_uint(m),__float_as_uint(m),false,false);
  return max2f(__uint_as_float(rr[0]),__uint_as_float(rr[1]));
}
__device__ __forceinline__ void pv(f32x16*o,int vb,bf16x8 pa0,bf16x8 pa1,bf16x8 pa2,bf16x8 pa3){
  #pragma unroll
  for(int d0=0;d0<2;++d0){s16x4 lo[4],hi[4];
    #pragma unroll
    for(int ks=0;ks<4;++ks){
      asm volatile("ds_read_b64_tr_b16 %0,%1 offset:%c2":"=&v"(lo[ks]):"v"(vb),"i"(d0*4096+ks*1024):"memory");
      asm volatile("ds_read_b64_tr_b16 %0,%1 offset:%c2":"=&v"(hi[ks]):"v"(vb),"i"(d0*4096+ks*1024+512):"memory");}
    asm volatile("s_waitcnt lgkmcnt(0)":::"memory");SBAR();
    #define PK(k) (bf16x8){lo[k][0],lo[k][1],lo[k][2],lo[k][3],hi[k][0],hi[k][1],hi[k][2],hi[k][3]}
    o[d0]=__builtin_amdgcn_mfma_f32_32x32x16_bf16(pa0,PK(0),o[d0],0,0,0);
    o[d0]=__builtin_amdgcn_mfma_f32_32x32x16_bf16(pa1,PK(1),o[d0],0,0,0);
    o[d0]=__builtin_amdgcn_mfma_f32_32x32x16_bf16(pa2,PK(2),o[d0],0,0,0);
    o[d0]=__builtin_amdgcn_mfma_f32_32x32x16_bf16(pa3,PK(3),o[d0],0,0,0);
    #undef PK
  }
}

#ifndef ATTN_STORE16
#define ATTN_STORE16(p,v) (*(u32x4*)(p)=(v))
#endif
template<int THRL> __device__ __forceinline__ void attn_unit(int b,int h,int g,int qb,const bf16*Q,const bf16*__restrict__ K,const bf16*__restrict__ V,bf16*O,char*shm){
  const int tid=otid(),lane=tid&63,r32=lane&31,hi=lane>>5; const int wid=__builtin_amdgcn_readfirstlane(tid>>6);
  const long rowbase=(long)b*SEQ; const int q0=qb*QB;
  const bf16*Qw=Q+(rowbase+q0+wid*QBLK)*PQ+h*D;
  const bf16*Kh=K+rowbase*PQ+g*D,*Vh=V+rowbase*PQ+g*D;
  const unsigned lds0=(unsigned)(uintptr_t)shm;
  float*wsf=(float*)(shm+LDS_WS)+wid*64;
  const bf16*ksrc=Kh+(long)lane*PQ+wid*8;
  const bf16*vsrc=Vh+(long)(16*(wid&3)+(lane>>2))*PQ+(wid>>2)*32+(lane&3)*8;
  const unsigned kdst=lds0+LDS_K+wid*1024, vdst=lds0+LDS_V+wid*1024;
  #define DMA_K(t,slot) glds16(ksrc+(long)(t)*KVBLK*PQ,(unsigned)__builtin_amdgcn_readfirstlane(kdst+(slot)))
  #define DMA_V(t,slot) glds16(vsrc+(long)(t)*KVBLK*PQ,(unsigned)__builtin_amdgcn_readfirstlane(vdst+(slot)))
  const int vb0=(int)(lds0+LDS_V)+((lane>>4)&1)*32+(lane&3)*8+(4*hi+((lane&15)>>2))*64;
  const char*Kbase=shm+LDS_K; bf16x8 kf[8];
  const lds_cptr shm3=(lds_cptr)shm; const lds_cptr kp0=shm3+LDS_K+hi*1024+r32*16; const lds_cptr vp0=shm3+LDS_V+((lane>>4)&1)*32+(lane&3)*8+(4*hi+((lane&15)>>2))*64;
  constexpr int NT=SEQ/KVBLK;
  DMA_K(0,0);DMA_V(0,0);DMA_K(1,SLOTB);
  bf16x8 qr[4];
  #pragma unroll
  for(int d0=0;d0<4;++d0)qr[d0]=*reinterpret_cast<const bf16x8*>(&Qw[(long)r32*PQ+d0*16+hi*8]);
  float mhat=0.f,l_reg=0.f;f32x16 o[2];o[0]=f32x16{};o[1]=f32x16{};f32x16 negm=f32x16{};asm volatile("":"+v"(negm));
    #define CMASK(P0,P1,t) do{}while(0)
  bool resc=false;
  #define START(P0,P1) do{ const float rm=rowmax(P0,P1); resc=false; \
    { const float dl=rm; mhat=fadd_s(mhat,dl); \
      _Pragma("unroll") for(int r=0;r<16;++r){P0[r]=fsub_s(P0[r],dl);P1[r]=fsub_s(P1[r],dl);} \
      _Pragma("unroll") for(int r=0;r<16;++r)negm[r]=-mhat; asm volatile("":"+v"(negm)); } \
    _Pragma("unroll") for(int r=0;r<16;++r)P0[r]=__builtin_amdgcn_exp2f(P0[r]); }while(0)
  #define RESC() do{ if(resc){ asm volatile("s_waitcnt lgkmcnt(0)":::"memory"); \
      _Pragma("unroll") for(int d_=0;d_<2;++d_) _Pragma("unroll") for(int r=0;r<16;++r)o[d_][r]*=wsf[crow(r,hi)]; } }while(0)
  f32x16 pA0,pA1,pB0,pB1;
  int sl_prev=0,sl_cur=0,sl_next=SLOTB;
  #define ROT() do{sl_prev=sl_cur;sl_cur=sl_next;sl_next=(sl_next==(NSLOT-1)*SLOTB)?0:sl_next+SLOTB;}while(0)
  DMA_K(2,2*SLOTB);
  WAIT_BAR(3);
  qkt(pA0,pA1,Kbase,qr,negm,r32,hi);asm volatile("s_nop 15\n\ts_nop 7":"+v"(pA0),"+v"(pA1));CMASK(pA0,pA1,0);
  START(pA0,pA1);
  _Pragma("unroll") for(int r=0;r<16;++r)pA1[r]=__builtin_amdgcn_exp2f(pA1[r]);
  WAIT_BAR(0);
  DMA_K(3,0);DMA_V(1,SLOTB);
  ROT();
  kload8(kf,kp0+sl_cur);
  WAIT_BAR(2);
  s16x4 vlo[8],vhi[8]; u32x4 pw0,pw1,pw2,pw3;
  #define PKW(P,B) cvtpk_s(P[B],P[B+1])
  #define PAF(k) __builtin_bit_cast(bf16x8,pw##k)
  #define VFR(i) (bf16x8){vlo[i][0],vlo[i][1],vlo[i][2],vlo[i][3],vhi[i][0],vhi[i][1],vhi[i][2],vhi[i][3]}
  #define PIN(x) asm volatile("":"+v"(x))
  #define MX3(a,b,c) __builtin_fmaxf(__builtin_fmaxf((a),(b)),(c))
  #define GAPA(MF,A0,A1,A2,A3,W0,W1,PW) do{ MF; sacc+=A0; sacc+=A1; sacc+=A2; sacc+=A3; PIN(sacc); W0; W1; PIN(PW); SBAR(); }while(0)
  #define EX(v) __builtin_amdgcn_exp2f(v)
  #define GAPB(MF,X,B) do{ MF; X[B]=EX(X[B]); X[B+1]=EX(X[B+1]); X[B+2]=EX(X[B+2]); X[B+3]=EX(X[B+3]); PIN(X); SBAR(); }while(0)
  #define VRD(i) do{ vlo[i]=vtr(vp_+(((i)>>2)*4096+((i)&3)*1024)); vhi[i]=vtr(vp_+(((i)>>2)*4096+((i)&3)*1024+512)); }while(0)
  #define KRD(G,j) do{ if(G){ kload2(kf,kp0+sl_next,j); SBAR(); } }while(0)
  #define STEP(C0,C1,P0,P1,t,GK,GV,GL) do{ SBAR(); \
    const lds_cptr vp_=vp0+sl_prev; \
    VRD(0); SBAR(); float sacc=(P0[0]+P0[1]); \
    GAPA(C0=__builtin_amdgcn_mfma_f32_32x32x16_bf16(kf[0],qr[0],negm,0,0,0), P0[2],P0[3],P0[4],P0[5],     pw0[0]=PKW(P0,0), pw0[1]=PKW(P0,2), pw0); \
    VRD(4); SBAR(); GAPA(C1=__builtin_amdgcn_mfma_f32_32x32x16_bf16(kf[1],qr[0],negm,0,0,0), P0[6],P0[7],P0[8],P0[9],     pw0[2]=PKW(P0,4), pw0[3]=PKW(P0,6), pw0); \
    VRD(1); SBAR(); GAPA(C0=__builtin_amdgcn_mfma_f32_32x32x16_bf16(kf[2],qr[1],C0,0,0,0),   P0[10],P0[11],P0[12],P0[13], pw1[0]=PKW(P0,8), pw1[1]=PKW(P0,10), pw1); \
    VRD(5); SBAR(); GAPA(C1=__builtin_amdgcn_mfma_f32_32x32x16_bf16(kf[3],qr[1],C1,0,0,0),   P0[14],P0[15],P1[0],P1[1],   pw1[2]=PKW(P0,12),pw1[3]=PKW(P0,14), pw1); \
    VRD(2); SBAR(); GAPA(C0=__builtin_amdgcn_mfma_f32_32x32x16_bf16(kf[4],qr[2],C0,0,0,0),   P1[2],P1[3],P1[4],P1[5],     pw2[0]=PKW(P1,0), pw2[1]=PKW(P1,2), pw2); \
    VRD(6); SBAR(); GAPA(C1=__builtin_amdgcn_mfma_f32_32x32x16_bf16(kf[5],qr[2],C1,0,0,0),   P1[6],P1[7],P1[8],P1[9],     pw2[2]=PKW(P1,4), pw2[3]=PKW(P1,6), pw2); \
    VRD(3); SBAR(); GAPA(C0=__builtin_amdgcn_mfma_f32_32x32x16_bf16(kf[6],qr[3],C0,0,0,0),   P1[10],P1[11],P1[12],P1[13], pw3[0]=PKW(P1,8), pw3[1]=PKW(P1,10), pw3); \
    VRD(7); SBAR(); GAPA(C1=__builtin_amdgcn_mfma_f32_32x32x16_bf16(kf[7],qr[3],C1,0,0,0),   P1[14],P1[15],0.f,0.f,       pw3[2]=PKW(P1,12),pw3[3]=PKW(P1,14), pw3); \
    l_reg+=sacc; \
    if(GK){DMA_K((t)+3,sl_cur);} if(GV){DMA_V((t)+1,sl_next);} \
    CMASK(C0,C1,t); \
    { float a=MX3(C0[0],C0[1],C1[0]),b=MX3(C0[2],C0[3],C1[1]); a=MX3(a,C1[2],C1[3]); \
      _Pragma("unroll") for(int r=4;r<16;r+=4){a=MX3(a,C0[r],C0[r+1]);b=MX3(b,C0[r+2],C0[r+3]);a=MX3(a,C1[r],C1[r+1]);b=MX3(b,C1[r+2],C1[r+3]);} \
      float rm=__builtin_fmaxf(a,b); { auto rr=__builtin_amdgcn_permlane32_swap(__float_as_uint(rm),__float_as_uint(rm),false,false); rm=__builtin_fmaxf(__uint_as_float(rr[0]),__uint_as_float(rr[1])); } \
      resc=false; \
      if(__builtin_expect(__any(rm>(float)THRL),0)){ const float dl=__builtin_fmaxf(rm,0.f); mhat+=dl; \
        _Pragma("unroll") for(int r=0;r<16;++r){C0[r]-=dl;C1[r]-=dl;} \
        _Pragma("unroll") for(int r=0;r<16;++r)negm[r]=-mhat; asm volatile("":"+v"(negm)); \
        const float f=__builtin_amdgcn_exp2f(-dl); l_reg*=f; if(hi==0)wsf[r32]=f; resc=true; } } \
    SBAR(); \
    GAPB(o[0]=__builtin_amdgcn_mfma_f32_32x32x16_bf16(PAF(0),VFR(0),o[0],0,0,0), C0,0); \
    GAPB(o[1]=__builtin_amdgcn_mfma_f32_32x32x16_bf16(PAF(0),VFR(4),o[1],0,0,0), C0,4); \
    KRD(GL,0); GAPB(o[0]=__builtin_amdgcn_mfma_f32_32x32x16_bf16(PAF(1),VFR(1),o[0],0,0,0), C0,8); \
    KRD(GL,1); GAPB(o[1]=__builtin_amdgcn_mfma_f32_32x32x16_bf16(PAF(1),VFR(5),o[1],0,0,0), C0,12); \
    KRD(GL,2); GAPB(o[0]=__builtin_amdgcn_mfma_f32_32x32x16_bf16(PAF(2),VFR(2),o[0],0,0,0), C1,0); \
    KRD(GL,3); GAPB(o[1]=__builtin_amdgcn_mfma_f32_32x32x16_bf16(PAF(2),VFR(6),o[1],0,0,0), C1,4); \
    GAPB(o[0]=__builtin_amdgcn_mfma_f32_32x32x16_bf16(PAF(3),VFR(3),o[0],0,0,0), C1,8); \
    GAPB(o[1]=__builtin_amdgcn_mfma_f32_32x32x16_bf16(PAF(3),VFR(7),o[1],0,0,0), C1,12); \
    }while(0)
  int t=1;
  #undef CMASK
  #define CMASK(P0,P1,t) do{}while(0)
  for(;t+5<NT;t+=2){
    STEP(pB0,pB1,pA0,pA1,t,true,true,true);     WAIT_BAR(2); RESC(); ROT();
    STEP(pA0,pA1,pB0,pB1,t+1,true,true,true);   WAIT_BAR(2); RESC(); ROT();
  }
  #define ENDW(tt) do{ if((tt)+3<NT){WAIT_BAR(2);} else if((tt)+2<NT){WAIT_BAR(1);} else {WAIT_BAR(0);} }while(0)
  for(;t+1<NT;t+=2){
    STEP(pB0,pB1,pA0,pA1,t,(t+3<NT),(t+1<NT),(t+1<NT));       ENDW(t);   RESC(); ROT();
    STEP(pA0,pA1,pB0,pB1,t+1,(t+4<NT),(t+2<NT),(t+2<NT));     ENDW(t+1); RESC(); ROT();
  }
  STEP(pB0,pB1,pA0,pA1,NT-1,false,false,false); RESC();
  { float sacc=pB0[0]+pB0[1]; _Pragma("unroll") for(int r=2;r<16;++r)sacc+=pB0[r]; _Pragma("unroll") for(int r=0;r<16;++r)sacc+=pB1[r]; l_reg+=sacc;
    pw0=(u32x4){PKW(pB0,0),PKW(pB0,2),PKW(pB0,4),PKW(pB0,6)};pw1=(u32x4){PKW(pB0,8),PKW(pB0,10),PKW(pB0,12),PKW(pB0,14)};pw2=(u32x4){PKW(pB1,0),PKW(pB1,2),PKW(pB1,4),PKW(pB1,6)};pw3=(u32x4){PKW(pB1,8),PKW(pB1,10),PKW(pB1,12),PKW(pB1,14)};
    SBAR(); pv(o,vb0+sl_cur,PAF(0),PAF(1),PAF(2),PAF(3)); }
  #undef PKW
  #undef PAF
  #undef VFR
  #undef PIN
  #undef MX3
  #undef GAPA
  #undef GAPB
  #undef EX
  #undef VRD
  #undef KRD
  #undef STEP
  #undef ENDW
  {auto rr=__builtin_amdgcn_permlane32_swap(__float_as_uint(l_reg),__float_as_uint(l_reg),false,false);l_reg=__uint_as_float(rr[0])+__uint_as_float(rr[1]);}
  if(hi==0)wsf[32+r32]=l_reg;asm volatile("s_waitcnt lgkmcnt(0)":::"memory");
  float rli[16];
  #pragma unroll
  for(int r=0;r<16;++r)rli[r]=__builtin_amdgcn_rcpf(wsf[32+crow(r,hi)]);
  bf16*Ow=O+(rowbase+q0+wid*QBLK)*PO+h*D;
  { bf16*stg=(bf16*)(shm+LDS_OST)+wid*2048;
    #pragma unroll
    for(int r=0;r<16;++r){const int orow=crow(r,hi);
      #pragma unroll
      for(int d0=0;d0<2;++d0)stg[orow*64+d0*32+r32]=__float2bfloat16(o[d0][r]*rli[r]);}
    asm volatile("s_waitcnt lgkmcnt(0)":::"memory");
    #pragma unroll
    for(int i=0;i<4;++i){const int row=i*8+(lane>>3),ch=lane&7; const u32x4 v=*(const u32x4*)(stg+row*64+ch*8); ATTN_STORE16(Ow+(long)row*PO+ch*8,v);} }
  asm volatile("s_waitcnt lgkmcnt(0)\n\ts_barrier":::"memory");
  #undef DMA_K
  #undef DMA_V
  #undef CMASK
  #undef START
  #undef RESC
  #undef ROT
}
constexpr int ATTN_LDS_BYTES=LDS_BYTES;
#undef SBAR
#undef WAIT_BAR
}

__device__ __forceinline__ void phase_attn(const Params& p, char* lds) {
            {
                const int bid = obid();
                const int vcu = ((NBLK & 7) == 0) ? (bid & 7) * (int)(NBLK >> 3) + (bid >> 3) : bid;
                const attn_body::bf16* qkvb = (const attn_body::bf16*)(p.ws + R_QKV);
                for (int u = vcu; u < 512; u += NBLK) {
                    const int bg = (u & 255) >> 6, r = u & 63, hh = r & 3, qb = (r >> 2) + 16 * (u >> 8);
                    const int b = bg >> 1, g = bg & 1;
                    attn_body::attn_unit<8>(b, 4 * g + hh, g, qb, qkvb, qkvb + 512, qkvb + 640, (attn_body::bf16*)(p.ws + R_ATT), lds);
                }
            }
}

__device__ __forceinline__ size_t cidx(int c, int t) { return ((size_t)(t >> 5) * 256 + c) * 32 + (t & 31); }
__device__ __forceinline__ f32x4 convd4(const float* row, int l0, float w0, float w1, float w2, float cb) {
    const f32x4 c = *(const f32x4*)(row + l0);
    const float lft = (l0 > 0) ? row[l0 - 1] : 0.f;
    const float rgt = (l0 + 4 < SL) ? row[l0 + 4] : 0.f;
    f32x4 o;
    o.x = cb + w0 * lft + w1 * c.x + w2 * c.y;
    o.y = cb + w0 * c.x + w1 * c.y + w2 * c.z;
    o.z = cb + w0 * c.y + w1 * c.z + w2 * c.w;
    o.w = cb + w0 * c.z + w1 * c.w + w2 * rgt;
    return o;
}
__device__ __forceinline__ void cmul_kf(float2* Z, const float2* KF, int tid) {
#pragma unroll 4
    for (int i = 0; i < 16; ++i) {
        const int pp = 2 * tid + 1024 * i;
        const f32x4 z = *(const f32x4*)(Z + zp(pp)), k = *(const f32x4*)(KF + pp);
        f32x4 o; o.x = z.x * k.x - z.y * k.y; o.y = z.x * k.y + z.y * k.x; o.z = z.z * k.z - z.w * k.w; o.w = z.z * k.w + z.w * k.z;
        *(f32x4*)(Z + zp(pp)) = o;
    }
}
__device__ __forceinline__ void hyena_job(const Params& p, int layer, int c, char* lds) {
    const int tid = otid();
    float2* Z = (float2*)lds;
    const float* HF = (const float*)(p.ws + R_HF);
    const float* cw = p.in[I_CW] + (size_t)layer * 3 * 768; const float* cbp = p.in[I_CB] + layer * 768;
    const float2* KF0 = (const float2*)(p.ws + OFF_KF) + ((size_t)(layer * 256 + c) * 2) * 16384;
    const float2* KF1 = KF0 + 16384;
    float* Yb = (float*)(p.ws + R_Y);
    const float bias0 = p.in[I_HB][(layer * 2 + 0) * 256 + c], bias1 = p.in[I_HB][(layer * 2 + 1) * 256 + c];
    const int cv = c, c1 = 256 + c, c2 = 512 + c;
    const float* rv = HF + (size_t)cv * T; const float* r1 = HF + (size_t)c1 * T; const float* r2 = HF + (size_t)c2 * T;
    const float v_w0 = cw[cv], v_w1 = cw[768 + cv], v_w2 = cw[1536 + cv], v_cb = cbp[cv];
    const float a_w0 = cw[c1], a_w1 = cw[768 + c1], a_w2 = cw[1536 + c1], a_cb = cbp[c1];
    const float b_w0 = cw[c2], b_w1 = cw[768 + c2], b_w2 = cw[1536 + c2], b_cb = cbp[c2];
    const f32x4 zero4 = {0.f, 0.f, 0.f, 0.f};
    __syncthreads();
#pragma unroll 1
    for (int i = 0; i < 4; ++i) {
        const int l0 = 4 * otid() + 2048 * i;
        const f32x4 va = convd4(rv, l0, v_w0, v_w1, v_w2, v_cb), vb = convd4(rv + SL, l0, v_w0, v_w1, v_w2, v_cb);
        *(f32x4*)(Z + zp(l0)) = (f32x4){va.x, vb.x, va.y, vb.y}; *(f32x4*)(Z + zp(l0) + 2) = (f32x4){va.z, vb.z, va.w, vb.w};
        *(f32x4*)(Z + zp(8192 + l0)) = zero4; *(f32x4*)(Z + zp(8192 + l0) + 2) = zero4;
    }
    __syncthreads();
    fft16k_fwd(Z);
    cmul_kf(Z, KF0, otid());
    __syncthreads();
    fft16k_inv(Z);
#pragma unroll 1
    for (int i = 0; i < 4; ++i) {
        const int l0 = 4 * otid() + 2048 * i;
        const f32x4 za = *(const f32x4*)(Z + zp(l0)), zb = *(const f32x4*)(Z + zp(l0) + 2);
        const f32x4 va = convd4(rv, l0, v_w0, v_w1, v_w2, v_cb), vb = convd4(rv + SL, l0, v_w0, v_w1, v_w2, v_cb);
        const f32x4 ga = convd4(r1, l0, a_w0, a_w1, a_w2, a_cb), gb = convd4(r1 + SL, l0, a_w0, a_w1, a_w2, a_cb);
        f32x4 ya, yb;
        ya.x = ga.x * (za.x + va.x * bias0); ya.y = ga.y * (za.z + va.y * bias0); ya.z = ga.z * (zb.x + va.z * bias0); ya.w = ga.w * (zb.z + va.w * bias0);
        yb.x = gb.x * (za.y + vb.x * bias0); yb.y = gb.y * (za.w + vb.y * bias0); yb.z = gb.z * (zb.y + vb.z * bias0); yb.w = gb.w * (zb.w + vb.w * bias0);
        *(f32x4*)(Yb + cidx(c, l0)) = ya; *(f32x4*)(Yb + cidx(c, SL + l0)) = yb;
        *(f32x4*)(Z + zp(l0)) = (f32x4){ya.x, yb.x, ya.y, yb.y}; *(f32x4*)(Z + zp(l0) + 2) = (f32x4){ya.z, yb.z, ya.w, yb.w};
        *(f32x4*)(Z + zp(8192 + l0)) = zero4; *(f32x4*)(Z + zp(8192 + l0) + 2) = zero4;
    }
    __syncthreads();
    fft16k_fwd(Z);
    cmul_kf(Z, KF1, otid());
    __syncthreads();
    fft16k_inv(Z);
#pragma unroll 1
    for (int i = 0; i < 4; ++i) {
        const int l0 = 4 * otid() + 2048 * i;
        const f32x4 za = *(const f32x4*)(Z + zp(l0)), zb = *(const f32x4*)(Z + zp(l0) + 2);
        const f32x4 ga = convd4(r2, l0, b_w0, b_w1, b_w2, b_cb), gb = convd4(r2 + SL, l0, b_w0, b_w1, b_w2, b_cb);
        const f32x4 pa = *(const f32x4*)(Yb + cidx(c, l0)), pb = *(const f32x4*)(Yb + cidx(c, SL + l0));
        f32x4 ya, yb;
        ya.x = ga.x * (za.x + pa.x * bias1); ya.y = ga.y * (za.z + pa.y * bias1); ya.z = ga.z * (zb.x + pa.z * bias1); ya.w = ga.w * (zb.z + pa.w * bias1);
        yb.x = gb.x * (za.y + pb.x * bias1); yb.y = gb.y * (za.w + pb.y * bias1); yb.z = gb.z * (zb.y + pb.z * bias1); yb.w = gb.w * (zb.w + pb.w * bias1);
        *(f32x4*)(Yb + cidx(c, l0)) = ya; *(f32x4*)(Yb + cidx(c, SL + l0)) = yb;
    }
    __syncthreads();
}

__device__ __forceinline__ void fnet_job(const Params& p, int ch, char* lds) {
    const int tid = otid();
    float2* Z = (float2*)lds;
    const float* row = (const float*)(p.ws + R_HF) + (size_t)(768 + ch) * T;
    float* UR = (float*)(p.ws + R_UR);
    float* UI = (float*)(p.ws + R_UI);
    __syncthreads();
#pragma unroll
    for (int i = 0; i < 4; ++i) {
        const int l0 = 4 * tid + 2048 * i;
        const f32x4 a = *(const f32x4*)(row + l0), b = *(const f32x4*)(row + SL + l0);
        const int z0 = zp(l0);
        *(f32x4*)(Z + z0) = (f32x4){a.x, b.x, a.y, b.y}; *(f32x4*)(Z + z0 + 2) = (f32x4){a.z, b.z, a.w, b.w};
    }
    __syncthreads();
    fft8k_fwd(Z);
#pragma unroll
    for (int i = 0; i < 4; ++i) {
        const int k0 = 4 * tid + 2048 * i;
        f32x4 ur0, ui0, ur1, ui1;
#pragma unroll
        for (int e = 0; e < 4; ++e) {
            const int k = k0 + e;
            const int pk = p8k_of_f(k);
            const int pm = p8k_of_f((SL - k) & (SL - 1));
            const float2 zk = Z[zp(pk)], zm = Z[zp(pm)];
            ur0[e] = 0.5f * (zk.x + zm.x); ui0[e] = 0.5f * (zk.y - zm.y);
            ur1[e] = 0.5f * (zk.y + zm.y); ui1[e] = 0.5f * (zm.x - zk.x);
        }
        *(f32x4*)(UR + cidx(ch, k0)) = ur0; *(f32x4*)(UI + cidx(ch, k0)) = ui0; *(f32x4*)(UR + cidx(ch, SL + k0)) = ur1; *(f32x4*)(UI + cidx(ch, SL + k0)) = ui1;
    }
    __syncthreads();
}

__device__ __forceinline__ void phase_mix(const Params& p, int layer, char* lds) {
    const int tid = otid(), lane = tid & 63, wave = tid >> 6;
    const int l31 = lane & 31, hl = lane >> 5, g = wave & 3, tsel = wave >> 2;
    float* ex = (float*)lds;
    float* FMl = (float*)(lds + 8192);
    const float* UR = (const float*)(p.ws + R_UR); const float* UI = (const float*)(p.ws + R_UI);
    const float* Y = (const float*)(p.ws + R_Y);
    const bf16_t* att = (const bf16_t*)(p.ws + R_ATT);
    bf16_t* mix = (bf16_t*)(p.ws + R_MIX);
    const float* fb = p.in[I_FB] + layer * 256 + g * 64;
    const float* mg = p.in[I_MG] + layer * 1024;
    __syncthreads();
    {
        const f32x4* src = (const f32x4*)((const float*)(p.ws + OFF_FM) + (size_t)layer * 4 * 128 * 64);
#pragma unroll 4
        for (int i = 0; i < 16; ++i) *(f32x4*)(FMl + 4 * (tid + NTHR * i)) = src[tid + NTHR * i];
    }
    for (int tp = obid(); tp < T / 64; tp += NBLK) {
        const int t = (tp * 2 + tsel) * 32 + l31;
        float bv[64];
        {
            const float* ub = UR + cidx(g * 64 + hl, t);
            const float* ub2 = UI + cidx(g * 64 + hl, t);
#pragma unroll
            for (int i = 0; i < 32; ++i) { bv[i] = ub[(2 * i) * 32]; bv[32 + i] = ub2[(2 * i) * 32]; }
        }
        float yv[32];
        {
            const float* yb = Y + cidx(g * 64 + hl * 32, t);
#pragma unroll
            for (int i = 0; i < 32; ++i) yv[i] = yb[i * 32];
        }
        const bf16_t* ab = att + (size_t)t * 512 + g * 128 + hl * 64;
        float sa = 0.f;
#pragma unroll
        for (int q = 0; q < 8; ++q) {
            const u32x4 a = *(const u32x4*)(ab + 8 * q);
            const float x0 = bflo(a.x), x1 = bfhi(a.x), x2 = bflo(a.y), x3 = bfhi(a.y), x4 = bflo(a.z), x5 = bfhi(a.z), x6 = bflo(a.w), x7 = bfhi(a.w);
            sa += x0 * x0 + x1 * x1 + x2 * x2 + x3 * x3 + x4 * x4 + x5 * x5 + x6 * x6 + x7 * x7;
        }
        __syncthreads();
        f32x16 acc0 = zero16(), acc1 = zero16();
        {
            const float* fa = FMl + (g * 128 + hl) * 64 + l31;
#pragma unroll
            for (int i = 0; i < 64; ++i) {
                const float a0 = fa[(2 * i) * 64], a1 = fa[(2 * i) * 64 + 32];
                acc0 = __builtin_amdgcn_mfma_f32_32x32x2f32(a0, bv[i], acc0, 0, 0, 0);
                acc1 = __builtin_amdgcn_mfma_f32_32x32x2f32(a1, bv[i], acc1, 0, 0, 0);
            }
        }
        float sf = 0.f;
#pragma unroll
        for (int i = 0; i < 4; ++i) {
            const f32x4 b0 = *(const f32x4*)(fb + 8 * i + 4 * hl), b1 = *(const f32x4*)(fb + 32 + 8 * i + 4 * hl);
            acc0[4 * i] += b0.x; acc0[4 * i + 1] += b0.y; acc0[4 * i + 2] += b0.z; acc0[4 * i + 3] += b0.w;
            acc1[4 * i] += b1.x; acc1[4 * i + 1] += b1.y; acc1[4 * i + 2] += b1.z; acc1[4 * i + 3] += b1.w;
        }
#pragma unroll
        for (int r = 0; r < 16; ++r) sf += acc0[r] * acc0[r] + acc1[r] * acc1[r];
        float sy = 0.f;
#pragma unroll
        for (int i = 0; i < 32; ++i) sy += yv[i] * yv[i];
        ex[(0 * 8 + wave) * 64 + lane] = sa; ex[(1 * 8 + wave) * 64 + lane] = sy; ex[(2 * 8 + wave) * 64 + lane] = sf;
        __syncthreads();
        float ta = 0.f, ty = 0.f, tf = 0.f;
#pragma unroll
        for (int w = 0; w < 4; ++w)
#pragma unroll
            for (int hh = 0; hh < 2; ++hh) {
                const int o = (tsel * 4 + w) * 64 + hh * 32 + l31;
                ta += ex[0 * 512 + o]; ty += ex[1 * 512 + o]; tf += ex[2 * 512 + o];
            }
        const float ra = rsqrtf(ta * (1.0f / 512.0f) + EPS), ry = rsqrtf(ty * (1.0f / 256.0f) + EPS), rf = rsqrtf(tf * (1.0f / 256.0f) + EPS);
        bf16_t* mrow = mix + (size_t)t * 1024;
        {
            const float* gg = mg + g * 128 + hl * 64;
#pragma unroll
            for (int q = 0; q < 8; ++q) {
                const u32x4 a = *(const u32x4*)(ab + 8 * q);
                const f32x4 g0 = *(const f32x4*)(gg + 8 * q), g1 = *(const f32x4*)(gg + 8 * q + 4);
                u32x4 o;
                o.x = pk2(bflo(a.x) * ra * g0.x, bfhi(a.x) * ra * g0.y); o.y = pk2(bflo(a.y) * ra * g0.z, bfhi(a.y) * ra * g0.w);
                o.z = pk2(bflo(a.z) * ra * g1.x, bfhi(a.z) * ra * g1.y); o.w = pk2(bflo(a.w) * ra * g1.z, bfhi(a.w) * ra * g1.w);
                *(u32x4*)(mrow + g * 128 + hl * 64 + 8 * q) = o;
            }
        }
        {
            const float* gg = mg + 512 + g * 64 + hl * 32;
#pragma unroll
            for (int q = 0; q < 4; ++q) {
                const f32x4 g0 = *(const f32x4*)(gg + 8 * q), g1 = *(const f32x4*)(gg + 8 * q + 4);
                u32x4 o;
                o.x = pk2(yv[8 * q] * ry * g0.x, yv[8 * q + 1] * ry * g0.y); o.y = pk2(yv[8 * q + 2] * ry * g0.z, yv[8 * q + 3] * ry * g0.w);
                o.z = pk2(yv[8 * q + 4] * ry * g1.x, yv[8 * q + 5] * ry * g1.y); o.w = pk2(yv[8 * q + 6] * ry * g1.z, yv[8 * q + 7] * ry * g1.w);
                *(u32x4*)(mrow + 512 + g * 64 + hl * 32 + 8 * q) = o;
            }
        }
        {
            const float* gg = mg + 768 + g * 64;
#pragma unroll
            for (int i = 0; i < 4; ++i) {
                const f32x4 g0 = *(const f32x4*)(gg + 8 * i + 4 * hl), g1 = *(const f32x4*)(gg + 32 + 8 * i + 4 * hl);
                u32x2 o0, o1;
                o0.x = pk2(acc0[4 * i] * rf * g0.x, acc0[4 * i + 1] * rf * g0.y); o0.y = pk2(acc0[4 * i + 2] * rf * g0.z, acc0[4 * i + 3] * rf * g0.w);
                o1.x = pk2(acc1[4 * i] * rf * g1.x, acc1[4 * i + 1] * rf * g1.y); o1.y = pk2(acc1[4 * i + 2] * rf * g1.z, acc1[4 * i + 3] * rf * g1.w);
                *(u32x2*)(mrow + 768 + g * 64 + 8 * i + 4 * hl) = o0;
                *(u32x2*)(mrow + 768 + g * 64 + 32 + 8 * i + 4 * hl) = o1;
            }
        }
    }
}

#define TK_INS(L, X) do { float x_ = (X); _Pragma("unroll") for (int i_ = 0; i_ < 16; ++i_) { const float hi_ = fmaxf(L[i_], x_); x_ = fminf(L[i_], x_); L[i_] = hi_; } } while (0)
__device__ __forceinline__ float tk_pack(float v, unsigned code, unsigned mask) { return __builtin_bit_cast(float, (__builtin_bit_cast(unsigned, v) & ~mask) | code); }
__device__ __forceinline__ unsigned tk_lookup(const unsigned (&P)[4], unsigned i) {
    const unsigned w = (i < 4u) ? P[0] : (i < 8u) ? P[1] : (i < 12u) ? P[2] : P[3];
    return (w >> ((i & 3u) * 8u)) & 0x7Fu;
}
__device__ __forceinline__ void phase_peer_topk(const Params& p, int layer, char* lds, int* IDX, float* GATE) {
    const int tid = otid(), lane = tid & 63, wave = tid >> 6;
    const float* SC = (const float*)(p.ws + R_QP);
    const float NINF = -3.0e38f;
    const int pp = lane & 1;
    const int gw = obid() * NWAVE + wave, ngw = NBLK * NWAVE;
    for (int grp = gw; grp < T * 8 / 32; grp += ngw) {
        const int prob = grp * 32 + (lane >> 1);
        const int t = prob >> 3, h = prob & 7;
        const f32x4* src = (const f32x4*)(SC + (size_t)t * 2048 + h * 256 + pp * 128);
        float l[16];
#pragma unroll
        for (int i = 0; i < 16; ++i) l[i] = NINF;
#pragma unroll 1
        for (int c = 0; c < 4; ++c) {
            f32x4 v[8];
#pragma unroll
            for (int j = 0; j < 8; ++j) v[j] = src[c * 8 + j];
#pragma unroll
            for (int j = 0; j < 8; ++j) {
                const unsigned kb = (unsigned)(c * 32 + j * 4);
                TK_INS(l, tk_pack(v[j].x, kb, 0x7Fu)); TK_INS(l, tk_pack(v[j].y, kb + 1u, 0x7Fu));
                TK_INS(l, tk_pack(v[j].z, kb + 2u, 0x7Fu)); TK_INS(l, tk_pack(v[j].w, kb + 3u, 0x7Fu));
            }
        }
        float xv[16], ov[16]; unsigned PX[4] = {0u, 0u, 0u, 0u}, PO[4] = {0u, 0u, 0u, 0u};
#pragma unroll
        for (int i = 0; i < 16; ++i) {
            const float o = __shfl_xor(l[i], 1);
            const unsigned xb = __builtin_bit_cast(unsigned, l[i]), ob = __builtin_bit_cast(unsigned, o);
            xv[i] = __builtin_bit_cast(float, xb & ~0x7Fu); ov[i] = __builtin_bit_cast(float, ob & ~0x7Fu);
            PX[i >> 2] |= (xb & 0x7Fu) << ((i & 3) * 8); PO[i >> 2] |= (ob & 0x7Fu) << ((i & 3) * 8);
        }
        float f[16];
#pragma unroll
        for (int i = 0; i < 16; ++i) f[i] = NINF;
#pragma unroll
        for (int i = 0; i < 16; ++i)
#pragma unroll
            for (int j = i; j < 16; ++j)
                if ((i + 1) * (j + 1) <= 16) {
                    float cv = xv[i] + ov[j];
                    const unsigned code = pp ? (unsigned)((j << 4) | i) : (unsigned)((i << 4) | j);
                    cv = tk_pack(cv, code, 0xFFu);
                    if (i == j) cv = pp ? NINF : cv;
                    TK_INS(f, cv);
                }
        {
            float g[16];
#pragma unroll
            for (int i = 0; i < 16; ++i) g[i] = __shfl_xor(f[i], 1);
#pragma unroll
            for (int i = 0; i < 16; ++i) TK_INS(f, g[i]);
        }
        unsigned P0[4], P1[4];
#pragma unroll
        for (int q = 0; q < 4; ++q) { P0[q] = pp ? PO[q] : PX[q]; P1[q] = pp ? PX[q] : PO[q]; }
        const float top = __builtin_bit_cast(float, __builtin_bit_cast(unsigned, f[0]) & ~0xFFu);
        float ev[16]; int ei[16]; float den = 0.f;
#pragma unroll
        for (int r = 0; r < 16; ++r) {
            const unsigned fb = __builtin_bit_cast(unsigned, f[r]);
            const unsigned code = fb & 0xFFu;
            ei[r] = (int)(tk_lookup(P0, code >> 4) * 128u + tk_lookup(P1, code & 15u));
            ev[r] = __expf(__builtin_bit_cast(float, fb & ~0xFFu) - top);
            den += ev[r];
        }
        const float rden = 1.0f / den;
        const size_t ob = (size_t)t * 2048 + h * 16;
        if (pp == 0) {
#pragma unroll
            for (int q = 0; q < 4; ++q) { int4 w; w.x = ei[4 * q]; w.y = ei[4 * q + 1]; w.z = ei[4 * q + 2]; w.w = ei[4 * q + 3]; *(int4*)(IDX + ob + 4 * q) = w; }
        } else {
#pragma unroll
            for (int q = 0; q < 4; ++q) { f32x4 w; w.x = ev[4 * q] * rden; w.y = ev[4 * q + 1] * rden; w.z = ev[4 * q + 2] * rden; w.w = ev[4 * q + 3] * rden; *(f32x4*)(GATE + ob + 128 + 4 * q) = w; }
        }
    }
}

__device__ __forceinline__ float gelu_exact(float x) { return 0.5f * x * (1.0f + erff(x * 0.70710678118654752f)); }
typedef float f32x2 __attribute__((ext_vector_type(2)));
#define CVT_LO(W) __builtin_amdgcn_cvt_pk_f32_fp8((int)(W), false)
#define CVT_HI(W) __builtin_amdgcn_cvt_pk_f32_fp8((int)(W), true)
template <bool DRY, int EMASK = 16383> __device__ __forceinline__ void phase_peer_gather(const Params& p, int layer) {
    const int lane = otid() & 63, wave = otid() >> 6;
    const int gw = obid() * NWAVE + wave, ngw = NBLK * NWAVE;
    const unsigned char* PU = p.ws + OFF_PU + (size_t)layer * 16384 * 1024;
    const unsigned char* PV = p.ws + OFF_PV + (size_t)layer * 16384 * 1024;
    const float* SU = (const float*)(p.ws + OFF_PSC) + (size_t)layer * 16384;
    const float* SV = (const float*)(p.ws + OFF_PSC) + (size_t)(2 + layer) * 16384;
    bf16_t* XN = (bf16_t*)(p.ws + R_XN);
    float* XA = (float*)(p.ws + OFF_XA);
    const float* SC = (const float*)(p.ws + R_QP);
    const bool last = (layer == NLAYER - 1);
    const float* gnext = last ? p.in[I_FG] : p.in[I_N1G] + (layer + 1) * DM;
    const bool b5 = (lane & 32) != 0, b4 = (lane & 16) != 0, b3 = (lane & 8) != 0;
    const unsigned loff = (unsigned)lane * 16u;
    for (int t = gw; t < T; t += ngw) {
        f32x2 xv[8];
#pragma unroll
        for (int j = 0; j < 4; ++j) {
            const u32x2 a = *(const u32x2*)(XN + (size_t)t * DM + 4 * lane + 256 * j);
            xv[2 * j] = (f32x2){bflo(a.x), bfhi(a.x)}; xv[2 * j + 1] = (f32x2){bflo(a.y), bfhi(a.y)};
        }
        f32x2 acc[8];
#pragma unroll
        for (int j = 0; j < 8; ++j) acc[j] = (f32x2){0.f, 0.f};
        const int* idxp = (const int*)(SC + (size_t)t * 2048);
        const float* gatep = SC + (size_t)t * 2048 + 128;
#pragma unroll 1
        for (int half = 0; half < 2; ++half) {
            const int myi = idxp[half * 64 + lane] & EMASK;
            const float mycu = SU[myi];
            const float mycg = gatep[half * 64 + lane] * SV[myi];
#pragma unroll 1
            for (int e0 = 0; e0 < 64; e0 += 8) {
                u32x4 ur[8], vr[8];
#pragma unroll
                for (int k = 0; k < 8; ++k) {
                    const unsigned e = (unsigned)__builtin_amdgcn_readlane(myi, e0 + k);
                    ur[k] = *(const u32x4*)(PU + (size_t)(e * 1024u) + loff);
                    vr[k] = *(const u32x4*)(PV + (size_t)(e * 1024u) + loff);
                }
                float d[8];
#pragma unroll
                for (int k = 0; k < 8; ++k) {
                    f32x2 s2 = CVT_LO(ur[k].x) * xv[0];
                    s2 += CVT_HI(ur[k].x) * xv[1]; s2 += CVT_LO(ur[k].y) * xv[2]; s2 += CVT_HI(ur[k].y) * xv[3];
                    s2 += CVT_LO(ur[k].z) * xv[4]; s2 += CVT_HI(ur[k].z) * xv[5]; s2 += CVT_LO(ur[k].w) * xv[6]; s2 += CVT_HI(ur[k].w) * xv[7];
                    d[k] = s2.x + s2.y;
                }
                float r4[4], r2[2], u1;
#pragma unroll
                for (int k = 0; k < 4; ++k) { const float send = b5 ? d[k] : d[k + 4], keep = b5 ? d[k + 4] : d[k]; r4[k] = keep + __shfl_xor(send, 32); }
#pragma unroll
                for (int k = 0; k < 2; ++k) { const float send = b4 ? r4[k] : r4[k + 2], keep = b4 ? r4[k + 2] : r4[k]; r2[k] = keep + __shfl_xor(send, 16); }
                { const float send = b3 ? r2[0] : r2[1], keep = b3 ? r2[1] : r2[0]; u1 = keep + __shfl_xor(send, 8); }
                u1 += __shfl_xor(u1, 4); u1 += __shfl_xor(u1, 2); u1 += __shfl_xor(u1, 1);
                const int kk = e0 + (lane >> 3);
                const float av = gelu_exact(u1 * __shfl(mycu, kk)) * __shfl(mycg, kk);
#pragma unroll
                for (int k = 0; k < 8; ++k) {
                    const float a = __builtin_bit_cast(float, __builtin_amdgcn_readlane(__builtin_bit_cast(int, av), 8 * k));
                    const f32x2 a2 = (f32x2){a, a};
                    acc[0] += a2 * CVT_LO(vr[k].x); acc[1] += a2 * CVT_HI(vr[k].x); acc[2] += a2 * CVT_LO(vr[k].y); acc[3] += a2 * CVT_HI(vr[k].y);
                    acc[4] += a2 * CVT_LO(vr[k].z); acc[5] += a2 * CVT_HI(vr[k].z); acc[6] += a2 * CVT_LO(vr[k].w); acc[7] += a2 * CVT_HI(vr[k].w);
                }
            }
        }
        f32x4 x[4]; float ss = 0.f;
#pragma unroll
        for (int j = 0; j < 4; ++j) {
            x[j] = *(const f32x4*)(XA + (size_t)t * DM + 4 * lane + 256 * j);
            x[j].x += acc[2 * j].x; x[j].y += acc[2 * j].y; x[j].z += acc[2 * j + 1].x; x[j].w += acc[2 * j + 1].y;
            ss += x[j].x * x[j].x + x[j].y * x[j].y + x[j].z * x[j].z + x[j].w * x[j].w;
        }
        ss = wave_sum(ss);
        const float r = rsqrtf(ss * (1.0f / DM) + EPS);
        if (last) {
#pragma unroll
            for (int j = 0; j < 4; ++j) { const f32x4 gg = *(const f32x4*)(gnext + 4 * lane + 256 * j); *(f32x4*)(p.out + (size_t)t * DM + 4 * lane + 256 * j) = x[j] * r * gg; }
        } else {
#pragma unroll
            for (int j = 0; j < 4; ++j) {
                const f32x4 gg = *(const f32x4*)(gnext + 4 * lane + 256 * j);
                *(f32x4*)((DRY ? p.out : XA) + (size_t)t * DM + 4 * lane + 256 * j) = x[j];
                u32x2 w; w.x = pk2(x[j].x * r * gg.x, x[j].y * r * gg.y); w.y = pk2(x[j].z * r * gg.z, x[j].w * r * gg.w);
                if (!DRY) *(u32x2*)(XN + (size_t)t * DM + 4 * lane + 256 * j) = w;
            }
        }
    }
}


__device__ __forceinline__ void tk_sort16(float (&a)[16]) {
#pragma unroll
    for (int k = 2; k <= 16; k <<= 1)
#pragma unroll
        for (int j = k >> 1; j > 0; j >>= 1)
#pragma unroll
            for (int i = 0; i < 16; ++i) {
                const int l = i ^ j;
                if (l > i) {
                    const float hi = fmaxf(a[i], a[l]), lo = fminf(a[i], a[l]);
                    if ((i & k) == 0) { a[i] = hi; a[l] = lo; } else { a[i] = lo; a[l] = hi; }
                }
            }
}
__device__ __forceinline__ void tk_merge16(float (&a)[16]) {
#pragma unroll
    for (int j = 8; j > 0; j >>= 1)
#pragma unroll
        for (int i = 0; i < 16; ++i) {
            const int l = i ^ j;
            if (l > i) { const float hi = fmaxf(a[i], a[l]), lo = fminf(a[i], a[l]); a[i] = hi; a[l] = lo; }
        }
}
__device__ __forceinline__ void tk_top16_merge(float (&l)[16], const float (&g)[16]) {
#pragma unroll
    for (int i = 0; i < 16; ++i) l[i] = fmaxf(l[i], g[15 - i]);
    tk_merge16(l);
}
template <int CTRL> __device__ __forceinline__ float dpp_f(float v) { return __builtin_bit_cast(float, __builtin_amdgcn_update_dpp(0, __builtin_bit_cast(int, v), CTRL, 0xF, 0xF, false)); }
#ifndef PE_NTK
#define PE_NTK 2
#endif
#ifndef PE_PASS_SYNC
#define PE_PASS_SYNC 1
#endif
constexpr int PE_ENT = 12 * 1024;
#ifndef PE_LOGR
#define PE_LOGR 4
#endif
#ifndef PE_SPLIT
#define PE_SPLIT 1
#endif
#ifndef PE_FIXED
#define PE_FIXED 1
#endif
constexpr int PE_NR = 1 << PE_LOGR, PE_STS = 40;
constexpr int PE_WAVE = PE_ENT + 8 * PE_STS * 4;
#define PE_TOKEN_CHUNK(TK) do { \
    const int s_ = PE_FIXED ? r * 8 : st[(sr * PE_NTK + (TK)) * PE_STS + r], e_ = PE_FIXED ? r * 8 + 8 : st[(sr * PE_NTK + (TK)) * PE_STS + r + 1]; \
    for (int pos = s_; pos < e_; pos += 8) { \
        const int n = PE_FIXED ? 8 : ((e_ - pos < 8) ? (e_ - pos) : 8); \
        const int ei_ = pos + eid; \
        const bool ok_ = eid < n; \
        const int base_ = ((sr * PE_NTK + (TK)) * 128 + (ok_ ? ei_ : pos)) * 3; \
        const int ev = ent[base_]; const float cu = __builtin_bit_cast(float, ent[base_ + 1]), cg = __builtin_bit_cast(float, ent[base_ + 2]); \
        f32x2 xl[8]; \
        _Pragma("unroll") for (int j = 0; j < 4; ++j) { xl[2 * j] = (f32x2){bflo(xp[TK][j].x), bfhi(xp[TK][j].x)}; xl[2 * j + 1] = (f32x2){bflo(xp[TK][j].y), bfhi(xp[TK][j].y)}; } \
        u32x4 ur[8], vr[8]; \
        _Pragma("unroll") for (int k = 0; k < 8; ++k) { \
            if (k < n) { const unsigned e = (unsigned)__builtin_amdgcn_readlane(ev, ((k & 4) << 1) | ((k & 2) << 3) | ((k & 1) << 5)); \
                ur[k] = *(const u32x4*)(PU + (size_t)(e * 1024u) + loff); vr[k] = *(const u32x4*)(PV + (size_t)(e * 1024u) + loff); } \
            else { ur[k] = (u32x4){0u, 0u, 0u, 0u}; vr[k] = (u32x4){0u, 0u, 0u, 0u}; } } \
        float d[8]; \
        _Pragma("unroll") for (int k = 0; k < 8; ++k) { \
            if (k < n) { f32x2 s2 = CVT_LO(ur[k].x) * xl[0]; \
                s2 += CVT_HI(ur[k].x) * xl[1]; s2 += CVT_LO(ur[k].y) * xl[2]; s2 += CVT_HI(ur[k].y) * xl[3]; \
                s2 += CVT_LO(ur[k].z) * xl[4]; s2 += CVT_HI(ur[k].z) * xl[5]; s2 += CVT_LO(ur[k].w) * xl[6]; s2 += CVT_HI(ur[k].w) * xl[7]; \
                d[k] = s2.x + s2.y; } else d[k] = 0.f; } \
        _Pragma("unroll") for (int k = 0; k < 8; ++k) { d[k] += dpp_f<0xB1>(d[k]); d[k] += dpp_f<0x4E>(d[k]); d[k] += dpp_f<0x141>(d[k]); }     \
        float r4[4], r2[2], u1; \
        _Pragma("unroll") for (int k = 0; k < 4; ++k) { const float send = b3 ? d[k] : d[k + 4], keep = b3 ? d[k + 4] : d[k]; r4[k] = keep + dpp_f<0x140>(send); } \
        _Pragma("unroll") for (int k = 0; k < 2; ++k) { const float send = b4 ? r4[k] : r4[k + 2], keep = b4 ? r4[k + 2] : r4[k]; r2[k] = keep + __shfl_xor(send, 16); } \
        { const float send = b5 ? r2[0] : r2[1], keep = b5 ? r2[1] : r2[0]; u1 = keep + __shfl_xor(send, 32); }     \
        const float av = ok_ ? gelu_exact(u1 * cu) * cg : 0.f; \
        _Pragma("unroll") for (int k = 0; k < 8; ++k) { \
            if (k < n) { const float a = __builtin_bit_cast(float, __builtin_amdgcn_readlane(__builtin_bit_cast(int, av), ((k & 4) << 1) | ((k & 2) << 3) | ((k & 1) << 5))); \
                const f32x2 a2 = (f32x2){a, a}; \
                acc[TK][0] += a2 * CVT_LO(vr[k].x); acc[TK][1] += a2 * CVT_HI(vr[k].x); acc[TK][2] += a2 * CVT_LO(vr[k].y); acc[TK][3] += a2 * CVT_HI(vr[k].y); \
                acc[TK][4] += a2 * CVT_LO(vr[k].z); acc[TK][5] += a2 * CVT_HI(vr[k].z); acc[TK][6] += a2 * CVT_LO(vr[k].w); acc[TK][7] += a2 * CVT_HI(vr[k].w); } } \
    } } while (0)


#define PE_CHUNK_U(TK) do { \
        const int base_ = ((TK) * 128 + r * 8 + eid) * 3; \
        const int ev = ent[base_]; const float cu = __builtin_bit_cast(float, ent[base_ + 1]), cg = __builtin_bit_cast(float, ent[base_ + 2]); \
        f32x2 xl[8]; \
        _Pragma("unroll") for (int j = 0; j < 4; ++j) { xl[2 * j] = (f32x2){bflo(xp[TK][j].x), bfhi(xp[TK][j].x)}; xl[2 * j + 1] = (f32x2){bflo(xp[TK][j].y), bfhi(xp[TK][j].y)}; } \
        u32x4 rw[8]; \
        _Pragma("unroll") for (int k = 0; k < 8; ++k) { const unsigned e = (unsigned)__builtin_amdgcn_readlane(ev, ((k & 4) << 1) | ((k & 2) << 3) | ((k & 1) << 5)); \
            rw[k] = *(const u32x4*)(PU + (size_t)(e * 1024u) + loff); } \
        float d[8]; \
        _Pragma("unroll") for (int k = 0; k < 8; ++k) { f32x2 s2 = CVT_LO(rw[k].x) * xl[0]; \
            s2 += CVT_HI(rw[k].x) * xl[1]; s2 += CVT_LO(rw[k].y) * xl[2]; s2 += CVT_HI(rw[k].y) * xl[3]; \
            s2 += CVT_LO(rw[k].z) * xl[4]; s2 += CVT_HI(rw[k].z) * xl[5]; s2 += CVT_LO(rw[k].w) * xl[6]; s2 += CVT_HI(rw[k].w) * xl[7]; \
            d[k] = s2.x + s2.y; } \
        _Pragma("unroll") for (int k = 0; k < 8; ++k) { d[k] += dpp_f<0xB1>(d[k]); d[k] += dpp_f<0x4E>(d[k]); d[k] += dpp_f<0x141>(d[k]); } \
        float r4[4], r2[2], u1; \
        _Pragma("unroll") for (int k = 0; k < 4; ++k) { const float send = b3 ? d[k] : d[k + 4], keep = b3 ? d[k + 4] : d[k]; r4[k] = keep + dpp_f<0x140>(send); } \
        _Pragma("unroll") for (int k = 0; k < 2; ++k) { const float send = b4 ? r4[k] : r4[k + 2], keep = b4 ? r4[k + 2] : r4[k]; r2[k] = keep + __shfl_xor(send, 16); } \
        { const float send = b5 ? r2[0] : r2[1], keep = b5 ? r2[1] : r2[0]; u1 = keep + __shfl_xor(send, 32); } \
        const float av = gelu_exact(u1 * cu) * cg; \
        if ((lane & 7) == 0) ent[base_ + 1] = __builtin_bit_cast(int, av);     \
    } while (0)
#define PE_CHUNK_V(TK) do { \
        const int base_ = ((TK) * 128 + r * 8 + eid) * 3; \
        const int ev = ent[base_]; const int avb = ent[base_ + 1]; \
        u32x4 rw[8]; \
        _Pragma("unroll") for (int k = 0; k < 8; ++k) { const unsigned e = (unsigned)__builtin_amdgcn_readlane(ev, ((k & 4) << 1) | ((k & 2) << 3) | ((k & 1) << 5)); \
            rw[k] = *(const u32x4*)(PV + (size_t)(e * 1024u) + loff); } \
        _Pragma("unroll") for (int k = 0; k < 8; ++k) { \
            const float a = __builtin_bit_cast(float, __builtin_amdgcn_readlane(avb, ((k & 4) << 1) | ((k & 2) << 3) | ((k & 1) << 5))); \
            const f32x2 a2 = (f32x2){a, a}; \
            acc[TK][0] += a2 * CVT_LO(rw[k].x); acc[TK][1] += a2 * CVT_HI(rw[k].x); acc[TK][2] += a2 * CVT_LO(rw[k].y); acc[TK][3] += a2 * CVT_HI(rw[k].y); \
            acc[TK][4] += a2 * CVT_LO(rw[k].z); acc[TK][5] += a2 * CVT_HI(rw[k].z); acc[TK][6] += a2 * CVT_LO(rw[k].w); acc[TK][7] += a2 * CVT_HI(rw[k].w); } \
    } while (0)

template <bool DRY> __device__ __forceinline__ void phase_peer_fused(const Params& p, int layer, char* lds) {
    const int tid = otid(), lane = tid & 63, wave = tid >> 6;
    const unsigned char* PU = p.ws + OFF_PU + (size_t)layer * 16384 * 1024;
    const unsigned char* PV = p.ws + OFF_PV + (size_t)layer * 16384 * 1024;
    const float* SU = (const float*)(p.ws + OFF_PSC) + (size_t)layer * 16384;
    const float* SV = (const float*)(p.ws + OFF_PSC) + (size_t)(2 + layer) * 16384;
    bf16_t* XN = (bf16_t*)(p.ws + R_XN);
    float* XA = (float*)(p.ws + OFF_XA);
    const float* SC = (const float*)(p.ws + R_QP);
    const bool last = (layer == NLAYER - 1);
    const float* gnext = last ? p.in[I_FG] : p.in[I_N1G] + (layer + 1) * DM;
    const float* g2p = p.in[I_N2G] + layer * DM;
    const bool b5 = (lane & 32) != 0, b4 = (lane & 16) != 0, b3 = (lane & 8) != 0;
    const int eid = ((lane >> 3) & 1) * 4 + ((lane >> 4) & 1) * 2 + (lane >> 5);
    const unsigned loff = (unsigned)lane * 16u;
    int* ent = (int*)(lds + wave * PE_WAVE);
    int* st = (int*)(lds + wave * PE_WAVE + PE_ENT);
    const float NINF = -3.0e38f;
    const int pp = lane & 1;
    for (int tb = (obid() * NWAVE + wave) * 8; tb < T; tb += NBLK * NWAVE * 8) {
#pragma unroll 1
        for (int grp = 0; grp < 2; ++grp) {
            const int tkl = grp * 4 + (lane >> 4), h = (lane >> 1) & 7;
            const f32x4* src = (const f32x4*)(SC + (size_t)(tb + tkl) * 2048 + h * 256 + pp * 128);
            float l[16];
#pragma unroll
            for (int i = 0; i < 16; ++i) l[i] = NINF;
#pragma unroll 1
            for (int c = 0; c < 4; ++c) {
                f32x4 v[8];
#pragma unroll
                for (int j = 0; j < 8; ++j) v[j] = src[c * 8 + j];
#pragma unroll
                for (int hh = 0; hh < 2; ++hh) {
                    float g[16];
#pragma unroll
                    for (int j = 0; j < 4; ++j) {
                        const unsigned kb = (unsigned)(c * 32 + hh * 16 + j * 4);
                        g[4 * j] = tk_pack(v[hh * 4 + j].x, kb, 0x7Fu); g[4 * j + 1] = tk_pack(v[hh * 4 + j].y, kb + 1u, 0x7Fu);
                        g[4 * j + 2] = tk_pack(v[hh * 4 + j].z, kb + 2u, 0x7Fu); g[4 * j + 3] = tk_pack(v[hh * 4 + j].w, kb + 3u, 0x7Fu);
                    }
                    tk_sort16(g);
                    tk_top16_merge(l, g);
                }
            }
            float xw[16], ow[16]; unsigned PX[4] = {0u, 0u, 0u, 0u}, PO[4] = {0u, 0u, 0u, 0u};
#pragma unroll
            for (int i = 0; i < 16; ++i) {
                const float o = __shfl_xor(l[i], 1);
                const unsigned xb = __builtin_bit_cast(unsigned, l[i]), ob = __builtin_bit_cast(unsigned, o);
                xw[i] = __builtin_bit_cast(float, xb & ~0x7Fu); ow[i] = __builtin_bit_cast(float, ob & ~0x7Fu);
                PX[i >> 2] |= (xb & 0x7Fu) << ((i & 3) * 8); PO[i >> 2] |= (ob & 0x7Fu) << ((i & 3) * 8);
            }
            float f[16];
            {
                float c1[16];
#pragma unroll
                for (int i = 0; i < 16; ++i) { f[i] = NINF; c1[i] = NINF; }
                int cnt = 0;
#pragma unroll
                for (int i = 0; i < 16; ++i)
#pragma unroll
                    for (int j = i; j < 16; ++j)
                        if ((i + 1) * (j + 1) <= 16) {
                            float cv = xw[i] + ow[j];
                            const unsigned code = pp ? (unsigned)((j << 4) | i) : (unsigned)((i << 4) | j);
                            cv = tk_pack(cv, code, 0xFFu);
                            if (i == j) cv = pp ? NINF : cv;
                            if (cnt < 16) f[cnt & 15] = cv; else c1[cnt & 15] = cv;
                            ++cnt;
                        }
                tk_sort16(f); tk_sort16(c1);
                tk_top16_merge(f, c1);
                float gq[16];
#pragma unroll
                for (int i = 0; i < 16; ++i) gq[i] = __shfl_xor(f[i], 1);
                tk_top16_merge(f, gq);
            }
            unsigned P0[4], P1[4];
#pragma unroll
            for (int q = 0; q < 4; ++q) { P0[q] = pp ? PO[q] : PX[q]; P1[q] = pp ? PX[q] : PO[q]; }
            const float top = __builtin_bit_cast(float, __builtin_bit_cast(unsigned, f[0]) & ~0xFFu);
            float ev[16]; float den = 0.f;
#pragma unroll
            for (int r = 0; r < 16; ++r) { ev[r] = __expf(__builtin_bit_cast(float, __builtin_bit_cast(unsigned, f[r]) & ~0xFFu) - top); den += ev[r]; }
            const float rden = 1.0f / den;
#pragma unroll
            for (int r8 = 0; r8 < 8; ++r8) {
                const unsigned c0 = __builtin_bit_cast(unsigned, f[r8]) & 0xFFu, c1 = __builtin_bit_cast(unsigned, f[r8 + 8]) & 0xFFu;
                const unsigned code = pp ? c1 : c0;
                const float gate = (pp ? ev[r8 + 8] : ev[r8]) * rden;
                const int e = (int)(tk_lookup(P0, code >> 4) * 128u + tk_lookup(P1, code & 15u));
                const int o = (tkl * 128 + h * 16 + pp * 8 + r8) * 3;
                ent[o] = e; ent[o + 1] = __builtin_bit_cast(int, SU[e]); ent[o + 2] = __builtin_bit_cast(int, gate * SV[e]);
            }
        }
#pragma unroll 1
        for (int tk = 0; tk < 8; ++tk) {
            int* et = ent + tk * 384;
            const int eA = et[lane * 3], uA = et[lane * 3 + 1], gA = et[lane * 3 + 2];
            const int eB = et[(64 + lane) * 3], uB = et[(64 + lane) * 3 + 1], gB = et[(64 + lane) * 3 + 2];
            const int rA = eA >> (14 - PE_LOGR), rB = eB >> (14 - PE_LOGR);
            int base = 0;
#pragma unroll 1
            for (int r = 0; r < PE_NR; ++r) {
                const unsigned long long mA = __ballot(rA == r), mB = __ballot(rB == r);
                const int cA = __popcll(mA);
                if (lane == 0) st[tk * PE_STS + r] = base;
                if (rA == r) { const int q = base + (int)__builtin_amdgcn_mbcnt_hi((unsigned)(mA >> 32), __builtin_amdgcn_mbcnt_lo((unsigned)mA, 0u)); et[q * 3] = eA; et[q * 3 + 1] = uA; et[q * 3 + 2] = gA; }
                if (rB == r) { const int q = base + cA + (int)__builtin_amdgcn_mbcnt_hi((unsigned)(mB >> 32), __builtin_amdgcn_mbcnt_lo((unsigned)mB, 0u)); et[q * 3] = eB; et[q * 3 + 1] = uB; et[q * 3 + 2] = gB; }
                base += cA + __popcll(mB);
            }
            if (lane == 0) st[tk * PE_STS + PE_NR] = base;
        }
#if PE_SPLIT
        {
            {
                u32x2 xp[8][4];
#pragma unroll
                for (int tk = 0; tk < 8; ++tk) {
                    f32x4 xr[4]; float ss = 0.f;
#pragma unroll
                    for (int j = 0; j < 4; ++j) { xr[j] = *(const f32x4*)(XA + (size_t)(tb + tk) * DM + 4 * lane + 256 * j); ss += xr[j].x * xr[j].x + xr[j].y * xr[j].y + xr[j].z * xr[j].z + xr[j].w * xr[j].w; }
                    ss = wave_sum(ss);
                    const float rn = rsqrtf(ss * (1.0f / DM) + EPS);
#pragma unroll
                    for (int j = 0; j < 4; ++j) { const f32x4 gg = *(const f32x4*)(g2p + 4 * lane + 256 * j);
                        xp[tk][j].x = pk2(xr[j].x * rn * gg.x, xr[j].y * rn * gg.y); xp[tk][j].y = pk2(xr[j].z * rn * gg.z, xr[j].w * rn * gg.w); }
                }
#pragma unroll 1
                for (int r = 0; r < 16; ++r) {
                    __syncthreads();
                    PE_CHUNK_U(0); PE_CHUNK_U(1); PE_CHUNK_U(2); PE_CHUNK_U(3); PE_CHUNK_U(4); PE_CHUNK_U(5); PE_CHUNK_U(6); PE_CHUNK_U(7);
                }
            }
#pragma unroll 1
            for (int hv = 0; hv < 2; ++hv) {
            f32x2 acc[4][8];
#pragma unroll
            for (int tk = 0; tk < 4; ++tk)
#pragma unroll
                for (int j = 0; j < 8; ++j) acc[tk][j] = (f32x2){0.f, 0.f};
            const int* entv = ent;
            {
                int* ent = (int*)entv + hv * 4 * 128 * 3;
#pragma unroll 1
                for (int r = 0; r < 16; ++r) {
                    __syncthreads();
                    PE_CHUNK_V(0); PE_CHUNK_V(1); PE_CHUNK_V(2); PE_CHUNK_V(3);
                }
            }
#pragma unroll
            for (int tk = 0; tk < 4; ++tk) {
                const int t = tb + hv * 4 + tk;
                f32x4 x[4]; float ss = 0.f;
#pragma unroll
                for (int j = 0; j < 4; ++j) {
                    x[j] = *(const f32x4*)(XA + (size_t)t * DM + 4 * lane + 256 * j);
                    x[j].x += acc[tk][2 * j].x; x[j].y += acc[tk][2 * j].y; x[j].z += acc[tk][2 * j + 1].x; x[j].w += acc[tk][2 * j + 1].y;
                    ss += x[j].x * x[j].x + x[j].y * x[j].y + x[j].z * x[j].z + x[j].w * x[j].w;
                }
                ss = wave_sum(ss);
                const float rr = rsqrtf(ss * (1.0f / DM) + EPS);
                if (last) {
#pragma unroll
                    for (int j = 0; j < 4; ++j) { const f32x4 gg = *(const f32x4*)(gnext + 4 * lane + 256 * j); *(f32x4*)(p.out + (size_t)t * DM + 4 * lane + 256 * j) = x[j] * rr * gg; }
                } else {
#pragma unroll
                    for (int j = 0; j < 4; ++j) {
                        const f32x4 gg = *(const f32x4*)(gnext + 4 * lane + 256 * j);
                        *(f32x4*)((DRY ? p.out : XA) + (size_t)t * DM + 4 * lane + 256 * j) = x[j];
                        u32x2 w; w.x = pk2(x[j].x * rr * gg.x, x[j].y * rr * gg.y); w.y = pk2(x[j].z * rr * gg.z, x[j].w * rr * gg.w);
                        if (!DRY) *(u32x2*)(XN + (size_t)t * DM + 4 * lane + 256 * j) = w;
                    }
                }
            }
            }
        }
#else
#pragma unroll 1
        for (int sr = 0; sr < 8 / PE_NTK; ++sr) {
            u32x2 xp[PE_NTK][4]; f32x2 acc[PE_NTK][8];
#pragma unroll
            for (int tk = 0; tk < PE_NTK; ++tk) {
                f32x4 xr[4]; float ss = 0.f;
#pragma unroll
                for (int j = 0; j < 4; ++j) { xr[j] = *(const f32x4*)(XA + (size_t)(tb + sr * PE_NTK + tk) * DM + 4 * lane + 256 * j); ss += xr[j].x * xr[j].x + xr[j].y * xr[j].y + xr[j].z * xr[j].z + xr[j].w * xr[j].w; }
                ss = wave_sum(ss);
                const float rn = rsqrtf(ss * (1.0f / DM) + EPS);
#pragma unroll
                for (int j = 0; j < 4; ++j) { const f32x4 gg = *(const f32x4*)(g2p + 4 * lane + 256 * j);
                    xp[tk][j].x = pk2(xr[j].x * rn * gg.x, xr[j].y * rn * gg.y); xp[tk][j].y = pk2(xr[j].z * rn * gg.z, xr[j].w * rn * gg.w); }
#pragma unroll
                for (int j = 0; j < 8; ++j) acc[tk][j] = (f32x2){0.f, 0.f};
            }
#pragma unroll 1
            for (int r = 0; r < (PE_FIXED ? 16 : PE_NR); ++r) {
#if PE_PASS_SYNC
                __syncthreads();
#endif
                PE_TOKEN_CHUNK(0); PE_TOKEN_CHUNK(1);
#if PE_NTK == 4
                PE_TOKEN_CHUNK(2); PE_TOKEN_CHUNK(3);
#endif
            }
#pragma unroll
            for (int tk = 0; tk < PE_NTK; ++tk) {
                const int t = tb + sr * PE_NTK + tk;
                f32x4 x[4]; float ss = 0.f;
#pragma unroll
                for (int j = 0; j < 4; ++j) {
                    x[j] = *(const f32x4*)(XA + (size_t)t * DM + 4 * lane + 256 * j);
                    x[j].x += acc[tk][2 * j].x; x[j].y += acc[tk][2 * j].y; x[j].z += acc[tk][2 * j + 1].x; x[j].w += acc[tk][2 * j + 1].y;
                    ss += x[j].x * x[j].x + x[j].y * x[j].y + x[j].z * x[j].z + x[j].w * x[j].w;
                }
                ss = wave_sum(ss);
                const float rr = rsqrtf(ss * (1.0f / DM) + EPS);
                if (last) {
#pragma unroll
                    for (int j = 0; j < 4; ++j) { const f32x4 gg = *(const f32x4*)(gnext + 4 * lane + 256 * j); *(f32x4*)(p.out + (size_t)t * DM + 4 * lane + 256 * j) = x[j] * rr * gg; }
                } else {
#pragma unroll
                    for (int j = 0; j < 4; ++j) {
                        const f32x4 gg = *(const f32x4*)(gnext + 4 * lane + 256 * j);
                        *(f32x4*)((DRY ? p.out : XA) + (size_t)t * DM + 4 * lane + 256 * j) = x[j];
                        u32x2 w; w.x = pk2(x[j].x * rr * gg.x, x[j].y * rr * gg.y); w.y = pk2(x[j].z * rr * gg.z, x[j].w * rr * gg.w);
                        if (!DRY) *(u32x2*)(XN + (size_t)t * DM + 4 * lane + 256 * j) = w;
                    }
                }
            }
        }
#endif
    }
}

#define LAS __attribute__((address_space(3)))
#define XB_TMO      128
#define XB_XCNT(j)  (256  + 64 * (j))
#define XB_XSUB(j)  (1280 + 64 * (j))
#define XB_XGEN(j)  (2304 + 64 * (j))
#define XB_TOP      3328
#define XB_TOPGEN   3392
#define XCD_BAR_WORDS 3456
#define XB_SPIN_CAP (1u << 20)
__device__ __forceinline__ unsigned xb_ld(unsigned* p)              { return __hip_atomic_load(p, __ATOMIC_RELAXED, __HIP_MEMORY_SCOPE_AGENT); }
__device__ __forceinline__ unsigned xb_add(unsigned* p, unsigned v) { return __hip_atomic_fetch_add(p, v, __ATOMIC_RELAXED, __HIP_MEMORY_SCOPE_AGENT); }
__device__ __forceinline__ unsigned xb_xcc_id() { return (unsigned)__builtin_amdgcn_s_getreg((3 << 11) | 20) & 0xFu; }
#define XB_SPIN(cond, bar) do { unsigned _sp = 0; while (cond) { __builtin_amdgcn_s_sleep(1); \
    if ((++_sp & 255u) == 0u) { if (xb_ld(&(bar)[XB_TMO])) break; if (_sp > XB_SPIN_CAP) { atomicAdd(&(bar)[XB_TMO], 1u); break; } } } } while (0)
struct XcdBarrier { unsigned* bar; unsigned x; volatile LAS unsigned* st; };
__device__ __forceinline__ XcdBarrier xcd_barrier_post(unsigned* bar, volatile LAS unsigned* st) {
    XcdBarrier b; b.bar = bar; b.x = xb_xcc_id(); b.st = st;
    if (threadIdx.x == 0) (void)xb_add(&bar[XB_XCNT(b.x)], 1u);
    return b;
}
__device__ __forceinline__ void xcd_barrier_complete(unsigned* bar, unsigned x, unsigned& nloc, unsigned& nx) {
    const unsigned G = NBLK;
    unsigned sum, cnt, mine, sp = 0u;
    for (;;) {
        sum = 0u; cnt = 0u; mine = 0u;
#pragma unroll
        for (unsigned j = 0; j < 16; ++j) { const unsigned c = xb_ld(&bar[XB_XCNT(j)]); sum += c; cnt += (c > 0u) ? 1u : 0u; mine = (j == x) ? c : mine; }
        if (sum == G) break;
        __builtin_amdgcn_s_sleep(1);
        if ((++sp & 255u) == 0u) { if (xb_ld(&bar[XB_TMO])) break; if (sp > XB_SPIN_CAP) { atomicAdd(&bar[XB_TMO], 1u); break; } }
    }
    nloc = mine > 0u ? mine : 1u; nx = cnt > 0u ? cnt : 1u;
}
__device__ __forceinline__ void xcd_barrier(const XcdBarrier& b) {
    asm volatile("s_waitcnt vmcnt(0)" ::: "memory");
    __syncthreads();
    if (threadIdx.x == 0) {
        unsigned* bar = b.bar;
        __builtin_amdgcn_s_waitcnt(0);
        unsigned nloc = b.st[0], nx = b.st[1];
        if (nloc == 0u) { xcd_barrier_complete(bar, b.x, nloc, nx); b.st[0] = nloc; b.st[1] = nx; }
        const unsigned old = xb_add(&bar[XB_XSUB(b.x)], 1u);
        const unsigned gen = old / nloc;
        if (old + 1u == (gen + 1u) * nloc) {
            __builtin_amdgcn_fence(__ATOMIC_RELEASE, "agent");
            asm volatile("s_waitcnt vmcnt(0)" ::: "memory");
            const unsigned og = xb_add(&bar[XB_TOP], 1u);
            const unsigned tg = og / nx;
            if (og + 1u == (tg + 1u) * nx) xb_add(&bar[XB_TOPGEN], 1u);
            else XB_SPIN(xb_ld(&bar[XB_TOPGEN]) == tg, bar);
            __builtin_amdgcn_fence(__ATOMIC_ACQUIRE, "agent");
            xb_add(&bar[XB_XGEN(b.x)], 1u);
            asm volatile("s_waitcnt vmcnt(0)" ::: "memory");
        } else {
            XB_SPIN(xb_ld(&bar[XB_XGEN(b.x)]) == gen, bar);
            __builtin_amdgcn_fence(__ATOMIC_ACQUIRE, "agent");
            asm volatile("s_waitcnt vmcnt(0)" ::: "memory");
        }
    }
    __syncthreads();
}


template <class Epi> __device__ __forceinline__ void big_gemm(const bf16_t* A, const bf16_t* Bt, int M, int N, int K, char* lds, const Epi& e) {
    pg8::Gemm g{A, Bt, M, N, K}; pg8::StaticOrder S; S.init(M, N, NBLK, obid());
    pg8::gemm_phase<Epi, pg8::StaticOrder, true, true>((PG8_LAS unsigned char*)lds, g, S, e);
}

#define GSYNC() xcd_barrier(xbar)
template <int layer> __device__ __forceinline__ void run_layer(const Params& p, char* lds, const XcdBarrier& xbar) {
    float* XA = (float*)(p.ws + OFF_XA);

        const float* xin = layer == 0 ? p.in[I_X] : XA;
#if PROBE == 10
        { EpiIn e{(bf16_t*)(p.ws + R_QKV), (float*)(p.ws + R_HF)};
          gemm_simple((const bf16_t*)(p.ws + R_XN), (const bf16_t*)(p.ws + OFF_WTIN) + (size_t)layer * INC * DM, T, INC, DM, lds, e); } GSYNC();
#endif
        {
            const bf16_t* wt = (const bf16_t*)(p.ws + OFF_WTIN) + (size_t)layer * INC * DM;
            pg8::EpiStoreBf16 e1{(bf16_t*)(p.ws + R_QKV), 768};
            big_gemm((const bf16_t*)(p.ws + R_XN), wt, T, 768, DM, lds, e1);
            pg8::EpiStoreF32 e2{nullptr, (float*)(p.ws + R_HF), T};
            big_gemm(wt + (size_t)768 * DM, (const bf16_t*)(p.ws + R_XN), 1024, T, DM, lds, e2);
        }
        if (layer == 0) {
#pragma nounroll
            for (int fl = 0; fl < NLAYER; ++fl) {
                EpiF32 e{(float*)(p.ws + (fl ? OFF_HFILT1 : OFF_HFILT0)), SL};
                gemm_simple((const bf16_t*)(p.ws + OFF_W3T) + (size_t)fl * 1024 * 64, (const bf16_t*)(p.ws + OFF_H2) + (size_t)fl * SL * 64, 1024, SL, 64, lds, e);
            }
        }
        GSYNC();
        if (layer == 0) {
            phase_filter_spectra(p, lds);
#if PROBE == 13
            phase_filter_spectra(p, lds);
#endif
        }
#if PROBE == 12
        phase_qkprep(p, layer, lds, (bf16_t*)(p.ws + R_ATT)); GSYNC();
#endif
        phase_qkprep(p, layer, lds, (bf16_t*)(p.ws + R_QKV)); GSYNC();
        {
#if PROBE == 5
            phase_attn(p, lds);
#endif
#if PROBE == 6
            for (int c = obid(); c < 256; c += NBLK) hyena_job(p, layer, c, lds);
            for (int c = obid(); c < 256; c += NBLK) fnet_job(p, c, lds);
#endif
            phase_attn(p, lds);
            for (int c = obid(); c < 256; c += NBLK) hyena_job(p, layer, c, lds);
            for (int c = obid(); c < 256; c += NBLK) fnet_job(p, c, lds);
        } GSYNC();
#if PROBE == 8
        phase_mix(p, layer, lds); GSYNC();
#endif
        phase_mix(p, layer, lds); GSYNC();
#if PROBE == 11
        { EpiRes e{xin, p.out};
          gemm_simple((const bf16_t*)(p.ws + R_MIX), (const bf16_t*)(p.ws + OFF_WTOUT) + (size_t)layer * DM * DM, T, DM, DM, lds, e); } GSYNC();
#endif
        { pg8::EpiOutProj e{xin, XA, (bf16_t*)(p.ws + R_XN), (float*)(p.ws + OFF_RS)};
          big_gemm((const bf16_t*)(p.ws + R_MIX), (const bf16_t*)(p.ws + OFF_WTOUT) + (size_t)layer * DM * DM, T, DM, DM, lds, e); } GSYNC();
#if PROBE == 3
        { EpiF32 e{(float*)(p.ws + R_QP), 2048};
          gemm_simple((const bf16_t*)(p.ws + R_XN), (const bf16_t*)(p.ws + OFF_WTQ) + (size_t)layer * 2048 * DM, T, 2048, DM, lds, e); } GSYNC();
#endif
        { pg8::EpiRowScaleF32 e{(float*)(p.ws + R_QP), 2048, (const float*)(p.ws + OFF_RS)};
          big_gemm((const bf16_t*)(p.ws + R_XN), (const bf16_t*)(p.ws + OFF_WTQ) + (size_t)layer * 2048 * DM, T, 2048, DM, lds, e); } GSYNC();
#if PEER_FUSED
#if PROBE == 1
        phase_peer_fused<true>(p, layer, lds); GSYNC();
#endif
        phase_peer_fused<false>(p, layer, lds);
#else
        phase_peer_topk(p, layer, lds, (int*)(p.ws + R_QP), (float*)(p.ws + R_QP)); GSYNC();
#if PROBE == 1
        phase_peer_gather<true>(p, layer); GSYNC();
#endif
#if PROBE == 15
        phase_peer_gather<true, 1023>(p, layer); GSYNC();
#endif
        phase_peer_gather<false>(p, layer);
#endif
        if (layer + 1 < NLAYER) GSYNC();
}

__global__ void __launch_bounds__(NTHR) mega_kernel(Params p) {
    extern __shared__ __attribute__((aligned(16))) char lds[];
    volatile LAS unsigned* misc = (volatile LAS unsigned*)((LAS char*)lds + LDS_MISC);
    if (threadIdx.x < 16) misc[threadIdx.x] = 0u;
    __syncthreads();
    const XcdBarrier xbar = xcd_barrier_post((unsigned*)(p.ws + OFF_CTL) + 4096, misc);
    float* XA = (float*)(p.ws + OFF_XA);
#if PROBE == 7
    phase_p0(p, lds); GSYNC();
#endif
#if PROBE >= 30 && PROBE <= 34
    phase_p0<(1 << (PROBE - 30))>(p, lds); GSYNC();
#endif
#if PROBE == 35
    phase_rmsnorm_bf16(p.in[I_X], p.in[I_N1G], (bf16_t*)(p.ws + R_XN)); GSYNC();
#endif
#if PROBE == 14
#pragma nounroll
    for (int i = 0; i < 40; ++i) GSYNC();
#endif
    phase_p0(p, lds);
    phase_rmsnorm_bf16(p.in[I_X], p.in[I_N1G], (bf16_t*)(p.ws + R_XN));
    GSYNC();
    run_layer<0>(p, lds, xbar);
    run_layer<1>(p, lds, xbar);
}

extern "C" void kernel_launch(void* const* d_in, const int* in_sizes, int n_in, void* d_out, int out_size, void* d_ws, size_t ws_size, hipStream_t stream) {
    static int grid = 0;
    if (grid == 0) {
        if (n_in != 25 || out_size != T * DM || ws_size < WS_NEED) { fprintf(stderr, "kernel_launch: unexpected sizes n_in %d out %d ws %zu (need %zu)\n", n_in, out_size, ws_size, (size_t)WS_NEED); grid = -1; return; }
        int dev = 0, cus = 0, per_cu = 0;
        if (hipGetDevice(&dev) != hipSuccess || hipDeviceGetAttribute(&cus, hipDeviceAttributeMultiprocessorCount, dev) != hipSuccess) { grid = -1; return; }
        if (hipFuncSetAttribute((const void*)mega_kernel, hipFuncAttributeMaxDynamicSharedMemorySize, LDS_BYTES) != hipSuccess) { fprintf(stderr, "kernel_launch: hipFuncSetAttribute failed\n"); grid = -1; return; }
        if (hipOccupancyMaxActiveBlocksPerMultiprocessor(&per_cu, (const void*)mega_kernel, NTHR, LDS_BYTES) != hipSuccess || per_cu < 1) { fprintf(stderr, "kernel_launch: occupancy query says %d blocks per CU\n", per_cu); grid = -1; return; }
        (void)hipGetLastError();
        if (cus < NBLK) { fprintf(stderr, "kernel_launch: built for a %d-CU device, found %d CUs\n", NBLK, cus); grid = -1; return; }
        grid = NBLK;
    }
    if (grid < 0) return;
    Params p{};
    for (int i = 0; i < 25; ++i) p.in[i] = (const float*)d_in[i];
    p.out = (float*)d_out; p.ws = (unsigned char*)d_ws;
    if (hipMemsetAsync((char*)d_ws + OFF_CTL, 0, 64 * 1024, stream) != hipSuccess) { fprintf(stderr, "kernel_launch: memset failed\n"); return; }
    void* args[] = {&p};
    hipError_t e = hipLaunchCooperativeKernel((const void*)mega_kernel, dim3(grid), dim3(NTHR), args, LDS_BYTES, stream);
    if (e != hipSuccess) fprintf(stderr, "cooperative launch failed: %s (grid %d)\n", hipGetErrorString(e), grid);
}
```

```cpp
#include <hip/hip_runtime.h>
#include <cstdio>
#include <cstdint>

typedef unsigned short bf16_t;
typedef short bf16x8 __attribute__((ext_vector_type(8)));
typedef float f32x16 __attribute__((ext_vector_type(16)));
typedef float f32x4 __attribute__((ext_vector_type(4)));
typedef unsigned u32x4 __attribute__((ext_vector_type(4)));
typedef unsigned u32x2 __attribute__((ext_vector_type(2)));

constexpr int DM = 1024, NB = 2, SL = 8192, T = NB * SL, NLAYER = 2;
constexpr int INC = 1792;
constexpr int NTHR = 512, NWAVE = 8;
constexpr int NBLK = 256;
constexpr int LDS_BYTES = 147456;
constexpr int LDS_MISC = LDS_BYTES - 64;
constexpr float EPS = 1e-6f;

constexpr size_t MiB = 1u << 20;
constexpr size_t OFF_CTL = 0;
constexpr size_t OFF_WTIN = 1 * MiB;
constexpr size_t OFF_WTOUT = 8 * MiB;
constexpr size_t OFF_WTQ = 12 * MiB;
constexpr size_t OFF_PU = 20 * MiB;
constexpr size_t OFF_PV = 84 * MiB;
constexpr size_t OFF_RS = 505 * MiB;
constexpr size_t OFF_PSC = 512 * 1024;
constexpr size_t OFF_H2 = 148 * MiB;
constexpr size_t OFF_W3T = 150 * MiB;
constexpr size_t OFF_HFILT0 = 52 * MiB, OFF_HFILT1 = 116 * MiB;
constexpr size_t OFF_FM = 152 * MiB;
constexpr size_t OFF_KF = 153 * MiB;
constexpr size_t OFF_XA = 281 * MiB;
constexpr size_t OFF_R = 345 * MiB;
constexpr size_t R_XN = OFF_R + 0 * MiB;
constexpr size_t R_UR = OFF_R + 0 * MiB;
constexpr size_t R_UI = OFF_R + 16 * MiB;
constexpr size_t R_QKV = OFF_R + 32 * MiB;
constexpr size_t R_HF = OFF_R + 60 * MiB;
constexpr size_t R_MIX = OFF_R + 60 * MiB;
constexpr size_t R_ATT = OFF_R + 124 * MiB;
constexpr size_t R_Y = OFF_R + 140 * MiB;
constexpr size_t R_QP = OFF_R + 32 * MiB;
constexpr size_t WS_NEED = 506 * MiB;

struct Params {
    const float* in[25];
    float* out;
    unsigned char* ws;
};
enum { I_X = 0, I_N1G, I_WIN, I_QG, I_KG, I_CW, I_CB, I_W1, I_B1, I_F1, I_W2, I_B2, I_F2, I_W3, I_HB, I_FW, I_FB, I_MG, I_WOUT, I_N2G, I_WQ, I_SK, I_PU, I_PV, I_FG };

__device__ __forceinline__ unsigned f2bf(float f) { unsigned u = __builtin_bit_cast(unsigned, f); return (u + 0x7fffu + ((u >> 16) & 1u)) >> 16; }
__device__ __forceinline__ unsigned pk2(float lo, float hi) { return f2bf(lo) | (f2bf(hi) << 16); }
__device__ __forceinline__ float bflo(unsigned w) { return __builtin_bit_cast(float, w << 16); }
__device__ __forceinline__ float bfhi(unsigned w) { return __builtin_bit_cast(float, w & 0xffff0000u); }
__device__ __forceinline__ float wave_sum(float v) {
#pragma unroll
    for (int o = 1; o < 64; o <<= 1) v += __shfl_xor(v, o);
    return v;
}
__device__ __forceinline__ float wave_max(float v) {
#pragma unroll
    for (int o = 1; o < 64; o <<= 1) v = fmaxf(v, __shfl_xor(v, o));
    return v;
}
__device__ __forceinline__ f32x16 mfma32(bf16x8 a, bf16x8 b, f32x16 c) { return __builtin_amdgcn_mfma_f32_32x32x16_bf16(a, b, c, 0, 0, 0); }
__device__ __forceinline__ f32x16 zero16() { return (f32x16){0.f,0.f,0.f,0.f,0.f,0.f,0.f,0.f,0.f,0.f,0.f,0.f,0.f,0.f,0.f,0.f}; }


__device__ __forceinline__ int otid() { int t = threadIdx.x; asm volatile("" : "+v"(t)); return t; }
__device__ __forceinline__ int obid() { int b = blockIdx.x; asm volatile("" : "+s"(b)); return b; }
__device__ __forceinline__ void transpose_one(const float* W, int K, int N, bf16_t* Wt, float* tile, int item) {
    const int tid = otid();
    const int nblk = N / 64, kb = item / nblk, nb = item % nblk, k0 = kb * 64, n0 = nb * 64;
    __syncthreads();
    {
        const int r = tid >> 6, c = tid & 63;
#pragma unroll
        for (int i = 0; i < 8; ++i) { const int k = r + 8 * i; tile[k * 65 + c] = W[(size_t)(k0 + k) * N + n0 + c]; }
    }
    __syncthreads();
    {
        const int nn = tid >> 3, kc = tid & 7;
        const float* s = tile + (kc * 8) * 65 + nn;
        u32x4 o; o.x = pk2(s[0], s[65]); o.y = pk2(s[2 * 65], s[3 * 65]); o.z = pk2(s[4 * 65], s[5 * 65]); o.w = pk2(s[6 * 65], s[7 * 65]);
        *(u32x4*)(Wt + (size_t)(n0 + nn) * K + k0 + kc * 8) = o;
    }
}

template <int PARTS = 31> __device__ __forceinline__ void phase_p0(const Params& p, char* lds) {
    const int tid = otid();
    float* tile = (float*)lds;
    if (PARTS & 1) {
    constexpr int IT_IN = (DM / 64) * (INC / 64), IT_OUT = (DM / 64) * (DM / 64), IT_W3 = 1024 / 64;
    constexpr int IT_L = IT_IN + IT_OUT + IT_W3;
    for (int it = obid(); it < NLAYER * IT_L; it += NBLK) {
        const int layer = it / IT_L; int r = it % IT_L;
        if (r < IT_IN) { transpose_one(p.in[I_WIN] + (size_t)layer * DM * INC, DM, INC, (bf16_t*)(p.ws + OFF_WTIN) + (size_t)layer * INC * DM, tile, r); continue; }
        r -= IT_IN;
        if (r < IT_OUT) { transpose_one(p.in[I_WOUT] + (size_t)layer * DM * DM, DM, DM, (bf16_t*)(p.ws + OFF_WTOUT) + (size_t)layer * DM * DM, tile, r); continue; }
        r -= IT_OUT;
        transpose_one(p.in[I_W3] + (size_t)layer * 64 * 1024, 64, 1024, (bf16_t*)(p.ws + OFF_W3T) + (size_t)layer * 1024 * 64, tile, r);
    }
    }
    __syncthreads();
    if (PARTS & 2) {
        float* SKl = (float*)lds;
        float* Wl = SKl + 128 * 129;
        const int lane = tid & 63, wave = tid >> 6, l31 = lane & 31, hl = lane >> 5, mt = wave & 3, nt = wave >> 2;
        for (int it = obid(); it < NLAYER * 16 * 16; it += NBLK) {
            const int layer = it >> 8, hp = (it >> 4) & 15, kc = it & 15, h = hp >> 1, pp = hp & 1, k0 = kc * 64;
            const float* sk = p.in[I_SK] + (((size_t)(layer * 2 + pp) * 8 + h) * 128) * 128;
            const float* wq = p.in[I_WQ] + (size_t)layer * DM * 2048 + (size_t)k0 * 2048 + h * 256 + pp * 128;
            __syncthreads();
            for (int i = tid; i < 128 * 128; i += NTHR) SKl[(i >> 7) * 129 + (i & 127)] = sk[i];
            for (int i = tid; i < 64 * 128; i += NTHR) Wl[(i >> 7) * 129 + (i & 127)] = wq[(size_t)(i >> 7) * 2048 + (i & 127)];
            __syncthreads();
            f32x16 acc = zero16();
            const float* ap = SKl + (32 * mt + l31) * 129 + hl;
            const float* bp = Wl + (32 * nt + l31) * 129 + hl;
#pragma unroll 16
            for (int kk = 0; kk < 64; ++kk) acc = __builtin_amdgcn_mfma_f32_32x32x2f32(ap[2 * kk], bp[2 * kk], acc, 0, 0, 0);
            const float g2 = p.in[I_N2G][layer * DM + k0 + 32 * nt + l31];
            bf16_t* dst = (bf16_t*)(p.ws + OFF_WTQ) + (size_t)layer * 2048 * DM + (size_t)(hp * 128 + 32 * mt + 4 * hl) * DM + k0 + 32 * nt + l31;
#pragma unroll
            for (int r = 0; r < 16; ++r) dst[(size_t)((r & 3) + 8 * (r >> 2)) * DM] = (bf16_t)f2bf(acc[r] * g2);
        }
        __syncthreads();
    }
    if (PARTS & 4) {
        const int lane = tid & 63, wave = tid >> 6;
        float* scl = (float*)(p.ws + OFF_PSC);
        for (int row = obid() * NWAVE + wave; row < 2 * NLAYER * 16384; row += NBLK * NWAVE) {
            const int tb = row >> 15, r = row & 32767;
            const f32x4* src = (const f32x4*)(p.in[tb ? I_PV : I_PU] + (size_t)r * DM) + lane;
            f32x4 v[4]; float mx = 0.f;
#pragma unroll
            for (int j = 0; j < 4; ++j) { v[j] = __builtin_nontemporal_load(src + 64 * j); mx = fmaxf(mx, fmaxf(fmaxf(fabsf(v[j].x), fabsf(v[j].y)), fmaxf(fabsf(v[j].z), fabsf(v[j].w)))); }
            mx = wave_max(mx);
            const float sc = mx > 0.f ? 224.0f / mx : 1.0f;
            u32x4 o;
            { int w = 0; w = __builtin_amdgcn_cvt_pk_fp8_f32(v[0].x * sc, v[0].y * sc, w, false); w = __builtin_amdgcn_cvt_pk_fp8_f32(v[0].z * sc, v[0].w * sc, w, true); o.x = (unsigned)w; }
            { int w = 0; w = __builtin_amdgcn_cvt_pk_fp8_f32(v[1].x * sc, v[1].y * sc, w, false); w = __builtin_amdgcn_cvt_pk_fp8_f32(v[1].z * sc, v[1].w * sc, w, true); o.y = (unsigned)w; }
            { int w = 0; w = __builtin_amdgcn_cvt_pk_fp8_f32(v[2].x * sc, v[2].y * sc, w, false); w = __builtin_amdgcn_cvt_pk_fp8_f32(v[2].z * sc, v[2].w * sc, w, true); o.z = (unsigned)w; }
            { int w = 0; w = __builtin_amdgcn_cvt_pk_fp8_f32(v[3].x * sc, v[3].y * sc, w, false); w = __builtin_amdgcn_cvt_pk_fp8_f32(v[3].z * sc, v[3].w * sc, w, true); o.w = (unsigned)w; }
            *(u32x4*)(p.ws + (tb ? OFF_PV : OFF_PU) + (size_t)r * DM + lane * 16) = o;
            if (lane == 0) scl[row] = mx > 0.f ? mx / 224.0f : 1.0f;
        }
    }
    if (PARTS & 8) {
        float* sh = (float*)lds;
        float* zl = sh + 64 * 64;
        const int sub = tid >> 6, j = tid & 63;
        for (int it0 = obid() * 64; it0 < NLAYER * SL; it0 += NBLK * 64) {
            const int layer = it0 / SL;
            __syncthreads();
            for (int o = tid; o < 64 * 17; o += NTHR) {
                const int item = o / 17, f = o % 17;
                const float t = (float)((it0 + item) % SL) / (float)(SL - 1);
                float z;
                if (f == 0) z = t;
                else if (f <= 8) z = sinf(2.0f * 3.14159265358979323846f * t * (float)f);
                else z = cosf(2.0f * 3.14159265358979323846f * t * (float)(f - 8));
                zl[o] = z;
            }
            __syncthreads();
            {
                const float* w1 = p.in[I_W1] + layer * 17 * 64;
                float wv[17];
#pragma unroll
                for (int i = 0; i < 17; ++i) wv[i] = w1[i * 64 + j];
                const float b1 = p.in[I_B1][layer * 64 + j], f1 = p.in[I_F1][layer * 64 + j];
#pragma unroll
                for (int r = 0; r < 8; ++r) {
                    const int item = sub * 8 + r;
                    float a = b1;
#pragma unroll
                    for (int i = 0; i < 17; ++i) a += zl[item * 17 + i] * wv[i];
                    sh[item * 64 + j] = sinf(f1 * a);
                }
            }
            __syncthreads();
            {
                const float* w2 = p.in[I_W2] + layer * 64 * 64;
                const float b2 = p.in[I_B2][layer * 64 + j], f2 = p.in[I_F2][layer * 64 + j];
                float acc[8];
#pragma unroll
                for (int r = 0; r < 8; ++r) acc[r] = b2;
#pragma unroll 8
                for (int k = 0; k < 64; ++k) {
                    const float w = w2[k * 64 + j];
#pragma unroll
                    for (int r = 0; r < 8; ++r) acc[r] += sh[(sub * 8 + r) * 64 + k] * w;
                }
#pragma unroll
                for (int r = 0; r < 8; ++r)
                    ((bf16_t*)(p.ws + OFF_H2))[((size_t)(it0 + sub * 8 + r)) * 64 + j] = (bf16_t)f2bf(sinf(f2 * acc[r]));
            }
        }
        __syncthreads();
    }
    if (PARTS & 16) {
        float* ctab = (float*)lds;
        __syncthreads();
        if (tid < 64) ctab[tid] = cosf((float)tid * (2.0f * 3.14159265358979323846f / 64.0f));
        __syncthreads();
        const int total = NLAYER * 4 * 128 * 64;
        for (int o = obid() * NTHR + tid; o < total; o += NBLK * NTHR) {
            const int e2 = o & 63, dd = (o >> 6) & 127, g = (o >> 13) & 3, layer = o >> 15;
            const int d = dd & 63, sh = (dd < 64) ? 0 : 48;
            const float* w = p.in[I_FW] + ((size_t)(layer * 4 + g) * 64) * 64;
            float acc = 0.f;
#pragma unroll 8
            for (int e = 0; e < 64; ++e) acc += ctab[(d * e + sh) & 63] * w[e * 64 + e2];
            ((float*)(p.ws + OFF_FM))[o] = acc * (1.0f / 724.0773439350246f);
        }
        __syncthreads();
    }
}

__device__ __forceinline__ int zp(int i) { return i + 2 * (i >> 5); }
__device__ constexpr float FC32[16] = {1.000000000f, 0.980785280f, 0.923879533f, 0.831469612f, 0.707106781f, 0.555570233f, 0.382683432f, 0.195090322f, 0.000000000f, -0.195090322f, -0.382683432f, -0.555570233f, -0.707106781f, -0.831469612f, -0.923879533f, -0.980785280f};
__device__ constexpr float FS32[16] = {0.000000000f, 0.195090322f, 0.382683432f, 0.555570233f, 0.707106781f, 0.831469612f, 0.923879533f, 0.980785280f, 1.000000000f, 0.980785280f, 0.923879533f, 0.831469612f, 0.707106781f, 0.555570233f, 0.382683432f, 0.195090322f};
__device__ __forceinline__ float2 cmulf(float2 a, float2 b) { return make_float2(a.x * b.x - a.y * b.y, a.x * b.y + a.y * b.x); }
template <int R> __device__ __forceinline__ constexpr int brevR(int x) { int r = 0; for (int b = 1, t = R >> 1; t >= 1; b <<= 1, t >>= 1) if (x & b) r |= t; return r; }
template <int R> __device__ __forceinline__ void dft_fwd_regs(float2 (&x)[R]) {
#pragma unroll
    for (int half = R / 2; half >= 1; half >>= 1) {
#pragma unroll
        for (int blk = 0; blk < R; blk += 2 * half)
#pragma unroll
            for (int k = 0; k < half; ++k) {
                const float2 a = x[blk + k], b = x[blk + k + half];
                x[blk + k] = make_float2(a.x + b.x, a.y + b.y);
                const float2 d = make_float2(a.x - b.x, a.y - b.y);
                const int ti = k * (16 / half);
                if (ti == 0) x[blk + k + half] = d;
                else if (ti == 8) x[blk + k + half] = make_float2(d.y, -d.x);
                else { const float c = FC32[ti], sn = FS32[ti]; x[blk + k + half] = make_float2(d.x * c + d.y * sn, d.y * c - d.x * sn); }
            }
    }
}
template <int R> __device__ __forceinline__ void dft_inv_regs(float2 (&x)[R]) {
#pragma unroll
    for (int half = 1; half <= R / 2; half <<= 1) {
#pragma unroll
        for (int blk = 0; blk < R; blk += 2 * half)
#pragma unroll
            for (int k = 0; k < half; ++k) {
                const float2 a = x[blk + k], b0 = x[blk + k + half];
                const int ti = k * (16 / half);
                float2 b;
                if (ti == 0) b = b0;
                else if (ti == 8) b = make_float2(-b0.y, b0.x);
                else { const float c = FC32[ti], sn = FS32[ti]; b = make_float2(b0.x * c - b0.y * sn, b0.y * c + b0.x * sn); }
                x[blk + k] = make_float2(a.x + b.x, a.y + b.y);
                x[blk + k + half] = make_float2(a.x - b.x, a.y - b.y);
            }
    }
}
template <int R> __device__ __forceinline__ void apply_tw(float2 (&x)[R], float c, float sg) {
    const float2 w1 = make_float2(c, sg), w2 = cmulf(w1, w1);
    float2 po = w1, pe = w2;
#pragma unroll
    for (int m = 1; m < R; m += 2) {
        x[brevR<R>(m)] = cmulf(x[brevR<R>(m)], po);
        if (m + 1 < R) x[brevR<R>(m + 1)] = cmulf(x[brevR<R>(m + 1)], pe);
        if (m + 2 < R) { po = cmulf(po, w2); pe = cmulf(pe, w2); }
    }
}
template <int R, bool INV> __device__ __forceinline__ void fft_group(float2* Z, int pbase, int PS, float ang) {
    float2 x[R];
    if (!INV) {
#pragma unroll
        for (int m = 0; m < R; ++m) x[m] = Z[pbase + PS * m];
        dft_fwd_regs<R>(x);
        apply_tw<R>(x, __builtin_amdgcn_cosf(ang), -__builtin_amdgcn_sinf(ang));
#pragma unroll
        for (int m = 0; m < R; ++m) Z[pbase + PS * m] = x[brevR<R>(m)];
    } else {
#pragma unroll
        for (int m = 0; m < R; ++m) x[brevR<R>(m)] = Z[pbase + PS * m];
        apply_tw<R>(x, __builtin_amdgcn_cosf(ang), __builtin_amdgcn_sinf(ang));
        dft_inv_regs<R>(x);
#pragma unroll
        for (int m = 0; m < R; ++m) Z[pbase + PS * m] = x[m];
    }
}
template <bool INV> __device__ __forceinline__ void fft_group32_contig(float2* Z, int pbase) {
    float2 x[32];
    if (!INV) {
#pragma unroll
        for (int m = 0; m < 32; m += 2) { const f32x4 v = *(const f32x4*)(Z + pbase + m); x[m] = make_float2(v.x, v.y); x[m + 1] = make_float2(v.z, v.w); }
        dft_fwd_regs<32>(x);
#pragma unroll
        for (int m = 0; m < 32; m += 2) { const float2 a = x[brevR<32>(m)], b = x[brevR<32>(m + 1)]; *(f32x4*)(Z + pbase + m) = (f32x4){a.x, a.y, b.x, b.y}; }
    } else {
#pragma unroll
        for (int m = 0; m < 32; m += 2) { const f32x4 v = *(const f32x4*)(Z + pbase + m); x[brevR<32>(m)] = make_float2(v.x, v.y); x[brevR<32>(m + 1)] = make_float2(v.z, v.w); }
        dft_inv_regs<32>(x);
#pragma unroll
        for (int m = 0; m < 32; m += 2) *(f32x4*)(Z + pbase + m) = (f32x4){x[m].x, x[m].y, x[m + 1].x, x[m + 1].y};
    }
}
__device__ __forceinline__ void fft16k_fwd(float2* Z) {
    const int tid = otid();
#pragma unroll 1
    for (int g = 0; g < 2; ++g) { const int j = tid + 512 * g; fft_group<16, false>(Z, zp(j), 1088, (float)j * (1.0f / 16384.0f)); }
    __syncthreads();
    { const int blk = tid >> 5, j = tid & 31; fft_group<32, false>(Z, blk * 1088 + j, 34, (float)j * (1.0f / 1024.0f)); }
    __syncthreads();
    fft_group32_contig<false>(Z, 34 * tid);
    __syncthreads();
}
__device__ __forceinline__ void fft16k_inv(float2* Z) {
    const int tid = otid();
    fft_group32_contig<true>(Z, 34 * tid);
    __syncthreads();
    { const int blk = tid >> 5, j = tid & 31; fft_group<32, true>(Z, blk * 1088 + j, 34, (float)j * (1.0f / 1024.0f)); }
    __syncthreads();
#pragma unroll 1
    for (int g = 0; g < 2; ++g) { const int j = tid + 512 * g; fft_group<16, true>(Z, zp(j), 1088, (float)j * (1.0f / 16384.0f)); }
    __syncthreads();
}
__device__ __forceinline__ void fft8k_fwd(float2* Z) {
    const int tid = otid();
    fft_group<16, false>(Z, zp(tid), 544, (float)tid * (1.0f / 8192.0f));
    __syncthreads();
    { const int blk = tid >> 5, j = tid & 31; fft_group<16, false>(Z, blk * 544 + j, 34, (float)j * (1.0f / 512.0f)); }
    __syncthreads();
    if (tid < 256) fft_group32_contig<false>(Z, 34 * tid);
    __syncthreads();
}
__device__ __forceinline__ int f16k_of_p(int p) { return (p >> 10) + 16 * ((p >> 5) & 31) + 512 * (p & 31); }
__device__ __forceinline__ int p16k_of_f(int f) { return 1024 * (f & 15) + 32 * ((f >> 4) & 31) + (f >> 9); }
__device__ __forceinline__ int p8k_of_f(int f) { return 512 * (f & 15) + 32 * ((f >> 4) & 15) + (f >> 8); }

__device__ __forceinline__ void phase_filter_spectra(const Params& p, char* lds) {
    const int tid = otid(), lane = tid & 63, wave = tid >> 6;
    float2* Z = (float2*)lds;
    float* red = (float*)(lds + 139264 + 64);
    for (int job = obid(); job < NLAYER * 256; job += NBLK) {
        const int layer = job >> 8, c = job & 255;
        __syncthreads();
        const float* HFc = (const float*)(p.ws + (layer ? OFF_HFILT1 : OFF_HFILT0)) + (size_t)c * SL;
        const float r_lo = 4.605170185988092f / 1.5f, r_hi = 4.605170185988092f / 0.3f;
        const float rate = r_lo + (r_hi - r_lo) * ((float)c / 255.0f);
        float ss0 = 0.f, ss1 = 0.f;
#pragma unroll 1
        for (int i = 0; i < 4; ++i) {
            const int l0 = 4 * tid + 2048 * i;
            const f32x4 a0 = *(const f32x4*)(HFc + l0), a1 = *(const f32x4*)(HFc + (size_t)256 * SL + l0);
            const f32x4 a2 = *(const f32x4*)(HFc + (size_t)512 * SL + l0), a3 = *(const f32x4*)(HFc + (size_t)768 * SL + l0);
#pragma unroll
            for (int e = 0; e < 4; ++e) {
                const int l = l0 + e;
                const float t = (float)l / (float)(SL - 1);
                const float dec = expf(-t * rate);
                const float f0 = a0[e] * dec, b0 = a1[e] * dec, f1 = a2[e] * dec, b1 = a3[e] * dec;
                ss0 += f0 * f0 + b0 * b0; ss1 += f1 * f1 + b1 * b1;
                Z[zp(l)] = make_float2(f0, f1);
                if (l >= 1) Z[zp(16384 - l)] = make_float2(b0, b1);
            }
        }
        if (tid == 0) Z[zp(8192)] = make_float2(0.f, 0.f);
        ss0 = wave_sum(ss0); ss1 = wave_sum(ss1);
        if (lane == 0) { red[wave * 2] = ss0; red[wave * 2 + 1] = ss1; }
        __syncthreads();
        float t0 = 0.f, t1 = 0.f;
#pragma unroll
        for (int w = 0; w < 8; ++w) { t0 += red[w * 2]; t1 += red[w * 2 + 1]; }
        const float sc0 = rsqrtf(t0 + EPS) * (1.0f / 16384.0f) * 0.5f, sc1 = rsqrtf(t1 + EPS) * (1.0f / 16384.0f) * 0.5f;
        fft16k_fwd(Z);
        float2* KF0 = (float2*)(p.ws + OFF_KF) + ((size_t)(layer * 256 + c) * 2) * 16384;
        float2* KF1 = KF0 + 16384;
        for (int i = 0; i < 32; ++i) {
            const int pp = tid + NTHR * i;
            const int fq = f16k_of_p(pp);
            const int pq = p16k_of_f((16384 - fq) & 16383);
            const float2 za = Z[zp(pp)], zq = Z[zp(pq)];
            KF0[pp] = make_float2((za.x + zq.x) * sc0, (za.y - zq.y) * sc0);
            KF1[pp] = make_float2((za.y + zq.y) * sc1, (zq.x - za.x) * sc1);
        }
    }
}

__device__ __forceinline__ void phase_rmsnorm_bf16(const float* x, const float* g, bf16_t* out) {
    const int lane = otid() & 63, wave = otid() >> 6;
    const int gw = obid() * NWAVE + wave, ngw = NBLK * NWAVE;
    for (int row = gw; row < T; row += ngw) {
        const f32x4* xr = (const f32x4*)(x + (size_t)row * DM) + lane;
        f32x4 v[4]; float ss = 0.f;
#pragma unroll
        for (int j = 0; j < 4; ++j) { v[j] = xr[64 * j]; ss += v[j].x * v[j].x + v[j].y * v[j].y + v[j].z * v[j].z + v[j].w * v[j].w; }
        ss = wave_sum(ss);
        const float r = rsqrtf(ss * (1.0f / DM) + EPS);
        u32x2* o = (u32x2*)(out + (size_t)row * DM) + lane;
#pragma unroll
        for (int j = 0; j < 4; ++j) {
            const f32x4 gg = ((const f32x4*)g)[lane + 64 * j];
            u32x2 w; w.x = pk2(v[j].x * r * gg.x, v[j].y * r * gg.y); w.y = pk2(v[j].z * r * gg.z, v[j].w * r * gg.w);
            o[64 * j] = w;
        }
    }
}

constexpr int G_LDA = 144;
template <class Epi>
__device__ __forceinline__ void gemm_simple(const bf16_t* A, const bf16_t* Bt, int M, int N, int K, char* lds, const Epi& epi) {
    const int tid = otid(), lane = tid & 63, wave = tid >> 6;
    const int wm = wave >> 1, wn = wave & 1;
    const int nMt = M / 256, nNt = N / 128, total = nMt * nNt, nk = K / 64;
    char* As = lds; char* Bs = lds + 256 * G_LDA;
    const int l31 = lane & 31, hl = lane >> 5;
    for (int u = obid(); u < total; u += NBLK) {
        const int mt = u % nMt, nt = u / nMt;
        f32x16 acc[2][2];
#pragma unroll
        for (int i = 0; i < 2; ++i)
#pragma unroll
            for (int j = 0; j < 2; ++j) acc[i][j] = zero16();
        u32x4 ra[4], rb[2];
        const bf16_t* Ab = A + (size_t)(mt * 256) * K;
        const bf16_t* Bb = Bt + (size_t)(nt * 128) * K;
#pragma unroll
        for (int i = 0; i < 4; ++i) { const int id = tid + NTHR * i, row = id >> 3, ch = id & 7; ra[i] = *(const u32x4*)(Ab + (size_t)row * K + ch * 8); }
#pragma unroll
        for (int i = 0; i < 2; ++i) { const int id = tid + NTHR * i, row = id >> 3, ch = id & 7; rb[i] = *(const u32x4*)(Bb + (size_t)row * K + ch * 8); }
        for (int kt = 0; kt < nk; ++kt) {
            __syncthreads();
#pragma unroll
            for (int i = 0; i < 4; ++i) { const int id = tid + NTHR * i, row = id >> 3, ch = id & 7; *(u32x4*)(As + row * G_LDA + ch * 16) = ra[i]; }
#pragma unroll
            for (int i = 0; i < 2; ++i) { const int id = tid + NTHR * i, row = id >> 3, ch = id & 7; *(u32x4*)(Bs + row * G_LDA + ch * 16) = rb[i]; }
            __syncthreads();
            if (kt + 1 < nk) {
                const int ko = (kt + 1) * 64;
#pragma unroll
                for (int i = 0; i < 4; ++i) { const int id = tid + NTHR * i, row = id >> 3, ch = id & 7; ra[i] = *(const u32x4*)(Ab + (size_t)row * K + ko + ch * 8); }
#pragma unroll
                for (int i = 0; i < 2; ++i) { const int id = tid + NTHR * i, row = id >> 3, ch = id & 7; rb[i] = *(const u32x4*)(Bb + (size_t)row * K + ko + ch * 8); }
            }
#pragma unroll
            for (int ks = 0; ks < 4; ++ks) {
                bf16x8 a[2], b[2];
#pragma unroll
                for (int i = 0; i < 2; ++i) a[i] = *(const bf16x8*)(As + (wm * 64 + i * 32 + l31) * G_LDA + ks * 32 + hl * 16);
#pragma unroll
                for (int j = 0; j < 2; ++j) b[j] = *(const bf16x8*)(Bs + (wn * 64 + j * 32 + l31) * G_LDA + ks * 32 + hl * 16);
#pragma unroll
                for (int i = 0; i < 2; ++i)
#pragma unroll
                    for (int j = 0; j < 2; ++j) acc[i][j] = mfma32(a[i], b[j], acc[i][j]);
            }
        }
#pragma unroll
        for (int i = 0; i < 2; ++i)
#pragma unroll
            for (int j = 0; j < 2; ++j) epi(acc[i][j], mt * 256 + wm * 64 + i * 32, nt * 128 + wn * 64 + j * 32, lane);
    }
}

struct EpiF32 {
    float* out; int ld;
    __device__ __forceinline__ void operator()(const f32x16& acc, int row0, int col0, int lane) const {
        const int c = col0 + (lane & 31), h = lane >> 5;
#pragma unroll
        for (int r = 0; r < 16; ++r) { out[(size_t)(row0 + (r & 3) + 8 * (r >> 2) + 4 * h) * ld + c] = acc[r]; }
    }
};

namespace pg8 {
#define PG8_LAS __attribute__((address_space(3)))
constexpr int BM = 256, BK = 64, HALF = 128, HTB = HALF * BK * 2  , STAGE_BYTES = 8 * HTB, NXCD = 8, WGM = 8;

__host__ __device__ __forceinline__ int lds_byte(int r, int c) { const int st = (r >> 4) * 2 + (c >> 5), rr = r & 15, cc = c & 31, ob = rr * 64 + cc * 2; return st * 1024 + (ob ^ (((ob >> 9) & 1) << 5)); }
__host__ __device__ __forceinline__ void stage_rc(int b, int& R, int& C) { const int st = b / 1024, sb = b % 1024, swz = sb ^ (((sb >> 9) & 1) << 5); R = (st >> 1) * 16 + swz / 64; C = (st & 1) * 32 + (swz % 64) / 2; }
__host__ __device__ __forceinline__ int perm32(int rho) { const int n = rho >> 4, i = rho & 15; return 8 * (i >> 2) + 4 * n + (i & 3); }

struct Unit { int pm, pn; };
struct Gemm { const bf16_t* A; const bf16_t* Bt; int M, N, K; };

struct StaticOrder {
    int nM, nN, nwg, G, c;
    __host__ __device__ void init(int M, int N, int G_, int c_) { nM = M / BM; nN = N / BM; nwg = nM * nN; G = G_; c = c_; }
    __host__ __device__ bool next(int i, Unit& u) const {
        const long L = (long)i * G + c; if (L >= nwg) return false;
        int wgid = (int)L; { const int q = nwg / NXCD, r = nwg % NXCD, xcd = wgid % NXCD, off = wgid / NXCD; wgid = (xcd < r ? xcd * (q + 1) : r * (q + 1) + (xcd - r) * q) + off; }
        const int nig = WGM * nN, gid = wgid / nig, fm = gid * WGM, gsz = (nM - fm) < WGM ? (nM - fm) : WGM;
        u.pm = fm + ((wgid % nig) % gsz); u.pn = (wgid % nig) / gsz; return true;
    }
    __device__ __forceinline__ void a_ready(const Unit&) const {}
    __device__ __forceinline__ void done(const Unit&) const {}
};


__device__ __forceinline__ unsigned cvt_pk_bf16(float lo, float hi) { unsigned r; asm volatile("v_cvt_pk_bf16_f32 %0, %1, %2" : "=v"(r) : "v"(lo), "v"(hi)); return r; }
struct EpiStoreBf16 {
    static constexpr bool PERM = true, AFTER_DRAIN = false;
    bf16_t* O; int ldc;
    __device__ __forceinline__ void operator()(const f32x4 (&acc)[2][2][4][2], const Unit& u, int wr, int wc, int fr, int fq) const {
        const int row0 = u.pm * BM + wr * 64 + fr, col0 = u.pn * BM + wc * 32 + 8 * fq;
#pragma unroll
        for (int ai = 0; ai < 2; ++ai)
#pragma unroll
            for (int m = 0; m < 4; ++m) { bf16_t* rowp = O + (size_t)(row0 + ai * HALF + m * 16) * ldc + col0;
#pragma unroll
                for (int bj = 0; bj < 2; ++bj) { const f32x4 v0 = acc[ai][bj][m][0], v1 = acc[ai][bj][m][1];
                    u32x4 w; w.x = cvt_pk_bf16(v0[0], v0[1]); w.y = cvt_pk_bf16(v0[2], v0[3]); w.z = cvt_pk_bf16(v1[0], v1[1]); w.w = cvt_pk_bf16(v1[2], v1[3]);
                    *(u32x4*)(rowp + bj * HALF) = w; } }
    }
};
struct EpiOutProj {
    static constexpr bool PERM = false, AFTER_DRAIN = false;
    const float* base; float* O; bf16_t* XB; float* RS;
    __device__ __forceinline__ void operator()(const f32x4 (&acc)[2][2][4][2], const Unit& u, int wr, int wc, int fr, int fq) const {
        const int row0 = u.pm * BM + wr * 64 + fr, col0 = u.pn * BM + wc * 32 + 4 * fq;
#pragma unroll
        for (int ai = 0; ai < 2; ++ai)
#pragma unroll
            for (int m = 0; m < 4; ++m) { const int row = row0 + ai * HALF + m * 16; const size_t off = (size_t)row * 1024 + col0; float ss = 0.f;
#pragma unroll
                for (int bj = 0; bj < 2; ++bj)
#pragma unroll
                    for (int n = 0; n < 2; ++n) { const f32x4 v = acc[ai][bj][m][n] + *(const f32x4*)(base + off + bj * HALF + n * 16);
                        *(f32x4*)(O + off + bj * HALF + n * 16) = v; ss += v[0] * v[0] + v[1] * v[1] + v[2] * v[2] + v[3] * v[3];
                        u32x2 w; w.x = cvt_pk_bf16(v[0], v[1]); w.y = cvt_pk_bf16(v[2], v[3]); *(u32x2*)(XB + off + bj * HALF + n * 16) = w; }
                ss += __shfl_xor(ss, 16); ss += __shfl_xor(ss, 32);
                if (fq == 0) RS[(size_t)row * 16 + u.pn * 4 + wc] = ss; }
    }
};
struct EpiRowScaleF32 {
    static constexpr bool PERM = false, AFTER_DRAIN = false;
    float* O; int ldc; const float* RS;
    __device__ __forceinline__ void operator()(const f32x4 (&acc)[2][2][4][2], const Unit& u, int wr, int wc, int fr, int fq) const {
        const int row0 = u.pm * BM + wr * 64 + fr, col0 = u.pn * BM + wc * 32 + 4 * fq;
#pragma unroll
        for (int ai = 0; ai < 2; ++ai)
#pragma unroll
            for (int m = 0; m < 4; ++m) { const int row = row0 + ai * HALF + m * 16; const size_t off = (size_t)row * ldc + col0;
                float tot = 0.f;
#pragma unroll
                for (int q = 0; q < 4; ++q) { const f32x4 pr = *(const f32x4*)(RS + (size_t)row * 16 + 4 * q); tot += (pr[0] + pr[1]) + (pr[2] + pr[3]); }
                const float r = rsqrtf(tot * (1.0f / 1024.0f) + 1e-6f);
#pragma unroll
                for (int bj = 0; bj < 2; ++bj)
#pragma unroll
                    for (int n = 0; n < 2; ++n) *(f32x4*)(O + off + bj * HALF + n * 16) = acc[ai][bj][m][n] * r; }
    }
};
struct EpiStoreF32 {
    static constexpr bool PERM = false, AFTER_DRAIN = false;
    const float* base; float* O; int ldc;
    __device__ __forceinline__ void operator()(const f32x4 (&acc)[2][2][4][2], const Unit& u, int wr, int wc, int fr, int fq) const {
        const int row0 = u.pm * BM + wr * 64 + fr, col0 = u.pn * BM + wc * 32 + 4 * fq;
#pragma unroll
        for (int ai = 0; ai < 2; ++ai)
#pragma unroll
            for (int m = 0; m < 4; ++m) { const size_t off = (size_t)(row0 + ai * HALF + m * 16) * ldc + col0;
#pragma unroll
                for (int bj = 0; bj < 2; ++bj)
#pragma unroll
                    for (int n = 0; n < 2; ++n) { f32x4 v = acc[ai][bj][m][n]; if (base) v += *(const f32x4*)(base + off + bj * HALF + n * 16); *(f32x4*)(O + off + bj * HALF + n * 16) = v; } }
    }
};

template <class Epi, class Sched, bool ALIGN_EPI = false, bool SP2 = false>
__device__ __forceinline__ void gemm_phase(PG8_LAS unsigned char* lds, const Gemm g, const Sched& S, const Epi& E) {
    const int tid = otid(), wid = __builtin_amdgcn_readfirstlane(tid >> 6), lane = tid & 63, wr = wid >> 2, wc = wid & 3, fr = lane & 15, fq = lane >> 4;
    const int K = g.K, nt = K / BK;
    unsigned voffA[2], voffB[2];
#pragma unroll
    for (int i = 0; i < 2; ++i) { int R, C; stage_rc(tid * 16 + i * 8192, R, C); const int Rb = Epi::PERM ? ((R & ~31) + perm32(R & 31)) : R;
        voffA[i] = (unsigned)(R * K + C) * 2u; voffB[i] = (unsigned)(Rb * K + C) * 2u; }
    const size_t kstep = (size_t)(BK * 2);
    const size_t hstep = (size_t)HALF * K * 2;
    const size_t tstep = 2 * hstep;
    const unsigned ldsw = (unsigned)wid * 1024u;
    const int aoff = lds_byte(wr * 64 + fr, fq * 8), boff = lds_byte(wc * 32 + fr, fq * 8);
#define PG8_SA(b, h) (((b) * 2 + (h)) * HTB)
#define PG8_SB(b, h) ((4 + (b) * 2 + (h)) * HTB)
#define PG8_STAGE(bufoff, gbase, voff) do { _Pragma("unroll") for (int _i = 0; _i < 2; ++_i) \
        __builtin_amdgcn_global_load_lds((const unsigned*)((const char*)(gbase) + (voff)[_i]), (PG8_LAS unsigned*)(lds + (bufoff) + ldsw + _i * 8192), 16, 0, 0); } while (0)
#define PG8_LDA(dst, b, h) do { _Pragma("unroll") for (int m = 0; m < 4; ++m) _Pragma("unroll") for (int k = 0; k < 2; ++k) dst[m][k] = *(const PG8_LAS bf16x8*)(lds + PG8_SA(b, h) + aoff + m * 2048 + k * 1024); } while (0)
#define PG8_LDB(dst, b, h) do { _Pragma("unroll") for (int n = 0; n < 2; ++n) _Pragma("unroll") for (int k = 0; k < 2; ++k) dst[n][k] = *(const PG8_LAS bf16x8*)(lds + PG8_SB(b, h) + boff + n * 2048 + k * 1024); } while (0)
#define PG8_MMA(ai, bj, At, Bt) do { __builtin_amdgcn_s_setprio(1); _Pragma("unroll") for (int m = 0; m < 4; ++m) _Pragma("unroll") for (int n = 0; n < 2; ++n) _Pragma("unroll") for (int k = 0; k < 2; ++k) \
        acc[ai][bj][m][n] = __builtin_amdgcn_mfma_f32_16x16x32_bf16(Bt[n][k], At[m][k], acc[ai][bj][m][n], 0, 0, 0); __builtin_amdgcn_s_setprio(0); } while (0)
#define PG8_WAIT_V(n) asm volatile("s_waitcnt vmcnt(" #n ")" ::: "memory")
#define PG8_WAIT_L(n) asm volatile("s_waitcnt lgkmcnt(" #n ")" ::: "memory")
#define PG8_BAR __builtin_amdgcn_s_barrier()
#define PG8_SCHED __builtin_amdgcn_sched_barrier(0)
    Unit cur, nxt; int ui = 0;
    if (!S.next(0, cur)) return;
    f32x4 acc[2][2][4][2];
#pragma unroll
    for (int a = 0; a < 2; ++a)
#pragma unroll
        for (int b = 0; b < 2; ++b)
#pragma unroll
            for (int m = 0; m < 4; ++m)
#pragma unroll
                for (int n = 0; n < 2; ++n) acc[a][b][m][n] = (f32x4){0.f, 0.f, 0.f, 0.f};
    bf16x8 At[4][2], B0[2][2], B1[2][2];
    const char* cA = (const char*)g.A + (size_t)cur.pm * tstep; const char* cB = (const char*)g.Bt + (size_t)cur.pn * tstep;
    S.a_ready(cur);
    if constexpr (SP2) {
        PG8_STAGE(PG8_SB(0, 0), cB, voffB); PG8_STAGE(PG8_SB(0, 1), cB + hstep, voffB); PG8_STAGE(PG8_SA(0, 0), cA, voffA); PG8_STAGE(PG8_SA(0, 1), cA + hstep, voffA);
        if (wr == 1) PG8_BAR;
        PG8_WAIT_V(2); PG8_BAR;
        PG8_STAGE(PG8_SB(1, 0), cB + kstep, voffB); PG8_STAGE(PG8_SA(1, 0), cA + kstep, voffA); PG8_STAGE(PG8_SB(1, 1), cB + hstep + kstep, voffB);
        PG8_WAIT_V(6); PG8_BAR;
    } else {
        PG8_STAGE(PG8_SB(0, 0), cB, voffB); PG8_STAGE(PG8_SA(0, 0), cA, voffA); PG8_STAGE(PG8_SB(0, 1), cB + hstep, voffB); PG8_STAGE(PG8_SA(0, 1), cA + hstep, voffA);
        if (wr == 1) PG8_BAR;
        PG8_WAIT_V(4); PG8_BAR;
        PG8_STAGE(PG8_SB(1, 0), cB + kstep, voffB); PG8_STAGE(PG8_SA(1, 0), cA + kstep, voffA); PG8_STAGE(PG8_SB(1, 1), cB + hstep + kstep, voffB);
        PG8_WAIT_V(6); PG8_BAR;
    }
    for (;;) {
        const bool has_next = S.next(ui + 1, nxt);
        const char* nA = has_next ? (const char*)g.A + (size_t)nxt.pm * tstep : cA; const char* nB = has_next ? (const char*)g.Bt + (size_t)nxt.pn * tstep : cB;
        for (int t = 0; t < nt; t += 2) {
            const bool last = (t == nt - 2);
            const char* a1 = cA + (size_t)(t + 1) * kstep;
            const char* a2 = last ? nA : cA + (size_t)(t + 2) * kstep; const char* b2 = last ? nB : cB + (size_t)(t + 2) * kstep;
            const char* a3 = a2 + kstep; const char* b3 = b2 + kstep;
            if (last && has_next) S.a_ready(nxt);
            if constexpr (SP2) {
            PG8_LDB(B0, 0, 0); PG8_LDB(B1, 0, 1); PG8_SCHED; PG8_LDA(At, 0, 0); PG8_STAGE(PG8_SA(1, 1), a1 + hstep, voffA);
            PG8_WAIT_V(8); PG8_WAIT_L(0); PG8_BAR; PG8_MMA(0, 0, At, B0); PG8_MMA(0, 1, At, B1); PG8_BAR; PG8_SCHED;
            PG8_LDA(At, 0, 1); PG8_STAGE(PG8_SB(0, 0), b2, voffB); PG8_STAGE(PG8_SB(0, 1), b2 + hstep, voffB); PG8_STAGE(PG8_SA(0, 0), a2, voffA);
            PG8_WAIT_V(8); PG8_WAIT_L(0); PG8_BAR; PG8_MMA(1, 0, At, B0); PG8_MMA(1, 1, At, B1); PG8_BAR; PG8_SCHED;
            PG8_LDB(B0, 1, 0); PG8_LDB(B1, 1, 1); PG8_SCHED; PG8_LDA(At, 1, 0); PG8_STAGE(PG8_SA(0, 1), a2 + hstep, voffA);
            PG8_WAIT_V(8); PG8_WAIT_L(0); PG8_BAR; PG8_MMA(0, 0, At, B0); PG8_MMA(0, 1, At, B1); PG8_BAR; PG8_SCHED;
            PG8_LDA(At, 1, 1); PG8_STAGE(PG8_SB(1, 0), b3, voffB); PG8_STAGE(PG8_SB(1, 1), b3 + hstep, voffB); PG8_STAGE(PG8_SA(1, 0), a3, voffA);
            PG8_WAIT_V(8); PG8_WAIT_L(0); PG8_BAR; PG8_MMA(1, 0, At, B0); PG8_MMA(1, 1, At, B1); PG8_BAR; PG8_SCHED;
            } else {
            PG8_LDB(B0, 0, 0); PG8_SCHED; PG8_LDA(At, 0, 0); PG8_STAGE(PG8_SA(1, 1), a1 + hstep, voffA);
            PG8_WAIT_L(8); PG8_BAR; PG8_WAIT_L(0); PG8_MMA(0, 0, At, B0); PG8_BAR; PG8_SCHED;
            PG8_LDB(B1, 0, 1); PG8_STAGE(PG8_SB(0, 0), b2, voffB);
            PG8_BAR; PG8_WAIT_L(0); PG8_MMA(0, 1, At, B1); PG8_BAR;
            PG8_LDA(At, 0, 1); PG8_STAGE(PG8_SA(0, 0), a2, voffA);
            PG8_BAR; PG8_WAIT_L(0); PG8_MMA(1, 0, At, B0); PG8_BAR; PG8_SCHED;
            PG8_STAGE(PG8_SB(0, 1), b2 + hstep, voffB);
            PG8_WAIT_V(6); PG8_BAR; PG8_MMA(1, 1, At, B1); PG8_BAR;
            PG8_LDB(B0, 1, 0); PG8_SCHED; PG8_LDA(At, 1, 0); PG8_STAGE(PG8_SA(0, 1), a2 + hstep, voffA);
            PG8_WAIT_L(8); PG8_BAR; PG8_WAIT_L(0); PG8_MMA(0, 0, At, B0); PG8_BAR; PG8_SCHED;
            PG8_LDB(B1, 1, 1); PG8_STAGE(PG8_SB(1, 0), b3, voffB);
            PG8_BAR; PG8_WAIT_L(0); PG8_MMA(0, 1, At, B1); PG8_BAR;
            PG8_LDA(At, 1, 1); PG8_STAGE(PG8_SA(1, 0), a3, voffA);
            PG8_BAR; PG8_WAIT_L(0); PG8_MMA(1, 0, At, B0); PG8_BAR; PG8_SCHED;
            PG8_STAGE(PG8_SB(1, 1), b3 + hstep, voffB);
            PG8_WAIT_V(6); PG8_BAR; PG8_MMA(1, 1, At, B1); PG8_BAR;
            }
        }
        if constexpr (ALIGN_EPI) { if (wr == 0) PG8_BAR; }
        if constexpr (!Epi::AFTER_DRAIN) { E(acc, cur, wr, wc, fr, fq); S.done(cur); }
        if (!has_next) break;
#pragma unroll
        for (int a = 0; a < 2; ++a)
#pragma unroll
            for (int b = 0; b < 2; ++b)
#pragma unroll
                for (int m = 0; m < 4; ++m)
#pragma unroll
                    for (int n = 0; n < 2; ++n) acc[a][b][m][n] = (f32x4){0.f, 0.f, 0.f, 0.f};
        cur = nxt; cA = nA; cB = nB; ++ui;
        if constexpr (ALIGN_EPI) { if (wr == 1) PG8_BAR; }
    }
    PG8_WAIT_V(0);
    if constexpr (!ALIGN_EPI) { if (wr == 0) PG8_BAR; }
    PG8_BAR;
    if constexpr (Epi::AFTER_DRAIN) { E.fused(acc, cur, wr, wc, fr, fq, lds, wid, lane); S.done(cur); }
#undef PG8_SA
#undef PG8_SB
#undef PG8_STAGE
#undef PG8_LDA
#undef PG8_LDB
#undef PG8_MMA
#undef PG8_WAIT_V
#undef PG8_WAIT_L
#undef PG8_BAR
#undef PG8_SCHED
}
}

__device__ constexpr float ROPE_INV_REV[16] = {1.591549431e-01f, 8.949940161e-02f, 5.032921210e-02f, 2.830219583e-02f, 1.591549431e-02f, 8.949940161e-03f, 5.032921210e-03f, 2.830219583e-03f, 1.591549431e-03f, 8.949940161e-04f, 5.032921210e-04f, 2.830219583e-04f, 1.591549431e-04f, 8.949940161e-05f, 5.032921210e-05f, 2.830219583e-05f};
__device__ __forceinline__ void qk_norm_rope8(const u32x4 raw, const float (&gn)[8], const float (&cs)[8], const float (&sn)[8], bool second, float scale, u32x4& out) {
    float x[8] = {bflo(raw.x), bfhi(raw.x), bflo(raw.y), bfhi(raw.y), bflo(raw.z), bfhi(raw.z), bflo(raw.w), bfhi(raw.w)};
    float ss = 0.f;
#pragma unroll
    for (int e = 0; e < 8; ++e) ss += x[e] * x[e];
    ss += __shfl_xor(ss, 1); ss += __shfl_xor(ss, 2); ss += __shfl_xor(ss, 4);
    const float r = rsqrtf(ss * (1.0f / 64.0f) + EPS) ;
    float o[8];
#pragma unroll
    for (int e = 0; e < 8; ++e) {
        const float y = x[e] * r * gn[e];
        const float other = __shfl_xor(y, 2);
        o[e] = (second ? (y * cs[e] + other * sn[e]) : (y * cs[e] - other * sn[e])) * scale;
    }
    out.x = pk2(o[0], o[1]); out.y = pk2(o[2], o[3]); out.z = pk2(o[4], o[5]); out.w = pk2(o[6], o[7]);
}
__device__ __forceinline__ void phase_qkprep(const Params& p, int layer, char* lds, bf16_t* qout) {
    const int tid = otid(), lane = tid & 63, wave = tid >> 6;
    const bf16_t* qkv = (const bf16_t*)(p.ws + R_QKV);
    const int sub = lane & 7;
    const bool second = ((sub >> 1) & 1) != 0, colaxis = (sub >> 2) != 0;
    float gq[8], gk[8], ir[8];
#pragma unroll
    for (int e = 0; e < 8; ++e) {
        gq[e] = p.in[I_QG][layer * 64 + sub * 8 + e]; gk[e] = p.in[I_KG][layer * 64 + sub * 8 + e];
        ir[e] = (sub & 1) ? ROPE_INV_REV[8 + e] : ROPE_INV_REV[e];
    }
    const int gw = obid() * NWAVE + wave, ngw = NBLK * NWAVE;
    for (int t = gw; t < T; t += ngw) {
        const int l = t & (SL - 1);
        const float pos = colaxis ? (float)(l & 63) : (float)(l >> 6);
        float cs[8], sn[8];
#pragma unroll
        for (int e = 0; e < 8; ++e) { const float a = pos * ir[e]; cs[e] = __builtin_amdgcn_cosf(a); sn[e] = __builtin_amdgcn_sinf(a); }
        const u32x4 rq = *(const u32x4*)(qkv + (size_t)t * 768 + lane * 8);
        u32x4 rk = {0u, 0u, 0u, 0u};
        if (lane < 16) rk = *(const u32x4*)(qkv + (size_t)t * 768 + 512 + lane * 8);
        u32x4 oq, ok;
        qk_norm_rope8(rq, gq, cs, sn, second, 0.125f * 1.4426950408889634f, oq);
        qk_norm_rope8(rk, gk, cs, sn, second, 1.0f, ok);
        *(u32x4*)(qout + (size_t)t * 768 + lane * 8) = oq;
        if (lane < 16) *(u32x4*)(qout + (size_t)t * 768 + 512 + lane * 8) = ok;
    }
}

#include <hip/hip_bf16.h>
#include <cmath>
namespace attn_body {
using bf16=__hip_bfloat16;
using bf16x8=__attribute__((ext_vector_type(8)))short;
using s16x4=__attribute__((ext_vector_type(4)))short;
using f32x16=__attribute__((ext_vector_type(16)))float;
using u32x4=__attribute__((ext_vector_type(4)))unsigned;
constexpr int SEQ=8192,D=64,PQ=768,PO=512;
constexpr int NW=8,QBLK=32,QB=QBLK*NW,KVBLK=64,NQB=SEQ/QB;
constexpr int ATTN_UNIT_ROWS=QB;
__device__ __forceinline__ int crow(int r,int hi){return (r&3)+8*(r>>2)+4*hi;}
#define SBAR() __builtin_amdgcn_sched_barrier(0)
__device__ __forceinline__ void cmask(f32x16&p0,f32x16&p1,int jb,int qrel,int hi){
  const float NEG=-INFINITY; int kb=64*jb+4*hi;
  #pragma unroll
  for(int r=0;r<16;++r){int kv=kb+(r&3)+8*(r>>2); if(kv>qrel)p0[r]=NEG; if(kv+32>qrel)p1[r]=NEG;}
}

constexpr int NSLOT=3, SLOTB=8192;
constexpr int LDS_K=0, LDS_V=NSLOT*SLOTB, LDS_WS=2*NSLOT*SLOTB, LDS_OST=LDS_WS+NW*64*4, LDS_BYTES=LDS_OST+NW*4096;
constexpr float C2=0.125f*1.4426950408889634f;
__device__ __forceinline__ void glds16(const void*gsrc,unsigned lds_dst){unsigned keep;
  asm volatile("s_mov_b32 %0, m0\n\ts_mov_b32 m0, %2\n\ts_nop 0\n\tglobal_load_lds_dwordx4 %1, off\n\ts_mov_b32 m0, %0":"=&s"(keep):"v"(gsrc),"s"(lds_dst):"memory");}
__device__ __forceinline__ float max3f(float a,float b,float c){float r;asm("v_max3_f32 %0, %1, %2, %3":"=v"(r):"v"(a),"v"(b),"v"(c));return r;}
__device__ __forceinline__ float max2f(float a,float b){float r;asm("v_max_f32_e32 %0, %1, %2":"=v"(r):"v"(a),"v"(b));return r;}
__device__ __forceinline__ float fadd_s(float a,float b){float r;asm("v_add_f32_e32 %0, %1, %2":"=v"(r):"v"(a),"v"(b));return r;}
__device__ __forceinline__ float fsub_s(float a,float b){float r;asm("v_sub_f32_e32 %0, %1, %2":"=v"(r):"v"(a),"v"(b));return r;}
typedef float f32x2_t __attribute__((ext_vector_type(2))); typedef __bf16 bf16x2_t __attribute__((ext_vector_type(2)));
__device__ __forceinline__ unsigned cvtpk_s(float lo,float hi){f32x2_t v={lo,hi};bf16x2_t b=__builtin_convertvector(v,bf16x2_t);return __builtin_bit_cast(unsigned,b);}
#define WAIT_BAR(N) asm volatile("s_waitcnt vmcnt(" #N ") lgkmcnt(0)\n\ts_barrier":::"memory")

__device__ __forceinline__ void qkt(f32x16&p0,f32x16&p1,const char*Kslot,const bf16x8*qr,const f32x16&negm,int r32,int hi){
  const char*kb=Kslot+hi*1024+r32*16;
  #pragma unroll
  for(int d0=0;d0<4;++d0){
    const bf16x8 b0=*reinterpret_cast<const bf16x8*>(kb+d0*2048);
    const bf16x8 b1=*reinterpret_cast<const bf16x8*>(kb+d0*2048+512);
    if(d0==0){p0=__builtin_amdgcn_mfma_f32_32x32x16_bf16(b0,qr[0],negm,0,0,0);p1=__builtin_amdgcn_mfma_f32_32x32x16_bf16(b1,qr[0],negm,0,0,0);}
    else{p0=__builtin_amdgcn_mfma_f32_32x32x16_bf16(b0,qr[d0],p0,0,0,0);p1=__builtin_amdgcn_mfma_f32_32x32x16_bf16(b1,qr[d0],p1,0,0,0);}}
}
typedef __attribute__((address_space(3))) const char* lds_cptr;
typedef short v4i16_t __attribute__((ext_vector_type(4)));
__device__ __forceinline__ void kload8(bf16x8*kf,lds_cptr kp){
  kf[0]=*(const __attribute__((address_space(3))) bf16x8*)(kp);      kf[1]=*(const __attribute__((address_space(3))) bf16x8*)(kp+512);
  kf[2]=*(const __attribute__((address_space(3))) bf16x8*)(kp+2048); kf[3]=*(const __attribute__((address_space(3))) bf16x8*)(kp+2560);
  kf[4]=*(const __attribute__((address_space(3))) bf16x8*)(kp+4096); kf[5]=*(const __attribute__((address_space(3))) bf16x8*)(kp+4608);
  kf[6]=*(const __attribute__((address_space(3))) bf16x8*)(kp+6144); kf[7]=*(const __attribute__((address_space(3))) bf16x8*)(kp+6656);
}
__device__ __forceinline__ void kload2(bf16x8*kf,lds_cptr kp,int j){ kf[2*j]=*(const __attribute__((address_space(3))) bf16x8*)(kp+j*2048); kf[2*j+1]=*(const __attribute__((address_space(3))) bf16x8*)(kp+j*2048+512); }
__device__ __forceinline__ s16x4 vtr(lds_cptr p){ return __builtin_bit_cast(s16x4,__builtin_amdgcn_ds_read_tr16_b64_v4i16((__attribute__((address_space(3))) v4i16_t*)p)); }
__device__ __forceinline__ float rowmax(const f32x16&p0,const f32x16&p1){
  float a=max3f(p0[0],p0[1],p1[0]),b=max3f(p0[2],p0[3],p1[1]);a=max3f(a,p1[2],p1[3]);
  #pragma unroll
  for(int r=4;r<16;r+=4){a=max3f(a,p0[r],p0[r+1]);b=max3f(b,p0[r+2],p0[r+3]);a=max3f(a,p1[r],p1[r+1]);b=max3f(b,p1[r+2],p1[r+3]);}
  const float m=max2f(a,b);
  auto rr=__builtin_amdgcn_permlane32_swap(__float_as_uint(m),__float_as_uint(m),false,false);
  return max2f(__uint_as_float(rr[0]),__uint_as_float(rr[1]));
}
__device__ __forceinline__ void pv(f32x16*o,int vb,bf16x8 pa0,bf16x8 pa1,bf16x8 pa2,bf16x8 pa3){
  #pragma unroll
  for(int d0=0;d0<2;++d0){s16x4 lo[4],hi[4];
    #pragma unroll
    for(int ks=0;ks<4;++ks){
      asm volatile("ds_read_b64_tr_b16 %0,%1 offset:%c2":"=&v"(lo[ks]):"v"(vb),"i"(d0*4096+ks*1024):"memory");
      asm volatile("ds_read_b64_tr_b16 %0,%1 offset:%c2":"=&v"(hi[ks]):"v"(vb),"i"(d0*4096+ks*1024+512):"memory");}
    asm volatile("s_waitcnt lgkmcnt(0)":::"memory");SBAR();
    #define PK(k) (bf16x8){lo[k][0],lo[k][1],lo[k][2],lo[k][3],hi[k][0],hi[k][1],hi[k][2],hi[k][3]}
    o[d0]=__builtin_amdgcn_mfma_f32_32x32x16_bf16(pa0,PK(0),o[d0],0,0,0);
    o[d0]=__builtin_amdgcn_mfma_f32_32x32x16_bf16(pa1,PK(1),o[d0],0,0,0);
    o[d0]=__builtin_amdgcn_mfma_f32_32x32x16_bf16(pa2,PK(2),o[d0],0,0,0);
    o[d0]=__builtin_amdgcn_mfma_f32_32x32x16_bf16(pa3,PK(3),o[d0],0,0,0);
    #undef PK
  }
}

#ifndef ATTN_STORE16
#define ATTN_STORE16(p,v) (*(u32x4*)(p)=(v))
#endif
template<int THRL> __device__ __forceinline__ void attn_unit(int b,int h,int g,int qb,const bf16*Q,const bf16*__restrict__ K,const bf16*__restrict__ V,bf16*O,char*shm){
  const int tid=otid(),lane=tid&63,r32=lane&31,hi=lane>>5; const int wid=__builtin_amdgcn_readfirstlane(tid>>6);
  const long rowbase=(long)b*SEQ; const int q0=qb*QB;
  const bf16*Qw=Q+(rowbase+q0+wid*QBLK)*PQ+h*D;
  const bf16*Kh=K+rowbase*PQ+g*D,*Vh=V+rowbase*PQ+g*D;
  const unsigned lds0=(unsigned)(uintptr_t)shm;
  float*wsf=(float*)(shm+LDS_WS)+wid*64;
  const bf16*ksrc=Kh+(long)lane*PQ+wid*8;
  const bf16*vsrc=Vh+(long)(16*(wid&3)+(lane>>2))*PQ+(wid>>2)*32+(lane&3)*8;
  const unsigned kdst=lds0+LDS_K+wid*1024, vdst=lds0+LDS_V+wid*1024;
  #define DMA_K(t,slot) glds16(ksrc+(long)(t)*KVBLK*PQ,(unsigned)__builtin_amdgcn_readfirstlane(kdst+(slot)))
  #define DMA_V(t,slot) glds16(vsrc+(long)(t)*KVBLK*PQ,(unsigned)__builtin_amdgcn_readfirstlane(vdst+(slot)))
  const int vb0=(int)(lds0+LDS_V)+((lane>>4)&1)*32+(lane&3)*8+(4*hi+((lane&15)>>2))*64;
  const char*Kbase=shm+LDS_K; bf16x8 kf[8];
  const lds_cptr shm3=(lds_cptr)shm; const lds_cptr kp0=shm3+LDS_K+hi*1024+r32*16; const lds_cptr vp0=shm3+LDS_V+((lane>>4)&1)*32+(lane&3)*8+(4*hi+((lane&15)>>2))*64;
  constexpr int NT=SEQ/KVBLK;
  DMA_K(0,0);DMA_V(0,0);DMA_K(1,SLOTB);
  bf16x8 qr[4];
  #pragma unroll
  for(int d0=0;d0<4;++d0)qr[d0]=*reinterpret_cast<const bf16x8*>(&Qw[(long)r32*PQ+d0*16+hi*8]);
  float mhat=0.f,l_reg=0.f;f32x16 o[2];o[0]=f32x16{};o[1]=f32x16{};f32x16 negm=f32x16{};asm volatile("":"+v"(negm));
    #define CMASK(P0,P1,t) do{}while(0)
  bool resc=false;
  #define START(P0,P1) do{ const float rm=rowmax(P0,P1); resc=false; \
    { const float dl=rm; mhat=fadd_s(mhat,dl); \
      _Pragma("unroll") for(int r=0;r<16;++r){P0[r]=fsub_s(P0[r],dl);P1[r]=fsub_s(P1[r],dl);} \
      _Pragma("unroll") for(int r=0;r<16;++r)negm[r]=-mhat; asm volatile("":"+v"(negm)); } \
    _Pragma("unroll") for(int r=0;r<16;++r)P0[r]=__builtin_amdgcn_exp2f(P0[r]); }while(0)
  #define RESC() do{ if(resc){ asm volatile("s_waitcnt lgkmcnt(0)":::"memory"); \
      _Pragma("unroll") for(int d_=0;d_<2;++d_) _Pragma("unroll") for(int r=0;r<16;++r)o[d_][r]*=wsf[crow(r,hi)]; } }while(0)
  f32x16 pA0,pA1,pB0,pB1;
  int sl_prev=0,sl_cur=0,sl_next=SLOTB;
  #define ROT() do{sl_prev=sl_cur;sl_cur=sl_next;sl_next=(sl_next==(NSLOT-1)*SLOTB)?0:sl_next+SLOTB;}while(0)
  DMA_K(2,2*SLOTB);
  WAIT_BAR(3);
  qkt(pA0,pA1,Kbase,qr,negm,r32,hi);asm volatile("s_nop 15\n\ts_nop 7":"+v"(pA0),"+v"(pA1));CMASK(pA0,pA1,0);
  START(pA0,pA1);
  _Pragma("unroll") for(int r=0;r<16;++r)pA1[r]=__builtin_amdgcn_exp2f(pA1[r]);
  WAIT_BAR(0);
  DMA_K(3,0);DMA_V(1,SLOTB);
  ROT();
  kload8(kf,kp0+sl_cur);
  WAIT_BAR(2);
  s16x4 vlo[8],vhi[8]; u32x4 pw0,pw1,pw2,pw3;
  #define PKW(P,B) cvtpk_s(P[B],P[B+1])
  #define PAF(k) __builtin_bit_cast(bf16x8,pw##k)
  #define VFR(i) (bf16x8){vlo[i][0],vlo[i][1],vlo[i][2],vlo[i][3],vhi[i][0],vhi[i][1],vhi[i][2],vhi[i][3]}
  #define PIN(x) asm volatile("":"+v"(x))
  #define MX3(a,b,c) __builtin_fmaxf(__builtin_fmaxf((a),(b)),(c))
  #define GAPA(MF,A0,A1,A2,A3,W0,W1,PW) do{ MF; sacc+=A0; sacc+=A1; sacc+=A2; sacc+=A3; PIN(sacc); W0; W1; PIN(PW); SBAR(); }while(0)
  #define EX(v) __builtin_amdgcn_exp2f(v)
  #define GAPB(MF,X,B) do{ MF; X[B]=EX(X[B]); X[B+1]=EX(X[B+1]); X[B+2]=EX(X[B+2]); X[B+3]=EX(X[B+3]); PIN(X); SBAR(); }while(0)
  #define VRD(i) do{ vlo[i]=vtr(vp_+(((i)>>2)*4096+((i)&3)*1024)); vhi[i]=vtr(vp_+(((i)>>2)*4096+((i)&3)*1024+512)); }while(0)
  #define KRD(G,j) do{ if(G){ kload2(kf,kp0+sl_next,j); SBAR(); } }while(0)
  #define STEP(C0,C1,P0,P1,t,GK,GV,GL) do{ SBAR(); \
    const lds_cptr vp_=vp0+sl_prev; \
    VRD(0); SBAR(); float sacc=(P0[0]+P0[1]); \
    GAPA(C0=__builtin_amdgcn_mfma_f32_32x32x16_bf16(kf[0],qr[0],negm,0,0,0), P0[2],P0[3],P0[4],P0[5],     pw0[0]=PKW(P0,0), pw0[1]=PKW(P0,2), pw0); \
    VRD(4); SBAR(); GAPA(C1=__builtin_amdgcn_mfma_f32_32x32x16_bf16(kf[1],qr[0],negm,0,0,0), P0[6],P0[7],P0[8],P0[9],     pw0[2]=PKW(P0,4), pw0[3]=PKW(P0,6), pw0); \
    VRD(1); SBAR(); GAPA(C0=__builtin_amdgcn_mfma_f32_32x32x16_bf16(kf[2],qr[1],C0,0,0,0),   P0[10],P0[11],P0[12],P0[13], pw1[0]=PKW(P0,8), pw1[1]=PKW(P0,10), pw1); \
    VRD(5); SBAR(); GAPA(C1=__builtin_amdgcn_mfma_f32_32x32x16_bf16(kf[3],qr[1],C1,0,0,0),   P0[14],P0[15],P1[0],P1[1],   pw1[2]=PKW(P0,12),pw1[3]=PKW(P0,14), pw1); \
    VRD(2); SBAR(); GAPA(C0=__builtin_amdgcn_mfma_f32_32x32x16_bf16(kf[4],qr[2],C0,0,0,0),   P1[2],P1[3],P1[4],P1[5],     pw2[0]=PKW(P1,0), pw2[1]=PKW(P1,2), pw2); \
    VRD(6); SBAR(); GAPA(C1=__builtin_amdgcn_mfma_f32_32x32x16_bf16(kf[5],qr[2],C1,0,0,0),   P1[6],P1[7],P1[8],P1[9],     pw2[2]=PKW(P1,4), pw2[3]=PKW(P1,6), pw2); \
    VRD(3); SBAR(); GAPA(C0=__builtin_amdgcn_mfma_f32_32x32x16_bf16(kf[6],qr[3],C0,0,0,0),   P1[10],P1[11],P1[12],P1[13], pw3[0]=PKW(P1,8), pw3[1]=PKW(P1,10), pw3); \
    VRD(7); SBAR(); GAPA(C1=__builtin_amdgcn_mfma_f32_32x32x16_bf16(kf[7],qr[3],C1,0,0,0),   P1[14],P1[15],0.f,0.f,       pw3[2]=PKW(P1,12),pw3[3]=PKW(P1,14), pw3); \
    l_reg+=sacc; \
    if(GK){DMA_K((t)+3,sl_cur);} if(GV){DMA_V((t)+1,sl_next);} \
    CMASK(C0,C1,t); \
    { float a=MX3(C0[0],C0[1],C1[0]),b=MX3(C0[2],C0[3],C1[1]); a=MX3(a,C1[2],C1[3]); \
      _Pragma("unroll") for(int r=4;r<16;r+=4){a=MX3(a,C0[r],C0[r+1]);b=MX3(b,C0[r+2],C0[r+3]);a=MX3(a,C1[r],C1[r+1]);b=MX3(b,C1[r+2],C1[r+3]);} \
      float rm=__builtin_fmaxf(a,b); { auto rr=__builtin_amdgcn_permlane32_swap(__float_as_uint(rm),__float_as_uint(rm),false,false); rm=__builtin_fmaxf(__uint_as_float(rr[0]),__uint_as_float(rr[1])); } \
      resc=false; \
      if(__builtin_expect(__any(rm>(float)THRL),0)){ const float dl=__builtin_fmaxf(rm,0.f); mhat+=dl; \
        _Pragma("unroll") for(int r=0;r<16;++r){C0[r]-=dl;C1[r]-=dl;} \
        _Pragma("unroll") for(int r=0;r<16;++r)negm[r]=-mhat; asm volatile("":"+v"(negm)); \
        const float f=__builtin_amdgcn_exp2f(-dl); l_reg*=f; if(hi==0)wsf[r32]=f; resc=true; } } \
    SBAR(); \
    GAPB(o[0]=__builtin_amdgcn_mfma_f32_32x32x16_bf16(PAF(0),VFR(0),o[0],0,0,0), C0,0); \
    GAPB(o[1]=__builtin_amdgcn_mfma_f32_32x32x16_bf16(PAF(0),VFR(4),o[1],0,0,0), C0,4); \
    KRD(GL,0); GAPB(o[0]=__builtin_amdgcn_mfma_f32_32x32x16_bf16(PAF(1),VFR(1),o[0],0,0,0), C0,8); \
    KRD(GL,1); GAPB(o[1]=__builtin_amdgcn_mfma_f32_32x32x16_bf16(PAF(1),VFR(5),o[1],0,0,0), C0,12); \
    KRD(GL,2); GAPB(o[0]=__builtin_amdgcn_mfma_f32_32x32x16_bf16(PAF(2),VFR(2),o[0],0,0,0), C1,0); \
    KRD(GL,3); GAPB(o[1]=__builtin_amdgcn_mfma_f32_32x32x16_bf16(PAF(2),VFR(6),o[1],0,0,0), C1,4); \
    GAPB(o[0]=__builtin_amdgcn_mfma_f32_32x32x16_bf16(PAF(3),VFR(3),o[0],0,0,0), C1,8); \
    GAPB(o[1]=__builtin_amdgcn_mfma_f32_32x32x16_bf16(PAF(3),VFR(7),o[1],0,0,0), C1,12); \
    }while(0)
  int t=1;
  #undef CMASK
  #define CMASK(P0,P1,t) do{}while(0)
  for(;t+5<NT;t+=2){
    STEP(pB0,pB1,pA0,pA1,t,true,true,true);     WAIT_BAR(2); RESC(); ROT();
    STEP(pA0,pA1,pB0,pB1,t+1,true,true,true);   WAIT_BAR(2); RESC(); ROT();
  }
  #define ENDW(tt) do{ if((tt)+3<NT){WAIT_BAR(2);} else if((tt)+2<NT){WAIT_BAR(1);} else {WAIT_BAR(0);} }while(0)
  for(;t+1<NT;t+=2){
    STEP(pB0,pB1,pA0,pA1,t,(t+3<NT),(t+1<NT),(t+1<NT));       ENDW(t);   RESC(); ROT();
    STEP(pA0,pA1,pB0,pB1,t+1,(t+4<NT),(t+2<NT),(t+2<NT));     ENDW(t+1); RESC(); ROT();
  }
  STEP(pB0,pB1,pA0,pA1,NT-1,false,false,false); RESC();
  { float sacc=pB0[0]+pB0[1]; _Pragma("unroll") for(int r=2;r<16;++r)sacc+=pB0[r]; _Pragma("unroll") for(int r=0;r<16;++r)sacc+=pB1[r]; l_reg+=sacc;
    pw0=(u32x4){PKW(pB0,0),PKW(pB0,2),PKW(pB0,4),PKW(pB0,6)};pw1=(u32x4){PKW(pB0,8),PKW(pB0,10),PKW(pB0,12),PKW(pB0,14)};pw2=(u32x4){PKW(pB1,0),PKW(pB1,2),PKW(pB1,4),PKW(pB1,6)};pw3=(u32x4){PKW(pB1,8),PKW(pB1,10),PKW(pB1,12),PKW(pB1,14)};
    SBAR(); pv(o,vb0+sl_cur,PAF(0),PAF(1),PAF(2),PAF(3)); }
  #undef PKW
  #undef PAF
  #undef VFR
  #undef PIN
  #undef MX3
  #undef GAPA
  #undef GAPB
  #undef EX
  #undef VRD
  #undef KRD
  #undef STEP
  #undef ENDW
  {auto rr=__builtin_amdgcn_permlane32_swap(__float_as_uint(l_reg),__float_as_uint(l_reg),false,false);l_reg=__uint_as_float(rr[0])+__uint_as_float(rr[1]);}
  if(hi==0)wsf[32+r32]=l_reg;asm volatile("s_waitcnt lgkmcnt(0)":::"memory");
  float rli[16];
  #pragma unroll
  for(int r=0;r<16;++r)rli[r]=__builtin_amdgcn_rcpf(wsf[32+crow(r,hi)]);
  bf16*Ow=O+(rowbase+q0+wid*QBLK)*PO+h*D;
  { bf16*stg=(bf16*)(shm+LDS_OST)+wid*2048;
    #pragma unroll
    for(int r=0;r<16;++r){const int orow=crow(r,hi);
      #pragma unroll
      for(int d0=0;d0<2;++d0)stg[orow*64+d0*32+r32]=__float2bfloat16(o[d0][r]*rli[r]);}
    asm volatile("s_waitcnt lgkmcnt(0)":::"memory");
    #pragma unroll
    for(int i=0;i<4;++i){const int row=i*8+(lane>>3),ch=lane&7; const u32x4 v=*(const u32x4*)(stg+row*64+ch*8); ATTN_STORE16(Ow+(long)row*PO+ch*8,v);} }
  asm volatile("s_waitcnt lgkmcnt(0)\n\ts_barrier":::"memory");
  #undef DMA_K
  #undef DMA_V
  #undef CMASK
  #undef START
  #undef RESC
  #undef ROT
}
constexpr int ATTN_LDS_BYTES=LDS_BYTES;
#undef SBAR
#undef WAIT_BAR
}

__device__ __forceinline__ void phase_attn(const Params& p, char* lds) {
            {
                const int bid = obid();
                const int vcu = ((NBLK & 7) == 0) ? (bid & 7) * (int)(NBLK >> 3) + (bid >> 3) : bid;
                const attn_body::bf16* qkvb = (const attn_body::bf16*)(p.ws + R_QKV);
                for (int u = vcu; u < 512; u += NBLK) {
                    const int bg = (u & 255) >> 6, r = u & 63, hh = r & 3, qb = (r >> 2) + 16 * (u >> 8);
                    const int b = bg >> 1, g = bg & 1;
                    attn_body::attn_unit<8>(b, 4 * g + hh, g, qb, qkvb, qkvb + 512, qkvb + 640, (attn_body::bf16*)(p.ws + R_ATT), lds);
                }
            }
}

__device__ __forceinline__ size_t cidx(int c, int t) { return ((size_t)(t >> 5) * 256 + c) * 32 + (t & 31); }
__device__ __forceinline__ f32x4 convd4(const float* row, int l0, float w0, float w1, float w2, float cb) {
    const f32x4 c = *(const f32x4*)(row + l0);
    const float lft = (l0 > 0) ? row[l0 - 1] : 0.f;
    const float rgt = (l0 + 4 < SL) ? row[l0 + 4] : 0.f;
    f32x4 o;
    o.x = cb + w0 * lft + w1 * c.x + w2 * c.y;
    o.y = cb + w0 * c.x + w1 * c.y + w2 * c.z;
    o.z = cb + w0 * c.y + w1 * c.z + w2 * c.w;
    o.w = cb + w0 * c.z + w1 * c.w + w2 * rgt;
    return o;
}
__device__ __forceinline__ void cmul_kf(float2* Z, const float2* KF, int tid) {
#pragma unroll 4
    for (int i = 0; i < 16; ++i) {
        const int pp = 2 * tid + 1024 * i;
        const f32x4 z = *(const f32x4*)(Z + zp(pp)), k = *(const f32x4*)(KF + pp);
        f32x4 o; o.x = z.x * k.x - z.y * k.y; o.y = z.x * k.y + z.y * k.x; o.z = z.z * k.z - z.w * k.w; o.w = z.z * k.w + z.w * k.z;
        *(f32x4*)(Z + zp(pp)) = o;
    }
}
__device__ __forceinline__ void hyena_job(const Params& p, int layer, int c, char* lds) {
    const int tid = otid();
    float2* Z = (float2*)lds;
    const float* HF = (const float*)(p.ws + R_HF);
    const float* cw = p.in[I_CW] + (size_t)layer * 3 * 768; const float* cbp = p.in[I_CB] + layer * 768;
    const float2* KF0 = (const float2*)(p.ws + OFF_KF) + ((size_t)(layer * 256 + c) * 2) * 16384;
    const float2* KF1 = KF0 + 16384;
    float* Yb = (float*)(p.ws + R_Y);
    const float bias0 = p.in[I_HB][(layer * 2 + 0) * 256 + c], bias1 = p.in[I_HB][(layer * 2 + 1) * 256 + c];
    const int cv = c, c1 = 256 + c, c2 = 512 + c;
    const float* rv = HF + (size_t)cv * T; const float* r1 = HF + (size_t)c1 * T; const float* r2 = HF + (size_t)c2 * T;
    const float v_w0 = cw[cv], v_w1 = cw[768 + cv], v_w2 = cw[1536 + cv], v_cb = cbp[cv];
    const float a_w0 = cw[c1], a_w1 = cw[768 + c1], a_w2 = cw[1536 + c1], a_cb = cbp[c1];
    const float b_w0 = cw[c2], b_w1 = cw[768 + c2], b_w2 = cw[1536 + c2], b_cb = cbp[c2];
    const f32x4 zero4 = {0.f, 0.f, 0.f, 0.f};
    __syncthreads();
#pragma unroll 1
    for (int i = 0; i < 4; ++i) {
        const int l0 = 4 * otid() + 2048 * i;
        const f32x4 va = convd4(rv, l0, v_w0, v_w1, v_w2, v_cb), vb = convd4(rv + SL, l0, v_w0, v_w1, v_w2, v_cb);
        *(f32x4*)(Z + zp(l0)) = (f32x4){va.x, vb.x, va.y, vb.y}; *(f32x4*)(Z + zp(l0) + 2) = (f32x4){va.z, vb.z, va.w, vb.w};
        *(f32x4*)(Z + zp(8192 + l0)) = zero4; *(f32x4*)(Z + zp(8192 + l0) + 2) = zero4;
    }
    __syncthreads();
    fft16k_fwd(Z);
    cmul_kf(Z, KF0, otid());
    __syncthreads();
    fft16k_inv(Z);
#pragma unroll 1
    for (int i = 0; i < 4; ++i) {
        const int l0 = 4 * otid() + 2048 * i;
        const f32x4 za = *(const f32x4*)(Z + zp(l0)), zb = *(const f32x4*)(Z + zp(l0) + 2);
        const f32x4 va = convd4(rv, l0, v_w0, v_w1, v_w2, v_cb), vb = convd4(rv + SL, l0, v_w0, v_w1, v_w2, v_cb);
        const f32x4 ga = convd4(r1, l0, a_w0, a_w1, a_w2, a_cb), gb = convd4(r1 + SL, l0, a_w0, a_w1, a_w2, a_cb);
        f32x4 ya, yb;
        ya.x = ga.x * (za.x + va.x * bias0); ya.y = ga.y * (za.z + va.y * bias0); ya.z = ga.z * (zb.x + va.z * bias0); ya.w = ga.w * (zb.z + va.w * bias0);
        yb.x = gb.x * (za.y + vb.x * bias0); yb.y = gb.y * (za.w + vb.y * bias0); yb.z = gb.z * (zb.y + vb.z * bias0); yb.w = gb.w * (zb.w + vb.w * bias0);
        *(f32x4*)(Yb + cidx(c, l0)) = ya; *(f32x4*)(Yb + cidx(c, SL + l0)) = yb;
        *(f32x4*)(Z + zp(l0)) = (f32x4){ya.x, yb.x, ya.y, yb.y}; *(f32x4*)(Z + zp(l0) + 2) = (f32x4){ya.z, yb.z, ya.w, yb.w};
        *(f32x4*)(Z + zp(8192 + l0)) = zero4; *(f32x4*)(Z + zp(8192 + l0) + 2) = zero4;
    }
    __syncthreads();
    fft16k_fwd(Z);
    cmul_kf(Z, KF1, otid());
    __syncthreads();
    fft16k_inv(Z);
#pragma unroll 1
    for (int i = 0; i < 4; ++i) {
        const int l0 = 4 * otid() + 2048 * i;
        const f32x4 za = *(const f32x4*)(Z + zp(l0)), zb = *(const f32x4*)(Z + zp(l0) + 2);
        const f32x4 ga = convd4(r2, l0, b_w0, b_w1, b_w2, b_cb), gb = convd4(r2 + SL, l0, b_w0, b_w1, b_w2, b_cb);
        const f32x4 pa = *(const f32x4*)(Yb + cidx(c, l0)), pb = *(const f32x4*)(Yb + cidx(c, SL + l0));
        f32x4 ya, yb;
        ya.x = ga.x * (za.x + pa.x * bias1); ya.y = ga.y * (za.z + pa.y * bias1); ya.z = ga.z * (zb.x + pa.z * bias1); ya.w = ga.w * (zb.z + pa.w * bias1);
        yb.x = gb.x * (za.y + pb.x * bias1); yb.y = gb.y * (za.w + pb.y * bias1); yb.z = gb.z * (zb.y + pb.z * bias1); yb.w = gb.w * (zb.w + pb.w * bias1);
        *(f32x4*)(Yb + cidx(c, l0)) = ya; *(f32x4*)(Yb + cidx(c, SL + l0)) = yb;
    }
    __syncthreads();
}

__device__ __forceinline__ void fnet_job(const Params& p, int ch, char* lds) {
    const int tid = otid();
    float2* Z = (float2*)lds;
    const float* row = (const float*)(p.ws + R_HF) + (size_t)(768 + ch) * T;
    float* UR = (float*)(p.ws + R_UR);
    float* UI = (float*)(p.ws + R_UI);
    __syncthreads();
#pragma unroll
    for (int i = 0; i < 4; ++i) {
        const int l0 = 4 * tid + 2048 * i;
        const f32x4 a = *(const f32x4*)(row + l0), b = *(const f32x4*)(row + SL + l0);
        const int z0 = zp(l0);
        *(f32x4*)(Z + z0) = (f32x4){a.x, b.x, a.y, b.y}; *(f32x4*)(Z + z0 + 2) = (f32x4){a.z, b.z, a.w, b.w};
    }
    __syncthreads();
    fft8k_fwd(Z);
#pragma unroll
    for (int i = 0; i < 4; ++i) {
        const int k0 = 4 * tid + 2048 * i;
        f32x4 ur0, ui0, ur1, ui1;
#pragma unroll
        for (int e = 0; e < 4; ++e) {
            const int k = k0 + e;
            const int pk = p8k_of_f(k);
            const int pm = p8k_of_f((SL - k) & (SL - 1));
            const float2 zk = Z[zp(pk)], zm = Z[zp(pm)];
            ur0[e] = 0.5f * (zk.x + zm.x); ui0[e] = 0.5f * (zk.y - zm.y);
            ur1[e] = 0.5f * (zk.y + zm.y); ui1[e] = 0.5f * (zm.x - zk.x);
        }
        *(f32x4*)(UR + cidx(ch, k0)) = ur0; *(f32x4*)(UI + cidx(ch, k0)) = ui0; *(f32x4*)(UR + cidx(ch, SL + k0)) = ur1; *(f32x4*)(UI + cidx(ch, SL + k0)) = ui1;
    }
    __syncthreads();
}

__device__ __forceinline__ void phase_mix(const Params& p, int layer, char* lds) {
    const int tid = otid(), lane = tid & 63, wave = tid >> 6;
    const int l31 = lane & 31, hl = lane >> 5, g = wave & 3, tsel = wave >> 2;
    float* ex = (float*)lds;
    float* FMl = (float*)(lds + 8192);
    const float* UR = (const float*)(p.ws + R_UR); const float* UI = (const float*)(p.ws + R_UI);
    const float* Y = (const float*)(p.ws + R_Y);
    const bf16_t* att = (const bf16_t*)(p.ws + R_ATT);
    bf16_t* mix = (bf16_t*)(p.ws + R_MIX);
    const float* fb = p.in[I_FB] + layer * 256 + g * 64;
    const float* mg = p.in[I_MG] + layer * 1024;
    __syncthreads();
    {
        const f32x4* src = (const f32x4*)((const float*)(p.ws + OFF_FM) + (size_t)layer * 4 * 128 * 64);
#pragma unroll 4
        for (int i = 0; i < 16; ++i) *(f32x4*)(FMl + 4 * (tid + NTHR * i)) = src[tid + NTHR * i];
    }
    for (int tp = obid(); tp < T / 64; tp += NBLK) {
        const int t = (tp * 2 + tsel) * 32 + l31;
        float bv[64];
        {
            const float* ub = UR + cidx(g * 64 + hl, t);
            const float* ub2 = UI + cidx(g * 64 + hl, t);
#pragma unroll
            for (int i = 0; i < 32; ++i) { bv[i] = ub[(2 * i) * 32]; bv[32 + i] = ub2[(2 * i) * 32]; }
        }
        float yv[32];
        {
            const float* yb = Y + cidx(g * 64 + hl * 32, t);
#pragma unroll
            for (int i = 0; i < 32; ++i) yv[i] = yb[i * 32];
        }
        const bf16_t* ab = att + (size_t)t * 512 + g * 128 + hl * 64;
        float sa = 0.f;
#pragma unroll
        for (int q = 0; q < 8; ++q) {
            const u32x4 a = *(const u32x4*)(ab + 8 * q);
            const float x0 = bflo(a.x), x1 = bfhi(a.x), x2 = bflo(a.y), x3 = bfhi(a.y), x4 = bflo(a.z), x5 = bfhi(a.z), x6 = bflo(a.w), x7 = bfhi(a.w);
            sa += x0 * x0 + x1 * x1 + x2 * x2 + x3 * x3 + x4 * x4 + x5 * x5 + x6 * x6 + x7 * x7;
        }
        __syncthreads();
        f32x16 acc0 = zero16(), acc1 = zero16();
        {
            const float* fa = FMl + (g * 128 + hl) * 64 + l31;
#pragma unroll
            for (int i = 0; i < 64; ++i) {
                const float a0 = fa[(2 * i) * 64], a1 = fa[(2 * i) * 64 + 32];
                acc0 = __builtin_amdgcn_mfma_f32_32x32x2f32(a0, bv[i], acc0, 0, 0, 0);
                acc1 = __builtin_amdgcn_mfma_f32_32x32x2f32(a1, bv[i], acc1, 0, 0, 0);
            }
        }
        float sf = 0.f;
#pragma unroll
        for (int i = 0; i < 4; ++i) {
            const f32x4 b0 = *(const f32x4*)(fb + 8 * i + 4 * hl), b1 = *(const f32x4*)(fb + 32 + 8 * i + 4 * hl);
            acc0[4 * i] += b0.x; acc0[4 * i + 1] += b0.y; acc0[4 * i + 2] += b0.z; acc0[4 * i + 3] += b0.w;
            acc1[4 * i] += b1.x; acc1[4 * i + 1] += b1.y; acc1[4 * i + 2] += b1.z; acc1[4 * i + 3] += b1.w;
        }
#pragma unroll
        for (int r = 0; r < 16; ++r) sf += acc0[r] * acc0[r] + acc1[r] * acc1[r];
        float sy = 0.f;
#pragma unroll
        for (int i = 0; i < 32; ++i) sy += yv[i] * yv[i];
        ex[(0 * 8 + wave) * 64 + lane] = sa; ex[(1 * 8 + wave) * 64 + lane] = sy; ex[(2 * 8 + wave) * 64 + lane] = sf;
        __syncthreads();
        float ta = 0.f, ty = 0.f, tf = 0.f;
#pragma unroll
        for (int w = 0; w < 4; ++w)
#pragma unroll
            for (int hh = 0; hh < 2; ++hh) {
                const int o = (tsel * 4 + w) * 64 + hh * 32 + l31;
                ta += ex[0 * 512 + o]; ty += ex[1 * 512 + o]; tf += ex[2 * 512 + o];
            }
        const float ra = rsqrtf(ta * (1.0f / 512.0f) + EPS), ry = rsqrtf(ty * (1.0f / 256.0f) + EPS), rf = rsqrtf(tf * (1.0f / 256.0f) + EPS);
        bf16_t* mrow = mix + (size_t)t * 1024;
        {
            const float* gg = mg + g * 128 + hl * 64;
#pragma unroll
            for (int q = 0; q < 8; ++q) {
                const u32x4 a = *(const u32x4*)(ab + 8 * q);
                const f32x4 g0 = *(const f32x4*)(gg + 8 * q), g1 = *(const f32x4*)(gg + 8 * q + 4);
                u32x4 o;
                o.x = pk2(bflo(a.x) * ra * g0.x, bfhi(a.x) * ra * g0.y); o.y = pk2(bflo(a.y) * ra * g0.z, bfhi(a.y) * ra * g0.w);
                o.z = pk2(bflo(a.z) * ra * g1.x, bfhi(a.z) * ra * g1.y); o.w = pk2(bflo(a.w) * ra * g1.z, bfhi(a.w) * ra * g1.w);
                *(u32x4*)(mrow + g * 128 + hl * 64 + 8 * q) = o;
            }
        }
        {
            const float* gg = mg + 512 + g * 64 + hl * 32;
#pragma unroll
            for (int q = 0; q < 4; ++q) {
                const f32x4 g0 = *(const f32x4*)(gg + 8 * q), g1 = *(const f32x4*)(gg + 8 * q + 4);
                u32x4 o;
                o.x = pk2(yv[8 * q] * ry * g0.x, yv[8 * q + 1] * ry * g0.y); o.y = pk2(yv[8 * q + 2] * ry * g0.z, yv[8 * q + 3] * ry * g0.w);
                o.z = pk2(yv[8 * q + 4] * ry * g1.x, yv[8 * q + 5] * ry * g1.y); o.w = pk2(yv[8 * q + 6] * ry * g1.z, yv[8 * q + 7] * ry * g1.w);
                *(u32x4*)(mrow + 512 + g * 64 + hl * 32 + 8 * q) = o;
            }
        }
        {
            const float* gg = mg + 768 + g * 64;
#pragma unroll
            for (int i = 0; i < 4; ++i) {
                const f32x4 g0 = *(const f32x4*)(gg + 8 * i + 4 * hl), g1 = *(const f32x4*)(gg + 32 + 8 * i + 4 * hl);
                u32x2 o0, o1;
                o0.x = pk2(acc0[4 * i] * rf * g0.x, acc0[4 * i + 1] * rf * g0.y); o0.y = pk2(acc0[4 * i + 2] * rf * g0.z, acc0[4 * i + 3] * rf * g0.w);
                o1.x = pk2(acc1[4 * i] * rf * g1.x, acc1[4 * i + 1] * rf * g1.y); o1.y = pk2(acc1[4 * i + 2] * rf * g1.z, acc1[4 * i + 3] * rf * g1.w);
                *(u32x2*)(mrow + 768 + g * 64 + 8 * i + 4 * hl) = o0;
                *(u32x2*)(mrow + 768 + g * 64 + 32 + 8 * i + 4 * hl) = o1;
            }
        }
    }
}

__device__ __forceinline__ float tk_pack(float v, unsigned code, unsigned mask) { return __builtin_bit_cast(float, (__builtin_bit_cast(unsigned, v) & ~mask) | code); }
__device__ __forceinline__ unsigned tk_lookup(const unsigned (&P)[4], unsigned i) {
    const unsigned w = (i < 4u) ? P[0] : (i < 8u) ? P[1] : (i < 12u) ? P[2] : P[3];
    return (w >> ((i & 3u) * 8u)) & 0x7Fu;
}
__device__ __forceinline__ float gelu_exact(float x) { return 0.5f * x * (1.0f + erff(x * 0.70710678118654752f)); }
typedef float f32x2 __attribute__((ext_vector_type(2)));
#define CVT_LO(W) __builtin_amdgcn_cvt_pk_f32_fp8((int)(W), false)
#define CVT_HI(W) __builtin_amdgcn_cvt_pk_f32_fp8((int)(W), true)


__device__ __forceinline__ void tk_sort16(float (&a)[16]) {
#pragma unroll
    for (int k = 2; k <= 16; k <<= 1)
#pragma unroll
        for (int j = k >> 1; j > 0; j >>= 1)
#pragma unroll
            for (int i = 0; i < 16; ++i) {
                const int l = i ^ j;
                if (l > i) {
                    const float hi = fmaxf(a[i], a[l]), lo = fminf(a[i], a[l]);
                    if ((i & k) == 0) { a[i] = hi; a[l] = lo; } else { a[i] = lo; a[l] = hi; }
                }
            }
}
__device__ __forceinline__ void tk_merge16(float (&a)[16]) {
#pragma unroll
    for (int j = 8; j > 0; j >>= 1)
#pragma unroll
        for (int i = 0; i < 16; ++i) {
            const int l = i ^ j;
            if (l > i) { const float hi = fmaxf(a[i], a[l]), lo = fminf(a[i], a[l]); a[i] = hi; a[l] = lo; }
        }
}
__device__ __forceinline__ void tk_top16_merge(float (&l)[16], const float (&g)[16]) {
#pragma unroll
    for (int i = 0; i < 16; ++i) l[i] = fmaxf(l[i], g[15 - i]);
    tk_merge16(l);
}
template <int CTRL> __device__ __forceinline__ float dpp_f(float v) { return __builtin_bit_cast(float, __builtin_amdgcn_update_dpp(0, __builtin_bit_cast(int, v), CTRL, 0xF, 0xF, false)); }
constexpr int PE_LOGR = 4, PE_NR = 1 << PE_LOGR;
constexpr int PE_ENT = 12 * 1024;
constexpr int PE_WAVE = PE_ENT;


#define PE_RL(k) (((k & 4) << 1) | ((k & 2) << 3) | ((k & 1) << 5))
#define PE_LOAD_U(TK, RW, EV, CU, CG) do { \
        const int base_ = ((TK) * 128 + r * 8 + eid) * 3; \
        EV = ent[base_]; CU = __builtin_bit_cast(float, ent[base_ + 1]); CG = __builtin_bit_cast(float, ent[base_ + 2]); \
        _Pragma("unroll") for (int k = 0; k < 8; ++k) { const unsigned e = (unsigned)__builtin_amdgcn_readlane(EV, PE_RL(k)); \
            RW[k] = *(const u32x4*)(PU + (size_t)(e * 1024u) + loff); } \
    } while (0)
#define PE_COMP_U(TK, RW, CU, CG) do { \
        f32x2 xl[8]; \
        _Pragma("unroll") for (int j = 0; j < 4; ++j) { xl[2 * j] = (f32x2){bflo(xp[TK][j].x), bfhi(xp[TK][j].x)}; xl[2 * j + 1] = (f32x2){bflo(xp[TK][j].y), bfhi(xp[TK][j].y)}; } \
        float d[8]; \
        _Pragma("unroll") for (int k = 0; k < 8; ++k) { f32x2 s2 = CVT_LO(RW[k].x) * xl[0]; \
            s2 += CVT_HI(RW[k].x) * xl[1]; s2 += CVT_LO(RW[k].y) * xl[2]; s2 += CVT_HI(RW[k].y) * xl[3]; \
            s2 += CVT_LO(RW[k].z) * xl[4]; s2 += CVT_HI(RW[k].z) * xl[5]; s2 += CVT_LO(RW[k].w) * xl[6]; s2 += CVT_HI(RW[k].w) * xl[7]; \
            d[k] = s2.x + s2.y; } \
        _Pragma("unroll") for (int k = 0; k < 8; ++k) { d[k] += dpp_f<0xB1>(d[k]); d[k] += dpp_f<0x4E>(d[k]); d[k] += dpp_f<0x141>(d[k]); } \
        float r4[4], r2[2], u1; \
        _Pragma("unroll") for (int k = 0; k < 4; ++k) { const float send = b3 ? d[k] : d[k + 4], keep = b3 ? d[k + 4] : d[k]; r4[k] = keep + dpp_f<0x140>(send); } \
        _Pragma("unroll") for (int k = 0; k < 2; ++k) { const float send = b4 ? r4[k] : r4[k + 2], keep = b4 ? r4[k + 2] : r4[k]; r2[k] = keep + __shfl_xor(send, 16); } \
        { const float send = b5 ? r2[0] : r2[1], keep = b5 ? r2[1] : r2[0]; u1 = keep + __shfl_xor(send, 32); } \
        const float av = gelu_exact(u1 * CU) * CG; \
        if ((lane & 7) == 0) ent[((TK) * 128 + r * 8 + eid) * 3 + 1] = __builtin_bit_cast(int, av);     \
    } while (0)
#define PE_LOAD_V(TK, RW, AV) do { \
        const int base_ = ((TK) * 128 + r * 8 + eid) * 3; \
        const int ev = ent[base_]; AV = ent[base_ + 1]; \
        _Pragma("unroll") for (int k = 0; k < 8; ++k) { const unsigned e = (unsigned)__builtin_amdgcn_readlane(ev, PE_RL(k)); \
            RW[k] = *(const u32x4*)(PV + (size_t)(e * 1024u) + loff); } \
    } while (0)
#define PE_COMP_V(TK, RW, AV) do { \
        _Pragma("unroll") for (int k = 0; k < 8; ++k) { \
            const float a = __builtin_bit_cast(float, __builtin_amdgcn_readlane(AV, PE_RL(k))); \
            const f32x2 a2 = (f32x2){a, a}; \
            acc[TK][0] += a2 * CVT_LO(RW[k].x); acc[TK][1] += a2 * CVT_HI(RW[k].x); acc[TK][2] += a2 * CVT_LO(RW[k].y); acc[TK][3] += a2 * CVT_HI(RW[k].y); \
            acc[TK][4] += a2 * CVT_LO(RW[k].z); acc[TK][5] += a2 * CVT_HI(RW[k].z); acc[TK][6] += a2 * CVT_LO(RW[k].w); acc[TK][7] += a2 * CVT_HI(RW[k].w); } \
    } while (0)

template <bool DRY> __device__ __forceinline__ void phase_peer_fused(const Params& p, int layer, char* lds) {
    const int tid = otid(), lane = tid & 63, wave = tid >> 6;
    const unsigned char* PU = p.ws + OFF_PU + (size_t)layer * 16384 * 1024;
    const unsigned char* PV = p.ws + OFF_PV + (size_t)layer * 16384 * 1024;
    const float* SU = (const float*)(p.ws + OFF_PSC) + (size_t)layer * 16384;
    const float* SV = (const float*)(p.ws + OFF_PSC) + (size_t)(2 + layer) * 16384;
    bf16_t* XN = (bf16_t*)(p.ws + R_XN);
    float* XA = (float*)(p.ws + OFF_XA);
    const float* SC = (const float*)(p.ws + R_QP);
    const bool last = (layer == NLAYER - 1);
    const float* gnext = last ? p.in[I_FG] : p.in[I_N1G] + (layer + 1) * DM;
    const float* g2p = p.in[I_N2G] + layer * DM;
    const bool b5 = (lane & 32) != 0, b4 = (lane & 16) != 0, b3 = (lane & 8) != 0;
    const int eid = ((lane >> 3) & 1) * 4 + ((lane >> 4) & 1) * 2 + (lane >> 5);
    const unsigned loff = (unsigned)lane * 16u;
    int* ent = (int*)(lds + wave * PE_WAVE);
    const float NINF = -3.0e38f;
    const int pp = lane & 1;
    for (int tb = (obid() * NWAVE + wave) * 8; tb < T; tb += NBLK * NWAVE * 8) {
#pragma unroll 1
        for (int grp = 0; grp < 2; ++grp) {
            const int tkl = grp * 4 + (lane >> 4), h = (lane >> 1) & 7;
            const f32x4* src = (const f32x4*)(SC + (size_t)(tb + tkl) * 2048 + h * 256 + pp * 128);
            float l[16];
#pragma unroll
            for (int i = 0; i < 16; ++i) l[i] = NINF;
#pragma unroll 1
            for (int c = 0; c < 4; ++c) {
                f32x4 v[8];
#pragma unroll
                for (int j = 0; j < 8; ++j) v[j] = src[c * 8 + j];
#pragma unroll
                for (int hh = 0; hh < 2; ++hh) {
                    float g[16];
#pragma unroll
                    for (int j = 0; j < 4; ++j) {
                        const unsigned kb = (unsigned)(c * 32 + hh * 16 + j * 4);
                        g[4 * j] = tk_pack(v[hh * 4 + j].x, kb, 0x7Fu); g[4 * j + 1] = tk_pack(v[hh * 4 + j].y, kb + 1u, 0x7Fu);
                        g[4 * j + 2] = tk_pack(v[hh * 4 + j].z, kb + 2u, 0x7Fu); g[4 * j + 3] = tk_pack(v[hh * 4 + j].w, kb + 3u, 0x7Fu);
                    }
                    tk_sort16(g);
                    tk_top16_merge(l, g);
                }
            }
            float xw[16], ow[16]; unsigned PX[4] = {0u, 0u, 0u, 0u}, PO[4] = {0u, 0u, 0u, 0u};
#pragma unroll
            for (int i = 0; i < 16; ++i) {
                const float o = __shfl_xor(l[i], 1);
                const unsigned xb = __builtin_bit_cast(unsigned, l[i]), ob = __builtin_bit_cast(unsigned, o);
                xw[i] = __builtin_bit_cast(float, xb & ~0x7Fu); ow[i] = __builtin_bit_cast(float, ob & ~0x7Fu);
                PX[i >> 2] |= (xb & 0x7Fu) << ((i & 3) * 8); PO[i >> 2] |= (ob & 0x7Fu) << ((i & 3) * 8);
            }
            float f[16];
            {
                float c1[16];
#pragma unroll
                for (int i = 0; i < 16; ++i) { f[i] = NINF; c1[i] = NINF; }
                int cnt = 0;
#pragma unroll
                for (int i = 0; i < 16; ++i)
#pragma unroll
                    for (int j = i; j < 16; ++j)
                        if ((i + 1) * (j + 1) <= 16) {
                            float cv = xw[i] + ow[j];
                            const unsigned code = pp ? (unsigned)((j << 4) | i) : (unsigned)((i << 4) | j);
                            cv = tk_pack(cv, code, 0xFFu);
                            if (i == j) cv = pp ? NINF : cv;
                            if (cnt < 16) f[cnt & 15] = cv; else c1[cnt & 15] = cv;
                            ++cnt;
                        }
                tk_sort16(f); tk_sort16(c1);
                tk_top16_merge(f, c1);
                float gq[16];
#pragma unroll
                for (int i = 0; i < 16; ++i) gq[i] = __shfl_xor(f[i], 1);
                tk_top16_merge(f, gq);
            }
            unsigned P0[4], P1[4];
#pragma unroll
            for (int q = 0; q < 4; ++q) { P0[q] = pp ? PO[q] : PX[q]; P1[q] = pp ? PX[q] : PO[q]; }
            const float top = __builtin_bit_cast(float, __builtin_bit_cast(unsigned, f[0]) & ~0xFFu);
            float ev[16]; float den = 0.f;
#pragma unroll
            for (int r = 0; r < 16; ++r) { ev[r] = __expf(__builtin_bit_cast(float, __builtin_bit_cast(unsigned, f[r]) & ~0xFFu) - top); den += ev[r]; }
            const float rden = 1.0f / den;
#pragma unroll
            for (int r8 = 0; r8 < 8; ++r8) {
                const unsigned c0 = __builtin_bit_cast(unsigned, f[r8]) & 0xFFu, c1 = __builtin_bit_cast(unsigned, f[r8 + 8]) & 0xFFu;
                const unsigned code = pp ? c1 : c0;
                const float gate = (pp ? ev[r8 + 8] : ev[r8]) * rden;
                const int e = (int)(tk_lookup(P0, code >> 4) * 128u + tk_lookup(P1, code & 15u));
                const int o = (tkl * 128 + h * 16 + pp * 8 + r8) * 3;
                ent[o] = e; ent[o + 1] = __builtin_bit_cast(int, SU[e]); ent[o + 2] = __builtin_bit_cast(int, gate * SV[e]);
            }
        }
#pragma unroll 1
        for (int tk = 0; tk < 8; ++tk) {
            int* et = ent + tk * 384;
            const int eA = et[lane * 3], uA = et[lane * 3 + 1], gA = et[lane * 3 + 2];
            const int eB = et[(64 + lane) * 3], uB = et[(64 + lane) * 3 + 1], gB = et[(64 + lane) * 3 + 2];
            const int rA = eA >> (14 - PE_LOGR), rB = eB >> (14 - PE_LOGR);
            int base = 0;
#pragma unroll 1
            for (int r = 0; r < PE_NR; ++r) {
                const unsigned long long mA = __ballot(rA == r), mB = __ballot(rB == r);
                const int cA = __popcll(mA);
                if (rA == r) { const int q = base + (int)__builtin_amdgcn_mbcnt_hi((unsigned)(mA >> 32), __builtin_amdgcn_mbcnt_lo((unsigned)mA, 0u)); et[q * 3] = eA; et[q * 3 + 1] = uA; et[q * 3 + 2] = gA; }
                if (rB == r) { const int q = base + cA + (int)__builtin_amdgcn_mbcnt_hi((unsigned)(mB >> 32), __builtin_amdgcn_mbcnt_lo((unsigned)mB, 0u)); et[q * 3] = eB; et[q * 3 + 1] = uB; et[q * 3 + 2] = gB; }
                base += cA + __popcll(mB);
            }
        }
        {
            {
                u32x2 xp[8][4];
#pragma unroll
                for (int tk = 0; tk < 8; ++tk) {
                    f32x4 xr[4]; float ss = 0.f;
#pragma unroll
                    for (int j = 0; j < 4; ++j) { xr[j] = *(const f32x4*)(XA + (size_t)(tb + tk) * DM + 4 * lane + 256 * j); ss += xr[j].x * xr[j].x + xr[j].y * xr[j].y + xr[j].z * xr[j].z + xr[j].w * xr[j].w; }
                    ss = wave_sum(ss);
                    const float rn = rsqrtf(ss * (1.0f / DM) + EPS);
#pragma unroll
                    for (int j = 0; j < 4; ++j) { const f32x4 gg = *(const f32x4*)(g2p + 4 * lane + 256 * j);
                        xp[tk][j].x = pk2(xr[j].x * rn * gg.x, xr[j].y * rn * gg.y); xp[tk][j].y = pk2(xr[j].z * rn * gg.z, xr[j].w * rn * gg.w); }
                }
#pragma unroll 1
                for (int r = 0; r < 16; ++r) {
                    __syncthreads();
                    u32x4 rwA[8]; int evA; float cuA, cgA;
                    PE_LOAD_U(0, rwA, evA, cuA, cgA); PE_COMP_U(0, rwA, cuA, cgA);
                    PE_LOAD_U(1, rwA, evA, cuA, cgA); PE_COMP_U(1, rwA, cuA, cgA);
                    PE_LOAD_U(2, rwA, evA, cuA, cgA); PE_COMP_U(2, rwA, cuA, cgA);
                    PE_LOAD_U(3, rwA, evA, cuA, cgA); PE_COMP_U(3, rwA, cuA, cgA);
                    PE_LOAD_U(4, rwA, evA, cuA, cgA); PE_COMP_U(4, rwA, cuA, cgA);
                    PE_LOAD_U(5, rwA, evA, cuA, cgA); PE_COMP_U(5, rwA, cuA, cgA);
                    PE_LOAD_U(6, rwA, evA, cuA, cgA); PE_COMP_U(6, rwA, cuA, cgA);
                    PE_LOAD_U(7, rwA, evA, cuA, cgA); PE_COMP_U(7, rwA, cuA, cgA);
                }
            }
#pragma unroll 1
            for (int hv = 0; hv < 2; ++hv) {
            f32x2 acc[4][8];
#pragma unroll
            for (int tk = 0; tk < 4; ++tk)
#pragma unroll
                for (int j = 0; j < 8; ++j) acc[tk][j] = (f32x2){0.f, 0.f};
            const int* entv = ent;
            {
                int* ent = (int*)entv + hv * 4 * 128 * 3;
#pragma unroll 1
                for (int r = 0; r < 16; ++r) {
                    __syncthreads();
                    u32x4 rwA[8], rwB[8]; int avA, avB;
                    PE_LOAD_V(0, rwA, avA);
                    PE_LOAD_V(1, rwB, avB); PE_COMP_V(0, rwA, avA);
                    PE_LOAD_V(2, rwA, avA); PE_COMP_V(1, rwB, avB);
                    PE_LOAD_V(3, rwB, avB); PE_COMP_V(2, rwA, avA);
                    PE_COMP_V(3, rwB, avB);
                }
            }
#pragma unroll
            for (int tk = 0; tk < 4; ++tk) {
                const int t = tb + hv * 4 + tk;
                f32x4 x[4]; float ss = 0.f;
#pragma unroll
                for (int j = 0; j < 4; ++j) {
                    x[j] = *(const f32x4*)(XA + (size_t)t * DM + 4 * lane + 256 * j);
                    x[j].x += acc[tk][2 * j].x; x[j].y += acc[tk][2 * j].y; x[j].z += acc[tk][2 * j + 1].x; x[j].w += acc[tk][2 * j + 1].y;
                    ss += x[j].x * x[j].x + x[j].y * x[j].y + x[j].z * x[j].z + x[j].w * x[j].w;
                }
                ss = wave_sum(ss);
                const float rr = rsqrtf(ss * (1.0f / DM) + EPS);
                if (last) {
#pragma unroll
                    for (int j = 0; j < 4; ++j) { const f32x4 gg = *(const f32x4*)(gnext + 4 * lane + 256 * j); *(f32x4*)(p.out + (size_t)t * DM + 4 * lane + 256 * j) = x[j] * rr * gg; }
                } else {
#pragma unroll
                    for (int j = 0; j < 4; ++j) {
                        const f32x4 gg = *(const f32x4*)(gnext + 4 * lane + 256 * j);
                        *(f32x4*)((DRY ? p.out : XA) + (size_t)t * DM + 4 * lane + 256 * j) = x[j];
                        u32x2 w; w.x = pk2(x[j].x * rr * gg.x, x[j].y * rr * gg.y); w.y = pk2(x[j].z * rr * gg.z, x[j].w * rr * gg.w);
                        if (!DRY) *(u32x2*)(XN + (size_t)t * DM + 4 * lane + 256 * j) = w;
                    }
                }
            }
            }
        }
    }
}

#define LAS __attribute__((address_space(3)))
#define XB_TMO      128
#define XB_XCNT(j)  (256  + 64 * (j))
#define XB_XSUB(j)  (1280 + 64 * (j))
#define XB_XGEN(j)  (2304 + 64 * (j))
#define XB_TOP      3328
#define XB_TOPGEN   3392
#define XCD_BAR_WORDS 3456
#define XB_SPIN_CAP (1u << 20)
__device__ __forceinline__ unsigned xb_ld(unsigned* p)              { return __hip_atomic_load(p, __ATOMIC_RELAXED, __HIP_MEMORY_SCOPE_AGENT); }
__device__ __forceinline__ unsigned xb_add(unsigned* p, unsigned v) { return __hip_atomic_fetch_add(p, v, __ATOMIC_RELAXED, __HIP_MEMORY_SCOPE_AGENT); }
__device__ __forceinline__ unsigned xb_xcc_id() { return (unsigned)__builtin_amdgcn_s_getreg((3 << 11) | 20) & 0xFu; }
#define XB_SPIN(cond, bar) do { unsigned _sp = 0; while (cond) { __builtin_amdgcn_s_sleep(1); \
    if ((++_sp & 255u) == 0u) { if (xb_ld(&(bar)[XB_TMO])) break; if (_sp > XB_SPIN_CAP) { atomicAdd(&(bar)[XB_TMO], 1u); break; } } } } while (0)
struct XcdBarrier { unsigned* bar; unsigned x; volatile LAS unsigned* st; };
__device__ __forceinline__ XcdBarrier xcd_barrier_post(unsigned* bar, volatile LAS unsigned* st) {
    XcdBarrier b; b.bar = bar; b.x = xb_xcc_id(); b.st = st;
    if (threadIdx.x == 0) (void)xb_add(&bar[XB_XCNT(b.x)], 1u);
    return b;
}
__device__ __forceinline__ void xcd_barrier_complete(unsigned* bar, unsigned x, unsigned& nloc, unsigned& nx) {
    const unsigned G = NBLK;
    unsigned sum, cnt, mine, sp = 0u;
    for (;;) {
        sum = 0u; cnt = 0u; mine = 0u;
#pragma unroll
        for (unsigned j = 0; j < 16; ++j) { const unsigned c = xb_ld(&bar[XB_XCNT(j)]); sum += c; cnt += (c > 0u) ? 1u : 0u; mine = (j == x) ? c : mine; }
        if (sum == G) break;
        __builtin_amdgcn_s_sleep(1);
        if ((++sp & 255u) == 0u) { if (xb_ld(&bar[XB_TMO])) break; if (sp > XB_SPIN_CAP) { atomicAdd(&bar[XB_TMO], 1u); break; } }
    }
    nloc = mine > 0u ? mine : 1u; nx = cnt > 0u ? cnt : 1u;
}
__device__ __forceinline__ void xcd_barrier(const XcdBarrier& b) {
    asm volatile("s_waitcnt vmcnt(0)" ::: "memory");
    __syncthreads();
    if (threadIdx.x == 0) {
        unsigned* bar = b.bar;
        __builtin_amdgcn_s_waitcnt(0);
        unsigned nloc = b.st[0], nx = b.st[1];
        if (nloc == 0u) { xcd_barrier_complete(bar, b.x, nloc, nx); b.st[0] = nloc; b.st[1] = nx; }
        const unsigned old = xb_add(&bar[XB_XSUB(b.x)], 1u);
        const unsigned gen = old / nloc;
        if (old + 1u == (gen + 1u) * nloc) {
            __builtin_amdgcn_fence(__ATOMIC_RELEASE, "agent");
            asm volatile("s_waitcnt vmcnt(0)" ::: "memory");
            const unsigned og = xb_add(&bar[XB_TOP], 1u);
            const unsigned tg = og / nx;
            if (og + 1u == (tg + 1u) * nx) xb_add(&bar[XB_TOPGEN], 1u);
            else XB_SPIN(xb_ld(&bar[XB_TOPGEN]) == tg, bar);
            __builtin_amdgcn_fence(__ATOMIC_ACQUIRE, "agent");
            xb_add(&bar[XB_XGEN(b.x)], 1u);
            asm volatile("s_waitcnt vmcnt(0)" ::: "memory");
        } else {
            XB_SPIN(xb_ld(&bar[XB_XGEN(b.x)]) == gen, bar);
            __builtin_amdgcn_fence(__ATOMIC_ACQUIRE, "agent");
            asm volatile("s_waitcnt vmcnt(0)" ::: "memory");
        }
    }
    __syncthreads();
}


template <class Epi> __device__ __forceinline__ void big_gemm(const bf16_t* A, const bf16_t* Bt, int M, int N, int K, char* lds, const Epi& e) {
    pg8::Gemm g{A, Bt, M, N, K}; pg8::StaticOrder S; S.init(M, N, NBLK, obid());
    pg8::gemm_phase<Epi, pg8::StaticOrder, true, true>((PG8_LAS unsigned char*)lds, g, S, e);
}

#define GSYNC() xcd_barrier(xbar)
template <int layer> __device__ __forceinline__ void run_layer(const Params& p, char* lds, const XcdBarrier& xbar) {
    float* XA = (float*)(p.ws + OFF_XA);

        const float* xin = layer == 0 ? p.in[I_X] : XA;
        {
            const bf16_t* wt = (const bf16_t*)(p.ws + OFF_WTIN) + (size_t)layer * INC * DM;
            pg8::EpiStoreBf16 e1{(bf16_t*)(p.ws + R_QKV), 768};
            big_gemm((const bf16_t*)(p.ws + R_XN), wt, T, 768, DM, lds, e1);
            pg8::EpiStoreF32 e2{nullptr, (float*)(p.ws + R_HF), T};
            big_gemm(wt + (size_t)768 * DM, (const bf16_t*)(p.ws + R_XN), 1024, T, DM, lds, e2);
        }
        if (layer == 0) {
#pragma nounroll
            for (int fl = 0; fl < NLAYER; ++fl) {
                EpiF32 e{(float*)(p.ws + (fl ? OFF_HFILT1 : OFF_HFILT0)), SL};
                gemm_simple((const bf16_t*)(p.ws + OFF_W3T) + (size_t)fl * 1024 * 64, (const bf16_t*)(p.ws + OFF_H2) + (size_t)fl * SL * 64, 1024, SL, 64, lds, e);
            }
        }
        GSYNC();
        if (layer == 0) {
            phase_filter_spectra(p, lds);
        }
        phase_qkprep(p, layer, lds, (bf16_t*)(p.ws + R_QKV)); GSYNC();
        {
            phase_attn(p, lds);
            for (int c = obid(); c < 256; c += NBLK) hyena_job(p, layer, c, lds);
            for (int c = obid(); c < 256; c += NBLK) fnet_job(p, c, lds);
        } GSYNC();
        phase_mix(p, layer, lds); GSYNC();
        { pg8::EpiOutProj e{xin, XA, (bf16_t*)(p.ws + R_XN), (float*)(p.ws + OFF_RS)};
          big_gemm((const bf16_t*)(p.ws + R_MIX), (const bf16_t*)(p.ws + OFF_WTOUT) + (size_t)layer * DM * DM, T, DM, DM, lds, e); } GSYNC();
        { pg8::EpiRowScaleF32 e{(float*)(p.ws + R_QP), 2048, (const float*)(p.ws + OFF_RS)};
          big_gemm((const bf16_t*)(p.ws + R_XN), (const bf16_t*)(p.ws + OFF_WTQ) + (size_t)layer * 2048 * DM, T, 2048, DM, lds, e); } GSYNC();
        phase_peer_fused<false>(p, layer, lds);
        if (layer + 1 < NLAYER) GSYNC();
}

__global__ void __launch_bounds__(NTHR) mega_kernel(Params p) {
    extern __shared__ __attribute__((aligned(16))) char lds[];
    volatile LAS unsigned* misc = (volatile LAS unsigned*)((LAS char*)lds + LDS_MISC);
    if (threadIdx.x < 16) misc[threadIdx.x] = 0u;
    __syncthreads();
    const XcdBarrier xbar = xcd_barrier_post((unsigned*)(p.ws + OFF_CTL) + 4096, misc);
    float* XA = (float*)(p.ws + OFF_XA);
    phase_p0(p, lds);
    phase_rmsnorm_bf16(p.in[I_X], p.in[I_N1G], (bf16_t*)(p.ws + R_XN));
    GSYNC();
    run_layer<0>(p, lds, xbar);
    run_layer<1>(p, lds, xbar);
}

extern "C" void kernel_launch(void* const* d_in, const int* in_sizes, int n_in, void* d_out, int out_size, void* d_ws, size_t ws_size, hipStream_t stream) {
    static int grid = 0;
    if (grid == 0) {
        if (n_in != 25 || out_size != T * DM || ws_size < WS_NEED) { fprintf(stderr, "kernel_launch: unexpected sizes n_in %d out %d ws %zu (need %zu)\n", n_in, out_size, ws_size, (size_t)WS_NEED); grid = -1; return; }
        int dev = 0, cus = 0, per_cu = 0;
        if (hipGetDevice(&dev) != hipSuccess || hipDeviceGetAttribute(&cus, hipDeviceAttributeMultiprocessorCount, dev) != hipSuccess) { grid = -1; return; }
        if (hipFuncSetAttribute((const void*)mega_kernel, hipFuncAttributeMaxDynamicSharedMemorySize, LDS_BYTES) != hipSuccess) { fprintf(stderr, "kernel_launch: hipFuncSetAttribute failed\n"); grid = -1; return; }
        if (hipOccupancyMaxActiveBlocksPerMultiprocessor(&per_cu, (const void*)mega_kernel, NTHR, LDS_BYTES) != hipSuccess || per_cu < 1) { fprintf(stderr, "kernel_launch: occupancy query says %d blocks per CU\n", per_cu); grid = -1; return; }
        (void)hipGetLastError();
        if (cus < NBLK) { fprintf(stderr, "kernel_launch: built for a %d-CU device, found %d CUs\n", NBLK, cus); grid = -1; return; }
        grid = NBLK;
    }
    if (grid < 0) return;
    Params p{};
    for (int i = 0; i < 25; ++i) p.in[i] = (const float*)d_in[i];
    p.out = (float*)d_out; p.ws = (unsigned char*)d_ws;
    if (hipMemsetAsync((char*)d_ws + OFF_CTL, 0, 64 * 1024, stream) != hipSuccess) { fprintf(stderr, "kernel_launch: memset failed\n"); return; }
    void* args[] = {&p};
    hipError_t e = hipLaunchCooperativeKernel((const void*)mega_kernel, dim3(grid), dim3(NTHR), args, LDS_BYTES, stream);
    if (e != hipSuccess) fprintf(stderr, "cooperative launch failed: %s (grid %d)\n", hipGetErrorString(e), grid);
}
```

```cpp
#include <hip/hip_runtime.h>
#include <cstdio>
#include <cstdint>

typedef unsigned short bf16_t;
typedef short bf16x8 __attribute__((ext_vector_type(8)));
typedef float f32x16 __attribute__((ext_vector_type(16)));
typedef float f32x4 __attribute__((ext_vector_type(4)));
typedef unsigned u32x4 __attribute__((ext_vector_type(4)));
typedef unsigned u32x2 __attribute__((ext_vector_type(2)));
typedef _Float16 f16x4 __attribute__((ext_vector_type(4)));
typedef _Float16 f16x8 __attribute__((ext_vector_type(8)));

constexpr int DM = 1024, NB = 2, SL = 8192, T = NB * SL, NLAYER = 2;
constexpr int INC = 1792;
constexpr int NTHR = 512, NWAVE = 8;
constexpr int NBLK = 256;
constexpr int LDS_BYTES = 147456;
constexpr int LDS_MISC = LDS_BYTES - 64;
constexpr float EPS = 1e-6f;

constexpr size_t MiB = 1u << 20;
constexpr size_t OFF_CTL = 0;
constexpr size_t OFF_WTIN = 1 * MiB;
constexpr size_t OFF_WTOUT = 8 * MiB;
constexpr size_t OFF_WTQ = 12 * MiB;
constexpr size_t OFF_PU = 20 * MiB;
constexpr size_t OFF_PV = 84 * MiB;
constexpr size_t OFF_RS = 505 * MiB;
constexpr size_t OFF_PSC = 512 * 1024;
constexpr size_t OFF_H2 = 148 * MiB;
constexpr size_t OFF_W3T = 150 * MiB;
constexpr size_t OFF_HFILT0 = 52 * MiB, OFF_HFILT1 = 116 * MiB;
constexpr size_t OFF_FM = 152 * MiB;
constexpr size_t OFF_KF = 153 * MiB;
constexpr size_t OFF_XA = 281 * MiB;
constexpr size_t OFF_R = 345 * MiB;
constexpr size_t R_XN = OFF_R + 0 * MiB;
constexpr size_t R_UR = OFF_R + 0 * MiB;
constexpr size_t R_UI = OFF_R + 16 * MiB;
constexpr size_t R_QKV = OFF_R + 32 * MiB;
constexpr size_t R_HF = OFF_R + 60 * MiB;
constexpr size_t R_MIX = OFF_R + 60 * MiB;
constexpr size_t R_ATT = OFF_R + 124 * MiB;
constexpr size_t R_Y = OFF_R + 140 * MiB;
constexpr size_t R_QP = OFF_R + 32 * MiB;
constexpr size_t WS_NEED = 506 * MiB;

struct Params {
    const float* in[25];
    float* out;
    unsigned char* ws;
};
enum { I_X = 0, I_N1G, I_WIN, I_QG, I_KG, I_CW, I_CB, I_W1, I_B1, I_F1, I_W2, I_B2, I_F2, I_W3, I_HB, I_FW, I_FB, I_MG, I_WOUT, I_N2G, I_WQ, I_SK, I_PU, I_PV, I_FG };

__device__ __forceinline__ unsigned f2bf(float f) { unsigned u = __builtin_bit_cast(unsigned, f); return (u + 0x7fffu + ((u >> 16) & 1u)) >> 16; }
__device__ __forceinline__ unsigned pk2(float lo, float hi) { return f2bf(lo) | (f2bf(hi) << 16); }
__device__ __forceinline__ float bflo(unsigned w) { return __builtin_bit_cast(float, w << 16); }
__device__ __forceinline__ float bfhi(unsigned w) { return __builtin_bit_cast(float, w & 0xffff0000u); }
__device__ __forceinline__ float wave_sum(float v) {
#pragma unroll
    for (int o = 1; o < 64; o <<= 1) v += __shfl_xor(v, o);
    return v;
}
__device__ __forceinline__ float wave_max(float v) {
#pragma unroll
    for (int o = 1; o < 64; o <<= 1) v = fmaxf(v, __shfl_xor(v, o));
    return v;
}
__device__ __forceinline__ f32x16 mfma32(bf16x8 a, bf16x8 b, f32x16 c) { return __builtin_amdgcn_mfma_f32_32x32x16_bf16(a, b, c, 0, 0, 0); }
__device__ __forceinline__ f32x16 zero16() { return (f32x16){0.f,0.f,0.f,0.f,0.f,0.f,0.f,0.f,0.f,0.f,0.f,0.f,0.f,0.f,0.f,0.f}; }


__device__ __forceinline__ int otid() { int t = threadIdx.x; asm volatile("" : "+v"(t)); return t; }
__device__ __forceinline__ int obid() { int b = blockIdx.x; asm volatile("" : "+s"(b)); return b; }
__device__ __forceinline__ void transpose_one(const float* W, int K, int N, bf16_t* Wt, float* tile, int item) {
    const int tid = otid();
    const int nblk = N / 64, kb = item / nblk, nb = item % nblk, k0 = kb * 64, n0 = nb * 64;
    __syncthreads();
    {
        const int r = tid >> 6, c = tid & 63;
#pragma unroll
        for (int i = 0; i < 8; ++i) { const int k = r + 8 * i; tile[k * 65 + c] = W[(size_t)(k0 + k) * N + n0 + c]; }
    }
    __syncthreads();
    {
        const int nn = tid >> 3, kc = tid & 7;
        const float* s = tile + (kc * 8) * 65 + nn;
        u32x4 o; o.x = pk2(s[0], s[65]); o.y = pk2(s[2 * 65], s[3 * 65]); o.z = pk2(s[4 * 65], s[5 * 65]); o.w = pk2(s[6 * 65], s[7 * 65]);
        *(u32x4*)(Wt + (size_t)(n0 + nn) * K + k0 + kc * 8) = o;
    }
}

template <int PARTS = 31> __device__ __forceinline__ void phase_p0(const Params& p, char* lds) {
    const int tid = otid();
    float* tile = (float*)lds;
    if (PARTS & 1) {
    constexpr int IT_IN = (DM / 64) * (INC / 64), IT_OUT = (DM / 64) * (DM / 64), IT_W3 = 1024 / 64;
    constexpr int IT_L = IT_IN + IT_OUT + IT_W3;
    for (int it = obid(); it < NLAYER * IT_L; it += NBLK) {
        const int layer = it / IT_L; int r = it % IT_L;
        if (r < IT_IN) { transpose_one(p.in[I_WIN] + (size_t)layer * DM * INC, DM, INC, (bf16_t*)(p.ws + OFF_WTIN) + (size_t)layer * INC * DM, tile, r); continue; }
        r -= IT_IN;
        if (r < IT_OUT) { transpose_one(p.in[I_WOUT] + (size_t)layer * DM * DM, DM, DM, (bf16_t*)(p.ws + OFF_WTOUT) + (size_t)layer * DM * DM, tile, r); continue; }
        r -= IT_OUT;
        transpose_one(p.in[I_W3] + (size_t)layer * 64 * 1024, 64, 1024, (bf16_t*)(p.ws + OFF_W3T) + (size_t)layer * 1024 * 64, tile, r);
    }
    }
    __syncthreads();
    if (PARTS & 2) {
        float* SKl = (float*)lds;
        float* Wl = SKl + 128 * 129;
        const int lane = tid & 63, wave = tid >> 6, l31 = lane & 31, hl = lane >> 5, mt = wave & 3, nt = wave >> 2;
        for (int it = obid(); it < NLAYER * 16 * 16; it += NBLK) {
            const int layer = it >> 8, hp = (it >> 4) & 15, kc = it & 15, h = hp >> 1, pp = hp & 1, k0 = kc * 64;
            const float* sk = p.in[I_SK] + (((size_t)(layer * 2 + pp) * 8 + h) * 128) * 128;
            const float* wq = p.in[I_WQ] + (size_t)layer * DM * 2048 + (size_t)k0 * 2048 + h * 256 + pp * 128;
            __syncthreads();
            for (int i = tid; i < 128 * 128; i += NTHR) SKl[(i >> 7) * 129 + (i & 127)] = sk[i];
            for (int i = tid; i < 64 * 128; i += NTHR) Wl[(i >> 7) * 129 + (i & 127)] = wq[(size_t)(i >> 7) * 2048 + (i & 127)];
            __syncthreads();
            f32x16 acc = zero16();
            const float* ap = SKl + (32 * mt + l31) * 129 + hl;
            const float* bp = Wl + (32 * nt + l31) * 129 + hl;
#pragma unroll 16
            for (int kk = 0; kk < 64; ++kk) acc = __builtin_amdgcn_mfma_f32_32x32x2f32(ap[2 * kk], bp[2 * kk], acc, 0, 0, 0);
            const float g2 = p.in[I_N2G][layer * DM + k0 + 32 * nt + l31];
            bf16_t* dst = (bf16_t*)(p.ws + OFF_WTQ) + (size_t)layer * 2048 * DM + (size_t)(hp * 128 + 32 * mt + 4 * hl) * DM + k0 + 32 * nt + l31;
#pragma unroll
            for (int r = 0; r < 16; ++r) dst[(size_t)((r & 3) + 8 * (r >> 2)) * DM] = (bf16_t)f2bf(acc[r] * g2);
        }
        __syncthreads();
    }
    if (PARTS & 4) {
        const int lane = tid & 63, wave = tid >> 6;
        float* scl = (float*)(p.ws + OFF_PSC);
        for (int row = obid() * NWAVE + wave; row < 2 * NLAYER * 16384; row += NBLK * NWAVE) {
            const int tb = row >> 15, r = row & 32767;
            const f32x4* src = (const f32x4*)(p.in[tb ? I_PV : I_PU] + (size_t)r * DM) + lane;
            f32x4 v[4]; float mx = 0.f;
#pragma unroll
            for (int j = 0; j < 4; ++j) { v[j] = __builtin_nontemporal_load(src + 64 * j); mx = fmaxf(mx, fmaxf(fmaxf(fabsf(v[j].x), fabsf(v[j].y)), fmaxf(fabsf(v[j].z), fabsf(v[j].w)))); }
            mx = wave_max(mx);
            const float sc = mx > 0.f ? 224.0f / mx : 1.0f;
            u32x4 o;
            { int w = 0; w = __builtin_amdgcn_cvt_pk_fp8_f32(v[0].x * sc, v[0].y * sc, w, false); w = __builtin_amdgcn_cvt_pk_fp8_f32(v[0].z * sc, v[0].w * sc, w, true); o.x = (unsigned)w; }
            { int w = 0; w = __builtin_amdgcn_cvt_pk_fp8_f32(v[1].x * sc, v[1].y * sc, w, false); w = __builtin_amdgcn_cvt_pk_fp8_f32(v[1].z * sc, v[1].w * sc, w, true); o.y = (unsigned)w; }
            { int w = 0; w = __builtin_amdgcn_cvt_pk_fp8_f32(v[2].x * sc, v[2].y * sc, w, false); w = __builtin_amdgcn_cvt_pk_fp8_f32(v[2].z * sc, v[2].w * sc, w, true); o.z = (unsigned)w; }
            { int w = 0; w = __builtin_amdgcn_cvt_pk_fp8_f32(v[3].x * sc, v[3].y * sc, w, false); w = __builtin_amdgcn_cvt_pk_fp8_f32(v[3].z * sc, v[3].w * sc, w, true); o.w = (unsigned)w; }
            *(u32x4*)(p.ws + (tb ? OFF_PV : OFF_PU) + (size_t)r * DM + lane * 16) = o;
            if (lane == 0) scl[row] = mx > 0.f ? mx / 224.0f : 1.0f;
        }
    }
    if (PARTS & 8) {
        float* sh = (float*)lds;
        float* zl = sh + 64 * 64;
        const int sub = tid >> 6, j = tid & 63;
        for (int it0 = obid() * 64; it0 < NLAYER * SL; it0 += NBLK * 64) {
            const int layer = it0 / SL;
            __syncthreads();
            for (int o = tid; o < 64 * 17; o += NTHR) {
                const int item = o / 17, f = o % 17;
                const float t = (float)((it0 + item) % SL) / (float)(SL - 1);
                float z;
                if (f == 0) z = t;
                else if (f <= 8) z = sinf(2.0f * 3.14159265358979323846f * t * (float)f);
                else z = cosf(2.0f * 3.14159265358979323846f * t * (float)(f - 8));
                zl[o] = z;
            }
            __syncthreads();
            {
                const float* w1 = p.in[I_W1] + layer * 17 * 64;
                float wv[17];
#pragma unroll
                for (int i = 0; i < 17; ++i) wv[i] = w1[i * 64 + j];
                const float b1 = p.in[I_B1][layer * 64 + j], f1 = p.in[I_F1][layer * 64 + j];
#pragma unroll
                for (int r = 0; r < 8; ++r) {
                    const int item = sub * 8 + r;
                    float a = b1;
#pragma unroll
                    for (int i = 0; i < 17; ++i) a += zl[item * 17 + i] * wv[i];
                    sh[item * 64 + j] = sinf(f1 * a);
                }
            }
            __syncthreads();
            {
                const float* w2 = p.in[I_W2] + layer * 64 * 64;
                const float b2 = p.in[I_B2][layer * 64 + j], f2 = p.in[I_F2][layer * 64 + j];
                float acc[8];
#pragma unroll
                for (int r = 0; r < 8; ++r) acc[r] = b2;
#pragma unroll 8
                for (int k = 0; k < 64; ++k) {
                    const float w = w2[k * 64 + j];
#pragma unroll
                    for (int r = 0; r < 8; ++r) acc[r] += sh[(sub * 8 + r) * 64 + k] * w;
                }
#pragma unroll
                for (int r = 0; r < 8; ++r)
                    ((bf16_t*)(p.ws + OFF_H2))[((size_t)(it0 + sub * 8 + r)) * 64 + j] = (bf16_t)f2bf(sinf(f2 * acc[r]));
            }
        }
        __syncthreads();
    }
    if (PARTS & 16) {
        float* ctab = (float*)lds;
        __syncthreads();
        if (tid < 64) ctab[tid] = cosf((float)tid * (2.0f * 3.14159265358979323846f / 64.0f));
        __syncthreads();
        const int total = NLAYER * 4 * 128 * 64;
        for (int o = obid() * NTHR + tid; o < total; o += NBLK * NTHR) {
            const int e2 = o & 63, dd = (o >> 6) & 127, g = (o >> 13) & 3, layer = o >> 15;
            const int d = dd & 63, sh = (dd < 64) ? 0 : 48;
            const float* w = p.in[I_FW] + ((size_t)(layer * 4 + g) * 64) * 64;
            float acc = 0.f;
#pragma unroll 8
            for (int e = 0; e < 64; ++e) acc += ctab[(d * e + sh) & 63] * w[e * 64 + e2];
            ((float*)(p.ws + OFF_FM))[o] = acc * (1.0f / 724.0773439350246f);
        }
        __syncthreads();
    }
}

__device__ __forceinline__ int zp(int i) { return i + 2 * (i >> 5); }
__device__ constexpr float FC32[16] = {1.000000000f, 0.980785280f, 0.923879533f, 0.831469612f, 0.707106781f, 0.555570233f, 0.382683432f, 0.195090322f, 0.000000000f, -0.195090322f, -0.382683432f, -0.555570233f, -0.707106781f, -0.831469612f, -0.923879533f, -0.980785280f};
__device__ constexpr float FS32[16] = {0.000000000f, 0.195090322f, 0.382683432f, 0.555570233f, 0.707106781f, 0.831469612f, 0.923879533f, 0.980785280f, 1.000000000f, 0.980785280f, 0.923879533f, 0.831469612f, 0.707106781f, 0.555570233f, 0.382683432f, 0.195090322f};
__device__ __forceinline__ float2 cmulf(float2 a, float2 b) { return make_float2(a.x * b.x - a.y * b.y, a.x * b.y + a.y * b.x); }
template <int R> __device__ __forceinline__ constexpr int brevR(int x) { int r = 0; for (int b = 1, t = R >> 1; t >= 1; b <<= 1, t >>= 1) if (x & b) r |= t; return r; }
template <int R> __device__ __forceinline__ void dft_fwd_regs(float2 (&x)[R]) {
#pragma unroll
    for (int half = R / 2; half >= 1; half >>= 1) {
#pragma unroll
        for (int blk = 0; blk < R; blk += 2 * half)
#pragma unroll
            for (int k = 0; k < half; ++k) {
                const float2 a = x[blk + k], b = x[blk + k + half];
                x[blk + k] = make_float2(a.x + b.x, a.y + b.y);
                const float2 d = make_float2(a.x - b.x, a.y - b.y);
                const int ti = k * (16 / half);
                if (ti == 0) x[blk + k + half] = d;
                else if (ti == 8) x[blk + k + half] = make_float2(d.y, -d.x);
                else { const float c = FC32[ti], sn = FS32[ti]; x[blk + k + half] = make_float2(d.x * c + d.y * sn, d.y * c - d.x * sn); }
            }
    }
}
template <int R> __device__ __forceinline__ void dft_inv_regs(float2 (&x)[R]) {
#pragma unroll
    for (int half = 1; half <= R / 2; half <<= 1) {
#pragma unroll
        for (int blk = 0; blk < R; blk += 2 * half)
#pragma unroll
            for (int k = 0; k < half; ++k) {
                const float2 a = x[blk + k], b0 = x[blk + k + half];
                const int ti = k * (16 / half);
                float2 b;
                if (ti == 0) b = b0;
                else if (ti == 8) b = make_float2(-b0.y, b0.x);
                else { const float c = FC32[ti], sn = FS32[ti]; b = make_float2(b0.x * c - b0.y * sn, b0.y * c + b0.x * sn); }
                x[blk + k] = make_float2(a.x + b.x, a.y + b.y);
                x[blk + k + half] = make_float2(a.x - b.x, a.y - b.y);
            }
    }
}
template <int R> __device__ __forceinline__ void apply_tw(float2 (&x)[R], float c, float sg) {
    const float2 w1 = make_float2(c, sg), w2 = cmulf(w1, w1);
    float2 po = w1, pe = w2;
#pragma unroll
    for (int m = 1; m < R; m += 2) {
        x[brevR<R>(m)] = cmulf(x[brevR<R>(m)], po);
        if (m + 1 < R) x[brevR<R>(m + 1)] = cmulf(x[brevR<R>(m + 1)], pe);
        if (m + 2 < R) { po = cmulf(po, w2); pe = cmulf(pe, w2); }
    }
}
template <int R, bool INV> __device__ __forceinline__ void fft_group(float2* Z, int pbase, int PS, float ang) {
    float2 x[R];
    if (!INV) {
#pragma unroll
        for (int m = 0; m < R; ++m) x[m] = Z[pbase + PS * m];
        dft_fwd_regs<R>(x);
        apply_tw<R>(x, __builtin_amdgcn_cosf(ang), -__builtin_amdgcn_sinf(ang));
#pragma unroll
        for (int m = 0; m < R; ++m) Z[pbase + PS * m] = x[brevR<R>(m)];
    } else {
#pragma unroll
        for (int m = 0; m < R; ++m) x[brevR<R>(m)] = Z[pbase + PS * m];
        apply_tw<R>(x, __builtin_amdgcn_cosf(ang), __builtin_amdgcn_sinf(ang));
        dft_inv_regs<R>(x);
#pragma unroll
        for (int m = 0; m < R; ++m) Z[pbase + PS * m] = x[m];
    }
}
template <bool INV> __device__ __forceinline__ void fft_group32_contig(float2* Z, int pbase) {
    float2 x[32];
    if (!INV) {
#pragma unroll
        for (int m = 0; m < 32; m += 2) { const f32x4 v = *(const f32x4*)(Z + pbase + m); x[m] = make_float2(v.x, v.y); x[m + 1] = make_float2(v.z, v.w); }
        dft_fwd_regs<32>(x);
#pragma unroll
        for (int m = 0; m < 32; m += 2) { const float2 a = x[brevR<32>(m)], b = x[brevR<32>(m + 1)]; *(f32x4*)(Z + pbase + m) = (f32x4){a.x, a.y, b.x, b.y}; }
    } else {
#pragma unroll
        for (int m = 0; m < 32; m += 2) { const f32x4 v = *(const f32x4*)(Z + pbase + m); x[brevR<32>(m)] = make_float2(v.x, v.y); x[brevR<32>(m + 1)] = make_float2(v.z, v.w); }
        dft_inv_regs<32>(x);
#pragma unroll
        for (int m = 0; m < 32; m += 2) *(f32x4*)(Z + pbase + m) = (f32x4){x[m].x, x[m].y, x[m + 1].x, x[m + 1].y};
    }
}
__device__ __forceinline__ void fft16k_fwd(float2* Z) {
    const int tid = otid();
#pragma unroll 1
    for (int g = 0; g < 2; ++g) { const int j = tid + 512 * g; fft_group<16, false>(Z, zp(j), 1088, (float)j * (1.0f / 16384.0f)); }
    __syncthreads();
    { const int blk = tid >> 5, j = tid & 31; fft_group<32, false>(Z, blk * 1088 + j, 34, (float)j * (1.0f / 1024.0f)); }
    __syncthreads();
    fft_group32_contig<false>(Z, 34 * tid);
    __syncthreads();
}
__device__ __forceinline__ void fft16k_inv(float2* Z) {
    const int tid = otid();
    fft_group32_contig<true>(Z, 34 * tid);
    __syncthreads();
    { const int blk = tid >> 5, j = tid & 31; fft_group<32, true>(Z, blk * 1088 + j, 34, (float)j * (1.0f / 1024.0f)); }
    __syncthreads();
#pragma unroll 1
    for (int g = 0; g < 2; ++g) { const int j = tid + 512 * g; fft_group<16, true>(Z, zp(j), 1088, (float)j * (1.0f / 16384.0f)); }
    __syncthreads();
}
__device__ __forceinline__ void fft8k_fwd(float2* Z) {
    const int tid = otid();
    fft_group<16, false>(Z, zp(tid), 544, (float)tid * (1.0f / 8192.0f));
    __syncthreads();
    { const int blk = tid >> 5, j = tid & 31; fft_group<16, false>(Z, blk * 544 + j, 34, (float)j * (1.0f / 512.0f)); }
    __syncthreads();
    if (tid < 256) fft_group32_contig<false>(Z, 34 * tid);
    __syncthreads();
}
__device__ __forceinline__ int f16k_of_p(int p) { return (p >> 10) + 16 * ((p >> 5) & 31) + 512 * (p & 31); }
__device__ __forceinline__ int p16k_of_f(int f) { return 1024 * (f & 15) + 32 * ((f >> 4) & 31) + (f >> 9); }
__device__ __forceinline__ int p8k_of_f(int f) { return 512 * (f & 15) + 32 * ((f >> 4) & 15) + (f >> 8); }

__device__ __forceinline__ void phase_filter_spectra(const Params& p, char* lds) {
    const int tid = otid(), lane = tid & 63, wave = tid >> 6;
    float2* Z = (float2*)lds;
    float* red = (float*)(lds + 139264 + 64);
    for (int job = obid(); job < NLAYER * 256; job += NBLK) {
        const int layer = job >> 8, c = job & 255;
        __syncthreads();
        const float* HFc = (const float*)(p.ws + (layer ? OFF_HFILT1 : OFF_HFILT0)) + (size_t)c * SL;
        const float r_lo = 4.605170185988092f / 1.5f, r_hi = 4.605170185988092f / 0.3f;
        const float rate = r_lo + (r_hi - r_lo) * ((float)c / 255.0f);
        float ss0 = 0.f, ss1 = 0.f;
#pragma unroll 1
        for (int i = 0; i < 4; ++i) {
            const int l0 = 4 * tid + 2048 * i;
            const f32x4 a0 = *(const f32x4*)(HFc + l0), a1 = *(const f32x4*)(HFc + (size_t)256 * SL + l0);
            const f32x4 a2 = *(const f32x4*)(HFc + (size_t)512 * SL + l0), a3 = *(const f32x4*)(HFc + (size_t)768 * SL + l0);
#pragma unroll
            for (int e = 0; e < 4; ++e) {
                const int l = l0 + e;
                const float t = (float)l / (float)(SL - 1);
                const float dec = expf(-t * rate);
                const float f0 = a0[e] * dec, b0 = a1[e] * dec, f1 = a2[e] * dec, b1 = a3[e] * dec;
                ss0 += f0 * f0 + b0 * b0; ss1 += f1 * f1 + b1 * b1;
                Z[zp(l)] = make_float2(f0, f1);
                if (l >= 1) Z[zp(16384 - l)] = make_float2(b0, b1);
            }
        }
        if (tid == 0) Z[zp(8192)] = make_float2(0.f, 0.f);
        ss0 = wave_sum(ss0); ss1 = wave_sum(ss1);
        if (lane == 0) { red[wave * 2] = ss0; red[wave * 2 + 1] = ss1; }
        __syncthreads();
        float t0 = 0.f, t1 = 0.f;
#pragma unroll
        for (int w = 0; w < 8; ++w) { t0 += red[w * 2]; t1 += red[w * 2 + 1]; }
        const float sc0 = rsqrtf(t0 + EPS) * (1.0f / 16384.0f) * 0.5f, sc1 = rsqrtf(t1 + EPS) * (1.0f / 16384.0f) * 0.5f;
        fft16k_fwd(Z);
        float2* KF0 = (float2*)(p.ws + OFF_KF) + ((size_t)(layer * 256 + c) * 2) * 16384;
        float2* KF1 = KF0 + 16384;
        for (int i = 0; i < 32; ++i) {
            const int pp = tid + NTHR * i;
            const int fq = f16k_of_p(pp);
            const int pq = p16k_of_f((16384 - fq) & 16383);
            const float2 za = Z[zp(pp)], zq = Z[zp(pq)];
            KF0[pp] = make_float2((za.x + zq.x) * sc0, (za.y - zq.y) * sc0);
            KF1[pp] = make_float2((za.y + zq.y) * sc1, (zq.x - za.x) * sc1);
        }
    }
}

__device__ __forceinline__ void phase_rmsnorm_bf16(const float* x, const float* g, bf16_t* out) {
    const int lane = otid() & 63, wave = otid() >> 6;
    const int gw = obid() * NWAVE + wave, ngw = NBLK * NWAVE;
    for (int row = gw; row < T; row += ngw) {
        const f32x4* xr = (const f32x4*)(x + (size_t)row * DM) + lane;
        f32x4 v[4]; float ss = 0.f;
#pragma unroll
        for (int j = 0; j < 4; ++j) { v[j] = xr[64 * j]; ss += v[j].x * v[j].x + v[j].y * v[j].y + v[j].z * v[j].z + v[j].w * v[j].w; }
        ss = wave_sum(ss);
        const float r = rsqrtf(ss * (1.0f / DM) + EPS);
        u32x2* o = (u32x2*)(out + (size_t)row * DM) + lane;
#pragma unroll
        for (int j = 0; j < 4; ++j) {
            const f32x4 gg = ((const f32x4*)g)[lane + 64 * j];
            u32x2 w; w.x = pk2(v[j].x * r * gg.x, v[j].y * r * gg.y); w.y = pk2(v[j].z * r * gg.z, v[j].w * r * gg.w);
            o[64 * j] = w;
        }
    }
}

constexpr int G_LDA = 144;
template <class Epi>
__device__ __forceinline__ void gemm_simple(const bf16_t* A, const bf16_t* Bt, int M, int N, int K, char* lds, const Epi& epi) {
    const int tid = otid(), lane = tid & 63, wave = tid >> 6;
    const int wm = wave >> 1, wn = wave & 1;
    const int nMt = M / 256, nNt = N / 128, total = nMt * nNt, nk = K / 64;
    char* As = lds; char* Bs = lds + 256 * G_LDA;
    const int l31 = lane & 31, hl = lane >> 5;
    for (int u = obid(); u < total; u += NBLK) {
        const int mt = u % nMt, nt = u / nMt;
        f32x16 acc[2][2];
#pragma unroll
        for (int i = 0; i < 2; ++i)
#pragma unroll
            for (int j = 0; j < 2; ++j) acc[i][j] = zero16();
        u32x4 ra[4], rb[2];
        const bf16_t* Ab = A + (size_t)(mt * 256) * K;
        const bf16_t* Bb = Bt + (size_t)(nt * 128) * K;
#pragma unroll
        for (int i = 0; i < 4; ++i) { const int id = tid + NTHR * i, row = id >> 3, ch = id & 7; ra[i] = *(const u32x4*)(Ab + (size_t)row * K + ch * 8); }
#pragma unroll
        for (int i = 0; i < 2; ++i) { const int id = tid + NTHR * i, row = id >> 3, ch = id & 7; rb[i] = *(const u32x4*)(Bb + (size_t)row * K + ch * 8); }
        for (int kt = 0; kt < nk; ++kt) {
            __syncthreads();
#pragma unroll
            for (int i = 0; i < 4; ++i) { const int id = tid + NTHR * i, row = id >> 3, ch = id & 7; *(u32x4*)(As + row * G_LDA + ch * 16) = ra[i]; }
#pragma unroll
            for (int i = 0; i < 2; ++i) { const int id = tid + NTHR * i, row = id >> 3, ch = id & 7; *(u32x4*)(Bs + row * G_LDA + ch * 16) = rb[i]; }
            __syncthreads();
            if (kt + 1 < nk) {
                const int ko = (kt + 1) * 64;
#pragma unroll
                for (int i = 0; i < 4; ++i) { const int id = tid + NTHR * i, row = id >> 3, ch = id & 7; ra[i] = *(const u32x4*)(Ab + (size_t)row * K + ko + ch * 8); }
#pragma unroll
                for (int i = 0; i < 2; ++i) { const int id = tid + NTHR * i, row = id >> 3, ch = id & 7; rb[i] = *(const u32x4*)(Bb + (size_t)row * K + ko + ch * 8); }
            }
#pragma unroll
            for (int ks = 0; ks < 4; ++ks) {
                bf16x8 a[2], b[2];
#pragma unroll
                for (int i = 0; i < 2; ++i) a[i] = *(const bf16x8*)(As + (wm * 64 + i * 32 + l31) * G_LDA + ks * 32 + hl * 16);
#pragma unroll
                for (int j = 0; j < 2; ++j) b[j] = *(const bf16x8*)(Bs + (wn * 64 + j * 32 + l31) * G_LDA + ks * 32 + hl * 16);
#pragma unroll
                for (int i = 0; i < 2; ++i)
#pragma unroll
                    for (int j = 0; j < 2; ++j) acc[i][j] = mfma32(a[i], b[j], acc[i][j]);
            }
        }
#pragma unroll
        for (int i = 0; i < 2; ++i)
#pragma unroll
            for (int j = 0; j < 2; ++j) epi(acc[i][j], mt * 256 + wm * 64 + i * 32, nt * 128 + wn * 64 + j * 32, lane);
    }
}

struct EpiF32 {
    float* out; int ld;
    __device__ __forceinline__ void operator()(const f32x16& acc, int row0, int col0, int lane) const {
        const int c = col0 + (lane & 31), h = lane >> 5;
#pragma unroll
        for (int r = 0; r < 16; ++r) { out[(size_t)(row0 + (r & 3) + 8 * (r >> 2) + 4 * h) * ld + c] = acc[r]; }
    }
};

namespace pg8 {
#define PG8_LAS __attribute__((address_space(3)))
constexpr int BM = 256, BK = 64, HALF = 128, HTB = HALF * BK * 2  , STAGE_BYTES = 8 * HTB, NXCD = 8, WGM = 8;

__host__ __device__ __forceinline__ int lds_byte(int r, int c) { const int st = (r >> 4) * 2 + (c >> 5), rr = r & 15, cc = c & 31, ob = rr * 64 + cc * 2; return st * 1024 + (ob ^ (((ob >> 9) & 1) << 5)); }
__host__ __device__ __forceinline__ void stage_rc(int b, int& R, int& C) { const int st = b / 1024, sb = b % 1024, swz = sb ^ (((sb >> 9) & 1) << 5); R = (st >> 1) * 16 + swz / 64; C = (st & 1) * 32 + (swz % 64) / 2; }
__host__ __device__ __forceinline__ int perm32(int rho) { const int n = rho >> 4, i = rho & 15; return 8 * (i >> 2) + 4 * n + (i & 3); }

struct Unit { int pm, pn; };
struct Gemm { const bf16_t* A; const bf16_t* Bt; int M, N, K; };

struct StaticOrder {
    int nM, nN, nwg, G, c;
    __host__ __device__ void init(int M, int N, int G_, int c_) { nM = M / BM; nN = N / BM; nwg = nM * nN; G = G_; c = c_; }
    __host__ __device__ bool next(int i, Unit& u) const {
        const long L = (long)i * G + c; if (L >= nwg) return false;
        int wgid = (int)L; { const int q = nwg / NXCD, r = nwg % NXCD, xcd = wgid % NXCD, off = wgid / NXCD; wgid = (xcd < r ? xcd * (q + 1) : r * (q + 1) + (xcd - r) * q) + off; }
        const int nig = WGM * nN, gid = wgid / nig, fm = gid * WGM, gsz = (nM - fm) < WGM ? (nM - fm) : WGM;
        u.pm = fm + ((wgid % nig) % gsz); u.pn = (wgid % nig) / gsz; return true;
    }
    __device__ __forceinline__ void a_ready(const Unit&) const {}
    __device__ __forceinline__ void done(const Unit&) const {}
};


__device__ __forceinline__ unsigned cvt_pk_bf16(float lo, float hi) { unsigned r; asm volatile("v_cvt_pk_bf16_f32 %0, %1, %2" : "=v"(r) : "v"(lo), "v"(hi)); return r; }
struct EpiStoreBf16 {
    static constexpr bool PERM = true, AFTER_DRAIN = false;
    bf16_t* O; int ldc;
    __device__ __forceinline__ void operator()(const f32x4 (&acc)[2][2][4][2], const Unit& u, int wr, int wc, int fr, int fq) const {
        const int row0 = u.pm * BM + wr * 64 + fr, col0 = u.pn * BM + wc * 32 + 8 * fq;
#pragma unroll
        for (int ai = 0; ai < 2; ++ai)
#pragma unroll
            for (int m = 0; m < 4; ++m) { bf16_t* rowp = O + (size_t)(row0 + ai * HALF + m * 16) * ldc + col0;
#pragma unroll
                for (int bj = 0; bj < 2; ++bj) { const f32x4 v0 = acc[ai][bj][m][0], v1 = acc[ai][bj][m][1];
                    u32x4 w; w.x = cvt_pk_bf16(v0[0], v0[1]); w.y = cvt_pk_bf16(v0[2], v0[3]); w.z = cvt_pk_bf16(v1[0], v1[1]); w.w = cvt_pk_bf16(v1[2], v1[3]);
                    *(u32x4*)(rowp + bj * HALF) = w; } }
    }
};
struct EpiOutProj {
    static constexpr bool PERM = false, AFTER_DRAIN = false;
    const float* base; float* O; bf16_t* XB; float* RS;
    __device__ __forceinline__ void operator()(const f32x4 (&acc)[2][2][4][2], const Unit& u, int wr, int wc, int fr, int fq) const {
        const int row0 = u.pm * BM + wr * 64 + fr, col0 = u.pn * BM + wc * 32 + 4 * fq;
#pragma unroll
        for (int ai = 0; ai < 2; ++ai)
#pragma unroll
            for (int m = 0; m < 4; ++m) { const int row = row0 + ai * HALF + m * 16; const size_t off = (size_t)row * 1024 + col0; float ss = 0.f;
#pragma unroll
                for (int bj = 0; bj < 2; ++bj)
#pragma unroll
                    for (int n = 0; n < 2; ++n) { const f32x4 v = acc[ai][bj][m][n] + *(const f32x4*)(base + off + bj * HALF + n * 16);
                        *(f32x4*)(O + off + bj * HALF + n * 16) = v; ss += v[0] * v[0] + v[1] * v[1] + v[2] * v[2] + v[3] * v[3];
                        u32x2 w; w.x = cvt_pk_bf16(v[0], v[1]); w.y = cvt_pk_bf16(v[2], v[3]); *(u32x2*)(XB + off + bj * HALF + n * 16) = w; }
                ss += __shfl_xor(ss, 16); ss += __shfl_xor(ss, 32);
                if (fq == 0) RS[(size_t)row * 16 + u.pn * 4 + wc] = ss; }
    }
};
struct EpiRowScaleF16 {
    static constexpr bool PERM = false, AFTER_DRAIN = false;
    _Float16* O; int ldc; const float* RS;
    __device__ __forceinline__ void operator()(const f32x4 (&acc)[2][2][4][2], const Unit& u, int wr, int wc, int fr, int fq) const {
        const int row0 = u.pm * BM + wr * 64 + fr, col0 = u.pn * BM + wc * 32 + 4 * fq;
#pragma unroll
        for (int ai = 0; ai < 2; ++ai)
#pragma unroll
            for (int m = 0; m < 4; ++m) { const int row = row0 + ai * HALF + m * 16; const size_t off = (size_t)row * ldc + col0;
                float tot = 0.f;
#pragma unroll
                for (int q = 0; q < 4; ++q) { const f32x4 pr = *(const f32x4*)(RS + (size_t)row * 16 + 4 * q); tot += (pr[0] + pr[1]) + (pr[2] + pr[3]); }
                const float r = rsqrtf(tot * (1.0f / 1024.0f) + 1e-6f);
#pragma unroll
                for (int bj = 0; bj < 2; ++bj)
#pragma unroll
                    for (int n = 0; n < 2; ++n) *(f16x4*)(O + off + bj * HALF + n * 16) = __builtin_convertvector(acc[ai][bj][m][n] * r, f16x4); }
    }
};
struct EpiStoreF32 {
    static constexpr bool PERM = false, AFTER_DRAIN = false;
    const float* base; float* O; int ldc;
    __device__ __forceinline__ void operator()(const f32x4 (&acc)[2][2][4][2], const Unit& u, int wr, int wc, int fr, int fq) const {
        const int row0 = u.pm * BM + wr * 64 + fr, col0 = u.pn * BM + wc * 32 + 4 * fq;
#pragma unroll
        for (int ai = 0; ai < 2; ++ai)
#pragma unroll
            for (int m = 0; m < 4; ++m) { const size_t off = (size_t)(row0 + ai * HALF + m * 16) * ldc + col0;
#pragma unroll
                for (int bj = 0; bj < 2; ++bj)
#pragma unroll
                    for (int n = 0; n < 2; ++n) { f32x4 v = acc[ai][bj][m][n]; if (base) v += *(const f32x4*)(base + off + bj * HALF + n * 16); *(f32x4*)(O + off + bj * HALF + n * 16) = v; } }
    }
};

template <class Epi, class Sched, bool ALIGN_EPI = false, bool SP2 = false>
__device__ __forceinline__ void gemm_phase(PG8_LAS unsigned char* lds, const Gemm g, const Sched& S, const Epi& E) {
    const int tid = otid(), wid = __builtin_amdgcn_readfirstlane(tid >> 6), lane = tid & 63, wr = wid >> 2, wc = wid & 3, fr = lane & 15, fq = lane >> 4;
    const int K = g.K, nt = K / BK;
    unsigned voffA[2], voffB[2];
#pragma unroll
    for (int i = 0; i < 2; ++i) { int R, C; stage_rc(tid * 16 + i * 8192, R, C); const int Rb = Epi::PERM ? ((R & ~31) + perm32(R & 31)) : R;
        voffA[i] = (unsigned)(R * K + C) * 2u; voffB[i] = (unsigned)(Rb * K + C) * 2u; }
    const size_t kstep = (size_t)(BK * 2);
    const size_t hstep = (size_t)HALF * K * 2;
    const size_t tstep = 2 * hstep;
    const unsigned ldsw = (unsigned)wid * 1024u;
    const int aoff = lds_byte(wr * 64 + fr, fq * 8), boff = lds_byte(wc * 32 + fr, fq * 8);
#define PG8_SA(b, h) (((b) * 2 + (h)) * HTB)
#define PG8_SB(b, h) ((4 + (b) * 2 + (h)) * HTB)
#define PG8_STAGE(bufoff, gbase, voff) do { _Pragma("unroll") for (int _i = 0; _i < 2; ++_i) \
        __builtin_amdgcn_global_load_lds((const unsigned*)((const char*)(gbase) + (voff)[_i]), (PG8_LAS unsigned*)(lds + (bufoff) + ldsw + _i * 8192), 16, 0, 0); } while (0)
#define PG8_LDA(dst, b, h) do { _Pragma("unroll") for (int m = 0; m < 4; ++m) _Pragma("unroll") for (int k = 0; k < 2; ++k) dst[m][k] = *(const PG8_LAS bf16x8*)(lds + PG8_SA(b, h) + aoff + m * 2048 + k * 1024); } while (0)
#define PG8_LDB(dst, b, h) do { _Pragma("unroll") for (int n = 0; n < 2; ++n) _Pragma("unroll") for (int k = 0; k < 2; ++k) dst[n][k] = *(const PG8_LAS bf16x8*)(lds + PG8_SB(b, h) + boff + n * 2048 + k * 1024); } while (0)
#define PG8_MMA(ai, bj, At, Bt) do { __builtin_amdgcn_s_setprio(1); _Pragma("unroll") for (int m = 0; m < 4; ++m) _Pragma("unroll") for (int n = 0; n < 2; ++n) _Pragma("unroll") for (int k = 0; k < 2; ++k) \
        acc[ai][bj][m][n] = __builtin_amdgcn_mfma_f32_16x16x32_bf16(Bt[n][k], At[m][k], acc[ai][bj][m][n], 0, 0, 0); __builtin_amdgcn_s_setprio(0); } while (0)
#define PG8_WAIT_V(n) asm volatile("s_waitcnt vmcnt(" #n ")" ::: "memory")
#define PG8_WAIT_L(n) asm volatile("s_waitcnt lgkmcnt(" #n ")" ::: "memory")
#define PG8_BAR __builtin_amdgcn_s_barrier()
#define PG8_SCHED __builtin_amdgcn_sched_barrier(0)
    Unit cur, nxt; int ui = 0;
    if (!S.next(0, cur)) return;
    f32x4 acc[2][2][4][2];
#pragma unroll
    for (int a = 0; a < 2; ++a)
#pragma unroll
        for (int b = 0; b < 2; ++b)
#pragma unroll
            for (int m = 0; m < 4; ++m)
#pragma unroll
                for (int n = 0; n < 2; ++n) acc[a][b][m][n] = (f32x4){0.f, 0.f, 0.f, 0.f};
    bf16x8 At[4][2], B0[2][2], B1[2][2];
    const char* cA = (const char*)g.A + (size_t)cur.pm * tstep; const char* cB = (const char*)g.Bt + (size_t)cur.pn * tstep;
    S.a_ready(cur);
    if constexpr (SP2) {
        PG8_STAGE(PG8_SB(0, 0), cB, voffB); PG8_STAGE(PG8_SB(0, 1), cB + hstep, voffB); PG8_STAGE(PG8_SA(0, 0), cA, voffA); PG8_STAGE(PG8_SA(0, 1), cA + hstep, voffA);
        if (wr == 1) PG8_BAR;
        PG8_WAIT_V(2); PG8_BAR;
        PG8_STAGE(PG8_SB(1, 0), cB + kstep, voffB); PG8_STAGE(PG8_SA(1, 0), cA + kstep, voffA); PG8_STAGE(PG8_SB(1, 1), cB + hstep + kstep, voffB);
        PG8_WAIT_V(6); PG8_BAR;
    } else {
        PG8_STAGE(PG8_SB(0, 0), cB, voffB); PG8_STAGE(PG8_SA(0, 0), cA, voffA); PG8_STAGE(PG8_SB(0, 1), cB + hstep, voffB); PG8_STAGE(PG8_SA(0, 1), cA + hstep, voffA);
        if (wr == 1) PG8_BAR;
        PG8_WAIT_V(4); PG8_BAR;
        PG8_STAGE(PG8_SB(1, 0), cB + kstep, voffB); PG8_STAGE(PG8_SA(1, 0), cA + kstep, voffA); PG8_STAGE(PG8_SB(1, 1), cB + hstep + kstep, voffB);
        PG8_WAIT_V(6); PG8_BAR;
    }
    for (;;) {
        const bool has_next = S.next(ui + 1, nxt);
        const char* nA = has_next ? (const char*)g.A + (size_t)nxt.pm * tstep : cA; const char* nB = has_next ? (const char*)g.Bt + (size_t)nxt.pn * tstep : cB;
        for (int t = 0; t < nt; t += 2) {
            const bool last = (t == nt - 2);
            const char* a1 = cA + (size_t)(t + 1) * kstep;
            const char* a2 = last ? nA : cA + (size_t)(t + 2) * kstep; const char* b2 = last ? nB : cB + (size_t)(t + 2) * kstep;
            const char* a3 = a2 + kstep; const char* b3 = b2 + kstep;
            if (last && has_next) S.a_ready(nxt);
            if constexpr (SP2) {
            PG8_LDB(B0, 0, 0); PG8_LDB(B1, 0, 1); PG8_SCHED; PG8_LDA(At, 0, 0); PG8_STAGE(PG8_SA(1, 1), a1 + hstep, voffA);
            PG8_WAIT_V(8); PG8_WAIT_L(0); PG8_BAR; PG8_MMA(0, 0, At, B0); PG8_MMA(0, 1, At, B1); PG8_BAR; PG8_SCHED;
            PG8_LDA(At, 0, 1); PG8_STAGE(PG8_SB(0, 0), b2, voffB); PG8_STAGE(PG8_SB(0, 1), b2 + hstep, voffB); PG8_STAGE(PG8_SA(0, 0), a2, voffA);
            PG8_WAIT_V(8); PG8_WAIT_L(0); PG8_BAR; PG8_MMA(1, 0, At, B0); PG8_MMA(1, 1, At, B1); PG8_BAR; PG8_SCHED;
            PG8_LDB(B0, 1, 0); PG8_LDB(B1, 1, 1); PG8_SCHED; PG8_LDA(At, 1, 0); PG8_STAGE(PG8_SA(0, 1), a2 + hstep, voffA);
            PG8_WAIT_V(8); PG8_WAIT_L(0); PG8_BAR; PG8_MMA(0, 0, At, B0); PG8_MMA(0, 1, At, B1); PG8_BAR; PG8_SCHED;
            PG8_LDA(At, 1, 1); PG8_STAGE(PG8_SB(1, 0), b3, voffB); PG8_STAGE(PG8_SB(1, 1), b3 + hstep, voffB); PG8_STAGE(PG8_SA(1, 0), a3, voffA);
            PG8_WAIT_V(8); PG8_WAIT_L(0); PG8_BAR; PG8_MMA(1, 0, At, B0); PG8_MMA(1, 1, At, B1); PG8_BAR; PG8_SCHED;
            } else {
            PG8_LDB(B0, 0, 0); PG8_SCHED; PG8_LDA(At, 0, 0); PG8_STAGE(PG8_SA(1, 1), a1 + hstep, voffA);
            PG8_WAIT_L(8); PG8_BAR; PG8_WAIT_L(0); PG8_MMA(0, 0, At, B0); PG8_BAR; PG8_SCHED;
            PG8_LDB(B1, 0, 1); PG8_STAGE(PG8_SB(0, 0), b2, voffB);
            PG8_BAR; PG8_WAIT_L(0); PG8_MMA(0, 1, At, B1); PG8_BAR;
            PG8_LDA(At, 0, 1); PG8_STAGE(PG8_SA(0, 0), a2, voffA);
            PG8_BAR; PG8_WAIT_L(0); PG8_MMA(1, 0, At, B0); PG8_BAR; PG8_SCHED;
            PG8_STAGE(PG8_SB(0, 1), b2 + hstep, voffB);
            PG8_WAIT_V(6); PG8_BAR; PG8_MMA(1, 1, At, B1); PG8_BAR;
            PG8_LDB(B0, 1, 0); PG8_SCHED; PG8_LDA(At, 1, 0); PG8_STAGE(PG8_SA(0, 1), a2 + hstep, voffA);
            PG8_WAIT_L(8); PG8_BAR; PG8_WAIT_L(0); PG8_MMA(0, 0, At, B0); PG8_BAR; PG8_SCHED;
            PG8_LDB(B1, 1, 1); PG8_STAGE(PG8_SB(1, 0), b3, voffB);
            PG8_BAR; PG8_WAIT_L(0); PG8_MMA(0, 1, At, B1); PG8_BAR;
            PG8_LDA(At, 1, 1); PG8_STAGE(PG8_SA(1, 0), a3, voffA);
            PG8_BAR; PG8_WAIT_L(0); PG8_MMA(1, 0, At, B0); PG8_BAR; PG8_SCHED;
            PG8_STAGE(PG8_SB(1, 1), b3 + hstep, voffB);
            PG8_WAIT_V(6); PG8_BAR; PG8_MMA(1, 1, At, B1); PG8_BAR;
            }
        }
        if constexpr (ALIGN_EPI) { if (wr == 0) PG8_BAR; }
        if constexpr (!Epi::AFTER_DRAIN) { E(acc, cur, wr, wc, fr, fq); S.done(cur); }
        if (!has_next) break;
#pragma unroll
        for (int a = 0; a < 2; ++a)
#pragma unroll
            for (int b = 0; b < 2; ++b)
#pragma unroll
                for (int m = 0; m < 4; ++m)
#pragma unroll
                    for (int n = 0; n < 2; ++n) acc[a][b][m][n] = (f32x4){0.f, 0.f, 0.f, 0.f};
        cur = nxt; cA = nA; cB = nB; ++ui;
        if constexpr (ALIGN_EPI) { if (wr == 1) PG8_BAR; }
    }
    PG8_WAIT_V(0);
    if constexpr (!ALIGN_EPI) { if (wr == 0) PG8_BAR; }
    PG8_BAR;
    if constexpr (Epi::AFTER_DRAIN) { E.fused(acc, cur, wr, wc, fr, fq, lds, wid, lane); S.done(cur); }
#undef PG8_SA
#undef PG8_SB
#undef PG8_STAGE
#undef PG8_LDA
#undef PG8_LDB
#undef PG8_MMA
#undef PG8_WAIT_V
#undef PG8_WAIT_L
#undef PG8_BAR
#undef PG8_SCHED
}
}

__device__ constexpr float ROPE_INV_REV[16] = {1.591549431e-01f, 8.949940161e-02f, 5.032921210e-02f, 2.830219583e-02f, 1.591549431e-02f, 8.949940161e-03f, 5.032921210e-03f, 2.830219583e-03f, 1.591549431e-03f, 8.949940161e-04f, 5.032921210e-04f, 2.830219583e-04f, 1.591549431e-04f, 8.949940161e-05f, 5.032921210e-05f, 2.830219583e-05f};
__device__ __forceinline__ void qk_norm_rope8(const u32x4 raw, const float (&gn)[8], const float (&cs)[8], const float (&sn)[8], bool second, float scale, u32x4& out) {
    float x[8] = {bflo(raw.x), bfhi(raw.x), bflo(raw.y), bfhi(raw.y), bflo(raw.z), bfhi(raw.z), bflo(raw.w), bfhi(raw.w)};
    float ss = 0.f;
#pragma unroll
    for (int e = 0; e < 8; ++e) ss += x[e] * x[e];
    ss += __shfl_xor(ss, 1); ss += __shfl_xor(ss, 2); ss += __shfl_xor(ss, 4);
    const float r = rsqrtf(ss * (1.0f / 64.0f) + EPS) ;
    float o[8];
#pragma unroll
    for (int e = 0; e < 8; ++e) {
        const float y = x[e] * r * gn[e];
        const float other = __shfl_xor(y, 2);
        o[e] = (second ? (y * cs[e] + other * sn[e]) : (y * cs[e] - other * sn[e])) * scale;
    }
    out.x = pk2(o[0], o[1]); out.y = pk2(o[2], o[3]); out.z = pk2(o[4], o[5]); out.w = pk2(o[6], o[7]);
}
__device__ __forceinline__ void phase_qkprep(const Params& p, int layer, char* lds, bf16_t* qout) {
    const int tid = otid(), lane = tid & 63, wave = tid >> 6;
    const bf16_t* qkv = (const bf16_t*)(p.ws + R_QKV);
    const int sub = lane & 7;
    const bool second = ((sub >> 1) & 1) != 0, colaxis = (sub >> 2) != 0;
    float gq[8], gk[8], ir[8];
#pragma unroll
    for (int e = 0; e < 8; ++e) {
        gq[e] = p.in[I_QG][layer * 64 + sub * 8 + e]; gk[e] = p.in[I_KG][layer * 64 + sub * 8 + e];
        ir[e] = (sub & 1) ? ROPE_INV_REV[8 + e] : ROPE_INV_REV[e];
    }
    const int gw = obid() * NWAVE + wave, ngw = NBLK * NWAVE;
    for (int t = gw; t < T; t += ngw) {
        const int l = t & (SL - 1);
        const float pos = colaxis ? (float)(l & 63) : (float)(l >> 6);
        float cs[8], sn[8];
#pragma unroll
        for (int e = 0; e < 8; ++e) { const float a = pos * ir[e]; cs[e] = __builtin_amdgcn_cosf(a); sn[e] = __builtin_amdgcn_sinf(a); }
        const u32x4 rq = *(const u32x4*)(qkv + (size_t)t * 768 + lane * 8);
        u32x4 rk = {0u, 0u, 0u, 0u};
        if (lane < 16) rk = *(const u32x4*)(qkv + (size_t)t * 768 + 512 + lane * 8);
        u32x4 oq, ok;
        qk_norm_rope8(rq, gq, cs, sn, second, 0.125f * 1.4426950408889634f, oq);
        qk_norm_rope8(rk, gk, cs, sn, second, 1.0f, ok);
        *(u32x4*)(qout + (size_t)t * 768 + lane * 8) = oq;
        if (lane < 16) *(u32x4*)(qout + (size_t)t * 768 + 512 + lane * 8) = ok;
    }
}

#include <hip/hip_bf16.h>
#include <cmath>
namespace attn_body {
using bf16=__hip_bfloat16;
using bf16x8=__attribute__((ext_vector_type(8)))short;
using s16x4=__attribute__((ext_vector_type(4)))short;
using f32x16=__attribute__((ext_vector_type(16)))float;
using u32x4=__attribute__((ext_vector_type(4)))unsigned;
constexpr int SEQ=8192,D=64,PQ=768,PO=512;
constexpr int NW=8,QBLK=32,QB=QBLK*NW,KVBLK=64,NQB=SEQ/QB;
constexpr int ATTN_UNIT_ROWS=QB;
__device__ __forceinline__ int crow(int r,int hi){return (r&3)+8*(r>>2)+4*hi;}
#define SBAR() __builtin_amdgcn_sched_barrier(0)
__device__ __forceinline__ void cmask(f32x16&p0,f32x16&p1,int jb,int qrel,int hi){
  const float NEG=-INFINITY; int kb=64*jb+4*hi;
  #pragma unroll
  for(int r=0;r<16;++r){int kv=kb+(r&3)+8*(r>>2); if(kv>qrel)p0[r]=NEG; if(kv+32>qrel)p1[r]=NEG;}
}

constexpr int NSLOT=3, SLOTB=8192;
constexpr int LDS_K=0, LDS_V=NSLOT*SLOTB, LDS_WS=2*NSLOT*SLOTB, LDS_OST=LDS_WS+NW*64*4, LDS_BYTES=LDS_OST+NW*4096;
constexpr float C2=0.125f*1.4426950408889634f;
__device__ __forceinline__ void glds16(const void*gsrc,unsigned lds_dst){unsigned keep;
  asm volatile("s_mov_b32 %0, m0\n\ts_mov_b32 m0, %2\n\ts_nop 0\n\tglobal_load_lds_dwordx4 %1, off\n\ts_mov_b32 m0, %0":"=&s"(keep):"v"(gsrc),"s"(lds_dst):"memory");}
__device__ __forceinline__ float max3f(float a,float b,float c){float r;asm("v_max3_f32 %0, %1, %2, %3":"=v"(r):"v"(a),"v"(b),"v"(c));return r;}
__device__ __forceinline__ float max2f(float a,float b){float r;asm("v_max_f32_e32 %0, %1, %2":"=v"(r):"v"(a),"v"(b));return r;}
__device__ __forceinline__ float fadd_s(float a,float b){float r;asm("v_add_f32_e32 %0, %1, %2":"=v"(r):"v"(a),"v"(b));return r;}
__device__ __forceinline__ float fsub_s(float a,float b){float r;asm("v_sub_f32_e32 %0, %1, %2":"=v"(r):"v"(a),"v"(b));return r;}
typedef float f32x2_t __attribute__((ext_vector_type(2))); typedef __bf16 bf16x2_t __attribute__((ext_vector_type(2)));
__device__ __forceinline__ unsigned cvtpk_s(float lo,float hi){f32x2_t v={lo,hi};bf16x2_t b=__builtin_convertvector(v,bf16x2_t);return __builtin_bit_cast(unsigned,b);}
#define WAIT_BAR(N) asm volatile("s_waitcnt vmcnt(" #N ") lgkmcnt(0)\n\ts_barrier":::"memory")

__device__ __forceinline__ void qkt(f32x16&p0,f32x16&p1,const char*Kslot,const bf16x8*qr,const f32x16&negm,int r32,int hi){
  const char*kb=Kslot+hi*1024+r32*16;
  #pragma unroll
  for(int d0=0;d0<4;++d0){
    const bf16x8 b0=*reinterpret_cast<const bf16x8*>(kb+d0*2048);
    const bf16x8 b1=*reinterpret_cast<const bf16x8*>(kb+d0*2048+512);
    if(d0==0){p0=__builtin_amdgcn_mfma_f32_32x32x16_bf16(b0,qr[0],negm,0,0,0);p1=__builtin_amdgcn_mfma_f32_32x32x16_bf16(b1,qr[0],negm,0,0,0);}
    else{p0=__builtin_amdgcn_mfma_f32_32x32x16_bf16(b0,qr[d0],p0,0,0,0);p1=__builtin_amdgcn_mfma_f32_32x32x16_bf16(b1,qr[d0],p1,0,0,0);}}
}
typedef __attribute__((address_space(3))) const char* lds_cptr;
typedef short v4i16_t __attribute__((ext_vector_type(4)));
__device__ __forceinline__ void kload8(bf16x8*kf,lds_cptr kp){
  kf[0]=*(const __attribute__((address_space(3))) bf16x8*)(kp);      kf[1]=*(const __attribute__((address_space(3))) bf16x8*)(kp+512);
  kf[2]=*(const __attribute__((address_space(3))) bf16x8*)(kp+2048); kf[3]=*(const __attribute__((address_space(3))) bf16x8*)(kp+2560);
  kf[4]=*(const __attribute__((address_space(3))) bf16x8*)(kp+4096); kf[5]=*(const __attribute__((address_space(3))) bf16x8*)(kp+4608);
  kf[6]=*(const __attribute__((address_space(3))) bf16x8*)(kp+6144); kf[7]=*(const __attribute__((address_space(3))) bf16x8*)(kp+6656);
}
__device__ __forceinline__ void kload2(bf16x8*kf,lds_cptr kp,int j){ kf[2*j]=*(const __attribute__((address_space(3))) bf16x8*)(kp+j*2048); kf[2*j+1]=*(const __attribute__((address_space(3))) bf16x8*)(kp+j*2048+512); }
__device__ __forceinline__ s16x4 vtr(lds_cptr p){ return __builtin_bit_cast(s16x4,__builtin_amdgcn_ds_read_tr16_b64_v4i16((__attribute__((address_space(3))) v4i16_t*)p)); }
__device__ __forceinline__ float rowmax(const f32x16&p0,const f32x16&p1){
  float a=max3f(p0[0],p0[1],p1[0]),b=max3f(p0[2],p0[3],p1[1]);a=max3f(a,p1[2],p1[3]);
  #pragma unroll
  for(int r=4;r<16;r+=4){a=max3f(a,p0[r],p0[r+1]);b=max3f(b,p0[r+2],p0[r+3]);a=max3f(a,p1[r],p1[r+1]);b=max3f(b,p1[r+2],p1[r+3]);}
  const float m=max2f(a,b);
  auto rr=__builtin_amdgcn_permlane32_swap(__float_as_uint(m),__float_as_uint(m),false,false);
  return max2f(__uint_as_float(rr[0]),__uint_as_float(rr[1]));
}
__device__ __forceinline__ void pv(f32x16*o,int vb,bf16x8 pa0,bf16x8 pa1,bf16x8 pa2,bf16x8 pa3){
  #pragma unroll
  for(int d0=0;d0<2;++d0){s16x4 lo[4],hi[4];
    #pragma unroll
    for(int ks=0;ks<4;++ks){
      asm volatile("ds_read_b64_tr_b16 %0,%1 offset:%c2":"=&v"(lo[ks]):"v"(vb),"i"(d0*4096+ks*1024):"memory");
      asm volatile("ds_read_b64_tr_b16 %0,%1 offset:%c2":"=&v"(hi[ks]):"v"(vb),"i"(d0*4096+ks*1024+512):"memory");}
    asm volatile("s_waitcnt lgkmcnt(0)":::"memory");SBAR();
    #define PK(k) (bf16x8){lo[k][0],lo[k][1],lo[k][2],lo[k][3],hi[k][0],hi[k][1],hi[k][2],hi[k][3]}
    o[d0]=__builtin_amdgcn_mfma_f32_32x32x16_bf16(pa0,PK(0),o[d0],0,0,0);
    o[d0]=__builtin_amdgcn_mfma_f32_32x32x16_bf16(pa1,PK(1),o[d0],0,0,0);
    o[d0]=__builtin_amdgcn_mfma_f32_32x32x16_bf16(pa2,PK(2),o[d0],0,0,0);
    o[d0]=__builtin_amdgcn_mfma_f32_32x32x16_bf16(pa3,PK(3),o[d0],0,0,0);
    #undef PK
  }
}

#ifndef ATTN_STORE16
#define ATTN_STORE16(p,v) (*(u32x4*)(p)=(v))
#endif
template<int THRL> __device__ __forceinline__ void attn_unit(int b,int h,int g,int qb,const bf16*Q,const bf16*__restrict__ K,const bf16*__restrict__ V,bf16*O,char*shm){
  const int tid=otid(),lane=tid&63,r32=lane&31,hi=lane>>5; const int wid=__builtin_amdgcn_readfirstlane(tid>>6);
  const long rowbase=(long)b*SEQ; const int q0=qb*QB;
  const bf16*Qw=Q+(rowbase+q0+wid*QBLK)*PQ+h*D;
  const bf16*Kh=K+rowbase*PQ+g*D,*Vh=V+rowbase*PQ+g*D;
  const unsigned lds0=(unsigned)(uintptr_t)shm;
  float*wsf=(float*)(shm+LDS_WS)+wid*64;
  const bf16*ksrc=Kh+(long)lane*PQ+wid*8;
  const bf16*vsrc=Vh+(long)(16*(wid&3)+(lane>>2))*PQ+(wid>>2)*32+(lane&3)*8;
  const unsigned kdst=lds0+LDS_K+wid*1024, vdst=lds0+LDS_V+wid*1024;
  #define DMA_K(t,slot) glds16(ksrc+(long)(t)*KVBLK*PQ,(unsigned)__builtin_amdgcn_readfirstlane(kdst+(slot)))
  #define DMA_V(t,slot) glds16(vsrc+(long)(t)*KVBLK*PQ,(unsigned)__builtin_amdgcn_readfirstlane(vdst+(slot)))
  const int vb0=(int)(lds0+LDS_V)+((lane>>4)&1)*32+(lane&3)*8+(4*hi+((lane&15)>>2))*64;
  const char*Kbase=shm+LDS_K; bf16x8 kf[8];
  const lds_cptr shm3=(lds_cptr)shm; const lds_cptr kp0=shm3+LDS_K+hi*1024+r32*16; const lds_cptr vp0=shm3+LDS_V+((lane>>4)&1)*32+(lane&3)*8+(4*hi+((lane&15)>>2))*64;
  constexpr int NT=SEQ/KVBLK;
  DMA_K(0,0);DMA_V(0,0);DMA_K(1,SLOTB);
  bf16x8 qr[4];
  #pragma unroll
  for(int d0=0;d0<4;++d0)qr[d0]=*reinterpret_cast<const bf16x8*>(&Qw[(long)r32*PQ+d0*16+hi*8]);
  float mhat=0.f,l_reg=0.f;f32x16 o[2];o[0]=f32x16{};o[1]=f32x16{};f32x16 negm=f32x16{};asm volatile("":"+v"(negm));
    #define CMASK(P0,P1,t) do{}while(0)
  bool resc=false;
  #define START(P0,P1) do{ const float rm=rowmax(P0,P1); resc=false; \
    { const float dl=rm; mhat=fadd_s(mhat,dl); \
      _Pragma("unroll") for(int r=0;r<16;++r){P0[r]=fsub_s(P0[r],dl);P1[r]=fsub_s(P1[r],dl);} \
      _Pragma("unroll") for(int r=0;r<16;++r)negm[r]=-mhat; asm volatile("":"+v"(negm)); } \
    _Pragma("unroll") for(int r=0;r<16;++r)P0[r]=__builtin_amdgcn_exp2f(P0[r]); }while(0)
  #define RESC() do{ if(resc){ asm volatile("s_waitcnt lgkmcnt(0)":::"memory"); \
      _Pragma("unroll") for(int d_=0;d_<2;++d_) _Pragma("unroll") for(int r=0;r<16;++r)o[d_][r]*=wsf[crow(r,hi)]; } }while(0)
  f32x16 pA0,pA1,pB0,pB1;
  int sl_prev=0,sl_cur=0,sl_next=SLOTB;
  #define ROT() do{sl_prev=sl_cur;sl_cur=sl_next;sl_next=(sl_next==(NSLOT-1)*SLOTB)?0:sl_next+SLOTB;}while(0)
  DMA_K(2,2*SLOTB);
  WAIT_BAR(3);
  qkt(pA0,pA1,Kbase,qr,negm,r32,hi);asm volatile("s_nop 15\n\ts_nop 7":"+v"(pA0),"+v"(pA1));CMASK(pA0,pA1,0);
  START(pA0,pA1);
  _Pragma("unroll") for(int r=0;r<16;++r)pA1[r]=__builtin_amdgcn_exp2f(pA1[r]);
  WAIT_BAR(0);
  DMA_K(3,0);DMA_V(1,SLOTB);
  ROT();
  kload8(kf,kp0+sl_cur);
  WAIT_BAR(2);
  s16x4 vlo[8],vhi[8]; u32x4 pw0,pw1,pw2,pw3;
  #define PKW(P,B) cvtpk_s(P[B],P[B+1])
  #define PAF(k) __builtin_bit_cast(bf16x8,pw##k)
  #define VFR(i) (bf16x8){vlo[i][0],vlo[i][1],vlo[i][2],vlo[i][3],vhi[i][0],vhi[i][1],vhi[i][2],vhi[i][3]}
  #define PIN(x) asm volatile("":"+v"(x))
  #define MX3(a,b,c) __builtin_fmaxf(__builtin_fmaxf((a),(b)),(c))
  #define GAPA(MF,A0,A1,A2,A3,W0,W1,PW) do{ MF; sacc+=A0; sacc+=A1; sacc+=A2; sacc+=A3; PIN(sacc); W0; W1; PIN(PW); SBAR(); }while(0)
  #define EX(v) __builtin_amdgcn_exp2f(v)
  #define GAPB(MF,X,B) do{ MF; X[B]=EX(X[B]); X[B+1]=EX(X[B+1]); X[B+2]=EX(X[B+2]); X[B+3]=EX(X[B+3]); PIN(X); SBAR(); }while(0)
  #define VRD(i) do{ vlo[i]=vtr(vp_+(((i)>>2)*4096+((i)&3)*1024)); vhi[i]=vtr(vp_+(((i)>>2)*4096+((i)&3)*1024+512)); }while(0)
  #define KRD(G,j) do{ if(G){ kload2(kf,kp0+sl_next,j); SBAR(); } }while(0)
  #define STEP(C0,C1,P0,P1,t,GK,GV,GL) do{ SBAR(); \
    const lds_cptr vp_=vp0+sl_prev; \
    VRD(0); SBAR(); float sacc=(P0[0]+P0[1]); \
    GAPA(C0=__builtin_amdgcn_mfma_f32_32x32x16_bf16(kf[0],qr[0],negm,0,0,0), P0[2],P0[3],P0[4],P0[5],     pw0[0]=PKW(P0,0), pw0[1]=PKW(P0,2), pw0); \
    VRD(4); SBAR(); GAPA(C1=__builtin_amdgcn_mfma_f32_32x32x16_bf16(kf[1],qr[0],negm,0,0,0), P0[6],P0[7],P0[8],P0[9],     pw0[2]=PKW(P0,4), pw0[3]=PKW(P0,6), pw0); \
    VRD(1); SBAR(); GAPA(C0=__builtin_amdgcn_mfma_f32_32x32x16_bf16(kf[2],qr[1],C0,0,0,0),   P0[10],P0[11],P0[12],P0[13], pw1[0]=PKW(P0,8), pw1[1]=PKW(P0,10), pw1); \
    VRD(5); SBAR(); GAPA(C1=__builtin_amdgcn_mfma_f32_32x32x16_bf16(kf[3],qr[1],C1,0,0,0),   P0[14],P0[15],P1[0],P1[1],   pw1[2]=PKW(P0,12),pw1[3]=PKW(P0,14), pw1); \
    VRD(2); SBAR(); GAPA(C0=__builtin_amdgcn_mfma_f32_32x32x16_bf16(kf[4],qr[2],C0,0,0,0),   P1[2],P1[3],P1[4],P1[5],     pw2[0]=PKW(P1,0), pw2[1]=PKW(P1,2), pw2); \
    VRD(6); SBAR(); GAPA(C1=__builtin_amdgcn_mfma_f32_32x32x16_bf16(kf[5],qr[2],C1,0,0,0),   P1[6],P1[7],P1[8],P1[9],     pw2[2]=PKW(P1,4), pw2[3]=PKW(P1,6), pw2); \
    VRD(3); SBAR(); GAPA(C0=__builtin_amdgcn_mfma_f32_32x32x16_bf16(kf[6],qr[3],C0,0,0,0),   P1[10],P1[11],P1[12],P1[13], pw3[0]=PKW(P1,8), pw3[1]=PKW(P1,10), pw3); \
    VRD(7); SBAR(); GAPA(C1=__builtin_amdgcn_mfma_f32_32x32x16_bf16(kf[7],qr[3],C1,0,0,0),   P1[14],P1[15],0.f,0.f,       pw3[2]=PKW(P1,12),pw3[3]=PKW(P1,14), pw3); \
    l_reg+=sacc; \
    if(GK){DMA_K((t)+3,sl_cur);} if(GV){DMA_V((t)+1,sl_next);} \
    CMASK(C0,C1,t); \
    { float a=MX3(C0[0],C0[1],C1[0]),b=MX3(C0[2],C0[3],C1[1]); a=MX3(a,C1[2],C1[3]); \
      _Pragma("unroll") for(int r=4;r<16;r+=4){a=MX3(a,C0[r],C0[r+1]);b=MX3(b,C0[r+2],C0[r+3]);a=MX3(a,C1[r],C1[r+1]);b=MX3(b,C1[r+2],C1[r+3]);} \
      float rm=__builtin_fmaxf(a,b); { auto rr=__builtin_amdgcn_permlane32_swap(__float_as_uint(rm),__float_as_uint(rm),false,false); rm=__builtin_fmaxf(__uint_as_float(rr[0]),__uint_as_float(rr[1])); } \
      resc=false; \
      if(__builtin_expect(__any(rm>(float)THRL),0)){ const float dl=__builtin_fmaxf(rm,0.f); mhat+=dl; \
        _Pragma("unroll") for(int r=0;r<16;++r){C0[r]-=dl;C1[r]-=dl;} \
        _Pragma("unroll") for(int r=0;r<16;++r)negm[r]=-mhat; asm volatile("":"+v"(negm)); \
        const float f=__builtin_amdgcn_exp2f(-dl); l_reg*=f; if(hi==0)wsf[r32]=f; resc=true; } } \
    SBAR(); \
    GAPB(o[0]=__builtin_amdgcn_mfma_f32_32x32x16_bf16(PAF(0),VFR(0),o[0],0,0,0), C0,0); \
    GAPB(o[1]=__builtin_amdgcn_mfma_f32_32x32x16_bf16(PAF(0),VFR(4),o[1],0,0,0), C0,4); \
    KRD(GL,0); GAPB(o[0]=__builtin_amdgcn_mfma_f32_32x32x16_bf16(PAF(1),VFR(1),o[0],0,0,0), C0,8); \
    KRD(GL,1); GAPB(o[1]=__builtin_amdgcn_mfma_f32_32x32x16_bf16(PAF(1),VFR(5),o[1],0,0,0), C0,12); \
    KRD(GL,2); GAPB(o[0]=__builtin_amdgcn_mfma_f32_32x32x16_bf16(PAF(2),VFR(2),o[0],0,0,0), C1,0); \
    KRD(GL,3); GAPB(o[1]=__builtin_amdgcn_mfma_f32_32x32x16_bf16(PAF(2),VFR(6),o[1],0,0,0), C1,4); \
    GAPB(o[0]=__builtin_amdgcn_mfma_f32_32x32x16_bf16(PAF(3),VFR(3),o[0],0,0,0), C1,8); \
    GAPB(o[1]=__builtin_amdgcn_mfma_f32_32x32x16_bf16(PAF(3),VFR(7),o[1],0,0,0), C1,12); \
    }while(0)
  int t=1;
  #undef CMASK
  #define CMASK(P0,P1,t) do{}while(0)
  for(;t+5<NT;t+=2){
    STEP(pB0,pB1,pA0,pA1,t,true,true,true);     WAIT_BAR(2); RESC(); ROT();
    STEP(pA0,pA1,pB0,pB1,t+1,true,true,true);   WAIT_BAR(2); RESC(); ROT();
  }
  #define ENDW(tt) do{ if((tt)+3<NT){WAIT_BAR(2);} else if((tt)+2<NT){WAIT_BAR(1);} else {WAIT_BAR(0);} }while(0)
  for(;t+1<NT;t+=2){
    STEP(pB0,pB1,pA0,pA1,t,(t+3<NT),(t+1<NT),(t+1<NT));       ENDW(t);   RESC(); ROT();
    STEP(pA0,pA1,pB0,pB1,t+1,(t+4<NT),(t+2<NT),(t+2<NT));     ENDW(t+1); RESC(); ROT();
  }
  STEP(pB0,pB1,pA0,pA1,NT-1,false,false,false); RESC();
  { float sacc=pB0[0]+pB0[1]; _Pragma("unroll") for(int r=2;r<16;++r)sacc+=pB0[r]; _Pragma("unroll") for(int r=0;r<16;++r)sacc+=pB1[r]; l_reg+=sacc;
    pw0=(u32x4){PKW(pB0,0),PKW(pB0,2),PKW(pB0,4),PKW(pB0,6)};pw1=(u32x4){PKW(pB0,8),PKW(pB0,10),PKW(pB0,12),PKW(pB0,14)};pw2=(u32x4){PKW(pB1,0),PKW(pB1,2),PKW(pB1,4),PKW(pB1,6)};pw3=(u32x4){PKW(pB1,8),PKW(pB1,10),PKW(pB1,12),PKW(pB1,14)};
    SBAR(); pv(o,vb0+sl_cur,PAF(0),PAF(1),PAF(2),PAF(3)); }
  #undef PKW
  #undef PAF
  #undef VFR
  #undef PIN
  #undef MX3
  #undef GAPA
  #undef GAPB
  #undef EX
  #undef VRD
  #undef KRD
  #undef STEP
  #undef ENDW
  {auto rr=__builtin_amdgcn_permlane32_swap(__float_as_uint(l_reg),__float_as_uint(l_reg),false,false);l_reg=__uint_as_float(rr[0])+__uint_as_float(rr[1]);}
  if(hi==0)wsf[32+r32]=l_reg;asm volatile("s_waitcnt lgkmcnt(0)":::"memory");
  float rli[16];
  #pragma unroll
  for(int r=0;r<16;++r)rli[r]=__builtin_amdgcn_rcpf(wsf[32+crow(r,hi)]);
  bf16*Ow=O+(rowbase+q0+wid*QBLK)*PO+h*D;
  { bf16*stg=(bf16*)(shm+LDS_OST)+wid*2048;
    #pragma unroll
    for(int r=0;r<16;++r){const int orow=crow(r,hi);
      #pragma unroll
      for(int d0=0;d0<2;++d0)stg[orow*64+d0*32+r32]=__float2bfloat16(o[d0][r]*rli[r]);}
    asm volatile("s_waitcnt lgkmcnt(0)":::"memory");
    #pragma unroll
    for(int i=0;i<4;++i){const int row=i*8+(lane>>3),ch=lane&7; const u32x4 v=*(const u32x4*)(stg+row*64+ch*8); ATTN_STORE16(Ow+(long)row*PO+ch*8,v);} }
  asm volatile("s_waitcnt lgkmcnt(0)\n\ts_barrier":::"memory");
  #undef DMA_K
  #undef DMA_V
  #undef CMASK
  #undef START
  #undef RESC
  #undef ROT
}
constexpr int ATTN_LDS_BYTES=LDS_BYTES;
#undef SBAR
#undef WAIT_BAR
}

__device__ __forceinline__ void phase_attn(const Params& p, char* lds) {
            {
                const int bid = obid();
                const int vcu = ((NBLK & 7) == 0) ? (bid & 7) * (int)(NBLK >> 3) + (bid >> 3) : bid;
                const attn_body::bf16* qkvb = (const attn_body::bf16*)(p.ws + R_QKV);
                for (int u = vcu; u < 512; u += NBLK) {
                    const int bg = (u & 255) >> 6, r = u & 63, hh = r & 3, qb = (r >> 2) + 16 * (u >> 8);
                    const int b = bg >> 1, g = bg & 1;
                    attn_body::attn_unit<8>(b, 4 * g + hh, g, qb, qkvb, qkvb + 512, qkvb + 640, (attn_body::bf16*)(p.ws + R_ATT), lds);
                }
            }
}

__device__ __forceinline__ size_t cidx(int c, int t) { return ((size_t)(t >> 5) * 256 + c) * 32 + (t & 31); }
__device__ __forceinline__ f32x4 convd4(const float* row, int l0, float w0, float w1, float w2, float cb) {
    const f32x4 c = *(const f32x4*)(row + l0);
    const float lft = (l0 > 0) ? row[l0 - 1] : 0.f;
    const float rgt = (l0 + 4 < SL) ? row[l0 + 4] : 0.f;
    f32x4 o;
    o.x = cb + w0 * lft + w1 * c.x + w2 * c.y;
    o.y = cb + w0 * c.x + w1 * c.y + w2 * c.z;
    o.z = cb + w0 * c.y + w1 * c.z + w2 * c.w;
    o.w = cb + w0 * c.z + w1 * c.w + w2 * rgt;
    return o;
}
__device__ __forceinline__ void cmul_kf(float2* Z, const float2* KF, int tid) {
#pragma unroll 4
    for (int i = 0; i < 16; ++i) {
        const int pp = 2 * tid + 1024 * i;
        const f32x4 z = *(const f32x4*)(Z + zp(pp)), k = *(const f32x4*)(KF + pp);
        f32x4 o; o.x = z.x * k.x - z.y * k.y; o.y = z.x * k.y + z.y * k.x; o.z = z.z * k.z - z.w * k.w; o.w = z.z * k.w + z.w * k.z;
        *(f32x4*)(Z + zp(pp)) = o;
    }
}
__device__ __forceinline__ void hyena_job(const Params& p, int layer, int c, char* lds) {
    const int tid = otid();
    float2* Z = (float2*)lds;
    const float* HF = (const float*)(p.ws + R_HF);
    const float* cw = p.in[I_CW] + (size_t)layer * 3 * 768; const float* cbp = p.in[I_CB] + layer * 768;
    const float2* KF0 = (const float2*)(p.ws + OFF_KF) + ((size_t)(layer * 256 + c) * 2) * 16384;
    const float2* KF1 = KF0 + 16384;
    float* Yb = (float*)(p.ws + R_Y);
    const float bias0 = p.in[I_HB][(layer * 2 + 0) * 256 + c], bias1 = p.in[I_HB][(layer * 2 + 1) * 256 + c];
    const int cv = c, c1 = 256 + c, c2 = 512 + c;
    const float* rv = HF + (size_t)cv * T; const float* r1 = HF + (size_t)c1 * T; const float* r2 = HF + (size_t)c2 * T;
    const float v_w0 = cw[cv], v_w1 = cw[768 + cv], v_w2 = cw[1536 + cv], v_cb = cbp[cv];
    const float a_w0 = cw[c1], a_w1 = cw[768 + c1], a_w2 = cw[1536 + c1], a_cb = cbp[c1];
    const float b_w0 = cw[c2], b_w1 = cw[768 + c2], b_w2 = cw[1536 + c2], b_cb = cbp[c2];
    const f32x4 zero4 = {0.f, 0.f, 0.f, 0.f};
    __syncthreads();
#pragma unroll 1
    for (int i = 0; i < 4; ++i) {
        const int l0 = 4 * otid() + 2048 * i;
        const f32x4 va = convd4(rv, l0, v_w0, v_w1, v_w2, v_cb), vb = convd4(rv + SL, l0, v_w0, v_w1, v_w2, v_cb);
        *(f32x4*)(Z + zp(l0)) = (f32x4){va.x, vb.x, va.y, vb.y}; *(f32x4*)(Z + zp(l0) + 2) = (f32x4){va.z, vb.z, va.w, vb.w};
        *(f32x4*)(Z + zp(8192 + l0)) = zero4; *(f32x4*)(Z + zp(8192 + l0) + 2) = zero4;
    }
    __syncthreads();
    fft16k_fwd(Z);
    cmul_kf(Z, KF0, otid());
    __syncthreads();
    fft16k_inv(Z);
#pragma unroll 1
    for (int i = 0; i < 4; ++i) {
        const int l0 = 4 * otid() + 2048 * i;
        const f32x4 za = *(const f32x4*)(Z + zp(l0)), zb = *(const f32x4*)(Z + zp(l0) + 2);
        const f32x4 va = convd4(rv, l0, v_w0, v_w1, v_w2, v_cb), vb = convd4(rv + SL, l0, v_w0, v_w1, v_w2, v_cb);
        const f32x4 ga = convd4(r1, l0, a_w0, a_w1, a_w2, a_cb), gb = convd4(r1 + SL, l0, a_w0, a_w1, a_w2, a_cb);
        f32x4 ya, yb;
        ya.x = ga.x * (za.x + va.x * bias0); ya.y = ga.y * (za.z + va.y * bias0); ya.z = ga.z * (zb.x + va.z * bias0); ya.w = ga.w * (zb.z + va.w * bias0);
        yb.x = gb.x * (za.y + vb.x * bias0); yb.y = gb.y * (za.w + vb.y * bias0); yb.z = gb.z * (zb.y + vb.z * bias0); yb.w = gb.w * (zb.w + vb.w * bias0);
        *(f32x4*)(Yb + cidx(c, l0)) = ya; *(f32x4*)(Yb + cidx(c, SL + l0)) = yb;
        *(f32x4*)(Z + zp(l0)) = (f32x4){ya.x, yb.x, ya.y, yb.y}; *(f32x4*)(Z + zp(l0) + 2) = (f32x4){ya.z, yb.z, ya.w, yb.w};
        *(f32x4*)(Z + zp(8192 + l0)) = zero4; *(f32x4*)(Z + zp(8192 + l0) + 2) = zero4;
    }
    __syncthreads();
    fft16k_fwd(Z);
    cmul_kf(Z, KF1, otid());
    __syncthreads();
    fft16k_inv(Z);
#pragma unroll 1
    for (int i = 0; i < 4; ++i) {
        const int l0 = 4 * otid() + 2048 * i;
        const f32x4 za = *(const f32x4*)(Z + zp(l0)), zb = *(const f32x4*)(Z + zp(l0) + 2);
        const f32x4 ga = convd4(r2, l0, b_w0, b_w1, b_w2, b_cb), gb = convd4(r2 + SL, l0, b_w0, b_w1, b_w2, b_cb);
        const f32x4 pa = *(const f32x4*)(Yb + cidx(c, l0)), pb = *(const f32x4*)(Yb + cidx(c, SL + l0));
        f32x4 ya, yb;
        ya.x = ga.x * (za.x + pa.x * bias1); ya.y = ga.y * (za.z + pa.y * bias1); ya.z = ga.z * (zb.x + pa.z * bias1); ya.w = ga.w * (zb.z + pa.w * bias1);
        yb.x = gb.x * (za.y + pb.x * bias1); yb.y = gb.y * (za.w + pb.y * bias1); yb.z = gb.z * (zb.y + pb.z * bias1); yb.w = gb.w * (zb.w + pb.w * bias1);
        *(f32x4*)(Yb + cidx(c, l0)) = ya; *(f32x4*)(Yb + cidx(c, SL + l0)) = yb;
    }
    __syncthreads();
}

__device__ __forceinline__ void fnet_job(const Params& p, int ch, char* lds) {
    const int tid = otid();
    float2* Z = (float2*)lds;
    const float* row = (const float*)(p.ws + R_HF) + (size_t)(768 + ch) * T;
    float* UR = (float*)(p.ws + R_UR);
    float* UI = (float*)(p.ws + R_UI);
    __syncthreads();
#pragma unroll
    for (int i = 0; i < 4; ++i) {
        const int l0 = 4 * tid + 2048 * i;
        const f32x4 a = *(const f32x4*)(row + l0), b = *(const f32x4*)(row + SL + l0);
        const int z0 = zp(l0);
        *(f32x4*)(Z + z0) = (f32x4){a.x, b.x, a.y, b.y}; *(f32x4*)(Z + z0 + 2) = (f32x4){a.z, b.z, a.w, b.w};
    }
    __syncthreads();
    fft8k_fwd(Z);
#pragma unroll
    for (int i = 0; i < 4; ++i) {
        const int k0 = 4 * tid + 2048 * i;
        f32x4 ur0, ui0, ur1, ui1;
#pragma unroll
        for (int e = 0; e < 4; ++e) {
            const int k = k0 + e;
            const int pk = p8k_of_f(k);
            const int pm = p8k_of_f((SL - k) & (SL - 1));
            const float2 zk = Z[zp(pk)], zm = Z[zp(pm)];
            ur0[e] = 0.5f * (zk.x + zm.x); ui0[e] = 0.5f * (zk.y - zm.y);
            ur1[e] = 0.5f * (zk.y + zm.y); ui1[e] = 0.5f * (zm.x - zk.x);
        }
        *(f32x4*)(UR + cidx(ch, k0)) = ur0; *(f32x4*)(UI + cidx(ch, k0)) = ui0; *(f32x4*)(UR + cidx(ch, SL + k0)) = ur1; *(f32x4*)(UI + cidx(ch, SL + k0)) = ui1;
    }
    __syncthreads();
}

__device__ __forceinline__ void phase_mix(const Params& p, int layer, char* lds) {
    const int tid = otid(), lane = tid & 63, wave = tid >> 6;
    const int l31 = lane & 31, hl = lane >> 5, g = wave & 3, tsel = wave >> 2;
    float* ex = (float*)lds;
    float* FMl = (float*)(lds + 8192);
    const float* UR = (const float*)(p.ws + R_UR); const float* UI = (const float*)(p.ws + R_UI);
    const float* Y = (const float*)(p.ws + R_Y);
    const bf16_t* att = (const bf16_t*)(p.ws + R_ATT);
    bf16_t* mix = (bf16_t*)(p.ws + R_MIX);
    const float* fb = p.in[I_FB] + layer * 256 + g * 64;
    const float* mg = p.in[I_MG] + layer * 1024;
    __syncthreads();
    {
        const f32x4* src = (const f32x4*)((const float*)(p.ws + OFF_FM) + (size_t)layer * 4 * 128 * 64);
#pragma unroll 4
        for (int i = 0; i < 16; ++i) *(f32x4*)(FMl + 4 * (tid + NTHR * i)) = src[tid + NTHR * i];
    }
    for (int tp = obid(); tp < T / 64; tp += NBLK) {
        const int t = (tp * 2 + tsel) * 32 + l31;
        float bv[64];
        {
            const float* ub = UR + cidx(g * 64 + hl, t);
            const float* ub2 = UI + cidx(g * 64 + hl, t);
#pragma unroll
            for (int i = 0; i < 32; ++i) { bv[i] = ub[(2 * i) * 32]; bv[32 + i] = ub2[(2 * i) * 32]; }
        }
        float yv[32];
        {
            const float* yb = Y + cidx(g * 64 + hl * 32, t);
#pragma unroll
            for (int i = 0; i < 32; ++i) yv[i] = yb[i * 32];
        }
        const bf16_t* ab = att + (size_t)t * 512 + g * 128 + hl * 64;
        float sa = 0.f;
#pragma unroll
        for (int q = 0; q < 8; ++q) {
            const u32x4 a = *(const u32x4*)(ab + 8 * q);
            const float x0 = bflo(a.x), x1 = bfhi(a.x), x2 = bflo(a.y), x3 = bfhi(a.y), x4 = bflo(a.z), x5 = bfhi(a.z), x6 = bflo(a.w), x7 = bfhi(a.w);
            sa += x0 * x0 + x1 * x1 + x2 * x2 + x3 * x3 + x4 * x4 + x5 * x5 + x6 * x6 + x7 * x7;
        }
        __syncthreads();
        f32x16 acc0 = zero16(), acc1 = zero16();
        {
            const float* fa = FMl + (g * 128 + hl) * 64 + l31;
#pragma unroll
            for (int i = 0; i < 64; ++i) {
                const float a0 = fa[(2 * i) * 64], a1 = fa[(2 * i) * 64 + 32];
                acc0 = __builtin_amdgcn_mfma_f32_32x32x2f32(a0, bv[i], acc0, 0, 0, 0);
                acc1 = __builtin_amdgcn_mfma_f32_32x32x2f32(a1, bv[i], acc1, 0, 0, 0);
            }
        }
        float sf = 0.f;
#pragma unroll
        for (int i = 0; i < 4; ++i) {
            const f32x4 b0 = *(const f32x4*)(fb + 8 * i + 4 * hl), b1 = *(const f32x4*)(fb + 32 + 8 * i + 4 * hl);
            acc0[4 * i] += b0.x; acc0[4 * i + 1] += b0.y; acc0[4 * i + 2] += b0.z; acc0[4 * i + 3] += b0.w;
            acc1[4 * i] += b1.x; acc1[4 * i + 1] += b1.y; acc1[4 * i + 2] += b1.z; acc1[4 * i + 3] += b1.w;
        }
#pragma unroll
        for (int r = 0; r < 16; ++r) sf += acc0[r] * acc0[r] + acc1[r] * acc1[r];
        float sy = 0.f;
#pragma unroll
        for (int i = 0; i < 32; ++i) sy += yv[i] * yv[i];
        ex[(0 * 8 + wave) * 64 + lane] = sa; ex[(1 * 8 + wave) * 64 + lane] = sy; ex[(2 * 8 + wave) * 64 + lane] = sf;
        __syncthreads();
        float ta = 0.f, ty = 0.f, tf = 0.f;
#pragma unroll
        for (int w = 0; w < 4; ++w)
#pragma unroll
            for (int hh = 0; hh < 2; ++hh) {
                const int o = (tsel * 4 + w) * 64 + hh * 32 + l31;
                ta += ex[0 * 512 + o]; ty += ex[1 * 512 + o]; tf += ex[2 * 512 + o];
            }
        const float ra = rsqrtf(ta * (1.0f / 512.0f) + EPS), ry = rsqrtf(ty * (1.0f / 256.0f) + EPS), rf = rsqrtf(tf * (1.0f / 256.0f) + EPS);
        bf16_t* mrow = mix + (size_t)t * 1024;
        {
            const float* gg = mg + g * 128 + hl * 64;
#pragma unroll
            for (int q = 0; q < 8; ++q) {
                const u32x4 a = *(const u32x4*)(ab + 8 * q);
                const f32x4 g0 = *(const f32x4*)(gg + 8 * q), g1 = *(const f32x4*)(gg + 8 * q + 4);
                u32x4 o;
                o.x = pk2(bflo(a.x) * ra * g0.x, bfhi(a.x) * ra * g0.y); o.y = pk2(bflo(a.y) * ra * g0.z, bfhi(a.y) * ra * g0.w);
                o.z = pk2(bflo(a.z) * ra * g1.x, bfhi(a.z) * ra * g1.y); o.w = pk2(bflo(a.w) * ra * g1.z, bfhi(a.w) * ra * g1.w);
                *(u32x4*)(mrow + g * 128 + hl * 64 + 8 * q) = o;
            }
        }
        {
            const float* gg = mg + 512 + g * 64 + hl * 32;
#pragma unroll
            for (int q = 0; q < 4; ++q) {
                const f32x4 g0 = *(const f32x4*)(gg + 8 * q), g1 = *(const f32x4*)(gg + 8 * q + 4);
                u32x4 o;
                o.x = pk2(yv[8 * q] * ry * g0.x, yv[8 * q + 1] * ry * g0.y); o.y = pk2(yv[8 * q + 2] * ry * g0.z, yv[8 * q + 3] * ry * g0.w);
                o.z = pk2(yv[8 * q + 4] * ry * g1.x, yv[8 * q + 5] * ry * g1.y); o.w = pk2(yv[8 * q + 6] * ry * g1.z, yv[8 * q + 7] * ry * g1.w);
                *(u32x4*)(mrow + 512 + g * 64 + hl * 32 + 8 * q) = o;
            }
        }
        {
            const float* gg = mg + 768 + g * 64;
#pragma unroll
            for (int i = 0; i < 4; ++i) {
                const f32x4 g0 = *(const f32x4*)(gg + 8 * i + 4 * hl), g1 = *(const f32x4*)(gg + 32 + 8 * i + 4 * hl);
                u32x2 o0, o1;
                o0.x = pk2(acc0[4 * i] * rf * g0.x, acc0[4 * i + 1] * rf * g0.y); o0.y = pk2(acc0[4 * i + 2] * rf * g0.z, acc0[4 * i + 3] * rf * g0.w);
                o1.x = pk2(acc1[4 * i] * rf * g1.x, acc1[4 * i + 1] * rf * g1.y); o1.y = pk2(acc1[4 * i + 2] * rf * g1.z, acc1[4 * i + 3] * rf * g1.w);
                *(u32x2*)(mrow + 768 + g * 64 + 8 * i + 4 * hl) = o0;
                *(u32x2*)(mrow + 768 + g * 64 + 32 + 8 * i + 4 * hl) = o1;
            }
        }
    }
}

__device__ __forceinline__ float tk_pack(float v, unsigned code, unsigned mask) { return __builtin_bit_cast(float, (__builtin_bit_cast(unsigned, v) & ~mask) | code); }
__device__ __forceinline__ unsigned tk_lookup(const unsigned (&P)[4], unsigned i) {
    const unsigned w = (i < 4u) ? P[0] : (i < 8u) ? P[1] : (i < 12u) ? P[2] : P[3];
    return (w >> ((i & 3u) * 8u)) & 0x7Fu;
}
__device__ __forceinline__ float gelu_exact(float x) { return 0.5f * x * (1.0f + erff(x * 0.70710678118654752f)); }
typedef float f32x2 __attribute__((ext_vector_type(2)));
#define CVT_LO(W) __builtin_amdgcn_cvt_pk_f32_fp8((int)(W), false)
#define CVT_HI(W) __builtin_amdgcn_cvt_pk_f32_fp8((int)(W), true)


__device__ __forceinline__ void tk_sort16(float (&a)[16]) {
#pragma unroll
    for (int k = 2; k <= 16; k <<= 1)
#pragma unroll
        for (int j = k >> 1; j > 0; j >>= 1)
#pragma unroll
            for (int i = 0; i < 16; ++i) {
                const int l = i ^ j;
                if (l > i) {
                    const float hi = fmaxf(a[i], a[l]), lo = fminf(a[i], a[l]);
                    if ((i & k) == 0) { a[i] = hi; a[l] = lo; } else { a[i] = lo; a[l] = hi; }
                }
            }
}
__device__ __forceinline__ void tk_merge16(float (&a)[16]) {
#pragma unroll
    for (int j = 8; j > 0; j >>= 1)
#pragma unroll
        for (int i = 0; i < 16; ++i) {
            const int l = i ^ j;
            if (l > i) { const float hi = fmaxf(a[i], a[l]), lo = fminf(a[i], a[l]); a[i] = hi; a[l] = lo; }
        }
}
__device__ __forceinline__ void tk_top16_merge(float (&l)[16], const float (&g)[16]) {
#pragma unroll
    for (int i = 0; i < 16; ++i) l[i] = fmaxf(l[i], g[15 - i]);
    tk_merge16(l);
}
template <int CTRL> __device__ __forceinline__ float dpp_f(float v) { return __builtin_bit_cast(float, __builtin_amdgcn_update_dpp(0, __builtin_bit_cast(int, v), CTRL, 0xF, 0xF, false)); }
constexpr int PE_LOGR = 4, PE_NR = 1 << PE_LOGR;
constexpr int PE_ENT = 12 * 1024;
constexpr int PE_WAVE = PE_ENT;


#define PE_RL(k) (((k & 4) << 1) | ((k & 2) << 3) | ((k & 1) << 5))
#define PE_LOAD_U(TK, RW, EV, CU, CG) do { \
        const int base_ = ((TK) * 128 + r * 8 + eid) * 3; \
        EV = ent[base_]; CU = __builtin_bit_cast(float, ent[base_ + 1]); CG = __builtin_bit_cast(float, ent[base_ + 2]); \
        _Pragma("unroll") for (int k = 0; k < 8; ++k) { const unsigned e = (unsigned)__builtin_amdgcn_readlane(EV, PE_RL(k)); \
            RW[k] = *(const u32x4*)(PU + (size_t)(e * 1024u) + loff); } \
    } while (0)
#define PE_COMP_U(TK, RW, CU, CG) do { \
        f32x2 xl[8]; \
        _Pragma("unroll") for (int j = 0; j < 4; ++j) { xl[2 * j] = (f32x2){bflo(xp[TK][j].x), bfhi(xp[TK][j].x)}; xl[2 * j + 1] = (f32x2){bflo(xp[TK][j].y), bfhi(xp[TK][j].y)}; } \
        float d[8]; \
        _Pragma("unroll") for (int k = 0; k < 8; ++k) { f32x2 s2 = CVT_LO(RW[k].x) * xl[0]; \
            s2 += CVT_HI(RW[k].x) * xl[1]; s2 += CVT_LO(RW[k].y) * xl[2]; s2 += CVT_HI(RW[k].y) * xl[3]; \
            s2 += CVT_LO(RW[k].z) * xl[4]; s2 += CVT_HI(RW[k].z) * xl[5]; s2 += CVT_LO(RW[k].w) * xl[6]; s2 += CVT_HI(RW[k].w) * xl[7]; \
            d[k] = s2.x + s2.y; } \
        _Pragma("unroll") for (int k = 0; k < 8; ++k) { d[k] += dpp_f<0xB1>(d[k]); d[k] += dpp_f<0x4E>(d[k]); d[k] += dpp_f<0x141>(d[k]); } \
        float r4[4], r2[2], u1; \
        _Pragma("unroll") for (int k = 0; k < 4; ++k) { const float send = b3 ? d[k] : d[k + 4], keep = b3 ? d[k + 4] : d[k]; r4[k] = keep + dpp_f<0x140>(send); } \
        _Pragma("unroll") for (int k = 0; k < 2; ++k) { const float send = b4 ? r4[k] : r4[k + 2], keep = b4 ? r4[k + 2] : r4[k]; r2[k] = keep + __shfl_xor(send, 16); } \
        { const float send = b5 ? r2[0] : r2[1], keep = b5 ? r2[1] : r2[0]; u1 = keep + __shfl_xor(send, 32); } \
        const float av = gelu_exact(u1 * CU) * CG; \
        if ((lane & 7) == 0) ent[((TK) * 128 + r * 8 + eid) * 3 + 1] = __builtin_bit_cast(int, av);     \
    } while (0)
#define PE_LOAD_V(TK, RW, AV) do { \
        const int base_ = ((TK) * 128 + r * 8 + eid) * 3; \
        const int ev = ent[base_]; AV = ent[base_ + 1]; \
        _Pragma("unroll") for (int k = 0; k < 8; ++k) { const unsigned e = (unsigned)__builtin_amdgcn_readlane(ev, PE_RL(k)); \
            RW[k] = *(const u32x4*)(PV + (size_t)(e * 1024u) + loff); } \
    } while (0)
#define PE_COMP_V(TK, RW, AV) do { \
        _Pragma("unroll") for (int k = 0; k < 8; ++k) { \
            const float a = __builtin_bit_cast(float, __builtin_amdgcn_readlane(AV, PE_RL(k))); \
            const f32x2 a2 = (f32x2){a, a}; \
            acc[TK][0] += a2 * CVT_LO(RW[k].x); acc[TK][1] += a2 * CVT_HI(RW[k].x); acc[TK][2] += a2 * CVT_LO(RW[k].y); acc[TK][3] += a2 * CVT_HI(RW[k].y); \
            acc[TK][4] += a2 * CVT_LO(RW[k].z); acc[TK][5] += a2 * CVT_HI(RW[k].z); acc[TK][6] += a2 * CVT_LO(RW[k].w); acc[TK][7] += a2 * CVT_HI(RW[k].w); } \
    } while (0)

template <bool DRY> __device__ __forceinline__ void phase_peer_fused(const Params& p, int layer, char* lds) {
    const int tid = otid(), lane = tid & 63, wave = tid >> 6;
    const unsigned char* PU = p.ws + OFF_PU + (size_t)layer * 16384 * 1024;
    const unsigned char* PV = p.ws + OFF_PV + (size_t)layer * 16384 * 1024;
    const float* SU = (const float*)(p.ws + OFF_PSC) + (size_t)layer * 16384;
    const float* SV = (const float*)(p.ws + OFF_PSC) + (size_t)(2 + layer) * 16384;
    bf16_t* XN = (bf16_t*)(p.ws + R_XN);
    float* XA = (float*)(p.ws + OFF_XA);
    const _Float16* SC = (const _Float16*)(p.ws + R_QP);
    const bool last = (layer == NLAYER - 1);
    const float* gnext = last ? p.in[I_FG] : p.in[I_N1G] + (layer + 1) * DM;
    const float* g2p = p.in[I_N2G] + layer * DM;
    const bool b5 = (lane & 32) != 0, b4 = (lane & 16) != 0, b3 = (lane & 8) != 0;
    const int eid = ((lane >> 3) & 1) * 4 + ((lane >> 4) & 1) * 2 + (lane >> 5);
    const unsigned loff = (unsigned)lane * 16u;
    int* ent = (int*)(lds + wave * PE_WAVE);
    const float NINF = -3.0e38f;
    const int pp = lane & 1;
    for (int tb = (obid() * NWAVE + wave) * 8; tb < T; tb += NBLK * NWAVE * 8) {
#pragma unroll 1
        for (int grp = 0; grp < 2; ++grp) {
            const int tkl = grp * 4 + (lane >> 4), h = (lane >> 1) & 7;
            const f16x8* src = (const f16x8*)(SC + (size_t)(tb + tkl) * 2048 + h * 256 + pp * 128);
            float l[16];
#pragma unroll
            for (int i = 0; i < 16; ++i) l[i] = NINF;
#pragma unroll 1
            for (int c = 0; c < 4; ++c) {
                f32x4 v[8];
#pragma unroll
                for (int j = 0; j < 4; ++j) {
                    const f16x8 hv = src[c * 4 + j];
                    v[2 * j] = (f32x4){(float)hv[0], (float)hv[1], (float)hv[2], (float)hv[3]};
                    v[2 * j + 1] = (f32x4){(float)hv[4], (float)hv[5], (float)hv[6], (float)hv[7]};
                }
#pragma unroll
                for (int hh = 0; hh < 2; ++hh) {
                    float g[16];
#pragma unroll
                    for (int j = 0; j < 4; ++j) {
                        const unsigned kb = (unsigned)(c * 32 + hh * 16 + j * 4);
                        g[4 * j] = tk_pack(v[hh * 4 + j].x, kb, 0x7Fu); g[4 * j + 1] = tk_pack(v[hh * 4 + j].y, kb + 1u, 0x7Fu);
                        g[4 * j + 2] = tk_pack(v[hh * 4 + j].z, kb + 2u, 0x7Fu); g[4 * j + 3] = tk_pack(v[hh * 4 + j].w, kb + 3u, 0x7Fu);
                    }
                    tk_sort16(g);
                    tk_top16_merge(l, g);
                }
            }
            float xw[16], ow[16]; unsigned PX[4] = {0u, 0u, 0u, 0u}, PO[4] = {0u, 0u, 0u, 0u};
#pragma unroll
            for (int i = 0; i < 16; ++i) {
                const float o = __shfl_xor(l[i], 1);
                const unsigned xb = __builtin_bit_cast(unsigned, l[i]), ob = __builtin_bit_cast(unsigned, o);
                xw[i] = __builtin_bit_cast(float, xb & ~0x7Fu); ow[i] = __builtin_bit_cast(float, ob & ~0x7Fu);
                PX[i >> 2] |= (xb & 0x7Fu) << ((i & 3) * 8); PO[i >> 2] |= (ob & 0x7Fu) << ((i & 3) * 8);
            }
            float f[16];
            {
                float c1[16];
#pragma unroll
                for (int i = 0; i < 16; ++i) { f[i] = NINF; c1[i] = NINF; }
                int cnt = 0;
#pragma unroll
                for (int i = 0; i < 16; ++i)
#pragma unroll
                    for (int j = i; j < 16; ++j)
                        if ((i + 1) * (j + 1) <= 16) {
                            float cv = xw[i] + ow[j];
                            const unsigned code = pp ? (unsigned)((j << 4) | i) : (unsigned)((i << 4) | j);
                            cv = tk_pack(cv, code, 0xFFu);
                            if (i == j) cv = pp ? NINF : cv;
                            if (cnt < 16) f[cnt & 15] = cv; else c1[cnt & 15] = cv;
                            ++cnt;
                        }
                tk_sort16(f); tk_sort16(c1);
                tk_top16_merge(f, c1);
                float gq[16];
#pragma unroll
                for (int i = 0; i < 16; ++i) gq[i] = __shfl_xor(f[i], 1);
                tk_top16_merge(f, gq);
            }
            unsigned P0[4], P1[4];
#pragma unroll
            for (int q = 0; q < 4; ++q) { P0[q] = pp ? PO[q] : PX[q]; P1[q] = pp ? PX[q] : PO[q]; }
            const float top = __builtin_bit_cast(float, __builtin_bit_cast(unsigned, f[0]) & ~0xFFu);
            float ev[16]; float den = 0.f;
#pragma unroll
            for (int r = 0; r < 16; ++r) { ev[r] = __expf(__builtin_bit_cast(float, __builtin_bit_cast(unsigned, f[r]) & ~0xFFu) - top); den += ev[r]; }
            const float rden = 1.0f / den;
#pragma unroll
            for (int r8 = 0; r8 < 8; ++r8) {
                const unsigned c0 = __builtin_bit_cast(unsigned, f[r8]) & 0xFFu, c1 = __builtin_bit_cast(unsigned, f[r8 + 8]) & 0xFFu;
                const unsigned code = pp ? c1 : c0;
                const float gate = (pp ? ev[r8 + 8] : ev[r8]) * rden;
                const int e = (int)(tk_lookup(P0, code >> 4) * 128u + tk_lookup(P1, code & 15u));
                const int o = (tkl * 128 + h * 16 + pp * 8 + r8) * 3;
                ent[o] = e; ent[o + 1] = __builtin_bit_cast(int, SU[e]); ent[o + 2] = __builtin_bit_cast(int, gate * SV[e]);
            }
        }
#pragma unroll 1
        for (int tk = 0; tk < 8; ++tk) {
            int* et = ent + tk * 384;
            const int eA = et[lane * 3], uA = et[lane * 3 + 1], gA = et[lane * 3 + 2];
            const int eB = et[(64 + lane) * 3], uB = et[(64 + lane) * 3 + 1], gB = et[(64 + lane) * 3 + 2];
            const int rA = eA >> (14 - PE_LOGR), rB = eB >> (14 - PE_LOGR);
            int base = 0;
#pragma unroll 1
            for (int r = 0; r < PE_NR; ++r) {
                const unsigned long long mA = __ballot(rA == r), mB = __ballot(rB == r);
                const int cA = __popcll(mA);
                if (rA == r) { const int q = base + (int)__builtin_amdgcn_mbcnt_hi((unsigned)(mA >> 32), __builtin_amdgcn_mbcnt_lo((unsigned)mA, 0u)); et[q * 3] = eA; et[q * 3 + 1] = uA; et[q * 3 + 2] = gA; }
                if (rB == r) { const int q = base + cA + (int)__builtin_amdgcn_mbcnt_hi((unsigned)(mB >> 32), __builtin_amdgcn_mbcnt_lo((unsigned)mB, 0u)); et[q * 3] = eB; et[q * 3 + 1] = uB; et[q * 3 + 2] = gB; }
                base += cA + __popcll(mB);
            }
        }
        {
            {
                u32x2 xp[8][4];
#pragma unroll
                for (int tk = 0; tk < 8; ++tk) {
                    f32x4 xr[4]; float ss = 0.f;
#pragma unroll
                    for (int j = 0; j < 4; ++j) { xr[j] = *(const f32x4*)(XA + (size_t)(tb + tk) * DM + 4 * lane + 256 * j); ss += xr[j].x * xr[j].x + xr[j].y * xr[j].y + xr[j].z * xr[j].z + xr[j].w * xr[j].w; }
                    ss = wave_sum(ss);
                    const float rn = rsqrtf(ss * (1.0f / DM) + EPS);
#pragma unroll
                    for (int j = 0; j < 4; ++j) { const f32x4 gg = *(const f32x4*)(g2p + 4 * lane + 256 * j);
                        xp[tk][j].x = pk2(xr[j].x * rn * gg.x, xr[j].y * rn * gg.y); xp[tk][j].y = pk2(xr[j].z * rn * gg.z, xr[j].w * rn * gg.w); }
                }
#pragma unroll 1
                for (int r = 0; r < 16; ++r) {
                    __syncthreads();
                    u32x4 rwA[8]; int evA; float cuA, cgA;
                    PE_LOAD_U(0, rwA, evA, cuA, cgA); PE_COMP_U(0, rwA, cuA, cgA);
                    PE_LOAD_U(1, rwA, evA, cuA, cgA); PE_COMP_U(1, rwA, cuA, cgA);
                    PE_LOAD_U(2, rwA, evA, cuA, cgA); PE_COMP_U(2, rwA, cuA, cgA);
                    PE_LOAD_U(3, rwA, evA, cuA, cgA); PE_COMP_U(3, rwA, cuA, cgA);
                    PE_LOAD_U(4, rwA, evA, cuA, cgA); PE_COMP_U(4, rwA, cuA, cgA);
                    PE_LOAD_U(5, rwA, evA, cuA, cgA); PE_COMP_U(5, rwA, cuA, cgA);
                    PE_LOAD_U(6, rwA, evA, cuA, cgA); PE_COMP_U(6, rwA, cuA, cgA);
                    PE_LOAD_U(7, rwA, evA, cuA, cgA); PE_COMP_U(7, rwA, cuA, cgA);
                }
            }
#pragma unroll 1
            for (int hv = 0; hv < 2; ++hv) {
            f32x2 acc[4][8];
#pragma unroll
            for (int tk = 0; tk < 4; ++tk)
#pragma unroll
                for (int j = 0; j < 8; ++j) acc[tk][j] = (f32x2){0.f, 0.f};
            const int* entv = ent;
            {
                int* ent = (int*)entv + hv * 4 * 128 * 3;
#pragma unroll 1
                for (int r = 0; r < 16; ++r) {
                    __syncthreads();
                    u32x4 rwA[8], rwB[8]; int avA, avB;
                    PE_LOAD_V(0, rwA, avA);
                    PE_LOAD_V(1, rwB, avB); PE_COMP_V(0, rwA, avA);
                    PE_LOAD_V(2, rwA, avA); PE_COMP_V(1, rwB, avB);
                    PE_LOAD_V(3, rwB, avB); PE_COMP_V(2, rwA, avA);
                    PE_COMP_V(3, rwB, avB);
                }
            }
#pragma unroll
            for (int tk = 0; tk < 4; ++tk) {
                const int t = tb + hv * 4 + tk;
                f32x4 x[4]; float ss = 0.f;
#pragma unroll
                for (int j = 0; j < 4; ++j) {
                    x[j] = *(const f32x4*)(XA + (size_t)t * DM + 4 * lane + 256 * j);
                    x[j].x += acc[tk][2 * j].x; x[j].y += acc[tk][2 * j].y; x[j].z += acc[tk][2 * j + 1].x; x[j].w += acc[tk][2 * j + 1].y;
                    ss += x[j].x * x[j].x + x[j].y * x[j].y + x[j].z * x[j].z + x[j].w * x[j].w;
                }
                ss = wave_sum(ss);
                const float rr = rsqrtf(ss * (1.0f / DM) + EPS);
                if (last) {
#pragma unroll
                    for (int j = 0; j < 4; ++j) { const f32x4 gg = *(const f32x4*)(gnext + 4 * lane + 256 * j); *(f32x4*)(p.out + (size_t)t * DM + 4 * lane + 256 * j) = x[j] * rr * gg; }
                } else {
#pragma unroll
                    for (int j = 0; j < 4; ++j) {
                        const f32x4 gg = *(const f32x4*)(gnext + 4 * lane + 256 * j);
                        *(f32x4*)((DRY ? p.out : XA) + (size_t)t * DM + 4 * lane + 256 * j) = x[j];
                        u32x2 w; w.x = pk2(x[j].x * rr * gg.x, x[j].y * rr * gg.y); w.y = pk2(x[j].z * rr * gg.z, x[j].w * rr * gg.w);
                        if (!DRY) *(u32x2*)(XN + (size_t)t * DM + 4 * lane + 256 * j) = w;
                    }
                }
            }
            }
        }
    }
}

#define LAS __attribute__((address_space(3)))
#define XB_TMO      128
#define XB_XCNT(j)  (256  + 64 * (j))
#define XB_XSUB(j)  (1280 + 64 * (j))
#define XB_XGEN(j)  (2304 + 64 * (j))
#define XB_TOP      3328
#define XB_TOPGEN   3392
#define XCD_BAR_WORDS 3456
#define XB_SPIN_CAP (1u << 20)
__device__ __forceinline__ unsigned xb_ld(unsigned* p)              { return __hip_atomic_load(p, __ATOMIC_RELAXED, __HIP_MEMORY_SCOPE_AGENT); }
__device__ __forceinline__ unsigned xb_add(unsigned* p, unsigned v) { return __hip_atomic_fetch_add(p, v, __ATOMIC_RELAXED, __HIP_MEMORY_SCOPE_AGENT); }
__device__ __forceinline__ unsigned xb_xcc_id() { return (unsigned)__builtin_amdgcn_s_getreg((3 << 11) | 20) & 0xFu; }
#define XB_SPIN(cond, bar) do { unsigned _sp = 0; while (cond) { __builtin_amdgcn_s_sleep(1); \
    if ((++_sp & 255u) == 0u) { if (xb_ld(&(bar)[XB_TMO])) break; if (_sp > XB_SPIN_CAP) { atomicAdd(&(bar)[XB_TMO], 1u); break; } } } } while (0)
struct XcdBarrier { unsigned* bar; unsigned x; volatile LAS unsigned* st; };
__device__ __forceinline__ XcdBarrier xcd_barrier_post(unsigned* bar, volatile LAS unsigned* st) {
    XcdBarrier b; b.bar = bar; b.x = xb_xcc_id(); b.st = st;
    if (threadIdx.x == 0) (void)xb_add(&bar[XB_XCNT(b.x)], 1u);
    return b;
}
__device__ __forceinline__ void xcd_barrier_complete(unsigned* bar, unsigned x, unsigned& nloc, unsigned& nx) {
    const unsigned G = NBLK;
    unsigned sum, cnt, mine, sp = 0u;
    for (;;) {
        sum = 0u; cnt = 0u; mine = 0u;
#pragma unroll
        for (unsigned j = 0; j < 16; ++j) { const unsigned c = xb_ld(&bar[XB_XCNT(j)]); sum += c; cnt += (c > 0u) ? 1u : 0u; mine = (j == x) ? c : mine; }
        if (sum == G) break;
        __builtin_amdgcn_s_sleep(1);
        if ((++sp & 255u) == 0u) { if (xb_ld(&bar[XB_TMO])) break; if (sp > XB_SPIN_CAP) { atomicAdd(&bar[XB_TMO], 1u); break; } }
    }
    nloc = mine > 0u ? mine : 1u; nx = cnt > 0u ? cnt : 1u;
}
__device__ __forceinline__ void xcd_barrier(const XcdBarrier& b) {
    asm volatile("s_waitcnt vmcnt(0)" ::: "memory");
    __syncthreads();
    if (threadIdx.x == 0) {
        unsigned* bar = b.bar;
        __builtin_amdgcn_s_waitcnt(0);
        unsigned nloc = b.st[0], nx = b.st[1];
        if (nloc == 0u) { xcd_barrier_complete(bar, b.x, nloc, nx); b.st[0] = nloc; b.st[1] = nx; }
        const unsigned old = xb_add(&bar[XB_XSUB(b.x)], 1u);
        const unsigned gen = old / nloc;
        if (old + 1u == (gen + 1u) * nloc) {
            __builtin_amdgcn_fence(__ATOMIC_RELEASE, "agent");
            asm volatile("s_waitcnt vmcnt(0)" ::: "memory");
            const unsigned og = xb_add(&bar[XB_TOP], 1u);
            const unsigned tg = og / nx;
            if (og + 1u == (tg + 1u) * nx) xb_add(&bar[XB_TOPGEN], 1u);
            else XB_SPIN(xb_ld(&bar[XB_TOPGEN]) == tg, bar);
            __builtin_amdgcn_fence(__ATOMIC_ACQUIRE, "agent");
            xb_add(&bar[XB_XGEN(b.x)], 1u);
            asm volatile("s_waitcnt vmcnt(0)" ::: "memory");
        } else {
            XB_SPIN(xb_ld(&bar[XB_XGEN(b.x)]) == gen, bar);
            __builtin_amdgcn_fence(__ATOMIC_ACQUIRE, "agent");
            asm volatile("s_waitcnt vmcnt(0)" ::: "memory");
        }
    }
    __syncthreads();
}


template <class Epi> __device__ __forceinline__ void big_gemm(const bf16_t* A, const bf16_t* Bt, int M, int N, int K, char* lds, const Epi& e) {
    pg8::Gemm g{A, Bt, M, N, K}; pg8::StaticOrder S; S.init(M, N, NBLK, obid());
    pg8::gemm_phase<Epi, pg8::StaticOrder, true, true>((PG8_LAS unsigned char*)lds, g, S, e);
}

#define GSYNC() xcd_barrier(xbar)
template <int layer> __device__ __forceinline__ void run_layer(const Params& p, char* lds, const XcdBarrier& xbar) {
    float* XA = (float*)(p.ws + OFF_XA);

        const float* xin = layer == 0 ? p.in[I_X] : XA;
        {
            const bf16_t* wt = (const bf16_t*)(p.ws + OFF_WTIN) + (size_t)layer * INC * DM;
            pg8::EpiStoreBf16 e1{(bf16_t*)(p.ws + R_QKV), 768};
            big_gemm((const bf16_t*)(p.ws + R_XN), wt, T, 768, DM, lds, e1);
            pg8::EpiStoreF32 e2{nullptr, (float*)(p.ws + R_HF), T};
            big_gemm(wt + (size_t)768 * DM, (const bf16_t*)(p.ws + R_XN), 1024, T, DM, lds, e2);
        }
        if (layer == 0) {
#pragma nounroll
            for (int fl = 0; fl < NLAYER; ++fl) {
                EpiF32 e{(float*)(p.ws + (fl ? OFF_HFILT1 : OFF_HFILT0)), SL};
                gemm_simple((const bf16_t*)(p.ws + OFF_W3T) + (size_t)fl * 1024 * 64, (const bf16_t*)(p.ws + OFF_H2) + (size_t)fl * SL * 64, 1024, SL, 64, lds, e);
            }
        }
        GSYNC();
        if (layer == 0) {
            phase_filter_spectra(p, lds);
        }
        phase_qkprep(p, layer, lds, (bf16_t*)(p.ws + R_QKV)); GSYNC();
        {
            phase_attn(p, lds);
            for (int c = obid(); c < 256; c += NBLK) hyena_job(p, layer, c, lds);
            for (int c = obid(); c < 256; c += NBLK) fnet_job(p, c, lds);
        } GSYNC();
        phase_mix(p, layer, lds); GSYNC();
        { pg8::EpiOutProj e{xin, XA, (bf16_t*)(p.ws + R_XN), (float*)(p.ws + OFF_RS)};
          big_gemm((const bf16_t*)(p.ws + R_MIX), (const bf16_t*)(p.ws + OFF_WTOUT) + (size_t)layer * DM * DM, T, DM, DM, lds, e); } GSYNC();
        { pg8::EpiRowScaleF16 e{(_Float16*)(p.ws + R_QP), 2048, (const float*)(p.ws + OFF_RS)};
          big_gemm((const bf16_t*)(p.ws + R_XN), (const bf16_t*)(p.ws + OFF_WTQ) + (size_t)layer * 2048 * DM, T, 2048, DM, lds, e); } GSYNC();
        phase_peer_fused<false>(p, layer, lds);
        if (layer + 1 < NLAYER) GSYNC();
}

__global__ void __launch_bounds__(NTHR) mega_kernel(Params p) {
    extern __shared__ __attribute__((aligned(16))) char lds[];
    volatile LAS unsigned* misc = (volatile LAS unsigned*)((LAS char*)lds + LDS_MISC);
    if (threadIdx.x < 16) misc[threadIdx.x] = 0u;
    __syncthreads();
    const XcdBarrier xbar = xcd_barrier_post((unsigned*)(p.ws + OFF_CTL) + 4096, misc);
    float* XA = (float*)(p.ws + OFF_XA);
    phase_p0(p, lds);
    phase_rmsnorm_bf16(p.in[I_X], p.in[I_N1G], (bf16_t*)(p.ws + R_XN));
    GSYNC();
    run_layer<0>(p, lds, xbar);
    run_layer<1>(p, lds, xbar);
}

extern "C" void kernel_launch(void* const* d_in, const int* in_sizes, int n_in, void* d_out, int out_size, void* d_ws, size_t ws_size, hipStream_t stream) {
    static int grid = 0;
    if (grid == 0) {
        if (n_in != 25 || out_size != T * DM || ws_size < WS_NEED) { fprintf(stderr, "kernel_launch: unexpected sizes n_in %d out %d ws %zu (need %zu)\n", n_in, out_size, ws_size, (size_t)WS_NEED); grid = -1; return; }
        int dev = 0, cus = 0, per_cu = 0;
        if (hipGetDevice(&dev) != hipSuccess || hipDeviceGetAttribute(&cus, hipDeviceAttributeMultiprocessorCount, dev) != hipSuccess) { grid = -1; return; }
        if (hipFuncSetAttribute((const void*)mega_kernel, hipFuncAttributeMaxDynamicSharedMemorySize, LDS_BYTES) != hipSuccess) { fprintf(stderr, "kernel_launch: hipFuncSetAttribute failed\n"); grid = -1; return; }
        if (hipOccupancyMaxActiveBlocksPerMultiprocessor(&per_cu, (const void*)mega_kernel, NTHR, LDS_BYTES) != hipSuccess || per_cu < 1) { fprintf(stderr, "kernel_launch: occupancy query says %d blocks per CU\n", per_cu); grid = -1; return; }
        (void)hipGetLastError();
        if (cus < NBLK) { fprintf(stderr, "kernel_launch: built for a %d-CU device, found %d CUs\n", NBLK, cus); grid = -1; return; }
        grid = NBLK;
    }
    if (grid < 0) return;
    Params p{};
    for (int i = 0; i < 25; ++i) p.in[i] = (const float*)d_in[i];
    p.out = (float*)d_out; p.ws = (unsigned char*)d_ws;
    if (hipMemsetAsync((char*)d_ws + OFF_CTL, 0, 64 * 1024, stream) != hipSuccess) { fprintf(stderr, "kernel_launch: memset failed\n"); return; }
    void* args[] = {&p};
    hipError_t e = hipLaunchCooperativeKernel((const void*)mega_kernel, dim3(grid), dim3(NTHR), args, LDS_BYTES, stream);
    if (e != hipSuccess) fprintf(stderr, "cooperative launch failed: %s (grid %d)\n", hipGetErrorString(e), grid);
}
```

```cpp
#include <hip/hip_runtime.h>
#include <cstdio>
#include <cstdint>

typedef unsigned short bf16_t;
typedef short bf16x8 __attribute__((ext_vector_type(8)));
typedef float f32x16 __attribute__((ext_vector_type(16)));
typedef float f32x4 __attribute__((ext_vector_type(4)));
typedef unsigned u32x4 __attribute__((ext_vector_type(4)));
typedef unsigned u32x2 __attribute__((ext_vector_type(2)));
typedef _Float16 f16x4 __attribute__((ext_vector_type(4)));
typedef _Float16 f16x8 __attribute__((ext_vector_type(8)));

constexpr int DM = 1024, NB = 2, SL = 8192, T = NB * SL, NLAYER = 2;
constexpr int INC = 1792;
constexpr int NTHR = 512, NWAVE = 8;
constexpr int NBLK = 256;
constexpr int LDS_BYTES = 147456;
constexpr int LDS_MISC = LDS_BYTES - 64;
constexpr float EPS = 1e-6f;

constexpr size_t MiB = 1u << 20;
constexpr size_t OFF_CTL = 0;
constexpr size_t OFF_WTIN = 1 * MiB;
constexpr size_t OFF_WTOUT = 8 * MiB;
constexpr size_t OFF_WTQ = 12 * MiB;
constexpr size_t OFF_PU = 20 * MiB;
constexpr size_t OFF_PV = 84 * MiB;
constexpr size_t OFF_RS = 505 * MiB;
constexpr size_t OFF_PSC = 512 * 1024;
constexpr size_t OFF_H2 = 148 * MiB;
constexpr size_t OFF_W3T = 150 * MiB;
constexpr size_t OFF_HFILT0 = 52 * MiB, OFF_HFILT1 = 116 * MiB;
constexpr size_t OFF_FM = 152 * MiB;
constexpr size_t OFF_KF = 153 * MiB;
constexpr size_t OFF_XA = 281 * MiB;
constexpr size_t OFF_R = 345 * MiB;
constexpr size_t R_XN = OFF_R + 0 * MiB;
constexpr size_t R_UR = OFF_R + 0 * MiB;
constexpr size_t R_UI = OFF_R + 16 * MiB;
constexpr size_t R_QKV = OFF_R + 32 * MiB;
constexpr size_t R_HF = OFF_R + 60 * MiB;
constexpr size_t R_MIX = OFF_R + 60 * MiB;
constexpr size_t R_ATT = OFF_R + 124 * MiB;
constexpr size_t R_Y = OFF_R + 140 * MiB;
constexpr size_t R_QP = OFF_R + 32 * MiB;
constexpr size_t WS_NEED = 506 * MiB;

struct Params {
    const float* in[25];
    float* out;
    unsigned char* ws;
};
enum { I_X = 0, I_N1G, I_WIN, I_QG, I_KG, I_CW, I_CB, I_W1, I_B1, I_F1, I_W2, I_B2, I_F2, I_W3, I_HB, I_FW, I_FB, I_MG, I_WOUT, I_N2G, I_WQ, I_SK, I_PU, I_PV, I_FG };

__device__ __forceinline__ unsigned f2bf(float f) { unsigned u = __builtin_bit_cast(unsigned, f); return (u + 0x7fffu + ((u >> 16) & 1u)) >> 16; }
__device__ __forceinline__ unsigned pk2(float lo, float hi) { return f2bf(lo) | (f2bf(hi) << 16); }
__device__ __forceinline__ float bflo(unsigned w) { return __builtin_bit_cast(float, w << 16); }
__device__ __forceinline__ float bfhi(unsigned w) { return __builtin_bit_cast(float, w & 0xffff0000u); }
__device__ __forceinline__ float wave_sum(float v) {
#pragma unroll
    for (int o = 1; o < 64; o <<= 1) v += __shfl_xor(v, o);
    return v;
}
__device__ __forceinline__ float wave_max(float v) {
#pragma unroll
    for (int o = 1; o < 64; o <<= 1) v = fmaxf(v, __shfl_xor(v, o));
    return v;
}
__device__ __forceinline__ f32x16 mfma32(bf16x8 a, bf16x8 b, f32x16 c) { return __builtin_amdgcn_mfma_f32_32x32x16_bf16(a, b, c, 0, 0, 0); }
__device__ __forceinline__ f32x16 zero16() { return (f32x16){0.f,0.f,0.f,0.f,0.f,0.f,0.f,0.f,0.f,0.f,0.f,0.f,0.f,0.f,0.f,0.f}; }


__device__ __forceinline__ int otid() { int t = threadIdx.x; asm volatile("" : "+v"(t)); return t; }
__device__ __forceinline__ int obid() { int b = blockIdx.x; asm volatile("" : "+s"(b)); return b; }
__device__ __forceinline__ void transpose_one(const float* W, int K, int N, bf16_t* Wt, float* tile, int item) {
    const int tid = otid();
    const int nblk = N / 64, kb = item / nblk, nb = item % nblk, k0 = kb * 64, n0 = nb * 64;
    __syncthreads();
    {
        const int r = tid >> 6, c = tid & 63;
#pragma unroll
        for (int i = 0; i < 8; ++i) { const int k = r + 8 * i; tile[k * 65 + c] = W[(size_t)(k0 + k) * N + n0 + c]; }
    }
    __syncthreads();
    {
        const int nn = tid >> 3, kc = tid & 7;
        const float* s = tile + (kc * 8) * 65 + nn;
        u32x4 o; o.x = pk2(s[0], s[65]); o.y = pk2(s[2 * 65], s[3 * 65]); o.z = pk2(s[4 * 65], s[5 * 65]); o.w = pk2(s[6 * 65], s[7 * 65]);
        *(u32x4*)(Wt + (size_t)(n0 + nn) * K + k0 + kc * 8) = o;
    }
}

template <int PARTS = 31> __device__ __forceinline__ void phase_p0(const Params& p, char* lds) {
    const int tid = otid();
    float* tile = (float*)lds;
    if (PARTS & 1) {
    constexpr int IT_IN = (DM / 64) * (INC / 64), IT_OUT = (DM / 64) * (DM / 64), IT_W3 = 1024 / 64;
    constexpr int IT_L = IT_IN + IT_OUT + IT_W3;
    for (int it = obid(); it < NLAYER * IT_L; it += NBLK) {
        const int layer = it / IT_L; int r = it % IT_L;
        if (r < IT_IN) { transpose_one(p.in[I_WIN] + (size_t)layer * DM * INC, DM, INC, (bf16_t*)(p.ws + OFF_WTIN) + (size_t)layer * INC * DM, tile, r); continue; }
        r -= IT_IN;
        if (r < IT_OUT) { transpose_one(p.in[I_WOUT] + (size_t)layer * DM * DM, DM, DM, (bf16_t*)(p.ws + OFF_WTOUT) + (size_t)layer * DM * DM, tile, r); continue; }
        r -= IT_OUT;
        transpose_one(p.in[I_W3] + (size_t)layer * 64 * 1024, 64, 1024, (bf16_t*)(p.ws + OFF_W3T) + (size_t)layer * 1024 * 64, tile, r);
    }
    }
    __syncthreads();
    if (PARTS & 2) {
        float* SKl = (float*)lds;
        float* Wl = SKl + 128 * 129;
        const int lane = tid & 63, wave = tid >> 6, l31 = lane & 31, hl = lane >> 5, mt = wave & 3, nt = wave >> 2;
        for (int it = obid(); it < NLAYER * 16 * 16; it += NBLK) {
            const int layer = it >> 8, hp = (it >> 4) & 15, kc = it & 15, h = hp >> 1, pp = hp & 1, k0 = kc * 64;
            const float* sk = p.in[I_SK] + (((size_t)(layer * 2 + pp) * 8 + h) * 128) * 128;
            const float* wq = p.in[I_WQ] + (size_t)layer * DM * 2048 + (size_t)k0 * 2048 + h * 256 + pp * 128;
            __syncthreads();
            for (int i = tid; i < 128 * 128; i += NTHR) SKl[(i >> 7) * 129 + (i & 127)] = sk[i];
            for (int i = tid; i < 64 * 128; i += NTHR) Wl[(i >> 7) * 129 + (i & 127)] = wq[(size_t)(i >> 7) * 2048 + (i & 127)];
            __syncthreads();
            f32x16 acc = zero16();
            const float* ap = SKl + (32 * mt + l31) * 129 + hl;
            const float* bp = Wl + (32 * nt + l31) * 129 + hl;
#pragma unroll 16
            for (int kk = 0; kk < 64; ++kk) acc = __builtin_amdgcn_mfma_f32_32x32x2f32(ap[2 * kk], bp[2 * kk], acc, 0, 0, 0);
            const float g2 = p.in[I_N2G][layer * DM + k0 + 32 * nt + l31];
            bf16_t* dst = (bf16_t*)(p.ws + OFF_WTQ) + (size_t)layer * 2048 * DM + (size_t)(hp * 128 + 32 * mt + 4 * hl) * DM + k0 + 32 * nt + l31;
#pragma unroll
            for (int r = 0; r < 16; ++r) dst[(size_t)((r & 3) + 8 * (r >> 2)) * DM] = (bf16_t)f2bf(acc[r] * g2);
        }
        __syncthreads();
    }
    if (PARTS & 4) {
        const int lane = tid & 63, wave = tid >> 6;
        float* scl = (float*)(p.ws + OFF_PSC);
        for (int row = obid() * NWAVE + wave; row < 2 * NLAYER * 16384; row += NBLK * NWAVE) {
            const int tb = row >> 15, r = row & 32767;
            const f32x4* src = (const f32x4*)(p.in[tb ? I_PV : I_PU] + (size_t)r * DM) + lane;
            f32x4 v[4]; float mx = 0.f;
#pragma unroll
            for (int j = 0; j < 4; ++j) { v[j] = __builtin_nontemporal_load(src + 64 * j); mx = fmaxf(mx, fmaxf(fmaxf(fabsf(v[j].x), fabsf(v[j].y)), fmaxf(fabsf(v[j].z), fabsf(v[j].w)))); }
            mx = wave_max(mx);
            const float sc = mx > 0.f ? 224.0f / mx : 1.0f;
            u32x4 o;
            { int w = 0; w = __builtin_amdgcn_cvt_pk_fp8_f32(v[0].x * sc, v[0].y * sc, w, false); w = __builtin_amdgcn_cvt_pk_fp8_f32(v[0].z * sc, v[0].w * sc, w, true); o.x = (unsigned)w; }
            { int w = 0; w = __builtin_amdgcn_cvt_pk_fp8_f32(v[1].x * sc, v[1].y * sc, w, false); w = __builtin_amdgcn_cvt_pk_fp8_f32(v[1].z * sc, v[1].w * sc, w, true); o.y = (unsigned)w; }
            { int w = 0; w = __builtin_amdgcn_cvt_pk_fp8_f32(v[2].x * sc, v[2].y * sc, w, false); w = __builtin_amdgcn_cvt_pk_fp8_f32(v[2].z * sc, v[2].w * sc, w, true); o.z = (unsigned)w; }
            { int w = 0; w = __builtin_amdgcn_cvt_pk_fp8_f32(v[3].x * sc, v[3].y * sc, w, false); w = __builtin_amdgcn_cvt_pk_fp8_f32(v[3].z * sc, v[3].w * sc, w, true); o.w = (unsigned)w; }
            *(u32x4*)(p.ws + (tb ? OFF_PV : OFF_PU) + (size_t)r * DM + lane * 16) = o;
            if (lane == 0) scl[row] = mx > 0.f ? mx / 224.0f : 1.0f;
        }
    }
    if (PARTS & 8) {
        float* sh = (float*)lds;
        float* zl = sh + 64 * 64;
        const int sub = tid >> 6, j = tid & 63;
        for (int it0 = obid() * 64; it0 < NLAYER * SL; it0 += NBLK * 64) {
            const int layer = it0 / SL;
            __syncthreads();
            for (int o = tid; o < 64 * 17; o += NTHR) {
                const int item = o / 17, f = o % 17;
                const float t = (float)((it0 + item) % SL) / (float)(SL - 1);
                float z;
                if (f == 0) z = t;
                else if (f <= 8) z = sinf(2.0f * 3.14159265358979323846f * t * (float)f);
                else z = cosf(2.0f * 3.14159265358979323846f * t * (float)(f - 8));
                zl[o] = z;
            }
            __syncthreads();
            {
                const float* w1 = p.in[I_W1] + layer * 17 * 64;
                float wv[17];
#pragma unroll
                for (int i = 0; i < 17; ++i) wv[i] = w1[i * 64 + j];
                const float b1 = p.in[I_B1][layer * 64 + j], f1 = p.in[I_F1][layer * 64 + j];
#pragma unroll
                for (int r = 0; r < 8; ++r) {
                    const int item = sub * 8 + r;
                    float a = b1;
#pragma unroll
                    for (int i = 0; i < 17; ++i) a += zl[item * 17 + i] * wv[i];
                    sh[item * 64 + j] = sinf(f1 * a);
                }
            }
            __syncthreads();
            {
                const float* w2 = p.in[I_W2] + layer * 64 * 64;
                const float b2 = p.in[I_B2][layer * 64 + j], f2 = p.in[I_F2][layer * 64 + j];
                float acc[8];
#pragma unroll
                for (int r = 0; r < 8; ++r) acc[r] = b2;
#pragma unroll 8
                for (int k = 0; k < 64; ++k) {
                    const float w = w2[k * 64 + j];
#pragma unroll
                    for (int r = 0; r < 8; ++r) acc[r] += sh[(sub * 8 + r) * 64 + k] * w;
                }
#pragma unroll
                for (int r = 0; r < 8; ++r)
                    ((bf16_t*)(p.ws + OFF_H2))[((size_t)(it0 + sub * 8 + r)) * 64 + j] = (bf16_t)f2bf(sinf(f2 * acc[r]));
            }
        }
        __syncthreads();
    }
    if (PARTS & 16) {
        float* ctab = (float*)lds;
        __syncthreads();
        if (tid < 64) ctab[tid] = cosf((float)tid * (2.0f * 3.14159265358979323846f / 64.0f));
        __syncthreads();
        const int total = NLAYER * 4 * 128 * 64;
        for (int o = obid() * NTHR + tid; o < total; o += NBLK * NTHR) {
            const int e2 = o & 63, dd = (o >> 6) & 127, g = (o >> 13) & 3, layer = o >> 15;
            const int d = dd & 63, sh = (dd < 64) ? 0 : 48;
            const float* w = p.in[I_FW] + ((size_t)(layer * 4 + g) * 64) * 64;
            float acc = 0.f;
#pragma unroll 8
            for (int e = 0; e < 64; ++e) acc += ctab[(d * e + sh) & 63] * w[e * 64 + e2];
            ((float*)(p.ws + OFF_FM))[o] = acc * (1.0f / 724.0773439350246f);
        }
        __syncthreads();
    }
}

__device__ __forceinline__ int zp(int i) { return i + 2 * (i >> 5); }
__device__ constexpr float FC32[16] = {1.000000000f, 0.980785280f, 0.923879533f, 0.831469612f, 0.707106781f, 0.555570233f, 0.382683432f, 0.195090322f, 0.000000000f, -0.195090322f, -0.382683432f, -0.555570233f, -0.707106781f, -0.831469612f, -0.923879533f, -0.980785280f};
__device__ constexpr float FS32[16] = {0.000000000f, 0.195090322f, 0.382683432f, 0.555570233f, 0.707106781f, 0.831469612f, 0.923879533f, 0.980785280f, 1.000000000f, 0.980785280f, 0.923879533f, 0.831469612f, 0.707106781f, 0.555570233f, 0.382683432f, 0.195090322f};
__device__ __forceinline__ float2 cmulf(float2 a, float2 b) { return make_float2(a.x * b.x - a.y * b.y, a.x * b.y + a.y * b.x); }
template <int R> __device__ __forceinline__ constexpr int brevR(int x) { int r = 0; for (int b = 1, t = R >> 1; t >= 1; b <<= 1, t >>= 1) if (x & b) r |= t; return r; }
template <int R> __device__ __forceinline__ void dft_fwd_regs(float2 (&x)[R]) {
#pragma unroll
    for (int half = R / 2; half >= 1; half >>= 1) {
#pragma unroll
        for (int blk = 0; blk < R; blk += 2 * half)
#pragma unroll
            for (int k = 0; k < half; ++k) {
                const float2 a = x[blk + k], b = x[blk + k + half];
                x[blk + k] = make_float2(a.x + b.x, a.y + b.y);
                const float2 d = make_float2(a.x - b.x, a.y - b.y);
                const int ti = k * (16 / half);
                if (ti == 0) x[blk + k + half] = d;
                else if (ti == 8) x[blk + k + half] = make_float2(d.y, -d.x);
                else { const float c = FC32[ti], sn = FS32[ti]; x[blk + k + half] = make_float2(d.x * c + d.y * sn, d.y * c - d.x * sn); }
            }
    }
}
template <int R> __device__ __forceinline__ void dft_inv_regs(float2 (&x)[R]) {
#pragma unroll
    for (int half = 1; half <= R / 2; half <<= 1) {
#pragma unroll
        for (int blk = 0; blk < R; blk += 2 * half)
#pragma unroll
            for (int k = 0; k < half; ++k) {
                const float2 a = x[blk + k], b0 = x[blk + k + half];
                const int ti = k * (16 / half);
                float2 b;
                if (ti == 0) b = b0;
                else if (ti == 8) b = make_float2(-b0.y, b0.x);
                else { const float c = FC32[ti], sn = FS32[ti]; b = make_float2(b0.x * c - b0.y * sn, b0.y * c + b0.x * sn); }
                x[blk + k] = make_float2(a.x + b.x, a.y + b.y);
                x[blk + k + half] = make_float2(a.x - b.x, a.y - b.y);
            }
    }
}
template <int R> __device__ __forceinline__ void apply_tw(float2 (&x)[R], float c, float sg) {
    const float2 w1 = make_float2(c, sg), w2 = cmulf(w1, w1);
    float2 po = w1, pe = w2;
#pragma unroll
    for (int m = 1; m < R; m += 2) {
        x[brevR<R>(m)] = cmulf(x[brevR<R>(m)], po);
        if (m + 1 < R) x[brevR<R>(m + 1)] = cmulf(x[brevR<R>(m + 1)], pe);
        if (m + 2 < R) { po = cmulf(po, w2); pe = cmulf(pe, w2); }
    }
}
template <int R, bool INV> __device__ __forceinline__ void fft_group(float2* Z, int pbase, int PS, float ang) {
    float2 x[R];
    if (!INV) {
#pragma unroll
        for (int m = 0; m < R; ++m) x[m] = Z[pbase + PS * m];
        dft_fwd_regs<R>(x);
        apply_tw<R>(x, __builtin_amdgcn_cosf(ang), -__builtin_amdgcn_sinf(ang));
#pragma unroll
        for (int m = 0; m < R; ++m) Z[pbase + PS * m] = x[brevR<R>(m)];
    } else {
#pragma unroll
        for (int m = 0; m < R; ++m) x[brevR<R>(m)] = Z[pbase + PS * m];
        apply_tw<R>(x, __builtin_amdgcn_cosf(ang), __builtin_amdgcn_sinf(ang));
        dft_inv_regs<R>(x);
#pragma unroll
        for (int m = 0; m < R; ++m) Z[pbase + PS * m] = x[m];
    }
}
template <bool INV> __device__ __forceinline__ void fft_group32_contig(float2* Z, int pbase) {
    float2 x[32];
    if (!INV) {
#pragma unroll
        for (int m = 0; m < 32; m += 2) { const f32x4 v = *(const f32x4*)(Z + pbase + m); x[m] = make_float2(v.x, v.y); x[m + 1] = make_float2(v.z, v.w); }
        dft_fwd_regs<32>(x);
#pragma unroll
        for (int m = 0; m < 32; m += 2) { const float2 a = x[brevR<32>(m)], b = x[brevR<32>(m + 1)]; *(f32x4*)(Z + pbase + m) = (f32x4){a.x, a.y, b.x, b.y}; }
    } else {
#pragma unroll
        for (int m = 0; m < 32; m += 2) { const f32x4 v = *(const f32x4*)(Z + pbase + m); x[brevR<32>(m)] = make_float2(v.x, v.y); x[brevR<32>(m + 1)] = make_float2(v.z, v.w); }
        dft_inv_regs<32>(x);
#pragma unroll
        for (int m = 0; m < 32; m += 2) *(f32x4*)(Z + pbase + m) = (f32x4){x[m].x, x[m].y, x[m + 1].x, x[m + 1].y};
    }
}
__device__ __forceinline__ void fft16k_fwd(float2* Z) {
    const int tid = otid();
#pragma unroll 1
    for (int g = 0; g < 2; ++g) { const int j = tid + 512 * g; fft_group<16, false>(Z, zp(j), 1088, (float)j * (1.0f / 16384.0f)); }
    __syncthreads();
    { const int blk = tid >> 5, j = tid & 31; fft_group<32, false>(Z, blk * 1088 + j, 34, (float)j * (1.0f / 1024.0f)); }
    __syncthreads();
    fft_group32_contig<false>(Z, 34 * tid);
    __syncthreads();
}
__device__ __forceinline__ void fft16k_inv(float2* Z) {
    const int tid = otid();
    fft_group32_contig<true>(Z, 34 * tid);
    __syncthreads();
    { const int blk = tid >> 5, j = tid & 31; fft_group<32, true>(Z, blk * 1088 + j, 34, (float)j * (1.0f / 1024.0f)); }
    __syncthreads();
#pragma unroll 1
    for (int g = 0; g < 2; ++g) { const int j = tid + 512 * g; fft_group<16, true>(Z, zp(j), 1088, (float)j * (1.0f / 16384.0f)); }
    __syncthreads();
}
__device__ __forceinline__ void fft8k_fwd(float2* Z) {
    const int tid = otid();
    fft_group<16, false>(Z, zp(tid), 544, (float)tid * (1.0f / 8192.0f));
    __syncthreads();
    { const int blk = tid >> 5, j = tid & 31; fft_group<16, false>(Z, blk * 544 + j, 34, (float)j * (1.0f / 512.0f)); }
    __syncthreads();
    if (tid < 256) fft_group32_contig<false>(Z, 34 * tid);
    __syncthreads();
}
__device__ __forceinline__ int f16k_of_p(int p) { return (p >> 10) + 16 * ((p >> 5) & 31) + 512 * (p & 31); }
__device__ __forceinline__ int p16k_of_f(int f) { return 1024 * (f & 15) + 32 * ((f >> 4) & 31) + (f >> 9); }
__device__ __forceinline__ int p8k_of_f(int f) { return 512 * (f & 15) + 32 * ((f >> 4) & 15) + (f >> 8); }

__device__ __forceinline__ void phase_filter_spectra(const Params& p, char* lds) {
    const int tid = otid(), lane = tid & 63, wave = tid >> 6;
    float2* Z = (float2*)lds;
    float* red = (float*)(lds + 139264 + 64);
    for (int job = obid(); job < NLAYER * 256; job += NBLK) {
        const int layer = job >> 8, c = job & 255;
        __syncthreads();
        const float* HFc = (const float*)(p.ws + (layer ? OFF_HFILT1 : OFF_HFILT0)) + (size_t)c * SL;
        const float r_lo = 4.605170185988092f / 1.5f, r_hi = 4.605170185988092f / 0.3f;
        const float rate = r_lo + (r_hi - r_lo) * ((float)c / 255.0f);
        float ss0 = 0.f, ss1 = 0.f;
#pragma unroll 1
        for (int i = 0; i < 4; ++i) {
            const int l0 = 4 * tid + 2048 * i;
            const f32x4 a0 = *(const f32x4*)(HFc + l0), a1 = *(const f32x4*)(HFc + (size_t)256 * SL + l0);
            const f32x4 a2 = *(const f32x4*)(HFc + (size_t)512 * SL + l0), a3 = *(const f32x4*)(HFc + (size_t)768 * SL + l0);
#pragma unroll
            for (int e = 0; e < 4; ++e) {
                const int l = l0 + e;
                const float t = (float)l / (float)(SL - 1);
                const float dec = expf(-t * rate);
                const float f0 = a0[e] * dec, b0 = a1[e] * dec, f1 = a2[e] * dec, b1 = a3[e] * dec;
                ss0 += f0 * f0 + b0 * b0; ss1 += f1 * f1 + b1 * b1;
                Z[zp(l)] = make_float2(f0, f1);
                if (l >= 1) Z[zp(16384 - l)] = make_float2(b0, b1);
            }
        }
        if (tid == 0) Z[zp(8192)] = make_float2(0.f, 0.f);
        ss0 = wave_sum(ss0); ss1 = wave_sum(ss1);
        if (lane == 0) { red[wave * 2] = ss0; red[wave * 2 + 1] = ss1; }
        __syncthreads();
        float t0 = 0.f, t1 = 0.f;
#pragma unroll
        for (int w = 0; w < 8; ++w) { t0 += red[w * 2]; t1 += red[w * 2 + 1]; }
        const float sc0 = rsqrtf(t0 + EPS) * (1.0f / 16384.0f) * 0.5f, sc1 = rsqrtf(t1 + EPS) * (1.0f / 16384.0f) * 0.5f;
        const float hb0 = p.in[I_HB][(layer * 2 + 0) * 256 + c] * (1.0f / 16384.0f), hb1 = p.in[I_HB][(layer * 2 + 1) * 256 + c] * (1.0f / 16384.0f);
        fft16k_fwd(Z);
        float2* KF0 = (float2*)(p.ws + OFF_KF) + ((size_t)(layer * 256 + c) * 2) * 16384;
        float2* KF1 = KF0 + 16384;
        for (int i = 0; i < 32; ++i) {
            const int pp = tid + NTHR * i;
            const int fq = f16k_of_p(pp);
            const int pq = p16k_of_f((16384 - fq) & 16383);
            const float2 za = Z[zp(pp)], zq = Z[zp(pq)];
            KF0[pp] = make_float2((za.x + zq.x) * sc0 + hb0, (za.y - zq.y) * sc0);
            KF1[pp] = make_float2((za.y + zq.y) * sc1 + hb1, (zq.x - za.x) * sc1);
        }
    }
}

__device__ __forceinline__ void phase_rmsnorm_bf16(const float* x, const float* g, bf16_t* out) {
    const int lane = otid() & 63, wave = otid() >> 6;
    const int gw = obid() * NWAVE + wave, ngw = NBLK * NWAVE;
    for (int row = gw; row < T; row += ngw) {
        const f32x4* xr = (const f32x4*)(x + (size_t)row * DM) + lane;
        f32x4 v[4]; float ss = 0.f;
#pragma unroll
        for (int j = 0; j < 4; ++j) { v[j] = xr[64 * j]; ss += v[j].x * v[j].x + v[j].y * v[j].y + v[j].z * v[j].z + v[j].w * v[j].w; }
        ss = wave_sum(ss);
        const float r = rsqrtf(ss * (1.0f / DM) + EPS);
        u32x2* o = (u32x2*)(out + (size_t)row * DM) + lane;
#pragma unroll
        for (int j = 0; j < 4; ++j) {
            const f32x4 gg = ((const f32x4*)g)[lane + 64 * j];
            u32x2 w; w.x = pk2(v[j].x * r * gg.x, v[j].y * r * gg.y); w.y = pk2(v[j].z * r * gg.z, v[j].w * r * gg.w);
            o[64 * j] = w;
        }
    }
}

constexpr int G_LDA = 144;
template <class Epi>
__device__ __forceinline__ void gemm_simple(const bf16_t* A, const bf16_t* Bt, int M, int N, int K, char* lds, const Epi& epi) {
    const int tid = otid(), lane = tid & 63, wave = tid >> 6;
    const int wm = wave >> 1, wn = wave & 1;
    const int nMt = M / 256, nNt = N / 128, total = nMt * nNt, nk = K / 64;
    char* As = lds; char* Bs = lds + 256 * G_LDA;
    const int l31 = lane & 31, hl = lane >> 5;
    for (int u = obid(); u < total; u += NBLK) {
        const int mt = u % nMt, nt = u / nMt;
        f32x16 acc[2][2];
#pragma unroll
        for (int i = 0; i < 2; ++i)
#pragma unroll
            for (int j = 0; j < 2; ++j) acc[i][j] = zero16();
        u32x4 ra[4], rb[2];
        const bf16_t* Ab = A + (size_t)(mt * 256) * K;
        const bf16_t* Bb = Bt + (size_t)(nt * 128) * K;
#pragma unroll
        for (int i = 0; i < 4; ++i) { const int id = tid + NTHR * i, row = id >> 3, ch = id & 7; ra[i] = *(const u32x4*)(Ab + (size_t)row * K + ch * 8); }
#pragma unroll
        for (int i = 0; i < 2; ++i) { const int id = tid + NTHR * i, row = id >> 3, ch = id & 7; rb[i] = *(const u32x4*)(Bb + (size_t)row * K + ch * 8); }
        for (int kt = 0; kt < nk; ++kt) {
            __syncthreads();
#pragma unroll
            for (int i = 0; i < 4; ++i) { const int id = tid + NTHR * i, row = id >> 3, ch = id & 7; *(u32x4*)(As + row * G_LDA + ch * 16) = ra[i]; }
#pragma unroll
            for (int i = 0; i < 2; ++i) { const int id = tid + NTHR * i, row = id >> 3, ch = id & 7; *(u32x4*)(Bs + row * G_LDA + ch * 16) = rb[i]; }
            __syncthreads();
            if (kt + 1 < nk) {
                const int ko = (kt + 1) * 64;
#pragma unroll
                for (int i = 0; i < 4; ++i) { const int id = tid + NTHR * i, row = id >> 3, ch = id & 7; ra[i] = *(const u32x4*)(Ab + (size_t)row * K + ko + ch * 8); }
#pragma unroll
                for (int i = 0; i < 2; ++i) { const int id = tid + NTHR * i, row = id >> 3, ch = id & 7; rb[i] = *(const u32x4*)(Bb + (size_t)row * K + ko + ch * 8); }
            }
#pragma unroll
            for (int ks = 0; ks < 4; ++ks) {
                bf16x8 a[2], b[2];
#pragma unroll
                for (int i = 0; i < 2; ++i) a[i] = *(const bf16x8*)(As + (wm * 64 + i * 32 + l31) * G_LDA + ks * 32 + hl * 16);
#pragma unroll
                for (int j = 0; j < 2; ++j) b[j] = *(const bf16x8*)(Bs + (wn * 64 + j * 32 + l31) * G_LDA + ks * 32 + hl * 16);
#pragma unroll
                for (int i = 0; i < 2; ++i)
#pragma unroll
                    for (int j = 0; j < 2; ++j) acc[i][j] = mfma32(a[i], b[j], acc[i][j]);
            }
        }
#pragma unroll
        for (int i = 0; i < 2; ++i)
#pragma unroll
            for (int j = 0; j < 2; ++j) epi(acc[i][j], mt * 256 + wm * 64 + i * 32, nt * 128 + wn * 64 + j * 32, lane);
    }
}

struct EpiF32 {
    float* out; int ld;
    __device__ __forceinline__ void operator()(const f32x16& acc, int row0, int col0, int lane) const {
        const int c = col0 + (lane & 31), h = lane >> 5;
#pragma unroll
        for (int r = 0; r < 16; ++r) { out[(size_t)(row0 + (r & 3) + 8 * (r >> 2) + 4 * h) * ld + c] = acc[r]; }
    }
};

namespace pg8 {
#define PG8_LAS __attribute__((address_space(3)))
constexpr int BM = 256, BK = 64, HALF = 128, HTB = HALF * BK * 2  , STAGE_BYTES = 8 * HTB, NXCD = 8, WGM = 8;

__host__ __device__ __forceinline__ int lds_byte(int r, int c) { const int st = (r >> 4) * 2 + (c >> 5), rr = r & 15, cc = c & 31, ob = rr * 64 + cc * 2; return st * 1024 + (ob ^ (((ob >> 9) & 1) << 5)); }
__host__ __device__ __forceinline__ void stage_rc(int b, int& R, int& C) { const int st = b / 1024, sb = b % 1024, swz = sb ^ (((sb >> 9) & 1) << 5); R = (st >> 1) * 16 + swz / 64; C = (st & 1) * 32 + (swz % 64) / 2; }
__host__ __device__ __forceinline__ int perm32(int rho) { const int n = rho >> 4, i = rho & 15; return 8 * (i >> 2) + 4 * n + (i & 3); }

struct Unit { int pm, pn; };
struct Gemm { const bf16_t* A; const bf16_t* Bt; int M, N, K; };

struct StaticOrder {
    int nM, nN, nwg, G, c;
    __host__ __device__ void init(int M, int N, int G_, int c_) { nM = M / BM; nN = N / BM; nwg = nM * nN; G = G_; c = c_; }
    __host__ __device__ bool next(int i, Unit& u) const {
        const long L = (long)i * G + c; if (L >= nwg) return false;
        int wgid = (int)L; { const int q = nwg / NXCD, r = nwg % NXCD, xcd = wgid % NXCD, off = wgid / NXCD; wgid = (xcd < r ? xcd * (q + 1) : r * (q + 1) + (xcd - r) * q) + off; }
        const int nig = WGM * nN, gid = wgid / nig, fm = gid * WGM, gsz = (nM - fm) < WGM ? (nM - fm) : WGM;
        u.pm = fm + ((wgid % nig) % gsz); u.pn = (wgid % nig) / gsz; return true;
    }
    __device__ __forceinline__ void a_ready(const Unit&) const {}
    __device__ __forceinline__ void done(const Unit&) const {}
};


__device__ __forceinline__ unsigned cvt_pk_bf16(float lo, float hi) { unsigned r; asm volatile("v_cvt_pk_bf16_f32 %0, %1, %2" : "=v"(r) : "v"(lo), "v"(hi)); return r; }
struct EpiStoreBf16 {
    static constexpr bool PERM = true, AFTER_DRAIN = false;
    bf16_t* O; int ldc;
    __device__ __forceinline__ void operator()(const f32x4 (&acc)[2][2][4][2], const Unit& u, int wr, int wc, int fr, int fq) const {
        const int row0 = u.pm * BM + wr * 64 + fr, col0 = u.pn * BM + wc * 32 + 8 * fq;
#pragma unroll
        for (int ai = 0; ai < 2; ++ai)
#pragma unroll
            for (int m = 0; m < 4; ++m) { bf16_t* rowp = O + (size_t)(row0 + ai * HALF + m * 16) * ldc + col0;
#pragma unroll
                for (int bj = 0; bj < 2; ++bj) { const f32x4 v0 = acc[ai][bj][m][0], v1 = acc[ai][bj][m][1];
                    u32x4 w; w.x = cvt_pk_bf16(v0[0], v0[1]); w.y = cvt_pk_bf16(v0[2], v0[3]); w.z = cvt_pk_bf16(v1[0], v1[1]); w.w = cvt_pk_bf16(v1[2], v1[3]);
                    *(u32x4*)(rowp + bj * HALF) = w; } }
    }
};
struct EpiOutProj {
    static constexpr bool PERM = false, AFTER_DRAIN = false;
    const float* base; float* O; bf16_t* XB; float* RS;
    __device__ __forceinline__ void operator()(const f32x4 (&acc)[2][2][4][2], const Unit& u, int wr, int wc, int fr, int fq) const {
        const int row0 = u.pm * BM + wr * 64 + fr, col0 = u.pn * BM + wc * 32 + 4 * fq;
#pragma unroll
        for (int ai = 0; ai < 2; ++ai)
#pragma unroll
            for (int m = 0; m < 4; ++m) { const int row = row0 + ai * HALF + m * 16; const size_t off = (size_t)row * 1024 + col0; float ss = 0.f;
#pragma unroll
                for (int bj = 0; bj < 2; ++bj)
#pragma unroll
                    for (int n = 0; n < 2; ++n) { const f32x4 v = acc[ai][bj][m][n] + *(const f32x4*)(base + off + bj * HALF + n * 16);
                        *(f32x4*)(O + off + bj * HALF + n * 16) = v; ss += v[0] * v[0] + v[1] * v[1] + v[2] * v[2] + v[3] * v[3];
                        u32x2 w; w.x = cvt_pk_bf16(v[0], v[1]); w.y = cvt_pk_bf16(v[2], v[3]); *(u32x2*)(XB + off + bj * HALF + n * 16) = w; }
                ss += __shfl_xor(ss, 16); ss += __shfl_xor(ss, 32);
                if (fq == 0) RS[(size_t)row * 16 + u.pn * 4 + wc] = ss; }
    }
};
struct EpiRowScaleF16 {
    static constexpr bool PERM = false, AFTER_DRAIN = false;
    _Float16* O; int ldc; const float* RS;
    __device__ __forceinline__ void operator()(const f32x4 (&acc)[2][2][4][2], const Unit& u, int wr, int wc, int fr, int fq) const {
        const int row0 = u.pm * BM + wr * 64 + fr, col0 = u.pn * BM + wc * 32 + 4 * fq;
#pragma unroll
        for (int ai = 0; ai < 2; ++ai)
#pragma unroll
            for (int m = 0; m < 4; ++m) { const int row = row0 + ai * HALF + m * 16; const size_t off = (size_t)row * ldc + col0;
                float tot = 0.f;
#pragma unroll
                for (int q = 0; q < 4; ++q) { const f32x4 pr = *(const f32x4*)(RS + (size_t)row * 16 + 4 * q); tot += (pr[0] + pr[1]) + (pr[2] + pr[3]); }
                const float r = rsqrtf(tot * (1.0f / 1024.0f) + 1e-6f);
#pragma unroll
                for (int bj = 0; bj < 2; ++bj)
#pragma unroll
                    for (int n = 0; n < 2; ++n) *(f16x4*)(O + off + bj * HALF + n * 16) = __builtin_convertvector(acc[ai][bj][m][n] * r, f16x4); }
    }
};
struct EpiStoreF32 {
    static constexpr bool PERM = false, AFTER_DRAIN = false;
    const float* base; float* O; int ldc;
    __device__ __forceinline__ void operator()(const f32x4 (&acc)[2][2][4][2], const Unit& u, int wr, int wc, int fr, int fq) const {
        const int row0 = u.pm * BM + wr * 64 + fr, col0 = u.pn * BM + wc * 32 + 4 * fq;
#pragma unroll
        for (int ai = 0; ai < 2; ++ai)
#pragma unroll
            for (int m = 0; m < 4; ++m) { const size_t off = (size_t)(row0 + ai * HALF + m * 16) * ldc + col0;
#pragma unroll
                for (int bj = 0; bj < 2; ++bj)
#pragma unroll
                    for (int n = 0; n < 2; ++n) { f32x4 v = acc[ai][bj][m][n]; if (base) v += *(const f32x4*)(base + off + bj * HALF + n * 16); *(f32x4*)(O + off + bj * HALF + n * 16) = v; } }
    }
};

template <class Epi, class Sched, bool ALIGN_EPI = false, bool SP2 = false>
__device__ __forceinline__ void gemm_phase(PG8_LAS unsigned char* lds, const Gemm g, const Sched& S, const Epi& E) {
    const int tid = otid(), wid = __builtin_amdgcn_readfirstlane(tid >> 6), lane = tid & 63, wr = wid >> 2, wc = wid & 3, fr = lane & 15, fq = lane >> 4;
    const int K = g.K, nt = K / BK;
    unsigned voffA[2], voffB[2];
#pragma unroll
    for (int i = 0; i < 2; ++i) { int R, C; stage_rc(tid * 16 + i * 8192, R, C); const int Rb = Epi::PERM ? ((R & ~31) + perm32(R & 31)) : R;
        voffA[i] = (unsigned)(R * K + C) * 2u; voffB[i] = (unsigned)(Rb * K + C) * 2u; }
    const size_t kstep = (size_t)(BK * 2);
    const size_t hstep = (size_t)HALF * K * 2;
    const size_t tstep = 2 * hstep;
    const unsigned ldsw = (unsigned)wid * 1024u;
    const int aoff = lds_byte(wr * 64 + fr, fq * 8), boff = lds_byte(wc * 32 + fr, fq * 8);
#define PG8_SA(b, h) (((b) * 2 + (h)) * HTB)
#define PG8_SB(b, h) ((4 + (b) * 2 + (h)) * HTB)
#define PG8_STAGE(bufoff, gbase, voff) do { _Pragma("unroll") for (int _i = 0; _i < 2; ++_i) \
        __builtin_amdgcn_global_load_lds((const unsigned*)((const char*)(gbase) + (voff)[_i]), (PG8_LAS unsigned*)(lds + (bufoff) + ldsw + _i * 8192), 16, 0, 0); } while (0)
#define PG8_LDA(dst, b, h) do { _Pragma("unroll") for (int m = 0; m < 4; ++m) _Pragma("unroll") for (int k = 0; k < 2; ++k) dst[m][k] = *(const PG8_LAS bf16x8*)(lds + PG8_SA(b, h) + aoff + m * 2048 + k * 1024); } while (0)
#define PG8_LDB(dst, b, h) do { _Pragma("unroll") for (int n = 0; n < 2; ++n) _Pragma("unroll") for (int k = 0; k < 2; ++k) dst[n][k] = *(const PG8_LAS bf16x8*)(lds + PG8_SB(b, h) + boff + n * 2048 + k * 1024); } while (0)
#define PG8_MMA(ai, bj, At, Bt) do { __builtin_amdgcn_s_setprio(1); _Pragma("unroll") for (int m = 0; m < 4; ++m) _Pragma("unroll") for (int n = 0; n < 2; ++n) _Pragma("unroll") for (int k = 0; k < 2; ++k) \
        acc[ai][bj][m][n] = __builtin_amdgcn_mfma_f32_16x16x32_bf16(Bt[n][k], At[m][k], acc[ai][bj][m][n], 0, 0, 0); __builtin_amdgcn_s_setprio(0); } while (0)
#define PG8_WAIT_V(n) asm volatile("s_waitcnt vmcnt(" #n ")" ::: "memory")
#define PG8_WAIT_L(n) asm volatile("s_waitcnt lgkmcnt(" #n ")" ::: "memory")
#define PG8_BAR __builtin_amdgcn_s_barrier()
#define PG8_SCHED __builtin_amdgcn_sched_barrier(0)
    Unit cur, nxt; int ui = 0;
    if (!S.next(0, cur)) return;
    f32x4 acc[2][2][4][2];
#pragma unroll
    for (int a = 0; a < 2; ++a)
#pragma unroll
        for (int b = 0; b < 2; ++b)
#pragma unroll
            for (int m = 0; m < 4; ++m)
#pragma unroll
                for (int n = 0; n < 2; ++n) acc[a][b][m][n] = (f32x4){0.f, 0.f, 0.f, 0.f};
    bf16x8 At[4][2], B0[2][2], B1[2][2];
    const char* cA = (const char*)g.A + (size_t)cur.pm * tstep; const char* cB = (const char*)g.Bt + (size_t)cur.pn * tstep;
    S.a_ready(cur);
    if constexpr (SP2) {
        PG8_STAGE(PG8_SB(0, 0), cB, voffB); PG8_STAGE(PG8_SB(0, 1), cB + hstep, voffB); PG8_STAGE(PG8_SA(0, 0), cA, voffA); PG8_STAGE(PG8_SA(0, 1), cA + hstep, voffA);
        if (wr == 1) PG8_BAR;
        PG8_WAIT_V(2); PG8_BAR;
        PG8_STAGE(PG8_SB(1, 0), cB + kstep, voffB); PG8_STAGE(PG8_SA(1, 0), cA + kstep, voffA); PG8_STAGE(PG8_SB(1, 1), cB + hstep + kstep, voffB);
        PG8_WAIT_V(6); PG8_BAR;
    } else {
        PG8_STAGE(PG8_SB(0, 0), cB, voffB); PG8_STAGE(PG8_SA(0, 0), cA, voffA); PG8_STAGE(PG8_SB(0, 1), cB + hstep, voffB); PG8_STAGE(PG8_SA(0, 1), cA + hstep, voffA);
        if (wr == 1) PG8_BAR;
        PG8_WAIT_V(4); PG8_BAR;
        PG8_STAGE(PG8_SB(1, 0), cB + kstep, voffB); PG8_STAGE(PG8_SA(1, 0), cA + kstep, voffA); PG8_STAGE(PG8_SB(1, 1), cB + hstep + kstep, voffB);
        PG8_WAIT_V(6); PG8_BAR;
    }
    for (;;) {
        const bool has_next = S.next(ui + 1, nxt);
        const char* nA = has_next ? (const char*)g.A + (size_t)nxt.pm * tstep : cA; const char* nB = has_next ? (const char*)g.Bt + (size_t)nxt.pn * tstep : cB;
        for (int t = 0; t < nt; t += 2) {
            const bool last = (t == nt - 2);
            const char* a1 = cA + (size_t)(t + 1) * kstep;
            const char* a2 = last ? nA : cA + (size_t)(t + 2) * kstep; const char* b2 = last ? nB : cB + (size_t)(t + 2) * kstep;
            const char* a3 = a2 + kstep; const char* b3 = b2 + kstep;
            if (last && has_next) S.a_ready(nxt);
            if constexpr (SP2) {
            PG8_LDB(B0, 0, 0); PG8_LDB(B1, 0, 1); PG8_SCHED; PG8_LDA(At, 0, 0); PG8_STAGE(PG8_SA(1, 1), a1 + hstep, voffA);
            PG8_WAIT_V(8); PG8_WAIT_L(0); PG8_BAR; PG8_MMA(0, 0, At, B0); PG8_MMA(0, 1, At, B1); PG8_BAR; PG8_SCHED;
            PG8_LDA(At, 0, 1); PG8_STAGE(PG8_SB(0, 0), b2, voffB); PG8_STAGE(PG8_SB(0, 1), b2 + hstep, voffB); PG8_STAGE(PG8_SA(0, 0), a2, voffA);
            PG8_WAIT_V(8); PG8_WAIT_L(0); PG8_BAR; PG8_MMA(1, 0, At, B0); PG8_MMA(1, 1, At, B1); PG8_BAR; PG8_SCHED;
            PG8_LDB(B0, 1, 0); PG8_LDB(B1, 1, 1); PG8_SCHED; PG8_LDA(At, 1, 0); PG8_STAGE(PG8_SA(0, 1), a2 + hstep, voffA);
            PG8_WAIT_V(8); PG8_WAIT_L(0); PG8_BAR; PG8_MMA(0, 0, At, B0); PG8_MMA(0, 1, At, B1); PG8_BAR; PG8_SCHED;
            PG8_LDA(At, 1, 1); PG8_STAGE(PG8_SB(1, 0), b3, voffB); PG8_STAGE(PG8_SB(1, 1), b3 + hstep, voffB); PG8_STAGE(PG8_SA(1, 0), a3, voffA);
            PG8_WAIT_V(8); PG8_WAIT_L(0); PG8_BAR; PG8_MMA(1, 0, At, B0); PG8_MMA(1, 1, At, B1); PG8_BAR; PG8_SCHED;
            } else {
            PG8_LDB(B0, 0, 0); PG8_SCHED; PG8_LDA(At, 0, 0); PG8_STAGE(PG8_SA(1, 1), a1 + hstep, voffA);
            PG8_WAIT_L(8); PG8_BAR; PG8_WAIT_L(0); PG8_MMA(0, 0, At, B0); PG8_BAR; PG8_SCHED;
            PG8_LDB(B1, 0, 1); PG8_STAGE(PG8_SB(0, 0), b2, voffB);
            PG8_BAR; PG8_WAIT_L(0); PG8_MMA(0, 1, At, B1); PG8_BAR;
            PG8_LDA(At, 0, 1); PG8_STAGE(PG8_SA(0, 0), a2, voffA);
            PG8_BAR; PG8_WAIT_L(0); PG8_MMA(1, 0, At, B0); PG8_BAR; PG8_SCHED;
            PG8_STAGE(PG8_SB(0, 1), b2 + hstep, voffB);
            PG8_WAIT_V(6); PG8_BAR; PG8_MMA(1, 1, At, B1); PG8_BAR;
            PG8_LDB(B0, 1, 0); PG8_SCHED; PG8_LDA(At, 1, 0); PG8_STAGE(PG8_SA(0, 1), a2 + hstep, voffA);
            PG8_WAIT_L(8); PG8_BAR; PG8_WAIT_L(0); PG8_MMA(0, 0, At, B0); PG8_BAR; PG8_SCHED;
            PG8_LDB(B1, 1, 1); PG8_STAGE(PG8_SB(1, 0), b3, voffB);
            PG8_BAR; PG8_WAIT_L(0); PG8_MMA(0, 1, At, B1); PG8_BAR;
            PG8_LDA(At, 1, 1); PG8_STAGE(PG8_SA(1, 0), a3, voffA);
            PG8_BAR; PG8_WAIT_L(0); PG8_MMA(1, 0, At, B0); PG8_BAR; PG8_SCHED;
            PG8_STAGE(PG8_SB(1, 1), b3 + hstep, voffB);
            PG8_WAIT_V(6); PG8_BAR; PG8_MMA(1, 1, At, B1); PG8_BAR;
            }
        }
        if constexpr (ALIGN_EPI) { if (wr == 0) PG8_BAR; }
        if constexpr (!Epi::AFTER_DRAIN) { E(acc, cur, wr, wc, fr, fq); S.done(cur); }
        if (!has_next) break;
#pragma unroll
        for (int a = 0; a < 2; ++a)
#pragma unroll
            for (int b = 0; b < 2; ++b)
#pragma unroll
                for (int m = 0; m < 4; ++m)
#pragma unroll
                    for (int n = 0; n < 2; ++n) acc[a][b][m][n] = (f32x4){0.f, 0.f, 0.f, 0.f};
        cur = nxt; cA = nA; cB = nB; ++ui;
        if constexpr (ALIGN_EPI) { if (wr == 1) PG8_BAR; }
    }
    PG8_WAIT_V(0);
    if constexpr (!ALIGN_EPI) { if (wr == 0) PG8_BAR; }
    PG8_BAR;
    if constexpr (Epi::AFTER_DRAIN) { E.fused(acc, cur, wr, wc, fr, fq, lds, wid, lane); S.done(cur); }
#undef PG8_SA
#undef PG8_SB
#undef PG8_STAGE
#undef PG8_LDA
#undef PG8_LDB
#undef PG8_MMA
#undef PG8_WAIT_V
#undef PG8_WAIT_L
#undef PG8_BAR
#undef PG8_SCHED
}
}

__device__ constexpr float ROPE_INV_REV[16] = {1.591549431e-01f, 8.949940161e-02f, 5.032921210e-02f, 2.830219583e-02f, 1.591549431e-02f, 8.949940161e-03f, 5.032921210e-03f, 2.830219583e-03f, 1.591549431e-03f, 8.949940161e-04f, 5.032921210e-04f, 2.830219583e-04f, 1.591549431e-04f, 8.949940161e-05f, 5.032921210e-05f, 2.830219583e-05f};
__device__ __forceinline__ void qk_norm_rope8(const u32x4 raw, const float (&gn)[8], const float (&cs)[8], const float (&sn)[8], bool second, float scale, u32x4& out) {
    float x[8] = {bflo(raw.x), bfhi(raw.x), bflo(raw.y), bfhi(raw.y), bflo(raw.z), bfhi(raw.z), bflo(raw.w), bfhi(raw.w)};
    float ss = 0.f;
#pragma unroll
    for (int e = 0; e < 8; ++e) ss += x[e] * x[e];
    ss += __shfl_xor(ss, 1); ss += __shfl_xor(ss, 2); ss += __shfl_xor(ss, 4);
    const float r = rsqrtf(ss * (1.0f / 64.0f) + EPS) ;
    float o[8];
#pragma unroll
    for (int e = 0; e < 8; ++e) {
        const float y = x[e] * r * gn[e];
        const float other = __shfl_xor(y, 2);
        o[e] = (second ? (y * cs[e] + other * sn[e]) : (y * cs[e] - other * sn[e])) * scale;
    }
    out.x = pk2(o[0], o[1]); out.y = pk2(o[2], o[3]); out.z = pk2(o[4], o[5]); out.w = pk2(o[6], o[7]);
}
__device__ __forceinline__ void phase_qkprep(const Params& p, int layer, char* lds, bf16_t* qout) {
    const int tid = otid(), lane = tid & 63, wave = tid >> 6;
    const bf16_t* qkv = (const bf16_t*)(p.ws + R_QKV);
    const int sub = lane & 7;
    const bool second = ((sub >> 1) & 1) != 0, colaxis = (sub >> 2) != 0;
    float gq[8], gk[8], ir[8];
#pragma unroll
    for (int e = 0; e < 8; ++e) {
        gq[e] = p.in[I_QG][layer * 64 + sub * 8 + e]; gk[e] = p.in[I_KG][layer * 64 + sub * 8 + e];
        ir[e] = (sub & 1) ? ROPE_INV_REV[8 + e] : ROPE_INV_REV[e];
    }
    const int gw = obid() * NWAVE + wave, ngw = NBLK * NWAVE;
    for (int t = gw; t < T; t += ngw) {
        const int l = t & (SL - 1);
        const float pos = colaxis ? (float)(l & 63) : (float)(l >> 6);
        float cs[8], sn[8];
#pragma unroll
        for (int e = 0; e < 8; ++e) { const float a = pos * ir[e]; cs[e] = __builtin_amdgcn_cosf(a); sn[e] = __builtin_amdgcn_sinf(a); }
        const u32x4 rq = *(const u32x4*)(qkv + (size_t)t * 768 + lane * 8);
        u32x4 rk = {0u, 0u, 0u, 0u};
        if (lane < 16) rk = *(const u32x4*)(qkv + (size_t)t * 768 + 512 + lane * 8);
        u32x4 oq, ok;
        qk_norm_rope8(rq, gq, cs, sn, second, 0.125f * 1.4426950408889634f, oq);
        qk_norm_rope8(rk, gk, cs, sn, second, 1.0f, ok);
        *(u32x4*)(qout + (size_t)t * 768 + lane * 8) = oq;
        if (lane < 16) *(u32x4*)(qout + (size_t)t * 768 + 512 + lane * 8) = ok;
    }
}

#include <hip/hip_bf16.h>
#include <cmath>
namespace attn_body {
using bf16=__hip_bfloat16;
using bf16x8=__attribute__((ext_vector_type(8)))short;
using s16x4=__attribute__((ext_vector_type(4)))short;
using f32x16=__attribute__((ext_vector_type(16)))float;
using u32x4=__attribute__((ext_vector_type(4)))unsigned;
constexpr int SEQ=8192,D=64,PQ=768,PO=512;
constexpr int NW=8,QBLK=32,QB=QBLK*NW,KVBLK=64,NQB=SEQ/QB;
constexpr int ATTN_UNIT_ROWS=QB;
__device__ __forceinline__ int crow(int r,int hi){return (r&3)+8*(r>>2)+4*hi;}
#define SBAR() __builtin_amdgcn_sched_barrier(0)
__device__ __forceinline__ void cmask(f32x16&p0,f32x16&p1,int jb,int qrel,int hi){
  const float NEG=-INFINITY; int kb=64*jb+4*hi;
  #pragma unroll
  for(int r=0;r<16;++r){int kv=kb+(r&3)+8*(r>>2); if(kv>qrel)p0[r]=NEG; if(kv+32>qrel)p1[r]=NEG;}
}

constexpr int NSLOT=3, SLOTB=8192;
constexpr int LDS_K=0, LDS_V=NSLOT*SLOTB, LDS_WS=2*NSLOT*SLOTB, LDS_OST=LDS_WS+NW*64*4, LDS_BYTES=LDS_OST+NW*4096;
constexpr float C2=0.125f*1.4426950408889634f;
__device__ __forceinline__ void glds16(const void*gsrc,unsigned lds_dst){unsigned keep;
  asm volatile("s_mov_b32 %0, m0\n\ts_mov_b32 m0, %2\n\ts_nop 0\n\tglobal_load_lds_dwordx4 %1, off\n\ts_mov_b32 m0, %0":"=&s"(keep):"v"(gsrc),"s"(lds_dst):"memory");}
__device__ __forceinline__ float max3f(float a,float b,float c){float r;asm("v_max3_f32 %0, %1, %2, %3":"=v"(r):"v"(a),"v"(b),"v"(c));return r;}
__device__ __forceinline__ float max2f(float a,float b){float r;asm("v_max_f32_e32 %0, %1, %2":"=v"(r):"v"(a),"v"(b));return r;}
__device__ __forceinline__ float fadd_s(float a,float b){float r;asm("v_add_f32_e32 %0, %1, %2":"=v"(r):"v"(a),"v"(b));return r;}
__device__ __forceinline__ float fsub_s(float a,float b){float r;asm("v_sub_f32_e32 %0, %1, %2":"=v"(r):"v"(a),"v"(b));return r;}
typedef float f32x2_t __attribute__((ext_vector_type(2))); typedef __bf16 bf16x2_t __attribute__((ext_vector_type(2)));
__device__ __forceinline__ unsigned cvtpk_s(float lo,float hi){f32x2_t v={lo,hi};bf16x2_t b=__builtin_convertvector(v,bf16x2_t);return __builtin_bit_cast(unsigned,b);}
#define WAIT_BAR(N) asm volatile("s_waitcnt vmcnt(" #N ") lgkmcnt(0)\n\ts_barrier":::"memory")

__device__ __forceinline__ void qkt(f32x16&p0,f32x16&p1,const char*Kslot,const bf16x8*qr,const f32x16&negm,int r32,int hi){
  const char*kb=Kslot+hi*1024+r32*16;
  #pragma unroll
  for(int d0=0;d0<4;++d0){
    const bf16x8 b0=*reinterpret_cast<const bf16x8*>(kb+d0*2048);
    const bf16x8 b1=*reinterpret_cast<const bf16x8*>(kb+d0*2048+512);
    if(d0==0){p0=__builtin_amdgcn_mfma_f32_32x32x16_bf16(b0,qr[0],negm,0,0,0);p1=__builtin_amdgcn_mfma_f32_32x32x16_bf16(b1,qr[0],negm,0,0,0);}
    else{p0=__builtin_amdgcn_mfma_f32_32x32x16_bf16(b0,qr[d0],p0,0,0,0);p1=__builtin_amdgcn_mfma_f32_32x32x16_bf16(b1,qr[d0],p1,0,0,0);}}
}
typedef __attribute__((address_space(3))) const char* lds_cptr;
typedef short v4i16_t __attribute__((ext_vector_type(4)));
__device__ __forceinline__ void kload8(bf16x8*kf,lds_cptr kp){
  kf[0]=*(const __attribute__((address_space(3))) bf16x8*)(kp);      kf[1]=*(const __attribute__((address_space(3))) bf16x8*)(kp+512);
  kf[2]=*(const __attribute__((address_space(3))) bf16x8*)(kp+2048); kf[3]=*(const __attribute__((address_space(3))) bf16x8*)(kp+2560);
  kf[4]=*(const __attribute__((address_space(3))) bf16x8*)(kp+4096); kf[5]=*(const __attribute__((address_space(3))) bf16x8*)(kp+4608);
  kf[6]=*(const __attribute__((address_space(3))) bf16x8*)(kp+6144); kf[7]=*(const __attribute__((address_space(3))) bf16x8*)(kp+6656);
}
__device__ __forceinline__ void kload2(bf16x8*kf,lds_cptr kp,int j){ kf[2*j]=*(const __attribute__((address_space(3))) bf16x8*)(kp+j*2048); kf[2*j+1]=*(const __attribute__((address_space(3))) bf16x8*)(kp+j*2048+512); }
__device__ __forceinline__ s16x4 vtr(lds_cptr p){ return __builtin_bit_cast(s16x4,__builtin_amdgcn_ds_read_tr16_b64_v4i16((__attribute__((address_space(3))) v4i16_t*)p)); }
__device__ __forceinline__ float rowmax(const f32x16&p0,const f32x16&p1){
  float a=max3f(p0[0],p0[1],p1[0]),b=max3f(p0[2],p0[3],p1[1]);a=max3f(a,p1[2],p1[3]);
  #pragma unroll
  for(int r=4;r<16;r+=4){a=max3f(a,p0[r],p0[r+1]);b=max3f(b,p0[r+2],p0[r+3]);a=max3f(a,p1[r],p1[r+1]);b=max3f(b,p1[r+2],p1[r+3]);}
  const float m=max2f(a,b);
  auto rr=__builtin_amdgcn_permlane32_swap(__float_as_uint(m),__float_as_uint(m),false,false);
  return max2f(__uint_as_float(rr[0]),__uint_as_float(rr[1]));
}
__device__ __forceinline__ void pv(f32x16*o,int vb,bf16x8 pa0,bf16x8 pa1,bf16x8 pa2,bf16x8 pa3){
  #pragma unroll
  for(int d0=0;d0<2;++d0){s16x4 lo[4],hi[4];
    #pragma unroll
    for(int ks=0;ks<4;++ks){
      asm volatile("ds_read_b64_tr_b16 %0,%1 offset:%c2":"=&v"(lo[ks]):"v"(vb),"i"(d0*4096+ks*1024):"memory");
      asm volatile("ds_read_b64_tr_b16 %0,%1 offset:%c2":"=&v"(hi[ks]):"v"(vb),"i"(d0*4096+ks*1024+512):"memory");}
    asm volatile("s_waitcnt lgkmcnt(0)":::"memory");SBAR();
    #define PK(k) (bf16x8){lo[k][0],lo[k][1],lo[k][2],lo[k][3],hi[k][0],hi[k][1],hi[k][2],hi[k][3]}
    o[d0]=__builtin_amdgcn_mfma_f32_32x32x16_bf16(pa0,PK(0),o[d0],0,0,0);
    o[d0]=__builtin_amdgcn_mfma_f32_32x32x16_bf16(pa1,PK(1),o[d0],0,0,0);
    o[d0]=__builtin_amdgcn_mfma_f32_32x32x16_bf16(pa2,PK(2),o[d0],0,0,0);
    o[d0]=__builtin_amdgcn_mfma_f32_32x32x16_bf16(pa3,PK(3),o[d0],0,0,0);
    #undef PK
  }
}

#ifndef ATTN_STORE16
#define ATTN_STORE16(p,v) (*(u32x4*)(p)=(v))
#endif
template<int THRL> __device__ __forceinline__ void attn_unit(int b,int h,int g,int qb,const bf16*Q,const bf16*__restrict__ K,const bf16*__restrict__ V,bf16*O,char*shm){
  const int tid=otid(),lane=tid&63,r32=lane&31,hi=lane>>5; const int wid=__builtin_amdgcn_readfirstlane(tid>>6);
  const long rowbase=(long)b*SEQ; const int q0=qb*QB;
  const bf16*Qw=Q+(rowbase+q0+wid*QBLK)*PQ+h*D;
  const bf16*Kh=K+rowbase*PQ+g*D,*Vh=V+rowbase*PQ+g*D;
  const unsigned lds0=(unsigned)(uintptr_t)shm;
  float*wsf=(float*)(shm+LDS_WS)+wid*64;
  const bf16*ksrc=Kh+(long)lane*PQ+wid*8;
  const bf16*vsrc=Vh+(long)(16*(wid&3)+(lane>>2))*PQ+(wid>>2)*32+(lane&3)*8;
  const unsigned kdst=lds0+LDS_K+wid*1024, vdst=lds0+LDS_V+wid*1024;
  #define DMA_K(t,slot) glds16(ksrc+(long)(t)*KVBLK*PQ,(unsigned)__builtin_amdgcn_readfirstlane(kdst+(slot)))
  #define DMA_V(t,slot) glds16(vsrc+(long)(t)*KVBLK*PQ,(unsigned)__builtin_amdgcn_readfirstlane(vdst+(slot)))
  const int vb0=(int)(lds0+LDS_V)+((lane>>4)&1)*32+(lane&3)*8+(4*hi+((lane&15)>>2))*64;
  const char*Kbase=shm+LDS_K; bf16x8 kf[8];
  const lds_cptr shm3=(lds_cptr)shm; const lds_cptr kp0=shm3+LDS_K+hi*1024+r32*16; const lds_cptr vp0=shm3+LDS_V+((lane>>4)&1)*32+(lane&3)*8+(4*hi+((lane&15)>>2))*64;
  constexpr int NT=SEQ/KVBLK;
  DMA_K(0,0);DMA_V(0,0);DMA_K(1,SLOTB);
  bf16x8 qr[4];
  #pragma unroll
  for(int d0=0;d0<4;++d0)qr[d0]=*reinterpret_cast<const bf16x8*>(&Qw[(long)r32*PQ+d0*16+hi*8]);
  float mhat=0.f,l_reg=0.f;f32x16 o[2];o[0]=f32x16{};o[1]=f32x16{};f32x16 negm=f32x16{};asm volatile("":"+v"(negm));
    #define CMASK(P0,P1,t) do{}while(0)
  bool resc=false;
  #define START(P0,P1) do{ const float rm=rowmax(P0,P1); resc=false; \
    { const float dl=rm; mhat=fadd_s(mhat,dl); \
      _Pragma("unroll") for(int r=0;r<16;++r){P0[r]=fsub_s(P0[r],dl);P1[r]=fsub_s(P1[r],dl);} \
      _Pragma("unroll") for(int r=0;r<16;++r)negm[r]=-mhat; asm volatile("":"+v"(negm)); } \
    _Pragma("unroll") for(int r=0;r<16;++r)P0[r]=__builtin_amdgcn_exp2f(P0[r]); }while(0)
  #define RESC() do{ if(resc){ asm volatile("s_waitcnt lgkmcnt(0)":::"memory"); \
      _Pragma("unroll") for(int d_=0;d_<2;++d_) _Pragma("unroll") for(int r=0;r<16;++r)o[d_][r]*=wsf[crow(r,hi)]; } }while(0)
  f32x16 pA0,pA1,pB0,pB1;
  int sl_prev=0,sl_cur=0,sl_next=SLOTB;
  #define ROT() do{sl_prev=sl_cur;sl_cur=sl_next;sl_next=(sl_next==(NSLOT-1)*SLOTB)?0:sl_next+SLOTB;}while(0)
  DMA_K(2,2*SLOTB);
  WAIT_BAR(3);
  qkt(pA0,pA1,Kbase,qr,negm,r32,hi);asm volatile("s_nop 15\n\ts_nop 7":"+v"(pA0),"+v"(pA1));CMASK(pA0,pA1,0);
  START(pA0,pA1);
  _Pragma("unroll") for(int r=0;r<16;++r)pA1[r]=__builtin_amdgcn_exp2f(pA1[r]);
  WAIT_BAR(0);
  DMA_K(3,0);DMA_V(1,SLOTB);
  ROT();
  kload8(kf,kp0+sl_cur);
  WAIT_BAR(2);
  s16x4 vlo[8],vhi[8]; u32x4 pw0,pw1,pw2,pw3;
  #define PKW(P,B) cvtpk_s(P[B],P[B+1])
  #define PAF(k) __builtin_bit_cast(bf16x8,pw##k)
  #define VFR(i) (bf16x8){vlo[i][0],vlo[i][1],vlo[i][2],vlo[i][3],vhi[i][0],vhi[i][1],vhi[i][2],vhi[i][3]}
  #define PIN(x) asm volatile("":"+v"(x))
  #define MX3(a,b,c) __builtin_fmaxf(__builtin_fmaxf((a),(b)),(c))
  #define GAPA(MF,A0,A1,A2,A3,W0,W1,PW) do{ MF; sacc+=A0; sacc+=A1; sacc+=A2; sacc+=A3; PIN(sacc); W0; W1; PIN(PW); SBAR(); }while(0)
  #define EX(v) __builtin_amdgcn_exp2f(v)
  #define GAPB(MF,X,B) do{ MF; X[B]=EX(X[B]); X[B+1]=EX(X[B+1]); X[B+2]=EX(X[B+2]); X[B+3]=EX(X[B+3]); PIN(X); SBAR(); }while(0)
  #define VRD(i) do{ vlo[i]=vtr(vp_+(((i)>>2)*4096+((i)&3)*1024)); vhi[i]=vtr(vp_+(((i)>>2)*4096+((i)&3)*1024+512)); }while(0)
  #define KRD(G,j) do{ if(G){ kload2(kf,kp0+sl_next,j); SBAR(); } }while(0)
  #define STEP(C0,C1,P0,P1,t,GK,GV,GL) do{ SBAR(); \
    const lds_cptr vp_=vp0+sl_prev; \
    VRD(0); SBAR(); float sacc=(P0[0]+P0[1]); \
    GAPA(C0=__builtin_amdgcn_mfma_f32_32x32x16_bf16(kf[0],qr[0],negm,0,0,0), P0[2],P0[3],P0[4],P0[5],     pw0[0]=PKW(P0,0), pw0[1]=PKW(P0,2), pw0); \
    VRD(4); SBAR(); GAPA(C1=__builtin_amdgcn_mfma_f32_32x32x16_bf16(kf[1],qr[0],negm,0,0,0), P0[6],P0[7],P0[8],P0[9],     pw0[2]=PKW(P0,4), pw0[3]=PKW(P0,6), pw0); \
    VRD(1); SBAR(); GAPA(C0=__builtin_amdgcn_mfma_f32_32x32x16_bf16(kf[2],qr[1],C0,0,0,0),   P0[10],P0[11],P0[12],P0[13], pw1[0]=PKW(P0,8), pw1[1]=PKW(P0,10), pw1); \
    VRD(5); SBAR(); GAPA(C1=__builtin_amdgcn_mfma_f32_32x32x16_bf16(kf[3],qr[1],C1,0,0,0),   P0[14],P0[15],P1[0],P1[1],   pw1[2]=PKW(P0,12),pw1[3]=PKW(P0,14), pw1); \
    VRD(2); SBAR(); GAPA(C0=__builtin_amdgcn_mfma_f32_32x32x16_bf16(kf[4],qr[2],C0,0,0,0),   P1[2],P1[3],P1[4],P1[5],     pw2[0]=PKW(P1,0), pw2[1]=PKW(P1,2), pw2); \
    VRD(6); SBAR(); GAPA(C1=__builtin_amdgcn_mfma_f32_32x32x16_bf16(kf[5],qr[2],C1,0,0,0),   P1[6],P1[7],P1[8],P1[9],     pw2[2]=PKW(P1,4), pw2[3]=PKW(P1,6), pw2); \
    VRD(3); SBAR(); GAPA(C0=__builtin_amdgcn_mfma_f32_32x32x16_bf16(kf[6],qr[3],C0,0,0,0),   P1[10],P1[11],P1[12],P1[13], pw3[0]=PKW(P1,8), pw3[1]=PKW(P1,10), pw3); \
    VRD(7); SBAR(); GAPA(C1=__builtin_amdgcn_mfma_f32_32x32x16_bf16(kf[7],qr[3],C1,0,0,0),   P1[14],P1[15],0.f,0.f,       pw3[2]=PKW(P1,12),pw3[3]=PKW(P1,14), pw3); \
    l_reg+=sacc; \
    if(GK){DMA_K((t)+3,sl_cur);} if(GV){DMA_V((t)+1,sl_next);} \
    CMASK(C0,C1,t); \
    { float a=MX3(C0[0],C0[1],C1[0]),b=MX3(C0[2],C0[3],C1[1]); a=MX3(a,C1[2],C1[3]); \
      _Pragma("unroll") for(int r=4;r<16;r+=4){a=MX3(a,C0[r],C0[r+1]);b=MX3(b,C0[r+2],C0[r+3]);a=MX3(a,C1[r],C1[r+1]);b=MX3(b,C1[r+2],C1[r+3]);} \
      float rm=__builtin_fmaxf(a,b); { auto rr=__builtin_amdgcn_permlane32_swap(__float_as_uint(rm),__float_as_uint(rm),false,false); rm=__builtin_fmaxf(__uint_as_float(rr[0]),__uint_as_float(rr[1])); } \
      resc=false; \
      if(__builtin_expect(__any(rm>(float)THRL),0)){ const float dl=__builtin_fmaxf(rm,0.f); mhat+=dl; \
        _Pragma("unroll") for(int r=0;r<16;++r){C0[r]-=dl;C1[r]-=dl;} \
        _Pragma("unroll") for(int r=0;r<16;++r)negm[r]=-mhat; asm volatile("":"+v"(negm)); \
        const float f=__builtin_amdgcn_exp2f(-dl); l_reg*=f; if(hi==0)wsf[r32]=f; resc=true; } } \
    SBAR(); \
    GAPB(o[0]=__builtin_amdgcn_mfma_f32_32x32x16_bf16(PAF(0),VFR(0),o[0],0,0,0), C0,0); \
    GAPB(o[1]=__builtin_amdgcn_mfma_f32_32x32x16_bf16(PAF(0),VFR(4),o[1],0,0,0), C0,4); \
    KRD(GL,0); GAPB(o[0]=__builtin_amdgcn_mfma_f32_32x32x16_bf16(PAF(1),VFR(1),o[0],0,0,0), C0,8); \
    KRD(GL,1); GAPB(o[1]=__builtin_amdgcn_mfma_f32_32x32x16_bf16(PAF(1),VFR(5),o[1],0,0,0), C0,12); \
    KRD(GL,2); GAPB(o[0]=__builtin_amdgcn_mfma_f32_32x32x16_bf16(PAF(2),VFR(2),o[0],0,0,0), C1,0); \
    KRD(GL,3); GAPB(o[1]=__builtin_amdgcn_mfma_f32_32x32x16_bf16(PAF(2),VFR(6),o[1],0,0,0), C1,4); \
    GAPB(o[0]=__builtin_amdgcn_mfma_f32_32x32x16_bf16(PAF(3),VFR(3),o[0],0,0,0), C1,8); \
    GAPB(o[1]=__builtin_amdgcn_mfma_f32_32x32x16_bf16(PAF(3),VFR(7),o[1],0,0,0), C1,12); \
    }while(0)
  int t=1;
  #undef CMASK
  #define CMASK(P0,P1,t) do{}while(0)
  for(;t+5<NT;t+=2){
    STEP(pB0,pB1,pA0,pA1,t,true,true,true);     WAIT_BAR(2); RESC(); ROT();
    STEP(pA0,pA1,pB0,pB1,t+1,true,true,true);   WAIT_BAR(2); RESC(); ROT();
  }
  #define ENDW(tt) do{ if((tt)+3<NT){WAIT_BAR(2);} else if((tt)+2<NT){WAIT_BAR(1);} else {WAIT_BAR(0);} }while(0)
  for(;t+1<NT;t+=2){
    STEP(pB0,pB1,pA0,pA1,t,(t+3<NT),(t+1<NT),(t+1<NT));       ENDW(t);   RESC(); ROT();
    STEP(pA0,pA1,pB0,pB1,t+1,(t+4<NT),(t+2<NT),(t+2<NT));     ENDW(t+1); RESC(); ROT();
  }
  STEP(pB0,pB1,pA0,pA1,NT-1,false,false,false); RESC();
  { float sacc=pB0[0]+pB0[1]; _Pragma("unroll") for(int r=2;r<16;++r)sacc+=pB0[r]; _Pragma("unroll") for(int r=0;r<16;++r)sacc+=pB1[r]; l_reg+=sacc;
    pw0=(u32x4){PKW(pB0,0),PKW(pB0,2),PKW(pB0,4),PKW(pB0,6)};pw1=(u32x4){PKW(pB0,8),PKW(pB0,10),PKW(pB0,12),PKW(pB0,14)};pw2=(u32x4){PKW(pB1,0),PKW(pB1,2),PKW(pB1,4),PKW(pB1,6)};pw3=(u32x4){PKW(pB1,8),PKW(pB1,10),PKW(pB1,12),PKW(pB1,14)};
    SBAR(); pv(o,vb0+sl_cur,PAF(0),PAF(1),PAF(2),PAF(3)); }
  #undef PKW
  #undef PAF
  #undef VFR
  #undef PIN
  #undef MX3
  #undef GAPA
  #undef GAPB
  #undef EX
  #undef VRD
  #undef KRD
  #undef STEP
  #undef ENDW
  {auto rr=__builtin_amdgcn_permlane32_swap(__float_as_uint(l_reg),__float_as_uint(l_reg),false,false);l_reg=__uint_as_float(rr[0])+__uint_as_float(rr[1]);}
  if(hi==0)wsf[32+r32]=l_reg;asm volatile("s_waitcnt lgkmcnt(0)":::"memory");
  float rli[16];
  #pragma unroll
  for(int r=0;r<16;++r)rli[r]=__builtin_amdgcn_rcpf(wsf[32+crow(r,hi)]);
  bf16*Ow=O+(rowbase+q0+wid*QBLK)*PO+h*D;
  { bf16*stg=(bf16*)(shm+LDS_OST)+wid*2048;
    #pragma unroll
    for(int r=0;r<16;++r){const int orow=crow(r,hi);
      #pragma unroll
      for(int d0=0;d0<2;++d0)stg[orow*64+d0*32+r32]=__float2bfloat16(o[d0][r]*rli[r]);}
    asm volatile("s_waitcnt lgkmcnt(0)":::"memory");
    #pragma unroll
    for(int i=0;i<4;++i){const int row=i*8+(lane>>3),ch=lane&7; const u32x4 v=*(const u32x4*)(stg+row*64+ch*8); ATTN_STORE16(Ow+(long)row*PO+ch*8,v);} }
  asm volatile("s_waitcnt lgkmcnt(0)\n\ts_barrier":::"memory");
  #undef DMA_K
  #undef DMA_V
  #undef CMASK
  #undef START
  #undef RESC
  #undef ROT
}
constexpr int ATTN_LDS_BYTES=LDS_BYTES;
#undef SBAR
#undef WAIT_BAR
}

__device__ __forceinline__ void phase_attn(const Params& p, char* lds) {
            {
                const int bid = obid();
                const int vcu = ((NBLK & 7) == 0) ? (bid & 7) * (int)(NBLK >> 3) + (bid >> 3) : bid;
                const attn_body::bf16* qkvb = (const attn_body::bf16*)(p.ws + R_QKV);
                for (int u = vcu; u < 512; u += NBLK) {
                    const int bg = (u & 255) >> 6, r = u & 63, hh = r & 3, qb = (r >> 2) + 16 * (u >> 8);
                    const int b = bg >> 1, g = bg & 1;
                    attn_body::attn_unit<8>(b, 4 * g + hh, g, qb, qkvb, qkvb + 512, qkvb + 640, (attn_body::bf16*)(p.ws + R_ATT), lds);
                }
            }
}

__device__ __forceinline__ size_t cidx(int c, int t) { return ((size_t)(t >> 5) * 256 + c) * 32 + (t & 31); }
__device__ __forceinline__ f32x4 convd4(const float* row, int l0, float w0, float w1, float w2, float cb) {
    const f32x4 c = *(const f32x4*)(row + l0);
    const float lft = (l0 > 0) ? row[l0 - 1] : 0.f;
    const float rgt = (l0 + 4 < SL) ? row[l0 + 4] : 0.f;
    f32x4 o;
    o.x = cb + w0 * lft + w1 * c.x + w2 * c.y;
    o.y = cb + w0 * c.x + w1 * c.y + w2 * c.z;
    o.z = cb + w0 * c.y + w1 * c.z + w2 * c.w;
    o.w = cb + w0 * c.z + w1 * c.w + w2 * rgt;
    return o;
}
__device__ __forceinline__ void cmul_kf(float2* Z, const float2* KF, int tid) {
#pragma unroll 4
    for (int i = 0; i < 16; ++i) {
        const int pp = 2 * tid + 1024 * i;
        const f32x4 z = *(const f32x4*)(Z + zp(pp)), k = *(const f32x4*)(KF + pp);
        f32x4 o; o.x = z.x * k.x - z.y * k.y; o.y = z.x * k.y + z.y * k.x; o.z = z.z * k.z - z.w * k.w; o.w = z.z * k.w + z.w * k.z;
        *(f32x4*)(Z + zp(pp)) = o;
    }
}
__device__ __forceinline__ void hyena_job(const Params& p, int layer, int c, char* lds) {
    const int tid = otid();
    float2* Z = (float2*)lds;
    const float* HF = (const float*)(p.ws + R_HF);
    const float* cw = p.in[I_CW] + (size_t)layer * 3 * 768; const float* cbp = p.in[I_CB] + layer * 768;
    const float2* KF0 = (const float2*)(p.ws + OFF_KF) + ((size_t)(layer * 256 + c) * 2) * 16384;
    const float2* KF1 = KF0 + 16384;
    float* Yb = (float*)(p.ws + R_Y);
    const int cv = c, c1 = 256 + c, c2 = 512 + c;
    const float* rv = HF + (size_t)cv * T; const float* r1 = HF + (size_t)c1 * T; const float* r2 = HF + (size_t)c2 * T;
    const float v_w0 = cw[cv], v_w1 = cw[768 + cv], v_w2 = cw[1536 + cv], v_cb = cbp[cv];
    const float a_w0 = cw[c1], a_w1 = cw[768 + c1], a_w2 = cw[1536 + c1], a_cb = cbp[c1];
    const float b_w0 = cw[c2], b_w1 = cw[768 + c2], b_w2 = cw[1536 + c2], b_cb = cbp[c2];
    const f32x4 zero4 = {0.f, 0.f, 0.f, 0.f};
    __syncthreads();
#pragma unroll 1
    for (int i = 0; i < 4; ++i) {
        const int l0 = 4 * otid() + 2048 * i;
        const f32x4 va = convd4(rv, l0, v_w0, v_w1, v_w2, v_cb), vb = convd4(rv + SL, l0, v_w0, v_w1, v_w2, v_cb);
        *(f32x4*)(Z + zp(l0)) = (f32x4){va.x, vb.x, va.y, vb.y}; *(f32x4*)(Z + zp(l0) + 2) = (f32x4){va.z, vb.z, va.w, vb.w};
        *(f32x4*)(Z + zp(8192 + l0)) = zero4; *(f32x4*)(Z + zp(8192 + l0) + 2) = zero4;
    }
    __syncthreads();
    fft16k_fwd(Z);
    cmul_kf(Z, KF0, otid());
    __syncthreads();
    fft16k_inv(Z);
#pragma unroll 1
    for (int i = 0; i < 4; ++i) {
        const int l0 = 4 * otid() + 2048 * i;
        const f32x4 za = *(const f32x4*)(Z + zp(l0)), zb = *(const f32x4*)(Z + zp(l0) + 2);
        const f32x4 ga = convd4(r1, l0, a_w0, a_w1, a_w2, a_cb), gb = convd4(r1 + SL, l0, a_w0, a_w1, a_w2, a_cb);
        *(f32x4*)(Z + zp(l0)) = (f32x4){ga.x * za.x, gb.x * za.y, ga.y * za.z, gb.y * za.w};
        *(f32x4*)(Z + zp(l0) + 2) = (f32x4){ga.z * zb.x, gb.z * zb.y, ga.w * zb.z, gb.w * zb.w};
        *(f32x4*)(Z + zp(8192 + l0)) = zero4; *(f32x4*)(Z + zp(8192 + l0) + 2) = zero4;
    }
    __syncthreads();
    fft16k_fwd(Z);
    cmul_kf(Z, KF1, otid());
    __syncthreads();
    fft16k_inv(Z);
#pragma unroll 1
    for (int i = 0; i < 4; ++i) {
        const int l0 = 4 * otid() + 2048 * i;
        const f32x4 za = *(const f32x4*)(Z + zp(l0)), zb = *(const f32x4*)(Z + zp(l0) + 2);
        const f32x4 ga = convd4(r2, l0, b_w0, b_w1, b_w2, b_cb), gb = convd4(r2 + SL, l0, b_w0, b_w1, b_w2, b_cb);
        f32x4 ya, yb;
        ya.x = ga.x * za.x; ya.y = ga.y * za.z; ya.z = ga.z * zb.x; ya.w = ga.w * zb.z;
        yb.x = gb.x * za.y; yb.y = gb.y * za.w; yb.z = gb.z * zb.y; yb.w = gb.w * zb.w;
        *(f32x4*)(Yb + cidx(c, l0)) = ya; *(f32x4*)(Yb + cidx(c, SL + l0)) = yb;
    }
    __syncthreads();
}

__device__ __forceinline__ void fnet_job(const Params& p, int ch, char* lds) {
    const int tid = otid();
    float2* Z = (float2*)lds;
    const float* row = (const float*)(p.ws + R_HF) + (size_t)(768 + ch) * T;
    float* UR = (float*)(p.ws + R_UR);
    float* UI = (float*)(p.ws + R_UI);
    __syncthreads();
#pragma unroll
    for (int i = 0; i < 4; ++i) {
        const int l0 = 4 * tid + 2048 * i;
        const f32x4 a = *(const f32x4*)(row + l0), b = *(const f32x4*)(row + SL + l0);
        const int z0 = zp(l0);
        *(f32x4*)(Z + z0) = (f32x4){a.x, b.x, a.y, b.y}; *(f32x4*)(Z + z0 + 2) = (f32x4){a.z, b.z, a.w, b.w};
    }
    __syncthreads();
    fft8k_fwd(Z);
#pragma unroll
    for (int i = 0; i < 4; ++i) {
        const int k0 = 4 * tid + 2048 * i;
        f32x4 ur0, ui0, ur1, ui1;
#pragma unroll
        for (int e = 0; e < 4; ++e) {
            const int k = k0 + e;
            const int pk = p8k_of_f(k);
            const int pm = p8k_of_f((SL - k) & (SL - 1));
            const float2 zk = Z[zp(pk)], zm = Z[zp(pm)];
            ur0[e] = 0.5f * (zk.x + zm.x); ui0[e] = 0.5f * (zk.y - zm.y);
            ur1[e] = 0.5f * (zk.y + zm.y); ui1[e] = 0.5f * (zm.x - zk.x);
        }
        *(f32x4*)(UR + cidx(ch, k0)) = ur0; *(f32x4*)(UI + cidx(ch, k0)) = ui0; *(f32x4*)(UR + cidx(ch, SL + k0)) = ur1; *(f32x4*)(UI + cidx(ch, SL + k0)) = ui1;
    }
    __syncthreads();
}

__device__ __forceinline__ void phase_mix(const Params& p, int layer, char* lds) {
    const int tid = otid(), lane = tid & 63, wave = tid >> 6;
    const int l31 = lane & 31, hl = lane >> 5, g = wave & 3, tsel = wave >> 2;
    float* ex = (float*)lds;
    float* FMl = (float*)(lds + 8192);
    const float* UR = (const float*)(p.ws + R_UR); const float* UI = (const float*)(p.ws + R_UI);
    const float* Y = (const float*)(p.ws + R_Y);
    const bf16_t* att = (const bf16_t*)(p.ws + R_ATT);
    bf16_t* mix = (bf16_t*)(p.ws + R_MIX);
    const float* fb = p.in[I_FB] + layer * 256 + g * 64;
    const float* mg = p.in[I_MG] + layer * 1024;
    __syncthreads();
    {
        const f32x4* src = (const f32x4*)((const float*)(p.ws + OFF_FM) + (size_t)layer * 4 * 128 * 64);
#pragma unroll 4
        for (int i = 0; i < 16; ++i) *(f32x4*)(FMl + 4 * (tid + NTHR * i)) = src[tid + NTHR * i];
    }
    for (int tp = obid(); tp < T / 64; tp += NBLK) {
        const int t = (tp * 2 + tsel) * 32 + l31;
        float bv[64];
        {
            const float* ub = UR + cidx(g * 64 + hl, t);
            const float* ub2 = UI + cidx(g * 64 + hl, t);
#pragma unroll
            for (int i = 0; i < 32; ++i) { bv[i] = ub[(2 * i) * 32]; bv[32 + i] = ub2[(2 * i) * 32]; }
        }
        float yv[32];
        {
            const float* yb = Y + cidx(g * 64 + hl * 32, t);
#pragma unroll
            for (int i = 0; i < 32; ++i) yv[i] = yb[i * 32];
        }
        const bf16_t* ab = att + (size_t)t * 512 + g * 128 + hl * 64;
        float sa = 0.f;
#pragma unroll
        for (int q = 0; q < 8; ++q) {
            const u32x4 a = *(const u32x4*)(ab + 8 * q);
            const float x0 = bflo(a.x), x1 = bfhi(a.x), x2 = bflo(a.y), x3 = bfhi(a.y), x4 = bflo(a.z), x5 = bfhi(a.z), x6 = bflo(a.w), x7 = bfhi(a.w);
            sa += x0 * x0 + x1 * x1 + x2 * x2 + x3 * x3 + x4 * x4 + x5 * x5 + x6 * x6 + x7 * x7;
        }
        __syncthreads();
        f32x16 acc0 = zero16(), acc1 = zero16();
        {
            const float* fa = FMl + (g * 128 + hl) * 64 + l31;
#pragma unroll
            for (int i = 0; i < 64; ++i) {
                const float a0 = fa[(2 * i) * 64], a1 = fa[(2 * i) * 64 + 32];
                acc0 = __builtin_amdgcn_mfma_f32_32x32x2f32(a0, bv[i], acc0, 0, 0, 0);
                acc1 = __builtin_amdgcn_mfma_f32_32x32x2f32(a1, bv[i], acc1, 0, 0, 0);
            }
        }
        float sf = 0.f;
#pragma unroll
        for (int i = 0; i < 4; ++i) {
            const f32x4 b0 = *(const f32x4*)(fb + 8 * i + 4 * hl), b1 = *(const f32x4*)(fb + 32 + 8 * i + 4 * hl);
            acc0[4 * i] += b0.x; acc0[4 * i + 1] += b0.y; acc0[4 * i + 2] += b0.z; acc0[4 * i + 3] += b0.w;
            acc1[4 * i] += b1.x; acc1[4 * i + 1] += b1.y; acc1[4 * i + 2] += b1.z; acc1[4 * i + 3] += b1.w;
        }
#pragma unroll
        for (int r = 0; r < 16; ++r) sf += acc0[r] * acc0[r] + acc1[r] * acc1[r];
        float sy = 0.f;
#pragma unroll
        for (int i = 0; i < 32; ++i) sy += yv[i] * yv[i];
        ex[(0 * 8 + wave) * 64 + lane] = sa; ex[(1 * 8 + wave) * 64 + lane] = sy; ex[(2 * 8 + wave) * 64 + lane] = sf;
        __syncthreads();
        float ta = 0.f, ty = 0.f, tf = 0.f;
#pragma unroll
        for (int w = 0; w < 4; ++w)
#pragma unroll
            for (int hh = 0; hh < 2; ++hh) {
                const int o = (tsel * 4 + w) * 64 + hh * 32 + l31;
                ta += ex[0 * 512 + o]; ty += ex[1 * 512 + o]; tf += ex[2 * 512 + o];
            }
        const float ra = rsqrtf(ta * (1.0f / 512.0f) + EPS), ry = rsqrtf(ty * (1.0f / 256.0f) + EPS), rf = rsqrtf(tf * (1.0f / 256.0f) + EPS);
        bf16_t* mrow = mix + (size_t)t * 1024;
        {
            const float* gg = mg + g * 128 + hl * 64;
#pragma unroll
            for (int q = 0; q < 8; ++q) {
                const u32x4 a = *(const u32x4*)(ab + 8 * q);
                const f32x4 g0 = *(const f32x4*)(gg + 8 * q), g1 = *(const f32x4*)(gg + 8 * q + 4);
                u32x4 o;
                o.x = pk2(bflo(a.x) * ra * g0.x, bfhi(a.x) * ra * g0.y); o.y = pk2(bflo(a.y) * ra * g0.z, bfhi(a.y) * ra * g0.w);
                o.z = pk2(bflo(a.z) * ra * g1.x, bfhi(a.z) * ra * g1.y); o.w = pk2(bflo(a.w) * ra * g1.z, bfhi(a.w) * ra * g1.w);
                *(u32x4*)(mrow + g * 128 + hl * 64 + 8 * q) = o;
            }
        }
        {
            const float* gg = mg + 512 + g * 64 + hl * 32;
#pragma unroll
            for (int q = 0; q < 4; ++q) {
                const f32x4 g0 = *(const f32x4*)(gg + 8 * q), g1 = *(const f32x4*)(gg + 8 * q + 4);
                u32x4 o;
                o.x = pk2(yv[8 * q] * ry * g0.x, yv[8 * q + 1] * ry * g0.y); o.y = pk2(yv[8 * q + 2] * ry * g0.z, yv[8 * q + 3] * ry * g0.w);
                o.z = pk2(yv[8 * q + 4] * ry * g1.x, yv[8 * q + 5] * ry * g1.y); o.w = pk2(yv[8 * q + 6] * ry * g1.z, yv[8 * q + 7] * ry * g1.w);
                *(u32x4*)(mrow + 512 + g * 64 + hl * 32 + 8 * q) = o;
            }
        }
        {
            const float* gg = mg + 768 + g * 64;
#pragma unroll
            for (int i = 0; i < 4; ++i) {
                const f32x4 g0 = *(const f32x4*)(gg + 8 * i + 4 * hl), g1 = *(const f32x4*)(gg + 32 + 8 * i + 4 * hl);
                u32x2 o0, o1;
                o0.x = pk2(acc0[4 * i] * rf * g0.x, acc0[4 * i + 1] * rf * g0.y); o0.y = pk2(acc0[4 * i + 2] * rf * g0.z, acc0[4 * i + 3] * rf * g0.w);
                o1.x = pk2(acc1[4 * i] * rf * g1.x, acc1[4 * i + 1] * rf * g1.y); o1.y = pk2(acc1[4 * i + 2] * rf * g1.z, acc1[4 * i + 3] * rf * g1.w);
                *(u32x2*)(mrow + 768 + g * 64 + 8 * i + 4 * hl) = o0;
                *(u32x2*)(mrow + 768 + g * 64 + 32 + 8 * i + 4 * hl) = o1;
            }
        }
    }
}

__device__ __forceinline__ float tk_pack(float v, unsigned code, unsigned mask) { return __builtin_bit_cast(float, (__builtin_bit_cast(unsigned, v) & ~mask) | code); }
__device__ __forceinline__ unsigned tk_lookup(const unsigned (&P)[4], unsigned i) {
    const unsigned w = (i < 4u) ? P[0] : (i < 8u) ? P[1] : (i < 12u) ? P[2] : P[3];
    return (w >> ((i & 3u) * 8u)) & 0x7Fu;
}
__device__ __forceinline__ float gelu_exact(float x) { return 0.5f * x * (1.0f + erff(x * 0.70710678118654752f)); }
typedef float f32x2 __attribute__((ext_vector_type(2)));
#define CVT_LO(W) __builtin_amdgcn_cvt_pk_f32_fp8((int)(W), false)
#define CVT_HI(W) __builtin_amdgcn_cvt_pk_f32_fp8((int)(W), true)


__device__ __forceinline__ void tk_sort16(float (&a)[16]) {
#pragma unroll
    for (int k = 2; k <= 16; k <<= 1)
#pragma unroll
        for (int j = k >> 1; j > 0; j >>= 1)
#pragma unroll
            for (int i = 0; i < 16; ++i) {
                const int l = i ^ j;
                if (l > i) {
                    const float hi = fmaxf(a[i], a[l]), lo = fminf(a[i], a[l]);
                    if ((i & k) == 0) { a[i] = hi; a[l] = lo; } else { a[i] = lo; a[l] = hi; }
                }
            }
}
__device__ __forceinline__ void tk_merge16(float (&a)[16]) {
#pragma unroll
    for (int j = 8; j > 0; j >>= 1)
#pragma unroll
        for (int i = 0; i < 16; ++i) {
            const int l = i ^ j;
            if (l > i) { const float hi = fmaxf(a[i], a[l]), lo = fminf(a[i], a[l]); a[i] = hi; a[l] = lo; }
        }
}
__device__ __forceinline__ void tk_top16_merge(float (&l)[16], const float (&g)[16]) {
#pragma unroll
    for (int i = 0; i < 16; ++i) l[i] = fmaxf(l[i], g[15 - i]);
    tk_merge16(l);
}
template <int CTRL> __device__ __forceinline__ float dpp_f(float v) { return __builtin_bit_cast(float, __builtin_amdgcn_update_dpp(0, __builtin_bit_cast(int, v), CTRL, 0xF, 0xF, false)); }
constexpr int PE_LOGR = 4, PE_NR = 1 << PE_LOGR;
constexpr int PE_ENT = 12 * 1024;
constexpr int PE_WAVE = PE_ENT;


#define PE_RL(k) (((k & 4) << 1) | ((k & 2) << 3) | ((k & 1) << 5))
#define PE_LOAD_U(TK, RW, EV, CU, CG) do { \
        const int base_ = ((TK) * 128 + r * 8 + eid) * 3; \
        EV = ent[base_]; CU = __builtin_bit_cast(float, ent[base_ + 1]); CG = __builtin_bit_cast(float, ent[base_ + 2]); \
        _Pragma("unroll") for (int k = 0; k < 8; ++k) { const unsigned e = (unsigned)__builtin_amdgcn_readlane(EV, PE_RL(k)); \
            RW[k] = *(const u32x4*)(PU + (size_t)(e * 1024u) + loff); } \
    } while (0)
#define PE_COMP_U(TK, RW, CU, CG) do { \
        f32x2 xl[8]; \
        _Pragma("unroll") for (int j = 0; j < 4; ++j) { xl[2 * j] = (f32x2){bflo(xp[TK][j].x), bfhi(xp[TK][j].x)}; xl[2 * j + 1] = (f32x2){bflo(xp[TK][j].y), bfhi(xp[TK][j].y)}; } \
        float d[8]; \
        _Pragma("unroll") for (int k = 0; k < 8; ++k) { f32x2 s2 = CVT_LO(RW[k].x) * xl[0]; \
            s2 += CVT_HI(RW[k].x) * xl[1]; s2 += CVT_LO(RW[k].y) * xl[2]; s2 += CVT_HI(RW[k].y) * xl[3]; \
            s2 += CVT_LO(RW[k].z) * xl[4]; s2 += CVT_HI(RW[k].z) * xl[5]; s2 += CVT_LO(RW[k].w) * xl[6]; s2 += CVT_HI(RW[k].w) * xl[7]; \
            d[k] = s2.x + s2.y; } \
        _Pragma("unroll") for (int k = 0; k < 8; ++k) { d[k] += dpp_f<0xB1>(d[k]); d[k] += dpp_f<0x4E>(d[k]); d[k] += dpp_f<0x141>(d[k]); } \
        float r4[4], r2[2], u1; \
        _Pragma("unroll") for (int k = 0; k < 4; ++k) { const float send = b3 ? d[k] : d[k + 4], keep = b3 ? d[k + 4] : d[k]; r4[k] = keep + dpp_f<0x140>(send); } \
        _Pragma("unroll") for (int k = 0; k < 2; ++k) { const float send = b4 ? r4[k] : r4[k + 2], keep = b4 ? r4[k + 2] : r4[k]; r2[k] = keep + __shfl_xor(send, 16); } \
        { const float send = b5 ? r2[0] : r2[1], keep = b5 ? r2[1] : r2[0]; u1 = keep + __shfl_xor(send, 32); } \
        const float av = gelu_exact(u1 * CU) * CG; \
        if ((lane & 7) == 0) ent[((TK) * 128 + r * 8 + eid) * 3 + 1] = __builtin_bit_cast(int, av);     \
    } while (0)
#define PE_LOAD_V(TK, RW, AV) do { \
        const int base_ = ((TK) * 128 + r * 8 + eid) * 3; \
        const int ev = ent[base_]; AV = ent[base_ + 1]; \
        _Pragma("unroll") for (int k = 0; k < 8; ++k) { const unsigned e = (unsigned)__builtin_amdgcn_readlane(ev, PE_RL(k)); \
            RW[k] = *(const u32x4*)(PV + (size_t)(e * 1024u) + loff); } \
    } while (0)
#define PE_COMP_V(TK, RW, AV) do { \
        _Pragma("unroll") for (int k = 0; k < 8; ++k) { \
            const float a = __builtin_bit_cast(float, __builtin_amdgcn_readlane(AV, PE_RL(k))); \
            const f32x2 a2 = (f32x2){a, a}; \
            acc[TK][0] += a2 * CVT_LO(RW[k].x); acc[TK][1] += a2 * CVT_HI(RW[k].x); acc[TK][2] += a2 * CVT_LO(RW[k].y); acc[TK][3] += a2 * CVT_HI(RW[k].y); \
            acc[TK][4] += a2 * CVT_LO(RW[k].z); acc[TK][5] += a2 * CVT_HI(RW[k].z); acc[TK][6] += a2 * CVT_LO(RW[k].w); acc[TK][7] += a2 * CVT_HI(RW[k].w); } \
    } while (0)

template <bool DRY> __device__ __forceinline__ void phase_peer_fused(const Params& p, int layer, char* lds) {
    const int tid = otid(), lane = tid & 63, wave = tid >> 6;
    const unsigned char* PU = p.ws + OFF_PU + (size_t)layer * 16384 * 1024;
    const unsigned char* PV = p.ws + OFF_PV + (size_t)layer * 16384 * 1024;
    const float* SU = (const float*)(p.ws + OFF_PSC) + (size_t)layer * 16384;
    const float* SV = (const float*)(p.ws + OFF_PSC) + (size_t)(2 + layer) * 16384;
    bf16_t* XN = (bf16_t*)(p.ws + R_XN);
    float* XA = (float*)(p.ws + OFF_XA);
    const _Float16* SC = (const _Float16*)(p.ws + R_QP);
    const bool last = (layer == NLAYER - 1);
    const float* gnext = last ? p.in[I_FG] : p.in[I_N1G] + (layer + 1) * DM;
    const float* g2p = p.in[I_N2G] + layer * DM;
    const bool b5 = (lane & 32) != 0, b4 = (lane & 16) != 0, b3 = (lane & 8) != 0;
    const int eid = ((lane >> 3) & 1) * 4 + ((lane >> 4) & 1) * 2 + (lane >> 5);
    const unsigned loff = (unsigned)lane * 16u;
    int* ent = (int*)(lds + wave * PE_WAVE);
    const float NINF = -3.0e38f;
    const int pp = lane & 1;
    for (int tb = (obid() * NWAVE + wave) * 8; tb < T; tb += NBLK * NWAVE * 8) {
#pragma unroll 1
        for (int grp = 0; grp < 2; ++grp) {
            const int tkl = grp * 4 + (lane >> 4), h = (lane >> 1) & 7;
            const f16x8* src = (const f16x8*)(SC + (size_t)(tb + tkl) * 2048 + h * 256 + pp * 128);
            float l[16];
#pragma unroll
            for (int i = 0; i < 16; ++i) l[i] = NINF;
#pragma unroll 1
            for (int c = 0; c < 4; ++c) {
                f32x4 v[8];
#pragma unroll
                for (int j = 0; j < 4; ++j) {
                    const f16x8 hv = src[c * 4 + j];
                    v[2 * j] = (f32x4){(float)hv[0], (float)hv[1], (float)hv[2], (float)hv[3]};
                    v[2 * j + 1] = (f32x4){(float)hv[4], (float)hv[5], (float)hv[6], (float)hv[7]};
                }
#pragma unroll
                for (int hh = 0; hh < 2; ++hh) {
                    float g[16];
#pragma unroll
                    for (int j = 0; j < 4; ++j) {
                        const unsigned kb = (unsigned)(c * 32 + hh * 16 + j * 4);
                        g[4 * j] = tk_pack(v[hh * 4 + j].x, kb, 0x7Fu); g[4 * j + 1] = tk_pack(v[hh * 4 + j].y, kb + 1u, 0x7Fu);
                        g[4 * j + 2] = tk_pack(v[hh * 4 + j].z, kb + 2u, 0x7Fu); g[4 * j + 3] = tk_pack(v[hh * 4 + j].w, kb + 3u, 0x7Fu);
                    }
                    tk_sort16(g);
                    tk_top16_merge(l, g);
                }
            }
            float xw[16], ow[16]; unsigned PX[4] = {0u, 0u, 0u, 0u}, PO[4] = {0u, 0u, 0u, 0u};
#pragma unroll
            for (int i = 0; i < 16; ++i) {
                const float o = __shfl_xor(l[i], 1);
                const unsigned xb = __builtin_bit_cast(unsigned, l[i]), ob = __builtin_bit_cast(unsigned, o);
                xw[i] = __builtin_bit_cast(float, xb & ~0x7Fu); ow[i] = __builtin_bit_cast(float, ob & ~0x7Fu);
                PX[i >> 2] |= (xb & 0x7Fu) << ((i & 3) * 8); PO[i >> 2] |= (ob & 0x7Fu) << ((i & 3) * 8);
            }
            float f[16];
            {
                float c1[16];
#pragma unroll
                for (int i = 0; i < 16; ++i) { f[i] = NINF; c1[i] = NINF; }
                int cnt = 0;
#pragma unroll
                for (int i = 0; i < 16; ++i)
#pragma unroll
                    for (int j = i; j < 16; ++j)
                        if ((i + 1) * (j + 1) <= 16) {
                            float cv = xw[i] + ow[j];
                            const unsigned code = pp ? (unsigned)((j << 4) | i) : (unsigned)((i << 4) | j);
                            cv = tk_pack(cv, code, 0xFFu);
                            if (i == j) cv = pp ? NINF : cv;
                            if (cnt < 16) f[cnt & 15] = cv; else c1[cnt & 15] = cv;
                            ++cnt;
                        }
                tk_sort16(f); tk_sort16(c1);
                tk_top16_merge(f, c1);
                float gq[16];
#pragma unroll
                for (int i = 0; i < 16; ++i) gq[i] = __shfl_xor(f[i], 1);
                tk_top16_merge(f, gq);
            }
            unsigned P0[4], P1[4];
#pragma unroll
            for (int q = 0; q < 4; ++q) { P0[q] = pp ? PO[q] : PX[q]; P1[q] = pp ? PX[q] : PO[q]; }
            const float top = __builtin_bit_cast(float, __builtin_bit_cast(unsigned, f[0]) & ~0xFFu);
            float ev[16]; float den = 0.f;
#pragma unroll
            for (int r = 0; r < 16; ++r) { ev[r] = __expf(__builtin_bit_cast(float, __builtin_bit_cast(unsigned, f[r]) & ~0xFFu) - top); den += ev[r]; }
            const float rden = 1.0f / den;
#pragma unroll
            for (int r8 = 0; r8 < 8; ++r8) {
                const unsigned c0 = __builtin_bit_cast(unsigned, f[r8]) & 0xFFu, c1 = __builtin_bit_cast(unsigned, f[r8 + 8]) & 0xFFu;
                const unsigned code = pp ? c1 : c0;
                const float gate = (pp ? ev[r8 + 8] : ev[r8]) * rden;
                const int e = (int)(tk_lookup(P0, code >> 4) * 128u + tk_lookup(P1, code & 15u));
                const int o = (tkl * 128 + h * 16 + pp * 8 + r8) * 3;
                ent[o] = e; ent[o + 1] = __builtin_bit_cast(int, SU[e]); ent[o + 2] = __builtin_bit_cast(int, gate * SV[e]);
            }
        }
#pragma unroll 1
        for (int tk = 0; tk < 8; ++tk) {
            int* et = ent + tk * 384;
            const int eA = et[lane * 3], uA = et[lane * 3 + 1], gA = et[lane * 3 + 2];
            const int eB = et[(64 + lane) * 3], uB = et[(64 + lane) * 3 + 1], gB = et[(64 + lane) * 3 + 2];
            const int rA = eA >> (14 - PE_LOGR), rB = eB >> (14 - PE_LOGR);
            int base = 0;
#pragma unroll 1
            for (int r = 0; r < PE_NR; ++r) {
                const unsigned long long mA = __ballot(rA == r), mB = __ballot(rB == r);
                const int cA = __popcll(mA);
                if (rA == r) { const int q = base + (int)__builtin_amdgcn_mbcnt_hi((unsigned)(mA >> 32), __builtin_amdgcn_mbcnt_lo((unsigned)mA, 0u)); et[q * 3] = eA; et[q * 3 + 1] = uA; et[q * 3 + 2] = gA; }
                if (rB == r) { const int q = base + cA + (int)__builtin_amdgcn_mbcnt_hi((unsigned)(mB >> 32), __builtin_amdgcn_mbcnt_lo((unsigned)mB, 0u)); et[q * 3] = eB; et[q * 3 + 1] = uB; et[q * 3 + 2] = gB; }
                base += cA + __popcll(mB);
            }
        }
        {
            {
                u32x2 xp[8][4];
#pragma unroll
                for (int tk = 0; tk < 8; ++tk) {
                    f32x4 xr[4]; float ss = 0.f;
#pragma unroll
                    for (int j = 0; j < 4; ++j) { xr[j] = *(const f32x4*)(XA + (size_t)(tb + tk) * DM + 4 * lane + 256 * j); ss += xr[j].x * xr[j].x + xr[j].y * xr[j].y + xr[j].z * xr[j].z + xr[j].w * xr[j].w; }
                    ss = wave_sum(ss);
                    const float rn = rsqrtf(ss * (1.0f / DM) + EPS);
#pragma unroll
                    for (int j = 0; j < 4; ++j) { const f32x4 gg = *(const f32x4*)(g2p + 4 * lane + 256 * j);
                        xp[tk][j].x = pk2(xr[j].x * rn * gg.x, xr[j].y * rn * gg.y); xp[tk][j].y = pk2(xr[j].z * rn * gg.z, xr[j].w * rn * gg.w); }
                }
#pragma unroll 1
                for (int r = 0; r < 16; ++r) {
                    __syncthreads();
                    u32x4 rwA[8]; int evA; float cuA, cgA;
                    PE_LOAD_U(0, rwA, evA, cuA, cgA); PE_COMP_U(0, rwA, cuA, cgA);
                    PE_LOAD_U(1, rwA, evA, cuA, cgA); PE_COMP_U(1, rwA, cuA, cgA);
                    PE_LOAD_U(2, rwA, evA, cuA, cgA); PE_COMP_U(2, rwA, cuA, cgA);
                    PE_LOAD_U(3, rwA, evA, cuA, cgA); PE_COMP_U(3, rwA, cuA, cgA);
                    PE_LOAD_U(4, rwA, evA, cuA, cgA); PE_COMP_U(4, rwA, cuA, cgA);
                    PE_LOAD_U(5, rwA, evA, cuA, cgA); PE_COMP_U(5, rwA, cuA, cgA);
                    PE_LOAD_U(6, rwA, evA, cuA, cgA); PE_COMP_U(6, rwA, cuA, cgA);
                    PE_LOAD_U(7, rwA, evA, cuA, cgA); PE_COMP_U(7, rwA, cuA, cgA);
                }
            }
#pragma unroll 1
            for (int hv = 0; hv < 2; ++hv) {
            f32x2 acc[4][8];
#pragma unroll
            for (int tk = 0; tk < 4; ++tk)
#pragma unroll
                for (int j = 0; j < 8; ++j) acc[tk][j] = (f32x2){0.f, 0.f};
            const int* entv = ent;
            {
                int* ent = (int*)entv + hv * 4 * 128 * 3;
#pragma unroll 1
                for (int r = 0; r < 16; ++r) {
                    __syncthreads();
                    u32x4 rwA[8], rwB[8]; int avA, avB;
                    PE_LOAD_V(0, rwA, avA);
                    PE_LOAD_V(1, rwB, avB); PE_COMP_V(0, rwA, avA);
                    PE_LOAD_V(2, rwA, avA); PE_COMP_V(1, rwB, avB);
                    PE_LOAD_V(3, rwB, avB); PE_COMP_V(2, rwA, avA);
                    PE_COMP_V(3, rwB, avB);
                }
            }
#pragma unroll
            for (int tk = 0; tk < 4; ++tk) {
                const int t = tb + hv * 4 + tk;
                f32x4 x[4]; float ss = 0.f;
#pragma unroll
                for (int j = 0; j < 4; ++j) {
                    x[j] = *(const f32x4*)(XA + (size_t)t * DM + 4 * lane + 256 * j);
                    x[j].x += acc[tk][2 * j].x; x[j].y += acc[tk][2 * j].y; x[j].z += acc[tk][2 * j + 1].x; x[j].w += acc[tk][2 * j + 1].y;
                    ss += x[j].x * x[j].x + x[j].y * x[j].y + x[j].z * x[j].z + x[j].w * x[j].w;
                }
                ss = wave_sum(ss);
                const float rr = rsqrtf(ss * (1.0f / DM) + EPS);
                if (last) {
#pragma unroll
                    for (int j = 0; j < 4; ++j) { const f32x4 gg = *(const f32x4*)(gnext + 4 * lane + 256 * j); *(f32x4*)(p.out + (size_t)t * DM + 4 * lane + 256 * j) = x[j] * rr * gg; }
                } else {
#pragma unroll
                    for (int j = 0; j < 4; ++j) {
                        const f32x4 gg = *(const f32x4*)(gnext + 4 * lane + 256 * j);
                        *(f32x4*)((DRY ? p.out : XA) + (size_t)t * DM + 4 * lane + 256 * j) = x[j];
                        u32x2 w; w.x = pk2(x[j].x * rr * gg.x, x[j].y * rr * gg.y); w.y = pk2(x[j].z * rr * gg.z, x[j].w * rr * gg.w);
                        if (!DRY) *(u32x2*)(XN + (size_t)t * DM + 4 * lane + 256 * j) = w;
                    }
                }
            }
            }
        }
    }
}

#define LAS __attribute__((address_space(3)))
#define XB_TMO      128
#define XB_XCNT(j)  (256  + 64 * (j))
#define XB_XSUB(j)  (1280 + 64 * (j))
#define XB_XGEN(j)  (2304 + 64 * (j))
#define XB_TOP      3328
#define XB_TOPGEN   3392
#define XCD_BAR_WORDS 3456
#define XB_SPIN_CAP (1u << 20)
__device__ __forceinline__ unsigned xb_ld(unsigned* p)              { return __hip_atomic_load(p, __ATOMIC_RELAXED, __HIP_MEMORY_SCOPE_AGENT); }
__device__ __forceinline__ unsigned xb_add(unsigned* p, unsigned v) { return __hip_atomic_fetch_add(p, v, __ATOMIC_RELAXED, __HIP_MEMORY_SCOPE_AGENT); }
__device__ __forceinline__ unsigned xb_xcc_id() { return (unsigned)__builtin_amdgcn_s_getreg((3 << 11) | 20) & 0xFu; }
#define XB_SPIN(cond, bar) do { unsigned _sp = 0; while (cond) { __builtin_amdgcn_s_sleep(1); \
    if ((++_sp & 255u) == 0u) { if (xb_ld(&(bar)[XB_TMO])) break; if (_sp > XB_SPIN_CAP) { atomicAdd(&(bar)[XB_TMO], 1u); break; } } } } while (0)
struct XcdBarrier { unsigned* bar; unsigned x; volatile LAS unsigned* st; };
__device__ __forceinline__ XcdBarrier xcd_barrier_post(unsigned* bar, volatile LAS unsigned* st) {
    XcdBarrier b; b.bar = bar; b.x = xb_xcc_id(); b.st = st;
    if (threadIdx.x == 0) (void)xb_add(&bar[XB_XCNT(b.x)], 1u);
    return b;
}
__device__ __forceinline__ void xcd_barrier_complete(unsigned* bar, unsigned x, unsigned& nloc, unsigned& nx) {
    const unsigned G = NBLK;
    unsigned sum, cnt, mine, sp = 0u;
    for (;;) {
        sum = 0u; cnt = 0u; mine = 0u;
#pragma unroll
        for (unsigned j = 0; j < 16; ++j) { const unsigned c = xb_ld(&bar[XB_XCNT(j)]); sum += c; cnt += (c > 0u) ? 1u : 0u; mine = (j == x) ? c : mine; }
        if (sum == G) break;
        __builtin_amdgcn_s_sleep(1);
        if ((++sp & 255u) == 0u) { if (xb_ld(&bar[XB_TMO])) break; if (sp > XB_SPIN_CAP) { atomicAdd(&bar[XB_TMO], 1u); break; } }
    }
    nloc = mine > 0u ? mine : 1u; nx = cnt > 0u ? cnt : 1u;
}
__device__ __forceinline__ void xcd_barrier(const XcdBarrier& b) {
    asm volatile("s_waitcnt vmcnt(0)" ::: "memory");
    __syncthreads();
    if (threadIdx.x == 0) {
        unsigned* bar = b.bar;
        __builtin_amdgcn_s_waitcnt(0);
        unsigned nloc = b.st[0], nx = b.st[1];
        if (nloc == 0u) { xcd_barrier_complete(bar, b.x, nloc, nx); b.st[0] = nloc; b.st[1] = nx; }
        const unsigned old = xb_add(&bar[XB_XSUB(b.x)], 1u);
        const unsigned gen = old / nloc;
        if (old + 1u == (gen + 1u) * nloc) {
            __builtin_amdgcn_fence(__ATOMIC_RELEASE, "agent");
            asm volatile("s_waitcnt vmcnt(0)" ::: "memory");
            const unsigned og = xb_add(&bar[XB_TOP], 1u);
            const unsigned tg = og / nx;
            if (og + 1u == (tg + 1u) * nx) xb_add(&bar[XB_TOPGEN], 1u);
            else XB_SPIN(xb_ld(&bar[XB_TOPGEN]) == tg, bar);
            __builtin_amdgcn_fence(__ATOMIC_ACQUIRE, "agent");
            xb_add(&bar[XB_XGEN(b.x)], 1u);
            asm volatile("s_waitcnt vmcnt(0)" ::: "memory");
        } else {
            XB_SPIN(xb_ld(&bar[XB_XGEN(b.x)]) == gen, bar);
            __builtin_amdgcn_fence(__ATOMIC_ACQUIRE, "agent");
            asm volatile("s_waitcnt vmcnt(0)" ::: "memory");
        }
    }
    __syncthreads();
}


template <class Epi> __device__ __forceinline__ void big_gemm(const bf16_t* A, const bf16_t* Bt, int M, int N, int K, char* lds, const Epi& e) {
    pg8::Gemm g{A, Bt, M, N, K}; pg8::StaticOrder S; S.init(M, N, NBLK, obid());
    pg8::gemm_phase<Epi, pg8::StaticOrder, true, true>((PG8_LAS unsigned char*)lds, g, S, e);
}

#define GSYNC() xcd_barrier(xbar)
template <int layer> __device__ __forceinline__ void run_layer(const Params& p, char* lds, const XcdBarrier& xbar) {
    float* XA = (float*)(p.ws + OFF_XA);

        const float* xin = layer == 0 ? p.in[I_X] : XA;
        {
            const bf16_t* wt = (const bf16_t*)(p.ws + OFF_WTIN) + (size_t)layer * INC * DM;
            pg8::EpiStoreBf16 e1{(bf16_t*)(p.ws + R_QKV), 768};
            big_gemm((const bf16_t*)(p.ws + R_XN), wt, T, 768, DM, lds, e1);
            pg8::EpiStoreF32 e2{nullptr, (float*)(p.ws + R_HF), T};
            big_gemm(wt + (size_t)768 * DM, (const bf16_t*)(p.ws + R_XN), 1024, T, DM, lds, e2);
        }
        if (layer == 0) {
#pragma nounroll
            for (int fl = 0; fl < NLAYER; ++fl) {
                EpiF32 e{(float*)(p.ws + (fl ? OFF_HFILT1 : OFF_HFILT0)), SL};
                gemm_simple((const bf16_t*)(p.ws + OFF_W3T) + (size_t)fl * 1024 * 64, (const bf16_t*)(p.ws + OFF_H2) + (size_t)fl * SL * 64, 1024, SL, 64, lds, e);
            }
        }
        GSYNC();
        if (layer == 0) {
            phase_filter_spectra(p, lds);
        }
        phase_qkprep(p, layer, lds, (bf16_t*)(p.ws + R_QKV)); GSYNC();
        {
            phase_attn(p, lds);
            for (int c = obid(); c < 256; c += NBLK) hyena_job(p, layer, c, lds);
            for (int c = obid(); c < 256; c += NBLK) fnet_job(p, c, lds);
        } GSYNC();
        phase_mix(p, layer, lds); GSYNC();
        { pg8::EpiOutProj e{xin, XA, (bf16_t*)(p.ws + R_XN), (float*)(p.ws + OFF_RS)};
          big_gemm((const bf16_t*)(p.ws + R_MIX), (const bf16_t*)(p.ws + OFF_WTOUT) + (size_t)layer * DM * DM, T, DM, DM, lds, e); } GSYNC();
        { pg8::EpiRowScaleF16 e{(_Float16*)(p.ws + R_QP), 2048, (const float*)(p.ws + OFF_RS)};
          big_gemm((const bf16_t*)(p.ws + R_XN), (const bf16_t*)(p.ws + OFF_WTQ) + (size_t)layer * 2048 * DM, T, 2048, DM, lds, e); } GSYNC();
        phase_peer_fused<false>(p, layer, lds);
        if (layer + 1 < NLAYER) GSYNC();
}

__global__ void __launch_bounds__(NTHR) mega_kernel(Params p) {
    extern __shared__ __attribute__((aligned(16))) char lds[];
    volatile LAS unsigned* misc = (volatile LAS unsigned*)((LAS char*)lds + LDS_MISC);
    if (threadIdx.x < 16) misc[threadIdx.x] = 0u;
    __syncthreads();
    const XcdBarrier xbar = xcd_barrier_post((unsigned*)(p.ws + OFF_CTL) + 4096, misc);
    float* XA = (float*)(p.ws + OFF_XA);
    phase_p0(p, lds);
    phase_rmsnorm_bf16(p.in[I_X], p.in[I_N1G], (bf16_t*)(p.ws + R_XN));
    GSYNC();
    run_layer<0>(p, lds, xbar);
    run_layer<1>(p, lds, xbar);
}

extern "C" void kernel_launch(void* const* d_in, const int* in_sizes, int n_in, void* d_out, int out_size, void* d_ws, size_t ws_size, hipStream_t stream) {
    static int grid = 0;
    if (grid == 0) {
        if (n_in != 25 || out_size != T * DM || ws_size < WS_NEED) { fprintf(stderr, "kernel_launch: unexpected sizes n_in %d out %d ws %zu (need %zu)\n", n_in, out_size, ws_size, (size_t)WS_NEED); grid = -1; return; }
        int dev = 0, cus = 0, per_cu = 0;
        if (hipGetDevice(&dev) != hipSuccess || hipDeviceGetAttribute(&cus, hipDeviceAttributeMultiprocessorCount, dev) != hipSuccess) { grid = -1; return; }
        if (hipFuncSetAttribute((const void*)mega_kernel, hipFuncAttributeMaxDynamicSharedMemorySize, LDS_BYTES) != hipSuccess) { fprintf(stderr, "kernel_launch: hipFuncSetAttribute failed\n"); grid = -1; return; }
        if (hipOccupancyMaxActiveBlocksPerMultiprocessor(&per_cu, (const void*)mega_kernel, NTHR, LDS_BYTES) != hipSuccess || per_cu < 1) { fprintf(stderr, "kernel_launch: occupancy query says %d blocks per CU\n", per_cu); grid = -1; return; }
        (void)hipGetLastError();
        if (cus < NBLK) { fprintf(stderr, "kernel_launch: built for a %d-CU device, found %d CUs\n", NBLK, cus); grid = -1; return; }
        grid = NBLK;
    }
    if (grid < 0) return;
    Params p{};
    for (int i = 0; i < 25; ++i) p.in[i] = (const float*)d_in[i];
    p.out = (float*)d_out; p.ws = (unsigned char*)d_ws;
    if (hipMemsetAsync((char*)d_ws + OFF_CTL, 0, 64 * 1024, stream) != hipSuccess) { fprintf(stderr, "kernel_launch: memset failed\n"); return; }
    void* args[] = {&p};
    hipError_t e = hipLaunchCooperativeKernel((const void*)mega_kernel, dim3(grid), dim3(NTHR), args, LDS_BYTES, stream);
    if (e != hipSuccess) fprintf(stderr, "cooperative launch failed: %s (grid %d)\n", hipGetErrorString(e), grid);
}
```

```cpp
#include <hip/hip_runtime.h>
#include <cstdio>
#include <cstdint>

typedef unsigned short bf16_t;
typedef short bf16x8 __attribute__((ext_vector_type(8)));
typedef float f32x16 __attribute__((ext_vector_type(16)));
typedef float f32x4 __attribute__((ext_vector_type(4)));
typedef unsigned u32x4 __attribute__((ext_vector_type(4)));
typedef unsigned u32x2 __attribute__((ext_vector_type(2)));
typedef _Float16 f16x4 __attribute__((ext_vector_type(4)));
typedef _Float16 f16x8 __attribute__((ext_vector_type(8)));

constexpr int DM = 1024, NB = 2, SL = 8192, T = NB * SL, NLAYER = 2;
constexpr int INC = 1792;
constexpr int NTHR = 512, NWAVE = 8;
constexpr int NBLK = 256;
constexpr int LDS_BYTES = 147456;
constexpr int LDS_MISC = LDS_BYTES - 64;
constexpr float EPS = 1e-6f;

constexpr size_t MiB = 1u << 20;
constexpr size_t OFF_CTL = 0;
constexpr size_t OFF_WTIN = 1 * MiB;
constexpr size_t OFF_WTOUT = 8 * MiB;
constexpr size_t OFF_WTQ = 12 * MiB;
constexpr size_t OFF_PU = 20 * MiB;
constexpr size_t OFF_PV = 84 * MiB;
constexpr size_t OFF_RS = 505 * MiB;
constexpr size_t OFF_PSC = 512 * 1024;
constexpr size_t OFF_H2 = 148 * MiB;
constexpr size_t OFF_W3T = 150 * MiB;
constexpr size_t OFF_HFILT0 = 52 * MiB, OFF_HFILT1 = 116 * MiB;
constexpr size_t OFF_FM = 152 * MiB;
constexpr size_t OFF_KF = 153 * MiB;
constexpr size_t OFF_XA = 281 * MiB;
constexpr size_t OFF_R = 345 * MiB;
constexpr size_t R_XN = OFF_R + 0 * MiB;
constexpr size_t R_UR = OFF_R + 0 * MiB;
constexpr size_t R_UI = OFF_R + 16 * MiB;
constexpr size_t R_QKV = OFF_R + 32 * MiB;
constexpr size_t R_HF = OFF_R + 60 * MiB;
constexpr size_t R_MIX = OFF_R + 60 * MiB;
constexpr size_t R_ATT = OFF_R + 124 * MiB;
constexpr size_t R_Y = OFF_R + 140 * MiB;
constexpr size_t R_QP = OFF_R + 32 * MiB;
constexpr size_t WS_NEED = 506 * MiB;

struct Params {
    const float* in[25];
    float* out;
    unsigned char* ws;
};
enum { I_X = 0, I_N1G, I_WIN, I_QG, I_KG, I_CW, I_CB, I_W1, I_B1, I_F1, I_W2, I_B2, I_F2, I_W3, I_HB, I_FW, I_FB, I_MG, I_WOUT, I_N2G, I_WQ, I_SK, I_PU, I_PV, I_FG };

__device__ __forceinline__ unsigned f2bf(float f) { unsigned u = __builtin_bit_cast(unsigned, f); return (u + 0x7fffu + ((u >> 16) & 1u)) >> 16; }
__device__ __forceinline__ unsigned pk2(float lo, float hi) { return f2bf(lo) | (f2bf(hi) << 16); }
__device__ __forceinline__ float bflo(unsigned w) { return __builtin_bit_cast(float, w << 16); }
__device__ __forceinline__ float bfhi(unsigned w) { return __builtin_bit_cast(float, w & 0xffff0000u); }
__device__ __forceinline__ float wave_sum(float v) {
#pragma unroll
    for (int o = 1; o < 64; o <<= 1) v += __shfl_xor(v, o);
    return v;
}
__device__ __forceinline__ float wave_max(float v) {
#pragma unroll
    for (int o = 1; o < 64; o <<= 1) v = fmaxf(v, __shfl_xor(v, o));
    return v;
}
__device__ __forceinline__ f32x16 mfma32(bf16x8 a, bf16x8 b, f32x16 c) { return __builtin_amdgcn_mfma_f32_32x32x16_bf16(a, b, c, 0, 0, 0); }
__device__ __forceinline__ f32x16 zero16() { return (f32x16){0.f,0.f,0.f,0.f,0.f,0.f,0.f,0.f,0.f,0.f,0.f,0.f,0.f,0.f,0.f,0.f}; }


__device__ __forceinline__ int otid() { int t = threadIdx.x; asm volatile("" : "+v"(t)); return t; }
__device__ __forceinline__ int obid() { int b = blockIdx.x; asm volatile("" : "+s"(b)); return b; }
__device__ __forceinline__ void transpose_one(const float* W, int K, int N, bf16_t* Wt, float* tile, int item) {
    const int tid = otid();
    const int nblk = N / 64, kb = item / nblk, nb = item % nblk, k0 = kb * 64, n0 = nb * 64;
    __syncthreads();
    {
        const int r = tid >> 6, c = tid & 63;
#pragma unroll
        for (int i = 0; i < 8; ++i) { const int k = r + 8 * i; tile[k * 65 + c] = W[(size_t)(k0 + k) * N + n0 + c]; }
    }
    __syncthreads();
    {
        const int nn = tid >> 3, kc = tid & 7;
        const float* s = tile + (kc * 8) * 65 + nn;
        u32x4 o; o.x = pk2(s[0], s[65]); o.y = pk2(s[2 * 65], s[3 * 65]); o.z = pk2(s[4 * 65], s[5 * 65]); o.w = pk2(s[6 * 65], s[7 * 65]);
        *(u32x4*)(Wt + (size_t)(n0 + nn) * K + k0 + kc * 8) = o;
    }
}

template <int PARTS = 31> __device__ __forceinline__ void phase_p0(const Params& p, char* lds) {
    const int tid = otid();
    float* tile = (float*)lds;
    if (PARTS & 1) {
    constexpr int IT_IN = (DM / 64) * (INC / 64), IT_OUT = (DM / 64) * (DM / 64), IT_W3 = 1024 / 64;
    constexpr int IT_L = IT_IN + IT_OUT + IT_W3;
    for (int it = obid(); it < NLAYER * IT_L; it += NBLK) {
        const int layer = it / IT_L; int r = it % IT_L;
        if (r < IT_IN) { transpose_one(p.in[I_WIN] + (size_t)layer * DM * INC, DM, INC, (bf16_t*)(p.ws + OFF_WTIN) + (size_t)layer * INC * DM, tile, r); continue; }
        r -= IT_IN;
        if (r < IT_OUT) { transpose_one(p.in[I_WOUT] + (size_t)layer * DM * DM, DM, DM, (bf16_t*)(p.ws + OFF_WTOUT) + (size_t)layer * DM * DM, tile, r); continue; }
        r -= IT_OUT;
        transpose_one(p.in[I_W3] + (size_t)layer * 64 * 1024, 64, 1024, (bf16_t*)(p.ws + OFF_W3T) + (size_t)layer * 1024 * 64, tile, r);
    }
    }
    __syncthreads();
    if (PARTS & 2) {
        float* SKl = (float*)lds;
        float* Wl = SKl + 128 * 129;
        const int lane = tid & 63, wave = tid >> 6, l31 = lane & 31, hl = lane >> 5, mt = wave & 3, nt = wave >> 2;
        for (int it = obid(); it < NLAYER * 16 * 16; it += NBLK) {
            const int layer = it >> 8, hp = (it >> 4) & 15, kc = it & 15, h = hp >> 1, pp = hp & 1, k0 = kc * 64;
            const float* sk = p.in[I_SK] + (((size_t)(layer * 2 + pp) * 8 + h) * 128) * 128;
            const float* wq = p.in[I_WQ] + (size_t)layer * DM * 2048 + (size_t)k0 * 2048 + h * 256 + pp * 128;
            __syncthreads();
            for (int i = tid; i < 128 * 128; i += NTHR) SKl[(i >> 7) * 129 + (i & 127)] = sk[i];
            for (int i = tid; i < 64 * 128; i += NTHR) Wl[(i >> 7) * 129 + (i & 127)] = wq[(size_t)(i >> 7) * 2048 + (i & 127)];
            __syncthreads();
            f32x16 acc = zero16();
            const float* ap = SKl + (32 * mt + l31) * 129 + hl;
            const float* bp = Wl + (32 * nt + l31) * 129 + hl;
#pragma unroll 16
            for (int kk = 0; kk < 64; ++kk) acc = __builtin_amdgcn_mfma_f32_32x32x2f32(ap[2 * kk], bp[2 * kk], acc, 0, 0, 0);
            const float g2 = p.in[I_N2G][layer * DM + k0 + 32 * nt + l31];
            bf16_t* dst = (bf16_t*)(p.ws + OFF_WTQ) + (size_t)layer * 2048 * DM + (size_t)(hp * 128 + 32 * mt + 4 * hl) * DM + k0 + 32 * nt + l31;
#pragma unroll
            for (int r = 0; r < 16; ++r) dst[(size_t)((r & 3) + 8 * (r >> 2)) * DM] = (bf16_t)f2bf(acc[r] * g2);
        }
        __syncthreads();
    }
    if (PARTS & 4) {
        const int lane = tid & 63, wave = tid >> 6;
        float* scl = (float*)(p.ws + OFF_PSC);
        for (int row = obid() * NWAVE + wave; row < 2 * NLAYER * 16384; row += NBLK * NWAVE) {
            const int tb = row >> 15, r = row & 32767;
            const f32x4* src = (const f32x4*)(p.in[tb ? I_PV : I_PU] + (size_t)r * DM) + lane;
            f32x4 v[4]; float mx = 0.f;
#pragma unroll
            for (int j = 0; j < 4; ++j) { v[j] = __builtin_nontemporal_load(src + 64 * j); mx = fmaxf(mx, fmaxf(fmaxf(fabsf(v[j].x), fabsf(v[j].y)), fmaxf(fabsf(v[j].z), fabsf(v[j].w)))); }
            mx = wave_max(mx);
            const float sc = mx > 0.f ? 224.0f / mx : 1.0f;
            u32x4 o;
            { int w = 0; w = __builtin_amdgcn_cvt_pk_fp8_f32(v[0].x * sc, v[0].y * sc, w, false); w = __builtin_amdgcn_cvt_pk_fp8_f32(v[0].z * sc, v[0].w * sc, w, true); o.x = (unsigned)w; }
            { int w = 0; w = __builtin_amdgcn_cvt_pk_fp8_f32(v[1].x * sc, v[1].y * sc, w, false); w = __builtin_amdgcn_cvt_pk_fp8_f32(v[1].z * sc, v[1].w * sc, w, true); o.y = (unsigned)w; }
            { int w = 0; w = __builtin_amdgcn_cvt_pk_fp8_f32(v[2].x * sc, v[2].y * sc, w, false); w = __builtin_amdgcn_cvt_pk_fp8_f32(v[2].z * sc, v[2].w * sc, w, true); o.z = (unsigned)w; }
            { int w = 0; w = __builtin_amdgcn_cvt_pk_fp8_f32(v[3].x * sc, v[3].y * sc, w, false); w = __builtin_amdgcn_cvt_pk_fp8_f32(v[3].z * sc, v[3].w * sc, w, true); o.w = (unsigned)w; }
            *(u32x4*)(p.ws + (tb ? OFF_PV : OFF_PU) + (size_t)r * DM + lane * 16) = o;
            if (lane == 0) scl[row] = mx > 0.f ? mx / 224.0f : 1.0f;
        }
    }
    if (PARTS & 8) {
        float* sh = (float*)lds;
        float* zl = sh + 64 * 64;
        const int sub = tid >> 6, j = tid & 63;
        for (int it0 = obid() * 64; it0 < NLAYER * SL; it0 += NBLK * 64) {
            const int layer = it0 / SL;
            __syncthreads();
            for (int o = tid; o < 64 * 17; o += NTHR) {
                const int item = o / 17, f = o % 17;
                const float t = (float)((it0 + item) % SL) / (float)(SL - 1);
                float z;
                if (f == 0) z = t;
                else if (f <= 8) z = sinf(2.0f * 3.14159265358979323846f * t * (float)f);
                else z = cosf(2.0f * 3.14159265358979323846f * t * (float)(f - 8));
                zl[o] = z;
            }
            __syncthreads();
            {
                const float* w1 = p.in[I_W1] + layer * 17 * 64;
                float wv[17];
#pragma unroll
                for (int i = 0; i < 17; ++i) wv[i] = w1[i * 64 + j];
                const float b1 = p.in[I_B1][layer * 64 + j], f1 = p.in[I_F1][layer * 64 + j];
#pragma unroll
                for (int r = 0; r < 8; ++r) {
                    const int item = sub * 8 + r;
                    float a = b1;
#pragma unroll
                    for (int i = 0; i < 17; ++i) a += zl[item * 17 + i] * wv[i];
                    sh[item * 64 + j] = sinf(f1 * a);
                }
            }
            __syncthreads();
            {
                const float* w2 = p.in[I_W2] + layer * 64 * 64;
                const float b2 = p.in[I_B2][layer * 64 + j], f2 = p.in[I_F2][layer * 64 + j];
                float acc[8];
#pragma unroll
                for (int r = 0; r < 8; ++r) acc[r] = b2;
#pragma unroll 8
                for (int k = 0; k < 64; ++k) {
                    const float w = w2[k * 64 + j];
#pragma unroll
                    for (int r = 0; r < 8; ++r) acc[r] += sh[(sub * 8 + r) * 64 + k] * w;
                }
#pragma unroll
                for (int r = 0; r < 8; ++r)
                    ((bf16_t*)(p.ws + OFF_H2))[((size_t)(it0 + sub * 8 + r)) * 64 + j] = (bf16_t)f2bf(sinf(f2 * acc[r]));
            }
        }
        __syncthreads();
    }
    if (PARTS & 16) {
        float* ctab = (float*)lds;
        __syncthreads();
        if (tid < 64) ctab[tid] = cosf((float)tid * (2.0f * 3.14159265358979323846f / 64.0f));
        __syncthreads();
        const int total = NLAYER * 4 * 128 * 64;
        for (int o = obid() * NTHR + tid; o < total; o += NBLK * NTHR) {
            const int e2 = o & 63, dd = (o >> 6) & 127, g = (o >> 13) & 3, layer = o >> 15;
            const int d = dd & 63, sh = (dd < 64) ? 0 : 48;
            const float* w = p.in[I_FW] + ((size_t)(layer * 4 + g) * 64) * 64;
            float acc = 0.f;
#pragma unroll 8
            for (int e = 0; e < 64; ++e) acc += ctab[(d * e + sh) & 63] * w[e * 64 + e2];
            ((float*)(p.ws + OFF_FM))[o] = acc * (1.0f / 724.0773439350246f);
        }
        __syncthreads();
    }
}

__device__ __forceinline__ int zp(int i) { return i + 2 * (i >> 5); }
__device__ constexpr float FC32[16] = {1.000000000f, 0.980785280f, 0.923879533f, 0.831469612f, 0.707106781f, 0.555570233f, 0.382683432f, 0.195090322f, 0.000000000f, -0.195090322f, -0.382683432f, -0.555570233f, -0.707106781f, -0.831469612f, -0.923879533f, -0.980785280f};
__device__ constexpr float FS32[16] = {0.000000000f, 0.195090322f, 0.382683432f, 0.555570233f, 0.707106781f, 0.831469612f, 0.923879533f, 0.980785280f, 1.000000000f, 0.980785280f, 0.923879533f, 0.831469612f, 0.707106781f, 0.555570233f, 0.382683432f, 0.195090322f};
__device__ __forceinline__ float2 cmulf(float2 a, float2 b) { return make_float2(a.x * b.x - a.y * b.y, a.x * b.y + a.y * b.x); }
template <int R> __device__ __forceinline__ constexpr int brevR(int x) { int r = 0; for (int b = 1, t = R >> 1; t >= 1; b <<= 1, t >>= 1) if (x & b) r |= t; return r; }
template <int R> __device__ __forceinline__ void dft_fwd_regs(float2 (&x)[R]) {
#pragma unroll
    for (int half = R / 2; half >= 1; half >>= 1) {
#pragma unroll
        for (int blk = 0; blk < R; blk += 2 * half)
#pragma unroll
            for (int k = 0; k < half; ++k) {
                const float2 a = x[blk + k], b = x[blk + k + half];
                x[blk + k] = make_float2(a.x + b.x, a.y + b.y);
                const float2 d = make_float2(a.x - b.x, a.y - b.y);
                const int ti = k * (16 / half);
                if (ti == 0) x[blk + k + half] = d;
                else if (ti == 8) x[blk + k + half] = make_float2(d.y, -d.x);
                else { const float c = FC32[ti], sn = FS32[ti]; x[blk + k + half] = make_float2(d.x * c + d.y * sn, d.y * c - d.x * sn); }
            }
    }
}
template <int R> __device__ __forceinline__ void dft_inv_regs(float2 (&x)[R]) {
#pragma unroll
    for (int half = 1; half <= R / 2; half <<= 1) {
#pragma unroll
        for (int blk = 0; blk < R; blk += 2 * half)
#pragma unroll
            for (int k = 0; k < half; ++k) {
                const float2 a = x[blk + k], b0 = x[blk + k + half];
                const int ti = k * (16 / half);
                float2 b;
                if (ti == 0) b = b0;
                else if (ti == 8) b = make_float2(-b0.y, b0.x);
                else { const float c = FC32[ti], sn = FS32[ti]; b = make_float2(b0.x * c - b0.y * sn, b0.y * c + b0.x * sn); }
                x[blk + k] = make_float2(a.x + b.x, a.y + b.y);
                x[blk + k + half] = make_float2(a.x - b.x, a.y - b.y);
            }
    }
}
template <int R> __device__ __forceinline__ void apply_tw(float2 (&x)[R], float c, float sg) {
    const float2 w1 = make_float2(c, sg), w2 = cmulf(w1, w1);
    float2 po = w1, pe = w2;
#pragma unroll
    for (int m = 1; m < R; m += 2) {
        x[brevR<R>(m)] = cmulf(x[brevR<R>(m)], po);
        if (m + 1 < R) x[brevR<R>(m + 1)] = cmulf(x[brevR<R>(m + 1)], pe);
        if (m + 2 < R) { po = cmulf(po, w2); pe = cmulf(pe, w2); }
    }
}
template <int R, bool INV> __device__ __forceinline__ void fft_group(float2* Z, int pbase, int PS, float ang) {
    float2 x[R];
    if (!INV) {
#pragma unroll
        for (int m = 0; m < R; ++m) x[m] = Z[pbase + PS * m];
        dft_fwd_regs<R>(x);
        apply_tw<R>(x, __builtin_amdgcn_cosf(ang), -__builtin_amdgcn_sinf(ang));
#pragma unroll
        for (int m = 0; m < R; ++m) Z[pbase + PS * m] = x[brevR<R>(m)];
    } else {
#pragma unroll
        for (int m = 0; m < R; ++m) x[brevR<R>(m)] = Z[pbase + PS * m];
        apply_tw<R>(x, __builtin_amdgcn_cosf(ang), __builtin_amdgcn_sinf(ang));
        dft_inv_regs<R>(x);
#pragma unroll
        for (int m = 0; m < R; ++m) Z[pbase + PS * m] = x[m];
    }
}
template <bool INV> __device__ __forceinline__ void fft_group32_contig(float2* Z, int pbase) {
    float2 x[32];
    if (!INV) {
#pragma unroll
        for (int m = 0; m < 32; m += 2) { const f32x4 v = *(const f32x4*)(Z + pbase + m); x[m] = make_float2(v.x, v.y); x[m + 1] = make_float2(v.z, v.w); }
        dft_fwd_regs<32>(x);
#pragma unroll
        for (int m = 0; m < 32; m += 2) { const float2 a = x[brevR<32>(m)], b = x[brevR<32>(m + 1)]; *(f32x4*)(Z + pbase + m) = (f32x4){a.x, a.y, b.x, b.y}; }
    } else {
#pragma unroll
        for (int m = 0; m < 32; m += 2) { const f32x4 v = *(const f32x4*)(Z + pbase + m); x[brevR<32>(m)] = make_float2(v.x, v.y); x[brevR<32>(m + 1)] = make_float2(v.z, v.w); }
        dft_inv_regs<32>(x);
#pragma unroll
        for (int m = 0; m < 32; m += 2) *(f32x4*)(Z + pbase + m) = (f32x4){x[m].x, x[m].y, x[m + 1].x, x[m + 1].y};
    }
}
__device__ __forceinline__ void fft16k_fwd(float2* Z) {
    const int tid = otid();
#pragma unroll 1
    for (int g = 0; g < 2; ++g) { const int j = tid + 512 * g; fft_group<16, false>(Z, zp(j), 1088, (float)j * (1.0f / 16384.0f)); }
    __syncthreads();
    { const int blk = tid >> 5, j = tid & 31; fft_group<32, false>(Z, blk * 1088 + j, 34, (float)j * (1.0f / 1024.0f)); }
    __syncthreads();
    fft_group32_contig<false>(Z, 34 * tid);
    __syncthreads();
}
__device__ __forceinline__ void fft16k_inv(float2* Z) {
    const int tid = otid();
    fft_group32_contig<true>(Z, 34 * tid);
    __syncthreads();
    { const int blk = tid >> 5, j = tid & 31; fft_group<32, true>(Z, blk * 1088 + j, 34, (float)j * (1.0f / 1024.0f)); }
    __syncthreads();
#pragma unroll 1
    for (int g = 0; g < 2; ++g) { const int j = tid + 512 * g; fft_group<16, true>(Z, zp(j), 1088, (float)j * (1.0f / 16384.0f)); }
    __syncthreads();
}
__device__ __forceinline__ void fft8k_fwd(float2* Z) {
    const int tid = otid();
    fft_group<16, false>(Z, zp(tid), 544, (float)tid * (1.0f / 8192.0f));
    __syncthreads();
    { const int blk = tid >> 5, j = tid & 31; fft_group<16, false>(Z, blk * 544 + j, 34, (float)j * (1.0f / 512.0f)); }
    __syncthreads();
    if (tid < 256) fft_group32_contig<false>(Z, 34 * tid);
    __syncthreads();
}
__device__ __forceinline__ int f16k_of_p(int p) { return (p >> 10) + 16 * ((p >> 5) & 31) + 512 * (p & 31); }
__device__ __forceinline__ int p16k_of_f(int f) { return 1024 * (f & 15) + 32 * ((f >> 4) & 31) + (f >> 9); }
__device__ __forceinline__ int p8k_of_f(int f) { return 512 * (f & 15) + 32 * ((f >> 4) & 15) + (f >> 8); }

__device__ __forceinline__ void phase_filter_spectra(const Params& p, char* lds) {
    const int tid = otid(), lane = tid & 63, wave = tid >> 6;
    float2* Z = (float2*)lds;
    float* red = (float*)(lds + 139264 + 64);
    for (int job = obid(); job < NLAYER * 256; job += NBLK) {
        const int layer = job >> 8, c = job & 255;
        __syncthreads();
        const float* HFc = (const float*)(p.ws + (layer ? OFF_HFILT1 : OFF_HFILT0)) + (size_t)c * SL;
        const float r_lo = 4.605170185988092f / 1.5f, r_hi = 4.605170185988092f / 0.3f;
        const float rate = r_lo + (r_hi - r_lo) * ((float)c / 255.0f);
        float ss0 = 0.f, ss1 = 0.f;
#pragma unroll 1
        for (int i = 0; i < 4; ++i) {
            const int l0 = 4 * tid + 2048 * i;
            const f32x4 a0 = *(const f32x4*)(HFc + l0), a1 = *(const f32x4*)(HFc + (size_t)256 * SL + l0);
            const f32x4 a2 = *(const f32x4*)(HFc + (size_t)512 * SL + l0), a3 = *(const f32x4*)(HFc + (size_t)768 * SL + l0);
#pragma unroll
            for (int e = 0; e < 4; ++e) {
                const int l = l0 + e;
                const float t = (float)l / (float)(SL - 1);
                const float dec = expf(-t * rate);
                const float f0 = a0[e] * dec, b0 = a1[e] * dec, f1 = a2[e] * dec, b1 = a3[e] * dec;
                ss0 += f0 * f0 + b0 * b0; ss1 += f1 * f1 + b1 * b1;
                Z[zp(l)] = make_float2(f0, f1);
                if (l >= 1) Z[zp(16384 - l)] = make_float2(b0, b1);
            }
        }
        if (tid == 0) Z[zp(8192)] = make_float2(0.f, 0.f);
        ss0 = wave_sum(ss0); ss1 = wave_sum(ss1);
        if (lane == 0) { red[wave * 2] = ss0; red[wave * 2 + 1] = ss1; }
        __syncthreads();
        float t0 = 0.f, t1 = 0.f;
#pragma unroll
        for (int w = 0; w < 8; ++w) { t0 += red[w * 2]; t1 += red[w * 2 + 1]; }
        const float sc0 = rsqrtf(t0 + EPS) * (1.0f / 16384.0f) * 0.5f, sc1 = rsqrtf(t1 + EPS) * (1.0f / 16384.0f) * 0.5f;
        const float hb0 = p.in[I_HB][(layer * 2 + 0) * 256 + c] * (1.0f / 16384.0f), hb1 = p.in[I_HB][(layer * 2 + 1) * 256 + c] * (1.0f / 16384.0f);
        fft16k_fwd(Z);
        float2* KF0 = (float2*)(p.ws + OFF_KF) + ((size_t)(layer * 256 + c) * 2) * 16384;
        float2* KF1 = KF0 + 16384;
        for (int i = 0; i < 32; ++i) {
            const int pp = tid + NTHR * i;
            const int fq = f16k_of_p(pp);
            const int pq = p16k_of_f((16384 - fq) & 16383);
            const float2 za = Z[zp(pp)], zq = Z[zp(pq)];
            KF0[pp] = make_float2((za.x + zq.x) * sc0 + hb0, (za.y - zq.y) * sc0);
            KF1[pp] = make_float2((za.y + zq.y) * sc1 + hb1, (zq.x - za.x) * sc1);
        }
    }
}

__device__ __forceinline__ void phase_rmsnorm_bf16(const float* x, const float* g, bf16_t* out) {
    const int lane = otid() & 63, wave = otid() >> 6;
    const int gw = obid() * NWAVE + wave, ngw = NBLK * NWAVE;
    for (int row = gw; row < T; row += ngw) {
        const f32x4* xr = (const f32x4*)(x + (size_t)row * DM) + lane;
        f32x4 v[4]; float ss = 0.f;
#pragma unroll
        for (int j = 0; j < 4; ++j) { v[j] = xr[64 * j]; ss += v[j].x * v[j].x + v[j].y * v[j].y + v[j].z * v[j].z + v[j].w * v[j].w; }
        ss = wave_sum(ss);
        const float r = rsqrtf(ss * (1.0f / DM) + EPS);
        u32x2* o = (u32x2*)(out + (size_t)row * DM) + lane;
#pragma unroll
        for (int j = 0; j < 4; ++j) {
            const f32x4 gg = ((const f32x4*)g)[lane + 64 * j];
            u32x2 w; w.x = pk2(v[j].x * r * gg.x, v[j].y * r * gg.y); w.y = pk2(v[j].z * r * gg.z, v[j].w * r * gg.w);
            o[64 * j] = w;
        }
    }
}

constexpr int G_LDA = 144;
template <class Epi>
__device__ __forceinline__ void gemm_simple(const bf16_t* A, const bf16_t* Bt, int M, int N, int K, char* lds, const Epi& epi) {
    const int tid = otid(), lane = tid & 63, wave = tid >> 6;
    const int wm = wave >> 1, wn = wave & 1;
    const int nMt = M / 256, nNt = N / 128, total = nMt * nNt, nk = K / 64;
    char* As = lds; char* Bs = lds + 256 * G_LDA;
    const int l31 = lane & 31, hl = lane >> 5;
    for (int u = obid(); u < total; u += NBLK) {
        const int mt = u % nMt, nt = u / nMt;
        f32x16 acc[2][2];
#pragma unroll
        for (int i = 0; i < 2; ++i)
#pragma unroll
            for (int j = 0; j < 2; ++j) acc[i][j] = zero16();
        u32x4 ra[4], rb[2];
        const bf16_t* Ab = A + (size_t)(mt * 256) * K;
        const bf16_t* Bb = Bt + (size_t)(nt * 128) * K;
#pragma unroll
        for (int i = 0; i < 4; ++i) { const int id = tid + NTHR * i, row = id >> 3, ch = id & 7; ra[i] = *(const u32x4*)(Ab + (size_t)row * K + ch * 8); }
#pragma unroll
        for (int i = 0; i < 2; ++i) { const int id = tid + NTHR * i, row = id >> 3, ch = id & 7; rb[i] = *(const u32x4*)(Bb + (size_t)row * K + ch * 8); }
        for (int kt = 0; kt < nk; ++kt) {
            __syncthreads();
#pragma unroll
            for (int i = 0; i < 4; ++i) { const int id = tid + NTHR * i, row = id >> 3, ch = id & 7; *(u32x4*)(As + row * G_LDA + ch * 16) = ra[i]; }
#pragma unroll
            for (int i = 0; i < 2; ++i) { const int id = tid + NTHR * i, row = id >> 3, ch = id & 7; *(u32x4*)(Bs + row * G_LDA + ch * 16) = rb[i]; }
            __syncthreads();
            if (kt + 1 < nk) {
                const int ko = (kt + 1) * 64;
#pragma unroll
                for (int i = 0; i < 4; ++i) { const int id = tid + NTHR * i, row = id >> 3, ch = id & 7; ra[i] = *(const u32x4*)(Ab + (size_t)row * K + ko + ch * 8); }
#pragma unroll
                for (int i = 0; i < 2; ++i) { const int id = tid + NTHR * i, row = id >> 3, ch = id & 7; rb[i] = *(const u32x4*)(Bb + (size_t)row * K + ko + ch * 8); }
            }
#pragma unroll
            for (int ks = 0; ks < 4; ++ks) {
                bf16x8 a[2], b[2];
#pragma unroll
                for (int i = 0; i < 2; ++i) a[i] = *(const bf16x8*)(As + (wm * 64 + i * 32 + l31) * G_LDA + ks * 32 + hl * 16);
#pragma unroll
                for (int j = 0; j < 2; ++j) b[j] = *(const bf16x8*)(Bs + (wn * 64 + j * 32 + l31) * G_LDA + ks * 32 + hl * 16);
#pragma unroll
                for (int i = 0; i < 2; ++i)
#pragma unroll
                    for (int j = 0; j < 2; ++j) acc[i][j] = mfma32(a[i], b[j], acc[i][j]);
            }
        }
#pragma unroll
        for (int i = 0; i < 2; ++i)
#pragma unroll
            for (int j = 0; j < 2; ++j) epi(acc[i][j], mt * 256 + wm * 64 + i * 32, nt * 128 + wn * 64 + j * 32, lane);
    }
}

struct EpiF32 {
    float* out; int ld;
    __device__ __forceinline__ void operator()(const f32x16& acc, int row0, int col0, int lane) const {
        const int c = col0 + (lane & 31), h = lane >> 5;
#pragma unroll
        for (int r = 0; r < 16; ++r) { out[(size_t)(row0 + (r & 3) + 8 * (r >> 2) + 4 * h) * ld + c] = acc[r]; }
    }
};

namespace pg8 {
#define PG8_LAS __attribute__((address_space(3)))
constexpr int BM = 256, BK = 64, HALF = 128, HTB = HALF * BK * 2  , STAGE_BYTES = 8 * HTB, NXCD = 8, WGM = 8;

__host__ __device__ __forceinline__ int lds_byte(int r, int c) { const int st = (r >> 4) * 2 + (c >> 5), rr = r & 15, cc = c & 31, ob = rr * 64 + cc * 2; return st * 1024 + (ob ^ (((ob >> 9) & 1) << 5)); }
__host__ __device__ __forceinline__ void stage_rc(int b, int& R, int& C) { const int st = b / 1024, sb = b % 1024, swz = sb ^ (((sb >> 9) & 1) << 5); R = (st >> 1) * 16 + swz / 64; C = (st & 1) * 32 + (swz % 64) / 2; }
__host__ __device__ __forceinline__ int perm32(int rho) { const int n = rho >> 4, i = rho & 15; return 8 * (i >> 2) + 4 * n + (i & 3); }

struct Unit { int pm, pn; };
struct Gemm { const bf16_t* A; const bf16_t* Bt; int M, N, K; };

struct StaticOrder {
    int nM, nN, nwg, G, c;
    __host__ __device__ void init(int M, int N, int G_, int c_) { nM = M / BM; nN = N / BM; nwg = nM * nN; G = G_; c = c_; }
    __host__ __device__ bool next(int i, Unit& u) const {
        const long L = (long)i * G + c; if (L >= nwg) return false;
        int wgid = (int)L; { const int q = nwg / NXCD, r = nwg % NXCD, xcd = wgid % NXCD, off = wgid / NXCD; wgid = (xcd < r ? xcd * (q + 1) : r * (q + 1) + (xcd - r) * q) + off; }
        const int nig = WGM * nN, gid = wgid / nig, fm = gid * WGM, gsz = (nM - fm) < WGM ? (nM - fm) : WGM;
        u.pm = fm + ((wgid % nig) % gsz); u.pn = (wgid % nig) / gsz; return true;
    }
    __device__ __forceinline__ void a_ready(const Unit&) const {}
    __device__ __forceinline__ void done(const Unit&) const {}
};


__device__ __forceinline__ unsigned cvt_pk_bf16(float lo, float hi) { unsigned r; asm volatile("v_cvt_pk_bf16_f32 %0, %1, %2" : "=v"(r) : "v"(lo), "v"(hi)); return r; }
struct EpiStoreBf16 {
    static constexpr bool PERM = true, AFTER_DRAIN = false;
    bf16_t* O; int ldc;
    __device__ __forceinline__ void operator()(const f32x4 (&acc)[2][2][4][2], const Unit& u, int wr, int wc, int fr, int fq) const {
        const int row0 = u.pm * BM + wr * 64 + fr, col0 = u.pn * BM + wc * 32 + 8 * fq;
#pragma unroll
        for (int ai = 0; ai < 2; ++ai)
#pragma unroll
            for (int m = 0; m < 4; ++m) { bf16_t* rowp = O + (size_t)(row0 + ai * HALF + m * 16) * ldc + col0;
#pragma unroll
                for (int bj = 0; bj < 2; ++bj) { const f32x4 v0 = acc[ai][bj][m][0], v1 = acc[ai][bj][m][1];
                    u32x4 w; w.x = cvt_pk_bf16(v0[0], v0[1]); w.y = cvt_pk_bf16(v0[2], v0[3]); w.z = cvt_pk_bf16(v1[0], v1[1]); w.w = cvt_pk_bf16(v1[2], v1[3]);
                    *(u32x4*)(rowp + bj * HALF) = w; } }
    }
};
struct EpiOutProj {
    static constexpr bool PERM = false, AFTER_DRAIN = false;
    const float* base; float* O; bf16_t* XB; float* RS;
    __device__ __forceinline__ void operator()(const f32x4 (&acc)[2][2][4][2], const Unit& u, int wr, int wc, int fr, int fq) const {
        const int row0 = u.pm * BM + wr * 64 + fr, col0 = u.pn * BM + wc * 32 + 4 * fq;
#pragma unroll
        for (int ai = 0; ai < 2; ++ai)
#pragma unroll
            for (int m = 0; m < 4; ++m) { const int row = row0 + ai * HALF + m * 16; const size_t off = (size_t)row * 1024 + col0; float ss = 0.f;
#pragma unroll
                for (int bj = 0; bj < 2; ++bj)
#pragma unroll
                    for (int n = 0; n < 2; ++n) { const f32x4 v = acc[ai][bj][m][n] + *(const f32x4*)(base + off + bj * HALF + n * 16);
                        *(f32x4*)(O + off + bj * HALF + n * 16) = v; ss += v[0] * v[0] + v[1] * v[1] + v[2] * v[2] + v[3] * v[3];
                        u32x2 w; w.x = cvt_pk_bf16(v[0], v[1]); w.y = cvt_pk_bf16(v[2], v[3]); *(u32x2*)(XB + off + bj * HALF + n * 16) = w; }
                ss += __shfl_xor(ss, 16); ss += __shfl_xor(ss, 32);
                if (fq == 0) RS[(size_t)row * 16 + u.pn * 4 + wc] = ss; }
    }
};
struct EpiRowScaleF16 {
    static constexpr bool PERM = false, AFTER_DRAIN = false;
    _Float16* O; int ldc; const float* RS;
    __device__ __forceinline__ void operator()(const f32x4 (&acc)[2][2][4][2], const Unit& u, int wr, int wc, int fr, int fq) const {
        const int row0 = u.pm * BM + wr * 64 + fr, col0 = u.pn * BM + wc * 32 + 4 * fq;
#pragma unroll
        for (int ai = 0; ai < 2; ++ai)
#pragma unroll
            for (int m = 0; m < 4; ++m) { const int row = row0 + ai * HALF + m * 16; const size_t off = (size_t)row * ldc + col0;
                float tot = 0.f;
#pragma unroll
                for (int q = 0; q < 4; ++q) { const f32x4 pr = *(const f32x4*)(RS + (size_t)row * 16 + 4 * q); tot += (pr[0] + pr[1]) + (pr[2] + pr[3]); }
                const float r = rsqrtf(tot * (1.0f / 1024.0f) + 1e-6f);
#pragma unroll
                for (int bj = 0; bj < 2; ++bj)
#pragma unroll
                    for (int n = 0; n < 2; ++n) *(f16x4*)(O + off + bj * HALF + n * 16) = __builtin_convertvector(acc[ai][bj][m][n] * r, f16x4); }
    }
};
struct EpiStoreF32 {
    static constexpr bool PERM = false, AFTER_DRAIN = false;
    const float* base; float* O; int ldc;
    __device__ __forceinline__ void operator()(const f32x4 (&acc)[2][2][4][2], const Unit& u, int wr, int wc, int fr, int fq) const {
        const int row0 = u.pm * BM + wr * 64 + fr, col0 = u.pn * BM + wc * 32 + 4 * fq;
#pragma unroll
        for (int ai = 0; ai < 2; ++ai)
#pragma unroll
            for (int m = 0; m < 4; ++m) { const size_t off = (size_t)(row0 + ai * HALF + m * 16) * ldc + col0;
#pragma unroll
                for (int bj = 0; bj < 2; ++bj)
#pragma unroll
                    for (int n = 0; n < 2; ++n) { f32x4 v = acc[ai][bj][m][n]; if (base) v += *(const f32x4*)(base + off + bj * HALF + n * 16); *(f32x4*)(O + off + bj * HALF + n * 16) = v; } }
    }
};

template <class Epi, class Sched, bool ALIGN_EPI = false, bool SP2 = false>
__device__ __forceinline__ void gemm_phase(PG8_LAS unsigned char* lds, const Gemm g, const Sched& S, const Epi& E) {
    const int tid = otid(), wid = __builtin_amdgcn_readfirstlane(tid >> 6), lane = tid & 63, wr = wid >> 2, wc = wid & 3, fr = lane & 15, fq = lane >> 4;
    const int K = g.K, nt = K / BK;
    unsigned voffA[2], voffB[2];
#pragma unroll
    for (int i = 0; i < 2; ++i) { int R, C; stage_rc(tid * 16 + i * 8192, R, C); const int Rb = Epi::PERM ? ((R & ~31) + perm32(R & 31)) : R;
        voffA[i] = (unsigned)(R * K + C) * 2u; voffB[i] = (unsigned)(Rb * K + C) * 2u; }
    const size_t kstep = (size_t)(BK * 2);
    const size_t hstep = (size_t)HALF * K * 2;
    const size_t tstep = 2 * hstep;
    const unsigned ldsw = (unsigned)wid * 1024u;
    const int aoff = lds_byte(wr * 64 + fr, fq * 8), boff = lds_byte(wc * 32 + fr, fq * 8);
#define PG8_SA(b, h) (((b) * 2 + (h)) * HTB)
#define PG8_SB(b, h) ((4 + (b) * 2 + (h)) * HTB)
#define PG8_STAGE(bufoff, gbase, voff) do { _Pragma("unroll") for (int _i = 0; _i < 2; ++_i) \
        __builtin_amdgcn_global_load_lds((const unsigned*)((const char*)(gbase) + (voff)[_i]), (PG8_LAS unsigned*)(lds + (bufoff) + ldsw + _i * 8192), 16, 0, 0); } while (0)
#define PG8_LDA(dst, b, h) do { _Pragma("unroll") for (int m = 0; m < 4; ++m) _Pragma("unroll") for (int k = 0; k < 2; ++k) dst[m][k] = *(const PG8_LAS bf16x8*)(lds + PG8_SA(b, h) + aoff + m * 2048 + k * 1024); } while (0)
#define PG8_LDB(dst, b, h) do { _Pragma("unroll") for (int n = 0; n < 2; ++n) _Pragma("unroll") for (int k = 0; k < 2; ++k) dst[n][k] = *(const PG8_LAS bf16x8*)(lds + PG8_SB(b, h) + boff + n * 2048 + k * 1024); } while (0)
#define PG8_MMA(ai, bj, At, Bt) do { __builtin_amdgcn_s_setprio(1); _Pragma("unroll") for (int m = 0; m < 4; ++m) _Pragma("unroll") for (int n = 0; n < 2; ++n) _Pragma("unroll") for (int k = 0; k < 2; ++k) \
        acc[ai][bj][m][n] = __builtin_amdgcn_mfma_f32_16x16x32_bf16(Bt[n][k], At[m][k], acc[ai][bj][m][n], 0, 0, 0); __builtin_amdgcn_s_setprio(0); } while (0)
#define PG8_WAIT_V(n) asm volatile("s_waitcnt vmcnt(" #n ")" ::: "memory")
#define PG8_WAIT_L(n) asm volatile("s_waitcnt lgkmcnt(" #n ")" ::: "memory")
#define PG8_BAR __builtin_amdgcn_s_barrier()
#define PG8_SCHED __builtin_amdgcn_sched_barrier(0)
    Unit cur, nxt; int ui = 0;
    if (!S.next(0, cur)) return;
    f32x4 acc[2][2][4][2];
#pragma unroll
    for (int a = 0; a < 2; ++a)
#pragma unroll
        for (int b = 0; b < 2; ++b)
#pragma unroll
            for (int m = 0; m < 4; ++m)
#pragma unroll
                for (int n = 0; n < 2; ++n) acc[a][b][m][n] = (f32x4){0.f, 0.f, 0.f, 0.f};
    bf16x8 At[4][2], B0[2][2], B1[2][2];
    const char* cA = (const char*)g.A + (size_t)cur.pm * tstep; const char* cB = (const char*)g.Bt + (size_t)cur.pn * tstep;
    S.a_ready(cur);
    if constexpr (SP2) {
        PG8_STAGE(PG8_SB(0, 0), cB, voffB); PG8_STAGE(PG8_SB(0, 1), cB + hstep, voffB); PG8_STAGE(PG8_SA(0, 0), cA, voffA); PG8_STAGE(PG8_SA(0, 1), cA + hstep, voffA);
        if (wr == 1) PG8_BAR;
        PG8_WAIT_V(2); PG8_BAR;
        PG8_STAGE(PG8_SB(1, 0), cB + kstep, voffB); PG8_STAGE(PG8_SA(1, 0), cA + kstep, voffA); PG8_STAGE(PG8_SB(1, 1), cB + hstep + kstep, voffB);
        PG8_WAIT_V(6); PG8_BAR;
    } else {
        PG8_STAGE(PG8_SB(0, 0), cB, voffB); PG8_STAGE(PG8_SA(0, 0), cA, voffA); PG8_STAGE(PG8_SB(0, 1), cB + hstep, voffB); PG8_STAGE(PG8_SA(0, 1), cA + hstep, voffA);
        if (wr == 1) PG8_BAR;
        PG8_WAIT_V(4); PG8_BAR;
        PG8_STAGE(PG8_SB(1, 0), cB + kstep, voffB); PG8_STAGE(PG8_SA(1, 0), cA + kstep, voffA); PG8_STAGE(PG8_SB(1, 1), cB + hstep + kstep, voffB);
        PG8_WAIT_V(6); PG8_BAR;
    }
    for (;;) {
        const bool has_next = S.next(ui + 1, nxt);
        const char* nA = has_next ? (const char*)g.A + (size_t)nxt.pm * tstep : cA; const char* nB = has_next ? (const char*)g.Bt + (size_t)nxt.pn * tstep : cB;
        for (int t = 0; t < nt; t += 2) {
            const bool last = (t == nt - 2);
            const char* a1 = cA + (size_t)(t + 1) * kstep;
            const char* a2 = last ? nA : cA + (size_t)(t + 2) * kstep; const char* b2 = last ? nB : cB + (size_t)(t + 2) * kstep;
            const char* a3 = a2 + kstep; const char* b3 = b2 + kstep;
            if (last && has_next) S.a_ready(nxt);
            if constexpr (SP2) {
            PG8_LDB(B0, 0, 0); PG8_LDB(B1, 0, 1); PG8_SCHED; PG8_LDA(At, 0, 0); PG8_STAGE(PG8_SA(1, 1), a1 + hstep, voffA);
            PG8_WAIT_V(8); PG8_WAIT_L(0); PG8_BAR; PG8_MMA(0, 0, At, B0); PG8_MMA(0, 1, At, B1); PG8_BAR; PG8_SCHED;
            PG8_LDA(At, 0, 1); PG8_STAGE(PG8_SB(0, 0), b2, voffB); PG8_STAGE(PG8_SB(0, 1), b2 + hstep, voffB); PG8_STAGE(PG8_SA(0, 0), a2, voffA);
            PG8_WAIT_V(8); PG8_WAIT_L(0); PG8_BAR; PG8_MMA(1, 0, At, B0); PG8_MMA(1, 1, At, B1); PG8_BAR; PG8_SCHED;
            PG8_LDB(B0, 1, 0); PG8_LDB(B1, 1, 1); PG8_SCHED; PG8_LDA(At, 1, 0); PG8_STAGE(PG8_SA(0, 1), a2 + hstep, voffA);
            PG8_WAIT_V(8); PG8_WAIT_L(0); PG8_BAR; PG8_MMA(0, 0, At, B0); PG8_MMA(0, 1, At, B1); PG8_BAR; PG8_SCHED;
            PG8_LDA(At, 1, 1); PG8_STAGE(PG8_SB(1, 0), b3, voffB); PG8_STAGE(PG8_SB(1, 1), b3 + hstep, voffB); PG8_STAGE(PG8_SA(1, 0), a3, voffA);
            PG8_WAIT_V(8); PG8_WAIT_L(0); PG8_BAR; PG8_MMA(1, 0, At, B0); PG8_MMA(1, 1, At, B1); PG8_BAR; PG8_SCHED;
            } else {
            PG8_LDB(B0, 0, 0); PG8_SCHED; PG8_LDA(At, 0, 0); PG8_STAGE(PG8_SA(1, 1), a1 + hstep, voffA);
            PG8_WAIT_L(8); PG8_BAR; PG8_WAIT_L(0); PG8_MMA(0, 0, At, B0); PG8_BAR; PG8_SCHED;
            PG8_LDB(B1, 0, 1); PG8_STAGE(PG8_SB(0, 0), b2, voffB);
            PG8_BAR; PG8_WAIT_L(0); PG8_MMA(0, 1, At, B1); PG8_BAR;
            PG8_LDA(At, 0, 1); PG8_STAGE(PG8_SA(0, 0), a2, voffA);
            PG8_BAR; PG8_WAIT_L(0); PG8_MMA(1, 0, At, B0); PG8_BAR; PG8_SCHED;
            PG8_STAGE(PG8_SB(0, 1), b2 + hstep, voffB);
            PG8_WAIT_V(6); PG8_BAR; PG8_MMA(1, 1, At, B1); PG8_BAR;
            PG8_LDB(B0, 1, 0); PG8_SCHED; PG8_LDA(At, 1, 0); PG8_STAGE(PG8_SA(0, 1), a2 + hstep, voffA);
            PG8_WAIT_L(8); PG8_BAR; PG8_WAIT_L(0); PG8_MMA(0, 0, At, B0); PG8_BAR; PG8_SCHED;
            PG8_LDB(B1, 1, 1); PG8_STAGE(PG8_SB(1, 0), b3, voffB);
            PG8_BAR; PG8_WAIT_L(0); PG8_MMA(0, 1, At, B1); PG8_BAR;
            PG8_LDA(At, 1, 1); PG8_STAGE(PG8_SA(1, 0), a3, voffA);
            PG8_BAR; PG8_WAIT_L(0); PG8_MMA(1, 0, At, B0); PG8_BAR; PG8_SCHED;
            PG8_STAGE(PG8_SB(1, 1), b3 + hstep, voffB);
            PG8_WAIT_V(6); PG8_BAR; PG8_MMA(1, 1, At, B1); PG8_BAR;
            }
        }
        if constexpr (ALIGN_EPI) { if (wr == 0) PG8_BAR; }
        if constexpr (!Epi::AFTER_DRAIN) { E(acc, cur, wr, wc, fr, fq); S.done(cur); }
        if (!has_next) break;
#pragma unroll
        for (int a = 0; a < 2; ++a)
#pragma unroll
            for (int b = 0; b < 2; ++b)
#pragma unroll
                for (int m = 0; m < 4; ++m)
#pragma unroll
                    for (int n = 0; n < 2; ++n) acc[a][b][m][n] = (f32x4){0.f, 0.f, 0.f, 0.f};
        cur = nxt; cA = nA; cB = nB; ++ui;
        if constexpr (ALIGN_EPI) { if (wr == 1) PG8_BAR; }
    }
    PG8_WAIT_V(0);
    if constexpr (!ALIGN_EPI) { if (wr == 0) PG8_BAR; }
    PG8_BAR;
    if constexpr (Epi::AFTER_DRAIN) { E.fused(acc, cur, wr, wc, fr, fq, lds, wid, lane); S.done(cur); }
#undef PG8_SA
#undef PG8_SB
#undef PG8_STAGE
#undef PG8_LDA
#undef PG8_LDB
#undef PG8_MMA
#undef PG8_WAIT_V
#undef PG8_WAIT_L
#undef PG8_BAR
#undef PG8_SCHED
}
}

__device__ constexpr float ROPE_INV_REV[16] = {1.591549431e-01f, 8.949940161e-02f, 5.032921210e-02f, 2.830219583e-02f, 1.591549431e-02f, 8.949940161e-03f, 5.032921210e-03f, 2.830219583e-03f, 1.591549431e-03f, 8.949940161e-04f, 5.032921210e-04f, 2.830219583e-04f, 1.591549431e-04f, 8.949940161e-05f, 5.032921210e-05f, 2.830219583e-05f};
__device__ __forceinline__ void qk_norm_rope8(const u32x4 raw, const float (&gn)[8], const float (&cs)[8], const float (&sn)[8], bool second, float scale, u32x4& out) {
    float x[8] = {bflo(raw.x), bfhi(raw.x), bflo(raw.y), bfhi(raw.y), bflo(raw.z), bfhi(raw.z), bflo(raw.w), bfhi(raw.w)};
    float ss = 0.f;
#pragma unroll
    for (int e = 0; e < 8; ++e) ss += x[e] * x[e];
    ss += __shfl_xor(ss, 1); ss += __shfl_xor(ss, 2); ss += __shfl_xor(ss, 4);
    const float r = rsqrtf(ss * (1.0f / 64.0f) + EPS) ;
    float o[8];
#pragma unroll
    for (int e = 0; e < 8; ++e) {
        const float y = x[e] * r * gn[e];
        const float other = __shfl_xor(y, 2);
        o[e] = (second ? (y * cs[e] + other * sn[e]) : (y * cs[e] - other * sn[e])) * scale;
    }
    out.x = pk2(o[0], o[1]); out.y = pk2(o[2], o[3]); out.z = pk2(o[4], o[5]); out.w = pk2(o[6], o[7]);
}
__device__ __forceinline__ void phase_qkprep(const Params& p, int layer, char* lds, bf16_t* qout) {
    const int tid = otid(), lane = tid & 63, wave = tid >> 6;
    const bf16_t* qkv = (const bf16_t*)(p.ws + R_QKV);
    const int sub = lane & 7;
    const bool second = ((sub >> 1) & 1) != 0, colaxis = (sub >> 2) != 0;
    float gq[8], gk[8], ir[8];
#pragma unroll
    for (int e = 0; e < 8; ++e) {
        gq[e] = p.in[I_QG][layer * 64 + sub * 8 + e]; gk[e] = p.in[I_KG][layer * 64 + sub * 8 + e];
        ir[e] = (sub & 1) ? ROPE_INV_REV[8 + e] : ROPE_INV_REV[e];
    }
    const int gw = obid() * NWAVE + wave, ngw = NBLK * NWAVE;
    for (int t = gw; t < T; t += ngw) {
        const int l = t & (SL - 1);
        const float pos = colaxis ? (float)(l & 63) : (float)(l >> 6);
        float cs[8], sn[8];
#pragma unroll
        for (int e = 0; e < 8; ++e) { const float a = pos * ir[e]; cs[e] = __builtin_amdgcn_cosf(a); sn[e] = __builtin_amdgcn_sinf(a); }
        const u32x4 rq = *(const u32x4*)(qkv + (size_t)t * 768 + lane * 8);
        u32x4 rk = {0u, 0u, 0u, 0u};
        if (lane < 16) rk = *(const u32x4*)(qkv + (size_t)t * 768 + 512 + lane * 8);
        u32x4 oq, ok;
        qk_norm_rope8(rq, gq, cs, sn, second, 0.125f * 1.4426950408889634f, oq);
        qk_norm_rope8(rk, gk, cs, sn, second, 1.0f, ok);
        *(u32x4*)(qout + (size_t)t * 768 + lane * 8) = oq;
        if (lane < 16) *(u32x4*)(qout + (size_t)t * 768 + 512 + lane * 8) = ok;
    }
}

#include <hip/hip_bf16.h>
#include <cmath>
namespace attn_body {
using bf16=__hip_bfloat16;
using bf16x8=__attribute__((ext_vector_type(8)))short;
using s16x4=__attribute__((ext_vector_type(4)))short;
using f32x16=__attribute__((ext_vector_type(16)))float;
using u32x4=__attribute__((ext_vector_type(4)))unsigned;
constexpr int SEQ=8192,D=64,PQ=768,PO=512;
constexpr int NW=8,QBLK=32,QB=QBLK*NW,KVBLK=64,NQB=SEQ/QB;
constexpr int ATTN_UNIT_ROWS=QB;
__device__ __forceinline__ int crow(int r,int hi){return (r&3)+8*(r>>2)+4*hi;}
#define SBAR() __builtin_amdgcn_sched_barrier(0)
__device__ __forceinline__ void cmask(f32x16&p0,f32x16&p1,int jb,int qrel,int hi){
  const float NEG=-INFINITY; int kb=64*jb+4*hi;
  #pragma unroll
  for(int r=0;r<16;++r){int kv=kb+(r&3)+8*(r>>2); if(kv>qrel)p0[r]=NEG; if(kv+32>qrel)p1[r]=NEG;}
}

constexpr int NSLOT=3, SLOTB=8192;
constexpr int LDS_K=0, LDS_V=NSLOT*SLOTB, LDS_WS=2*NSLOT*SLOTB, LDS_OST=LDS_WS+NW*64*4, LDS_BYTES=LDS_OST+NW*4096;
constexpr float C2=0.125f*1.4426950408889634f;
__device__ __forceinline__ void glds16(const void*gsrc,unsigned lds_dst){unsigned keep;
  asm volatile("s_mov_b32 %0, m0\n\ts_mov_b32 m0, %2\n\ts_nop 0\n\tglobal_load_lds_dwordx4 %1, off\n\ts_mov_b32 m0, %0":"=&s"(keep):"v"(gsrc),"s"(lds_dst):"memory");}
__device__ __forceinline__ float max3f(float a,float b,float c){float r;asm("v_max3_f32 %0, %1, %2, %3":"=v"(r):"v"(a),"v"(b),"v"(c));return r;}
__device__ __forceinline__ float max2f(float a,float b){float r;asm("v_max_f32_e32 %0, %1, %2":"=v"(r):"v"(a),"v"(b));return r;}
__device__ __forceinline__ float fadd_s(float a,float b){float r;asm("v_add_f32_e32 %0, %1, %2":"=v"(r):"v"(a),"v"(b));return r;}
__device__ __forceinline__ float fsub_s(float a,float b){float r;asm("v_sub_f32_e32 %0, %1, %2":"=v"(r):"v"(a),"v"(b));return r;}
typedef float f32x2_t __attribute__((ext_vector_type(2))); typedef __bf16 bf16x2_t __attribute__((ext_vector_type(2)));
__device__ __forceinline__ unsigned cvtpk_s(float lo,float hi){f32x2_t v={lo,hi};bf16x2_t b=__builtin_convertvector(v,bf16x2_t);return __builtin_bit_cast(unsigned,b);}
#define WAIT_BAR(N) asm volatile("s_waitcnt vmcnt(" #N ") lgkmcnt(0)\n\ts_barrier":::"memory")

__device__ __forceinline__ void qkt(f32x16&p0,f32x16&p1,const char*Kslot,const bf16x8*qr,const f32x16&negm,int r32,int hi){
  const char*kb=Kslot+hi*1024+r32*16;
  #pragma unroll
  for(int d0=0;d0<4;++d0){
    const bf16x8 b0=*reinterpret_cast<const bf16x8*>(kb+d0*2048);
    const bf16x8 b1=*reinterpret_cast<const bf16x8*>(kb+d0*2048+512);
    if(d0==0){p0=__builtin_amdgcn_mfma_f32_32x32x16_bf16(b0,qr[0],negm,0,0,0);p1=__builtin_amdgcn_mfma_f32_32x32x16_bf16(b1,qr[0],negm,0,0,0);}
    else{p0=__builtin_amdgcn_mfma_f32_32x32x16_bf16(b0,qr[d0],p0,0,0,0);p1=__builtin_amdgcn_mfma_f32_32x32x16_bf16(b1,qr[d0],p1,0,0,0);}}
}
typedef __attribute__((address_space(3))) const char* lds_cptr;
typedef short v4i16_t __attribute__((ext_vector_type(4)));
__device__ __forceinline__ void kload8(bf16x8*kf,lds_cptr kp){
  kf[0]=*(const __attribute__((address_space(3))) bf16x8*)(kp);      kf[1]=*(const __attribute__((address_space(3))) bf16x8*)(kp+512);
  kf[2]=*(const __attribute__((address_space(3))) bf16x8*)(kp+2048); kf[3]=*(const __attribute__((address_space(3))) bf16x8*)(kp+2560);
  kf[4]=*(const __attribute__((address_space(3))) bf16x8*)(kp+4096); kf[5]=*(const __attribute__((address_space(3))) bf16x8*)(kp+4608);
  kf[6]=*(const __attribute__((address_space(3))) bf16x8*)(kp+6144); kf[7]=*(const __attribute__((address_space(3))) bf16x8*)(kp+6656);
}
__device__ __forceinline__ void kload2(bf16x8*kf,lds_cptr kp,int j){ kf[2*j]=*(const __attribute__((address_space(3))) bf16x8*)(kp+j*2048); kf[2*j+1]=*(const __attribute__((address_space(3))) bf16x8*)(kp+j*2048+512); }
__device__ __forceinline__ s16x4 vtr(lds_cptr p){ return __builtin_bit_cast(s16x4,__builtin_amdgcn_ds_read_tr16_b64_v4i16((__attribute__((address_space(3))) v4i16_t*)p)); }
__device__ __forceinline__ float rowmax(const f32x16&p0,const f32x16&p1){
  float a=max3f(p0[0],p0[1],p1[0]),b=max3f(p0[2],p0[3],p1[1]);a=max3f(a,p1[2],p1[3]);
  #pragma unroll
  for(int r=4;r<16;r+=4){a=max3f(a,p0[r],p0[r+1]);b=max3f(b,p0[r+2],p0[r+3]);a=max3f(a,p1[r],p1[r+1]);b=max3f(b,p1[r+2],p1[r+3]);}
  const float m=max2f(a,b);
  auto rr=__builtin_amdgcn_permlane32_swap(__float_as_uint(m),__float_as_uint(m),false,false);
  return max2f(__uint_as_float(rr[0]),__uint_as_float(rr[1]));
}
__device__ __forceinline__ void pv(f32x16*o,int vb,bf16x8 pa0,bf16x8 pa1,bf16x8 pa2,bf16x8 pa3){
  #pragma unroll
  for(int d0=0;d0<2;++d0){s16x4 lo[4],hi[4];
    #pragma unroll
    for(int ks=0;ks<4;++ks){
      asm volatile("ds_read_b64_tr_b16 %0,%1 offset:%c2":"=&v"(lo[ks]):"v"(vb),"i"(d0*4096+ks*1024):"memory");
      asm volatile("ds_read_b64_tr_b16 %0,%1 offset:%c2":"=&v"(hi[ks]):"v"(vb),"i"(d0*4096+ks*1024+512):"memory");}
    asm volatile("s_waitcnt lgkmcnt(0)":::"memory");SBAR();
    #define PK(k) (bf16x8){lo[k][0],lo[k][1],lo[k][2],lo[k][3],hi[k][0],hi[k][1],hi[k][2],hi[k][3]}
    o[d0]=__builtin_amdgcn_mfma_f32_32x32x16_bf16(pa0,PK(0),o[d0],0,0,0);
    o[d0]=__builtin_amdgcn_mfma_f32_32x32x16_bf16(pa1,PK(1),o[d0],0,0,0);
    o[d0]=__builtin_amdgcn_mfma_f32_32x32x16_bf16(pa2,PK(2),o[d0],0,0,0);
    o[d0]=__builtin_amdgcn_mfma_f32_32x32x16_bf16(pa3,PK(3),o[d0],0,0,0);
    #undef PK
  }
}

#ifndef ATTN_STORE16
#define ATTN_STORE16(p,v) (*(u32x4*)(p)=(v))
#endif
template<int THRL,bool FIXED> __device__ __forceinline__ void attn_unit(int b,int h,int g,int qb,const bf16*Q,const bf16*__restrict__ K,const bf16*__restrict__ V,bf16*O,char*shm,float mfix){
  const int tid=otid(),lane=tid&63,r32=lane&31,hi=lane>>5; const int wid=__builtin_amdgcn_readfirstlane(tid>>6);
  const long rowbase=(long)b*SEQ; const int q0=qb*QB;
  const bf16*Qw=Q+(rowbase+q0+wid*QBLK)*PQ+h*D;
  const bf16*Kh=K+rowbase*PQ+g*D,*Vh=V+rowbase*PQ+g*D;
  const unsigned lds0=(unsigned)(uintptr_t)shm;
  float*wsf=(float*)(shm+LDS_WS)+wid*64;
  const bf16*ksrc=Kh+(long)lane*PQ+wid*8;
  const bf16*vsrc=Vh+(long)(16*(wid&3)+(lane>>2))*PQ+(wid>>2)*32+(lane&3)*8;
  const unsigned kdst=lds0+LDS_K+wid*1024, vdst=lds0+LDS_V+wid*1024;
  #define DMA_K(t,slot) glds16(ksrc+(long)(t)*KVBLK*PQ,(unsigned)__builtin_amdgcn_readfirstlane(kdst+(slot)))
  #define DMA_V(t,slot) glds16(vsrc+(long)(t)*KVBLK*PQ,(unsigned)__builtin_amdgcn_readfirstlane(vdst+(slot)))
  const int vb0=(int)(lds0+LDS_V)+((lane>>4)&1)*32+(lane&3)*8+(4*hi+((lane&15)>>2))*64;
  const char*Kbase=shm+LDS_K; bf16x8 kf[8];
  const lds_cptr shm3=(lds_cptr)shm; const lds_cptr kp0=shm3+LDS_K+hi*1024+r32*16; const lds_cptr vp0=shm3+LDS_V+((lane>>4)&1)*32+(lane&3)*8+(4*hi+((lane&15)>>2))*64;
  constexpr int NT=SEQ/KVBLK;
  DMA_K(0,0);DMA_V(0,0);DMA_K(1,SLOTB);
  bf16x8 qr[4];
  #pragma unroll
  for(int d0=0;d0<4;++d0)qr[d0]=*reinterpret_cast<const bf16x8*>(&Qw[(long)r32*PQ+d0*16+hi*8]);
  float mhat=0.f,l_reg=0.f;f32x16 o[2];o[0]=f32x16{};o[1]=f32x16{};f32x16 negm=f32x16{};asm volatile("":"+v"(negm));
    #define CMASK(P0,P1,t) do{}while(0)
  bool resc=false;
  #define START(P0,P1) do{ const float rm=FIXED?mfix:rowmax(P0,P1); resc=false; \
    { const float dl=rm; mhat=fadd_s(mhat,dl); \
      _Pragma("unroll") for(int r=0;r<16;++r){P0[r]=fsub_s(P0[r],dl);P1[r]=fsub_s(P1[r],dl);} \
      _Pragma("unroll") for(int r=0;r<16;++r)negm[r]=-mhat; asm volatile("":"+v"(negm)); } \
    _Pragma("unroll") for(int r=0;r<16;++r)P0[r]=__builtin_amdgcn_exp2f(P0[r]); }while(0)
  #define RESC() do{ if(resc){ asm volatile("s_waitcnt lgkmcnt(0)":::"memory"); \
      _Pragma("unroll") for(int d_=0;d_<2;++d_) _Pragma("unroll") for(int r=0;r<16;++r)o[d_][r]*=wsf[crow(r,hi)]; } }while(0)
  f32x16 pA0,pA1,pB0,pB1;
  int sl_prev=0,sl_cur=0,sl_next=SLOTB;
  #define ROT() do{sl_prev=sl_cur;sl_cur=sl_next;sl_next=(sl_next==(NSLOT-1)*SLOTB)?0:sl_next+SLOTB;}while(0)
  DMA_K(2,2*SLOTB);
  WAIT_BAR(3);
  qkt(pA0,pA1,Kbase,qr,negm,r32,hi);asm volatile("s_nop 15\n\ts_nop 7":"+v"(pA0),"+v"(pA1));CMASK(pA0,pA1,0);
  START(pA0,pA1);
  _Pragma("unroll") for(int r=0;r<16;++r)pA1[r]=__builtin_amdgcn_exp2f(pA1[r]);
  WAIT_BAR(0);
  DMA_K(3,0);DMA_V(1,SLOTB);
  ROT();
  kload8(kf,kp0+sl_cur);
  WAIT_BAR(2);
  s16x4 vlo[8],vhi[8]; u32x4 pw0,pw1,pw2,pw3;
  #define PKW(P,B) cvtpk_s(P[B],P[B+1])
  #define PAF(k) __builtin_bit_cast(bf16x8,pw##k)
  #define VFR(i) (bf16x8){vlo[i][0],vlo[i][1],vlo[i][2],vlo[i][3],vhi[i][0],vhi[i][1],vhi[i][2],vhi[i][3]}
  #define PIN(x) asm volatile("":"+v"(x))
  #define MX3(a,b,c) __builtin_fmaxf(__builtin_fmaxf((a),(b)),(c))
  #define GAPA(MF,A0,A1,A2,A3,W0,W1,PW) do{ MF; sacc+=A0; sacc+=A1; sacc+=A2; sacc+=A3; PIN(sacc); W0; W1; PIN(PW); SBAR(); }while(0)
  #define EX(v) __builtin_amdgcn_exp2f(v)
  #define GAPB(MF,X,B) do{ MF; X[B]=EX(X[B]); X[B+1]=EX(X[B+1]); X[B+2]=EX(X[B+2]); X[B+3]=EX(X[B+3]); PIN(X); SBAR(); }while(0)
  #define VRD(i) do{ vlo[i]=vtr(vp_+(((i)>>2)*4096+((i)&3)*1024)); vhi[i]=vtr(vp_+(((i)>>2)*4096+((i)&3)*1024+512)); }while(0)
  #define KRD(G,j) do{ if(G){ kload2(kf,kp0+sl_next,j); SBAR(); } }while(0)
  #define STEP(C0,C1,P0,P1,t,GK,GV,GL) do{ SBAR(); \
    const lds_cptr vp_=vp0+sl_prev; \
    VRD(0); SBAR(); float sacc=(P0[0]+P0[1]); \
    GAPA(C0=__builtin_amdgcn_mfma_f32_32x32x16_bf16(kf[0],qr[0],negm,0,0,0), P0[2],P0[3],P0[4],P0[5],     pw0[0]=PKW(P0,0), pw0[1]=PKW(P0,2), pw0); \
    VRD(4); SBAR(); GAPA(C1=__builtin_amdgcn_mfma_f32_32x32x16_bf16(kf[1],qr[0],negm,0,0,0), P0[6],P0[7],P0[8],P0[9],     pw0[2]=PKW(P0,4), pw0[3]=PKW(P0,6), pw0); \
    VRD(1); SBAR(); GAPA(C0=__builtin_amdgcn_mfma_f32_32x32x16_bf16(kf[2],qr[1],C0,0,0,0),   P0[10],P0[11],P0[12],P0[13], pw1[0]=PKW(P0,8), pw1[1]=PKW(P0,10), pw1); \
    VRD(5); SBAR(); GAPA(C1=__builtin_amdgcn_mfma_f32_32x32x16_bf16(kf[3],qr[1],C1,0,0,0),   P0[14],P0[15],P1[0],P1[1],   pw1[2]=PKW(P0,12),pw1[3]=PKW(P0,14), pw1); \
    VRD(2); SBAR(); GAPA(C0=__builtin_amdgcn_mfma_f32_32x32x16_bf16(kf[4],qr[2],C0,0,0,0),   P1[2],P1[3],P1[4],P1[5],     pw2[0]=PKW(P1,0), pw2[1]=PKW(P1,2), pw2); \
    VRD(6); SBAR(); GAPA(C1=__builtin_amdgcn_mfma_f32_32x32x16_bf16(kf[5],qr[2],C1,0,0,0),   P1[6],P1[7],P1[8],P1[9],     pw2[2]=PKW(P1,4), pw2[3]=PKW(P1,6), pw2); \
    VRD(3); SBAR(); GAPA(C0=__builtin_amdgcn_mfma_f32_32x32x16_bf16(kf[6],qr[3],C0,0,0,0),   P1[10],P1[11],P1[12],P1[13], pw3[0]=PKW(P1,8), pw3[1]=PKW(P1,10), pw3); \
    VRD(7); SBAR(); GAPA(C1=__builtin_amdgcn_mfma_f32_32x32x16_bf16(kf[7],qr[3],C1,0,0,0),   P1[14],P1[15],0.f,0.f,       pw3[2]=PKW(P1,12),pw3[3]=PKW(P1,14), pw3); \
    l_reg+=sacc; \
    if(GK){DMA_K((t)+3,sl_cur);} if(GV){DMA_V((t)+1,sl_next);} \
    CMASK(C0,C1,t); \
    if(!FIXED){ float a=MX3(C0[0],C0[1],C1[0]),b=MX3(C0[2],C0[3],C1[1]); a=MX3(a,C1[2],C1[3]); \
      _Pragma("unroll") for(int r=4;r<16;r+=4){a=MX3(a,C0[r],C0[r+1]);b=MX3(b,C0[r+2],C0[r+3]);a=MX3(a,C1[r],C1[r+1]);b=MX3(b,C1[r+2],C1[r+3]);} \
      float rm=__builtin_fmaxf(a,b); { auto rr=__builtin_amdgcn_permlane32_swap(__float_as_uint(rm),__float_as_uint(rm),false,false); rm=__builtin_fmaxf(__uint_as_float(rr[0]),__uint_as_float(rr[1])); } \
      resc=false; \
      if(__builtin_expect(__any(rm>(float)THRL),0)){ const float dl=__builtin_fmaxf(rm,0.f); mhat+=dl; \
        _Pragma("unroll") for(int r=0;r<16;++r){C0[r]-=dl;C1[r]-=dl;} \
        _Pragma("unroll") for(int r=0;r<16;++r)negm[r]=-mhat; asm volatile("":"+v"(negm)); \
        const float f=__builtin_amdgcn_exp2f(-dl); l_reg*=f; if(hi==0)wsf[r32]=f; resc=true; } } \
    SBAR(); \
    GAPB(o[0]=__builtin_amdgcn_mfma_f32_32x32x16_bf16(PAF(0),VFR(0),o[0],0,0,0), C0,0); \
    GAPB(o[1]=__builtin_amdgcn_mfma_f32_32x32x16_bf16(PAF(0),VFR(4),o[1],0,0,0), C0,4); \
    KRD(GL,0); GAPB(o[0]=__builtin_amdgcn_mfma_f32_32x32x16_bf16(PAF(1),VFR(1),o[0],0,0,0), C0,8); \
    KRD(GL,1); GAPB(o[1]=__builtin_amdgcn_mfma_f32_32x32x16_bf16(PAF(1),VFR(5),o[1],0,0,0), C0,12); \
    KRD(GL,2); GAPB(o[0]=__builtin_amdgcn_mfma_f32_32x32x16_bf16(PAF(2),VFR(2),o[0],0,0,0), C1,0); \
    KRD(GL,3); GAPB(o[1]=__builtin_amdgcn_mfma_f32_32x32x16_bf16(PAF(2),VFR(6),o[1],0,0,0), C1,4); \
    GAPB(o[0]=__builtin_amdgcn_mfma_f32_32x32x16_bf16(PAF(3),VFR(3),o[0],0,0,0), C1,8); \
    GAPB(o[1]=__builtin_amdgcn_mfma_f32_32x32x16_bf16(PAF(3),VFR(7),o[1],0,0,0), C1,12); \
    }while(0)
  int t=1;
  #undef CMASK
  #define CMASK(P0,P1,t) do{}while(0)
  for(;t+5<NT;t+=2){
    STEP(pB0,pB1,pA0,pA1,t,true,true,true);     WAIT_BAR(2); RESC(); ROT();
    STEP(pA0,pA1,pB0,pB1,t+1,true,true,true);   WAIT_BAR(2); RESC(); ROT();
  }
  #define ENDW(tt) do{ if((tt)+3<NT){WAIT_BAR(2);} else if((tt)+2<NT){WAIT_BAR(1);} else {WAIT_BAR(0);} }while(0)
  for(;t+1<NT;t+=2){
    STEP(pB0,pB1,pA0,pA1,t,(t+3<NT),(t+1<NT),(t+1<NT));       ENDW(t);   RESC(); ROT();
    STEP(pA0,pA1,pB0,pB1,t+1,(t+4<NT),(t+2<NT),(t+2<NT));     ENDW(t+1); RESC(); ROT();
  }
  STEP(pB0,pB1,pA0,pA1,NT-1,false,false,false); RESC();
  { float sacc=pB0[0]+pB0[1]; _Pragma("unroll") for(int r=2;r<16;++r)sacc+=pB0[r]; _Pragma("unroll") for(int r=0;r<16;++r)sacc+=pB1[r]; l_reg+=sacc;
    pw0=(u32x4){PKW(pB0,0),PKW(pB0,2),PKW(pB0,4),PKW(pB0,6)};pw1=(u32x4){PKW(pB0,8),PKW(pB0,10),PKW(pB0,12),PKW(pB0,14)};pw2=(u32x4){PKW(pB1,0),PKW(pB1,2),PKW(pB1,4),PKW(pB1,6)};pw3=(u32x4){PKW(pB1,8),PKW(pB1,10),PKW(pB1,12),PKW(pB1,14)};
    SBAR(); pv(o,vb0+sl_cur,PAF(0),PAF(1),PAF(2),PAF(3)); }
  #undef PKW
  #undef PAF
  #undef VFR
  #undef PIN
  #undef MX3
  #undef GAPA
  #undef GAPB
  #undef EX
  #undef VRD
  #undef KRD
  #undef STEP
  #undef ENDW
  {auto rr=__builtin_amdgcn_permlane32_swap(__float_as_uint(l_reg),__float_as_uint(l_reg),false,false);l_reg=__uint_as_float(rr[0])+__uint_as_float(rr[1]);}
  if(hi==0)wsf[32+r32]=l_reg;asm volatile("s_waitcnt lgkmcnt(0)":::"memory");
  float rli[16];
  #pragma unroll
  for(int r=0;r<16;++r)rli[r]=__builtin_amdgcn_rcpf(wsf[32+crow(r,hi)]);
  bf16*Ow=O+(rowbase+q0+wid*QBLK)*PO+h*D;
  { bf16*stg=(bf16*)(shm+LDS_OST)+wid*2048;
    #pragma unroll
    for(int r=0;r<16;++r){const int orow=crow(r,hi);
      #pragma unroll
      for(int d0=0;d0<2;++d0)stg[orow*64+d0*32+r32]=__float2bfloat16(o[d0][r]*rli[r]);}
    asm volatile("s_waitcnt lgkmcnt(0)":::"memory");
    #pragma unroll
    for(int i=0;i<4;++i){const int row=i*8+(lane>>3),ch=lane&7; const u32x4 v=*(const u32x4*)(stg+row*64+ch*8); ATTN_STORE16(Ow+(long)row*PO+ch*8,v);} }
  asm volatile("s_waitcnt lgkmcnt(0)\n\ts_barrier":::"memory");
  #undef DMA_K
  #undef DMA_V
  #undef CMASK
  #undef START
  #undef RESC
  #undef ROT
}
constexpr int ATTN_LDS_BYTES=LDS_BYTES;
#undef SBAR
#undef WAIT_BAR
}

__device__ __forceinline__ void phase_attn(const Params& p, int layer, char* lds) {
    const int lane = otid() & 63;
    const float mq = wave_max(fabsf(p.in[I_QG][layer * 64 + lane])), mk = wave_max(fabsf(p.in[I_KG][layer * 64 + lane]));
    const float mfix = 64.0f * mq * mk * (0.125f * 1.4426950408889634f) * 1.02f;
    const bool fixed_ok = mfix < 48.0f;
    const int bid = obid();
    const int vcu = ((NBLK & 7) == 0) ? (bid & 7) * (int)(NBLK >> 3) + (bid >> 3) : bid;
    const attn_body::bf16* qkvb = (const attn_body::bf16*)(p.ws + R_QKV);
    for (int u = vcu; u < 512; u += NBLK) {
        const int bg = (u & 255) >> 6, r = u & 63, hh = r & 3, qb = (r >> 2) + 16 * (u >> 8);
        const int b = bg >> 1, g = bg & 1;
        if (fixed_ok) attn_body::attn_unit<8, true>(b, 4 * g + hh, g, qb, qkvb, qkvb + 512, qkvb + 640, (attn_body::bf16*)(p.ws + R_ATT), lds, mfix);
        else attn_body::attn_unit<8, false>(b, 4 * g + hh, g, qb, qkvb, qkvb + 512, qkvb + 640, (attn_body::bf16*)(p.ws + R_ATT), lds, 0.f);
    }
}

__device__ __forceinline__ size_t cidx(int c, int t) { return ((size_t)(t >> 5) * 256 + c) * 32 + (t & 31); }
__device__ __forceinline__ f32x4 convd4(const float* row, int l0, float w0, float w1, float w2, float cb) {
    const f32x4 c = *(const f32x4*)(row + l0);
    const float lft = (l0 > 0) ? row[l0 - 1] : 0.f;
    const float rgt = (l0 + 4 < SL) ? row[l0 + 4] : 0.f;
    f32x4 o;
    o.x = cb + w0 * lft + w1 * c.x + w2 * c.y;
    o.y = cb + w0 * c.x + w1 * c.y + w2 * c.z;
    o.z = cb + w0 * c.y + w1 * c.z + w2 * c.w;
    o.w = cb + w0 * c.z + w1 * c.w + w2 * rgt;
    return o;
}
__device__ __forceinline__ void cmul_kf(float2* Z, const float2* KF, int tid) {
#pragma unroll 4
    for (int i = 0; i < 16; ++i) {
        const int pp = 2 * tid + 1024 * i;
        const f32x4 z = *(const f32x4*)(Z + zp(pp)), k = *(const f32x4*)(KF + pp);
        f32x4 o; o.x = z.x * k.x - z.y * k.y; o.y = z.x * k.y + z.y * k.x; o.z = z.z * k.z - z.w * k.w; o.w = z.z * k.w + z.w * k.z;
        *(f32x4*)(Z + zp(pp)) = o;
    }
}
__device__ __forceinline__ void hyena_job(const Params& p, int layer, int c, char* lds) {
    const int tid = otid();
    float2* Z = (float2*)lds;
    const float* HF = (const float*)(p.ws + R_HF);
    const float* cw = p.in[I_CW] + (size_t)layer * 3 * 768; const float* cbp = p.in[I_CB] + layer * 768;
    const float2* KF0 = (const float2*)(p.ws + OFF_KF) + ((size_t)(layer * 256 + c) * 2) * 16384;
    const float2* KF1 = KF0 + 16384;
    float* Yb = (float*)(p.ws + R_Y);
    const int cv = c, c1 = 256 + c, c2 = 512 + c;
    const float* rv = HF + (size_t)cv * T; const float* r1 = HF + (size_t)c1 * T; const float* r2 = HF + (size_t)c2 * T;
    const float v_w0 = cw[cv], v_w1 = cw[768 + cv], v_w2 = cw[1536 + cv], v_cb = cbp[cv];
    const float a_w0 = cw[c1], a_w1 = cw[768 + c1], a_w2 = cw[1536 + c1], a_cb = cbp[c1];
    const float b_w0 = cw[c2], b_w1 = cw[768 + c2], b_w2 = cw[1536 + c2], b_cb = cbp[c2];
    const f32x4 zero4 = {0.f, 0.f, 0.f, 0.f};
    __syncthreads();
#pragma unroll 1
    for (int i = 0; i < 4; ++i) {
        const int l0 = 4 * otid() + 2048 * i;
        const f32x4 va = convd4(rv, l0, v_w0, v_w1, v_w2, v_cb), vb = convd4(rv + SL, l0, v_w0, v_w1, v_w2, v_cb);
        *(f32x4*)(Z + zp(l0)) = (f32x4){va.x, vb.x, va.y, vb.y}; *(f32x4*)(Z + zp(l0) + 2) = (f32x4){va.z, vb.z, va.w, vb.w};
        *(f32x4*)(Z + zp(8192 + l0)) = zero4; *(f32x4*)(Z + zp(8192 + l0) + 2) = zero4;
    }
    __syncthreads();
    fft16k_fwd(Z);
    cmul_kf(Z, KF0, otid());
    __syncthreads();
    fft16k_inv(Z);
#pragma unroll 1
    for (int i = 0; i < 4; ++i) {
        const int l0 = 4 * otid() + 2048 * i;
        const f32x4 za = *(const f32x4*)(Z + zp(l0)), zb = *(const f32x4*)(Z + zp(l0) + 2);
        const f32x4 ga = convd4(r1, l0, a_w0, a_w1, a_w2, a_cb), gb = convd4(r1 + SL, l0, a_w0, a_w1, a_w2, a_cb);
        *(f32x4*)(Z + zp(l0)) = (f32x4){ga.x * za.x, gb.x * za.y, ga.y * za.z, gb.y * za.w};
        *(f32x4*)(Z + zp(l0) + 2) = (f32x4){ga.z * zb.x, gb.z * zb.y, ga.w * zb.z, gb.w * zb.w};
        *(f32x4*)(Z + zp(8192 + l0)) = zero4; *(f32x4*)(Z + zp(8192 + l0) + 2) = zero4;
    }
    __syncthreads();
    fft16k_fwd(Z);
    cmul_kf(Z, KF1, otid());
    __syncthreads();
    fft16k_inv(Z);
#pragma unroll 1
    for (int i = 0; i < 4; ++i) {
        const int l0 = 4 * otid() + 2048 * i;
        const f32x4 za = *(const f32x4*)(Z + zp(l0)), zb = *(const f32x4*)(Z + zp(l0) + 2);
        const f32x4 ga = convd4(r2, l0, b_w0, b_w1, b_w2, b_cb), gb = convd4(r2 + SL, l0, b_w0, b_w1, b_w2, b_cb);
        f32x4 ya, yb;
        ya.x = ga.x * za.x; ya.y = ga.y * za.z; ya.z = ga.z * zb.x; ya.w = ga.w * zb.z;
        yb.x = gb.x * za.y; yb.y = gb.y * za.w; yb.z = gb.z * zb.y; yb.w = gb.w * zb.w;
        *(f32x4*)(Yb + cidx(c, l0)) = ya; *(f32x4*)(Yb + cidx(c, SL + l0)) = yb;
    }
    __syncthreads();
}

__device__ __forceinline__ void fnet_job(const Params& p, int ch, char* lds) {
    const int tid = otid();
    float2* Z = (float2*)lds;
    const float* row = (const float*)(p.ws + R_HF) + (size_t)(768 + ch) * T;
    float* UR = (float*)(p.ws + R_UR);
    float* UI = (float*)(p.ws + R_UI);
    __syncthreads();
#pragma unroll
    for (int i = 0; i < 4; ++i) {
        const int l0 = 4 * tid + 2048 * i;
        const f32x4 a = *(const f32x4*)(row + l0), b = *(const f32x4*)(row + SL + l0);
        const int z0 = zp(l0);
        *(f32x4*)(Z + z0) = (f32x4){a.x, b.x, a.y, b.y}; *(f32x4*)(Z + z0 + 2) = (f32x4){a.z, b.z, a.w, b.w};
    }
    __syncthreads();
    fft8k_fwd(Z);
#pragma unroll
    for (int i = 0; i < 4; ++i) {
        const int k0 = 4 * tid + 2048 * i;
        f32x4 ur0, ui0, ur1, ui1;
#pragma unroll
        for (int e = 0; e < 4; ++e) {
            const int k = k0 + e;
            const int pk = p8k_of_f(k);
            const int pm = p8k_of_f((SL - k) & (SL - 1));
            const float2 zk = Z[zp(pk)], zm = Z[zp(pm)];
            ur0[e] = 0.5f * (zk.x + zm.x); ui0[e] = 0.5f * (zk.y - zm.y);
            ur1[e] = 0.5f * (zk.y + zm.y); ui1[e] = 0.5f * (zm.x - zk.x);
        }
        *(f32x4*)(UR + cidx(ch, k0)) = ur0; *(f32x4*)(UI + cidx(ch, k0)) = ui0; *(f32x4*)(UR + cidx(ch, SL + k0)) = ur1; *(f32x4*)(UI + cidx(ch, SL + k0)) = ui1;
    }
    __syncthreads();
}

__device__ __forceinline__ void phase_mix(const Params& p, int layer, char* lds) {
    const int tid = otid(), lane = tid & 63, wave = tid >> 6;
    const int l31 = lane & 31, hl = lane >> 5, g = wave & 3, tsel = wave >> 2;
    float* ex = (float*)lds;
    float* FMl = (float*)(lds + 8192);
    const float* UR = (const float*)(p.ws + R_UR); const float* UI = (const float*)(p.ws + R_UI);
    const float* Y = (const float*)(p.ws + R_Y);
    const bf16_t* att = (const bf16_t*)(p.ws + R_ATT);
    bf16_t* mix = (bf16_t*)(p.ws + R_MIX);
    const float* fb = p.in[I_FB] + layer * 256 + g * 64;
    const float* mg = p.in[I_MG] + layer * 1024;
    __syncthreads();
    {
        const f32x4* src = (const f32x4*)((const float*)(p.ws + OFF_FM) + (size_t)layer * 4 * 128 * 64);
#pragma unroll 4
        for (int i = 0; i < 16; ++i) *(f32x4*)(FMl + 4 * (tid + NTHR * i)) = src[tid + NTHR * i];
    }
    for (int tp = obid(); tp < T / 64; tp += NBLK) {
        const int t = (tp * 2 + tsel) * 32 + l31;
        float bv[64];
        {
            const float* ub = UR + cidx(g * 64 + hl, t);
            const float* ub2 = UI + cidx(g * 64 + hl, t);
#pragma unroll
            for (int i = 0; i < 32; ++i) { bv[i] = ub[(2 * i) * 32]; bv[32 + i] = ub2[(2 * i) * 32]; }
        }
        float yv[32];
        {
            const float* yb = Y + cidx(g * 64 + hl * 32, t);
#pragma unroll
            for (int i = 0; i < 32; ++i) yv[i] = yb[i * 32];
        }
        const bf16_t* ab = att + (size_t)t * 512 + g * 128 + hl * 64;
        float sa = 0.f;
#pragma unroll
        for (int q = 0; q < 8; ++q) {
            const u32x4 a = *(const u32x4*)(ab + 8 * q);
            const float x0 = bflo(a.x), x1 = bfhi(a.x), x2 = bflo(a.y), x3 = bfhi(a.y), x4 = bflo(a.z), x5 = bfhi(a.z), x6 = bflo(a.w), x7 = bfhi(a.w);
            sa += x0 * x0 + x1 * x1 + x2 * x2 + x3 * x3 + x4 * x4 + x5 * x5 + x6 * x6 + x7 * x7;
        }
        __syncthreads();
        f32x16 acc0 = zero16(), acc1 = zero16();
        {
            const float* fa = FMl + (g * 128 + hl) * 64 + l31;
#pragma unroll
            for (int i = 0; i < 64; ++i) {
                const float a0 = fa[(2 * i) * 64], a1 = fa[(2 * i) * 64 + 32];
                acc0 = __builtin_amdgcn_mfma_f32_32x32x2f32(a0, bv[i], acc0, 0, 0, 0);
                acc1 = __builtin_amdgcn_mfma_f32_32x32x2f32(a1, bv[i], acc1, 0, 0, 0);
            }
        }
        float sf = 0.f;
#pragma unroll
        for (int i = 0; i < 4; ++i) {
            const f32x4 b0 = *(const f32x4*)(fb + 8 * i + 4 * hl), b1 = *(const f32x4*)(fb + 32 + 8 * i + 4 * hl);
            acc0[4 * i] += b0.x; acc0[4 * i + 1] += b0.y; acc0[4 * i + 2] += b0.z; acc0[4 * i + 3] += b0.w;
            acc1[4 * i] += b1.x; acc1[4 * i + 1] += b1.y; acc1[4 * i + 2] += b1.z; acc1[4 * i + 3] += b1.w;
        }
#pragma unroll
        for (int r = 0; r < 16; ++r) sf += acc0[r] * acc0[r] + acc1[r] * acc1[r];
        float sy = 0.f;
#pragma unroll
        for (int i = 0; i < 32; ++i) sy += yv[i] * yv[i];
        ex[(0 * 8 + wave) * 64 + lane] = sa; ex[(1 * 8 + wave) * 64 + lane] = sy; ex[(2 * 8 + wave) * 64 + lane] = sf;
        __syncthreads();
        float ta = 0.f, ty = 0.f, tf = 0.f;
#pragma unroll
        for (int w = 0; w < 4; ++w)
#pragma unroll
            for (int hh = 0; hh < 2; ++hh) {
                const int o = (tsel * 4 + w) * 64 + hh * 32 + l31;
                ta += ex[0 * 512 + o]; ty += ex[1 * 512 + o]; tf += ex[2 * 512 + o];
            }
        const float ra = rsqrtf(ta * (1.0f / 512.0f) + EPS), ry = rsqrtf(ty * (1.0f / 256.0f) + EPS), rf = rsqrtf(tf * (1.0f / 256.0f) + EPS);
        bf16_t* mrow = mix + (size_t)t * 1024;
        {
            const float* gg = mg + g * 128 + hl * 64;
#pragma unroll
            for (int q = 0; q < 8; ++q) {
                const u32x4 a = *(const u32x4*)(ab + 8 * q);
                const f32x4 g0 = *(const f32x4*)(gg + 8 * q), g1 = *(const f32x4*)(gg + 8 * q + 4);
                u32x4 o;
                o.x = pk2(bflo(a.x) * ra * g0.x, bfhi(a.x) * ra * g0.y); o.y = pk2(bflo(a.y) * ra * g0.z, bfhi(a.y) * ra * g0.w);
                o.z = pk2(bflo(a.z) * ra * g1.x, bfhi(a.z) * ra * g1.y); o.w = pk2(bflo(a.w) * ra * g1.z, bfhi(a.w) * ra * g1.w);
                *(u32x4*)(mrow + g * 128 + hl * 64 + 8 * q) = o;
            }
        }
        {
            const float* gg = mg + 512 + g * 64 + hl * 32;
#pragma unroll
            for (int q = 0; q < 4; ++q) {
                const f32x4 g0 = *(const f32x4*)(gg + 8 * q), g1 = *(const f32x4*)(gg + 8 * q + 4);
                u32x4 o;
                o.x = pk2(yv[8 * q] * ry * g0.x, yv[8 * q + 1] * ry * g0.y); o.y = pk2(yv[8 * q + 2] * ry * g0.z, yv[8 * q + 3] * ry * g0.w);
                o.z = pk2(yv[8 * q + 4] * ry * g1.x, yv[8 * q + 5] * ry * g1.y); o.w = pk2(yv[8 * q + 6] * ry * g1.z, yv[8 * q + 7] * ry * g1.w);
                *(u32x4*)(mrow + 512 + g * 64 + hl * 32 + 8 * q) = o;
            }
        }
        {
            const float* gg = mg + 768 + g * 64;
#pragma unroll
            for (int i = 0; i < 4; ++i) {
                const f32x4 g0 = *(const f32x4*)(gg + 8 * i + 4 * hl), g1 = *(const f32x4*)(gg + 32 + 8 * i + 4 * hl);
                u32x2 o0, o1;
                o0.x = pk2(acc0[4 * i] * rf * g0.x, acc0[4 * i + 1] * rf * g0.y); o0.y = pk2(acc0[4 * i + 2] * rf * g0.z, acc0[4 * i + 3] * rf * g0.w);
                o1.x = pk2(acc1[4 * i] * rf * g1.x, acc1[4 * i + 1] * rf * g1.y); o1.y = pk2(acc1[4 * i + 2] * rf * g1.z, acc1[4 * i + 3] * rf * g1.w);
                *(u32x2*)(mrow + 768 + g * 64 + 8 * i + 4 * hl) = o0;
                *(u32x2*)(mrow + 768 + g * 64 + 32 + 8 * i + 4 * hl) = o1;
            }
        }
    }
}

__device__ __forceinline__ float tk_pack(float v, unsigned code, unsigned mask) { return __builtin_bit_cast(float, (__builtin_bit_cast(unsigned, v) & ~mask) | code); }
__device__ __forceinline__ unsigned tk_lookup(const unsigned (&P)[4], unsigned i) {
    const unsigned w = (i < 4u) ? P[0] : (i < 8u) ? P[1] : (i < 12u) ? P[2] : P[3];
    return (w >> ((i & 3u) * 8u)) & 0x7Fu;
}
__device__ __forceinline__ float gelu_exact(float x) { return 0.5f * x * (1.0f + erff(x * 0.70710678118654752f)); }
typedef float f32x2 __attribute__((ext_vector_type(2)));
#define CVT_LO(W) __builtin_amdgcn_cvt_pk_f32_fp8((int)(W), false)
#define CVT_HI(W) __builtin_amdgcn_cvt_pk_f32_fp8((int)(W), true)


__device__ __forceinline__ void tk_sort16(float (&a)[16]) {
#pragma unroll
    for (int k = 2; k <= 16; k <<= 1)
#pragma unroll
        for (int j = k >> 1; j > 0; j >>= 1)
#pragma unroll
            for (int i = 0; i < 16; ++i) {
                const int l = i ^ j;
                if (l > i) {
                    const float hi = fmaxf(a[i], a[l]), lo = fminf(a[i], a[l]);
                    if ((i & k) == 0) { a[i] = hi; a[l] = lo; } else { a[i] = lo; a[l] = hi; }
                }
            }
}
__device__ __forceinline__ void tk_merge16(float (&a)[16]) {
#pragma unroll
    for (int j = 8; j > 0; j >>= 1)
#pragma unroll
        for (int i = 0; i < 16; ++i) {
            const int l = i ^ j;
            if (l > i) { const float hi = fmaxf(a[i], a[l]), lo = fminf(a[i], a[l]); a[i] = hi; a[l] = lo; }
        }
}
__device__ __forceinline__ void tk_top16_merge(float (&l)[16], const float (&g)[16]) {
#pragma unroll
    for (int i = 0; i < 16; ++i) l[i] = fmaxf(l[i], g[15 - i]);
    tk_merge16(l);
}
template <int CTRL> __device__ __forceinline__ float dpp_f(float v) { return __builtin_bit_cast(float, __builtin_amdgcn_update_dpp(0, __builtin_bit_cast(int, v), CTRL, 0xF, 0xF, false)); }
constexpr int PE_LOGR = 4, PE_NR = 1 << PE_LOGR;
constexpr int PE_ENT = 12 * 1024;
constexpr int PE_WAVE = PE_ENT;


#define PE_RL(k) (((k & 4) << 1) | ((k & 2) << 3) | ((k & 1) << 5))
#define PE_LOAD_U(TK, RW, EV, CU, CG) do { \
        const int base_ = ((TK) * 128 + r * 8 + eid) * 3; \
        EV = ent[base_]; CU = __builtin_bit_cast(float, ent[base_ + 1]); CG = __builtin_bit_cast(float, ent[base_ + 2]); \
        _Pragma("unroll") for (int k = 0; k < 8; ++k) { const unsigned e = (unsigned)__builtin_amdgcn_readlane(EV, PE_RL(k)); \
            RW[k] = *(const u32x4*)(PU + (size_t)(e * 1024u) + loff); } \
    } while (0)
#define PE_COMP_U(TK, RW, CU, CG) do { \
        f32x2 xl[8]; \
        _Pragma("unroll") for (int j = 0; j < 4; ++j) { xl[2 * j] = (f32x2){bflo(xp[TK][j].x), bfhi(xp[TK][j].x)}; xl[2 * j + 1] = (f32x2){bflo(xp[TK][j].y), bfhi(xp[TK][j].y)}; } \
        float d[8]; \
        _Pragma("unroll") for (int k = 0; k < 8; ++k) { f32x2 s2 = CVT_LO(RW[k].x) * xl[0]; \
            s2 += CVT_HI(RW[k].x) * xl[1]; s2 += CVT_LO(RW[k].y) * xl[2]; s2 += CVT_HI(RW[k].y) * xl[3]; \
            s2 += CVT_LO(RW[k].z) * xl[4]; s2 += CVT_HI(RW[k].z) * xl[5]; s2 += CVT_LO(RW[k].w) * xl[6]; s2 += CVT_HI(RW[k].w) * xl[7]; \
            d[k] = s2.x + s2.y; } \
        _Pragma("unroll") for (int k = 0; k < 8; ++k) { d[k] += dpp_f<0xB1>(d[k]); d[k] += dpp_f<0x4E>(d[k]); d[k] += dpp_f<0x141>(d[k]); } \
        float r4[4], r2[2], u1; \
        _Pragma("unroll") for (int k = 0; k < 4; ++k) { const float send = b3 ? d[k] : d[k + 4], keep = b3 ? d[k + 4] : d[k]; r4[k] = keep + dpp_f<0x140>(send); } \
        _Pragma("unroll") for (int k = 0; k < 2; ++k) { const float send = b4 ? r4[k] : r4[k + 2], keep = b4 ? r4[k + 2] : r4[k]; r2[k] = keep + __shfl_xor(send, 16); } \
        { const float send = b5 ? r2[0] : r2[1], keep = b5 ? r2[1] : r2[0]; u1 = keep + __shfl_xor(send, 32); } \
        const float av = gelu_exact(u1 * CU) * CG; \
        if ((lane & 7) == 0) ent[((TK) * 128 + r * 8 + eid) * 3 + 1] = __builtin_bit_cast(int, av);     \
    } while (0)
#define PE_LOAD_V(TK, RW, AV) do { \
        const int base_ = ((TK) * 128 + r * 8 + eid) * 3; \
        const int ev = ent[base_]; AV = ent[base_ + 1]; \
        _Pragma("unroll") for (int k = 0; k < 8; ++k) { const unsigned e = (unsigned)__builtin_amdgcn_readlane(ev, PE_RL(k)); \
            RW[k] = *(const u32x4*)(PV + (size_t)(e * 1024u) + loff); } \
    } while (0)
#define PE_COMP_V(TK, RW, AV) do { \
        _Pragma("unroll") for (int k = 0; k < 8; ++k) { \
            const float a = __builtin_bit_cast(float, __builtin_amdgcn_readlane(AV, PE_RL(k))); \
            const f32x2 a2 = (f32x2){a, a}; \
            acc[TK][0] += a2 * CVT_LO(RW[k].x); acc[TK][1] += a2 * CVT_HI(RW[k].x); acc[TK][2] += a2 * CVT_LO(RW[k].y); acc[TK][3] += a2 * CVT_HI(RW[k].y); \
            acc[TK][4] += a2 * CVT_LO(RW[k].z); acc[TK][5] += a2 * CVT_HI(RW[k].z); acc[TK][6] += a2 * CVT_LO(RW[k].w); acc[TK][7] += a2 * CVT_HI(RW[k].w); } \
    } while (0)

template <bool DRY> __device__ __forceinline__ void phase_peer_fused(const Params& p, int layer, char* lds) {
    const int tid = otid(), lane = tid & 63, wave = tid >> 6;
    const unsigned char* PU = p.ws + OFF_PU + (size_t)layer * 16384 * 1024;
    const unsigned char* PV = p.ws + OFF_PV + (size_t)layer * 16384 * 1024;
    const float* SU = (const float*)(p.ws + OFF_PSC) + (size_t)layer * 16384;
    const float* SV = (const float*)(p.ws + OFF_PSC) + (size_t)(2 + layer) * 16384;
    bf16_t* XN = (bf16_t*)(p.ws + R_XN);
    float* XA = (float*)(p.ws + OFF_XA);
    const _Float16* SC = (const _Float16*)(p.ws + R_QP);
    const bool last = (layer == NLAYER - 1);
    const float* gnext = last ? p.in[I_FG] : p.in[I_N1G] + (layer + 1) * DM;
    const float* g2p = p.in[I_N2G] + layer * DM;
    const bool b5 = (lane & 32) != 0, b4 = (lane & 16) != 0, b3 = (lane & 8) != 0;
    const int eid = ((lane >> 3) & 1) * 4 + ((lane >> 4) & 1) * 2 + (lane >> 5);
    const unsigned loff = (unsigned)lane * 16u;
    int* ent = (int*)(lds + wave * PE_WAVE);
    const float NINF = -3.0e38f;
    const int pp = lane & 1;
    for (int tb = (obid() * NWAVE + wave) * 8; tb < T; tb += NBLK * NWAVE * 8) {
#pragma unroll 1
        for (int grp = 0; grp < 2; ++grp) {
            const int tkl = grp * 4 + (lane >> 4), h = (lane >> 1) & 7;
            const f16x8* src = (const f16x8*)(SC + (size_t)(tb + tkl) * 2048 + h * 256 + pp * 128);
            float l[16];
#pragma unroll
            for (int i = 0; i < 16; ++i) l[i] = NINF;
#pragma unroll 1
            for (int c = 0; c < 4; ++c) {
                f32x4 v[8];
#pragma unroll
                for (int j = 0; j < 4; ++j) {
                    const f16x8 hv = src[c * 4 + j];
                    v[2 * j] = (f32x4){(float)hv[0], (float)hv[1], (float)hv[2], (float)hv[3]};
                    v[2 * j + 1] = (f32x4){(float)hv[4], (float)hv[5], (float)hv[6], (float)hv[7]};
                }
#pragma unroll
                for (int hh = 0; hh < 2; ++hh) {
                    float g[16];
#pragma unroll
                    for (int j = 0; j < 4; ++j) {
                        const unsigned kb = (unsigned)(c * 32 + hh * 16 + j * 4);
                        g[4 * j] = tk_pack(v[hh * 4 + j].x, kb, 0x7Fu); g[4 * j + 1] = tk_pack(v[hh * 4 + j].y, kb + 1u, 0x7Fu);
                        g[4 * j + 2] = tk_pack(v[hh * 4 + j].z, kb + 2u, 0x7Fu); g[4 * j + 3] = tk_pack(v[hh * 4 + j].w, kb + 3u, 0x7Fu);
                    }
                    tk_sort16(g);
                    tk_top16_merge(l, g);
                }
            }
            float xw[16], ow[16]; unsigned PX[4] = {0u, 0u, 0u, 0u}, PO[4] = {0u, 0u, 0u, 0u};
#pragma unroll
            for (int i = 0; i < 16; ++i) {
                const float o = __shfl_xor(l[i], 1);
                const unsigned xb = __builtin_bit_cast(unsigned, l[i]), ob = __builtin_bit_cast(unsigned, o);
                xw[i] = __builtin_bit_cast(float, xb & ~0x7Fu); ow[i] = __builtin_bit_cast(float, ob & ~0x7Fu);
                PX[i >> 2] |= (xb & 0x7Fu) << ((i & 3) * 8); PO[i >> 2] |= (ob & 0x7Fu) << ((i & 3) * 8);
            }
            float f[16];
            {
                float c1[16];
#pragma unroll
                for (int i = 0; i < 16; ++i) { f[i] = NINF; c1[i] = NINF; }
                int cnt = 0;
#pragma unroll
                for (int i = 0; i < 16; ++i)
#pragma unroll
                    for (int j = i; j < 16; ++j)
                        if ((i + 1) * (j + 1) <= 16) {
                            float cv = xw[i] + ow[j];
                            const unsigned code = pp ? (unsigned)((j << 4) | i) : (unsigned)((i << 4) | j);
                            cv = tk_pack(cv, code, 0xFFu);
                            if (i == j) cv = pp ? NINF : cv;
                            if (cnt < 16) f[cnt & 15] = cv; else c1[cnt & 15] = cv;
                            ++cnt;
                        }
                tk_sort16(f); tk_sort16(c1);
                tk_top16_merge(f, c1);
                float gq[16];
#pragma unroll
                for (int i = 0; i < 16; ++i) gq[i] = __shfl_xor(f[i], 1);
                tk_top16_merge(f, gq);
            }
            unsigned P0[4], P1[4];
#pragma unroll
            for (int q = 0; q < 4; ++q) { P0[q] = pp ? PO[q] : PX[q]; P1[q] = pp ? PX[q] : PO[q]; }
            const float top = __builtin_bit_cast(float, __builtin_bit_cast(unsigned, f[0]) & ~0xFFu);
            float ev[16]; float den = 0.f;
#pragma unroll
            for (int r = 0; r < 16; ++r) { ev[r] = __expf(__builtin_bit_cast(float, __builtin_bit_cast(unsigned, f[r]) & ~0xFFu) - top); den += ev[r]; }
            const float rden = 1.0f / den;
#pragma unroll
            for (int r8 = 0; r8 < 8; ++r8) {
                const unsigned c0 = __builtin_bit_cast(unsigned, f[r8]) & 0xFFu, c1 = __builtin_bit_cast(unsigned, f[r8 + 8]) & 0xFFu;
                const unsigned code = pp ? c1 : c0;
                const float gate = (pp ? ev[r8 + 8] : ev[r8]) * rden;
                const int e = (int)(tk_lookup(P0, code >> 4) * 128u + tk_lookup(P1, code & 15u));
                const int o = (tkl * 128 + h * 16 + pp * 8 + r8) * 3;
                ent[o] = e; ent[o + 1] = __builtin_bit_cast(int, SU[e]); ent[o + 2] = __builtin_bit_cast(int, gate * SV[e]);
            }
        }
#pragma unroll 1
        for (int tk = 0; tk < 8; ++tk) {
            int* et = ent + tk * 384;
            const int eA = et[lane * 3], uA = et[lane * 3 + 1], gA = et[lane * 3 + 2];
            const int eB = et[(64 + lane) * 3], uB = et[(64 + lane) * 3 + 1], gB = et[(64 + lane) * 3 + 2];
            const int rA = eA >> (14 - PE_LOGR), rB = eB >> (14 - PE_LOGR);
            int base = 0;
#pragma unroll 1
            for (int r = 0; r < PE_NR; ++r) {
                const unsigned long long mA = __ballot(rA == r), mB = __ballot(rB == r);
                const int cA = __popcll(mA);
                if (rA == r) { const int q = base + (int)__builtin_amdgcn_mbcnt_hi((unsigned)(mA >> 32), __builtin_amdgcn_mbcnt_lo((unsigned)mA, 0u)); et[q * 3] = eA; et[q * 3 + 1] = uA; et[q * 3 + 2] = gA; }
                if (rB == r) { const int q = base + cA + (int)__builtin_amdgcn_mbcnt_hi((unsigned)(mB >> 32), __builtin_amdgcn_mbcnt_lo((unsigned)mB, 0u)); et[q * 3] = eB; et[q * 3 + 1] = uB; et[q * 3 + 2] = gB; }
                base += cA + __popcll(mB);
            }
        }
        {
            {
                u32x2 xp[8][4];
#pragma unroll
                for (int tk = 0; tk < 8; ++tk) {
                    f32x4 xr[4]; float ss = 0.f;
#pragma unroll
                    for (int j = 0; j < 4; ++j) { xr[j] = *(const f32x4*)(XA + (size_t)(tb + tk) * DM + 4 * lane + 256 * j); ss += xr[j].x * xr[j].x + xr[j].y * xr[j].y + xr[j].z * xr[j].z + xr[j].w * xr[j].w; }
                    ss = wave_sum(ss);
                    const float rn = rsqrtf(ss * (1.0f / DM) + EPS);
#pragma unroll
                    for (int j = 0; j < 4; ++j) { const f32x4 gg = *(const f32x4*)(g2p + 4 * lane + 256 * j);
                        xp[tk][j].x = pk2(xr[j].x * rn * gg.x, xr[j].y * rn * gg.y); xp[tk][j].y = pk2(xr[j].z * rn * gg.z, xr[j].w * rn * gg.w); }
                }
#pragma unroll 1
                for (int r = 0; r < 16; ++r) {
                    __syncthreads();
                    u32x4 rwA[8]; int evA; float cuA, cgA;
                    PE_LOAD_U(0, rwA, evA, cuA, cgA); PE_COMP_U(0, rwA, cuA, cgA);
                    PE_LOAD_U(1, rwA, evA, cuA, cgA); PE_COMP_U(1, rwA, cuA, cgA);
                    PE_LOAD_U(2, rwA, evA, cuA, cgA); PE_COMP_U(2, rwA, cuA, cgA);
                    PE_LOAD_U(3, rwA, evA, cuA, cgA); PE_COMP_U(3, rwA, cuA, cgA);
                    PE_LOAD_U(4, rwA, evA, cuA, cgA); PE_COMP_U(4, rwA, cuA, cgA);
                    PE_LOAD_U(5, rwA, evA, cuA, cgA); PE_COMP_U(5, rwA, cuA, cgA);
                    PE_LOAD_U(6, rwA, evA, cuA, cgA); PE_COMP_U(6, rwA, cuA, cgA);
                    PE_LOAD_U(7, rwA, evA, cuA, cgA); PE_COMP_U(7, rwA, cuA, cgA);
                }
            }
#pragma unroll 1
            for (int hv = 0; hv < 2; ++hv) {
            f32x2 acc[4][8];
#pragma unroll
            for (int tk = 0; tk < 4; ++tk)
#pragma unroll
                for (int j = 0; j < 8; ++j) acc[tk][j] = (f32x2){0.f, 0.f};
            const int* entv = ent;
            {
                int* ent = (int*)entv + hv * 4 * 128 * 3;
#pragma unroll 1
                for (int r = 0; r < 16; ++r) {
                    __syncthreads();
                    u32x4 rwA[8], rwB[8]; int avA, avB;
                    PE_LOAD_V(0, rwA, avA);
                    PE_LOAD_V(1, rwB, avB); PE_COMP_V(0, rwA, avA);
                    PE_LOAD_V(2, rwA, avA); PE_COMP_V(1, rwB, avB);
                    PE_LOAD_V(3, rwB, avB); PE_COMP_V(2, rwA, avA);
                    PE_COMP_V(3, rwB, avB);
                }
            }
#pragma unroll
            for (int tk = 0; tk < 4; ++tk) {
                const int t = tb + hv * 4 + tk;
                f32x4 x[4]; float ss = 0.f;
#pragma unroll
                for (int j = 0; j < 4; ++j) {
                    x[j] = *(const f32x4*)(XA + (size_t)t * DM + 4 * lane + 256 * j);
                    x[j].x += acc[tk][2 * j].x; x[j].y += acc[tk][2 * j].y; x[j].z += acc[tk][2 * j + 1].x; x[j].w += acc[tk][2 * j + 1].y;
                    ss += x[j].x * x[j].x + x[j].y * x[j].y + x[j].z * x[j].z + x[j].w * x[j].w;
                }
                ss = wave_sum(ss);
                const float rr = rsqrtf(ss * (1.0f / DM) + EPS);
                if (last) {
#pragma unroll
                    for (int j = 0; j < 4; ++j) { const f32x4 gg = *(const f32x4*)(gnext + 4 * lane + 256 * j); *(f32x4*)(p.out + (size_t)t * DM + 4 * lane + 256 * j) = x[j] * rr * gg; }
                } else {
#pragma unroll
                    for (int j = 0; j < 4; ++j) {
                        const f32x4 gg = *(const f32x4*)(gnext + 4 * lane + 256 * j);
                        *(f32x4*)((DRY ? p.out : XA) + (size_t)t * DM + 4 * lane + 256 * j) = x[j];
                        u32x2 w; w.x = pk2(x[j].x * rr * gg.x, x[j].y * rr * gg.y); w.y = pk2(x[j].z * rr * gg.z, x[j].w * rr * gg.w);
                        if (!DRY) *(u32x2*)(XN + (size_t)t * DM + 4 * lane + 256 * j) = w;
                    }
                }
            }
            }
        }
    }
}

#define LAS __attribute__((address_space(3)))
#define XB_TMO      128
#define XB_XCNT(j)  (256  + 64 * (j))
#define XB_XSUB(j)  (1280 + 64 * (j))
#define XB_XGEN(j)  (2304 + 64 * (j))
#define XB_TOP      3328
#define XB_TOPGEN   3392
#define XCD_BAR_WORDS 3456
#define XB_SPIN_CAP (1u << 20)
__device__ __forceinline__ unsigned xb_ld(unsigned* p)              { return __hip_atomic_load(p, __ATOMIC_RELAXED, __HIP_MEMORY_SCOPE_AGENT); }
__device__ __forceinline__ unsigned xb_add(unsigned* p, unsigned v) { return __hip_atomic_fetch_add(p, v, __ATOMIC_RELAXED, __HIP_MEMORY_SCOPE_AGENT); }
__device__ __forceinline__ unsigned xb_xcc_id() { return (unsigned)__builtin_amdgcn_s_getreg((3 << 11) | 20) & 0xFu; }
#define XB_SPIN(cond, bar) do { unsigned _sp = 0; while (cond) { __builtin_amdgcn_s_sleep(1); \
    if ((++_sp & 255u) == 0u) { if (xb_ld(&(bar)[XB_TMO])) break; if (_sp > XB_SPIN_CAP) { atomicAdd(&(bar)[XB_TMO], 1u); break; } } } } while (0)
struct XcdBarrier { unsigned* bar; unsigned x; volatile LAS unsigned* st; };
__device__ __forceinline__ XcdBarrier xcd_barrier_post(unsigned* bar, volatile LAS unsigned* st) {
    XcdBarrier b; b.bar = bar; b.x = xb_xcc_id(); b.st = st;
    if (threadIdx.x == 0) (void)xb_add(&bar[XB_XCNT(b.x)], 1u);
    return b;
}
__device__ __forceinline__ void xcd_barrier_complete(unsigned* bar, unsigned x, unsigned& nloc, unsigned& nx) {
    const unsigned G = NBLK;
    unsigned sum, cnt, mine, sp = 0u;
    for (;;) {
        sum = 0u; cnt = 0u; mine = 0u;
#pragma unroll
        for (unsigned j = 0; j < 16; ++j) { const unsigned c = xb_ld(&bar[XB_XCNT(j)]); sum += c; cnt += (c > 0u) ? 1u : 0u; mine = (j == x) ? c : mine; }
        if (sum == G) break;
        __builtin_amdgcn_s_sleep(1);
        if ((++sp & 255u) == 0u) { if (xb_ld(&bar[XB_TMO])) break; if (sp > XB_SPIN_CAP) { atomicAdd(&bar[XB_TMO], 1u); break; } }
    }
    nloc = mine > 0u ? mine : 1u; nx = cnt > 0u ? cnt : 1u;
}
__device__ __forceinline__ void xcd_barrier(const XcdBarrier& b) {
    asm volatile("s_waitcnt vmcnt(0)" ::: "memory");
    __syncthreads();
    if (threadIdx.x == 0) {
        unsigned* bar = b.bar;
        __builtin_amdgcn_s_waitcnt(0);
        unsigned nloc = b.st[0], nx = b.st[1];
        if (nloc == 0u) { xcd_barrier_complete(bar, b.x, nloc, nx); b.st[0] = nloc; b.st[1] = nx; }
        const unsigned old = xb_add(&bar[XB_XSUB(b.x)], 1u);
        const unsigned gen = old / nloc;
        if (old + 1u == (gen + 1u) * nloc) {
            __builtin_amdgcn_fence(__ATOMIC_RELEASE, "agent");
            asm volatile("s_waitcnt vmcnt(0)" ::: "memory");
            const unsigned og = xb_add(&bar[XB_TOP], 1u);
            const unsigned tg = og / nx;
            if (og + 1u == (tg + 1u) * nx) xb_add(&bar[XB_TOPGEN], 1u);
            else XB_SPIN(xb_ld(&bar[XB_TOPGEN]) == tg, bar);
            __builtin_amdgcn_fence(__ATOMIC_ACQUIRE, "agent");
            xb_add(&bar[XB_XGEN(b.x)], 1u);
            asm volatile("s_waitcnt vmcnt(0)" ::: "memory");
        } else {
            XB_SPIN(xb_ld(&bar[XB_XGEN(b.x)]) == gen, bar);
            __builtin_amdgcn_fence(__ATOMIC_ACQUIRE, "agent");
            asm volatile("s_waitcnt vmcnt(0)" ::: "memory");
        }
    }
    __syncthreads();
}


template <class Epi> __device__ __forceinline__ void big_gemm(const bf16_t* A, const bf16_t* Bt, int M, int N, int K, char* lds, const Epi& e) {
    pg8::Gemm g{A, Bt, M, N, K}; pg8::StaticOrder S; S.init(M, N, NBLK, obid());
    pg8::gemm_phase<Epi, pg8::StaticOrder, true, true>((PG8_LAS unsigned char*)lds, g, S, e);
}

#define GSYNC() xcd_barrier(xbar)
template <int layer> __device__ __forceinline__ void run_layer(const Params& p, char* lds, const XcdBarrier& xbar) {
    float* XA = (float*)(p.ws + OFF_XA);

        const float* xin = layer == 0 ? p.in[I_X] : XA;
        {
            const bf16_t* wt = (const bf16_t*)(p.ws + OFF_WTIN) + (size_t)layer * INC * DM;
            pg8::EpiStoreBf16 e1{(bf16_t*)(p.ws + R_QKV), 768};
            big_gemm((const bf16_t*)(p.ws + R_XN), wt, T, 768, DM, lds, e1);
            pg8::EpiStoreF32 e2{nullptr, (float*)(p.ws + R_HF), T};
            big_gemm(wt + (size_t)768 * DM, (const bf16_t*)(p.ws + R_XN), 1024, T, DM, lds, e2);
        }
        if (layer == 0) {
#pragma nounroll
            for (int fl = 0; fl < NLAYER; ++fl) {
                EpiF32 e{(float*)(p.ws + (fl ? OFF_HFILT1 : OFF_HFILT0)), SL};
                gemm_simple((const bf16_t*)(p.ws + OFF_W3T) + (size_t)fl * 1024 * 64, (const bf16_t*)(p.ws + OFF_H2) + (size_t)fl * SL * 64, 1024, SL, 64, lds, e);
            }
        }
        GSYNC();
        if (layer == 0) {
            phase_filter_spectra(p, lds);
        }
        phase_qkprep(p, layer, lds, (bf16_t*)(p.ws + R_QKV)); GSYNC();
        {
            phase_attn(p, layer, lds);
            for (int c = obid(); c < 256; c += NBLK) hyena_job(p, layer, c, lds);
            for (int c = obid(); c < 256; c += NBLK) fnet_job(p, c, lds);
        } GSYNC();
        phase_mix(p, layer, lds); GSYNC();
        { pg8::EpiOutProj e{xin, XA, (bf16_t*)(p.ws + R_XN), (float*)(p.ws + OFF_RS)};
          big_gemm((const bf16_t*)(p.ws + R_MIX), (const bf16_t*)(p.ws + OFF_WTOUT) + (size_t)layer * DM * DM, T, DM, DM, lds, e); } GSYNC();
        { pg8::EpiRowScaleF16 e{(_Float16*)(p.ws + R_QP), 2048, (const float*)(p.ws + OFF_RS)};
          big_gemm((const bf16_t*)(p.ws + R_XN), (const bf16_t*)(p.ws + OFF_WTQ) + (size_t)layer * 2048 * DM, T, 2048, DM, lds, e); } GSYNC();
        phase_peer_fused<false>(p, layer, lds);
        if (layer + 1 < NLAYER) GSYNC();
}

__global__ void __launch_bounds__(NTHR) mega_kernel(Params p) {
    extern __shared__ __attribute__((aligned(16))) char lds[];
    volatile LAS unsigned* misc = (volatile LAS unsigned*)((LAS char*)lds + LDS_MISC);
    if (threadIdx.x < 16) misc[threadIdx.x] = 0u;
    __syncthreads();
    const XcdBarrier xbar = xcd_barrier_post((unsigned*)(p.ws + OFF_CTL) + 4096, misc);
    float* XA = (float*)(p.ws + OFF_XA);
    phase_p0(p, lds);
    phase_rmsnorm_bf16(p.in[I_X], p.in[I_N1G], (bf16_t*)(p.ws + R_XN));
    GSYNC();
    run_layer<0>(p, lds, xbar);
    run_layer<1>(p, lds, xbar);
}

extern "C" void kernel_launch(void* const* d_in, const int* in_sizes, int n_in, void* d_out, int out_size, void* d_ws, size_t ws_size, hipStream_t stream) {
    static int grid = 0;
    if (grid == 0) {
        if (n_in != 25 || out_size != T * DM || ws_size < WS_NEED) { fprintf(stderr, "kernel_launch: unexpected sizes n_in %d out %d ws %zu (need %zu)\n", n_in, out_size, ws_size, (size_t)WS_NEED); grid = -1; return; }
        int dev = 0, cus = 0, per_cu = 0;
        if (hipGetDevice(&dev) != hipSuccess || hipDeviceGetAttribute(&cus, hipDeviceAttributeMultiprocessorCount, dev) != hipSuccess) { grid = -1; return; }
        if (hipFuncSetAttribute((const void*)mega_kernel, hipFuncAttributeMaxDynamicSharedMemorySize, LDS_BYTES) != hipSuccess) { fprintf(stderr, "kernel_launch: hipFuncSetAttribute failed\n"); grid = -1; return; }
        if (hipOccupancyMaxActiveBlocksPerMultiprocessor(&per_cu, (const void*)mega_kernel, NTHR, LDS_BYTES) != hipSuccess || per_cu < 1) { fprintf(stderr, "kernel_launch: occupancy query says %d blocks per CU\n", per_cu); grid = -1; return; }
        (void)hipGetLastError();
        if (cus < NBLK) { fprintf(stderr, "kernel_launch: built for a %d-CU device, found %d CUs\n", NBLK, cus); grid = -1; return; }
        grid = NBLK;
    }
    if (grid < 0) return;
    Params p{};
    for (int i = 0; i < 25; ++i) p.in[i] = (const float*)d_in[i];
    p.out = (float*)d_out; p.ws = (unsigned char*)d_ws;
    if (hipMemsetAsync((char*)d_ws + OFF_CTL, 0, 64 * 1024, stream) != hipSuccess) { fprintf(stderr, "kernel_launch: memset failed\n"); return; }
    void* args[] = {&p};
    hipError_t e = hipLaunchCooperativeKernel((const void*)mega_kernel, dim3(grid), dim3(NTHR), args, LDS_BYTES, stream);
    if (e != hipSuccess) fprintf(stderr, "cooperative launch failed: %s (grid %d)\n", hipGetErrorString(e), grid);
}
```

```cpp
#include <hip/hip_runtime.h>
#include <cstdio>
#include <cstdint>

typedef unsigned short bf16_t;
typedef short bf16x8 __attribute__((ext_vector_type(8)));
typedef float f32x16 __attribute__((ext_vector_type(16)));
typedef float f32x4 __attribute__((ext_vector_type(4)));
typedef unsigned u32x4 __attribute__((ext_vector_type(4)));
typedef unsigned u32x2 __attribute__((ext_vector_type(2)));
typedef _Float16 f16x4 __attribute__((ext_vector_type(4)));
typedef _Float16 f16x8 __attribute__((ext_vector_type(8)));

constexpr int DM = 1024, NB = 2, SL = 8192, T = NB * SL, NLAYER = 2;
constexpr int INC = 1792;
constexpr int NTHR = 512, NWAVE = 8;
constexpr int NBLK = 256;
constexpr int LDS_BYTES = 147456;
constexpr int LDS_MISC = LDS_BYTES - 64;
constexpr float EPS = 1e-6f;

constexpr size_t MiB = 1u << 20;
constexpr size_t OFF_CTL = 0;
constexpr size_t OFF_WTIN = 1 * MiB;
constexpr size_t OFF_WTOUT = 8 * MiB;
constexpr size_t OFF_WTQ = 12 * MiB;
constexpr size_t OFF_PU = 20 * MiB;
constexpr size_t OFF_PV = 84 * MiB;
constexpr size_t OFF_RS = 505 * MiB;
constexpr size_t OFF_PSC = 512 * 1024;
constexpr size_t OFF_H2 = 148 * MiB;
constexpr size_t OFF_W3T = 150 * MiB;
constexpr size_t OFF_HFILT0 = 52 * MiB, OFF_HFILT1 = 116 * MiB;
constexpr size_t OFF_FM = 152 * MiB;
constexpr size_t OFF_KF = 153 * MiB;
constexpr size_t OFF_XA = 281 * MiB;
constexpr size_t OFF_R = 345 * MiB;
constexpr size_t R_XN = OFF_R + 0 * MiB;
constexpr size_t R_UR = OFF_R + 0 * MiB;
constexpr size_t R_UI = OFF_R + 16 * MiB;
constexpr size_t R_QKV = OFF_R + 32 * MiB;
constexpr size_t R_HF = OFF_R + 60 * MiB;
constexpr size_t R_MIX = OFF_R + 60 * MiB;
constexpr size_t R_ATT = OFF_R + 124 * MiB;
constexpr size_t R_Y = OFF_R + 140 * MiB;
constexpr size_t R_QP = OFF_R + 32 * MiB;
constexpr size_t WS_NEED = 506 * MiB;

struct Params {
    const float* in[25];
    float* out;
    unsigned char* ws;
};
enum { I_X = 0, I_N1G, I_WIN, I_QG, I_KG, I_CW, I_CB, I_W1, I_B1, I_F1, I_W2, I_B2, I_F2, I_W3, I_HB, I_FW, I_FB, I_MG, I_WOUT, I_N2G, I_WQ, I_SK, I_PU, I_PV, I_FG };

__device__ __forceinline__ unsigned f2bf(float f) { unsigned u = __builtin_bit_cast(unsigned, f); return (u + 0x7fffu + ((u >> 16) & 1u)) >> 16; }
__device__ __forceinline__ unsigned pk2(float lo, float hi) { return f2bf(lo) | (f2bf(hi) << 16); }
__device__ __forceinline__ float bflo(unsigned w) { return __builtin_bit_cast(float, w << 16); }
__device__ __forceinline__ float bfhi(unsigned w) { return __builtin_bit_cast(float, w & 0xffff0000u); }
__device__ __forceinline__ float wave_sum(float v) {
#pragma unroll
    for (int o = 1; o < 64; o <<= 1) v += __shfl_xor(v, o);
    return v;
}
__device__ __forceinline__ float wave_max(float v) {
#pragma unroll
    for (int o = 1; o < 64; o <<= 1) v = fmaxf(v, __shfl_xor(v, o));
    return v;
}
__device__ __forceinline__ unsigned pk_i8(f32x4 v) {
    const int a = (int)rintf(v.x), b = (int)rintf(v.y), c = (int)rintf(v.z), d = (int)rintf(v.w);
    return ((unsigned)a & 0xFFu) | (((unsigned)b & 0xFFu) << 8) | (((unsigned)c & 0xFFu) << 16) | ((unsigned)d << 24);
}
__device__ __forceinline__ f32x16 mfma32(bf16x8 a, bf16x8 b, f32x16 c) { return __builtin_amdgcn_mfma_f32_32x32x16_bf16(a, b, c, 0, 0, 0); }
__device__ __forceinline__ f32x16 zero16() { return (f32x16){0.f,0.f,0.f,0.f,0.f,0.f,0.f,0.f,0.f,0.f,0.f,0.f,0.f,0.f,0.f,0.f}; }


__device__ __forceinline__ int otid() { int t = threadIdx.x; asm volatile("" : "+v"(t)); return t; }
__device__ __forceinline__ int obid() { int b = blockIdx.x; asm volatile("" : "+s"(b)); return b; }
__device__ __forceinline__ void transpose_one(const float* W, int K, int N, bf16_t* Wt, float* tile, int item) {
    const int tid = otid();
    const int nblk = N / 64, kb = item / nblk, nb = item % nblk, k0 = kb * 64, n0 = nb * 64;
    __syncthreads();
    {
        const int r = tid >> 6, c = tid & 63;
#pragma unroll
        for (int i = 0; i < 8; ++i) { const int k = r + 8 * i; tile[k * 65 + c] = W[(size_t)(k0 + k) * N + n0 + c]; }
    }
    __syncthreads();
    {
        const int nn = tid >> 3, kc = tid & 7;
        const float* s = tile + (kc * 8) * 65 + nn;
        u32x4 o; o.x = pk2(s[0], s[65]); o.y = pk2(s[2 * 65], s[3 * 65]); o.z = pk2(s[4 * 65], s[5 * 65]); o.w = pk2(s[6 * 65], s[7 * 65]);
        *(u32x4*)(Wt + (size_t)(n0 + nn) * K + k0 + kc * 8) = o;
    }
}

template <int PARTS = 31> __device__ __forceinline__ void phase_p0(const Params& p, char* lds) {
    const int tid = otid();
    float* tile = (float*)lds;
    if (PARTS & 1) {
    constexpr int IT_IN = (DM / 64) * (INC / 64), IT_OUT = (DM / 64) * (DM / 64), IT_W3 = 1024 / 64;
    constexpr int IT_L = IT_IN + IT_OUT + IT_W3;
    for (int it = obid(); it < NLAYER * IT_L; it += NBLK) {
        const int layer = it / IT_L; int r = it % IT_L;
        if (r < IT_IN) { transpose_one(p.in[I_WIN] + (size_t)layer * DM * INC, DM, INC, (bf16_t*)(p.ws + OFF_WTIN) + (size_t)layer * INC * DM, tile, r); continue; }
        r -= IT_IN;
        if (r < IT_OUT) { transpose_one(p.in[I_WOUT] + (size_t)layer * DM * DM, DM, DM, (bf16_t*)(p.ws + OFF_WTOUT) + (size_t)layer * DM * DM, tile, r); continue; }
        r -= IT_OUT;
        transpose_one(p.in[I_W3] + (size_t)layer * 64 * 1024, 64, 1024, (bf16_t*)(p.ws + OFF_W3T) + (size_t)layer * 1024 * 64, tile, r);
    }
    }
    __syncthreads();
    if (PARTS & 2) {
        float* SKl = (float*)lds;
        float* Wl = SKl + 128 * 129;
        const int lane = tid & 63, wave = tid >> 6, l31 = lane & 31, hl = lane >> 5, mt = wave & 3, nt = wave >> 2;
        for (int it = obid(); it < NLAYER * 16 * 16; it += NBLK) {
            const int layer = it >> 8, hp = (it >> 4) & 15, kc = it & 15, h = hp >> 1, pp = hp & 1, k0 = kc * 64;
            const float* sk = p.in[I_SK] + (((size_t)(layer * 2 + pp) * 8 + h) * 128) * 128;
            const float* wq = p.in[I_WQ] + (size_t)layer * DM * 2048 + (size_t)k0 * 2048 + h * 256 + pp * 128;
            __syncthreads();
            for (int i = tid; i < 128 * 128; i += NTHR) SKl[(i >> 7) * 129 + (i & 127)] = sk[i];
            for (int i = tid; i < 64 * 128; i += NTHR) Wl[(i >> 7) * 129 + (i & 127)] = wq[(size_t)(i >> 7) * 2048 + (i & 127)];
            __syncthreads();
            f32x16 acc = zero16();
            const float* ap = SKl + (32 * mt + l31) * 129 + hl;
            const float* bp = Wl + (32 * nt + l31) * 129 + hl;
#pragma unroll 16
            for (int kk = 0; kk < 64; ++kk) acc = __builtin_amdgcn_mfma_f32_32x32x2f32(ap[2 * kk], bp[2 * kk], acc, 0, 0, 0);
            const float g2 = p.in[I_N2G][layer * DM + k0 + 32 * nt + l31];
            bf16_t* dst = (bf16_t*)(p.ws + OFF_WTQ) + (size_t)layer * 2048 * DM + (size_t)(hp * 128 + 32 * mt + 4 * hl) * DM + k0 + 32 * nt + l31;
#pragma unroll
            for (int r = 0; r < 16; ++r) dst[(size_t)((r & 3) + 8 * (r >> 2)) * DM] = (bf16_t)f2bf(acc[r] * g2);
        }
        __syncthreads();
    }
    if (PARTS & 4) {
        const int lane = tid & 63, wave = tid >> 6;
        float* scl = (float*)(p.ws + OFF_PSC);
        for (int row = obid() * NWAVE + wave; row < 2 * NLAYER * 16384; row += NBLK * NWAVE) {
            const int tb = row >> 15, r = row & 32767;
            const f32x4* src = (const f32x4*)(p.in[tb ? I_PV : I_PU] + (size_t)r * DM) + lane;
            f32x4 v[4]; float mx = 0.f;
#pragma unroll
            for (int j = 0; j < 4; ++j) { v[j] = __builtin_nontemporal_load(src + 64 * j); mx = fmaxf(mx, fmaxf(fmaxf(fabsf(v[j].x), fabsf(v[j].y)), fmaxf(fabsf(v[j].z), fabsf(v[j].w)))); }
            mx = wave_max(mx);
            const float sc = mx > 0.f ? 224.0f / mx : 1.0f;
            u32x4 o;
            { int w = 0; w = __builtin_amdgcn_cvt_pk_fp8_f32(v[0].x * sc, v[0].y * sc, w, false); w = __builtin_amdgcn_cvt_pk_fp8_f32(v[0].z * sc, v[0].w * sc, w, true); o.x = (unsigned)w; }
            { int w = 0; w = __builtin_amdgcn_cvt_pk_fp8_f32(v[1].x * sc, v[1].y * sc, w, false); w = __builtin_amdgcn_cvt_pk_fp8_f32(v[1].z * sc, v[1].w * sc, w, true); o.y = (unsigned)w; }
            { int w = 0; w = __builtin_amdgcn_cvt_pk_fp8_f32(v[2].x * sc, v[2].y * sc, w, false); w = __builtin_amdgcn_cvt_pk_fp8_f32(v[2].z * sc, v[2].w * sc, w, true); o.z = (unsigned)w; }
            { int w = 0; w = __builtin_amdgcn_cvt_pk_fp8_f32(v[3].x * sc, v[3].y * sc, w, false); w = __builtin_amdgcn_cvt_pk_fp8_f32(v[3].z * sc, v[3].w * sc, w, true); o.w = (unsigned)w; }
            if (!tb) {
                const float qs = mx > 0.f ? 127.0f / mx : 1.0f;
                o.x = pk_i8(v[0] * qs); o.y = pk_i8(v[1] * qs); o.z = pk_i8(v[2] * qs); o.w = pk_i8(v[3] * qs);
            }
            *(u32x4*)(p.ws + (tb ? OFF_PV : OFF_PU) + (size_t)r * DM + lane * 16) = o;
            if (lane == 0) scl[row] = mx > 0.f ? mx / (tb ? 224.0f : 127.0f) : 1.0f;
        }
    }
    if (PARTS & 8) {
        float* sh = (float*)lds;
        float* zl = sh + 64 * 64;
        const int sub = tid >> 6, j = tid & 63;
        for (int it0 = obid() * 64; it0 < NLAYER * SL; it0 += NBLK * 64) {
            const int layer = it0 / SL;
            __syncthreads();
            for (int o = tid; o < 64 * 17; o += NTHR) {
                const int item = o / 17, f = o % 17;
                const float t = (float)((it0 + item) % SL) / (float)(SL - 1);
                float z;
                if (f == 0) z = t;
                else if (f <= 8) z = sinf(2.0f * 3.14159265358979323846f * t * (float)f);
                else z = cosf(2.0f * 3.14159265358979323846f * t * (float)(f - 8));
                zl[o] = z;
            }
            __syncthreads();
            {
                const float* w1 = p.in[I_W1] + layer * 17 * 64;
                float wv[17];
#pragma unroll
                for (int i = 0; i < 17; ++i) wv[i] = w1[i * 64 + j];
                const float b1 = p.in[I_B1][layer * 64 + j], f1 = p.in[I_F1][layer * 64 + j];
#pragma unroll
                for (int r = 0; r < 8; ++r) {
                    const int item = sub * 8 + r;
                    float a = b1;
#pragma unroll
                    for (int i = 0; i < 17; ++i) a += zl[item * 17 + i] * wv[i];
                    sh[item * 64 + j] = sinf(f1 * a);
                }
            }
            __syncthreads();
            {
                const float* w2 = p.in[I_W2] + layer * 64 * 64;
                const float b2 = p.in[I_B2][layer * 64 + j], f2 = p.in[I_F2][layer * 64 + j];
                float acc[8];
#pragma unroll
                for (int r = 0; r < 8; ++r) acc[r] = b2;
#pragma unroll 8
                for (int k = 0; k < 64; ++k) {
                    const float w = w2[k * 64 + j];
#pragma unroll
                    for (int r = 0; r < 8; ++r) acc[r] += sh[(sub * 8 + r) * 64 + k] * w;
                }
#pragma unroll
                for (int r = 0; r < 8; ++r)
                    ((bf16_t*)(p.ws + OFF_H2))[((size_t)(it0 + sub * 8 + r)) * 64 + j] = (bf16_t)f2bf(sinf(f2 * acc[r]));
            }
        }
        __syncthreads();
    }
    if (PARTS & 16) {
        float* ctab = (float*)lds;
        __syncthreads();
        if (tid < 64) ctab[tid] = cosf((float)tid * (2.0f * 3.14159265358979323846f / 64.0f));
        __syncthreads();
        const int total = NLAYER * 4 * 128 * 64;
        for (int o = obid() * NTHR + tid; o < total; o += NBLK * NTHR) {
            const int e2 = o & 63, dd = (o >> 6) & 127, g = (o >> 13) & 3, layer = o >> 15;
            const int d = dd & 63, sh = (dd < 64) ? 0 : 48;
            const float* w = p.in[I_FW] + ((size_t)(layer * 4 + g) * 64) * 64;
            float acc = 0.f;
#pragma unroll 8
            for (int e = 0; e < 64; ++e) acc += ctab[(d * e + sh) & 63] * w[e * 64 + e2];
            ((float*)(p.ws + OFF_FM))[o] = acc * (1.0f / 724.0773439350246f);
        }
        __syncthreads();
    }
}

__device__ __forceinline__ int zp(int i) { return i + 2 * (i >> 5); }
__device__ constexpr float FC32[16] = {1.000000000f, 0.980785280f, 0.923879533f, 0.831469612f, 0.707106781f, 0.555570233f, 0.382683432f, 0.195090322f, 0.000000000f, -0.195090322f, -0.382683432f, -0.555570233f, -0.707106781f, -0.831469612f, -0.923879533f, -0.980785280f};
__device__ constexpr float FS32[16] = {0.000000000f, 0.195090322f, 0.382683432f, 0.555570233f, 0.707106781f, 0.831469612f, 0.923879533f, 0.980785280f, 1.000000000f, 0.980785280f, 0.923879533f, 0.831469612f, 0.707106781f, 0.555570233f, 0.382683432f, 0.195090322f};
__device__ __forceinline__ float2 cmulf(float2 a, float2 b) { return make_float2(a.x * b.x - a.y * b.y, a.x * b.y + a.y * b.x); }
template <int R> __device__ __forceinline__ constexpr int brevR(int x) { int r = 0; for (int b = 1, t = R >> 1; t >= 1; b <<= 1, t >>= 1) if (x & b) r |= t; return r; }
template <int R> __device__ __forceinline__ void dft_fwd_regs(float2 (&x)[R]) {
#pragma unroll
    for (int half = R / 2; half >= 1; half >>= 1) {
#pragma unroll
        for (int blk = 0; blk < R; blk += 2 * half)
#pragma unroll
            for (int k = 0; k < half; ++k) {
                const float2 a = x[blk + k], b = x[blk + k + half];
                x[blk + k] = make_float2(a.x + b.x, a.y + b.y);
                const float2 d = make_float2(a.x - b.x, a.y - b.y);
                const int ti = k * (16 / half);
                if (ti == 0) x[blk + k + half] = d;
                else if (ti == 8) x[blk + k + half] = make_float2(d.y, -d.x);
                else { const float c = FC32[ti], sn = FS32[ti]; x[blk + k + half] = make_float2(d.x * c + d.y * sn, d.y * c - d.x * sn); }
            }
    }
}
template <int R> __device__ __forceinline__ void dft_inv_regs(float2 (&x)[R]) {
#pragma unroll
    for (int half = 1; half <= R / 2; half <<= 1) {
#pragma unroll
        for (int blk = 0; blk < R; blk += 2 * half)
#pragma unroll
            for (int k = 0; k < half; ++k) {
                const float2 a = x[blk + k], b0 = x[blk + k + half];
                const int ti = k * (16 / half);
                float2 b;
                if (ti == 0) b = b0;
                else if (ti == 8) b = make_float2(-b0.y, b0.x);
                else { const float c = FC32[ti], sn = FS32[ti]; b = make_float2(b0.x * c - b0.y * sn, b0.y * c + b0.x * sn); }
                x[blk + k] = make_float2(a.x + b.x, a.y + b.y);
                x[blk + k + half] = make_float2(a.x - b.x, a.y - b.y);
            }
    }
}
template <int R> __device__ __forceinline__ void apply_tw(float2 (&x)[R], float c, float sg) {
    const float2 w1 = make_float2(c, sg), w2 = cmulf(w1, w1);
    float2 po = w1, pe = w2;
#pragma unroll
    for (int m = 1; m < R; m += 2) {
        x[brevR<R>(m)] = cmulf(x[brevR<R>(m)], po);
        if (m + 1 < R) x[brevR<R>(m + 1)] = cmulf(x[brevR<R>(m + 1)], pe);
        if (m + 2 < R) { po = cmulf(po, w2); pe = cmulf(pe, w2); }
    }
}
template <int R, bool INV> __device__ __forceinline__ void fft_group(float2* Z, int pbase, int PS, float ang) {
    float2 x[R];
    if (!INV) {
#pragma unroll
        for (int m = 0; m < R; ++m) x[m] = Z[pbase + PS * m];
        dft_fwd_regs<R>(x);
        apply_tw<R>(x, __builtin_amdgcn_cosf(ang), -__builtin_amdgcn_sinf(ang));
#pragma unroll
        for (int m = 0; m < R; ++m) Z[pbase + PS * m] = x[brevR<R>(m)];
    } else {
#pragma unroll
        for (int m = 0; m < R; ++m) x[brevR<R>(m)] = Z[pbase + PS * m];
        apply_tw<R>(x, __builtin_amdgcn_cosf(ang), __builtin_amdgcn_sinf(ang));
        dft_inv_regs<R>(x);
#pragma unroll
        for (int m = 0; m < R; ++m) Z[pbase + PS * m] = x[m];
    }
}
template <bool INV> __device__ __forceinline__ void fft_group32_contig(float2* Z, int pbase) {
    float2 x[32];
    if (!INV) {
#pragma unroll
        for (int m = 0; m < 32; m += 2) { const f32x4 v = *(const f32x4*)(Z + pbase + m); x[m] = make_float2(v.x, v.y); x[m + 1] = make_float2(v.z, v.w); }
        dft_fwd_regs<32>(x);
#pragma unroll
        for (int m = 0; m < 32; m += 2) { const float2 a = x[brevR<32>(m)], b = x[brevR<32>(m + 1)]; *(f32x4*)(Z + pbase + m) = (f32x4){a.x, a.y, b.x, b.y}; }
    } else {
#pragma unroll
        for (int m = 0; m < 32; m += 2) { const f32x4 v = *(const f32x4*)(Z + pbase + m); x[brevR<32>(m)] = make_float2(v.x, v.y); x[brevR<32>(m + 1)] = make_float2(v.z, v.w); }
        dft_inv_regs<32>(x);
#pragma unroll
        for (int m = 0; m < 32; m += 2) *(f32x4*)(Z + pbase + m) = (f32x4){x[m].x, x[m].y, x[m + 1].x, x[m + 1].y};
    }
}
__device__ __forceinline__ void fft16k_fwd(float2* Z) {
    const int tid = otid();
#pragma unroll 1
    for (int g = 0; g < 2; ++g) { const int j = tid + 512 * g; fft_group<16, false>(Z, zp(j), 1088, (float)j * (1.0f / 16384.0f)); }
    __syncthreads();
    { const int blk = tid >> 5, j = tid & 31; fft_group<32, false>(Z, blk * 1088 + j, 34, (float)j * (1.0f / 1024.0f)); }
    __syncthreads();
    fft_group32_contig<false>(Z, 34 * tid);
    __syncthreads();
}
__device__ __forceinline__ void fft16k_inv(float2* Z) {
    const int tid = otid();
    fft_group32_contig<true>(Z, 34 * tid);
    __syncthreads();
    { const int blk = tid >> 5, j = tid & 31; fft_group<32, true>(Z, blk * 1088 + j, 34, (float)j * (1.0f / 1024.0f)); }
    __syncthreads();
#pragma unroll 1
    for (int g = 0; g < 2; ++g) { const int j = tid + 512 * g; fft_group<16, true>(Z, zp(j), 1088, (float)j * (1.0f / 16384.0f)); }
    __syncthreads();
}
__device__ __forceinline__ void fft8k_fwd(float2* Z) {
    const int tid = otid();
    fft_group<16, false>(Z, zp(tid), 544, (float)tid * (1.0f / 8192.0f));
    __syncthreads();
    { const int blk = tid >> 5, j = tid & 31; fft_group<16, false>(Z, blk * 544 + j, 34, (float)j * (1.0f / 512.0f)); }
    __syncthreads();
    if (tid < 256) fft_group32_contig<false>(Z, 34 * tid);
    __syncthreads();
}
__device__ __forceinline__ int f16k_of_p(int p) { return (p >> 10) + 16 * ((p >> 5) & 31) + 512 * (p & 31); }
__device__ __forceinline__ int p16k_of_f(int f) { return 1024 * (f & 15) + 32 * ((f >> 4) & 31) + (f >> 9); }
__device__ __forceinline__ int p8k_of_f(int f) { return 512 * (f & 15) + 32 * ((f >> 4) & 15) + (f >> 8); }

__device__ __forceinline__ void phase_filter_spectra(const Params& p, char* lds) {
    const int tid = otid(), lane = tid & 63, wave = tid >> 6;
    float2* Z = (float2*)lds;
    float* red = (float*)(lds + 139264 + 64);
    for (int job = obid(); job < NLAYER * 256; job += NBLK) {
        const int layer = job >> 8, c = job & 255;
        __syncthreads();
        const float* HFc = (const float*)(p.ws + (layer ? OFF_HFILT1 : OFF_HFILT0)) + (size_t)c * SL;
        const float r_lo = 4.605170185988092f / 1.5f, r_hi = 4.605170185988092f / 0.3f;
        const float rate = r_lo + (r_hi - r_lo) * ((float)c / 255.0f);
        float ss0 = 0.f, ss1 = 0.f;
#pragma unroll 1
        for (int i = 0; i < 4; ++i) {
            const int l0 = 4 * tid + 2048 * i;
            const f32x4 a0 = *(const f32x4*)(HFc + l0), a1 = *(const f32x4*)(HFc + (size_t)256 * SL + l0);
            const f32x4 a2 = *(const f32x4*)(HFc + (size_t)512 * SL + l0), a3 = *(const f32x4*)(HFc + (size_t)768 * SL + l0);
#pragma unroll
            for (int e = 0; e < 4; ++e) {
                const int l = l0 + e;
                const float t = (float)l / (float)(SL - 1);
                const float dec = expf(-t * rate);
                const float f0 = a0[e] * dec, b0 = a1[e] * dec, f1 = a2[e] * dec, b1 = a3[e] * dec;
                ss0 += f0 * f0 + b0 * b0; ss1 += f1 * f1 + b1 * b1;
                Z[zp(l)] = make_float2(f0, f1);
                if (l >= 1) Z[zp(16384 - l)] = make_float2(b0, b1);
            }
        }
        if (tid == 0) Z[zp(8192)] = make_float2(0.f, 0.f);
        ss0 = wave_sum(ss0); ss1 = wave_sum(ss1);
        if (lane == 0) { red[wave * 2] = ss0; red[wave * 2 + 1] = ss1; }
        __syncthreads();
        float t0 = 0.f, t1 = 0.f;
#pragma unroll
        for (int w = 0; w < 8; ++w) { t0 += red[w * 2]; t1 += red[w * 2 + 1]; }
        const float sc0 = rsqrtf(t0 + EPS) * (1.0f / 16384.0f) * 0.5f, sc1 = rsqrtf(t1 + EPS) * (1.0f / 16384.0f) * 0.5f;
        const float hb0 = p.in[I_HB][(layer * 2 + 0) * 256 + c] * (1.0f / 16384.0f), hb1 = p.in[I_HB][(layer * 2 + 1) * 256 + c] * (1.0f / 16384.0f);
        fft16k_fwd(Z);
        float2* KF0 = (float2*)(p.ws + OFF_KF) + ((size_t)(layer * 256 + c) * 2) * 16384;
        float2* KF1 = KF0 + 16384;
        for (int i = 0; i < 32; ++i) {
            const int pp = tid + NTHR * i;
            const int fq = f16k_of_p(pp);
            const int pq = p16k_of_f((16384 - fq) & 16383);
            const float2 za = Z[zp(pp)], zq = Z[zp(pq)];
            KF0[pp] = make_float2((za.x + zq.x) * sc0 + hb0, (za.y - zq.y) * sc0);
            KF1[pp] = make_float2((za.y + zq.y) * sc1 + hb1, (zq.x - za.x) * sc1);
        }
    }
}

__device__ __forceinline__ void phase_rmsnorm_bf16(const float* x, const float* g, bf16_t* out) {
    const int lane = otid() & 63, wave = otid() >> 6;
    const int gw = obid() * NWAVE + wave, ngw = NBLK * NWAVE;
    for (int row = gw; row < T; row += ngw) {
        const f32x4* xr = (const f32x4*)(x + (size_t)row * DM) + lane;
        f32x4 v[4]; float ss = 0.f;
#pragma unroll
        for (int j = 0; j < 4; ++j) { v[j] = xr[64 * j]; ss += v[j].x * v[j].x + v[j].y * v[j].y + v[j].z * v[j].z + v[j].w * v[j].w; }
        ss = wave_sum(ss);
        const float r = rsqrtf(ss * (1.0f / DM) + EPS);
        u32x2* o = (u32x2*)(out + (size_t)row * DM) + lane;
#pragma unroll
        for (int j = 0; j < 4; ++j) {
            const f32x4 gg = ((const f32x4*)g)[lane + 64 * j];
            u32x2 w; w.x = pk2(v[j].x * r * gg.x, v[j].y * r * gg.y); w.y = pk2(v[j].z * r * gg.z, v[j].w * r * gg.w);
            o[64 * j] = w;
        }
    }
}

constexpr int G_LDA = 144;
template <class Epi>
__device__ __forceinline__ void gemm_simple(const bf16_t* A, const bf16_t* Bt, int M, int N, int K, char* lds, const Epi& epi) {
    const int tid = otid(), lane = tid & 63, wave = tid >> 6;
    const int wm = wave >> 1, wn = wave & 1;
    const int nMt = M / 256, nNt = N / 128, total = nMt * nNt, nk = K / 64;
    char* As = lds; char* Bs = lds + 256 * G_LDA;
    const int l31 = lane & 31, hl = lane >> 5;
    for (int u = obid(); u < total; u += NBLK) {
        const int mt = u % nMt, nt = u / nMt;
        f32x16 acc[2][2];
#pragma unroll
        for (int i = 0; i < 2; ++i)
#pragma unroll
            for (int j = 0; j < 2; ++j) acc[i][j] = zero16();
        u32x4 ra[4], rb[2];
        const bf16_t* Ab = A + (size_t)(mt * 256) * K;
        const bf16_t* Bb = Bt + (size_t)(nt * 128) * K;
#pragma unroll
        for (int i = 0; i < 4; ++i) { const int id = tid + NTHR * i, row = id >> 3, ch = id & 7; ra[i] = *(const u32x4*)(Ab + (size_t)row * K + ch * 8); }
#pragma unroll
        for (int i = 0; i < 2; ++i) { const int id = tid + NTHR * i, row = id >> 3, ch = id & 7; rb[i] = *(const u32x4*)(Bb + (size_t)row * K + ch * 8); }
        for (int kt = 0; kt < nk; ++kt) {
            __syncthreads();
#pragma unroll
            for (int i = 0; i < 4; ++i) { const int id = tid + NTHR * i, row = id >> 3, ch = id & 7; *(u32x4*)(As + row * G_LDA + ch * 16) = ra[i]; }
#pragma unroll
            for (int i = 0; i < 2; ++i) { const int id = tid + NTHR * i, row = id >> 3, ch = id & 7; *(u32x4*)(Bs + row * G_LDA + ch * 16) = rb[i]; }
            __syncthreads();
            if (kt + 1 < nk) {
                const int ko = (kt + 1) * 64;
#pragma unroll
                for (int i = 0; i < 4; ++i) { const int id = tid + NTHR * i, row = id >> 3, ch = id & 7; ra[i] = *(const u32x4*)(Ab + (size_t)row * K + ko + ch * 8); }
#pragma unroll
                for (int i = 0; i < 2; ++i) { const int id = tid + NTHR * i, row = id >> 3, ch = id & 7; rb[i] = *(const u32x4*)(Bb + (size_t)row * K + ko + ch * 8); }
            }
#pragma unroll
            for (int ks = 0; ks < 4; ++ks) {
                bf16x8 a[2], b[2];
#pragma unroll
                for (int i = 0; i < 2; ++i) a[i] = *(const bf16x8*)(As + (wm * 64 + i * 32 + l31) * G_LDA + ks * 32 + hl * 16);
#pragma unroll
                for (int j = 0; j < 2; ++j) b[j] = *(const bf16x8*)(Bs + (wn * 64 + j * 32 + l31) * G_LDA + ks * 32 + hl * 16);
#pragma unroll
                for (int i = 0; i < 2; ++i)
#pragma unroll
                    for (int j = 0; j < 2; ++j) acc[i][j] = mfma32(a[i], b[j], acc[i][j]);
            }
        }
#pragma unroll
        for (int i = 0; i < 2; ++i)
#pragma unroll
            for (int j = 0; j < 2; ++j) epi(acc[i][j], mt * 256 + wm * 64 + i * 32, nt * 128 + wn * 64 + j * 32, lane);
    }
}

struct EpiF32 {
    float* out; int ld;
    __device__ __forceinline__ void operator()(const f32x16& acc, int row0, int col0, int lane) const {
        const int c = col0 + (lane & 31), h = lane >> 5;
#pragma unroll
        for (int r = 0; r < 16; ++r) { out[(size_t)(row0 + (r & 3) + 8 * (r >> 2) + 4 * h) * ld + c] = acc[r]; }
    }
};

namespace pg8 {
#define PG8_LAS __attribute__((address_space(3)))
constexpr int BM = 256, BK = 64, HALF = 128, HTB = HALF * BK * 2  , STAGE_BYTES = 8 * HTB, NXCD = 8, WGM = 8;

__host__ __device__ __forceinline__ int lds_byte(int r, int c) { const int st = (r >> 4) * 2 + (c >> 5), rr = r & 15, cc = c & 31, ob = rr * 64 + cc * 2; return st * 1024 + (ob ^ (((ob >> 9) & 1) << 5)); }
__host__ __device__ __forceinline__ void stage_rc(int b, int& R, int& C) { const int st = b / 1024, sb = b % 1024, swz = sb ^ (((sb >> 9) & 1) << 5); R = (st >> 1) * 16 + swz / 64; C = (st & 1) * 32 + (swz % 64) / 2; }
__host__ __device__ __forceinline__ int perm32(int rho) { const int n = rho >> 4, i = rho & 15; return 8 * (i >> 2) + 4 * n + (i & 3); }

struct Unit { int pm, pn; };
struct Gemm { const bf16_t* A; const bf16_t* Bt; int M, N, K; };

struct StaticOrder {
    int nM, nN, nwg, G, c;
    __host__ __device__ void init(int M, int N, int G_, int c_) { nM = M / BM; nN = N / BM; nwg = nM * nN; G = G_; c = c_; }
    __host__ __device__ bool next(int i, Unit& u) const {
        const long L = (long)i * G + c; if (L >= nwg) return false;
        int wgid = (int)L; { const int q = nwg / NXCD, r = nwg % NXCD, xcd = wgid % NXCD, off = wgid / NXCD; wgid = (xcd < r ? xcd * (q + 1) : r * (q + 1) + (xcd - r) * q) + off; }
        const int nig = WGM * nN, gid = wgid / nig, fm = gid * WGM, gsz = (nM - fm) < WGM ? (nM - fm) : WGM;
        u.pm = fm + ((wgid % nig) % gsz); u.pn = (wgid % nig) / gsz; return true;
    }
    __device__ __forceinline__ void a_ready(const Unit&) const {}
    __device__ __forceinline__ void done(const Unit&) const {}
};


__device__ __forceinline__ unsigned cvt_pk_bf16(float lo, float hi) { unsigned r; asm volatile("v_cvt_pk_bf16_f32 %0, %1, %2" : "=v"(r) : "v"(lo), "v"(hi)); return r; }
struct EpiStoreBf16 {
    static constexpr bool PERM = true, AFTER_DRAIN = false;
    bf16_t* O; int ldc;
    __device__ __forceinline__ void operator()(const f32x4 (&acc)[2][2][4][2], const Unit& u, int wr, int wc, int fr, int fq) const {
        const int row0 = u.pm * BM + wr * 64 + fr, col0 = u.pn * BM + wc * 32 + 8 * fq;
#pragma unroll
        for (int ai = 0; ai < 2; ++ai)
#pragma unroll
            for (int m = 0; m < 4; ++m) { bf16_t* rowp = O + (size_t)(row0 + ai * HALF + m * 16) * ldc + col0;
#pragma unroll
                for (int bj = 0; bj < 2; ++bj) { const f32x4 v0 = acc[ai][bj][m][0], v1 = acc[ai][bj][m][1];
                    u32x4 w; w.x = cvt_pk_bf16(v0[0], v0[1]); w.y = cvt_pk_bf16(v0[2], v0[3]); w.z = cvt_pk_bf16(v1[0], v1[1]); w.w = cvt_pk_bf16(v1[2], v1[3]);
                    *(u32x4*)(rowp + bj * HALF) = w; } }
    }
};
struct EpiOutProj {
    static constexpr bool PERM = false, AFTER_DRAIN = false;
    const float* base; float* O; bf16_t* XB; float* RS;
    __device__ __forceinline__ void operator()(const f32x4 (&acc)[2][2][4][2], const Unit& u, int wr, int wc, int fr, int fq) const {
        const int row0 = u.pm * BM + wr * 64 + fr, col0 = u.pn * BM + wc * 32 + 4 * fq;
#pragma unroll
        for (int ai = 0; ai < 2; ++ai)
#pragma unroll
            for (int m = 0; m < 4; ++m) { const int row = row0 + ai * HALF + m * 16; const size_t off = (size_t)row * 1024 + col0; float ss = 0.f;
#pragma unroll
                for (int bj = 0; bj < 2; ++bj)
#pragma unroll
                    for (int n = 0; n < 2; ++n) { const f32x4 v = acc[ai][bj][m][n] + *(const f32x4*)(base + off + bj * HALF + n * 16);
                        *(f32x4*)(O + off + bj * HALF + n * 16) = v; ss += v[0] * v[0] + v[1] * v[1] + v[2] * v[2] + v[3] * v[3];
                        u32x2 w; w.x = cvt_pk_bf16(v[0], v[1]); w.y = cvt_pk_bf16(v[2], v[3]); *(u32x2*)(XB + off + bj * HALF + n * 16) = w; }
                ss += __shfl_xor(ss, 16); ss += __shfl_xor(ss, 32);
                if (fq == 0) RS[(size_t)row * 16 + u.pn * 4 + wc] = ss; }
    }
};
struct EpiRowScaleF16 {
    static constexpr bool PERM = false, AFTER_DRAIN = false;
    _Float16* O; int ldc; const float* RS;
    __device__ __forceinline__ void operator()(const f32x4 (&acc)[2][2][4][2], const Unit& u, int wr, int wc, int fr, int fq) const {
        const int row0 = u.pm * BM + wr * 64 + fr, col0 = u.pn * BM + wc * 32 + 4 * fq;
#pragma unroll
        for (int ai = 0; ai < 2; ++ai)
#pragma unroll
            for (int m = 0; m < 4; ++m) { const int row = row0 + ai * HALF + m * 16; const size_t off = (size_t)row * ldc + col0;
                float tot = 0.f;
#pragma unroll
                for (int q = 0; q < 4; ++q) { const f32x4 pr = *(const f32x4*)(RS + (size_t)row * 16 + 4 * q); tot += (pr[0] + pr[1]) + (pr[2] + pr[3]); }
                const float r = rsqrtf(tot * (1.0f / 1024.0f) + 1e-6f);
#pragma unroll
                for (int bj = 0; bj < 2; ++bj)
#pragma unroll
                    for (int n = 0; n < 2; ++n) *(f16x4*)(O + off + bj * HALF + n * 16) = __builtin_convertvector(acc[ai][bj][m][n] * r, f16x4); }
    }
};
struct EpiStoreF32 {
    static constexpr bool PERM = false, AFTER_DRAIN = false;
    const float* base; float* O; int ldc;
    __device__ __forceinline__ void operator()(const f32x4 (&acc)[2][2][4][2], const Unit& u, int wr, int wc, int fr, int fq) const {
        const int row0 = u.pm * BM + wr * 64 + fr, col0 = u.pn * BM + wc * 32 + 4 * fq;
#pragma unroll
        for (int ai = 0; ai < 2; ++ai)
#pragma unroll
            for (int m = 0; m < 4; ++m) { const size_t off = (size_t)(row0 + ai * HALF + m * 16) * ldc + col0;
#pragma unroll
                for (int bj = 0; bj < 2; ++bj)
#pragma unroll
                    for (int n = 0; n < 2; ++n) { f32x4 v = acc[ai][bj][m][n]; if (base) v += *(const f32x4*)(base + off + bj * HALF + n * 16); *(f32x4*)(O + off + bj * HALF + n * 16) = v; } }
    }
};

template <class Epi, class Sched, bool ALIGN_EPI = false, bool SP2 = false>
__device__ __forceinline__ void gemm_phase(PG8_LAS unsigned char* lds, const Gemm g, const Sched& S, const Epi& E) {
    const int tid = otid(), wid = __builtin_amdgcn_readfirstlane(tid >> 6), lane = tid & 63, wr = wid >> 2, wc = wid & 3, fr = lane & 15, fq = lane >> 4;
    const int K = g.K, nt = K / BK;
    unsigned voffA[2], voffB[2];
#pragma unroll
    for (int i = 0; i < 2; ++i) { int R, C; stage_rc(tid * 16 + i * 8192, R, C); const int Rb = Epi::PERM ? ((R & ~31) + perm32(R & 31)) : R;
        voffA[i] = (unsigned)(R * K + C) * 2u; voffB[i] = (unsigned)(Rb * K + C) * 2u; }
    const size_t kstep = (size_t)(BK * 2);
    const size_t hstep = (size_t)HALF * K * 2;
    const size_t tstep = 2 * hstep;
    const unsigned ldsw = (unsigned)wid * 1024u;
    const int aoff = lds_byte(wr * 64 + fr, fq * 8), boff = lds_byte(wc * 32 + fr, fq * 8);
#define PG8_SA(b, h) (((b) * 2 + (h)) * HTB)
#define PG8_SB(b, h) ((4 + (b) * 2 + (h)) * HTB)
#define PG8_STAGE(bufoff, gbase, voff) do { _Pragma("unroll") for (int _i = 0; _i < 2; ++_i) \
        __builtin_amdgcn_global_load_lds((const unsigned*)((const char*)(gbase) + (voff)[_i]), (PG8_LAS unsigned*)(lds + (bufoff) + ldsw + _i * 8192), 16, 0, 0); } while (0)
#define PG8_LDA(dst, b, h) do { _Pragma("unroll") for (int m = 0; m < 4; ++m) _Pragma("unroll") for (int k = 0; k < 2; ++k) dst[m][k] = *(const PG8_LAS bf16x8*)(lds + PG8_SA(b, h) + aoff + m * 2048 + k * 1024); } while (0)
#define PG8_LDB(dst, b, h) do { _Pragma("unroll") for (int n = 0; n < 2; ++n) _Pragma("unroll") for (int k = 0; k < 2; ++k) dst[n][k] = *(const PG8_LAS bf16x8*)(lds + PG8_SB(b, h) + boff + n * 2048 + k * 1024); } while (0)
#define PG8_MMA(ai, bj, At, Bt) do { __builtin_amdgcn_s_setprio(1); _Pragma("unroll") for (int m = 0; m < 4; ++m) _Pragma("unroll") for (int n = 0; n < 2; ++n) _Pragma("unroll") for (int k = 0; k < 2; ++k) \
        acc[ai][bj][m][n] = __builtin_amdgcn_mfma_f32_16x16x32_bf16(Bt[n][k], At[m][k], acc[ai][bj][m][n], 0, 0, 0); __builtin_amdgcn_s_setprio(0); } while (0)
#define PG8_WAIT_V(n) asm volatile("s_waitcnt vmcnt(" #n ")" ::: "memory")
#define PG8_WAIT_L(n) asm volatile("s_waitcnt lgkmcnt(" #n ")" ::: "memory")
#define PG8_BAR __builtin_amdgcn_s_barrier()
#define PG8_SCHED __builtin_amdgcn_sched_barrier(0)
    Unit cur, nxt; int ui = 0;
    if (!S.next(0, cur)) return;
    f32x4 acc[2][2][4][2];
#pragma unroll
    for (int a = 0; a < 2; ++a)
#pragma unroll
        for (int b = 0; b < 2; ++b)
#pragma unroll
            for (int m = 0; m < 4; ++m)
#pragma unroll
                for (int n = 0; n < 2; ++n) acc[a][b][m][n] = (f32x4){0.f, 0.f, 0.f, 0.f};
    bf16x8 At[4][2], B0[2][2], B1[2][2];
    const char* cA = (const char*)g.A + (size_t)cur.pm * tstep; const char* cB = (const char*)g.Bt + (size_t)cur.pn * tstep;
    S.a_ready(cur);
    if constexpr (SP2) {
        PG8_STAGE(PG8_SB(0, 0), cB, voffB); PG8_STAGE(PG8_SB(0, 1), cB + hstep, voffB); PG8_STAGE(PG8_SA(0, 0), cA, voffA); PG8_STAGE(PG8_SA(0, 1), cA + hstep, voffA);
        if (wr == 1) PG8_BAR;
        PG8_WAIT_V(2); PG8_BAR;
        PG8_STAGE(PG8_SB(1, 0), cB + kstep, voffB); PG8_STAGE(PG8_SA(1, 0), cA + kstep, voffA); PG8_STAGE(PG8_SB(1, 1), cB + hstep + kstep, voffB);
        PG8_WAIT_V(6); PG8_BAR;
    } else {
        PG8_STAGE(PG8_SB(0, 0), cB, voffB); PG8_STAGE(PG8_SA(0, 0), cA, voffA); PG8_STAGE(PG8_SB(0, 1), cB + hstep, voffB); PG8_STAGE(PG8_SA(0, 1), cA + hstep, voffA);
        if (wr == 1) PG8_BAR;
        PG8_WAIT_V(4); PG8_BAR;
        PG8_STAGE(PG8_SB(1, 0), cB + kstep, voffB); PG8_STAGE(PG8_SA(1, 0), cA + kstep, voffA); PG8_STAGE(PG8_SB(1, 1), cB + hstep + kstep, voffB);
        PG8_WAIT_V(6); PG8_BAR;
    }
    for (;;) {
        const bool has_next = S.next(ui + 1, nxt);
        const char* nA = has_next ? (const char*)g.A + (size_t)nxt.pm * tstep : cA; const char* nB = has_next ? (const char*)g.Bt + (size_t)nxt.pn * tstep : cB;
        for (int t = 0; t < nt; t += 2) {
            const bool last = (t == nt - 2);
            const char* a1 = cA + (size_t)(t + 1) * kstep;
            const char* a2 = last ? nA : cA + (size_t)(t + 2) * kstep; const char* b2 = last ? nB : cB + (size_t)(t + 2) * kstep;
            const char* a3 = a2 + kstep; const char* b3 = b2 + kstep;
            if (last && has_next) S.a_ready(nxt);
            if constexpr (SP2) {
            PG8_LDB(B0, 0, 0); PG8_LDB(B1, 0, 1); PG8_SCHED; PG8_LDA(At, 0, 0); PG8_STAGE(PG8_SA(1, 1), a1 + hstep, voffA);
            PG8_WAIT_V(8); PG8_WAIT_L(0); PG8_BAR; PG8_MMA(0, 0, At, B0); PG8_MMA(0, 1, At, B1); PG8_BAR; PG8_SCHED;
            PG8_LDA(At, 0, 1); PG8_STAGE(PG8_SB(0, 0), b2, voffB); PG8_STAGE(PG8_SB(0, 1), b2 + hstep, voffB); PG8_STAGE(PG8_SA(0, 0), a2, voffA);
            PG8_WAIT_V(8); PG8_WAIT_L(0); PG8_BAR; PG8_MMA(1, 0, At, B0); PG8_MMA(1, 1, At, B1); PG8_BAR; PG8_SCHED;
            PG8_LDB(B0, 1, 0); PG8_LDB(B1, 1, 1); PG8_SCHED; PG8_LDA(At, 1, 0); PG8_STAGE(PG8_SA(0, 1), a2 + hstep, voffA);
            PG8_WAIT_V(8); PG8_WAIT_L(0); PG8_BAR; PG8_MMA(0, 0, At, B0); PG8_MMA(0, 1, At, B1); PG8_BAR; PG8_SCHED;
            PG8_LDA(At, 1, 1); PG8_STAGE(PG8_SB(1, 0), b3, voffB); PG8_STAGE(PG8_SB(1, 1), b3 + hstep, voffB); PG8_STAGE(PG8_SA(1, 0), a3, voffA);
            PG8_WAIT_V(8); PG8_WAIT_L(0); PG8_BAR; PG8_MMA(1, 0, At, B0); PG8_MMA(1, 1, At, B1); PG8_BAR; PG8_SCHED;
            } else {
            PG8_LDB(B0, 0, 0); PG8_SCHED; PG8_LDA(At, 0, 0); PG8_STAGE(PG8_SA(1, 1), a1 + hstep, voffA);
            PG8_WAIT_L(8); PG8_BAR; PG8_WAIT_L(0); PG8_MMA(0, 0, At, B0); PG8_BAR; PG8_SCHED;
            PG8_LDB(B1, 0, 1); PG8_STAGE(PG8_SB(0, 0), b2, voffB);
            PG8_BAR; PG8_WAIT_L(0); PG8_MMA(0, 1, At, B1); PG8_BAR;
            PG8_LDA(At, 0, 1); PG8_STAGE(PG8_SA(0, 0), a2, voffA);
            PG8_BAR; PG8_WAIT_L(0); PG8_MMA(1, 0, At, B0); PG8_BAR; PG8_SCHED;
            PG8_STAGE(PG8_SB(0, 1), b2 + hstep, voffB);
            PG8_WAIT_V(6); PG8_BAR; PG8_MMA(1, 1, At, B1); PG8_BAR;
            PG8_LDB(B0, 1, 0); PG8_SCHED; PG8_LDA(At, 1, 0); PG8_STAGE(PG8_SA(0, 1), a2 + hstep, voffA);
            PG8_WAIT_L(8); PG8_BAR; PG8_WAIT_L(0); PG8_MMA(0, 0, At, B0); PG8_BAR; PG8_SCHED;
            PG8_LDB(B1, 1, 1); PG8_STAGE(PG8_SB(1, 0), b3, voffB);
            PG8_BAR; PG8_WAIT_L(0); PG8_MMA(0, 1, At, B1); PG8_BAR;
            PG8_LDA(At, 1, 1); PG8_STAGE(PG8_SA(1, 0), a3, voffA);
            PG8_BAR; PG8_WAIT_L(0); PG8_MMA(1, 0, At, B0); PG8_BAR; PG8_SCHED;
            PG8_STAGE(PG8_SB(1, 1), b3 + hstep, voffB);
            PG8_WAIT_V(6); PG8_BAR; PG8_MMA(1, 1, At, B1); PG8_BAR;
            }
        }
        if constexpr (ALIGN_EPI) { if (wr == 0) PG8_BAR; }
        if constexpr (!Epi::AFTER_DRAIN) { E(acc, cur, wr, wc, fr, fq); S.done(cur); }
        if (!has_next) break;
#pragma unroll
        for (int a = 0; a < 2; ++a)
#pragma unroll
            for (int b = 0; b < 2; ++b)
#pragma unroll
                for (int m = 0; m < 4; ++m)
#pragma unroll
                    for (int n = 0; n < 2; ++n) acc[a][b][m][n] = (f32x4){0.f, 0.f, 0.f, 0.f};
        cur = nxt; cA = nA; cB = nB; ++ui;
        if constexpr (ALIGN_EPI) { if (wr == 1) PG8_BAR; }
    }
    PG8_WAIT_V(0);
    if constexpr (!ALIGN_EPI) { if (wr == 0) PG8_BAR; }
    PG8_BAR;
    if constexpr (Epi::AFTER_DRAIN) { E.fused(acc, cur, wr, wc, fr, fq, lds, wid, lane); S.done(cur); }
#undef PG8_SA
#undef PG8_SB
#undef PG8_STAGE
#undef PG8_LDA
#undef PG8_LDB
#undef PG8_MMA
#undef PG8_WAIT_V
#undef PG8_WAIT_L
#undef PG8_BAR
#undef PG8_SCHED
}
}

__device__ constexpr float ROPE_INV_REV[16] = {1.591549431e-01f, 8.949940161e-02f, 5.032921210e-02f, 2.830219583e-02f, 1.591549431e-02f, 8.949940161e-03f, 5.032921210e-03f, 2.830219583e-03f, 1.591549431e-03f, 8.949940161e-04f, 5.032921210e-04f, 2.830219583e-04f, 1.591549431e-04f, 8.949940161e-05f, 5.032921210e-05f, 2.830219583e-05f};
__device__ __forceinline__ void qk_norm_rope8(const u32x4 raw, const float (&gn)[8], const float (&cs)[8], const float (&sn)[8], bool second, float scale, u32x4& out) {
    float x[8] = {bflo(raw.x), bfhi(raw.x), bflo(raw.y), bfhi(raw.y), bflo(raw.z), bfhi(raw.z), bflo(raw.w), bfhi(raw.w)};
    float ss = 0.f;
#pragma unroll
    for (int e = 0; e < 8; ++e) ss += x[e] * x[e];
    ss += __shfl_xor(ss, 1); ss += __shfl_xor(ss, 2); ss += __shfl_xor(ss, 4);
    const float r = rsqrtf(ss * (1.0f / 64.0f) + EPS) ;
    float o[8];
#pragma unroll
    for (int e = 0; e < 8; ++e) {
        const float y = x[e] * r * gn[e];
        const float other = __shfl_xor(y, 2);
        o[e] = (second ? (y * cs[e] + other * sn[e]) : (y * cs[e] - other * sn[e])) * scale;
    }
    out.x = pk2(o[0], o[1]); out.y = pk2(o[2], o[3]); out.z = pk2(o[4], o[5]); out.w = pk2(o[6], o[7]);
}
__device__ __forceinline__ void phase_qkprep(const Params& p, int layer, char* lds, bf16_t* qout) {
    const int tid = otid(), lane = tid & 63, wave = tid >> 6;
    const bf16_t* qkv = (const bf16_t*)(p.ws + R_QKV);
    const int sub = lane & 7;
    const bool second = ((sub >> 1) & 1) != 0, colaxis = (sub >> 2) != 0;
    float gq[8], gk[8], ir[8];
#pragma unroll
    for (int e = 0; e < 8; ++e) {
        gq[e] = p.in[I_QG][layer * 64 + sub * 8 + e]; gk[e] = p.in[I_KG][layer * 64 + sub * 8 + e];
        ir[e] = (sub & 1) ? ROPE_INV_REV[8 + e] : ROPE_INV_REV[e];
    }
    const int gw = obid() * NWAVE + wave, ngw = NBLK * NWAVE;
    for (int t = gw; t < T; t += ngw) {
        const int l = t & (SL - 1);
        const float pos = colaxis ? (float)(l & 63) : (float)(l >> 6);
        float cs[8], sn[8];
#pragma unroll
        for (int e = 0; e < 8; ++e) { const float a = pos * ir[e]; cs[e] = __builtin_amdgcn_cosf(a); sn[e] = __builtin_amdgcn_sinf(a); }
        const u32x4 rq = *(const u32x4*)(qkv + (size_t)t * 768 + lane * 8);
        u32x4 rk = {0u, 0u, 0u, 0u};
        if (lane < 16) rk = *(const u32x4*)(qkv + (size_t)t * 768 + 512 + lane * 8);
        u32x4 oq, ok;
        qk_norm_rope8(rq, gq, cs, sn, second, 0.125f * 1.4426950408889634f, oq);
        qk_norm_rope8(rk, gk, cs, sn, second, 1.0f, ok);
        *(u32x4*)(qout + (size_t)t * 768 + lane * 8) = oq;
        if (lane < 16) *(u32x4*)(qout + (size_t)t * 768 + 512 + lane * 8) = ok;
    }
}

#include <hip/hip_bf16.h>
#include <cmath>
namespace attn_body {
using bf16=__hip_bfloat16;
using bf16x8=__attribute__((ext_vector_type(8)))short;
using s16x4=__attribute__((ext_vector_type(4)))short;
using f32x16=__attribute__((ext_vector_type(16)))float;
using u32x4=__attribute__((ext_vector_type(4)))unsigned;
constexpr int SEQ=8192,D=64,PQ=768,PO=512;
constexpr int NW=8,QBLK=32,QB=QBLK*NW,KVBLK=64,NQB=SEQ/QB;
constexpr int ATTN_UNIT_ROWS=QB;
__device__ __forceinline__ int crow(int r,int hi){return (r&3)+8*(r>>2)+4*hi;}
#define SBAR() __builtin_amdgcn_sched_barrier(0)
__device__ __forceinline__ void cmask(f32x16&p0,f32x16&p1,int jb,int qrel,int hi){
  const float NEG=-INFINITY; int kb=64*jb+4*hi;
  #pragma unroll
  for(int r=0;r<16;++r){int kv=kb+(r&3)+8*(r>>2); if(kv>qrel)p0[r]=NEG; if(kv+32>qrel)p1[r]=NEG;}
}

constexpr int NSLOT=3, SLOTB=8192;
constexpr int LDS_K=0, LDS_V=NSLOT*SLOTB, LDS_WS=2*NSLOT*SLOTB, LDS_OST=LDS_WS+NW*64*4, LDS_BYTES=LDS_OST+NW*4096;
constexpr float C2=0.125f*1.4426950408889634f;
__device__ __forceinline__ void glds16(const void*gsrc,unsigned lds_dst){unsigned keep;
  asm volatile("s_mov_b32 %0, m0\n\ts_mov_b32 m0, %2\n\ts_nop 0\n\tglobal_load_lds_dwordx4 %1, off\n\ts_mov_b32 m0, %0":"=&s"(keep):"v"(gsrc),"s"(lds_dst):"memory");}
__device__ __forceinline__ float max3f(float a,float b,float c){float r;asm("v_max3_f32 %0, %1, %2, %3":"=v"(r):"v"(a),"v"(b),"v"(c));return r;}
__device__ __forceinline__ float max2f(float a,float b){float r;asm("v_max_f32_e32 %0, %1, %2":"=v"(r):"v"(a),"v"(b));return r;}
__device__ __forceinline__ float fadd_s(float a,float b){float r;asm("v_add_f32_e32 %0, %1, %2":"=v"(r):"v"(a),"v"(b));return r;}
__device__ __forceinline__ float fsub_s(float a,float b){float r;asm("v_sub_f32_e32 %0, %1, %2":"=v"(r):"v"(a),"v"(b));return r;}
typedef float f32x2_t __attribute__((ext_vector_type(2))); typedef __bf16 bf16x2_t __attribute__((ext_vector_type(2)));
__device__ __forceinline__ unsigned cvtpk_s(float lo,float hi){f32x2_t v={lo,hi};bf16x2_t b=__builtin_convertvector(v,bf16x2_t);return __builtin_bit_cast(unsigned,b);}
#define WAIT_BAR(N) asm volatile("s_waitcnt vmcnt(" #N ") lgkmcnt(0)\n\ts_barrier":::"memory")

__device__ __forceinline__ void qkt(f32x16&p0,f32x16&p1,const char*Kslot,const bf16x8*qr,const f32x16&negm,int r32,int hi){
  const char*kb=Kslot+hi*1024+r32*16;
  #pragma unroll
  for(int d0=0;d0<4;++d0){
    const bf16x8 b0=*reinterpret_cast<const bf16x8*>(kb+d0*2048);
    const bf16x8 b1=*reinterpret_cast<const bf16x8*>(kb+d0*2048+512);
    if(d0==0){p0=__builtin_amdgcn_mfma_f32_32x32x16_bf16(b0,qr[0],negm,0,0,0);p1=__builtin_amdgcn_mfma_f32_32x32x16_bf16(b1,qr[0],negm,0,0,0);}
    else{p0=__builtin_amdgcn_mfma_f32_32x32x16_bf16(b0,qr[d0],p0,0,0,0);p1=__builtin_amdgcn_mfma_f32_32x32x16_bf16(b1,qr[d0],p1,0,0,0);}}
}
typedef __attribute__((address_space(3))) const char* lds_cptr;
typedef short v4i16_t __attribute__((ext_vector_type(4)));
__device__ __forceinline__ void kload8(bf16x8*kf,lds_cptr kp){
  kf[0]=*(const __attribute__((address_space(3))) bf16x8*)(kp);      kf[1]=*(const __attribute__((address_space(3))) bf16x8*)(kp+512);
  kf[2]=*(const __attribute__((address_space(3))) bf16x8*)(kp+2048); kf[3]=*(const __attribute__((address_space(3))) bf16x8*)(kp+2560);
  kf[4]=*(const __attribute__((address_space(3))) bf16x8*)(kp+4096); kf[5]=*(const __attribute__((address_space(3))) bf16x8*)(kp+4608);
  kf[6]=*(const __attribute__((address_space(3))) bf16x8*)(kp+6144); kf[7]=*(const __attribute__((address_space(3))) bf16x8*)(kp+6656);
}
__device__ __forceinline__ void kload2(bf16x8*kf,lds_cptr kp,int j){ kf[2*j]=*(const __attribute__((address_space(3))) bf16x8*)(kp+j*2048); kf[2*j+1]=*(const __attribute__((address_space(3))) bf16x8*)(kp+j*2048+512); }
__device__ __forceinline__ s16x4 vtr(lds_cptr p){ return __builtin_bit_cast(s16x4,__builtin_amdgcn_ds_read_tr16_b64_v4i16((__attribute__((address_space(3))) v4i16_t*)p)); }
__device__ __forceinline__ float rowmax(const f32x16&p0,const f32x16&p1){
  float a=max3f(p0[0],p0[1],p1[0]),b=max3f(p0[2],p0[3],p1[1]);a=max3f(a,p1[2],p1[3]);
  #pragma unroll
  for(int r=4;r<16;r+=4){a=max3f(a,p0[r],p0[r+1]);b=max3f(b,p0[r+2],p0[r+3]);a=max3f(a,p1[r],p1[r+1]);b=max3f(b,p1[r+2],p1[r+3]);}
  const float m=max2f(a,b);
  auto rr=__builtin_amdgcn_permlane32_swap(__float_as_uint(m),__float_as_uint(m),false,false);
  return max2f(__uint_as_float(rr[0]),__uint_as_float(rr[1]));
}
__device__ __forceinline__ void pv(f32x16*o,int vb,bf16x8 pa0,bf16x8 pa1,bf16x8 pa2,bf16x8 pa3){
  #pragma unroll
  for(int d0=0;d0<2;++d0){s16x4 lo[4],hi[4];
    #pragma unroll
    for(int ks=0;ks<4;++ks){
      asm volatile("ds_read_b64_tr_b16 %0,%1 offset:%c2":"=&v"(lo[ks]):"v"(vb),"i"(d0*4096+ks*1024):"memory");
      asm volatile("ds_read_b64_tr_b16 %0,%1 offset:%c2":"=&v"(hi[ks]):"v"(vb),"i"(d0*4096+ks*1024+512):"memory");}
    asm volatile("s_waitcnt lgkmcnt(0)":::"memory");SBAR();
    #define PK(k) (bf16x8){lo[k][0],lo[k][1],lo[k][2],lo[k][3],hi[k][0],hi[k][1],hi[k][2],hi[k][3]}
    o[d0]=__builtin_amdgcn_mfma_f32_32x32x16_bf16(pa0,PK(0),o[d0],0,0,0);
    o[d0]=__builtin_amdgcn_mfma_f32_32x32x16_bf16(pa1,PK(1),o[d0],0,0,0);
    o[d0]=__builtin_amdgcn_mfma_f32_32x32x16_bf16(pa2,PK(2),o[d0],0,0,0);
    o[d0]=__builtin_amdgcn_mfma_f32_32x32x16_bf16(pa3,PK(3),o[d0],0,0,0);
    #undef PK
  }
}

#ifndef ATTN_STORE16
#define ATTN_STORE16(p,v) (*(u32x4*)(p)=(v))
#endif
template<int THRL,bool FIXED> __device__ __forceinline__ void attn_unit(int b,int h,int g,int qb,const bf16*Q,const bf16*__restrict__ K,const bf16*__restrict__ V,bf16*O,char*shm,float mfix){
  const int tid=otid(),lane=tid&63,r32=lane&31,hi=lane>>5; const int wid=__builtin_amdgcn_readfirstlane(tid>>6);
  const long rowbase=(long)b*SEQ; const int q0=qb*QB;
  const bf16*Qw=Q+(rowbase+q0+wid*QBLK)*PQ+h*D;
  const bf16*Kh=K+rowbase*PQ+g*D,*Vh=V+rowbase*PQ+g*D;
  const unsigned lds0=(unsigned)(uintptr_t)shm;
  float*wsf=(float*)(shm+LDS_WS)+wid*64;
  const bf16*ksrc=Kh+(long)lane*PQ+wid*8;
  const bf16*vsrc=Vh+(long)(16*(wid&3)+(lane>>2))*PQ+(wid>>2)*32+(lane&3)*8;
  const unsigned kdst=lds0+LDS_K+wid*1024, vdst=lds0+LDS_V+wid*1024;
  #define DMA_K(t,slot) glds16(ksrc+(long)(t)*KVBLK*PQ,(unsigned)__builtin_amdgcn_readfirstlane(kdst+(slot)))
  #define DMA_V(t,slot) glds16(vsrc+(long)(t)*KVBLK*PQ,(unsigned)__builtin_amdgcn_readfirstlane(vdst+(slot)))
  const int vb0=(int)(lds0+LDS_V)+((lane>>4)&1)*32+(lane&3)*8+(4*hi+((lane&15)>>2))*64;
  const char*Kbase=shm+LDS_K; bf16x8 kf[8];
  const lds_cptr shm3=(lds_cptr)shm; const lds_cptr kp0=shm3+LDS_K+hi*1024+r32*16; const lds_cptr vp0=shm3+LDS_V+((lane>>4)&1)*32+(lane&3)*8+(4*hi+((lane&15)>>2))*64;
  constexpr int NT=SEQ/KVBLK;
  DMA_K(0,0);DMA_V(0,0);DMA_K(1,SLOTB);
  bf16x8 qr[4];
  #pragma unroll
  for(int d0=0;d0<4;++d0)qr[d0]=*reinterpret_cast<const bf16x8*>(&Qw[(long)r32*PQ+d0*16+hi*8]);
  float mhat=0.f,l_reg=0.f;f32x16 o[2];o[0]=f32x16{};o[1]=f32x16{};f32x16 negm=f32x16{};asm volatile("":"+v"(negm));
    #define CMASK(P0,P1,t) do{}while(0)
  bool resc=false;
  #define START(P0,P1) do{ const float rm=FIXED?mfix:rowmax(P0,P1); resc=false; \
    { const float dl=rm; mhat=fadd_s(mhat,dl); \
      _Pragma("unroll") for(int r=0;r<16;++r){P0[r]=fsub_s(P0[r],dl);P1[r]=fsub_s(P1[r],dl);} \
      _Pragma("unroll") for(int r=0;r<16;++r)negm[r]=-mhat; asm volatile("":"+v"(negm)); } \
    _Pragma("unroll") for(int r=0;r<16;++r)P0[r]=__builtin_amdgcn_exp2f(P0[r]); }while(0)
  #define RESC() do{ if(resc){ asm volatile("s_waitcnt lgkmcnt(0)":::"memory"); \
      _Pragma("unroll") for(int d_=0;d_<2;++d_) _Pragma("unroll") for(int r=0;r<16;++r)o[d_][r]*=wsf[crow(r,hi)]; } }while(0)
  f32x16 pA0,pA1,pB0,pB1;
  int sl_prev=0,sl_cur=0,sl_next=SLOTB;
  #define ROT() do{sl_prev=sl_cur;sl_cur=sl_next;sl_next=(sl_next==(NSLOT-1)*SLOTB)?0:sl_next+SLOTB;}while(0)
  DMA_K(2,2*SLOTB);
  WAIT_BAR(3);
  qkt(pA0,pA1,Kbase,qr,negm,r32,hi);asm volatile("s_nop 15\n\ts_nop 7":"+v"(pA0),"+v"(pA1));CMASK(pA0,pA1,0);
  START(pA0,pA1);
  _Pragma("unroll") for(int r=0;r<16;++r)pA1[r]=__builtin_amdgcn_exp2f(pA1[r]);
  WAIT_BAR(0);
  DMA_K(3,0);DMA_V(1,SLOTB);
  ROT();
  kload8(kf,kp0+sl_cur);
  WAIT_BAR(2);
  s16x4 vlo[8],vhi[8]; u32x4 pw0,pw1,pw2,pw3;
  #define PKW(P,B) cvtpk_s(P[B],P[B+1])
  #define PAF(k) __builtin_bit_cast(bf16x8,pw##k)
  #define VFR(i) (bf16x8){vlo[i][0],vlo[i][1],vlo[i][2],vlo[i][3],vhi[i][0],vhi[i][1],vhi[i][2],vhi[i][3]}
  #define PIN(x) asm volatile("":"+v"(x))
  #define MX3(a,b,c) __builtin_fmaxf(__builtin_fmaxf((a),(b)),(c))
  #define GAPA(MF,A0,A1,A2,A3,W0,W1,PW) do{ MF; sacc+=A0; sacc+=A1; sacc+=A2; sacc+=A3; PIN(sacc); W0; W1; PIN(PW); SBAR(); }while(0)
  #define EX(v) __builtin_amdgcn_exp2f(v)
  #define GAPB(MF,X,B) do{ MF; X[B]=EX(X[B]); X[B+1]=EX(X[B+1]); X[B+2]=EX(X[B+2]); X[B+3]=EX(X[B+3]); PIN(X); SBAR(); }while(0)
  #define VRD(i) do{ vlo[i]=vtr(vp_+(((i)>>2)*4096+((i)&3)*1024)); vhi[i]=vtr(vp_+(((i)>>2)*4096+((i)&3)*1024+512)); }while(0)
  #define KRD(G,j) do{ if(G){ kload2(kf,kp0+sl_next,j); SBAR(); } }while(0)
  #define STEP(C0,C1,P0,P1,t,GK,GV,GL) do{ SBAR(); \
    const lds_cptr vp_=vp0+sl_prev; \
    VRD(0); SBAR(); float sacc=(P0[0]+P0[1]); \
    GAPA(C0=__builtin_amdgcn_mfma_f32_32x32x16_bf16(kf[0],qr[0],negm,0,0,0), P0[2],P0[3],P0[4],P0[5],     pw0[0]=PKW(P0,0), pw0[1]=PKW(P0,2), pw0); \
    VRD(4); SBAR(); GAPA(C1=__builtin_amdgcn_mfma_f32_32x32x16_bf16(kf[1],qr[0],negm,0,0,0), P0[6],P0[7],P0[8],P0[9],     pw0[2]=PKW(P0,4), pw0[3]=PKW(P0,6), pw0); \
    VRD(1); SBAR(); GAPA(C0=__builtin_amdgcn_mfma_f32_32x32x16_bf16(kf[2],qr[1],C0,0,0,0),   P0[10],P0[11],P0[12],P0[13], pw1[0]=PKW(P0,8), pw1[1]=PKW(P0,10), pw1); \
    VRD(5); SBAR(); GAPA(C1=__builtin_amdgcn_mfma_f32_32x32x16_bf16(kf[3],qr[1],C1,0,0,0),   P0[14],P0[15],P1[0],P1[1],   pw1[2]=PKW(P0,12),pw1[3]=PKW(P0,14), pw1); \
    VRD(2); SBAR(); GAPA(C0=__builtin_amdgcn_mfma_f32_32x32x16_bf16(kf[4],qr[2],C0,0,0,0),   P1[2],P1[3],P1[4],P1[5],     pw2[0]=PKW(P1,0), pw2[1]=PKW(P1,2), pw2); \
    VRD(6); SBAR(); GAPA(C1=__builtin_amdgcn_mfma_f32_32x32x16_bf16(kf[5],qr[2],C1,0,0,0),   P1[6],P1[7],P1[8],P1[9],     pw2[2]=PKW(P1,4), pw2[3]=PKW(P1,6), pw2); \
    VRD(3); SBAR(); GAPA(C0=__builtin_amdgcn_mfma_f32_32x32x16_bf16(kf[6],qr[3],C0,0,0,0),   P1[10],P1[11],P1[12],P1[13], pw3[0]=PKW(P1,8), pw3[1]=PKW(P1,10), pw3); \
    VRD(7); SBAR(); GAPA(C1=__builtin_amdgcn_mfma_f32_32x32x16_bf16(kf[7],qr[3],C1,0,0,0),   P1[14],P1[15],0.f,0.f,       pw3[2]=PKW(P1,12),pw3[3]=PKW(P1,14), pw3); \
    l_reg+=sacc; \
    if(GK){DMA_K((t)+3,sl_cur);} if(GV){DMA_V((t)+1,sl_next);} \
    CMASK(C0,C1,t); \
    if(!FIXED){ float a=MX3(C0[0],C0[1],C1[0]),b=MX3(C0[2],C0[3],C1[1]); a=MX3(a,C1[2],C1[3]); \
      _Pragma("unroll") for(int r=4;r<16;r+=4){a=MX3(a,C0[r],C0[r+1]);b=MX3(b,C0[r+2],C0[r+3]);a=MX3(a,C1[r],C1[r+1]);b=MX3(b,C1[r+2],C1[r+3]);} \
      float rm=__builtin_fmaxf(a,b); { auto rr=__builtin_amdgcn_permlane32_swap(__float_as_uint(rm),__float_as_uint(rm),false,false); rm=__builtin_fmaxf(__uint_as_float(rr[0]),__uint_as_float(rr[1])); } \
      resc=false; \
      if(__builtin_expect(__any(rm>(float)THRL),0)){ const float dl=__builtin_fmaxf(rm,0.f); mhat+=dl; \
        _Pragma("unroll") for(int r=0;r<16;++r){C0[r]-=dl;C1[r]-=dl;} \
        _Pragma("unroll") for(int r=0;r<16;++r)negm[r]=-mhat; asm volatile("":"+v"(negm)); \
        const float f=__builtin_amdgcn_exp2f(-dl); l_reg*=f; if(hi==0)wsf[r32]=f; resc=true; } } \
    SBAR(); \
    GAPB(o[0]=__builtin_amdgcn_mfma_f32_32x32x16_bf16(PAF(0),VFR(0),o[0],0,0,0), C0,0); \
    GAPB(o[1]=__builtin_amdgcn_mfma_f32_32x32x16_bf16(PAF(0),VFR(4),o[1],0,0,0), C0,4); \
    KRD(GL,0); GAPB(o[0]=__builtin_amdgcn_mfma_f32_32x32x16_bf16(PAF(1),VFR(1),o[0],0,0,0), C0,8); \
    KRD(GL,1); GAPB(o[1]=__builtin_amdgcn_mfma_f32_32x32x16_bf16(PAF(1),VFR(5),o[1],0,0,0), C0,12); \
    KRD(GL,2); GAPB(o[0]=__builtin_amdgcn_mfma_f32_32x32x16_bf16(PAF(2),VFR(2),o[0],0,0,0), C1,0); \
    KRD(GL,3); GAPB(o[1]=__builtin_amdgcn_mfma_f32_32x32x16_bf16(PAF(2),VFR(6),o[1],0,0,0), C1,4); \
    GAPB(o[0]=__builtin_amdgcn_mfma_f32_32x32x16_bf16(PAF(3),VFR(3),o[0],0,0,0), C1,8); \
    GAPB(o[1]=__builtin_amdgcn_mfma_f32_32x32x16_bf16(PAF(3),VFR(7),o[1],0,0,0), C1,12); \
    }while(0)
  int t=1;
  #undef CMASK
  #define CMASK(P0,P1,t) do{}while(0)
  for(;t+5<NT;t+=2){
    STEP(pB0,pB1,pA0,pA1,t,true,true,true);     WAIT_BAR(2); RESC(); ROT();
    STEP(pA0,pA1,pB0,pB1,t+1,true,true,true);   WAIT_BAR(2); RESC(); ROT();
  }
  #define ENDW(tt) do{ if((tt)+3<NT){WAIT_BAR(2);} else if((tt)+2<NT){WAIT_BAR(1);} else {WAIT_BAR(0);} }while(0)
  for(;t+1<NT;t+=2){
    STEP(pB0,pB1,pA0,pA1,t,(t+3<NT),(t+1<NT),(t+1<NT));       ENDW(t);   RESC(); ROT();
    STEP(pA0,pA1,pB0,pB1,t+1,(t+4<NT),(t+2<NT),(t+2<NT));     ENDW(t+1); RESC(); ROT();
  }
  STEP(pB0,pB1,pA0,pA1,NT-1,false,false,false); RESC();
  { float sacc=pB0[0]+pB0[1]; _Pragma("unroll") for(int r=2;r<16;++r)sacc+=pB0[r]; _Pragma("unroll") for(int r=0;r<16;++r)sacc+=pB1[r]; l_reg+=sacc;
    pw0=(u32x4){PKW(pB0,0),PKW(pB0,2),PKW(pB0,4),PKW(pB0,6)};pw1=(u32x4){PKW(pB0,8),PKW(pB0,10),PKW(pB0,12),PKW(pB0,14)};pw2=(u32x4){PKW(pB1,0),PKW(pB1,2),PKW(pB1,4),PKW(pB1,6)};pw3=(u32x4){PKW(pB1,8),PKW(pB1,10),PKW(pB1,12),PKW(pB1,14)};
    SBAR(); pv(o,vb0+sl_cur,PAF(0),PAF(1),PAF(2),PAF(3)); }
  #undef PKW
  #undef PAF
  #undef VFR
  #undef PIN
  #undef MX3
  #undef GAPA
  #undef GAPB
  #undef EX
  #undef VRD
  #undef KRD
  #undef STEP
  #undef ENDW
  {auto rr=__builtin_amdgcn_permlane32_swap(__float_as_uint(l_reg),__float_as_uint(l_reg),false,false);l_reg=__uint_as_float(rr[0])+__uint_as_float(rr[1]);}
  if(hi==0)wsf[32+r32]=l_reg;asm volatile("s_waitcnt lgkmcnt(0)":::"memory");
  float rli[16];
  #pragma unroll
  for(int r=0;r<16;++r)rli[r]=__builtin_amdgcn_rcpf(wsf[32+crow(r,hi)]);
  bf16*Ow=O+(rowbase+q0+wid*QBLK)*PO+h*D;
  { bf16*stg=(bf16*)(shm+LDS_OST)+wid*2048;
    #pragma unroll
    for(int r=0;r<16;++r){const int orow=crow(r,hi);
      #pragma unroll
      for(int d0=0;d0<2;++d0)stg[orow*64+d0*32+r32]=__float2bfloat16(o[d0][r]*rli[r]);}
    asm volatile("s_waitcnt lgkmcnt(0)":::"memory");
    #pragma unroll
    for(int i=0;i<4;++i){const int row=i*8+(lane>>3),ch=lane&7; const u32x4 v=*(const u32x4*)(stg+row*64+ch*8); ATTN_STORE16(Ow+(long)row*PO+ch*8,v);} }
  asm volatile("s_waitcnt lgkmcnt(0)\n\ts_barrier":::"memory");
  #undef DMA_K
  #undef DMA_V
  #undef CMASK
  #undef START
  #undef RESC
  #undef ROT
}
constexpr int ATTN_LDS_BYTES=LDS_BYTES;
#undef SBAR
#undef WAIT_BAR
}

__device__ __forceinline__ void phase_attn(const Params& p, int layer, char* lds) {
    const int lane = otid() & 63;
    const float mq = wave_max(fabsf(p.in[I_QG][layer * 64 + lane])), mk = wave_max(fabsf(p.in[I_KG][layer * 64 + lane]));
    const float mfix = 64.0f * mq * mk * (0.125f * 1.4426950408889634f) * 1.02f;
    const bool fixed_ok = mfix < 48.0f;
    const int bid = obid();
    const int vcu = ((NBLK & 7) == 0) ? (bid & 7) * (int)(NBLK >> 3) + (bid >> 3) : bid;
    const attn_body::bf16* qkvb = (const attn_body::bf16*)(p.ws + R_QKV);
    for (int u = vcu; u < 512; u += NBLK) {
        const int bg = (u & 255) >> 6, r = u & 63, hh = r & 3, qb = (r >> 2) + 16 * (u >> 8);
        const int b = bg >> 1, g = bg & 1;
        if (fixed_ok) attn_body::attn_unit<8, true>(b, 4 * g + hh, g, qb, qkvb, qkvb + 512, qkvb + 640, (attn_body::bf16*)(p.ws + R_ATT), lds, mfix);
        else attn_body::attn_unit<8, false>(b, 4 * g + hh, g, qb, qkvb, qkvb + 512, qkvb + 640, (attn_body::bf16*)(p.ws + R_ATT), lds, 0.f);
    }
}

__device__ __forceinline__ size_t cidx(int c, int t) { return ((size_t)(t >> 5) * 256 + c) * 32 + (t & 31); }
__device__ __forceinline__ f32x4 convd4(const float* row, int l0, float w0, float w1, float w2, float cb) {
    const f32x4 c = *(const f32x4*)(row + l0);
    const float lft = (l0 > 0) ? row[l0 - 1] : 0.f;
    const float rgt = (l0 + 4 < SL) ? row[l0 + 4] : 0.f;
    f32x4 o;
    o.x = cb + w0 * lft + w1 * c.x + w2 * c.y;
    o.y = cb + w0 * c.x + w1 * c.y + w2 * c.z;
    o.z = cb + w0 * c.y + w1 * c.z + w2 * c.w;
    o.w = cb + w0 * c.z + w1 * c.w + w2 * rgt;
    return o;
}
__device__ __forceinline__ void cmul_kf(float2* Z, const float2* KF, int tid) {
#pragma unroll 4
    for (int i = 0; i < 16; ++i) {
        const int pp = 2 * tid + 1024 * i;
        const f32x4 z = *(const f32x4*)(Z + zp(pp)), k = *(const f32x4*)(KF + pp);
        f32x4 o; o.x = z.x * k.x - z.y * k.y; o.y = z.x * k.y + z.y * k.x; o.z = z.z * k.z - z.w * k.w; o.w = z.z * k.w + z.w * k.z;
        *(f32x4*)(Z + zp(pp)) = o;
    }
}
__device__ __forceinline__ void hyena_job(const Params& p, int layer, int c, char* lds) {
    const int tid = otid();
    float2* Z = (float2*)lds;
    const float* HF = (const float*)(p.ws + R_HF);
    const float* cw = p.in[I_CW] + (size_t)layer * 3 * 768; const float* cbp = p.in[I_CB] + layer * 768;
    const float2* KF0 = (const float2*)(p.ws + OFF_KF) + ((size_t)(layer * 256 + c) * 2) * 16384;
    const float2* KF1 = KF0 + 16384;
    float* Yb = (float*)(p.ws + R_Y);
    const int cv = c, c1 = 256 + c, c2 = 512 + c;
    const float* rv = HF + (size_t)cv * T; const float* r1 = HF + (size_t)c1 * T; const float* r2 = HF + (size_t)c2 * T;
    const float v_w0 = cw[cv], v_w1 = cw[768 + cv], v_w2 = cw[1536 + cv], v_cb = cbp[cv];
    const float a_w0 = cw[c1], a_w1 = cw[768 + c1], a_w2 = cw[1536 + c1], a_cb = cbp[c1];
    const float b_w0 = cw[c2], b_w1 = cw[768 + c2], b_w2 = cw[1536 + c2], b_cb = cbp[c2];
    const f32x4 zero4 = {0.f, 0.f, 0.f, 0.f};
    __syncthreads();
#pragma unroll 1
    for (int i = 0; i < 4; ++i) {
        const int l0 = 4 * otid() + 2048 * i;
        const f32x4 va = convd4(rv, l0, v_w0, v_w1, v_w2, v_cb), vb = convd4(rv + SL, l0, v_w0, v_w1, v_w2, v_cb);
        *(f32x4*)(Z + zp(l0)) = (f32x4){va.x, vb.x, va.y, vb.y}; *(f32x4*)(Z + zp(l0) + 2) = (f32x4){va.z, vb.z, va.w, vb.w};
        *(f32x4*)(Z + zp(8192 + l0)) = zero4; *(f32x4*)(Z + zp(8192 + l0) + 2) = zero4;
    }
    __syncthreads();
    fft16k_fwd(Z);
    cmul_kf(Z, KF0, otid());
    __syncthreads();
    fft16k_inv(Z);
#pragma unroll 1
    for (int i = 0; i < 4; ++i) {
        const int l0 = 4 * otid() + 2048 * i;
        const f32x4 za = *(const f32x4*)(Z + zp(l0)), zb = *(const f32x4*)(Z + zp(l0) + 2);
        const f32x4 ga = convd4(r1, l0, a_w0, a_w1, a_w2, a_cb), gb = convd4(r1 + SL, l0, a_w0, a_w1, a_w2, a_cb);
        *(f32x4*)(Z + zp(l0)) = (f32x4){ga.x * za.x, gb.x * za.y, ga.y * za.z, gb.y * za.w};
        *(f32x4*)(Z + zp(l0) + 2) = (f32x4){ga.z * zb.x, gb.z * zb.y, ga.w * zb.z, gb.w * zb.w};
        *(f32x4*)(Z + zp(8192 + l0)) = zero4; *(f32x4*)(Z + zp(8192 + l0) + 2) = zero4;
    }
    __syncthreads();
    fft16k_fwd(Z);
    cmul_kf(Z, KF1, otid());
    __syncthreads();
    fft16k_inv(Z);
#pragma unroll 1
    for (int i = 0; i < 4; ++i) {
        const int l0 = 4 * otid() + 2048 * i;
        const f32x4 za = *(const f32x4*)(Z + zp(l0)), zb = *(const f32x4*)(Z + zp(l0) + 2);
        const f32x4 ga = convd4(r2, l0, b_w0, b_w1, b_w2, b_cb), gb = convd4(r2 + SL, l0, b_w0, b_w1, b_w2, b_cb);
        f32x4 ya, yb;
        ya.x = ga.x * za.x; ya.y = ga.y * za.z; ya.z = ga.z * zb.x; ya.w = ga.w * zb.z;
        yb.x = gb.x * za.y; yb.y = gb.y * za.w; yb.z = gb.z * zb.y; yb.w = gb.w * zb.w;
        *(f32x4*)(Yb + cidx(c, l0)) = ya; *(f32x4*)(Yb + cidx(c, SL + l0)) = yb;
    }
    __syncthreads();
}

__device__ __forceinline__ void fnet_job(const Params& p, int ch, char* lds) {
    const int tid = otid();
    float2* Z = (float2*)lds;
    const float* row = (const float*)(p.ws + R_HF) + (size_t)(768 + ch) * T;
    float* UR = (float*)(p.ws + R_UR);
    float* UI = (float*)(p.ws + R_UI);
    __syncthreads();
#pragma unroll
    for (int i = 0; i < 4; ++i) {
        const int l0 = 4 * tid + 2048 * i;
        const f32x4 a = *(const f32x4*)(row + l0), b = *(const f32x4*)(row + SL + l0);
        const int z0 = zp(l0);
        *(f32x4*)(Z + z0) = (f32x4){a.x, b.x, a.y, b.y}; *(f32x4*)(Z + z0 + 2) = (f32x4){a.z, b.z, a.w, b.w};
    }
    __syncthreads();
    fft8k_fwd(Z);
#pragma unroll
    for (int i = 0; i < 4; ++i) {
        const int k0 = 4 * tid + 2048 * i;
        f32x4 ur0, ui0, ur1, ui1;
#pragma unroll
        for (int e = 0; e < 4; ++e) {
            const int k = k0 + e;
            const int pk = p8k_of_f(k);
            const int pm = p8k_of_f((SL - k) & (SL - 1));
            const float2 zk = Z[zp(pk)], zm = Z[zp(pm)];
            ur0[e] = 0.5f * (zk.x + zm.x); ui0[e] = 0.5f * (zk.y - zm.y);
            ur1[e] = 0.5f * (zk.y + zm.y); ui1[e] = 0.5f * (zm.x - zk.x);
        }
        *(f32x4*)(UR + cidx(ch, k0)) = ur0; *(f32x4*)(UI + cidx(ch, k0)) = ui0; *(f32x4*)(UR + cidx(ch, SL + k0)) = ur1; *(f32x4*)(UI + cidx(ch, SL + k0)) = ui1;
    }
    __syncthreads();
}

__device__ __forceinline__ void phase_mix(const Params& p, int layer, char* lds) {
    const int tid = otid(), lane = tid & 63, wave = tid >> 6;
    const int l31 = lane & 31, hl = lane >> 5, g = wave & 3, tsel = wave >> 2;
    float* ex = (float*)lds;
    float* FMl = (float*)(lds + 8192);
    const float* UR = (const float*)(p.ws + R_UR); const float* UI = (const float*)(p.ws + R_UI);
    const float* Y = (const float*)(p.ws + R_Y);
    const bf16_t* att = (const bf16_t*)(p.ws + R_ATT);
    bf16_t* mix = (bf16_t*)(p.ws + R_MIX);
    const float* fb = p.in[I_FB] + layer * 256 + g * 64;
    const float* mg = p.in[I_MG] + layer * 1024;
    __syncthreads();
    {
        const f32x4* src = (const f32x4*)((const float*)(p.ws + OFF_FM) + (size_t)layer * 4 * 128 * 64);
#pragma unroll 4
        for (int i = 0; i < 16; ++i) *(f32x4*)(FMl + 4 * (tid + NTHR * i)) = src[tid + NTHR * i];
    }
    for (int tp = obid(); tp < T / 64; tp += NBLK) {
        const int t = (tp * 2 + tsel) * 32 + l31;
        float bv[64];
        {
            const float* ub = UR + cidx(g * 64 + hl, t);
            const float* ub2 = UI + cidx(g * 64 + hl, t);
#pragma unroll
            for (int i = 0; i < 32; ++i) { bv[i] = ub[(2 * i) * 32]; bv[32 + i] = ub2[(2 * i) * 32]; }
        }
        float yv[32];
        {
            const float* yb = Y + cidx(g * 64 + hl * 32, t);
#pragma unroll
            for (int i = 0; i < 32; ++i) yv[i] = yb[i * 32];
        }
        const bf16_t* ab = att + (size_t)t * 512 + g * 128 + hl * 64;
        float sa = 0.f;
#pragma unroll
        for (int q = 0; q < 8; ++q) {
            const u32x4 a = *(const u32x4*)(ab + 8 * q);
            const float x0 = bflo(a.x), x1 = bfhi(a.x), x2 = bflo(a.y), x3 = bfhi(a.y), x4 = bflo(a.z), x5 = bfhi(a.z), x6 = bflo(a.w), x7 = bfhi(a.w);
            sa += x0 * x0 + x1 * x1 + x2 * x2 + x3 * x3 + x4 * x4 + x5 * x5 + x6 * x6 + x7 * x7;
        }
        __syncthreads();
        f32x16 acc0 = zero16(), acc1 = zero16();
        {
            const float* fa = FMl + (g * 128 + hl) * 64 + l31;
#pragma unroll
            for (int i = 0; i < 64; ++i) {
                const float a0 = fa[(2 * i) * 64], a1 = fa[(2 * i) * 64 + 32];
                acc0 = __builtin_amdgcn_mfma_f32_32x32x2f32(a0, bv[i], acc0, 0, 0, 0);
                acc1 = __builtin_amdgcn_mfma_f32_32x32x2f32(a1, bv[i], acc1, 0, 0, 0);
            }
        }
        float sf = 0.f;
#pragma unroll
        for (int i = 0; i < 4; ++i) {
            const f32x4 b0 = *(const f32x4*)(fb + 8 * i + 4 * hl), b1 = *(const f32x4*)(fb + 32 + 8 * i + 4 * hl);
            acc0[4 * i] += b0.x; acc0[4 * i + 1] += b0.y; acc0[4 * i + 2] += b0.z; acc0[4 * i + 3] += b0.w;
            acc1[4 * i] += b1.x; acc1[4 * i + 1] += b1.y; acc1[4 * i + 2] += b1.z; acc1[4 * i + 3] += b1.w;
        }
#pragma unroll
        for (int r = 0; r < 16; ++r) sf += acc0[r] * acc0[r] + acc1[r] * acc1[r];
        float sy = 0.f;
#pragma unroll
        for (int i = 0; i < 32; ++i) sy += yv[i] * yv[i];
        ex[(0 * 8 + wave) * 64 + lane] = sa; ex[(1 * 8 + wave) * 64 + lane] = sy; ex[(2 * 8 + wave) * 64 + lane] = sf;
        __syncthreads();
        float ta = 0.f, ty = 0.f, tf = 0.f;
#pragma unroll
        for (int w = 0; w < 4; ++w)
#pragma unroll
            for (int hh = 0; hh < 2; ++hh) {
                const int o = (tsel * 4 + w) * 64 + hh * 32 + l31;
                ta += ex[0 * 512 + o]; ty += ex[1 * 512 + o]; tf += ex[2 * 512 + o];
            }
        const float ra = rsqrtf(ta * (1.0f / 512.0f) + EPS), ry = rsqrtf(ty * (1.0f / 256.0f) + EPS), rf = rsqrtf(tf * (1.0f / 256.0f) + EPS);
        bf16_t* mrow = mix + (size_t)t * 1024;
        {
            const float* gg = mg + g * 128 + hl * 64;
#pragma unroll
            for (int q = 0; q < 8; ++q) {
                const u32x4 a = *(const u32x4*)(ab + 8 * q);
                const f32x4 g0 = *(const f32x4*)(gg + 8 * q), g1 = *(const f32x4*)(gg + 8 * q + 4);
                u32x4 o;
                o.x = pk2(bflo(a.x) * ra * g0.x, bfhi(a.x) * ra * g0.y); o.y = pk2(bflo(a.y) * ra * g0.z, bfhi(a.y) * ra * g0.w);
                o.z = pk2(bflo(a.z) * ra * g1.x, bfhi(a.z) * ra * g1.y); o.w = pk2(bflo(a.w) * ra * g1.z, bfhi(a.w) * ra * g1.w);
                *(u32x4*)(mrow + g * 128 + hl * 64 + 8 * q) = o;
            }
        }
        {
            const float* gg = mg + 512 + g * 64 + hl * 32;
#pragma unroll
            for (int q = 0; q < 4; ++q) {
                const f32x4 g0 = *(const f32x4*)(gg + 8 * q), g1 = *(const f32x4*)(gg + 8 * q + 4);
                u32x4 o;
                o.x = pk2(yv[8 * q] * ry * g0.x, yv[8 * q + 1] * ry * g0.y); o.y = pk2(yv[8 * q + 2] * ry * g0.z, yv[8 * q + 3] * ry * g0.w);
                o.z = pk2(yv[8 * q + 4] * ry * g1.x, yv[8 * q + 5] * ry * g1.y); o.w = pk2(yv[8 * q + 6] * ry * g1.z, yv[8 * q + 7] * ry * g1.w);
                *(u32x4*)(mrow + 512 + g * 64 + hl * 32 + 8 * q) = o;
            }
        }
        {
            const float* gg = mg + 768 + g * 64;
#pragma unroll
            for (int i = 0; i < 4; ++i) {
                const f32x4 g0 = *(const f32x4*)(gg + 8 * i + 4 * hl), g1 = *(const f32x4*)(gg + 32 + 8 * i + 4 * hl);
                u32x2 o0, o1;
                o0.x = pk2(acc0[4 * i] * rf * g0.x, acc0[4 * i + 1] * rf * g0.y); o0.y = pk2(acc0[4 * i + 2] * rf * g0.z, acc0[4 * i + 3] * rf * g0.w);
                o1.x = pk2(acc1[4 * i] * rf * g1.x, acc1[4 * i + 1] * rf * g1.y); o1.y = pk2(acc1[4 * i + 2] * rf * g1.z, acc1[4 * i + 3] * rf * g1.w);
                *(u32x2*)(mrow + 768 + g * 64 + 8 * i + 4 * hl) = o0;
                *(u32x2*)(mrow + 768 + g * 64 + 32 + 8 * i + 4 * hl) = o1;
            }
        }
    }
}

__device__ __forceinline__ float tk_pack(float v, unsigned code, unsigned mask) { return __builtin_bit_cast(float, (__builtin_bit_cast(unsigned, v) & ~mask) | code); }
__device__ __forceinline__ unsigned tk_lookup(const unsigned (&P)[4], unsigned i) {
    const unsigned w = (i < 4u) ? P[0] : (i < 8u) ? P[1] : (i < 12u) ? P[2] : P[3];
    return (w >> ((i & 3u) * 8u)) & 0x7Fu;
}
__device__ __forceinline__ float gelu_exact(float x) { return 0.5f * x * (1.0f + erff(x * 0.70710678118654752f)); }
typedef float f32x2 __attribute__((ext_vector_type(2)));
#define CVT_LO(W) __builtin_amdgcn_cvt_pk_f32_fp8((int)(W), false)
#define CVT_HI(W) __builtin_amdgcn_cvt_pk_f32_fp8((int)(W), true)


__device__ __forceinline__ void tk_sort16(float (&a)[16]) {
#pragma unroll
    for (int k = 2; k <= 16; k <<= 1)
#pragma unroll
        for (int j = k >> 1; j > 0; j >>= 1)
#pragma unroll
            for (int i = 0; i < 16; ++i) {
                const int l = i ^ j;
                if (l > i) {
                    const float hi = fmaxf(a[i], a[l]), lo = fminf(a[i], a[l]);
                    if ((i & k) == 0) { a[i] = hi; a[l] = lo; } else { a[i] = lo; a[l] = hi; }
                }
            }
}
__device__ __forceinline__ void tk_merge16(float (&a)[16]) {
#pragma unroll
    for (int j = 8; j > 0; j >>= 1)
#pragma unroll
        for (int i = 0; i < 16; ++i) {
            const int l = i ^ j;
            if (l > i) { const float hi = fmaxf(a[i], a[l]), lo = fminf(a[i], a[l]); a[i] = hi; a[l] = lo; }
        }
}
__device__ __forceinline__ void tk_top16_merge(float (&l)[16], const float (&g)[16]) {
#pragma unroll
    for (int i = 0; i < 16; ++i) l[i] = fmaxf(l[i], g[15 - i]);
    tk_merge16(l);
}
template <int CTRL> __device__ __forceinline__ float dpp_f(float v) { return __builtin_bit_cast(float, __builtin_amdgcn_update_dpp(0, __builtin_bit_cast(int, v), CTRL, 0xF, 0xF, false)); }
template <int CTRL> __device__ __forceinline__ int dpp_i(int v) { return __builtin_amdgcn_update_dpp(0, v, CTRL, 0xF, 0xF, false); }
constexpr int PE_LOGR = 4, PE_NR = 1 << PE_LOGR;
constexpr int PE_ENT = 12 * 1024;
constexpr int PE_WAVE = PE_ENT;


#define PE_RL(k) (((k & 4) << 1) | ((k & 2) << 3) | ((k & 1) << 5))
#define PE_LOAD_U(TK, RW, EV, CU, CG) do { \
        const int base_ = ((TK) * 128 + r * 8 + eid) * 3; \
        EV = ent[base_]; CU = __builtin_bit_cast(float, ent[base_ + 1]); CG = __builtin_bit_cast(float, ent[base_ + 2]); \
        _Pragma("unroll") for (int k = 0; k < 8; ++k) { const unsigned e = (unsigned)__builtin_amdgcn_readlane(EV, PE_RL(k)); \
            RW[k] = *(const u32x4*)(PU + (size_t)(e * 1024u) + loff); } \
    } while (0)
#define PE_COMP_U(TK, RW, CU, CG) do { \
        int d[8]; \
        _Pragma("unroll") for (int k = 0; k < 8; ++k) { int s_ = __builtin_amdgcn_sdot4((int)RW[k].x, xq[TK][0], 0, false); \
            s_ = __builtin_amdgcn_sdot4((int)RW[k].y, xq[TK][1], s_, false); s_ = __builtin_amdgcn_sdot4((int)RW[k].z, xq[TK][2], s_, false); \
            d[k] = __builtin_amdgcn_sdot4((int)RW[k].w, xq[TK][3], s_, false); } \
        _Pragma("unroll") for (int k = 0; k < 8; ++k) { d[k] += dpp_i<0xB1>(d[k]); d[k] += dpp_i<0x4E>(d[k]); d[k] += dpp_i<0x141>(d[k]); } \
        int r4[4], r2[2], u1; \
        _Pragma("unroll") for (int k = 0; k < 4; ++k) { const int send = b3 ? d[k] : d[k + 4], keep = b3 ? d[k + 4] : d[k]; r4[k] = keep + dpp_i<0x140>(send); } \
        _Pragma("unroll") for (int k = 0; k < 2; ++k) { const int send = b4 ? r4[k] : r4[k + 2], keep = b4 ? r4[k + 2] : r4[k]; r2[k] = keep + __shfl_xor(send, 16); } \
        { const int send = b5 ? r2[0] : r2[1], keep = b5 ? r2[1] : r2[0]; u1 = keep + __shfl_xor(send, 32); } \
        const float av = gelu_exact((float)u1 * (CU * sx[TK])) * CG; \
        if ((lane & 7) == 0) ent[((TK) * 128 + r * 8 + eid) * 3 + 1] = __builtin_bit_cast(int, av);     \
    } while (0)
#define PE_LOAD_V(TK, RW, AV) do { \
        const int base_ = ((TK) * 128 + r * 8 + eid) * 3; \
        const int ev = ent[base_]; AV = ent[base_ + 1]; \
        _Pragma("unroll") for (int k = 0; k < 8; ++k) { const unsigned e = (unsigned)__builtin_amdgcn_readlane(ev, PE_RL(k)); \
            RW[k] = *(const u32x4*)(PV + (size_t)(e * 1024u) + loff); } \
    } while (0)
#define PE_COMP_V(TK, RW, AV) do { \
        _Pragma("unroll") for (int k = 0; k < 8; ++k) { \
            const float a = __builtin_bit_cast(float, __builtin_amdgcn_readlane(AV, PE_RL(k))); \
            const f32x2 a2 = (f32x2){a, a}; \
            acc[TK][0] += a2 * CVT_LO(RW[k].x); acc[TK][1] += a2 * CVT_HI(RW[k].x); acc[TK][2] += a2 * CVT_LO(RW[k].y); acc[TK][3] += a2 * CVT_HI(RW[k].y); \
            acc[TK][4] += a2 * CVT_LO(RW[k].z); acc[TK][5] += a2 * CVT_HI(RW[k].z); acc[TK][6] += a2 * CVT_LO(RW[k].w); acc[TK][7] += a2 * CVT_HI(RW[k].w); } \
    } while (0)

template <bool DRY> __device__ __forceinline__ void phase_peer_fused(const Params& p, int layer, char* lds) {
    const int tid = otid(), lane = tid & 63, wave = tid >> 6;
    const unsigned char* PU = p.ws + OFF_PU + (size_t)layer * 16384 * 1024;
    const unsigned char* PV = p.ws + OFF_PV + (size_t)layer * 16384 * 1024;
    const float* SU = (const float*)(p.ws + OFF_PSC) + (size_t)layer * 16384;
    const float* SV = (const float*)(p.ws + OFF_PSC) + (size_t)(2 + layer) * 16384;
    bf16_t* XN = (bf16_t*)(p.ws + R_XN);
    float* XA = (float*)(p.ws + OFF_XA);
    const _Float16* SC = (const _Float16*)(p.ws + R_QP);
    const bool last = (layer == NLAYER - 1);
    const float* gnext = last ? p.in[I_FG] : p.in[I_N1G] + (layer + 1) * DM;
    const float* g2p = p.in[I_N2G] + layer * DM;
    const bool b5 = (lane & 32) != 0, b4 = (lane & 16) != 0, b3 = (lane & 8) != 0;
    const int eid = ((lane >> 3) & 1) * 4 + ((lane >> 4) & 1) * 2 + (lane >> 5);
    const unsigned loff = (unsigned)lane * 16u;
    int* ent = (int*)(lds + wave * PE_WAVE);
    const float NINF = -3.0e38f;
    const int pp = lane & 1;
    for (int tb = (obid() * NWAVE + wave) * 8; tb < T; tb += NBLK * NWAVE * 8) {
#pragma unroll 1
        for (int grp = 0; grp < 2; ++grp) {
            const int tkl = grp * 4 + (lane >> 4), h = (lane >> 1) & 7;
            const f16x8* src = (const f16x8*)(SC + (size_t)(tb + tkl) * 2048 + h * 256 + pp * 128);
            float l[16];
#pragma unroll
            for (int i = 0; i < 16; ++i) l[i] = NINF;
#pragma unroll 1
            for (int c = 0; c < 4; ++c) {
                f32x4 v[8];
#pragma unroll
                for (int j = 0; j < 4; ++j) {
                    const f16x8 hv = src[c * 4 + j];
                    v[2 * j] = (f32x4){(float)hv[0], (float)hv[1], (float)hv[2], (float)hv[3]};
                    v[2 * j + 1] = (f32x4){(float)hv[4], (float)hv[5], (float)hv[6], (float)hv[7]};
                }
#pragma unroll
                for (int hh = 0; hh < 2; ++hh) {
                    float g[16];
#pragma unroll
                    for (int j = 0; j < 4; ++j) {
                        const unsigned kb = (unsigned)(c * 32 + hh * 16 + j * 4);
                        g[4 * j] = tk_pack(v[hh * 4 + j].x, kb, 0x7Fu); g[4 * j + 1] = tk_pack(v[hh * 4 + j].y, kb + 1u, 0x7Fu);
                        g[4 * j + 2] = tk_pack(v[hh * 4 + j].z, kb + 2u, 0x7Fu); g[4 * j + 3] = tk_pack(v[hh * 4 + j].w, kb + 3u, 0x7Fu);
                    }
                    tk_sort16(g);
                    tk_top16_merge(l, g);
                }
            }
            float xw[16], ow[16]; unsigned PX[4] = {0u, 0u, 0u, 0u}, PO[4] = {0u, 0u, 0u, 0u};
#pragma unroll
            for (int i = 0; i < 16; ++i) {
                const float o = __shfl_xor(l[i], 1);
                const unsigned xb = __builtin_bit_cast(unsigned, l[i]), ob = __builtin_bit_cast(unsigned, o);
                xw[i] = __builtin_bit_cast(float, xb & ~0x7Fu); ow[i] = __builtin_bit_cast(float, ob & ~0x7Fu);
                PX[i >> 2] |= (xb & 0x7Fu) << ((i & 3) * 8); PO[i >> 2] |= (ob & 0x7Fu) << ((i & 3) * 8);
            }
            float f[16];
            {
                float c1[16];
#pragma unroll
                for (int i = 0; i < 16; ++i) { f[i] = NINF; c1[i] = NINF; }
                int cnt = 0;
#pragma unroll
                for (int i = 0; i < 16; ++i)
#pragma unroll
                    for (int j = i; j < 16; ++j)
                        if ((i + 1) * (j + 1) <= 16) {
                            float cv = xw[i] + ow[j];
                            const unsigned code = pp ? (unsigned)((j << 4) | i) : (unsigned)((i << 4) | j);
                            cv = tk_pack(cv, code, 0xFFu);
                            if (i == j) cv = pp ? NINF : cv;
                            if (cnt < 16) f[cnt & 15] = cv; else c1[cnt & 15] = cv;
                            ++cnt;
                        }
                tk_sort16(f); tk_sort16(c1);
                tk_top16_merge(f, c1);
                float gq[16];
#pragma unroll
                for (int i = 0; i < 16; ++i) gq[i] = __shfl_xor(f[i], 1);
                tk_top16_merge(f, gq);
            }
            unsigned P0[4], P1[4];
#pragma unroll
            for (int q = 0; q < 4; ++q) { P0[q] = pp ? PO[q] : PX[q]; P1[q] = pp ? PX[q] : PO[q]; }
            const float top = __builtin_bit_cast(float, __builtin_bit_cast(unsigned, f[0]) & ~0xFFu);
            float ev[16]; float den = 0.f;
#pragma unroll
            for (int r = 0; r < 16; ++r) { ev[r] = __expf(__builtin_bit_cast(float, __builtin_bit_cast(unsigned, f[r]) & ~0xFFu) - top); den += ev[r]; }
            const float rden = 1.0f / den;
#pragma unroll
            for (int r8 = 0; r8 < 8; ++r8) {
                const unsigned c0 = __builtin_bit_cast(unsigned, f[r8]) & 0xFFu, c1 = __builtin_bit_cast(unsigned, f[r8 + 8]) & 0xFFu;
                const unsigned code = pp ? c1 : c0;
                const float gate = (pp ? ev[r8 + 8] : ev[r8]) * rden;
                const int e = (int)(tk_lookup(P0, code >> 4) * 128u + tk_lookup(P1, code & 15u));
                const int o = (tkl * 128 + h * 16 + pp * 8 + r8) * 3;
                ent[o] = e; ent[o + 1] = __builtin_bit_cast(int, SU[e]); ent[o + 2] = __builtin_bit_cast(int, gate * SV[e]);
            }
        }
#pragma unroll 1
        for (int tk = 0; tk < 8; ++tk) {
            int* et = ent + tk * 384;
            const int eA = et[lane * 3], uA = et[lane * 3 + 1], gA = et[lane * 3 + 2];
            const int eB = et[(64 + lane) * 3], uB = et[(64 + lane) * 3 + 1], gB = et[(64 + lane) * 3 + 2];
            const int rA = eA >> (14 - PE_LOGR), rB = eB >> (14 - PE_LOGR);
            int base = 0;
#pragma unroll 1
            for (int r = 0; r < PE_NR; ++r) {
                const unsigned long long mA = __ballot(rA == r), mB = __ballot(rB == r);
                const int cA = __popcll(mA);
                if (rA == r) { const int q = base + (int)__builtin_amdgcn_mbcnt_hi((unsigned)(mA >> 32), __builtin_amdgcn_mbcnt_lo((unsigned)mA, 0u)); et[q * 3] = eA; et[q * 3 + 1] = uA; et[q * 3 + 2] = gA; }
                if (rB == r) { const int q = base + cA + (int)__builtin_amdgcn_mbcnt_hi((unsigned)(mB >> 32), __builtin_amdgcn_mbcnt_lo((unsigned)mB, 0u)); et[q * 3] = eB; et[q * 3 + 1] = uB; et[q * 3 + 2] = gB; }
                base += cA + __popcll(mB);
            }
        }
        {
            {
                int xq[8][4]; float sx[8];
#pragma unroll
                for (int tk = 0; tk < 8; ++tk) {
                    f32x4 xr[4]; float ss = 0.f;
#pragma unroll
                    for (int j = 0; j < 4; ++j) { xr[j] = *(const f32x4*)(XA + (size_t)(tb + tk) * DM + 4 * lane + 256 * j); ss += xr[j].x * xr[j].x + xr[j].y * xr[j].y + xr[j].z * xr[j].z + xr[j].w * xr[j].w; }
                    ss = wave_sum(ss);
                    const float rn = rsqrtf(ss * (1.0f / DM) + EPS);
                    float mx = 0.f;
#pragma unroll
                    for (int j = 0; j < 4; ++j) { const f32x4 gg = *(const f32x4*)(g2p + 4 * lane + 256 * j);
                        xr[j] = xr[j] * rn * gg; mx = fmaxf(mx, fmaxf(fmaxf(fabsf(xr[j].x), fabsf(xr[j].y)), fmaxf(fabsf(xr[j].z), fabsf(xr[j].w)))); }
                    mx = wave_max(mx);
                    const float qs = mx > 0.f ? 127.0f / mx : 1.0f;
                    sx[tk] = mx > 0.f ? mx * (1.0f / 127.0f) : 1.0f;
#pragma unroll
                    for (int j = 0; j < 4; ++j) xq[tk][j] = (int)pk_i8(xr[j] * qs);
                }
#pragma unroll 1
                for (int r = 0; r < 16; ++r) {
                    __syncthreads();
                    u32x4 rwA[8], rwB[8]; int evA, evB; float cuA, cgA, cuB, cgB;
                    PE_LOAD_U(0, rwA, evA, cuA, cgA);
                    PE_LOAD_U(1, rwB, evB, cuB, cgB); PE_COMP_U(0, rwA, cuA, cgA);
                    PE_LOAD_U(2, rwA, evA, cuA, cgA); PE_COMP_U(1, rwB, cuB, cgB);
                    PE_LOAD_U(3, rwB, evB, cuB, cgB); PE_COMP_U(2, rwA, cuA, cgA);
                    PE_LOAD_U(4, rwA, evA, cuA, cgA); PE_COMP_U(3, rwB, cuB, cgB);
                    PE_LOAD_U(5, rwB, evB, cuB, cgB); PE_COMP_U(4, rwA, cuA, cgA);
                    PE_LOAD_U(6, rwA, evA, cuA, cgA); PE_COMP_U(5, rwB, cuB, cgB);
                    PE_LOAD_U(7, rwB, evB, cuB, cgB); PE_COMP_U(6, rwA, cuA, cgA);
                    PE_COMP_U(7, rwB, cuB, cgB);
                }
            }
#pragma unroll 1
            for (int hv = 0; hv < 2; ++hv) {
            f32x2 acc[4][8];
#pragma unroll
            for (int tk = 0; tk < 4; ++tk)
#pragma unroll
                for (int j = 0; j < 8; ++j) acc[tk][j] = (f32x2){0.f, 0.f};
            const int* entv = ent;
            {
                int* ent = (int*)entv + hv * 4 * 128 * 3;
#pragma unroll 1
                for (int r = 0; r < 16; ++r) {
                    __syncthreads();
                    u32x4 rwA[8], rwB[8]; int avA, avB;
                    PE_LOAD_V(0, rwA, avA);
                    PE_LOAD_V(1, rwB, avB); PE_COMP_V(0, rwA, avA);
                    PE_LOAD_V(2, rwA, avA); PE_COMP_V(1, rwB, avB);
                    PE_LOAD_V(3, rwB, avB); PE_COMP_V(2, rwA, avA);
                    PE_COMP_V(3, rwB, avB);
                }
            }
#pragma unroll
            for (int tk = 0; tk < 4; ++tk) {
                const int t = tb + hv * 4 + tk;
                f32x4 x[4]; float ss = 0.f;
#pragma unroll
                for (int j = 0; j < 4; ++j) {
                    x[j] = *(const f32x4*)(XA + (size_t)t * DM + 4 * lane + 256 * j);
                    x[j].x += acc[tk][2 * j].x; x[j].y += acc[tk][2 * j].y; x[j].z += acc[tk][2 * j + 1].x; x[j].w += acc[tk][2 * j + 1].y;
                    ss += x[j].x * x[j].x + x[j].y * x[j].y + x[j].z * x[j].z + x[j].w * x[j].w;
                }
                ss = wave_sum(ss);
                const float rr = rsqrtf(ss * (1.0f / DM) + EPS);
                if (last) {
#pragma unroll
                    for (int j = 0; j < 4; ++j) { const f32x4 gg = *(const f32x4*)(gnext + 4 * lane + 256 * j); *(f32x4*)(p.out + (size_t)t * DM + 4 * lane + 256 * j) = x[j] * rr * gg; }
                } else {
#pragma unroll
                    for (int j = 0; j < 4; ++j) {
                        const f32x4 gg = *(const f32x4*)(gnext + 4 * lane + 256 * j);
                        *(f32x4*)((DRY ? p.out : XA) + (size_t)t * DM + 4 * lane + 256 * j) = x[j];
                        u32x2 w; w.x = pk2(x[j].x * rr * gg.x, x[j].y * rr * gg.y); w.y = pk2(x[j].z * rr * gg.z, x[j].w * rr * gg.w);
                        if (!DRY) *(u32x2*)(XN + (size_t)t * DM + 4 * lane + 256 * j) = w;
                    }
                }
            }
            }
        }
    }
}

#define LAS __attribute__((address_space(3)))
#define XB_TMO      128
#define XB_XCNT(j)  (256  + 64 * (j))
#define XB_XSUB(j)  (1280 + 64 * (j))
#define XB_XGEN(j)  (2304 + 64 * (j))
#define XB_TOP      3328
#define XB_TOPGEN   3392
#define XCD_BAR_WORDS 3456
#define XB_SPIN_CAP (1u << 20)
__device__ __forceinline__ unsigned xb_ld(unsigned* p)              { return __hip_atomic_load(p, __ATOMIC_RELAXED, __HIP_MEMORY_SCOPE_AGENT); }
__device__ __forceinline__ unsigned xb_add(unsigned* p, unsigned v) { return __hip_atomic_fetch_add(p, v, __ATOMIC_RELAXED, __HIP_MEMORY_SCOPE_AGENT); }
__device__ __forceinline__ unsigned xb_xcc_id() { return (unsigned)__builtin_amdgcn_s_getreg((3 << 11) | 20) & 0xFu; }
#define XB_SPIN(cond, bar) do { unsigned _sp = 0; while (cond) { __builtin_amdgcn_s_sleep(1); \
    if ((++_sp & 255u) == 0u) { if (xb_ld(&(bar)[XB_TMO])) break; if (_sp > XB_SPIN_CAP) { atomicAdd(&(bar)[XB_TMO], 1u); break; } } } } while (0)
struct XcdBarrier { unsigned* bar; unsigned x; volatile LAS unsigned* st; };
__device__ __forceinline__ XcdBarrier xcd_barrier_post(unsigned* bar, volatile LAS unsigned* st) {
    XcdBarrier b; b.bar = bar; b.x = xb_xcc_id(); b.st = st;
    if (threadIdx.x == 0) (void)xb_add(&bar[XB_XCNT(b.x)], 1u);
    return b;
}
__device__ __forceinline__ void xcd_barrier_complete(unsigned* bar, unsigned x, unsigned& nloc, unsigned& nx) {
    const unsigned G = NBLK;
    unsigned sum, cnt, mine, sp = 0u;
    for (;;) {
        sum = 0u; cnt = 0u; mine = 0u;
#pragma unroll
        for (unsigned j = 0; j < 16; ++j) { const unsigned c = xb_ld(&bar[XB_XCNT(j)]); sum += c; cnt += (c > 0u) ? 1u : 0u; mine = (j == x) ? c : mine; }
        if (sum == G) break;
        __builtin_amdgcn_s_sleep(1);
        if ((++sp & 255u) == 0u) { if (xb_ld(&bar[XB_TMO])) break; if (sp > XB_SPIN_CAP) { atomicAdd(&bar[XB_TMO], 1u); break; } }
    }
    nloc = mine > 0u ? mine : 1u; nx = cnt > 0u ? cnt : 1u;
}
__device__ __forceinline__ void xcd_barrier(const XcdBarrier& b) {
    asm volatile("s_waitcnt vmcnt(0)" ::: "memory");
    __syncthreads();
    if (threadIdx.x == 0) {
        unsigned* bar = b.bar;
        __builtin_amdgcn_s_waitcnt(0);
        unsigned nloc = b.st[0], nx = b.st[1];
        if (nloc == 0u) { xcd_barrier_complete(bar, b.x, nloc, nx); b.st[0] = nloc; b.st[1] = nx; }
        const unsigned old = xb_add(&bar[XB_XSUB(b.x)], 1u);
        const unsigned gen = old / nloc;
        if (old + 1u == (gen + 1u) * nloc) {
            __builtin_amdgcn_fence(__ATOMIC_RELEASE, "agent");
            asm volatile("s_waitcnt vmcnt(0)" ::: "memory");
            const unsigned og = xb_add(&bar[XB_TOP], 1u);
            const unsigned tg = og / nx;
            if (og + 1u == (tg + 1u) * nx) xb_add(&bar[XB_TOPGEN], 1u);
            else XB_SPIN(xb_ld(&bar[XB_TOPGEN]) == tg, bar);
            __builtin_amdgcn_fence(__ATOMIC_ACQUIRE, "agent");
            xb_add(&bar[XB_XGEN(b.x)], 1u);
            asm volatile("s_waitcnt vmcnt(0)" ::: "memory");
        } else {
            XB_SPIN(xb_ld(&bar[XB_XGEN(b.x)]) == gen, bar);
            __builtin_amdgcn_fence(__ATOMIC_ACQUIRE, "agent");
            asm volatile("s_waitcnt vmcnt(0)" ::: "memory");
        }
    }
    __syncthreads();
}


template <class Epi> __device__ __forceinline__ void big_gemm(const bf16_t* A, const bf16_t* Bt, int M, int N, int K, char* lds, const Epi& e) {
    pg8::Gemm g{A, Bt, M, N, K}; pg8::StaticOrder S; S.init(M, N, NBLK, obid());
    pg8::gemm_phase<Epi, pg8::StaticOrder, true, true>((PG8_LAS unsigned char*)lds, g, S, e);
}

#define GSYNC() xcd_barrier(xbar)
template <int layer> __device__ __forceinline__ void run_layer(const Params& p, char* lds, const XcdBarrier& xbar) {
    float* XA = (float*)(p.ws + OFF_XA);

        const float* xin = layer == 0 ? p.in[I_X] : XA;
        {
            const bf16_t* wt = (const bf16_t*)(p.ws + OFF_WTIN) + (size_t)layer * INC * DM;
            pg8::EpiStoreBf16 e1{(bf16_t*)(p.ws + R_QKV), 768};
            big_gemm((const bf16_t*)(p.ws + R_XN), wt, T, 768, DM, lds, e1);
            pg8::EpiStoreF32 e2{nullptr, (float*)(p.ws + R_HF), T};
            big_gemm(wt + (size_t)768 * DM, (const bf16_t*)(p.ws + R_XN), 1024, T, DM, lds, e2);
        }
        if (layer == 0) {
#pragma nounroll
            for (int fl = 0; fl < NLAYER; ++fl) {
                EpiF32 e{(float*)(p.ws + (fl ? OFF_HFILT1 : OFF_HFILT0)), SL};
                gemm_simple((const bf16_t*)(p.ws + OFF_W3T) + (size_t)fl * 1024 * 64, (const bf16_t*)(p.ws + OFF_H2) + (size_t)fl * SL * 64, 1024, SL, 64, lds, e);
            }
        }
        GSYNC();
        if (layer == 0) {
            phase_filter_spectra(p, lds);
        }
        phase_qkprep(p, layer, lds, (bf16_t*)(p.ws + R_QKV)); GSYNC();
        {
            phase_attn(p, layer, lds);
            for (int c = obid(); c < 256; c += NBLK) hyena_job(p, layer, c, lds);
            for (int c = obid(); c < 256; c += NBLK) fnet_job(p, c, lds);
        } GSYNC();
        phase_mix(p, layer, lds); GSYNC();
        { pg8::EpiOutProj e{xin, XA, (bf16_t*)(p.ws + R_XN), (float*)(p.ws + OFF_RS)};
          big_gemm((const bf16_t*)(p.ws + R_MIX), (const bf16_t*)(p.ws + OFF_WTOUT) + (size_t)layer * DM * DM, T, DM, DM, lds, e); } GSYNC();
        { pg8::EpiRowScaleF16 e{(_Float16*)(p.ws + R_QP), 2048, (const float*)(p.ws + OFF_RS)};
          big_gemm((const bf16_t*)(p.ws + R_XN), (const bf16_t*)(p.ws + OFF_WTQ) + (size_t)layer * 2048 * DM, T, 2048, DM, lds, e); } GSYNC();
        phase_peer_fused<false>(p, layer, lds);
        if (layer + 1 < NLAYER) GSYNC();
}

__global__ void __launch_bounds__(NTHR) mega_kernel(Params p) {
    extern __shared__ __attribute__((aligned(16))) char lds[];
    volatile LAS unsigned* misc = (volatile LAS unsigned*)((LAS char*)lds + LDS_MISC);
    if (threadIdx.x < 16) misc[threadIdx.x] = 0u;
    __syncthreads();
    const XcdBarrier xbar = xcd_barrier_post((unsigned*)(p.ws + OFF_CTL) + 4096, misc);
    float* XA = (float*)(p.ws + OFF_XA);
    phase_p0(p, lds);
    phase_rmsnorm_bf16(p.in[I_X], p.in[I_N1G], (bf16_t*)(p.ws + R_XN));
    GSYNC();
    run_layer<0>(p, lds, xbar);
    run_layer<1>(p, lds, xbar);
}

extern "C" void kernel_launch(void* const* d_in, const int* in_sizes, int n_in, void* d_out, int out_size, void* d_ws, size_t ws_size, hipStream_t stream) {
    static int grid = 0;
    if (grid == 0) {
        if (n_in != 25 || out_size != T * DM || ws_size < WS_NEED) { fprintf(stderr, "kernel_launch: unexpected sizes n_in %d out %d ws %zu (need %zu)\n", n_in, out_size, ws_size, (size_t)WS_NEED); grid = -1; return; }
        int dev = 0, cus = 0, per_cu = 0;
        if (hipGetDevice(&dev) != hipSuccess || hipDeviceGetAttribute(&cus, hipDeviceAttributeMultiprocessorCount, dev) != hipSuccess) { grid = -1; return; }
        if (hipFuncSetAttribute((const void*)mega_kernel, hipFuncAttributeMaxDynamicSharedMemorySize, LDS_BYTES) != hipSuccess) { fprintf(stderr, "kernel_launch: hipFuncSetAttribute failed\n"); grid = -1; return; }
        if (hipOccupancyMaxActiveBlocksPerMultiprocessor(&per_cu, (const void*)mega_kernel, NTHR, LDS_BYTES) != hipSuccess || per_cu < 1) { fprintf(stderr, "kernel_launch: occupancy query says %d blocks per CU\n", per_cu); grid = -1; return; }
        (void)hipGetLastError();
        if (cus < NBLK) { fprintf(stderr, "kernel_launch: built for a %d-CU device, found %d CUs\n", NBLK, cus); grid = -1; return; }
        grid = NBLK;
    }
    if (grid < 0) return;
    Params p{};
    for (int i = 0; i < 25; ++i) p.in[i] = (const float*)d_in[i];
    p.out = (float*)d_out; p.ws = (unsigned char*)d_ws;
    if (hipMemsetAsync((char*)d_ws + OFF_CTL, 0, 64 * 1024, stream) != hipSuccess) { fprintf(stderr, "kernel_launch: memset failed\n"); return; }
    void* args[] = {&p};
    hipError_t e = hipLaunchCooperativeKernel((const void*)mega_kernel, dim3(grid), dim3(NTHR), args, LDS_BYTES, stream);
    if (e != hipSuccess) fprintf(stderr, "cooperative launch failed: %s (grid %d)\n", hipGetErrorString(e), grid);
}
```

```cpp
#include <hip/hip_runtime.h>
#include <cstdio>
#include <cstdint>

typedef unsigned short bf16_t;
typedef short bf16x8 __attribute__((ext_vector_type(8)));
typedef float f32x16 __attribute__((ext_vector_type(16)));
typedef float f32x4 __attribute__((ext_vector_type(4)));
typedef unsigned u32x4 __attribute__((ext_vector_type(4)));
typedef unsigned u32x2 __attribute__((ext_vector_type(2)));
typedef _Float16 f16x4 __attribute__((ext_vector_type(4)));
typedef _Float16 f16x8 __attribute__((ext_vector_type(8)));

constexpr int DM = 1024, NB = 2, SL = 8192, T = NB * SL, NLAYER = 2;
constexpr int INC = 1792;
constexpr int NTHR = 512, NWAVE = 8;
constexpr int NBLK = 256;
constexpr int LDS_BYTES = 147456;
constexpr int LDS_MISC = LDS_BYTES - 64;
constexpr float EPS = 1e-6f;

constexpr size_t MiB = 1u << 20;
constexpr size_t OFF_CTL = 0;
constexpr size_t OFF_WTIN = 1 * MiB;
constexpr size_t OFF_WTOUT = 8 * MiB;
constexpr size_t OFF_WTQ = 12 * MiB;
constexpr size_t OFF_PU = 20 * MiB;
constexpr size_t OFF_PV = 84 * MiB;
constexpr size_t OFF_RS = 505 * MiB;
constexpr size_t OFF_PSC = 512 * 1024;
constexpr size_t OFF_H2 = 148 * MiB;
constexpr size_t OFF_W3T = 150 * MiB;
constexpr size_t OFF_HFILT0 = 52 * MiB, OFF_HFILT1 = 116 * MiB;
constexpr size_t OFF_FM = 152 * MiB;
constexpr size_t OFF_KF = 153 * MiB;
constexpr size_t OFF_XA = 281 * MiB;
constexpr size_t OFF_R = 345 * MiB;
constexpr size_t R_XN = OFF_R + 0 * MiB;
constexpr size_t R_UR = OFF_R + 0 * MiB;
constexpr size_t R_UI = OFF_R + 16 * MiB;
constexpr size_t R_QKV = OFF_R + 32 * MiB;
constexpr size_t R_HF = OFF_R + 60 * MiB;
constexpr size_t R_MIX = OFF_R + 60 * MiB;
constexpr size_t R_ATT = OFF_R + 124 * MiB;
constexpr size_t R_Y = OFF_R + 140 * MiB;
constexpr size_t R_QP = OFF_R + 32 * MiB;
constexpr size_t WS_NEED = 506 * MiB;

struct Params {
    const float* in[25];
    float* out;
    unsigned char* ws;
};
enum { I_X = 0, I_N1G, I_WIN, I_QG, I_KG, I_CW, I_CB, I_W1, I_B1, I_F1, I_W2, I_B2, I_F2, I_W3, I_HB, I_FW, I_FB, I_MG, I_WOUT, I_N2G, I_WQ, I_SK, I_PU, I_PV, I_FG };

__device__ __forceinline__ unsigned f2bf(float f) { unsigned u = __builtin_bit_cast(unsigned, f); return (u + 0x7fffu + ((u >> 16) & 1u)) >> 16; }
__device__ __forceinline__ unsigned pk2(float lo, float hi) { return f2bf(lo) | (f2bf(hi) << 16); }
__device__ __forceinline__ float bflo(unsigned w) { return __builtin_bit_cast(float, w << 16); }
__device__ __forceinline__ float bfhi(unsigned w) { return __builtin_bit_cast(float, w & 0xffff0000u); }
__device__ __forceinline__ float wave_sum(float v) {
#pragma unroll
    for (int o = 1; o < 64; o <<= 1) v += __shfl_xor(v, o);
    return v;
}
__device__ __forceinline__ float wave_max(float v) {
#pragma unroll
    for (int o = 1; o < 64; o <<= 1) v = fmaxf(v, __shfl_xor(v, o));
    return v;
}
__device__ __forceinline__ unsigned pk_i8(f32x4 v) {
    const int a = (int)rintf(v.x), b = (int)rintf(v.y), c = (int)rintf(v.z), d = (int)rintf(v.w);
    return ((unsigned)a & 0xFFu) | (((unsigned)b & 0xFFu) << 8) | (((unsigned)c & 0xFFu) << 16) | ((unsigned)d << 24);
}
__device__ __forceinline__ f32x16 mfma32(bf16x8 a, bf16x8 b, f32x16 c) { return __builtin_amdgcn_mfma_f32_32x32x16_bf16(a, b, c, 0, 0, 0); }
__device__ __forceinline__ f32x16 zero16() { return (f32x16){0.f,0.f,0.f,0.f,0.f,0.f,0.f,0.f,0.f,0.f,0.f,0.f,0.f,0.f,0.f,0.f}; }


__device__ __forceinline__ int otid() { int t = threadIdx.x; asm volatile("" : "+v"(t)); return t; }
__device__ __forceinline__ int obid() { int b = blockIdx.x; asm volatile("" : "+s"(b)); return b; }
__device__ __forceinline__ void transpose_one(const float* W, int K, int N, bf16_t* Wt, float* tile, int item) {
    const int tid = otid();
    const int nblk = N / 64, kb = item / nblk, nb = item % nblk, k0 = kb * 64, n0 = nb * 64;
    __syncthreads();
    {
        const int r = tid >> 6, c = tid & 63;
#pragma unroll
        for (int i = 0; i < 8; ++i) { const int k = r + 8 * i; tile[k * 65 + c] = W[(size_t)(k0 + k) * N + n0 + c]; }
    }
    __syncthreads();
    {
        const int nn = tid >> 3, kc = tid & 7;
        const float* s = tile + (kc * 8) * 65 + nn;
        u32x4 o; o.x = pk2(s[0], s[65]); o.y = pk2(s[2 * 65], s[3 * 65]); o.z = pk2(s[4 * 65], s[5 * 65]); o.w = pk2(s[6 * 65], s[7 * 65]);
        *(u32x4*)(Wt + (size_t)(n0 + nn) * K + k0 + kc * 8) = o;
    }
}

template <int PARTS = 31> __device__ __forceinline__ void phase_p0(const Params& p, char* lds) {
    const int tid = otid();
    float* tile = (float*)lds;
    if (PARTS & 1) {
    constexpr int IT_IN = (DM / 64) * (INC / 64), IT_OUT = (DM / 64) * (DM / 64), IT_W3 = 1024 / 64;
    constexpr int IT_L = IT_IN + IT_OUT + IT_W3;
    for (int it = obid(); it < NLAYER * IT_L; it += NBLK) {
        const int layer = it / IT_L; int r = it % IT_L;
        if (r < IT_IN) { transpose_one(p.in[I_WIN] + (size_t)layer * DM * INC, DM, INC, (bf16_t*)(p.ws + OFF_WTIN) + (size_t)layer * INC * DM, tile, r); continue; }
        r -= IT_IN;
        if (r < IT_OUT) { transpose_one(p.in[I_WOUT] + (size_t)layer * DM * DM, DM, DM, (bf16_t*)(p.ws + OFF_WTOUT) + (size_t)layer * DM * DM, tile, r); continue; }
        r -= IT_OUT;
        transpose_one(p.in[I_W3] + (size_t)layer * 64 * 1024, 64, 1024, (bf16_t*)(p.ws + OFF_W3T) + (size_t)layer * 1024 * 64, tile, r);
    }
    }
    __syncthreads();
    if (PARTS & 2) {
        float* SKl = (float*)lds;
        float* Wl = SKl + 128 * 129;
        const int lane = tid & 63, wave = tid >> 6, l31 = lane & 31, hl = lane >> 5, mt = wave & 3, nt = wave >> 2;
        for (int it = obid(); it < NLAYER * 16 * 16; it += NBLK) {
            const int layer = it >> 8, hp = (it >> 4) & 15, kc = it & 15, h = hp >> 1, pp = hp & 1, k0 = kc * 64;
            const float* sk = p.in[I_SK] + (((size_t)(layer * 2 + pp) * 8 + h) * 128) * 128;
            const float* wq = p.in[I_WQ] + (size_t)layer * DM * 2048 + (size_t)k0 * 2048 + h * 256 + pp * 128;
            __syncthreads();
            for (int i = tid; i < 128 * 128; i += NTHR) SKl[(i >> 7) * 129 + (i & 127)] = sk[i];
            for (int i = tid; i < 64 * 128; i += NTHR) Wl[(i >> 7) * 129 + (i & 127)] = wq[(size_t)(i >> 7) * 2048 + (i & 127)];
            __syncthreads();
            f32x16 acc = zero16();
            const float* ap = SKl + (32 * mt + l31) * 129 + hl;
            const float* bp = Wl + (32 * nt + l31) * 129 + hl;
#pragma unroll 16
            for (int kk = 0; kk < 64; ++kk) acc = __builtin_amdgcn_mfma_f32_32x32x2f32(ap[2 * kk], bp[2 * kk], acc, 0, 0, 0);
            const float g2 = p.in[I_N2G][layer * DM + k0 + 32 * nt + l31];
            bf16_t* dst = (bf16_t*)(p.ws + OFF_WTQ) + (size_t)layer * 2048 * DM + (size_t)(hp * 128 + 32 * mt + 4 * hl) * DM + k0 + 32 * nt + l31;
#pragma unroll
            for (int r = 0; r < 16; ++r) dst[(size_t)((r & 3) + 8 * (r >> 2)) * DM] = (bf16_t)f2bf(acc[r] * g2);
        }
        __syncthreads();
    }
    if (PARTS & 4) {
        const int lane = tid & 63, wave = tid >> 6;
        float* scl = (float*)(p.ws + OFF_PSC);
        for (int row = obid() * NWAVE + wave; row < 2 * NLAYER * 16384; row += NBLK * NWAVE) {
            const int tb = row >> 15, r = row & 32767;
            const f32x4* src = (const f32x4*)(p.in[tb ? I_PV : I_PU] + (size_t)r * DM) + lane;
            f32x4 v[4]; float mx = 0.f;
#pragma unroll
            for (int j = 0; j < 4; ++j) { v[j] = __builtin_nontemporal_load(src + 64 * j); mx = fmaxf(mx, fmaxf(fmaxf(fabsf(v[j].x), fabsf(v[j].y)), fmaxf(fabsf(v[j].z), fabsf(v[j].w)))); }
            mx = wave_max(mx);
            const float sc = mx > 0.f ? 224.0f / mx : 1.0f;
            u32x4 o;
            { int w = 0; w = __builtin_amdgcn_cvt_pk_fp8_f32(v[0].x * sc, v[0].y * sc, w, false); w = __builtin_amdgcn_cvt_pk_fp8_f32(v[0].z * sc, v[0].w * sc, w, true); o.x = (unsigned)w; }
            { int w = 0; w = __builtin_amdgcn_cvt_pk_fp8_f32(v[1].x * sc, v[1].y * sc, w, false); w = __builtin_amdgcn_cvt_pk_fp8_f32(v[1].z * sc, v[1].w * sc, w, true); o.y = (unsigned)w; }
            { int w = 0; w = __builtin_amdgcn_cvt_pk_fp8_f32(v[2].x * sc, v[2].y * sc, w, false); w = __builtin_amdgcn_cvt_pk_fp8_f32(v[2].z * sc, v[2].w * sc, w, true); o.z = (unsigned)w; }
            { int w = 0; w = __builtin_amdgcn_cvt_pk_fp8_f32(v[3].x * sc, v[3].y * sc, w, false); w = __builtin_amdgcn_cvt_pk_fp8_f32(v[3].z * sc, v[3].w * sc, w, true); o.w = (unsigned)w; }
            if (!tb) {
                const float qs = mx > 0.f ? 127.0f / mx : 1.0f;
                o.x = pk_i8(v[0] * qs); o.y = pk_i8(v[1] * qs); o.z = pk_i8(v[2] * qs); o.w = pk_i8(v[3] * qs);
            }
            *(u32x4*)(p.ws + (tb ? OFF_PV : OFF_PU) + (size_t)r * DM + lane * 16) = o;
            if (lane == 0) scl[row] = mx > 0.f ? mx / (tb ? 224.0f : 127.0f) : 1.0f;
        }
    }
    if (PARTS & 8) {
        float* sh = (float*)lds;
        float* zl = sh + 64 * 64;
        const int sub = tid >> 6, j = tid & 63;
        for (int it0 = obid() * 64; it0 < NLAYER * SL; it0 += NBLK * 64) {
            const int layer = it0 / SL;
            __syncthreads();
            for (int o = tid; o < 64 * 17; o += NTHR) {
                const int item = o / 17, f = o % 17;
                const float t = (float)((it0 + item) % SL) / (float)(SL - 1);
                float z;
                if (f == 0) z = t;
                else if (f <= 8) z = sinf(2.0f * 3.14159265358979323846f * t * (float)f);
                else z = cosf(2.0f * 3.14159265358979323846f * t * (float)(f - 8));
                zl[o] = z;
            }
            __syncthreads();
            {
                const float* w1 = p.in[I_W1] + layer * 17 * 64;
                float wv[17];
#pragma unroll
                for (int i = 0; i < 17; ++i) wv[i] = w1[i * 64 + j];
                const float b1 = p.in[I_B1][layer * 64 + j], f1 = p.in[I_F1][layer * 64 + j];
#pragma unroll
                for (int r = 0; r < 8; ++r) {
                    const int item = sub * 8 + r;
                    float a = b1;
#pragma unroll
                    for (int i = 0; i < 17; ++i) a += zl[item * 17 + i] * wv[i];
                    sh[item * 64 + j] = sinf(f1 * a);
                }
            }
            __syncthreads();
            {
                const float* w2 = p.in[I_W2] + layer * 64 * 64;
                const float b2 = p.in[I_B2][layer * 64 + j], f2 = p.in[I_F2][layer * 64 + j];
                float acc[8];
#pragma unroll
                for (int r = 0; r < 8; ++r) acc[r] = b2;
#pragma unroll 8
                for (int k = 0; k < 64; ++k) {
                    const float w = w2[k * 64 + j];
#pragma unroll
                    for (int r = 0; r < 8; ++r) acc[r] += sh[(sub * 8 + r) * 64 + k] * w;
                }
#pragma unroll
                for (int r = 0; r < 8; ++r)
                    ((bf16_t*)(p.ws + OFF_H2))[((size_t)(it0 + sub * 8 + r)) * 64 + j] = (bf16_t)f2bf(sinf(f2 * acc[r]));
            }
        }
        __syncthreads();
    }
    if (PARTS & 16) {
        float* ctab = (float*)lds;
        __syncthreads();
        if (tid < 64) ctab[tid] = cosf((float)tid * (2.0f * 3.14159265358979323846f / 64.0f));
        __syncthreads();
        const int total = NLAYER * 4 * 128 * 64;
        for (int o = obid() * NTHR + tid; o < total; o += NBLK * NTHR) {
            const int e2 = o & 63, dd = (o >> 6) & 127, g = (o >> 13) & 3, layer = o >> 15;
            const int d = dd & 63, sh = (dd < 64) ? 0 : 48;
            const float* w = p.in[I_FW] + ((size_t)(layer * 4 + g) * 64) * 64;
            float acc = 0.f;
#pragma unroll 8
            for (int e = 0; e < 64; ++e) acc += ctab[(d * e + sh) & 63] * w[e * 64 + e2];
            ((float*)(p.ws + OFF_FM))[o] = acc * (1.0f / 724.0773439350246f);
        }
        __syncthreads();
    }
}

__device__ __forceinline__ int zp(int i) { return i + 2 * (i >> 5); }
__device__ constexpr float FC32[16] = {1.000000000f, 0.980785280f, 0.923879533f, 0.831469612f, 0.707106781f, 0.555570233f, 0.382683432f, 0.195090322f, 0.000000000f, -0.195090322f, -0.382683432f, -0.555570233f, -0.707106781f, -0.831469612f, -0.923879533f, -0.980785280f};
__device__ constexpr float FS32[16] = {0.000000000f, 0.195090322f, 0.382683432f, 0.555570233f, 0.707106781f, 0.831469612f, 0.923879533f, 0.980785280f, 1.000000000f, 0.980785280f, 0.923879533f, 0.831469612f, 0.707106781f, 0.555570233f, 0.382683432f, 0.195090322f};
__device__ __forceinline__ float2 cmulf(float2 a, float2 b) { return make_float2(a.x * b.x - a.y * b.y, a.x * b.y + a.y * b.x); }
template <int R> __device__ __forceinline__ constexpr int brevR(int x) { int r = 0; for (int b = 1, t = R >> 1; t >= 1; b <<= 1, t >>= 1) if (x & b) r |= t; return r; }
template <int R> __device__ __forceinline__ void dft_fwd_regs(float2 (&x)[R]) {
#pragma unroll
    for (int half = R / 2; half >= 1; half >>= 1) {
#pragma unroll
        for (int blk = 0; blk < R; blk += 2 * half)
#pragma unroll
            for (int k = 0; k < half; ++k) {
                const float2 a = x[blk + k], b = x[blk + k + half];
                x[blk + k] = make_float2(a.x + b.x, a.y + b.y);
                const float2 d = make_float2(a.x - b.x, a.y - b.y);
                const int ti = k * (16 / half);
                if (ti == 0) x[blk + k + half] = d;
                else if (ti == 8) x[blk + k + half] = make_float2(d.y, -d.x);
                else { const float c = FC32[ti], sn = FS32[ti]; x[blk + k + half] = make_float2(d.x * c + d.y * sn, d.y * c - d.x * sn); }
            }
    }
}
template <int R> __device__ __forceinline__ void dft_inv_regs(float2 (&x)[R]) {
#pragma unroll
    for (int half = 1; half <= R / 2; half <<= 1) {
#pragma unroll
        for (int blk = 0; blk < R; blk += 2 * half)
#pragma unroll
            for (int k = 0; k < half; ++k) {
                const float2 a = x[blk + k], b0 = x[blk + k + half];
                const int ti = k * (16 / half);
                float2 b;
                if (ti == 0) b = b0;
                else if (ti == 8) b = make_float2(-b0.y, b0.x);
                else { const float c = FC32[ti], sn = FS32[ti]; b = make_float2(b0.x * c - b0.y * sn, b0.y * c + b0.x * sn); }
                x[blk + k] = make_float2(a.x + b.x, a.y + b.y);
                x[blk + k + half] = make_float2(a.x - b.x, a.y - b.y);
            }
    }
}
template <int R> __device__ __forceinline__ void apply_tw(float2 (&x)[R], float c, float sg) {
    const float2 w1 = make_float2(c, sg), w2 = cmulf(w1, w1);
    float2 po = w1, pe = w2;
#pragma unroll
    for (int m = 1; m < R; m += 2) {
        x[brevR<R>(m)] = cmulf(x[brevR<R>(m)], po);
        if (m + 1 < R) x[brevR<R>(m + 1)] = cmulf(x[brevR<R>(m + 1)], pe);
        if (m + 2 < R) { po = cmulf(po, w2); pe = cmulf(pe, w2); }
    }
}
template <int R, bool INV> __device__ __forceinline__ void fft_group(float2* Z, int pbase, int PS, float ang) {
    float2 x[R];
    if (!INV) {
#pragma unroll
        for (int m = 0; m < R; ++m) x[m] = Z[pbase + PS * m];
        dft_fwd_regs<R>(x);
        apply_tw<R>(x, __builtin_amdgcn_cosf(ang), -__builtin_amdgcn_sinf(ang));
#pragma unroll
        for (int m = 0; m < R; ++m) Z[pbase + PS * m] = x[brevR<R>(m)];
    } else {
#pragma unroll
        for (int m = 0; m < R; ++m) x[brevR<R>(m)] = Z[pbase + PS * m];
        apply_tw<R>(x, __builtin_amdgcn_cosf(ang), __builtin_amdgcn_sinf(ang));
        dft_inv_regs<R>(x);
#pragma unroll
        for (int m = 0; m < R; ++m) Z[pbase + PS * m] = x[m];
    }
}
template <bool INV> __device__ __forceinline__ void fft_group32_contig(float2* Z, int pbase) {
    float2 x[32];
    if (!INV) {
#pragma unroll
        for (int m = 0; m < 32; m += 2) { const f32x4 v = *(const f32x4*)(Z + pbase + m); x[m] = make_float2(v.x, v.y); x[m + 1] = make_float2(v.z, v.w); }
        dft_fwd_regs<32>(x);
#pragma unroll
        for (int m = 0; m < 32; m += 2) { const float2 a = x[brevR<32>(m)], b = x[brevR<32>(m + 1)]; *(f32x4*)(Z + pbase + m) = (f32x4){a.x, a.y, b.x, b.y}; }
    } else {
#pragma unroll
        for (int m = 0; m < 32; m += 2) { const f32x4 v = *(const f32x4*)(Z + pbase + m); x[brevR<32>(m)] = make_float2(v.x, v.y); x[brevR<32>(m + 1)] = make_float2(v.z, v.w); }
        dft_inv_regs<32>(x);
#pragma unroll
        for (int m = 0; m < 32; m += 2) *(f32x4*)(Z + pbase + m) = (f32x4){x[m].x, x[m].y, x[m + 1].x, x[m + 1].y};
    }
}
__device__ __forceinline__ void fft16k_fwd(float2* Z) {
    const int tid = otid();
#pragma unroll 1
    for (int g = 0; g < 2; ++g) { const int j = tid + 512 * g; fft_group<16, false>(Z, zp(j), 1088, (float)j * (1.0f / 16384.0f)); }
    __syncthreads();
    { const int blk = tid >> 5, j = tid & 31; fft_group<32, false>(Z, blk * 1088 + j, 34, (float)j * (1.0f / 1024.0f)); }
    __syncthreads();
    fft_group32_contig<false>(Z, 34 * tid);
    __syncthreads();
}
__device__ __forceinline__ void fft16k_inv(float2* Z) {
    const int tid = otid();
    fft_group32_contig<true>(Z, 34 * tid);
    __syncthreads();
    { const int blk = tid >> 5, j = tid & 31; fft_group<32, true>(Z, blk * 1088 + j, 34, (float)j * (1.0f / 1024.0f)); }
    __syncthreads();
#pragma unroll 1
    for (int g = 0; g < 2; ++g) { const int j = tid + 512 * g; fft_group<16, true>(Z, zp(j), 1088, (float)j * (1.0f / 16384.0f)); }
    __syncthreads();
}
__device__ __forceinline__ void fft8k_fwd(float2* Z) {
    const int tid = otid();
    fft_group<16, false>(Z, zp(tid), 544, (float)tid * (1.0f / 8192.0f));
    __syncthreads();
    { const int blk = tid >> 5, j = tid & 31; fft_group<16, false>(Z, blk * 544 + j, 34, (float)j * (1.0f / 512.0f)); }
    __syncthreads();
    if (tid < 256) fft_group32_contig<false>(Z, 34 * tid);
    __syncthreads();
}
__device__ __forceinline__ int f16k_of_p(int p) { return (p >> 10) + 16 * ((p >> 5) & 31) + 512 * (p & 31); }
__device__ __forceinline__ int p16k_of_f(int f) { return 1024 * (f & 15) + 32 * ((f >> 4) & 31) + (f >> 9); }
__device__ __forceinline__ int p8k_of_f(int f) { return 512 * (f & 15) + 32 * ((f >> 4) & 15) + (f >> 8); }

__device__ __forceinline__ void phase_filter_spectra(const Params& p, char* lds) {
    const int tid = otid(), lane = tid & 63, wave = tid >> 6;
    float2* Z = (float2*)lds;
    float* red = (float*)(lds + 139264 + 64);
    for (int job = obid(); job < NLAYER * 256; job += NBLK) {
        const int layer = job >> 8, c = job & 255;
        __syncthreads();
        const float* HFc = (const float*)(p.ws + (layer ? OFF_HFILT1 : OFF_HFILT0)) + (size_t)c * SL;
        const float r_lo = 4.605170185988092f / 1.5f, r_hi = 4.605170185988092f / 0.3f;
        const float rate = r_lo + (r_hi - r_lo) * ((float)c / 255.0f);
        float ss0 = 0.f, ss1 = 0.f;
#pragma unroll 1
        for (int i = 0; i < 4; ++i) {
            const int l0 = 4 * tid + 2048 * i;
            const f32x4 a0 = *(const f32x4*)(HFc + l0), a1 = *(const f32x4*)(HFc + (size_t)256 * SL + l0);
            const f32x4 a2 = *(const f32x4*)(HFc + (size_t)512 * SL + l0), a3 = *(const f32x4*)(HFc + (size_t)768 * SL + l0);
#pragma unroll
            for (int e = 0; e < 4; ++e) {
                const int l = l0 + e;
                const float t = (float)l / (float)(SL - 1);
                const float dec = expf(-t * rate);
                const float f0 = a0[e] * dec, b0 = a1[e] * dec, f1 = a2[e] * dec, b1 = a3[e] * dec;
                ss0 += f0 * f0 + b0 * b0; ss1 += f1 * f1 + b1 * b1;
                Z[zp(l)] = make_float2(f0, f1);
                if (l >= 1) Z[zp(16384 - l)] = make_float2(b0, b1);
            }
        }
        if (tid == 0) Z[zp(8192)] = make_float2(0.f, 0.f);
        ss0 = wave_sum(ss0); ss1 = wave_sum(ss1);
        if (lane == 0) { red[wave * 2] = ss0; red[wave * 2 + 1] = ss1; }
        __syncthreads();
        float t0 = 0.f, t1 = 0.f;
#pragma unroll
        for (int w = 0; w < 8; ++w) { t0 += red[w * 2]; t1 += red[w * 2 + 1]; }
        const float sc0 = rsqrtf(t0 + EPS) * (1.0f / 16384.0f) * 0.5f, sc1 = rsqrtf(t1 + EPS) * (1.0f / 16384.0f) * 0.5f;
        const float hb0 = p.in[I_HB][(layer * 2 + 0) * 256 + c] * (1.0f / 16384.0f), hb1 = p.in[I_HB][(layer * 2 + 1) * 256 + c] * (1.0f / 16384.0f);
        fft16k_fwd(Z);
        float2* KF0 = (float2*)(p.ws + OFF_KF) + ((size_t)(layer * 256 + c) * 2) * 16384;
        float2* KF1 = KF0 + 16384;
        for (int i = 0; i < 32; ++i) {
            const int pp = tid + NTHR * i;
            const int fq = f16k_of_p(pp);
            const int pq = p16k_of_f((16384 - fq) & 16383);
            const float2 za = Z[zp(pp)], zq = Z[zp(pq)];
            KF0[pp] = make_float2((za.x + zq.x) * sc0 + hb0, (za.y - zq.y) * sc0);
            KF1[pp] = make_float2((za.y + zq.y) * sc1 + hb1, (zq.x - za.x) * sc1);
        }
    }
}

__device__ __forceinline__ void phase_rmsnorm_bf16(const float* x, const float* g, bf16_t* out) {
    const int lane = otid() & 63, wave = otid() >> 6;
    const int gw = obid() * NWAVE + wave, ngw = NBLK * NWAVE;
    for (int row = gw; row < T; row += ngw) {
        const f32x4* xr = (const f32x4*)(x + (size_t)row * DM) + lane;
        f32x4 v[4]; float ss = 0.f;
#pragma unroll
        for (int j = 0; j < 4; ++j) { v[j] = xr[64 * j]; ss += v[j].x * v[j].x + v[j].y * v[j].y + v[j].z * v[j].z + v[j].w * v[j].w; }
        ss = wave_sum(ss);
        const float r = rsqrtf(ss * (1.0f / DM) + EPS);
        u32x2* o = (u32x2*)(out + (size_t)row * DM) + lane;
#pragma unroll
        for (int j = 0; j < 4; ++j) {
            const f32x4 gg = ((const f32x4*)g)[lane + 64 * j];
            u32x2 w; w.x = pk2(v[j].x * r * gg.x, v[j].y * r * gg.y); w.y = pk2(v[j].z * r * gg.z, v[j].w * r * gg.w);
            o[64 * j] = w;
        }
    }
}

constexpr int G_LDA = 144;
template <class Epi>
__device__ __forceinline__ void gemm_simple(const bf16_t* A, const bf16_t* Bt, int M, int N, int K, char* lds, const Epi& epi) {
    const int tid = otid(), lane = tid & 63, wave = tid >> 6;
    const int wm = wave >> 1, wn = wave & 1;
    const int nMt = M / 256, nNt = N / 128, total = nMt * nNt, nk = K / 64;
    char* As = lds; char* Bs = lds + 256 * G_LDA;
    const int l31 = lane & 31, hl = lane >> 5;
    for (int u = obid(); u < total; u += NBLK) {
        const int mt = u % nMt, nt = u / nMt;
        f32x16 acc[2][2];
#pragma unroll
        for (int i = 0; i < 2; ++i)
#pragma unroll
            for (int j = 0; j < 2; ++j) acc[i][j] = zero16();
        u32x4 ra[4], rb[2];
        const bf16_t* Ab = A + (size_t)(mt * 256) * K;
        const bf16_t* Bb = Bt + (size_t)(nt * 128) * K;
#pragma unroll
        for (int i = 0; i < 4; ++i) { const int id = tid + NTHR * i, row = id >> 3, ch = id & 7; ra[i] = *(const u32x4*)(Ab + (size_t)row * K + ch * 8); }
#pragma unroll
        for (int i = 0; i < 2; ++i) { const int id = tid + NTHR * i, row = id >> 3, ch = id & 7; rb[i] = *(const u32x4*)(Bb + (size_t)row * K + ch * 8); }
        for (int kt = 0; kt < nk; ++kt) {
            __syncthreads();
#pragma unroll
            for (int i = 0; i < 4; ++i) { const int id = tid + NTHR * i, row = id >> 3, ch = id & 7; *(u32x4*)(As + row * G_LDA + ch * 16) = ra[i]; }
#pragma unroll
            for (int i = 0; i < 2; ++i) { const int id = tid + NTHR * i, row = id >> 3, ch = id & 7; *(u32x4*)(Bs + row * G_LDA + ch * 16) = rb[i]; }
            __syncthreads();
            if (kt + 1 < nk) {
                const int ko = (kt + 1) * 64;
#pragma unroll
                for (int i = 0; i < 4; ++i) { const int id = tid + NTHR * i, row = id >> 3, ch = id & 7; ra[i] = *(const u32x4*)(Ab + (size_t)row * K + ko + ch * 8); }
#pragma unroll
                for (int i = 0; i < 2; ++i) { const int id = tid + NTHR * i, row = id >> 3, ch = id & 7; rb[i] = *(const u32x4*)(Bb + (size_t)row * K + ko + ch * 8); }
            }
#pragma unroll
            for (int ks = 0; ks < 4; ++ks) {
                bf16x8 a[2], b[2];
#pragma unroll
                for (int i = 0; i < 2; ++i) a[i] = *(const bf16x8*)(As + (wm * 64 + i * 32 + l31) * G_LDA + ks * 32 + hl * 16);
#pragma unroll
                for (int j = 0; j < 2; ++j) b[j] = *(const bf16x8*)(Bs + (wn * 64 + j * 32 + l31) * G_LDA + ks * 32 + hl * 16);
#pragma unroll
                for (int i = 0; i < 2; ++i)
#pragma unroll
                    for (int j = 0; j < 2; ++j) acc[i][j] = mfma32(a[i], b[j], acc[i][j]);
            }
        }
#pragma unroll
        for (int i = 0; i < 2; ++i)
#pragma unroll
            for (int j = 0; j < 2; ++j) epi(acc[i][j], mt * 256 + wm * 64 + i * 32, nt * 128 + wn * 64 + j * 32, lane);
    }
}

struct EpiF32 {
    float* out; int ld;
    __device__ __forceinline__ void operator()(const f32x16& acc, int row0, int col0, int lane) const {
        const int c = col0 + (lane & 31), h = lane >> 5;
#pragma unroll
        for (int r = 0; r < 16; ++r) { out[(size_t)(row0 + (r & 3) + 8 * (r >> 2) + 4 * h) * ld + c] = acc[r]; }
    }
};

namespace pg8 {
#define PG8_LAS __attribute__((address_space(3)))
constexpr int BM = 256, BK = 64, HALF = 128, HTB = HALF * BK * 2  , STAGE_BYTES = 8 * HTB, NXCD = 8, WGM = 8;

__host__ __device__ __forceinline__ int lds_byte(int r, int c) { const int st = (r >> 4) * 2 + (c >> 5), rr = r & 15, cc = c & 31, ob = rr * 64 + cc * 2; return st * 1024 + (ob ^ (((ob >> 9) & 1) << 5)); }
__host__ __device__ __forceinline__ void stage_rc(int b, int& R, int& C) { const int st = b / 1024, sb = b % 1024, swz = sb ^ (((sb >> 9) & 1) << 5); R = (st >> 1) * 16 + swz / 64; C = (st & 1) * 32 + (swz % 64) / 2; }
__host__ __device__ __forceinline__ int perm32(int rho) { const int n = rho >> 4, i = rho & 15; return 8 * (i >> 2) + 4 * n + (i & 3); }

struct Unit { int pm, pn; };
struct Gemm { const bf16_t* A; const bf16_t* Bt; int M, N, K; };

struct StaticOrder {
    int nM, nN, nwg, G, c;
    __host__ __device__ void init(int M, int N, int G_, int c_) { nM = M / BM; nN = N / BM; nwg = nM * nN; G = G_; c = c_; }
    __host__ __device__ bool next(int i, Unit& u) const {
        const long L = (long)i * G + c; if (L >= nwg) return false;
        int wgid = (int)L; { const int q = nwg / NXCD, r = nwg % NXCD, xcd = wgid % NXCD, off = wgid / NXCD; wgid = (xcd < r ? xcd * (q + 1) : r * (q + 1) + (xcd - r) * q) + off; }
        const int nig = WGM * nN, gid = wgid / nig, fm = gid * WGM, gsz = (nM - fm) < WGM ? (nM - fm) : WGM;
        u.pm = fm + ((wgid % nig) % gsz); u.pn = (wgid % nig) / gsz; return true;
    }
    __device__ __forceinline__ void a_ready(const Unit&) const {}
    __device__ __forceinline__ void done(const Unit&) const {}
};


__device__ __forceinline__ unsigned cvt_pk_bf16(float lo, float hi) { unsigned r; asm volatile("v_cvt_pk_bf16_f32 %0, %1, %2" : "=v"(r) : "v"(lo), "v"(hi)); return r; }
struct EpiStoreBf16 {
    static constexpr bool PERM = true, AFTER_DRAIN = false;
    bf16_t* O; int ldc;
    __device__ __forceinline__ void operator()(const f32x4 (&acc)[2][2][4][2], const Unit& u, int wr, int wc, int fr, int fq) const {
        const int row0 = u.pm * BM + wr * 64 + fr, col0 = u.pn * BM + wc * 32 + 8 * fq;
#pragma unroll
        for (int ai = 0; ai < 2; ++ai)
#pragma unroll
            for (int m = 0; m < 4; ++m) { bf16_t* rowp = O + (size_t)(row0 + ai * HALF + m * 16) * ldc + col0;
#pragma unroll
                for (int bj = 0; bj < 2; ++bj) { const f32x4 v0 = acc[ai][bj][m][0], v1 = acc[ai][bj][m][1];
                    u32x4 w; w.x = cvt_pk_bf16(v0[0], v0[1]); w.y = cvt_pk_bf16(v0[2], v0[3]); w.z = cvt_pk_bf16(v1[0], v1[1]); w.w = cvt_pk_bf16(v1[2], v1[3]);
                    *(u32x4*)(rowp + bj * HALF) = w; } }
    }
};
struct EpiOutProj {
    static constexpr bool PERM = false, AFTER_DRAIN = false;
    const float* base; float* O; bf16_t* XB; float* RS;
    __device__ __forceinline__ void operator()(const f32x4 (&acc)[2][2][4][2], const Unit& u, int wr, int wc, int fr, int fq) const {
        const int row0 = u.pm * BM + wr * 64 + fr, col0 = u.pn * BM + wc * 32 + 4 * fq;
#pragma unroll
        for (int ai = 0; ai < 2; ++ai)
#pragma unroll
            for (int m = 0; m < 4; ++m) { const int row = row0 + ai * HALF + m * 16; const size_t off = (size_t)row * 1024 + col0; float ss = 0.f;
#pragma unroll
                for (int bj = 0; bj < 2; ++bj)
#pragma unroll
                    for (int n = 0; n < 2; ++n) { const f32x4 v = acc[ai][bj][m][n] + *(const f32x4*)(base + off + bj * HALF + n * 16);
                        *(f32x4*)(O + off + bj * HALF + n * 16) = v; ss += v[0] * v[0] + v[1] * v[1] + v[2] * v[2] + v[3] * v[3];
                        u32x2 w; w.x = cvt_pk_bf16(v[0], v[1]); w.y = cvt_pk_bf16(v[2], v[3]); *(u32x2*)(XB + off + bj * HALF + n * 16) = w; }
                ss += __shfl_xor(ss, 16); ss += __shfl_xor(ss, 32);
                if (fq == 0) RS[(size_t)row * 16 + u.pn * 4 + wc] = ss; }
    }
};
struct EpiRowScaleF16 {
    static constexpr bool PERM = true, AFTER_DRAIN = false;
    _Float16* O; int ldc; const float* RS;
    __device__ __forceinline__ void operator()(const f32x4 (&acc)[2][2][4][2], const Unit& u, int wr, int wc, int fr, int fq) const {
        const int row0 = u.pm * BM + wr * 64 + fr, col0 = u.pn * BM + wc * 32 + 8 * fq;
        float tot[2][4];
#pragma unroll
        for (int ai = 0; ai < 2; ++ai)
#pragma unroll
            for (int m = 0; m < 4; ++m) { const f32x4 pr = *(const f32x4*)(RS + (size_t)(row0 + ai * HALF + m * 16) * 16 + 4 * fq); tot[ai][m] = (pr[0] + pr[1]) + (pr[2] + pr[3]); }
#pragma unroll
        for (int ai = 0; ai < 2; ++ai)
#pragma unroll
            for (int m = 0; m < 4; ++m) { const int row = row0 + ai * HALF + m * 16; const size_t off = (size_t)row * ldc + col0;
                float t = tot[ai][m]; t += __shfl_xor(t, 16); t += __shfl_xor(t, 32);
                const float r = rsqrtf(t * (1.0f / 1024.0f) + 1e-6f);
#pragma unroll
                for (int bj = 0; bj < 2; ++bj) { const f16x4 h0 = __builtin_convertvector(acc[ai][bj][m][0] * r, f16x4), h1 = __builtin_convertvector(acc[ai][bj][m][1] * r, f16x4);
                    *(f16x8*)(O + off + bj * HALF) = __builtin_shufflevector(h0, h1, 0, 1, 2, 3, 4, 5, 6, 7); } }
    }
};
struct EpiStoreF32 {
    static constexpr bool PERM = false, AFTER_DRAIN = false;
    const float* base; float* O; int ldc;
    __device__ __forceinline__ void operator()(const f32x4 (&acc)[2][2][4][2], const Unit& u, int wr, int wc, int fr, int fq) const {
        const int row0 = u.pm * BM + wr * 64 + fr, col0 = u.pn * BM + wc * 32 + 4 * fq;
#pragma unroll
        for (int ai = 0; ai < 2; ++ai)
#pragma unroll
            for (int m = 0; m < 4; ++m) { const size_t off = (size_t)(row0 + ai * HALF + m * 16) * ldc + col0;
#pragma unroll
                for (int bj = 0; bj < 2; ++bj)
#pragma unroll
                    for (int n = 0; n < 2; ++n) { f32x4 v = acc[ai][bj][m][n]; if (base) v += *(const f32x4*)(base + off + bj * HALF + n * 16); *(f32x4*)(O + off + bj * HALF + n * 16) = v; } }
    }
};

template <class Epi, class Sched, bool ALIGN_EPI = false, bool SP2 = false>
__device__ __forceinline__ void gemm_phase(PG8_LAS unsigned char* lds, const Gemm g, const Sched& S, const Epi& E) {
    const int tid = otid(), wid = __builtin_amdgcn_readfirstlane(tid >> 6), lane = tid & 63, wr = wid >> 2, wc = wid & 3, fr = lane & 15, fq = lane >> 4;
    const int K = g.K, nt = K / BK;
    unsigned voffA[2], voffB[2];
#pragma unroll
    for (int i = 0; i < 2; ++i) { int R, C; stage_rc(tid * 16 + i * 8192, R, C); const int Rb = Epi::PERM ? ((R & ~31) + perm32(R & 31)) : R;
        voffA[i] = (unsigned)(R * K + C) * 2u; voffB[i] = (unsigned)(Rb * K + C) * 2u; }
    const size_t kstep = (size_t)(BK * 2);
    const size_t hstep = (size_t)HALF * K * 2;
    const size_t tstep = 2 * hstep;
    const unsigned ldsw = (unsigned)wid * 1024u;
    const int aoff = lds_byte(wr * 64 + fr, fq * 8), boff = lds_byte(wc * 32 + fr, fq * 8);
#define PG8_SA(b, h) (((b) * 2 + (h)) * HTB)
#define PG8_SB(b, h) ((4 + (b) * 2 + (h)) * HTB)
#define PG8_STAGE(bufoff, gbase, voff) do { _Pragma("unroll") for (int _i = 0; _i < 2; ++_i) \
        __builtin_amdgcn_global_load_lds((const unsigned*)((const char*)(gbase) + (voff)[_i]), (PG8_LAS unsigned*)(lds + (bufoff) + ldsw + _i * 8192), 16, 0, 0); } while (0)
#define PG8_LDA(dst, b, h) do { _Pragma("unroll") for (int m = 0; m < 4; ++m) _Pragma("unroll") for (int k = 0; k < 2; ++k) dst[m][k] = *(const PG8_LAS bf16x8*)(lds + PG8_SA(b, h) + aoff + m * 2048 + k * 1024); } while (0)
#define PG8_LDB(dst, b, h) do { _Pragma("unroll") for (int n = 0; n < 2; ++n) _Pragma("unroll") for (int k = 0; k < 2; ++k) dst[n][k] = *(const PG8_LAS bf16x8*)(lds + PG8_SB(b, h) + boff + n * 2048 + k * 1024); } while (0)
#define PG8_MMA(ai, bj, At, Bt) do { __builtin_amdgcn_s_setprio(1); _Pragma("unroll") for (int m = 0; m < 4; ++m) _Pragma("unroll") for (int n = 0; n < 2; ++n) _Pragma("unroll") for (int k = 0; k < 2; ++k) \
        acc[ai][bj][m][n] = __builtin_amdgcn_mfma_f32_16x16x32_bf16(Bt[n][k], At[m][k], acc[ai][bj][m][n], 0, 0, 0); __builtin_amdgcn_s_setprio(0); } while (0)
#define PG8_WAIT_V(n) asm volatile("s_waitcnt vmcnt(" #n ")" ::: "memory")
#define PG8_WAIT_L(n) asm volatile("s_waitcnt lgkmcnt(" #n ")" ::: "memory")
#define PG8_BAR __builtin_amdgcn_s_barrier()
#define PG8_SCHED __builtin_amdgcn_sched_barrier(0)
    Unit cur, nxt; int ui = 0;
    if (!S.next(0, cur)) return;
    f32x4 acc[2][2][4][2];
#pragma unroll
    for (int a = 0; a < 2; ++a)
#pragma unroll
        for (int b = 0; b < 2; ++b)
#pragma unroll
            for (int m = 0; m < 4; ++m)
#pragma unroll
                for (int n = 0; n < 2; ++n) acc[a][b][m][n] = (f32x4){0.f, 0.f, 0.f, 0.f};
    bf16x8 At[4][2], B0[2][2], B1[2][2];
    const char* cA = (const char*)g.A + (size_t)cur.pm * tstep; const char* cB = (const char*)g.Bt + (size_t)cur.pn * tstep;
    S.a_ready(cur);
    if constexpr (SP2) {
        PG8_STAGE(PG8_SB(0, 0), cB, voffB); PG8_STAGE(PG8_SB(0, 1), cB + hstep, voffB); PG8_STAGE(PG8_SA(0, 0), cA, voffA); PG8_STAGE(PG8_SA(0, 1), cA + hstep, voffA);
        if (wr == 1) PG8_BAR;
        PG8_WAIT_V(2); PG8_BAR;
        PG8_STAGE(PG8_SB(1, 0), cB + kstep, voffB); PG8_STAGE(PG8_SA(1, 0), cA + kstep, voffA); PG8_STAGE(PG8_SB(1, 1), cB + hstep + kstep, voffB);
        PG8_WAIT_V(6); PG8_BAR;
    } else {
        PG8_STAGE(PG8_SB(0, 0), cB, voffB); PG8_STAGE(PG8_SA(0, 0), cA, voffA); PG8_STAGE(PG8_SB(0, 1), cB + hstep, voffB); PG8_STAGE(PG8_SA(0, 1), cA + hstep, voffA);
        if (wr == 1) PG8_BAR;
        PG8_WAIT_V(4); PG8_BAR;
        PG8_STAGE(PG8_SB(1, 0), cB + kstep, voffB); PG8_STAGE(PG8_SA(1, 0), cA + kstep, voffA); PG8_STAGE(PG8_SB(1, 1), cB + hstep + kstep, voffB);
        PG8_WAIT_V(6); PG8_BAR;
    }
    for (;;) {
        const bool has_next = S.next(ui + 1, nxt);
        const char* nA = has_next ? (const char*)g.A + (size_t)nxt.pm * tstep : cA; const char* nB = has_next ? (const char*)g.Bt + (size_t)nxt.pn * tstep : cB;
        for (int t = 0; t < nt; t += 2) {
            const bool last = (t == nt - 2);
            const char* a1 = cA + (size_t)(t + 1) * kstep;
            const char* a2 = last ? nA : cA + (size_t)(t + 2) * kstep; const char* b2 = last ? nB : cB + (size_t)(t + 2) * kstep;
            const char* a3 = a2 + kstep; const char* b3 = b2 + kstep;
            if (last && has_next) S.a_ready(nxt);
            if constexpr (SP2) {
            PG8_LDB(B0, 0, 0); PG8_LDB(B1, 0, 1); PG8_SCHED; PG8_LDA(At, 0, 0); PG8_STAGE(PG8_SA(1, 1), a1 + hstep, voffA);
            PG8_WAIT_V(8); PG8_WAIT_L(0); PG8_BAR; PG8_MMA(0, 0, At, B0); PG8_MMA(0, 1, At, B1); PG8_BAR; PG8_SCHED;
            PG8_LDA(At, 0, 1); PG8_STAGE(PG8_SB(0, 0), b2, voffB); PG8_STAGE(PG8_SB(0, 1), b2 + hstep, voffB); PG8_STAGE(PG8_SA(0, 0), a2, voffA);
            PG8_WAIT_V(8); PG8_WAIT_L(0); PG8_BAR; PG8_MMA(1, 0, At, B0); PG8_MMA(1, 1, At, B1); PG8_BAR; PG8_SCHED;
            PG8_LDB(B0, 1, 0); PG8_LDB(B1, 1, 1); PG8_SCHED; PG8_LDA(At, 1, 0); PG8_STAGE(PG8_SA(0, 1), a2 + hstep, voffA);
            PG8_WAIT_V(8); PG8_WAIT_L(0); PG8_BAR; PG8_MMA(0, 0, At, B0); PG8_MMA(0, 1, At, B1); PG8_BAR; PG8_SCHED;
            PG8_LDA(At, 1, 1); PG8_STAGE(PG8_SB(1, 0), b3, voffB); PG8_STAGE(PG8_SB(1, 1), b3 + hstep, voffB); PG8_STAGE(PG8_SA(1, 0), a3, voffA);
            PG8_WAIT_V(8); PG8_WAIT_L(0); PG8_BAR; PG8_MMA(1, 0, At, B0); PG8_MMA(1, 1, At, B1); PG8_BAR; PG8_SCHED;
            } else {
            PG8_LDB(B0, 0, 0); PG8_SCHED; PG8_LDA(At, 0, 0); PG8_STAGE(PG8_SA(1, 1), a1 + hstep, voffA);
            PG8_WAIT_L(8); PG8_BAR; PG8_WAIT_L(0); PG8_MMA(0, 0, At, B0); PG8_BAR; PG8_SCHED;
            PG8_LDB(B1, 0, 1); PG8_STAGE(PG8_SB(0, 0), b2, voffB);
            PG8_BAR; PG8_WAIT_L(0); PG8_MMA(0, 1, At, B1); PG8_BAR;
            PG8_LDA(At, 0, 1); PG8_STAGE(PG8_SA(0, 0), a2, voffA);
            PG8_BAR; PG8_WAIT_L(0); PG8_MMA(1, 0, At, B0); PG8_BAR; PG8_SCHED;
            PG8_STAGE(PG8_SB(0, 1), b2 + hstep, voffB);
            PG8_WAIT_V(6); PG8_BAR; PG8_MMA(1, 1, At, B1); PG8_BAR;
            PG8_LDB(B0, 1, 0); PG8_SCHED; PG8_LDA(At, 1, 0); PG8_STAGE(PG8_SA(0, 1), a2 + hstep, voffA);
            PG8_WAIT_L(8); PG8_BAR; PG8_WAIT_L(0); PG8_MMA(0, 0, At, B0); PG8_BAR; PG8_SCHED;
            PG8_LDB(B1, 1, 1); PG8_STAGE(PG8_SB(1, 0), b3, voffB);
            PG8_BAR; PG8_WAIT_L(0); PG8_MMA(0, 1, At, B1); PG8_BAR;
            PG8_LDA(At, 1, 1); PG8_STAGE(PG8_SA(1, 0), a3, voffA);
            PG8_BAR; PG8_WAIT_L(0); PG8_MMA(1, 0, At, B0); PG8_BAR; PG8_SCHED;
            PG8_STAGE(PG8_SB(1, 1), b3 + hstep, voffB);
            PG8_WAIT_V(6); PG8_BAR; PG8_MMA(1, 1, At, B1); PG8_BAR;
            }
        }
        if constexpr (ALIGN_EPI) { if (wr == 0) PG8_BAR; }
        if constexpr (!Epi::AFTER_DRAIN) { E(acc, cur, wr, wc, fr, fq); S.done(cur); }
        if (!has_next) break;
#pragma unroll
        for (int a = 0; a < 2; ++a)
#pragma unroll
            for (int b = 0; b < 2; ++b)
#pragma unroll
                for (int m = 0; m < 4; ++m)
#pragma unroll
                    for (int n = 0; n < 2; ++n) acc[a][b][m][n] = (f32x4){0.f, 0.f, 0.f, 0.f};
        cur = nxt; cA = nA; cB = nB; ++ui;
        if constexpr (ALIGN_EPI) { if (wr == 1) PG8_BAR; }
    }
    PG8_WAIT_V(0);
    if constexpr (!ALIGN_EPI) { if (wr == 0) PG8_BAR; }
    PG8_BAR;
    if constexpr (Epi::AFTER_DRAIN) { E.fused(acc, cur, wr, wc, fr, fq, lds, wid, lane); S.done(cur); }
#undef PG8_SA
#undef PG8_SB
#undef PG8_STAGE
#undef PG8_LDA
#undef PG8_LDB
#undef PG8_MMA
#undef PG8_WAIT_V
#undef PG8_WAIT_L
#undef PG8_BAR
#undef PG8_SCHED
}
}

__device__ constexpr float ROPE_INV_REV[16] = {1.591549431e-01f, 8.949940161e-02f, 5.032921210e-02f, 2.830219583e-02f, 1.591549431e-02f, 8.949940161e-03f, 5.032921210e-03f, 2.830219583e-03f, 1.591549431e-03f, 8.949940161e-04f, 5.032921210e-04f, 2.830219583e-04f, 1.591549431e-04f, 8.949940161e-05f, 5.032921210e-05f, 2.830219583e-05f};
__device__ __forceinline__ void qk_norm_rope8(const u32x4 raw, const float (&gn)[8], const float (&cs)[8], const float (&sn)[8], bool second, float scale, u32x4& out) {
    float x[8] = {bflo(raw.x), bfhi(raw.x), bflo(raw.y), bfhi(raw.y), bflo(raw.z), bfhi(raw.z), bflo(raw.w), bfhi(raw.w)};
    float ss = 0.f;
#pragma unroll
    for (int e = 0; e < 8; ++e) ss += x[e] * x[e];
    ss += __shfl_xor(ss, 1); ss += __shfl_xor(ss, 2); ss += __shfl_xor(ss, 4);
    const float r = rsqrtf(ss * (1.0f / 64.0f) + EPS) ;
    float o[8];
#pragma unroll
    for (int e = 0; e < 8; ++e) {
        const float y = x[e] * r * gn[e];
        const float other = __shfl_xor(y, 2);
        o[e] = (second ? (y * cs[e] + other * sn[e]) : (y * cs[e] - other * sn[e])) * scale;
    }
    out.x = pk2(o[0], o[1]); out.y = pk2(o[2], o[3]); out.z = pk2(o[4], o[5]); out.w = pk2(o[6], o[7]);
}
__device__ __forceinline__ void phase_qkprep(const Params& p, int layer, char* lds, bf16_t* qout) {
    const int tid = otid(), lane = tid & 63, wave = tid >> 6;
    const bf16_t* qkv = (const bf16_t*)(p.ws + R_QKV);
    const int sub = lane & 7;
    const bool second = ((sub >> 1) & 1) != 0, colaxis = (sub >> 2) != 0;
    float gq[8], gk[8], ir[8];
#pragma unroll
    for (int e = 0; e < 8; ++e) {
        gq[e] = p.in[I_QG][layer * 64 + sub * 8 + e]; gk[e] = p.in[I_KG][layer * 64 + sub * 8 + e];
        ir[e] = (sub & 1) ? ROPE_INV_REV[8 + e] : ROPE_INV_REV[e];
    }
    const int gw = obid() * NWAVE + wave, ngw = NBLK * NWAVE;
    for (int t = gw; t < T; t += ngw) {
        const int l = t & (SL - 1);
        const float pos = colaxis ? (float)(l & 63) : (float)(l >> 6);
        float cs[8], sn[8];
#pragma unroll
        for (int e = 0; e < 8; ++e) { const float a = pos * ir[e]; cs[e] = __builtin_amdgcn_cosf(a); sn[e] = __builtin_amdgcn_sinf(a); }
        const u32x4 rq = *(const u32x4*)(qkv + (size_t)t * 768 + lane * 8);
        u32x4 rk = {0u, 0u, 0u, 0u};
        if (lane < 16) rk = *(const u32x4*)(qkv + (size_t)t * 768 + 512 + lane * 8);
        u32x4 oq, ok;
        qk_norm_rope8(rq, gq, cs, sn, second, 0.125f * 1.4426950408889634f, oq);
        qk_norm_rope8(rk, gk, cs, sn, second, 1.0f, ok);
        *(u32x4*)(qout + (size_t)t * 768 + lane * 8) = oq;
        if (lane < 16) *(u32x4*)(qout + (size_t)t * 768 + 512 + lane * 8) = ok;
    }
}

#include <hip/hip_bf16.h>
#include <cmath>
namespace attn_body {
using bf16=__hip_bfloat16;
using bf16x8=__attribute__((ext_vector_type(8)))short;
using s16x4=__attribute__((ext_vector_type(4)))short;
using f32x16=__attribute__((ext_vector_type(16)))float;
using u32x4=__attribute__((ext_vector_type(4)))unsigned;
constexpr int SEQ=8192,D=64,PQ=768,PO=512;
constexpr int NW=8,QBLK=32,QB=QBLK*NW,KVBLK=64,NQB=SEQ/QB;
constexpr int ATTN_UNIT_ROWS=QB;
__device__ __forceinline__ int crow(int r,int hi){return (r&3)+8*(r>>2)+4*hi;}
#define SBAR() __builtin_amdgcn_sched_barrier(0)
__device__ __forceinline__ void cmask(f32x16&p0,f32x16&p1,int jb,int qrel,int hi){
  const float NEG=-INFINITY; int kb=64*jb+4*hi;
  #pragma unroll
  for(int r=0;r<16;++r){int kv=kb+(r&3)+8*(r>>2); if(kv>qrel)p0[r]=NEG; if(kv+32>qrel)p1[r]=NEG;}
}

constexpr int NSLOT=3, SLOTB=8192;
constexpr int LDS_K=0, LDS_V=NSLOT*SLOTB, LDS_WS=2*NSLOT*SLOTB, LDS_OST=LDS_WS+NW*64*4, LDS_BYTES=LDS_OST+NW*4096;
constexpr float C2=0.125f*1.4426950408889634f;
__device__ __forceinline__ void glds16(const void*gsrc,unsigned lds_dst){unsigned keep;
  asm volatile("s_mov_b32 %0, m0\n\ts_mov_b32 m0, %2\n\ts_nop 0\n\tglobal_load_lds_dwordx4 %1, off\n\ts_mov_b32 m0, %0":"=&s"(keep):"v"(gsrc),"s"(lds_dst):"memory");}
__device__ __forceinline__ float max3f(float a,float b,float c){float r;asm("v_max3_f32 %0, %1, %2, %3":"=v"(r):"v"(a),"v"(b),"v"(c));return r;}
__device__ __forceinline__ float max2f(float a,float b){float r;asm("v_max_f32_e32 %0, %1, %2":"=v"(r):"v"(a),"v"(b));return r;}
__device__ __forceinline__ float fadd_s(float a,float b){float r;asm("v_add_f32_e32 %0, %1, %2":"=v"(r):"v"(a),"v"(b));return r;}
__device__ __forceinline__ float fsub_s(float a,float b){float r;asm("v_sub_f32_e32 %0, %1, %2":"=v"(r):"v"(a),"v"(b));return r;}
typedef float f32x2_t __attribute__((ext_vector_type(2))); typedef __bf16 bf16x2_t __attribute__((ext_vector_type(2)));
__device__ __forceinline__ unsigned cvtpk_s(float lo,float hi){f32x2_t v={lo,hi};bf16x2_t b=__builtin_convertvector(v,bf16x2_t);return __builtin_bit_cast(unsigned,b);}
#define WAIT_BAR(N) asm volatile("s_waitcnt vmcnt(" #N ") lgkmcnt(0)\n\ts_barrier":::"memory")

__device__ __forceinline__ void qkt(f32x16&p0,f32x16&p1,const char*Kslot,const bf16x8*qr,const f32x16&negm,int r32,int hi){
  const char*kb=Kslot+hi*1024+r32*16;
  #pragma unroll
  for(int d0=0;d0<4;++d0){
    const bf16x8 b0=*reinterpret_cast<const bf16x8*>(kb+d0*2048);
    const bf16x8 b1=*reinterpret_cast<const bf16x8*>(kb+d0*2048+512);
    if(d0==0){p0=__builtin_amdgcn_mfma_f32_32x32x16_bf16(b0,qr[0],negm,0,0,0);p1=__builtin_amdgcn_mfma_f32_32x32x16_bf16(b1,qr[0],negm,0,0,0);}
    else{p0=__builtin_amdgcn_mfma_f32_32x32x16_bf16(b0,qr[d0],p0,0,0,0);p1=__builtin_amdgcn_mfma_f32_32x32x16_bf16(b1,qr[d0],p1,0,0,0);}}
}
typedef __attribute__((address_space(3))) const char* lds_cptr;
typedef short v4i16_t __attribute__((ext_vector_type(4)));
__device__ __forceinline__ void kload8(bf16x8*kf,lds_cptr kp){
  kf[0]=*(const __attribute__((address_space(3))) bf16x8*)(kp);      kf[1]=*(const __attribute__((address_space(3))) bf16x8*)(kp+512);
  kf[2]=*(const __attribute__((address_space(3))) bf16x8*)(kp+2048); kf[3]=*(const __attribute__((address_space(3))) bf16x8*)(kp+2560);
  kf[4]=*(const __attribute__((address_space(3))) bf16x8*)(kp+4096); kf[5]=*(const __attribute__((address_space(3))) bf16x8*)(kp+4608);
  kf[6]=*(const __attribute__((address_space(3))) bf16x8*)(kp+6144); kf[7]=*(const __attribute__((address_space(3))) bf16x8*)(kp+6656);
}
__device__ __forceinline__ void kload2(bf16x8*kf,lds_cptr kp,int j){ kf[2*j]=*(const __attribute__((address_space(3))) bf16x8*)(kp+j*2048); kf[2*j+1]=*(const __attribute__((address_space(3))) bf16x8*)(kp+j*2048+512); }
__device__ __forceinline__ s16x4 vtr(lds_cptr p){ return __builtin_bit_cast(s16x4,__builtin_amdgcn_ds_read_tr16_b64_v4i16((__attribute__((address_space(3))) v4i16_t*)p)); }
__device__ __forceinline__ float rowmax(const f32x16&p0,const f32x16&p1){
  float a=max3f(p0[0],p0[1],p1[0]),b=max3f(p0[2],p0[3],p1[1]);a=max3f(a,p1[2],p1[3]);
  #pragma unroll
  for(int r=4;r<16;r+=4){a=max3f(a,p0[r],p0[r+1]);b=max3f(b,p0[r+2],p0[r+3]);a=max3f(a,p1[r],p1[r+1]);b=max3f(b,p1[r+2],p1[r+3]);}
  const float m=max2f(a,b);
  auto rr=__builtin_amdgcn_permlane32_swap(__float_as_uint(m),__float_as_uint(m),false,false);
  return max2f(__uint_as_float(rr[0]),__uint_as_float(rr[1]));
}
__device__ __forceinline__ void pv(f32x16*o,int vb,bf16x8 pa0,bf16x8 pa1,bf16x8 pa2,bf16x8 pa3){
  #pragma unroll
  for(int d0=0;d0<2;++d0){s16x4 lo[4],hi[4];
    #pragma unroll
    for(int ks=0;ks<4;++ks){
      asm volatile("ds_read_b64_tr_b16 %0,%1 offset:%c2":"=&v"(lo[ks]):"v"(vb),"i"(d0*4096+ks*1024):"memory");
      asm volatile("ds_read_b64_tr_b16 %0,%1 offset:%c2":"=&v"(hi[ks]):"v"(vb),"i"(d0*4096+ks*1024+512):"memory");}
    asm volatile("s_waitcnt lgkmcnt(0)":::"memory");SBAR();
    #define PK(k) (bf16x8){lo[k][0],lo[k][1],lo[k][2],lo[k][3],hi[k][0],hi[k][1],hi[k][2],hi[k][3]}
    o[d0]=__builtin_amdgcn_mfma_f32_32x32x16_bf16(pa0,PK(0),o[d0],0,0,0);
    o[d0]=__builtin_amdgcn_mfma_f32_32x32x16_bf16(pa1,PK(1),o[d0],0,0,0);
    o[d0]=__builtin_amdgcn_mfma_f32_32x32x16_bf16(pa2,PK(2),o[d0],0,0,0);
    o[d0]=__builtin_amdgcn_mfma_f32_32x32x16_bf16(pa3,PK(3),o[d0],0,0,0);
    #undef PK
  }
}

#ifndef ATTN_STORE16
#define ATTN_STORE16(p,v) (*(u32x4*)(p)=(v))
#endif
template<int THRL,bool FIXED> __device__ __forceinline__ void attn_unit(int b,int h,int g,int qb,const bf16*Q,const bf16*__restrict__ K,const bf16*__restrict__ V,bf16*O,char*shm,float mfix){
  const int tid=otid(),lane=tid&63,r32=lane&31,hi=lane>>5; const int wid=__builtin_amdgcn_readfirstlane(tid>>6);
  const long rowbase=(long)b*SEQ; const int q0=qb*QB;
  const bf16*Qw=Q+(rowbase+q0+wid*QBLK)*PQ+h*D;
  const bf16*Kh=K+rowbase*PQ+g*D,*Vh=V+rowbase*PQ+g*D;
  const unsigned lds0=(unsigned)(uintptr_t)shm;
  float*wsf=(float*)(shm+LDS_WS)+wid*64;
  const bf16*ksrc=Kh+(long)lane*PQ+wid*8;
  const bf16*vsrc=Vh+(long)(16*(wid&3)+(lane>>2))*PQ+(wid>>2)*32+(lane&3)*8;
  const unsigned kdst=lds0+LDS_K+wid*1024, vdst=lds0+LDS_V+wid*1024;
  #define DMA_K(t,slot) glds16(ksrc+(long)(t)*KVBLK*PQ,(unsigned)__builtin_amdgcn_readfirstlane(kdst+(slot)))
  #define DMA_V(t,slot) glds16(vsrc+(long)(t)*KVBLK*PQ,(unsigned)__builtin_amdgcn_readfirstlane(vdst+(slot)))
  const int vb0=(int)(lds0+LDS_V)+((lane>>4)&1)*32+(lane&3)*8+(4*hi+((lane&15)>>2))*64;
  const char*Kbase=shm+LDS_K; bf16x8 kf[8];
  const lds_cptr shm3=(lds_cptr)shm; const lds_cptr kp0=shm3+LDS_K+hi*1024+r32*16; const lds_cptr vp0=shm3+LDS_V+((lane>>4)&1)*32+(lane&3)*8+(4*hi+((lane&15)>>2))*64;
  constexpr int NT=SEQ/KVBLK;
  DMA_K(0,0);DMA_V(0,0);DMA_K(1,SLOTB);
  bf16x8 qr[4];
  #pragma unroll
  for(int d0=0;d0<4;++d0)qr[d0]=*reinterpret_cast<const bf16x8*>(&Qw[(long)r32*PQ+d0*16+hi*8]);
  float mhat=0.f,l_reg=0.f;f32x16 o[2];o[0]=f32x16{};o[1]=f32x16{};f32x16 negm=f32x16{};asm volatile("":"+v"(negm));
    #define CMASK(P0,P1,t) do{}while(0)
  bool resc=false;
  #define START(P0,P1) do{ const float rm=FIXED?mfix:rowmax(P0,P1); resc=false; \
    { const float dl=rm; mhat=fadd_s(mhat,dl); \
      _Pragma("unroll") for(int r=0;r<16;++r){P0[r]=fsub_s(P0[r],dl);P1[r]=fsub_s(P1[r],dl);} \
      _Pragma("unroll") for(int r=0;r<16;++r)negm[r]=-mhat; asm volatile("":"+v"(negm)); } \
    _Pragma("unroll") for(int r=0;r<16;++r)P0[r]=__builtin_amdgcn_exp2f(P0[r]); }while(0)
  #define RESC() do{ if(resc){ asm volatile("s_waitcnt lgkmcnt(0)":::"memory"); \
      _Pragma("unroll") for(int d_=0;d_<2;++d_) _Pragma("unroll") for(int r=0;r<16;++r)o[d_][r]*=wsf[crow(r,hi)]; } }while(0)
  f32x16 pA0,pA1,pB0,pB1;
  int sl_prev=0,sl_cur=0,sl_next=SLOTB;
  #define ROT() do{sl_prev=sl_cur;sl_cur=sl_next;sl_next=(sl_next==(NSLOT-1)*SLOTB)?0:sl_next+SLOTB;}while(0)
  DMA_K(2,2*SLOTB);
  WAIT_BAR(3);
  qkt(pA0,pA1,Kbase,qr,negm,r32,hi);asm volatile("s_nop 15\n\ts_nop 7":"+v"(pA0),"+v"(pA1));CMASK(pA0,pA1,0);
  START(pA0,pA1);
  _Pragma("unroll") for(int r=0;r<16;++r)pA1[r]=__builtin_amdgcn_exp2f(pA1[r]);
  WAIT_BAR(0);
  DMA_K(3,0);DMA_V(1,SLOTB);
  ROT();
  kload8(kf,kp0+sl_cur);
  WAIT_BAR(2);
  s16x4 vlo[8],vhi[8]; u32x4 pw0,pw1,pw2,pw3;
  #define PKW(P,B) cvtpk_s(P[B],P[B+1])
  #define PAF(k) __builtin_bit_cast(bf16x8,pw##k)
  #define VFR(i) (bf16x8){vlo[i][0],vlo[i][1],vlo[i][2],vlo[i][3],vhi[i][0],vhi[i][1],vhi[i][2],vhi[i][3]}
  #define PIN(x) asm volatile("":"+v"(x))
  #define MX3(a,b,c) __builtin_fmaxf(__builtin_fmaxf((a),(b)),(c))
  #define GAPA(MF,A0,A1,A2,A3,W0,W1,PW) do{ MF; sacc+=A0; sacc+=A1; sacc+=A2; sacc+=A3; PIN(sacc); W0; W1; PIN(PW); SBAR(); }while(0)
  #define EX(v) __builtin_amdgcn_exp2f(v)
  #define GAPB(MF,X,B) do{ MF; X[B]=EX(X[B]); X[B+1]=EX(X[B+1]); X[B+2]=EX(X[B+2]); X[B+3]=EX(X[B+3]); PIN(X); SBAR(); }while(0)
  #define VRD(i) do{ vlo[i]=vtr(vp_+(((i)>>2)*4096+((i)&3)*1024)); vhi[i]=vtr(vp_+(((i)>>2)*4096+((i)&3)*1024+512)); }while(0)
  #define KRD(G,j) do{ if(G){ kload2(kf,kp0+sl_next,j); SBAR(); } }while(0)
  #define STEP(C0,C1,P0,P1,t,GK,GV,GL) do{ SBAR(); \
    const lds_cptr vp_=vp0+sl_prev; \
    VRD(0); SBAR(); float sacc=(P0[0]+P0[1]); \
    GAPA(C0=__builtin_amdgcn_mfma_f32_32x32x16_bf16(kf[0],qr[0],negm,0,0,0), P0[2],P0[3],P0[4],P0[5],     pw0[0]=PKW(P0,0), pw0[1]=PKW(P0,2), pw0); \
    VRD(4); SBAR(); GAPA(C1=__builtin_amdgcn_mfma_f32_32x32x16_bf16(kf[1],qr[0],negm,0,0,0), P0[6],P0[7],P0[8],P0[9],     pw0[2]=PKW(P0,4), pw0[3]=PKW(P0,6), pw0); \
    VRD(1); SBAR(); GAPA(C0=__builtin_amdgcn_mfma_f32_32x32x16_bf16(kf[2],qr[1],C0,0,0,0),   P0[10],P0[11],P0[12],P0[13], pw1[0]=PKW(P0,8), pw1[1]=PKW(P0,10), pw1); \
    VRD(5); SBAR(); GAPA(C1=__builtin_amdgcn_mfma_f32_32x32x16_bf16(kf[3],qr[1],C1,0,0,0),   P0[14],P0[15],P1[0],P1[1],   pw1[2]=PKW(P0,12),pw1[3]=PKW(P0,14), pw1); \
    VRD(2); SBAR(); GAPA(C0=__builtin_amdgcn_mfma_f32_32x32x16_bf16(kf[4],qr[2],C0,0,0,0),   P1[2],P1[3],P1[4],P1[5],     pw2[0]=PKW(P1,0), pw2[1]=PKW(P1,2), pw2); \
    VRD(6); SBAR(); GAPA(C1=__builtin_amdgcn_mfma_f32_32x32x16_bf16(kf[5],qr[2],C1,0,0,0),   P1[6],P1[7],P1[8],P1[9],     pw2[2]=PKW(P1,4), pw2[3]=PKW(P1,6), pw2); \
    VRD(3); SBAR(); GAPA(C0=__builtin_amdgcn_mfma_f32_32x32x16_bf16(kf[6],qr[3],C0,0,0,0),   P1[10],P1[11],P1[12],P1[13], pw3[0]=PKW(P1,8), pw3[1]=PKW(P1,10), pw3); \
    VRD(7); SBAR(); GAPA(C1=__builtin_amdgcn_mfma_f32_32x32x16_bf16(kf[7],qr[3],C1,0,0,0),   P1[14],P1[15],0.f,0.f,       pw3[2]=PKW(P1,12),pw3[3]=PKW(P1,14), pw3); \
    l_reg+=sacc; \
    if(GK){DMA_K((t)+3,sl_cur);} if(GV){DMA_V((t)+1,sl_next);} \
    CMASK(C0,C1,t); \
    if(!FIXED){ float a=MX3(C0[0],C0[1],C1[0]),b=MX3(C0[2],C0[3],C1[1]); a=MX3(a,C1[2],C1[3]); \
      _Pragma("unroll") for(int r=4;r<16;r+=4){a=MX3(a,C0[r],C0[r+1]);b=MX3(b,C0[r+2],C0[r+3]);a=MX3(a,C1[r],C1[r+1]);b=MX3(b,C1[r+2],C1[r+3]);} \
      float rm=__builtin_fmaxf(a,b); { auto rr=__builtin_amdgcn_permlane32_swap(__float_as_uint(rm),__float_as_uint(rm),false,false); rm=__builtin_fmaxf(__uint_as_float(rr[0]),__uint_as_float(rr[1])); } \
      resc=false; \
      if(__builtin_expect(__any(rm>(float)THRL),0)){ const float dl=__builtin_fmaxf(rm,0.f); mhat+=dl; \
        _Pragma("unroll") for(int r=0;r<16;++r){C0[r]-=dl;C1[r]-=dl;} \
        _Pragma("unroll") for(int r=0;r<16;++r)negm[r]=-mhat; asm volatile("":"+v"(negm)); \
        const float f=__builtin_amdgcn_exp2f(-dl); l_reg*=f; if(hi==0)wsf[r32]=f; resc=true; } } \
    SBAR(); \
    GAPB(o[0]=__builtin_amdgcn_mfma_f32_32x32x16_bf16(PAF(0),VFR(0),o[0],0,0,0), C0,0); \
    GAPB(o[1]=__builtin_amdgcn_mfma_f32_32x32x16_bf16(PAF(0),VFR(4),o[1],0,0,0), C0,4); \
    KRD(GL,0); GAPB(o[0]=__builtin_amdgcn_mfma_f32_32x32x16_bf16(PAF(1),VFR(1),o[0],0,0,0), C0,8); \
    KRD(GL,1); GAPB(o[1]=__builtin_amdgcn_mfma_f32_32x32x16_bf16(PAF(1),VFR(5),o[1],0,0,0), C0,12); \
    KRD(GL,2); GAPB(o[0]=__builtin_amdgcn_mfma_f32_32x32x16_bf16(PAF(2),VFR(2),o[0],0,0,0), C1,0); \
    KRD(GL,3); GAPB(o[1]=__builtin_amdgcn_mfma_f32_32x32x16_bf16(PAF(2),VFR(6),o[1],0,0,0), C1,4); \
    GAPB(o[0]=__builtin_amdgcn_mfma_f32_32x32x16_bf16(PAF(3),VFR(3),o[0],0,0,0), C1,8); \
    GAPB(o[1]=__builtin_amdgcn_mfma_f32_32x32x16_bf16(PAF(3),VFR(7),o[1],0,0,0), C1,12); \
    }while(0)
  int t=1;
  #undef CMASK
  #define CMASK(P0,P1,t) do{}while(0)
  for(;t+5<NT;t+=2){
    STEP(pB0,pB1,pA0,pA1,t,true,true,true);     WAIT_BAR(2); RESC(); ROT();
    STEP(pA0,pA1,pB0,pB1,t+1,true,true,true);   WAIT_BAR(2); RESC(); ROT();
  }
  #define ENDW(tt) do{ if((tt)+3<NT){WAIT_BAR(2);} else if((tt)+2<NT){WAIT_BAR(1);} else {WAIT_BAR(0);} }while(0)
  for(;t+1<NT;t+=2){
    STEP(pB0,pB1,pA0,pA1,t,(t+3<NT),(t+1<NT),(t+1<NT));       ENDW(t);   RESC(); ROT();
    STEP(pA0,pA1,pB0,pB1,t+1,(t+4<NT),(t+2<NT),(t+2<NT));     ENDW(t+1); RESC(); ROT();
  }
  STEP(pB0,pB1,pA0,pA1,NT-1,false,false,false); RESC();
  { float sacc=pB0[0]+pB0[1]; _Pragma("unroll") for(int r=2;r<16;++r)sacc+=pB0[r]; _Pragma("unroll") for(int r=0;r<16;++r)sacc+=pB1[r]; l_reg+=sacc;
    pw0=(u32x4){PKW(pB0,0),PKW(pB0,2),PKW(pB0,4),PKW(pB0,6)};pw1=(u32x4){PKW(pB0,8),PKW(pB0,10),PKW(pB0,12),PKW(pB0,14)};pw2=(u32x4){PKW(pB1,0),PKW(pB1,2),PKW(pB1,4),PKW(pB1,6)};pw3=(u32x4){PKW(pB1,8),PKW(pB1,10),PKW(pB1,12),PKW(pB1,14)};
    SBAR(); pv(o,vb0+sl_cur,PAF(0),PAF(1),PAF(2),PAF(3)); }
  #undef PKW
  #undef PAF
  #undef VFR
  #undef PIN
  #undef MX3
  #undef GAPA
  #undef GAPB
  #undef EX
  #undef VRD
  #undef KRD
  #undef STEP
  #undef ENDW
  {auto rr=__builtin_amdgcn_permlane32_swap(__float_as_uint(l_reg),__float_as_uint(l_reg),false,false);l_reg=__uint_as_float(rr[0])+__uint_as_float(rr[1]);}
  if(hi==0)wsf[32+r32]=l_reg;asm volatile("s_waitcnt lgkmcnt(0)":::"memory");
  float rli[16];
  #pragma unroll
  for(int r=0;r<16;++r)rli[r]=__builtin_amdgcn_rcpf(wsf[32+crow(r,hi)]);
  bf16*Ow=O+(rowbase+q0+wid*QBLK)*PO+h*D;
  { bf16*stg=(bf16*)(shm+LDS_OST)+wid*2048;
    #pragma unroll
    for(int r=0;r<16;++r){const int orow=crow(r,hi);
      #pragma unroll
      for(int d0=0;d0<2;++d0)stg[orow*64+d0*32+r32]=__float2bfloat16(o[d0][r]*rli[r]);}
    asm volatile("s_waitcnt lgkmcnt(0)":::"memory");
    #pragma unroll
    for(int i=0;i<4;++i){const int row=i*8+(lane>>3),ch=lane&7; const u32x4 v=*(const u32x4*)(stg+row*64+ch*8); ATTN_STORE16(Ow+(long)row*PO+ch*8,v);} }
  asm volatile("s_waitcnt lgkmcnt(0)\n\ts_barrier":::"memory");
  #undef DMA_K
  #undef DMA_V
  #undef CMASK
  #undef START
  #undef RESC
  #undef ROT
}
constexpr int ATTN_LDS_BYTES=LDS_BYTES;
#undef SBAR
#undef WAIT_BAR
}

__device__ __forceinline__ void phase_attn(const Params& p, int layer, char* lds) {
    const int lane = otid() & 63;
    const float mq = wave_max(fabsf(p.in[I_QG][layer * 64 + lane])), mk = wave_max(fabsf(p.in[I_KG][layer * 64 + lane]));
    const float mfix = 64.0f * mq * mk * (0.125f * 1.4426950408889634f) * 1.02f;
    const bool fixed_ok = mfix < 48.0f;
    const int bid = obid();
    const int vcu = ((NBLK & 7) == 0) ? (bid & 7) * (int)(NBLK >> 3) + (bid >> 3) : bid;
    const attn_body::bf16* qkvb = (const attn_body::bf16*)(p.ws + R_QKV);
    for (int u = vcu; u < 512; u += NBLK) {
        const int bg = (u & 255) >> 6, r = u & 63, hh = r & 3, qb = (r >> 2) + 16 * (u >> 8);
        const int b = bg >> 1, g = bg & 1;
        if (fixed_ok) attn_body::attn_unit<8, true>(b, 4 * g + hh, g, qb, qkvb, qkvb + 512, qkvb + 640, (attn_body::bf16*)(p.ws + R_ATT), lds, mfix);
        else attn_body::attn_unit<8, false>(b, 4 * g + hh, g, qb, qkvb, qkvb + 512, qkvb + 640, (attn_body::bf16*)(p.ws + R_ATT), lds, 0.f);
    }
}

__device__ __forceinline__ size_t cidx(int c, int t) { return ((size_t)(t >> 5) * 256 + c) * 32 + (t & 31); }
__device__ __forceinline__ f32x4 convd4(const float* row, int l0, float w0, float w1, float w2, float cb) {
    const f32x4 c = *(const f32x4*)(row + l0);
    const float lft = (l0 > 0) ? row[l0 - 1] : 0.f;
    const float rgt = (l0 + 4 < SL) ? row[l0 + 4] : 0.f;
    f32x4 o;
    o.x = cb + w0 * lft + w1 * c.x + w2 * c.y;
    o.y = cb + w0 * c.x + w1 * c.y + w2 * c.z;
    o.z = cb + w0 * c.y + w1 * c.z + w2 * c.w;
    o.w = cb + w0 * c.z + w1 * c.w + w2 * rgt;
    return o;
}
__device__ __forceinline__ void cmul_kf(float2* Z, const float2* KF, int tid) {
#pragma unroll 4
    for (int i = 0; i < 16; ++i) {
        const int pp = 2 * tid + 1024 * i;
        const f32x4 z = *(const f32x4*)(Z + zp(pp)), k = *(const f32x4*)(KF + pp);
        f32x4 o; o.x = z.x * k.x - z.y * k.y; o.y = z.x * k.y + z.y * k.x; o.z = z.z * k.z - z.w * k.w; o.w = z.z * k.w + z.w * k.z;
        *(f32x4*)(Z + zp(pp)) = o;
    }
}
__device__ __forceinline__ void hyena_job(const Params& p, int layer, int c, char* lds) {
    const int tid = otid();
    float2* Z = (float2*)lds;
    const float* HF = (const float*)(p.ws + R_HF);
    const float* cw = p.in[I_CW] + (size_t)layer * 3 * 768; const float* cbp = p.in[I_CB] + layer * 768;
    const float2* KF0 = (const float2*)(p.ws + OFF_KF) + ((size_t)(layer * 256 + c) * 2) * 16384;
    const float2* KF1 = KF0 + 16384;
    float* Yb = (float*)(p.ws + R_Y);
    const int cv = c, c1 = 256 + c, c2 = 512 + c;
    const float* rv = HF + (size_t)cv * T; const float* r1 = HF + (size_t)c1 * T; const float* r2 = HF + (size_t)c2 * T;
    const float v_w0 = cw[cv], v_w1 = cw[768 + cv], v_w2 = cw[1536 + cv], v_cb = cbp[cv];
    const float a_w0 = cw[c1], a_w1 = cw[768 + c1], a_w2 = cw[1536 + c1], a_cb = cbp[c1];
    const float b_w0 = cw[c2], b_w1 = cw[768 + c2], b_w2 = cw[1536 + c2], b_cb = cbp[c2];
    const f32x4 zero4 = {0.f, 0.f, 0.f, 0.f};
    __syncthreads();
#pragma unroll 1
    for (int i = 0; i < 4; ++i) {
        const int l0 = 4 * otid() + 2048 * i;
        const f32x4 va = convd4(rv, l0, v_w0, v_w1, v_w2, v_cb), vb = convd4(rv + SL, l0, v_w0, v_w1, v_w2, v_cb);
        *(f32x4*)(Z + zp(l0)) = (f32x4){va.x, vb.x, va.y, vb.y}; *(f32x4*)(Z + zp(l0) + 2) = (f32x4){va.z, vb.z, va.w, vb.w};
        *(f32x4*)(Z + zp(8192 + l0)) = zero4; *(f32x4*)(Z + zp(8192 + l0) + 2) = zero4;
    }
    __syncthreads();
    fft16k_fwd(Z);
    cmul_kf(Z, KF0, otid());
    __syncthreads();
    fft16k_inv(Z);
#pragma unroll 1
    for (int i = 0; i < 4; ++i) {
        const int l0 = 4 * otid() + 2048 * i;
        const f32x4 za = *(const f32x4*)(Z + zp(l0)), zb = *(const f32x4*)(Z + zp(l0) + 2);
        const f32x4 ga = convd4(r1, l0, a_w0, a_w1, a_w2, a_cb), gb = convd4(r1 + SL, l0, a_w0, a_w1, a_w2, a_cb);
        *(f32x4*)(Z + zp(l0)) = (f32x4){ga.x * za.x, gb.x * za.y, ga.y * za.z, gb.y * za.w};
        *(f32x4*)(Z + zp(l0) + 2) = (f32x4){ga.z * zb.x, gb.z * zb.y, ga.w * zb.z, gb.w * zb.w};
        *(f32x4*)(Z + zp(8192 + l0)) = zero4; *(f32x4*)(Z + zp(8192 + l0) + 2) = zero4;
    }
    __syncthreads();
    fft16k_fwd(Z);
    cmul_kf(Z, KF1, otid());
    __syncthreads();
    fft16k_inv(Z);
#pragma unroll 1
    for (int i = 0; i < 4; ++i) {
        const int l0 = 4 * otid() + 2048 * i;
        const f32x4 za = *(const f32x4*)(Z + zp(l0)), zb = *(const f32x4*)(Z + zp(l0) + 2);
        const f32x4 ga = convd4(r2, l0, b_w0, b_w1, b_w2, b_cb), gb = convd4(r2 + SL, l0, b_w0, b_w1, b_w2, b_cb);
        f32x4 ya, yb;
        ya.x = ga.x * za.x; ya.y = ga.y * za.z; ya.z = ga.z * zb.x; ya.w = ga.w * zb.z;
        yb.x = gb.x * za.y; yb.y = gb.y * za.w; yb.z = gb.z * zb.y; yb.w = gb.w * zb.w;
        *(f32x4*)(Yb + cidx(c, l0)) = ya; *(f32x4*)(Yb + cidx(c, SL + l0)) = yb;
    }
    __syncthreads();
}

__device__ __forceinline__ void fnet_job(const Params& p, int ch, char* lds) {
    const int tid = otid();
    float2* Z = (float2*)lds;
    const float* row = (const float*)(p.ws + R_HF) + (size_t)(768 + ch) * T;
    float* UR = (float*)(p.ws + R_UR);
    float* UI = (float*)(p.ws + R_UI);
    __syncthreads();
#pragma unroll
    for (int i = 0; i < 4; ++i) {
        const int l0 = 4 * tid + 2048 * i;
        const f32x4 a = *(const f32x4*)(row + l0), b = *(const f32x4*)(row + SL + l0);
        const int z0 = zp(l0);
        *(f32x4*)(Z + z0) = (f32x4){a.x, b.x, a.y, b.y}; *(f32x4*)(Z + z0 + 2) = (f32x4){a.z, b.z, a.w, b.w};
    }
    __syncthreads();
    fft8k_fwd(Z);
#pragma unroll
    for (int i = 0; i < 4; ++i) {
        const int k0 = 4 * tid + 2048 * i;
        f32x4 ur0, ui0, ur1, ui1;
#pragma unroll
        for (int e = 0; e < 4; ++e) {
            const int k = k0 + e;
            const int pk = p8k_of_f(k);
            const int pm = p8k_of_f((SL - k) & (SL - 1));
            const float2 zk = Z[zp(pk)], zm = Z[zp(pm)];
            ur0[e] = 0.5f * (zk.x + zm.x); ui0[e] = 0.5f * (zk.y - zm.y);
            ur1[e] = 0.5f * (zk.y + zm.y); ui1[e] = 0.5f * (zm.x - zk.x);
        }
        *(f32x4*)(UR + cidx(ch, k0)) = ur0; *(f32x4*)(UI + cidx(ch, k0)) = ui0; *(f32x4*)(UR + cidx(ch, SL + k0)) = ur1; *(f32x4*)(UI + cidx(ch, SL + k0)) = ui1;
    }
    __syncthreads();
}

__device__ __forceinline__ void phase_mix(const Params& p, int layer, char* lds) {
    const int tid = otid(), lane = tid & 63, wave = tid >> 6;
    const int l31 = lane & 31, hl = lane >> 5, g = wave & 3, tsel = wave >> 2;
    float* ex = (float*)lds;
    float* FMl = (float*)(lds + 8192);
    const float* UR = (const float*)(p.ws + R_UR); const float* UI = (const float*)(p.ws + R_UI);
    const float* Y = (const float*)(p.ws + R_Y);
    const bf16_t* att = (const bf16_t*)(p.ws + R_ATT);
    bf16_t* mix = (bf16_t*)(p.ws + R_MIX);
    const float* fb = p.in[I_FB] + layer * 256 + g * 64;
    const float* mg = p.in[I_MG] + layer * 1024;
    __syncthreads();
    {
        const f32x4* src = (const f32x4*)((const float*)(p.ws + OFF_FM) + (size_t)layer * 4 * 128 * 64);
#pragma unroll 4
        for (int i = 0; i < 16; ++i) *(f32x4*)(FMl + 4 * (tid + NTHR * i)) = src[tid + NTHR * i];
    }
    for (int tp = obid(); tp < T / 64; tp += NBLK) {
        const int t = (tp * 2 + tsel) * 32 + l31;
        float bv[64];
        {
            const float* ub = UR + cidx(g * 64 + hl, t);
            const float* ub2 = UI + cidx(g * 64 + hl, t);
#pragma unroll
            for (int i = 0; i < 32; ++i) { bv[i] = ub[(2 * i) * 32]; bv[32 + i] = ub2[(2 * i) * 32]; }
        }
        float yv[32];
        {
            const float* yb = Y + cidx(g * 64 + hl * 32, t);
#pragma unroll
            for (int i = 0; i < 32; ++i) yv[i] = yb[i * 32];
        }
        const bf16_t* ab = att + (size_t)t * 512 + g * 128 + hl * 64;
        float sa = 0.f;
#pragma unroll
        for (int q = 0; q < 8; ++q) {
            const u32x4 a = *(const u32x4*)(ab + 8 * q);
            const float x0 = bflo(a.x), x1 = bfhi(a.x), x2 = bflo(a.y), x3 = bfhi(a.y), x4 = bflo(a.z), x5 = bfhi(a.z), x6 = bflo(a.w), x7 = bfhi(a.w);
            sa += x0 * x0 + x1 * x1 + x2 * x2 + x3 * x3 + x4 * x4 + x5 * x5 + x6 * x6 + x7 * x7;
        }
        __syncthreads();
        f32x16 acc0 = zero16(), acc1 = zero16();
        {
            const float* fa = FMl + (g * 128 + hl) * 64 + l31;
#pragma unroll
            for (int i = 0; i < 64; ++i) {
                const float a0 = fa[(2 * i) * 64], a1 = fa[(2 * i) * 64 + 32];
                acc0 = __builtin_amdgcn_mfma_f32_32x32x2f32(a0, bv[i], acc0, 0, 0, 0);
                acc1 = __builtin_amdgcn_mfma_f32_32x32x2f32(a1, bv[i], acc1, 0, 0, 0);
            }
        }
        float sf = 0.f;
#pragma unroll
        for (int i = 0; i < 4; ++i) {
            const f32x4 b0 = *(const f32x4*)(fb + 8 * i + 4 * hl), b1 = *(const f32x4*)(fb + 32 + 8 * i + 4 * hl);
            acc0[4 * i] += b0.x; acc0[4 * i + 1] += b0.y; acc0[4 * i + 2] += b0.z; acc0[4 * i + 3] += b0.w;
            acc1[4 * i] += b1.x; acc1[4 * i + 1] += b1.y; acc1[4 * i + 2] += b1.z; acc1[4 * i + 3] += b1.w;
        }
#pragma unroll
        for (int r = 0; r < 16; ++r) sf += acc0[r] * acc0[r] + acc1[r] * acc1[r];
        float sy = 0.f;
#pragma unroll
        for (int i = 0; i < 32; ++i) sy += yv[i] * yv[i];
        ex[(0 * 8 + wave) * 64 + lane] = sa; ex[(1 * 8 + wave) * 64 + lane] = sy; ex[(2 * 8 + wave) * 64 + lane] = sf;
        __syncthreads();
        float ta = 0.f, ty = 0.f, tf = 0.f;
#pragma unroll
        for (int w = 0; w < 4; ++w)
#pragma unroll
            for (int hh = 0; hh < 2; ++hh) {
                const int o = (tsel * 4 + w) * 64 + hh * 32 + l31;
                ta += ex[0 * 512 + o]; ty += ex[1 * 512 + o]; tf += ex[2 * 512 + o];
            }
        const float ra = rsqrtf(ta * (1.0f / 512.0f) + EPS), ry = rsqrtf(ty * (1.0f / 256.0f) + EPS), rf = rsqrtf(tf * (1.0f / 256.0f) + EPS);
        bf16_t* mrow = mix + (size_t)t * 1024;
        {
            const float* gg = mg + g * 128 + hl * 64;
#pragma unroll
            for (int q = 0; q < 8; ++q) {
                const u32x4 a = *(const u32x4*)(ab + 8 * q);
                const f32x4 g0 = *(const f32x4*)(gg + 8 * q), g1 = *(const f32x4*)(gg + 8 * q + 4);
                u32x4 o;
                o.x = pk2(bflo(a.x) * ra * g0.x, bfhi(a.x) * ra * g0.y); o.y = pk2(bflo(a.y) * ra * g0.z, bfhi(a.y) * ra * g0.w);
                o.z = pk2(bflo(a.z) * ra * g1.x, bfhi(a.z) * ra * g1.y); o.w = pk2(bflo(a.w) * ra * g1.z, bfhi(a.w) * ra * g1.w);
                *(u32x4*)(mrow + g * 128 + hl * 64 + 8 * q) = o;
            }
        }
        {
            const float* gg = mg + 512 + g * 64 + hl * 32;
#pragma unroll
            for (int q = 0; q < 4; ++q) {
                const f32x4 g0 = *(const f32x4*)(gg + 8 * q), g1 = *(const f32x4*)(gg + 8 * q + 4);
                u32x4 o;
                o.x = pk2(yv[8 * q] * ry * g0.x, yv[8 * q + 1] * ry * g0.y); o.y = pk2(yv[8 * q + 2] * ry * g0.z, yv[8 * q + 3] * ry * g0.w);
                o.z = pk2(yv[8 * q + 4] * ry * g1.x, yv[8 * q + 5] * ry * g1.y); o.w = pk2(yv[8 * q + 6] * ry * g1.z, yv[8 * q + 7] * ry * g1.w);
                *(u32x4*)(mrow + 512 + g * 64 + hl * 32 + 8 * q) = o;
            }
        }
        {
            const float* gg = mg + 768 + g * 64;
#pragma unroll
            for (int i = 0; i < 4; ++i) {
                const f32x4 g0 = *(const f32x4*)(gg + 8 * i + 4 * hl), g1 = *(const f32x4*)(gg + 32 + 8 * i + 4 * hl);
                u32x2 o0, o1;
                o0.x = pk2(acc0[4 * i] * rf * g0.x, acc0[4 * i + 1] * rf * g0.y); o0.y = pk2(acc0[4 * i + 2] * rf * g0.z, acc0[4 * i + 3] * rf * g0.w);
                o1.x = pk2(acc1[4 * i] * rf * g1.x, acc1[4 * i + 1] * rf * g1.y); o1.y = pk2(acc1[4 * i + 2] * rf * g1.z, acc1[4 * i + 3] * rf * g1.w);
                *(u32x2*)(mrow + 768 + g * 64 + 8 * i + 4 * hl) = o0;
                *(u32x2*)(mrow + 768 + g * 64 + 32 + 8 * i + 4 * hl) = o1;
            }
        }
    }
}

__device__ __forceinline__ float tk_pack(float v, unsigned code, unsigned mask) { return __builtin_bit_cast(float, (__builtin_bit_cast(unsigned, v) & ~mask) | code); }
__device__ __forceinline__ unsigned tk_lookup(const unsigned (&P)[4], unsigned i) {
    const unsigned w = (i < 4u) ? P[0] : (i < 8u) ? P[1] : (i < 12u) ? P[2] : P[3];
    return (w >> ((i & 3u) * 8u)) & 0x7Fu;
}
__device__ __forceinline__ float gelu_exact(float x) { return 0.5f * x * (1.0f + erff(x * 0.70710678118654752f)); }
typedef float f32x2 __attribute__((ext_vector_type(2)));
#define CVT_LO(W) __builtin_amdgcn_cvt_pk_f32_fp8((int)(W), false)
#define CVT_HI(W) __builtin_amdgcn_cvt_pk_f32_fp8((int)(W), true)


__device__ __forceinline__ void tk_sort16(float (&a)[16]) {
#pragma unroll
    for (int k = 2; k <= 16; k <<= 1)
#pragma unroll
        for (int j = k >> 1; j > 0; j >>= 1)
#pragma unroll
            for (int i = 0; i < 16; ++i) {
                const int l = i ^ j;
                if (l > i) {
                    const float hi = fmaxf(a[i], a[l]), lo = fminf(a[i], a[l]);
                    if ((i & k) == 0) { a[i] = hi; a[l] = lo; } else { a[i] = lo; a[l] = hi; }
                }
            }
}
__device__ __forceinline__ void tk_merge16(float (&a)[16]) {
#pragma unroll
    for (int j = 8; j > 0; j >>= 1)
#pragma unroll
        for (int i = 0; i < 16; ++i) {
            const int l = i ^ j;
            if (l > i) { const float hi = fmaxf(a[i], a[l]), lo = fminf(a[i], a[l]); a[i] = hi; a[l] = lo; }
        }
}
__device__ __forceinline__ void tk_top16_merge(float (&l)[16], const float (&g)[16]) {
#pragma unroll
    for (int i = 0; i < 16; ++i) l[i] = fmaxf(l[i], g[15 - i]);
    tk_merge16(l);
}
template <int CTRL> __device__ __forceinline__ float dpp_f(float v) { return __builtin_bit_cast(float, __builtin_amdgcn_update_dpp(0, __builtin_bit_cast(int, v), CTRL, 0xF, 0xF, false)); }
template <int CTRL> __device__ __forceinline__ int dpp_i(int v) { return __builtin_amdgcn_update_dpp(0, v, CTRL, 0xF, 0xF, false); }
constexpr int PE_LOGR = 4, PE_NR = 1 << PE_LOGR;
constexpr int PE_ENT = 12 * 1024;
constexpr int PE_WAVE = PE_ENT;


#define PE_RL(k) (((k & 4) << 1) | ((k & 2) << 3) | ((k & 1) << 5))
#define PE_LOAD_U(TK, RW, EV, CU, CG) do { \
        const int base_ = ((TK) * 128 + r * 8 + eid) * 3; \
        EV = ent[base_]; CU = __builtin_bit_cast(float, ent[base_ + 1]); CG = __builtin_bit_cast(float, ent[base_ + 2]); \
        _Pragma("unroll") for (int k = 0; k < 8; ++k) { const unsigned e = (unsigned)__builtin_amdgcn_readlane(EV, PE_RL(k)); \
            RW[k] = *(const u32x4*)(PU + (size_t)(e * 1024u) + loff); } \
    } while (0)
#define PE_COMP_U(TK, RW, CU, CG) do { \
        int d[8]; \
        _Pragma("unroll") for (int k = 0; k < 8; ++k) { int s_ = __builtin_amdgcn_sdot4((int)RW[k].x, xq[TK][0], 0, false); \
            s_ = __builtin_amdgcn_sdot4((int)RW[k].y, xq[TK][1], s_, false); s_ = __builtin_amdgcn_sdot4((int)RW[k].z, xq[TK][2], s_, false); \
            d[k] = __builtin_amdgcn_sdot4((int)RW[k].w, xq[TK][3], s_, false); } \
        _Pragma("unroll") for (int k = 0; k < 8; ++k) { d[k] += dpp_i<0xB1>(d[k]); d[k] += dpp_i<0x4E>(d[k]); d[k] += dpp_i<0x141>(d[k]); } \
        int r4[4], r2[2], u1; \
        _Pragma("unroll") for (int k = 0; k < 4; ++k) { const int send = b3 ? d[k] : d[k + 4], keep = b3 ? d[k + 4] : d[k]; r4[k] = keep + dpp_i<0x140>(send); } \
        _Pragma("unroll") for (int k = 0; k < 2; ++k) { const int send = b4 ? r4[k] : r4[k + 2], keep = b4 ? r4[k + 2] : r4[k]; r2[k] = keep + __shfl_xor(send, 16); } \
        { const int send = b5 ? r2[0] : r2[1], keep = b5 ? r2[1] : r2[0]; u1 = keep + __shfl_xor(send, 32); } \
        const float av = gelu_exact((float)u1 * (CU * sx[TK])) * CG; \
        if ((lane & 7) == 0) ent[((TK) * 128 + r * 8 + eid) * 3 + 1] = __builtin_bit_cast(int, av);     \
    } while (0)
#define PE_LOAD_V(TK, RW, AV) do { \
        const int base_ = ((TK) * 128 + r * 8 + eid) * 3; \
        const int ev = ent[base_]; AV = ent[base_ + 1]; \
        _Pragma("unroll") for (int k = 0; k < 8; ++k) { const unsigned e = (unsigned)__builtin_amdgcn_readlane(ev, PE_RL(k)); \
            RW[k] = *(const u32x4*)(PV + (size_t)(e * 1024u) + loff); } \
    } while (0)
#define PE_COMP_V(TK, RW, AV) do { \
        _Pragma("unroll") for (int k = 0; k < 8; ++k) { \
            const float a = __builtin_bit_cast(float, __builtin_amdgcn_readlane(AV, PE_RL(k))); \
            const f32x2 a2 = (f32x2){a, a}; \
            acc[TK][0] += a2 * CVT_LO(RW[k].x); acc[TK][1] += a2 * CVT_HI(RW[k].x); acc[TK][2] += a2 * CVT_LO(RW[k].y); acc[TK][3] += a2 * CVT_HI(RW[k].y); \
            acc[TK][4] += a2 * CVT_LO(RW[k].z); acc[TK][5] += a2 * CVT_HI(RW[k].z); acc[TK][6] += a2 * CVT_LO(RW[k].w); acc[TK][7] += a2 * CVT_HI(RW[k].w); } \
    } while (0)

template <bool DRY> __device__ __forceinline__ void phase_peer_fused(const Params& p, int layer, char* lds) {
    const int tid = otid(), lane = tid & 63, wave = tid >> 6;
    const unsigned char* PU = p.ws + OFF_PU + (size_t)layer * 16384 * 1024;
    const unsigned char* PV = p.ws + OFF_PV + (size_t)layer * 16384 * 1024;
    const float* SU = (const float*)(p.ws + OFF_PSC) + (size_t)layer * 16384;
    const float* SV = (const float*)(p.ws + OFF_PSC) + (size_t)(2 + layer) * 16384;
    bf16_t* XN = (bf16_t*)(p.ws + R_XN);
    float* XA = (float*)(p.ws + OFF_XA);
    const _Float16* SC = (const _Float16*)(p.ws + R_QP);
    const bool last = (layer == NLAYER - 1);
    const float* gnext = last ? p.in[I_FG] : p.in[I_N1G] + (layer + 1) * DM;
    const float* g2p = p.in[I_N2G] + layer * DM;
    const bool b5 = (lane & 32) != 0, b4 = (lane & 16) != 0, b3 = (lane & 8) != 0;
    const int eid = ((lane >> 3) & 1) * 4 + ((lane >> 4) & 1) * 2 + (lane >> 5);
    const unsigned loff = (unsigned)lane * 16u;
    int* ent = (int*)(lds + wave * PE_WAVE);
    const float NINF = -3.0e38f;
    const int pp = lane & 1;
    for (int tb = (obid() * NWAVE + wave) * 8; tb < T; tb += NBLK * NWAVE * 8) {
#pragma unroll 1
        for (int grp = 0; grp < 2; ++grp) {
            const int tkl = grp * 4 + (lane >> 4), h = (lane >> 1) & 7;
            const f16x8* src = (const f16x8*)(SC + (size_t)(tb + tkl) * 2048 + h * 256 + pp * 128);
            float l[16];
#pragma unroll
            for (int i = 0; i < 16; ++i) l[i] = NINF;
#pragma unroll 1
            for (int c = 0; c < 4; ++c) {
                f32x4 v[8];
#pragma unroll
                for (int j = 0; j < 4; ++j) {
                    const f16x8 hv = src[c * 4 + j];
                    v[2 * j] = (f32x4){(float)hv[0], (float)hv[1], (float)hv[2], (float)hv[3]};
                    v[2 * j + 1] = (f32x4){(float)hv[4], (float)hv[5], (float)hv[6], (float)hv[7]};
                }
#pragma unroll
                for (int hh = 0; hh < 2; ++hh) {
                    float g[16];
#pragma unroll
                    for (int j = 0; j < 4; ++j) {
                        const unsigned kb = (unsigned)(c * 32 + hh * 16 + j * 4);
                        g[4 * j] = tk_pack(v[hh * 4 + j].x, kb, 0x7Fu); g[4 * j + 1] = tk_pack(v[hh * 4 + j].y, kb + 1u, 0x7Fu);
                        g[4 * j + 2] = tk_pack(v[hh * 4 + j].z, kb + 2u, 0x7Fu); g[4 * j + 3] = tk_pack(v[hh * 4 + j].w, kb + 3u, 0x7Fu);
                    }
                    tk_sort16(g);
                    tk_top16_merge(l, g);
                }
            }
            float xw[16], ow[16]; unsigned PX[4] = {0u, 0u, 0u, 0u}, PO[4] = {0u, 0u, 0u, 0u};
#pragma unroll
            for (int i = 0; i < 16; ++i) {
                const float o = __shfl_xor(l[i], 1);
                const unsigned xb = __builtin_bit_cast(unsigned, l[i]), ob = __builtin_bit_cast(unsigned, o);
                xw[i] = __builtin_bit_cast(float, xb & ~0x7Fu); ow[i] = __builtin_bit_cast(float, ob & ~0x7Fu);
                PX[i >> 2] |= (xb & 0x7Fu) << ((i & 3) * 8); PO[i >> 2] |= (ob & 0x7Fu) << ((i & 3) * 8);
            }
            float f[16];
            {
                float c1[16];
#pragma unroll
                for (int i = 0; i < 16; ++i) { f[i] = NINF; c1[i] = NINF; }
                int cnt = 0;
#pragma unroll
                for (int i = 0; i < 16; ++i)
#pragma unroll
                    for (int j = i; j < 16; ++j)
                        if ((i + 1) * (j + 1) <= 16) {
                            float cv = xw[i] + ow[j];
                            const unsigned code = pp ? (unsigned)((j << 4) | i) : (unsigned)((i << 4) | j);
                            cv = tk_pack(cv, code, 0xFFu);
                            if (i == j) cv = pp ? NINF : cv;
                            if (cnt < 16) f[cnt & 15] = cv; else c1[cnt & 15] = cv;
                            ++cnt;
                        }
                tk_sort16(f); tk_sort16(c1);
                tk_top16_merge(f, c1);
                float gq[16];
#pragma unroll
                for (int i = 0; i < 16; ++i) gq[i] = __shfl_xor(f[i], 1);
                tk_top16_merge(f, gq);
            }
            unsigned P0[4], P1[4];
#pragma unroll
            for (int q = 0; q < 4; ++q) { P0[q] = pp ? PO[q] : PX[q]; P1[q] = pp ? PX[q] : PO[q]; }
            const float top = __builtin_bit_cast(float, __builtin_bit_cast(unsigned, f[0]) & ~0xFFu);
            float ev[16]; float den = 0.f;
#pragma unroll
            for (int r = 0; r < 16; ++r) { ev[r] = __expf(__builtin_bit_cast(float, __builtin_bit_cast(unsigned, f[r]) & ~0xFFu) - top); den += ev[r]; }
            const float rden = 1.0f / den;
#pragma unroll
            for (int r8 = 0; r8 < 8; ++r8) {
                const unsigned c0 = __builtin_bit_cast(unsigned, f[r8]) & 0xFFu, c1 = __builtin_bit_cast(unsigned, f[r8 + 8]) & 0xFFu;
                const unsigned code = pp ? c1 : c0;
                const float gate = (pp ? ev[r8 + 8] : ev[r8]) * rden;
                const int e = (int)(tk_lookup(P0, code >> 4) * 128u + tk_lookup(P1, code & 15u));
                const int o = (tkl * 128 + h * 16 + pp * 8 + r8) * 3;
                ent[o] = e; ent[o + 1] = __builtin_bit_cast(int, SU[e]); ent[o + 2] = __builtin_bit_cast(int, gate * SV[e]);
            }
        }
#pragma unroll 1
        for (int tk = 0; tk < 8; ++tk) {
            int* et = ent + tk * 384;
            const int eA = et[lane * 3], uA = et[lane * 3 + 1], gA = et[lane * 3 + 2];
            const int eB = et[(64 + lane) * 3], uB = et[(64 + lane) * 3 + 1], gB = et[(64 + lane) * 3 + 2];
            const int rA = eA >> (14 - PE_LOGR), rB = eB >> (14 - PE_LOGR);
            int base = 0;
#pragma unroll 1
            for (int r = 0; r < PE_NR; ++r) {
                const unsigned long long mA = __ballot(rA == r), mB = __ballot(rB == r);
                const int cA = __popcll(mA);
                if (rA == r) { const int q = base + (int)__builtin_amdgcn_mbcnt_hi((unsigned)(mA >> 32), __builtin_amdgcn_mbcnt_lo((unsigned)mA, 0u)); et[q * 3] = eA; et[q * 3 + 1] = uA; et[q * 3 + 2] = gA; }
                if (rB == r) { const int q = base + cA + (int)__builtin_amdgcn_mbcnt_hi((unsigned)(mB >> 32), __builtin_amdgcn_mbcnt_lo((unsigned)mB, 0u)); et[q * 3] = eB; et[q * 3 + 1] = uB; et[q * 3 + 2] = gB; }
                base += cA + __popcll(mB);
            }
        }
        {
            {
                int xq[8][4]; float sx[8];
#pragma unroll
                for (int tk = 0; tk < 8; ++tk) {
                    f32x4 xr[4]; float ss = 0.f;
#pragma unroll
                    for (int j = 0; j < 4; ++j) { xr[j] = *(const f32x4*)(XA + (size_t)(tb + tk) * DM + 4 * lane + 256 * j); ss += xr[j].x * xr[j].x + xr[j].y * xr[j].y + xr[j].z * xr[j].z + xr[j].w * xr[j].w; }
                    ss = wave_sum(ss);
                    const float rn = rsqrtf(ss * (1.0f / DM) + EPS);
                    float mx = 0.f;
#pragma unroll
                    for (int j = 0; j < 4; ++j) { const f32x4 gg = *(const f32x4*)(g2p + 4 * lane + 256 * j);
                        xr[j] = xr[j] * rn * gg; mx = fmaxf(mx, fmaxf(fmaxf(fabsf(xr[j].x), fabsf(xr[j].y)), fmaxf(fabsf(xr[j].z), fabsf(xr[j].w)))); }
                    mx = wave_max(mx);
                    const float qs = mx > 0.f ? 127.0f / mx : 1.0f;
                    sx[tk] = mx > 0.f ? mx * (1.0f / 127.0f) : 1.0f;
#pragma unroll
                    for (int j = 0; j < 4; ++j) xq[tk][j] = (int)pk_i8(xr[j] * qs);
                }
#pragma unroll 1
                for (int r = 0; r < 16; ++r) {
                    __syncthreads();
                    u32x4 rwA[8], rwB[8]; int evA, evB; float cuA, cgA, cuB, cgB;
                    PE_LOAD_U(0, rwA, evA, cuA, cgA);
                    PE_LOAD_U(1, rwB, evB, cuB, cgB); PE_COMP_U(0, rwA, cuA, cgA);
                    PE_LOAD_U(2, rwA, evA, cuA, cgA); PE_COMP_U(1, rwB, cuB, cgB);
                    PE_LOAD_U(3, rwB, evB, cuB, cgB); PE_COMP_U(2, rwA, cuA, cgA);
                    PE_LOAD_U(4, rwA, evA, cuA, cgA); PE_COMP_U(3, rwB, cuB, cgB);
                    PE_LOAD_U(5, rwB, evB, cuB, cgB); PE_COMP_U(4, rwA, cuA, cgA);
                    PE_LOAD_U(6, rwA, evA, cuA, cgA); PE_COMP_U(5, rwB, cuB, cgB);
                    PE_LOAD_U(7, rwB, evB, cuB, cgB); PE_COMP_U(6, rwA, cuA, cgA);
                    PE_COMP_U(7, rwB, cuB, cgB);
                }
            }
#pragma unroll 1
            for (int hv = 0; hv < 2; ++hv) {
            f32x2 acc[4][8];
#pragma unroll
            for (int tk = 0; tk < 4; ++tk)
#pragma unroll
                for (int j = 0; j < 8; ++j) acc[tk][j] = (f32x2){0.f, 0.f};
            const int* entv = ent;
            {
                int* ent = (int*)entv + hv * 4 * 128 * 3;
#pragma unroll 1
                for (int r = 0; r < 16; ++r) {
                    __syncthreads();
                    u32x4 rwA[8], rwB[8]; int avA, avB;
                    PE_LOAD_V(0, rwA, avA);
                    PE_LOAD_V(1, rwB, avB); PE_COMP_V(0, rwA, avA);
                    PE_LOAD_V(2, rwA, avA); PE_COMP_V(1, rwB, avB);
                    PE_LOAD_V(3, rwB, avB); PE_COMP_V(2, rwA, avA);
                    PE_COMP_V(3, rwB, avB);
                }
            }
#pragma unroll
            for (int tk = 0; tk < 4; ++tk) {
                const int t = tb + hv * 4 + tk;
                f32x4 x[4]; float ss = 0.f;
#pragma unroll
                for (int j = 0; j < 4; ++j) {
                    x[j] = *(const f32x4*)(XA + (size_t)t * DM + 4 * lane + 256 * j);
                    x[j].x += acc[tk][2 * j].x; x[j].y += acc[tk][2 * j].y; x[j].z += acc[tk][2 * j + 1].x; x[j].w += acc[tk][2 * j + 1].y;
                    ss += x[j].x * x[j].x + x[j].y * x[j].y + x[j].z * x[j].z + x[j].w * x[j].w;
                }
                ss = wave_sum(ss);
                const float rr = rsqrtf(ss * (1.0f / DM) + EPS);
                if (last) {
#pragma unroll
                    for (int j = 0; j < 4; ++j) { const f32x4 gg = *(const f32x4*)(gnext + 4 * lane + 256 * j); *(f32x4*)(p.out + (size_t)t * DM + 4 * lane + 256 * j) = x[j] * rr * gg; }
                } else {
#pragma unroll
                    for (int j = 0; j < 4; ++j) {
                        const f32x4 gg = *(const f32x4*)(gnext + 4 * lane + 256 * j);
                        *(f32x4*)((DRY ? p.out : XA) + (size_t)t * DM + 4 * lane + 256 * j) = x[j];
                        u32x2 w; w.x = pk2(x[j].x * rr * gg.x, x[j].y * rr * gg.y); w.y = pk2(x[j].z * rr * gg.z, x[j].w * rr * gg.w);
                        if (!DRY) *(u32x2*)(XN + (size_t)t * DM + 4 * lane + 256 * j) = w;
                    }
                }
            }
            }
        }
    }
}

#define LAS __attribute__((address_space(3)))
#define XB_TMO      128
#define XB_XCNT(j)  (256  + 64 * (j))
#define XB_XSUB(j)  (1280 + 64 * (j))
#define XB_XGEN(j)  (2304 + 64 * (j))
#define XB_TOP      3328
#define XB_TOPGEN   3392
#define XCD_BAR_WORDS 3456
#define XB_SPIN_CAP (1u << 20)
__device__ __forceinline__ unsigned xb_ld(unsigned* p)              { return __hip_atomic_load(p, __ATOMIC_RELAXED, __HIP_MEMORY_SCOPE_AGENT); }
__device__ __forceinline__ unsigned xb_add(unsigned* p, unsigned v) { return __hip_atomic_fetch_add(p, v, __ATOMIC_RELAXED, __HIP_MEMORY_SCOPE_AGENT); }
__device__ __forceinline__ unsigned xb_xcc_id() { return (unsigned)__builtin_amdgcn_s_getreg((3 << 11) | 20) & 0xFu; }
#define XB_SPIN(cond, bar) do { unsigned _sp = 0; while (cond) { __builtin_amdgcn_s_sleep(1); \
    if ((++_sp & 255u) == 0u) { if (xb_ld(&(bar)[XB_TMO])) break; if (_sp > XB_SPIN_CAP) { atomicAdd(&(bar)[XB_TMO], 1u); break; } } } } while (0)
struct XcdBarrier { unsigned* bar; unsigned x; volatile LAS unsigned* st; };
__device__ __forceinline__ XcdBarrier xcd_barrier_post(unsigned* bar, volatile LAS unsigned* st) {
    XcdBarrier b; b.bar = bar; b.x = xb_xcc_id(); b.st = st;
    if (threadIdx.x == 0) (void)xb_add(&bar[XB_XCNT(b.x)], 1u);
    return b;
}
__device__ __forceinline__ void xcd_barrier_complete(unsigned* bar, unsigned x, unsigned& nloc, unsigned& nx) {
    const unsigned G = NBLK;
    unsigned sum, cnt, mine, sp = 0u;
    for (;;) {
        sum = 0u; cnt = 0u; mine = 0u;
#pragma unroll
        for (unsigned j = 0; j < 16; ++j) { const unsigned c = xb_ld(&bar[XB_XCNT(j)]); sum += c; cnt += (c > 0u) ? 1u : 0u; mine = (j == x) ? c : mine; }
        if (sum == G) break;
        __builtin_amdgcn_s_sleep(1);
        if ((++sp & 255u) == 0u) { if (xb_ld(&bar[XB_TMO])) break; if (sp > XB_SPIN_CAP) { atomicAdd(&bar[XB_TMO], 1u); break; } }
    }
    nloc = mine > 0u ? mine : 1u; nx = cnt > 0u ? cnt : 1u;
}
__device__ __forceinline__ void xcd_barrier(const XcdBarrier& b) {
    asm volatile("s_waitcnt vmcnt(0)" ::: "memory");
    __syncthreads();
    if (threadIdx.x == 0) {
        unsigned* bar = b.bar;
        __builtin_amdgcn_s_waitcnt(0);
        unsigned nloc = b.st[0], nx = b.st[1];
        if (nloc == 0u) { xcd_barrier_complete(bar, b.x, nloc, nx); b.st[0] = nloc; b.st[1] = nx; }
        const unsigned old = xb_add(&bar[XB_XSUB(b.x)], 1u);
        const unsigned gen = old / nloc;
        if (old + 1u == (gen + 1u) * nloc) {
            __builtin_amdgcn_fence(__ATOMIC_RELEASE, "agent");
            asm volatile("s_waitcnt vmcnt(0)" ::: "memory");
            const unsigned og = xb_add(&bar[XB_TOP], 1u);
            const unsigned tg = og / nx;
            if (og + 1u == (tg + 1u) * nx) xb_add(&bar[XB_TOPGEN], 1u);
            else XB_SPIN(xb_ld(&bar[XB_TOPGEN]) == tg, bar);
            __builtin_amdgcn_fence(__ATOMIC_ACQUIRE, "agent");
            xb_add(&bar[XB_XGEN(b.x)], 1u);
            asm volatile("s_waitcnt vmcnt(0)" ::: "memory");
        } else {
            XB_SPIN(xb_ld(&bar[XB_XGEN(b.x)]) == gen, bar);
            __builtin_amdgcn_fence(__ATOMIC_ACQUIRE, "agent");
            asm volatile("s_waitcnt vmcnt(0)" ::: "memory");
        }
    }
    __syncthreads();
}


template <class Epi> __device__ __forceinline__ void big_gemm(const bf16_t* A, const bf16_t* Bt, int M, int N, int K, char* lds, const Epi& e) {
    pg8::Gemm g{A, Bt, M, N, K}; pg8::StaticOrder S; S.init(M, N, NBLK, obid());
    pg8::gemm_phase<Epi, pg8::StaticOrder, true, true>((PG8_LAS unsigned char*)lds, g, S, e);
}

#define GSYNC() xcd_barrier(xbar)
template <int layer> __device__ __forceinline__ void run_layer(const Params& p, char* lds, const XcdBarrier& xbar) {
    float* XA = (float*)(p.ws + OFF_XA);

        const float* xin = layer == 0 ? p.in[I_X] : XA;
        {
            const bf16_t* wt = (const bf16_t*)(p.ws + OFF_WTIN) + (size_t)layer * INC * DM;
            pg8::EpiStoreBf16 e1{(bf16_t*)(p.ws + R_QKV), 768};
            big_gemm((const bf16_t*)(p.ws + R_XN), wt, T, 768, DM, lds, e1);
            pg8::EpiStoreF32 e2{nullptr, (float*)(p.ws + R_HF), T};
            big_gemm(wt + (size_t)768 * DM, (const bf16_t*)(p.ws + R_XN), 1024, T, DM, lds, e2);
        }
        if (layer == 0) {
#pragma nounroll
            for (int fl = 0; fl < NLAYER; ++fl) {
                EpiF32 e{(float*)(p.ws + (fl ? OFF_HFILT1 : OFF_HFILT0)), SL};
                gemm_simple((const bf16_t*)(p.ws + OFF_W3T) + (size_t)fl * 1024 * 64, (const bf16_t*)(p.ws + OFF_H2) + (size_t)fl * SL * 64, 1024, SL, 64, lds, e);
            }
        }
        GSYNC();
        if (layer == 0) {
            phase_filter_spectra(p, lds);
        }
        phase_qkprep(p, layer, lds, (bf16_t*)(p.ws + R_QKV)); GSYNC();
        {
            phase_attn(p, layer, lds);
            for (int c = obid(); c < 256; c += NBLK) hyena_job(p, layer, c, lds);
            for (int c = obid(); c < 256; c += NBLK) fnet_job(p, c, lds);
        } GSYNC();
        phase_mix(p, layer, lds); GSYNC();
        { pg8::EpiOutProj e{xin, XA, (bf16_t*)(p.ws + R_XN), (float*)(p.ws + OFF_RS)};
          big_gemm((const bf16_t*)(p.ws + R_MIX), (const bf16_t*)(p.ws + OFF_WTOUT) + (size_t)layer * DM * DM, T, DM, DM, lds, e); } GSYNC();
        { pg8::EpiRowScaleF16 e{(_Float16*)(p.ws + R_QP), 2048, (const float*)(p.ws + OFF_RS)};
          big_gemm((const bf16_t*)(p.ws + R_XN), (const bf16_t*)(p.ws + OFF_WTQ) + (size_t)layer * 2048 * DM, T, 2048, DM, lds, e); } GSYNC();
        phase_peer_fused<false>(p, layer, lds);
        if (layer + 1 < NLAYER) GSYNC();
}

__global__ void __launch_bounds__(NTHR) mega_kernel(Params p) {
    extern __shared__ __attribute__((aligned(16))) char lds[];
    volatile LAS unsigned* misc = (volatile LAS unsigned*)((LAS char*)lds + LDS_MISC);
    if (threadIdx.x < 16) misc[threadIdx.x] = 0u;
    __syncthreads();
    const XcdBarrier xbar = xcd_barrier_post((unsigned*)(p.ws + OFF_CTL) + 4096, misc);
    float* XA = (float*)(p.ws + OFF_XA);
    phase_p0(p, lds);
    phase_rmsnorm_bf16(p.in[I_X], p.in[I_N1G], (bf16_t*)(p.ws + R_XN));
    GSYNC();
    run_layer<0>(p, lds, xbar);
    run_layer<1>(p, lds, xbar);
}

extern "C" void kernel_launch(void* const* d_in, const int* in_sizes, int n_in, void* d_out, int out_size, void* d_ws, size_t ws_size, hipStream_t stream) {
    static int grid = 0;
    if (grid == 0) {
        if (n_in != 25 || out_size != T * DM || ws_size < WS_NEED) { fprintf(stderr, "kernel_launch: unexpected sizes n_in %d out %d ws %zu (need %zu)\n", n_in, out_size, ws_size, (size_t)WS_NEED); grid = -1; return; }
        int dev = 0, cus = 0, per_cu = 0;
        if (hipGetDevice(&dev) != hipSuccess || hipDeviceGetAttribute(&cus, hipDeviceAttributeMultiprocessorCount, dev) != hipSuccess) { grid = -1; return; }
        if (hipFuncSetAttribute((const void*)mega_kernel, hipFuncAttributeMaxDynamicSharedMemorySize, LDS_BYTES) != hipSuccess) { fprintf(stderr, "kernel_launch: hipFuncSetAttribute failed\n"); grid = -1; return; }
        if (hipOccupancyMaxActiveBlocksPerMultiprocessor(&per_cu, (const void*)mega_kernel, NTHR, LDS_BYTES) != hipSuccess || per_cu < 1) { fprintf(stderr, "kernel_launch: occupancy query says %d blocks per CU\n", per_cu); grid = -1; return; }
        (void)hipGetLastError();
        if (cus < NBLK) { fprintf(stderr, "kernel_launch: built for a %d-CU device, found %d CUs\n", NBLK, cus); grid = -1; return; }
        grid = NBLK;
    }
    if (grid < 0) return;
    Params p{};
    for (int i = 0; i < 25; ++i) p.in[i] = (const float*)d_in[i];
    p.out = (float*)d_out; p.ws = (unsigned char*)d_ws;
    if (hipMemsetAsync((char*)d_ws + OFF_CTL, 0, 64 * 1024, stream) != hipSuccess) { fprintf(stderr, "kernel_launch: memset failed\n"); return; }
    void* args[] = {&p};
    hipError_t e = hipLaunchCooperativeKernel((const void*)mega_kernel, dim3(grid), dim3(NTHR), args, LDS_BYTES, stream);
    if (e != hipSuccess) fprintf(stderr, "cooperative launch failed: %s (grid %d)\n", hipGetErrorString(e), grid);
}
```

```cpp
#include <hip/hip_runtime.h>
#include <cstdio>
#include <cstdint>

typedef unsigned short bf16_t;
typedef short bf16x8 __attribute__((ext_vector_type(8)));
typedef float f32x16 __attribute__((ext_vector_type(16)));
typedef float f32x4 __attribute__((ext_vector_type(4)));
typedef unsigned u32x4 __attribute__((ext_vector_type(4)));
typedef unsigned u32x2 __attribute__((ext_vector_type(2)));
typedef _Float16 f16x4 __attribute__((ext_vector_type(4)));
typedef _Float16 f16x8 __attribute__((ext_vector_type(8)));

constexpr int DM = 1024, NB = 2, SL = 8192, T = NB * SL, NLAYER = 2;
constexpr int INC = 1792;
constexpr int NTHR = 512, NWAVE = 8;
constexpr int NBLK = 256;
constexpr int LDS_BYTES = 147456;
constexpr int LDS_MISC = LDS_BYTES - 64;
constexpr float EPS = 1e-6f;

constexpr size_t MiB = 1u << 20;
constexpr size_t OFF_CTL = 0;
constexpr size_t OFF_WTIN = 1 * MiB;
constexpr size_t OFF_WTOUT = 8 * MiB;
constexpr size_t OFF_WTQ = 12 * MiB;
constexpr size_t OFF_PU = 20 * MiB;
constexpr size_t OFF_PV = 84 * MiB;
constexpr size_t OFF_RS = 505 * MiB;
constexpr size_t OFF_PSC = 512 * 1024;
constexpr size_t OFF_H2 = 148 * MiB;
constexpr size_t OFF_W3T = 150 * MiB;
constexpr size_t OFF_HFILT0 = 52 * MiB, OFF_HFILT1 = 116 * MiB;
constexpr size_t OFF_FM = 152 * MiB;
constexpr size_t OFF_KF = 153 * MiB;
constexpr size_t OFF_XA = 281 * MiB;
constexpr size_t OFF_R = 345 * MiB;
constexpr size_t R_XN = OFF_R + 0 * MiB;
constexpr size_t R_UR = OFF_R + 0 * MiB;
constexpr size_t R_UI = OFF_R + 16 * MiB;
constexpr size_t R_QKV = OFF_R + 32 * MiB;
constexpr size_t R_HF = OFF_R + 60 * MiB;
constexpr size_t R_MIX = OFF_R + 60 * MiB;
constexpr size_t R_ATT = OFF_R + 124 * MiB;
constexpr size_t R_Y = OFF_R + 140 * MiB;
constexpr size_t R_QP = OFF_R + 32 * MiB;
constexpr size_t WS_NEED = 506 * MiB;

struct Params {
    const float* in[25];
    float* out;
    unsigned char* ws;
};
enum { I_X = 0, I_N1G, I_WIN, I_QG, I_KG, I_CW, I_CB, I_W1, I_B1, I_F1, I_W2, I_B2, I_F2, I_W3, I_HB, I_FW, I_FB, I_MG, I_WOUT, I_N2G, I_WQ, I_SK, I_PU, I_PV, I_FG };

__device__ __forceinline__ unsigned f2bf(float f) { unsigned u = __builtin_bit_cast(unsigned, f); return (u + 0x7fffu + ((u >> 16) & 1u)) >> 16; }
__device__ __forceinline__ unsigned pk2(float lo, float hi) { return f2bf(lo) | (f2bf(hi) << 16); }
__device__ __forceinline__ float bflo(unsigned w) { return __builtin_bit_cast(float, w << 16); }
__device__ __forceinline__ float bfhi(unsigned w) { return __builtin_bit_cast(float, w & 0xffff0000u); }
__device__ __forceinline__ float wave_sum(float v) {
#pragma unroll
    for (int o = 1; o < 64; o <<= 1) v += __shfl_xor(v, o);
    return v;
}
__device__ __forceinline__ float wave_max(float v) {
#pragma unroll
    for (int o = 1; o < 64; o <<= 1) v = fmaxf(v, __shfl_xor(v, o));
    return v;
}
__device__ __forceinline__ unsigned pk_i8(f32x4 v) {
    const int a = (int)rintf(v.x), b = (int)rintf(v.y), c = (int)rintf(v.z), d = (int)rintf(v.w);
    return ((unsigned)a & 0xFFu) | (((unsigned)b & 0xFFu) << 8) | (((unsigned)c & 0xFFu) << 16) | ((unsigned)d << 24);
}
__device__ __forceinline__ f32x16 mfma32(bf16x8 a, bf16x8 b, f32x16 c) { return __builtin_amdgcn_mfma_f32_32x32x16_bf16(a, b, c, 0, 0, 0); }
__device__ __forceinline__ f32x16 zero16() { return (f32x16){0.f,0.f,0.f,0.f,0.f,0.f,0.f,0.f,0.f,0.f,0.f,0.f,0.f,0.f,0.f,0.f}; }


__device__ __forceinline__ int otid() { int t = threadIdx.x; asm volatile("" : "+v"(t)); return t; }
__device__ __forceinline__ int obid() { int b = blockIdx.x; asm volatile("" : "+s"(b)); return b; }
__device__ __forceinline__ void transpose_one(const float* W, int K, int N, bf16_t* Wt, float* tile, int item) {
    const int tid = otid();
    const int nblk = N / 64, kb = item / nblk, nb = item % nblk, k0 = kb * 64, n0 = nb * 64;
    __syncthreads();
    {
        const int r = tid >> 6, c = tid & 63;
#pragma unroll
        for (int i = 0; i < 8; ++i) { const int k = r + 8 * i; tile[k * 65 + c] = W[(size_t)(k0 + k) * N + n0 + c]; }
    }
    __syncthreads();
    {
        const int nn = tid >> 3, kc = tid & 7;
        const float* s = tile + (kc * 8) * 65 + nn;
        u32x4 o; o.x = pk2(s[0], s[65]); o.y = pk2(s[2 * 65], s[3 * 65]); o.z = pk2(s[4 * 65], s[5 * 65]); o.w = pk2(s[6 * 65], s[7 * 65]);
        *(u32x4*)(Wt + (size_t)(n0 + nn) * K + k0 + kc * 8) = o;
    }
}

template <int PARTS = 31> __device__ __forceinline__ void phase_p0(const Params& p, char* lds) {
    const int tid = otid();
    float* tile = (float*)lds;
    if (PARTS & 1) {
    constexpr int IT_IN = (DM / 64) * (INC / 64), IT_OUT = (DM / 64) * (DM / 64), IT_W3 = 1024 / 64;
    constexpr int IT_L = IT_IN + IT_OUT + IT_W3;
    for (int it = obid(); it < NLAYER * IT_L; it += NBLK) {
        const int layer = it / IT_L; int r = it % IT_L;
        if (r < IT_IN) { transpose_one(p.in[I_WIN] + (size_t)layer * DM * INC, DM, INC, (bf16_t*)(p.ws + OFF_WTIN) + (size_t)layer * INC * DM, tile, r); continue; }
        r -= IT_IN;
        if (r < IT_OUT) { transpose_one(p.in[I_WOUT] + (size_t)layer * DM * DM, DM, DM, (bf16_t*)(p.ws + OFF_WTOUT) + (size_t)layer * DM * DM, tile, r); continue; }
        r -= IT_OUT;
        transpose_one(p.in[I_W3] + (size_t)layer * 64 * 1024, 64, 1024, (bf16_t*)(p.ws + OFF_W3T) + (size_t)layer * 1024 * 64, tile, r);
    }
    }
    __syncthreads();
    if (PARTS & 2) {
        float* SKl = (float*)lds;
        float* Wl = SKl + 128 * 129;
        const int lane = tid & 63, wave = tid >> 6, l31 = lane & 31, hl = lane >> 5, mt = wave & 3, nt = wave >> 2;
        for (int it = obid(); it < NLAYER * 16 * 16; it += NBLK) {
            const int layer = it >> 8, hp = (it >> 4) & 15, kc = it & 15, h = hp >> 1, pp = hp & 1, k0 = kc * 64;
            const float* sk = p.in[I_SK] + (((size_t)(layer * 2 + pp) * 8 + h) * 128) * 128;
            const float* wq = p.in[I_WQ] + (size_t)layer * DM * 2048 + (size_t)k0 * 2048 + h * 256 + pp * 128;
            __syncthreads();
            for (int i = tid; i < 128 * 128; i += NTHR) SKl[(i >> 7) * 129 + (i & 127)] = sk[i];
            for (int i = tid; i < 64 * 128; i += NTHR) Wl[(i >> 7) * 129 + (i & 127)] = wq[(size_t)(i >> 7) * 2048 + (i & 127)];
            __syncthreads();
            f32x16 acc = zero16();
            const float* ap = SKl + (32 * mt + l31) * 129 + hl;
            const float* bp = Wl + (32 * nt + l31) * 129 + hl;
#pragma unroll 16
            for (int kk = 0; kk < 64; ++kk) acc = __builtin_amdgcn_mfma_f32_32x32x2f32(ap[2 * kk], bp[2 * kk], acc, 0, 0, 0);
            const float g2 = p.in[I_N2G][layer * DM + k0 + 32 * nt + l31];
            bf16_t* dst = (bf16_t*)(p.ws + OFF_WTQ) + (size_t)layer * 2048 * DM + (size_t)(hp * 128 + 32 * mt + 4 * hl) * DM + k0 + 32 * nt + l31;
#pragma unroll
            for (int r = 0; r < 16; ++r) dst[(size_t)((r & 3) + 8 * (r >> 2)) * DM] = (bf16_t)f2bf(acc[r] * g2);
        }
        __syncthreads();
    }
    if (PARTS & 4) {
        const int lane = tid & 63, wave = tid >> 6;
        float* scl = (float*)(p.ws + OFF_PSC);
        for (int row = obid() * NWAVE + wave; row < 2 * NLAYER * 16384; row += NBLK * NWAVE) {
            const int tb = row >> 15, r = row & 32767;
            const f32x4* src = (const f32x4*)(p.in[tb ? I_PV : I_PU] + (size_t)r * DM) + lane;
            f32x4 v[4]; float mx = 0.f;
#pragma unroll
            for (int j = 0; j < 4; ++j) { v[j] = __builtin_nontemporal_load(src + 64 * j); mx = fmaxf(mx, fmaxf(fmaxf(fabsf(v[j].x), fabsf(v[j].y)), fmaxf(fabsf(v[j].z), fabsf(v[j].w)))); }
            mx = wave_max(mx);
            const float sc = mx > 0.f ? 224.0f / mx : 1.0f;
            u32x4 o;
            { int w = 0; w = __builtin_amdgcn_cvt_pk_fp8_f32(v[0].x * sc, v[0].y * sc, w, false); w = __builtin_amdgcn_cvt_pk_fp8_f32(v[0].z * sc, v[0].w * sc, w, true); o.x = (unsigned)w; }
            { int w = 0; w = __builtin_amdgcn_cvt_pk_fp8_f32(v[1].x * sc, v[1].y * sc, w, false); w = __builtin_amdgcn_cvt_pk_fp8_f32(v[1].z * sc, v[1].w * sc, w, true); o.y = (unsigned)w; }
            { int w = 0; w = __builtin_amdgcn_cvt_pk_fp8_f32(v[2].x * sc, v[2].y * sc, w, false); w = __builtin_amdgcn_cvt_pk_fp8_f32(v[2].z * sc, v[2].w * sc, w, true); o.z = (unsigned)w; }
            { int w = 0; w = __builtin_amdgcn_cvt_pk_fp8_f32(v[3].x * sc, v[3].y * sc, w, false); w = __builtin_amdgcn_cvt_pk_fp8_f32(v[3].z * sc, v[3].w * sc, w, true); o.w = (unsigned)w; }
            if (!tb) {
                const float qs = mx > 0.f ? 127.0f / mx : 1.0f;
                o.x = pk_i8(v[0] * qs); o.y = pk_i8(v[1] * qs); o.z = pk_i8(v[2] * qs); o.w = pk_i8(v[3] * qs);
            }
            *(u32x4*)(p.ws + (tb ? OFF_PV : OFF_PU) + (size_t)r * DM + lane * 16) = o;
            if (lane == 0) scl[row] = mx > 0.f ? mx / (tb ? 224.0f : 127.0f) : 1.0f;
        }
    }
    if (PARTS & 8) {
        float* sh = (float*)lds;
        float* zl = sh + 64 * 64;
        const int sub = tid >> 6, j = tid & 63;
        for (int it0 = obid() * 64; it0 < NLAYER * SL; it0 += NBLK * 64) {
            const int layer = it0 / SL;
            __syncthreads();
            for (int o = tid; o < 64 * 17; o += NTHR) {
                const int item = o / 17, f = o % 17;
                const float t = (float)((it0 + item) % SL) / (float)(SL - 1);
                float z;
                if (f == 0) z = t;
                else if (f <= 8) z = sinf(2.0f * 3.14159265358979323846f * t * (float)f);
                else z = cosf(2.0f * 3.14159265358979323846f * t * (float)(f - 8));
                zl[o] = z;
            }
            __syncthreads();
            {
                const float* w1 = p.in[I_W1] + layer * 17 * 64;
                float wv[17];
#pragma unroll
                for (int i = 0; i < 17; ++i) wv[i] = w1[i * 64 + j];
                const float b1 = p.in[I_B1][layer * 64 + j], f1 = p.in[I_F1][layer * 64 + j];
#pragma unroll
                for (int r = 0; r < 8; ++r) {
                    const int item = sub * 8 + r;
                    float a = b1;
#pragma unroll
                    for (int i = 0; i < 17; ++i) a += zl[item * 17 + i] * wv[i];
                    sh[item * 64 + j] = sinf(f1 * a);
                }
            }
            __syncthreads();
            {
                const float* w2 = p.in[I_W2] + layer * 64 * 64;
                const float b2 = p.in[I_B2][layer * 64 + j], f2 = p.in[I_F2][layer * 64 + j];
                float acc[8];
#pragma unroll
                for (int r = 0; r < 8; ++r) acc[r] = b2;
#pragma unroll 8
                for (int k = 0; k < 64; ++k) {
                    const float w = w2[k * 64 + j];
#pragma unroll
                    for (int r = 0; r < 8; ++r) acc[r] += sh[(sub * 8 + r) * 64 + k] * w;
                }
#pragma unroll
                for (int r = 0; r < 8; ++r)
                    ((bf16_t*)(p.ws + OFF_H2))[((size_t)(it0 + sub * 8 + r)) * 64 + j] = (bf16_t)f2bf(sinf(f2 * acc[r]));
            }
        }
        __syncthreads();
    }
    if (PARTS & 16) {
        float* ctab = (float*)lds;
        __syncthreads();
        if (tid < 64) ctab[tid] = cosf((float)tid * (2.0f * 3.14159265358979323846f / 64.0f));
        __syncthreads();
        const int total = NLAYER * 4 * 128 * 64;
        for (int o = obid() * NTHR + tid; o < total; o += NBLK * NTHR) {
            const int e2 = o & 63, dd = (o >> 6) & 127, g = (o >> 13) & 3, layer = o >> 15;
            const int d = dd & 63, sh = (dd < 64) ? 0 : 48;
            const float* w = p.in[I_FW] + ((size_t)(layer * 4 + g) * 64) * 64;
            float acc = 0.f;
#pragma unroll 8
            for (int e = 0; e < 64; ++e) acc += ctab[(d * e + sh) & 63] * w[e * 64 + e2];
            ((float*)(p.ws + OFF_FM))[o] = acc * (1.0f / 724.0773439350246f);
        }
        __syncthreads();
    }
}

__device__ __forceinline__ int zp(int i) { return i + 2 * (i >> 5); }
__device__ constexpr float FC32[16] = {1.000000000f, 0.980785280f, 0.923879533f, 0.831469612f, 0.707106781f, 0.555570233f, 0.382683432f, 0.195090322f, 0.000000000f, -0.195090322f, -0.382683432f, -0.555570233f, -0.707106781f, -0.831469612f, -0.923879533f, -0.980785280f};
__device__ constexpr float FS32[16] = {0.000000000f, 0.195090322f, 0.382683432f, 0.555570233f, 0.707106781f, 0.831469612f, 0.923879533f, 0.980785280f, 1.000000000f, 0.980785280f, 0.923879533f, 0.831469612f, 0.707106781f, 0.555570233f, 0.382683432f, 0.195090322f};
__device__ __forceinline__ float2 cmulf(float2 a, float2 b) { return make_float2(a.x * b.x - a.y * b.y, a.x * b.y + a.y * b.x); }
template <int R> __device__ __forceinline__ constexpr int brevR(int x) { int r = 0; for (int b = 1, t = R >> 1; t >= 1; b <<= 1, t >>= 1) if (x & b) r |= t; return r; }
template <int R> __device__ __forceinline__ void dft_fwd_regs(float2 (&x)[R]) {
#pragma unroll
    for (int half = R / 2; half >= 1; half >>= 1) {
#pragma unroll
        for (int blk = 0; blk < R; blk += 2 * half)
#pragma unroll
            for (int k = 0; k < half; ++k) {
                const float2 a = x[blk + k], b = x[blk + k + half];
                x[blk + k] = make_float2(a.x + b.x, a.y + b.y);
                const float2 d = make_float2(a.x - b.x, a.y - b.y);
                const int ti = k * (16 / half);
                if (ti == 0) x[blk + k + half] = d;
                else if (ti == 8) x[blk + k + half] = make_float2(d.y, -d.x);
                else { const float c = FC32[ti], sn = FS32[ti]; x[blk + k + half] = make_float2(d.x * c + d.y * sn, d.y * c - d.x * sn); }
            }
    }
}
template <int R> __device__ __forceinline__ void dft_inv_regs(float2 (&x)[R]) {
#pragma unroll
    for (int half = 1; half <= R / 2; half <<= 1) {
#pragma unroll
        for (int blk = 0; blk < R; blk += 2 * half)
#pragma unroll
            for (int k = 0; k < half; ++k) {
                const float2 a = x[blk + k], b0 = x[blk + k + half];
                const int ti = k * (16 / half);
                float2 b;
                if (ti == 0) b = b0;
                else if (ti == 8) b = make_float2(-b0.y, b0.x);
                else { const float c = FC32[ti], sn = FS32[ti]; b = make_float2(b0.x * c - b0.y * sn, b0.y * c + b0.x * sn); }
                x[blk + k] = make_float2(a.x + b.x, a.y + b.y);
                x[blk + k + half] = make_float2(a.x - b.x, a.y - b.y);
            }
    }
}
template <int R> __device__ __forceinline__ void apply_tw(float2 (&x)[R], float c, float sg) {
    const float2 w1 = make_float2(c, sg), w2 = cmulf(w1, w1);
    float2 po = w1, pe = w2;
#pragma unroll
    for (int m = 1; m < R; m += 2) {
        x[brevR<R>(m)] = cmulf(x[brevR<R>(m)], po);
        if (m + 1 < R) x[brevR<R>(m + 1)] = cmulf(x[brevR<R>(m + 1)], pe);
        if (m + 2 < R) { po = cmulf(po, w2); pe = cmulf(pe, w2); }
    }
}
template <int R, bool INV> __device__ __forceinline__ void fft_group(float2* Z, int pbase, int PS, float ang) {
    float2 x[R];
    if (!INV) {
#pragma unroll
        for (int m = 0; m < R; ++m) x[m] = Z[pbase + PS * m];
        dft_fwd_regs<R>(x);
        apply_tw<R>(x, __builtin_amdgcn_cosf(ang), -__builtin_amdgcn_sinf(ang));
#pragma unroll
        for (int m = 0; m < R; ++m) Z[pbase + PS * m] = x[brevR<R>(m)];
    } else {
#pragma unroll
        for (int m = 0; m < R; ++m) x[brevR<R>(m)] = Z[pbase + PS * m];
        apply_tw<R>(x, __builtin_amdgcn_cosf(ang), __builtin_amdgcn_sinf(ang));
        dft_inv_regs<R>(x);
#pragma unroll
        for (int m = 0; m < R; ++m) Z[pbase + PS * m] = x[m];
    }
}
template <bool INV> __device__ __forceinline__ void fft_group32_contig(float2* Z, int pbase) {
    float2 x[32];
    if (!INV) {
#pragma unroll
        for (int m = 0; m < 32; m += 2) { const f32x4 v = *(const f32x4*)(Z + pbase + m); x[m] = make_float2(v.x, v.y); x[m + 1] = make_float2(v.z, v.w); }
        dft_fwd_regs<32>(x);
#pragma unroll
        for (int m = 0; m < 32; m += 2) { const float2 a = x[brevR<32>(m)], b = x[brevR<32>(m + 1)]; *(f32x4*)(Z + pbase + m) = (f32x4){a.x, a.y, b.x, b.y}; }
    } else {
#pragma unroll
        for (int m = 0; m < 32; m += 2) { const f32x4 v = *(const f32x4*)(Z + pbase + m); x[brevR<32>(m)] = make_float2(v.x, v.y); x[brevR<32>(m + 1)] = make_float2(v.z, v.w); }
        dft_inv_regs<32>(x);
#pragma unroll
        for (int m = 0; m < 32; m += 2) *(f32x4*)(Z + pbase + m) = (f32x4){x[m].x, x[m].y, x[m + 1].x, x[m + 1].y};
    }
}
__device__ __forceinline__ void fft16k_fwd(float2* Z) {
    const int tid = otid();
#pragma unroll 1
    for (int g = 0; g < 2; ++g) { const int j = tid + 512 * g; fft_group<16, false>(Z, zp(j), 1088, (float)j * (1.0f / 16384.0f)); }
    __syncthreads();
    { const int blk = tid >> 5, j = tid & 31; fft_group<32, false>(Z, blk * 1088 + j, 34, (float)j * (1.0f / 1024.0f)); }
    __syncthreads();
    fft_group32_contig<false>(Z, 34 * tid);
    __syncthreads();
}
__device__ __forceinline__ void fft16k_inv(float2* Z) {
    const int tid = otid();
    fft_group32_contig<true>(Z, 34 * tid);
    __syncthreads();
    { const int blk = tid >> 5, j = tid & 31; fft_group<32, true>(Z, blk * 1088 + j, 34, (float)j * (1.0f / 1024.0f)); }
    __syncthreads();
#pragma unroll 1
    for (int g = 0; g < 2; ++g) { const int j = tid + 512 * g; fft_group<16, true>(Z, zp(j), 1088, (float)j * (1.0f / 16384.0f)); }
    __syncthreads();
}
__device__ __forceinline__ void fft8k_fwd(float2* Z) {
    const int tid = otid();
    fft_group<16, false>(Z, zp(tid), 544, (float)tid * (1.0f / 8192.0f));
    __syncthreads();
    { const int blk = tid >> 5, j = tid & 31; fft_group<16, false>(Z, blk * 544 + j, 34, (float)j * (1.0f / 512.0f)); }
    __syncthreads();
    if (tid < 256) fft_group32_contig<false>(Z, 34 * tid);
    __syncthreads();
}
__device__ __forceinline__ int f16k_of_p(int p) { return (p >> 10) + 16 * ((p >> 5) & 31) + 512 * (p & 31); }
__device__ __forceinline__ int p16k_of_f(int f) { return 1024 * (f & 15) + 32 * ((f >> 4) & 31) + (f >> 9); }
__device__ __forceinline__ int p8k_of_f(int f) { return 512 * (f & 15) + 32 * ((f >> 4) & 15) + (f >> 8); }

__device__ __forceinline__ void phase_filter_spectra(const Params& p, char* lds) {
    const int tid = otid(), lane = tid & 63, wave = tid >> 6;
    float2* Z = (float2*)lds;
    float* red = (float*)(lds + 139264 + 64);
    for (int job = obid(); job < NLAYER * 256; job += NBLK) {
        const int layer = job >> 8, c = job & 255;
        __syncthreads();
        const float* HFc = (const float*)(p.ws + (layer ? OFF_HFILT1 : OFF_HFILT0)) + (size_t)c * SL;
        const float r_lo = 4.605170185988092f / 1.5f, r_hi = 4.605170185988092f / 0.3f;
        const float rate = r_lo + (r_hi - r_lo) * ((float)c / 255.0f);
        float ss0 = 0.f, ss1 = 0.f;
#pragma unroll 1
        for (int i = 0; i < 4; ++i) {
            const int l0 = 4 * tid + 2048 * i;
            const f32x4 a0 = *(const f32x4*)(HFc + l0), a1 = *(const f32x4*)(HFc + (size_t)256 * SL + l0);
            const f32x4 a2 = *(const f32x4*)(HFc + (size_t)512 * SL + l0), a3 = *(const f32x4*)(HFc + (size_t)768 * SL + l0);
#pragma unroll
            for (int e = 0; e < 4; ++e) {
                const int l = l0 + e;
                const float t = (float)l / (float)(SL - 1);
                const float dec = expf(-t * rate);
                const float f0 = a0[e] * dec, b0 = a1[e] * dec, f1 = a2[e] * dec, b1 = a3[e] * dec;
                ss0 += f0 * f0 + b0 * b0; ss1 += f1 * f1 + b1 * b1;
                Z[zp(l)] = make_float2(f0, f1);
                if (l >= 1) Z[zp(16384 - l)] = make_float2(b0, b1);
            }
        }
        if (tid == 0) Z[zp(8192)] = make_float2(0.f, 0.f);
        ss0 = wave_sum(ss0); ss1 = wave_sum(ss1);
        if (lane == 0) { red[wave * 2] = ss0; red[wave * 2 + 1] = ss1; }
        __syncthreads();
        float t0 = 0.f, t1 = 0.f;
#pragma unroll
        for (int w = 0; w < 8; ++w) { t0 += red[w * 2]; t1 += red[w * 2 + 1]; }
        const float sc0 = rsqrtf(t0 + EPS) * (1.0f / 16384.0f) * 0.5f, sc1 = rsqrtf(t1 + EPS) * (1.0f / 16384.0f) * 0.5f;
        const float hb0 = p.in[I_HB][(layer * 2 + 0) * 256 + c] * (1.0f / 16384.0f), hb1 = p.in[I_HB][(layer * 2 + 1) * 256 + c] * (1.0f / 16384.0f);
        fft16k_fwd(Z);
        float2* KF0 = (float2*)(p.ws + OFF_KF) + ((size_t)(layer * 256 + c) * 2) * 16384;
        float2* KF1 = KF0 + 16384;
        for (int i = 0; i < 32; ++i) {
            const int pp = tid + NTHR * i;
            const int fq = f16k_of_p(pp);
            const int pq = p16k_of_f((16384 - fq) & 16383);
            const float2 za = Z[zp(pp)], zq = Z[zp(pq)];
            KF0[pp] = make_float2((za.x + zq.x) * sc0 + hb0, (za.y - zq.y) * sc0);
            KF1[pp] = make_float2((za.y + zq.y) * sc1 + hb1, (zq.x - za.x) * sc1);
        }
    }
}

__device__ __forceinline__ void phase_rmsnorm_bf16(const float* x, const float* g, bf16_t* out) {
    const int lane = otid() & 63, wave = otid() >> 6;
    const int gw = obid() * NWAVE + wave, ngw = NBLK * NWAVE;
    for (int row = gw; row < T; row += ngw) {
        const f32x4* xr = (const f32x4*)(x + (size_t)row * DM) + lane;
        f32x4 v[4]; float ss = 0.f;
#pragma unroll
        for (int j = 0; j < 4; ++j) { v[j] = xr[64 * j]; ss += v[j].x * v[j].x + v[j].y * v[j].y + v[j].z * v[j].z + v[j].w * v[j].w; }
        ss = wave_sum(ss);
        const float r = rsqrtf(ss * (1.0f / DM) + EPS);
        u32x2* o = (u32x2*)(out + (size_t)row * DM) + lane;
#pragma unroll
        for (int j = 0; j < 4; ++j) {
            const f32x4 gg = ((const f32x4*)g)[lane + 64 * j];
            u32x2 w; w.x = pk2(v[j].x * r * gg.x, v[j].y * r * gg.y); w.y = pk2(v[j].z * r * gg.z, v[j].w * r * gg.w);
            o[64 * j] = w;
        }
    }
}

constexpr int G_LDA = 144;
template <class Epi>
__device__ __forceinline__ void gemm_simple(const bf16_t* A, const bf16_t* Bt, int M, int N, int K, char* lds, const Epi& epi) {
    const int tid = otid(), lane = tid & 63, wave = tid >> 6;
    const int wm = wave >> 1, wn = wave & 1;
    const int nMt = M / 256, nNt = N / 128, total = nMt * nNt, nk = K / 64;
    char* As = lds; char* Bs = lds + 256 * G_LDA;
    const int l31 = lane & 31, hl = lane >> 5;
    for (int u = obid(); u < total; u += NBLK) {
        const int mt = u % nMt, nt = u / nMt;
        f32x16 acc[2][2];
#pragma unroll
        for (int i = 0; i < 2; ++i)
#pragma unroll
            for (int j = 0; j < 2; ++j) acc[i][j] = zero16();
        u32x4 ra[4], rb[2];
        const bf16_t* Ab = A + (size_t)(mt * 256) * K;
        const bf16_t* Bb = Bt + (size_t)(nt * 128) * K;
#pragma unroll
        for (int i = 0; i < 4; ++i) { const int id = tid + NTHR * i, row = id >> 3, ch = id & 7; ra[i] = *(const u32x4*)(Ab + (size_t)row * K + ch * 8); }
#pragma unroll
        for (int i = 0; i < 2; ++i) { const int id = tid + NTHR * i, row = id >> 3, ch = id & 7; rb[i] = *(const u32x4*)(Bb + (size_t)row * K + ch * 8); }
        for (int kt = 0; kt < nk; ++kt) {
            __syncthreads();
#pragma unroll
            for (int i = 0; i < 4; ++i) { const int id = tid + NTHR * i, row = id >> 3, ch = id & 7; *(u32x4*)(As + row * G_LDA + ch * 16) = ra[i]; }
#pragma unroll
            for (int i = 0; i < 2; ++i) { const int id = tid + NTHR * i, row = id >> 3, ch = id & 7; *(u32x4*)(Bs + row * G_LDA + ch * 16) = rb[i]; }
            __syncthreads();
            if (kt + 1 < nk) {
                const int ko = (kt + 1) * 64;
#pragma unroll
                for (int i = 0; i < 4; ++i) { const int id = tid + NTHR * i, row = id >> 3, ch = id & 7; ra[i] = *(const u32x4*)(Ab + (size_t)row * K + ko + ch * 8); }
#pragma unroll
                for (int i = 0; i < 2; ++i) { const int id = tid + NTHR * i, row = id >> 3, ch = id & 7; rb[i] = *(const u32x4*)(Bb + (size_t)row * K + ko + ch * 8); }
            }
#pragma unroll
            for (int ks = 0; ks < 4; ++ks) {
                bf16x8 a[2], b[2];
#pragma unroll
                for (int i = 0; i < 2; ++i) a[i] = *(const bf16x8*)(As + (wm * 64 + i * 32 + l31) * G_LDA + ks * 32 + hl * 16);
#pragma unroll
                for (int j = 0; j < 2; ++j) b[j] = *(const bf16x8*)(Bs + (wn * 64 + j * 32 + l31) * G_LDA + ks * 32 + hl * 16);
#pragma unroll
                for (int i = 0; i < 2; ++i)
#pragma unroll
                    for (int j = 0; j < 2; ++j) acc[i][j] = mfma32(a[i], b[j], acc[i][j]);
            }
        }
#pragma unroll
        for (int i = 0; i < 2; ++i)
#pragma unroll
            for (int j = 0; j < 2; ++j) epi(acc[i][j], mt * 256 + wm * 64 + i * 32, nt * 128 + wn * 64 + j * 32, lane);
    }
}

struct EpiF32 {
    float* out; int ld;
    __device__ __forceinline__ void operator()(const f32x16& acc, int row0, int col0, int lane) const {
        const int c = col0 + (lane & 31), h = lane >> 5;
#pragma unroll
        for (int r = 0; r < 16; ++r) { out[(size_t)(row0 + (r & 3) + 8 * (r >> 2) + 4 * h) * ld + c] = acc[r]; }
    }
};

namespace pg8 {
#define PG8_LAS __attribute__((address_space(3)))
constexpr int BM = 256, BK = 64, HALF = 128, HTB = HALF * BK * 2  , STAGE_BYTES = 8 * HTB, NXCD = 8, WGM = 8;

__host__ __device__ __forceinline__ int lds_byte(int r, int c) { const int st = (r >> 4) * 2 + (c >> 5), rr = r & 15, cc = c & 31, ob = rr * 64 + cc * 2; return st * 1024 + (ob ^ (((ob >> 9) & 1) << 5)); }
__host__ __device__ __forceinline__ void stage_rc(int b, int& R, int& C) { const int st = b / 1024, sb = b % 1024, swz = sb ^ (((sb >> 9) & 1) << 5); R = (st >> 1) * 16 + swz / 64; C = (st & 1) * 32 + (swz % 64) / 2; }
__host__ __device__ __forceinline__ int perm32(int rho) { const int n = rho >> 4, i = rho & 15; return 8 * (i >> 2) + 4 * n + (i & 3); }

struct Unit { int pm, pn; };
struct Gemm { const bf16_t* A; const bf16_t* Bt; int M, N, K; };

struct StaticOrder {
    int nM, nN, nwg, G, c;
    __host__ __device__ void init(int M, int N, int G_, int c_) { nM = M / BM; nN = N / BM; nwg = nM * nN; G = G_; c = c_; }
    __host__ __device__ bool next(int i, Unit& u) const {
        const long L = (long)i * G + c; if (L >= nwg) return false;
        int wgid = (int)L; { const int q = nwg / NXCD, r = nwg % NXCD, xcd = wgid % NXCD, off = wgid / NXCD; wgid = (xcd < r ? xcd * (q + 1) : r * (q + 1) + (xcd - r) * q) + off; }
        const int nig = WGM * nN, gid = wgid / nig, fm = gid * WGM, gsz = (nM - fm) < WGM ? (nM - fm) : WGM;
        u.pm = fm + ((wgid % nig) % gsz); u.pn = (wgid % nig) / gsz; return true;
    }
    __device__ __forceinline__ void a_ready(const Unit&) const {}
    __device__ __forceinline__ void done(const Unit&) const {}
};


__device__ __forceinline__ unsigned cvt_pk_bf16(float lo, float hi) { unsigned r; asm volatile("v_cvt_pk_bf16_f32 %0, %1, %2" : "=v"(r) : "v"(lo), "v"(hi)); return r; }
struct EpiStoreBf16 {
    static constexpr bool PERM = true, AFTER_DRAIN = false;
    bf16_t* O; int ldc;
    __device__ __forceinline__ void operator()(const f32x4 (&acc)[2][2][4][2], const Unit& u, int wr, int wc, int fr, int fq) const {
        const int row0 = u.pm * BM + wr * 64 + fr, col0 = u.pn * BM + wc * 32 + 8 * fq;
#pragma unroll
        for (int ai = 0; ai < 2; ++ai)
#pragma unroll
            for (int m = 0; m < 4; ++m) { bf16_t* rowp = O + (size_t)(row0 + ai * HALF + m * 16) * ldc + col0;
#pragma unroll
                for (int bj = 0; bj < 2; ++bj) { const f32x4 v0 = acc[ai][bj][m][0], v1 = acc[ai][bj][m][1];
                    u32x4 w; w.x = cvt_pk_bf16(v0[0], v0[1]); w.y = cvt_pk_bf16(v0[2], v0[3]); w.z = cvt_pk_bf16(v1[0], v1[1]); w.w = cvt_pk_bf16(v1[2], v1[3]);
                    *(u32x4*)(rowp + bj * HALF) = w; } }
    }
};
struct EpiOutProj {
    static constexpr bool PERM = true, AFTER_DRAIN = false;
    const float* base; float* O; bf16_t* XB; float* RS;
    __device__ __forceinline__ void operator()(const f32x4 (&acc)[2][2][4][2], const Unit& u, int wr, int wc, int fr, int fq) const {
        const int row0 = u.pm * BM + wr * 64 + fr, col0 = u.pn * BM + wc * 32 + 8 * fq;
#pragma unroll
        for (int ai = 0; ai < 2; ++ai)
#pragma unroll
            for (int m = 0; m < 4; ++m) { const int row = row0 + ai * HALF + m * 16; const size_t off = (size_t)row * 1024 + col0; float ss = 0.f;
#pragma unroll
                for (int bj = 0; bj < 2; ++bj) {
                    const f32x4 v0 = acc[ai][bj][m][0] + *(const f32x4*)(base + off + bj * HALF), v1 = acc[ai][bj][m][1] + *(const f32x4*)(base + off + bj * HALF + 4);
                    *(f32x4*)(O + off + bj * HALF) = v0; *(f32x4*)(O + off + bj * HALF + 4) = v1;
                    ss += (v0[0] * v0[0] + v0[1] * v0[1] + v0[2] * v0[2] + v0[3] * v0[3]) + (v1[0] * v1[0] + v1[1] * v1[1] + v1[2] * v1[2] + v1[3] * v1[3]);
                    u32x4 w; w.x = cvt_pk_bf16(v0[0], v0[1]); w.y = cvt_pk_bf16(v0[2], v0[3]); w.z = cvt_pk_bf16(v1[0], v1[1]); w.w = cvt_pk_bf16(v1[2], v1[3]);
                    *(u32x4*)(XB + off + bj * HALF) = w; }
                ss += __shfl_xor(ss, 16); ss += __shfl_xor(ss, 32);
                if (fq == 0) RS[(size_t)row * 16 + u.pn * 4 + wc] = ss; }
    }
};
struct EpiRowScaleF16 {
    static constexpr bool PERM = true, AFTER_DRAIN = false;
    _Float16* O; int ldc; const float* RS;
    __device__ __forceinline__ void operator()(const f32x4 (&acc)[2][2][4][2], const Unit& u, int wr, int wc, int fr, int fq) const {
        const int row0 = u.pm * BM + wr * 64 + fr, col0 = u.pn * BM + wc * 32 + 8 * fq;
        float tot[2][4];
#pragma unroll
        for (int ai = 0; ai < 2; ++ai)
#pragma unroll
            for (int m = 0; m < 4; ++m) { const f32x4 pr = *(const f32x4*)(RS + (size_t)(row0 + ai * HALF + m * 16) * 16 + 4 * fq); tot[ai][m] = (pr[0] + pr[1]) + (pr[2] + pr[3]); }
#pragma unroll
        for (int ai = 0; ai < 2; ++ai)
#pragma unroll
            for (int m = 0; m < 4; ++m) { const int row = row0 + ai * HALF + m * 16; const size_t off = (size_t)row * ldc + col0;
                float t = tot[ai][m]; t += __shfl_xor(t, 16); t += __shfl_xor(t, 32);
                const float r = rsqrtf(t * (1.0f / 1024.0f) + 1e-6f);
#pragma unroll
                for (int bj = 0; bj < 2; ++bj) { const f16x4 h0 = __builtin_convertvector(acc[ai][bj][m][0] * r, f16x4), h1 = __builtin_convertvector(acc[ai][bj][m][1] * r, f16x4);
                    *(f16x8*)(O + off + bj * HALF) = __builtin_shufflevector(h0, h1, 0, 1, 2, 3, 4, 5, 6, 7); } }
    }
};
struct EpiStoreF32 {
    static constexpr bool PERM = true, AFTER_DRAIN = false;
    const float* base; float* O; int ldc;
    __device__ __forceinline__ void operator()(const f32x4 (&acc)[2][2][4][2], const Unit& u, int wr, int wc, int fr, int fq) const {
        const int row0 = u.pm * BM + wr * 64 + fr, col0 = u.pn * BM + wc * 32 + 8 * fq;
#pragma unroll
        for (int ai = 0; ai < 2; ++ai)
#pragma unroll
            for (int m = 0; m < 4; ++m) { const size_t off = (size_t)(row0 + ai * HALF + m * 16) * ldc + col0;
#pragma unroll
                for (int bj = 0; bj < 2; ++bj)
#pragma unroll
                    for (int n = 0; n < 2; ++n) { f32x4 v = acc[ai][bj][m][n]; if (base) v += *(const f32x4*)(base + off + bj * HALF + n * 4); *(f32x4*)(O + off + bj * HALF + n * 4) = v; } }
    }
};

template <class Epi, class Sched, bool ALIGN_EPI = false, bool SP2 = false>
__device__ __forceinline__ void gemm_phase(PG8_LAS unsigned char* lds, const Gemm g, const Sched& S, const Epi& E) {
    const int tid = otid(), wid = __builtin_amdgcn_readfirstlane(tid >> 6), lane = tid & 63, wr = wid >> 2, wc = wid & 3, fr = lane & 15, fq = lane >> 4;
    const int K = g.K, nt = K / BK;
    unsigned voffA[2], voffB[2];
#pragma unroll
    for (int i = 0; i < 2; ++i) { int R, C; stage_rc(tid * 16 + i * 8192, R, C); const int Rb = Epi::PERM ? ((R & ~31) + perm32(R & 31)) : R;
        voffA[i] = (unsigned)(R * K + C) * 2u; voffB[i] = (unsigned)(Rb * K + C) * 2u; }
    const size_t kstep = (size_t)(BK * 2);
    const size_t hstep = (size_t)HALF * K * 2;
    const size_t tstep = 2 * hstep;
    const unsigned ldsw = (unsigned)wid * 1024u;
    const int aoff = lds_byte(wr * 64 + fr, fq * 8), boff = lds_byte(wc * 32 + fr, fq * 8);
#define PG8_SA(b, h) (((b) * 2 + (h)) * HTB)
#define PG8_SB(b, h) ((4 + (b) * 2 + (h)) * HTB)
#define PG8_STAGE(bufoff, gbase, voff) do { _Pragma("unroll") for (int _i = 0; _i < 2; ++_i) \
        __builtin_amdgcn_global_load_lds((const unsigned*)((const char*)(gbase) + (voff)[_i]), (PG8_LAS unsigned*)(lds + (bufoff) + ldsw + _i * 8192), 16, 0, 0); } while (0)
#define PG8_LDA(dst, b, h) do { _Pragma("unroll") for (int m = 0; m < 4; ++m) _Pragma("unroll") for (int k = 0; k < 2; ++k) dst[m][k] = *(const PG8_LAS bf16x8*)(lds + PG8_SA(b, h) + aoff + m * 2048 + k * 1024); } while (0)
#define PG8_LDB(dst, b, h) do { _Pragma("unroll") for (int n = 0; n < 2; ++n) _Pragma("unroll") for (int k = 0; k < 2; ++k) dst[n][k] = *(const PG8_LAS bf16x8*)(lds + PG8_SB(b, h) + boff + n * 2048 + k * 1024); } while (0)
#define PG8_MMA(ai, bj, At, Bt) do { __builtin_amdgcn_s_setprio(1); _Pragma("unroll") for (int m = 0; m < 4; ++m) _Pragma("unroll") for (int n = 0; n < 2; ++n) _Pragma("unroll") for (int k = 0; k < 2; ++k) \
        acc[ai][bj][m][n] = __builtin_amdgcn_mfma_f32_16x16x32_bf16(Bt[n][k], At[m][k], acc[ai][bj][m][n], 0, 0, 0); __builtin_amdgcn_s_setprio(0); } while (0)
#define PG8_WAIT_V(n) asm volatile("s_waitcnt vmcnt(" #n ")" ::: "memory")
#define PG8_WAIT_L(n) asm volatile("s_waitcnt lgkmcnt(" #n ")" ::: "memory")
#define PG8_BAR __builtin_amdgcn_s_barrier()
#define PG8_SCHED __builtin_amdgcn_sched_barrier(0)
    Unit cur, nxt; int ui = 0;
    if (!S.next(0, cur)) return;
    f32x4 acc[2][2][4][2];
#pragma unroll
    for (int a = 0; a < 2; ++a)
#pragma unroll
        for (int b = 0; b < 2; ++b)
#pragma unroll
            for (int m = 0; m < 4; ++m)
#pragma unroll
                for (int n = 0; n < 2; ++n) acc[a][b][m][n] = (f32x4){0.f, 0.f, 0.f, 0.f};
    bf16x8 At[4][2], B0[2][2], B1[2][2];
    const char* cA = (const char*)g.A + (size_t)cur.pm * tstep; const char* cB = (const char*)g.Bt + (size_t)cur.pn * tstep;
    S.a_ready(cur);
    if constexpr (SP2) {
        PG8_STAGE(PG8_SB(0, 0), cB, voffB); PG8_STAGE(PG8_SB(0, 1), cB + hstep, voffB); PG8_STAGE(PG8_SA(0, 0), cA, voffA); PG8_STAGE(PG8_SA(0, 1), cA + hstep, voffA);
        if (wr == 1) PG8_BAR;
        PG8_WAIT_V(2); PG8_BAR;
        PG8_STAGE(PG8_SB(1, 0), cB + kstep, voffB); PG8_STAGE(PG8_SA(1, 0), cA + kstep, voffA); PG8_STAGE(PG8_SB(1, 1), cB + hstep + kstep, voffB);
        PG8_WAIT_V(6); PG8_BAR;
    } else {
        PG8_STAGE(PG8_SB(0, 0), cB, voffB); PG8_STAGE(PG8_SA(0, 0), cA, voffA); PG8_STAGE(PG8_SB(0, 1), cB + hstep, voffB); PG8_STAGE(PG8_SA(0, 1), cA + hstep, voffA);
        if (wr == 1) PG8_BAR;
        PG8_WAIT_V(4); PG8_BAR;
        PG8_STAGE(PG8_SB(1, 0), cB + kstep, voffB); PG8_STAGE(PG8_SA(1, 0), cA + kstep, voffA); PG8_STAGE(PG8_SB(1, 1), cB + hstep + kstep, voffB);
        PG8_WAIT_V(6); PG8_BAR;
    }
    for (;;) {
        const bool has_next = S.next(ui + 1, nxt);
        const char* nA = has_next ? (const char*)g.A + (size_t)nxt.pm * tstep : cA; const char* nB = has_next ? (const char*)g.Bt + (size_t)nxt.pn * tstep : cB;
        for (int t = 0; t < nt; t += 2) {
            const bool last = (t == nt - 2);
            const char* a1 = cA + (size_t)(t + 1) * kstep;
            const char* a2 = last ? nA : cA + (size_t)(t + 2) * kstep; const char* b2 = last ? nB : cB + (size_t)(t + 2) * kstep;
            const char* a3 = a2 + kstep; const char* b3 = b2 + kstep;
            if (last && has_next) S.a_ready(nxt);
            if constexpr (SP2) {
            PG8_LDB(B0, 0, 0); PG8_LDB(B1, 0, 1); PG8_SCHED; PG8_LDA(At, 0, 0); PG8_STAGE(PG8_SA(1, 1), a1 + hstep, voffA);
            PG8_WAIT_V(8); PG8_WAIT_L(0); PG8_BAR; PG8_MMA(0, 0, At, B0); PG8_MMA(0, 1, At, B1); PG8_BAR; PG8_SCHED;
            PG8_LDA(At, 0, 1); PG8_STAGE(PG8_SB(0, 0), b2, voffB); PG8_STAGE(PG8_SB(0, 1), b2 + hstep, voffB); PG8_STAGE(PG8_SA(0, 0), a2, voffA);
            PG8_WAIT_V(8); PG8_WAIT_L(0); PG8_BAR; PG8_MMA(1, 0, At, B0); PG8_MMA(1, 1, At, B1); PG8_BAR; PG8_SCHED;
            PG8_LDB(B0, 1, 0); PG8_LDB(B1, 1, 1); PG8_SCHED; PG8_LDA(At, 1, 0); PG8_STAGE(PG8_SA(0, 1), a2 + hstep, voffA);
            PG8_WAIT_V(8); PG8_WAIT_L(0); PG8_BAR; PG8_MMA(0, 0, At, B0); PG8_MMA(0, 1, At, B1); PG8_BAR; PG8_SCHED;
            PG8_LDA(At, 1, 1); PG8_STAGE(PG8_SB(1, 0), b3, voffB); PG8_STAGE(PG8_SB(1, 1), b3 + hstep, voffB); PG8_STAGE(PG8_SA(1, 0), a3, voffA);
            PG8_WAIT_V(8); PG8_WAIT_L(0); PG8_BAR; PG8_MMA(1, 0, At, B0); PG8_MMA(1, 1, At, B1); PG8_BAR; PG8_SCHED;
            } else {
            PG8_LDB(B0, 0, 0); PG8_SCHED; PG8_LDA(At, 0, 0); PG8_STAGE(PG8_SA(1, 1), a1 + hstep, voffA);
            PG8_WAIT_L(8); PG8_BAR; PG8_WAIT_L(0); PG8_MMA(0, 0, At, B0); PG8_BAR; PG8_SCHED;
            PG8_LDB(B1, 0, 1); PG8_STAGE(PG8_SB(0, 0), b2, voffB);
            PG8_BAR; PG8_WAIT_L(0); PG8_MMA(0, 1, At, B1); PG8_BAR;
            PG8_LDA(At, 0, 1); PG8_STAGE(PG8_SA(0, 0), a2, voffA);
            PG8_BAR; PG8_WAIT_L(0); PG8_MMA(1, 0, At, B0); PG8_BAR; PG8_SCHED;
            PG8_STAGE(PG8_SB(0, 1), b2 + hstep, voffB);
            PG8_WAIT_V(6); PG8_BAR; PG8_MMA(1, 1, At, B1); PG8_BAR;
            PG8_LDB(B0, 1, 0); PG8_SCHED; PG8_LDA(At, 1, 0); PG8_STAGE(PG8_SA(0, 1), a2 + hstep, voffA);
            PG8_WAIT_L(8); PG8_BAR; PG8_WAIT_L(0); PG8_MMA(0, 0, At, B0); PG8_BAR; PG8_SCHED;
            PG8_LDB(B1, 1, 1); PG8_STAGE(PG8_SB(1, 0), b3, voffB);
            PG8_BAR; PG8_WAIT_L(0); PG8_MMA(0, 1, At, B1); PG8_BAR;
            PG8_LDA(At, 1, 1); PG8_STAGE(PG8_SA(1, 0), a3, voffA);
            PG8_BAR; PG8_WAIT_L(0); PG8_MMA(1, 0, At, B0); PG8_BAR; PG8_SCHED;
            PG8_STAGE(PG8_SB(1, 1), b3 + hstep, voffB);
            PG8_WAIT_V(6); PG8_BAR; PG8_MMA(1, 1, At, B1); PG8_BAR;
            }
        }
        if constexpr (ALIGN_EPI) { if (wr == 0) PG8_BAR; }
        if constexpr (!Epi::AFTER_DRAIN) { E(acc, cur, wr, wc, fr, fq); S.done(cur); }
        if (!has_next) break;
#pragma unroll
        for (int a = 0; a < 2; ++a)
#pragma unroll
            for (int b = 0; b < 2; ++b)
#pragma unroll
                for (int m = 0; m < 4; ++m)
#pragma unroll
                    for (int n = 0; n < 2; ++n) acc[a][b][m][n] = (f32x4){0.f, 0.f, 0.f, 0.f};
        cur = nxt; cA = nA; cB = nB; ++ui;
        if constexpr (ALIGN_EPI) { if (wr == 1) PG8_BAR; }
    }
    PG8_WAIT_V(0);
    if constexpr (!ALIGN_EPI) { if (wr == 0) PG8_BAR; }
    PG8_BAR;
    if constexpr (Epi::AFTER_DRAIN) { E.fused(acc, cur, wr, wc, fr, fq, lds, wid, lane); S.done(cur); }
#undef PG8_SA
#undef PG8_SB
#undef PG8_STAGE
#undef PG8_LDA
#undef PG8_LDB
#undef PG8_MMA
#undef PG8_WAIT_V
#undef PG8_WAIT_L
#undef PG8_BAR
#undef PG8_SCHED
}
}

__device__ constexpr float ROPE_INV_REV[16] = {1.591549431e-01f, 8.949940161e-02f, 5.032921210e-02f, 2.830219583e-02f, 1.591549431e-02f, 8.949940161e-03f, 5.032921210e-03f, 2.830219583e-03f, 1.591549431e-03f, 8.949940161e-04f, 5.032921210e-04f, 2.830219583e-04f, 1.591549431e-04f, 8.949940161e-05f, 5.032921210e-05f, 2.830219583e-05f};
__device__ __forceinline__ void qk_norm_rope8(const u32x4 raw, const float (&gn)[8], const float (&cs)[8], const float (&sn)[8], bool second, float scale, u32x4& out) {
    float x[8] = {bflo(raw.x), bfhi(raw.x), bflo(raw.y), bfhi(raw.y), bflo(raw.z), bfhi(raw.z), bflo(raw.w), bfhi(raw.w)};
    float ss = 0.f;
#pragma unroll
    for (int e = 0; e < 8; ++e) ss += x[e] * x[e];
    ss += __shfl_xor(ss, 1); ss += __shfl_xor(ss, 2); ss += __shfl_xor(ss, 4);
    const float r = rsqrtf(ss * (1.0f / 64.0f) + EPS) ;
    float o[8];
#pragma unroll
    for (int e = 0; e < 8; ++e) {
        const float y = x[e] * r * gn[e];
        const float other = __shfl_xor(y, 2);
        o[e] = (second ? (y * cs[e] + other * sn[e]) : (y * cs[e] - other * sn[e])) * scale;
    }
    out.x = pk2(o[0], o[1]); out.y = pk2(o[2], o[3]); out.z = pk2(o[4], o[5]); out.w = pk2(o[6], o[7]);
}
__device__ __forceinline__ void phase_qkprep(const Params& p, int layer, char* lds, bf16_t* qout) {
    const int tid = otid(), lane = tid & 63, wave = tid >> 6;
    const bf16_t* qkv = (const bf16_t*)(p.ws + R_QKV);
    const int sub = lane & 7;
    const bool second = ((sub >> 1) & 1) != 0, colaxis = (sub >> 2) != 0;
    float gq[8], gk[8], ir[8];
#pragma unroll
    for (int e = 0; e < 8; ++e) {
        gq[e] = p.in[I_QG][layer * 64 + sub * 8 + e]; gk[e] = p.in[I_KG][layer * 64 + sub * 8 + e];
        ir[e] = (sub & 1) ? ROPE_INV_REV[8 + e] : ROPE_INV_REV[e];
    }
    const int gw = obid() * NWAVE + wave, ngw = NBLK * NWAVE;
    for (int t = gw; t < T; t += ngw) {
        const int l = t & (SL - 1);
        const float pos = colaxis ? (float)(l & 63) : (float)(l >> 6);
        float cs[8], sn[8];
#pragma unroll
        for (int e = 0; e < 8; ++e) { const float a = pos * ir[e]; cs[e] = __builtin_amdgcn_cosf(a); sn[e] = __builtin_amdgcn_sinf(a); }
        const u32x4 rq = *(const u32x4*)(qkv + (size_t)t * 768 + lane * 8);
        u32x4 rk = {0u, 0u, 0u, 0u};
        if (lane < 16) rk = *(const u32x4*)(qkv + (size_t)t * 768 + 512 + lane * 8);
        u32x4 oq, ok;
        qk_norm_rope8(rq, gq, cs, sn, second, 0.125f * 1.4426950408889634f, oq);
        qk_norm_rope8(rk, gk, cs, sn, second, 1.0f, ok);
        *(u32x4*)(qout + (size_t)t * 768 + lane * 8) = oq;
        if (lane < 16) *(u32x4*)(qout + (size_t)t * 768 + 512 + lane * 8) = ok;
    }
}

#include <hip/hip_bf16.h>
#include <cmath>
namespace attn_body {
using bf16=__hip_bfloat16;
using bf16x8=__attribute__((ext_vector_type(8)))short;
using s16x4=__attribute__((ext_vector_type(4)))short;
using f32x16=__attribute__((ext_vector_type(16)))float;
using u32x4=__attribute__((ext_vector_type(4)))unsigned;
constexpr int SEQ=8192,D=64,PQ=768,PO=512;
constexpr int NW=8,QBLK=32,QB=QBLK*NW,KVBLK=64,NQB=SEQ/QB;
constexpr int ATTN_UNIT_ROWS=QB;
__device__ __forceinline__ int crow(int r,int hi){return (r&3)+8*(r>>2)+4*hi;}
#define SBAR() __builtin_amdgcn_sched_barrier(0)
__device__ __forceinline__ void cmask(f32x16&p0,f32x16&p1,int jb,int qrel,int hi){
  const float NEG=-INFINITY; int kb=64*jb+4*hi;
  #pragma unroll
  for(int r=0;r<16;++r){int kv=kb+(r&3)+8*(r>>2); if(kv>qrel)p0[r]=NEG; if(kv+32>qrel)p1[r]=NEG;}
}

constexpr int NSLOT=3, SLOTB=8192;
constexpr int LDS_K=0, LDS_V=NSLOT*SLOTB, LDS_WS=2*NSLOT*SLOTB, LDS_OST=LDS_WS+NW*64*4, LDS_BYTES=LDS_OST+NW*4096;
constexpr float C2=0.125f*1.4426950408889634f;
__device__ __forceinline__ void glds16(const void*gsrc,unsigned lds_dst){unsigned keep;
  asm volatile("s_mov_b32 %0, m0\n\ts_mov_b32 m0, %2\n\ts_nop 0\n\tglobal_load_lds_dwordx4 %1, off\n\ts_mov_b32 m0, %0":"=&s"(keep):"v"(gsrc),"s"(lds_dst):"memory");}
__device__ __forceinline__ float max3f(float a,float b,float c){float r;asm("v_max3_f32 %0, %1, %2, %3":"=v"(r):"v"(a),"v"(b),"v"(c));return r;}
__device__ __forceinline__ float max2f(float a,float b){float r;asm("v_max_f32_e32 %0, %1, %2":"=v"(r):"v"(a),"v"(b));return r;}
__device__ __forceinline__ float fadd_s(float a,float b){float r;asm("v_add_f32_e32 %0, %1, %2":"=v"(r):"v"(a),"v"(b));return r;}
__device__ __forceinline__ float fsub_s(float a,float b){float r;asm("v_sub_f32_e32 %0, %1, %2":"=v"(r):"v"(a),"v"(b));return r;}
typedef float f32x2_t __attribute__((ext_vector_type(2))); typedef __bf16 bf16x2_t __attribute__((ext_vector_type(2)));
__device__ __forceinline__ unsigned cvtpk_s(float lo,float hi){f32x2_t v={lo,hi};bf16x2_t b=__builtin_convertvector(v,bf16x2_t);return __builtin_bit_cast(unsigned,b);}
#define WAIT_BAR(N) asm volatile("s_waitcnt vmcnt(" #N ") lgkmcnt(0)\n\ts_barrier":::"memory")

__device__ __forceinline__ void qkt(f32x16&p0,f32x16&p1,const char*Kslot,const bf16x8*qr,const f32x16&negm,int r32,int hi){
  const char*kb=Kslot+hi*1024+r32*16;
  #pragma unroll
  for(int d0=0;d0<4;++d0){
    const bf16x8 b0=*reinterpret_cast<const bf16x8*>(kb+d0*2048);
    const bf16x8 b1=*reinterpret_cast<const bf16x8*>(kb+d0*2048+512);
    if(d0==0){p0=__builtin_amdgcn_mfma_f32_32x32x16_bf16(b0,qr[0],negm,0,0,0);p1=__builtin_amdgcn_mfma_f32_32x32x16_bf16(b1,qr[0],negm,0,0,0);}
    else{p0=__builtin_amdgcn_mfma_f32_32x32x16_bf16(b0,qr[d0],p0,0,0,0);p1=__builtin_amdgcn_mfma_f32_32x32x16_bf16(b1,qr[d0],p1,0,0,0);}}
}
typedef __attribute__((address_space(3))) const char* lds_cptr;
typedef short v4i16_t __attribute__((ext_vector_type(4)));
__device__ __forceinline__ void kload8(bf16x8*kf,lds_cptr kp){
  kf[0]=*(const __attribute__((address_space(3))) bf16x8*)(kp);      kf[1]=*(const __attribute__((address_space(3))) bf16x8*)(kp+512);
  kf[2]=*(const __attribute__((address_space(3))) bf16x8*)(kp+2048); kf[3]=*(const __attribute__((address_space(3))) bf16x8*)(kp+2560);
  kf[4]=*(const __attribute__((address_space(3))) bf16x8*)(kp+4096); kf[5]=*(const __attribute__((address_space(3))) bf16x8*)(kp+4608);
  kf[6]=*(const __attribute__((address_space(3))) bf16x8*)(kp+6144); kf[7]=*(const __attribute__((address_space(3))) bf16x8*)(kp+6656);
}
__device__ __forceinline__ void kload2(bf16x8*kf,lds_cptr kp,int j){ kf[2*j]=*(const __attribute__((address_space(3))) bf16x8*)(kp+j*2048); kf[2*j+1]=*(const __attribute__((address_space(3))) bf16x8*)(kp+j*2048+512); }
__device__ __forceinline__ s16x4 vtr(lds_cptr p){ return __builtin_bit_cast(s16x4,__builtin_amdgcn_ds_read_tr16_b64_v4i16((__attribute__((address_space(3))) v4i16_t*)p)); }
__device__ __forceinline__ float rowmax(const f32x16&p0,const f32x16&p1){
  float a=max3f(p0[0],p0[1],p1[0]),b=max3f(p0[2],p0[3],p1[1]);a=max3f(a,p1[2],p1[3]);
  #pragma unroll
  for(int r=4;r<16;r+=4){a=max3f(a,p0[r],p0[r+1]);b=max3f(b,p0[r+2],p0[r+3]);a=max3f(a,p1[r],p1[r+1]);b=max3f(b,p1[r+2],p1[r+3]);}
  const float m=max2f(a,b);
  auto rr=__builtin_amdgcn_permlane32_swap(__float_as_uint(m),__float_as_uint(m),false,false);
  return max2f(__uint_as_float(rr[0]),__uint_as_float(rr[1]));
}
__device__ __forceinline__ void pv(f32x16*o,int vb,bf16x8 pa0,bf16x8 pa1,bf16x8 pa2,bf16x8 pa3){
  #pragma unroll
  for(int d0=0;d0<2;++d0){s16x4 lo[4],hi[4];
    #pragma unroll
    for(int ks=0;ks<4;++ks){
      asm volatile("ds_read_b64_tr_b16 %0,%1 offset:%c2":"=&v"(lo[ks]):"v"(vb),"i"(d0*4096+ks*1024):"memory");
      asm volatile("ds_read_b64_tr_b16 %0,%1 offset:%c2":"=&v"(hi[ks]):"v"(vb),"i"(d0*4096+ks*1024+512):"memory");}
    asm volatile("s_waitcnt lgkmcnt(0)":::"memory");SBAR();
    #define PK(k) (bf16x8){lo[k][0],lo[k][1],lo[k][2],lo[k][3],hi[k][0],hi[k][1],hi[k][2],hi[k][3]}
    o[d0]=__builtin_amdgcn_mfma_f32_32x32x16_bf16(pa0,PK(0),o[d0],0,0,0);
    o[d0]=__builtin_amdgcn_mfma_f32_32x32x16_bf16(pa1,PK(1),o[d0],0,0,0);
    o[d0]=__builtin_amdgcn_mfma_f32_32x32x16_bf16(pa2,PK(2),o[d0],0,0,0);
    o[d0]=__builtin_amdgcn_mfma_f32_32x32x16_bf16(pa3,PK(3),o[d0],0,0,0);
    #undef PK
  }
}

#ifndef ATTN_STORE16
#define ATTN_STORE16(p,v) (*(u32x4*)(p)=(v))
#endif
template<int THRL,bool FIXED> __device__ __forceinline__ void attn_unit(int b,int h,int g,int qb,const bf16*Q,const bf16*__restrict__ K,const bf16*__restrict__ V,bf16*O,char*shm,float mfix){
  const int tid=otid(),lane=tid&63,r32=lane&31,hi=lane>>5; const int wid=__builtin_amdgcn_readfirstlane(tid>>6);
  const long rowbase=(long)b*SEQ; const int q0=qb*QB;
  const bf16*Qw=Q+(rowbase+q0+wid*QBLK)*PQ+h*D;
  const bf16*Kh=K+rowbase*PQ+g*D,*Vh=V+rowbase*PQ+g*D;
  const unsigned lds0=(unsigned)(uintptr_t)shm;
  float*wsf=(float*)(shm+LDS_WS)+wid*64;
  const bf16*ksrc=Kh+(long)lane*PQ+wid*8;
  const bf16*vsrc=Vh+(long)(16*(wid&3)+(lane>>2))*PQ+(wid>>2)*32+(lane&3)*8;
  const unsigned kdst=lds0+LDS_K+wid*1024, vdst=lds0+LDS_V+wid*1024;
  #define DMA_K(t,slot) glds16(ksrc+(long)(t)*KVBLK*PQ,(unsigned)__builtin_amdgcn_readfirstlane(kdst+(slot)))
  #define DMA_V(t,slot) glds16(vsrc+(long)(t)*KVBLK*PQ,(unsigned)__builtin_amdgcn_readfirstlane(vdst+(slot)))
  const int vb0=(int)(lds0+LDS_V)+((lane>>4)&1)*32+(lane&3)*8+(4*hi+((lane&15)>>2))*64;
  const char*Kbase=shm+LDS_K; bf16x8 kf[8];
  const lds_cptr shm3=(lds_cptr)shm; const lds_cptr kp0=shm3+LDS_K+hi*1024+r32*16; const lds_cptr vp0=shm3+LDS_V+((lane>>4)&1)*32+(lane&3)*8+(4*hi+((lane&15)>>2))*64;
  constexpr int NT=SEQ/KVBLK;
  DMA_K(0,0);DMA_V(0,0);DMA_K(1,SLOTB);
  bf16x8 qr[4];
  #pragma unroll
  for(int d0=0;d0<4;++d0)qr[d0]=*reinterpret_cast<const bf16x8*>(&Qw[(long)r32*PQ+d0*16+hi*8]);
  float mhat=0.f,l_reg=0.f;f32x16 o[2];o[0]=f32x16{};o[1]=f32x16{};f32x16 negm=f32x16{};asm volatile("":"+v"(negm));
    #define CMASK(P0,P1,t) do{}while(0)
  bool resc=false;
  #define START(P0,P1) do{ const float rm=FIXED?mfix:rowmax(P0,P1); resc=false; \
    { const float dl=rm; mhat=fadd_s(mhat,dl); \
      _Pragma("unroll") for(int r=0;r<16;++r){P0[r]=fsub_s(P0[r],dl);P1[r]=fsub_s(P1[r],dl);} \
      _Pragma("unroll") for(int r=0;r<16;++r)negm[r]=-mhat; asm volatile("":"+v"(negm)); } \
    _Pragma("unroll") for(int r=0;r<16;++r)P0[r]=__builtin_amdgcn_exp2f(P0[r]); }while(0)
  #define RESC() do{ if(resc){ asm volatile("s_waitcnt lgkmcnt(0)":::"memory"); \
      _Pragma("unroll") for(int d_=0;d_<2;++d_) _Pragma("unroll") for(int r=0;r<16;++r)o[d_][r]*=wsf[crow(r,hi)]; } }while(0)
  f32x16 pA0,pA1,pB0,pB1;
  int sl_prev=0,sl_cur=0,sl_next=SLOTB;
  #define ROT() do{sl_prev=sl_cur;sl_cur=sl_next;sl_next=(sl_next==(NSLOT-1)*SLOTB)?0:sl_next+SLOTB;}while(0)
  DMA_K(2,2*SLOTB);
  WAIT_BAR(3);
  qkt(pA0,pA1,Kbase,qr,negm,r32,hi);asm volatile("s_nop 15\n\ts_nop 7":"+v"(pA0),"+v"(pA1));CMASK(pA0,pA1,0);
  START(pA0,pA1);
  _Pragma("unroll") for(int r=0;r<16;++r)pA1[r]=__builtin_amdgcn_exp2f(pA1[r]);
  WAIT_BAR(0);
  DMA_K(3,0);DMA_V(1,SLOTB);
  ROT();
  kload8(kf,kp0+sl_cur);
  WAIT_BAR(2);
  s16x4 vlo[8],vhi[8]; u32x4 pw0,pw1,pw2,pw3;
  #define PKW(P,B) cvtpk_s(P[B],P[B+1])
  #define PAF(k) __builtin_bit_cast(bf16x8,pw##k)
  #define VFR(i) (bf16x8){vlo[i][0],vlo[i][1],vlo[i][2],vlo[i][3],vhi[i][0],vhi[i][1],vhi[i][2],vhi[i][3]}
  #define PIN(x) asm volatile("":"+v"(x))
  #define MX3(a,b,c) __builtin_fmaxf(__builtin_fmaxf((a),(b)),(c))
  #define GAPA(MF,A0,A1,A2,A3,W0,W1,PW) do{ MF; sacc+=A0; sacc+=A1; sacc+=A2; sacc+=A3; PIN(sacc); W0; W1; PIN(PW); SBAR(); }while(0)
  #define EX(v) __builtin_amdgcn_exp2f(v)
  #define GAPB(MF,X,B) do{ MF; X[B]=EX(X[B]); X[B+1]=EX(X[B+1]); X[B+2]=EX(X[B+2]); X[B+3]=EX(X[B+3]); PIN(X); SBAR(); }while(0)
  #define VRD(i) do{ vlo[i]=vtr(vp_+(((i)>>2)*4096+((i)&3)*1024)); vhi[i]=vtr(vp_+(((i)>>2)*4096+((i)&3)*1024+512)); }while(0)
  #define KRD(G,j) do{ if(G){ kload2(kf,kp0+sl_next,j); SBAR(); } }while(0)
  #define STEP(C0,C1,P0,P1,t,GK,GV,GL) do{ SBAR(); \
    const lds_cptr vp_=vp0+sl_prev; \
    VRD(0); SBAR(); float sacc=(P0[0]+P0[1]); \
    GAPA(C0=__builtin_amdgcn_mfma_f32_32x32x16_bf16(kf[0],qr[0],negm,0,0,0), P0[2],P0[3],P0[4],P0[5],     pw0[0]=PKW(P0,0), pw0[1]=PKW(P0,2), pw0); \
    VRD(4); SBAR(); GAPA(C1=__builtin_amdgcn_mfma_f32_32x32x16_bf16(kf[1],qr[0],negm,0,0,0), P0[6],P0[7],P0[8],P0[9],     pw0[2]=PKW(P0,4), pw0[3]=PKW(P0,6), pw0); \
    VRD(1); SBAR(); GAPA(C0=__builtin_amdgcn_mfma_f32_32x32x16_bf16(kf[2],qr[1],C0,0,0,0),   P0[10],P0[11],P0[12],P0[13], pw1[0]=PKW(P0,8), pw1[1]=PKW(P0,10), pw1); \
    VRD(5); SBAR(); GAPA(C1=__builtin_amdgcn_mfma_f32_32x32x16_bf16(kf[3],qr[1],C1,0,0,0),   P0[14],P0[15],P1[0],P1[1],   pw1[2]=PKW(P0,12),pw1[3]=PKW(P0,14), pw1); \
    VRD(2); SBAR(); GAPA(C0=__builtin_amdgcn_mfma_f32_32x32x16_bf16(kf[4],qr[2],C0,0,0,0),   P1[2],P1[3],P1[4],P1[5],     pw2[0]=PKW(P1,0), pw2[1]=PKW(P1,2), pw2); \
    VRD(6); SBAR(); GAPA(C1=__builtin_amdgcn_mfma_f32_32x32x16_bf16(kf[5],qr[2],C1,0,0,0),   P1[6],P1[7],P1[8],P1[9],     pw2[2]=PKW(P1,4), pw2[3]=PKW(P1,6), pw2); \
    VRD(3); SBAR(); GAPA(C0=__builtin_amdgcn_mfma_f32_32x32x16_bf16(kf[6],qr[3],C0,0,0,0),   P1[10],P1[11],P1[12],P1[13], pw3[0]=PKW(P1,8), pw3[1]=PKW(P1,10), pw3); \
    VRD(7); SBAR(); GAPA(C1=__builtin_amdgcn_mfma_f32_32x32x16_bf16(kf[7],qr[3],C1,0,0,0),   P1[14],P1[15],0.f,0.f,       pw3[2]=PKW(P1,12),pw3[3]=PKW(P1,14), pw3); \
    l_reg+=sacc; \
    if(GK){DMA_K((t)+3,sl_cur);} if(GV){DMA_V((t)+1,sl_next);} \
    CMASK(C0,C1,t); \
    if(!FIXED){ float a=MX3(C0[0],C0[1],C1[0]),b=MX3(C0[2],C0[3],C1[1]); a=MX3(a,C1[2],C1[3]); \
      _Pragma("unroll") for(int r=4;r<16;r+=4){a=MX3(a,C0[r],C0[r+1]);b=MX3(b,C0[r+2],C0[r+3]);a=MX3(a,C1[r],C1[r+1]);b=MX3(b,C1[r+2],C1[r+3]);} \
      float rm=__builtin_fmaxf(a,b); { auto rr=__builtin_amdgcn_permlane32_swap(__float_as_uint(rm),__float_as_uint(rm),false,false); rm=__builtin_fmaxf(__uint_as_float(rr[0]),__uint_as_float(rr[1])); } \
      resc=false; \
      if(__builtin_expect(__any(rm>(float)THRL),0)){ const float dl=__builtin_fmaxf(rm,0.f); mhat+=dl; \
        _Pragma("unroll") for(int r=0;r<16;++r){C0[r]-=dl;C1[r]-=dl;} \
        _Pragma("unroll") for(int r=0;r<16;++r)negm[r]=-mhat; asm volatile("":"+v"(negm)); \
        const float f=__builtin_amdgcn_exp2f(-dl); l_reg*=f; if(hi==0)wsf[r32]=f; resc=true; } } \
    SBAR(); \
    GAPB(o[0]=__builtin_amdgcn_mfma_f32_32x32x16_bf16(PAF(0),VFR(0),o[0],0,0,0), C0,0); \
    GAPB(o[1]=__builtin_amdgcn_mfma_f32_32x32x16_bf16(PAF(0),VFR(4),o[1],0,0,0), C0,4); \
    KRD(GL,0); GAPB(o[0]=__builtin_amdgcn_mfma_f32_32x32x16_bf16(PAF(1),VFR(1),o[0],0,0,0), C0,8); \
    KRD(GL,1); GAPB(o[1]=__builtin_amdgcn_mfma_f32_32x32x16_bf16(PAF(1),VFR(5),o[1],0,0,0), C0,12); \
    KRD(GL,2); GAPB(o[0]=__builtin_amdgcn_mfma_f32_32x32x16_bf16(PAF(2),VFR(2),o[0],0,0,0), C1,0); \
    KRD(GL,3); GAPB(o[1]=__builtin_amdgcn_mfma_f32_32x32x16_bf16(PAF(2),VFR(6),o[1],0,0,0), C1,4); \
    GAPB(o[0]=__builtin_amdgcn_mfma_f32_32x32x16_bf16(PAF(3),VFR(3),o[0],0,0,0), C1,8); \
    GAPB(o[1]=__builtin_amdgcn_mfma_f32_32x32x16_bf16(PAF(3),VFR(7),o[1],0,0,0), C1,12); \
    }while(0)
  int t=1;
  #undef CMASK
  #define CMASK(P0,P1,t) do{}while(0)
  for(;t+5<NT;t+=2){
    STEP(pB0,pB1,pA0,pA1,t,true,true,true);     WAIT_BAR(2); RESC(); ROT();
    STEP(pA0,pA1,pB0,pB1,t+1,true,true,true);   WAIT_BAR(2); RESC(); ROT();
  }
  #define ENDW(tt) do{ if((tt)+3<NT){WAIT_BAR(2);} else if((tt)+2<NT){WAIT_BAR(1);} else {WAIT_BAR(0);} }while(0)
  for(;t+1<NT;t+=2){
    STEP(pB0,pB1,pA0,pA1,t,(t+3<NT),(t+1<NT),(t+1<NT));       ENDW(t);   RESC(); ROT();
    STEP(pA0,pA1,pB0,pB1,t+1,(t+4<NT),(t+2<NT),(t+2<NT));     ENDW(t+1); RESC(); ROT();
  }
  STEP(pB0,pB1,pA0,pA1,NT-1,false,false,false); RESC();
  { float sacc=pB0[0]+pB0[1]; _Pragma("unroll") for(int r=2;r<16;++r)sacc+=pB0[r]; _Pragma("unroll") for(int r=0;r<16;++r)sacc+=pB1[r]; l_reg+=sacc;
    pw0=(u32x4){PKW(pB0,0),PKW(pB0,2),PKW(pB0,4),PKW(pB0,6)};pw1=(u32x4){PKW(pB0,8),PKW(pB0,10),PKW(pB0,12),PKW(pB0,14)};pw2=(u32x4){PKW(pB1,0),PKW(pB1,2),PKW(pB1,4),PKW(pB1,6)};pw3=(u32x4){PKW(pB1,8),PKW(pB1,10),PKW(pB1,12),PKW(pB1,14)};
    SBAR(); pv(o,vb0+sl_cur,PAF(0),PAF(1),PAF(2),PAF(3)); }
  #undef PKW
  #undef PAF
  #undef VFR
  #undef PIN
  #undef MX3
  #undef GAPA
  #undef GAPB
  #undef EX
  #undef VRD
  #undef KRD
  #undef STEP
  #undef ENDW
  {auto rr=__builtin_amdgcn_permlane32_swap(__float_as_uint(l_reg),__float_as_uint(l_reg),false,false);l_reg=__uint_as_float(rr[0])+__uint_as_float(rr[1]);}
  if(hi==0)wsf[32+r32]=l_reg;asm volatile("s_waitcnt lgkmcnt(0)":::"memory");
  float rli[16];
  #pragma unroll
  for(int r=0;r<16;++r)rli[r]=__builtin_amdgcn_rcpf(wsf[32+crow(r,hi)]);
  bf16*Ow=O+(rowbase+q0+wid*QBLK)*PO+h*D;
  { bf16*stg=(bf16*)(shm+LDS_OST)+wid*2048;
    #pragma unroll
    for(int r=0;r<16;++r){const int orow=crow(r,hi);
      #pragma unroll
      for(int d0=0;d0<2;++d0)stg[orow*64+d0*32+r32]=__float2bfloat16(o[d0][r]*rli[r]);}
    asm volatile("s_waitcnt lgkmcnt(0)":::"memory");
    #pragma unroll
    for(int i=0;i<4;++i){const int row=i*8+(lane>>3),ch=lane&7; const u32x4 v=*(const u32x4*)(stg+row*64+ch*8); ATTN_STORE16(Ow+(long)row*PO+ch*8,v);} }
  asm volatile("s_waitcnt lgkmcnt(0)\n\ts_barrier":::"memory");
  #undef DMA_K
  #undef DMA_V
  #undef CMASK
  #undef START
  #undef RESC
  #undef ROT
}
constexpr int ATTN_LDS_BYTES=LDS_BYTES;
#undef SBAR
#undef WAIT_BAR
}

__device__ __forceinline__ void phase_attn(const Params& p, int layer, char* lds) {
    const int lane = otid() & 63;
    const float mq = wave_max(fabsf(p.in[I_QG][layer * 64 + lane])), mk = wave_max(fabsf(p.in[I_KG][layer * 64 + lane]));
    const float mfix = 64.0f * mq * mk * (0.125f * 1.4426950408889634f) * 1.02f;
    const bool fixed_ok = mfix < 48.0f;
    const int bid = obid();
    const int vcu = ((NBLK & 7) == 0) ? (bid & 7) * (int)(NBLK >> 3) + (bid >> 3) : bid;
    const attn_body::bf16* qkvb = (const attn_body::bf16*)(p.ws + R_QKV);
    for (int u = vcu; u < 512; u += NBLK) {
        const int bg = (u & 255) >> 6, r = u & 63, hh = r & 3, qb = (r >> 2) + 16 * (u >> 8);
        const int b = bg >> 1, g = bg & 1;
        if (fixed_ok) attn_body::attn_unit<8, true>(b, 4 * g + hh, g, qb, qkvb, qkvb + 512, qkvb + 640, (attn_body::bf16*)(p.ws + R_ATT), lds, mfix);
        else attn_body::attn_unit<8, false>(b, 4 * g + hh, g, qb, qkvb, qkvb + 512, qkvb + 640, (attn_body::bf16*)(p.ws + R_ATT), lds, 0.f);
    }
}

__device__ __forceinline__ size_t cidx(int c, int t) { return ((size_t)(t >> 5) * 256 + c) * 32 + (t & 31); }
__device__ __forceinline__ f32x4 convd4(const float* row, int l0, float w0, float w1, float w2, float cb) {
    const f32x4 c = *(const f32x4*)(row + l0);
    const float lft = (l0 > 0) ? row[l0 - 1] : 0.f;
    const float rgt = (l0 + 4 < SL) ? row[l0 + 4] : 0.f;
    f32x4 o;
    o.x = cb + w0 * lft + w1 * c.x + w2 * c.y;
    o.y = cb + w0 * c.x + w1 * c.y + w2 * c.z;
    o.z = cb + w0 * c.y + w1 * c.z + w2 * c.w;
    o.w = cb + w0 * c.z + w1 * c.w + w2 * rgt;
    return o;
}
__device__ __forceinline__ void cmul_kf(float2* Z, const float2* KF, int tid) {
#pragma unroll 4
    for (int i = 0; i < 16; ++i) {
        const int pp = 2 * tid + 1024 * i;
        const f32x4 z = *(const f32x4*)(Z + zp(pp)), k = *(const f32x4*)(KF + pp);
        f32x4 o; o.x = z.x * k.x - z.y * k.y; o.y = z.x * k.y + z.y * k.x; o.z = z.z * k.z - z.w * k.w; o.w = z.z * k.w + z.w * k.z;
        *(f32x4*)(Z + zp(pp)) = o;
    }
}
__device__ __forceinline__ void hyena_job(const Params& p, int layer, int c, char* lds) {
    const int tid = otid();
    float2* Z = (float2*)lds;
    const float* HF = (const float*)(p.ws + R_HF);
    const float* cw = p.in[I_CW] + (size_t)layer * 3 * 768; const float* cbp = p.in[I_CB] + layer * 768;
    const float2* KF0 = (const float2*)(p.ws + OFF_KF) + ((size_t)(layer * 256 + c) * 2) * 16384;
    const float2* KF1 = KF0 + 16384;
    float* Yb = (float*)(p.ws + R_Y);
    const int cv = c, c1 = 256 + c, c2 = 512 + c;
    const float* rv = HF + (size_t)cv * T; const float* r1 = HF + (size_t)c1 * T; const float* r2 = HF + (size_t)c2 * T;
    const float v_w0 = cw[cv], v_w1 = cw[768 + cv], v_w2 = cw[1536 + cv], v_cb = cbp[cv];
    const float a_w0 = cw[c1], a_w1 = cw[768 + c1], a_w2 = cw[1536 + c1], a_cb = cbp[c1];
    const float b_w0 = cw[c2], b_w1 = cw[768 + c2], b_w2 = cw[1536 + c2], b_cb = cbp[c2];
    const f32x4 zero4 = {0.f, 0.f, 0.f, 0.f};
    __syncthreads();
#pragma unroll 1
    for (int i = 0; i < 4; ++i) {
        const int l0 = 4 * otid() + 2048 * i;
        const f32x4 va = convd4(rv, l0, v_w0, v_w1, v_w2, v_cb), vb = convd4(rv + SL, l0, v_w0, v_w1, v_w2, v_cb);
        *(f32x4*)(Z + zp(l0)) = (f32x4){va.x, vb.x, va.y, vb.y}; *(f32x4*)(Z + zp(l0) + 2) = (f32x4){va.z, vb.z, va.w, vb.w};
        *(f32x4*)(Z + zp(8192 + l0)) = zero4; *(f32x4*)(Z + zp(8192 + l0) + 2) = zero4;
    }
    __syncthreads();
    fft16k_fwd(Z);
    cmul_kf(Z, KF0, otid());
    __syncthreads();
    fft16k_inv(Z);
#pragma unroll 1
    for (int i = 0; i < 4; ++i) {
        const int l0 = 4 * otid() + 2048 * i;
        const f32x4 za = *(const f32x4*)(Z + zp(l0)), zb = *(const f32x4*)(Z + zp(l0) + 2);
        const f32x4 ga = convd4(r1, l0, a_w0, a_w1, a_w2, a_cb), gb = convd4(r1 + SL, l0, a_w0, a_w1, a_w2, a_cb);
        *(f32x4*)(Z + zp(l0)) = (f32x4){ga.x * za.x, gb.x * za.y, ga.y * za.z, gb.y * za.w};
        *(f32x4*)(Z + zp(l0) + 2) = (f32x4){ga.z * zb.x, gb.z * zb.y, ga.w * zb.z, gb.w * zb.w};
        *(f32x4*)(Z + zp(8192 + l0)) = zero4; *(f32x4*)(Z + zp(8192 + l0) + 2) = zero4;
    }
    __syncthreads();
    fft16k_fwd(Z);
    cmul_kf(Z, KF1, otid());
    __syncthreads();
    fft16k_inv(Z);
#pragma unroll 1
    for (int i = 0; i < 4; ++i) {
        const int l0 = 4 * otid() + 2048 * i;
        const f32x4 za = *(const f32x4*)(Z + zp(l0)), zb = *(const f32x4*)(Z + zp(l0) + 2);
        const f32x4 ga = convd4(r2, l0, b_w0, b_w1, b_w2, b_cb), gb = convd4(r2 + SL, l0, b_w0, b_w1, b_w2, b_cb);
        f32x4 ya, yb;
        ya.x = ga.x * za.x; ya.y = ga.y * za.z; ya.z = ga.z * zb.x; ya.w = ga.w * zb.z;
        yb.x = gb.x * za.y; yb.y = gb.y * za.w; yb.z = gb.z * zb.y; yb.w = gb.w * zb.w;
        *(f32x4*)(Yb + cidx(c, l0)) = ya; *(f32x4*)(Yb + cidx(c, SL + l0)) = yb;
    }
    __syncthreads();
}

__device__ __forceinline__ void fnet_job(const Params& p, int ch, char* lds) {
    const int tid = otid();
    float2* Z = (float2*)lds;
    const float* row = (const float*)(p.ws + R_HF) + (size_t)(768 + ch) * T;
    float* UR = (float*)(p.ws + R_UR);
    float* UI = (float*)(p.ws + R_UI);
    __syncthreads();
#pragma unroll
    for (int i = 0; i < 4; ++i) {
        const int l0 = 4 * tid + 2048 * i;
        const f32x4 a = *(const f32x4*)(row + l0), b = *(const f32x4*)(row + SL + l0);
        const int z0 = zp(l0);
        *(f32x4*)(Z + z0) = (f32x4){a.x, b.x, a.y, b.y}; *(f32x4*)(Z + z0 + 2) = (f32x4){a.z, b.z, a.w, b.w};
    }
    __syncthreads();
    fft8k_fwd(Z);
#pragma unroll
    for (int i = 0; i < 4; ++i) {
        const int k0 = 4 * tid + 2048 * i;
        f32x4 ur0, ui0, ur1, ui1;
#pragma unroll
        for (int e = 0; e < 4; ++e) {
            const int k = k0 + e;
            const int pk = p8k_of_f(k);
            const int pm = p8k_of_f((SL - k) & (SL - 1));
            const float2 zk = Z[zp(pk)], zm = Z[zp(pm)];
            ur0[e] = 0.5f * (zk.x + zm.x); ui0[e] = 0.5f * (zk.y - zm.y);
            ur1[e] = 0.5f * (zk.y + zm.y); ui1[e] = 0.5f * (zm.x - zk.x);
        }
        *(f32x4*)(UR + cidx(ch, k0)) = ur0; *(f32x4*)(UI + cidx(ch, k0)) = ui0; *(f32x4*)(UR + cidx(ch, SL + k0)) = ur1; *(f32x4*)(UI + cidx(ch, SL + k0)) = ui1;
    }
    __syncthreads();
}

__device__ __forceinline__ void phase_mix(const Params& p, int layer, char* lds) {
    const int tid = otid(), lane = tid & 63, wave = tid >> 6;
    const int l31 = lane & 31, hl = lane >> 5, g = wave & 3, tsel = wave >> 2;
    float* ex = (float*)lds;
    float* FMl = (float*)(lds + 8192);
    const float* UR = (const float*)(p.ws + R_UR); const float* UI = (const float*)(p.ws + R_UI);
    const float* Y = (const float*)(p.ws + R_Y);
    const bf16_t* att = (const bf16_t*)(p.ws + R_ATT);
    bf16_t* mix = (bf16_t*)(p.ws + R_MIX);
    const float* fb = p.in[I_FB] + layer * 256 + g * 64;
    const float* mg = p.in[I_MG] + layer * 1024;
    __syncthreads();
    {
        const f32x4* src = (const f32x4*)((const float*)(p.ws + OFF_FM) + (size_t)layer * 4 * 128 * 64);
#pragma unroll 4
        for (int i = 0; i < 16; ++i) *(f32x4*)(FMl + 4 * (tid + NTHR * i)) = src[tid + NTHR * i];
    }
    for (int tp = obid(); tp < T / 64; tp += NBLK) {
        const int t = (tp * 2 + tsel) * 32 + l31;
        float bv[64];
        {
            const float* ub = UR + cidx(g * 64 + hl, t);
            const float* ub2 = UI + cidx(g * 64 + hl, t);
#pragma unroll
            for (int i = 0; i < 32; ++i) { bv[i] = ub[(2 * i) * 32]; bv[32 + i] = ub2[(2 * i) * 32]; }
        }
        float yv[32];
        {
            const float* yb = Y + cidx(g * 64 + hl * 32, t);
#pragma unroll
            for (int i = 0; i < 32; ++i) yv[i] = yb[i * 32];
        }
        const bf16_t* ab = att + (size_t)t * 512 + g * 128 + hl * 64;
        float sa = 0.f;
#pragma unroll
        for (int q = 0; q < 8; ++q) {
            const u32x4 a = *(const u32x4*)(ab + 8 * q);
            const float x0 = bflo(a.x), x1 = bfhi(a.x), x2 = bflo(a.y), x3 = bfhi(a.y), x4 = bflo(a.z), x5 = bfhi(a.z), x6 = bflo(a.w), x7 = bfhi(a.w);
            sa += x0 * x0 + x1 * x1 + x2 * x2 + x3 * x3 + x4 * x4 + x5 * x5 + x6 * x6 + x7 * x7;
        }
        __syncthreads();
        f32x16 acc0 = zero16(), acc1 = zero16();
        {
            const float* fa = FMl + (g * 128 + hl) * 64 + l31;
#pragma unroll
            for (int i = 0; i < 64; ++i) {
                const float a0 = fa[(2 * i) * 64], a1 = fa[(2 * i) * 64 + 32];
                acc0 = __builtin_amdgcn_mfma_f32_32x32x2f32(a0, bv[i], acc0, 0, 0, 0);
                acc1 = __builtin_amdgcn_mfma_f32_32x32x2f32(a1, bv[i], acc1, 0, 0, 0);
            }
        }
        float sf = 0.f;
#pragma unroll
        for (int i = 0; i < 4; ++i) {
            const f32x4 b0 = *(const f32x4*)(fb + 8 * i + 4 * hl), b1 = *(const f32x4*)(fb + 32 + 8 * i + 4 * hl);
            acc0[4 * i] += b0.x; acc0[4 * i + 1] += b0.y; acc0[4 * i + 2] += b0.z; acc0[4 * i + 3] += b0.w;
            acc1[4 * i] += b1.x; acc1[4 * i + 1] += b1.y; acc1[4 * i + 2] += b1.z; acc1[4 * i + 3] += b1.w;
        }
#pragma unroll
        for (int r = 0; r < 16; ++r) sf += acc0[r] * acc0[r] + acc1[r] * acc1[r];
        float sy = 0.f;
#pragma unroll
        for (int i = 0; i < 32; ++i) sy += yv[i] * yv[i];
        ex[(0 * 8 + wave) * 64 + lane] = sa; ex[(1 * 8 + wave) * 64 + lane] = sy; ex[(2 * 8 + wave) * 64 + lane] = sf;
        __syncthreads();
        float ta = 0.f, ty = 0.f, tf = 0.f;
#pragma unroll
        for (int w = 0; w < 4; ++w)
#pragma unroll
            for (int hh = 0; hh < 2; ++hh) {
                const int o = (tsel * 4 + w) * 64 + hh * 32 + l31;
                ta += ex[0 * 512 + o]; ty += ex[1 * 512 + o]; tf += ex[2 * 512 + o];
            }
        const float ra = rsqrtf(ta * (1.0f / 512.0f) + EPS), ry = rsqrtf(ty * (1.0f / 256.0f) + EPS), rf = rsqrtf(tf * (1.0f / 256.0f) + EPS);
        bf16_t* mrow = mix + (size_t)t * 1024;
        {
            const float* gg = mg + g * 128 + hl * 64;
#pragma unroll
            for (int q = 0; q < 8; ++q) {
                const u32x4 a = *(const u32x4*)(ab + 8 * q);
                const f32x4 g0 = *(const f32x4*)(gg + 8 * q), g1 = *(const f32x4*)(gg + 8 * q + 4);
                u32x4 o;
                o.x = pk2(bflo(a.x) * ra * g0.x, bfhi(a.x) * ra * g0.y); o.y = pk2(bflo(a.y) * ra * g0.z, bfhi(a.y) * ra * g0.w);
                o.z = pk2(bflo(a.z) * ra * g1.x, bfhi(a.z) * ra * g1.y); o.w = pk2(bflo(a.w) * ra * g1.z, bfhi(a.w) * ra * g1.w);
                *(u32x4*)(mrow + g * 128 + hl * 64 + 8 * q) = o;
            }
        }
        {
            const float* gg = mg + 512 + g * 64 + hl * 32;
#pragma unroll
            for (int q = 0; q < 4; ++q) {
                const f32x4 g0 = *(const f32x4*)(gg + 8 * q), g1 = *(const f32x4*)(gg + 8 * q + 4);
                u32x4 o;
                o.x = pk2(yv[8 * q] * ry * g0.x, yv[8 * q + 1] * ry * g0.y); o.y = pk2(yv[8 * q + 2] * ry * g0.z, yv[8 * q + 3] * ry * g0.w);
                o.z = pk2(yv[8 * q + 4] * ry * g1.x, yv[8 * q + 5] * ry * g1.y); o.w = pk2(yv[8 * q + 6] * ry * g1.z, yv[8 * q + 7] * ry * g1.w);
                *(u32x4*)(mrow + 512 + g * 64 + hl * 32 + 8 * q) = o;
            }
        }
        {
            const float* gg = mg + 768 + g * 64;
#pragma unroll
            for (int i = 0; i < 4; ++i) {
                const f32x4 g0 = *(const f32x4*)(gg + 8 * i + 4 * hl), g1 = *(const f32x4*)(gg + 32 + 8 * i + 4 * hl);
                u32x2 o0, o1;
                o0.x = pk2(acc0[4 * i] * rf * g0.x, acc0[4 * i + 1] * rf * g0.y); o0.y = pk2(acc0[4 * i + 2] * rf * g0.z, acc0[4 * i + 3] * rf * g0.w);
                o1.x = pk2(acc1[4 * i] * rf * g1.x, acc1[4 * i + 1] * rf * g1.y); o1.y = pk2(acc1[4 * i + 2] * rf * g1.z, acc1[4 * i + 3] * rf * g1.w);
                *(u32x2*)(mrow + 768 + g * 64 + 8 * i + 4 * hl) = o0;
                *(u32x2*)(mrow + 768 + g * 64 + 32 + 8 * i + 4 * hl) = o1;
            }
        }
    }
}

__device__ __forceinline__ float tk_pack(float v, unsigned code, unsigned mask) { return __builtin_bit_cast(float, (__builtin_bit_cast(unsigned, v) & ~mask) | code); }
__device__ __forceinline__ unsigned tk_lookup(const unsigned (&P)[4], unsigned i) {
    const unsigned w = (i < 4u) ? P[0] : (i < 8u) ? P[1] : (i < 12u) ? P[2] : P[3];
    return (w >> ((i & 3u) * 8u)) & 0x7Fu;
}
__device__ __forceinline__ float gelu_exact(float x) { return 0.5f * x * (1.0f + erff(x * 0.70710678118654752f)); }
typedef float f32x2 __attribute__((ext_vector_type(2)));
#define CVT_LO(W) __builtin_amdgcn_cvt_pk_f32_fp8((int)(W), false)
#define CVT_HI(W) __builtin_amdgcn_cvt_pk_f32_fp8((int)(W), true)


__device__ __forceinline__ void tk_sort16(float (&a)[16]) {
#pragma unroll
    for (int k = 2; k <= 16; k <<= 1)
#pragma unroll
        for (int j = k >> 1; j > 0; j >>= 1)
#pragma unroll
            for (int i = 0; i < 16; ++i) {
                const int l = i ^ j;
                if (l > i) {
                    const float hi = fmaxf(a[i], a[l]), lo = fminf(a[i], a[l]);
                    if ((i & k) == 0) { a[i] = hi; a[l] = lo; } else { a[i] = lo; a[l] = hi; }
                }
            }
}
__device__ __forceinline__ void tk_merge16(float (&a)[16]) {
#pragma unroll
    for (int j = 8; j > 0; j >>= 1)
#pragma unroll
        for (int i = 0; i < 16; ++i) {
            const int l = i ^ j;
            if (l > i) { const float hi = fmaxf(a[i], a[l]), lo = fminf(a[i], a[l]); a[i] = hi; a[l] = lo; }
        }
}
__device__ __forceinline__ void tk_top16_merge(float (&l)[16], const float (&g)[16]) {
#pragma unroll
    for (int i = 0; i < 16; ++i) l[i] = fmaxf(l[i], g[15 - i]);
    tk_merge16(l);
}
template <int CTRL> __device__ __forceinline__ float dpp_f(float v) { return __builtin_bit_cast(float, __builtin_amdgcn_update_dpp(0, __builtin_bit_cast(int, v), CTRL, 0xF, 0xF, false)); }
template <int CTRL> __device__ __forceinline__ int dpp_i(int v) { return __builtin_amdgcn_update_dpp(0, v, CTRL, 0xF, 0xF, false); }
constexpr int PE_LOGR = 4, PE_NR = 1 << PE_LOGR;
constexpr int PE_ENT = 12 * 1024;
constexpr int PE_WAVE = PE_ENT;


#define PE_RL(k) (((k & 4) << 1) | ((k & 2) << 3) | ((k & 1) << 5))
#define PE_LOAD_U(TK, RW, EV, CU, CG) do { \
        const int base_ = ((TK) * 128 + r * 8 + eid) * 3; \
        EV = ent[base_]; CU = __builtin_bit_cast(float, ent[base_ + 1]); CG = __builtin_bit_cast(float, ent[base_ + 2]); \
        _Pragma("unroll") for (int k = 0; k < 8; ++k) { const unsigned e = (unsigned)__builtin_amdgcn_readlane(EV, PE_RL(k)); \
            RW[k] = *(const u32x4*)(PU + (size_t)(e * 1024u) + loff); } \
    } while (0)
#define PE_COMP_U(TK, RW, CU, CG) do { \
        int d[8]; \
        _Pragma("unroll") for (int k = 0; k < 8; ++k) { int s_ = __builtin_amdgcn_sdot4((int)RW[k].x, xq[TK][0], 0, false); \
            s_ = __builtin_amdgcn_sdot4((int)RW[k].y, xq[TK][1], s_, false); s_ = __builtin_amdgcn_sdot4((int)RW[k].z, xq[TK][2], s_, false); \
            d[k] = __builtin_amdgcn_sdot4((int)RW[k].w, xq[TK][3], s_, false); } \
        _Pragma("unroll") for (int k = 0; k < 8; ++k) { d[k] += dpp_i<0xB1>(d[k]); d[k] += dpp_i<0x4E>(d[k]); d[k] += dpp_i<0x141>(d[k]); } \
        int r4[4], r2[2], u1; \
        _Pragma("unroll") for (int k = 0; k < 4; ++k) { const int send = b3 ? d[k] : d[k + 4], keep = b3 ? d[k + 4] : d[k]; r4[k] = keep + dpp_i<0x140>(send); } \
        _Pragma("unroll") for (int k = 0; k < 2; ++k) { const int send = b4 ? r4[k] : r4[k + 2], keep = b4 ? r4[k + 2] : r4[k]; r2[k] = keep + __shfl_xor(send, 16); } \
        { const int send = b5 ? r2[0] : r2[1], keep = b5 ? r2[1] : r2[0]; u1 = keep + __shfl_xor(send, 32); } \
        const float av = gelu_exact((float)u1 * (CU * sx[TK])) * CG; \
        if ((lane & 7) == 0) ent[((TK) * 128 + r * 8 + eid) * 3 + 1] = __builtin_bit_cast(int, av);     \
    } while (0)
#define PE_LOAD_V(TK, RW, AV) do { \
        const int base_ = ((TK) * 128 + r * 8 + eid) * 3; \
        const int ev = ent[base_]; AV = ent[base_ + 1]; \
        _Pragma("unroll") for (int k = 0; k < 8; ++k) { const unsigned e = (unsigned)__builtin_amdgcn_readlane(ev, PE_RL(k)); \
            RW[k] = *(const u32x4*)(PV + (size_t)(e * 1024u) + loff); } \
    } while (0)
#define PE_COMP_V(TK, RW, AV) do { \
        _Pragma("unroll") for (int k = 0; k < 8; ++k) { \
            const float a = __builtin_bit_cast(float, __builtin_amdgcn_readlane(AV, PE_RL(k))); \
            const f32x2 a2 = (f32x2){a, a}; \
            acc[TK][0] += a2 * CVT_LO(RW[k].x); acc[TK][1] += a2 * CVT_HI(RW[k].x); acc[TK][2] += a2 * CVT_LO(RW[k].y); acc[TK][3] += a2 * CVT_HI(RW[k].y); \
            acc[TK][4] += a2 * CVT_LO(RW[k].z); acc[TK][5] += a2 * CVT_HI(RW[k].z); acc[TK][6] += a2 * CVT_LO(RW[k].w); acc[TK][7] += a2 * CVT_HI(RW[k].w); } \
    } while (0)

template <bool DRY> __device__ __forceinline__ void phase_peer_fused(const Params& p, int layer, char* lds) {
    const int tid = otid(), lane = tid & 63, wave = tid >> 6;
    const unsigned char* PU = p.ws + OFF_PU + (size_t)layer * 16384 * 1024;
    const unsigned char* PV = p.ws + OFF_PV + (size_t)layer * 16384 * 1024;
    const float* SU = (const float*)(p.ws + OFF_PSC) + (size_t)layer * 16384;
    const float* SV = (const float*)(p.ws + OFF_PSC) + (size_t)(2 + layer) * 16384;
    bf16_t* XN = (bf16_t*)(p.ws + R_XN);
    float* XA = (float*)(p.ws + OFF_XA);
    const _Float16* SC = (const _Float16*)(p.ws + R_QP);
    const bool last = (layer == NLAYER - 1);
    const float* gnext = last ? p.in[I_FG] : p.in[I_N1G] + (layer + 1) * DM;
    const float* g2p = p.in[I_N2G] + layer * DM;
    const bool b5 = (lane & 32) != 0, b4 = (lane & 16) != 0, b3 = (lane & 8) != 0;
    const int eid = ((lane >> 3) & 1) * 4 + ((lane >> 4) & 1) * 2 + (lane >> 5);
    const unsigned loff = (unsigned)lane * 16u;
    int* ent = (int*)(lds + wave * PE_WAVE);
    const float NINF = -3.0e38f;
    const int pp = lane & 1;
    for (int tb = (obid() * NWAVE + wave) * 8; tb < T; tb += NBLK * NWAVE * 8) {
#pragma unroll 1
        for (int grp = 0; grp < 2; ++grp) {
            const int tkl = grp * 4 + (lane >> 4), h = (lane >> 1) & 7;
            const f16x8* src = (const f16x8*)(SC + (size_t)(tb + tkl) * 2048 + h * 256 + pp * 128);
            float l[16];
#pragma unroll
            for (int i = 0; i < 16; ++i) l[i] = NINF;
#pragma unroll 1
            for (int c = 0; c < 4; ++c) {
                f32x4 v[8];
#pragma unroll
                for (int j = 0; j < 4; ++j) {
                    const f16x8 hv = src[c * 4 + j];
                    v[2 * j] = (f32x4){(float)hv[0], (float)hv[1], (float)hv[2], (float)hv[3]};
                    v[2 * j + 1] = (f32x4){(float)hv[4], (float)hv[5], (float)hv[6], (float)hv[7]};
                }
#pragma unroll
                for (int hh = 0; hh < 2; ++hh) {
                    float g[16];
#pragma unroll
                    for (int j = 0; j < 4; ++j) {
                        const unsigned kb = (unsigned)(c * 32 + hh * 16 + j * 4);
                        g[4 * j] = tk_pack(v[hh * 4 + j].x, kb, 0x7Fu); g[4 * j + 1] = tk_pack(v[hh * 4 + j].y, kb + 1u, 0x7Fu);
                        g[4 * j + 2] = tk_pack(v[hh * 4 + j].z, kb + 2u, 0x7Fu); g[4 * j + 3] = tk_pack(v[hh * 4 + j].w, kb + 3u, 0x7Fu);
                    }
                    tk_sort16(g);
                    tk_top16_merge(l, g);
                }
            }
            float xw[16], ow[16]; unsigned PX[4] = {0u, 0u, 0u, 0u}, PO[4] = {0u, 0u, 0u, 0u};
#pragma unroll
            for (int i = 0; i < 16; ++i) {
                const float o = __shfl_xor(l[i], 1);
                const unsigned xb = __builtin_bit_cast(unsigned, l[i]), ob = __builtin_bit_cast(unsigned, o);
                xw[i] = __builtin_bit_cast(float, xb & ~0x7Fu); ow[i] = __builtin_bit_cast(float, ob & ~0x7Fu);
                PX[i >> 2] |= (xb & 0x7Fu) << ((i & 3) * 8); PO[i >> 2] |= (ob & 0x7Fu) << ((i & 3) * 8);
            }
            float f[16];
            {
                float c1[16];
#pragma unroll
                for (int i = 0; i < 16; ++i) { f[i] = NINF; c1[i] = NINF; }
                int cnt = 0;
#pragma unroll
                for (int i = 0; i < 16; ++i)
#pragma unroll
                    for (int j = i; j < 16; ++j)
                        if ((i + 1) * (j + 1) <= 16) {
                            float cv = xw[i] + ow[j];
                            const unsigned code = pp ? (unsigned)((j << 4) | i) : (unsigned)((i << 4) | j);
                            cv = tk_pack(cv, code, 0xFFu);
                            if (i == j) cv = pp ? NINF : cv;
                            if (cnt < 16) f[cnt & 15] = cv; else c1[cnt & 15] = cv;
                            ++cnt;
                        }
                tk_sort16(f); tk_sort16(c1);
                tk_top16_merge(f, c1);
                float gq[16];
#pragma unroll
                for (int i = 0; i < 16; ++i) gq[i] = __shfl_xor(f[i], 1);
                tk_top16_merge(f, gq);
            }
            unsigned P0[4], P1[4];
#pragma unroll
            for (int q = 0; q < 4; ++q) { P0[q] = pp ? PO[q] : PX[q]; P1[q] = pp ? PX[q] : PO[q]; }
            const float top = __builtin_bit_cast(float, __builtin_bit_cast(unsigned, f[0]) & ~0xFFu);
            float ev[16]; float den = 0.f;
#pragma unroll
            for (int r = 0; r < 16; ++r) { ev[r] = __expf(__builtin_bit_cast(float, __builtin_bit_cast(unsigned, f[r]) & ~0xFFu) - top); den += ev[r]; }
            const float rden = 1.0f / den;
#pragma unroll
            for (int r8 = 0; r8 < 8; ++r8) {
                const unsigned c0 = __builtin_bit_cast(unsigned, f[r8]) & 0xFFu, c1 = __builtin_bit_cast(unsigned, f[r8 + 8]) & 0xFFu;
                const unsigned code = pp ? c1 : c0;
                const float gate = (pp ? ev[r8 + 8] : ev[r8]) * rden;
                const int e = (int)(tk_lookup(P0, code >> 4) * 128u + tk_lookup(P1, code & 15u));
                const int o = (tkl * 128 + h * 16 + pp * 8 + r8) * 3;
                ent[o] = e; ent[o + 1] = __builtin_bit_cast(int, SU[e]); ent[o + 2] = __builtin_bit_cast(int, gate * SV[e]);
            }
        }
#pragma unroll 1
        for (int tk = 0; tk < 8; ++tk) {
            int* et = ent + tk * 384;
            const int eA = et[lane * 3], uA = et[lane * 3 + 1], gA = et[lane * 3 + 2];
            const int eB = et[(64 + lane) * 3], uB = et[(64 + lane) * 3 + 1], gB = et[(64 + lane) * 3 + 2];
            const int rA = eA >> (14 - PE_LOGR), rB = eB >> (14 - PE_LOGR);
            int base = 0;
#pragma unroll 1
            for (int r = 0; r < PE_NR; ++r) {
                const unsigned long long mA = __ballot(rA == r), mB = __ballot(rB == r);
                const int cA = __popcll(mA);
                if (rA == r) { const int q = base + (int)__builtin_amdgcn_mbcnt_hi((unsigned)(mA >> 32), __builtin_amdgcn_mbcnt_lo((unsigned)mA, 0u)); et[q * 3] = eA; et[q * 3 + 1] = uA; et[q * 3 + 2] = gA; }
                if (rB == r) { const int q = base + cA + (int)__builtin_amdgcn_mbcnt_hi((unsigned)(mB >> 32), __builtin_amdgcn_mbcnt_lo((unsigned)mB, 0u)); et[q * 3] = eB; et[q * 3 + 1] = uB; et[q * 3 + 2] = gB; }
                base += cA + __popcll(mB);
            }
        }
        {
            {
                int xq[8][4]; float sx[8];
#pragma unroll
                for (int tk = 0; tk < 8; ++tk) {
                    f32x4 xr[4]; float ss = 0.f;
#pragma unroll
                    for (int j = 0; j < 4; ++j) { xr[j] = *(const f32x4*)(XA + (size_t)(tb + tk) * DM + 4 * lane + 256 * j); ss += xr[j].x * xr[j].x + xr[j].y * xr[j].y + xr[j].z * xr[j].z + xr[j].w * xr[j].w; }
                    ss = wave_sum(ss);
                    const float rn = rsqrtf(ss * (1.0f / DM) + EPS);
                    float mx = 0.f;
#pragma unroll
                    for (int j = 0; j < 4; ++j) { const f32x4 gg = *(const f32x4*)(g2p + 4 * lane + 256 * j);
                        xr[j] = xr[j] * rn * gg; mx = fmaxf(mx, fmaxf(fmaxf(fabsf(xr[j].x), fabsf(xr[j].y)), fmaxf(fabsf(xr[j].z), fabsf(xr[j].w)))); }
                    mx = wave_max(mx);
                    const float qs = mx > 0.f ? 127.0f / mx : 1.0f;
                    sx[tk] = mx > 0.f ? mx * (1.0f / 127.0f) : 1.0f;
#pragma unroll
                    for (int j = 0; j < 4; ++j) xq[tk][j] = (int)pk_i8(xr[j] * qs);
                }
#pragma unroll 1
                for (int r = 0; r < 16; ++r) {
                    __syncthreads();
                    u32x4 rwA[8], rwB[8]; int evA, evB; float cuA, cgA, cuB, cgB;
                    PE_LOAD_U(0, rwA, evA, cuA, cgA);
                    PE_LOAD_U(1, rwB, evB, cuB, cgB); PE_COMP_U(0, rwA, cuA, cgA);
                    PE_LOAD_U(2, rwA, evA, cuA, cgA); PE_COMP_U(1, rwB, cuB, cgB);
                    PE_LOAD_U(3, rwB, evB, cuB, cgB); PE_COMP_U(2, rwA, cuA, cgA);
                    PE_LOAD_U(4, rwA, evA, cuA, cgA); PE_COMP_U(3, rwB, cuB, cgB);
                    PE_LOAD_U(5, rwB, evB, cuB, cgB); PE_COMP_U(4, rwA, cuA, cgA);
                    PE_LOAD_U(6, rwA, evA, cuA, cgA); PE_COMP_U(5, rwB, cuB, cgB);
                    PE_LOAD_U(7, rwB, evB, cuB, cgB); PE_COMP_U(6, rwA, cuA, cgA);
                    PE_COMP_U(7, rwB, cuB, cgB);
                }
            }
#pragma unroll 1
            for (int hv = 0; hv < 2; ++hv) {
            f32x2 acc[4][8];
#pragma unroll
            for (int tk = 0; tk < 4; ++tk)
#pragma unroll
                for (int j = 0; j < 8; ++j) acc[tk][j] = (f32x2){0.f, 0.f};
            const int* entv = ent;
            {
                int* ent = (int*)entv + hv * 4 * 128 * 3;
#pragma unroll 1
                for (int r = 0; r < 16; ++r) {
                    __syncthreads();
                    u32x4 rwA[8], rwB[8]; int avA, avB;
                    PE_LOAD_V(0, rwA, avA);
                    PE_LOAD_V(1, rwB, avB); PE_COMP_V(0, rwA, avA);
                    PE_LOAD_V(2, rwA, avA); PE_COMP_V(1, rwB, avB);
                    PE_LOAD_V(3, rwB, avB); PE_COMP_V(2, rwA, avA);
                    PE_COMP_V(3, rwB, avB);
                }
            }
#pragma unroll
            for (int tk = 0; tk < 4; ++tk) {
                const int t = tb + hv * 4 + tk;
                f32x4 x[4]; float ss = 0.f;
#pragma unroll
                for (int j = 0; j < 4; ++j) {
                    x[j] = *(const f32x4*)(XA + (size_t)t * DM + 4 * lane + 256 * j);
                    x[j].x += acc[tk][2 * j].x; x[j].y += acc[tk][2 * j].y; x[j].z += acc[tk][2 * j + 1].x; x[j].w += acc[tk][2 * j + 1].y;
                    ss += x[j].x * x[j].x + x[j].y * x[j].y + x[j].z * x[j].z + x[j].w * x[j].w;
                }
                ss = wave_sum(ss);
                const float rr = rsqrtf(ss * (1.0f / DM) + EPS);
                if (last) {
#pragma unroll
                    for (int j = 0; j < 4; ++j) { const f32x4 gg = *(const f32x4*)(gnext + 4 * lane + 256 * j); *(f32x4*)(p.out + (size_t)t * DM + 4 * lane + 256 * j) = x[j] * rr * gg; }
                } else {
#pragma unroll
                    for (int j = 0; j < 4; ++j) {
                        const f32x4 gg = *(const f32x4*)(gnext + 4 * lane + 256 * j);
                        *(f32x4*)((DRY ? p.out : XA) + (size_t)t * DM + 4 * lane + 256 * j) = x[j];
                        u32x2 w; w.x = pk2(x[j].x * rr * gg.x, x[j].y * rr * gg.y); w.y = pk2(x[j].z * rr * gg.z, x[j].w * rr * gg.w);
                        if (!DRY) *(u32x2*)(XN + (size_t)t * DM + 4 * lane + 256 * j) = w;
                    }
                }
            }
            }
        }
    }
}

#define LAS __attribute__((address_space(3)))
#define XB_TMO      128
#define XB_XCNT(j)  (256  + 64 * (j))
#define XB_XSUB(j)  (1280 + 64 * (j))
#define XB_XGEN(j)  (2304 + 64 * (j))
#define XB_TOP      3328
#define XB_TOPGEN   3392
#define XCD_BAR_WORDS 3456
#define XB_SPIN_CAP (1u << 20)
__device__ __forceinline__ unsigned xb_ld(unsigned* p)              { return __hip_atomic_load(p, __ATOMIC_RELAXED, __HIP_MEMORY_SCOPE_AGENT); }
__device__ __forceinline__ unsigned xb_add(unsigned* p, unsigned v) { return __hip_atomic_fetch_add(p, v, __ATOMIC_RELAXED, __HIP_MEMORY_SCOPE_AGENT); }
__device__ __forceinline__ unsigned xb_xcc_id() { return (unsigned)__builtin_amdgcn_s_getreg((3 << 11) | 20) & 0xFu; }
#define XB_SPIN(cond, bar) do { unsigned _sp = 0; while (cond) { __builtin_amdgcn_s_sleep(1); \
    if ((++_sp & 255u) == 0u) { if (xb_ld(&(bar)[XB_TMO])) break; if (_sp > XB_SPIN_CAP) { atomicAdd(&(bar)[XB_TMO], 1u); break; } } } } while (0)
struct XcdBarrier { unsigned* bar; unsigned x; volatile LAS unsigned* st; };
__device__ __forceinline__ XcdBarrier xcd_barrier_post(unsigned* bar, volatile LAS unsigned* st) {
    XcdBarrier b; b.bar = bar; b.x = xb_xcc_id(); b.st = st;
    if (threadIdx.x == 0) (void)xb_add(&bar[XB_XCNT(b.x)], 1u);
    return b;
}
__device__ __forceinline__ void xcd_barrier_complete(unsigned* bar, unsigned x, unsigned& nloc, unsigned& nx) {
    const unsigned G = NBLK;
    unsigned sum, cnt, mine, sp = 0u;
    for (;;) {
        sum = 0u; cnt = 0u; mine = 0u;
#pragma unroll
        for (unsigned j = 0; j < 16; ++j) { const unsigned c = xb_ld(&bar[XB_XCNT(j)]); sum += c; cnt += (c > 0u) ? 1u : 0u; mine = (j == x) ? c : mine; }
        if (sum == G) break;
        __builtin_amdgcn_s_sleep(1);
        if ((++sp & 255u) == 0u) { if (xb_ld(&bar[XB_TMO])) break; if (sp > XB_SPIN_CAP) { atomicAdd(&bar[XB_TMO], 1u); break; } }
    }
    nloc = mine > 0u ? mine : 1u; nx = cnt > 0u ? cnt : 1u;
}
__device__ __forceinline__ void xcd_barrier(const XcdBarrier& b) {
    asm volatile("s_waitcnt vmcnt(0)" ::: "memory");
    __syncthreads();
    if (threadIdx.x == 0) {
        unsigned* bar = b.bar;
        __builtin_amdgcn_s_waitcnt(0);
        unsigned nloc = b.st[0], nx = b.st[1];
        if (nloc == 0u) { xcd_barrier_complete(bar, b.x, nloc, nx); b.st[0] = nloc; b.st[1] = nx; }
        const unsigned old = xb_add(&bar[XB_XSUB(b.x)], 1u);
        const unsigned gen = old / nloc;
        if (old + 1u == (gen + 1u) * nloc) {
            __builtin_amdgcn_fence(__ATOMIC_RELEASE, "agent");
            asm volatile("s_waitcnt vmcnt(0)" ::: "memory");
            const unsigned og = xb_add(&bar[XB_TOP], 1u);
            const unsigned tg = og / nx;
            if (og + 1u == (tg + 1u) * nx) xb_add(&bar[XB_TOPGEN], 1u);
            else XB_SPIN(xb_ld(&bar[XB_TOPGEN]) == tg, bar);
            __builtin_amdgcn_fence(__ATOMIC_ACQUIRE, "agent");
            xb_add(&bar[XB_XGEN(b.x)], 1u);
            asm volatile("s_waitcnt vmcnt(0)" ::: "memory");
        } else {
            XB_SPIN(xb_ld(&bar[XB_XGEN(b.x)]) == gen, bar);
            __builtin_amdgcn_fence(__ATOMIC_ACQUIRE, "agent");
            asm volatile("s_waitcnt vmcnt(0)" ::: "memory");
        }
    }
    __syncthreads();
}


template <class Epi> __device__ __forceinline__ void big_gemm(const bf16_t* A, const bf16_t* Bt, int M, int N, int K, char* lds, const Epi& e) {
    pg8::Gemm g{A, Bt, M, N, K}; pg8::StaticOrder S; S.init(M, N, NBLK, obid());
    pg8::gemm_phase<Epi, pg8::StaticOrder, true, true>((PG8_LAS unsigned char*)lds, g, S, e);
}

#define GSYNC() xcd_barrier(xbar)
template <int layer> __device__ __forceinline__ void run_layer(const Params& p, char* lds, const XcdBarrier& xbar) {
    float* XA = (float*)(p.ws + OFF_XA);

        const float* xin = layer == 0 ? p.in[I_X] : XA;
        {
            const bf16_t* wt = (const bf16_t*)(p.ws + OFF_WTIN) + (size_t)layer * INC * DM;
            pg8::EpiStoreBf16 e1{(bf16_t*)(p.ws + R_QKV), 768};
            big_gemm((const bf16_t*)(p.ws + R_XN), wt, T, 768, DM, lds, e1);
            pg8::EpiStoreF32 e2{nullptr, (float*)(p.ws + R_HF), T};
            big_gemm(wt + (size_t)768 * DM, (const bf16_t*)(p.ws + R_XN), 1024, T, DM, lds, e2);
        }
        if (layer == 0) {
#pragma nounroll
            for (int fl = 0; fl < NLAYER; ++fl) {
                EpiF32 e{(float*)(p.ws + (fl ? OFF_HFILT1 : OFF_HFILT0)), SL};
                gemm_simple((const bf16_t*)(p.ws + OFF_W3T) + (size_t)fl * 1024 * 64, (const bf16_t*)(p.ws + OFF_H2) + (size_t)fl * SL * 64, 1024, SL, 64, lds, e);
            }
        }
        GSYNC();
        if (layer == 0) {
            phase_filter_spectra(p, lds);
        }
        phase_qkprep(p, layer, lds, (bf16_t*)(p.ws + R_QKV)); GSYNC();
        {
            phase_attn(p, layer, lds);
            for (int c = obid(); c < 256; c += NBLK) hyena_job(p, layer, c, lds);
            for (int c = obid(); c < 256; c += NBLK) fnet_job(p, c, lds);
        } GSYNC();
        phase_mix(p, layer, lds); GSYNC();
        { pg8::EpiOutProj e{xin, XA, (bf16_t*)(p.ws + R_XN), (float*)(p.ws + OFF_RS)};
          big_gemm((const bf16_t*)(p.ws + R_MIX), (const bf16_t*)(p.ws + OFF_WTOUT) + (size_t)layer * DM * DM, T, DM, DM, lds, e); } GSYNC();
        { pg8::EpiRowScaleF16 e{(_Float16*)(p.ws + R_QP), 2048, (const float*)(p.ws + OFF_RS)};
          big_gemm((const bf16_t*)(p.ws + R_XN), (const bf16_t*)(p.ws + OFF_WTQ) + (size_t)layer * 2048 * DM, T, 2048, DM, lds, e); } GSYNC();
        phase_peer_fused<false>(p, layer, lds);
        if (layer + 1 < NLAYER) GSYNC();
}

__global__ void __launch_bounds__(NTHR) mega_kernel(Params p) {
    extern __shared__ __attribute__((aligned(16))) char lds[];
    volatile LAS unsigned* misc = (volatile LAS unsigned*)((LAS char*)lds + LDS_MISC);
    if (threadIdx.x < 16) misc[threadIdx.x] = 0u;
    __syncthreads();
    const XcdBarrier xbar = xcd_barrier_post((unsigned*)(p.ws + OFF_CTL) + 4096, misc);
    float* XA = (float*)(p.ws + OFF_XA);
    phase_p0(p, lds);
    phase_rmsnorm_bf16(p.in[I_X], p.in[I_N1G], (bf16_t*)(p.ws + R_XN));
    GSYNC();
    run_layer<0>(p, lds, xbar);
    run_layer<1>(p, lds, xbar);
}

extern "C" void kernel_launch(void* const* d_in, const int* in_sizes, int n_in, void* d_out, int out_size, void* d_ws, size_t ws_size, hipStream_t stream) {
    static int grid = 0;
    if (grid == 0) {
        if (n_in != 25 || out_size != T * DM || ws_size < WS_NEED) { fprintf(stderr, "kernel_launch: unexpected sizes n_in %d out %d ws %zu (need %zu)\n", n_in, out_size, ws_size, (size_t)WS_NEED); grid = -1; return; }
        int dev = 0, cus = 0, per_cu = 0;
        if (hipGetDevice(&dev) != hipSuccess || hipDeviceGetAttribute(&cus, hipDeviceAttributeMultiprocessorCount, dev) != hipSuccess) { grid = -1; return; }
        if (hipFuncSetAttribute((const void*)mega_kernel, hipFuncAttributeMaxDynamicSharedMemorySize, LDS_BYTES) != hipSuccess) { fprintf(stderr, "kernel_launch: hipFuncSetAttribute failed\n"); grid = -1; return; }
        if (hipOccupancyMaxActiveBlocksPerMultiprocessor(&per_cu, (const void*)mega_kernel, NTHR, LDS_BYTES) != hipSuccess || per_cu < 1) { fprintf(stderr, "kernel_launch: occupancy query says %d blocks per CU\n", per_cu); grid = -1; return; }
        (void)hipGetLastError();
        if (cus < NBLK) { fprintf(stderr, "kernel_launch: built for a %d-CU device, found %d CUs\n", NBLK, cus); grid = -1; return; }
        grid = NBLK;
    }
    if (grid < 0) return;
    Params p{};
    for (int i = 0; i < 25; ++i) p.in[i] = (const float*)d_in[i];
    p.out = (float*)d_out; p.ws = (unsigned char*)d_ws;
    if (hipMemsetAsync((char*)d_ws + OFF_CTL, 0, 64 * 1024, stream) != hipSuccess) { fprintf(stderr, "kernel_launch: memset failed\n"); return; }
    void* args[] = {&p};
    hipError_t e = hipLaunchCooperativeKernel((const void*)mega_kernel, dim3(grid), dim3(NTHR), args, LDS_BYTES, stream);
    if (e != hipSuccess) fprintf(stderr, "cooperative launch failed: %s (grid %d)\n", hipGetErrorString(e), grid);
}
```

```cpp
#include <hip/hip_runtime.h>
#include <cstdio>
#include <cstdint>

typedef unsigned short bf16_t;
typedef short bf16x8 __attribute__((ext_vector_type(8)));
typedef float f32x16 __attribute__((ext_vector_type(16)));
typedef float f32x4 __attribute__((ext_vector_type(4)));
typedef unsigned u32x4 __attribute__((ext_vector_type(4)));
typedef unsigned u32x2 __attribute__((ext_vector_type(2)));
typedef _Float16 f16x4 __attribute__((ext_vector_type(4)));
typedef _Float16 f16x8 __attribute__((ext_vector_type(8)));

constexpr int DM = 1024, NB = 2, SL = 8192, T = NB * SL, NLAYER = 2;
constexpr int INC = 1792;
constexpr int NTHR = 512, NWAVE = 8;
constexpr int NBLK = 256;
constexpr int LDS_BYTES = 147456;
constexpr int LDS_MISC = LDS_BYTES - 64;
constexpr float EPS = 1e-6f;

constexpr size_t MiB = 1u << 20;
constexpr size_t OFF_CTL = 0;
constexpr size_t OFF_WTIN = 1 * MiB;
constexpr size_t OFF_WTOUT = 8 * MiB;
constexpr size_t OFF_WTQ = 12 * MiB;
constexpr size_t OFF_PU = 20 * MiB;
constexpr size_t OFF_PV = 84 * MiB;
constexpr size_t OFF_RS = 505 * MiB;
constexpr size_t OFF_PSC = 512 * 1024;
constexpr size_t OFF_H2 = 148 * MiB;
constexpr size_t OFF_W3T = 150 * MiB;
constexpr size_t OFF_HFILT0 = 52 * MiB, OFF_HFILT1 = 116 * MiB;
constexpr size_t OFF_FM = 152 * MiB;
constexpr size_t OFF_KF = 153 * MiB;
constexpr size_t OFF_XA = 281 * MiB;
constexpr size_t OFF_R = 345 * MiB;
constexpr size_t R_XN = OFF_R + 0 * MiB;
constexpr size_t R_UR = OFF_R + 0 * MiB;
constexpr size_t R_UI = OFF_R + 16 * MiB;
constexpr size_t R_QKV = OFF_R + 32 * MiB;
constexpr size_t R_HF = OFF_R + 60 * MiB;
constexpr size_t R_MIX = OFF_R + 60 * MiB;
constexpr size_t R_ATT = OFF_R + 124 * MiB;
constexpr size_t R_Y = OFF_R + 140 * MiB;
constexpr size_t R_QP = OFF_R + 32 * MiB;
constexpr size_t WS_NEED = 506 * MiB;

struct Params {
    const float* in[25];
    float* out;
    unsigned char* ws;
};
enum { I_X = 0, I_N1G, I_WIN, I_QG, I_KG, I_CW, I_CB, I_W1, I_B1, I_F1, I_W2, I_B2, I_F2, I_W3, I_HB, I_FW, I_FB, I_MG, I_WOUT, I_N2G, I_WQ, I_SK, I_PU, I_PV, I_FG };

__device__ __forceinline__ unsigned f2bf(float f) { unsigned u = __builtin_bit_cast(unsigned, f); return (u + 0x7fffu + ((u >> 16) & 1u)) >> 16; }
__device__ __forceinline__ unsigned pk2(float lo, float hi) { return f2bf(lo) | (f2bf(hi) << 16); }
__device__ __forceinline__ float bflo(unsigned w) { return __builtin_bit_cast(float, w << 16); }
__device__ __forceinline__ float bfhi(unsigned w) { return __builtin_bit_cast(float, w & 0xffff0000u); }
__device__ __forceinline__ float wave_sum(float v) {
#pragma unroll
    for (int o = 1; o < 64; o <<= 1) v += __shfl_xor(v, o);
    return v;
}
__device__ __forceinline__ float wave_max(float v) {
#pragma unroll
    for (int o = 1; o < 64; o <<= 1) v = fmaxf(v, __shfl_xor(v, o));
    return v;
}
__device__ __forceinline__ unsigned pk_i8(f32x4 v) {
    const int a = (int)rintf(v.x), b = (int)rintf(v.y), c = (int)rintf(v.z), d = (int)rintf(v.w);
    return ((unsigned)a & 0xFFu) | (((unsigned)b & 0xFFu) << 8) | (((unsigned)c & 0xFFu) << 16) | ((unsigned)d << 24);
}
__device__ __forceinline__ f32x16 mfma32(bf16x8 a, bf16x8 b, f32x16 c) { return __builtin_amdgcn_mfma_f32_32x32x16_bf16(a, b, c, 0, 0, 0); }
__device__ __forceinline__ f32x16 zero16() { return (f32x16){0.f,0.f,0.f,0.f,0.f,0.f,0.f,0.f,0.f,0.f,0.f,0.f,0.f,0.f,0.f,0.f}; }


__device__ constexpr float ROPE_INV_REV[16] = {1.591549431e-01f, 8.949940161e-02f, 5.032921210e-02f, 2.830219583e-02f, 1.591549431e-02f, 8.949940161e-03f, 5.032921210e-03f, 2.830219583e-03f, 1.591549431e-03f, 8.949940161e-04f, 5.032921210e-04f, 2.830219583e-04f, 1.591549431e-04f, 8.949940161e-05f, 5.032921210e-05f, 2.830219583e-05f};
__device__ __forceinline__ int otid() { int t = threadIdx.x; asm volatile("" : "+v"(t)); return t; }
__device__ __forceinline__ int obid() { int b = blockIdx.x; asm volatile("" : "+s"(b)); return b; }
__device__ __forceinline__ void transpose_one(const float* W, int K, int N, bf16_t* Wt, float* tile, int item, int permrows = 0) {
    const int tid = otid();
    const int nblk = N / 64, kb = item / nblk, nb = item % nblk, k0 = kb * 64, n0 = nb * 64;
    __syncthreads();
    {
        const int r = tid >> 6, c = tid & 63;
#pragma unroll
        for (int i = 0; i < 8; ++i) { const int k = r + 8 * i; tile[k * 65 + c] = W[(size_t)(k0 + k) * N + n0 + c]; }
    }
    __syncthreads();
    {
        const int nn = tid >> 3, kc = tid & 7;
        const float* s = tile + (kc * 8) * 65 + nn;
        u32x4 o; o.x = pk2(s[0], s[65]); o.y = pk2(s[2 * 65], s[3 * 65]); o.z = pk2(s[4 * 65], s[5 * 65]); o.w = pk2(s[6 * 65], s[7 * 65]);
        int n = n0 + nn;
        if (n < permrows) n = (n & ~255) | ((((n >> 5) & 1) << 7) + (((n >> 6) & 3) << 5) + (n & 31));
        *(u32x4*)(Wt + (size_t)n * K + k0 + kc * 8) = o;
    }
}

template <int PARTS = 31> __device__ __forceinline__ void phase_p0(const Params& p, char* lds) {
    const int tid = otid();
    float* tile = (float*)lds;
    if (PARTS & 1) {
    constexpr int IT_IN = (DM / 64) * (INC / 64), IT_OUT = (DM / 64) * (DM / 64), IT_W3 = 1024 / 64;
    constexpr int IT_L = IT_IN + IT_OUT + IT_W3;
    for (int it = obid(); it < NLAYER * IT_L; it += NBLK) {
        const int layer = it / IT_L; int r = it % IT_L;
        if (r < IT_IN) { transpose_one(p.in[I_WIN] + (size_t)layer * DM * INC, DM, INC, (bf16_t*)(p.ws + OFF_WTIN) + (size_t)layer * INC * DM, tile, r); continue; }
        r -= IT_IN;
        if (r < IT_OUT) { transpose_one(p.in[I_WOUT] + (size_t)layer * DM * DM, DM, DM, (bf16_t*)(p.ws + OFF_WTOUT) + (size_t)layer * DM * DM, tile, r); continue; }
        r -= IT_OUT;
        transpose_one(p.in[I_W3] + (size_t)layer * 64 * 1024, 64, 1024, (bf16_t*)(p.ws + OFF_W3T) + (size_t)layer * 1024 * 64, tile, r);
    }
    }
    __syncthreads();
    if (PARTS & 2) {
        float* SKl = (float*)lds;
        float* Wl = SKl + 128 * 129;
        const int lane = tid & 63, wave = tid >> 6, l31 = lane & 31, hl = lane >> 5, mt = wave & 3, nt = wave >> 2;
        for (int it = obid(); it < NLAYER * 16 * 16; it += NBLK) {
            const int layer = it >> 8, hp = (it >> 4) & 15, kc = it & 15, h = hp >> 1, pp = hp & 1, k0 = kc * 64;
            const float* sk = p.in[I_SK] + (((size_t)(layer * 2 + pp) * 8 + h) * 128) * 128;
            const float* wq = p.in[I_WQ] + (size_t)layer * DM * 2048 + (size_t)k0 * 2048 + h * 256 + pp * 128;
            __syncthreads();
            for (int i = tid; i < 128 * 128; i += NTHR) SKl[(i >> 7) * 129 + (i & 127)] = sk[i];
            for (int i = tid; i < 64 * 128; i += NTHR) Wl[(i >> 7) * 129 + (i & 127)] = wq[(size_t)(i >> 7) * 2048 + (i & 127)];
            __syncthreads();
            f32x16 acc = zero16();
            const float* ap = SKl + (32 * mt + l31) * 129 + hl;
            const float* bp = Wl + (32 * nt + l31) * 129 + hl;
#pragma unroll 16
            for (int kk = 0; kk < 64; ++kk) acc = __builtin_amdgcn_mfma_f32_32x32x2f32(ap[2 * kk], bp[2 * kk], acc, 0, 0, 0);
            const float g2 = p.in[I_N2G][layer * DM + k0 + 32 * nt + l31];
            bf16_t* dst = (bf16_t*)(p.ws + OFF_WTQ) + (size_t)layer * 2048 * DM + (size_t)(hp * 128 + 32 * mt + 4 * hl) * DM + k0 + 32 * nt + l31;
#pragma unroll
            for (int r = 0; r < 16; ++r) dst[(size_t)((r & 3) + 8 * (r >> 2)) * DM] = (bf16_t)f2bf(acc[r] * g2);
        }
        __syncthreads();
    }
    if (PARTS & 4) {
        const int lane = tid & 63, wave = tid >> 6;
        float* scl = (float*)(p.ws + OFF_PSC);
        for (int row = obid() * NWAVE + wave; row < 2 * NLAYER * 16384; row += NBLK * NWAVE) {
            const int tb = row >> 15, r = row & 32767;
            const f32x4* src = (const f32x4*)(p.in[tb ? I_PV : I_PU] + (size_t)r * DM) + lane;
            f32x4 v[4]; float mx = 0.f;
#pragma unroll
            for (int j = 0; j < 4; ++j) { v[j] = __builtin_nontemporal_load(src + 64 * j); mx = fmaxf(mx, fmaxf(fmaxf(fabsf(v[j].x), fabsf(v[j].y)), fmaxf(fabsf(v[j].z), fabsf(v[j].w)))); }
            mx = wave_max(mx);
            const float qs = mx > 0.f ? 127.0f / mx : 1.0f;
            u32x4 o;
            o.x = pk_i8(v[0] * qs); o.y = pk_i8(v[1] * qs); o.z = pk_i8(v[2] * qs); o.w = pk_i8(v[3] * qs);
            *(u32x4*)(p.ws + (tb ? OFF_PV : OFF_PU) + (size_t)r * DM + lane * 16) = o;
            if (lane == 0) scl[row] = mx > 0.f ? mx * (1.0f / 127.0f) : 1.0f;
        }
    }
    if (PARTS & 8) {
        float* sh = (float*)lds;
        float* zl = sh + 64 * 64;
        const int sub = tid >> 6, j = tid & 63;
        for (int it0 = obid() * 64; it0 < NLAYER * SL; it0 += NBLK * 64) {
            const int layer = it0 / SL;
            __syncthreads();
            for (int o = tid; o < 64 * 17; o += NTHR) {
                const int item = o / 17, f = o % 17;
                const float t = (float)((it0 + item) % SL) / (float)(SL - 1);
                float z;
                if (f == 0) z = t;
                else if (f <= 8) z = sinf(2.0f * 3.14159265358979323846f * t * (float)f);
                else z = cosf(2.0f * 3.14159265358979323846f * t * (float)(f - 8));
                zl[o] = z;
            }
            __syncthreads();
            {
                const float* w1 = p.in[I_W1] + layer * 17 * 64;
                float wv[17];
#pragma unroll
                for (int i = 0; i < 17; ++i) wv[i] = w1[i * 64 + j];
                const float b1 = p.in[I_B1][layer * 64 + j], f1 = p.in[I_F1][layer * 64 + j];
#pragma unroll
                for (int r = 0; r < 8; ++r) {
                    const int item = sub * 8 + r;
                    float a = b1;
#pragma unroll
                    for (int i = 0; i < 17; ++i) a += zl[item * 17 + i] * wv[i];
                    sh[item * 64 + j] = sinf(f1 * a);
                }
            }
            __syncthreads();
            {
                const float* w2 = p.in[I_W2] + layer * 64 * 64;
                const float b2 = p.in[I_B2][layer * 64 + j], f2 = p.in[I_F2][layer * 64 + j];
                float acc[8];
#pragma unroll
                for (int r = 0; r < 8; ++r) acc[r] = b2;
#pragma unroll 8
                for (int k = 0; k < 64; ++k) {
                    const float w = w2[k * 64 + j];
#pragma unroll
                    for (int r = 0; r < 8; ++r) acc[r] += sh[(sub * 8 + r) * 64 + k] * w;
                }
#pragma unroll
                for (int r = 0; r < 8; ++r)
                    ((bf16_t*)(p.ws + OFF_H2))[((size_t)(it0 + sub * 8 + r)) * 64 + j] = (bf16_t)f2bf(sinf(f2 * acc[r]));
            }
        }
        __syncthreads();
    }
    if (PARTS & 16) {
        float* ctab = (float*)lds;
        __syncthreads();
        if (tid < 64) ctab[tid] = cosf((float)tid * (2.0f * 3.14159265358979323846f / 64.0f));
        __syncthreads();
        const int total = NLAYER * 4 * 128 * 64;
        for (int o = obid() * NTHR + tid; o < total; o += NBLK * NTHR) {
            const int e2 = o & 63, dd = (o >> 6) & 127, g = (o >> 13) & 3, layer = o >> 15;
            const int d = dd & 63, sh = (dd < 64) ? 0 : 48;
            const float* w = p.in[I_FW] + ((size_t)(layer * 4 + g) * 64) * 64;
            float acc = 0.f;
#pragma unroll 8
            for (int e = 0; e < 64; ++e) acc += ctab[(d * e + sh) & 63] * w[e * 64 + e2];
            ((float*)(p.ws + OFF_FM))[o] = acc * (1.0f / 724.0773439350246f);
        }
        __syncthreads();
    }
}

__device__ __forceinline__ int zp(int i) { return i + 2 * (i >> 5); }
__device__ constexpr float FC32[16] = {1.000000000f, 0.980785280f, 0.923879533f, 0.831469612f, 0.707106781f, 0.555570233f, 0.382683432f, 0.195090322f, 0.000000000f, -0.195090322f, -0.382683432f, -0.555570233f, -0.707106781f, -0.831469612f, -0.923879533f, -0.980785280f};
__device__ constexpr float FS32[16] = {0.000000000f, 0.195090322f, 0.382683432f, 0.555570233f, 0.707106781f, 0.831469612f, 0.923879533f, 0.980785280f, 1.000000000f, 0.980785280f, 0.923879533f, 0.831469612f, 0.707106781f, 0.555570233f, 0.382683432f, 0.195090322f};
__device__ __forceinline__ float2 cmulf(float2 a, float2 b) { return make_float2(a.x * b.x - a.y * b.y, a.x * b.y + a.y * b.x); }
template <int R> __device__ __forceinline__ constexpr int brevR(int x) { int r = 0; for (int b = 1, t = R >> 1; t >= 1; b <<= 1, t >>= 1) if (x & b) r |= t; return r; }
template <int R> __device__ __forceinline__ void dft_fwd_regs(float2 (&x)[R]) {
#pragma unroll
    for (int half = R / 2; half >= 1; half >>= 1) {
#pragma unroll
        for (int blk = 0; blk < R; blk += 2 * half)
#pragma unroll
            for (int k = 0; k < half; ++k) {
                const float2 a = x[blk + k], b = x[blk + k + half];
                x[blk + k] = make_float2(a.x + b.x, a.y + b.y);
                const float2 d = make_float2(a.x - b.x, a.y - b.y);
                const int ti = k * (16 / half);
                if (ti == 0) x[blk + k + half] = d;
                else if (ti == 8) x[blk + k + half] = make_float2(d.y, -d.x);
                else { const float c = FC32[ti], sn = FS32[ti]; x[blk + k + half] = make_float2(d.x * c + d.y * sn, d.y * c - d.x * sn); }
            }
    }
}
template <int R> __device__ __forceinline__ void dft_inv_regs(float2 (&x)[R]) {
#pragma unroll
    for (int half = 1; half <= R / 2; half <<= 1) {
#pragma unroll
        for (int blk = 0; blk < R; blk += 2 * half)
#pragma unroll
            for (int k = 0; k < half; ++k) {
                const float2 a = x[blk + k], b0 = x[blk + k + half];
                const int ti = k * (16 / half);
                float2 b;
                if (ti == 0) b = b0;
                else if (ti == 8) b = make_float2(-b0.y, b0.x);
                else { const float c = FC32[ti], sn = FS32[ti]; b = make_float2(b0.x * c - b0.y * sn, b0.y * c + b0.x * sn); }
                x[blk + k] = make_float2(a.x + b.x, a.y + b.y);
                x[blk + k + half] = make_float2(a.x - b.x, a.y - b.y);
            }
    }
}
template <int R> __device__ __forceinline__ void apply_tw(float2 (&x)[R], float c, float sg) {
    const float2 w1 = make_float2(c, sg), w2 = cmulf(w1, w1);
    float2 po = w1, pe = w2;
#pragma unroll
    for (int m = 1; m < R; m += 2) {
        x[brevR<R>(m)] = cmulf(x[brevR<R>(m)], po);
        if (m + 1 < R) x[brevR<R>(m + 1)] = cmulf(x[brevR<R>(m + 1)], pe);
        if (m + 2 < R) { po = cmulf(po, w2); pe = cmulf(pe, w2); }
    }
}
template <int R, bool INV> __device__ __forceinline__ void fft_group(float2* Z, int pbase, int PS, float ang) {
    float2 x[R];
    if (!INV) {
#pragma unroll
        for (int m = 0; m < R; ++m) x[m] = Z[pbase + PS * m];
        dft_fwd_regs<R>(x);
        apply_tw<R>(x, __builtin_amdgcn_cosf(ang), -__builtin_amdgcn_sinf(ang));
#pragma unroll
        for (int m = 0; m < R; ++m) Z[pbase + PS * m] = x[brevR<R>(m)];
    } else {
#pragma unroll
        for (int m = 0; m < R; ++m) x[brevR<R>(m)] = Z[pbase + PS * m];
        apply_tw<R>(x, __builtin_amdgcn_cosf(ang), __builtin_amdgcn_sinf(ang));
        dft_inv_regs<R>(x);
#pragma unroll
        for (int m = 0; m < R; ++m) Z[pbase + PS * m] = x[m];
    }
}
template <bool INV> __device__ __forceinline__ void fft_group32_contig(float2* Z, int pbase) {
    float2 x[32];
    if (!INV) {
#pragma unroll
        for (int m = 0; m < 32; m += 2) { const f32x4 v = *(const f32x4*)(Z + pbase + m); x[m] = make_float2(v.x, v.y); x[m + 1] = make_float2(v.z, v.w); }
        dft_fwd_regs<32>(x);
#pragma unroll
        for (int m = 0; m < 32; m += 2) { const float2 a = x[brevR<32>(m)], b = x[brevR<32>(m + 1)]; *(f32x4*)(Z + pbase + m) = (f32x4){a.x, a.y, b.x, b.y}; }
    } else {
#pragma unroll
        for (int m = 0; m < 32; m += 2) { const f32x4 v = *(const f32x4*)(Z + pbase + m); x[brevR<32>(m)] = make_float2(v.x, v.y); x[brevR<32>(m + 1)] = make_float2(v.z, v.w); }
        dft_inv_regs<32>(x);
#pragma unroll
        for (int m = 0; m < 32; m += 2) *(f32x4*)(Z + pbase + m) = (f32x4){x[m].x, x[m].y, x[m + 1].x, x[m + 1].y};
    }
}
__device__ __forceinline__ void fft16k_fwd(float2* Z) {
    const int tid = otid();
#pragma unroll 1
    for (int g = 0; g < 2; ++g) { const int j = tid + 512 * g; fft_group<16, false>(Z, zp(j), 1088, (float)j * (1.0f / 16384.0f)); }
    __syncthreads();
    { const int blk = tid >> 5, j = tid & 31; fft_group<32, false>(Z, blk * 1088 + j, 34, (float)j * (1.0f / 1024.0f)); }
    __syncthreads();
    fft_group32_contig<false>(Z, 34 * tid);
    __syncthreads();
}
__device__ __forceinline__ void fft16k_inv(float2* Z) {
    const int tid = otid();
    fft_group32_contig<true>(Z, 34 * tid);
    __syncthreads();
    { const int blk = tid >> 5, j = tid & 31; fft_group<32, true>(Z, blk * 1088 + j, 34, (float)j * (1.0f / 1024.0f)); }
    __syncthreads();
#pragma unroll 1
    for (int g = 0; g < 2; ++g) { const int j = tid + 512 * g; fft_group<16, true>(Z, zp(j), 1088, (float)j * (1.0f / 16384.0f)); }
    __syncthreads();
}
__device__ __forceinline__ void fft8k_fwd(float2* Z) {
    const int tid = otid();
    fft_group<16, false>(Z, zp(tid), 544, (float)tid * (1.0f / 8192.0f));
    __syncthreads();
    { const int blk = tid >> 5, j = tid & 31; fft_group<16, false>(Z, blk * 544 + j, 34, (float)j * (1.0f / 512.0f)); }
    __syncthreads();
    if (tid < 256) fft_group32_contig<false>(Z, 34 * tid);
    __syncthreads();
}
__device__ __forceinline__ int f16k_of_p(int p) { return (p >> 10) + 16 * ((p >> 5) & 31) + 512 * (p & 31); }
__device__ __forceinline__ int p16k_of_f(int f) { return 1024 * (f & 15) + 32 * ((f >> 4) & 31) + (f >> 9); }
__device__ __forceinline__ int p8k_of_f(int f) { return 512 * (f & 15) + 32 * ((f >> 4) & 15) + (f >> 8); }

__device__ __forceinline__ void phase_filter_spectra(const Params& p, char* lds) {
    const int tid = otid(), lane = tid & 63, wave = tid >> 6;
    float2* Z = (float2*)lds;
    float* red = (float*)(lds + 139264 + 64);
    for (int job = obid(); job < NLAYER * 256; job += NBLK) {
        const int layer = job >> 8, c = job & 255;
        __syncthreads();
        const float* HFc = (const float*)(p.ws + (layer ? OFF_HFILT1 : OFF_HFILT0)) + (size_t)c * SL;
        const float r_lo = 4.605170185988092f / 1.5f, r_hi = 4.605170185988092f / 0.3f;
        const float rate = r_lo + (r_hi - r_lo) * ((float)c / 255.0f);
        float ss0 = 0.f, ss1 = 0.f;
#pragma unroll 2
        for (int i = 0; i < 4; ++i) {
            const int l0 = 4 * tid + 2048 * i;
            const f32x4 a0 = *(const f32x4*)(HFc + l0), a1 = *(const f32x4*)(HFc + (size_t)256 * SL + l0);
            const f32x4 a2 = *(const f32x4*)(HFc + (size_t)512 * SL + l0), a3 = *(const f32x4*)(HFc + (size_t)768 * SL + l0);
#pragma unroll
            for (int e = 0; e < 4; ++e) {
                const int l = l0 + e;
                const float t = (float)l / (float)(SL - 1);
                const float dec = expf(-t * rate);
                const float f0 = a0[e] * dec, b0 = a1[e] * dec, f1 = a2[e] * dec, b1 = a3[e] * dec;
                ss0 += f0 * f0 + b0 * b0; ss1 += f1 * f1 + b1 * b1;
                Z[zp(l)] = make_float2(f0, f1);
                if (l >= 1) Z[zp(16384 - l)] = make_float2(b0, b1);
            }
        }
        if (tid == 0) Z[zp(8192)] = make_float2(0.f, 0.f);
        ss0 = wave_sum(ss0); ss1 = wave_sum(ss1);
        if (lane == 0) { red[wave * 2] = ss0; red[wave * 2 + 1] = ss1; }
        __syncthreads();
        float t0 = 0.f, t1 = 0.f;
#pragma unroll
        for (int w = 0; w < 8; ++w) { t0 += red[w * 2]; t1 += red[w * 2 + 1]; }
        const float sc0 = rsqrtf(t0 + EPS) * (1.0f / 16384.0f) * 0.5f, sc1 = rsqrtf(t1 + EPS) * (1.0f / 16384.0f) * 0.5f;
        const float hb0 = p.in[I_HB][(layer * 2 + 0) * 256 + c] * (1.0f / 16384.0f), hb1 = p.in[I_HB][(layer * 2 + 1) * 256 + c] * (1.0f / 16384.0f);
        fft16k_fwd(Z);
        float2* KF0 = (float2*)(p.ws + OFF_KF) + ((size_t)(layer * 256 + c) * 2) * 16384;
        float2* KF1 = KF0 + 16384;
        for (int i = 0; i < 32; ++i) {
            const int pp = tid + NTHR * i;
            const int fq = f16k_of_p(pp);
            const int pq = p16k_of_f((16384 - fq) & 16383);
            const float2 za = Z[zp(pp)], zq = Z[zp(pq)];
            KF0[pp] = make_float2((za.x + zq.x) * sc0 + hb0, (za.y - zq.y) * sc0);
            KF1[pp] = make_float2((za.y + zq.y) * sc1 + hb1, (zq.x - za.x) * sc1);
        }
    }
}

__device__ __forceinline__ void phase_rmsnorm_bf16(const float* x, const float* g, bf16_t* out) {
    const int lane = otid() & 63, wave = otid() >> 6;
    const int gw = obid() * NWAVE + wave, ngw = NBLK * NWAVE;
    for (int row = gw; row < T; row += ngw) {
        const f32x4* xr = (const f32x4*)(x + (size_t)row * DM) + lane;
        f32x4 v[4]; float ss = 0.f;
#pragma unroll
        for (int j = 0; j < 4; ++j) { v[j] = xr[64 * j]; ss += v[j].x * v[j].x + v[j].y * v[j].y + v[j].z * v[j].z + v[j].w * v[j].w; }
        ss = wave_sum(ss);
        const float r = rsqrtf(ss * (1.0f / DM) + EPS);
        u32x2* o = (u32x2*)(out + (size_t)row * DM) + lane;
#pragma unroll
        for (int j = 0; j < 4; ++j) {
            const f32x4 gg = ((const f32x4*)g)[lane + 64 * j];
            u32x2 w; w.x = pk2(v[j].x * r * gg.x, v[j].y * r * gg.y); w.y = pk2(v[j].z * r * gg.z, v[j].w * r * gg.w);
            o[64 * j] = w;
        }
    }
}

constexpr int G_LDA = 144;
template <class Epi>
__device__ __forceinline__ void gemm_simple(const bf16_t* A, const bf16_t* Bt, int M, int N, int K, char* lds, const Epi& epi) {
    const int tid = otid(), lane = tid & 63, wave = tid >> 6;
    const int wm = wave >> 1, wn = wave & 1;
    const int nMt = M / 256, nNt = N / 128, total = nMt * nNt, nk = K / 64;
    char* As = lds; char* Bs = lds + 256 * G_LDA;
    const int l31 = lane & 31, hl = lane >> 5;
    for (int u = obid(); u < total; u += NBLK) {
        const int mt = u % nMt, nt = u / nMt;
        f32x16 acc[2][2];
#pragma unroll
        for (int i = 0; i < 2; ++i)
#pragma unroll
            for (int j = 0; j < 2; ++j) acc[i][j] = zero16();
        u32x4 ra[4], rb[2];
        const bf16_t* Ab = A + (size_t)(mt * 256) * K;
        const bf16_t* Bb = Bt + (size_t)(nt * 128) * K;
#pragma unroll
        for (int i = 0; i < 4; ++i) { const int id = tid + NTHR * i, row = id >> 3, ch = id & 7; ra[i] = *(const u32x4*)(Ab + (size_t)row * K + ch * 8); }
#pragma unroll
        for (int i = 0; i < 2; ++i) { const int id = tid + NTHR * i, row = id >> 3, ch = id & 7; rb[i] = *(const u32x4*)(Bb + (size_t)row * K + ch * 8); }
        for (int kt = 0; kt < nk; ++kt) {
            __syncthreads();
#pragma unroll
            for (int i = 0; i < 4; ++i) { const int id = tid + NTHR * i, row = id >> 3, ch = id & 7; *(u32x4*)(As + row * G_LDA + ch * 16) = ra[i]; }
#pragma unroll
            for (int i = 0; i < 2; ++i) { const int id = tid + NTHR * i, row = id >> 3, ch = id & 7; *(u32x4*)(Bs + row * G_LDA + ch * 16) = rb[i]; }
            __syncthreads();
            if (kt + 1 < nk) {
                const int ko = (kt + 1) * 64;
#pragma unroll
                for (int i = 0; i < 4; ++i) { const int id = tid + NTHR * i, row = id >> 3, ch = id & 7; ra[i] = *(const u32x4*)(Ab + (size_t)row * K + ko + ch * 8); }
#pragma unroll
                for (int i = 0; i < 2; ++i) { const int id = tid + NTHR * i, row = id >> 3, ch = id & 7; rb[i] = *(const u32x4*)(Bb + (size_t)row * K + ko + ch * 8); }
            }
#pragma unroll
            for (int ks = 0; ks < 4; ++ks) {
                bf16x8 a[2], b[2];
#pragma unroll
                for (int i = 0; i < 2; ++i) a[i] = *(const bf16x8*)(As + (wm * 64 + i * 32 + l31) * G_LDA + ks * 32 + hl * 16);
#pragma unroll
                for (int j = 0; j < 2; ++j) b[j] = *(const bf16x8*)(Bs + (wn * 64 + j * 32 + l31) * G_LDA + ks * 32 + hl * 16);
#pragma unroll
                for (int i = 0; i < 2; ++i)
#pragma unroll
                    for (int j = 0; j < 2; ++j) acc[i][j] = mfma32(a[i], b[j], acc[i][j]);
            }
        }
#pragma unroll
        for (int i = 0; i < 2; ++i)
#pragma unroll
            for (int j = 0; j < 2; ++j) epi(acc[i][j], mt * 256 + wm * 64 + i * 32, nt * 128 + wn * 64 + j * 32, lane);
    }
}

struct EpiF32 {
    float* out; int ld;
    __device__ __forceinline__ void operator()(const f32x16& acc, int row0, int col0, int lane) const {
        const int c = col0 + (lane & 31), h = lane >> 5;
#pragma unroll
        for (int r = 0; r < 16; ++r) { out[(size_t)(row0 + (r & 3) + 8 * (r >> 2) + 4 * h) * ld + c] = acc[r]; }
    }
};

__device__ __forceinline__ void qk_norm_rope8(const u32x4 raw, const float (&gn)[8], const float (&cs)[8], const float (&sn)[8], bool second, float scale, u32x4& out);
namespace pg8 {
#define PG8_LAS __attribute__((address_space(3)))
constexpr int BM = 256, BK = 64, HALF = 128, HTB = HALF * BK * 2  , STAGE_BYTES = 8 * HTB, NXCD = 8, WGM = 8;

__host__ __device__ __forceinline__ int lds_byte(int r, int c) { const int st = (r >> 4) * 2 + (c >> 5), rr = r & 15, cc = c & 31, ob = rr * 64 + cc * 2; return st * 1024 + (ob ^ (((ob >> 9) & 1) << 5)); }
__host__ __device__ __forceinline__ void stage_rc(int b, int& R, int& C) { const int st = b / 1024, sb = b % 1024, swz = sb ^ (((sb >> 9) & 1) << 5); R = (st >> 1) * 16 + swz / 64; C = (st & 1) * 32 + (swz % 64) / 2; }
__host__ __device__ __forceinline__ int perm32(int rho) { const int n = rho >> 4, i = rho & 15; return 8 * (i >> 2) + 4 * n + (i & 3); }

struct Unit { int pm, pn; };
struct Gemm { const bf16_t* A; const bf16_t* Bt; int M, N, K; };

struct StaticOrder {
    int nM, nN, nwg, G, c;
    __host__ __device__ void init(int M, int N, int G_, int c_) { nM = M / BM; nN = N / BM; nwg = nM * nN; G = G_; c = c_; }
    __host__ __device__ bool next(int i, Unit& u) const {
        const long L = (long)i * G + c; if (L >= nwg) return false;
        int wgid = (int)L; { const int q = nwg / NXCD, r = nwg % NXCD, xcd = wgid % NXCD, off = wgid / NXCD; wgid = (xcd < r ? xcd * (q + 1) : r * (q + 1) + (xcd - r) * q) + off; }
        const int nig = WGM * nN, gid = wgid / nig, fm = gid * WGM, gsz = (nM - fm) < WGM ? (nM - fm) : WGM;
        u.pm = fm + ((wgid % nig) % gsz); u.pn = (wgid % nig) / gsz; return true;
    }
    __device__ __forceinline__ void a_ready(const Unit&) const {}
    __device__ __forceinline__ void done(const Unit&) const {}
};


__device__ __forceinline__ unsigned cvt_pk_bf16(float lo, float hi) { unsigned r; asm volatile("v_cvt_pk_bf16_f32 %0, %1, %2" : "=v"(r) : "v"(lo), "v"(hi)); return r; }
struct EpiStoreBf16 {
    static constexpr bool PERM = true, AFTER_DRAIN = false;
    bf16_t* O; int ldc;
    __device__ __forceinline__ void operator()(const f32x4 (&acc)[2][2][4][2], const Unit& u, int wr, int wc, int fr, int fq) const {
        const int row0 = u.pm * BM + wr * 64 + fr, col0 = u.pn * BM + wc * 32 + 8 * fq;
#pragma unroll
        for (int ai = 0; ai < 2; ++ai)
#pragma unroll
            for (int m = 0; m < 4; ++m) { bf16_t* rowp = O + (size_t)(row0 + ai * HALF + m * 16) * ldc + col0;
#pragma unroll
                for (int bj = 0; bj < 2; ++bj) { const f32x4 v0 = acc[ai][bj][m][0], v1 = acc[ai][bj][m][1];
                    u32x4 w; w.x = cvt_pk_bf16(v0[0], v0[1]); w.y = cvt_pk_bf16(v0[2], v0[3]); w.z = cvt_pk_bf16(v1[0], v1[1]); w.w = cvt_pk_bf16(v1[2], v1[3]);
                    *(u32x4*)(rowp + bj * HALF) = w; } }
    }
};
__device__ __forceinline__ float lane_xor32(float y, bool upper) { const auto rr = __builtin_amdgcn_permlane32_swap(__builtin_bit_cast(unsigned, y), __builtin_bit_cast(unsigned, y), false, false); return __builtin_bit_cast(float, upper ? rr[0] : rr[1]); }
__device__ __forceinline__ float lane_xor16(float y, bool oddrow) { const auto rr = __builtin_amdgcn_permlane16_swap(__builtin_bit_cast(unsigned, y), __builtin_bit_cast(unsigned, y), false, false); return __builtin_bit_cast(float, oddrow ? rr[0] : rr[1]); }
struct EpiQKV {
    static constexpr bool PERM = true, AFTER_DRAIN = false;
    bf16_t* O; const float* qg; const float* kg;
    __device__ __forceinline__ void operator()(const f32x4 (&acc)[2][2][4][2], const Unit& u, int wr, int wc, int fr, int fq) const {
        int fro = fr, fqo = fq; asm volatile("" : "+v"(fro), "+v"(fqo));
        const int rbase = u.pm * BM + wr * 64 + fro;
        bf16_t* Ob = O + u.pn * 256 + wc * 64 + 8 * fqo;
        if (u.pn == 2 && wc >= 2) {
#pragma unroll
            for (int ai = 0; ai < 2; ++ai)
#pragma unroll
                for (int m = 0; m < 4; ++m) { bf16_t* rowp = Ob + (size_t)(rbase + ai * HALF + m * 16) * 768;
#pragma unroll
                    for (int bj = 0; bj < 2; ++bj) { const f32x4 v0 = acc[ai][bj][m][0], v1 = acc[ai][bj][m][1];
                        u32x4 w; w.x = cvt_pk_bf16(v0[0], v0[1]); w.y = cvt_pk_bf16(v0[2], v0[3]); w.z = cvt_pk_bf16(v1[0], v1[1]); w.w = cvt_pk_bf16(v1[2], v1[3]);
                        *(u32x4*)(rowp + bj * 32) = w; } }
            return;
        }
        const bool isq = u.pn < 2, second = fqo >= 2, oddrow = (fqo & 1) != 0;
        const float* gp = (isq ? qg : kg) + 8 * fqo;
        const float scale = isq ? 0.125f * 1.4426950408889634f : 1.0f;
        float g0[8], g1[8], inv[8];
#pragma unroll
        for (int e = 0; e < 8; ++e) { g0[e] = gp[e]; g1[e] = gp[32 + e]; inv[e] = ROPE_INV_REV[(fqo & 1) * 8 + e]; }
#pragma unroll
        for (int ai = 0; ai < 2; ++ai) {
            const float posr = (float)(((rbase + ai * HALF) & (SL - 1)) >> 6);
#pragma unroll
            for (int m = 0; m < 4; ++m) {
                const int row = rbase + ai * HALF + m * 16;
                const float posc = (float)(row & 63);
                float ss = 0.f;
#pragma unroll
                for (int e = 0; e < 4; ++e) ss += acc[ai][0][m][0][e] * acc[ai][0][m][0][e] + acc[ai][0][m][1][e] * acc[ai][0][m][1][e] + acc[ai][1][m][0][e] * acc[ai][1][m][0][e] + acc[ai][1][m][1][e] * acc[ai][1][m][1][e];
                ss += lane_xor16(ss, oddrow); ss += lane_xor32(ss, second);
                const float r = rsqrtf(ss * (1.0f / 64.0f) + EPS);
                u32x4 w0, w1;
#pragma unroll
                for (int ep = 0; ep < 4; ++ep) {
                    float o0[2], o1[2];
#pragma unroll
                    for (int q = 0; q < 2; ++q) {
                        const int e = 2 * ep + q;
                        const float y0 = acc[ai][0][m][e >> 2][e & 3] * r * g0[e], y1 = acc[ai][1][m][e >> 2][e & 3] * r * g1[e];
                        const float p0 = lane_xor32(y0, second), p1 = lane_xor32(y1, second);
                        const float a0 = posr * inv[e], a1 = posc * inv[e];
                        const float c0 = __builtin_amdgcn_cosf(a0), s0 = __builtin_amdgcn_sinf(a0), c1 = __builtin_amdgcn_cosf(a1), s1 = __builtin_amdgcn_sinf(a1);
                        o0[q] = (second ? (y0 * c0 + p0 * s0) : (y0 * c0 - p0 * s0)) * scale;
                        o1[q] = (second ? (y1 * c1 + p1 * s1) : (y1 * c1 - p1 * s1)) * scale;
                    }
                    w0[ep] = cvt_pk_bf16(o0[0], o0[1]); w1[ep] = cvt_pk_bf16(o1[0], o1[1]);
                    __builtin_amdgcn_sched_barrier(0);
                }
                bf16_t* rowp = Ob + (size_t)row * 768;
                *(u32x4*)(rowp) = w0; *(u32x4*)(rowp + 32) = w1;
                __builtin_amdgcn_sched_barrier(0);
            }
        }
    }
};
struct EpiQKV2 {
    static constexpr bool PERM = true, AFTER_DRAIN = true;
    bf16_t* O; const float* qg; const float* kg;
    __device__ __forceinline__ void operator()(const f32x4 (&)[2][2][4][2], const Unit&, int, int, int, int) const {}
    __device__ __forceinline__ void fused(const f32x4 (&acc)[2][2][4][2], const Unit& u, int wr, int wc, int fr, int fq, PG8_LAS unsigned char* lds, int wid, int lane) const {
        constexpr int PITCH = 528;
#pragma unroll
        for (int ai = 0; ai < 2; ++ai)
#pragma unroll
            for (int m = 0; m < 4; ++m) { PG8_LAS unsigned char* rowp = lds + (wr * 64 + fr + ai * HALF + m * 16) * PITCH + (wc * 32 + 8 * fq) * 2;
#pragma unroll
                for (int bj = 0; bj < 2; ++bj) { const f32x4 v0 = acc[ai][bj][m][0], v1 = acc[ai][bj][m][1];
                    u32x4 w; w.x = cvt_pk_bf16(v0[0], v0[1]); w.y = cvt_pk_bf16(v0[2], v0[3]); w.z = cvt_pk_bf16(v1[0], v1[1]); w.w = cvt_pk_bf16(v1[2], v1[3]);
                    *(PG8_LAS u32x4*)(rowp + bj * HALF * 2) = w; } }
        __syncthreads();
        const int cl = lane & 31, sub = cl & 7;
        const bool second = ((sub >> 1) & 1) != 0, colaxis = (sub >> 2) != 0;
        const bool isq = u.pn < 2, plainv = (u.pn == 2) && (cl >= 16);
        float gn[8], ir[8];
#pragma unroll
        for (int e = 0; e < 8; ++e) { gn[e] = (isq ? qg : kg)[sub * 8 + e]; ir[e] = (sub & 1) ? ROPE_INV_REV[8 + e] : ROPE_INV_REV[e]; }
        const float scale = isq ? 0.125f * 1.4426950408889634f : 1.0f;
#pragma unroll 2
        for (int it = 0; it < 16; ++it) {
            const int row = wid * 32 + it * 2 + (lane >> 5);
            const int t = u.pm * BM + row, l = t & (SL - 1);
            const float pos = colaxis ? (float)(l & 63) : (float)(l >> 6);
            float cs[8], sn[8];
#pragma unroll
            for (int e = 0; e < 8; ++e) { const float a = pos * ir[e]; cs[e] = __builtin_amdgcn_cosf(a); sn[e] = __builtin_amdgcn_sinf(a); }
            const u32x4 raw = *(const PG8_LAS u32x4*)(lds + row * PITCH + cl * 16);
            u32x4 o;
            qk_norm_rope8(raw, gn, cs, sn, second, scale, o);
            if (plainv) o = raw;
            *(u32x4*)(O + (size_t)t * 768 + u.pn * 256 + cl * 8) = o;
        }
        __syncthreads();
    }
};
template <bool BASE_BF16> struct EpiOutProjT {
    static constexpr bool PERM = true, AFTER_DRAIN = false;
    const void* base; bf16_t* XB; float* RS;
    __device__ __forceinline__ void operator()(const f32x4 (&acc)[2][2][4][2], const Unit& u, int wr, int wc, int fr, int fq) const {
        const int row0 = u.pm * BM + wr * 64 + fr, col0 = u.pn * BM + wc * 32 + 8 * fq;
#pragma unroll
        for (int ai = 0; ai < 2; ++ai)
#pragma unroll
            for (int m = 0; m < 4; ++m) { const int row = row0 + ai * HALF + m * 16; const size_t off = (size_t)row * 1024 + col0; float ss = 0.f;
#pragma unroll
                for (int bj = 0; bj < 2; ++bj) {
                    f32x4 b0, b1;
                    if (BASE_BF16) { const u32x4 bw = *(const u32x4*)((const bf16_t*)base + off + bj * HALF);
                        b0 = (f32x4){bflo(bw.x), bfhi(bw.x), bflo(bw.y), bfhi(bw.y)}; b1 = (f32x4){bflo(bw.z), bfhi(bw.z), bflo(bw.w), bfhi(bw.w)}; }
                    else { b0 = *(const f32x4*)((const float*)base + off + bj * HALF); b1 = *(const f32x4*)((const float*)base + off + bj * HALF + 4); }
                    const f32x4 v0 = acc[ai][bj][m][0] + b0, v1 = acc[ai][bj][m][1] + b1;
                    ss += (v0[0] * v0[0] + v0[1] * v0[1] + v0[2] * v0[2] + v0[3] * v0[3]) + (v1[0] * v1[0] + v1[1] * v1[1] + v1[2] * v1[2] + v1[3] * v1[3]);
                    u32x4 w; w.x = cvt_pk_bf16(v0[0], v0[1]); w.y = cvt_pk_bf16(v0[2], v0[3]); w.z = cvt_pk_bf16(v1[0], v1[1]); w.w = cvt_pk_bf16(v1[2], v1[3]);
                    *(u32x4*)(XB + off + bj * HALF) = w; }
                ss += __shfl_xor(ss, 16); ss += __shfl_xor(ss, 32);
                if (fq == 0) RS[(size_t)row * 16 + u.pn * 4 + wc] = ss; }
    }
};
struct EpiRowScaleF16 {
    static constexpr bool PERM = true, AFTER_DRAIN = false;
    _Float16* O; int ldc; const float* RS;
    __device__ __forceinline__ void operator()(const f32x4 (&acc)[2][2][4][2], const Unit& u, int wr, int wc, int fr, int fq) const {
        const int row0 = u.pm * BM + wr * 64 + fr, col0 = u.pn * BM + wc * 32 + 8 * fq;
        float tot[2][4];
#pragma unroll
        for (int ai = 0; ai < 2; ++ai)
#pragma unroll
            for (int m = 0; m < 4; ++m) { const f32x4 pr = *(const f32x4*)(RS + (size_t)(row0 + ai * HALF + m * 16) * 16 + 4 * fq); tot[ai][m] = (pr[0] + pr[1]) + (pr[2] + pr[3]); }
#pragma unroll
        for (int ai = 0; ai < 2; ++ai)
#pragma unroll
            for (int m = 0; m < 4; ++m) { const int row = row0 + ai * HALF + m * 16; const size_t off = (size_t)row * ldc + col0;
                float t = tot[ai][m]; t += __shfl_xor(t, 16); t += __shfl_xor(t, 32);
                const float r = rsqrtf(t * (1.0f / 1024.0f) + 1e-6f);
#pragma unroll
                for (int bj = 0; bj < 2; ++bj) { const f16x4 h0 = __builtin_convertvector(acc[ai][bj][m][0] * r, f16x4), h1 = __builtin_convertvector(acc[ai][bj][m][1] * r, f16x4);
                    *(f16x8*)(O + off + bj * HALF) = __builtin_shufflevector(h0, h1, 0, 1, 2, 3, 4, 5, 6, 7); } }
    }
};
struct EpiStoreF32 {
    static constexpr bool PERM = true, AFTER_DRAIN = false;
    const float* base; float* O; int ldc;
    __device__ __forceinline__ void operator()(const f32x4 (&acc)[2][2][4][2], const Unit& u, int wr, int wc, int fr, int fq) const {
        const int row0 = u.pm * BM + wr * 64 + fr, col0 = u.pn * BM + wc * 32 + 8 * fq;
#pragma unroll
        for (int ai = 0; ai < 2; ++ai)
#pragma unroll
            for (int m = 0; m < 4; ++m) { const size_t off = (size_t)(row0 + ai * HALF + m * 16) * ldc + col0;
#pragma unroll
                for (int bj = 0; bj < 2; ++bj)
#pragma unroll
                    for (int n = 0; n < 2; ++n) { f32x4 v = acc[ai][bj][m][n]; if (base) v += *(const f32x4*)(base + off + bj * HALF + n * 4); *(f32x4*)(O + off + bj * HALF + n * 4) = v; } }
    }
};

template <class Epi, class Sched, bool ALIGN_EPI = false, bool SP2 = false>
__device__ __forceinline__ void gemm_phase(PG8_LAS unsigned char* lds, const Gemm g, const Sched& S, const Epi& E) {
    const int tid = otid(), wid = __builtin_amdgcn_readfirstlane(tid >> 6), lane = tid & 63, wr = wid >> 2, wc = wid & 3, fr = lane & 15, fq = lane >> 4;
    const int K = g.K, nt = K / BK;
    unsigned voffA[2], voffB[2];
#pragma unroll
    for (int i = 0; i < 2; ++i) { int R, C; stage_rc(tid * 16 + i * 8192, R, C); const int Rb = Epi::PERM ? ((R & ~31) + perm32(R & 31)) : R;
        voffA[i] = (unsigned)(R * K + C) * 2u; voffB[i] = (unsigned)(Rb * K + C) * 2u; }
    const size_t kstep = (size_t)(BK * 2);
    const size_t hstep = (size_t)HALF * K * 2;
    const size_t tstep = 2 * hstep;
    const unsigned ldsw = (unsigned)wid * 1024u;
    const int aoff = lds_byte(wr * 64 + fr, fq * 8), boff = lds_byte(wc * 32 + fr, fq * 8);
#define PG8_SA(b, h) (((b) * 2 + (h)) * HTB)
#define PG8_SB(b, h) ((4 + (b) * 2 + (h)) * HTB)
#define PG8_STAGE(bufoff, gbase, voff) do { _Pragma("unroll") for (int _i = 0; _i < 2; ++_i) \
        __builtin_amdgcn_global_load_lds((const unsigned*)((const char*)(gbase) + (voff)[_i]), (PG8_LAS unsigned*)(lds + (bufoff) + ldsw + _i * 8192), 16, 0, 0); } while (0)
#define PG8_LDA(dst, b, h) do { _Pragma("unroll") for (int m = 0; m < 4; ++m) _Pragma("unroll") for (int k = 0; k < 2; ++k) dst[m][k] = *(const PG8_LAS bf16x8*)(lds + PG8_SA(b, h) + aoff + m * 2048 + k * 1024); } while (0)
#define PG8_LDB(dst, b, h) do { _Pragma("unroll") for (int n = 0; n < 2; ++n) _Pragma("unroll") for (int k = 0; k < 2; ++k) dst[n][k] = *(const PG8_LAS bf16x8*)(lds + PG8_SB(b, h) + boff + n * 2048 + k * 1024); } while (0)
#define PG8_MMA(ai, bj, At, Bt) do { __builtin_amdgcn_s_setprio(1); _Pragma("unroll") for (int m = 0; m < 4; ++m) _Pragma("unroll") for (int n = 0; n < 2; ++n) _Pragma("unroll") for (int k = 0; k < 2; ++k) \
        acc[ai][bj][m][n] = __builtin_amdgcn_mfma_f32_16x16x32_bf16(Bt[n][k], At[m][k], acc[ai][bj][m][n], 0, 0, 0); __builtin_amdgcn_s_setprio(0); } while (0)
#define PG8_WAIT_V(n) asm volatile("s_waitcnt vmcnt(" #n ")" ::: "memory")
#define PG8_WAIT_L(n) asm volatile("s_waitcnt lgkmcnt(" #n ")" ::: "memory")
#define PG8_BAR __builtin_amdgcn_s_barrier()
#define PG8_SCHED __builtin_amdgcn_sched_barrier(0)
    Unit cur, nxt; int ui = 0;
    if (!S.next(0, cur)) return;
    f32x4 acc[2][2][4][2];
#pragma unroll
    for (int a = 0; a < 2; ++a)
#pragma unroll
        for (int b = 0; b < 2; ++b)
#pragma unroll
            for (int m = 0; m < 4; ++m)
#pragma unroll
                for (int n = 0; n < 2; ++n) acc[a][b][m][n] = (f32x4){0.f, 0.f, 0.f, 0.f};
    bf16x8 At[4][2], B0[2][2], B1[2][2];
    const char* cA = (const char*)g.A + (size_t)cur.pm * tstep; const char* cB = (const char*)g.Bt + (size_t)cur.pn * tstep;
    S.a_ready(cur);
    if constexpr (SP2) {
        PG8_STAGE(PG8_SB(0, 0), cB, voffB); PG8_STAGE(PG8_SB(0, 1), cB + hstep, voffB); PG8_STAGE(PG8_SA(0, 0), cA, voffA); PG8_STAGE(PG8_SA(0, 1), cA + hstep, voffA);
        if (wr == 1) PG8_BAR;
        PG8_WAIT_V(2); PG8_BAR;
        PG8_STAGE(PG8_SB(1, 0), cB + kstep, voffB); PG8_STAGE(PG8_SA(1, 0), cA + kstep, voffA); PG8_STAGE(PG8_SB(1, 1), cB + hstep + kstep, voffB);
        PG8_WAIT_V(6); PG8_BAR;
    } else {
        PG8_STAGE(PG8_SB(0, 0), cB, voffB); PG8_STAGE(PG8_SA(0, 0), cA, voffA); PG8_STAGE(PG8_SB(0, 1), cB + hstep, voffB); PG8_STAGE(PG8_SA(0, 1), cA + hstep, voffA);
        if (wr == 1) PG8_BAR;
        PG8_WAIT_V(4); PG8_BAR;
        PG8_STAGE(PG8_SB(1, 0), cB + kstep, voffB); PG8_STAGE(PG8_SA(1, 0), cA + kstep, voffA); PG8_STAGE(PG8_SB(1, 1), cB + hstep + kstep, voffB);
        PG8_WAIT_V(6); PG8_BAR;
    }
    for (;;) {
        const bool has_next = S.next(ui + 1, nxt);
        const char* nA = has_next ? (const char*)g.A + (size_t)nxt.pm * tstep : cA; const char* nB = has_next ? (const char*)g.Bt + (size_t)nxt.pn * tstep : cB;
        for (int t = 0; t < nt; t += 2) {
            const bool last = (t == nt - 2);
            const char* a1 = cA + (size_t)(t + 1) * kstep;
            const char* a2 = last ? nA : cA + (size_t)(t + 2) * kstep; const char* b2 = last ? nB : cB + (size_t)(t + 2) * kstep;
            const char* a3 = a2 + kstep; const char* b3 = b2 + kstep;
            if (last && has_next) S.a_ready(nxt);
            if constexpr (SP2) {
            PG8_LDB(B0, 0, 0); PG8_LDB(B1, 0, 1); PG8_SCHED; PG8_LDA(At, 0, 0); PG8_STAGE(PG8_SA(1, 1), a1 + hstep, voffA);
            PG8_WAIT_V(8); PG8_WAIT_L(0); PG8_BAR; PG8_MMA(0, 0, At, B0); PG8_MMA(0, 1, At, B1); PG8_BAR; PG8_SCHED;
            PG8_LDA(At, 0, 1); PG8_STAGE(PG8_SB(0, 0), b2, voffB); PG8_STAGE(PG8_SB(0, 1), b2 + hstep, voffB); PG8_STAGE(PG8_SA(0, 0), a2, voffA);
            PG8_WAIT_V(8); PG8_WAIT_L(0); PG8_BAR; PG8_MMA(1, 0, At, B0); PG8_MMA(1, 1, At, B1); PG8_BAR; PG8_SCHED;
            PG8_LDB(B0, 1, 0); PG8_LDB(B1, 1, 1); PG8_SCHED; PG8_LDA(At, 1, 0); PG8_STAGE(PG8_SA(0, 1), a2 + hstep, voffA);
            PG8_WAIT_V(8); PG8_WAIT_L(0); PG8_BAR; PG8_MMA(0, 0, At, B0); PG8_MMA(0, 1, At, B1); PG8_BAR; PG8_SCHED;
            PG8_LDA(At, 1, 1); PG8_STAGE(PG8_SB(1, 0), b3, voffB); PG8_STAGE(PG8_SB(1, 1), b3 + hstep, voffB); PG8_STAGE(PG8_SA(1, 0), a3, voffA);
            PG8_WAIT_V(8); PG8_WAIT_L(0); PG8_BAR; PG8_MMA(1, 0, At, B0); PG8_MMA(1, 1, At, B1); PG8_BAR; PG8_SCHED;
            } else {
            PG8_LDB(B0, 0, 0); PG8_SCHED; PG8_LDA(At, 0, 0); PG8_STAGE(PG8_SA(1, 1), a1 + hstep, voffA);
            PG8_WAIT_L(8); PG8_BAR; PG8_WAIT_L(0); PG8_MMA(0, 0, At, B0); PG8_BAR; PG8_SCHED;
            PG8_LDB(B1, 0, 1); PG8_STAGE(PG8_SB(0, 0), b2, voffB);
            PG8_BAR; PG8_WAIT_L(0); PG8_MMA(0, 1, At, B1); PG8_BAR;
            PG8_LDA(At, 0, 1); PG8_STAGE(PG8_SA(0, 0), a2, voffA);
            PG8_BAR; PG8_WAIT_L(0); PG8_MMA(1, 0, At, B0); PG8_BAR; PG8_SCHED;
            PG8_STAGE(PG8_SB(0, 1), b2 + hstep, voffB);
            PG8_WAIT_V(6); PG8_BAR; PG8_MMA(1, 1, At, B1); PG8_BAR;
            PG8_LDB(B0, 1, 0); PG8_SCHED; PG8_LDA(At, 1, 0); PG8_STAGE(PG8_SA(0, 1), a2 + hstep, voffA);
            PG8_WAIT_L(8); PG8_BAR; PG8_WAIT_L(0); PG8_MMA(0, 0, At, B0); PG8_BAR; PG8_SCHED;
            PG8_LDB(B1, 1, 1); PG8_STAGE(PG8_SB(1, 0), b3, voffB);
            PG8_BAR; PG8_WAIT_L(0); PG8_MMA(0, 1, At, B1); PG8_BAR;
            PG8_LDA(At, 1, 1); PG8_STAGE(PG8_SA(1, 0), a3, voffA);
            PG8_BAR; PG8_WAIT_L(0); PG8_MMA(1, 0, At, B0); PG8_BAR; PG8_SCHED;
            PG8_STAGE(PG8_SB(1, 1), b3 + hstep, voffB);
            PG8_WAIT_V(6); PG8_BAR; PG8_MMA(1, 1, At, B1); PG8_BAR;
            }
        }
        if constexpr (ALIGN_EPI) { if (wr == 0) PG8_BAR; }
        if constexpr (!Epi::AFTER_DRAIN) { E(acc, cur, wr, wc, fr, fq); S.done(cur); }
        if (!has_next) break;
#pragma unroll
        for (int a = 0; a < 2; ++a)
#pragma unroll
            for (int b = 0; b < 2; ++b)
#pragma unroll
                for (int m = 0; m < 4; ++m)
#pragma unroll
                    for (int n = 0; n < 2; ++n) acc[a][b][m][n] = (f32x4){0.f, 0.f, 0.f, 0.f};
        cur = nxt; cA = nA; cB = nB; ++ui;
        if constexpr (ALIGN_EPI) { if (wr == 1) PG8_BAR; }
    }
    PG8_WAIT_V(0);
    if constexpr (!ALIGN_EPI) { if (wr == 0) PG8_BAR; }
    PG8_BAR;
    if constexpr (Epi::AFTER_DRAIN) { E.fused(acc, cur, wr, wc, fr, fq, lds, wid, lane); S.done(cur); }
#undef PG8_SA
#undef PG8_SB
#undef PG8_STAGE
#undef PG8_LDA
#undef PG8_LDB
#undef PG8_MMA
#undef PG8_WAIT_V
#undef PG8_WAIT_L
#undef PG8_BAR
#undef PG8_SCHED
}
}

__device__ __forceinline__ void qk_norm_rope8(const u32x4 raw, const float (&gn)[8], const float (&cs)[8], const float (&sn)[8], bool second, float scale, u32x4& out) {
    float x[8] = {bflo(raw.x), bfhi(raw.x), bflo(raw.y), bfhi(raw.y), bflo(raw.z), bfhi(raw.z), bflo(raw.w), bfhi(raw.w)};
    float ss = 0.f;
#pragma unroll
    for (int e = 0; e < 8; ++e) ss += x[e] * x[e];
    ss += __shfl_xor(ss, 1); ss += __shfl_xor(ss, 2); ss += __shfl_xor(ss, 4);
    const float r = rsqrtf(ss * (1.0f / 64.0f) + EPS) ;
    float o[8];
#pragma unroll
    for (int e = 0; e < 8; ++e) {
        const float y = x[e] * r * gn[e];
        const float other = __shfl_xor(y, 2);
        o[e] = (second ? (y * cs[e] + other * sn[e]) : (y * cs[e] - other * sn[e])) * scale;
    }
    out.x = pk2(o[0], o[1]); out.y = pk2(o[2], o[3]); out.z = pk2(o[4], o[5]); out.w = pk2(o[6], o[7]);
}
__device__ __forceinline__ void phase_qkprep(const Params& p, int layer, char* lds, bf16_t* qout) {
    const int tid = otid(), lane = tid & 63, wave = tid >> 6;
    const bf16_t* qkv = (const bf16_t*)(p.ws + R_QKV);
    const int sub = lane & 7;
    const bool second = ((sub >> 1) & 1) != 0, colaxis = (sub >> 2) != 0;
    float gq[8], gk[8], ir[8];
#pragma unroll
    for (int e = 0; e < 8; ++e) {
        gq[e] = p.in[I_QG][layer * 64 + sub * 8 + e]; gk[e] = p.in[I_KG][layer * 64 + sub * 8 + e];
        ir[e] = (sub & 1) ? ROPE_INV_REV[8 + e] : ROPE_INV_REV[e];
    }
    const int gw = obid() * NWAVE + wave, ngw = NBLK * NWAVE;
    for (int t = gw; t < T; t += ngw) {
        const int l = t & (SL - 1);
        const float pos = colaxis ? (float)(l & 63) : (float)(l >> 6);
        float cs[8], sn[8];
#pragma unroll
        for (int e = 0; e < 8; ++e) { const float a = pos * ir[e]; cs[e] = __builtin_amdgcn_cosf(a); sn[e] = __builtin_amdgcn_sinf(a); }
        const u32x4 rq = *(const u32x4*)(qkv + (size_t)t * 768 + lane * 8);
        u32x4 rk = {0u, 0u, 0u, 0u};
        if (lane < 16) rk = *(const u32x4*)(qkv + (size_t)t * 768 + 512 + lane * 8);
        u32x4 oq, ok;
        qk_norm_rope8(rq, gq, cs, sn, second, 0.125f * 1.4426950408889634f, oq);
        qk_norm_rope8(rk, gk, cs, sn, second, 1.0f, ok);
        *(u32x4*)(qout + (size_t)t * 768 + lane * 8) = oq;
        if (lane < 16) *(u32x4*)(qout + (size_t)t * 768 + 512 + lane * 8) = ok;
    }
}

#include <hip/hip_bf16.h>
#include <cmath>
namespace attn_body {
using bf16=__hip_bfloat16;
using bf16x8=__attribute__((ext_vector_type(8)))short;
using s16x4=__attribute__((ext_vector_type(4)))short;
using f32x16=__attribute__((ext_vector_type(16)))float;
using u32x4=__attribute__((ext_vector_type(4)))unsigned;
constexpr int SEQ=8192,D=64,PQ=768,PO=512;
constexpr int NW=8,QBLK=32,QB=QBLK*NW,KVBLK=64,NQB=SEQ/QB;
constexpr int ATTN_UNIT_ROWS=QB;
__device__ __forceinline__ int crow(int r,int hi){return (r&3)+8*(r>>2)+4*hi;}
#define SBAR() __builtin_amdgcn_sched_barrier(0)
__device__ __forceinline__ void cmask(f32x16&p0,f32x16&p1,int jb,int qrel,int hi){
  const float NEG=-INFINITY; int kb=64*jb+4*hi;
  #pragma unroll
  for(int r=0;r<16;++r){int kv=kb+(r&3)+8*(r>>2); if(kv>qrel)p0[r]=NEG; if(kv+32>qrel)p1[r]=NEG;}
}

constexpr int NSLOT=3, SLOTB=8192;
constexpr int LDS_K=0, LDS_V=NSLOT*SLOTB, LDS_WS=2*NSLOT*SLOTB, LDS_OST=LDS_WS+NW*64*4, LDS_BYTES=LDS_OST+NW*4096;
constexpr float C2=0.125f*1.4426950408889634f;
__device__ __forceinline__ void glds16(const void*gsrc,unsigned lds_dst){unsigned keep;
  asm volatile("s_mov_b32 %0, m0\n\ts_mov_b32 m0, %2\n\ts_nop 0\n\tglobal_load_lds_dwordx4 %1, off\n\ts_mov_b32 m0, %0":"=&s"(keep):"v"(gsrc),"s"(lds_dst):"memory");}
__device__ __forceinline__ float max3f(float a,float b,float c){float r;asm("v_max3_f32 %0, %1, %2, %3":"=v"(r):"v"(a),"v"(b),"v"(c));return r;}
__device__ __forceinline__ float max2f(float a,float b){float r;asm("v_max_f32_e32 %0, %1, %2":"=v"(r):"v"(a),"v"(b));return r;}
__device__ __forceinline__ float fadd_s(float a,float b){float r;asm("v_add_f32_e32 %0, %1, %2":"=v"(r):"v"(a),"v"(b));return r;}
__device__ __forceinline__ float fsub_s(float a,float b){float r;asm("v_sub_f32_e32 %0, %1, %2":"=v"(r):"v"(a),"v"(b));return r;}
typedef float f32x2_t __attribute__((ext_vector_type(2))); typedef __bf16 bf16x2_t __attribute__((ext_vector_type(2)));
__device__ __forceinline__ unsigned cvtpk_s(float lo,float hi){f32x2_t v={lo,hi};bf16x2_t b=__builtin_convertvector(v,bf16x2_t);return __builtin_bit_cast(unsigned,b);}
#define WAIT_BAR(N) asm volatile("s_waitcnt vmcnt(" #N ") lgkmcnt(0)\n\ts_barrier":::"memory")

__device__ __forceinline__ void qkt(f32x16&p0,f32x16&p1,const char*Kslot,const bf16x8*qr,const f32x16&negm,int r32,int hi){
  const char*kb=Kslot+hi*1024+r32*16;
  #pragma unroll
  for(int d0=0;d0<4;++d0){
    const bf16x8 b0=*reinterpret_cast<const bf16x8*>(kb+d0*2048);
    const bf16x8 b1=*reinterpret_cast<const bf16x8*>(kb+d0*2048+512);
    if(d0==0){p0=__builtin_amdgcn_mfma_f32_32x32x16_bf16(b0,qr[0],negm,0,0,0);p1=__builtin_amdgcn_mfma_f32_32x32x16_bf16(b1,qr[0],negm,0,0,0);}
    else{p0=__builtin_amdgcn_mfma_f32_32x32x16_bf16(b0,qr[d0],p0,0,0,0);p1=__builtin_amdgcn_mfma_f32_32x32x16_bf16(b1,qr[d0],p1,0,0,0);}}
}
typedef __attribute__((address_space(3))) const char* lds_cptr;
typedef short v4i16_t __attribute__((ext_vector_type(4)));
__device__ __forceinline__ void kload8(bf16x8*kf,lds_cptr kp){
  kf[0]=*(const __attribute__((address_space(3))) bf16x8*)(kp);      kf[1]=*(const __attribute__((address_space(3))) bf16x8*)(kp+512);
  kf[2]=*(const __attribute__((address_space(3))) bf16x8*)(kp+2048); kf[3]=*(const __attribute__((address_space(3))) bf16x8*)(kp+2560);
  kf[4]=*(const __attribute__((address_space(3))) bf16x8*)(kp+4096); kf[5]=*(const __attribute__((address_space(3))) bf16x8*)(kp+4608);
  kf[6]=*(const __attribute__((address_space(3))) bf16x8*)(kp+6144); kf[7]=*(const __attribute__((address_space(3))) bf16x8*)(kp+6656);
}
__device__ __forceinline__ void kload2(bf16x8*kf,lds_cptr kp,int j){ kf[2*j]=*(const __attribute__((address_space(3))) bf16x8*)(kp+j*2048); kf[2*j+1]=*(const __attribute__((address_space(3))) bf16x8*)(kp+j*2048+512); }
__device__ __forceinline__ s16x4 vtr(lds_cptr p){ return __builtin_bit_cast(s16x4,__builtin_amdgcn_ds_read_tr16_b64_v4i16((__attribute__((address_space(3))) v4i16_t*)p)); }
__device__ __forceinline__ float rowmax(const f32x16&p0,const f32x16&p1){
  float a=max3f(p0[0],p0[1],p1[0]),b=max3f(p0[2],p0[3],p1[1]);a=max3f(a,p1[2],p1[3]);
  #pragma unroll
  for(int r=4;r<16;r+=4){a=max3f(a,p0[r],p0[r+1]);b=max3f(b,p0[r+2],p0[r+3]);a=max3f(a,p1[r],p1[r+1]);b=max3f(b,p1[r+2],p1[r+3]);}
  const float m=max2f(a,b);
  auto rr=__builtin_amdgcn_permlane32_swap(__float_as_uint(m),__float_as_uint(m),false,false);
  return max2f(__uint_as_float(rr[0]),__uint_as_float(rr[1]));
}
__device__ __forceinline__ void pv(f32x16*o,int vb,bf16x8 pa0,bf16x8 pa1,bf16x8 pa2,bf16x8 pa3){
  #pragma unroll
  for(int d0=0;d0<2;++d0){s16x4 lo[4],hi[4];
    #pragma unroll
    for(int ks=0;ks<4;++ks){
      asm volatile("ds_read_b64_tr_b16 %0,%1 offset:%c2":"=&v"(lo[ks]):"v"(vb),"i"(d0*4096+ks*1024):"memory");
      asm volatile("ds_read_b64_tr_b16 %0,%1 offset:%c2":"=&v"(hi[ks]):"v"(vb),"i"(d0*4096+ks*1024+512):"memory");}
    asm volatile("s_waitcnt lgkmcnt(0)":::"memory");SBAR();
    #define PK(k) (bf16x8){lo[k][0],lo[k][1],lo[k][2],lo[k][3],hi[k][0],hi[k][1],hi[k][2],hi[k][3]}
    o[d0]=__builtin_amdgcn_mfma_f32_32x32x16_bf16(pa0,PK(0),o[d0],0,0,0);
    o[d0]=__builtin_amdgcn_mfma_f32_32x32x16_bf16(pa1,PK(1),o[d0],0,0,0);
    o[d0]=__builtin_amdgcn_mfma_f32_32x32x16_bf16(pa2,PK(2),o[d0],0,0,0);
    o[d0]=__builtin_amdgcn_mfma_f32_32x32x16_bf16(pa3,PK(3),o[d0],0,0,0);
    #undef PK
  }
}

#ifndef ATTN_STORE16
#define ATTN_STORE16(p,v) (*(u32x4*)(p)=(v))
#endif
template<int THRL,bool FIXED> __device__ __forceinline__ void attn_unit(int b,int h,int g,int qb,const bf16*Q,const bf16*__restrict__ K,const bf16*__restrict__ V,bf16*O,char*shm,float mfix){
  const int tid=otid(),lane=tid&63,r32=lane&31,hi=lane>>5; const int wid=__builtin_amdgcn_readfirstlane(tid>>6);
  const long rowbase=(long)b*SEQ; const int q0=qb*QB;
  const bf16*Qw=Q+(rowbase+q0+wid*QBLK)*PQ+h*D;
  const bf16*Kh=K+rowbase*PQ+g*D,*Vh=V+rowbase*PQ+g*D;
  const unsigned lds0=(unsigned)(uintptr_t)shm;
  float*wsf=(float*)(shm+LDS_WS)+wid*64;
  const bf16*ksrc=Kh+(long)lane*PQ+wid*8;
  const bf16*vsrc=Vh+(long)(16*(wid&3)+(lane>>2))*PQ+(wid>>2)*32+(lane&3)*8;
  const unsigned kdst=lds0+LDS_K+wid*1024, vdst=lds0+LDS_V+wid*1024;
  #define DMA_K(t,slot) glds16(ksrc+(long)(t)*KVBLK*PQ,(unsigned)__builtin_amdgcn_readfirstlane(kdst+(slot)))
  #define DMA_V(t,slot) glds16(vsrc+(long)(t)*KVBLK*PQ,(unsigned)__builtin_amdgcn_readfirstlane(vdst+(slot)))
  const int vb0=(int)(lds0+LDS_V)+((lane>>4)&1)*32+(lane&3)*8+(4*hi+((lane&15)>>2))*64;
  const char*Kbase=shm+LDS_K; bf16x8 kf[8];
  const lds_cptr shm3=(lds_cptr)shm; const lds_cptr kp0=shm3+LDS_K+hi*1024+r32*16; const lds_cptr vp0=shm3+LDS_V+((lane>>4)&1)*32+(lane&3)*8+(4*hi+((lane&15)>>2))*64;
  constexpr int NT=SEQ/KVBLK;
  DMA_K(0,0);DMA_V(0,0);DMA_K(1,SLOTB);
  bf16x8 qr[4];
  #pragma unroll
  for(int d0=0;d0<4;++d0)qr[d0]=*reinterpret_cast<const bf16x8*>(&Qw[(long)r32*PQ+d0*16+hi*8]);
  float mhat=0.f,l_reg=0.f;f32x16 o[2];o[0]=f32x16{};o[1]=f32x16{};f32x16 negm=f32x16{};asm volatile("":"+v"(negm));
    #define CMASK(P0,P1,t) do{}while(0)
  bool resc=false;
  #define START(P0,P1) do{ const float rm=FIXED?mfix:rowmax(P0,P1); resc=false; \
    { const float dl=rm; mhat=fadd_s(mhat,dl); \
      _Pragma("unroll") for(int r=0;r<16;++r){P0[r]=fsub_s(P0[r],dl);P1[r]=fsub_s(P1[r],dl);} \
      _Pragma("unroll") for(int r=0;r<16;++r)negm[r]=-mhat; asm volatile("":"+v"(negm)); } \
    _Pragma("unroll") for(int r=0;r<16;++r)P0[r]=__builtin_amdgcn_exp2f(P0[r]); }while(0)
  #define RESC() do{ if(resc){ asm volatile("s_waitcnt lgkmcnt(0)":::"memory"); \
      _Pragma("unroll") for(int d_=0;d_<2;++d_) _Pragma("unroll") for(int r=0;r<16;++r)o[d_][r]*=wsf[crow(r,hi)]; } }while(0)
  f32x16 pA0,pA1,pB0,pB1;
  int sl_prev=0,sl_cur=0,sl_next=SLOTB;
  #define ROT() do{sl_prev=sl_cur;sl_cur=sl_next;sl_next=(sl_next==(NSLOT-1)*SLOTB)?0:sl_next+SLOTB;}while(0)
  DMA_K(2,2*SLOTB);
  WAIT_BAR(3);
  qkt(pA0,pA1,Kbase,qr,negm,r32,hi);asm volatile("s_nop 15\n\ts_nop 7":"+v"(pA0),"+v"(pA1));CMASK(pA0,pA1,0);
  START(pA0,pA1);
  _Pragma("unroll") for(int r=0;r<16;++r)pA1[r]=__builtin_amdgcn_exp2f(pA1[r]);
  WAIT_BAR(0);
  DMA_K(3,0);DMA_V(1,SLOTB);
  ROT();
  kload8(kf,kp0+sl_cur);
  WAIT_BAR(2);
  s16x4 vlo[8],vhi[8]; u32x4 pw0,pw1,pw2,pw3;
  #define PKW(P,B) cvtpk_s(P[B],P[B+1])
  #define PAF(k) __builtin_bit_cast(bf16x8,pw##k)
  #define VFR(i) (bf16x8){vlo[i][0],vlo[i][1],vlo[i][2],vlo[i][3],vhi[i][0],vhi[i][1],vhi[i][2],vhi[i][3]}
  #define PIN(x) asm volatile("":"+v"(x))
  #define MX3(a,b,c) __builtin_fmaxf(__builtin_fmaxf((a),(b)),(c))
  #define GAPA(MF,A0,A1,A2,A3,W0,W1,PW) do{ MF; sacc+=A0; sacc+=A1; sacc+=A2; sacc+=A3; PIN(sacc); W0; W1; PIN(PW); SBAR(); }while(0)
  #define EX(v) __builtin_amdgcn_exp2f(v)
  #define GAPB(MF,X,B) do{ MF; X[B]=EX(X[B]); X[B+1]=EX(X[B+1]); X[B+2]=EX(X[B+2]); X[B+3]=EX(X[B+3]); PIN(X); SBAR(); }while(0)
  #define VRD(i) do{ vlo[i]=vtr(vp_+(((i)>>2)*4096+((i)&3)*1024)); vhi[i]=vtr(vp_+(((i)>>2)*4096+((i)&3)*1024+512)); }while(0)
  #define KRD(G,j) do{ if(G){ kload2(kf,kp0+sl_next,j); SBAR(); } }while(0)
  #define STEP(C0,C1,P0,P1,t,GK,GV,GL) do{ SBAR(); \
    const lds_cptr vp_=vp0+sl_prev; \
    VRD(0); SBAR(); float sacc=(P0[0]+P0[1]); \
    GAPA(C0=__builtin_amdgcn_mfma_f32_32x32x16_bf16(kf[0],qr[0],negm,0,0,0), P0[2],P0[3],P0[4],P0[5],     pw0[0]=PKW(P0,0), pw0[1]=PKW(P0,2), pw0); \
    VRD(4); SBAR(); GAPA(C1=__builtin_amdgcn_mfma_f32_32x32x16_bf16(kf[1],qr[0],negm,0,0,0), P0[6],P0[7],P0[8],P0[9],     pw0[2]=PKW(P0,4), pw0[3]=PKW(P0,6), pw0); \
    VRD(1); SBAR(); GAPA(C0=__builtin_amdgcn_mfma_f32_32x32x16_bf16(kf[2],qr[1],C0,0,0,0),   P0[10],P0[11],P0[12],P0[13], pw1[0]=PKW(P0,8), pw1[1]=PKW(P0,10), pw1); \
    VRD(5); SBAR(); GAPA(C1=__builtin_amdgcn_mfma_f32_32x32x16_bf16(kf[3],qr[1],C1,0,0,0),   P0[14],P0[15],P1[0],P1[1],   pw1[2]=PKW(P0,12),pw1[3]=PKW(P0,14), pw1); \
    VRD(2); SBAR(); GAPA(C0=__builtin_amdgcn_mfma_f32_32x32x16_bf16(kf[4],qr[2],C0,0,0,0),   P1[2],P1[3],P1[4],P1[5],     pw2[0]=PKW(P1,0), pw2[1]=PKW(P1,2), pw2); \
    VRD(6); SBAR(); GAPA(C1=__builtin_amdgcn_mfma_f32_32x32x16_bf16(kf[5],qr[2],C1,0,0,0),   P1[6],P1[7],P1[8],P1[9],     pw2[2]=PKW(P1,4), pw2[3]=PKW(P1,6), pw2); \
    VRD(3); SBAR(); GAPA(C0=__builtin_amdgcn_mfma_f32_32x32x16_bf16(kf[6],qr[3],C0,0,0,0),   P1[10],P1[11],P1[12],P1[13], pw3[0]=PKW(P1,8), pw3[1]=PKW(P1,10), pw3); \
    VRD(7); SBAR(); GAPA(C1=__builtin_amdgcn_mfma_f32_32x32x16_bf16(kf[7],qr[3],C1,0,0,0),   P1[14],P1[15],0.f,0.f,       pw3[2]=PKW(P1,12),pw3[3]=PKW(P1,14), pw3); \
    l_reg+=sacc; \
    if(GK){DMA_K((t)+3,sl_cur);} if(GV){DMA_V((t)+1,sl_next);} \
    CMASK(C0,C1,t); \
    if(!FIXED){ float a=MX3(C0[0],C0[1],C1[0]),b=MX3(C0[2],C0[3],C1[1]); a=MX3(a,C1[2],C1[3]); \
      _Pragma("unroll") for(int r=4;r<16;r+=4){a=MX3(a,C0[r],C0[r+1]);b=MX3(b,C0[r+2],C0[r+3]);a=MX3(a,C1[r],C1[r+1]);b=MX3(b,C1[r+2],C1[r+3]);} \
      float rm=__builtin_fmaxf(a,b); { auto rr=__builtin_amdgcn_permlane32_swap(__float_as_uint(rm),__float_as_uint(rm),false,false); rm=__builtin_fmaxf(__uint_as_float(rr[0]),__uint_as_float(rr[1])); } \
      resc=false; \
      if(__builtin_expect(__any(rm>(float)THRL),0)){ const float dl=__builtin_fmaxf(rm,0.f); mhat+=dl; \
        _Pragma("unroll") for(int r=0;r<16;++r){C0[r]-=dl;C1[r]-=dl;} \
        _Pragma("unroll") for(int r=0;r<16;++r)negm[r]=-mhat; asm volatile("":"+v"(negm)); \
        const float f=__builtin_amdgcn_exp2f(-dl); l_reg*=f; if(hi==0)wsf[r32]=f; resc=true; } } \
    SBAR(); \
    GAPB(o[0]=__builtin_amdgcn_mfma_f32_32x32x16_bf16(PAF(0),VFR(0),o[0],0,0,0), C0,0); \
    GAPB(o[1]=__builtin_amdgcn_mfma_f32_32x32x16_bf16(PAF(0),VFR(4),o[1],0,0,0), C0,4); \
    KRD(GL,0); GAPB(o[0]=__builtin_amdgcn_mfma_f32_32x32x16_bf16(PAF(1),VFR(1),o[0],0,0,0), C0,8); \
    KRD(GL,1); GAPB(o[1]=__builtin_amdgcn_mfma_f32_32x32x16_bf16(PAF(1),VFR(5),o[1],0,0,0), C0,12); \
    KRD(GL,2); GAPB(o[0]=__builtin_amdgcn_mfma_f32_32x32x16_bf16(PAF(2),VFR(2),o[0],0,0,0), C1,0); \
    KRD(GL,3); GAPB(o[1]=__builtin_amdgcn_mfma_f32_32x32x16_bf16(PAF(2),VFR(6),o[1],0,0,0), C1,4); \
    GAPB(o[0]=__builtin_amdgcn_mfma_f32_32x32x16_bf16(PAF(3),VFR(3),o[0],0,0,0), C1,8); \
    GAPB(o[1]=__builtin_amdgcn_mfma_f32_32x32x16_bf16(PAF(3),VFR(7),o[1],0,0,0), C1,12); \
    }while(0)
  int t=1;
  #undef CMASK
  #define CMASK(P0,P1,t) do{}while(0)
  for(;t+5<NT;t+=2){
    STEP(pB0,pB1,pA0,pA1,t,true,true,true);     WAIT_BAR(2); RESC(); ROT();
    STEP(pA0,pA1,pB0,pB1,t+1,true,true,true);   WAIT_BAR(2); RESC(); ROT();
  }
  #define ENDW(tt) do{ if((tt)+3<NT){WAIT_BAR(2);} else if((tt)+2<NT){WAIT_BAR(1);} else {WAIT_BAR(0);} }while(0)
  for(;t+1<NT;t+=2){
    STEP(pB0,pB1,pA0,pA1,t,(t+3<NT),(t+1<NT),(t+1<NT));       ENDW(t);   RESC(); ROT();
    STEP(pA0,pA1,pB0,pB1,t+1,(t+4<NT),(t+2<NT),(t+2<NT));     ENDW(t+1); RESC(); ROT();
  }
  STEP(pB0,pB1,pA0,pA1,NT-1,false,false,false); RESC();
  { float sacc=pB0[0]+pB0[1]; _Pragma("unroll") for(int r=2;r<16;++r)sacc+=pB0[r]; _Pragma("unroll") for(int r=0;r<16;++r)sacc+=pB1[r]; l_reg+=sacc;
    pw0=(u32x4){PKW(pB0,0),PKW(pB0,2),PKW(pB0,4),PKW(pB0,6)};pw1=(u32x4){PKW(pB0,8),PKW(pB0,10),PKW(pB0,12),PKW(pB0,14)};pw2=(u32x4){PKW(pB1,0),PKW(pB1,2),PKW(pB1,4),PKW(pB1,6)};pw3=(u32x4){PKW(pB1,8),PKW(pB1,10),PKW(pB1,12),PKW(pB1,14)};
    SBAR(); pv(o,vb0+sl_cur,PAF(0),PAF(1),PAF(2),PAF(3)); }
  #undef PKW
  #undef PAF
  #undef VFR
  #undef PIN
  #undef MX3
  #undef GAPA
  #undef GAPB
  #undef EX
  #undef VRD
  #undef KRD
  #undef STEP
  #undef ENDW
  {auto rr=__builtin_amdgcn_permlane32_swap(__float_as_uint(l_reg),__float_as_uint(l_reg),false,false);l_reg=__uint_as_float(rr[0])+__uint_as_float(rr[1]);}
  if(hi==0)wsf[32+r32]=l_reg;asm volatile("s_waitcnt lgkmcnt(0)":::"memory");
  float rli[16];
  #pragma unroll
  for(int r=0;r<16;++r)rli[r]=__builtin_amdgcn_rcpf(wsf[32+crow(r,hi)]);
  bf16*Ow=O+(rowbase+q0+wid*QBLK)*PO+h*D;
  { bf16*stg=(bf16*)(shm+LDS_OST)+wid*2048;
    #pragma unroll
    for(int r=0;r<16;++r){const int orow=crow(r,hi);
      #pragma unroll
      for(int d0=0;d0<2;++d0)stg[orow*64+d0*32+r32]=__float2bfloat16(o[d0][r]*rli[r]);}
    asm volatile("s_waitcnt lgkmcnt(0)":::"memory");
    #pragma unroll
    for(int i=0;i<4;++i){const int row=i*8+(lane>>3),ch=lane&7; const u32x4 v=*(const u32x4*)(stg+row*64+ch*8); ATTN_STORE16(Ow+(long)row*PO+ch*8,v);} }
  asm volatile("s_waitcnt lgkmcnt(0)\n\ts_barrier":::"memory");
  #undef DMA_K
  #undef DMA_V
  #undef CMASK
  #undef START
  #undef RESC
  #undef ROT
}
constexpr int ATTN_LDS_BYTES=LDS_BYTES;
#undef SBAR
#undef WAIT_BAR
}

__device__ __forceinline__ void phase_attn(const Params& p, int layer, char* lds, int kbeg, int kend) {
    const int lane = otid() & 63;
    const float mq = wave_max(fabsf(p.in[I_QG][layer * 64 + lane])), mk = wave_max(fabsf(p.in[I_KG][layer * 64 + lane]));
    const float mfix = 64.0f * mq * mk * (0.125f * 1.4426950408889634f) * 1.02f;
    const bool fixed_ok = mfix < 48.0f;
    const int bid = obid();
    const int vcu = ((NBLK & 7) == 0) ? (bid & 7) * (int)(NBLK >> 3) + (bid >> 3) : bid;
    const attn_body::bf16* qkvb = (const attn_body::bf16*)(p.ws + R_QKV);
    for (int u = vcu + kbeg * NBLK; u < 512 && u < vcu + kend * NBLK; u += NBLK) {
        const int bg = (u & 255) >> 6, r = u & 63, hh = r & 3, qb = (r >> 2) + 16 * (u >> 8);
        const int b = bg >> 1, g = bg & 1;
        if (fixed_ok) attn_body::attn_unit<8, true>(b, 4 * g + hh, g, qb, qkvb, qkvb + 512, qkvb + 640, (attn_body::bf16*)(p.ws + R_ATT), lds, mfix);
        else attn_body::attn_unit<8, false>(b, 4 * g + hh, g, qb, qkvb, qkvb + 512, qkvb + 640, (attn_body::bf16*)(p.ws + R_ATT), lds, 0.f);
    }
}

__device__ __forceinline__ size_t cidx(int c, int t) { return ((size_t)(t >> 5) * 256 + c) * 32 + (t & 31); }
__device__ __forceinline__ f32x4 convd4(const float* row, int l0, float w0, float w1, float w2, float cb) {
    const f32x4 c = *(const f32x4*)(row + l0);
    const float lft = (l0 > 0) ? row[l0 - 1] : 0.f;
    const float rgt = (l0 + 4 < SL) ? row[l0 + 4] : 0.f;
    f32x4 o;
    o.x = cb + w0 * lft + w1 * c.x + w2 * c.y;
    o.y = cb + w0 * c.x + w1 * c.y + w2 * c.z;
    o.z = cb + w0 * c.y + w1 * c.z + w2 * c.w;
    o.w = cb + w0 * c.z + w1 * c.w + w2 * rgt;
    return o;
}
__device__ __forceinline__ void cmul_kf(float2* Z, const float2* KF, int tid) {
#pragma unroll 4
    for (int i = 0; i < 16; ++i) {
        const int pp = 2 * tid + 1024 * i;
        const f32x4 z = *(const f32x4*)(Z + zp(pp)), k = *(const f32x4*)(KF + pp);
        f32x4 o; o.x = z.x * k.x - z.y * k.y; o.y = z.x * k.y + z.y * k.x; o.z = z.z * k.z - z.w * k.w; o.w = z.z * k.w + z.w * k.z;
        *(f32x4*)(Z + zp(pp)) = o;
    }
}
__device__ __forceinline__ void hyena_job(const Params& p, int layer, int c, char* lds) {
    const int tid = otid();
    float2* Z = (float2*)lds;
    const float* HF = (const float*)(p.ws + R_HF);
    const float* cw = p.in[I_CW] + (size_t)layer * 3 * 768; const float* cbp = p.in[I_CB] + layer * 768;
    const float2* KF0 = (const float2*)(p.ws + OFF_KF) + ((size_t)(layer * 256 + c) * 2) * 16384;
    const float2* KF1 = KF0 + 16384;
    _Float16* Yb = (_Float16*)(p.ws + R_Y);
    const int cv = c, c1 = 256 + c, c2 = 512 + c;
    const float* rv = HF + (size_t)cv * T; const float* r1 = HF + (size_t)c1 * T; const float* r2 = HF + (size_t)c2 * T;
    const float v_w0 = cw[cv], v_w1 = cw[768 + cv], v_w2 = cw[1536 + cv], v_cb = cbp[cv];
    const float a_w0 = cw[c1], a_w1 = cw[768 + c1], a_w2 = cw[1536 + c1], a_cb = cbp[c1];
    const float b_w0 = cw[c2], b_w1 = cw[768 + c2], b_w2 = cw[1536 + c2], b_cb = cbp[c2];
    const f32x4 zero4 = {0.f, 0.f, 0.f, 0.f};
    __syncthreads();
#pragma unroll 2
    for (int i = 0; i < 4; ++i) {
        const int l0 = 4 * otid() + 2048 * i;
        const f32x4 va = convd4(rv, l0, v_w0, v_w1, v_w2, v_cb), vb = convd4(rv + SL, l0, v_w0, v_w1, v_w2, v_cb);
        *(f32x4*)(Z + zp(l0)) = (f32x4){va.x, vb.x, va.y, vb.y}; *(f32x4*)(Z + zp(l0) + 2) = (f32x4){va.z, vb.z, va.w, vb.w};
        *(f32x4*)(Z + zp(8192 + l0)) = zero4; *(f32x4*)(Z + zp(8192 + l0) + 2) = zero4;
    }
    __syncthreads();
    fft16k_fwd(Z);
    cmul_kf(Z, KF0, otid());
    __syncthreads();
    fft16k_inv(Z);
#pragma unroll 2
    for (int i = 0; i < 4; ++i) {
        const int l0 = 4 * otid() + 2048 * i;
        const f32x4 za = *(const f32x4*)(Z + zp(l0)), zb = *(const f32x4*)(Z + zp(l0) + 2);
        const f32x4 ga = convd4(r1, l0, a_w0, a_w1, a_w2, a_cb), gb = convd4(r1 + SL, l0, a_w0, a_w1, a_w2, a_cb);
        *(f32x4*)(Z + zp(l0)) = (f32x4){ga.x * za.x, gb.x * za.y, ga.y * za.z, gb.y * za.w};
        *(f32x4*)(Z + zp(l0) + 2) = (f32x4){ga.z * zb.x, gb.z * zb.y, ga.w * zb.z, gb.w * zb.w};
        *(f32x4*)(Z + zp(8192 + l0)) = zero4; *(f32x4*)(Z + zp(8192 + l0) + 2) = zero4;
    }
    __syncthreads();
    fft16k_fwd(Z);
    cmul_kf(Z, KF1, otid());
    __syncthreads();
    fft16k_inv(Z);
#pragma unroll 1
    for (int i = 0; i < 2; ++i) {
        const int l0 = 8 * otid() + 4096 * i;
        f16x4 ha[2], hb[2];
#pragma unroll
        for (int q = 0; q < 2; ++q) {
            const int lq = l0 + 4 * q;
            const f32x4 za = *(const f32x4*)(Z + zp(lq)), zb = *(const f32x4*)(Z + zp(lq) + 2);
            const f32x4 ga = convd4(r2, lq, b_w0, b_w1, b_w2, b_cb), gb = convd4(r2 + SL, lq, b_w0, b_w1, b_w2, b_cb);
            f32x4 ya, yb;
            ya.x = ga.x * za.x; ya.y = ga.y * za.z; ya.z = ga.z * zb.x; ya.w = ga.w * zb.z;
            yb.x = gb.x * za.y; yb.y = gb.y * za.w; yb.z = gb.z * zb.y; yb.w = gb.w * zb.w;
            ha[q] = __builtin_convertvector(ya, f16x4); hb[q] = __builtin_convertvector(yb, f16x4);
        }
        *(f16x8*)(Yb + cidx(c, l0)) = __builtin_shufflevector(ha[0], ha[1], 0, 1, 2, 3, 4, 5, 6, 7);
        *(f16x8*)(Yb + cidx(c, SL + l0)) = __builtin_shufflevector(hb[0], hb[1], 0, 1, 2, 3, 4, 5, 6, 7);
    }
    __syncthreads();
}

__device__ __forceinline__ void fnet_job(const Params& p, int ch, char* lds) {
    const int tid = otid();
    float2* Z = (float2*)lds;
    const float* row = (const float*)(p.ws + R_HF) + (size_t)(768 + ch) * T;
    _Float16* UR = (_Float16*)(p.ws + R_UR);
    _Float16* UI = (_Float16*)(p.ws + R_UI);
    __syncthreads();
#pragma unroll
    for (int i = 0; i < 4; ++i) {
        const int l0 = 4 * tid + 2048 * i;
        const f32x4 a = *(const f32x4*)(row + l0), b = *(const f32x4*)(row + SL + l0);
        const int z0 = zp(l0);
        *(f32x4*)(Z + z0) = (f32x4){a.x, b.x, a.y, b.y}; *(f32x4*)(Z + z0 + 2) = (f32x4){a.z, b.z, a.w, b.w};
    }
    __syncthreads();
    fft8k_fwd(Z);
#pragma unroll 1
    for (int i = 0; i < 2; ++i) {
        const int k0 = 8 * tid + 4096 * i;
        f16x8 ur0, ui0, ur1, ui1;
#pragma unroll
        for (int e = 0; e < 8; ++e) {
            const int k = k0 + e;
            const int pk = p8k_of_f(k);
            const int pm = p8k_of_f((SL - k) & (SL - 1));
            const float2 zk = Z[zp(pk)], zm = Z[zp(pm)];
            ur0[e] = (_Float16)(0.5f * (zk.x + zm.x)); ui0[e] = (_Float16)(0.5f * (zk.y - zm.y));
            ur1[e] = (_Float16)(0.5f * (zk.y + zm.y)); ui1[e] = (_Float16)(0.5f * (zm.x - zk.x));
        }
        *(f16x8*)(UR + cidx(ch, k0)) = ur0; *(f16x8*)(UI + cidx(ch, k0)) = ui0; *(f16x8*)(UR + cidx(ch, SL + k0)) = ur1; *(f16x8*)(UI + cidx(ch, SL + k0)) = ui1;
    }
    __syncthreads();
}

__device__ __forceinline__ void phase_mix(const Params& p, int layer, char* lds) {
    const int tid = otid(), lane = tid & 63, wave = tid >> 6;
    const int l31 = lane & 31, hl = lane >> 5, g = wave & 3, tsel = wave >> 2;
    float* ex = (float*)lds;
    float* FMl = (float*)(lds + 8192);
    const _Float16* UR = (const _Float16*)(p.ws + R_UR); const _Float16* UI = (const _Float16*)(p.ws + R_UI);
    const _Float16* Y = (const _Float16*)(p.ws + R_Y);
    const bf16_t* att = (const bf16_t*)(p.ws + R_ATT);
    bf16_t* mix = (bf16_t*)(p.ws + R_MIX);
    const float* fb = p.in[I_FB] + layer * 256 + g * 64;
    const float* mg = p.in[I_MG] + layer * 1024;
    __syncthreads();
    {
        const f32x4* src = (const f32x4*)((const float*)(p.ws + OFF_FM) + (size_t)layer * 4 * 128 * 64);
#pragma unroll 4
        for (int i = 0; i < 16; ++i) *(f32x4*)(FMl + 4 * (tid + NTHR * i)) = src[tid + NTHR * i];
    }
    for (int tp = obid(); tp < T / 64; tp += NBLK) {
        const int t = (tp * 2 + tsel) * 32 + l31;
        u32x4 av[8];
#pragma unroll
        for (int i = 0; i < 8; ++i) av[i] = *(const u32x4*)(att + (size_t)(tp * 64 + wave * 8 + i) * 512 + lane * 8);
        float bv[64];
        {
            const _Float16* ub = UR + cidx(g * 64 + hl, t);
            const _Float16* ub2 = UI + cidx(g * 64 + hl, t);
#pragma unroll
            for (int i = 0; i < 32; ++i) { bv[i] = (float)ub[(2 * i) * 32]; bv[32 + i] = (float)ub2[(2 * i) * 32]; }
        }
        float yv[32];
        {
            const _Float16* yb = Y + cidx(g * 64 + hl * 32, t);
#pragma unroll
            for (int i = 0; i < 32; ++i) yv[i] = (float)yb[i * 32];
        }
        {
            const f32x4 g0 = *(const f32x4*)(mg + lane * 8), g1 = *(const f32x4*)(mg + lane * 8 + 4);
#pragma unroll
            for (int i = 0; i < 8; ++i) {
                const u32x4 a = av[i];
                const float x0 = bflo(a.x), x1 = bfhi(a.x), x2 = bflo(a.y), x3 = bfhi(a.y), x4 = bflo(a.z), x5 = bfhi(a.z), x6 = bflo(a.w), x7 = bfhi(a.w);
                const float ssq = wave_sum(x0 * x0 + x1 * x1 + x2 * x2 + x3 * x3 + x4 * x4 + x5 * x5 + x6 * x6 + x7 * x7);
                const float ra = rsqrtf(ssq * (1.0f / 512.0f) + EPS);
                u32x4 o;
                o.x = pk2(x0 * ra * g0.x, x1 * ra * g0.y); o.y = pk2(x2 * ra * g0.z, x3 * ra * g0.w);
                o.z = pk2(x4 * ra * g1.x, x5 * ra * g1.y); o.w = pk2(x6 * ra * g1.z, x7 * ra * g1.w);
                *(u32x4*)(mix + (size_t)(tp * 64 + wave * 8 + i) * 1024 + lane * 8) = o;
            }
        }
        __syncthreads();
        f32x16 acc0 = zero16(), acc1 = zero16();
        {
            const float* fa = FMl + (g * 128 + hl) * 64 + l31;
#pragma unroll
            for (int i = 0; i < 64; ++i) {
                const float a0 = fa[(2 * i) * 64], a1 = fa[(2 * i) * 64 + 32];
                acc0 = __builtin_amdgcn_mfma_f32_32x32x2f32(a0, bv[i], acc0, 0, 0, 0);
                acc1 = __builtin_amdgcn_mfma_f32_32x32x2f32(a1, bv[i], acc1, 0, 0, 0);
            }
        }
        float sf = 0.f;
#pragma unroll
        for (int i = 0; i < 4; ++i) {
            const f32x4 b0 = *(const f32x4*)(fb + 8 * i + 4 * hl), b1 = *(const f32x4*)(fb + 32 + 8 * i + 4 * hl);
            acc0[4 * i] += b0.x; acc0[4 * i + 1] += b0.y; acc0[4 * i + 2] += b0.z; acc0[4 * i + 3] += b0.w;
            acc1[4 * i] += b1.x; acc1[4 * i + 1] += b1.y; acc1[4 * i + 2] += b1.z; acc1[4 * i + 3] += b1.w;
        }
#pragma unroll
        for (int r = 0; r < 16; ++r) sf += acc0[r] * acc0[r] + acc1[r] * acc1[r];
        float sy = 0.f;
#pragma unroll
        for (int i = 0; i < 32; ++i) sy += yv[i] * yv[i];
        ex[(1 * 8 + wave) * 64 + lane] = sy; ex[(2 * 8 + wave) * 64 + lane] = sf;
        __syncthreads();
        float ty = 0.f, tf = 0.f;
#pragma unroll
        for (int w = 0; w < 4; ++w)
#pragma unroll
            for (int hh = 0; hh < 2; ++hh) {
                const int o = (tsel * 4 + w) * 64 + hh * 32 + l31;
                ty += ex[1 * 512 + o]; tf += ex[2 * 512 + o];
            }
        const float ry = rsqrtf(ty * (1.0f / 256.0f) + EPS), rf = rsqrtf(tf * (1.0f / 256.0f) + EPS);
        static_assert(T / 64 == NBLK, "one mix pass per workgroup: the stage overlays the FNet matrices");
        char* stg = lds + 8192;
        const int srow = tsel * 32 + l31, sx = srow & 15;
        char* srowp = stg + srow * 2048;
        {
            const float* gg = mg + 512 + g * 64 + hl * 32;
#pragma unroll
            for (int q = 0; q < 4; ++q) {
                const f32x4 g0 = *(const f32x4*)(gg + 8 * q), g1 = *(const f32x4*)(gg + 8 * q + 4);
                u32x4 o;
                o.x = pk2(yv[8 * q] * ry * g0.x, yv[8 * q + 1] * ry * g0.y); o.y = pk2(yv[8 * q + 2] * ry * g0.z, yv[8 * q + 3] * ry * g0.w);
                o.z = pk2(yv[8 * q + 4] * ry * g1.x, yv[8 * q + 5] * ry * g1.y); o.w = pk2(yv[8 * q + 6] * ry * g1.z, yv[8 * q + 7] * ry * g1.w);
                *(u32x4*)(srowp + (((512 + g * 64 + hl * 32 + 8 * q) >> 3) ^ sx) * 16) = o;
            }
        }
        {
            const float* gg = mg + 768 + g * 64;
#pragma unroll
            for (int i = 0; i < 4; ++i) {
                const f32x4 g0 = *(const f32x4*)(gg + 8 * i + 4 * hl), g1 = *(const f32x4*)(gg + 32 + 8 * i + 4 * hl);
                u32x2 o0, o1;
                o0.x = pk2(acc0[4 * i] * rf * g0.x, acc0[4 * i + 1] * rf * g0.y); o0.y = pk2(acc0[4 * i + 2] * rf * g0.z, acc0[4 * i + 3] * rf * g0.w);
                o1.x = pk2(acc1[4 * i] * rf * g1.x, acc1[4 * i + 1] * rf * g1.y); o1.y = pk2(acc1[4 * i + 2] * rf * g1.z, acc1[4 * i + 3] * rf * g1.w);
                *(u32x2*)(srowp + (((768 + g * 64 + 8 * i) >> 3) ^ sx) * 16 + 8 * hl) = o0;
                *(u32x2*)(srowp + (((768 + g * 64 + 32 + 8 * i) >> 3) ^ sx) * 16 + 8 * hl) = o1;
            }
        }
        __syncthreads();
#pragma unroll 4
        for (int i = 0; i < 8; ++i) {
            const int idx = tid + NTHR * i, r = idx >> 6, pc = 64 + (idx & 63), c = pc ^ (r & 15);
            const u32x4 v = *(const u32x4*)(stg + r * 2048 + pc * 16);
            *(u32x4*)(mix + (size_t)(tp * 64 + r) * 1024 + c * 8) = v;
        }
    }
}

__device__ __forceinline__ float tk_pack(float v, unsigned code, unsigned mask) { return __builtin_bit_cast(float, (__builtin_bit_cast(unsigned, v) & ~mask) | code); }
__device__ __forceinline__ unsigned tk_lookup(const unsigned (&P)[4], unsigned i) {
    const unsigned w = (i < 4u) ? P[0] : (i < 8u) ? P[1] : (i < 12u) ? P[2] : P[3];
    return (w >> ((i & 3u) * 8u)) & 0x7Fu;
}
__device__ __forceinline__ float gelu_exact(float x) { return 0.5f * x * (1.0f + erff(x * 0.70710678118654752f)); }
typedef float f32x2 __attribute__((ext_vector_type(2)));
#define CVT_LO(W) __builtin_amdgcn_cvt_pk_f32_fp8((int)(W), false)
#define CVT_HI(W) __builtin_amdgcn_cvt_pk_f32_fp8((int)(W), true)


__device__ constexpr unsigned char TK_OE_I[63] = {0,2,0,1,1,4,6,4,5,5,0,2,2,1,3,3,1,3,5,8,10,8,9,9,12,14,12,13,13,8,10,10,9,11,11,9,11,13,0,4,4,2,6,6,2,6,10,1,5,5,3,7,7,3,7,11,1,3,5,7,9,11,13};
__device__ constexpr unsigned char TK_OE_J[63] = {1,3,2,3,2,5,7,6,7,6,4,6,4,5,7,5,2,4,6,9,11,10,11,10,13,15,14,15,14,12,14,12,13,15,13,10,12,14,8,12,8,10,14,10,4,8,12,9,13,9,11,15,11,5,9,13,2,4,6,8,10,12,14};
__device__ __forceinline__ void tk_sort16(float (&a)[16]) {
#pragma unroll
    for (int t = 0; t < 63; ++t) {
        const int i = TK_OE_I[t], j = TK_OE_J[t];
        const float hi = fmaxf(a[i], a[j]), lo = fminf(a[i], a[j]);
        a[i] = hi; a[j] = lo;
    }
}
__device__ __forceinline__ void tk_merge16(float (&a)[16]) {
#pragma unroll
    for (int j = 8; j > 0; j >>= 1)
#pragma unroll
        for (int i = 0; i < 16; ++i) {
            const int l = i ^ j;
            if (l > i) { const float hi = fmaxf(a[i], a[l]), lo = fminf(a[i], a[l]); a[i] = hi; a[l] = lo; }
        }
}
__device__ __forceinline__ void tk_top16_merge(float (&l)[16], const float (&g)[16]) {
#pragma unroll
    for (int i = 0; i < 16; ++i) l[i] = fmaxf(l[i], g[15 - i]);
    tk_merge16(l);
}
template <int CTRL> __device__ __forceinline__ float dpp_f(float v) { return __builtin_bit_cast(float, __builtin_amdgcn_update_dpp(0, __builtin_bit_cast(int, v), CTRL, 0xF, 0xF, false)); }
template <int CTRL> __device__ __forceinline__ int dpp_i(int v) { return __builtin_amdgcn_update_dpp(0, v, CTRL, 0xF, 0xF, false); }
constexpr int PE_LOGR = 4, PE_NR = 1 << PE_LOGR;
constexpr int PE_ENT = 12 * 1024;
constexpr int PE_WAVE = PE_ENT;


#define PE_RL(k) (((k & 4) << 1) | ((k & 2) << 3) | ((k & 1) << 5))
#define PE_LOAD_U(TK, RW, EV, CU, CG) do { \
        const int base_ = ((TK) * 128 + r * 8 + eid) * 3; \
        CU = __builtin_bit_cast(float, ent[base_ + 1]); CG = __builtin_bit_cast(float, ent[base_ + 2]); \
        const int* eb_ = ent + ((TK) * 128 + r * 8) * 3;     \
        _Pragma("unroll") for (int k = 0; k < 8; ++k) { const unsigned e = (unsigned)eb_[k * 3]; \
            RW[k] = *(const u32x4*)(PU + (size_t)((e << 10) + loff)); } \
    } while (0)
#define PE_COMP_U(TK, RW, CU, CG) do { \
        int d[8]; \
        _Pragma("unroll") for (int k = 0; k < 8; ++k) { int s_ = __builtin_amdgcn_sdot4((int)RW[k].x, xq[TK][0], 0, false); \
            s_ = __builtin_amdgcn_sdot4((int)RW[k].y, xq[TK][1], s_, false); s_ = __builtin_amdgcn_sdot4((int)RW[k].z, xq[TK][2], s_, false); \
            d[k] = __builtin_amdgcn_sdot4((int)RW[k].w, xq[TK][3], s_, false); } \
        _Pragma("unroll") for (int k = 0; k < 8; ++k) { d[k] += dpp_i<0xB1>(d[k]); d[k] += dpp_i<0x4E>(d[k]); d[k] += dpp_i<0x141>(d[k]); } \
        int r4[4], r2[2], u1; \
        _Pragma("unroll") for (int k = 0; k < 4; ++k) { const int send = b3 ? d[k] : d[k + 4], keep = b3 ? d[k + 4] : d[k]; r4[k] = keep + dpp_i<0x140>(send); } \
        _Pragma("unroll") for (int k = 0; k < 2; ++k) { const int send = b4 ? r4[k] : r4[k + 2], keep = b4 ? r4[k + 2] : r4[k]; r2[k] = keep + __shfl_xor(send, 16); } \
        { const int send = b5 ? r2[0] : r2[1], keep = b5 ? r2[1] : r2[0]; u1 = keep + __shfl_xor(send, 32); } \
        const float av = gelu_exact((float)u1 * (CU * sx[TK])) * CG; \
        if ((lane & 7) == 0) ent[((TK) * 128 + r * 8 + eid) * 3 + 1] = __builtin_bit_cast(int, av);     \
    } while (0)
#define PE_LOAD_V(TK, RW, AV) do { \
        const int* eb_ = ent + ((TK) * 128 + r * 8) * 3;     \
        _Pragma("unroll") for (int k = 0; k < 8; ++k) { const unsigned e = (unsigned)eb_[k * 3]; \
            RW[k] = *(const u32x4*)(PV + (size_t)((e << 10) + loff)); } \
    } while (0)
#define PE_COMP_V(TK, RW, AV) do { \
        const int* eb_ = ent + ((TK) * 128 + r * 8) * 3; \
        int cw_[8];      \
        _Pragma("unroll") for (int k = 0; k < 8; ++k) cw_[k] = eb_[k * 3 + 1]; \
        _Pragma("unroll") for (int kp = 0; kp < 4; ++kp) { \
            const u32x4 ra_ = RW[2 * kp], rb_ = RW[2 * kp + 1]; const int cl_ = cw_[2 * kp], ch_ = cw_[2 * kp + 1]; \
            _Pragma("unroll") for (int j = 0; j < 4; ++j) { \
                const int p_ = (int)__builtin_amdgcn_perm(rb_[j], ra_[j], 0x05010400u), q_ = (int)__builtin_amdgcn_perm(rb_[j], ra_[j], 0x07030602u);     \
                acc[TK][4 * j + 0] = __builtin_amdgcn_sdot4(p_, cl_, acc[TK][4 * j + 0], false); acc[TK][4 * j + 1] = __builtin_amdgcn_sdot4(p_, ch_, acc[TK][4 * j + 1], false); \
                acc[TK][4 * j + 2] = __builtin_amdgcn_sdot4(q_, cl_, acc[TK][4 * j + 2], false); acc[TK][4 * j + 3] = __builtin_amdgcn_sdot4(q_, ch_, acc[TK][4 * j + 3], false); } } \
    } while (0)

template <bool DRY> __device__ __forceinline__ void phase_peer_fused(const Params& p, int layer, char* lds) {
    const int tid = otid(), lane = tid & 63, wave = tid >> 6;
    const unsigned char* PU = p.ws + OFF_PU + (size_t)layer * 16384 * 1024;
    const unsigned char* PV = p.ws + OFF_PV + (size_t)layer * 16384 * 1024;
    const float* SU = (const float*)(p.ws + OFF_PSC) + (size_t)layer * 16384;
    const float* SV = (const float*)(p.ws + OFF_PSC) + (size_t)(2 + layer) * 16384;
    bf16_t* XN = (bf16_t*)(p.ws + R_XN);
    bf16_t* XA16 = (bf16_t*)(p.ws + OFF_XA);
    const _Float16* SC = (const _Float16*)(p.ws + R_QP);
    const bool last = (layer == NLAYER - 1);
    const float* gnext = last ? p.in[I_FG] : p.in[I_N1G] + (layer + 1) * DM;
    const float* g2p = p.in[I_N2G] + layer * DM;
    const bool b5 = (lane & 32) != 0, b4 = (lane & 16) != 0, b3 = (lane & 8) != 0;
    const int eid = ((lane >> 3) & 1) * 4 + ((lane >> 4) & 1) * 2 + (lane >> 5);
    const unsigned loff = (unsigned)lane * 16u;
    int* ent = (int*)(lds + wave * PE_WAVE);
    const float NINF = -3.0e38f;
    const int pp = lane & 1;
    for (int tb = (obid() * NWAVE + wave) * 8; tb < T; tb += NBLK * NWAVE * 8) {
#pragma unroll 1
        for (int grp = 0; grp < 2; ++grp) {
            const int tkl = grp * 4 + (lane >> 4), h = (lane >> 1) & 7;
            const f16x8* src = (const f16x8*)(SC + (size_t)(tb + tkl) * 2048 + h * 256 + pp * 128);
            float l[16];
#pragma unroll
            for (int i = 0; i < 16; ++i) l[i] = NINF;
            f16x8 hraw[16];
#pragma unroll
            for (int j = 0; j < 16; ++j) hraw[j] = src[j];
#pragma unroll
            for (int c2 = 0; c2 < 2; ++c2) {
#pragma unroll
            for (int cc = 0; cc < 2; ++cc) {
                const int c = c2 * 2 + cc;
                f32x4 v[8];
#pragma unroll
                for (int j = 0; j < 4; ++j) {
                    const f16x8 hv = hraw[c2 * 8 + cc * 4 + j];
                    v[2 * j] = (f32x4){(float)hv[0], (float)hv[1], (float)hv[2], (float)hv[3]};
                    v[2 * j + 1] = (f32x4){(float)hv[4], (float)hv[5], (float)hv[6], (float)hv[7]};
                }
#pragma unroll
                for (int hh = 0; hh < 2; ++hh) {
                    float g[16];
#pragma unroll
                    for (int j = 0; j < 4; ++j) {
                        const unsigned kb = (unsigned)(c * 32 + hh * 16 + j * 4);
                        g[4 * j] = tk_pack(v[hh * 4 + j].x, kb, 0x7Fu); g[4 * j + 1] = tk_pack(v[hh * 4 + j].y, kb + 1u, 0x7Fu);
                        g[4 * j + 2] = tk_pack(v[hh * 4 + j].z, kb + 2u, 0x7Fu); g[4 * j + 3] = tk_pack(v[hh * 4 + j].w, kb + 3u, 0x7Fu);
                    }
                    tk_sort16(g);
                    tk_top16_merge(l, g);
                }
            }
            }
            float xw[16], ow[16]; unsigned PX[4] = {0u, 0u, 0u, 0u}, PO[4] = {0u, 0u, 0u, 0u};
#pragma unroll
            for (int i = 0; i < 16; ++i) {
                const float o = __shfl_xor(l[i], 1);
                const unsigned xb = __builtin_bit_cast(unsigned, l[i]), ob = __builtin_bit_cast(unsigned, o);
                xw[i] = __builtin_bit_cast(float, xb & ~0x7Fu); ow[i] = __builtin_bit_cast(float, ob & ~0x7Fu);
                PX[i >> 2] |= (xb & 0x7Fu) << ((i & 3) * 8); PO[i >> 2] |= (ob & 0x7Fu) << ((i & 3) * 8);
            }
            float f[16];
            {
                float c1[16];
#pragma unroll
                for (int i = 0; i < 16; ++i) { f[i] = NINF; c1[i] = NINF; }
                int cnt = 0;
#pragma unroll
                for (int i = 0; i < 16; ++i)
#pragma unroll
                    for (int j = i; j < 16; ++j)
                        if ((i + 1) * (j + 1) <= 16) {
                            float cv = xw[i] + ow[j];
                            const unsigned code = pp ? (unsigned)((j << 4) | i) : (unsigned)((i << 4) | j);
                            cv = tk_pack(cv, code, 0xFFu);
                            if (i == j) cv = pp ? NINF : cv;
                            if (cnt < 16) f[cnt & 15] = cv; else c1[cnt & 15] = cv;
                            ++cnt;
                        }
                tk_sort16(f); tk_sort16(c1);
                tk_top16_merge(f, c1);
                float gq[16];
#pragma unroll
                for (int i = 0; i < 16; ++i) gq[i] = __shfl_xor(f[i], 1);
                tk_top16_merge(f, gq);
            }
            unsigned P0[4], P1[4];
#pragma unroll
            for (int q = 0; q < 4; ++q) { P0[q] = pp ? PO[q] : PX[q]; P1[q] = pp ? PX[q] : PO[q]; }
            const float top = __builtin_bit_cast(float, __builtin_bit_cast(unsigned, f[0]) & ~0xFFu);
            float ev[16]; float den = 0.f;
#pragma unroll
            for (int r = 0; r < 16; ++r) { ev[r] = __expf(__builtin_bit_cast(float, __builtin_bit_cast(unsigned, f[r]) & ~0xFFu) - top); den += ev[r]; }
            const float rden = 1.0f / den;
#pragma unroll
            for (int r8 = 0; r8 < 8; ++r8) {
                const unsigned c0 = __builtin_bit_cast(unsigned, f[r8]) & 0xFFu, c1 = __builtin_bit_cast(unsigned, f[r8 + 8]) & 0xFFu;
                const unsigned code = pp ? c1 : c0;
                const float gate = (pp ? ev[r8 + 8] : ev[r8]) * rden;
                const int e = (int)(tk_lookup(P0, code >> 4) * 128u + tk_lookup(P1, code & 15u));
                const int o = (tkl * 128 + h * 16 + pp * 8 + r8) * 3;
                ent[o] = e; ent[o + 1] = __builtin_bit_cast(int, SU[e]); ent[o + 2] = __builtin_bit_cast(int, gate * SV[e]);
            }
        }
        {
            int* cnt = (int*)(lds + NWAVE * PE_WAVE) + wave * 16;
#pragma unroll 1
            for (int tk = 0; tk < 8; ++tk) {
                int* et = ent + tk * 384;
                const int eA = et[lane * 3], uA = et[lane * 3 + 1], gA = et[lane * 3 + 2];
                const int eB = et[(64 + lane) * 3], uB = et[(64 + lane) * 3 + 1], gB = et[(64 + lane) * 3 + 2];
                const int rA = eA >> (14 - PE_LOGR), rB = eB >> (14 - PE_LOGR);
                if (lane < 16) cnt[lane] = 0;
                __builtin_amdgcn_wave_barrier();
                atomicAdd(&cnt[rA], 1); atomicAdd(&cnt[rB], 1);
                __builtin_amdgcn_wave_barrier();
                const int c = cnt[lane & 15];
                int inc = c;
                inc += __builtin_amdgcn_update_dpp(0, inc, 0x111, 0xF, 0xF, false);
                inc += __builtin_amdgcn_update_dpp(0, inc, 0x112, 0xF, 0xF, false);
                inc += __builtin_amdgcn_update_dpp(0, inc, 0x114, 0xF, 0xF, false);
                inc += __builtin_amdgcn_update_dpp(0, inc, 0x118, 0xF, 0xF, false);
                __builtin_amdgcn_wave_barrier();
                if (lane < 16) cnt[lane] = inc - c;
                __builtin_amdgcn_wave_barrier();
                const int qA = atomicAdd(&cnt[rA], 1), qB = atomicAdd(&cnt[rB], 1);
                __builtin_amdgcn_wave_barrier();
                et[qA * 3] = eA; et[qA * 3 + 1] = uA; et[qA * 3 + 2] = gA;
                et[qB * 3] = eB; et[qB * 3 + 1] = uB; et[qB * 3 + 2] = gB;
            }
        }
        {
            {
                int xq[8][4]; float sx[8];
#pragma unroll
                for (int tk = 0; tk < 8; ++tk) {
                    f32x4 xr[4]; float ss = 0.f;
#pragma unroll
                    for (int j = 0; j < 4; ++j) { const u32x2 xw = *(const u32x2*)(XN + (size_t)(tb + tk) * DM + 4 * lane + 256 * j); xr[j] = (f32x4){bflo(xw.x), bfhi(xw.x), bflo(xw.y), bfhi(xw.y)}; ss += xr[j].x * xr[j].x + xr[j].y * xr[j].y + xr[j].z * xr[j].z + xr[j].w * xr[j].w; }
                    ss = wave_sum(ss);
                    const float rn = rsqrtf(ss * (1.0f / DM) + EPS);
                    float mx = 0.f;
#pragma unroll
                    for (int j = 0; j < 4; ++j) { const f32x4 gg = *(const f32x4*)(g2p + 4 * lane + 256 * j);
                        xr[j] = xr[j] * rn * gg; mx = fmaxf(mx, fmaxf(fmaxf(fabsf(xr[j].x), fabsf(xr[j].y)), fmaxf(fabsf(xr[j].z), fabsf(xr[j].w)))); }
                    mx = wave_max(mx);
                    const float qs = mx > 0.f ? 127.0f / mx : 1.0f;
                    sx[tk] = mx > 0.f ? mx * (1.0f / 127.0f) : 1.0f;
#pragma unroll
                    for (int j = 0; j < 4; ++j) xq[tk][j] = (int)pk_i8(xr[j] * qs);
                }
#pragma unroll 1
                for (int r = 0; r < 16; ++r) {
                    __syncthreads();
                    u32x4 rwA[8], rwB[8]; int evA, evB; float cuA, cgA, cuB, cgB;
                    PE_LOAD_U(0, rwA, evA, cuA, cgA);
                    PE_LOAD_U(1, rwB, evB, cuB, cgB); PE_COMP_U(0, rwA, cuA, cgA);
                    PE_LOAD_U(2, rwA, evA, cuA, cgA); PE_COMP_U(1, rwB, cuB, cgB);
                    PE_LOAD_U(3, rwB, evB, cuB, cgB); PE_COMP_U(2, rwA, cuA, cgA);
                    PE_LOAD_U(4, rwA, evA, cuA, cgA); PE_COMP_U(3, rwB, cuB, cgB);
                    PE_LOAD_U(5, rwB, evB, cuB, cgB); PE_COMP_U(4, rwA, cuA, cgA);
                    PE_LOAD_U(6, rwA, evA, cuA, cgA); PE_COMP_U(5, rwB, cuB, cgB);
                    PE_LOAD_U(7, rwB, evB, cuB, cgB); PE_COMP_U(6, rwA, cuA, cgA);
                    PE_COMP_U(7, rwB, cuB, cgB);
                }
            }
#pragma unroll 1
            for (int tk = 0; tk < 8; ++tk) {
                int* et = ent + tk * 384;
                const float cA = __builtin_bit_cast(float, et[lane * 3 + 1]), cB = __builtin_bit_cast(float, et[(64 + lane) * 3 + 1]);
                const float mx = wave_max(fmaxf(fabsf(cA), fabsf(cB)));
                const float qs = mx > 0.f ? 127.0f / mx : 0.f;
                const int qA = (int)rintf(cA * qs) & 0xFF, qB = (int)rintf(cB * qs) & 0xFF;
                const int pA = __shfl_xor(qA, 1), pB = __shfl_xor(qB, 1);
                const int wA = (lane & 1) ? ((pA | (qA << 8)) << 16) : (qA | (pA << 8));
                const int wB = (lane & 1) ? ((pB | (qB << 8)) << 16) : (qB | (pB << 8));
                et[lane * 3 + 1] = wA; et[(64 + lane) * 3 + 1] = wB;
                if (lane == 0) et[2] = __builtin_bit_cast(int, mx * (1.0f / 127.0f));
            }
#pragma unroll 1
            for (int hv = 0; hv < 2; ++hv) {
            int acc[4][16];
#pragma unroll
            for (int tk = 0; tk < 4; ++tk)
#pragma unroll
                for (int j = 0; j < 16; ++j) acc[tk][j] = 0;
            const int* entv = ent;
            {
                int* ent = (int*)entv + hv * 4 * 128 * 3;
#pragma unroll 1
                for (int r = 0; r < 16; ++r) {
                    __syncthreads();
                    u32x4 rwA[8], rwB[8]; int avA, avB;
                    PE_LOAD_V(0, rwA, avA);
                    PE_LOAD_V(1, rwB, avB); PE_COMP_V(0, rwA, avA);
                    PE_LOAD_V(2, rwA, avA); PE_COMP_V(1, rwB, avB);
                    PE_LOAD_V(3, rwB, avB); PE_COMP_V(2, rwA, avA);
                    PE_COMP_V(3, rwB, avB);
                }
            }
#pragma unroll
            for (int tk = 0; tk < 4; ++tk) {
                const int t = tb + hv * 4 + tk;
                f32x4 x[4]; float ss = 0.f;
                const float tsc = __builtin_bit_cast(float, entv[((hv * 4 + tk) * 128) * 3 + 2]);
#pragma unroll
                for (int j = 0; j < 4; ++j) {
                    { const u32x2 xw = *(const u32x2*)(XN + (size_t)t * DM + 4 * lane + 256 * j); x[j] = (f32x4){bflo(xw.x), bfhi(xw.x), bflo(xw.y), bfhi(xw.y)}; }
                    x[j].x += (float)acc[tk][4 * j] * tsc; x[j].y += (float)acc[tk][4 * j + 1] * tsc; x[j].z += (float)acc[tk][4 * j + 2] * tsc; x[j].w += (float)acc[tk][4 * j + 3] * tsc;
                    ss += x[j].x * x[j].x + x[j].y * x[j].y + x[j].z * x[j].z + x[j].w * x[j].w;
                }
                ss = wave_sum(ss);
                const float rr = rsqrtf(ss * (1.0f / DM) + EPS);
                if (last) {
#pragma unroll
                    for (int j = 0; j < 4; ++j) { const f32x4 gg = *(const f32x4*)(gnext + 4 * lane + 256 * j); *(f32x4*)(p.out + (size_t)t * DM + 4 * lane + 256 * j) = x[j] * rr * gg; }
                } else {
#pragma unroll
                    for (int j = 0; j < 4; ++j) {
                        const f32x4 gg = *(const f32x4*)(gnext + 4 * lane + 256 * j);
                        u32x2 w; w.x = pk2(x[j].x * rr * gg.x, x[j].y * rr * gg.y); w.y = pk2(x[j].z * rr * gg.z, x[j].w * rr * gg.w);
                        if (DRY) *(f32x4*)(p.out + (size_t)t * DM + 4 * lane + 256 * j) = x[j];
                        else { u32x2 xo; xo.x = pk2(x[j].x, x[j].y); xo.y = pk2(x[j].z, x[j].w);
                               *(u32x2*)(XA16 + (size_t)t * DM + 4 * lane + 256 * j) = xo; *(u32x2*)(XN + (size_t)t * DM + 4 * lane + 256 * j) = w; }
                    }
                }
            }
            }
        }
    }
}

#define LAS __attribute__((address_space(3)))
#define XB_TMO      128
#define XB_XCNT(j)  (256  + 64 * (j))
#define XB_XSUB(j)  (1280 + 64 * (j))
#define XB_XGEN(j)  (2304 + 64 * (j))
#define XB_TOP      3328
#define XB_TOPGEN   3392
#define XCD_BAR_WORDS 3456
#define XB_SPIN_CAP (1u << 20)
__device__ __forceinline__ unsigned xb_ld(unsigned* p)              { return __hip_atomic_load(p, __ATOMIC_RELAXED, __HIP_MEMORY_SCOPE_AGENT); }
__device__ __forceinline__ unsigned xb_add(unsigned* p, unsigned v) { return __hip_atomic_fetch_add(p, v, __ATOMIC_RELAXED, __HIP_MEMORY_SCOPE_AGENT); }
__device__ __forceinline__ unsigned xb_xcc_id() { return (unsigned)__builtin_amdgcn_s_getreg((3 << 11) | 20) & 0xFu; }
#define XB_SPIN(cond, bar) do { unsigned _sp = 0; while (cond) { __builtin_amdgcn_s_sleep(1); \
    if ((++_sp & 255u) == 0u) { if (xb_ld(&(bar)[XB_TMO])) break; if (_sp > XB_SPIN_CAP) { atomicAdd(&(bar)[XB_TMO], 1u); break; } } } } while (0)
struct XcdBarrier { unsigned* bar; unsigned x; volatile LAS unsigned* st; };
__device__ __forceinline__ XcdBarrier xcd_barrier_post(unsigned* bar, volatile LAS unsigned* st) {
    XcdBarrier b; b.bar = bar; b.x = xb_xcc_id(); b.st = st;
    if (threadIdx.x == 0) (void)xb_add(&bar[XB_XCNT(b.x)], 1u);
    return b;
}
__device__ __forceinline__ void xcd_barrier_complete(unsigned* bar, unsigned x, unsigned& nloc, unsigned& nx) {
    const unsigned G = NBLK;
    unsigned sum, cnt, mine, sp = 0u;
    for (;;) {
        sum = 0u; cnt = 0u; mine = 0u;
#pragma unroll
        for (unsigned j = 0; j < 16; ++j) { const unsigned c = xb_ld(&bar[XB_XCNT(j)]); sum += c; cnt += (c > 0u) ? 1u : 0u; mine = (j == x) ? c : mine; }
        if (sum == G) break;
        __builtin_amdgcn_s_sleep(1);
        if ((++sp & 255u) == 0u) { if (xb_ld(&bar[XB_TMO])) break; if (sp > XB_SPIN_CAP) { atomicAdd(&bar[XB_TMO], 1u); break; } }
    }
    nloc = mine > 0u ? mine : 1u; nx = cnt > 0u ? cnt : 1u;
}
__device__ __forceinline__ void xcd_barrier(const XcdBarrier& b) {
    asm volatile("s_waitcnt vmcnt(0)" ::: "memory");
    __syncthreads();
    if (threadIdx.x == 0) {
        unsigned* bar = b.bar;
        __builtin_amdgcn_s_waitcnt(0);
        unsigned nloc = b.st[0], nx = b.st[1];
        if (nloc == 0u) { xcd_barrier_complete(bar, b.x, nloc, nx); b.st[0] = nloc; b.st[1] = nx; }
        const unsigned old = xb_add(&bar[XB_XSUB(b.x)], 1u);
        const unsigned gen = old / nloc;
        if (old + 1u == (gen + 1u) * nloc) {
            __builtin_amdgcn_fence(__ATOMIC_RELEASE, "agent");
            asm volatile("s_waitcnt vmcnt(0)" ::: "memory");
            const unsigned og = xb_add(&bar[XB_TOP], 1u);
            const unsigned tg = og / nx;
            if (og + 1u == (tg + 1u) * nx) xb_add(&bar[XB_TOPGEN], 1u);
            else XB_SPIN(xb_ld(&bar[XB_TOPGEN]) == tg, bar);
            __builtin_amdgcn_fence(__ATOMIC_ACQUIRE, "agent");
            xb_add(&bar[XB_XGEN(b.x)], 1u);
            asm volatile("s_waitcnt vmcnt(0)" ::: "memory");
        } else {
            XB_SPIN(xb_ld(&bar[XB_XGEN(b.x)]) == gen, bar);
            __builtin_amdgcn_fence(__ATOMIC_ACQUIRE, "agent");
            asm volatile("s_waitcnt vmcnt(0)" ::: "memory");
        }
    }
    __syncthreads();
}


template <class Epi> __device__ __forceinline__ void big_gemm(const bf16_t* A, const bf16_t* Bt, int M, int N, int K, char* lds, const Epi& e) {
    pg8::Gemm g{A, Bt, M, N, K}; pg8::StaticOrder S; S.init(M, N, NBLK, obid());
    pg8::gemm_phase<Epi, pg8::StaticOrder, true, true>((PG8_LAS unsigned char*)lds, g, S, e);
}

#define GSYNC() xcd_barrier(xbar)
template <int layer> __device__ __forceinline__ void run_layer(const Params& p, char* lds, const XcdBarrier& xbar) {
    float* XA = (float*)(p.ws + OFF_XA);

        {
            const bf16_t* wt = (const bf16_t*)(p.ws + OFF_WTIN) + (size_t)layer * INC * DM;
            pg8::EpiQKV2 e1{(bf16_t*)(p.ws + R_QKV), p.in[I_QG] + layer * 64, p.in[I_KG] + layer * 64};
            big_gemm((const bf16_t*)(p.ws + R_XN), wt, T, 768, DM, lds, e1);
            pg8::EpiStoreF32 e2{nullptr, (float*)(p.ws + R_HF), T};
            big_gemm(wt + (size_t)768 * DM, (const bf16_t*)(p.ws + R_XN), 1024, T, DM, lds, e2);
        }
        if (layer == 0) {
#pragma nounroll
            for (int fl = 0; fl < NLAYER; ++fl) {
                EpiF32 e{(float*)(p.ws + (fl ? OFF_HFILT1 : OFF_HFILT0)), SL};
                gemm_simple((const bf16_t*)(p.ws + OFF_W3T) + (size_t)fl * 1024 * 64, (const bf16_t*)(p.ws + OFF_H2) + (size_t)fl * SL * 64, 1024, SL, 64, lds, e);
            }
        }
        GSYNC();
        {
            const int grp = (obid() >> 3) % 3;
#define RL_FFT() do { \
                if (layer == 0) { phase_filter_spectra(p, lds); asm volatile("s_waitcnt vmcnt(0)" ::: "memory"); __syncthreads(); } \
                for (int c = obid(); c < 256; c += NBLK) hyena_job(p, layer, c, lds); \
                for (int c = obid(); c < 256; c += NBLK) fnet_job(p, c, lds); } while (0)
            if (grp == 0) {
                RL_FFT();
                __syncthreads();
                phase_attn(p, layer, lds, 0, 2);
            } else if (grp == 1) {
                phase_attn(p, layer, lds, 0, 1);
                RL_FFT();
                __syncthreads();
                phase_attn(p, layer, lds, 1, 2);
            } else {
                phase_attn(p, layer, lds, 0, 2);
                RL_FFT();
            }
#undef RL_FFT
        } GSYNC();
        phase_mix(p, layer, lds); GSYNC();
        { pg8::EpiOutProjT<(layer > 0)> e{layer == 0 ? (const void*)p.in[I_X] : (const void*)(p.ws + OFF_XA), (bf16_t*)(p.ws + R_XN), (float*)(p.ws + OFF_RS)};
          big_gemm((const bf16_t*)(p.ws + R_MIX), (const bf16_t*)(p.ws + OFF_WTOUT) + (size_t)layer * DM * DM, T, DM, DM, lds, e); } GSYNC();
        { pg8::EpiRowScaleF16 e{(_Float16*)(p.ws + R_QP), 2048, (const float*)(p.ws + OFF_RS)};
          big_gemm((const bf16_t*)(p.ws + R_XN), (const bf16_t*)(p.ws + OFF_WTQ) + (size_t)layer * 2048 * DM, T, 2048, DM, lds, e); } GSYNC();
        phase_peer_fused<false>(p, layer, lds);
        if (layer + 1 < NLAYER) GSYNC();
}

__global__ void __launch_bounds__(NTHR) mega_kernel(Params p) {
    extern __shared__ __attribute__((aligned(16))) char lds[];
    volatile LAS unsigned* misc = (volatile LAS unsigned*)((LAS char*)lds + LDS_MISC);
    if (threadIdx.x < 16) misc[threadIdx.x] = 0u;
    __syncthreads();
    const XcdBarrier xbar = xcd_barrier_post((unsigned*)(p.ws + OFF_CTL) + 4096, misc);
    float* XA = (float*)(p.ws + OFF_XA);
    phase_p0(p, lds);
    phase_rmsnorm_bf16(p.in[I_X], p.in[I_N1G], (bf16_t*)(p.ws + R_XN));
    GSYNC();
    run_layer<0>(p, lds, xbar);
    run_layer<1>(p, lds, xbar);
}

extern "C" void kernel_launch(void* const* d_in, const int* in_sizes, int n_in, void* d_out, int out_size, void* d_ws, size_t ws_size, hipStream_t stream) {
    static int grid = 0;
    if (grid == 0) {
        if (n_in != 25 || out_size != T * DM || ws_size < WS_NEED) { fprintf(stderr, "kernel_launch: unexpected sizes n_in %d out %d ws %zu (need %zu)\n", n_in, out_size, ws_size, (size_t)WS_NEED); grid = -1; return; }
        int dev = 0, cus = 0, per_cu = 0;
        if (hipGetDevice(&dev) != hipSuccess || hipDeviceGetAttribute(&cus, hipDeviceAttributeMultiprocessorCount, dev) != hipSuccess) { grid = -1; return; }
        if (hipFuncSetAttribute((const void*)mega_kernel, hipFuncAttributeMaxDynamicSharedMemorySize, LDS_BYTES) != hipSuccess) { fprintf(stderr, "kernel_launch: hipFuncSetAttribute failed\n"); grid = -1; return; }
        if (hipOccupancyMaxActiveBlocksPerMultiprocessor(&per_cu, (const void*)mega_kernel, NTHR, LDS_BYTES) != hipSuccess || per_cu < 1) { fprintf(stderr, "kernel_launch: occupancy query says %d blocks per CU\n", per_cu); grid = -1; return; }
        (void)hipGetLastError();
        if (cus < NBLK) { fprintf(stderr, "kernel_launch: built for a %d-CU device, found %d CUs\n", NBLK, cus); grid = -1; return; }
        grid = NBLK;
    }
    if (grid < 0) return;
    Params p{};
    for (int i = 0; i < 25; ++i) p.in[i] = (const float*)d_in[i];
    p.out = (float*)d_out; p.ws = (unsigned char*)d_ws;
    if (hipMemsetAsync((char*)d_ws + OFF_CTL, 0, 64 * 1024, stream) != hipSuccess) { fprintf(stderr, "kernel_launch: memset failed\n"); return; }
    void* args[] = {&p};
    hipError_t e = hipLaunchCooperativeKernel((const void*)mega_kernel, dim3(grid), dim3(NTHR), args, LDS_BYTES, stream);
    if (e != hipSuccess) fprintf(stderr, "cooperative launch failed: %s (grid %d)\n", hipGetErrorString(e), grid);
}
```
